# Optimizing an MI355X kernel written in HIP

```python
import jax, jax.numpy as jnp
from jax import lax
import numpy as np


D_MODEL = 2048
BATCH = 8
SEQ = 2048
DEPTH = 1

CHUNK = 64
Q_BLOCK = 128
EPS = 1e-6

H_A = 8
D_LATENT = 128
DH_A = 128
H_IDX = 8
D_IDX = 64
TOPK_MAX = 256

H_R = 8
DK_R = 128
DV_R = 128
ROPE_BASE = 10000.0

D_BRANCH = 1024
N_BRANCH = 2

N_GROUPS = 4
EXP_PER_GROUP = 8
N_EXPERTS = N_GROUPS * EXP_PER_GROUP
TOP_K_EXP = 2
D_EXPERT = 1024
EXPERT_BLOCK = 128

SPLITS = (H_A * D_LATENT,
          D_LATENT,
          H_IDX * D_IDX,
          D_IDX,
          H_IDX,
          H_R * DK_R,
          H_R * DK_R,
          H_R * DV_R,
          H_R * DV_R,
          N_BRANCH * D_MODEL)
D_IN = sum(SPLITS)

kernel_name = "hybrid_dsa_retention_hmoe_block"


def rms_norm(x, g):
    xf = x.astype(jnp.float32)
    y = xf * lax.rsqrt(jnp.mean(xf * xf, axis=-1, keepdims=True) + EPS)
    return (y * g.astype(jnp.float32)).astype(x.dtype)


def head_group_norm(o, g):
    b, s = o.shape[:2]
    of = o.astype(jnp.float32)
    mu = jnp.mean(of, axis=-1, keepdims=True)
    var = jnp.mean(jnp.square(of - mu), axis=-1, keepdims=True)
    y = ((of - mu) * lax.rsqrt(var + EPS)).reshape(b, s, -1)
    return (y * g.astype(jnp.float32)).astype(o.dtype)


def rotary(x, pos):
    half = x.shape[-1] // 2
    freq = ROPE_BASE ** (-jnp.arange(half, dtype=jnp.float32) / half)
    ang = pos.astype(jnp.float32)[:, None] * freq[None, :]
    cos = jnp.cos(ang)[None, :, None, :].astype(x.dtype)
    sin = jnp.sin(ang)[None, :, None, :].astype(x.dtype)
    x1, x2 = x[..., :half], x[..., half:]
    return jnp.concatenate([x1 * cos - x2 * sin, x1 * sin + x2 * cos], axis=-1)


def sparse_indexer_attention(q_lat, kv, q_idx, k_idx, w_idx, w_uv):
    b, s = kv.shape[:2]
    n_sel = min(TOPK_MAX, s // 4)
    nb = s // Q_BLOCK
    key_chunk = jnp.arange(s) // CHUNK
    idx_scale = (H_IDX ** -0.5) * (D_IDX ** -0.5)
    attn_scale = D_LATENT ** -0.5

    def to_blocks(t):
        return jnp.moveaxis(t.reshape((b, nb, Q_BLOCK) + t.shape[2:]), 1, 0)

    def block(args):
        q_blk, qi_blk, wi_blk, start = args
        q_chunk = (start + jnp.arange(Q_BLOCK)) // CHUNK
        dots = jnp.einsum('bqhd,bsd->bqhs', qi_blk, k_idx).astype(jnp.float32)
        score = jnp.einsum('bqh,bqhs->bqs', wi_blk.astype(jnp.float32), jax.nn.relu(dots)) * idx_scale
        admissible = key_chunk[None, :] <= q_chunk[:, None]
        score = jnp.where(admissible[None], score, -jnp.inf)
        _, sel = lax.top_k(score, n_sel)
        kv_sel = jax.vmap(lambda kv_b, sel_b: kv_b[sel_b])(kv, sel)
        valid = key_chunk[sel] <= q_chunk[None, :, None]
        logits = jnp.einsum('bqhc,bqkc->bqhk', q_blk, kv_sel).astype(jnp.float32) * attn_scale
        logits = jnp.where(valid[:, :, None, :], logits, -jnp.inf)
        p = jax.nn.softmax(logits, axis=-1).astype(kv.dtype)
        return jnp.einsum('bqhk,bqkc->bqhc', p, kv_sel)

    starts = jnp.arange(nb) * Q_BLOCK
    o = lax.map(block, (to_blocks(q_lat), to_blocks(q_idx), to_blocks(w_idx), starts))
    o = jnp.moveaxis(o, 0, 1).reshape(b, s, H_A, D_LATENT)
    return jnp.einsum('bshc,hcd->bshd', o, w_uv).reshape(b, s, H_A * DH_A)


def multiscale_retention(q, k, v):
    b, s = q.shape[:2]
    nc = s // CHUNK
    dt = q.dtype
    log_gamma = jnp.log1p(-jnp.exp2(-5.0 - jnp.arange(H_R, dtype=jnp.float32)))
    n = jnp.arange(CHUNK, dtype=jnp.float32)
    diff = n[:, None] - n[None, :]
    decay_in = jnp.where(diff >= 0, jnp.exp(log_gamma[:, None, None] * jnp.maximum(diff, 0.0)), 0.0).astype(dt)
    decay_q = jnp.exp(log_gamma[:, None] * (n + 1.0)).astype(dt)
    decay_k = jnp.exp(log_gamma[:, None] * (CHUNK - 1.0 - n)).astype(dt)
    decay_chunk = jnp.exp(log_gamma * CHUNK).astype(dt)

    def to_chunks(t):
        return t.reshape(b, nc, CHUNK, H_R, t.shape[-1]).transpose(1, 0, 3, 2, 4)

    k = k * (DK_R ** -0.5)

    def step(state, qkv):
        qc, kc, vc = qkv
        inner = jnp.einsum('bhnd,bhmd->bhnm', qc, kc) * decay_in[None]
        o = jnp.einsum('bhnm,bhme->bhne', inner, vc)
        o = o + jnp.einsum('bhnd,bhde->bhne', qc, state) * decay_q[None, :, :, None]
        state = state * decay_chunk[None, :, None, None] + jnp.einsum(
            'bhmd,bhme->bhde', kc * decay_k[None, :, :, None], vc)
        return state, o

    state0 = jnp.zeros((b, H_R, DK_R, DV_R), dt)
    _, o = lax.scan(step, state0, (to_chunks(q), to_chunks(k), to_chunks(v)))
    return o.transpose(1, 0, 3, 2, 4).reshape(b, s, H_R, DV_R)


def hierarchical_moe(x, w_rg, b_rg, w_re, b_re, w_gate, w_up, w_down):
    b, s, d = x.shape
    t = x.reshape(-1, d)
    n_tok = t.shape[0]
    g_prob = jax.nn.softmax((t @ w_rg + b_rg).astype(jnp.float32), axis=-1)
    p_grp, grp = lax.top_k(g_prob, 1)
    e_logits = (t @ w_re + b_re).astype(jnp.float32).reshape(n_tok, N_GROUPS, EXP_PER_GROUP)
    e_logits = jnp.take_along_axis(e_logits, grp[:, :, None], axis=1)[:, 0]
    p_exp, e_loc = lax.top_k(jax.nn.softmax(e_logits, axis=-1), TOP_K_EXP)
    p_exp = p_exp / jnp.sum(p_exp, axis=-1, keepdims=True)
    gate = (p_grp * p_exp).astype(x.dtype)
    expert = (grp * EXP_PER_GROUP + e_loc).astype(jnp.int32)

    n_asg = n_tok * TOP_K_EXP
    e_flat = expert.reshape(-1)
    tok_flat = jnp.repeat(jnp.arange(n_tok, dtype=jnp.int32), TOP_K_EXP)
    gate_flat = gate.reshape(-1)
    order = jnp.argsort(e_flat)
    e_sorted = e_flat[order]
    counts = jnp.bincount(e_flat, length=N_EXPERTS)
    padded = (counts + EXPERT_BLOCK - 1) // EXPERT_BLOCK * EXPERT_BLOCK
    pad_end = jnp.cumsum(padded)
    pad_start = pad_end - padded
    cnt_start = jnp.cumsum(counts) - counts
    rank = jnp.arange(n_asg) - cnt_start[e_sorted]
    dest = (pad_start[e_sorted] + rank).astype(jnp.int32)
    n_rows = -(-(n_asg + N_EXPERTS * (EXPERT_BLOCK - 1)) // EXPERT_BLOCK) * EXPERT_BLOCK
    n_blocks = n_rows // EXPERT_BLOCK
    row_tok = jnp.full((n_rows,), n_tok, jnp.int32).at[dest].set(tok_flat[order])
    row_gate = jnp.zeros((n_rows,), x.dtype).at[dest].set(gate_flat[order])
    block_expert = jnp.minimum(
        jnp.searchsorted(pad_end, jnp.arange(n_blocks) * EXPERT_BLOCK, side='right'), N_EXPERTS - 1)
    t_pad = jnp.concatenate([t, jnp.zeros((1, d), t.dtype)], axis=0)

    def block(args):
        rows, e = args
        xb = t_pad[rows]
        hmid = jax.nn.silu(xb @ w_gate[e]) * (xb @ w_up[e])
        return hmid @ w_down[e]

    y = lax.map(block, (row_tok.reshape(n_blocks, EXPERT_BLOCK), block_expert))
    y = y.reshape(n_rows, d) * row_gate[:, None]
    out = jnp.zeros((n_tok + 1, d), x.dtype).at[row_tok].add(y)[:n_tok]
    return out.reshape(b, s, d)


def setup_inputs(seed: int = 0) -> dict:
    key = jax.random.key(seed)
    ks = jax.random.split(key, 20)
    f32 = jnp.float32

    def nrm(k, shape, scale):
        return jax.random.normal(k, shape, f32) * scale

    def gain(k, shape):
        return 1.0 + 0.01 * jax.random.normal(k, shape, f32)

    return {
        'x': jax.random.normal(ks[0], (BATCH, SEQ, D_MODEL), f32),
        'g_mix_norm': gain(ks[1], (DEPTH, D_MODEL)),
        'w_in': nrm(ks[2], (DEPTH, D_MODEL, D_IN), D_MODEL ** -0.5),
        'g_kv': gain(ks[3], (DEPTH, D_LATENT)),
        'w_uv': nrm(ks[4], (DEPTH, H_A, D_LATENT, DH_A), D_LATENT ** -0.5),
        'g_ret': gain(ks[5], (DEPTH, H_R * DV_R)),
        'w_branch': nrm(ks[6], (DEPTH, N_BRANCH, D_BRANCH, D_MODEL), D_BRANCH ** -0.5),
        'w_out': nrm(ks[7], (DEPTH, D_MODEL, D_MODEL), D_MODEL ** -0.5),
        'g_ffn_norm': gain(ks[8], (DEPTH, D_MODEL)),
        'w_router_group': nrm(ks[9], (DEPTH, D_MODEL, N_GROUPS), D_MODEL ** -0.5),
        'b_router_group': nrm(ks[10], (DEPTH, N_GROUPS), 0.01),
        'w_router_expert': nrm(ks[11], (DEPTH, D_MODEL, N_EXPERTS), D_MODEL ** -0.5),
        'b_router_expert': nrm(ks[12], (DEPTH, N_EXPERTS), 0.01),
        'w_expert_gate': nrm(ks[13], (DEPTH, N_EXPERTS, D_MODEL, D_EXPERT), D_MODEL ** -0.5),
        'w_expert_up': nrm(ks[14], (DEPTH, N_EXPERTS, D_MODEL, D_EXPERT), D_MODEL ** -0.5),
        'w_expert_down': nrm(ks[15], (DEPTH, N_EXPERTS, D_EXPERT, D_MODEL), D_EXPERT ** -0.5),
        'g_final': gain(ks[16], (D_MODEL,)),
    }


def reference(x, g_mix_norm, w_in, g_kv, w_uv, g_ret, w_branch, w_out, g_ffn_norm,
              w_router_group, b_router_group, w_router_expert, b_router_expert,
              w_expert_gate, w_expert_up, w_expert_down, g_final):
    b, s, d = x.shape
    pos = jnp.arange(s)
    split_points = np.cumsum(np.array(SPLITS))[:-1].tolist()
    h = x
    for l in range(DEPTH):
        xn = rms_norm(h, g_mix_norm[l])
        proj = xn @ w_in[l]
        (q_lat, c_kv, q_idx, k_idx, w_idx, q_r, k_r, v_r, gate_r, gate_br) = jnp.split(
            proj, split_points, axis=-1)

        kv = rms_norm(c_kv, g_kv[l])
        o_a = sparse_indexer_attention(
            q_lat.reshape(b, s, H_A, D_LATENT), kv,
            q_idx.reshape(b, s, H_IDX, D_IDX), k_idx, w_idx, w_uv[l])

        q_r = rotary(q_r.reshape(b, s, H_R, DK_R), pos)
        k_r = rotary(k_r.reshape(b, s, H_R, DK_R), pos)
        ret = multiscale_retention(q_r, k_r, v_r.reshape(b, s, H_R, DV_R))
        o_b = jax.nn.silu(gate_r) * head_group_norm(ret, g_ret[l])

        branches = jnp.einsum('bsnc,ncd->bsnd', jnp.stack([o_a, o_b], axis=2), w_branch[l])
        gates = jax.nn.sigmoid(gate_br.reshape(b, s, N_BRANCH, d))
        mixed = jnp.einsum('bsnd,bsnd->bsd', gates, branches)
        h = h + mixed @ w_out[l]

        h = h + hierarchical_moe(rms_norm(h, g_ffn_norm[l]),
                                 w_router_group[l], b_router_group[l],
                                 w_router_expert[l], b_router_expert[l],
                                 w_expert_gate[l], w_expert_up[l], w_expert_down[l])
    return rms_norm(h, g_final)
```

```cpp
#include <hip/hip_runtime.h>
#include <hip/hip_cooperative_groups.h>
#include <cstdio>
#include <cstdint>
namespace cg = cooperative_groups;
namespace pg8 {
#define PG8_LAS __attribute__((address_space(3)))
typedef unsigned short bf16_t;
typedef short bf16x8 __attribute__((ext_vector_type(8)));
typedef float f32x4 __attribute__((ext_vector_type(4)));
typedef unsigned u32x4 __attribute__((ext_vector_type(4)));
constexpr int BM = 256, BK = 64, HALF = 128, HTB = HALF * BK * 2  , STAGE_BYTES = 8 * HTB, NXCD = 8, WGM = 8;

__host__ __device__ __forceinline__ int lds_byte(int r, int c) { const int st = (r >> 4) * 2 + (c >> 5), rr = r & 15, cc = c & 31, ob = rr * 64 + cc * 2; return st * 1024 + (ob ^ (((ob >> 9) & 1) << 5)); }
__host__ __device__ __forceinline__ void stage_rc(int b, int& R, int& C) { const int st = b / 1024, sb = b % 1024, swz = sb ^ (((sb >> 9) & 1) << 5); R = (st >> 1) * 16 + swz / 64; C = (st & 1) * 32 + (swz % 64) / 2; }
__host__ __device__ __forceinline__ int perm32(int rho) { const int n = rho >> 4, i = rho & 15; return 8 * (i >> 2) + 4 * n + (i & 3); }

struct Unit { int pm, pn, e; };
struct Gemm { const bf16_t* A; const bf16_t* Bt; int M, N, K; };

struct StaticOrder {
    int nM, nN, nwg, G, c;
    __host__ __device__ void init(int M, int N, int G_, int c_) { nM = M / BM; nN = N / BM; nwg = nM * nN; G = G_; c = c_; }
    __host__ __device__ bool next(int i, Unit& u) const {
        const long L = (long)i * G + c; if (L >= nwg) return false;
        int wgid = (int)L; { const int q = nwg / NXCD, r = nwg % NXCD, xcd = wgid % NXCD, off = wgid / NXCD; wgid = (xcd < r ? xcd * (q + 1) : r * (q + 1) + (xcd - r) * q) + off; }
        const int nig = WGM * nN, gid = wgid / nig, fm = gid * WGM, gsz = (nM - fm) < WGM ? (nM - fm) : WGM;
        u.pm = fm + ((wgid % nig) % gsz); u.pn = (wgid % nig) / gsz; u.e = 0; return true;
    }
    __device__ __forceinline__ void a_ready(const Unit&) const {}
    __device__ __forceinline__ void done(const Unit&) const {}
};

template <class Epi, class Sched, bool ALIGN_EPI = false, bool SP2 = false>
__device__ __forceinline__ void gemm_phase(PG8_LAS unsigned char* lds, const Gemm g, const Sched& S, const Epi& E, const int tid) {
    const int wid = __builtin_amdgcn_readfirstlane(tid >> 6), lane = tid & 63, wr = wid >> 2, wc = wid & 3, fr = lane & 15, fq = lane >> 4;
    const int K = g.K, nt = K / BK;
    unsigned voffA[2], voffB[2];
#pragma unroll
    for (int i = 0; i < 2; ++i) { int R, C; stage_rc(tid * 16 + i * 8192, R, C); const int Rb = Epi::PERM ? ((R & ~31) + perm32(R & 31)) : R;
        voffA[i] = (unsigned)(R * K + C) * 2u; voffB[i] = (unsigned)(Rb * K + C) * 2u; }
    const size_t kstep = (size_t)(BK * 2);
    const size_t hstep = (size_t)HALF * K * 2;
    const size_t tstep = 2 * hstep;
    const unsigned ldsw = (unsigned)wid * 1024u;
    const int aoff = lds_byte(wr * 64 + fr, fq * 8), boff = lds_byte(wc * 32 + fr, fq * 8);
#define PG8_SA(b, h) (((b) * 2 + (h)) * HTB)
#define PG8_SB(b, h) ((4 + (b) * 2 + (h)) * HTB)
#define PG8_STAGE(bufoff, gbase, voff) do { _Pragma("unroll") for (int _i = 0; _i < 2; ++_i) \
        __builtin_amdgcn_global_load_lds((const unsigned*)((const char*)(gbase) + (voff)[_i]), (PG8_LAS unsigned*)(lds + (bufoff) + ldsw + _i * 8192), 16, 0, 0); } while (0)
#define PG8_LDA(dst, b, h) do { _Pragma("unroll") for (int m = 0; m < 4; ++m) _Pragma("unroll") for (int k = 0; k < 2; ++k) dst[m][k] = *(const PG8_LAS bf16x8*)(lds + PG8_SA(b, h) + aoff + m * 2048 + k * 1024); } while (0)
#define PG8_LDB(dst, b, h) do { _Pragma("unroll") for (int n = 0; n < 2; ++n) _Pragma("unroll") for (int k = 0; k < 2; ++k) dst[n][k] = *(const PG8_LAS bf16x8*)(lds + PG8_SB(b, h) + boff + n * 2048 + k * 1024); } while (0)
#define PG8_MMA(ai, bj, At, Bt) do { __builtin_amdgcn_s_setprio(1); _Pragma("unroll") for (int m = 0; m < 4; ++m) _Pragma("unroll") for (int n = 0; n < 2; ++n) _Pragma("unroll") for (int k = 0; k < 2; ++k) \
        acc[ai][bj][m][n] = __builtin_amdgcn_mfma_f32_16x16x32_bf16(Bt[n][k], At[m][k], acc[ai][bj][m][n], 0, 0, 0); __builtin_amdgcn_s_setprio(0); } while (0)
#define PG8_WAIT_V(n) asm volatile("s_waitcnt vmcnt(" #n ")" ::: "memory")
#define PG8_WAIT_L(n) asm volatile("s_waitcnt lgkmcnt(" #n ")" ::: "memory")
#define PG8_BAR __builtin_amdgcn_s_barrier()
#define PG8_SCHED __builtin_amdgcn_sched_barrier(0)
    Unit cur, nxt; int ui = 0;
    if (!S.next(0, cur)) return;
    f32x4 acc[2][2][4][2];
#pragma unroll
    for (int a = 0; a < 2; ++a)
#pragma unroll
        for (int b = 0; b < 2; ++b)
#pragma unroll
            for (int m = 0; m < 4; ++m)
#pragma unroll
                for (int n = 0; n < 2; ++n) acc[a][b][m][n] = (f32x4){0.f, 0.f, 0.f, 0.f};
    bf16x8 At[4][2], B0[2][2], B1[2][2];
    const size_t estep = (size_t)g.N * K * 2;
    const char* cA = (const char*)g.A + (size_t)cur.pm * tstep; const char* cB = (const char*)g.Bt + (size_t)cur.e * estep + (size_t)cur.pn * tstep;
    S.a_ready(cur);
    if constexpr (SP2) {
        PG8_STAGE(PG8_SB(0, 0), cB, voffB); PG8_STAGE(PG8_SB(0, 1), cB + hstep, voffB); PG8_STAGE(PG8_SA(0, 0), cA, voffA); PG8_STAGE(PG8_SA(0, 1), cA + hstep, voffA);
        if (wr == 1) PG8_BAR;
        PG8_WAIT_V(2); PG8_BAR;
        PG8_STAGE(PG8_SB(1, 0), cB + kstep, voffB); PG8_STAGE(PG8_SA(1, 0), cA + kstep, voffA); PG8_STAGE(PG8_SB(1, 1), cB + hstep + kstep, voffB);
        PG8_WAIT_V(6); PG8_BAR;
    } else {
        PG8_STAGE(PG8_SB(0, 0), cB, voffB); PG8_STAGE(PG8_SA(0, 0), cA, voffA); PG8_STAGE(PG8_SB(0, 1), cB + hstep, voffB); PG8_STAGE(PG8_SA(0, 1), cA + hstep, voffA);
        if (wr == 1) PG8_BAR;
        PG8_WAIT_V(4); PG8_BAR;
        PG8_STAGE(PG8_SB(1, 0), cB + kstep, voffB); PG8_STAGE(PG8_SA(1, 0), cA + kstep, voffA); PG8_STAGE(PG8_SB(1, 1), cB + hstep + kstep, voffB);
        PG8_WAIT_V(6); PG8_BAR;
    }
    for (;;) {
        const bool has_next = S.next(ui + 1, nxt);
        const char* nA = has_next ? (const char*)g.A + (size_t)nxt.pm * tstep : cA; const char* nB = has_next ? (const char*)g.Bt + (size_t)nxt.e * estep + (size_t)nxt.pn * tstep : cB;
        for (int t = 0; t < nt; t += 2) {
            const bool last = (t == nt - 2);
            const char* a1 = cA + (size_t)(t + 1) * kstep;
            const char* a2 = last ? nA : cA + (size_t)(t + 2) * kstep; const char* b2 = last ? nB : cB + (size_t)(t + 2) * kstep;
            const char* a3 = a2 + kstep; const char* b3 = b2 + kstep;
            if (last && has_next) S.a_ready(nxt);
            if constexpr (SP2) {
            PG8_LDB(B0, 0, 0); PG8_LDB(B1, 0, 1); PG8_SCHED; PG8_LDA(At, 0, 0); PG8_STAGE(PG8_SA(1, 1), a1 + hstep, voffA);
            PG8_WAIT_V(8); PG8_WAIT_L(0); PG8_BAR; PG8_MMA(0, 0, At, B0); PG8_MMA(0, 1, At, B1); PG8_BAR; PG8_SCHED;
            PG8_LDA(At, 0, 1); PG8_STAGE(PG8_SB(0, 0), b2, voffB); PG8_STAGE(PG8_SB(0, 1), b2 + hstep, voffB); PG8_STAGE(PG8_SA(0, 0), a2, voffA);
            PG8_WAIT_V(8); PG8_WAIT_L(0); PG8_BAR; PG8_MMA(1, 0, At, B0); PG8_MMA(1, 1, At, B1); PG8_BAR; PG8_SCHED;
            PG8_LDB(B0, 1, 0); PG8_LDB(B1, 1, 1); PG8_SCHED; PG8_LDA(At, 1, 0); PG8_STAGE(PG8_SA(0, 1), a2 + hstep, voffA);
            PG8_WAIT_V(8); PG8_WAIT_L(0); PG8_BAR; PG8_MMA(0, 0, At, B0); PG8_MMA(0, 1, At, B1); PG8_BAR; PG8_SCHED;
            PG8_LDA(At, 1, 1); PG8_STAGE(PG8_SB(1, 0), b3, voffB); PG8_STAGE(PG8_SB(1, 1), b3 + hstep, voffB); PG8_STAGE(PG8_SA(1, 0), a3, voffA);
            PG8_WAIT_V(8); PG8_WAIT_L(0); PG8_BAR; PG8_MMA(1, 0, At, B0); PG8_MMA(1, 1, At, B1); PG8_BAR; PG8_SCHED;
            } else {
            PG8_LDB(B0, 0, 0); PG8_SCHED; PG8_LDA(At, 0, 0); PG8_STAGE(PG8_SA(1, 1), a1 + hstep, voffA);
            PG8_WAIT_L(8); PG8_BAR; PG8_WAIT_L(0); PG8_MMA(0, 0, At, B0); PG8_BAR; PG8_SCHED;
            PG8_LDB(B1, 0, 1); PG8_STAGE(PG8_SB(0, 0), b2, voffB);
            PG8_BAR; PG8_WAIT_L(0); PG8_MMA(0, 1, At, B1); PG8_BAR;
            PG8_LDA(At, 0, 1); PG8_STAGE(PG8_SA(0, 0), a2, voffA);
            PG8_BAR; PG8_WAIT_L(0); PG8_MMA(1, 0, At, B0); PG8_BAR; PG8_SCHED;
            PG8_STAGE(PG8_SB(0, 1), b2 + hstep, voffB);
            PG8_WAIT_V(6); PG8_BAR; PG8_MMA(1, 1, At, B1); PG8_BAR;
            PG8_LDB(B0, 1, 0); PG8_SCHED; PG8_LDA(At, 1, 0); PG8_STAGE(PG8_SA(0, 1), a2 + hstep, voffA);
            PG8_WAIT_L(8); PG8_BAR; PG8_WAIT_L(0); PG8_MMA(0, 0, At, B0); PG8_BAR; PG8_SCHED;
            PG8_LDB(B1, 1, 1); PG8_STAGE(PG8_SB(1, 0), b3, voffB);
            PG8_BAR; PG8_WAIT_L(0); PG8_MMA(0, 1, At, B1); PG8_BAR;
            PG8_LDA(At, 1, 1); PG8_STAGE(PG8_SA(1, 0), a3, voffA);
            PG8_BAR; PG8_WAIT_L(0); PG8_MMA(1, 0, At, B0); PG8_BAR; PG8_SCHED;
            PG8_STAGE(PG8_SB(1, 1), b3 + hstep, voffB);
            PG8_WAIT_V(6); PG8_BAR; PG8_MMA(1, 1, At, B1); PG8_BAR;
            }
        }
        if constexpr (ALIGN_EPI) { if (wr == 0) PG8_BAR; }
        if constexpr (!Epi::AFTER_DRAIN) { E(acc, cur, wr, wc, fr, fq); S.done(cur); }
        if (!has_next) break;
#pragma unroll
        for (int a = 0; a < 2; ++a)
#pragma unroll
            for (int b = 0; b < 2; ++b)
#pragma unroll
                for (int m = 0; m < 4; ++m)
#pragma unroll
                    for (int n = 0; n < 2; ++n) acc[a][b][m][n] = (f32x4){0.f, 0.f, 0.f, 0.f};
        cur = nxt; cA = nA; cB = nB; ++ui;
        if constexpr (ALIGN_EPI) { if (wr == 1) PG8_BAR; }
    }
    PG8_WAIT_V(0);
    if constexpr (!ALIGN_EPI) { if (wr == 0) PG8_BAR; }
    PG8_BAR;
    if constexpr (Epi::AFTER_DRAIN) { E.fused(acc, cur, wr, wc, fr, fq, lds, wid, lane); S.done(cur); }
#undef PG8_SA
#undef PG8_SB
#undef PG8_STAGE
#undef PG8_LDA
#undef PG8_LDB
#undef PG8_MMA
#undef PG8_WAIT_V
#undef PG8_WAIT_L
#undef PG8_BAR
#undef PG8_SCHED
}
}

#define LAS __attribute__((address_space(3)))
typedef unsigned short bf16_t;
typedef float f32x4 __attribute__((ext_vector_type(4)));
typedef unsigned u32x4 __attribute__((ext_vector_type(4)));
typedef unsigned u32x2 __attribute__((ext_vector_type(2)));
typedef unsigned long long u64;

constexpr int T_TOK = 16384, DMODEL = 2048, SEQL = 2048;
constexpr int NPROJ = 9984;
constexpr int C_QLAT = 0, C_CKV = 1024, C_QIDX = 1152, C_KIDX = 1664, C_WIDX = 1728, C_QR = 1792, C_KR = 2816, C_VR = 3840, C_GR = 4864, C_GBR = 5888;
constexpr int MAXSLOT = 40960;
constexpr float EPS_F = 1e-6f;
constexpr float IDX_SCALE = 0.04419417382415922f;
constexpr float ATT_SCALE = 0.08838834764831845f;
constexpr float K_SCALE = 0.08838834764831845f;

constexpr size_t WS_CTL = 0;
constexpr size_t WS_ROT = 65536;
constexpr size_t WS_WIN = WS_ROT + 1048576;
constexpr size_t WS_WCOMB = WS_WIN + (size_t)NPROJ * 2048 * 2;
constexpr size_t WS_WB = WS_WCOMB + (size_t)2048 * 1024 * 2;
constexpr size_t WS_WO = WS_WB + (size_t)2048 * 1024 * 2;
constexpr size_t WS_WGU = WS_WO + (size_t)2048 * 2048 * 2;
constexpr size_t WS_WD = WS_WGU + (size_t)32 * 2048 * 2048 * 2;
constexpr size_t WS_P = WS_WD + (size_t)32 * 2048 * 1024 * 2;
constexpr size_t WS_HMID = WS_P;
constexpr size_t WS_Y = WS_HMID + (size_t)MAXSLOT * 1024 * 2;
constexpr size_t WS_XN = WS_P + (size_t)T_TOK * NPROJ * 2;
constexpr size_t WS_OA = WS_XN + (size_t)T_TOK * 2048 * 2;
constexpr size_t WS_OB = WS_OA + (size_t)T_TOK * 1024 * 2;
constexpr size_t WS_MIXED = WS_OB + (size_t)T_TOK * 1024 * 2;
constexpr size_t WS_SPARE = WS_MIXED + (size_t)T_TOK * 2048 * 2;
constexpr size_t WS_XG = WS_OA;
constexpr size_t WS_KV = WS_SPARE + (size_t)T_TOK * 1024 * 2;
constexpr size_t WS_MASK = WS_KV + (size_t)T_TOK * 128 * 2;
constexpr size_t WS_MISC = WS_MASK + (size_t)T_TOK * 256;
constexpr size_t WS_END = WS_MISC + 1048576;
static_assert(WS_Y + (size_t)MAXSLOT * 2048 * 2 <= WS_XN, "HMID + Y must fit in P");
static_assert(WS_XG + (size_t)MAXSLOT * 2048 * 2 <= WS_KV, "XG must fit in OA..SPARE");
static_assert(WS_END <= (size_t)1073741824, "workspace budget");
constexpr int MI_ROWTOK = 0, MI_ROWGATE = MAXSLOT, MI_TOKSLOT = 2 * MAXSLOT, MI_ASGE = MI_TOKSLOT + 2 * T_TOK, MI_ASGR = MI_ASGE + 2 * T_TOK, MI_ASGG = MI_ASGR + 2 * T_TOK;
static_assert((size_t)(MI_ASGG + 2 * T_TOK) * 4 <= 1048576, "misc budget");
constexpr int LDS_BYTES = 136 * 1024;
constexpr int LDS_MISC = 128 * 1024;

__device__ __forceinline__ float bflo(unsigned w) { return __uint_as_float(w << 16); }
__device__ __forceinline__ float bfhi(unsigned w) { return __uint_as_float(w & 0xffff0000u); }
__device__ __forceinline__ unsigned pkbf(float lo, float hi) { unsigned r; asm volatile("v_cvt_pk_bf16_f32 %0, %1, %2" : "=v"(r) : "v"(lo), "v"(hi)); return r; }
__device__ __forceinline__ int hide_i(int v) { asm volatile("" : "+v"(v)); return v; }
template <class Tp> __device__ __forceinline__ Tp* hide_p(Tp* q) { asm volatile("" : "+s"(q)); return q; }
__device__ __forceinline__ float shx(float v, int lane, int o) { return __int_as_float(__builtin_amdgcn_ds_bpermute((lane ^ o) << 2, __float_as_int(v))); }
__device__ __forceinline__ float wave_sum(float v, int lane) {
#pragma unroll
    for (int o = 1; o < 64; o <<= 1) v += shx(v, lane, o);
    return v;
}
__device__ __forceinline__ float wave_max(float v, int lane) {
#pragma unroll
    for (int o = 1; o < 64; o <<= 1) v = fmaxf(v, shx(v, lane, o));
    return v;
}
__device__ __forceinline__ float sigmoidf_(float x) { return __builtin_amdgcn_rcpf(1.0f + __expf(-x)); }
__device__ __forceinline__ float siluf_(float x) { return x * sigmoidf_(x); }
__device__ __forceinline__ unsigned fkey(float f) { const unsigned u = __float_as_uint(f + 0.0f); return (u & 0x80000000u) ? ~u : (u | 0x80000000u); }

namespace pg8 {
struct EpiProj {
    static constexpr bool PERM = true, AFTER_DRAIN = false;
    bf16_t* P; const float* rot;
    __device__ __forceinline__ void operator()(const f32x4 (&acc)[2][2][4][2], const Unit& u, int wr, int wc, int fr, int fq) const {
        const int row0 = u.pm * BM + wr * 64 + fr, colb = u.pn * BM + wc * 32 + 8 * fq;
        const bool rotq = (u.pn >= 7) && (u.pn < 15);
        const float ksc = (u.pn >= 11) ? K_SCALE : 1.0f;
        const int i0 = 16 * wc + 4 * fq;
#pragma unroll
        for (int ai = 0; ai < 2; ++ai)
#pragma unroll
            for (int m = 0; m < 4; ++m) {
                const int row = row0 + ai * HALF + m * 16; const int pos = row & (SEQL - 1);
                bf16_t* rowp = P + (size_t)row * NPROJ + colb;
                f32x4 r0 = (f32x4){1.f, 0.f, 1.f, 0.f}, r1 = r0;
                if (rotq) { const f32x4* rt = (const f32x4*)(rot + ((size_t)pos * 64 + i0) * 2); r0 = rt[0]; r1 = rt[1]; }
#pragma unroll
                for (int bj = 0; bj < 2; ++bj) {
                    f32x4 v0 = acc[ai][bj][m][0], v1 = acc[ai][bj][m][1];
                    if (rotq) {
                        f32x4 w0, w1;
                        w0[0] = (v0[0] * r0[0] - v0[1] * r0[1]) * ksc; w0[1] = (v0[0] * r0[1] + v0[1] * r0[0]) * ksc;
                        w0[2] = (v0[2] * r0[2] - v0[3] * r0[3]) * ksc; w0[3] = (v0[2] * r0[3] + v0[3] * r0[2]) * ksc;
                        w1[0] = (v1[0] * r1[0] - v1[1] * r1[1]) * ksc; w1[1] = (v1[0] * r1[1] + v1[1] * r1[0]) * ksc;
                        w1[2] = (v1[2] * r1[2] - v1[3] * r1[3]) * ksc; w1[3] = (v1[2] * r1[3] + v1[3] * r1[2]) * ksc;
                        v0 = w0; v1 = w1;
                    }
                    u32x4 w; w.x = pkbf(v0[0], v0[1]); w.y = pkbf(v0[2], v0[3]); w.z = pkbf(v1[0], v1[1]); w.w = pkbf(v1[2], v1[3]);
                    *(u32x4*)(rowp + bj * HALF) = w;
                }
            }
    }
};
template <int WHICH> struct EpiMerge {
    static constexpr bool PERM = true, AFTER_DRAIN = false;
    const bf16_t* P; const bf16_t* BA; bf16_t* O;
    __device__ __forceinline__ void operator()(const f32x4 (&acc)[2][2][4][2], const Unit& u, int wr, int wc, int fr, int fq) const {
        const int row0 = u.pm * BM + wr * 64 + fr, colb = u.pn * BM + wc * 32 + 8 * fq;
#pragma unroll
        for (int ai = 0; ai < 2; ++ai)
#pragma unroll
            for (int m = 0; m < 4; ++m) {
                const int row = row0 + ai * HALF + m * 16;
#pragma unroll
                for (int bj = 0; bj < 2; ++bj) {
                    const int col = colb + bj * HALF;
                    const u32x4 g = *(const u32x4*)(P + (size_t)row * NPROJ + C_GBR + WHICH * DMODEL + col);
                    const f32x4 v0 = acc[ai][bj][m][0], v1 = acc[ai][bj][m][1];
                    float o[8];
                    o[0] = sigmoidf_(bflo(g.x)) * v0[0]; o[1] = sigmoidf_(bfhi(g.x)) * v0[1]; o[2] = sigmoidf_(bflo(g.y)) * v0[2]; o[3] = sigmoidf_(bfhi(g.y)) * v0[3];
                    o[4] = sigmoidf_(bflo(g.z)) * v1[0]; o[5] = sigmoidf_(bfhi(g.z)) * v1[1]; o[6] = sigmoidf_(bflo(g.w)) * v1[2]; o[7] = sigmoidf_(bfhi(g.w)) * v1[3];
                    if (WHICH == 1) {
                        const u32x4 a = *(const u32x4*)(BA + (size_t)row * DMODEL + col);
                        o[0] += bflo(a.x); o[1] += bfhi(a.x); o[2] += bflo(a.y); o[3] += bfhi(a.y); o[4] += bflo(a.z); o[5] += bfhi(a.z); o[6] += bflo(a.w); o[7] += bfhi(a.w);
                    }
                    u32x4 w; w.x = pkbf(o[0], o[1]); w.y = pkbf(o[2], o[3]); w.z = pkbf(o[4], o[5]); w.w = pkbf(o[6], o[7]);
                    *(u32x4*)(O + (size_t)row * DMODEL + col) = w;
                }
            }
    }
};
struct EpiRes {
    static constexpr bool PERM = false, AFTER_DRAIN = false;
    const float* X; float* O;
    __device__ __forceinline__ void operator()(const f32x4 (&acc)[2][2][4][2], const Unit& u, int wr, int wc, int fr, int fq) const {
        const int row0 = u.pm * BM + wr * 64 + fr, col0 = u.pn * BM + wc * 32 + 4 * fq;
#pragma unroll
        for (int ai = 0; ai < 2; ++ai)
#pragma unroll
            for (int m = 0; m < 4; ++m) {
                const size_t off = (size_t)(row0 + ai * HALF + m * 16) * DMODEL + col0;
#pragma unroll
                for (int bj = 0; bj < 2; ++bj)
#pragma unroll
                    for (int n = 0; n < 2; ++n) { const f32x4 xv = *(const f32x4*)(X + off + bj * HALF + n * 16); *(f32x4*)(O + off + bj * HALF + n * 16) = xv + acc[ai][bj][m][n]; }
            }
    }
};
struct EpiSwiglu {
    static constexpr bool PERM = true, AFTER_DRAIN = false;
    bf16_t* H;
    __device__ __forceinline__ void operator()(const f32x4 (&acc)[2][2][4][2], const Unit& u, int wr, int wc, int fr, int fq) const {
        const int row0 = u.pm * BM + wr * 64 + fr, col = u.pn * HALF + wc * 32 + 8 * fq;
#pragma unroll
        for (int ai = 0; ai < 2; ++ai)
#pragma unroll
            for (int m = 0; m < 4; ++m) {
                const int row = row0 + ai * HALF + m * 16;
                const f32x4 g0 = acc[ai][0][m][0], g1 = acc[ai][0][m][1], u0 = acc[ai][1][m][0], u1 = acc[ai][1][m][1];
                u32x4 w; w.x = pkbf(siluf_(g0[0]) * u0[0], siluf_(g0[1]) * u0[1]); w.y = pkbf(siluf_(g0[2]) * u0[2], siluf_(g0[3]) * u0[3]);
                w.z = pkbf(siluf_(g1[0]) * u1[0], siluf_(g1[1]) * u1[1]); w.w = pkbf(siluf_(g1[2]) * u1[2], siluf_(g1[3]) * u1[3]);
                *(u32x4*)(H + (size_t)row * 1024 + col) = w;
            }
    }
};
struct EpiDown {
    static constexpr bool PERM = true, AFTER_DRAIN = false;
    bf16_t* Y; const float* rg;
    __device__ __forceinline__ void operator()(const f32x4 (&acc)[2][2][4][2], const Unit& u, int wr, int wc, int fr, int fq) const {
        const int row0 = u.pm * BM + wr * 64 + fr, colb = u.pn * BM + wc * 32 + 8 * fq;
#pragma unroll
        for (int ai = 0; ai < 2; ++ai)
#pragma unroll
            for (int m = 0; m < 4; ++m) {
                const int row = row0 + ai * HALF + m * 16; const float gt = rg[row];
#pragma unroll
                for (int bj = 0; bj < 2; ++bj) {
                    const f32x4 v0 = acc[ai][bj][m][0] * gt, v1 = acc[ai][bj][m][1] * gt;
                    u32x4 w; w.x = pkbf(v0[0], v0[1]); w.y = pkbf(v0[2], v0[3]); w.z = pkbf(v1[0], v1[1]); w.w = pkbf(v1[2], v1[3]);
                    *(u32x4*)(Y + (size_t)row * DMODEL + colb + bj * HALF) = w;
                }
            }
    }
};
struct ExpertOrder {
    const LAS int* ts; int G, c;
    __device__ __forceinline__ bool next(int i, Unit& u) const {
        const int L = i * G + c; const int total = ts[32] * 8; if (L >= total) return false;
        const int gt = L >> 3; u.pm = gt; u.pn = L & 7; int e = 0;
        for (int k = 1; k < 32; ++k) e += (gt >= ts[k]) ? 1 : 0;
        u.e = e; return true;
    }
    __device__ __forceinline__ void a_ready(const Unit&) const {}
    __device__ __forceinline__ void done(const Unit&) const {}
};
}

struct MapId { __device__ __forceinline__ int operator()(int n) const { return n; } };
struct MapGate { __device__ __forceinline__ int operator()(int f) const { return ((f >> 7) << 8) + (f & 127); } };
struct MapUp { __device__ __forceinline__ int operator()(int f) const { return ((f >> 7) << 8) + 128 + (f & 127); } };
struct MapProj {
    __device__ __forceinline__ int operator()(int n) const {
        if (n < 1736) return n;
        if (n < 2760) { const int l = n - 1736, d = l & 127; return C_QR + (l & ~127) + ((d & 63) << 1) + (d >> 6); }
        if (n < 3784) { const int l = n - 2760, d = l & 127; return C_KR + (l & ~127) + ((d & 63) << 1) + (d >> 6); }
        if (n < 4808) return C_VR + (n - 3784);
        if (n < 5832) return C_GR + (n - 4808);
        return C_GBR + (n - 5832);
    }
};
template <class RowMap>
__device__ __forceinline__ void tr_item(const float* __restrict__ src, int N, bf16_t* __restrict__ dst, int ldd, int kb, int nb, int lane, RowMap rm) {
    const int kc = lane >> 3, nc = lane & 7;
    const int n = nb * 32 + nc * 4, k0 = kb * 64 + kc * 8;
    if (n < N) {
        f32x4 v[8];
#pragma unroll
        for (int i = 0; i < 8; ++i) v[i] = *(const f32x4*)(src + (size_t)(k0 + i) * N + n);
#pragma unroll
        for (int j = 0; j < 4; ++j) {
            u32x4 o; o.x = pkbf(v[0][j], v[1][j]); o.y = pkbf(v[2][j], v[3][j]); o.z = pkbf(v[4][j], v[5][j]); o.w = pkbf(v[6][j], v[7][j]);
            *(u32x4*)(dst + (size_t)rm(n + j) * ldd + k0) = o;
        }
    }
}
__device__ __forceinline__ void sincos_d(double a, double& s, double& c) {
    const double TWO_PI = 6.283185307179586476925, HALF_PI = 1.5707963267948966192313;
    double k = rint(a / HALF_PI); double r = a - k * HALF_PI;
    r -= k * 6.123233995736766e-17;
    const int q = ((int)k) & 3; const double r2 = r * r;
    double sp = r2 * (-1.0 / 1307674368000.0);
    sp = r2 * (sp + 1.0 / 6227020800.0); sp = r2 * (sp - 1.0 / 39916800.0); sp = r2 * (sp + 1.0 / 362880.0); sp = r2 * (sp - 1.0 / 5040.0); sp = r2 * (sp + 1.0 / 120.0); sp = r2 * (sp - 1.0 / 6.0);
    const double sr = r + r * sp;
    double cp = r2 * (1.0 / 20922789888000.0);
    cp = r2 * (cp - 1.0 / 87178291200.0); cp = r2 * (cp + 1.0 / 479001600.0); cp = r2 * (cp - 1.0 / 3628800.0); cp = r2 * (cp + 1.0 / 40320.0); cp = r2 * (cp - 1.0 / 720.0); cp = r2 * (cp + 1.0 / 24.0); cp = r2 * (cp - 0.5);
    const double cr = 1.0 + cp;
    s = (q == 0) ? sr : (q == 1) ? cr : (q == 2) ? -sr : -cr;
    c = (q == 0) ? cr : (q == 1) ? -sr : (q == 2) ? -cr : sr;
    (void)TWO_PI;
}

struct Params { const float* in[17]; float* out; unsigned char* ws; };

#define GSYNC() grid.sync()

__global__ void __launch_bounds__(512, 2) mega_fwd(Params p) {
    extern __shared__ __attribute__((aligned(16))) unsigned char lds_raw[];
    LAS unsigned char* lds = (LAS unsigned char*)lds_raw;
    cg::grid_group grid = cg::this_grid();
    const int G = gridDim.x, bx = blockIdx.x;
    const int wave_id = __builtin_amdgcn_readfirstlane((int)threadIdx.x >> 6);
    const int NGW = G * 8, NGT = G * 512;
#define PH_LOCALS \
    const int lane = (int)__builtin_amdgcn_mbcnt_hi(~0u, __builtin_amdgcn_mbcnt_lo(~0u, (unsigned)hide_i(0))), wave = wave_id, tid = wave * 64 + lane; (void)tid; \
    const int gw = bx * 8 + wave, gtid = bx * 512 + tid; (void)gw; (void)gtid; (void)lane; \
    unsigned char* ws = hide_p(p.ws); float* out = hide_p(p.out); (void)out; \
    unsigned* ctl = (unsigned*)(ws + WS_CTL); float* rot = (float*)(ws + WS_ROT); (void)ctl; (void)rot; \
    bf16_t* WIN = (bf16_t*)(ws + WS_WIN); bf16_t* WCOMB = (bf16_t*)(ws + WS_WCOMB); bf16_t* WB = (bf16_t*)(ws + WS_WB); bf16_t* WO = (bf16_t*)(ws + WS_WO); (void)WIN; (void)WCOMB; (void)WB; (void)WO; \
    bf16_t* WGU = (bf16_t*)(ws + WS_WGU); bf16_t* WD = (bf16_t*)(ws + WS_WD); (void)WGU; (void)WD; \
    bf16_t* P = (bf16_t*)(ws + WS_P); bf16_t* HMID = (bf16_t*)(ws + WS_HMID); bf16_t* Y = (bf16_t*)(ws + WS_Y); (void)P; (void)HMID; (void)Y; \
    bf16_t* XN = (bf16_t*)(ws + WS_XN); bf16_t* BA = XN; bf16_t* TN = XN; (void)BA; (void)TN; \
    bf16_t* OA = (bf16_t*)(ws + WS_OA); bf16_t* OB = (bf16_t*)(ws + WS_OB); bf16_t* MIXED = (bf16_t*)(ws + WS_MIXED); bf16_t* XG = (bf16_t*)(ws + WS_XG); (void)OA; (void)OB; (void)MIXED; (void)XG; \
    bf16_t* KV = (bf16_t*)(ws + WS_KV); u64* MASK = (u64*)(ws + WS_MASK); (void)KV; (void)MASK; \
    int* misc = (int*)(ws + WS_MISC); \
    int* row_tok = misc + MI_ROWTOK; float* row_gate = (float*)(misc + MI_ROWGATE); int* tok_slot = misc + MI_TOKSLOT; (void)row_tok; (void)row_gate; (void)tok_slot; \
    int* asg_e = misc + MI_ASGE; int* asg_r = misc + MI_ASGR; float* asg_g = (float*)(misc + MI_ASGG); (void)asg_e; (void)asg_r; (void)asg_g;
#define IN(k) hide_p(p.in[k])

    {
        PH_LOCALS
        const float* x = IN(0); const float* g_mix = IN(1); const float* w_in = IN(2); const float* w_uv = IN(4); const float* w_branch = IN(6); const float* w_out = IN(7);
        const float* w_eg = IN(13); const float* w_eu = IN(14); const float* w_ed = IN(15);
        constexpr int NB_WIN = 311;
        constexpr int I_WIN = 32 * NB_WIN, I_WB = 16 * 64, I_WO = 32 * 64, I_EG = 32 * 1024, I_EU = 32 * 1024, I_ED = 32 * 1024;
        constexpr int I_TOTAL = I_WIN + I_WB + I_WO + I_EG + I_EU + I_ED;
        for (int it = gw; it < I_TOTAL; it += NGW) {
            int r = it;
            if (r < I_WIN) { tr_item(w_in, 9928, WIN, 2048, r / NB_WIN, r % NB_WIN, lane, MapProj{}); continue; } r -= I_WIN;
            if (r < I_WB) { tr_item(w_branch + (size_t)1024 * 2048, 2048, WB, 1024, r >> 6, r & 63, lane, MapId{}); continue; } r -= I_WB;
            if (r < I_WO) { tr_item(w_out, 2048, WO, 2048, r >> 6, r & 63, lane, MapId{}); continue; } r -= I_WO;
            if (r < I_EG) { const int e = r >> 10, q = r & 1023; tr_item(w_eg + (size_t)e * 2048 * 1024, 1024, WGU + (size_t)e * 2048 * 2048, 2048, q >> 5, q & 31, lane, MapGate{}); continue; } r -= I_EG;
            if (r < I_EU) { const int e = r >> 10, q = r & 1023; tr_item(w_eu + (size_t)e * 2048 * 1024, 1024, WGU + (size_t)e * 2048 * 2048, 2048, q >> 5, q & 31, lane, MapUp{}); continue; } r -= I_EU;
            { const int e = r >> 10, q = r & 1023; tr_item(w_ed + (size_t)e * 1024 * 2048, 2048, WD + (size_t)e * 2048 * 1024, 1024, q >> 6, q & 63, lane, MapId{}); }
        }
        for (int i = gtid; i < 56 * 256; i += NGT) ((u32x4*)(WIN + (size_t)1736 * 2048))[i] = (u32x4){0u, 0u, 0u, 0u};
        for (int it = gw; it < 2048; it += NGW) {
            const int h = it >> 8, ch = (it >> 7) & 1, n0 = (it & 127) * 16, c = ch * 64 + lane;
            const float* wuv = w_uv + ((size_t)h * 128 + c) * 128;
            const float* wa = w_branch + (size_t)(h * 128) * 2048 + n0;
            float a[16];
#pragma unroll
            for (int j = 0; j < 16; ++j) a[j] = 0.f;
            for (int d4 = 0; d4 < 32; ++d4) {
                const f32x4 wv = *(const f32x4*)(wuv + d4 * 4);
#pragma unroll
                for (int dd = 0; dd < 4; ++dd) {
                    const float* wr_ = wa + (size_t)(d4 * 4 + dd) * 2048;
#pragma unroll
                    for (int j4 = 0; j4 < 4; ++j4) { const f32x4 b = *(const f32x4*)(wr_ + j4 * 4); a[j4 * 4 + 0] += wv[dd] * b[0]; a[j4 * 4 + 1] += wv[dd] * b[1]; a[j4 * 4 + 2] += wv[dd] * b[2]; a[j4 * 4 + 3] += wv[dd] * b[3]; }
                }
            }
#pragma unroll
            for (int j = 0; j < 16; ++j) WCOMB[(size_t)(n0 + j) * 1024 + h * 128 + c] = (bf16_t)(pkbf(a[j], 0.f) & 0xffffu);
        }
        for (int m = gw; m < T_TOK; m += NGW) {
            const f32x4* xr = (const f32x4*)(x + (size_t)m * DMODEL) + lane; f32x4 v[8]; float ss = 0.f;
#pragma unroll
            for (int j = 0; j < 8; ++j) { v[j] = xr[64 * j]; ss += (v[j][0] * v[j][0] + v[j][1] * v[j][1]) + (v[j][2] * v[j][2] + v[j][3] * v[j][3]); }
            const float rstd = 1.0f / sqrtf(wave_sum(ss, lane) * (1.0f / DMODEL) + EPS_F);
            u32x2* o = (u32x2*)(XN + (size_t)m * DMODEL) + lane;
#pragma unroll
            for (int j = 0; j < 8; ++j) { const f32x4 gg = ((const f32x4*)g_mix)[lane + 64 * j]; u32x2 w; w.x = pkbf(v[j][0] * rstd * gg[0], v[j][1] * rstd * gg[1]); w.y = pkbf(v[j][2] * rstd * gg[2], v[j][3] * rstd * gg[3]); o[64 * j] = w; }
        }
        for (int idx = gtid; idx < SEQL * 64; idx += NGT) {
            const int pos = idx >> 6, i = idx & 63; double f = 1.0;
            for (int k = 0; k < i; ++k) f *= 0.8659643233600653;
            double s, c; sincos_d((double)pos * f, s, c);
            rot[2 * idx] = (float)c; rot[2 * idx + 1] = (float)s;
        }
        for (int i = gtid; i < 32; i += NGT) ctl[64 * i] = 0u;
        for (int i = gtid; i < MAXSLOT; i += NGT) { row_tok[i] = 0; row_gate[i] = 0.f; }
    }
    GSYNC();

    {
        PH_LOCALS
        pg8::Gemm g{XN, WIN, T_TOK, NPROJ, 2048}; pg8::StaticOrder S; S.init(T_TOK, NPROJ, G, bx);
        pg8::EpiProj E{P, rot};
        pg8::gemm_phase<pg8::EpiProj, pg8::StaticOrder, true, true>(lds, g, S, E, tid);
    }
    GSYNC();

    {
        PH_LOCALS
        const float* g_kv = IN(3);
        for (int t = gw; t < T_TOK; t += NGW) {
            const unsigned v = *(const unsigned*)(P + (size_t)t * NPROJ + C_CKV + 2 * lane);
            const float a = bflo(v), b = bfhi(v);
            const float rstd = 1.0f / sqrtf(wave_sum(a * a + b * b, lane) * (1.0f / 128.0f) + EPS_F);
            *(unsigned*)(KV + (size_t)t * 128 + 2 * lane) = pkbf(a * rstd * g_kv[2 * lane], b * rstd * g_kv[2 * lane + 1]);
        }
        LAS float* qi = (LAS float*)(lds + wave * 10240); LAS float* sc = qi + 512;
        for (int t = gw; t < T_TOK; t += NGW) {
            const int b = t >> 11, q = t & 2047, ng = (q >> 6) + 1;
            { const u32x4 v = *(const u32x4*)(P + (size_t)t * NPROJ + C_QIDX + lane * 8);
              f32x4 lo4 = (f32x4){bflo(v.x), bfhi(v.x), bflo(v.y), bfhi(v.y)}, hi4 = (f32x4){bflo(v.z), bfhi(v.z), bflo(v.w), bfhi(v.w)};
              *(LAS f32x4*)(qi + lane * 8) = lo4; *(LAS f32x4*)(qi + lane * 8 + 4) = hi4; }
            float w[8];
            { const u32x4 v = *(const u32x4*)(P + (size_t)t * NPROJ + C_WIDX); w[0] = bflo(v.x); w[1] = bfhi(v.x); w[2] = bflo(v.y); w[3] = bfhi(v.y); w[4] = bflo(v.z); w[5] = bfhi(v.z); w[6] = bflo(v.w); w[7] = bfhi(v.w); }
            for (int g = 0; g < ng; ++g) {
                LAS float* qg = qi; asm volatile("" : "+v"(qg));
                const int s = g * 64 + lane; const u32x4* kr = (const u32x4*)(P + (size_t)(b * SEQL + s) * NPROJ + C_KIDX);
                float dot[8];
#pragma unroll
                for (int h = 0; h < 8; ++h) dot[h] = 0.f;
#pragma unroll
                for (int c = 0; c < 8; ++c) {
                    const u32x4 v = kr[c];
                    const f32x4 ka = (f32x4){bflo(v.x), bfhi(v.x), bflo(v.y), bfhi(v.y)}, kb = (f32x4){bflo(v.z), bfhi(v.z), bflo(v.w), bfhi(v.w)};
#pragma unroll
                    for (int h = 0; h < 8; ++h) {
                        const f32x4 qa = *(const LAS f32x4*)(qg + h * 64 + c * 8), qb = *(const LAS f32x4*)(qg + h * 64 + c * 8 + 4);
                        dot[h] += (qa[0] * ka[0] + qa[1] * ka[1]) + (qa[2] * ka[2] + qa[3] * ka[3]) + (qb[0] * kb[0] + qb[1] * kb[1]) + (qb[2] * kb[2] + qb[3] * kb[3]);
                    }
                }
                float score = 0.f;
#pragma unroll
                for (int h = 0; h < 8; ++h) score += w[h] * fmaxf(dot[h], 0.f);
                sc[s] = score * IDX_SCALE;
            }
            u64* mrow = MASK + (size_t)t * 32;
            if (ng <= 4) { if (lane < 32) mrow[lane] = (lane < ng) ? ~0ull : 0ull; }
            else {
                unsigned lo = 0u;
                for (int bit = 31; bit >= 0; --bit) {
                    const unsigned cand = lo | (1u << bit); int cnt = 0;
                    for (int g = 0; g < ng; ++g) cnt += __popcll(__ballot(fkey(sc[g * 64 + lane]) >= cand));
                    if (cnt >= 256) lo = cand;
                }
                const unsigned tau = lo; int cgt = 0;
                for (int g = 0; g < ng; ++g) cgt += __popcll(__ballot(fkey(sc[g * 64 + lane]) > tau));
                const int need = 256 - cgt; int run = 0;
                for (int g = 0; g < ng; ++g) {
                    const unsigned key = fkey(sc[g * 64 + lane]);
                    const u64 gt = __ballot(key > tau), eq = __ballot(key == tau);
                    const u64 below = eq & ((1ull << lane) - 1ull);
                    const bool sel = (key == tau) && (run + (int)__popcll(below) < need);
                    const u64 word = gt | __ballot(sel);
                    run += (int)__popcll(eq);
                    if (lane == 0) mrow[g] = word;
                }
                if (lane >= ng && lane < 32) mrow[lane] = 0ull;
            }
        }
    }
    GSYNC();

    {
        PH_LOCALS
        const float* g_ret = IN(5);
        float* qv = (float*)(lds_raw + wave * 10240); float* lg = qv + 512;
        for (int it = gw; it < T_TOK * 8; it += NGW) {
            const int t = it >> 3, h = it & 7, b = t >> 11, q = t & 2047, ng = (q >> 6) + 1;
            { const unsigned v = *(const unsigned*)(P + (size_t)t * NPROJ + C_QLAT + h * 128 + 2 * lane); qv[2 * lane] = bflo(v); qv[2 * lane + 1] = bfhi(v); }
            const u64* mrow = MASK + (size_t)t * 32;
            float mx = -INFINITY;
            for (int g = 0; g < ng; ++g) {
                asm volatile("" ::: "memory");
                const u64 word = mrow[g]; float l = -INFINITY;
                if ((word >> lane) & 1ull) {
                    const u32x4* kr = (const u32x4*)(KV + (size_t)(b * SEQL + g * 64 + lane) * 128);
                    float d0 = 0.f, d1 = 0.f, d2 = 0.f, d3 = 0.f;
#pragma unroll
                    for (int c = 0; c < 16; ++c) { const u32x4 v = kr[c]; const f32x4 qa = *(const f32x4*)(qv + 8 * c), qb = *(const f32x4*)(qv + 8 * c + 4);
                        d0 += qa[0] * bflo(v.x) + qb[0] * bflo(v.z); d1 += qa[1] * bfhi(v.x) + qb[1] * bfhi(v.z); d2 += qa[2] * bflo(v.y) + qb[2] * bflo(v.w); d3 += qa[3] * bfhi(v.y) + qb[3] * bfhi(v.w); }
                    l = ((d0 + d1) + (d2 + d3)) * ATT_SCALE;
                }
                lg[g * 64 + lane] = l; mx = fmaxf(mx, l);
            }
            mx = wave_max(mx, lane);
            float o0 = 0.f, o1 = 0.f, sum = 0.f;
            for (int g = 0; g < ng; ++g) {
                const u64 wv = mrow[g];
                u64 word = ((u64)__builtin_amdgcn_readfirstlane((unsigned)(wv >> 32)) << 32) | (u64)__builtin_amdgcn_readfirstlane((unsigned)wv);
                while (word) {
                    const int j = __builtin_ctzll(word); word &= word - 1ull;
                    const int s = g * 64 + j; const float pj = __expf(lg[s] - mx);
                    const unsigned v = *(const unsigned*)(KV + (size_t)(b * SEQL + s) * 128 + 2 * lane);
                    o0 += pj * bflo(v); o1 += pj * bfhi(v); sum += pj;
                }
            }
            const float inv = 1.0f / sum;
            *(unsigned*)(OA + (size_t)t * 1024 + h * 128 + 2 * lane) = pkbf(o0 * inv, o1 * inv);
        }
        float* wl = lg;
        for (int it = gw; it < T_TOK * 8; it += NGW) {
            const int t = it >> 3, h = it & 7, b = t >> 11, n = t & 2047, ng = (n >> 6) + 1;
            const float lgam = (h == 0) ? -0.04580368961312479f : (h == 1) ? -0.02272007650008353f : (h == 2) ? -0.011315313227834146f : (h == 3) ? -0.005646563141142063f :
                               (h == 4) ? -0.0028205190623786626f : (h == 5) ? -0.0014095702546713536f : (h == 6) ? -0.0007046129765893727f : -0.0003522634716290214f;
            { const unsigned v = *(const unsigned*)(P + (size_t)t * NPROJ + C_QR + h * 128 + 2 * lane); qv[2 * lane] = bflo(v); qv[2 * lane + 1] = bfhi(v); }
            float o0 = 0.f, o1 = 0.f;
            for (int g = 0; g < ng; ++g) {
                asm volatile("" ::: "memory");
                const int m = g * 64 + lane;
                const u32x4* kr = (const u32x4*)(P + (size_t)(b * SEQL + m) * NPROJ + C_KR + h * 128);
                float d0 = 0.f, d1 = 0.f, d2 = 0.f, d3 = 0.f;
#pragma unroll
                for (int c = 0; c < 16; ++c) { const u32x4 v = kr[c]; const f32x4 qa = *(const f32x4*)(qv + 8 * c), qb = *(const f32x4*)(qv + 8 * c + 4);
                    d0 += qa[0] * bflo(v.x) + qb[0] * bflo(v.z); d1 += qa[1] * bfhi(v.x) + qb[1] * bfhi(v.z); d2 += qa[2] * bflo(v.y) + qb[2] * bflo(v.w); d3 += qa[3] * bfhi(v.y) + qb[3] * bfhi(v.w); }
                const float dot = (d0 + d1) + (d2 + d3);
                wl[lane] = (m <= n) ? dot * exp2f((float)(n - m) * lgam) : 0.f;
                const int jmax = (g == ng - 1) ? (n & 63) : 63;
                for (int j = 0; j <= jmax; ++j) {
                    const float wj = wl[j];
                    const unsigned v = *(const unsigned*)(P + (size_t)(b * SEQL + g * 64 + j) * NPROJ + C_VR + h * 128 + 2 * lane);
                    o0 += wj * bflo(v); o1 += wj * bfhi(v);
                }
            }
            const float mu = wave_sum(o0 + o1, lane) * (1.0f / 128.0f); const float e0 = o0 - mu, e1 = o1 - mu;
            const float rs = 1.0f / sqrtf(wave_sum(e0 * e0 + e1 * e1, lane) * (1.0f / 128.0f) + EPS_F);
            const unsigned gv = *(const unsigned*)(P + (size_t)t * NPROJ + C_GR + h * 128 + 2 * lane);
            const float y0 = siluf_(bflo(gv)) * e0 * rs * g_ret[h * 128 + 2 * lane], y1 = siluf_(bfhi(gv)) * e1 * rs * g_ret[h * 128 + 2 * lane + 1];
            *(unsigned*)(OB + (size_t)t * 1024 + h * 128 + 2 * lane) = pkbf(y0, y1);
        }
    }
    GSYNC();

    {
        PH_LOCALS
        pg8::Gemm g{OA, WCOMB, T_TOK, DMODEL, 1024}; pg8::StaticOrder S; S.init(T_TOK, DMODEL, G, bx);
        pg8::EpiMerge<0> E{P, nullptr, BA};
        pg8::gemm_phase<pg8::EpiMerge<0>, pg8::StaticOrder, true, true>(lds, g, S, E, tid);
    }
    GSYNC();
    {
        PH_LOCALS
        pg8::Gemm g{OB, WB, T_TOK, DMODEL, 1024}; pg8::StaticOrder S; S.init(T_TOK, DMODEL, G, bx);
        pg8::EpiMerge<1> E{P, BA, MIXED};
        pg8::gemm_phase<pg8::EpiMerge<1>, pg8::StaticOrder, true, true>(lds, g, S, E, tid);
    }
    GSYNC();
    {
        PH_LOCALS
        const float* x = IN(0);
        pg8::Gemm g{MIXED, WO, T_TOK, DMODEL, 2048}; pg8::StaticOrder S; S.init(T_TOK, DMODEL, G, bx);
        pg8::EpiRes E{x, out};
        pg8::gemm_phase<pg8::EpiRes, pg8::StaticOrder, true, true>(lds, g, S, E, tid);
    }
    GSYNC();

    {
    PH_LOCALS
    const float* g_ffn = IN(8); const float* w_rg = IN(9); const float* b_rg = IN(10); const float* w_re = IN(11); const float* b_re = IN(12);
    for (int t = gw; t < T_TOK; t += NGW) {
        const f32x4* hr = (const f32x4*)(out + (size_t)t * DMODEL) + lane; f32x4 v[8]; float ss = 0.f;
#pragma unroll
        for (int j = 0; j < 8; ++j) { v[j] = hr[64 * j]; ss += (v[j][0] * v[j][0] + v[j][1] * v[j][1]) + (v[j][2] * v[j][2] + v[j][3] * v[j][3]); }
        const float rstd = 1.0f / sqrtf(wave_sum(ss, lane) * (1.0f / DMODEL) + EPS_F);
        u32x2* o = (u32x2*)(TN + (size_t)t * DMODEL) + lane;
        const float* wrg_l = hide_p(w_rg); const float* wre_l = hide_p(w_re);
        float ga[4] = {0.f, 0.f, 0.f, 0.f};
#pragma unroll
        for (int j = 0; j < 8; ++j) {
            const f32x4 gg = ((const f32x4*)g_ffn)[lane + 64 * j]; v[j] = v[j] * gg;
            u32x2 w; w.x = pkbf(v[j][0] * rstd, v[j][1] * rstd); w.y = pkbf(v[j][2] * rstd, v[j][3] * rstd); o[64 * j] = w;
#pragma unroll
            for (int i = 0; i < 4; ++i) { const f32x4 wr_ = *(const f32x4*)(wrg_l + (unsigned)((4 * (lane + 64 * j) + i) * 4)); ga[0] += v[j][i] * wr_[0]; ga[1] += v[j][i] * wr_[1]; ga[2] += v[j][i] * wr_[2]; ga[3] += v[j][i] * wr_[3]; }
        }
        float gl[4];
#pragma unroll
        for (int k = 0; k < 4; ++k) gl[k] = wave_sum(ga[k], lane) * rstd + b_rg[k];
        int grp = 0; float gmx = gl[0];
#pragma unroll
        for (int k = 1; k < 4; ++k) if (gl[k] > gmx) { gmx = gl[k]; grp = k; }
        float gz = 0.f;
#pragma unroll
        for (int k = 0; k < 4; ++k) gz += __expf(gl[k] - gmx);
        const float p_grp = 1.0f / gz;
        float ea[8] = {0.f, 0.f, 0.f, 0.f, 0.f, 0.f, 0.f, 0.f};
#pragma unroll
        for (int j = 0; j < 8; ++j)
#pragma unroll
            for (int i = 0; i < 4; ++i) {
                const f32x4* we = (const f32x4*)(wre_l + (unsigned)((4 * (lane + 64 * j) + i) * 32 + grp * 8)); const f32x4 a = we[0], b2 = we[1];
                ea[0] += v[j][i] * a[0]; ea[1] += v[j][i] * a[1]; ea[2] += v[j][i] * a[2]; ea[3] += v[j][i] * a[3];
                ea[4] += v[j][i] * b2[0]; ea[5] += v[j][i] * b2[1]; ea[6] += v[j][i] * b2[2]; ea[7] += v[j][i] * b2[3];
            }
        float el[8];
#pragma unroll
        for (int k = 0; k < 8; ++k) el[k] = wave_sum(ea[k], lane) * rstd + b_re[grp * 8 + k];
        int i1 = 0; float m1 = el[0];
#pragma unroll
        for (int k = 1; k < 8; ++k) if (el[k] > m1) { m1 = el[k]; i1 = k; }
        int i2 = -1; float m2 = -INFINITY;
#pragma unroll
        for (int k = 0; k < 8; ++k) if (k != i1 && el[k] > m2) { m2 = el[k]; i2 = k; }
        const float e2 = __expf(m2 - m1); const float den = 1.0f / (1.0f + e2);
        const float g1 = p_grp * den, g2 = p_grp * e2 * den;
        if (lane == 0) {
            const int ex1 = grp * 8 + i1, ex2 = grp * 8 + i2;
            const unsigned r1 = atomicAdd(ctl + 64 * ex1, 1u), r2 = atomicAdd(ctl + 64 * ex2, 1u);
            asg_e[2 * t] = ex1; asg_e[2 * t + 1] = ex2; asg_r[2 * t] = (int)r1; asg_r[2 * t + 1] = (int)r2; asg_g[2 * t] = g1; asg_g[2 * t + 1] = g2;
        }
    }
    }
    GSYNC();

    LAS int* tile_start = (LAS int*)(lds + LDS_MISC);
    {
    PH_LOCALS
    if (tid == 0) {
        int acc_t = 0;
        for (int e = 0; e < 32; ++e) { tile_start[e] = acc_t; const int c = (int)__hip_atomic_load(ctl + 64 * e, __ATOMIC_RELAXED, __HIP_MEMORY_SCOPE_AGENT); acc_t += (c + 255) >> 8; }
        tile_start[32] = acc_t;
    }
    __syncthreads();
    for (int a = gw; a < 2 * T_TOK; a += NGW) {
        const int t = a >> 1; const int e = asg_e[a], rk = asg_r[a]; const int slot = tile_start[e] * 256 + rk;
        if (lane == 0) { row_tok[slot] = t; row_gate[slot] = asg_g[a]; tok_slot[a] = slot; }
        const u32x4* src = (const u32x4*)(TN + (size_t)t * DMODEL) + lane; u32x4* dst = (u32x4*)(XG + (size_t)slot * DMODEL) + lane;
#pragma unroll
        for (int j = 0; j < 4; ++j) dst[64 * j] = src[64 * j];
    }
    }
    GSYNC();

    {
        PH_LOCALS
        pg8::Gemm g{XG, WGU, MAXSLOT, 2048, 2048}; pg8::ExpertOrder S{tile_start, G, bx};
        pg8::EpiSwiglu E{HMID};
        pg8::gemm_phase<pg8::EpiSwiglu, pg8::ExpertOrder, true, true>(lds, g, S, E, tid);
    }
    GSYNC();
    {
        PH_LOCALS
        pg8::Gemm g{HMID, WD, MAXSLOT, 2048, 1024}; pg8::ExpertOrder S{tile_start, G, bx};
        pg8::EpiDown E{Y, row_gate};
        pg8::gemm_phase<pg8::EpiDown, pg8::ExpertOrder, true, true>(lds, g, S, E, tid);
    }
    GSYNC();

    {
    PH_LOCALS
    const float* g_fin = IN(16);
    for (int t = gw; t < T_TOK; t += NGW) {
        const int s0 = tok_slot[2 * t], s1 = tok_slot[2 * t + 1];
        f32x4* hr = (f32x4*)(out + (size_t)t * DMODEL) + lane; const u32x2* y0 = (const u32x2*)(Y + (size_t)s0 * DMODEL) + lane; const u32x2* y1 = (const u32x2*)(Y + (size_t)s1 * DMODEL) + lane;
        f32x4 v[8]; float ss = 0.f;
#pragma unroll
        for (int j = 0; j < 8; ++j) {
            v[j] = hr[64 * j]; const u32x2 a = y0[64 * j], b2 = y1[64 * j];
            v[j][0] += bflo(a.x) + bflo(b2.x); v[j][1] += bfhi(a.x) + bfhi(b2.x); v[j][2] += bflo(a.y) + bflo(b2.y); v[j][3] += bfhi(a.y) + bfhi(b2.y);
            ss += (v[j][0] * v[j][0] + v[j][1] * v[j][1]) + (v[j][2] * v[j][2] + v[j][3] * v[j][3]);
        }
        const float rstd = 1.0f / sqrtf(wave_sum(ss, lane) * (1.0f / DMODEL) + EPS_F);
#pragma unroll
        for (int j = 0; j < 8; ++j) { const f32x4 gg = ((const f32x4*)g_fin)[lane + 64 * j]; hr[64 * j] = v[j] * rstd * gg; }
    }
    }
}

extern "C" void kernel_launch(void* const* d_in, const int* in_sizes, int n_in, void* d_out, int out_size, void* d_ws, size_t ws_size, hipStream_t stream) {
    static int grid_blocks = 0;
    if (grid_blocks == 0) {
        if (n_in != 17 || out_size != T_TOK * DMODEL || ws_size < WS_END) { fprintf(stderr, "kernel_launch: unexpected problem (n_in %d, out %d, ws %zu < %zu)\n", n_in, out_size, ws_size, (size_t)WS_END); grid_blocks = -1; return; }
        int dev = 0, cus = 0, per_cu = 0;
        (void)hipGetDevice(&dev);
        (void)hipDeviceGetAttribute(&cus, hipDeviceAttributeMultiprocessorCount, dev);
        if (hipFuncSetAttribute((const void*)mega_fwd, hipFuncAttributeMaxDynamicSharedMemorySize, LDS_BYTES) != hipSuccess) { fprintf(stderr, "kernel_launch: hipFuncSetAttribute failed\n"); grid_blocks = -1; return; }
        if (hipOccupancyMaxActiveBlocksPerMultiprocessor(&per_cu, (const void*)mega_fwd, 512, LDS_BYTES) != hipSuccess || per_cu < 1) { fprintf(stderr, "kernel_launch: occupancy query says %d\n", per_cu); grid_blocks = -1; return; }
        grid_blocks = cus;
        fprintf(stderr, "kernel_launch: cus %d per_cu %d grid %d ws %zu need %zu\n", cus, per_cu, grid_blocks, ws_size, (size_t)WS_END);
    }
    if (grid_blocks < 0) return;
    Params prm{};
    for (int i = 0; i < 17; ++i) prm.in[i] = (const float*)d_in[i];
    prm.out = (float*)d_out; prm.ws = (unsigned char*)d_ws;
    void* args[] = {&prm};
    hipError_t e = hipLaunchCooperativeKernel((void*)mega_fwd, dim3(grid_blocks), dim3(512), args, LDS_BYTES, stream);
    if (e != hipSuccess) fprintf(stderr, "cooperative launch failed: %s (grid %d)\n", hipGetErrorString(e), grid_blocks);
}
```

```cpp
#include <hip/hip_runtime.h>
#include <hip/hip_cooperative_groups.h>
#include <cstdio>
#include <cstdint>
namespace cg = cooperative_groups;
namespace pg8 {
#define PG8_LAS __attribute__((address_space(3)))
typedef unsigned short bf16_t;
typedef short bf16x8 __attribute__((ext_vector_type(8)));
typedef float f32x4 __attribute__((ext_vector_type(4)));
typedef unsigned u32x4 __attribute__((ext_vector_type(4)));
constexpr int BM = 256, BK = 64, HALF = 128, HTB = HALF * BK * 2  , STAGE_BYTES = 8 * HTB, NXCD = 8, WGM = 8;

__host__ __device__ __forceinline__ int lds_byte(int r, int c) { const int st = (r >> 4) * 2 + (c >> 5), rr = r & 15, cc = c & 31, ob = rr * 64 + cc * 2; return st * 1024 + (ob ^ (((ob >> 9) & 1) << 5)); }
__host__ __device__ __forceinline__ void stage_rc(int b, int& R, int& C) { const int st = b / 1024, sb = b % 1024, swz = sb ^ (((sb >> 9) & 1) << 5); R = (st >> 1) * 16 + swz / 64; C = (st & 1) * 32 + (swz % 64) / 2; }
__host__ __device__ __forceinline__ int perm32(int rho) { const int n = rho >> 4, i = rho & 15; return 8 * (i >> 2) + 4 * n + (i & 3); }

struct Unit { int pm, pn, e; };
struct Gemm { const bf16_t* A; const bf16_t* Bt; int M, N, K; };

struct StaticOrder {
    int nM, nN, nwg, G, c;
    __host__ __device__ void init(int M, int N, int G_, int c_) { nM = M / BM; nN = N / BM; nwg = nM * nN; G = G_; c = c_; }
    __host__ __device__ bool next(int i, Unit& u) const {
        const long L = (long)i * G + c; if (L >= nwg) return false;
        int wgid = (int)L; { const int q = nwg / NXCD, r = nwg % NXCD, xcd = wgid % NXCD, off = wgid / NXCD; wgid = (xcd < r ? xcd * (q + 1) : r * (q + 1) + (xcd - r) * q) + off; }
        const int nig = WGM * nN, gid = wgid / nig, fm = gid * WGM, gsz = (nM - fm) < WGM ? (nM - fm) : WGM;
        u.pm = fm + ((wgid % nig) % gsz); u.pn = (wgid % nig) / gsz; u.e = 0; return true;
    }
    __device__ __forceinline__ void a_ready(const Unit&) const {}
    __device__ __forceinline__ void done(const Unit&) const {}
};

template <class Epi, class Sched, bool ALIGN_EPI = false, bool SP2 = false>
__device__ __forceinline__ void gemm_phase(PG8_LAS unsigned char* lds, const Gemm g, const Sched& S, const Epi& E, const int tid) {
    const int wid = __builtin_amdgcn_readfirstlane(tid >> 6), lane = tid & 63, wr = wid >> 2, wc = wid & 3, fr = lane & 15, fq = lane >> 4;
    const int K = g.K, nt = K / BK;
    unsigned voffA[2], voffB[2];
#pragma unroll
    for (int i = 0; i < 2; ++i) { int R, C; stage_rc(tid * 16 + i * 8192, R, C); const int Rb = Epi::PERM ? ((R & ~31) + perm32(R & 31)) : R;
        voffA[i] = (unsigned)(R * K + C) * 2u; voffB[i] = (unsigned)(Rb * K + C) * 2u; }
    const size_t kstep = (size_t)(BK * 2);
    const size_t hstep = (size_t)HALF * K * 2;
    const size_t tstep = 2 * hstep;
    const unsigned ldsw = (unsigned)wid * 1024u;
    const int aoff = lds_byte(wr * 64 + fr, fq * 8), boff = lds_byte(wc * 32 + fr, fq * 8);
#define PG8_SA(b, h) (((b) * 2 + (h)) * HTB)
#define PG8_SB(b, h) ((4 + (b) * 2 + (h)) * HTB)
#define PG8_STAGE(bufoff, gbase, voff) do { _Pragma("unroll") for (int _i = 0; _i < 2; ++_i) \
        __builtin_amdgcn_global_load_lds((const unsigned*)((const char*)(gbase) + (voff)[_i]), (PG8_LAS unsigned*)(lds + (bufoff) + ldsw + _i * 8192), 16, 0, 0); } while (0)
#define PG8_LDA(dst, b, h) do { _Pragma("unroll") for (int m = 0; m < 4; ++m) _Pragma("unroll") for (int k = 0; k < 2; ++k) dst[m][k] = *(const PG8_LAS bf16x8*)(lds + PG8_SA(b, h) + aoff + m * 2048 + k * 1024); } while (0)
#define PG8_LDB(dst, b, h) do { _Pragma("unroll") for (int n = 0; n < 2; ++n) _Pragma("unroll") for (int k = 0; k < 2; ++k) dst[n][k] = *(const PG8_LAS bf16x8*)(lds + PG8_SB(b, h) + boff + n * 2048 + k * 1024); } while (0)
#define PG8_MMA(ai, bj, At, Bt) do { __builtin_amdgcn_s_setprio(1); _Pragma("unroll") for (int m = 0; m < 4; ++m) _Pragma("unroll") for (int n = 0; n < 2; ++n) _Pragma("unroll") for (int k = 0; k < 2; ++k) \
        acc[ai][bj][m][n] = __builtin_amdgcn_mfma_f32_16x16x32_bf16(Bt[n][k], At[m][k], acc[ai][bj][m][n], 0, 0, 0); __builtin_amdgcn_s_setprio(0); } while (0)
#define PG8_WAIT_V(n) asm volatile("s_waitcnt vmcnt(" #n ")" ::: "memory")
#define PG8_WAIT_L(n) asm volatile("s_waitcnt lgkmcnt(" #n ")" ::: "memory")
#define PG8_BAR __builtin_amdgcn_s_barrier()
#define PG8_SCHED __builtin_amdgcn_sched_barrier(0)
    Unit cur, nxt; int ui = 0;
    if (!S.next(0, cur)) return;
    f32x4 acc[2][2][4][2];
#pragma unroll
    for (int a = 0; a < 2; ++a)
#pragma unroll
        for (int b = 0; b < 2; ++b)
#pragma unroll
            for (int m = 0; m < 4; ++m)
#pragma unroll
                for (int n = 0; n < 2; ++n) acc[a][b][m][n] = (f32x4){0.f, 0.f, 0.f, 0.f};
    bf16x8 At[4][2], B0[2][2], B1[2][2];
    const size_t estep = (size_t)g.N * K * 2;
    const char* cA = (const char*)g.A + (size_t)cur.pm * tstep; const char* cB = (const char*)g.Bt + (size_t)cur.e * estep + (size_t)cur.pn * tstep;
    S.a_ready(cur);
    if constexpr (SP2) {
        PG8_STAGE(PG8_SB(0, 0), cB, voffB); PG8_STAGE(PG8_SB(0, 1), cB + hstep, voffB); PG8_STAGE(PG8_SA(0, 0), cA, voffA); PG8_STAGE(PG8_SA(0, 1), cA + hstep, voffA);
        if (wr == 1) PG8_BAR;
        PG8_WAIT_V(2); PG8_BAR;
        PG8_STAGE(PG8_SB(1, 0), cB + kstep, voffB); PG8_STAGE(PG8_SA(1, 0), cA + kstep, voffA); PG8_STAGE(PG8_SB(1, 1), cB + hstep + kstep, voffB);
        PG8_WAIT_V(6); PG8_BAR;
    } else {
        PG8_STAGE(PG8_SB(0, 0), cB, voffB); PG8_STAGE(PG8_SA(0, 0), cA, voffA); PG8_STAGE(PG8_SB(0, 1), cB + hstep, voffB); PG8_STAGE(PG8_SA(0, 1), cA + hstep, voffA);
        if (wr == 1) PG8_BAR;
        PG8_WAIT_V(4); PG8_BAR;
        PG8_STAGE(PG8_SB(1, 0), cB + kstep, voffB); PG8_STAGE(PG8_SA(1, 0), cA + kstep, voffA); PG8_STAGE(PG8_SB(1, 1), cB + hstep + kstep, voffB);
        PG8_WAIT_V(6); PG8_BAR;
    }
    for (;;) {
        const bool has_next = S.next(ui + 1, nxt);
        const char* nA = has_next ? (const char*)g.A + (size_t)nxt.pm * tstep : cA; const char* nB = has_next ? (const char*)g.Bt + (size_t)nxt.e * estep + (size_t)nxt.pn * tstep : cB;
        for (int t = 0; t < nt; t += 2) {
            const bool last = (t == nt - 2);
            const char* a1 = cA + (size_t)(t + 1) * kstep;
            const char* a2 = last ? nA : cA + (size_t)(t + 2) * kstep; const char* b2 = last ? nB : cB + (size_t)(t + 2) * kstep;
            const char* a3 = a2 + kstep; const char* b3 = b2 + kstep;
            if (last && has_next) S.a_ready(nxt);
            if constexpr (SP2) {
            PG8_LDB(B0, 0, 0); PG8_LDB(B1, 0, 1); PG8_SCHED; PG8_LDA(At, 0, 0); PG8_STAGE(PG8_SA(1, 1), a1 + hstep, voffA);
            PG8_WAIT_V(8); PG8_WAIT_L(0); PG8_BAR; PG8_MMA(0, 0, At, B0); PG8_MMA(0, 1, At, B1); PG8_BAR; PG8_SCHED;
            PG8_LDA(At, 0, 1); PG8_STAGE(PG8_SB(0, 0), b2, voffB); PG8_STAGE(PG8_SB(0, 1), b2 + hstep, voffB); PG8_STAGE(PG8_SA(0, 0), a2, voffA);
            PG8_WAIT_V(8); PG8_WAIT_L(0); PG8_BAR; PG8_MMA(1, 0, At, B0); PG8_MMA(1, 1, At, B1); PG8_BAR; PG8_SCHED;
            PG8_LDB(B0, 1, 0); PG8_LDB(B1, 1, 1); PG8_SCHED; PG8_LDA(At, 1, 0); PG8_STAGE(PG8_SA(0, 1), a2 + hstep, voffA);
            PG8_WAIT_V(8); PG8_WAIT_L(0); PG8_BAR; PG8_MMA(0, 0, At, B0); PG8_MMA(0, 1, At, B1); PG8_BAR; PG8_SCHED;
            PG8_LDA(At, 1, 1); PG8_STAGE(PG8_SB(1, 0), b3, voffB); PG8_STAGE(PG8_SB(1, 1), b3 + hstep, voffB); PG8_STAGE(PG8_SA(1, 0), a3, voffA);
            PG8_WAIT_V(8); PG8_WAIT_L(0); PG8_BAR; PG8_MMA(1, 0, At, B0); PG8_MMA(1, 1, At, B1); PG8_BAR; PG8_SCHED;
            } else {
            PG8_LDB(B0, 0, 0); PG8_SCHED; PG8_LDA(At, 0, 0); PG8_STAGE(PG8_SA(1, 1), a1 + hstep, voffA);
            PG8_WAIT_L(8); PG8_BAR; PG8_WAIT_L(0); PG8_MMA(0, 0, At, B0); PG8_BAR; PG8_SCHED;
            PG8_LDB(B1, 0, 1); PG8_STAGE(PG8_SB(0, 0), b2, voffB);
            PG8_BAR; PG8_WAIT_L(0); PG8_MMA(0, 1, At, B1); PG8_BAR;
            PG8_LDA(At, 0, 1); PG8_STAGE(PG8_SA(0, 0), a2, voffA);
            PG8_BAR; PG8_WAIT_L(0); PG8_MMA(1, 0, At, B0); PG8_BAR; PG8_SCHED;
            PG8_STAGE(PG8_SB(0, 1), b2 + hstep, voffB);
            PG8_WAIT_V(6); PG8_BAR; PG8_MMA(1, 1, At, B1); PG8_BAR;
            PG8_LDB(B0, 1, 0); PG8_SCHED; PG8_LDA(At, 1, 0); PG8_STAGE(PG8_SA(0, 1), a2 + hstep, voffA);
            PG8_WAIT_L(8); PG8_BAR; PG8_WAIT_L(0); PG8_MMA(0, 0, At, B0); PG8_BAR; PG8_SCHED;
            PG8_LDB(B1, 1, 1); PG8_STAGE(PG8_SB(1, 0), b3, voffB);
            PG8_BAR; PG8_WAIT_L(0); PG8_MMA(0, 1, At, B1); PG8_BAR;
            PG8_LDA(At, 1, 1); PG8_STAGE(PG8_SA(1, 0), a3, voffA);
            PG8_BAR; PG8_WAIT_L(0); PG8_MMA(1, 0, At, B0); PG8_BAR; PG8_SCHED;
            PG8_STAGE(PG8_SB(1, 1), b3 + hstep, voffB);
            PG8_WAIT_V(6); PG8_BAR; PG8_MMA(1, 1, At, B1); PG8_BAR;
            }
        }
        if constexpr (ALIGN_EPI) { if (wr == 0) PG8_BAR; }
        if constexpr (!Epi::AFTER_DRAIN) { E(acc, cur, wr, wc, fr, fq); S.done(cur); }
        if (!has_next) break;
#pragma unroll
        for (int a = 0; a < 2; ++a)
#pragma unroll
            for (int b = 0; b < 2; ++b)
#pragma unroll
                for (int m = 0; m < 4; ++m)
#pragma unroll
                    for (int n = 0; n < 2; ++n) acc[a][b][m][n] = (f32x4){0.f, 0.f, 0.f, 0.f};
        cur = nxt; cA = nA; cB = nB; ++ui;
        if constexpr (ALIGN_EPI) { if (wr == 1) PG8_BAR; }
    }
    PG8_WAIT_V(0);
    if constexpr (!ALIGN_EPI) { if (wr == 0) PG8_BAR; }
    PG8_BAR;
    if constexpr (Epi::AFTER_DRAIN) { E.fused(acc, cur, wr, wc, fr, fq, lds, wid, lane); S.done(cur); }
#undef PG8_SA
#undef PG8_SB
#undef PG8_STAGE
#undef PG8_LDA
#undef PG8_LDB
#undef PG8_MMA
#undef PG8_WAIT_V
#undef PG8_WAIT_L
#undef PG8_BAR
#undef PG8_SCHED
}
}

#ifndef DBG_CMP
#define DBG_CMP 0
#endif
#define LAS __attribute__((address_space(3)))
typedef unsigned short bf16_t;
typedef float f32x4 __attribute__((ext_vector_type(4)));
typedef unsigned u32x4 __attribute__((ext_vector_type(4)));
typedef unsigned u32x2 __attribute__((ext_vector_type(2)));
typedef unsigned long long u64;

constexpr int T_TOK = 16384, DMODEL = 2048, SEQL = 2048;
constexpr int NPROJ = 9984;
constexpr int C_QLAT = 0, C_CKV = 1024, C_QIDX = 1152, C_KIDX = 1664, C_WIDX = 1728, C_QR = 1792, C_KR = 2816, C_VR = 3840, C_GR = 4864, C_GBR = 5888;
constexpr int MAXSLOT = 40960;
constexpr float EPS_F = 1e-6f;
constexpr float IDX_SCALE = 0.04419417382415922f;
constexpr float ATT_SCALE = 0.08838834764831845f;
constexpr float K_SCALE = 0.08838834764831845f;

constexpr size_t WS_CTL = 0;
constexpr size_t WS_ROT = 65536;
constexpr size_t WS_WIN = WS_ROT + 1048576;
constexpr size_t WS_WCOMB = WS_WIN + (size_t)NPROJ * 2048 * 2;
constexpr size_t WS_WB = WS_WCOMB + (size_t)2048 * 1024 * 2;
constexpr size_t WS_WO = WS_WB + (size_t)2048 * 1024 * 2;
constexpr size_t WS_WGU = WS_WO + (size_t)2048 * 2048 * 2;
constexpr size_t WS_WD = WS_WGU + (size_t)32 * 2048 * 2048 * 2;
constexpr size_t WS_P = WS_WD + (size_t)32 * 2048 * 1024 * 2;
constexpr size_t WS_HMID = WS_P;
constexpr size_t WS_Y = WS_HMID + (size_t)MAXSLOT * 1024 * 2;
constexpr size_t WS_XN = WS_P + (size_t)T_TOK * NPROJ * 2;
constexpr size_t WS_OA = WS_XN + (size_t)T_TOK * 2048 * 2;
constexpr size_t WS_OB = WS_OA + (size_t)T_TOK * 1024 * 2;
constexpr size_t WS_MIXED = WS_OB + (size_t)T_TOK * 1024 * 2;
constexpr size_t WS_SPARE = WS_MIXED + (size_t)T_TOK * 2048 * 2;
constexpr size_t WS_XG = WS_OA;
constexpr size_t WS_KV = WS_SPARE + (size_t)T_TOK * 1024 * 2;
constexpr size_t WS_MASK = WS_KV + (size_t)T_TOK * 128 * 2;
constexpr size_t WS_MISC = WS_MASK + (size_t)T_TOK * 256;
constexpr size_t WS_END = WS_MISC + 1048576;
static_assert(WS_Y + (size_t)MAXSLOT * 2048 * 2 <= WS_XN, "HMID + Y must fit in P");
static_assert(WS_XG + (size_t)MAXSLOT * 2048 * 2 <= WS_KV, "XG must fit in OA..SPARE");
static_assert(WS_END <= (size_t)1073741824, "workspace budget");
constexpr int MI_ROWTOK = 0, MI_ROWGATE = MAXSLOT, MI_TOKSLOT = 2 * MAXSLOT, MI_ASGE = MI_TOKSLOT + 2 * T_TOK, MI_ASGR = MI_ASGE + 2 * T_TOK, MI_ASGG = MI_ASGR + 2 * T_TOK;
static_assert((size_t)(MI_ASGG + 2 * T_TOK) * 4 <= 1048576, "misc budget");
constexpr int LDS_BYTES = 136 * 1024;
constexpr int LDS_MISC = 128 * 1024;

__device__ __forceinline__ float bflo(unsigned w) { return __uint_as_float(w << 16); }
__device__ __forceinline__ float bfhi(unsigned w) { return __uint_as_float(w & 0xffff0000u); }
__device__ __forceinline__ unsigned pkbf(float lo, float hi) { unsigned r; asm volatile("v_cvt_pk_bf16_f32 %0, %1, %2" : "=v"(r) : "v"(lo), "v"(hi)); return r; }
__device__ __forceinline__ int hide_i(int v) { asm volatile("" : "+v"(v)); return v; }
template <class Tp> __device__ __forceinline__ Tp* hide_p(Tp* q) { asm volatile("" : "+s"(q)); return q; }
__device__ __forceinline__ float shx(float v, int lane, int o) { return __int_as_float(__builtin_amdgcn_ds_bpermute((lane ^ o) << 2, __float_as_int(v))); }
__device__ __forceinline__ float wave_sum(float v, int lane) {
#pragma unroll
    for (int o = 1; o < 64; o <<= 1) v += shx(v, lane, o);
    return v;
}
__device__ __forceinline__ float wave_max(float v, int lane) {
#pragma unroll
    for (int o = 1; o < 64; o <<= 1) v = fmaxf(v, shx(v, lane, o));
    return v;
}
__device__ __forceinline__ float sigmoidf_(float x) { return __builtin_amdgcn_rcpf(1.0f + __expf(-x)); }
__device__ __forceinline__ float siluf_(float x) { return x * sigmoidf_(x); }
__device__ __forceinline__ unsigned fkey(float f) { const unsigned u = __float_as_uint(f + 0.0f); return (u & 0x80000000u) ? ~u : (u | 0x80000000u); }


namespace fa {
using bf16x8 = __attribute__((ext_vector_type(8))) short;
using s16x4  = __attribute__((ext_vector_type(4))) short;
using f32x16 = __attribute__((ext_vector_type(16))) float;
constexpr int TILE_B = 64 * 128 * 2;
constexpr int OFF_V = 0, OFF_K = 2 * TILE_B, OFF_M = 4 * TILE_B, OFF_WS = OFF_M + 2 * 256, LDS_NEED = OFF_WS + 8 * 256;
#define FA_KSWZ(row, colB) ((row) * 256 + ((colB) ^ (((row) & 7) << 4)))
#define FA_SBAR() __builtin_amdgcn_sched_barrier(0)
__device__ __forceinline__ int crow(int r, int hi) { return (r & 3) + 8 * (r >> 2) + 4 * hi; }
__device__ __forceinline__ int v_st(int k, int c) { const int kk = (k & ~0xC) | ((k & 4) << 1) | ((k & 8) >> 1); return ((kk >> 3) * 4 + (c >> 5)) * 512 + ((kk & 7) * 32 + (c & 31)) * 2; }
__device__ __forceinline__ int v_rd_base(int lane) { return ((lane & 3) << 3) | (((lane >> 2) & 3) << 6) | (((lane >> 4) & 1) << 5) | (((lane >> 5) & 1) << 8); }
constexpr int v_rd_off(int d0, int ks, int half) { return d0 * 512 + ks * 4096 + half * 2048; }
template <int OFF> __device__ __forceinline__ s16x4 tr_read(int vb) { s16x4 r; asm volatile("ds_read_b64_tr_b16 %0, %1 offset:%2" : "=&v"(r) : "v"(vb), "i"(OFF) : "memory"); return r; }
template <int D0> __device__ __forceinline__ void pv_one(f32x16& od, int vb, bf16x8 pa0, bf16x8 pa1, bf16x8 pa2, bf16x8 pa3) {
    const s16x4 l0 = tr_read<v_rd_off(D0, 0, 0)>(vb), h0 = tr_read<v_rd_off(D0, 0, 1)>(vb), l1 = tr_read<v_rd_off(D0, 1, 0)>(vb), h1 = tr_read<v_rd_off(D0, 1, 1)>(vb);
    const s16x4 l2 = tr_read<v_rd_off(D0, 2, 0)>(vb), h2 = tr_read<v_rd_off(D0, 2, 1)>(vb), l3 = tr_read<v_rd_off(D0, 3, 0)>(vb), h3 = tr_read<v_rd_off(D0, 3, 1)>(vb);
    asm volatile("s_waitcnt lgkmcnt(0)" ::: "memory"); FA_SBAR();
#define FA_PK(L, H) (bf16x8){L[0], L[1], L[2], L[3], H[0], H[1], H[2], H[3]}
    od = __builtin_amdgcn_mfma_f32_32x32x16_bf16(pa0, FA_PK(l0, h0), od, 0, 0, 0);
    od = __builtin_amdgcn_mfma_f32_32x32x16_bf16(pa1, FA_PK(l1, h1), od, 0, 0, 0);
    od = __builtin_amdgcn_mfma_f32_32x32x16_bf16(pa2, FA_PK(l2, h2), od, 0, 0, 0);
    od = __builtin_amdgcn_mfma_f32_32x32x16_bf16(pa3, FA_PK(l3, h3), od, 0, 0, 0);
#undef FA_PK
}
__device__ __forceinline__ void qkt(f32x16& p0, f32x16& p1, const LAS char* Ks, const bf16x8 (&qr)[8], int r32, int hi) {
    p0 = f32x16{}; p1 = f32x16{};
#pragma unroll
    for (int d0 = 0; d0 < 8; ++d0) { const int cb = (d0 * 16 + hi * 8) * 2;
        const bf16x8 b0 = *(const LAS bf16x8*)(Ks + FA_KSWZ(r32, cb));
        const bf16x8 b1 = *(const LAS bf16x8*)(Ks + FA_KSWZ(32 + r32, cb));
        p0 = __builtin_amdgcn_mfma_f32_32x32x16_bf16(b0, qr[d0], p0, 0, 0, 0);
        p1 = __builtin_amdgcn_mfma_f32_32x32x16_bf16(b1, qr[d0], p1, 0, 0, 0); }
}
__device__ __forceinline__ void p_to_frag(const f32x16& p0, const f32x16& p1, bf16x8& pa0, bf16x8& pa1, bf16x8& pa2, bf16x8& pa3) {
#define FA_PK4(P, BASE, OUT) do { unsigned a0 = pkbf(P[BASE + 0], P[BASE + 1]), a1 = pkbf(P[BASE + 2], P[BASE + 3]);   \
    unsigned b0 = pkbf(P[BASE + 4], P[BASE + 5]), b1 = pkbf(P[BASE + 6], P[BASE + 7]);                              \
    auto r0 = __builtin_amdgcn_permlane32_swap(a0, b0, false, false); auto r1 = __builtin_amdgcn_permlane32_swap(a1, b1, false, false); \
    u32x4 w = {r0[0], r1[0], r0[1], r1[1]}; OUT = *reinterpret_cast<bf16x8*>(&w); } while (0)
    FA_PK4(p0, 0, pa0); FA_PK4(p0, 8, pa1); FA_PK4(p1, 0, pa2); FA_PK4(p1, 8, pa3);
#undef FA_PK4
}

struct UnitArgs {
    const bf16_t* Q; int ldq;
    const bf16_t* K; const bf16_t* V; int ldk;
    const u64* mask;
    int ntiles;
    int n0;
    float lgam;
};

template <int MODE>
__device__ __forceinline__ void unit_body(LAS char* L, const UnitArgs& U, int tid, f32x16 (&o)[4], float& l_out) {
    const int wid = __builtin_amdgcn_readfirstlane(tid >> 6), lane = tid & 63, r32 = lane & 31, hi = lane >> 5;
    LAS char* V_lds = L + OFF_V; LAS char* K_lds = L + OFF_K; LAS u64* M_lds = (LAS u64*)(L + OFF_M);
    LAS float* wsf = (LAS float*)(L + OFF_WS) + wid * 64; LAS float* al_l = wsf + 32;
    constexpr float C = ATT_SCALE * 1.4426950408889634f;
    float m_reg = -1e30f, l_reg = 0.f;
#pragma unroll
    for (int d = 0; d < 4; ++d) o[d] = f32x16{};
    bf16x8 qr[8];
    { const bf16_t* Qw = (MODE == 0) ? U.Q + (size_t)r32 * U.ldq + wid * 128 + hi * 8 : U.Q + (size_t)(wid * 32 + r32) * U.ldq + hi * 8;
#pragma unroll
      for (int d0 = 0; d0 < 8; ++d0) qr[d0] = *(const bf16x8*)(Qw + d0 * 16); }
    const int sr = tid >> 4, sc = (tid & 15) * 8, vst0 = v_st(sr, sc), vst1 = v_st(32 + sr, sc), kst0 = FA_KSWZ(sr, sc * 2), kst1 = FA_KSWZ(32 + sr, sc * 2);
    const int vb0 = (int)(unsigned)(size_t)V_lds + v_rd_base(lane);
    bf16x8 ks0, ks1, vs0, vs1; u64 mws = 0ull;
#define FA_SLOAD(k0) do { ks0 = *(const bf16x8*)(U.K + (size_t)((k0) + sr) * U.ldk + sc); ks1 = *(const bf16x8*)(U.K + (size_t)((k0) + 32 + sr) * U.ldk + sc); \
        if (MODE == 1) { vs0 = *(const bf16x8*)(U.V + (size_t)((k0) + sr) * U.ldk + sc); vs1 = *(const bf16x8*)(U.V + (size_t)((k0) + 32 + sr) * U.ldk + sc); } \
        if (MODE == 0 && tid < 32) mws = U.mask[(size_t)tid * 32 + ((k0) >> 6)]; } while (0)
#define FA_SWRITE(b) do { *(LAS bf16x8*)(K_lds + (b) * TILE_B + kst0) = ks0; *(LAS bf16x8*)(K_lds + (b) * TILE_B + kst1) = ks1; \
        *(LAS bf16x8*)(V_lds + (b) * TILE_B + vst0) = (MODE == 1) ? vs0 : ks0; *(LAS bf16x8*)(V_lds + (b) * TILE_B + vst1) = (MODE == 1) ? vs1 : ks1; \
        if (MODE == 0 && tid < 32) M_lds[(b) * 32 + tid] = mws; } while (0)
    const int NT = U.ntiles;
    FA_SLOAD(0); FA_SWRITE(0);
    if (NT > 1) { FA_SLOAD(64); FA_SWRITE(1); }
    __syncthreads();
    for (int j = 0; j < NT; ++j) {
        const int b = j & 1;
        if (j + 2 < NT) FA_SLOAD((j + 2) * 64);
        f32x16 p0, p1; bf16x8 pa0, pa1, pa2, pa3;
        qkt(p0, p1, K_lds + b * TILE_B, qr, r32, hi);
        if (MODE == 0) {
            const u64 mw = M_lds[b * 32 + r32] >> (4 * hi);
            const unsigned mlo = (unsigned)mw, mhi = (unsigned)(mw >> 32);
#pragma unroll
            for (int r = 0; r < 16; ++r) { const unsigned bit = 1u << ((r & 3) + 8 * (r >> 2)); p0[r] = (mlo & bit) ? p0[r] : -INFINITY; p1[r] = (mhi & bit) ? p1[r] : -INFINITY; }
            float pmax = p0[0];
#pragma unroll
            for (int r = 1; r < 16; ++r) pmax = fmaxf(pmax, p0[r]);
#pragma unroll
            for (int r = 0; r < 16; ++r) pmax = fmaxf(pmax, p1[r]);
            { auto rr = __builtin_amdgcn_permlane32_swap(__float_as_uint(pmax), __float_as_uint(pmax), false, false); pmax = fmaxf(__uint_as_float(rr[0]), __uint_as_float(rr[1])); }
            const float mn = fmaxf(m_reg, pmax); const float alpha = __builtin_amdgcn_exp2f((m_reg - mn) * C); m_reg = mn;
            const float mnC = -mn * C; float ps = 0.f;
#pragma unroll
            for (int r = 0; r < 16; ++r) { p0[r] = __builtin_amdgcn_exp2f(fmaf(p0[r], C, mnC)); p1[r] = __builtin_amdgcn_exp2f(fmaf(p1[r], C, mnC)); ps += p0[r] + p1[r]; }
            { auto rr = __builtin_amdgcn_permlane32_swap(__float_as_uint(ps), __float_as_uint(ps), false, false); ps = __uint_as_float(rr[0]) + __uint_as_float(rr[1]); }
            l_reg = l_reg * alpha + ps;
            if (__any(alpha < 1.f)) {
                if (hi == 0) al_l[r32] = alpha;
                asm volatile("s_waitcnt lgkmcnt(0)" ::: "memory");
#pragma unroll
                for (int r = 0; r < 16; ++r) { const float a = al_l[crow(r, hi)];
#pragma unroll
                    for (int d = 0; d < 4; ++d) o[d][r] *= a; }
            }
        } else {
            const int dn = U.n0 + wid * 32 + r32 - j * 64 - 4 * hi;
            const float base = (float)dn * U.lgam;
#pragma unroll
            for (int r = 0; r < 16; ++r) { const int kk = (r & 3) + 8 * (r >> 2);
                const float f0 = __builtin_amdgcn_exp2f(base - (float)kk * U.lgam), f1 = __builtin_amdgcn_exp2f(base - (float)(kk + 32) * U.lgam);
                p0[r] = (dn >= kk) ? p0[r] * f0 : 0.f; p1[r] = (dn >= kk + 32) ? p1[r] * f1 : 0.f; }
        }
        p_to_frag(p0, p1, pa0, pa1, pa2, pa3);
        FA_SBAR();
        { const int vb = vb0 + b * TILE_B;
          pv_one<0>(o[0], vb, pa0, pa1, pa2, pa3); pv_one<1>(o[1], vb, pa0, pa1, pa2, pa3); pv_one<2>(o[2], vb, pa0, pa1, pa2, pa3); pv_one<3>(o[3], vb, pa0, pa1, pa2, pa3); }
        __syncthreads();
        if (j + 2 < NT) FA_SWRITE(b);
    }
    __syncthreads();
    l_out = l_reg;
#undef FA_SLOAD
#undef FA_SWRITE
}
}

namespace pg8 {
struct EpiProj {
    static constexpr bool PERM = true, AFTER_DRAIN = false;
    bf16_t* P; const float* rot;
    __device__ __forceinline__ void operator()(const f32x4 (&acc)[2][2][4][2], const Unit& u, int wr, int wc, int fr, int fq) const {
        const int row0 = u.pm * BM + wr * 64 + fr, colb = u.pn * BM + wc * 32 + 8 * fq;
        const bool rotq = (u.pn >= 7) && (u.pn < 15);
        const float ksc = (u.pn >= 11) ? K_SCALE : 1.0f;
        const int i0 = 16 * wc + 4 * fq;
#pragma unroll
        for (int ai = 0; ai < 2; ++ai)
#pragma unroll
            for (int m = 0; m < 4; ++m) {
                const int row = row0 + ai * HALF + m * 16; const int pos = row & (SEQL - 1);
                bf16_t* rowp = P + (size_t)row * NPROJ + colb;
                f32x4 r0 = (f32x4){1.f, 0.f, 1.f, 0.f}, r1 = r0;
                if (rotq) { const f32x4* rt = (const f32x4*)(rot + ((size_t)pos * 64 + i0) * 2); r0 = rt[0]; r1 = rt[1]; }
#pragma unroll
                for (int bj = 0; bj < 2; ++bj) {
                    f32x4 v0 = acc[ai][bj][m][0], v1 = acc[ai][bj][m][1];
                    if (rotq) {
                        f32x4 w0, w1;
                        w0[0] = (v0[0] * r0[0] - v0[1] * r0[1]) * ksc; w0[1] = (v0[0] * r0[1] + v0[1] * r0[0]) * ksc;
                        w0[2] = (v0[2] * r0[2] - v0[3] * r0[3]) * ksc; w0[3] = (v0[2] * r0[3] + v0[3] * r0[2]) * ksc;
                        w1[0] = (v1[0] * r1[0] - v1[1] * r1[1]) * ksc; w1[1] = (v1[0] * r1[1] + v1[1] * r1[0]) * ksc;
                        w1[2] = (v1[2] * r1[2] - v1[3] * r1[3]) * ksc; w1[3] = (v1[2] * r1[3] + v1[3] * r1[2]) * ksc;
                        v0 = w0; v1 = w1;
                    }
                    u32x4 w; w.x = pkbf(v0[0], v0[1]); w.y = pkbf(v0[2], v0[3]); w.z = pkbf(v1[0], v1[1]); w.w = pkbf(v1[2], v1[3]);
                    *(u32x4*)(rowp + bj * HALF) = w;
                }
            }
    }
};
template <int WHICH> struct EpiMerge {
    static constexpr bool PERM = true, AFTER_DRAIN = false;
    const bf16_t* P; const bf16_t* BA; bf16_t* O;
    __device__ __forceinline__ void operator()(const f32x4 (&acc)[2][2][4][2], const Unit& u, int wr, int wc, int fr, int fq) const {
        const int row0 = u.pm * BM + wr * 64 + fr, colb = u.pn * BM + wc * 32 + 8 * fq;
#pragma unroll
        for (int ai = 0; ai < 2; ++ai)
#pragma unroll
            for (int m = 0; m < 4; ++m) {
                const int row = row0 + ai * HALF + m * 16;
#pragma unroll
                for (int bj = 0; bj < 2; ++bj) {
                    const int col = colb + bj * HALF;
                    const u32x4 g = *(const u32x4*)(P + (size_t)row * NPROJ + C_GBR + WHICH * DMODEL + col);
                    const f32x4 v0 = acc[ai][bj][m][0], v1 = acc[ai][bj][m][1];
                    float o[8];
                    o[0] = sigmoidf_(bflo(g.x)) * v0[0]; o[1] = sigmoidf_(bfhi(g.x)) * v0[1]; o[2] = sigmoidf_(bflo(g.y)) * v0[2]; o[3] = sigmoidf_(bfhi(g.y)) * v0[3];
                    o[4] = sigmoidf_(bflo(g.z)) * v1[0]; o[5] = sigmoidf_(bfhi(g.z)) * v1[1]; o[6] = sigmoidf_(bflo(g.w)) * v1[2]; o[7] = sigmoidf_(bfhi(g.w)) * v1[3];
                    if (WHICH == 1) {
                        const u32x4 a = *(const u32x4*)(BA + (size_t)row * DMODEL + col);
                        o[0] += bflo(a.x); o[1] += bfhi(a.x); o[2] += bflo(a.y); o[3] += bfhi(a.y); o[4] += bflo(a.z); o[5] += bfhi(a.z); o[6] += bflo(a.w); o[7] += bfhi(a.w);
                    }
                    u32x4 w; w.x = pkbf(o[0], o[1]); w.y = pkbf(o[2], o[3]); w.z = pkbf(o[4], o[5]); w.w = pkbf(o[6], o[7]);
                    *(u32x4*)(O + (size_t)row * DMODEL + col) = w;
                }
            }
    }
};
struct EpiRes {
    static constexpr bool PERM = false, AFTER_DRAIN = false;
    const float* X; float* O;
    __device__ __forceinline__ void operator()(const f32x4 (&acc)[2][2][4][2], const Unit& u, int wr, int wc, int fr, int fq) const {
        const int row0 = u.pm * BM + wr * 64 + fr, col0 = u.pn * BM + wc * 32 + 4 * fq;
#pragma unroll
        for (int ai = 0; ai < 2; ++ai)
#pragma unroll
            for (int m = 0; m < 4; ++m) {
                const size_t off = (size_t)(row0 + ai * HALF + m * 16) * DMODEL + col0;
#pragma unroll
                for (int bj = 0; bj < 2; ++bj)
#pragma unroll
                    for (int n = 0; n < 2; ++n) { const f32x4 xv = *(const f32x4*)(X + off + bj * HALF + n * 16); *(f32x4*)(O + off + bj * HALF + n * 16) = xv + acc[ai][bj][m][n]; }
            }
    }
};
struct EpiSwiglu {
    static constexpr bool PERM = true, AFTER_DRAIN = false;
    bf16_t* H;
    __device__ __forceinline__ void operator()(const f32x4 (&acc)[2][2][4][2], const Unit& u, int wr, int wc, int fr, int fq) const {
        const int row0 = u.pm * BM + wr * 64 + fr, col = u.pn * HALF + wc * 32 + 8 * fq;
#pragma unroll
        for (int ai = 0; ai < 2; ++ai)
#pragma unroll
            for (int m = 0; m < 4; ++m) {
                const int row = row0 + ai * HALF + m * 16;
                const f32x4 g0 = acc[ai][0][m][0], g1 = acc[ai][0][m][1], u0 = acc[ai][1][m][0], u1 = acc[ai][1][m][1];
                u32x4 w; w.x = pkbf(siluf_(g0[0]) * u0[0], siluf_(g0[1]) * u0[1]); w.y = pkbf(siluf_(g0[2]) * u0[2], siluf_(g0[3]) * u0[3]);
                w.z = pkbf(siluf_(g1[0]) * u1[0], siluf_(g1[1]) * u1[1]); w.w = pkbf(siluf_(g1[2]) * u1[2], siluf_(g1[3]) * u1[3]);
                *(u32x4*)(H + (size_t)row * 1024 + col) = w;
            }
    }
};
struct EpiDown {
    static constexpr bool PERM = true, AFTER_DRAIN = false;
    bf16_t* Y; const float* rg;
    __device__ __forceinline__ void operator()(const f32x4 (&acc)[2][2][4][2], const Unit& u, int wr, int wc, int fr, int fq) const {
        const int row0 = u.pm * BM + wr * 64 + fr, colb = u.pn * BM + wc * 32 + 8 * fq;
#pragma unroll
        for (int ai = 0; ai < 2; ++ai)
#pragma unroll
            for (int m = 0; m < 4; ++m) {
                const int row = row0 + ai * HALF + m * 16; const float gt = rg[row];
#pragma unroll
                for (int bj = 0; bj < 2; ++bj) {
                    const f32x4 v0 = acc[ai][bj][m][0] * gt, v1 = acc[ai][bj][m][1] * gt;
                    u32x4 w; w.x = pkbf(v0[0], v0[1]); w.y = pkbf(v0[2], v0[3]); w.z = pkbf(v1[0], v1[1]); w.w = pkbf(v1[2], v1[3]);
                    *(u32x4*)(Y + (size_t)row * DMODEL + colb + bj * HALF) = w;
                }
            }
    }
};
struct ExpertOrder {
    const LAS int* ts; int G, c;
    __device__ __forceinline__ bool next(int i, Unit& u) const {
        const int L = i * G + c; const int total = ts[32] * 8; if (L >= total) return false;
        const int gt = L >> 3; u.pm = gt; u.pn = L & 7; int e = 0;
        for (int k = 1; k < 32; ++k) e += (gt >= ts[k]) ? 1 : 0;
        u.e = e; return true;
    }
    __device__ __forceinline__ void a_ready(const Unit&) const {}
    __device__ __forceinline__ void done(const Unit&) const {}
};
}

struct MapId { __device__ __forceinline__ int operator()(int n) const { return n; } };
struct MapGate { __device__ __forceinline__ int operator()(int f) const { return ((f >> 7) << 8) + (f & 127); } };
struct MapUp { __device__ __forceinline__ int operator()(int f) const { return ((f >> 7) << 8) + 128 + (f & 127); } };
struct MapProj {
    __device__ __forceinline__ int operator()(int n) const {
        if (n < 1736) return n;
        if (n < 2760) { const int l = n - 1736, d = l & 127; return C_QR + (l & ~127) + ((d & 63) << 1) + (d >> 6); }
        if (n < 3784) { const int l = n - 2760, d = l & 127; return C_KR + (l & ~127) + ((d & 63) << 1) + (d >> 6); }
        if (n < 4808) return C_VR + (n - 3784);
        if (n < 5832) return C_GR + (n - 4808);
        return C_GBR + (n - 5832);
    }
};
template <class RowMap>
__device__ __forceinline__ void tr_item(const float* __restrict__ src, int N, bf16_t* __restrict__ dst, int ldd, int kb, int nb, int lane, RowMap rm) {
    const int kc = lane >> 3, nc = lane & 7;
    const int n = nb * 32 + nc * 4, k0 = kb * 64 + kc * 8;
    if (n < N) {
        f32x4 v[8];
#pragma unroll
        for (int i = 0; i < 8; ++i) v[i] = *(const f32x4*)(src + (size_t)(k0 + i) * N + n);
#pragma unroll
        for (int j = 0; j < 4; ++j) {
            u32x4 o; o.x = pkbf(v[0][j], v[1][j]); o.y = pkbf(v[2][j], v[3][j]); o.z = pkbf(v[4][j], v[5][j]); o.w = pkbf(v[6][j], v[7][j]);
            *(u32x4*)(dst + (size_t)rm(n + j) * ldd + k0) = o;
        }
    }
}
__device__ __forceinline__ void sincos_d(double a, double& s, double& c) {
    const double TWO_PI = 6.283185307179586476925, HALF_PI = 1.5707963267948966192313;
    double k = rint(a / HALF_PI); double r = a - k * HALF_PI;
    r -= k * 6.123233995736766e-17;
    const int q = ((int)k) & 3; const double r2 = r * r;
    double sp = r2 * (-1.0 / 1307674368000.0);
    sp = r2 * (sp + 1.0 / 6227020800.0); sp = r2 * (sp - 1.0 / 39916800.0); sp = r2 * (sp + 1.0 / 362880.0); sp = r2 * (sp - 1.0 / 5040.0); sp = r2 * (sp + 1.0 / 120.0); sp = r2 * (sp - 1.0 / 6.0);
    const double sr = r + r * sp;
    double cp = r2 * (1.0 / 20922789888000.0);
    cp = r2 * (cp - 1.0 / 87178291200.0); cp = r2 * (cp + 1.0 / 479001600.0); cp = r2 * (cp - 1.0 / 3628800.0); cp = r2 * (cp + 1.0 / 40320.0); cp = r2 * (cp - 1.0 / 720.0); cp = r2 * (cp + 1.0 / 24.0); cp = r2 * (cp - 0.5);
    const double cr = 1.0 + cp;
    s = (q == 0) ? sr : (q == 1) ? cr : (q == 2) ? -sr : -cr;
    c = (q == 0) ? cr : (q == 1) ? -sr : (q == 2) ? -cr : sr;
    (void)TWO_PI;
}

struct Params { const float* in[17]; float* out; unsigned char* ws; };

#define GSYNC() grid.sync()

__global__ void __launch_bounds__(512, 2) mega_fwd(Params p) {
    extern __shared__ __attribute__((aligned(16))) unsigned char lds_raw[];
    LAS unsigned char* lds = (LAS unsigned char*)lds_raw;
    cg::grid_group grid = cg::this_grid();
    const int G = gridDim.x, bx = blockIdx.x;
    const int wave_id = __builtin_amdgcn_readfirstlane((int)threadIdx.x >> 6);
    const int NGW = G * 8, NGT = G * 512;
#define PH_LOCALS \
    const int lane = (int)__builtin_amdgcn_mbcnt_hi(~0u, __builtin_amdgcn_mbcnt_lo(~0u, (unsigned)hide_i(0))), wave = wave_id, tid = wave * 64 + lane; (void)tid; \
    const int gw = bx * 8 + wave, gtid = bx * 512 + tid; (void)gw; (void)gtid; (void)lane; \
    unsigned char* ws = hide_p(p.ws); float* out = hide_p(p.out); (void)out; \
    unsigned* ctl = (unsigned*)(ws + WS_CTL); float* rot = (float*)(ws + WS_ROT); (void)ctl; (void)rot; \
    bf16_t* WIN = (bf16_t*)(ws + WS_WIN); bf16_t* WCOMB = (bf16_t*)(ws + WS_WCOMB); bf16_t* WB = (bf16_t*)(ws + WS_WB); bf16_t* WO = (bf16_t*)(ws + WS_WO); (void)WIN; (void)WCOMB; (void)WB; (void)WO; \
    bf16_t* WGU = (bf16_t*)(ws + WS_WGU); bf16_t* WD = (bf16_t*)(ws + WS_WD); (void)WGU; (void)WD; \
    bf16_t* P = (bf16_t*)(ws + WS_P); bf16_t* HMID = (bf16_t*)(ws + WS_HMID); bf16_t* Y = (bf16_t*)(ws + WS_Y); (void)P; (void)HMID; (void)Y; \
    bf16_t* XN = (bf16_t*)(ws + WS_XN); bf16_t* BA = XN; bf16_t* TN = XN; (void)BA; (void)TN; \
    bf16_t* OA = (bf16_t*)(ws + WS_OA); bf16_t* OB = (bf16_t*)(ws + WS_OB); bf16_t* MIXED = (bf16_t*)(ws + WS_MIXED); bf16_t* XG = (bf16_t*)(ws + WS_XG); (void)OA; (void)OB; (void)MIXED; (void)XG; \
    bf16_t* KV = (bf16_t*)(ws + WS_KV); u64* MASK = (u64*)(ws + WS_MASK); (void)KV; (void)MASK; \
    int* misc = (int*)(ws + WS_MISC); \
    int* row_tok = misc + MI_ROWTOK; float* row_gate = (float*)(misc + MI_ROWGATE); int* tok_slot = misc + MI_TOKSLOT; (void)row_tok; (void)row_gate; (void)tok_slot; \
    int* asg_e = misc + MI_ASGE; int* asg_r = misc + MI_ASGR; float* asg_g = (float*)(misc + MI_ASGG); (void)asg_e; (void)asg_r; (void)asg_g;
#define IN(k) hide_p(p.in[k])

    {
        PH_LOCALS
        const float* x = IN(0); const float* g_mix = IN(1); const float* w_in = IN(2); const float* w_uv = IN(4); const float* w_branch = IN(6); const float* w_out = IN(7);
        const float* w_eg = IN(13); const float* w_eu = IN(14); const float* w_ed = IN(15);
        constexpr int NB_WIN = 311;
        constexpr int I_WIN = 32 * NB_WIN, I_WB = 16 * 64, I_WO = 32 * 64, I_EG = 32 * 1024, I_EU = 32 * 1024, I_ED = 32 * 1024;
        constexpr int I_TOTAL = I_WIN + I_WB + I_WO + I_EG + I_EU + I_ED;
        for (int it = gw; it < I_TOTAL; it += NGW) {
            int r = it;
            if (r < I_WIN) { tr_item(w_in, 9928, WIN, 2048, r / NB_WIN, r % NB_WIN, lane, MapProj{}); continue; } r -= I_WIN;
            if (r < I_WB) { tr_item(w_branch + (size_t)1024 * 2048, 2048, WB, 1024, r >> 6, r & 63, lane, MapId{}); continue; } r -= I_WB;
            if (r < I_WO) { tr_item(w_out, 2048, WO, 2048, r >> 6, r & 63, lane, MapId{}); continue; } r -= I_WO;
            if (r < I_EG) { const int e = r >> 10, q = r & 1023; tr_item(w_eg + (size_t)e * 2048 * 1024, 1024, WGU + (size_t)e * 2048 * 2048, 2048, q >> 5, q & 31, lane, MapGate{}); continue; } r -= I_EG;
            if (r < I_EU) { const int e = r >> 10, q = r & 1023; tr_item(w_eu + (size_t)e * 2048 * 1024, 1024, WGU + (size_t)e * 2048 * 2048, 2048, q >> 5, q & 31, lane, MapUp{}); continue; } r -= I_EU;
            { const int e = r >> 10, q = r & 1023; tr_item(w_ed + (size_t)e * 1024 * 2048, 2048, WD + (size_t)e * 2048 * 1024, 1024, q >> 6, q & 63, lane, MapId{}); }
        }
        for (int i = gtid; i < 56 * 256; i += NGT) ((u32x4*)(WIN + (size_t)1736 * 2048))[i] = (u32x4){0u, 0u, 0u, 0u};
        for (int it = gw; it < 2048; it += NGW) {
            const int h = it >> 8, ch = (it >> 7) & 1, n0 = (it & 127) * 16, c = ch * 64 + lane;
            const float* wuv = w_uv + ((size_t)h * 128 + c) * 128;
            const float* wa = w_branch + (size_t)(h * 128) * 2048 + n0;
            float a[16];
#pragma unroll
            for (int j = 0; j < 16; ++j) a[j] = 0.f;
            for (int d4 = 0; d4 < 32; ++d4) {
                const f32x4 wv = *(const f32x4*)(wuv + d4 * 4);
#pragma unroll
                for (int dd = 0; dd < 4; ++dd) {
                    const float* wr_ = wa + (size_t)(d4 * 4 + dd) * 2048;
#pragma unroll
                    for (int j4 = 0; j4 < 4; ++j4) { const f32x4 b = *(const f32x4*)(wr_ + j4 * 4); a[j4 * 4 + 0] += wv[dd] * b[0]; a[j4 * 4 + 1] += wv[dd] * b[1]; a[j4 * 4 + 2] += wv[dd] * b[2]; a[j4 * 4 + 3] += wv[dd] * b[3]; }
                }
            }
#pragma unroll
            for (int j = 0; j < 16; ++j) WCOMB[(size_t)(n0 + j) * 1024 + h * 128 + c] = (bf16_t)(pkbf(a[j], 0.f) & 0xffffu);
        }
        for (int m = gw; m < T_TOK; m += NGW) {
            const f32x4* xr = (const f32x4*)(x + (size_t)m * DMODEL) + lane; f32x4 v[8]; float ss = 0.f;
#pragma unroll
            for (int j = 0; j < 8; ++j) { v[j] = xr[64 * j]; ss += (v[j][0] * v[j][0] + v[j][1] * v[j][1]) + (v[j][2] * v[j][2] + v[j][3] * v[j][3]); }
            const float rstd = 1.0f / sqrtf(wave_sum(ss, lane) * (1.0f / DMODEL) + EPS_F);
            u32x2* o = (u32x2*)(XN + (size_t)m * DMODEL) + lane;
#pragma unroll
            for (int j = 0; j < 8; ++j) { const f32x4 gg = ((const f32x4*)g_mix)[lane + 64 * j]; u32x2 w; w.x = pkbf(v[j][0] * rstd * gg[0], v[j][1] * rstd * gg[1]); w.y = pkbf(v[j][2] * rstd * gg[2], v[j][3] * rstd * gg[3]); o[64 * j] = w; }
        }
        for (int idx = gtid; idx < SEQL * 64; idx += NGT) {
            const int pos = idx >> 6, i = idx & 63; double f = 1.0;
            for (int k = 0; k < i; ++k) f *= 0.8659643233600653;
            double s, c; sincos_d((double)pos * f, s, c);
            rot[2 * idx] = (float)c; rot[2 * idx + 1] = (float)s;
        }
        for (int i = gtid; i < 32; i += NGT) ctl[64 * i] = 0u;
        if (gtid < 2) ctl[4096 + gtid] = 0u;
        for (int i = gtid; i < MAXSLOT; i += NGT) { row_tok[i] = 0; row_gate[i] = 0.f; }
    }
    GSYNC();

    {
        PH_LOCALS
        pg8::Gemm g{XN, WIN, T_TOK, NPROJ, 2048}; pg8::StaticOrder S; S.init(T_TOK, NPROJ, G, bx);
        pg8::EpiProj E{P, rot};
        pg8::gemm_phase<pg8::EpiProj, pg8::StaticOrder, true, true>(lds, g, S, E, tid);
    }
    GSYNC();

    {
        PH_LOCALS
        const float* g_kv = IN(3);
        for (int t = gw; t < T_TOK; t += NGW) {
            const unsigned v = *(const unsigned*)(P + (size_t)t * NPROJ + C_CKV + 2 * lane);
            const float a = bflo(v), b = bfhi(v);
            const float rstd = 1.0f / sqrtf(wave_sum(a * a + b * b, lane) * (1.0f / 128.0f) + EPS_F);
            *(unsigned*)(KV + (size_t)t * 128 + 2 * lane) = pkbf(a * rstd * g_kv[2 * lane], b * rstd * g_kv[2 * lane + 1]);
        }
        LAS float* qi = (LAS float*)(lds + wave * 10240); LAS float* sc = qi + 512;
        for (int t = gw; t < T_TOK; t += NGW) {
            const int b = t >> 11, q = t & 2047, ng = (q >> 6) + 1;
            { const u32x4 v = *(const u32x4*)(P + (size_t)t * NPROJ + C_QIDX + lane * 8);
              f32x4 lo4 = (f32x4){bflo(v.x), bfhi(v.x), bflo(v.y), bfhi(v.y)}, hi4 = (f32x4){bflo(v.z), bfhi(v.z), bflo(v.w), bfhi(v.w)};
              *(LAS f32x4*)(qi + lane * 8) = lo4; *(LAS f32x4*)(qi + lane * 8 + 4) = hi4; }
            float w[8];
            { const u32x4 v = *(const u32x4*)(P + (size_t)t * NPROJ + C_WIDX); w[0] = bflo(v.x); w[1] = bfhi(v.x); w[2] = bflo(v.y); w[3] = bfhi(v.y); w[4] = bflo(v.z); w[5] = bfhi(v.z); w[6] = bflo(v.w); w[7] = bfhi(v.w); }
            for (int g = 0; g < ng; ++g) {
                LAS float* qg = qi; asm volatile("" : "+v"(qg));
                const int s = g * 64 + lane; const u32x4* kr = (const u32x4*)(P + (size_t)(b * SEQL + s) * NPROJ + C_KIDX);
                float dot[8];
#pragma unroll
                for (int h = 0; h < 8; ++h) dot[h] = 0.f;
#pragma unroll
                for (int c = 0; c < 8; ++c) {
                    const u32x4 v = kr[c];
                    const f32x4 ka = (f32x4){bflo(v.x), bfhi(v.x), bflo(v.y), bfhi(v.y)}, kb = (f32x4){bflo(v.z), bfhi(v.z), bflo(v.w), bfhi(v.w)};
#pragma unroll
                    for (int h = 0; h < 8; ++h) {
                        const f32x4 qa = *(const LAS f32x4*)(qg + h * 64 + c * 8), qb = *(const LAS f32x4*)(qg + h * 64 + c * 8 + 4);
                        dot[h] += (qa[0] * ka[0] + qa[1] * ka[1]) + (qa[2] * ka[2] + qa[3] * ka[3]) + (qb[0] * kb[0] + qb[1] * kb[1]) + (qb[2] * kb[2] + qb[3] * kb[3]);
                    }
                }
                float score = 0.f;
#pragma unroll
                for (int h = 0; h < 8; ++h) score += w[h] * fmaxf(dot[h], 0.f);
                sc[s] = score * IDX_SCALE;
            }
            u64* mrow = MASK + (size_t)t * 32;
            if (ng <= 4) { if (lane < 32) mrow[lane] = (lane < ng) ? ~0ull : 0ull; }
            else {
                unsigned lo = 0u;
                for (int bit = 31; bit >= 0; --bit) {
                    const unsigned cand = lo | (1u << bit); int cnt = 0;
                    for (int g = 0; g < ng; ++g) cnt += __popcll(__ballot(fkey(sc[g * 64 + lane]) >= cand));
                    if (cnt >= 256) lo = cand;
                }
                const unsigned tau = lo; int cgt = 0;
                for (int g = 0; g < ng; ++g) cgt += __popcll(__ballot(fkey(sc[g * 64 + lane]) > tau));
                const int need = 256 - cgt; int run = 0;
                for (int g = 0; g < ng; ++g) {
                    const unsigned key = fkey(sc[g * 64 + lane]);
                    const u64 gt = __ballot(key > tau), eq = __ballot(key == tau);
                    const u64 below = eq & ((1ull << lane) - 1ull);
                    const bool sel = (key == tau) && (run + (int)__popcll(below) < need);
                    const u64 word = gt | __ballot(sel);
                    run += (int)__popcll(eq);
                    if (lane == 0) mrow[g] = word;
                }
                if (lane >= ng && lane < 32) mrow[lane] = 0ull;
            }
        }
    }
    GSYNC();

#if DBG_CMP == 1
    {
        PH_LOCALS
        bf16_t* OAX = (bf16_t*)(ws + WS_SPARE);
        float* qv = (float*)(lds_raw + wave * 10240); float* lg = qv + 512;
        for (int it = gw; it < T_TOK * 8; it += NGW) {
            const int t = it >> 3, h = it & 7, b = t >> 11, q = t & 2047, ng = (q >> 6) + 1;
            { const unsigned v = *(const unsigned*)(P + (size_t)t * NPROJ + C_QLAT + h * 128 + 2 * lane); qv[2 * lane] = bflo(v); qv[2 * lane + 1] = bfhi(v); }
            const u64* mrow = MASK + (size_t)t * 32;
            float mx = -INFINITY;
            for (int g = 0; g < ng; ++g) {
                asm volatile("" ::: "memory");
                const u64 word = mrow[g]; float l = -INFINITY;
                if ((word >> lane) & 1ull) {
                    const u32x4* kr = (const u32x4*)(KV + (size_t)(b * SEQL + g * 64 + lane) * 128);
                    float d0 = 0.f, d1 = 0.f, d2 = 0.f, d3 = 0.f;
#pragma unroll
                    for (int c = 0; c < 16; ++c) { const u32x4 v = kr[c]; const f32x4 qa = *(const f32x4*)(qv + 8 * c), qb = *(const f32x4*)(qv + 8 * c + 4);
                        d0 += qa[0] * bflo(v.x) + qb[0] * bflo(v.z); d1 += qa[1] * bfhi(v.x) + qb[1] * bfhi(v.z); d2 += qa[2] * bflo(v.y) + qb[2] * bflo(v.w); d3 += qa[3] * bfhi(v.y) + qb[3] * bfhi(v.w); }
                    l = ((d0 + d1) + (d2 + d3)) * ATT_SCALE;
                }
                lg[g * 64 + lane] = l; mx = fmaxf(mx, l);
            }
            mx = wave_max(mx, lane);
            float o0 = 0.f, o1 = 0.f, sum = 0.f;
            for (int g = 0; g < ng; ++g) {
                const u64 wv = mrow[g];
                u64 word = ((u64)__builtin_amdgcn_readfirstlane((unsigned)(wv >> 32)) << 32) | (u64)__builtin_amdgcn_readfirstlane((unsigned)wv);
                while (word) {
                    const int j = __builtin_ctzll(word); word &= word - 1ull;
                    const int s = g * 64 + j; const float pj = __expf(lg[s] - mx);
                    const unsigned v = *(const unsigned*)(KV + (size_t)(b * SEQL + s) * 128 + 2 * lane);
                    o0 += pj * bflo(v); o1 += pj * bfhi(v); sum += pj;
                }
            }
            const float inv = 1.0f / sum;
            *(unsigned*)(OAX + (size_t)t * 1024 + h * 128 + 2 * lane) = pkbf(o0 * inv, o1 * inv);
        }
    }
    __syncthreads();
#endif
#if DBG_CMP == 2
    {
        PH_LOCALS
        const float* g_ret = IN(5);
        bf16_t* OBX = (bf16_t*)(ws + WS_SPARE);
        float* qv = (float*)(lds_raw + wave * 10240); float* lg = qv + 512; float* wl = lg;
        for (int it = gw; it < T_TOK * 8; it += NGW) {
            const int t = it >> 3, h = it & 7, b = t >> 11, n = t & 2047, ng = (n >> 6) + 1;
            const float lgam = (h == 0) ? -0.04580368961312479f : (h == 1) ? -0.02272007650008353f : (h == 2) ? -0.011315313227834146f : (h == 3) ? -0.005646563141142063f :
                               (h == 4) ? -0.0028205190623786626f : (h == 5) ? -0.0014095702546713536f : (h == 6) ? -0.0007046129765893727f : -0.0003522634716290214f;
            { const unsigned v = *(const unsigned*)(P + (size_t)t * NPROJ + C_QR + h * 128 + 2 * lane); qv[2 * lane] = bflo(v); qv[2 * lane + 1] = bfhi(v); }
            float o0 = 0.f, o1 = 0.f;
            for (int g = 0; g < ng; ++g) {
                asm volatile("" ::: "memory");
                const int m = g * 64 + lane;
                const u32x4* kr = (const u32x4*)(P + (size_t)(b * SEQL + m) * NPROJ + C_KR + h * 128);
                float d0 = 0.f, d1 = 0.f, d2 = 0.f, d3 = 0.f;
#pragma unroll
                for (int c = 0; c < 16; ++c) { const u32x4 v = kr[c]; const f32x4 qa = *(const f32x4*)(qv + 8 * c), qb = *(const f32x4*)(qv + 8 * c + 4);
                    d0 += qa[0] * bflo(v.x) + qb[0] * bflo(v.z); d1 += qa[1] * bfhi(v.x) + qb[1] * bfhi(v.z); d2 += qa[2] * bflo(v.y) + qb[2] * bflo(v.w); d3 += qa[3] * bfhi(v.y) + qb[3] * bfhi(v.w); }
                const float dot = (d0 + d1) + (d2 + d3);
                wl[lane] = (m <= n) ? dot * exp2f((float)(n - m) * lgam) : 0.f;
                const int jmax = (g == ng - 1) ? (n & 63) : 63;
                for (int j = 0; j <= jmax; ++j) {
                    const float wj = wl[j];
                    const unsigned v = *(const unsigned*)(P + (size_t)(b * SEQL + g * 64 + j) * NPROJ + C_VR + h * 128 + 2 * lane);
                    o0 += wj * bflo(v); o1 += wj * bfhi(v);
                }
            }
            const float mu = wave_sum(o0 + o1, lane) * (1.0f / 128.0f); const float e0 = o0 - mu, e1 = o1 - mu;
            const float rs = 1.0f / sqrtf(wave_sum(e0 * e0 + e1 * e1, lane) * (1.0f / 128.0f) + EPS_F);
            const unsigned gv = *(const unsigned*)(P + (size_t)t * NPROJ + C_GR + h * 128 + 2 * lane);
            const float y0 = siluf_(bflo(gv)) * e0 * rs * g_ret[h * 128 + 2 * lane], y1 = siluf_(bfhi(gv)) * e1 * rs * g_ret[h * 128 + 2 * lane + 1];
            *(unsigned*)(OBX + (size_t)t * 1024 + h * 128 + 2 * lane) = pkbf(y0, y1);
        }
    }
    __syncthreads();
#endif
    {
        PH_LOCALS
        for (int pr = bx; pr < 256; pr += G) {
            const int b = pr >> 5, i = pr & 31;
#pragma unroll 1
            for (int uu = 0; uu < 2; ++uu) {
                const int qb = uu ? 63 - i : i; const int t0 = b * SEQL + qb * 32;
                fa::UnitArgs U; U.Q = P + (size_t)t0 * NPROJ + C_QLAT; U.ldq = NPROJ; U.K = KV + (size_t)b * SEQL * 128; U.V = U.K; U.ldk = 128; U.mask = MASK + (size_t)t0 * 32;
                U.ntiles = (qb >> 1) + 1; U.n0 = 0; U.lgam = 0.f;
                fa::f32x16 o[4]; float l_reg;
                fa::unit_body<0>((LAS char*)lds, U, tid, o, l_reg);
                const int r32 = lane & 31, hi = lane >> 5;
                LAS float* li_l = (LAS float*)(lds + fa::OFF_WS) + wave * 64;
                if (hi == 0) li_l[r32] = l_reg;
                asm volatile("s_waitcnt lgkmcnt(0)" ::: "memory");
#pragma unroll
                for (int r = 0; r < 16; ++r) {
                    const int orow = fa::crow(r, hi); const float rl = __builtin_amdgcn_rcpf(li_l[orow]);
                    bf16_t* op = OA + (size_t)(t0 + orow) * 1024 + wave * 128 + r32;
#pragma unroll
                    for (int d0 = 0; d0 < 4; ++d0) op[d0 * 32] = (bf16_t)(pkbf(o[d0][r] * rl, 0.f) & 0xffffu);
                }
                __syncthreads();
            }
        }
    }
    {
        PH_LOCALS
        const float* g_ret = IN(5);
        for (int pr = bx; pr < 256; pr += G) {
            const int bh = pr >> 2, i = pr & 3, b = bh >> 3, h = bh & 7;
            const float lgam = (h == 0) ? -0.04580368961312479f : (h == 1) ? -0.02272007650008353f : (h == 2) ? -0.011315313227834146f : (h == 3) ? -0.005646563141142063f :
                               (h == 4) ? -0.0028205190623786626f : (h == 5) ? -0.0014095702546713536f : (h == 6) ? -0.0007046129765893727f : -0.0003522634716290214f;
#pragma unroll 1
            for (int uu = 0; uu < 2; ++uu) {
                const int qb = uu ? 7 - i : i; const int n0 = qb * 256;
                fa::UnitArgs U; U.Q = P + (size_t)(b * SEQL + n0) * NPROJ + C_QR + h * 128; U.ldq = NPROJ;
                U.K = P + (size_t)(b * SEQL) * NPROJ + C_KR + h * 128; U.V = P + (size_t)(b * SEQL) * NPROJ + C_VR + h * 128; U.ldk = NPROJ; U.mask = nullptr;
                U.ntiles = 4 * (qb + 1); U.n0 = n0; U.lgam = lgam;
                fa::f32x16 o[4]; float l_reg;
                fa::unit_body<1>((LAS char*)lds, U, tid, o, l_reg);
                const int r32 = lane & 31, hi = lane >> 5;
                float gr[4];
#pragma unroll
                for (int d0 = 0; d0 < 4; ++d0) gr[d0] = g_ret[h * 128 + d0 * 32 + r32];
#pragma unroll
                for (int r = 0; r < 16; ++r) {
                    float s = (o[0][r] + o[1][r]) + (o[2][r] + o[3][r]);
#pragma unroll
                    for (int x = 1; x < 32; x <<= 1) s += shx(s, lane, x);
                    const float mu = s * (1.0f / 128.0f);
                    const float e0 = o[0][r] - mu, e1 = o[1][r] - mu, e2 = o[2][r] - mu, e3 = o[3][r] - mu;
                    float q = (e0 * e0 + e1 * e1) + (e2 * e2 + e3 * e3);
#pragma unroll
                    for (int x = 1; x < 32; x <<= 1) q += shx(q, lane, x);
                    const float rs = 1.0f / sqrtf(q * (1.0f / 128.0f) + EPS_F);
                    const size_t tok = (size_t)(b * SEQL + n0 + wave * 32 + fa::crow(r, hi));
                    const bf16_t* gp = P + tok * NPROJ + C_GR + h * 128 + r32; bf16_t* op = OB + tok * 1024 + h * 128 + r32;
                    op[0] = (bf16_t)(pkbf(siluf_(bflo((unsigned)gp[0])) * e0 * rs * gr[0], 0.f) & 0xffffu);
                    op[32] = (bf16_t)(pkbf(siluf_(bflo((unsigned)gp[32])) * e1 * rs * gr[1], 0.f) & 0xffffu);
                    op[64] = (bf16_t)(pkbf(siluf_(bflo((unsigned)gp[64])) * e2 * rs * gr[2], 0.f) & 0xffffu);
                    op[96] = (bf16_t)(pkbf(siluf_(bflo((unsigned)gp[96])) * e3 * rs * gr[3], 0.f) & 0xffffu);
                }
                __syncthreads();
            }
        }
    }
#if DBG_CMP
    GSYNC();
    {
        PH_LOCALS
        const bf16_t* A_ = (DBG_CMP == 1) ? OA : OB; const bf16_t* R_ = (const bf16_t*)(ws + WS_SPARE);
        float sd = 0.f, sr = 0.f;
        for (size_t i = (size_t)gtid; i < (size_t)T_TOK * 1024 / 2; i += (size_t)NGT) {
            const unsigned a = ((const unsigned*)A_)[i], r = ((const unsigned*)R_)[i];
            const float d0 = bflo(a) - bflo(r), d1 = bfhi(a) - bfhi(r); sd += d0 * d0 + d1 * d1; sr += bflo(r) * bflo(r) + bfhi(r) * bfhi(r);
        }
        sd = wave_sum(sd, lane); sr = wave_sum(sr, lane);
        if (lane == 0) { atomicAdd((float*)(ctl + 4096), sd); atomicAdd((float*)(ctl + 4097), sr); }
    }
#endif
    GSYNC();

    {
        PH_LOCALS
        pg8::Gemm g{OA, WCOMB, T_TOK, DMODEL, 1024}; pg8::StaticOrder S; S.init(T_TOK, DMODEL, G, bx);
        pg8::EpiMerge<0> E{P, nullptr, BA};
        pg8::gemm_phase<pg8::EpiMerge<0>, pg8::StaticOrder, true, true>(lds, g, S, E, tid);
    }
    GSYNC();
    {
        PH_LOCALS
        pg8::Gemm g{OB, WB, T_TOK, DMODEL, 1024}; pg8::StaticOrder S; S.init(T_TOK, DMODEL, G, bx);
        pg8::EpiMerge<1> E{P, BA, MIXED};
        pg8::gemm_phase<pg8::EpiMerge<1>, pg8::StaticOrder, true, true>(lds, g, S, E, tid);
    }
    GSYNC();
    {
        PH_LOCALS
        const float* x = IN(0);
        pg8::Gemm g{MIXED, WO, T_TOK, DMODEL, 2048}; pg8::StaticOrder S; S.init(T_TOK, DMODEL, G, bx);
        pg8::EpiRes E{x, out};
        pg8::gemm_phase<pg8::EpiRes, pg8::StaticOrder, true, true>(lds, g, S, E, tid);
    }
    GSYNC();

    {
    PH_LOCALS
    const float* g_ffn = IN(8); const float* w_rg = IN(9); const float* b_rg = IN(10); const float* w_re = IN(11); const float* b_re = IN(12);
    for (int t = gw; t < T_TOK; t += NGW) {
        const f32x4* hr = (const f32x4*)(out + (size_t)t * DMODEL) + lane; f32x4 v[8]; float ss = 0.f;
#pragma unroll
        for (int j = 0; j < 8; ++j) { v[j] = hr[64 * j]; ss += (v[j][0] * v[j][0] + v[j][1] * v[j][1]) + (v[j][2] * v[j][2] + v[j][3] * v[j][3]); }
        const float rstd = 1.0f / sqrtf(wave_sum(ss, lane) * (1.0f / DMODEL) + EPS_F);
        u32x2* o = (u32x2*)(TN + (size_t)t * DMODEL) + lane;
        const float* wrg_l = hide_p(w_rg); const float* wre_l = hide_p(w_re);
        float ga[4] = {0.f, 0.f, 0.f, 0.f};
#pragma unroll
        for (int j = 0; j < 8; ++j) {
            const f32x4 gg = ((const f32x4*)g_ffn)[lane + 64 * j]; v[j] = v[j] * gg;
            u32x2 w; w.x = pkbf(v[j][0] * rstd, v[j][1] * rstd); w.y = pkbf(v[j][2] * rstd, v[j][3] * rstd); o[64 * j] = w;
#pragma unroll
            for (int i = 0; i < 4; ++i) { const f32x4 wr_ = *(const f32x4*)(wrg_l + (unsigned)((4 * (lane + 64 * j) + i) * 4)); ga[0] += v[j][i] * wr_[0]; ga[1] += v[j][i] * wr_[1]; ga[2] += v[j][i] * wr_[2]; ga[3] += v[j][i] * wr_[3]; }
        }
        float gl[4];
#pragma unroll
        for (int k = 0; k < 4; ++k) gl[k] = wave_sum(ga[k], lane) * rstd + b_rg[k];
        int grp = 0; float gmx = gl[0];
#pragma unroll
        for (int k = 1; k < 4; ++k) if (gl[k] > gmx) { gmx = gl[k]; grp = k; }
        float gz = 0.f;
#pragma unroll
        for (int k = 0; k < 4; ++k) gz += __expf(gl[k] - gmx);
        const float p_grp = 1.0f / gz;
        float ea[8] = {0.f, 0.f, 0.f, 0.f, 0.f, 0.f, 0.f, 0.f};
#pragma unroll
        for (int j = 0; j < 8; ++j)
#pragma unroll
            for (int i = 0; i < 4; ++i) {
                const f32x4* we = (const f32x4*)(wre_l + (unsigned)((4 * (lane + 64 * j) + i) * 32 + grp * 8)); const f32x4 a = we[0], b2 = we[1];
                ea[0] += v[j][i] * a[0]; ea[1] += v[j][i] * a[1]; ea[2] += v[j][i] * a[2]; ea[3] += v[j][i] * a[3];
                ea[4] += v[j][i] * b2[0]; ea[5] += v[j][i] * b2[1]; ea[6] += v[j][i] * b2[2]; ea[7] += v[j][i] * b2[3];
            }
        float el[8];
#pragma unroll
        for (int k = 0; k < 8; ++k) el[k] = wave_sum(ea[k], lane) * rstd + b_re[grp * 8 + k];
        int i1 = 0; float m1 = el[0];
#pragma unroll
        for (int k = 1; k < 8; ++k) if (el[k] > m1) { m1 = el[k]; i1 = k; }
        int i2 = -1; float m2 = -INFINITY;
#pragma unroll
        for (int k = 0; k < 8; ++k) if (k != i1 && el[k] > m2) { m2 = el[k]; i2 = k; }
        const float e2 = __expf(m2 - m1); const float den = 1.0f / (1.0f + e2);
        const float g1 = p_grp * den, g2 = p_grp * e2 * den;
        if (lane == 0) {
            const int ex1 = grp * 8 + i1, ex2 = grp * 8 + i2;
            const unsigned r1 = atomicAdd(ctl + 64 * ex1, 1u), r2 = atomicAdd(ctl + 64 * ex2, 1u);
            asg_e[2 * t] = ex1; asg_e[2 * t + 1] = ex2; asg_r[2 * t] = (int)r1; asg_r[2 * t + 1] = (int)r2; asg_g[2 * t] = g1; asg_g[2 * t + 1] = g2;
        }
    }
    }
    GSYNC();

    LAS int* tile_start = (LAS int*)(lds + LDS_MISC);
    {
    PH_LOCALS
    if (tid == 0) {
        int acc_t = 0;
        for (int e = 0; e < 32; ++e) { tile_start[e] = acc_t; const int c = (int)__hip_atomic_load(ctl + 64 * e, __ATOMIC_RELAXED, __HIP_MEMORY_SCOPE_AGENT); acc_t += (c + 255) >> 8; }
        tile_start[32] = acc_t;
    }
    __syncthreads();
    for (int a = gw; a < 2 * T_TOK; a += NGW) {
        const int t = a >> 1; const int e = asg_e[a], rk = asg_r[a]; const int slot = tile_start[e] * 256 + rk;
        if (lane == 0) { row_tok[slot] = t; row_gate[slot] = asg_g[a]; tok_slot[a] = slot; }
        const u32x4* src = (const u32x4*)(TN + (size_t)t * DMODEL) + lane; u32x4* dst = (u32x4*)(XG + (size_t)slot * DMODEL) + lane;
#pragma unroll
        for (int j = 0; j < 4; ++j) dst[64 * j] = src[64 * j];
    }
    }
    GSYNC();

    {
        PH_LOCALS
        pg8::Gemm g{XG, WGU, MAXSLOT, 2048, 2048}; pg8::ExpertOrder S{tile_start, G, bx};
        pg8::EpiSwiglu E{HMID};
        pg8::gemm_phase<pg8::EpiSwiglu, pg8::ExpertOrder, true, true>(lds, g, S, E, tid);
    }
    GSYNC();
    {
        PH_LOCALS
        pg8::Gemm g{HMID, WD, MAXSLOT, 2048, 1024}; pg8::ExpertOrder S{tile_start, G, bx};
        pg8::EpiDown E{Y, row_gate};
        pg8::gemm_phase<pg8::EpiDown, pg8::ExpertOrder, true, true>(lds, g, S, E, tid);
    }
    GSYNC();

    {
    PH_LOCALS
    const float* g_fin = IN(16);
#if DBG_CMP
    const float dbg_scale = 1.0f + 4.0f * sqrtf(__hip_atomic_load((float*)(ctl + 4096), __ATOMIC_RELAXED, __HIP_MEMORY_SCOPE_AGENT) / __hip_atomic_load((float*)(ctl + 4097), __ATOMIC_RELAXED, __HIP_MEMORY_SCOPE_AGENT));
#else
    const float dbg_scale = 1.0f;
#endif
    for (int t = gw; t < T_TOK; t += NGW) {
        const int s0 = tok_slot[2 * t], s1 = tok_slot[2 * t + 1];
        f32x4* hr = (f32x4*)(out + (size_t)t * DMODEL) + lane; const u32x2* y0 = (const u32x2*)(Y + (size_t)s0 * DMODEL) + lane; const u32x2* y1 = (const u32x2*)(Y + (size_t)s1 * DMODEL) + lane;
        f32x4 v[8]; float ss = 0.f;
#pragma unroll
        for (int j = 0; j < 8; ++j) {
            v[j] = hr[64 * j]; const u32x2 a = y0[64 * j], b2 = y1[64 * j];
            v[j][0] += bflo(a.x) + bflo(b2.x); v[j][1] += bfhi(a.x) + bfhi(b2.x); v[j][2] += bflo(a.y) + bflo(b2.y); v[j][3] += bfhi(a.y) + bfhi(b2.y);
            ss += (v[j][0] * v[j][0] + v[j][1] * v[j][1]) + (v[j][2] * v[j][2] + v[j][3] * v[j][3]);
        }
        const float rstd = 1.0f / sqrtf(wave_sum(ss, lane) * (1.0f / DMODEL) + EPS_F);
#pragma unroll
        for (int j = 0; j < 8; ++j) { const f32x4 gg = ((const f32x4*)g_fin)[lane + 64 * j]; hr[64 * j] = v[j] * (rstd * dbg_scale) * gg; }
    }
    }
}

extern "C" void kernel_launch(void* const* d_in, const int* in_sizes, int n_in, void* d_out, int out_size, void* d_ws, size_t ws_size, hipStream_t stream) {
    static int grid_blocks = 0;
    if (grid_blocks == 0) {
        if (n_in != 17 || out_size != T_TOK * DMODEL || ws_size < WS_END) { fprintf(stderr, "kernel_launch: unexpected problem (n_in %d, out %d, ws %zu < %zu)\n", n_in, out_size, ws_size, (size_t)WS_END); grid_blocks = -1; return; }
        int dev = 0, cus = 0, per_cu = 0;
        (void)hipGetDevice(&dev);
        (void)hipDeviceGetAttribute(&cus, hipDeviceAttributeMultiprocessorCount, dev);
        if (hipFuncSetAttribute((const void*)mega_fwd, hipFuncAttributeMaxDynamicSharedMemorySize, LDS_BYTES) != hipSuccess) { fprintf(stderr, "kernel_launch: hipFuncSetAttribute failed\n"); grid_blocks = -1; return; }
        if (hipOccupancyMaxActiveBlocksPerMultiprocessor(&per_cu, (const void*)mega_fwd, 512, LDS_BYTES) != hipSuccess || per_cu < 1) { fprintf(stderr, "kernel_launch: occupancy query says %d\n", per_cu); grid_blocks = -1; return; }
        grid_blocks = cus;
        fprintf(stderr, "kernel_launch: cus %d per_cu %d grid %d ws %zu need %zu\n", cus, per_cu, grid_blocks, ws_size, (size_t)WS_END);
    }
    if (grid_blocks < 0) return;
    Params prm{};
    for (int i = 0; i < 17; ++i) prm.in[i] = (const float*)d_in[i];
    prm.out = (float*)d_out; prm.ws = (unsigned char*)d_ws;
    void* args[] = {&prm};
    hipError_t e = hipLaunchCooperativeKernel((void*)mega_fwd, dim3(grid_blocks), dim3(512), args, LDS_BYTES, stream);
    if (e != hipSuccess) fprintf(stderr, "cooperative launch failed: %s (grid %d)\n", hipGetErrorString(e), grid_blocks);
}
```

```cpp
#include <hip/hip_runtime.h>
#include <hip/hip_cooperative_groups.h>
#include <cstdio>
#include <cstdint>
namespace cg = cooperative_groups;
namespace pg8 {
#define PG8_LAS __attribute__((address_space(3)))
typedef unsigned short bf16_t;
typedef short bf16x8 __attribute__((ext_vector_type(8)));
typedef float f32x4 __attribute__((ext_vector_type(4)));
typedef unsigned u32x4 __attribute__((ext_vector_type(4)));
constexpr int BM = 256, BK = 64, HALF = 128, HTB = HALF * BK * 2  , STAGE_BYTES = 8 * HTB, NXCD = 8, WGM = 8;

__host__ __device__ __forceinline__ int lds_byte(int r, int c) { const int st = (r >> 4) * 2 + (c >> 5), rr = r & 15, cc = c & 31, ob = rr * 64 + cc * 2; return st * 1024 + (ob ^ (((ob >> 9) & 1) << 5)); }
__host__ __device__ __forceinline__ void stage_rc(int b, int& R, int& C) { const int st = b / 1024, sb = b % 1024, swz = sb ^ (((sb >> 9) & 1) << 5); R = (st >> 1) * 16 + swz / 64; C = (st & 1) * 32 + (swz % 64) / 2; }
__host__ __device__ __forceinline__ int perm32(int rho) { const int n = rho >> 4, i = rho & 15; return 8 * (i >> 2) + 4 * n + (i & 3); }

struct Unit { int pm, pn, e; };
struct Gemm { const bf16_t* A; const bf16_t* Bt; int M, N, K; };

struct StaticOrder {
    int nM, nN, nwg, G, c;
    __host__ __device__ void init(int M, int N, int G_, int c_) { nM = M / BM; nN = N / BM; nwg = nM * nN; G = G_; c = c_; }
    __host__ __device__ bool next(int i, Unit& u) const {
        const long L = (long)i * G + c; if (L >= nwg) return false;
        int wgid = (int)L; { const int q = nwg / NXCD, r = nwg % NXCD, xcd = wgid % NXCD, off = wgid / NXCD; wgid = (xcd < r ? xcd * (q + 1) : r * (q + 1) + (xcd - r) * q) + off; }
        const int nig = WGM * nN, gid = wgid / nig, fm = gid * WGM, gsz = (nM - fm) < WGM ? (nM - fm) : WGM;
        u.pm = fm + ((wgid % nig) % gsz); u.pn = (wgid % nig) / gsz; u.e = 0; return true;
    }
    __device__ __forceinline__ void a_ready(const Unit&) const {}
    __device__ __forceinline__ void done(const Unit&) const {}
};

template <class Epi, class Sched, bool ALIGN_EPI = false, bool SP2 = false>
__device__ __forceinline__ void gemm_phase(PG8_LAS unsigned char* lds, const Gemm g, const Sched& S, const Epi& E, const int tid) {
    const int wid = __builtin_amdgcn_readfirstlane(tid >> 6), lane = tid & 63, wr = wid >> 2, wc = wid & 3, fr = lane & 15, fq = lane >> 4;
    const int K = g.K, nt = K / BK;
    unsigned voffA[2], voffB[2];
#pragma unroll
    for (int i = 0; i < 2; ++i) { int R, C; stage_rc(tid * 16 + i * 8192, R, C); const int Rb = Epi::PERM ? ((R & ~31) + perm32(R & 31)) : R;
        voffA[i] = (unsigned)(R * K + C) * 2u; voffB[i] = (unsigned)(Rb * K + C) * 2u; }
    const size_t kstep = (size_t)(BK * 2);
    const size_t hstep = (size_t)HALF * K * 2;
    const size_t tstep = 2 * hstep;
    const unsigned ldsw = (unsigned)wid * 1024u;
    const int aoff = lds_byte(wr * 64 + fr, fq * 8), boff = lds_byte(wc * 32 + fr, fq * 8);
#define PG8_SA(b, h) (((b) * 2 + (h)) * HTB)
#define PG8_SB(b, h) ((4 + (b) * 2 + (h)) * HTB)
#define PG8_STAGE(bufoff, gbase, voff) do { _Pragma("unroll") for (int _i = 0; _i < 2; ++_i) \
        __builtin_amdgcn_global_load_lds((const unsigned*)((const char*)(gbase) + (voff)[_i]), (PG8_LAS unsigned*)(lds + (bufoff) + ldsw + _i * 8192), 16, 0, 0); } while (0)
#define PG8_LDA(dst, b, h) do { _Pragma("unroll") for (int m = 0; m < 4; ++m) _Pragma("unroll") for (int k = 0; k < 2; ++k) dst[m][k] = *(const PG8_LAS bf16x8*)(lds + PG8_SA(b, h) + aoff + m * 2048 + k * 1024); } while (0)
#define PG8_LDB(dst, b, h) do { _Pragma("unroll") for (int n = 0; n < 2; ++n) _Pragma("unroll") for (int k = 0; k < 2; ++k) dst[n][k] = *(const PG8_LAS bf16x8*)(lds + PG8_SB(b, h) + boff + n * 2048 + k * 1024); } while (0)
#define PG8_MMA(ai, bj, At, Bt) do { __builtin_amdgcn_s_setprio(1); _Pragma("unroll") for (int m = 0; m < 4; ++m) _Pragma("unroll") for (int n = 0; n < 2; ++n) _Pragma("unroll") for (int k = 0; k < 2; ++k) \
        acc[ai][bj][m][n] = __builtin_amdgcn_mfma_f32_16x16x32_bf16(Bt[n][k], At[m][k], acc[ai][bj][m][n], 0, 0, 0); __builtin_amdgcn_s_setprio(0); } while (0)
#define PG8_WAIT_V(n) asm volatile("s_waitcnt vmcnt(" #n ")" ::: "memory")
#define PG8_WAIT_L(n) asm volatile("s_waitcnt lgkmcnt(" #n ")" ::: "memory")
#define PG8_BAR __builtin_amdgcn_s_barrier()
#define PG8_SCHED __builtin_amdgcn_sched_barrier(0)
    Unit cur, nxt; int ui = 0;
    if (!S.next(0, cur)) return;
    f32x4 acc[2][2][4][2];
#pragma unroll
    for (int a = 0; a < 2; ++a)
#pragma unroll
        for (int b = 0; b < 2; ++b)
#pragma unroll
            for (int m = 0; m < 4; ++m)
#pragma unroll
                for (int n = 0; n < 2; ++n) acc[a][b][m][n] = (f32x4){0.f, 0.f, 0.f, 0.f};
    bf16x8 At[4][2], B0[2][2], B1[2][2];
    const size_t estep = (size_t)g.N * K * 2;
    const char* cA = (const char*)g.A + (size_t)cur.pm * tstep; const char* cB = (const char*)g.Bt + (size_t)cur.e * estep + (size_t)cur.pn * tstep;
    S.a_ready(cur);
    if constexpr (SP2) {
        PG8_STAGE(PG8_SB(0, 0), cB, voffB); PG8_STAGE(PG8_SB(0, 1), cB + hstep, voffB); PG8_STAGE(PG8_SA(0, 0), cA, voffA); PG8_STAGE(PG8_SA(0, 1), cA + hstep, voffA);
        if (wr == 1) PG8_BAR;
        PG8_WAIT_V(2); PG8_BAR;
        PG8_STAGE(PG8_SB(1, 0), cB + kstep, voffB); PG8_STAGE(PG8_SA(1, 0), cA + kstep, voffA); PG8_STAGE(PG8_SB(1, 1), cB + hstep + kstep, voffB);
        PG8_WAIT_V(6); PG8_BAR;
    } else {
        PG8_STAGE(PG8_SB(0, 0), cB, voffB); PG8_STAGE(PG8_SA(0, 0), cA, voffA); PG8_STAGE(PG8_SB(0, 1), cB + hstep, voffB); PG8_STAGE(PG8_SA(0, 1), cA + hstep, voffA);
        if (wr == 1) PG8_BAR;
        PG8_WAIT_V(4); PG8_BAR;
        PG8_STAGE(PG8_SB(1, 0), cB + kstep, voffB); PG8_STAGE(PG8_SA(1, 0), cA + kstep, voffA); PG8_STAGE(PG8_SB(1, 1), cB + hstep + kstep, voffB);
        PG8_WAIT_V(6); PG8_BAR;
    }
    for (;;) {
        const bool has_next = S.next(ui + 1, nxt);
        const char* nA = has_next ? (const char*)g.A + (size_t)nxt.pm * tstep : cA; const char* nB = has_next ? (const char*)g.Bt + (size_t)nxt.e * estep + (size_t)nxt.pn * tstep : cB;
        for (int t = 0; t < nt; t += 2) {
            const bool last = (t == nt - 2);
            const char* a1 = cA + (size_t)(t + 1) * kstep;
            const char* a2 = last ? nA : cA + (size_t)(t + 2) * kstep; const char* b2 = last ? nB : cB + (size_t)(t + 2) * kstep;
            const char* a3 = a2 + kstep; const char* b3 = b2 + kstep;
            if (last && has_next) S.a_ready(nxt);
            if constexpr (SP2) {
            PG8_LDB(B0, 0, 0); PG8_LDB(B1, 0, 1); PG8_SCHED; PG8_LDA(At, 0, 0); PG8_STAGE(PG8_SA(1, 1), a1 + hstep, voffA);
            PG8_WAIT_V(8); PG8_WAIT_L(0); PG8_BAR; PG8_MMA(0, 0, At, B0); PG8_MMA(0, 1, At, B1); PG8_BAR; PG8_SCHED;
            PG8_LDA(At, 0, 1); PG8_STAGE(PG8_SB(0, 0), b2, voffB); PG8_STAGE(PG8_SB(0, 1), b2 + hstep, voffB); PG8_STAGE(PG8_SA(0, 0), a2, voffA);
            PG8_WAIT_V(8); PG8_WAIT_L(0); PG8_BAR; PG8_MMA(1, 0, At, B0); PG8_MMA(1, 1, At, B1); PG8_BAR; PG8_SCHED;
            PG8_LDB(B0, 1, 0); PG8_LDB(B1, 1, 1); PG8_SCHED; PG8_LDA(At, 1, 0); PG8_STAGE(PG8_SA(0, 1), a2 + hstep, voffA);
            PG8_WAIT_V(8); PG8_WAIT_L(0); PG8_BAR; PG8_MMA(0, 0, At, B0); PG8_MMA(0, 1, At, B1); PG8_BAR; PG8_SCHED;
            PG8_LDA(At, 1, 1); PG8_STAGE(PG8_SB(1, 0), b3, voffB); PG8_STAGE(PG8_SB(1, 1), b3 + hstep, voffB); PG8_STAGE(PG8_SA(1, 0), a3, voffA);
            PG8_WAIT_V(8); PG8_WAIT_L(0); PG8_BAR; PG8_MMA(1, 0, At, B0); PG8_MMA(1, 1, At, B1); PG8_BAR; PG8_SCHED;
            } else {
            PG8_LDB(B0, 0, 0); PG8_SCHED; PG8_LDA(At, 0, 0); PG8_STAGE(PG8_SA(1, 1), a1 + hstep, voffA);
            PG8_WAIT_L(8); PG8_BAR; PG8_WAIT_L(0); PG8_MMA(0, 0, At, B0); PG8_BAR; PG8_SCHED;
            PG8_LDB(B1, 0, 1); PG8_STAGE(PG8_SB(0, 0), b2, voffB);
            PG8_BAR; PG8_WAIT_L(0); PG8_MMA(0, 1, At, B1); PG8_BAR;
            PG8_LDA(At, 0, 1); PG8_STAGE(PG8_SA(0, 0), a2, voffA);
            PG8_BAR; PG8_WAIT_L(0); PG8_MMA(1, 0, At, B0); PG8_BAR; PG8_SCHED;
            PG8_STAGE(PG8_SB(0, 1), b2 + hstep, voffB);
            PG8_WAIT_V(6); PG8_BAR; PG8_MMA(1, 1, At, B1); PG8_BAR;
            PG8_LDB(B0, 1, 0); PG8_SCHED; PG8_LDA(At, 1, 0); PG8_STAGE(PG8_SA(0, 1), a2 + hstep, voffA);
            PG8_WAIT_L(8); PG8_BAR; PG8_WAIT_L(0); PG8_MMA(0, 0, At, B0); PG8_BAR; PG8_SCHED;
            PG8_LDB(B1, 1, 1); PG8_STAGE(PG8_SB(1, 0), b3, voffB);
            PG8_BAR; PG8_WAIT_L(0); PG8_MMA(0, 1, At, B1); PG8_BAR;
            PG8_LDA(At, 1, 1); PG8_STAGE(PG8_SA(1, 0), a3, voffA);
            PG8_BAR; PG8_WAIT_L(0); PG8_MMA(1, 0, At, B0); PG8_BAR; PG8_SCHED;
            PG8_STAGE(PG8_SB(1, 1), b3 + hstep, voffB);
            PG8_WAIT_V(6); PG8_BAR; PG8_MMA(1, 1, At, B1); PG8_BAR;
            }
        }
        if constexpr (ALIGN_EPI) { if (wr == 0) PG8_BAR; }
        if constexpr (!Epi::AFTER_DRAIN) { E(acc, cur, wr, wc, fr, fq); S.done(cur); }
        if (!has_next) break;
#pragma unroll
        for (int a = 0; a < 2; ++a)
#pragma unroll
            for (int b = 0; b < 2; ++b)
#pragma unroll
                for (int m = 0; m < 4; ++m)
#pragma unroll
                    for (int n = 0; n < 2; ++n) acc[a][b][m][n] = (f32x4){0.f, 0.f, 0.f, 0.f};
        cur = nxt; cA = nA; cB = nB; ++ui;
        if constexpr (ALIGN_EPI) { if (wr == 1) PG8_BAR; }
    }
    PG8_WAIT_V(0);
    if constexpr (!ALIGN_EPI) { if (wr == 0) PG8_BAR; }
    PG8_BAR;
    if constexpr (Epi::AFTER_DRAIN) { E.fused(acc, cur, wr, wc, fr, fq, lds, wid, lane); S.done(cur); }
#undef PG8_SA
#undef PG8_SB
#undef PG8_STAGE
#undef PG8_LDA
#undef PG8_LDB
#undef PG8_MMA
#undef PG8_WAIT_V
#undef PG8_WAIT_L
#undef PG8_BAR
#undef PG8_SCHED
}
}

#ifndef DBG_CMP
#define DBG_CMP 0
#endif
#define LAS __attribute__((address_space(3)))
typedef unsigned short bf16_t;
typedef float f32x4 __attribute__((ext_vector_type(4)));
typedef unsigned u32x4 __attribute__((ext_vector_type(4)));
typedef unsigned u32x2 __attribute__((ext_vector_type(2)));
typedef unsigned long long u64;

constexpr int T_TOK = 16384, DMODEL = 2048, SEQL = 2048;
constexpr int NPROJ = 9984;
constexpr int C_QLAT = 0, C_CKV = 1024, C_QIDX = 1152, C_KIDX = 1664, C_WIDX = 1728, C_QR = 1792, C_KR = 2816, C_VR = 3840, C_GR = 4864, C_GBR = 5888;
constexpr int MAXSLOT = 40960;
constexpr float EPS_F = 1e-6f;
constexpr float IDX_SCALE = 0.04419417382415922f;
constexpr float ATT_SCALE = 0.08838834764831845f;
constexpr float K_SCALE = 0.08838834764831845f;

constexpr size_t WS_CTL = 0;
constexpr size_t WS_ROT = 65536;
constexpr size_t WS_WIN = WS_ROT + 1048576;
constexpr size_t WS_WCOMB = WS_WIN + (size_t)NPROJ * 2048 * 2;
constexpr size_t WS_WB = WS_WCOMB + (size_t)2048 * 1024 * 2;
constexpr size_t WS_WO = WS_WB + (size_t)2048 * 1024 * 2;
constexpr size_t WS_WGU = WS_WO + (size_t)2048 * 2048 * 2;
constexpr size_t WS_WD = WS_WGU + (size_t)32 * 2048 * 2048 * 2;
constexpr size_t WS_P = WS_WD + (size_t)32 * 2048 * 1024 * 2;
constexpr size_t WS_HMID = WS_P;
constexpr size_t WS_Y = WS_HMID + (size_t)MAXSLOT * 1024 * 2;
constexpr size_t WS_XN = WS_P + (size_t)T_TOK * NPROJ * 2;
constexpr size_t WS_OA = WS_XN + (size_t)T_TOK * 2048 * 2;
constexpr size_t WS_OB = WS_OA + (size_t)T_TOK * 1024 * 2;
constexpr size_t WS_MIXED = WS_OB + (size_t)T_TOK * 1024 * 2;
constexpr size_t WS_SPARE = WS_MIXED + (size_t)T_TOK * 2048 * 2;
constexpr size_t WS_XG = WS_OA;
constexpr size_t WS_KV = WS_SPARE + (size_t)T_TOK * 1024 * 2;
constexpr size_t WS_MASK = WS_KV + (size_t)T_TOK * 128 * 2;
constexpr size_t WS_MISC = WS_MASK + (size_t)T_TOK * 256;
constexpr size_t WS_END = WS_MISC + 1048576;
static_assert(WS_Y + (size_t)MAXSLOT * 2048 * 2 <= WS_XN, "HMID + Y must fit in P");
static_assert(WS_XG + (size_t)MAXSLOT * 2048 * 2 <= WS_KV, "XG must fit in OA..SPARE");
static_assert(WS_END <= (size_t)1073741824, "workspace budget");
constexpr int MI_ROWTOK = 0, MI_ROWGATE = MAXSLOT, MI_TOKSLOT = 2 * MAXSLOT, MI_ASGE = MI_TOKSLOT + 2 * T_TOK, MI_ASGR = MI_ASGE + 2 * T_TOK, MI_ASGG = MI_ASGR + 2 * T_TOK;
static_assert((size_t)(MI_ASGG + 2 * T_TOK) * 4 <= 1048576, "misc budget");
constexpr int LDS_BYTES = 136 * 1024;
constexpr int LDS_MISC = 132 * 1024;

__device__ __forceinline__ float bflo(unsigned w) { return __uint_as_float(w << 16); }
__device__ __forceinline__ float bfhi(unsigned w) { return __uint_as_float(w & 0xffff0000u); }
__device__ __forceinline__ unsigned pkbf(float lo, float hi) { unsigned r; asm volatile("v_cvt_pk_bf16_f32 %0, %1, %2" : "=v"(r) : "v"(lo), "v"(hi)); return r; }
__device__ __forceinline__ int hide_i(int v) { asm volatile("" : "+v"(v)); return v; }
template <class Tp> __device__ __forceinline__ Tp* hide_p(Tp* q) { asm volatile("" : "+s"(q)); return q; }
__device__ __forceinline__ float shx(float v, int lane, int o) { return __int_as_float(__builtin_amdgcn_ds_bpermute((lane ^ o) << 2, __float_as_int(v))); }
__device__ __forceinline__ float wave_sum(float v, int lane) {
#pragma unroll
    for (int o = 1; o < 64; o <<= 1) v += shx(v, lane, o);
    return v;
}
__device__ __forceinline__ float wave_max(float v, int lane) {
#pragma unroll
    for (int o = 1; o < 64; o <<= 1) v = fmaxf(v, shx(v, lane, o));
    return v;
}
__device__ __forceinline__ float sigmoidf_(float x) { return __builtin_amdgcn_rcpf(1.0f + __expf(-x)); }
__device__ __forceinline__ float siluf_(float x) { return x * sigmoidf_(x); }
__device__ __forceinline__ unsigned fkey(float f) { const unsigned u = __float_as_uint(f + 0.0f); return (u & 0x80000000u) ? ~u : (u | 0x80000000u); }


namespace fa {
using bf16x8 = __attribute__((ext_vector_type(8))) short;
using s16x4  = __attribute__((ext_vector_type(4))) short;
using f32x16 = __attribute__((ext_vector_type(16))) float;
constexpr int TILE_B = 64 * 128 * 2;
constexpr int OFF_V = 0, OFF_K = 2 * TILE_B, OFF_M = 4 * TILE_B, OFF_WS = OFF_M + 2 * 256, LDS_NEED = OFF_WS + 8 * 256;
#define FA_KSWZ(row, colB) ((row) * 256 + ((colB) ^ (((row) & 7) << 4)))
#define FA_SBAR() __builtin_amdgcn_sched_barrier(0)
__device__ __forceinline__ int crow(int r, int hi) { return (r & 3) + 8 * (r >> 2) + 4 * hi; }
__device__ __forceinline__ int v_st(int k, int c) { const int kk = (k & ~0xC) | ((k & 4) << 1) | ((k & 8) >> 1); return ((kk >> 3) * 4 + (c >> 5)) * 512 + ((kk & 7) * 32 + (c & 31)) * 2; }
__device__ __forceinline__ int v_rd_base(int lane) { return ((lane & 3) << 3) | (((lane >> 2) & 3) << 6) | (((lane >> 4) & 1) << 5) | (((lane >> 5) & 1) << 8); }
constexpr int v_rd_off(int d0, int ks, int half) { return d0 * 512 + ks * 4096 + half * 2048; }
template <int OFF> __device__ __forceinline__ s16x4 tr_read(int vb) { s16x4 r; asm volatile("ds_read_b64_tr_b16 %0, %1 offset:%2" : "=&v"(r) : "v"(vb), "i"(OFF) : "memory"); return r; }
template <int D0> __device__ __forceinline__ void pv_one(f32x16& od, int vb, bf16x8 pa0, bf16x8 pa1, bf16x8 pa2, bf16x8 pa3) {
    const s16x4 l0 = tr_read<v_rd_off(D0, 0, 0)>(vb), h0 = tr_read<v_rd_off(D0, 0, 1)>(vb), l1 = tr_read<v_rd_off(D0, 1, 0)>(vb), h1 = tr_read<v_rd_off(D0, 1, 1)>(vb);
    const s16x4 l2 = tr_read<v_rd_off(D0, 2, 0)>(vb), h2 = tr_read<v_rd_off(D0, 2, 1)>(vb), l3 = tr_read<v_rd_off(D0, 3, 0)>(vb), h3 = tr_read<v_rd_off(D0, 3, 1)>(vb);
    asm volatile("s_waitcnt lgkmcnt(0)" ::: "memory"); FA_SBAR();
#define FA_PK(L, H) (bf16x8){L[0], L[1], L[2], L[3], H[0], H[1], H[2], H[3]}
    od = __builtin_amdgcn_mfma_f32_32x32x16_bf16(pa0, FA_PK(l0, h0), od, 0, 0, 0);
    od = __builtin_amdgcn_mfma_f32_32x32x16_bf16(pa1, FA_PK(l1, h1), od, 0, 0, 0);
    od = __builtin_amdgcn_mfma_f32_32x32x16_bf16(pa2, FA_PK(l2, h2), od, 0, 0, 0);
    od = __builtin_amdgcn_mfma_f32_32x32x16_bf16(pa3, FA_PK(l3, h3), od, 0, 0, 0);
#undef FA_PK
}
__device__ __forceinline__ void qkt(f32x16& p0, f32x16& p1, const LAS char* Ks, const bf16x8 (&qr)[8], int r32, int hi) {
    p0 = f32x16{}; p1 = f32x16{};
#pragma unroll
    for (int d0 = 0; d0 < 8; ++d0) { const int cb = (d0 * 16 + hi * 8) * 2;
        const bf16x8 b0 = *(const LAS bf16x8*)(Ks + FA_KSWZ(r32, cb));
        const bf16x8 b1 = *(const LAS bf16x8*)(Ks + FA_KSWZ(32 + r32, cb));
        p0 = __builtin_amdgcn_mfma_f32_32x32x16_bf16(b0, qr[d0], p0, 0, 0, 0);
        p1 = __builtin_amdgcn_mfma_f32_32x32x16_bf16(b1, qr[d0], p1, 0, 0, 0); }
}
__device__ __forceinline__ void p_to_frag(const f32x16& p0, const f32x16& p1, bf16x8& pa0, bf16x8& pa1, bf16x8& pa2, bf16x8& pa3) {
#define FA_PK4(P, BASE, OUT) do { unsigned a0 = pkbf(P[BASE + 0], P[BASE + 1]), a1 = pkbf(P[BASE + 2], P[BASE + 3]);   \
    unsigned b0 = pkbf(P[BASE + 4], P[BASE + 5]), b1 = pkbf(P[BASE + 6], P[BASE + 7]);                              \
    auto r0 = __builtin_amdgcn_permlane32_swap(a0, b0, false, false); auto r1 = __builtin_amdgcn_permlane32_swap(a1, b1, false, false); \
    u32x4 w = {r0[0], r1[0], r0[1], r1[1]}; OUT = *reinterpret_cast<bf16x8*>(&w); } while (0)
    FA_PK4(p0, 0, pa0); FA_PK4(p0, 8, pa1); FA_PK4(p1, 0, pa2); FA_PK4(p1, 8, pa3);
#undef FA_PK4
}

struct UnitArgs {
    const bf16_t* Q; int ldq;
    const bf16_t* K; const bf16_t* V; int ldk;
    const u64* mask;
    int ntiles;
    int n0;
    float lgam;
};

template <int MODE>
__device__ __forceinline__ void unit_body(LAS char* L, const UnitArgs& U, int tid, f32x16 (&o)[4], float& l_out) {
    const int wid = __builtin_amdgcn_readfirstlane(tid >> 6), lane = tid & 63, r32 = lane & 31, hi = lane >> 5;
    LAS char* V_lds = L + OFF_V; LAS char* K_lds = L + OFF_K; LAS u64* M_lds = (LAS u64*)(L + OFF_M);
    LAS float* wsf = (LAS float*)(L + OFF_WS) + wid * 64; LAS float* al_l = wsf + 32;
    constexpr float C = ATT_SCALE * 1.4426950408889634f;
    float m_reg = -1e30f, l_reg = 0.f;
#pragma unroll
    for (int d = 0; d < 4; ++d) o[d] = f32x16{};
    bf16x8 qr[8];
    { const bf16_t* Qw = (MODE == 0) ? U.Q + (size_t)r32 * U.ldq + wid * 128 + hi * 8 : U.Q + (size_t)(wid * 32 + r32) * U.ldq + hi * 8;
#pragma unroll
      for (int d0 = 0; d0 < 8; ++d0) qr[d0] = *(const bf16x8*)(Qw + d0 * 16); }
    const int sr = tid >> 4, sc = (tid & 15) * 8, vst0 = v_st(sr, sc), vst1 = v_st(32 + sr, sc), kst0 = FA_KSWZ(sr, sc * 2), kst1 = FA_KSWZ(32 + sr, sc * 2);
    const int vb0 = (int)(unsigned)(size_t)V_lds + v_rd_base(lane);
    bf16x8 ks0, ks1, vs0, vs1; u64 mws = 0ull;
#define FA_SLOAD(k0) do { ks0 = *(const bf16x8*)(U.K + (size_t)((k0) + sr) * U.ldk + sc); ks1 = *(const bf16x8*)(U.K + (size_t)((k0) + 32 + sr) * U.ldk + sc); \
        if (MODE == 1) { vs0 = *(const bf16x8*)(U.V + (size_t)((k0) + sr) * U.ldk + sc); vs1 = *(const bf16x8*)(U.V + (size_t)((k0) + 32 + sr) * U.ldk + sc); } \
        if (MODE == 0 && tid < 32) mws = U.mask[(size_t)tid * 32 + ((k0) >> 6)]; } while (0)
#define FA_SWRITE(b) do { *(LAS bf16x8*)(K_lds + (b) * TILE_B + kst0) = ks0; *(LAS bf16x8*)(K_lds + (b) * TILE_B + kst1) = ks1; \
        *(LAS bf16x8*)(V_lds + (b) * TILE_B + vst0) = (MODE == 1) ? vs0 : ks0; *(LAS bf16x8*)(V_lds + (b) * TILE_B + vst1) = (MODE == 1) ? vs1 : ks1; \
        if (MODE == 0 && tid < 32) M_lds[(b) * 32 + tid] = mws; } while (0)
    const int NT = U.ntiles;
    FA_SLOAD(0); FA_SWRITE(0);
    if (NT > 1) { FA_SLOAD(64); FA_SWRITE(1); }
    __syncthreads();
    for (int j = 0; j < NT; ++j) {
        const int b = j & 1;
        if (j + 2 < NT) FA_SLOAD((j + 2) * 64);
        f32x16 p0, p1; bf16x8 pa0, pa1, pa2, pa3;
        qkt(p0, p1, K_lds + b * TILE_B, qr, r32, hi);
        if (MODE == 0) {
            const u64 mw = M_lds[b * 32 + r32] >> (4 * hi);
            const unsigned mlo = (unsigned)mw, mhi = (unsigned)(mw >> 32);
#pragma unroll
            for (int r = 0; r < 16; ++r) { const unsigned bit = 1u << ((r & 3) + 8 * (r >> 2)); p0[r] = (mlo & bit) ? p0[r] : -INFINITY; p1[r] = (mhi & bit) ? p1[r] : -INFINITY; }
            float pmax = p0[0];
#pragma unroll
            for (int r = 1; r < 16; ++r) pmax = fmaxf(pmax, p0[r]);
#pragma unroll
            for (int r = 0; r < 16; ++r) pmax = fmaxf(pmax, p1[r]);
            { auto rr = __builtin_amdgcn_permlane32_swap(__float_as_uint(pmax), __float_as_uint(pmax), false, false); pmax = fmaxf(__uint_as_float(rr[0]), __uint_as_float(rr[1])); }
            const float mn = fmaxf(m_reg, pmax); const float alpha = __builtin_amdgcn_exp2f((m_reg - mn) * C); m_reg = mn;
            const float mnC = -mn * C; float ps = 0.f;
#pragma unroll
            for (int r = 0; r < 16; ++r) { p0[r] = __builtin_amdgcn_exp2f(fmaf(p0[r], C, mnC)); p1[r] = __builtin_amdgcn_exp2f(fmaf(p1[r], C, mnC)); ps += p0[r] + p1[r]; }
            { auto rr = __builtin_amdgcn_permlane32_swap(__float_as_uint(ps), __float_as_uint(ps), false, false); ps = __uint_as_float(rr[0]) + __uint_as_float(rr[1]); }
            l_reg = l_reg * alpha + ps;
            if (__any(alpha < 1.f)) {
                if (hi == 0) al_l[r32] = alpha;
                asm volatile("s_waitcnt lgkmcnt(0)" ::: "memory");
#pragma unroll
                for (int r = 0; r < 16; ++r) { const float a = al_l[crow(r, hi)];
#pragma unroll
                    for (int d = 0; d < 4; ++d) o[d][r] *= a; }
            }
        } else {
            const int dn = U.n0 + wid * 32 + r32 - j * 64 - 4 * hi;
            const float base = (float)dn * U.lgam;
#pragma unroll
            for (int r = 0; r < 16; ++r) { const int kk = (r & 3) + 8 * (r >> 2);
                const float f0 = __builtin_amdgcn_exp2f(base - (float)kk * U.lgam), f1 = __builtin_amdgcn_exp2f(base - (float)(kk + 32) * U.lgam);
                p0[r] = (dn >= kk) ? p0[r] * f0 : 0.f; p1[r] = (dn >= kk + 32) ? p1[r] * f1 : 0.f; }
        }
        p_to_frag(p0, p1, pa0, pa1, pa2, pa3);
        FA_SBAR();
        { const int vb = vb0 + b * TILE_B;
          pv_one<0>(o[0], vb, pa0, pa1, pa2, pa3); pv_one<1>(o[1], vb, pa0, pa1, pa2, pa3); pv_one<2>(o[2], vb, pa0, pa1, pa2, pa3); pv_one<3>(o[3], vb, pa0, pa1, pa2, pa3); }
        __syncthreads();
        if (j + 2 < NT) FA_SWRITE(b);
    }
    __syncthreads();
    l_out = l_reg;
#undef FA_SLOAD
#undef FA_SWRITE
}
}

namespace pg8 {
struct EpiProj {
    static constexpr bool PERM = true, AFTER_DRAIN = false;
    bf16_t* P; const float* rot;
    __device__ __forceinline__ void operator()(const f32x4 (&acc)[2][2][4][2], const Unit& u, int wr, int wc, int fr, int fq) const {
        const int row0 = u.pm * BM + wr * 64 + fr, colb = u.pn * BM + wc * 32 + 8 * fq;
        const bool rotq = (u.pn >= 7) && (u.pn < 15);
        const float ksc = (u.pn >= 11) ? K_SCALE : 1.0f;
        const int i0 = 16 * wc + 4 * fq;
#pragma unroll
        for (int ai = 0; ai < 2; ++ai)
#pragma unroll
            for (int m = 0; m < 4; ++m) {
                const int row = row0 + ai * HALF + m * 16; const int pos = row & (SEQL - 1);
                bf16_t* rowp = P + (size_t)row * NPROJ + colb;
                f32x4 r0 = (f32x4){1.f, 0.f, 1.f, 0.f}, r1 = r0;
                if (rotq) { const f32x4* rt = (const f32x4*)(rot + ((size_t)pos * 64 + i0) * 2); r0 = rt[0]; r1 = rt[1]; }
#pragma unroll
                for (int bj = 0; bj < 2; ++bj) {
                    f32x4 v0 = acc[ai][bj][m][0], v1 = acc[ai][bj][m][1];
                    if (rotq) {
                        f32x4 w0, w1;
                        w0[0] = (v0[0] * r0[0] - v0[1] * r0[1]) * ksc; w0[1] = (v0[0] * r0[1] + v0[1] * r0[0]) * ksc;
                        w0[2] = (v0[2] * r0[2] - v0[3] * r0[3]) * ksc; w0[3] = (v0[2] * r0[3] + v0[3] * r0[2]) * ksc;
                        w1[0] = (v1[0] * r1[0] - v1[1] * r1[1]) * ksc; w1[1] = (v1[0] * r1[1] + v1[1] * r1[0]) * ksc;
                        w1[2] = (v1[2] * r1[2] - v1[3] * r1[3]) * ksc; w1[3] = (v1[2] * r1[3] + v1[3] * r1[2]) * ksc;
                        v0 = w0; v1 = w1;
                    }
                    u32x4 w; w.x = pkbf(v0[0], v0[1]); w.y = pkbf(v0[2], v0[3]); w.z = pkbf(v1[0], v1[1]); w.w = pkbf(v1[2], v1[3]);
                    *(u32x4*)(rowp + bj * HALF) = w;
                }
            }
    }
};
template <int WHICH> struct EpiMerge {
    static constexpr bool PERM = true, AFTER_DRAIN = false;
    const bf16_t* P; const bf16_t* BA; bf16_t* O;
    __device__ __forceinline__ void operator()(const f32x4 (&acc)[2][2][4][2], const Unit& u, int wr, int wc, int fr, int fq) const {
        const int row0 = u.pm * BM + wr * 64 + fr, colb = u.pn * BM + wc * 32 + 8 * fq;
#pragma unroll
        for (int ai = 0; ai < 2; ++ai)
#pragma unroll
            for (int m = 0; m < 4; ++m) {
                const int row = row0 + ai * HALF + m * 16;
#pragma unroll
                for (int bj = 0; bj < 2; ++bj) {
                    const int col = colb + bj * HALF;
                    const u32x4 g = *(const u32x4*)(P + (size_t)row * NPROJ + C_GBR + WHICH * DMODEL + col);
                    const f32x4 v0 = acc[ai][bj][m][0], v1 = acc[ai][bj][m][1];
                    float o[8];
                    o[0] = sigmoidf_(bflo(g.x)) * v0[0]; o[1] = sigmoidf_(bfhi(g.x)) * v0[1]; o[2] = sigmoidf_(bflo(g.y)) * v0[2]; o[3] = sigmoidf_(bfhi(g.y)) * v0[3];
                    o[4] = sigmoidf_(bflo(g.z)) * v1[0]; o[5] = sigmoidf_(bfhi(g.z)) * v1[1]; o[6] = sigmoidf_(bflo(g.w)) * v1[2]; o[7] = sigmoidf_(bfhi(g.w)) * v1[3];
                    if (WHICH == 1) {
                        const u32x4 a = *(const u32x4*)(BA + (size_t)row * DMODEL + col);
                        o[0] += bflo(a.x); o[1] += bfhi(a.x); o[2] += bflo(a.y); o[3] += bfhi(a.y); o[4] += bflo(a.z); o[5] += bfhi(a.z); o[6] += bflo(a.w); o[7] += bfhi(a.w);
                    }
                    u32x4 w; w.x = pkbf(o[0], o[1]); w.y = pkbf(o[2], o[3]); w.z = pkbf(o[4], o[5]); w.w = pkbf(o[6], o[7]);
                    *(u32x4*)(O + (size_t)row * DMODEL + col) = w;
                }
            }
    }
};
struct EpiRes {
    static constexpr bool PERM = false, AFTER_DRAIN = false;
    const float* X; float* O;
    __device__ __forceinline__ void operator()(const f32x4 (&acc)[2][2][4][2], const Unit& u, int wr, int wc, int fr, int fq) const {
        const int row0 = u.pm * BM + wr * 64 + fr, col0 = u.pn * BM + wc * 32 + 4 * fq;
#pragma unroll
        for (int ai = 0; ai < 2; ++ai)
#pragma unroll
            for (int m = 0; m < 4; ++m) {
                const size_t off = (size_t)(row0 + ai * HALF + m * 16) * DMODEL + col0;
#pragma unroll
                for (int bj = 0; bj < 2; ++bj)
#pragma unroll
                    for (int n = 0; n < 2; ++n) { const f32x4 xv = *(const f32x4*)(X + off + bj * HALF + n * 16); *(f32x4*)(O + off + bj * HALF + n * 16) = xv + acc[ai][bj][m][n]; }
            }
    }
};
struct EpiSwiglu {
    static constexpr bool PERM = true, AFTER_DRAIN = false;
    bf16_t* H;
    __device__ __forceinline__ void operator()(const f32x4 (&acc)[2][2][4][2], const Unit& u, int wr, int wc, int fr, int fq) const {
        const int row0 = u.pm * BM + wr * 64 + fr, col = u.pn * HALF + wc * 32 + 8 * fq;
#pragma unroll
        for (int ai = 0; ai < 2; ++ai)
#pragma unroll
            for (int m = 0; m < 4; ++m) {
                const int row = row0 + ai * HALF + m * 16;
                const f32x4 g0 = acc[ai][0][m][0], g1 = acc[ai][0][m][1], u0 = acc[ai][1][m][0], u1 = acc[ai][1][m][1];
                u32x4 w; w.x = pkbf(siluf_(g0[0]) * u0[0], siluf_(g0[1]) * u0[1]); w.y = pkbf(siluf_(g0[2]) * u0[2], siluf_(g0[3]) * u0[3]);
                w.z = pkbf(siluf_(g1[0]) * u1[0], siluf_(g1[1]) * u1[1]); w.w = pkbf(siluf_(g1[2]) * u1[2], siluf_(g1[3]) * u1[3]);
                *(u32x4*)(H + (size_t)row * 1024 + col) = w;
            }
    }
};
struct EpiDown {
    static constexpr bool PERM = true, AFTER_DRAIN = false;
    bf16_t* Y; const float* rg;
    __device__ __forceinline__ void operator()(const f32x4 (&acc)[2][2][4][2], const Unit& u, int wr, int wc, int fr, int fq) const {
        const int row0 = u.pm * BM + wr * 64 + fr, colb = u.pn * BM + wc * 32 + 8 * fq;
#pragma unroll
        for (int ai = 0; ai < 2; ++ai)
#pragma unroll
            for (int m = 0; m < 4; ++m) {
                const int row = row0 + ai * HALF + m * 16; const float gt = rg[row];
#pragma unroll
                for (int bj = 0; bj < 2; ++bj) {
                    const f32x4 v0 = acc[ai][bj][m][0] * gt, v1 = acc[ai][bj][m][1] * gt;
                    u32x4 w; w.x = pkbf(v0[0], v0[1]); w.y = pkbf(v0[2], v0[3]); w.z = pkbf(v1[0], v1[1]); w.w = pkbf(v1[2], v1[3]);
                    *(u32x4*)(Y + (size_t)row * DMODEL + colb + bj * HALF) = w;
                }
            }
    }
};
struct ExpertOrder {
    const LAS int* ts; int G, c;
    __device__ __forceinline__ bool next(int i, Unit& u) const {
        const int L = i * G + c; const int total = ts[32] * 8; if (L >= total) return false;
        const int gt = L >> 3; u.pm = gt; u.pn = L & 7; int e = 0;
        for (int k = 1; k < 32; ++k) e += (gt >= ts[k]) ? 1 : 0;
        u.e = e; return true;
    }
    __device__ __forceinline__ void a_ready(const Unit&) const {}
    __device__ __forceinline__ void done(const Unit&) const {}
};
}

struct MapId { __device__ __forceinline__ int operator()(int n) const { return n; } };
struct MapGate { __device__ __forceinline__ int operator()(int f) const { return ((f >> 7) << 8) + (f & 127); } };
struct MapUp { __device__ __forceinline__ int operator()(int f) const { return ((f >> 7) << 8) + 128 + (f & 127); } };
struct MapProj {
    __device__ __forceinline__ int operator()(int n) const {
        if (n < 1736) return n;
        if (n < 2760) { const int l = n - 1736, d = l & 127; return C_QR + (l & ~127) + ((d & 63) << 1) + (d >> 6); }
        if (n < 3784) { const int l = n - 2760, d = l & 127; return C_KR + (l & ~127) + ((d & 63) << 1) + (d >> 6); }
        if (n < 4808) return C_VR + (n - 3784);
        if (n < 5832) return C_GR + (n - 4808);
        return C_GBR + (n - 5832);
    }
};
template <class RowMap>
__device__ __forceinline__ void tr_item(const float* __restrict__ src, int N, bf16_t* __restrict__ dst, int ldd, int kb, int nb, int lane, RowMap rm) {
    const int kc = lane >> 3, nc = lane & 7;
    const int n = nb * 32 + nc * 4, k0 = kb * 64 + kc * 8;
    if (n < N) {
        f32x4 v[8];
#pragma unroll
        for (int i = 0; i < 8; ++i) v[i] = *(const f32x4*)(src + (size_t)(k0 + i) * N + n);
#pragma unroll
        for (int j = 0; j < 4; ++j) {
            u32x4 o; o.x = pkbf(v[0][j], v[1][j]); o.y = pkbf(v[2][j], v[3][j]); o.z = pkbf(v[4][j], v[5][j]); o.w = pkbf(v[6][j], v[7][j]);
            *(u32x4*)(dst + (size_t)rm(n + j) * ldd + k0) = o;
        }
    }
}
__device__ __forceinline__ void sincos_d(double a, double& s, double& c) {
    const double TWO_PI = 6.283185307179586476925, HALF_PI = 1.5707963267948966192313;
    double k = rint(a / HALF_PI); double r = a - k * HALF_PI;
    r -= k * 6.123233995736766e-17;
    const int q = ((int)k) & 3; const double r2 = r * r;
    double sp = r2 * (-1.0 / 1307674368000.0);
    sp = r2 * (sp + 1.0 / 6227020800.0); sp = r2 * (sp - 1.0 / 39916800.0); sp = r2 * (sp + 1.0 / 362880.0); sp = r2 * (sp - 1.0 / 5040.0); sp = r2 * (sp + 1.0 / 120.0); sp = r2 * (sp - 1.0 / 6.0);
    const double sr = r + r * sp;
    double cp = r2 * (1.0 / 20922789888000.0);
    cp = r2 * (cp - 1.0 / 87178291200.0); cp = r2 * (cp + 1.0 / 479001600.0); cp = r2 * (cp - 1.0 / 3628800.0); cp = r2 * (cp + 1.0 / 40320.0); cp = r2 * (cp - 1.0 / 720.0); cp = r2 * (cp + 1.0 / 24.0); cp = r2 * (cp - 0.5);
    const double cr = 1.0 + cp;
    s = (q == 0) ? sr : (q == 1) ? cr : (q == 2) ? -sr : -cr;
    c = (q == 0) ? cr : (q == 1) ? -sr : (q == 2) ? -cr : sr;
    (void)TWO_PI;
}

struct Params { const float* in[17]; float* out; unsigned char* ws; };

#define GSYNC() grid.sync()

__global__ void __launch_bounds__(512, 2) mega_fwd(Params p) {
    extern __shared__ __attribute__((aligned(16))) unsigned char lds_raw[];
    LAS unsigned char* lds = (LAS unsigned char*)lds_raw;
    cg::grid_group grid = cg::this_grid();
    const int G = gridDim.x, bx = blockIdx.x;
    const int wave_id = __builtin_amdgcn_readfirstlane((int)threadIdx.x >> 6);
    const int NGW = G * 8, NGT = G * 512;
#define PH_LOCALS \
    const int lane = (int)__builtin_amdgcn_mbcnt_hi(~0u, __builtin_amdgcn_mbcnt_lo(~0u, (unsigned)hide_i(0))), wave = wave_id, tid = wave * 64 + lane; (void)tid; \
    const int gw = bx * 8 + wave, gtid = bx * 512 + tid; (void)gw; (void)gtid; (void)lane; \
    unsigned char* ws = hide_p(p.ws); float* out = hide_p(p.out); (void)out; \
    unsigned* ctl = (unsigned*)(ws + WS_CTL); float* rot = (float*)(ws + WS_ROT); (void)ctl; (void)rot; \
    bf16_t* WIN = (bf16_t*)(ws + WS_WIN); bf16_t* WCOMB = (bf16_t*)(ws + WS_WCOMB); bf16_t* WB = (bf16_t*)(ws + WS_WB); bf16_t* WO = (bf16_t*)(ws + WS_WO); (void)WIN; (void)WCOMB; (void)WB; (void)WO; \
    bf16_t* WGU = (bf16_t*)(ws + WS_WGU); bf16_t* WD = (bf16_t*)(ws + WS_WD); (void)WGU; (void)WD; \
    bf16_t* P = (bf16_t*)(ws + WS_P); bf16_t* HMID = (bf16_t*)(ws + WS_HMID); bf16_t* Y = (bf16_t*)(ws + WS_Y); (void)P; (void)HMID; (void)Y; \
    bf16_t* XN = (bf16_t*)(ws + WS_XN); bf16_t* BA = XN; bf16_t* TN = XN; (void)BA; (void)TN; \
    bf16_t* OA = (bf16_t*)(ws + WS_OA); bf16_t* OB = (bf16_t*)(ws + WS_OB); bf16_t* MIXED = (bf16_t*)(ws + WS_MIXED); bf16_t* XG = (bf16_t*)(ws + WS_XG); (void)OA; (void)OB; (void)MIXED; (void)XG; \
    bf16_t* KV = (bf16_t*)(ws + WS_KV); u64* MASK = (u64*)(ws + WS_MASK); (void)KV; (void)MASK; \
    int* misc = (int*)(ws + WS_MISC); \
    int* row_tok = misc + MI_ROWTOK; float* row_gate = (float*)(misc + MI_ROWGATE); int* tok_slot = misc + MI_TOKSLOT; (void)row_tok; (void)row_gate; (void)tok_slot; \
    int* asg_e = misc + MI_ASGE; int* asg_r = misc + MI_ASGR; float* asg_g = (float*)(misc + MI_ASGG); (void)asg_e; (void)asg_r; (void)asg_g;
#define IN(k) hide_p(p.in[k])

    {
        PH_LOCALS
        const float* x = IN(0); const float* g_mix = IN(1); const float* w_in = IN(2); const float* w_uv = IN(4); const float* w_branch = IN(6); const float* w_out = IN(7);
        const float* w_eg = IN(13); const float* w_eu = IN(14); const float* w_ed = IN(15);
        constexpr int NB_WIN = 311;
        constexpr int I_WIN = 32 * NB_WIN, I_WB = 16 * 64, I_WO = 32 * 64, I_EG = 32 * 1024, I_EU = 32 * 1024, I_ED = 32 * 1024;
        constexpr int I_TOTAL = I_WIN + I_WB + I_WO + I_EG + I_EU + I_ED;
        for (int it = gw; it < I_TOTAL; it += NGW) {
            int r = it;
            if (r < I_WIN) { tr_item(w_in, 9928, WIN, 2048, r / NB_WIN, r % NB_WIN, lane, MapProj{}); continue; } r -= I_WIN;
            if (r < I_WB) { tr_item(w_branch + (size_t)1024 * 2048, 2048, WB, 1024, r >> 6, r & 63, lane, MapId{}); continue; } r -= I_WB;
            if (r < I_WO) { tr_item(w_out, 2048, WO, 2048, r >> 6, r & 63, lane, MapId{}); continue; } r -= I_WO;
            if (r < I_EG) { const int e = r >> 10, q = r & 1023; tr_item(w_eg + (size_t)e * 2048 * 1024, 1024, WGU + (size_t)e * 2048 * 2048, 2048, q >> 5, q & 31, lane, MapGate{}); continue; } r -= I_EG;
            if (r < I_EU) { const int e = r >> 10, q = r & 1023; tr_item(w_eu + (size_t)e * 2048 * 1024, 1024, WGU + (size_t)e * 2048 * 2048, 2048, q >> 5, q & 31, lane, MapUp{}); continue; } r -= I_EU;
            { const int e = r >> 10, q = r & 1023; tr_item(w_ed + (size_t)e * 1024 * 2048, 2048, WD + (size_t)e * 2048 * 1024, 1024, q >> 6, q & 63, lane, MapId{}); }
        }
        for (int i = gtid; i < 56 * 256; i += NGT) ((u32x4*)(WIN + (size_t)1736 * 2048))[i] = (u32x4){0u, 0u, 0u, 0u};
        for (int it = gw; it < 2048; it += NGW) {
            const int h = it >> 8, ch = (it >> 7) & 1, n0 = (it & 127) * 16, c = ch * 64 + lane;
            const float* wuv = w_uv + ((size_t)h * 128 + c) * 128;
            const float* wa = w_branch + (size_t)(h * 128) * 2048 + n0;
            float a[16];
#pragma unroll
            for (int j = 0; j < 16; ++j) a[j] = 0.f;
            for (int d4 = 0; d4 < 32; ++d4) {
                const f32x4 wv = *(const f32x4*)(wuv + d4 * 4);
#pragma unroll
                for (int dd = 0; dd < 4; ++dd) {
                    const float* wr_ = wa + (size_t)(d4 * 4 + dd) * 2048;
#pragma unroll
                    for (int j4 = 0; j4 < 4; ++j4) { const f32x4 b = *(const f32x4*)(wr_ + j4 * 4); a[j4 * 4 + 0] += wv[dd] * b[0]; a[j4 * 4 + 1] += wv[dd] * b[1]; a[j4 * 4 + 2] += wv[dd] * b[2]; a[j4 * 4 + 3] += wv[dd] * b[3]; }
                }
            }
#pragma unroll
            for (int j = 0; j < 16; ++j) WCOMB[(size_t)(n0 + j) * 1024 + h * 128 + c] = (bf16_t)(pkbf(a[j], 0.f) & 0xffffu);
        }
        for (int m = gw; m < T_TOK; m += NGW) {
            const f32x4* xr = (const f32x4*)(x + (size_t)m * DMODEL) + lane; f32x4 v[8]; float ss = 0.f;
#pragma unroll
            for (int j = 0; j < 8; ++j) { v[j] = xr[64 * j]; ss += (v[j][0] * v[j][0] + v[j][1] * v[j][1]) + (v[j][2] * v[j][2] + v[j][3] * v[j][3]); }
            const float rstd = 1.0f / sqrtf(wave_sum(ss, lane) * (1.0f / DMODEL) + EPS_F);
            u32x2* o = (u32x2*)(XN + (size_t)m * DMODEL) + lane;
#pragma unroll
            for (int j = 0; j < 8; ++j) { const f32x4 gg = ((const f32x4*)g_mix)[lane + 64 * j]; u32x2 w; w.x = pkbf(v[j][0] * rstd * gg[0], v[j][1] * rstd * gg[1]); w.y = pkbf(v[j][2] * rstd * gg[2], v[j][3] * rstd * gg[3]); o[64 * j] = w; }
        }
        for (int idx = gtid; idx < SEQL * 64; idx += NGT) {
            const int pos = idx >> 6, i = idx & 63; double f = 1.0;
            for (int k = 0; k < i; ++k) f *= 0.8659643233600653;
            double s, c; sincos_d((double)pos * f, s, c);
            rot[2 * idx] = (float)c; rot[2 * idx + 1] = (float)s;
        }
        for (int i = gtid; i < 32; i += NGT) ctl[64 * i] = 0u;
        if (gtid < 2) ctl[4096 + gtid] = 0u;
        for (int i = gtid; i < MAXSLOT; i += NGT) { row_tok[i] = 0; row_gate[i] = 0.f; }
    }
    GSYNC();

    {
        PH_LOCALS
        pg8::Gemm g{XN, WIN, T_TOK, NPROJ, 2048}; pg8::StaticOrder S; S.init(T_TOK, NPROJ, G, bx);
        pg8::EpiProj E{P, rot};
        pg8::gemm_phase<pg8::EpiProj, pg8::StaticOrder, true, true>(lds, g, S, E, tid);
    }
    GSYNC();

    {
        PH_LOCALS
        const float* g_kv = IN(3);
        for (int t = gw; t < T_TOK; t += NGW) {
            const unsigned v = *(const unsigned*)(P + (size_t)t * NPROJ + C_CKV + 2 * lane);
            const float a = bflo(v), b = bfhi(v);
            const float rstd = 1.0f / sqrtf(wave_sum(a * a + b * b, lane) * (1.0f / 128.0f) + EPS_F);
            *(unsigned*)(KV + (size_t)t * 128 + 2 * lane) = pkbf(a * rstd * g_kv[2 * lane], b * rstd * g_kv[2 * lane + 1]);
        }
#if DBG_CMP == 3
        {
        u64* MASKX = (u64*)(ws + WS_SPARE);
        LAS float* qi = (LAS float*)(lds + wave * 10240); LAS float* sc = qi + 512;
        for (int t = gw; t < T_TOK; t += NGW) {
            const int b = t >> 11, q = t & 2047, ng = (q >> 6) + 1;
            { const u32x4 v = *(const u32x4*)(P + (size_t)t * NPROJ + C_QIDX + lane * 8);
              f32x4 lo4 = (f32x4){bflo(v.x), bfhi(v.x), bflo(v.y), bfhi(v.y)}, hi4 = (f32x4){bflo(v.z), bfhi(v.z), bflo(v.w), bfhi(v.w)};
              *(LAS f32x4*)(qi + lane * 8) = lo4; *(LAS f32x4*)(qi + lane * 8 + 4) = hi4; }
            float w[8];
            { const u32x4 v = *(const u32x4*)(P + (size_t)t * NPROJ + C_WIDX); w[0] = bflo(v.x); w[1] = bfhi(v.x); w[2] = bflo(v.y); w[3] = bfhi(v.y); w[4] = bflo(v.z); w[5] = bfhi(v.z); w[6] = bflo(v.w); w[7] = bfhi(v.w); }
            for (int g = 0; g < ng; ++g) {
                LAS float* qg = qi; asm volatile("" : "+v"(qg));
                const int s = g * 64 + lane; const u32x4* kr = (const u32x4*)(P + (size_t)(b * SEQL + s) * NPROJ + C_KIDX);
                float dot[8];
#pragma unroll
                for (int h = 0; h < 8; ++h) dot[h] = 0.f;
#pragma unroll
                for (int c = 0; c < 8; ++c) {
                    const u32x4 v = kr[c];
                    const f32x4 ka = (f32x4){bflo(v.x), bfhi(v.x), bflo(v.y), bfhi(v.y)}, kb = (f32x4){bflo(v.z), bfhi(v.z), bflo(v.w), bfhi(v.w)};
#pragma unroll
                    for (int h = 0; h < 8; ++h) {
                        const f32x4 qa = *(const LAS f32x4*)(qg + h * 64 + c * 8), qb = *(const LAS f32x4*)(qg + h * 64 + c * 8 + 4);
                        dot[h] += (qa[0] * ka[0] + qa[1] * ka[1]) + (qa[2] * ka[2] + qa[3] * ka[3]) + (qb[0] * kb[0] + qb[1] * kb[1]) + (qb[2] * kb[2] + qb[3] * kb[3]);
                    }
                }
                float score = 0.f;
#pragma unroll
                for (int h = 0; h < 8; ++h) score += w[h] * fmaxf(dot[h], 0.f);
                sc[s] = score * IDX_SCALE;
            }
            u64* mrow = MASKX + (size_t)t * 32;
            if (ng <= 4) { if (lane < 32) mrow[lane] = (lane < ng) ? ~0ull : 0ull; }
            else {
                unsigned lo = 0u;
                for (int bit = 31; bit >= 0; --bit) {
                    const unsigned cand = lo | (1u << bit); int cnt = 0;
                    for (int g = 0; g < ng; ++g) cnt += __popcll(__ballot(fkey(sc[g * 64 + lane]) >= cand));
                    if (cnt >= 256) lo = cand;
                }
                const unsigned tau = lo; int cgt = 0;
                for (int g = 0; g < ng; ++g) cgt += __popcll(__ballot(fkey(sc[g * 64 + lane]) > tau));
                const int need = 256 - cgt; int run = 0;
                for (int g = 0; g < ng; ++g) {
                    const unsigned key = fkey(sc[g * 64 + lane]);
                    const u64 gt = __ballot(key > tau), eq = __ballot(key == tau);
                    const u64 below = eq & ((1ull << lane) - 1ull);
                    const bool sel = (key == tau) && (run + (int)__popcll(below) < need);
                    const u64 word = gt | __ballot(sel);
                    run += (int)__popcll(eq);
                    if (lane == 0) mrow[g] = word;
                }
                if (lane >= ng && lane < 32) mrow[lane] = 0ull;
            }
        }
        }
        __syncthreads();
#endif
        typedef short bf16x8_t __attribute__((ext_vector_type(8)));
        constexpr int SCS = 2052;
        LAS float* scl = (LAS float*)lds;
        for (int ui = 0; ui < 4; ++ui) {
            const int uu = ui * 256 + ((ui & 1) ? 255 - bx : bx);
            if (uu >= 1024 || bx >= 256) break;
            const int b = uu & 7, qblk = uu >> 3, q0 = qblk * 16, t0 = b * SEQL + q0, ng = (q0 >> 6) + 1, N = ng * 64;
            if (ng <= 4) {
                for (int qq = 0; qq < 2; ++qq) { u64* mrow = MASK + (size_t)(t0 + 2 * wave + qq) * 32; if (lane < 32) mrow[lane] = (lane < ng) ? ~0ull : 0ull; }
                continue;
            }
            const int qrow = lane & 15, kg = lane >> 4;
            bf16x8_t qf[8][2]; float w[8];
            { const bf16_t* qp = P + (size_t)(t0 + qrow) * NPROJ + C_QIDX + 8 * kg;
#pragma unroll
              for (int h = 0; h < 8; ++h) { qf[h][0] = *(const bf16x8_t*)(qp + h * 64); qf[h][1] = *(const bf16x8_t*)(qp + h * 64 + 32); }
              const u32x4 v = *(const u32x4*)(P + (size_t)(t0 + qrow) * NPROJ + C_WIDX); w[0] = bflo(v.x); w[1] = bfhi(v.x); w[2] = bflo(v.y); w[3] = bfhi(v.y); w[4] = bflo(v.z); w[5] = bfhi(v.z); w[6] = bflo(v.w); w[7] = bfhi(v.w); }
            for (int kt = wave; kt < N / 16; kt += 8) {
                const int s0 = kt * 16;
                const bf16_t* kp = P + (size_t)(b * SEQL + s0 + qrow) * NPROJ + C_KIDX + 8 * kg;
                const bf16x8_t a0 = *(const bf16x8_t*)kp, a1 = *(const bf16x8_t*)(kp + 32);
                f32x4 sacc = (f32x4){0.f, 0.f, 0.f, 0.f};
#pragma unroll
                for (int h = 0; h < 8; ++h) {
                    f32x4 acc = (f32x4){0.f, 0.f, 0.f, 0.f};
                    acc = __builtin_amdgcn_mfma_f32_16x16x32_bf16(a0, qf[h][0], acc, 0, 0, 0);
                    acc = __builtin_amdgcn_mfma_f32_16x16x32_bf16(a1, qf[h][1], acc, 0, 0, 0);
                    sacc[0] += w[h] * fmaxf(acc[0], 0.f); sacc[1] += w[h] * fmaxf(acc[1], 0.f); sacc[2] += w[h] * fmaxf(acc[2], 0.f); sacc[3] += w[h] * fmaxf(acc[3], 0.f);
                }
                *(LAS f32x4*)(scl + qrow * SCS + s0 + 4 * kg) = sacc * IDX_SCALE;
            }
            __syncthreads();
#pragma unroll 1
            for (int qq = 0; qq < 2; ++qq) {
                const int q = 2 * wave + qq; const LAS float* row = scl + q * SCS;
                unsigned key[32];
#pragma unroll
                for (int j = 0; j < 32; ++j) key[j] = (j < ng) ? fkey(row[64 * j + lane]) : 0u;
                unsigned lo = 0u;
#pragma unroll 1
                for (int bit = 31; bit >= 0; --bit) {
                    const unsigned cand = lo | (1u << bit); int c = 0;
#pragma unroll
                    for (int j = 0; j < 32; ++j) c += (key[j] >= cand) ? 1 : 0;
#pragma unroll
                    for (int x = 1; x < 64; x <<= 1) c += __builtin_amdgcn_ds_bpermute((lane ^ x) << 2, c);
                    if (c >= 256) lo = cand;
                }
                const unsigned tau = lo; int cgt = 0;
#pragma unroll
                for (int j = 0; j < 32; ++j) cgt += (key[j] > tau) ? 1 : 0;
#pragma unroll
                for (int x = 1; x < 64; x <<= 1) cgt += __builtin_amdgcn_ds_bpermute((lane ^ x) << 2, cgt);
                const int need = 256 - cgt; int run = 0; u64 myword = 0ull;
#pragma unroll
                for (int j = 0; j < 32; ++j) {
                    const u64 gt = __ballot(key[j] > tau), eq = __ballot(key[j] == tau);
                    const u64 below = eq & ((1ull << lane) - 1ull);
                    const bool sel = (key[j] == tau) && (run + (int)__popcll(below) < need);
                    const u64 word = gt | __ballot(sel);
                    run += (int)__popcll(eq);
                    if (lane == j) myword = word;
                    __builtin_amdgcn_sched_barrier(0);
                }
                if (lane < 32) MASK[(size_t)(t0 + q) * 32 + lane] = myword;
            }
            __syncthreads();
        }
    }
    GSYNC();

#if DBG_CMP == 1
    {
        PH_LOCALS
        bf16_t* OAX = (bf16_t*)(ws + WS_SPARE);
        float* qv = (float*)(lds_raw + wave * 10240); float* lg = qv + 512;
        for (int it = gw; it < T_TOK * 8; it += NGW) {
            const int t = it >> 3, h = it & 7, b = t >> 11, q = t & 2047, ng = (q >> 6) + 1;
            { const unsigned v = *(const unsigned*)(P + (size_t)t * NPROJ + C_QLAT + h * 128 + 2 * lane); qv[2 * lane] = bflo(v); qv[2 * lane + 1] = bfhi(v); }
            const u64* mrow = MASK + (size_t)t * 32;
            float mx = -INFINITY;
            for (int g = 0; g < ng; ++g) {
                asm volatile("" ::: "memory");
                const u64 word = mrow[g]; float l = -INFINITY;
                if ((word >> lane) & 1ull) {
                    const u32x4* kr = (const u32x4*)(KV + (size_t)(b * SEQL + g * 64 + lane) * 128);
                    float d0 = 0.f, d1 = 0.f, d2 = 0.f, d3 = 0.f;
#pragma unroll
                    for (int c = 0; c < 16; ++c) { const u32x4 v = kr[c]; const f32x4 qa = *(const f32x4*)(qv + 8 * c), qb = *(const f32x4*)(qv + 8 * c + 4);
                        d0 += qa[0] * bflo(v.x) + qb[0] * bflo(v.z); d1 += qa[1] * bfhi(v.x) + qb[1] * bfhi(v.z); d2 += qa[2] * bflo(v.y) + qb[2] * bflo(v.w); d3 += qa[3] * bfhi(v.y) + qb[3] * bfhi(v.w); }
                    l = ((d0 + d1) + (d2 + d3)) * ATT_SCALE;
                }
                lg[g * 64 + lane] = l; mx = fmaxf(mx, l);
            }
            mx = wave_max(mx, lane);
            float o0 = 0.f, o1 = 0.f, sum = 0.f;
            for (int g = 0; g < ng; ++g) {
                const u64 wv = mrow[g];
                u64 word = ((u64)__builtin_amdgcn_readfirstlane((unsigned)(wv >> 32)) << 32) | (u64)__builtin_amdgcn_readfirstlane((unsigned)wv);
                while (word) {
                    const int j = __builtin_ctzll(word); word &= word - 1ull;
                    const int s = g * 64 + j; const float pj = __expf(lg[s] - mx);
                    const unsigned v = *(const unsigned*)(KV + (size_t)(b * SEQL + s) * 128 + 2 * lane);
                    o0 += pj * bflo(v); o1 += pj * bfhi(v); sum += pj;
                }
            }
            const float inv = 1.0f / sum;
            *(unsigned*)(OAX + (size_t)t * 1024 + h * 128 + 2 * lane) = pkbf(o0 * inv, o1 * inv);
        }
    }
    __syncthreads();
#endif
#if DBG_CMP == 2
    {
        PH_LOCALS
        const float* g_ret = IN(5);
        bf16_t* OBX = (bf16_t*)(ws + WS_SPARE);
        float* qv = (float*)(lds_raw + wave * 10240); float* lg = qv + 512; float* wl = lg;
        for (int it = gw; it < T_TOK * 8; it += NGW) {
            const int t = it >> 3, h = it & 7, b = t >> 11, n = t & 2047, ng = (n >> 6) + 1;
            const float lgam = (h == 0) ? -0.04580368961312479f : (h == 1) ? -0.02272007650008353f : (h == 2) ? -0.011315313227834146f : (h == 3) ? -0.005646563141142063f :
                               (h == 4) ? -0.0028205190623786626f : (h == 5) ? -0.0014095702546713536f : (h == 6) ? -0.0007046129765893727f : -0.0003522634716290214f;
            { const unsigned v = *(const unsigned*)(P + (size_t)t * NPROJ + C_QR + h * 128 + 2 * lane); qv[2 * lane] = bflo(v); qv[2 * lane + 1] = bfhi(v); }
            float o0 = 0.f, o1 = 0.f;
            for (int g = 0; g < ng; ++g) {
                asm volatile("" ::: "memory");
                const int m = g * 64 + lane;
                const u32x4* kr = (const u32x4*)(P + (size_t)(b * SEQL + m) * NPROJ + C_KR + h * 128);
                float d0 = 0.f, d1 = 0.f, d2 = 0.f, d3 = 0.f;
#pragma unroll
                for (int c = 0; c < 16; ++c) { const u32x4 v = kr[c]; const f32x4 qa = *(const f32x4*)(qv + 8 * c), qb = *(const f32x4*)(qv + 8 * c + 4);
                    d0 += qa[0] * bflo(v.x) + qb[0] * bflo(v.z); d1 += qa[1] * bfhi(v.x) + qb[1] * bfhi(v.z); d2 += qa[2] * bflo(v.y) + qb[2] * bflo(v.w); d3 += qa[3] * bfhi(v.y) + qb[3] * bfhi(v.w); }
                const float dot = (d0 + d1) + (d2 + d3);
                wl[lane] = (m <= n) ? dot * exp2f((float)(n - m) * lgam) : 0.f;
                const int jmax = (g == ng - 1) ? (n & 63) : 63;
                for (int j = 0; j <= jmax; ++j) {
                    const float wj = wl[j];
                    const unsigned v = *(const unsigned*)(P + (size_t)(b * SEQL + g * 64 + j) * NPROJ + C_VR + h * 128 + 2 * lane);
                    o0 += wj * bflo(v); o1 += wj * bfhi(v);
                }
            }
            const float mu = wave_sum(o0 + o1, lane) * (1.0f / 128.0f); const float e0 = o0 - mu, e1 = o1 - mu;
            const float rs = 1.0f / sqrtf(wave_sum(e0 * e0 + e1 * e1, lane) * (1.0f / 128.0f) + EPS_F);
            const unsigned gv = *(const unsigned*)(P + (size_t)t * NPROJ + C_GR + h * 128 + 2 * lane);
            const float y0 = siluf_(bflo(gv)) * e0 * rs * g_ret[h * 128 + 2 * lane], y1 = siluf_(bfhi(gv)) * e1 * rs * g_ret[h * 128 + 2 * lane + 1];
            *(unsigned*)(OBX + (size_t)t * 1024 + h * 128 + 2 * lane) = pkbf(y0, y1);
        }
    }
    __syncthreads();
#endif
    {
        PH_LOCALS
        for (int pr = bx; pr < 256; pr += G) {
            const int b = pr >> 5, i = pr & 31;
#pragma unroll 1
            for (int uu = 0; uu < 2; ++uu) {
                const int qb = uu ? 63 - i : i; const int t0 = b * SEQL + qb * 32;
                fa::UnitArgs U; U.Q = P + (size_t)t0 * NPROJ + C_QLAT; U.ldq = NPROJ; U.K = KV + (size_t)b * SEQL * 128; U.V = U.K; U.ldk = 128; U.mask = MASK + (size_t)t0 * 32;
                U.ntiles = (qb >> 1) + 1; U.n0 = 0; U.lgam = 0.f;
                fa::f32x16 o[4]; float l_reg;
                fa::unit_body<0>((LAS char*)lds, U, tid, o, l_reg);
                const int r32 = lane & 31, hi = lane >> 5;
                LAS float* li_l = (LAS float*)(lds + fa::OFF_WS) + wave * 64;
                if (hi == 0) li_l[r32] = l_reg;
                asm volatile("s_waitcnt lgkmcnt(0)" ::: "memory");
#pragma unroll
                for (int r = 0; r < 16; ++r) {
                    const int orow = fa::crow(r, hi); const float rl = __builtin_amdgcn_rcpf(li_l[orow]);
                    bf16_t* op = OA + (size_t)(t0 + orow) * 1024 + wave * 128 + r32;
#pragma unroll
                    for (int d0 = 0; d0 < 4; ++d0) op[d0 * 32] = (bf16_t)(pkbf(o[d0][r] * rl, 0.f) & 0xffffu);
                }
                __syncthreads();
            }
        }
    }
    {
        PH_LOCALS
        const float* g_ret = IN(5);
        for (int pr = bx; pr < 256; pr += G) {
            const int bh = pr >> 2, i = pr & 3, b = bh >> 3, h = bh & 7;
            const float lgam = (h == 0) ? -0.04580368961312479f : (h == 1) ? -0.02272007650008353f : (h == 2) ? -0.011315313227834146f : (h == 3) ? -0.005646563141142063f :
                               (h == 4) ? -0.0028205190623786626f : (h == 5) ? -0.0014095702546713536f : (h == 6) ? -0.0007046129765893727f : -0.0003522634716290214f;
#pragma unroll 1
            for (int uu = 0; uu < 2; ++uu) {
                const int qb = uu ? 7 - i : i; const int n0 = qb * 256;
                fa::UnitArgs U; U.Q = P + (size_t)(b * SEQL + n0) * NPROJ + C_QR + h * 128; U.ldq = NPROJ;
                U.K = P + (size_t)(b * SEQL) * NPROJ + C_KR + h * 128; U.V = P + (size_t)(b * SEQL) * NPROJ + C_VR + h * 128; U.ldk = NPROJ; U.mask = nullptr;
                U.ntiles = 4 * (qb + 1); U.n0 = n0; U.lgam = lgam;
                fa::f32x16 o[4]; float l_reg;
                fa::unit_body<1>((LAS char*)lds, U, tid, o, l_reg);
                const int r32 = lane & 31, hi = lane >> 5;
                float gr[4];
#pragma unroll
                for (int d0 = 0; d0 < 4; ++d0) gr[d0] = g_ret[h * 128 + d0 * 32 + r32];
#pragma unroll
                for (int r = 0; r < 16; ++r) {
                    float s = (o[0][r] + o[1][r]) + (o[2][r] + o[3][r]);
#pragma unroll
                    for (int x = 1; x < 32; x <<= 1) s += shx(s, lane, x);
                    const float mu = s * (1.0f / 128.0f);
                    const float e0 = o[0][r] - mu, e1 = o[1][r] - mu, e2 = o[2][r] - mu, e3 = o[3][r] - mu;
                    float q = (e0 * e0 + e1 * e1) + (e2 * e2 + e3 * e3);
#pragma unroll
                    for (int x = 1; x < 32; x <<= 1) q += shx(q, lane, x);
                    const float rs = 1.0f / sqrtf(q * (1.0f / 128.0f) + EPS_F);
                    const size_t tok = (size_t)(b * SEQL + n0 + wave * 32 + fa::crow(r, hi));
                    const bf16_t* gp = P + tok * NPROJ + C_GR + h * 128 + r32; bf16_t* op = OB + tok * 1024 + h * 128 + r32;
                    op[0] = (bf16_t)(pkbf(siluf_(bflo((unsigned)gp[0])) * e0 * rs * gr[0], 0.f) & 0xffffu);
                    op[32] = (bf16_t)(pkbf(siluf_(bflo((unsigned)gp[32])) * e1 * rs * gr[1], 0.f) & 0xffffu);
                    op[64] = (bf16_t)(pkbf(siluf_(bflo((unsigned)gp[64])) * e2 * rs * gr[2], 0.f) & 0xffffu);
                    op[96] = (bf16_t)(pkbf(siluf_(bflo((unsigned)gp[96])) * e3 * rs * gr[3], 0.f) & 0xffffu);
                }
                __syncthreads();
            }
        }
    }
#if DBG_CMP
    GSYNC();
    {
        PH_LOCALS
        const bf16_t* A_ = (DBG_CMP == 1) ? OA : OB; const bf16_t* R_ = (const bf16_t*)(ws + WS_SPARE);
        float sd = 0.f, sr = 0.f;
#if DBG_CMP == 3
        for (size_t i = (size_t)gtid; i < (size_t)T_TOK * 32; i += (size_t)NGT) { const u64 a = MASK[i], r = ((const u64*)(ws + WS_SPARE))[i]; sd += (float)__popcll(a ^ r); sr += 100.0f * (float)__popcll(r); }
#else
        for (size_t i = (size_t)gtid; i < (size_t)T_TOK * 1024 / 2; i += (size_t)NGT) {
            const unsigned a = ((const unsigned*)A_)[i], r = ((const unsigned*)R_)[i];
            const float d0 = bflo(a) - bflo(r), d1 = bfhi(a) - bfhi(r); sd += d0 * d0 + d1 * d1; sr += bflo(r) * bflo(r) + bfhi(r) * bfhi(r);
        }
#endif
        sd = wave_sum(sd, lane); sr = wave_sum(sr, lane);
        if (lane == 0) { atomicAdd((float*)(ctl + 4096), sd); atomicAdd((float*)(ctl + 4097), sr); }
    }
#endif
    GSYNC();

    {
        PH_LOCALS
        pg8::Gemm g{OA, WCOMB, T_TOK, DMODEL, 1024}; pg8::StaticOrder S; S.init(T_TOK, DMODEL, G, bx);
        pg8::EpiMerge<0> E{P, nullptr, BA};
        pg8::gemm_phase<pg8::EpiMerge<0>, pg8::StaticOrder, true, true>(lds, g, S, E, tid);
    }
    GSYNC();
    {
        PH_LOCALS
        pg8::Gemm g{OB, WB, T_TOK, DMODEL, 1024}; pg8::StaticOrder S; S.init(T_TOK, DMODEL, G, bx);
        pg8::EpiMerge<1> E{P, BA, MIXED};
        pg8::gemm_phase<pg8::EpiMerge<1>, pg8::StaticOrder, true, true>(lds, g, S, E, tid);
    }
    GSYNC();
    {
        PH_LOCALS
        const float* x = IN(0);
        pg8::Gemm g{MIXED, WO, T_TOK, DMODEL, 2048}; pg8::StaticOrder S; S.init(T_TOK, DMODEL, G, bx);
        pg8::EpiRes E{x, out};
        pg8::gemm_phase<pg8::EpiRes, pg8::StaticOrder, true, true>(lds, g, S, E, tid);
    }
    GSYNC();

    {
    PH_LOCALS
    const float* g_ffn = IN(8); const float* w_rg = IN(9); const float* b_rg = IN(10); const float* w_re = IN(11); const float* b_re = IN(12);
    for (int t = gw; t < T_TOK; t += NGW) {
        const f32x4* hr = (const f32x4*)(out + (size_t)t * DMODEL) + lane; f32x4 v[8]; float ss = 0.f;
#pragma unroll
        for (int j = 0; j < 8; ++j) { v[j] = hr[64 * j]; ss += (v[j][0] * v[j][0] + v[j][1] * v[j][1]) + (v[j][2] * v[j][2] + v[j][3] * v[j][3]); }
        const float rstd = 1.0f / sqrtf(wave_sum(ss, lane) * (1.0f / DMODEL) + EPS_F);
        u32x2* o = (u32x2*)(TN + (size_t)t * DMODEL) + lane;
        const float* wrg_l = hide_p(w_rg); const float* wre_l = hide_p(w_re);
        float ga[4] = {0.f, 0.f, 0.f, 0.f};
#pragma unroll
        for (int j = 0; j < 8; ++j) {
            const f32x4 gg = ((const f32x4*)g_ffn)[lane + 64 * j]; v[j] = v[j] * gg;
            u32x2 w; w.x = pkbf(v[j][0] * rstd, v[j][1] * rstd); w.y = pkbf(v[j][2] * rstd, v[j][3] * rstd); o[64 * j] = w;
#pragma unroll
            for (int i = 0; i < 4; ++i) { const f32x4 wr_ = *(const f32x4*)(wrg_l + (unsigned)((4 * (lane + 64 * j) + i) * 4)); ga[0] += v[j][i] * wr_[0]; ga[1] += v[j][i] * wr_[1]; ga[2] += v[j][i] * wr_[2]; ga[3] += v[j][i] * wr_[3]; }
        }
        float gl[4];
#pragma unroll
        for (int k = 0; k < 4; ++k) gl[k] = wave_sum(ga[k], lane) * rstd + b_rg[k];
        int grp = 0; float gmx = gl[0];
#pragma unroll
        for (int k = 1; k < 4; ++k) if (gl[k] > gmx) { gmx = gl[k]; grp = k; }
        float gz = 0.f;
#pragma unroll
        for (int k = 0; k < 4; ++k) gz += __expf(gl[k] - gmx);
        const float p_grp = 1.0f / gz;
        float ea[8] = {0.f, 0.f, 0.f, 0.f, 0.f, 0.f, 0.f, 0.f};
#pragma unroll
        for (int j = 0; j < 8; ++j)
#pragma unroll
            for (int i = 0; i < 4; ++i) {
                const f32x4* we = (const f32x4*)(wre_l + (unsigned)((4 * (lane + 64 * j) + i) * 32 + grp * 8)); const f32x4 a = we[0], b2 = we[1];
                ea[0] += v[j][i] * a[0]; ea[1] += v[j][i] * a[1]; ea[2] += v[j][i] * a[2]; ea[3] += v[j][i] * a[3];
                ea[4] += v[j][i] * b2[0]; ea[5] += v[j][i] * b2[1]; ea[6] += v[j][i] * b2[2]; ea[7] += v[j][i] * b2[3];
            }
        float el[8];
#pragma unroll
        for (int k = 0; k < 8; ++k) el[k] = wave_sum(ea[k], lane) * rstd + b_re[grp * 8 + k];
        int i1 = 0; float m1 = el[0];
#pragma unroll
        for (int k = 1; k < 8; ++k) if (el[k] > m1) { m1 = el[k]; i1 = k; }
        int i2 = -1; float m2 = -INFINITY;
#pragma unroll
        for (int k = 0; k < 8; ++k) if (k != i1 && el[k] > m2) { m2 = el[k]; i2 = k; }
        const float e2 = __expf(m2 - m1); const float den = 1.0f / (1.0f + e2);
        const float g1 = p_grp * den, g2 = p_grp * e2 * den;
        if (lane == 0) {
            const int ex1 = grp * 8 + i1, ex2 = grp * 8 + i2;
            const unsigned r1 = atomicAdd(ctl + 64 * ex1, 1u), r2 = atomicAdd(ctl + 64 * ex2, 1u);
            asg_e[2 * t] = ex1; asg_e[2 * t + 1] = ex2; asg_r[2 * t] = (int)r1; asg_r[2 * t + 1] = (int)r2; asg_g[2 * t] = g1; asg_g[2 * t + 1] = g2;
        }
    }
    }
    GSYNC();

    LAS int* tile_start = (LAS int*)(lds + LDS_MISC);
    {
    PH_LOCALS
    if (tid == 0) {
        int acc_t = 0;
        for (int e = 0; e < 32; ++e) { tile_start[e] = acc_t; const int c = (int)__hip_atomic_load(ctl + 64 * e, __ATOMIC_RELAXED, __HIP_MEMORY_SCOPE_AGENT); acc_t += (c + 255) >> 8; }
        tile_start[32] = acc_t;
    }
    __syncthreads();
    for (int a = gw; a < 2 * T_TOK; a += NGW) {
        const int t = a >> 1; const int e = asg_e[a], rk = asg_r[a]; const int slot = tile_start[e] * 256 + rk;
        if (lane == 0) { row_tok[slot] = t; row_gate[slot] = asg_g[a]; tok_slot[a] = slot; }
        const u32x4* src = (const u32x4*)(TN + (size_t)t * DMODEL) + lane; u32x4* dst = (u32x4*)(XG + (size_t)slot * DMODEL) + lane;
#pragma unroll
        for (int j = 0; j < 4; ++j) dst[64 * j] = src[64 * j];
    }
    }
    GSYNC();

    {
        PH_LOCALS
        pg8::Gemm g{XG, WGU, MAXSLOT, 2048, 2048}; pg8::ExpertOrder S{tile_start, G, bx};
        pg8::EpiSwiglu E{HMID};
        pg8::gemm_phase<pg8::EpiSwiglu, pg8::ExpertOrder, true, true>(lds, g, S, E, tid);
    }
    GSYNC();
    {
        PH_LOCALS
        pg8::Gemm g{HMID, WD, MAXSLOT, 2048, 1024}; pg8::ExpertOrder S{tile_start, G, bx};
        pg8::EpiDown E{Y, row_gate};
        pg8::gemm_phase<pg8::EpiDown, pg8::ExpertOrder, true, true>(lds, g, S, E, tid);
    }
    GSYNC();

    {
    PH_LOCALS
    const float* g_fin = IN(16);
#if DBG_CMP
    const float dbg_scale = 1.0f + 4.0f * sqrtf(__hip_atomic_load((float*)(ctl + 4096), __ATOMIC_RELAXED, __HIP_MEMORY_SCOPE_AGENT) / __hip_atomic_load((float*)(ctl + 4097), __ATOMIC_RELAXED, __HIP_MEMORY_SCOPE_AGENT));
#else
    const float dbg_scale = 1.0f;
#endif
    for (int t = gw; t < T_TOK; t += NGW) {
        const int s0 = tok_slot[2 * t], s1 = tok_slot[2 * t + 1];
        f32x4* hr = (f32x4*)(out + (size_t)t * DMODEL) + lane; const u32x2* y0 = (const u32x2*)(Y + (size_t)s0 * DMODEL) + lane; const u32x2* y1 = (const u32x2*)(Y + (size_t)s1 * DMODEL) + lane;
        f32x4 v[8]; float ss = 0.f;
#pragma unroll
        for (int j = 0; j < 8; ++j) {
            v[j] = hr[64 * j]; const u32x2 a = y0[64 * j], b2 = y1[64 * j];
            v[j][0] += bflo(a.x) + bflo(b2.x); v[j][1] += bfhi(a.x) + bfhi(b2.x); v[j][2] += bflo(a.y) + bflo(b2.y); v[j][3] += bfhi(a.y) + bfhi(b2.y);
            ss += (v[j][0] * v[j][0] + v[j][1] * v[j][1]) + (v[j][2] * v[j][2] + v[j][3] * v[j][3]);
        }
        const float rstd = 1.0f / sqrtf(wave_sum(ss, lane) * (1.0f / DMODEL) + EPS_F);
#pragma unroll
        for (int j = 0; j < 8; ++j) { const f32x4 gg = ((const f32x4*)g_fin)[lane + 64 * j]; hr[64 * j] = v[j] * (rstd * dbg_scale) * gg; }
    }
    }
}

extern "C" void kernel_launch(void* const* d_in, const int* in_sizes, int n_in, void* d_out, int out_size, void* d_ws, size_t ws_size, hipStream_t stream) {
    static int grid_blocks = 0;
    if (grid_blocks == 0) {
        if (n_in != 17 || out_size != T_TOK * DMODEL || ws_size < WS_END) { fprintf(stderr, "kernel_launch: unexpected problem (n_in %d, out %d, ws %zu < %zu)\n", n_in, out_size, ws_size, (size_t)WS_END); grid_blocks = -1; return; }
        int dev = 0, cus = 0, per_cu = 0;
        (void)hipGetDevice(&dev);
        (void)hipDeviceGetAttribute(&cus, hipDeviceAttributeMultiprocessorCount, dev);
        if (hipFuncSetAttribute((const void*)mega_fwd, hipFuncAttributeMaxDynamicSharedMemorySize, LDS_BYTES) != hipSuccess) { fprintf(stderr, "kernel_launch: hipFuncSetAttribute failed\n"); grid_blocks = -1; return; }
        if (hipOccupancyMaxActiveBlocksPerMultiprocessor(&per_cu, (const void*)mega_fwd, 512, LDS_BYTES) != hipSuccess || per_cu < 1) { fprintf(stderr, "kernel_launch: occupancy query says %d\n", per_cu); grid_blocks = -1; return; }
        grid_blocks = cus;
        fprintf(stderr, "kernel_launch: cus %d per_cu %d grid %d ws %zu need %zu\n", cus, per_cu, grid_blocks, ws_size, (size_t)WS_END);
    }
    if (grid_blocks < 0) return;
    Params prm{};
    for (int i = 0; i < 17; ++i) prm.in[i] = (const float*)d_in[i];
    prm.out = (float*)d_out; prm.ws = (unsigned char*)d_ws;
    void* args[] = {&prm};
    hipError_t e = hipLaunchCooperativeKernel((void*)mega_fwd, dim3(grid_blocks), dim3(512), args, LDS_BYTES, stream);
    if (e != hipSuccess) fprintf(stderr, "cooperative launch failed: %s (grid %d)\n", hipGetErrorString(e), grid_blocks);
}
```

```cpp
#include <hip/hip_runtime.h>
#include <hip/hip_cooperative_groups.h>
#include <cstdio>
#include <cstdint>
namespace cg = cooperative_groups;
namespace pg8 {
#define PG8_LAS __attribute__((address_space(3)))
typedef unsigned short bf16_t;
typedef short bf16x8 __attribute__((ext_vector_type(8)));
typedef float f32x4 __attribute__((ext_vector_type(4)));
typedef unsigned u32x4 __attribute__((ext_vector_type(4)));
constexpr int BM = 256, BK = 64, HALF = 128, HTB = HALF * BK * 2  , STAGE_BYTES = 8 * HTB, NXCD = 8, WGM = 8;

__host__ __device__ __forceinline__ int lds_byte(int r, int c) { const int st = (r >> 4) * 2 + (c >> 5), rr = r & 15, cc = c & 31, ob = rr * 64 + cc * 2; return st * 1024 + (ob ^ (((ob >> 9) & 1) << 5)); }
__host__ __device__ __forceinline__ void stage_rc(int b, int& R, int& C) { const int st = b / 1024, sb = b % 1024, swz = sb ^ (((sb >> 9) & 1) << 5); R = (st >> 1) * 16 + swz / 64; C = (st & 1) * 32 + (swz % 64) / 2; }
__host__ __device__ __forceinline__ int perm32(int rho) { const int n = rho >> 4, i = rho & 15; return 8 * (i >> 2) + 4 * n + (i & 3); }

struct Unit { int pm, pn, e; };
struct Gemm { const bf16_t* A; const bf16_t* Bt; int M, N, K; };

struct StaticOrder {
    int nM, nN, nwg, G, c;
    __host__ __device__ void init(int M, int N, int G_, int c_) { nM = M / BM; nN = N / BM; nwg = nM * nN; G = G_; c = c_; }
    __host__ __device__ bool next(int i, Unit& u) const {
        const long L = (long)i * G + c; if (L >= nwg) return false;
        int wgid = (int)L; { const int q = nwg / NXCD, r = nwg % NXCD, xcd = wgid % NXCD, off = wgid / NXCD; wgid = (xcd < r ? xcd * (q + 1) : r * (q + 1) + (xcd - r) * q) + off; }
        const int nig = WGM * nN, gid = wgid / nig, fm = gid * WGM, gsz = (nM - fm) < WGM ? (nM - fm) : WGM;
        u.pm = fm + ((wgid % nig) % gsz); u.pn = (wgid % nig) / gsz; u.e = 0; return true;
    }
    __device__ __forceinline__ void a_ready(const Unit&) const {}
    __device__ __forceinline__ void done(const Unit&) const {}
};

template <class Epi, class Sched, bool ALIGN_EPI = false, bool SP2 = false>
__device__ __forceinline__ void gemm_phase(PG8_LAS unsigned char* lds, const Gemm g, const Sched& S, const Epi& E, const int tid) {
    const int wid = __builtin_amdgcn_readfirstlane(tid >> 6), lane = tid & 63, wr = wid >> 2, wc = wid & 3, fr = lane & 15, fq = lane >> 4;
    const int K = g.K, nt = K / BK;
    unsigned voffA[2], voffB[2];
#pragma unroll
    for (int i = 0; i < 2; ++i) { int R, C; stage_rc(tid * 16 + i * 8192, R, C); const int Rb = Epi::PERM ? ((R & ~31) + perm32(R & 31)) : R;
        voffA[i] = (unsigned)(R * K + C) * 2u; voffB[i] = (unsigned)(Rb * K + C) * 2u; }
    const size_t kstep = (size_t)(BK * 2);
    const size_t hstep = (size_t)HALF * K * 2;
    const size_t tstep = 2 * hstep;
    const unsigned ldsw = (unsigned)wid * 1024u;
    const int aoff = lds_byte(wr * 64 + fr, fq * 8), boff = lds_byte(wc * 32 + fr, fq * 8);
#define PG8_SA(b, h) (((b) * 2 + (h)) * HTB)
#define PG8_SB(b, h) ((4 + (b) * 2 + (h)) * HTB)
#define PG8_STAGE(bufoff, gbase, voff) do { _Pragma("unroll") for (int _i = 0; _i < 2; ++_i) \
        __builtin_amdgcn_global_load_lds((const unsigned*)((const char*)(gbase) + (voff)[_i]), (PG8_LAS unsigned*)(lds + (bufoff) + ldsw + _i * 8192), 16, 0, 0); } while (0)
#define PG8_LDA(dst, b, h) do { _Pragma("unroll") for (int m = 0; m < 4; ++m) _Pragma("unroll") for (int k = 0; k < 2; ++k) dst[m][k] = *(const PG8_LAS bf16x8*)(lds + PG8_SA(b, h) + aoff + m * 2048 + k * 1024); } while (0)
#define PG8_LDB(dst, b, h) do { _Pragma("unroll") for (int n = 0; n < 2; ++n) _Pragma("unroll") for (int k = 0; k < 2; ++k) dst[n][k] = *(const PG8_LAS bf16x8*)(lds + PG8_SB(b, h) + boff + n * 2048 + k * 1024); } while (0)
#define PG8_MMA(ai, bj, At, Bt) do { __builtin_amdgcn_s_setprio(1); _Pragma("unroll") for (int m = 0; m < 4; ++m) _Pragma("unroll") for (int n = 0; n < 2; ++n) _Pragma("unroll") for (int k = 0; k < 2; ++k) \
        acc[ai][bj][m][n] = __builtin_amdgcn_mfma_f32_16x16x32_bf16(Bt[n][k], At[m][k], acc[ai][bj][m][n], 0, 0, 0); __builtin_amdgcn_s_setprio(0); } while (0)
#define PG8_WAIT_V(n) asm volatile("s_waitcnt vmcnt(" #n ")" ::: "memory")
#define PG8_WAIT_L(n) asm volatile("s_waitcnt lgkmcnt(" #n ")" ::: "memory")
#define PG8_BAR __builtin_amdgcn_s_barrier()
#define PG8_SCHED __builtin_amdgcn_sched_barrier(0)
    Unit cur, nxt; int ui = 0;
    if (!S.next(0, cur)) return;
    f32x4 acc[2][2][4][2];
#pragma unroll
    for (int a = 0; a < 2; ++a)
#pragma unroll
        for (int b = 0; b < 2; ++b)
#pragma unroll
            for (int m = 0; m < 4; ++m)
#pragma unroll
                for (int n = 0; n < 2; ++n) acc[a][b][m][n] = (f32x4){0.f, 0.f, 0.f, 0.f};
    bf16x8 At[4][2], B0[2][2], B1[2][2];
    const size_t estep = (size_t)g.N * K * 2;
    const char* cA = (const char*)g.A + (size_t)cur.pm * tstep; const char* cB = (const char*)g.Bt + (size_t)cur.e * estep + (size_t)cur.pn * tstep;
    S.a_ready(cur);
    if constexpr (SP2) {
        PG8_STAGE(PG8_SB(0, 0), cB, voffB); PG8_STAGE(PG8_SB(0, 1), cB + hstep, voffB); PG8_STAGE(PG8_SA(0, 0), cA, voffA); PG8_STAGE(PG8_SA(0, 1), cA + hstep, voffA);
        if (wr == 1) PG8_BAR;
        PG8_WAIT_V(2); PG8_BAR;
        PG8_STAGE(PG8_SB(1, 0), cB + kstep, voffB); PG8_STAGE(PG8_SA(1, 0), cA + kstep, voffA); PG8_STAGE(PG8_SB(1, 1), cB + hstep + kstep, voffB);
        PG8_WAIT_V(6); PG8_BAR;
    } else {
        PG8_STAGE(PG8_SB(0, 0), cB, voffB); PG8_STAGE(PG8_SA(0, 0), cA, voffA); PG8_STAGE(PG8_SB(0, 1), cB + hstep, voffB); PG8_STAGE(PG8_SA(0, 1), cA + hstep, voffA);
        if (wr == 1) PG8_BAR;
        PG8_WAIT_V(4); PG8_BAR;
        PG8_STAGE(PG8_SB(1, 0), cB + kstep, voffB); PG8_STAGE(PG8_SA(1, 0), cA + kstep, voffA); PG8_STAGE(PG8_SB(1, 1), cB + hstep + kstep, voffB);
        PG8_WAIT_V(6); PG8_BAR;
    }
    for (;;) {
        const bool has_next = S.next(ui + 1, nxt);
        const char* nA = has_next ? (const char*)g.A + (size_t)nxt.pm * tstep : cA; const char* nB = has_next ? (const char*)g.Bt + (size_t)nxt.e * estep + (size_t)nxt.pn * tstep : cB;
        for (int t = 0; t < nt; t += 2) {
            const bool last = (t == nt - 2);
            const char* a1 = cA + (size_t)(t + 1) * kstep;
            const char* a2 = last ? nA : cA + (size_t)(t + 2) * kstep; const char* b2 = last ? nB : cB + (size_t)(t + 2) * kstep;
            const char* a3 = a2 + kstep; const char* b3 = b2 + kstep;
            if (last && has_next) S.a_ready(nxt);
            if constexpr (SP2) {
            PG8_LDB(B0, 0, 0); PG8_LDB(B1, 0, 1); PG8_SCHED; PG8_LDA(At, 0, 0); PG8_STAGE(PG8_SA(1, 1), a1 + hstep, voffA);
            PG8_WAIT_V(8); PG8_WAIT_L(0); PG8_BAR; PG8_MMA(0, 0, At, B0); PG8_MMA(0, 1, At, B1); PG8_BAR; PG8_SCHED;
            PG8_LDA(At, 0, 1); PG8_STAGE(PG8_SB(0, 0), b2, voffB); PG8_STAGE(PG8_SB(0, 1), b2 + hstep, voffB); PG8_STAGE(PG8_SA(0, 0), a2, voffA);
            PG8_WAIT_V(8); PG8_WAIT_L(0); PG8_BAR; PG8_MMA(1, 0, At, B0); PG8_MMA(1, 1, At, B1); PG8_BAR; PG8_SCHED;
            PG8_LDB(B0, 1, 0); PG8_LDB(B1, 1, 1); PG8_SCHED; PG8_LDA(At, 1, 0); PG8_STAGE(PG8_SA(0, 1), a2 + hstep, voffA);
            PG8_WAIT_V(8); PG8_WAIT_L(0); PG8_BAR; PG8_MMA(0, 0, At, B0); PG8_MMA(0, 1, At, B1); PG8_BAR; PG8_SCHED;
            PG8_LDA(At, 1, 1); PG8_STAGE(PG8_SB(1, 0), b3, voffB); PG8_STAGE(PG8_SB(1, 1), b3 + hstep, voffB); PG8_STAGE(PG8_SA(1, 0), a3, voffA);
            PG8_WAIT_V(8); PG8_WAIT_L(0); PG8_BAR; PG8_MMA(1, 0, At, B0); PG8_MMA(1, 1, At, B1); PG8_BAR; PG8_SCHED;
            } else {
            PG8_LDB(B0, 0, 0); PG8_SCHED; PG8_LDA(At, 0, 0); PG8_STAGE(PG8_SA(1, 1), a1 + hstep, voffA);
            PG8_WAIT_L(8); PG8_BAR; PG8_WAIT_L(0); PG8_MMA(0, 0, At, B0); PG8_BAR; PG8_SCHED;
            PG8_LDB(B1, 0, 1); PG8_STAGE(PG8_SB(0, 0), b2, voffB);
            PG8_BAR; PG8_WAIT_L(0); PG8_MMA(0, 1, At, B1); PG8_BAR;
            PG8_LDA(At, 0, 1); PG8_STAGE(PG8_SA(0, 0), a2, voffA);
            PG8_BAR; PG8_WAIT_L(0); PG8_MMA(1, 0, At, B0); PG8_BAR; PG8_SCHED;
            PG8_STAGE(PG8_SB(0, 1), b2 + hstep, voffB);
            PG8_WAIT_V(6); PG8_BAR; PG8_MMA(1, 1, At, B1); PG8_BAR;
            PG8_LDB(B0, 1, 0); PG8_SCHED; PG8_LDA(At, 1, 0); PG8_STAGE(PG8_SA(0, 1), a2 + hstep, voffA);
            PG8_WAIT_L(8); PG8_BAR; PG8_WAIT_L(0); PG8_MMA(0, 0, At, B0); PG8_BAR; PG8_SCHED;
            PG8_LDB(B1, 1, 1); PG8_STAGE(PG8_SB(1, 0), b3, voffB);
            PG8_BAR; PG8_WAIT_L(0); PG8_MMA(0, 1, At, B1); PG8_BAR;
            PG8_LDA(At, 1, 1); PG8_STAGE(PG8_SA(1, 0), a3, voffA);
            PG8_BAR; PG8_WAIT_L(0); PG8_MMA(1, 0, At, B0); PG8_BAR; PG8_SCHED;
            PG8_STAGE(PG8_SB(1, 1), b3 + hstep, voffB);
            PG8_WAIT_V(6); PG8_BAR; PG8_MMA(1, 1, At, B1); PG8_BAR;
            }
        }
        if constexpr (ALIGN_EPI) { if (wr == 0) PG8_BAR; }
        if constexpr (!Epi::AFTER_DRAIN) { E(acc, cur, wr, wc, fr, fq); S.done(cur); }
        if (!has_next) break;
#pragma unroll
        for (int a = 0; a < 2; ++a)
#pragma unroll
            for (int b = 0; b < 2; ++b)
#pragma unroll
                for (int m = 0; m < 4; ++m)
#pragma unroll
                    for (int n = 0; n < 2; ++n) acc[a][b][m][n] = (f32x4){0.f, 0.f, 0.f, 0.f};
        cur = nxt; cA = nA; cB = nB; ++ui;
        if constexpr (ALIGN_EPI) { if (wr == 1) PG8_BAR; }
    }
    PG8_WAIT_V(0);
    if constexpr (!ALIGN_EPI) { if (wr == 0) PG8_BAR; }
    PG8_BAR;
    if constexpr (Epi::AFTER_DRAIN) { E.fused(acc, cur, wr, wc, fr, fq, lds, wid, lane); S.done(cur); }
#undef PG8_SA
#undef PG8_SB
#undef PG8_STAGE
#undef PG8_LDA
#undef PG8_LDB
#undef PG8_MMA
#undef PG8_WAIT_V
#undef PG8_WAIT_L
#undef PG8_BAR
#undef PG8_SCHED
}
}

#ifndef DBG_CMP
#define DBG_CMP 0
#endif
#define LAS __attribute__((address_space(3)))
typedef unsigned short bf16_t;
typedef float f32x4 __attribute__((ext_vector_type(4)));
typedef unsigned u32x4 __attribute__((ext_vector_type(4)));
typedef unsigned u32x2 __attribute__((ext_vector_type(2)));
typedef unsigned long long u64;

constexpr int T_TOK = 16384, DMODEL = 2048, SEQL = 2048;
constexpr int NPROJ = 9984;
constexpr int C_QLAT = 0, C_CKV = 1024, C_QIDX = 1152, C_KIDX = 1664, C_WIDX = 1728, C_QR = 1792, C_KR = 2816, C_VR = 3840, C_GR = 4864, C_GBR = 5888;
constexpr int MAXSLOT = 40960;
constexpr float EPS_F = 1e-6f;
constexpr float IDX_SCALE = 0.04419417382415922f;
constexpr float ATT_SCALE = 0.08838834764831845f;
constexpr float K_SCALE = 0.08838834764831845f;

constexpr size_t WS_CTL = 0;
constexpr size_t WS_ROT = 65536;
constexpr size_t WS_WIN = WS_ROT + 1048576;
constexpr size_t WS_WCOMB = WS_WIN + (size_t)NPROJ * 2048 * 2;
constexpr size_t WS_WB = WS_WCOMB + (size_t)2048 * 1024 * 2;
constexpr size_t WS_WO = WS_WB + (size_t)2048 * 1024 * 2;
constexpr size_t WS_WGU = WS_WO + (size_t)2048 * 2048 * 2;
constexpr size_t WS_WD = WS_WGU + (size_t)32 * 2048 * 2048 * 2;
constexpr size_t WS_P = WS_WD + (size_t)32 * 2048 * 1024 * 2;
constexpr size_t WS_HMID = WS_P;
constexpr size_t WS_Y = WS_HMID + (size_t)MAXSLOT * 1024 * 2;
constexpr size_t WS_XN = WS_P + (size_t)T_TOK * NPROJ * 2;
constexpr size_t WS_OA = WS_XN + (size_t)T_TOK * 2048 * 2;
constexpr size_t WS_OB = WS_OA + (size_t)T_TOK * 1024 * 2;
constexpr size_t WS_MIXED = WS_OB + (size_t)T_TOK * 1024 * 2;
constexpr size_t WS_SPARE = WS_MIXED + (size_t)T_TOK * 2048 * 2;
constexpr size_t WS_XG = WS_OA;
constexpr size_t WS_KV = WS_SPARE + (size_t)T_TOK * 1024 * 2;
constexpr size_t WS_MASK = WS_KV + (size_t)T_TOK * 128 * 2;
constexpr size_t WS_MISC = WS_MASK + (size_t)T_TOK * 256;
constexpr size_t WS_END = WS_MISC + 1048576;
static_assert(WS_Y + (size_t)MAXSLOT * 2048 * 2 <= WS_XN, "HMID + Y must fit in P");
static_assert(WS_XG + (size_t)MAXSLOT * 2048 * 2 <= WS_KV, "XG must fit in OA..SPARE");
static_assert(WS_END <= (size_t)1073741824, "workspace budget");
constexpr int MI_ROWTOK = 0, MI_ROWGATE = MAXSLOT, MI_TOKSLOT = 2 * MAXSLOT, MI_ASGE = MI_TOKSLOT + 2 * T_TOK, MI_ASGR = MI_ASGE + 2 * T_TOK, MI_ASGG = MI_ASGR + 2 * T_TOK;
static_assert((size_t)(MI_ASGG + 2 * T_TOK) * 4 <= 1048576, "misc budget");
constexpr int LDS_BYTES = 136 * 1024;
constexpr int LDS_MISC = 132 * 1024;

__device__ __forceinline__ float bflo(unsigned w) { return __uint_as_float(w << 16); }
__device__ __forceinline__ float bfhi(unsigned w) { return __uint_as_float(w & 0xffff0000u); }
__device__ __forceinline__ unsigned pkbf(float lo, float hi) { unsigned r; asm volatile("v_cvt_pk_bf16_f32 %0, %1, %2" : "=v"(r) : "v"(lo), "v"(hi)); return r; }
__device__ __forceinline__ int hide_i(int v) { asm volatile("" : "+v"(v)); return v; }
template <class Tp> __device__ __forceinline__ Tp* hide_p(Tp* q) { asm volatile("" : "+s"(q)); return q; }
__device__ __forceinline__ float shx(float v, int lane, int o) { return __int_as_float(__builtin_amdgcn_ds_bpermute((lane ^ o) << 2, __float_as_int(v))); }
__device__ __forceinline__ float wave_sum(float v, int lane) {
#pragma unroll
    for (int o = 1; o < 64; o <<= 1) v += shx(v, lane, o);
    return v;
}
__device__ __forceinline__ float wave_max(float v, int lane) {
#pragma unroll
    for (int o = 1; o < 64; o <<= 1) v = fmaxf(v, shx(v, lane, o));
    return v;
}
__device__ __forceinline__ float sigmoidf_(float x) { return __builtin_amdgcn_rcpf(1.0f + __expf(-x)); }
__device__ __forceinline__ float siluf_(float x) { return x * sigmoidf_(x); }
__device__ __forceinline__ unsigned fkey(float f) { const unsigned u = __float_as_uint(f + 0.0f); return (u & 0x80000000u) ? ~u : (u | 0x80000000u); }


#define XB_TMO      128
#define XB_XCNT(j)  (256  + 64 * (j))
#define XB_XSUB(j)  (1280 + 64 * (j))
#define XB_XGEN(j)  (2304 + 64 * (j))
#define XB_TOP      3328
#define XB_TOPGEN   3392
#define XCD_BAR_WORDS 3456
#define XB_SPIN_CAP (1u << 18)
__device__ __forceinline__ unsigned xb_ld(unsigned* p)              { return __hip_atomic_load(p, __ATOMIC_RELAXED, __HIP_MEMORY_SCOPE_AGENT); }
__device__ __forceinline__ unsigned xb_add(unsigned* p, unsigned v) { return __hip_atomic_fetch_add(p, v, __ATOMIC_RELAXED, __HIP_MEMORY_SCOPE_AGENT); }
__device__ __forceinline__ unsigned xb_xcc_id() { return (unsigned)__builtin_amdgcn_s_getreg((3 << 11) | 20) & 0xFu; }
#define XB_SPIN(cond, bar) do { unsigned _sp = 0; while (cond) { __builtin_amdgcn_s_sleep(1); \
    if ((++_sp & 255u) == 0u) { if (xb_ld(&(bar)[XB_TMO])) break; if (_sp > XB_SPIN_CAP) { atomicAdd(&(bar)[XB_TMO], 1u); break; } } } } while (0)
struct XcdBarrier { unsigned* bar; unsigned x; volatile __attribute__((address_space(3))) unsigned* st; };
__device__ __forceinline__ void xcd_barrier_complete(unsigned* bar, unsigned x, unsigned& nloc, unsigned& nx) {
    const unsigned G = gridDim.x * gridDim.y * gridDim.z;
    unsigned sum, cnt, mine, sp = 0u;
    for (;;) {
        sum = 0u; cnt = 0u; mine = 0u;
#pragma unroll
        for (unsigned j = 0; j < 16; ++j) { const unsigned c = xb_ld(&bar[XB_XCNT(j)]); sum += c; cnt += (c > 0u) ? 1u : 0u; mine = (j == x) ? c : mine; }
        if (sum == G) break;
        __builtin_amdgcn_s_sleep(1);
        if ((++sp & 255u) == 0u) { if (xb_ld(&bar[XB_TMO])) break; if (sp > XB_SPIN_CAP) { atomicAdd(&bar[XB_TMO], 1u); break; } }
    }
    nloc = mine > 0u ? mine : 1u; nx = cnt > 0u ? cnt : 1u;
}
__device__ __forceinline__ void xcd_barrier(const XcdBarrier& b, int tid) {
    asm volatile("s_waitcnt vmcnt(0)" ::: "memory");
    __syncthreads();
    if (tid == 0) {
        unsigned* bar = b.bar;
        __builtin_amdgcn_s_waitcnt(0);
        unsigned nloc = b.st[0], nx = b.st[1];
        if (nloc == 0u) { xcd_barrier_complete(bar, b.x, nloc, nx); b.st[0] = nloc; b.st[1] = nx; }
        const unsigned old = xb_add(&bar[XB_XSUB(b.x)], 1u);
        const unsigned gen = old / nloc;
        if (old + 1u == (gen + 1u) * nloc) {
            __builtin_amdgcn_fence(__ATOMIC_RELEASE, "agent");
            asm volatile("s_waitcnt vmcnt(0)" ::: "memory");
            const unsigned og = xb_add(&bar[XB_TOP], 1u);
            const unsigned tg = og / nx;
            if (og + 1u == (tg + 1u) * nx) xb_add(&bar[XB_TOPGEN], 1u);
            else XB_SPIN(xb_ld(&bar[XB_TOPGEN]) == tg, bar);
            __builtin_amdgcn_fence(__ATOMIC_ACQUIRE, "agent");
            xb_add(&bar[XB_XGEN(b.x)], 1u);
            asm volatile("s_waitcnt vmcnt(0)" ::: "memory");
        } else {
            XB_SPIN(xb_ld(&bar[XB_XGEN(b.x)]) == gen, bar);
            __builtin_amdgcn_fence(__ATOMIC_ACQUIRE, "agent");
            asm volatile("s_waitcnt vmcnt(0)" ::: "memory");
        }
    }
    __syncthreads();
}

namespace fa {
using bf16x8 = __attribute__((ext_vector_type(8))) short;
using s16x4  = __attribute__((ext_vector_type(4))) short;
using f32x16 = __attribute__((ext_vector_type(16))) float;
constexpr int TILE_B = 64 * 128 * 2;
constexpr int OFF_V = 0, OFF_K = 2 * TILE_B, OFF_M = 4 * TILE_B, OFF_WS = OFF_M + 2 * 256, LDS_NEED = OFF_WS + 8 * 256;
#define FA_KSWZ(row, colB) ((row) * 256 + ((colB) ^ (((row) & 7) << 4)))
#define FA_SBAR() __builtin_amdgcn_sched_barrier(0)
__device__ __forceinline__ int crow(int r, int hi) { return (r & 3) + 8 * (r >> 2) + 4 * hi; }
__device__ __forceinline__ int v_st(int k, int c) { const int kk = (k & ~0xC) | ((k & 4) << 1) | ((k & 8) >> 1); return ((kk >> 3) * 4 + (c >> 5)) * 512 + ((kk & 7) * 32 + (c & 31)) * 2; }
__device__ __forceinline__ int v_rd_base(int lane) { return ((lane & 3) << 3) | (((lane >> 2) & 3) << 6) | (((lane >> 4) & 1) << 5) | (((lane >> 5) & 1) << 8); }
constexpr int v_rd_off(int d0, int ks, int half) { return d0 * 512 + ks * 4096 + half * 2048; }
template <int OFF> __device__ __forceinline__ s16x4 tr_read(int vb) { s16x4 r; asm volatile("ds_read_b64_tr_b16 %0, %1 offset:%2" : "=&v"(r) : "v"(vb), "i"(OFF) : "memory"); return r; }
template <int D0> __device__ __forceinline__ void pv_one(f32x16& od, int vb, bf16x8 pa0, bf16x8 pa1, bf16x8 pa2, bf16x8 pa3) {
    const s16x4 l0 = tr_read<v_rd_off(D0, 0, 0)>(vb), h0 = tr_read<v_rd_off(D0, 0, 1)>(vb), l1 = tr_read<v_rd_off(D0, 1, 0)>(vb), h1 = tr_read<v_rd_off(D0, 1, 1)>(vb);
    const s16x4 l2 = tr_read<v_rd_off(D0, 2, 0)>(vb), h2 = tr_read<v_rd_off(D0, 2, 1)>(vb), l3 = tr_read<v_rd_off(D0, 3, 0)>(vb), h3 = tr_read<v_rd_off(D0, 3, 1)>(vb);
    asm volatile("s_waitcnt lgkmcnt(0)" ::: "memory"); FA_SBAR();
#define FA_PK(L, H) (bf16x8){L[0], L[1], L[2], L[3], H[0], H[1], H[2], H[3]}
    od = __builtin_amdgcn_mfma_f32_32x32x16_bf16(pa0, FA_PK(l0, h0), od, 0, 0, 0);
    od = __builtin_amdgcn_mfma_f32_32x32x16_bf16(pa1, FA_PK(l1, h1), od, 0, 0, 0);
    od = __builtin_amdgcn_mfma_f32_32x32x16_bf16(pa2, FA_PK(l2, h2), od, 0, 0, 0);
    od = __builtin_amdgcn_mfma_f32_32x32x16_bf16(pa3, FA_PK(l3, h3), od, 0, 0, 0);
#undef FA_PK
}
__device__ __forceinline__ void qkt(f32x16& p0, f32x16& p1, const LAS char* Ks, const bf16x8 (&qr)[8], int r32, int hi) {
    p0 = f32x16{}; p1 = f32x16{};
#pragma unroll
    for (int d0 = 0; d0 < 8; ++d0) { const int cb = (d0 * 16 + hi * 8) * 2;
        const bf16x8 b0 = *(const LAS bf16x8*)(Ks + FA_KSWZ(r32, cb));
        const bf16x8 b1 = *(const LAS bf16x8*)(Ks + FA_KSWZ(32 + r32, cb));
        p0 = __builtin_amdgcn_mfma_f32_32x32x16_bf16(b0, qr[d0], p0, 0, 0, 0);
        p1 = __builtin_amdgcn_mfma_f32_32x32x16_bf16(b1, qr[d0], p1, 0, 0, 0); }
}
__device__ __forceinline__ void p_to_frag(const f32x16& p0, const f32x16& p1, bf16x8& pa0, bf16x8& pa1, bf16x8& pa2, bf16x8& pa3) {
#define FA_PK4(P, BASE, OUT) do { unsigned a0 = pkbf(P[BASE + 0], P[BASE + 1]), a1 = pkbf(P[BASE + 2], P[BASE + 3]);   \
    unsigned b0 = pkbf(P[BASE + 4], P[BASE + 5]), b1 = pkbf(P[BASE + 6], P[BASE + 7]);                              \
    auto r0 = __builtin_amdgcn_permlane32_swap(a0, b0, false, false); auto r1 = __builtin_amdgcn_permlane32_swap(a1, b1, false, false); \
    u32x4 w = {r0[0], r1[0], r0[1], r1[1]}; OUT = *reinterpret_cast<bf16x8*>(&w); } while (0)
    FA_PK4(p0, 0, pa0); FA_PK4(p0, 8, pa1); FA_PK4(p1, 0, pa2); FA_PK4(p1, 8, pa3);
#undef FA_PK4
}

struct UnitArgs {
    const bf16_t* Q; int ldq;
    const bf16_t* K; const bf16_t* V; int ldk;
    const u64* mask;
    int ntiles;
    int n0;
    float lgam;
};

template <int MODE>
__device__ __forceinline__ void unit_body(LAS char* L, const UnitArgs& U, int tid, f32x16 (&o)[4], float& l_out) {
    const int wid = __builtin_amdgcn_readfirstlane(tid >> 6), lane = tid & 63, r32 = lane & 31, hi = lane >> 5;
    LAS char* V_lds = L + OFF_V; LAS char* K_lds = L + OFF_K; LAS u64* M_lds = (LAS u64*)(L + OFF_M);
    LAS float* wsf = (LAS float*)(L + OFF_WS) + wid * 64; LAS float* al_l = wsf + 32;
    constexpr float C = ATT_SCALE * 1.4426950408889634f;
    float m_reg = -1e30f, l_reg = 0.f;
#pragma unroll
    for (int d = 0; d < 4; ++d) o[d] = f32x16{};
    bf16x8 qr[8];
    { const bf16_t* Qw = (MODE == 0) ? U.Q + (size_t)r32 * U.ldq + wid * 128 + hi * 8 : U.Q + (size_t)(wid * 32 + r32) * U.ldq + hi * 8;
#pragma unroll
      for (int d0 = 0; d0 < 8; ++d0) qr[d0] = *(const bf16x8*)(Qw + d0 * 16); }
    const int sr = tid >> 4, sc = (tid & 15) * 8, vst0 = v_st(sr, sc), vst1 = v_st(32 + sr, sc), kst0 = FA_KSWZ(sr, sc * 2), kst1 = FA_KSWZ(32 + sr, sc * 2);
    const int vb0 = (int)(unsigned)(size_t)V_lds + v_rd_base(lane);
    bf16x8 ks0, ks1, vs0, vs1; u64 mws = 0ull;
#define FA_SLOAD(k0) do { ks0 = *(const bf16x8*)(U.K + (size_t)((k0) + sr) * U.ldk + sc); ks1 = *(const bf16x8*)(U.K + (size_t)((k0) + 32 + sr) * U.ldk + sc); \
        if (MODE == 1) { vs0 = *(const bf16x8*)(U.V + (size_t)((k0) + sr) * U.ldk + sc); vs1 = *(const bf16x8*)(U.V + (size_t)((k0) + 32 + sr) * U.ldk + sc); } \
        if (MODE == 0 && tid < 32) mws = U.mask[(size_t)tid * 32 + ((k0) >> 6)]; } while (0)
#define FA_SWRITE(b) do { *(LAS bf16x8*)(K_lds + (b) * TILE_B + kst0) = ks0; *(LAS bf16x8*)(K_lds + (b) * TILE_B + kst1) = ks1; \
        *(LAS bf16x8*)(V_lds + (b) * TILE_B + vst0) = (MODE == 1) ? vs0 : ks0; *(LAS bf16x8*)(V_lds + (b) * TILE_B + vst1) = (MODE == 1) ? vs1 : ks1; \
        if (MODE == 0 && tid < 32) M_lds[(b) * 32 + tid] = mws; } while (0)
    const int NT = U.ntiles;
    FA_SLOAD(0); FA_SWRITE(0);
    if (NT > 1) { FA_SLOAD(64); FA_SWRITE(1); }
    __syncthreads();
    for (int j = 0; j < NT; ++j) {
        const int b = j & 1;
        if (j + 2 < NT) FA_SLOAD((j + 2) * 64);
        f32x16 p0, p1; bf16x8 pa0, pa1, pa2, pa3;
        qkt(p0, p1, K_lds + b * TILE_B, qr, r32, hi);
        if (MODE == 0) {
            const u64 mw = M_lds[b * 32 + r32] >> (4 * hi);
            const unsigned mlo = (unsigned)mw, mhi = (unsigned)(mw >> 32);
#pragma unroll
            for (int r = 0; r < 16; ++r) { const unsigned bit = 1u << ((r & 3) + 8 * (r >> 2)); p0[r] = (mlo & bit) ? p0[r] : -INFINITY; p1[r] = (mhi & bit) ? p1[r] : -INFINITY; }
            float pmax = p0[0];
#pragma unroll
            for (int r = 1; r < 16; ++r) pmax = fmaxf(pmax, p0[r]);
#pragma unroll
            for (int r = 0; r < 16; ++r) pmax = fmaxf(pmax, p1[r]);
            { auto rr = __builtin_amdgcn_permlane32_swap(__float_as_uint(pmax), __float_as_uint(pmax), false, false); pmax = fmaxf(__uint_as_float(rr[0]), __uint_as_float(rr[1])); }
            const float mn = fmaxf(m_reg, pmax); const float alpha = __builtin_amdgcn_exp2f((m_reg - mn) * C); m_reg = mn;
            const float mnC = -mn * C; float ps = 0.f;
#pragma unroll
            for (int r = 0; r < 16; ++r) { p0[r] = __builtin_amdgcn_exp2f(fmaf(p0[r], C, mnC)); p1[r] = __builtin_amdgcn_exp2f(fmaf(p1[r], C, mnC)); ps += p0[r] + p1[r]; }
            { auto rr = __builtin_amdgcn_permlane32_swap(__float_as_uint(ps), __float_as_uint(ps), false, false); ps = __uint_as_float(rr[0]) + __uint_as_float(rr[1]); }
            l_reg = l_reg * alpha + ps;
            if (__any(alpha < 1.f)) {
                if (hi == 0) al_l[r32] = alpha;
                asm volatile("s_waitcnt lgkmcnt(0)" ::: "memory");
#pragma unroll
                for (int r = 0; r < 16; ++r) { const float a = al_l[crow(r, hi)];
#pragma unroll
                    for (int d = 0; d < 4; ++d) o[d][r] *= a; }
            }
        } else {
            const int dn = U.n0 + wid * 32 + r32 - j * 64 - 4 * hi;
            const float base = (float)dn * U.lgam;
#pragma unroll
            for (int r = 0; r < 16; ++r) { const int kk = (r & 3) + 8 * (r >> 2);
                const float f0 = __builtin_amdgcn_exp2f(base - (float)kk * U.lgam), f1 = __builtin_amdgcn_exp2f(base - (float)(kk + 32) * U.lgam);
                p0[r] = (dn >= kk) ? p0[r] * f0 : 0.f; p1[r] = (dn >= kk + 32) ? p1[r] * f1 : 0.f; }
        }
        p_to_frag(p0, p1, pa0, pa1, pa2, pa3);
        FA_SBAR();
        { const int vb = vb0 + b * TILE_B;
          pv_one<0>(o[0], vb, pa0, pa1, pa2, pa3); pv_one<1>(o[1], vb, pa0, pa1, pa2, pa3); pv_one<2>(o[2], vb, pa0, pa1, pa2, pa3); pv_one<3>(o[3], vb, pa0, pa1, pa2, pa3); }
        __syncthreads();
        if (j + 2 < NT) FA_SWRITE(b);
    }
    __syncthreads();
    l_out = l_reg;
#undef FA_SLOAD
#undef FA_SWRITE
}
}

namespace pg8 {
struct EpiProj {
    static constexpr bool PERM = true, AFTER_DRAIN = false;
    bf16_t* P; const float* rot;
    __device__ __forceinline__ void operator()(const f32x4 (&acc)[2][2][4][2], const Unit& u, int wr, int wc, int fr, int fq) const {
        const int row0 = u.pm * BM + wr * 64 + fr, colb = u.pn * BM + wc * 32 + 8 * fq;
        const bool rotq = (u.pn >= 7) && (u.pn < 15);
        const float ksc = (u.pn >= 11) ? K_SCALE : 1.0f;
        const int i0 = 16 * wc + 4 * fq;
#pragma unroll
        for (int ai = 0; ai < 2; ++ai)
#pragma unroll
            for (int m = 0; m < 4; ++m) {
                const int row = row0 + ai * HALF + m * 16; const int pos = row & (SEQL - 1);
                bf16_t* rowp = P + (size_t)row * NPROJ + colb;
                f32x4 r0 = (f32x4){1.f, 0.f, 1.f, 0.f}, r1 = r0;
                if (rotq) { const f32x4* rt = (const f32x4*)(rot + ((size_t)pos * 64 + i0) * 2); r0 = rt[0]; r1 = rt[1]; }
#pragma unroll
                for (int bj = 0; bj < 2; ++bj) {
                    f32x4 v0 = acc[ai][bj][m][0], v1 = acc[ai][bj][m][1];
                    if (rotq) {
                        f32x4 w0, w1;
                        w0[0] = (v0[0] * r0[0] - v0[1] * r0[1]) * ksc; w0[1] = (v0[0] * r0[1] + v0[1] * r0[0]) * ksc;
                        w0[2] = (v0[2] * r0[2] - v0[3] * r0[3]) * ksc; w0[3] = (v0[2] * r0[3] + v0[3] * r0[2]) * ksc;
                        w1[0] = (v1[0] * r1[0] - v1[1] * r1[1]) * ksc; w1[1] = (v1[0] * r1[1] + v1[1] * r1[0]) * ksc;
                        w1[2] = (v1[2] * r1[2] - v1[3] * r1[3]) * ksc; w1[3] = (v1[2] * r1[3] + v1[3] * r1[2]) * ksc;
                        v0 = w0; v1 = w1;
                    }
                    u32x4 w; w.x = pkbf(v0[0], v0[1]); w.y = pkbf(v0[2], v0[3]); w.z = pkbf(v1[0], v1[1]); w.w = pkbf(v1[2], v1[3]);
                    *(u32x4*)(rowp + bj * HALF) = w;
                }
            }
    }
};
template <int WHICH> struct EpiMerge {
    static constexpr bool PERM = true, AFTER_DRAIN = false;
    const bf16_t* P; const bf16_t* BA; bf16_t* O;
    __device__ __forceinline__ void operator()(const f32x4 (&acc)[2][2][4][2], const Unit& u, int wr, int wc, int fr, int fq) const {
        const int row0 = u.pm * BM + wr * 64 + fr, colb = u.pn * BM + wc * 32 + 8 * fq;
#pragma unroll
        for (int ai = 0; ai < 2; ++ai)
#pragma unroll
            for (int m = 0; m < 4; ++m) {
                const int row = row0 + ai * HALF + m * 16;
#pragma unroll
                for (int bj = 0; bj < 2; ++bj) {
                    const int col = colb + bj * HALF;
                    const u32x4 g = *(const u32x4*)(P + (size_t)row * NPROJ + C_GBR + WHICH * DMODEL + col);
                    const f32x4 v0 = acc[ai][bj][m][0], v1 = acc[ai][bj][m][1];
                    float o[8];
                    o[0] = sigmoidf_(bflo(g.x)) * v0[0]; o[1] = sigmoidf_(bfhi(g.x)) * v0[1]; o[2] = sigmoidf_(bflo(g.y)) * v0[2]; o[3] = sigmoidf_(bfhi(g.y)) * v0[3];
                    o[4] = sigmoidf_(bflo(g.z)) * v1[0]; o[5] = sigmoidf_(bfhi(g.z)) * v1[1]; o[6] = sigmoidf_(bflo(g.w)) * v1[2]; o[7] = sigmoidf_(bfhi(g.w)) * v1[3];
                    if (WHICH == 1) {
                        const u32x4 a = *(const u32x4*)(BA + (size_t)row * DMODEL + col);
                        o[0] += bflo(a.x); o[1] += bfhi(a.x); o[2] += bflo(a.y); o[3] += bfhi(a.y); o[4] += bflo(a.z); o[5] += bfhi(a.z); o[6] += bflo(a.w); o[7] += bfhi(a.w);
                    }
                    u32x4 w; w.x = pkbf(o[0], o[1]); w.y = pkbf(o[2], o[3]); w.z = pkbf(o[4], o[5]); w.w = pkbf(o[6], o[7]);
                    *(u32x4*)(O + (size_t)row * DMODEL + col) = w;
                }
            }
    }
};
struct EpiRes {
    static constexpr bool PERM = false, AFTER_DRAIN = false;
    const float* X; float* O;
    __device__ __forceinline__ void operator()(const f32x4 (&acc)[2][2][4][2], const Unit& u, int wr, int wc, int fr, int fq) const {
        const int row0 = u.pm * BM + wr * 64 + fr, col0 = u.pn * BM + wc * 32 + 4 * fq;
#pragma unroll
        for (int ai = 0; ai < 2; ++ai)
#pragma unroll
            for (int m = 0; m < 4; ++m) {
                const size_t off = (size_t)(row0 + ai * HALF + m * 16) * DMODEL + col0;
#pragma unroll
                for (int bj = 0; bj < 2; ++bj)
#pragma unroll
                    for (int n = 0; n < 2; ++n) { const f32x4 xv = *(const f32x4*)(X + off + bj * HALF + n * 16); *(f32x4*)(O + off + bj * HALF + n * 16) = xv + acc[ai][bj][m][n]; }
            }
    }
};
struct EpiSwiglu {
    static constexpr bool PERM = true, AFTER_DRAIN = false;
    bf16_t* H;
    __device__ __forceinline__ void operator()(const f32x4 (&acc)[2][2][4][2], const Unit& u, int wr, int wc, int fr, int fq) const {
        const int row0 = u.pm * BM + wr * 64 + fr, col = u.pn * HALF + wc * 32 + 8 * fq;
#pragma unroll
        for (int ai = 0; ai < 2; ++ai)
#pragma unroll
            for (int m = 0; m < 4; ++m) {
                const int row = row0 + ai * HALF + m * 16;
                const f32x4 g0 = acc[ai][0][m][0], g1 = acc[ai][0][m][1], u0 = acc[ai][1][m][0], u1 = acc[ai][1][m][1];
                u32x4 w; w.x = pkbf(siluf_(g0[0]) * u0[0], siluf_(g0[1]) * u0[1]); w.y = pkbf(siluf_(g0[2]) * u0[2], siluf_(g0[3]) * u0[3]);
                w.z = pkbf(siluf_(g1[0]) * u1[0], siluf_(g1[1]) * u1[1]); w.w = pkbf(siluf_(g1[2]) * u1[2], siluf_(g1[3]) * u1[3]);
                *(u32x4*)(H + (size_t)row * 1024 + col) = w;
            }
    }
};
struct EpiDown {
    static constexpr bool PERM = true, AFTER_DRAIN = false;
    bf16_t* Y; const float* rg;
    __device__ __forceinline__ void operator()(const f32x4 (&acc)[2][2][4][2], const Unit& u, int wr, int wc, int fr, int fq) const {
        const int row0 = u.pm * BM + wr * 64 + fr, colb = u.pn * BM + wc * 32 + 8 * fq;
#pragma unroll
        for (int ai = 0; ai < 2; ++ai)
#pragma unroll
            for (int m = 0; m < 4; ++m) {
                const int row = row0 + ai * HALF + m * 16; const float gt = rg[row];
#pragma unroll
                for (int bj = 0; bj < 2; ++bj) {
                    const f32x4 v0 = acc[ai][bj][m][0] * gt, v1 = acc[ai][bj][m][1] * gt;
                    u32x4 w; w.x = pkbf(v0[0], v0[1]); w.y = pkbf(v0[2], v0[3]); w.z = pkbf(v1[0], v1[1]); w.w = pkbf(v1[2], v1[3]);
                    *(u32x4*)(Y + (size_t)row * DMODEL + colb + bj * HALF) = w;
                }
            }
    }
};
struct ExpertOrder {
    const LAS int* ts; int G, c;
    __device__ __forceinline__ bool next(int i, Unit& u) const {
        const int L = i * G + c; const int total = ts[32] * 8; if (L >= total) return false;
        const int gt = L >> 3; u.pm = gt; u.pn = L & 7; int e = 0;
        for (int k = 1; k < 32; ++k) e += (gt >= ts[k]) ? 1 : 0;
        u.e = e; return true;
    }
    __device__ __forceinline__ void a_ready(const Unit&) const {}
    __device__ __forceinline__ void done(const Unit&) const {}
};
}

struct MapId { __device__ __forceinline__ int operator()(int n) const { return n; } };
struct MapGate { __device__ __forceinline__ int operator()(int f) const { return ((f >> 7) << 8) + (f & 127); } };
struct MapUp { __device__ __forceinline__ int operator()(int f) const { return ((f >> 7) << 8) + 128 + (f & 127); } };
struct MapProj {
    __device__ __forceinline__ int operator()(int n) const {
        if (n < 1736) return n;
        if (n < 2760) { const int l = n - 1736, d = l & 127; return C_QR + (l & ~127) + ((d & 63) << 1) + (d >> 6); }
        if (n < 3784) { const int l = n - 2760, d = l & 127; return C_KR + (l & ~127) + ((d & 63) << 1) + (d >> 6); }
        if (n < 4808) return C_VR + (n - 3784);
        if (n < 5832) return C_GR + (n - 4808);
        return C_GBR + (n - 5832);
    }
};
template <class RowMap>
__device__ __forceinline__ void tr_item(const float* __restrict__ src, int N, bf16_t* __restrict__ dst, int ldd, int kb, int nb, int lane, RowMap rm) {
    const int kc = lane >> 3, nc = lane & 7;
    const int n = nb * 32 + nc * 4, k0 = kb * 64 + kc * 8;
    if (n < N) {
        f32x4 v[8];
#pragma unroll
        for (int i = 0; i < 8; ++i) v[i] = *(const f32x4*)(src + (size_t)(k0 + i) * N + n);
#pragma unroll
        for (int j = 0; j < 4; ++j) {
            u32x4 o; o.x = pkbf(v[0][j], v[1][j]); o.y = pkbf(v[2][j], v[3][j]); o.z = pkbf(v[4][j], v[5][j]); o.w = pkbf(v[6][j], v[7][j]);
            *(u32x4*)(dst + (size_t)rm(n + j) * ldd + k0) = o;
        }
    }
}
__device__ __forceinline__ void sincos_d(double a, double& s, double& c) {
    const double TWO_PI = 6.283185307179586476925, HALF_PI = 1.5707963267948966192313;
    double k = rint(a / HALF_PI); double r = a - k * HALF_PI;
    r -= k * 6.123233995736766e-17;
    const int q = ((int)k) & 3; const double r2 = r * r;
    double sp = r2 * (-1.0 / 1307674368000.0);
    sp = r2 * (sp + 1.0 / 6227020800.0); sp = r2 * (sp - 1.0 / 39916800.0); sp = r2 * (sp + 1.0 / 362880.0); sp = r2 * (sp - 1.0 / 5040.0); sp = r2 * (sp + 1.0 / 120.0); sp = r2 * (sp - 1.0 / 6.0);
    const double sr = r + r * sp;
    double cp = r2 * (1.0 / 20922789888000.0);
    cp = r2 * (cp - 1.0 / 87178291200.0); cp = r2 * (cp + 1.0 / 479001600.0); cp = r2 * (cp - 1.0 / 3628800.0); cp = r2 * (cp + 1.0 / 40320.0); cp = r2 * (cp - 1.0 / 720.0); cp = r2 * (cp + 1.0 / 24.0); cp = r2 * (cp - 0.5);
    const double cr = 1.0 + cp;
    s = (q == 0) ? sr : (q == 1) ? cr : (q == 2) ? -sr : -cr;
    c = (q == 0) ? cr : (q == 1) ? -sr : (q == 2) ? -cr : sr;
    (void)TWO_PI;
}

struct Params { const float* in[17]; float* out; unsigned char* ws; };

#define GSYNC() grid.sync()
#define XBAR() do { const int l__ = (int)__builtin_amdgcn_mbcnt_hi(~0u, __builtin_amdgcn_mbcnt_lo(~0u, (unsigned)hide_i(0))); xcd_barrier(xbar, wave_id * 64 + l__); } while (0)
constexpr int CTL_BAR_WORD = 8192;

__global__ void __launch_bounds__(512, 2) mega_fwd(Params p) {
    extern __shared__ __attribute__((aligned(16))) unsigned char lds_raw[];
    LAS unsigned char* lds = (LAS unsigned char*)lds_raw;
    cg::grid_group grid = cg::this_grid();
    const int G = gridDim.x, bx = blockIdx.x;
    const int wave_id = __builtin_amdgcn_readfirstlane((int)threadIdx.x >> 6);
    const int NGW = G * 8, NGT = G * 512;
    XcdBarrier xbar;
    {
        const int l0 = (int)__builtin_amdgcn_mbcnt_hi(~0u, __builtin_amdgcn_mbcnt_lo(~0u, (unsigned)hide_i(0)));
        volatile LAS unsigned* st = (volatile LAS unsigned*)(lds + LDS_MISC + 256);
        if (wave_id == 0 && l0 < 2) st[l0] = 0u;
        __syncthreads();
        xbar.bar = (unsigned*)(p.ws + WS_CTL) + CTL_BAR_WORD; xbar.x = xb_xcc_id(); xbar.st = st;
        if (wave_id == 0 && l0 == 0) (void)xb_add(&xbar.bar[XB_XCNT(xbar.x)], 1u);
    }
#define PH_LOCALS \
    const int lane = (int)__builtin_amdgcn_mbcnt_hi(~0u, __builtin_amdgcn_mbcnt_lo(~0u, (unsigned)hide_i(0))), wave = wave_id, tid = wave * 64 + lane; (void)tid; \
    const int gw = bx * 8 + wave, gtid = bx * 512 + tid; (void)gw; (void)gtid; (void)lane; \
    unsigned char* ws = hide_p(p.ws); float* out = hide_p(p.out); (void)out; \
    unsigned* ctl = (unsigned*)(ws + WS_CTL); float* rot = (float*)(ws + WS_ROT); (void)ctl; (void)rot; \
    bf16_t* WIN = (bf16_t*)(ws + WS_WIN); bf16_t* WCOMB = (bf16_t*)(ws + WS_WCOMB); bf16_t* WB = (bf16_t*)(ws + WS_WB); bf16_t* WO = (bf16_t*)(ws + WS_WO); (void)WIN; (void)WCOMB; (void)WB; (void)WO; \
    bf16_t* WGU = (bf16_t*)(ws + WS_WGU); bf16_t* WD = (bf16_t*)(ws + WS_WD); (void)WGU; (void)WD; \
    bf16_t* P = (bf16_t*)(ws + WS_P); bf16_t* HMID = (bf16_t*)(ws + WS_HMID); bf16_t* Y = (bf16_t*)(ws + WS_Y); (void)P; (void)HMID; (void)Y; \
    bf16_t* XN = (bf16_t*)(ws + WS_XN); bf16_t* BA = XN; bf16_t* TN = XN; (void)BA; (void)TN; \
    bf16_t* OA = (bf16_t*)(ws + WS_OA); bf16_t* OB = (bf16_t*)(ws + WS_OB); bf16_t* MIXED = (bf16_t*)(ws + WS_MIXED); bf16_t* XG = (bf16_t*)(ws + WS_XG); (void)OA; (void)OB; (void)MIXED; (void)XG; \
    bf16_t* KV = (bf16_t*)(ws + WS_KV); u64* MASK = (u64*)(ws + WS_MASK); (void)KV; (void)MASK; \
    int* misc = (int*)(ws + WS_MISC); \
    int* row_tok = misc + MI_ROWTOK; float* row_gate = (float*)(misc + MI_ROWGATE); int* tok_slot = misc + MI_TOKSLOT; (void)row_tok; (void)row_gate; (void)tok_slot; \
    int* asg_e = misc + MI_ASGE; int* asg_r = misc + MI_ASGR; float* asg_g = (float*)(misc + MI_ASGG); (void)asg_e; (void)asg_r; (void)asg_g;
#define IN(k) hide_p(p.in[k])

    {
        PH_LOCALS
        const float* x = IN(0); const float* g_mix = IN(1); const float* w_in = IN(2); const float* w_uv = IN(4); const float* w_branch = IN(6); const float* w_out = IN(7);
        const float* w_eg = IN(13); const float* w_eu = IN(14); const float* w_ed = IN(15);
        constexpr int NB_WIN = 311;
        constexpr int I_WIN = 32 * NB_WIN, I_WB = 16 * 64, I_WO = 32 * 64, I_EG = 32 * 1024, I_EU = 32 * 1024, I_ED = 32 * 1024;
        constexpr int I_TOTAL = I_WIN + I_WB + I_WO + I_EG + I_EU + I_ED;
        for (int it = gw; it < I_TOTAL; it += NGW) {
            int r = it;
            if (r < I_WIN) { tr_item(w_in, 9928, WIN, 2048, r / NB_WIN, r % NB_WIN, lane, MapProj{}); continue; } r -= I_WIN;
            if (r < I_WB) { tr_item(w_branch + (size_t)1024 * 2048, 2048, WB, 1024, r >> 6, r & 63, lane, MapId{}); continue; } r -= I_WB;
            if (r < I_WO) { tr_item(w_out, 2048, WO, 2048, r >> 6, r & 63, lane, MapId{}); continue; } r -= I_WO;
            if (r < I_EG) { const int e = r >> 10, q = r & 1023; tr_item(w_eg + (size_t)e * 2048 * 1024, 1024, WGU + (size_t)e * 2048 * 2048, 2048, q >> 5, q & 31, lane, MapGate{}); continue; } r -= I_EG;
            if (r < I_EU) { const int e = r >> 10, q = r & 1023; tr_item(w_eu + (size_t)e * 2048 * 1024, 1024, WGU + (size_t)e * 2048 * 2048, 2048, q >> 5, q & 31, lane, MapUp{}); continue; } r -= I_EU;
            { const int e = r >> 10, q = r & 1023; tr_item(w_ed + (size_t)e * 1024 * 2048, 2048, WD + (size_t)e * 2048 * 1024, 1024, q >> 6, q & 63, lane, MapId{}); }
        }
        for (int i = gtid; i < 56 * 256; i += NGT) ((u32x4*)(WIN + (size_t)1736 * 2048))[i] = (u32x4){0u, 0u, 0u, 0u};
        for (int it = gw; it < 2048; it += NGW) {
            const int h = it >> 8, ch = (it >> 7) & 1, n0 = (it & 127) * 16, c = ch * 64 + lane;
            const float* wuv = w_uv + ((size_t)h * 128 + c) * 128;
            const float* wa = w_branch + (size_t)(h * 128) * 2048 + n0;
            float a[16];
#pragma unroll
            for (int j = 0; j < 16; ++j) a[j] = 0.f;
            for (int d4 = 0; d4 < 32; ++d4) {
                const f32x4 wv = *(const f32x4*)(wuv + d4 * 4);
#pragma unroll
                for (int dd = 0; dd < 4; ++dd) {
                    const float* wr_ = wa + (size_t)(d4 * 4 + dd) * 2048;
#pragma unroll
                    for (int j4 = 0; j4 < 4; ++j4) { const f32x4 b = *(const f32x4*)(wr_ + j4 * 4); a[j4 * 4 + 0] += wv[dd] * b[0]; a[j4 * 4 + 1] += wv[dd] * b[1]; a[j4 * 4 + 2] += wv[dd] * b[2]; a[j4 * 4 + 3] += wv[dd] * b[3]; }
                }
            }
#pragma unroll
            for (int j = 0; j < 16; ++j) WCOMB[(size_t)(n0 + j) * 1024 + h * 128 + c] = (bf16_t)(pkbf(a[j], 0.f) & 0xffffu);
        }
        for (int m = gw; m < T_TOK; m += NGW) {
            const f32x4* xr = (const f32x4*)(x + (size_t)m * DMODEL) + lane; f32x4 v[8]; float ss = 0.f;
#pragma unroll
            for (int j = 0; j < 8; ++j) { v[j] = xr[64 * j]; ss += (v[j][0] * v[j][0] + v[j][1] * v[j][1]) + (v[j][2] * v[j][2] + v[j][3] * v[j][3]); }
            const float rstd = 1.0f / sqrtf(wave_sum(ss, lane) * (1.0f / DMODEL) + EPS_F);
            u32x2* o = (u32x2*)(XN + (size_t)m * DMODEL) + lane;
#pragma unroll
            for (int j = 0; j < 8; ++j) { const f32x4 gg = ((const f32x4*)g_mix)[lane + 64 * j]; u32x2 w; w.x = pkbf(v[j][0] * rstd * gg[0], v[j][1] * rstd * gg[1]); w.y = pkbf(v[j][2] * rstd * gg[2], v[j][3] * rstd * gg[3]); o[64 * j] = w; }
        }
        for (int idx = gtid; idx < SEQL * 64; idx += NGT) {
            const int pos = idx >> 6, i = idx & 63; double f = 1.0;
            for (int k = 0; k < i; ++k) f *= 0.8659643233600653;
            double s, c; sincos_d((double)pos * f, s, c);
            rot[2 * idx] = (float)c; rot[2 * idx + 1] = (float)s;
        }
        for (int i = gtid; i < 32; i += NGT) ctl[64 * i] = 0u;
        if (gtid < 2) ctl[4096 + gtid] = 0u;
        for (int i = gtid; i < MAXSLOT; i += NGT) { row_tok[i] = 0; row_gate[i] = 0.f; }
    }
    GSYNC();

    {
        PH_LOCALS
        pg8::Gemm g{XN, WIN, T_TOK, NPROJ, 2048}; pg8::StaticOrder S; S.init(T_TOK, NPROJ, G, bx);
        pg8::EpiProj E{P, rot};
        pg8::gemm_phase<pg8::EpiProj, pg8::StaticOrder, true, true>(lds, g, S, E, tid);
    }
    XBAR();

    {
        PH_LOCALS
        const float* g_kv = IN(3);
        for (int t = gw; t < T_TOK; t += NGW) {
            const unsigned v = *(const unsigned*)(P + (size_t)t * NPROJ + C_CKV + 2 * lane);
            const float a = bflo(v), b = bfhi(v);
            const float rstd = 1.0f / sqrtf(wave_sum(a * a + b * b, lane) * (1.0f / 128.0f) + EPS_F);
            *(unsigned*)(KV + (size_t)t * 128 + 2 * lane) = pkbf(a * rstd * g_kv[2 * lane], b * rstd * g_kv[2 * lane + 1]);
        }
#if DBG_CMP == 3
        {
        u64* MASKX = (u64*)(ws + WS_SPARE);
        LAS float* qi = (LAS float*)(lds + wave * 10240); LAS float* sc = qi + 512;
        for (int t = gw; t < T_TOK; t += NGW) {
            const int b = t >> 11, q = t & 2047, ng = (q >> 6) + 1;
            { const u32x4 v = *(const u32x4*)(P + (size_t)t * NPROJ + C_QIDX + lane * 8);
              f32x4 lo4 = (f32x4){bflo(v.x), bfhi(v.x), bflo(v.y), bfhi(v.y)}, hi4 = (f32x4){bflo(v.z), bfhi(v.z), bflo(v.w), bfhi(v.w)};
              *(LAS f32x4*)(qi + lane * 8) = lo4; *(LAS f32x4*)(qi + lane * 8 + 4) = hi4; }
            float w[8];
            { const u32x4 v = *(const u32x4*)(P + (size_t)t * NPROJ + C_WIDX); w[0] = bflo(v.x); w[1] = bfhi(v.x); w[2] = bflo(v.y); w[3] = bfhi(v.y); w[4] = bflo(v.z); w[5] = bfhi(v.z); w[6] = bflo(v.w); w[7] = bfhi(v.w); }
            for (int g = 0; g < ng; ++g) {
                LAS float* qg = qi; asm volatile("" : "+v"(qg));
                const int s = g * 64 + lane; const u32x4* kr = (const u32x4*)(P + (size_t)(b * SEQL + s) * NPROJ + C_KIDX);
                float dot[8];
#pragma unroll
                for (int h = 0; h < 8; ++h) dot[h] = 0.f;
#pragma unroll
                for (int c = 0; c < 8; ++c) {
                    const u32x4 v = kr[c];
                    const f32x4 ka = (f32x4){bflo(v.x), bfhi(v.x), bflo(v.y), bfhi(v.y)}, kb = (f32x4){bflo(v.z), bfhi(v.z), bflo(v.w), bfhi(v.w)};
#pragma unroll
                    for (int h = 0; h < 8; ++h) {
                        const f32x4 qa = *(const LAS f32x4*)(qg + h * 64 + c * 8), qb = *(const LAS f32x4*)(qg + h * 64 + c * 8 + 4);
                        dot[h] += (qa[0] * ka[0] + qa[1] * ka[1]) + (qa[2] * ka[2] + qa[3] * ka[3]) + (qb[0] * kb[0] + qb[1] * kb[1]) + (qb[2] * kb[2] + qb[3] * kb[3]);
                    }
                }
                float score = 0.f;
#pragma unroll
                for (int h = 0; h < 8; ++h) score += w[h] * fmaxf(dot[h], 0.f);
                sc[s] = score * IDX_SCALE;
            }
            u64* mrow = MASKX + (size_t)t * 32;
            if (ng <= 4) { if (lane < 32) mrow[lane] = (lane < ng) ? ~0ull : 0ull; }
            else {
                unsigned lo = 0u;
                for (int bit = 31; bit >= 0; --bit) {
                    const unsigned cand = lo | (1u << bit); int cnt = 0;
                    for (int g = 0; g < ng; ++g) cnt += __popcll(__ballot(fkey(sc[g * 64 + lane]) >= cand));
                    if (cnt >= 256) lo = cand;
                }
                const unsigned tau = lo; int cgt = 0;
                for (int g = 0; g < ng; ++g) cgt += __popcll(__ballot(fkey(sc[g * 64 + lane]) > tau));
                const int need = 256 - cgt; int run = 0;
                for (int g = 0; g < ng; ++g) {
                    const unsigned key = fkey(sc[g * 64 + lane]);
                    const u64 gt = __ballot(key > tau), eq = __ballot(key == tau);
                    const u64 below = eq & ((1ull << lane) - 1ull);
                    const bool sel = (key == tau) && (run + (int)__popcll(below) < need);
                    const u64 word = gt | __ballot(sel);
                    run += (int)__popcll(eq);
                    if (lane == 0) mrow[g] = word;
                }
                if (lane >= ng && lane < 32) mrow[lane] = 0ull;
            }
        }
        }
        __syncthreads();
#endif
        typedef short bf16x8_t __attribute__((ext_vector_type(8)));
        constexpr int SCS = 2052;
        LAS float* scl = (LAS float*)lds;
        for (int ui = 0; ui < 4; ++ui) {
            const int uu = ui * 256 + ((ui & 1) ? 255 - bx : bx);
            if (uu >= 1024 || bx >= 256) break;
            const int b = uu & 7, qblk = uu >> 3, q0 = qblk * 16, t0 = b * SEQL + q0, ng = (q0 >> 6) + 1, N = ng * 64;
            if (ng <= 4) {
                for (int qq = 0; qq < 2; ++qq) { u64* mrow = MASK + (size_t)(t0 + 2 * wave + qq) * 32; if (lane < 32) mrow[lane] = (lane < ng) ? ~0ull : 0ull; }
                continue;
            }
            const int qrow = lane & 15, kg = lane >> 4;
            bf16x8_t qf[8][2]; float w[8];
            { const bf16_t* qp = P + (size_t)(t0 + qrow) * NPROJ + C_QIDX + 8 * kg;
#pragma unroll
              for (int h = 0; h < 8; ++h) { qf[h][0] = *(const bf16x8_t*)(qp + h * 64); qf[h][1] = *(const bf16x8_t*)(qp + h * 64 + 32); }
              const u32x4 v = *(const u32x4*)(P + (size_t)(t0 + qrow) * NPROJ + C_WIDX); w[0] = bflo(v.x); w[1] = bfhi(v.x); w[2] = bflo(v.y); w[3] = bfhi(v.y); w[4] = bflo(v.z); w[5] = bfhi(v.z); w[6] = bflo(v.w); w[7] = bfhi(v.w); }
            for (int kt = wave; kt < N / 16; kt += 8) {
                const int s0 = kt * 16;
                const bf16_t* kp = P + (size_t)(b * SEQL + s0 + qrow) * NPROJ + C_KIDX + 8 * kg;
                const bf16x8_t a0 = *(const bf16x8_t*)kp, a1 = *(const bf16x8_t*)(kp + 32);
                f32x4 sacc = (f32x4){0.f, 0.f, 0.f, 0.f};
#pragma unroll
                for (int h = 0; h < 8; ++h) {
                    f32x4 acc = (f32x4){0.f, 0.f, 0.f, 0.f};
                    acc = __builtin_amdgcn_mfma_f32_16x16x32_bf16(a0, qf[h][0], acc, 0, 0, 0);
                    acc = __builtin_amdgcn_mfma_f32_16x16x32_bf16(a1, qf[h][1], acc, 0, 0, 0);
                    sacc[0] += w[h] * fmaxf(acc[0], 0.f); sacc[1] += w[h] * fmaxf(acc[1], 0.f); sacc[2] += w[h] * fmaxf(acc[2], 0.f); sacc[3] += w[h] * fmaxf(acc[3], 0.f);
                }
                *(LAS f32x4*)(scl + qrow * SCS + s0 + 4 * kg) = sacc * IDX_SCALE;
            }
            __syncthreads();
#pragma unroll 1
            for (int qq = 0; qq < 2; ++qq) {
                const int q = 2 * wave + qq; const LAS float* row = scl + q * SCS;
                unsigned key[32];
#pragma unroll
                for (int j = 0; j < 32; ++j) key[j] = (j < ng) ? fkey(row[64 * j + lane]) : 0u;
                unsigned lo = 0u;
#pragma unroll 1
                for (int bit = 31; bit >= 0; --bit) {
                    const unsigned cand = lo | (1u << bit); int c = 0;
#pragma unroll
                    for (int j = 0; j < 32; ++j) c += (key[j] >= cand) ? 1 : 0;
#pragma unroll
                    for (int x = 1; x < 64; x <<= 1) c += __builtin_amdgcn_ds_bpermute((lane ^ x) << 2, c);
                    if (c >= 256) lo = cand;
                }
                const unsigned tau = lo; int cgt = 0;
#pragma unroll
                for (int j = 0; j < 32; ++j) cgt += (key[j] > tau) ? 1 : 0;
#pragma unroll
                for (int x = 1; x < 64; x <<= 1) cgt += __builtin_amdgcn_ds_bpermute((lane ^ x) << 2, cgt);
                const int need = 256 - cgt; int run = 0; u64 myword = 0ull;
#pragma unroll
                for (int j = 0; j < 32; ++j) {
                    const u64 gt = __ballot(key[j] > tau), eq = __ballot(key[j] == tau);
                    const u64 below = eq & ((1ull << lane) - 1ull);
                    const bool sel = (key[j] == tau) && (run + (int)__popcll(below) < need);
                    const u64 word = gt | __ballot(sel);
                    run += (int)__popcll(eq);
                    if (lane == j) myword = word;
                    __builtin_amdgcn_sched_barrier(0);
                }
                if (lane < 32) MASK[(size_t)(t0 + q) * 32 + lane] = myword;
            }
            __syncthreads();
        }
    }
    XBAR();

#if DBG_CMP == 1
    {
        PH_LOCALS
        bf16_t* OAX = (bf16_t*)(ws + WS_SPARE);
        float* qv = (float*)(lds_raw + wave * 10240); float* lg = qv + 512;
        for (int it = gw; it < T_TOK * 8; it += NGW) {
            const int t = it >> 3, h = it & 7, b = t >> 11, q = t & 2047, ng = (q >> 6) + 1;
            { const unsigned v = *(const unsigned*)(P + (size_t)t * NPROJ + C_QLAT + h * 128 + 2 * lane); qv[2 * lane] = bflo(v); qv[2 * lane + 1] = bfhi(v); }
            const u64* mrow = MASK + (size_t)t * 32;
            float mx = -INFINITY;
            for (int g = 0; g < ng; ++g) {
                asm volatile("" ::: "memory");
                const u64 word = mrow[g]; float l = -INFINITY;
                if ((word >> lane) & 1ull) {
                    const u32x4* kr = (const u32x4*)(KV + (size_t)(b * SEQL + g * 64 + lane) * 128);
                    float d0 = 0.f, d1 = 0.f, d2 = 0.f, d3 = 0.f;
#pragma unroll
                    for (int c = 0; c < 16; ++c) { const u32x4 v = kr[c]; const f32x4 qa = *(const f32x4*)(qv + 8 * c), qb = *(const f32x4*)(qv + 8 * c + 4);
                        d0 += qa[0] * bflo(v.x) + qb[0] * bflo(v.z); d1 += qa[1] * bfhi(v.x) + qb[1] * bfhi(v.z); d2 += qa[2] * bflo(v.y) + qb[2] * bflo(v.w); d3 += qa[3] * bfhi(v.y) + qb[3] * bfhi(v.w); }
                    l = ((d0 + d1) + (d2 + d3)) * ATT_SCALE;
                }
                lg[g * 64 + lane] = l; mx = fmaxf(mx, l);
            }
            mx = wave_max(mx, lane);
            float o0 = 0.f, o1 = 0.f, sum = 0.f;
            for (int g = 0; g < ng; ++g) {
                const u64 wv = mrow[g];
                u64 word = ((u64)__builtin_amdgcn_readfirstlane((unsigned)(wv >> 32)) << 32) | (u64)__builtin_amdgcn_readfirstlane((unsigned)wv);
                while (word) {
                    const int j = __builtin_ctzll(word); word &= word - 1ull;
                    const int s = g * 64 + j; const float pj = __expf(lg[s] - mx);
                    const unsigned v = *(const unsigned*)(KV + (size_t)(b * SEQL + s) * 128 + 2 * lane);
                    o0 += pj * bflo(v); o1 += pj * bfhi(v); sum += pj;
                }
            }
            const float inv = 1.0f / sum;
            *(unsigned*)(OAX + (size_t)t * 1024 + h * 128 + 2 * lane) = pkbf(o0 * inv, o1 * inv);
        }
    }
    __syncthreads();
#endif
#if DBG_CMP == 2
    {
        PH_LOCALS
        const float* g_ret = IN(5);
        bf16_t* OBX = (bf16_t*)(ws + WS_SPARE);
        float* qv = (float*)(lds_raw + wave * 10240); float* lg = qv + 512; float* wl = lg;
        for (int it = gw; it < T_TOK * 8; it += NGW) {
            const int t = it >> 3, h = it & 7, b = t >> 11, n = t & 2047, ng = (n >> 6) + 1;
            const float lgam = (h == 0) ? -0.04580368961312479f : (h == 1) ? -0.02272007650008353f : (h == 2) ? -0.011315313227834146f : (h == 3) ? -0.005646563141142063f :
                               (h == 4) ? -0.0028205190623786626f : (h == 5) ? -0.0014095702546713536f : (h == 6) ? -0.0007046129765893727f : -0.0003522634716290214f;
            { const unsigned v = *(const unsigned*)(P + (size_t)t * NPROJ + C_QR + h * 128 + 2 * lane); qv[2 * lane] = bflo(v); qv[2 * lane + 1] = bfhi(v); }
            float o0 = 0.f, o1 = 0.f;
            for (int g = 0; g < ng; ++g) {
                asm volatile("" ::: "memory");
                const int m = g * 64 + lane;
                const u32x4* kr = (const u32x4*)(P + (size_t)(b * SEQL + m) * NPROJ + C_KR + h * 128);
                float d0 = 0.f, d1 = 0.f, d2 = 0.f, d3 = 0.f;
#pragma unroll
                for (int c = 0; c < 16; ++c) { const u32x4 v = kr[c]; const f32x4 qa = *(const f32x4*)(qv + 8 * c), qb = *(const f32x4*)(qv + 8 * c + 4);
                    d0 += qa[0] * bflo(v.x) + qb[0] * bflo(v.z); d1 += qa[1] * bfhi(v.x) + qb[1] * bfhi(v.z); d2 += qa[2] * bflo(v.y) + qb[2] * bflo(v.w); d3 += qa[3] * bfhi(v.y) + qb[3] * bfhi(v.w); }
                const float dot = (d0 + d1) + (d2 + d3);
                wl[lane] = (m <= n) ? dot * exp2f((float)(n - m) * lgam) : 0.f;
                const int jmax = (g == ng - 1) ? (n & 63) : 63;
                for (int j = 0; j <= jmax; ++j) {
                    const float wj = wl[j];
                    const unsigned v = *(const unsigned*)(P + (size_t)(b * SEQL + g * 64 + j) * NPROJ + C_VR + h * 128 + 2 * lane);
                    o0 += wj * bflo(v); o1 += wj * bfhi(v);
                }
            }
            const float mu = wave_sum(o0 + o1, lane) * (1.0f / 128.0f); const float e0 = o0 - mu, e1 = o1 - mu;
            const float rs = 1.0f / sqrtf(wave_sum(e0 * e0 + e1 * e1, lane) * (1.0f / 128.0f) + EPS_F);
            const unsigned gv = *(const unsigned*)(P + (size_t)t * NPROJ + C_GR + h * 128 + 2 * lane);
            const float y0 = siluf_(bflo(gv)) * e0 * rs * g_ret[h * 128 + 2 * lane], y1 = siluf_(bfhi(gv)) * e1 * rs * g_ret[h * 128 + 2 * lane + 1];
            *(unsigned*)(OBX + (size_t)t * 1024 + h * 128 + 2 * lane) = pkbf(y0, y1);
        }
    }
    __syncthreads();
#endif
    {
        PH_LOCALS
        for (int pr = bx; pr < 256; pr += G) {
            const int b = pr >> 5, i = pr & 31;
#pragma unroll 1
            for (int uu = 0; uu < 2; ++uu) {
                const int qb = uu ? 63 - i : i; const int t0 = b * SEQL + qb * 32;
                fa::UnitArgs U; U.Q = P + (size_t)t0 * NPROJ + C_QLAT; U.ldq = NPROJ; U.K = KV + (size_t)b * SEQL * 128; U.V = U.K; U.ldk = 128; U.mask = MASK + (size_t)t0 * 32;
                U.ntiles = (qb >> 1) + 1; U.n0 = 0; U.lgam = 0.f;
                fa::f32x16 o[4]; float l_reg;
                fa::unit_body<0>((LAS char*)lds, U, tid, o, l_reg);
                const int r32 = lane & 31, hi = lane >> 5;
                LAS float* li_l = (LAS float*)(lds + fa::OFF_WS) + wave * 64;
                if (hi == 0) li_l[r32] = l_reg;
                asm volatile("s_waitcnt lgkmcnt(0)" ::: "memory");
#pragma unroll
                for (int r = 0; r < 16; ++r) {
                    const int orow = fa::crow(r, hi); const float rl = __builtin_amdgcn_rcpf(li_l[orow]);
                    bf16_t* op = OA + (size_t)(t0 + orow) * 1024 + wave * 128 + r32;
#pragma unroll
                    for (int d0 = 0; d0 < 4; ++d0) op[d0 * 32] = (bf16_t)(pkbf(o[d0][r] * rl, 0.f) & 0xffffu);
                }
                __syncthreads();
            }
        }
    }
    {
        PH_LOCALS
        const float* g_ret = IN(5);
        for (int pr = bx; pr < 256; pr += G) {
            const int bh = pr >> 2, i = pr & 3, b = bh >> 3, h = bh & 7;
            const float lgam = (h == 0) ? -0.04580368961312479f : (h == 1) ? -0.02272007650008353f : (h == 2) ? -0.011315313227834146f : (h == 3) ? -0.005646563141142063f :
                               (h == 4) ? -0.0028205190623786626f : (h == 5) ? -0.0014095702546713536f : (h == 6) ? -0.0007046129765893727f : -0.0003522634716290214f;
#pragma unroll 1
            for (int uu = 0; uu < 2; ++uu) {
                const int qb = uu ? 7 - i : i; const int n0 = qb * 256;
                fa::UnitArgs U; U.Q = P + (size_t)(b * SEQL + n0) * NPROJ + C_QR + h * 128; U.ldq = NPROJ;
                U.K = P + (size_t)(b * SEQL) * NPROJ + C_KR + h * 128; U.V = P + (size_t)(b * SEQL) * NPROJ + C_VR + h * 128; U.ldk = NPROJ; U.mask = nullptr;
                U.ntiles = 4 * (qb + 1); U.n0 = n0; U.lgam = lgam;
                fa::f32x16 o[4]; float l_reg;
                fa::unit_body<1>((LAS char*)lds, U, tid, o, l_reg);
                const int r32 = lane & 31, hi = lane >> 5;
                float gr[4];
#pragma unroll
                for (int d0 = 0; d0 < 4; ++d0) gr[d0] = g_ret[h * 128 + d0 * 32 + r32];
#pragma unroll
                for (int r = 0; r < 16; ++r) {
                    float s = (o[0][r] + o[1][r]) + (o[2][r] + o[3][r]);
#pragma unroll
                    for (int x = 1; x < 32; x <<= 1) s += shx(s, lane, x);
                    const float mu = s * (1.0f / 128.0f);
                    const float e0 = o[0][r] - mu, e1 = o[1][r] - mu, e2 = o[2][r] - mu, e3 = o[3][r] - mu;
                    float q = (e0 * e0 + e1 * e1) + (e2 * e2 + e3 * e3);
#pragma unroll
                    for (int x = 1; x < 32; x <<= 1) q += shx(q, lane, x);
                    const float rs = 1.0f / sqrtf(q * (1.0f / 128.0f) + EPS_F);
                    const size_t tok = (size_t)(b * SEQL + n0 + wave * 32 + fa::crow(r, hi));
                    const bf16_t* gp = P + tok * NPROJ + C_GR + h * 128 + r32; bf16_t* op = OB + tok * 1024 + h * 128 + r32;
                    op[0] = (bf16_t)(pkbf(siluf_(bflo((unsigned)gp[0])) * e0 * rs * gr[0], 0.f) & 0xffffu);
                    op[32] = (bf16_t)(pkbf(siluf_(bflo((unsigned)gp[32])) * e1 * rs * gr[1], 0.f) & 0xffffu);
                    op[64] = (bf16_t)(pkbf(siluf_(bflo((unsigned)gp[64])) * e2 * rs * gr[2], 0.f) & 0xffffu);
                    op[96] = (bf16_t)(pkbf(siluf_(bflo((unsigned)gp[96])) * e3 * rs * gr[3], 0.f) & 0xffffu);
                }
                __syncthreads();
            }
        }
    }
#if DBG_CMP
    XBAR();
    {
        PH_LOCALS
        const bf16_t* A_ = (DBG_CMP == 1) ? OA : OB; const bf16_t* R_ = (const bf16_t*)(ws + WS_SPARE);
        float sd = 0.f, sr = 0.f;
#if DBG_CMP == 3
        for (size_t i = (size_t)gtid; i < (size_t)T_TOK * 32; i += (size_t)NGT) { const u64 a = MASK[i], r = ((const u64*)(ws + WS_SPARE))[i]; sd += (float)__popcll(a ^ r); sr += 100.0f * (float)__popcll(r); }
#else
        for (size_t i = (size_t)gtid; i < (size_t)T_TOK * 1024 / 2; i += (size_t)NGT) {
            const unsigned a = ((const unsigned*)A_)[i], r = ((const unsigned*)R_)[i];
            const float d0 = bflo(a) - bflo(r), d1 = bfhi(a) - bfhi(r); sd += d0 * d0 + d1 * d1; sr += bflo(r) * bflo(r) + bfhi(r) * bfhi(r);
        }
#endif
        sd = wave_sum(sd, lane); sr = wave_sum(sr, lane);
        if (lane == 0) { atomicAdd((float*)(ctl + 4096), sd); atomicAdd((float*)(ctl + 4097), sr); }
    }
#endif
    XBAR();

    {
        PH_LOCALS
        pg8::Gemm g{OA, WCOMB, T_TOK, DMODEL, 1024}; pg8::StaticOrder S; S.init(T_TOK, DMODEL, G, bx);
        pg8::EpiMerge<0> E{P, nullptr, BA};
        pg8::gemm_phase<pg8::EpiMerge<0>, pg8::StaticOrder, true, true>(lds, g, S, E, tid);
    }
    XBAR();
    {
        PH_LOCALS
        pg8::Gemm g{OB, WB, T_TOK, DMODEL, 1024}; pg8::StaticOrder S; S.init(T_TOK, DMODEL, G, bx);
        pg8::EpiMerge<1> E{P, BA, MIXED};
        pg8::gemm_phase<pg8::EpiMerge<1>, pg8::StaticOrder, true, true>(lds, g, S, E, tid);
    }
    XBAR();
    {
        PH_LOCALS
        const float* x = IN(0);
        pg8::Gemm g{MIXED, WO, T_TOK, DMODEL, 2048}; pg8::StaticOrder S; S.init(T_TOK, DMODEL, G, bx);
        pg8::EpiRes E{x, out};
        pg8::gemm_phase<pg8::EpiRes, pg8::StaticOrder, true, true>(lds, g, S, E, tid);
    }
    XBAR();

    {
    PH_LOCALS
    const float* g_ffn = IN(8); const float* w_rg = IN(9); const float* b_rg = IN(10); const float* w_re = IN(11); const float* b_re = IN(12);
    for (int t = gw; t < T_TOK; t += NGW) {
        const f32x4* hr = (const f32x4*)(out + (size_t)t * DMODEL) + lane; f32x4 v[8]; float ss = 0.f;
#pragma unroll
        for (int j = 0; j < 8; ++j) { v[j] = hr[64 * j]; ss += (v[j][0] * v[j][0] + v[j][1] * v[j][1]) + (v[j][2] * v[j][2] + v[j][3] * v[j][3]); }
        const float rstd = 1.0f / sqrtf(wave_sum(ss, lane) * (1.0f / DMODEL) + EPS_F);
        u32x2* o = (u32x2*)(TN + (size_t)t * DMODEL) + lane;
        const float* wrg_l = hide_p(w_rg); const float* wre_l = hide_p(w_re);
        float ga[4] = {0.f, 0.f, 0.f, 0.f};
#pragma unroll
        for (int j = 0; j < 8; ++j) {
            const f32x4 gg = ((const f32x4*)g_ffn)[lane + 64 * j]; v[j] = v[j] * gg;
            u32x2 w; w.x = pkbf(v[j][0] * rstd, v[j][1] * rstd); w.y = pkbf(v[j][2] * rstd, v[j][3] * rstd); o[64 * j] = w;
#pragma unroll
            for (int i = 0; i < 4; ++i) { const f32x4 wr_ = *(const f32x4*)(wrg_l + (unsigned)((4 * (lane + 64 * j) + i) * 4)); ga[0] += v[j][i] * wr_[0]; ga[1] += v[j][i] * wr_[1]; ga[2] += v[j][i] * wr_[2]; ga[3] += v[j][i] * wr_[3]; }
        }
        float gl[4];
#pragma unroll
        for (int k = 0; k < 4; ++k) gl[k] = wave_sum(ga[k], lane) * rstd + b_rg[k];
        int grp = 0; float gmx = gl[0];
#pragma unroll
        for (int k = 1; k < 4; ++k) if (gl[k] > gmx) { gmx = gl[k]; grp = k; }
        float gz = 0.f;
#pragma unroll
        for (int k = 0; k < 4; ++k) gz += __expf(gl[k] - gmx);
        const float p_grp = 1.0f / gz;
        float ea[8] = {0.f, 0.f, 0.f, 0.f, 0.f, 0.f, 0.f, 0.f};
#pragma unroll
        for (int j = 0; j < 8; ++j)
#pragma unroll
            for (int i = 0; i < 4; ++i) {
                const f32x4* we = (const f32x4*)(wre_l + (unsigned)((4 * (lane + 64 * j) + i) * 32 + grp * 8)); const f32x4 a = we[0], b2 = we[1];
                ea[0] += v[j][i] * a[0]; ea[1] += v[j][i] * a[1]; ea[2] += v[j][i] * a[2]; ea[3] += v[j][i] * a[3];
                ea[4] += v[j][i] * b2[0]; ea[5] += v[j][i] * b2[1]; ea[6] += v[j][i] * b2[2]; ea[7] += v[j][i] * b2[3];
            }
        float el[8];
#pragma unroll
        for (int k = 0; k < 8; ++k) el[k] = wave_sum(ea[k], lane) * rstd + b_re[grp * 8 + k];
        int i1 = 0; float m1 = el[0];
#pragma unroll
        for (int k = 1; k < 8; ++k) if (el[k] > m1) { m1 = el[k]; i1 = k; }
        int i2 = -1; float m2 = -INFINITY;
#pragma unroll
        for (int k = 0; k < 8; ++k) if (k != i1 && el[k] > m2) { m2 = el[k]; i2 = k; }
        const float e2 = __expf(m2 - m1); const float den = 1.0f / (1.0f + e2);
        const float g1 = p_grp * den, g2 = p_grp * e2 * den;
        if (lane == 0) {
            const int ex1 = grp * 8 + i1, ex2 = grp * 8 + i2;
            const unsigned r1 = atomicAdd(ctl + 64 * ex1, 1u), r2 = atomicAdd(ctl + 64 * ex2, 1u);
            asg_e[2 * t] = ex1; asg_e[2 * t + 1] = ex2; asg_r[2 * t] = (int)r1; asg_r[2 * t + 1] = (int)r2; asg_g[2 * t] = g1; asg_g[2 * t + 1] = g2;
        }
    }
    }
    XBAR();

    LAS int* tile_start = (LAS int*)(lds + LDS_MISC);
    {
    PH_LOCALS
    if (tid == 0) {
        int acc_t = 0;
        for (int e = 0; e < 32; ++e) { tile_start[e] = acc_t; const int c = (int)__hip_atomic_load(ctl + 64 * e, __ATOMIC_RELAXED, __HIP_MEMORY_SCOPE_AGENT); acc_t += (c + 255) >> 8; }
        tile_start[32] = acc_t;
    }
    __syncthreads();
    for (int a = gw; a < 2 * T_TOK; a += NGW) {
        const int t = a >> 1; const int e = asg_e[a], rk = asg_r[a]; const int slot = tile_start[e] * 256 + rk;
        if (lane == 0) { row_tok[slot] = t; row_gate[slot] = asg_g[a]; tok_slot[a] = slot; }
        const u32x4* src = (const u32x4*)(TN + (size_t)t * DMODEL) + lane; u32x4* dst = (u32x4*)(XG + (size_t)slot * DMODEL) + lane;
#pragma unroll
        for (int j = 0; j < 4; ++j) dst[64 * j] = src[64 * j];
    }
    }
    XBAR();

    {
        PH_LOCALS
        pg8::Gemm g{XG, WGU, MAXSLOT, 2048, 2048}; pg8::ExpertOrder S{tile_start, G, bx};
        pg8::EpiSwiglu E{HMID};
        pg8::gemm_phase<pg8::EpiSwiglu, pg8::ExpertOrder, true, true>(lds, g, S, E, tid);
    }
    XBAR();
    {
        PH_LOCALS
        pg8::Gemm g{HMID, WD, MAXSLOT, 2048, 1024}; pg8::ExpertOrder S{tile_start, G, bx};
        pg8::EpiDown E{Y, row_gate};
        pg8::gemm_phase<pg8::EpiDown, pg8::ExpertOrder, true, true>(lds, g, S, E, tid);
    }
    XBAR();

    {
    PH_LOCALS
    const float* g_fin = IN(16);
#if DBG_CMP
    const float dbg_scale = 1.0f + 4.0f * sqrtf(__hip_atomic_load((float*)(ctl + 4096), __ATOMIC_RELAXED, __HIP_MEMORY_SCOPE_AGENT) / __hip_atomic_load((float*)(ctl + 4097), __ATOMIC_RELAXED, __HIP_MEMORY_SCOPE_AGENT));
#else
    const float dbg_scale = 1.0f;
#endif
    for (int t = gw; t < T_TOK; t += NGW) {
        const int s0 = tok_slot[2 * t], s1 = tok_slot[2 * t + 1];
        f32x4* hr = (f32x4*)(out + (size_t)t * DMODEL) + lane; const u32x2* y0 = (const u32x2*)(Y + (size_t)s0 * DMODEL) + lane; const u32x2* y1 = (const u32x2*)(Y + (size_t)s1 * DMODEL) + lane;
        f32x4 v[8]; float ss = 0.f;
#pragma unroll
        for (int j = 0; j < 8; ++j) {
            v[j] = hr[64 * j]; const u32x2 a = y0[64 * j], b2 = y1[64 * j];
            v[j][0] += bflo(a.x) + bflo(b2.x); v[j][1] += bfhi(a.x) + bfhi(b2.x); v[j][2] += bflo(a.y) + bflo(b2.y); v[j][3] += bfhi(a.y) + bfhi(b2.y);
            ss += (v[j][0] * v[j][0] + v[j][1] * v[j][1]) + (v[j][2] * v[j][2] + v[j][3] * v[j][3]);
        }
        const float rstd = 1.0f / sqrtf(wave_sum(ss, lane) * (1.0f / DMODEL) + EPS_F);
#pragma unroll
        for (int j = 0; j < 8; ++j) { const f32x4 gg = ((const f32x4*)g_fin)[lane + 64 * j]; hr[64 * j] = v[j] * (rstd * dbg_scale) * gg; }
    }
    }
}

extern "C" void kernel_launch(void* const* d_in, const int* in_sizes, int n_in, void* d_out, int out_size, void* d_ws, size_t ws_size, hipStream_t stream) {
    static int grid_blocks = 0;
    if (grid_blocks == 0) {
        if (n_in != 17 || out_size != T_TOK * DMODEL || ws_size < WS_END) { fprintf(stderr, "kernel_launch: unexpected problem (n_in %d, out %d, ws %zu < %zu)\n", n_in, out_size, ws_size, (size_t)WS_END); grid_blocks = -1; return; }
        int dev = 0, cus = 0, per_cu = 0;
        (void)hipGetDevice(&dev);
        (void)hipDeviceGetAttribute(&cus, hipDeviceAttributeMultiprocessorCount, dev);
        if (hipFuncSetAttribute((const void*)mega_fwd, hipFuncAttributeMaxDynamicSharedMemorySize, LDS_BYTES) != hipSuccess) { fprintf(stderr, "kernel_launch: hipFuncSetAttribute failed\n"); grid_blocks = -1; return; }
        if (hipOccupancyMaxActiveBlocksPerMultiprocessor(&per_cu, (const void*)mega_fwd, 512, LDS_BYTES) != hipSuccess || per_cu < 1) { fprintf(stderr, "kernel_launch: occupancy query says %d\n", per_cu); grid_blocks = -1; return; }
        grid_blocks = cus;
        fprintf(stderr, "kernel_launch: cus %d per_cu %d grid %d ws %zu need %zu\n", cus, per_cu, grid_blocks, ws_size, (size_t)WS_END);
    }
    if (grid_blocks < 0) return;
    if (hipMemsetAsync((char*)d_ws + WS_CTL, 0, 65536, stream) != hipSuccess) { fprintf(stderr, "kernel_launch: memset of control words failed\n"); return; }
    Params prm{};
    for (int i = 0; i < 17; ++i) prm.in[i] = (const float*)d_in[i];
    prm.out = (float*)d_out; prm.ws = (unsigned char*)d_ws;
    void* args[] = {&prm};
    hipError_t e = hipLaunchCooperativeKernel((void*)mega_fwd, dim3(grid_blocks), dim3(512), args, LDS_BYTES, stream);
    if (e != hipSuccess) fprintf(stderr, "cooperative launch failed: %s (grid %d)\n", hipGetErrorString(e), grid_blocks);
}
```

```cpp
#include <hip/hip_runtime.h>
#include <hip/hip_cooperative_groups.h>
#include <cstdio>
#include <cstdint>
namespace cg = cooperative_groups;
namespace pg8 {
#define PG8_LAS __attribute__((address_space(3)))
typedef unsigned short bf16_t;
typedef short bf16x8 __attribute__((ext_vector_type(8)));
typedef float f32x4 __attribute__((ext_vector_type(4)));
typedef unsigned u32x4 __attribute__((ext_vector_type(4)));
constexpr int BM = 256, BK = 64, HALF = 128, HTB = HALF * BK * 2  , STAGE_BYTES = 8 * HTB, NXCD = 8, WGM = 8;

__host__ __device__ __forceinline__ int lds_byte(int r, int c) { const int st = (r >> 4) * 2 + (c >> 5), rr = r & 15, cc = c & 31, ob = rr * 64 + cc * 2; return st * 1024 + (ob ^ (((ob >> 9) & 1) << 5)); }
__host__ __device__ __forceinline__ void stage_rc(int b, int& R, int& C) { const int st = b / 1024, sb = b % 1024, swz = sb ^ (((sb >> 9) & 1) << 5); R = (st >> 1) * 16 + swz / 64; C = (st & 1) * 32 + (swz % 64) / 2; }
__host__ __device__ __forceinline__ int perm32(int rho) { const int n = rho >> 4, i = rho & 15; return 8 * (i >> 2) + 4 * n + (i & 3); }

struct Unit { int pm, pn, e; };
struct Gemm { const bf16_t* A; const bf16_t* Bt; int M, N, K; };

struct StaticOrder {
    int nM, nN, nwg, G, c;
    __host__ __device__ void init(int M, int N, int G_, int c_) { nM = M / BM; nN = N / BM; nwg = nM * nN; G = G_; c = c_; }
    __host__ __device__ bool next(int i, Unit& u) const {
        const long L = (long)i * G + c; if (L >= nwg) return false;
        int wgid = (int)L; { const int q = nwg / NXCD, r = nwg % NXCD, xcd = wgid % NXCD, off = wgid / NXCD; wgid = (xcd < r ? xcd * (q + 1) : r * (q + 1) + (xcd - r) * q) + off; }
        const int nig = WGM * nN, gid = wgid / nig, fm = gid * WGM, gsz = (nM - fm) < WGM ? (nM - fm) : WGM;
        u.pm = fm + ((wgid % nig) % gsz); u.pn = (wgid % nig) / gsz; u.e = 0; return true;
    }
    __device__ __forceinline__ void a_ready(const Unit&) const {}
    __device__ __forceinline__ void done(const Unit&) const {}
};

template <class Epi, class Sched, bool ALIGN_EPI = false, bool SP2 = false>
__device__ __forceinline__ void gemm_phase(PG8_LAS unsigned char* lds, const Gemm g, const Sched& S, const Epi& E, const int tid) {
    const int wid = __builtin_amdgcn_readfirstlane(tid >> 6), lane = tid & 63, wr = wid >> 2, wc = wid & 3, fr = lane & 15, fq = lane >> 4;
    const int K = g.K, nt = K / BK;
    unsigned voffA[2], voffB[2];
#pragma unroll
    for (int i = 0; i < 2; ++i) { int R, C; stage_rc(tid * 16 + i * 8192, R, C); const int Rb = Epi::PERM ? ((R & ~31) + perm32(R & 31)) : R;
        voffA[i] = (unsigned)(R * K + C) * 2u; voffB[i] = (unsigned)(Rb * K + C) * 2u; }
    const size_t kstep = (size_t)(BK * 2);
    const size_t hstep = (size_t)HALF * K * 2;
    const size_t tstep = 2 * hstep;
    const unsigned ldsw = (unsigned)wid * 1024u;
    const int aoff = lds_byte(wr * 64 + fr, fq * 8), boff = lds_byte(wc * 32 + fr, fq * 8);
#define PG8_SA(b, h) (((b) * 2 + (h)) * HTB)
#define PG8_SB(b, h) ((4 + (b) * 2 + (h)) * HTB)
#define PG8_STAGE(bufoff, gbase, voff) do { _Pragma("unroll") for (int _i = 0; _i < 2; ++_i) \
        __builtin_amdgcn_global_load_lds((const unsigned*)((const char*)(gbase) + (voff)[_i]), (PG8_LAS unsigned*)(lds + (bufoff) + ldsw + _i * 8192), 16, 0, 0); } while (0)
#define PG8_LDA(dst, b, h) do { _Pragma("unroll") for (int m = 0; m < 4; ++m) _Pragma("unroll") for (int k = 0; k < 2; ++k) dst[m][k] = *(const PG8_LAS bf16x8*)(lds + PG8_SA(b, h) + aoff + m * 2048 + k * 1024); } while (0)
#define PG8_LDB(dst, b, h) do { _Pragma("unroll") for (int n = 0; n < 2; ++n) _Pragma("unroll") for (int k = 0; k < 2; ++k) dst[n][k] = *(const PG8_LAS bf16x8*)(lds + PG8_SB(b, h) + boff + n * 2048 + k * 1024); } while (0)
#define PG8_MMA(ai, bj, At, Bt) do { __builtin_amdgcn_s_setprio(1); _Pragma("unroll") for (int m = 0; m < 4; ++m) _Pragma("unroll") for (int n = 0; n < 2; ++n) _Pragma("unroll") for (int k = 0; k < 2; ++k) \
        acc[ai][bj][m][n] = __builtin_amdgcn_mfma_f32_16x16x32_bf16(Bt[n][k], At[m][k], acc[ai][bj][m][n], 0, 0, 0); __builtin_amdgcn_s_setprio(0); } while (0)
#define PG8_WAIT_V(n) asm volatile("s_waitcnt vmcnt(" #n ")" ::: "memory")
#define PG8_WAIT_L(n) asm volatile("s_waitcnt lgkmcnt(" #n ")" ::: "memory")
#define PG8_BAR __builtin_amdgcn_s_barrier()
#define PG8_SCHED __builtin_amdgcn_sched_barrier(0)
    Unit cur, nxt; int ui = 0;
    if (!S.next(0, cur)) return;
    f32x4 acc[2][2][4][2];
#pragma unroll
    for (int a = 0; a < 2; ++a)
#pragma unroll
        for (int b = 0; b < 2; ++b)
#pragma unroll
            for (int m = 0; m < 4; ++m)
#pragma unroll
                for (int n = 0; n < 2; ++n) acc[a][b][m][n] = (f32x4){0.f, 0.f, 0.f, 0.f};
    bf16x8 At[4][2], B0[2][2], B1[2][2];
    const size_t estep = (size_t)g.N * K * 2;
    const char* cA = (const char*)g.A + (size_t)cur.pm * tstep; const char* cB = (const char*)g.Bt + (size_t)cur.e * estep + (size_t)cur.pn * tstep;
    S.a_ready(cur);
    if constexpr (SP2) {
        PG8_STAGE(PG8_SB(0, 0), cB, voffB); PG8_STAGE(PG8_SB(0, 1), cB + hstep, voffB); PG8_STAGE(PG8_SA(0, 0), cA, voffA); PG8_STAGE(PG8_SA(0, 1), cA + hstep, voffA);
        if (wr == 1) PG8_BAR;
        PG8_WAIT_V(2); PG8_BAR;
        PG8_STAGE(PG8_SB(1, 0), cB + kstep, voffB); PG8_STAGE(PG8_SA(1, 0), cA + kstep, voffA); PG8_STAGE(PG8_SB(1, 1), cB + hstep + kstep, voffB);
        PG8_WAIT_V(6); PG8_BAR;
    } else {
        PG8_STAGE(PG8_SB(0, 0), cB, voffB); PG8_STAGE(PG8_SA(0, 0), cA, voffA); PG8_STAGE(PG8_SB(0, 1), cB + hstep, voffB); PG8_STAGE(PG8_SA(0, 1), cA + hstep, voffA);
        if (wr == 1) PG8_BAR;
        PG8_WAIT_V(4); PG8_BAR;
        PG8_STAGE(PG8_SB(1, 0), cB + kstep, voffB); PG8_STAGE(PG8_SA(1, 0), cA + kstep, voffA); PG8_STAGE(PG8_SB(1, 1), cB + hstep + kstep, voffB);
        PG8_WAIT_V(6); PG8_BAR;
    }
    for (;;) {
        const bool has_next = S.next(ui + 1, nxt);
        const char* nA = has_next ? (const char*)g.A + (size_t)nxt.pm * tstep : cA; const char* nB = has_next ? (const char*)g.Bt + (size_t)nxt.e * estep + (size_t)nxt.pn * tstep : cB;
        for (int t = 0; t < nt; t += 2) {
            const bool last = (t == nt - 2);
            const char* a1 = cA + (size_t)(t + 1) * kstep;
            const char* a2 = last ? nA : cA + (size_t)(t + 2) * kstep; const char* b2 = last ? nB : cB + (size_t)(t + 2) * kstep;
            const char* a3 = a2 + kstep; const char* b3 = b2 + kstep;
            if (last && has_next) S.a_ready(nxt);
            if constexpr (SP2) {
            PG8_LDB(B0, 0, 0); PG8_LDB(B1, 0, 1); PG8_SCHED; PG8_LDA(At, 0, 0); PG8_STAGE(PG8_SA(1, 1), a1 + hstep, voffA);
            PG8_WAIT_V(8); PG8_WAIT_L(0); PG8_BAR; PG8_MMA(0, 0, At, B0); PG8_MMA(0, 1, At, B1); PG8_BAR; PG8_SCHED;
            PG8_LDA(At, 0, 1); PG8_STAGE(PG8_SB(0, 0), b2, voffB); PG8_STAGE(PG8_SB(0, 1), b2 + hstep, voffB); PG8_STAGE(PG8_SA(0, 0), a2, voffA);
            PG8_WAIT_V(8); PG8_WAIT_L(0); PG8_BAR; PG8_MMA(1, 0, At, B0); PG8_MMA(1, 1, At, B1); PG8_BAR; PG8_SCHED;
            PG8_LDB(B0, 1, 0); PG8_LDB(B1, 1, 1); PG8_SCHED; PG8_LDA(At, 1, 0); PG8_STAGE(PG8_SA(0, 1), a2 + hstep, voffA);
            PG8_WAIT_V(8); PG8_WAIT_L(0); PG8_BAR; PG8_MMA(0, 0, At, B0); PG8_MMA(0, 1, At, B1); PG8_BAR; PG8_SCHED;
            PG8_LDA(At, 1, 1); PG8_STAGE(PG8_SB(1, 0), b3, voffB); PG8_STAGE(PG8_SB(1, 1), b3 + hstep, voffB); PG8_STAGE(PG8_SA(1, 0), a3, voffA);
            PG8_WAIT_V(8); PG8_WAIT_L(0); PG8_BAR; PG8_MMA(1, 0, At, B0); PG8_MMA(1, 1, At, B1); PG8_BAR; PG8_SCHED;
            } else {
            PG8_LDB(B0, 0, 0); PG8_SCHED; PG8_LDA(At, 0, 0); PG8_STAGE(PG8_SA(1, 1), a1 + hstep, voffA);
            PG8_WAIT_L(8); PG8_BAR; PG8_WAIT_L(0); PG8_MMA(0, 0, At, B0); PG8_BAR; PG8_SCHED;
            PG8_LDB(B1, 0, 1); PG8_STAGE(PG8_SB(0, 0), b2, voffB);
            PG8_BAR; PG8_WAIT_L(0); PG8_MMA(0, 1, At, B1); PG8_BAR;
            PG8_LDA(At, 0, 1); PG8_STAGE(PG8_SA(0, 0), a2, voffA);
            PG8_BAR; PG8_WAIT_L(0); PG8_MMA(1, 0, At, B0); PG8_BAR; PG8_SCHED;
            PG8_STAGE(PG8_SB(0, 1), b2 + hstep, voffB);
            PG8_WAIT_V(6); PG8_BAR; PG8_MMA(1, 1, At, B1); PG8_BAR;
            PG8_LDB(B0, 1, 0); PG8_SCHED; PG8_LDA(At, 1, 0); PG8_STAGE(PG8_SA(0, 1), a2 + hstep, voffA);
            PG8_WAIT_L(8); PG8_BAR; PG8_WAIT_L(0); PG8_MMA(0, 0, At, B0); PG8_BAR; PG8_SCHED;
            PG8_LDB(B1, 1, 1); PG8_STAGE(PG8_SB(1, 0), b3, voffB);
            PG8_BAR; PG8_WAIT_L(0); PG8_MMA(0, 1, At, B1); PG8_BAR;
            PG8_LDA(At, 1, 1); PG8_STAGE(PG8_SA(1, 0), a3, voffA);
            PG8_BAR; PG8_WAIT_L(0); PG8_MMA(1, 0, At, B0); PG8_BAR; PG8_SCHED;
            PG8_STAGE(PG8_SB(1, 1), b3 + hstep, voffB);
            PG8_WAIT_V(6); PG8_BAR; PG8_MMA(1, 1, At, B1); PG8_BAR;
            }
        }
        if constexpr (ALIGN_EPI) { if (wr == 0) PG8_BAR; }
        if constexpr (!Epi::AFTER_DRAIN) { E(acc, cur, wr, wc, fr, fq); S.done(cur); }
        if (!has_next) break;
#pragma unroll
        for (int a = 0; a < 2; ++a)
#pragma unroll
            for (int b = 0; b < 2; ++b)
#pragma unroll
                for (int m = 0; m < 4; ++m)
#pragma unroll
                    for (int n = 0; n < 2; ++n) acc[a][b][m][n] = (f32x4){0.f, 0.f, 0.f, 0.f};
        cur = nxt; cA = nA; cB = nB; ++ui;
        if constexpr (ALIGN_EPI) { if (wr == 1) PG8_BAR; }
    }
    PG8_WAIT_V(0);
    if constexpr (!ALIGN_EPI) { if (wr == 0) PG8_BAR; }
    PG8_BAR;
    if constexpr (Epi::AFTER_DRAIN) { E.fused(acc, cur, wr, wc, fr, fq, lds, wid, lane); S.done(cur); }
#undef PG8_SA
#undef PG8_SB
#undef PG8_STAGE
#undef PG8_LDA
#undef PG8_LDB
#undef PG8_MMA
#undef PG8_WAIT_V
#undef PG8_WAIT_L
#undef PG8_BAR
#undef PG8_SCHED
}
}

#ifndef DBG_CMP
#define DBG_CMP 0
#endif
#define LAS __attribute__((address_space(3)))
typedef unsigned short bf16_t;
typedef float f32x4 __attribute__((ext_vector_type(4)));
typedef unsigned u32x4 __attribute__((ext_vector_type(4)));
typedef unsigned u32x2 __attribute__((ext_vector_type(2)));
typedef unsigned long long u64;

constexpr int T_TOK = 16384, DMODEL = 2048, SEQL = 2048;
constexpr int NPROJ = 9984;
constexpr int C_QLAT = 0, C_CKV = 1024, C_QIDX = 1152, C_KIDX = 1664, C_WIDX = 1728, C_QR = 1792, C_KR = 2816, C_VR = 3840, C_GR = 4864, C_GBR = 5888;
constexpr int MAXSLOT = 40960;
constexpr float EPS_F = 1e-6f;
constexpr float IDX_SCALE = 0.04419417382415922f;
constexpr float ATT_SCALE = 0.08838834764831845f;
constexpr float K_SCALE = 0.08838834764831845f;

constexpr size_t WS_CTL = 0;
constexpr size_t WS_ROT = 65536;
constexpr size_t WS_WIN = WS_ROT + 1048576;
constexpr size_t WS_WCOMB = WS_WIN + (size_t)NPROJ * 2048 * 2;
constexpr size_t WS_WB = WS_WCOMB + (size_t)2048 * 1024 * 2;
constexpr size_t WS_WO = WS_WB + (size_t)2048 * 1024 * 2;
constexpr size_t WS_WGU = WS_WO + (size_t)2048 * 2048 * 2;
constexpr size_t WS_WD = WS_WGU + (size_t)32 * 2048 * 2048 * 2;
constexpr size_t WS_P = WS_WD + (size_t)32 * 2048 * 1024 * 2;
constexpr size_t WS_HMID = WS_P;
constexpr size_t WS_Y = WS_HMID + (size_t)MAXSLOT * 1024 * 2;
constexpr size_t WS_XN = WS_P + (size_t)T_TOK * NPROJ * 2;
constexpr size_t WS_OA = WS_XN + (size_t)T_TOK * 2048 * 2;
constexpr size_t WS_OB = WS_OA + (size_t)T_TOK * 1024 * 2;
constexpr size_t WS_MIXED = WS_OB + (size_t)T_TOK * 1024 * 2;
constexpr size_t WS_SPARE = WS_MIXED + (size_t)T_TOK * 2048 * 2;
constexpr size_t WS_XG = WS_OA;
constexpr size_t WS_KV = WS_SPARE + (size_t)T_TOK * 1024 * 2;
constexpr size_t WS_MASK = WS_KV + (size_t)T_TOK * 128 * 2;
constexpr size_t WS_MISC = WS_MASK + (size_t)T_TOK * 256;
constexpr size_t WS_WC = WS_MISC + 1048576;
constexpr size_t WS_END = WS_WC + 1048576;
static_assert(WS_Y + (size_t)MAXSLOT * 2048 * 2 <= WS_XN, "HMID + Y must fit in P");
static_assert(WS_XG + (size_t)MAXSLOT * 2048 * 2 <= WS_KV, "XG must fit in OA..SPARE");
static_assert(WS_END <= (size_t)1073741824, "workspace budget");
constexpr int MI_ROWTOK = 0, MI_ROWGATE = MAXSLOT, MI_TOKSLOT = 2 * MAXSLOT, MI_ASGE = MI_TOKSLOT + 2 * T_TOK, MI_ASGR = MI_ASGE + 2 * T_TOK, MI_ASGG = MI_ASGR + 2 * T_TOK;
static_assert((size_t)(MI_ASGG + 2 * T_TOK) * 4 <= 1048576, "misc budget");
constexpr int LDS_BYTES = 136 * 1024;
constexpr int LDS_MISC = 132 * 1024;

__device__ __forceinline__ float bflo(unsigned w) { return __uint_as_float(w << 16); }
__device__ __forceinline__ float bfhi(unsigned w) { return __uint_as_float(w & 0xffff0000u); }
__device__ __forceinline__ unsigned pkbf(float lo, float hi) { unsigned r; asm volatile("v_cvt_pk_bf16_f32 %0, %1, %2" : "=v"(r) : "v"(lo), "v"(hi)); return r; }
__device__ __forceinline__ int hide_i(int v) { asm volatile("" : "+v"(v)); return v; }
template <class Tp> __device__ __forceinline__ Tp* hide_p(Tp* q) { asm volatile("" : "+s"(q)); return q; }
__device__ __forceinline__ float shx(float v, int lane, int o) { return __int_as_float(__builtin_amdgcn_ds_bpermute((lane ^ o) << 2, __float_as_int(v))); }
__device__ __forceinline__ float wave_sum(float v, int lane) {
#pragma unroll
    for (int o = 1; o < 64; o <<= 1) v += shx(v, lane, o);
    return v;
}
__device__ __forceinline__ float wave_max(float v, int lane) {
#pragma unroll
    for (int o = 1; o < 64; o <<= 1) v = fmaxf(v, shx(v, lane, o));
    return v;
}
__device__ __forceinline__ float sigmoidf_(float x) { return __builtin_amdgcn_rcpf(1.0f + __expf(-x)); }
__device__ __forceinline__ float siluf_(float x) { return x * sigmoidf_(x); }
__device__ __forceinline__ unsigned fkey(float f) { const unsigned u = __float_as_uint(f + 0.0f); return (u & 0x80000000u) ? ~u : (u | 0x80000000u); }


#define XB_TMO      128
#define XB_XCNT(j)  (256  + 64 * (j))
#define XB_XSUB(j)  (1280 + 64 * (j))
#define XB_XGEN(j)  (2304 + 64 * (j))
#define XB_TOP      3328
#define XB_TOPGEN   3392
#define XCD_BAR_WORDS 3456
#define XB_SPIN_CAP (1u << 18)
__device__ __forceinline__ unsigned xb_ld(unsigned* p)              { return __hip_atomic_load(p, __ATOMIC_RELAXED, __HIP_MEMORY_SCOPE_AGENT); }
__device__ __forceinline__ unsigned xb_add(unsigned* p, unsigned v) { return __hip_atomic_fetch_add(p, v, __ATOMIC_RELAXED, __HIP_MEMORY_SCOPE_AGENT); }
__device__ __forceinline__ unsigned xb_xcc_id() { return (unsigned)__builtin_amdgcn_s_getreg((3 << 11) | 20) & 0xFu; }
#define XB_SPIN(cond, bar) do { unsigned _sp = 0; while (cond) { __builtin_amdgcn_s_sleep(1); \
    if ((++_sp & 255u) == 0u) { if (xb_ld(&(bar)[XB_TMO])) break; if (_sp > XB_SPIN_CAP) { atomicAdd(&(bar)[XB_TMO], 1u); break; } } } } while (0)
struct XcdBarrier { unsigned* bar; unsigned x; volatile __attribute__((address_space(3))) unsigned* st; };
__device__ __forceinline__ void xcd_barrier_complete(unsigned* bar, unsigned x, unsigned& nloc, unsigned& nx) {
    const unsigned G = gridDim.x * gridDim.y * gridDim.z;
    unsigned sum, cnt, mine, sp = 0u;
    for (;;) {
        sum = 0u; cnt = 0u; mine = 0u;
#pragma unroll
        for (unsigned j = 0; j < 16; ++j) { const unsigned c = xb_ld(&bar[XB_XCNT(j)]); sum += c; cnt += (c > 0u) ? 1u : 0u; mine = (j == x) ? c : mine; }
        if (sum == G) break;
        __builtin_amdgcn_s_sleep(1);
        if ((++sp & 255u) == 0u) { if (xb_ld(&bar[XB_TMO])) break; if (sp > XB_SPIN_CAP) { atomicAdd(&bar[XB_TMO], 1u); break; } }
    }
    nloc = mine > 0u ? mine : 1u; nx = cnt > 0u ? cnt : 1u;
}
__device__ __forceinline__ void xcd_barrier(const XcdBarrier& b, int tid) {
    asm volatile("s_waitcnt vmcnt(0)" ::: "memory");
    __syncthreads();
    if (tid == 0) {
        unsigned* bar = b.bar;
        __builtin_amdgcn_s_waitcnt(0);
        unsigned nloc = b.st[0], nx = b.st[1];
        if (nloc == 0u) { xcd_barrier_complete(bar, b.x, nloc, nx); b.st[0] = nloc; b.st[1] = nx; }
        const unsigned old = xb_add(&bar[XB_XSUB(b.x)], 1u);
        const unsigned gen = old / nloc;
        if (old + 1u == (gen + 1u) * nloc) {
            __builtin_amdgcn_fence(__ATOMIC_RELEASE, "agent");
            asm volatile("s_waitcnt vmcnt(0)" ::: "memory");
            const unsigned og = xb_add(&bar[XB_TOP], 1u);
            const unsigned tg = og / nx;
            if (og + 1u == (tg + 1u) * nx) xb_add(&bar[XB_TOPGEN], 1u);
            else XB_SPIN(xb_ld(&bar[XB_TOPGEN]) == tg, bar);
            __builtin_amdgcn_fence(__ATOMIC_ACQUIRE, "agent");
            xb_add(&bar[XB_XGEN(b.x)], 1u);
            asm volatile("s_waitcnt vmcnt(0)" ::: "memory");
        } else {
            XB_SPIN(xb_ld(&bar[XB_XGEN(b.x)]) == gen, bar);
            __builtin_amdgcn_fence(__ATOMIC_ACQUIRE, "agent");
            asm volatile("s_waitcnt vmcnt(0)" ::: "memory");
        }
    }
    __syncthreads();
}

namespace fa {
using bf16x8 = __attribute__((ext_vector_type(8))) short;
using s16x4  = __attribute__((ext_vector_type(4))) short;
using f32x16 = __attribute__((ext_vector_type(16))) float;
constexpr int TILE_B = 64 * 128 * 2;
constexpr int OFF_V = 0, OFF_K = 2 * TILE_B, OFF_M = 4 * TILE_B, OFF_WS = OFF_M + 2 * 256, LDS_NEED = OFF_WS + 8 * 256;
#define FA_KSWZ(row, colB) ((row) * 256 + ((colB) ^ (((row) & 7) << 4)))
#define FA_SBAR() __builtin_amdgcn_sched_barrier(0)
__device__ __forceinline__ int crow(int r, int hi) { return (r & 3) + 8 * (r >> 2) + 4 * hi; }
__device__ __forceinline__ int v_st(int k, int c) { const int kk = (k & ~0xC) | ((k & 4) << 1) | ((k & 8) >> 1); return ((kk >> 3) * 4 + (c >> 5)) * 512 + ((kk & 7) * 32 + (c & 31)) * 2; }
__device__ __forceinline__ int v_rd_base(int lane) { return ((lane & 3) << 3) | (((lane >> 2) & 3) << 6) | (((lane >> 4) & 1) << 5) | (((lane >> 5) & 1) << 8); }
constexpr int v_rd_off(int d0, int ks, int half) { return d0 * 512 + ks * 4096 + half * 2048; }
template <int OFF> __device__ __forceinline__ s16x4 tr_read(int vb) { s16x4 r; asm volatile("ds_read_b64_tr_b16 %0, %1 offset:%2" : "=&v"(r) : "v"(vb), "i"(OFF) : "memory"); return r; }
template <int D0> __device__ __forceinline__ void pv_one(f32x16& od, int vb, bf16x8 pa0, bf16x8 pa1, bf16x8 pa2, bf16x8 pa3) {
    const s16x4 l0 = tr_read<v_rd_off(D0, 0, 0)>(vb), h0 = tr_read<v_rd_off(D0, 0, 1)>(vb), l1 = tr_read<v_rd_off(D0, 1, 0)>(vb), h1 = tr_read<v_rd_off(D0, 1, 1)>(vb);
    const s16x4 l2 = tr_read<v_rd_off(D0, 2, 0)>(vb), h2 = tr_read<v_rd_off(D0, 2, 1)>(vb), l3 = tr_read<v_rd_off(D0, 3, 0)>(vb), h3 = tr_read<v_rd_off(D0, 3, 1)>(vb);
    asm volatile("s_waitcnt lgkmcnt(0)" ::: "memory"); FA_SBAR();
#define FA_PK(L, H) (bf16x8){L[0], L[1], L[2], L[3], H[0], H[1], H[2], H[3]}
    od = __builtin_amdgcn_mfma_f32_32x32x16_bf16(pa0, FA_PK(l0, h0), od, 0, 0, 0);
    od = __builtin_amdgcn_mfma_f32_32x32x16_bf16(pa1, FA_PK(l1, h1), od, 0, 0, 0);
    od = __builtin_amdgcn_mfma_f32_32x32x16_bf16(pa2, FA_PK(l2, h2), od, 0, 0, 0);
    od = __builtin_amdgcn_mfma_f32_32x32x16_bf16(pa3, FA_PK(l3, h3), od, 0, 0, 0);
#undef FA_PK
}
__device__ __forceinline__ void qkt(f32x16& p0, f32x16& p1, const LAS char* Ks, const bf16x8 (&qr)[8], int r32, int hi) {
    p0 = f32x16{}; p1 = f32x16{};
#pragma unroll
    for (int d0 = 0; d0 < 8; ++d0) { const int cb = (d0 * 16 + hi * 8) * 2;
        const bf16x8 b0 = *(const LAS bf16x8*)(Ks + FA_KSWZ(r32, cb));
        const bf16x8 b1 = *(const LAS bf16x8*)(Ks + FA_KSWZ(32 + r32, cb));
        p0 = __builtin_amdgcn_mfma_f32_32x32x16_bf16(b0, qr[d0], p0, 0, 0, 0);
        p1 = __builtin_amdgcn_mfma_f32_32x32x16_bf16(b1, qr[d0], p1, 0, 0, 0); }
}
__device__ __forceinline__ void p_to_frag(const f32x16& p0, const f32x16& p1, bf16x8& pa0, bf16x8& pa1, bf16x8& pa2, bf16x8& pa3) {
#define FA_PK4(P, BASE, OUT) do { unsigned a0 = pkbf(P[BASE + 0], P[BASE + 1]), a1 = pkbf(P[BASE + 2], P[BASE + 3]);   \
    unsigned b0 = pkbf(P[BASE + 4], P[BASE + 5]), b1 = pkbf(P[BASE + 6], P[BASE + 7]);                              \
    auto r0 = __builtin_amdgcn_permlane32_swap(a0, b0, false, false); auto r1 = __builtin_amdgcn_permlane32_swap(a1, b1, false, false); \
    u32x4 w = {r0[0], r1[0], r0[1], r1[1]}; OUT = *reinterpret_cast<bf16x8*>(&w); } while (0)
    FA_PK4(p0, 0, pa0); FA_PK4(p0, 8, pa1); FA_PK4(p1, 0, pa2); FA_PK4(p1, 8, pa3);
#undef FA_PK4
}

struct UnitArgs {
    const bf16_t* Q; int ldq;
    const bf16_t* K; const bf16_t* V; int ldk;
    const u64* mask;
    int ntiles;
    int n0;
    float lgam;
};

template <int MODE>
__device__ __forceinline__ void unit_body(LAS char* L, const UnitArgs& U, int tid, f32x16 (&o)[4], float& l_out) {
    const int wid = __builtin_amdgcn_readfirstlane(tid >> 6), lane = tid & 63, r32 = lane & 31, hi = lane >> 5;
    LAS char* V_lds = L + OFF_V; LAS char* K_lds = L + OFF_K; LAS u64* M_lds = (LAS u64*)(L + OFF_M);
    LAS float* wsf = (LAS float*)(L + OFF_WS) + wid * 64; LAS float* al_l = wsf + 32;
    constexpr float C = ATT_SCALE * 1.4426950408889634f;
    float m_reg = -1e30f, l_reg = 0.f;
#pragma unroll
    for (int d = 0; d < 4; ++d) o[d] = f32x16{};
    bf16x8 qr[8];
    { const bf16_t* Qw = (MODE == 0) ? U.Q + (size_t)r32 * U.ldq + wid * 128 + hi * 8 : U.Q + (size_t)(wid * 32 + r32) * U.ldq + hi * 8;
#pragma unroll
      for (int d0 = 0; d0 < 8; ++d0) qr[d0] = *(const bf16x8*)(Qw + d0 * 16); }
    const int sr = tid >> 4, sc = (tid & 15) * 8, vst0 = v_st(sr, sc), vst1 = v_st(32 + sr, sc), kst0 = FA_KSWZ(sr, sc * 2), kst1 = FA_KSWZ(32 + sr, sc * 2);
    const int vb0 = (int)(unsigned)(size_t)V_lds + v_rd_base(lane);
    bf16x8 ks0, ks1, vs0, vs1; u64 mws = 0ull;
#define FA_SLOAD(k0) do { ks0 = *(const bf16x8*)(U.K + (size_t)((k0) + sr) * U.ldk + sc); ks1 = *(const bf16x8*)(U.K + (size_t)((k0) + 32 + sr) * U.ldk + sc); \
        if (MODE == 1) { vs0 = *(const bf16x8*)(U.V + (size_t)((k0) + sr) * U.ldk + sc); vs1 = *(const bf16x8*)(U.V + (size_t)((k0) + 32 + sr) * U.ldk + sc); } \
        if (MODE == 0 && tid < 32) mws = U.mask[(size_t)tid * 32 + ((k0) >> 6)]; } while (0)
#define FA_SWRITE(b) do { *(LAS bf16x8*)(K_lds + (b) * TILE_B + kst0) = ks0; *(LAS bf16x8*)(K_lds + (b) * TILE_B + kst1) = ks1; \
        *(LAS bf16x8*)(V_lds + (b) * TILE_B + vst0) = (MODE == 1) ? vs0 : ks0; *(LAS bf16x8*)(V_lds + (b) * TILE_B + vst1) = (MODE == 1) ? vs1 : ks1; \
        if (MODE == 0 && tid < 32) M_lds[(b) * 32 + tid] = mws; } while (0)
    const int NT = U.ntiles;
    FA_SLOAD(0); FA_SWRITE(0);
    if (NT > 1) { FA_SLOAD(64); FA_SWRITE(1); }
    __syncthreads();
    for (int j = 0; j < NT; ++j) {
        const int b = j & 1;
        if (j + 2 < NT) FA_SLOAD((j + 2) * 64);
        f32x16 p0, p1; bf16x8 pa0, pa1, pa2, pa3;
        qkt(p0, p1, K_lds + b * TILE_B, qr, r32, hi);
        if (MODE == 0) {
            const u64 mw = M_lds[b * 32 + r32] >> (4 * hi);
            const unsigned mlo = (unsigned)mw, mhi = (unsigned)(mw >> 32);
#pragma unroll
            for (int r = 0; r < 16; ++r) { const unsigned bit = 1u << ((r & 3) + 8 * (r >> 2)); p0[r] = (mlo & bit) ? p0[r] : -INFINITY; p1[r] = (mhi & bit) ? p1[r] : -INFINITY; }
            float pmax = p0[0];
#pragma unroll
            for (int r = 1; r < 16; ++r) pmax = fmaxf(pmax, p0[r]);
#pragma unroll
            for (int r = 0; r < 16; ++r) pmax = fmaxf(pmax, p1[r]);
            { auto rr = __builtin_amdgcn_permlane32_swap(__float_as_uint(pmax), __float_as_uint(pmax), false, false); pmax = fmaxf(__uint_as_float(rr[0]), __uint_as_float(rr[1])); }
            const float mn = fmaxf(m_reg, pmax); const float alpha = __builtin_amdgcn_exp2f((m_reg - mn) * C); m_reg = mn;
            const float mnC = -mn * C; float ps = 0.f;
#pragma unroll
            for (int r = 0; r < 16; ++r) { p0[r] = __builtin_amdgcn_exp2f(fmaf(p0[r], C, mnC)); p1[r] = __builtin_amdgcn_exp2f(fmaf(p1[r], C, mnC)); ps += p0[r] + p1[r]; }
            { auto rr = __builtin_amdgcn_permlane32_swap(__float_as_uint(ps), __float_as_uint(ps), false, false); ps = __uint_as_float(rr[0]) + __uint_as_float(rr[1]); }
            l_reg = l_reg * alpha + ps;
            if (__any(alpha < 1.f)) {
                if (hi == 0) al_l[r32] = alpha;
                asm volatile("s_waitcnt lgkmcnt(0)" ::: "memory");
#pragma unroll
                for (int r = 0; r < 16; ++r) { const float a = al_l[crow(r, hi)];
#pragma unroll
                    for (int d = 0; d < 4; ++d) o[d][r] *= a; }
            }
        } else {
            const int dn = U.n0 + wid * 32 + r32 - j * 64 - 4 * hi;
            const float base = (float)dn * U.lgam;
#pragma unroll
            for (int r = 0; r < 16; ++r) { const int kk = (r & 3) + 8 * (r >> 2);
                const float f0 = __builtin_amdgcn_exp2f(base - (float)kk * U.lgam), f1 = __builtin_amdgcn_exp2f(base - (float)(kk + 32) * U.lgam);
                p0[r] = (dn >= kk) ? p0[r] * f0 : 0.f; p1[r] = (dn >= kk + 32) ? p1[r] * f1 : 0.f; }
        }
        p_to_frag(p0, p1, pa0, pa1, pa2, pa3);
        FA_SBAR();
        { const int vb = vb0 + b * TILE_B;
          pv_one<0>(o[0], vb, pa0, pa1, pa2, pa3); pv_one<1>(o[1], vb, pa0, pa1, pa2, pa3); pv_one<2>(o[2], vb, pa0, pa1, pa2, pa3); pv_one<3>(o[3], vb, pa0, pa1, pa2, pa3); }
        __syncthreads();
        if (j + 2 < NT) FA_SWRITE(b);
    }
    __syncthreads();
    l_out = l_reg;
#undef FA_SLOAD
#undef FA_SWRITE
}
}

namespace pg8 {
struct EpiProj {
    static constexpr bool PERM = true, AFTER_DRAIN = false;
    bf16_t* P; const float* rot;
    __device__ __forceinline__ void operator()(const f32x4 (&acc)[2][2][4][2], const Unit& u, int wr, int wc, int fr, int fq) const {
        const int row0 = u.pm * BM + wr * 64 + fr, colb = u.pn * BM + wc * 32 + 8 * fq;
        const bool rotq = (u.pn >= 7) && (u.pn < 15);
        const float ksc = (u.pn >= 11) ? K_SCALE : 1.0f;
        const int i0 = 16 * wc + 4 * fq;
#pragma unroll
        for (int ai = 0; ai < 2; ++ai)
#pragma unroll
            for (int m = 0; m < 4; ++m) {
                const int row = row0 + ai * HALF + m * 16; const int pos = row & (SEQL - 1);
                bf16_t* rowp = P + (size_t)row * NPROJ + colb;
                f32x4 r0 = (f32x4){1.f, 0.f, 1.f, 0.f}, r1 = r0;
                if (rotq) { const f32x4* rt = (const f32x4*)(rot + ((size_t)pos * 64 + i0) * 2); r0 = rt[0]; r1 = rt[1]; }
#pragma unroll
                for (int bj = 0; bj < 2; ++bj) {
                    f32x4 v0 = acc[ai][bj][m][0], v1 = acc[ai][bj][m][1];
                    if (rotq) {
                        f32x4 w0, w1;
                        w0[0] = (v0[0] * r0[0] - v0[1] * r0[1]) * ksc; w0[1] = (v0[0] * r0[1] + v0[1] * r0[0]) * ksc;
                        w0[2] = (v0[2] * r0[2] - v0[3] * r0[3]) * ksc; w0[3] = (v0[2] * r0[3] + v0[3] * r0[2]) * ksc;
                        w1[0] = (v1[0] * r1[0] - v1[1] * r1[1]) * ksc; w1[1] = (v1[0] * r1[1] + v1[1] * r1[0]) * ksc;
                        w1[2] = (v1[2] * r1[2] - v1[3] * r1[3]) * ksc; w1[3] = (v1[2] * r1[3] + v1[3] * r1[2]) * ksc;
                        v0 = w0; v1 = w1;
                    }
                    u32x4 w; w.x = pkbf(v0[0], v0[1]); w.y = pkbf(v0[2], v0[3]); w.z = pkbf(v1[0], v1[1]); w.w = pkbf(v1[2], v1[3]);
                    *(u32x4*)(rowp + bj * HALF) = w;
                }
            }
    }
};
template <int WHICH> struct EpiMerge {
    static constexpr bool PERM = true, AFTER_DRAIN = false;
    const bf16_t* P; const bf16_t* BA; bf16_t* O;
    __device__ __forceinline__ void operator()(const f32x4 (&acc)[2][2][4][2], const Unit& u, int wr, int wc, int fr, int fq) const {
        const int row0 = u.pm * BM + wr * 64 + fr, colb = u.pn * BM + wc * 32 + 8 * fq;
#pragma unroll
        for (int ai = 0; ai < 2; ++ai)
#pragma unroll
            for (int m = 0; m < 4; ++m) {
                const int row = row0 + ai * HALF + m * 16;
#pragma unroll
                for (int bj = 0; bj < 2; ++bj) {
                    const int col = colb + bj * HALF;
                    const u32x4 g = *(const u32x4*)(P + (size_t)row * NPROJ + C_GBR + WHICH * DMODEL + col);
                    const f32x4 v0 = acc[ai][bj][m][0], v1 = acc[ai][bj][m][1];
                    float o[8];
                    o[0] = sigmoidf_(bflo(g.x)) * v0[0]; o[1] = sigmoidf_(bfhi(g.x)) * v0[1]; o[2] = sigmoidf_(bflo(g.y)) * v0[2]; o[3] = sigmoidf_(bfhi(g.y)) * v0[3];
                    o[4] = sigmoidf_(bflo(g.z)) * v1[0]; o[5] = sigmoidf_(bfhi(g.z)) * v1[1]; o[6] = sigmoidf_(bflo(g.w)) * v1[2]; o[7] = sigmoidf_(bfhi(g.w)) * v1[3];
                    if (WHICH == 1) {
                        const u32x4 a = *(const u32x4*)(BA + (size_t)row * DMODEL + col);
                        o[0] += bflo(a.x); o[1] += bfhi(a.x); o[2] += bflo(a.y); o[3] += bfhi(a.y); o[4] += bflo(a.z); o[5] += bfhi(a.z); o[6] += bflo(a.w); o[7] += bfhi(a.w);
                    }
                    u32x4 w; w.x = pkbf(o[0], o[1]); w.y = pkbf(o[2], o[3]); w.z = pkbf(o[4], o[5]); w.w = pkbf(o[6], o[7]);
                    *(u32x4*)(O + (size_t)row * DMODEL + col) = w;
                }
            }
    }
};
struct EpiRes {
    static constexpr bool PERM = false, AFTER_DRAIN = false;
    const float* X; float* O;
    __device__ __forceinline__ void operator()(const f32x4 (&acc)[2][2][4][2], const Unit& u, int wr, int wc, int fr, int fq) const {
        const int row0 = u.pm * BM + wr * 64 + fr, col0 = u.pn * BM + wc * 32 + 4 * fq;
#pragma unroll
        for (int ai = 0; ai < 2; ++ai)
#pragma unroll
            for (int m = 0; m < 4; ++m) {
                const size_t off = (size_t)(row0 + ai * HALF + m * 16) * DMODEL + col0;
#pragma unroll
                for (int bj = 0; bj < 2; ++bj)
#pragma unroll
                    for (int n = 0; n < 2; ++n) { const f32x4 xv = *(const f32x4*)(X + off + bj * HALF + n * 16); *(f32x4*)(O + off + bj * HALF + n * 16) = xv + acc[ai][bj][m][n]; }
            }
    }
};
struct EpiSwiglu {
    static constexpr bool PERM = true, AFTER_DRAIN = false;
    bf16_t* H; const float* rs;
    __device__ __forceinline__ void operator()(const f32x4 (&acc)[2][2][4][2], const Unit& u, int wr, int wc, int fr, int fq) const {
        const int row0 = u.pm * BM + wr * 64 + fr, col = u.pn * HALF + wc * 32 + 8 * fq;
#pragma unroll
        for (int ai = 0; ai < 2; ++ai)
#pragma unroll
            for (int m = 0; m < 4; ++m) {
                const int row = row0 + ai * HALF + m * 16; const float r_ = rs[row];
                const f32x4 g0 = acc[ai][0][m][0] * r_, g1 = acc[ai][0][m][1] * r_, u0 = acc[ai][1][m][0] * r_, u1 = acc[ai][1][m][1] * r_;
                u32x4 w; w.x = pkbf(siluf_(g0[0]) * u0[0], siluf_(g0[1]) * u0[1]); w.y = pkbf(siluf_(g0[2]) * u0[2], siluf_(g0[3]) * u0[3]);
                w.z = pkbf(siluf_(g1[0]) * u1[0], siluf_(g1[1]) * u1[1]); w.w = pkbf(siluf_(g1[2]) * u1[2], siluf_(g1[3]) * u1[3]);
                *(u32x4*)(H + (size_t)row * 1024 + col) = w;
            }
    }
};
struct EpiDown {
    static constexpr bool PERM = true, AFTER_DRAIN = false;
    bf16_t* Y; const float* rg;
    __device__ __forceinline__ void operator()(const f32x4 (&acc)[2][2][4][2], const Unit& u, int wr, int wc, int fr, int fq) const {
        const int row0 = u.pm * BM + wr * 64 + fr, colb = u.pn * BM + wc * 32 + 8 * fq;
#pragma unroll
        for (int ai = 0; ai < 2; ++ai)
#pragma unroll
            for (int m = 0; m < 4; ++m) {
                const int row = row0 + ai * HALF + m * 16; const float gt = rg[row];
#pragma unroll
                for (int bj = 0; bj < 2; ++bj) {
                    const f32x4 v0 = acc[ai][bj][m][0] * gt, v1 = acc[ai][bj][m][1] * gt;
                    u32x4 w; w.x = pkbf(v0[0], v0[1]); w.y = pkbf(v0[2], v0[3]); w.z = pkbf(v1[0], v1[1]); w.w = pkbf(v1[2], v1[3]);
                    *(u32x4*)(Y + (size_t)row * DMODEL + colb + bj * HALF) = w;
                }
            }
    }
};
struct ExpertOrder {
    const LAS int* ts; int G, c;
    __device__ __forceinline__ bool next(int i, Unit& u) const {
        const int L = i * G + c; const int total = ts[32] * 8; if (L >= total) return false;
        const int gt = L >> 3; u.pm = gt; u.pn = L & 7; int e = 0;
        for (int k = 1; k < 32; ++k) e += (gt >= ts[k]) ? 1 : 0;
        u.e = e; return true;
    }
    __device__ __forceinline__ void a_ready(const Unit&) const {}
    __device__ __forceinline__ void done(const Unit&) const {}
};
}

struct MapId { __device__ __forceinline__ int operator()(int n) const { return n; } };
struct MapGate { __device__ __forceinline__ int operator()(int f) const { return ((f >> 7) << 8) + (f & 127); } };
struct MapUp { __device__ __forceinline__ int operator()(int f) const { return ((f >> 7) << 8) + 128 + (f & 127); } };
struct MapProj {
    __device__ __forceinline__ int operator()(int n) const {
        if (n < 1736) return n;
        if (n < 2760) { const int l = n - 1736, d = l & 127; return C_QR + (l & ~127) + ((d & 63) << 1) + (d >> 6); }
        if (n < 3784) { const int l = n - 2760, d = l & 127; return C_KR + (l & ~127) + ((d & 63) << 1) + (d >> 6); }
        if (n < 4808) return C_VR + (n - 3784);
        if (n < 5832) return C_GR + (n - 4808);
        return C_GBR + (n - 5832);
    }
};
template <class RowMap>
__device__ __forceinline__ void tr_item(const float* __restrict__ src, int N, bf16_t* __restrict__ dst, int ldd, int kb, int nb, int lane, RowMap rm) {
    const int kc = lane >> 3, nc = lane & 7;
    const int n = nb * 32 + nc * 4, k0 = kb * 64 + kc * 8;
    if (n < N) {
        f32x4 v[8];
#pragma unroll
        for (int i = 0; i < 8; ++i) v[i] = *(const f32x4*)(src + (size_t)(k0 + i) * N + n);
#pragma unroll
        for (int j = 0; j < 4; ++j) {
            u32x4 o; o.x = pkbf(v[0][j], v[1][j]); o.y = pkbf(v[2][j], v[3][j]); o.z = pkbf(v[4][j], v[5][j]); o.w = pkbf(v[6][j], v[7][j]);
            *(u32x4*)(dst + (size_t)rm(n + j) * ldd + k0) = o;
        }
    }
}
template <class RowMap>
__device__ __forceinline__ void tr_item2(const float* __restrict__ src, int N, bf16_t* __restrict__ dst, int ldd, int kb, int nb, int lane, RowMap rm) {
    const int kc = lane >> 3, nc = lane & 7;
    const int n = nb * 32 + nc * 4, k0 = kb * 64 + kc * 8;
    f32x4 va[8], vb[8];
#pragma unroll
    for (int i = 0; i < 8; ++i) { va[i] = *(const f32x4*)(src + (size_t)(k0 + i) * N + n); vb[i] = *(const f32x4*)(src + (size_t)(k0 + i) * N + n + 32); }
#pragma unroll
    for (int j = 0; j < 4; ++j) {
        u32x4 o; o.x = pkbf(va[0][j], va[1][j]); o.y = pkbf(va[2][j], va[3][j]); o.z = pkbf(va[4][j], va[5][j]); o.w = pkbf(va[6][j], va[7][j]);
        *(u32x4*)(dst + (size_t)rm(n + j) * ldd + k0) = o;
    }
#pragma unroll
    for (int j = 0; j < 4; ++j) {
        u32x4 o; o.x = pkbf(vb[0][j], vb[1][j]); o.y = pkbf(vb[2][j], vb[3][j]); o.z = pkbf(vb[4][j], vb[5][j]); o.w = pkbf(vb[6][j], vb[7][j]);
        *(u32x4*)(dst + (size_t)rm(n + 32 + j) * ldd + k0) = o;
    }
}
constexpr int EXP_ITEMS = 3 * 32 * 1024;
__device__ __forceinline__ void convert_experts(const float* w_eg, const float* w_eu, const float* w_ed, bf16_t* WGU, bf16_t* WD, unsigned* qctr, int lane) {
    int nxt = 0; if (lane == 0) nxt = (int)atomicAdd(qctr, 8u);
    for (;;) {
        const int it = __builtin_amdgcn_readfirstlane(nxt);
        if (it >= EXP_ITEMS) break;
        if (lane == 0) nxt = (int)atomicAdd(qctr, 8u);
        const int kind = it >> 15, r = it & 32767, e = r >> 10, q = r & 1023;
        if (kind == 0) { const float* src = w_eg + (size_t)e * 2048 * 1024; bf16_t* dst = WGU + (size_t)e * 2048 * 2048;
#pragma unroll 1
            for (int u = 0; u < 8; u += 2) tr_item2(src, 1024, dst, 2048, q >> 5, (q & 31) + u, lane, MapGate{}); }
        else if (kind == 1) { const float* src = w_eu + (size_t)e * 2048 * 1024; bf16_t* dst = WGU + (size_t)e * 2048 * 2048;
#pragma unroll 1
            for (int u = 0; u < 8; u += 2) tr_item2(src, 1024, dst, 2048, q >> 5, (q & 31) + u, lane, MapUp{}); }
        else { const float* src = w_ed + (size_t)e * 1024 * 2048; bf16_t* dst = WD + (size_t)e * 2048 * 1024;
#pragma unroll 1
            for (int u = 0; u < 8; u += 2) tr_item2(src, 2048, dst, 1024, q >> 6, (q & 63) + u, lane, MapId{}); }
    }
}
__device__ __forceinline__ void sincos_d(double a, double& s, double& c) {
    const double TWO_PI = 6.283185307179586476925, HALF_PI = 1.5707963267948966192313;
    double k = rint(a / HALF_PI); double r = a - k * HALF_PI;
    r -= k * 6.123233995736766e-17;
    const int q = ((int)k) & 3; const double r2 = r * r;
    double sp = r2 * (-1.0 / 1307674368000.0);
    sp = r2 * (sp + 1.0 / 6227020800.0); sp = r2 * (sp - 1.0 / 39916800.0); sp = r2 * (sp + 1.0 / 362880.0); sp = r2 * (sp - 1.0 / 5040.0); sp = r2 * (sp + 1.0 / 120.0); sp = r2 * (sp - 1.0 / 6.0);
    const double sr = r + r * sp;
    double cp = r2 * (1.0 / 20922789888000.0);
    cp = r2 * (cp - 1.0 / 87178291200.0); cp = r2 * (cp + 1.0 / 479001600.0); cp = r2 * (cp - 1.0 / 3628800.0); cp = r2 * (cp + 1.0 / 40320.0); cp = r2 * (cp - 1.0 / 720.0); cp = r2 * (cp + 1.0 / 24.0); cp = r2 * (cp - 0.5);
    const double cr = 1.0 + cp;
    s = (q == 0) ? sr : (q == 1) ? cr : (q == 2) ? -sr : -cr;
    c = (q == 0) ? cr : (q == 1) ? -sr : (q == 2) ? -cr : sr;
    (void)TWO_PI;
}

struct Params { const float* in[17]; float* out; unsigned char* ws; };

#ifndef PROF_PHASE
#define PROF_PHASE -1
#endif
#define STAMP(i) do { if (PROF_PHASE >= 0 && bx == 0 && wave_id == 0) ((unsigned*)(p.ws + WS_CTL))[6000 + (i)] = (unsigned)__builtin_amdgcn_s_memrealtime(); } while (0)
#define GSYNC() grid.sync()
#define XBAR() do { const int l__ = (int)__builtin_amdgcn_mbcnt_hi(~0u, __builtin_amdgcn_mbcnt_lo(~0u, (unsigned)hide_i(0))); xcd_barrier(xbar, wave_id * 64 + l__); } while (0)
constexpr int CTL_BAR_WORD = 8192;
constexpr int CTL_QCTR = 2048;
#ifndef NGEMM_P1
#define NGEMM_P1 192
#endif

__global__ void __launch_bounds__(512, 2) mega_fwd(Params p) {
    extern __shared__ __attribute__((aligned(16))) unsigned char lds_raw[];
    LAS unsigned char* lds = (LAS unsigned char*)lds_raw;
    cg::grid_group grid = cg::this_grid();
    const int G = gridDim.x, bx = blockIdx.x;
    const int wave_id = __builtin_amdgcn_readfirstlane((int)threadIdx.x >> 6);
    const int NGW = G * 8, NGT = G * 512;
    XcdBarrier xbar;
    {
        const int l0 = (int)__builtin_amdgcn_mbcnt_hi(~0u, __builtin_amdgcn_mbcnt_lo(~0u, (unsigned)hide_i(0)));
        volatile LAS unsigned* st = (volatile LAS unsigned*)(lds + LDS_MISC + 256);
        if (wave_id == 0 && l0 < 2) st[l0] = 0u;
        __syncthreads();
        xbar.bar = (unsigned*)(p.ws + WS_CTL) + CTL_BAR_WORD; xbar.x = xb_xcc_id(); xbar.st = st;
        if (wave_id == 0 && l0 == 0) (void)xb_add(&xbar.bar[XB_XCNT(xbar.x)], 1u);
    }
#define PH_LOCALS \
    const int lane = (int)__builtin_amdgcn_mbcnt_hi(~0u, __builtin_amdgcn_mbcnt_lo(~0u, (unsigned)hide_i(0))), wave = wave_id, tid = wave * 64 + lane; (void)tid; \
    const int gw = bx * 8 + wave, gtid = bx * 512 + tid; (void)gw; (void)gtid; (void)lane; \
    unsigned char* ws = hide_p(p.ws); float* out = hide_p(p.out); (void)out; \
    unsigned* ctl = (unsigned*)(ws + WS_CTL); float* rot = (float*)(ws + WS_ROT); (void)ctl; (void)rot; \
    bf16_t* WIN = (bf16_t*)(ws + WS_WIN); bf16_t* WCOMB = (bf16_t*)(ws + WS_WCOMB); bf16_t* WB = (bf16_t*)(ws + WS_WB); bf16_t* WO = (bf16_t*)(ws + WS_WO); (void)WIN; (void)WCOMB; (void)WB; (void)WO; \
    bf16_t* WGU = (bf16_t*)(ws + WS_WGU); bf16_t* WD = (bf16_t*)(ws + WS_WD); (void)WGU; (void)WD; \
    bf16_t* P = (bf16_t*)(ws + WS_P); bf16_t* HMID = (bf16_t*)(ws + WS_HMID); bf16_t* Y = (bf16_t*)(ws + WS_Y); (void)P; (void)HMID; (void)Y; \
    bf16_t* XN = (bf16_t*)(ws + WS_XN); bf16_t* BA = XN; bf16_t* TN = XN; (void)BA; (void)TN; \
    bf16_t* OA = (bf16_t*)(ws + WS_OA); bf16_t* OB = (bf16_t*)(ws + WS_OB); bf16_t* MIXED = (bf16_t*)(ws + WS_MIXED); bf16_t* XG = (bf16_t*)(ws + WS_XG); (void)OA; (void)OB; (void)MIXED; (void)XG; \
    bf16_t* KV = (bf16_t*)(ws + WS_KV); u64* MASK = (u64*)(ws + WS_MASK); (void)KV; (void)MASK; \
    int* misc = (int*)(ws + WS_MISC); \
    int* row_tok = misc + MI_ROWTOK; float* row_gate = (float*)(misc + MI_ROWGATE); int* tok_slot = misc + MI_TOKSLOT; (void)row_tok; (void)row_gate; (void)tok_slot; \
    int* asg_e = misc + MI_ASGE; int* asg_r = misc + MI_ASGR; float* asg_g = (float*)(misc + MI_ASGG); (void)asg_e; (void)asg_r; (void)asg_g;
#define IN(k) hide_p(p.in[k])

    STAMP(0);
    {
        PH_LOCALS
        const float* x = IN(0); const float* g_mix = IN(1); const float* w_in = IN(2); const float* w_uv = IN(4); const float* w_branch = IN(6); const float* w_out = IN(7);
        constexpr int NB_WIN = 311;
        constexpr int I_WIN = 32 * NB_WIN, I_WB = 16 * 64, I_WO = 32 * 64;
        constexpr int I_TOTAL = I_WIN + I_WB + I_WO;
        for (int it = gw; it < I_TOTAL; it += NGW) {
            int r = it;
            if (r < I_WIN) { tr_item(w_in, 9928, WIN, 2048, r / NB_WIN, r % NB_WIN, lane, MapProj{}); continue; } r -= I_WIN;
            if (r < I_WB) { tr_item(w_branch + (size_t)1024 * 2048, 2048, WB, 1024, r >> 6, r & 63, lane, MapId{}); continue; } r -= I_WB;
            tr_item(w_out, 2048, WO, 2048, r >> 6, r & 63, lane, MapId{});
        }
        {
            const float* w_eg = IN(13); const float* w_eu = IN(14); const float* w_ed = IN(15);
            for (int it = 2 * gw; it < EXP_ITEMS; it += 2 * NGW) {
                const int kind = it >> 15, r = it & 32767, e = r >> 10, q = r & 1023;
                if (kind == 0) tr_item2(w_eg + (size_t)e * 2048 * 1024, 1024, WGU + (size_t)e * 2048 * 2048, 2048, q >> 5, q & 31, lane, MapGate{});
                else if (kind == 1) tr_item2(w_eu + (size_t)e * 2048 * 1024, 1024, WGU + (size_t)e * 2048 * 2048, 2048, q >> 5, q & 31, lane, MapUp{});
                else tr_item2(w_ed + (size_t)e * 1024 * 2048, 2048, WD + (size_t)e * 2048 * 1024, 1024, q >> 6, q & 63, lane, MapId{});
            }
        }
        for (int i = gtid; i < 56 * 256; i += NGT) ((u32x4*)(WIN + (size_t)1736 * 2048))[i] = (u32x4){0u, 0u, 0u, 0u};
        for (int it = gw; it < 2048; it += NGW) {
            const int h = it >> 8, ch = (it >> 7) & 1, n0 = (it & 127) * 16, c = ch * 64 + lane;
            const float* wuv = w_uv + ((size_t)h * 128 + c) * 128;
            const float* wa = w_branch + (size_t)(h * 128) * 2048 + n0;
            float a[16];
#pragma unroll
            for (int j = 0; j < 16; ++j) a[j] = 0.f;
#pragma unroll 4
            for (int d4 = 0; d4 < 32; ++d4) {
                const f32x4 wv = *(const f32x4*)(wuv + d4 * 4);
#pragma unroll
                for (int dd = 0; dd < 4; ++dd) {
                    const float* wr_ = wa + (size_t)(d4 * 4 + dd) * 2048;
#pragma unroll
                    for (int j4 = 0; j4 < 4; ++j4) { const f32x4 b = *(const f32x4*)(wr_ + j4 * 4); a[j4 * 4 + 0] += wv[dd] * b[0]; a[j4 * 4 + 1] += wv[dd] * b[1]; a[j4 * 4 + 2] += wv[dd] * b[2]; a[j4 * 4 + 3] += wv[dd] * b[3]; }
                }
            }
#pragma unroll
            for (int j = 0; j < 16; ++j) WCOMB[(size_t)(n0 + j) * 1024 + h * 128 + c] = (bf16_t)(pkbf(a[j], 0.f) & 0xffffu);
        }
        for (int m = gw; m < T_TOK; m += 2 * NGW) {
            const int m1 = (m + NGW < T_TOK) ? m + NGW : m;
            const f32x4* xr0 = (const f32x4*)(x + (size_t)m * DMODEL) + lane; const f32x4* xr1 = (const f32x4*)(x + (size_t)m1 * DMODEL) + lane;
            f32x4 v0[8], v1[8]; float s0 = 0.f, s1 = 0.f;
#pragma unroll
            for (int j = 0; j < 8; ++j) { v0[j] = xr0[64 * j]; v1[j] = xr1[64 * j]; }
#pragma unroll
            for (int j = 0; j < 8; ++j) { s0 += (v0[j][0] * v0[j][0] + v0[j][1] * v0[j][1]) + (v0[j][2] * v0[j][2] + v0[j][3] * v0[j][3]); s1 += (v1[j][0] * v1[j][0] + v1[j][1] * v1[j][1]) + (v1[j][2] * v1[j][2] + v1[j][3] * v1[j][3]); }
            const float r0 = 1.0f / sqrtf(wave_sum(s0, lane) * (1.0f / DMODEL) + EPS_F), r1 = 1.0f / sqrtf(wave_sum(s1, lane) * (1.0f / DMODEL) + EPS_F);
            u32x2* o0 = (u32x2*)(XN + (size_t)m * DMODEL) + lane; u32x2* o1 = (u32x2*)(XN + (size_t)m1 * DMODEL) + lane;
#pragma unroll
            for (int j = 0; j < 8; ++j) { const f32x4 gg = ((const f32x4*)g_mix)[lane + 64 * j];
                u32x2 w; w.x = pkbf(v0[j][0] * r0 * gg[0], v0[j][1] * r0 * gg[1]); w.y = pkbf(v0[j][2] * r0 * gg[2], v0[j][3] * r0 * gg[3]); o0[64 * j] = w;
                u32x2 w2; w2.x = pkbf(v1[j][0] * r1 * gg[0], v1[j][1] * r1 * gg[1]); w2.y = pkbf(v1[j][2] * r1 * gg[2], v1[j][3] * r1 * gg[3]); o1[64 * j] = w2; }
        }
        for (int idx = gtid; idx < SEQL * 64; idx += NGT) {
            const int pos = idx >> 6, i = idx & 63; double f = 1.0;
            for (int k = 0; k < i; ++k) f *= 0.8659643233600653;
            double s, c; sincos_d((double)pos * f, s, c);
            rot[2 * idx] = (float)c; rot[2 * idx + 1] = (float)s;
        }
        { const float* g_ffn = IN(8); const float* w_rg = IN(9); const float* w_re = IN(11); float* WC = (float*)(ws + WS_WC);
          for (int idx = gtid; idx < 256 * 48 * 8; idx += NGT) { const int j = idx & 7, c = (idx >> 3) % 48, k = (idx / 384) * 8 + j;
              const float wv = (c < 4) ? w_rg[k * 4 + c] : (c < 36) ? w_re[k * 32 + (c - 4)] : 0.f; WC[idx] = wv * g_ffn[k]; } }
        for (int i = gtid; i < 32; i += NGT) ctl[64 * i] = 0u;
        if (gtid < 2) ctl[4096 + gtid] = 0u;
        for (int i = gtid; i < MAXSLOT; i += NGT) { row_tok[i] = 0; row_gate[i] = 0.f; ((float*)(ws + WS_WC + 524288))[i] = 0.f; }
    }
    GSYNC();
    STAMP(1);

    {
        PH_LOCALS
        pg8::Gemm g{XN, WIN, T_TOK, NPROJ, 2048}; pg8::StaticOrder S; S.init(T_TOK, NPROJ, G, bx);
        pg8::EpiProj E{P, rot};
        pg8::gemm_phase<pg8::EpiProj, pg8::StaticOrder, true, true>(lds, g, S, E, tid);
    }
    XBAR();
    STAMP(2);

    {
        PH_LOCALS
        const float* g_kv = IN(3);
        for (int t = gw; t < T_TOK; t += NGW) {
            const unsigned v = *(const unsigned*)(P + (size_t)t * NPROJ + C_CKV + 2 * lane);
            const float a = bflo(v), b = bfhi(v);
            const float rstd = 1.0f / sqrtf(wave_sum(a * a + b * b, lane) * (1.0f / 128.0f) + EPS_F);
            *(unsigned*)(KV + (size_t)t * 128 + 2 * lane) = pkbf(a * rstd * g_kv[2 * lane], b * rstd * g_kv[2 * lane + 1]);
        }
#if DBG_CMP == 3
        {
        u64* MASKX = (u64*)(ws + WS_SPARE);
        LAS float* qi = (LAS float*)(lds + wave * 10240); LAS float* sc = qi + 512;
        for (int t = gw; t < T_TOK; t += NGW) {
            const int b = t >> 11, q = t & 2047, ng = (q >> 6) + 1;
            { const u32x4 v = *(const u32x4*)(P + (size_t)t * NPROJ + C_QIDX + lane * 8);
              f32x4 lo4 = (f32x4){bflo(v.x), bfhi(v.x), bflo(v.y), bfhi(v.y)}, hi4 = (f32x4){bflo(v.z), bfhi(v.z), bflo(v.w), bfhi(v.w)};
              *(LAS f32x4*)(qi + lane * 8) = lo4; *(LAS f32x4*)(qi + lane * 8 + 4) = hi4; }
            float w[8];
            { const u32x4 v = *(const u32x4*)(P + (size_t)t * NPROJ + C_WIDX); w[0] = bflo(v.x); w[1] = bfhi(v.x); w[2] = bflo(v.y); w[3] = bfhi(v.y); w[4] = bflo(v.z); w[5] = bfhi(v.z); w[6] = bflo(v.w); w[7] = bfhi(v.w); }
            for (int g = 0; g < ng; ++g) {
                LAS float* qg = qi; asm volatile("" : "+v"(qg));
                const int s = g * 64 + lane; const u32x4* kr = (const u32x4*)(P + (size_t)(b * SEQL + s) * NPROJ + C_KIDX);
                float dot[8];
#pragma unroll
                for (int h = 0; h < 8; ++h) dot[h] = 0.f;
#pragma unroll
                for (int c = 0; c < 8; ++c) {
                    const u32x4 v = kr[c];
                    const f32x4 ka = (f32x4){bflo(v.x), bfhi(v.x), bflo(v.y), bfhi(v.y)}, kb = (f32x4){bflo(v.z), bfhi(v.z), bflo(v.w), bfhi(v.w)};
#pragma unroll
                    for (int h = 0; h < 8; ++h) {
                        const f32x4 qa = *(const LAS f32x4*)(qg + h * 64 + c * 8), qb = *(const LAS f32x4*)(qg + h * 64 + c * 8 + 4);
                        dot[h] += (qa[0] * ka[0] + qa[1] * ka[1]) + (qa[2] * ka[2] + qa[3] * ka[3]) + (qb[0] * kb[0] + qb[1] * kb[1]) + (qb[2] * kb[2] + qb[3] * kb[3]);
                    }
                }
                float score = 0.f;
#pragma unroll
                for (int h = 0; h < 8; ++h) score += w[h] * fmaxf(dot[h], 0.f);
                sc[s] = score * IDX_SCALE;
            }
            u64* mrow = MASKX + (size_t)t * 32;
            if (ng <= 4) { if (lane < 32) mrow[lane] = (lane < ng) ? ~0ull : 0ull; }
            else {
                unsigned lo = 0u;
                for (int bit = 31; bit >= 0; --bit) {
                    const unsigned cand = lo | (1u << bit); int cnt = 0;
                    for (int g = 0; g < ng; ++g) cnt += __popcll(__ballot(fkey(sc[g * 64 + lane]) >= cand));
                    if (cnt >= 256) lo = cand;
                }
                const unsigned tau = lo; int cgt = 0;
                for (int g = 0; g < ng; ++g) cgt += __popcll(__ballot(fkey(sc[g * 64 + lane]) > tau));
                const int need = 256 - cgt; int run = 0;
                for (int g = 0; g < ng; ++g) {
                    const unsigned key = fkey(sc[g * 64 + lane]);
                    const u64 gt = __ballot(key > tau), eq = __ballot(key == tau);
                    const u64 below = eq & ((1ull << lane) - 1ull);
                    const bool sel = (key == tau) && (run + (int)__popcll(below) < need);
                    const u64 word = gt | __ballot(sel);
                    run += (int)__popcll(eq);
                    if (lane == 0) mrow[g] = word;
                }
                if (lane >= ng && lane < 32) mrow[lane] = 0ull;
            }
        }
        }
        __syncthreads();
#endif
        typedef short bf16x8_t __attribute__((ext_vector_type(8)));
        constexpr int SCS = 2052;
        LAS float* scl = (LAS float*)lds;
        for (int ui = 0; ui < 4; ++ui) {
            const int uu = ui * 256 + ((ui & 1) ? 255 - bx : bx);
            if (uu >= 1024 || bx >= 256) break;
            const int b = uu & 7, qblk = uu >> 3, q0 = qblk * 16, t0 = b * SEQL + q0, ng = (q0 >> 6) + 1, N = ng * 64;
            if (ng <= 4) {
                for (int qq = 0; qq < 2; ++qq) { u64* mrow = MASK + (size_t)(t0 + 2 * wave + qq) * 32; if (lane < 32) mrow[lane] = (lane < ng) ? ~0ull : 0ull; }
                continue;
            }
            const int qrow = lane & 15, kg = lane >> 4;
            bf16x8_t qf[8][2]; float w[8];
            { const bf16_t* qp = P + (size_t)(t0 + qrow) * NPROJ + C_QIDX + 8 * kg;
#pragma unroll
              for (int h = 0; h < 8; ++h) { qf[h][0] = *(const bf16x8_t*)(qp + h * 64); qf[h][1] = *(const bf16x8_t*)(qp + h * 64 + 32); }
              const u32x4 v = *(const u32x4*)(P + (size_t)(t0 + qrow) * NPROJ + C_WIDX); w[0] = bflo(v.x); w[1] = bfhi(v.x); w[2] = bflo(v.y); w[3] = bfhi(v.y); w[4] = bflo(v.z); w[5] = bfhi(v.z); w[6] = bflo(v.w); w[7] = bfhi(v.w); }
            for (int kt = wave; kt < N / 16; kt += 8) {
                const int s0 = kt * 16;
                const bf16_t* kp = P + (size_t)(b * SEQL + s0 + qrow) * NPROJ + C_KIDX + 8 * kg;
                const bf16x8_t a0 = *(const bf16x8_t*)kp, a1 = *(const bf16x8_t*)(kp + 32);
                f32x4 sacc = (f32x4){0.f, 0.f, 0.f, 0.f};
#pragma unroll
                for (int h = 0; h < 8; ++h) {
                    f32x4 acc = (f32x4){0.f, 0.f, 0.f, 0.f};
                    acc = __builtin_amdgcn_mfma_f32_16x16x32_bf16(a0, qf[h][0], acc, 0, 0, 0);
                    acc = __builtin_amdgcn_mfma_f32_16x16x32_bf16(a1, qf[h][1], acc, 0, 0, 0);
                    sacc[0] += w[h] * fmaxf(acc[0], 0.f); sacc[1] += w[h] * fmaxf(acc[1], 0.f); sacc[2] += w[h] * fmaxf(acc[2], 0.f); sacc[3] += w[h] * fmaxf(acc[3], 0.f);
                }
                *(LAS f32x4*)(scl + qrow * SCS + s0 + 4 * kg) = sacc * IDX_SCALE;
            }
            __syncthreads();
#pragma unroll 1
            for (int qq = 0; qq < 2; ++qq) {
                const int q = 2 * wave + qq; const LAS float* row = scl + q * SCS;
                unsigned key[32];
#pragma unroll
                for (int j = 0; j < 32; ++j) key[j] = (j < ng) ? fkey(row[64 * j + lane]) : 0u;
                unsigned lo = 0u;
#pragma unroll 1
                for (int bit = 31; bit >= 0; --bit) {
                    const unsigned cand = lo | (1u << bit); int c = 0;
#pragma unroll
                    for (int j = 0; j < 32; ++j) c += (key[j] >= cand) ? 1 : 0;
#pragma unroll
                    for (int x = 1; x < 64; x <<= 1) c += __builtin_amdgcn_ds_bpermute((lane ^ x) << 2, c);
                    if (c >= 256) lo = cand;
                }
                const unsigned tau = lo; int cgt = 0;
#pragma unroll
                for (int j = 0; j < 32; ++j) cgt += (key[j] > tau) ? 1 : 0;
#pragma unroll
                for (int x = 1; x < 64; x <<= 1) cgt += __builtin_amdgcn_ds_bpermute((lane ^ x) << 2, cgt);
                const int need = 256 - cgt; int run = 0; u64 myword = 0ull;
#pragma unroll
                for (int j = 0; j < 32; ++j) {
                    const u64 gt = __ballot(key[j] > tau), eq = __ballot(key[j] == tau);
                    const u64 below = eq & ((1ull << lane) - 1ull);
                    const bool sel = (key[j] == tau) && (run + (int)__popcll(below) < need);
                    const u64 word = gt | __ballot(sel);
                    run += (int)__popcll(eq);
                    if (lane == j) myword = word;
                    __builtin_amdgcn_sched_barrier(0);
                }
                if (lane < 32) MASK[(size_t)(t0 + q) * 32 + lane] = myword;
            }
            __syncthreads();
        }
    }
    XBAR();
    STAMP(3);

#if DBG_CMP == 1
    {
        PH_LOCALS
        bf16_t* OAX = (bf16_t*)(ws + WS_SPARE);
        float* qv = (float*)(lds_raw + wave * 10240); float* lg = qv + 512;
        for (int it = gw; it < T_TOK * 8; it += NGW) {
            const int t = it >> 3, h = it & 7, b = t >> 11, q = t & 2047, ng = (q >> 6) + 1;
            { const unsigned v = *(const unsigned*)(P + (size_t)t * NPROJ + C_QLAT + h * 128 + 2 * lane); qv[2 * lane] = bflo(v); qv[2 * lane + 1] = bfhi(v); }
            const u64* mrow = MASK + (size_t)t * 32;
            float mx = -INFINITY;
            for (int g = 0; g < ng; ++g) {
                asm volatile("" ::: "memory");
                const u64 word = mrow[g]; float l = -INFINITY;
                if ((word >> lane) & 1ull) {
                    const u32x4* kr = (const u32x4*)(KV + (size_t)(b * SEQL + g * 64 + lane) * 128);
                    float d0 = 0.f, d1 = 0.f, d2 = 0.f, d3 = 0.f;
#pragma unroll
                    for (int c = 0; c < 16; ++c) { const u32x4 v = kr[c]; const f32x4 qa = *(const f32x4*)(qv + 8 * c), qb = *(const f32x4*)(qv + 8 * c + 4);
                        d0 += qa[0] * bflo(v.x) + qb[0] * bflo(v.z); d1 += qa[1] * bfhi(v.x) + qb[1] * bfhi(v.z); d2 += qa[2] * bflo(v.y) + qb[2] * bflo(v.w); d3 += qa[3] * bfhi(v.y) + qb[3] * bfhi(v.w); }
                    l = ((d0 + d1) + (d2 + d3)) * ATT_SCALE;
                }
                lg[g * 64 + lane] = l; mx = fmaxf(mx, l);
            }
            mx = wave_max(mx, lane);
            float o0 = 0.f, o1 = 0.f, sum = 0.f;
            for (int g = 0; g < ng; ++g) {
                const u64 wv = mrow[g];
                u64 word = ((u64)__builtin_amdgcn_readfirstlane((unsigned)(wv >> 32)) << 32) | (u64)__builtin_amdgcn_readfirstlane((unsigned)wv);
                while (word) {
                    const int j = __builtin_ctzll(word); word &= word - 1ull;
                    const int s = g * 64 + j; const float pj = __expf(lg[s] - mx);
                    const unsigned v = *(const unsigned*)(KV + (size_t)(b * SEQL + s) * 128 + 2 * lane);
                    o0 += pj * bflo(v); o1 += pj * bfhi(v); sum += pj;
                }
            }
            const float inv = 1.0f / sum;
            *(unsigned*)(OAX + (size_t)t * 1024 + h * 128 + 2 * lane) = pkbf(o0 * inv, o1 * inv);
        }
    }
    __syncthreads();
#endif
#if DBG_CMP == 2
    {
        PH_LOCALS
        const float* g_ret = IN(5);
        bf16_t* OBX = (bf16_t*)(ws + WS_SPARE);
        float* qv = (float*)(lds_raw + wave * 10240); float* lg = qv + 512; float* wl = lg;
        for (int it = gw; it < T_TOK * 8; it += NGW) {
            const int t = it >> 3, h = it & 7, b = t >> 11, n = t & 2047, ng = (n >> 6) + 1;
            const float lgam = (h == 0) ? -0.04580368961312479f : (h == 1) ? -0.02272007650008353f : (h == 2) ? -0.011315313227834146f : (h == 3) ? -0.005646563141142063f :
                               (h == 4) ? -0.0028205190623786626f : (h == 5) ? -0.0014095702546713536f : (h == 6) ? -0.0007046129765893727f : -0.0003522634716290214f;
            { const unsigned v = *(const unsigned*)(P + (size_t)t * NPROJ + C_QR + h * 128 + 2 * lane); qv[2 * lane] = bflo(v); qv[2 * lane + 1] = bfhi(v); }
            float o0 = 0.f, o1 = 0.f;
            for (int g = 0; g < ng; ++g) {
                asm volatile("" ::: "memory");
                const int m = g * 64 + lane;
                const u32x4* kr = (const u32x4*)(P + (size_t)(b * SEQL + m) * NPROJ + C_KR + h * 128);
                float d0 = 0.f, d1 = 0.f, d2 = 0.f, d3 = 0.f;
#pragma unroll
                for (int c = 0; c < 16; ++c) { const u32x4 v = kr[c]; const f32x4 qa = *(const f32x4*)(qv + 8 * c), qb = *(const f32x4*)(qv + 8 * c + 4);
                    d0 += qa[0] * bflo(v.x) + qb[0] * bflo(v.z); d1 += qa[1] * bfhi(v.x) + qb[1] * bfhi(v.z); d2 += qa[2] * bflo(v.y) + qb[2] * bflo(v.w); d3 += qa[3] * bfhi(v.y) + qb[3] * bfhi(v.w); }
                const float dot = (d0 + d1) + (d2 + d3);
                wl[lane] = (m <= n) ? dot * exp2f((float)(n - m) * lgam) : 0.f;
                const int jmax = (g == ng - 1) ? (n & 63) : 63;
                for (int j = 0; j <= jmax; ++j) {
                    const float wj = wl[j];
                    const unsigned v = *(const unsigned*)(P + (size_t)(b * SEQL + g * 64 + j) * NPROJ + C_VR + h * 128 + 2 * lane);
                    o0 += wj * bflo(v); o1 += wj * bfhi(v);
                }
            }
            const float mu = wave_sum(o0 + o1, lane) * (1.0f / 128.0f); const float e0 = o0 - mu, e1 = o1 - mu;
            const float rs = 1.0f / sqrtf(wave_sum(e0 * e0 + e1 * e1, lane) * (1.0f / 128.0f) + EPS_F);
            const unsigned gv = *(const unsigned*)(P + (size_t)t * NPROJ + C_GR + h * 128 + 2 * lane);
            const float y0 = siluf_(bflo(gv)) * e0 * rs * g_ret[h * 128 + 2 * lane], y1 = siluf_(bfhi(gv)) * e1 * rs * g_ret[h * 128 + 2 * lane + 1];
            *(unsigned*)(OBX + (size_t)t * 1024 + h * 128 + 2 * lane) = pkbf(y0, y1);
        }
    }
    __syncthreads();
#endif
    {
        PH_LOCALS
        for (int pr = bx; pr < 256; pr += G) {
            const int b = pr >> 5, i = pr & 31;
#pragma unroll 1
            for (int uu = 0; uu < 2; ++uu) {
                const int qb = uu ? 63 - i : i; const int t0 = b * SEQL + qb * 32;
                fa::UnitArgs U; U.Q = P + (size_t)t0 * NPROJ + C_QLAT; U.ldq = NPROJ; U.K = KV + (size_t)b * SEQL * 128; U.V = U.K; U.ldk = 128; U.mask = MASK + (size_t)t0 * 32;
                U.ntiles = (qb >> 1) + 1; U.n0 = 0; U.lgam = 0.f;
                fa::f32x16 o[4]; float l_reg;
                fa::unit_body<0>((LAS char*)lds, U, tid, o, l_reg);
                const int r32 = lane & 31, hi = lane >> 5;
                LAS float* li_l = (LAS float*)(lds + fa::OFF_WS) + wave * 64;
                if (hi == 0) li_l[r32] = l_reg;
                asm volatile("s_waitcnt lgkmcnt(0)" ::: "memory");
#pragma unroll
                for (int r = 0; r < 16; ++r) {
                    const int orow = fa::crow(r, hi); const float rl = __builtin_amdgcn_rcpf(li_l[orow]);
                    bf16_t* op = OA + (size_t)(t0 + orow) * 1024 + wave * 128 + r32;
#pragma unroll
                    for (int d0 = 0; d0 < 4; ++d0) op[d0 * 32] = (bf16_t)(pkbf(o[d0][r] * rl, 0.f) & 0xffffu);
                }
                __syncthreads();
            }
        }
    }
    STAMP(20);
    {
        PH_LOCALS
        const float* g_ret = IN(5);
        for (int pr = bx; pr < 256; pr += G) {
            const int bh = pr >> 2, i = pr & 3, b = bh >> 3, h = bh & 7;
            const float lgam = (h == 0) ? -0.04580368961312479f : (h == 1) ? -0.02272007650008353f : (h == 2) ? -0.011315313227834146f : (h == 3) ? -0.005646563141142063f :
                               (h == 4) ? -0.0028205190623786626f : (h == 5) ? -0.0014095702546713536f : (h == 6) ? -0.0007046129765893727f : -0.0003522634716290214f;
#pragma unroll 1
            for (int uu = 0; uu < 2; ++uu) {
                const int qb = uu ? 7 - i : i; const int n0 = qb * 256;
                fa::UnitArgs U; U.Q = P + (size_t)(b * SEQL + n0) * NPROJ + C_QR + h * 128; U.ldq = NPROJ;
                U.K = P + (size_t)(b * SEQL) * NPROJ + C_KR + h * 128; U.V = P + (size_t)(b * SEQL) * NPROJ + C_VR + h * 128; U.ldk = NPROJ; U.mask = nullptr;
                U.ntiles = 4 * (qb + 1); U.n0 = n0; U.lgam = lgam;
                fa::f32x16 o[4]; float l_reg;
                fa::unit_body<1>((LAS char*)lds, U, tid, o, l_reg);
                const int r32 = lane & 31, hi = lane >> 5;
                float gr[4];
#pragma unroll
                for (int d0 = 0; d0 < 4; ++d0) gr[d0] = g_ret[h * 128 + d0 * 32 + r32];
#pragma unroll
                for (int r = 0; r < 16; ++r) {
                    float s = (o[0][r] + o[1][r]) + (o[2][r] + o[3][r]);
#pragma unroll
                    for (int x = 1; x < 32; x <<= 1) s += shx(s, lane, x);
                    const float mu = s * (1.0f / 128.0f);
                    const float e0 = o[0][r] - mu, e1 = o[1][r] - mu, e2 = o[2][r] - mu, e3 = o[3][r] - mu;
                    float q = (e0 * e0 + e1 * e1) + (e2 * e2 + e3 * e3);
#pragma unroll
                    for (int x = 1; x < 32; x <<= 1) q += shx(q, lane, x);
                    const float rs = 1.0f / sqrtf(q * (1.0f / 128.0f) + EPS_F);
                    const size_t tok = (size_t)(b * SEQL + n0 + wave * 32 + fa::crow(r, hi));
                    const bf16_t* gp = P + tok * NPROJ + C_GR + h * 128 + r32; bf16_t* op = OB + tok * 1024 + h * 128 + r32;
                    op[0] = (bf16_t)(pkbf(siluf_(bflo((unsigned)gp[0])) * e0 * rs * gr[0], 0.f) & 0xffffu);
                    op[32] = (bf16_t)(pkbf(siluf_(bflo((unsigned)gp[32])) * e1 * rs * gr[1], 0.f) & 0xffffu);
                    op[64] = (bf16_t)(pkbf(siluf_(bflo((unsigned)gp[64])) * e2 * rs * gr[2], 0.f) & 0xffffu);
                    op[96] = (bf16_t)(pkbf(siluf_(bflo((unsigned)gp[96])) * e3 * rs * gr[3], 0.f) & 0xffffu);
                }
                __syncthreads();
            }
        }
    }
#if DBG_CMP
    XBAR();
    {
        PH_LOCALS
        const bf16_t* A_ = (DBG_CMP == 1) ? OA : OB; const bf16_t* R_ = (const bf16_t*)(ws + WS_SPARE);
        float sd = 0.f, sr = 0.f;
#if DBG_CMP == 3
        for (size_t i = (size_t)gtid; i < (size_t)T_TOK * 32; i += (size_t)NGT) { const u64 a = MASK[i], r = ((const u64*)(ws + WS_SPARE))[i]; sd += (float)__popcll(a ^ r); sr += 100.0f * (float)__popcll(r); }
#else
        for (size_t i = (size_t)gtid; i < (size_t)T_TOK * 1024 / 2; i += (size_t)NGT) {
            const unsigned a = ((const unsigned*)A_)[i], r = ((const unsigned*)R_)[i];
            const float d0 = bflo(a) - bflo(r), d1 = bfhi(a) - bfhi(r); sd += d0 * d0 + d1 * d1; sr += bflo(r) * bflo(r) + bfhi(r) * bfhi(r);
        }
#endif
        sd = wave_sum(sd, lane); sr = wave_sum(sr, lane);
        if (lane == 0) { atomicAdd((float*)(ctl + 4096), sd); atomicAdd((float*)(ctl + 4097), sr); }
    }
#endif
    XBAR();
    STAMP(4);

    {
        PH_LOCALS
        pg8::Gemm g{OA, WCOMB, T_TOK, DMODEL, 1024}; pg8::StaticOrder S; S.init(T_TOK, DMODEL, G, bx);
        pg8::EpiMerge<0> E{P, nullptr, BA};
        pg8::gemm_phase<pg8::EpiMerge<0>, pg8::StaticOrder, true, true>(lds, g, S, E, tid);
    }
    XBAR();
    STAMP(5);
    {
        PH_LOCALS
        pg8::Gemm g{OB, WB, T_TOK, DMODEL, 1024}; pg8::StaticOrder S; S.init(T_TOK, DMODEL, G, bx);
        pg8::EpiMerge<1> E{P, BA, MIXED};
        pg8::gemm_phase<pg8::EpiMerge<1>, pg8::StaticOrder, true, true>(lds, g, S, E, tid);
    }
    XBAR();
    STAMP(6);
    {
        PH_LOCALS
        const float* x = IN(0);
        pg8::Gemm g{MIXED, WO, T_TOK, DMODEL, 2048}; pg8::StaticOrder S; S.init(T_TOK, DMODEL, G, bx);
        pg8::EpiRes E{x, out};
        pg8::gemm_phase<pg8::EpiRes, pg8::StaticOrder, true, true>(lds, g, S, E, tid);
    }
    XBAR();
    STAMP(7);

    {
    PH_LOCALS
    const float* g_ffn = IN(8); const float* b_rg = IN(10); const float* b_re = IN(12);
    const f32x4* WC4 = (const f32x4*)(ws + WS_WC); float* tok_rs = (float*)(ws + WS_WC + 786432);
    LAS float* lg = (LAS float*)lds + wave * (16 * 52);
    const int row = lane & 15, g4 = lane >> 4;
    LAS float* part = (LAS float*)lds + 4 * (16 * 52) + (wave & 3) * (13 * 64);
    for (int tile0 = bx * 4; tile0 < T_TOK / 16; tile0 += G * 4) {
        const int tile = tile0 + (wave & 3), kh = wave >> 2;
        const int tok0 = tile * 16;
        const float* hrow = out + (size_t)(tok0 + row) * DMODEL + 8 * g4 + 1024 * kh;
        bf16_t* trow = TN + (size_t)(tok0 + row) * DMODEL + 8 * g4 + 1024 * kh;
        const f32x4* wp = WC4 + (size_t)g4 * 96 + 2 * row + (size_t)kh * 32 * 384;
        const float* gp = g_ffn + 8 * g4 + 1024 * kh;
        f32x4 acc0 = (f32x4){0.f, 0.f, 0.f, 0.f}, acc1 = acc0, acc2 = acc0; float ssq = 0.f;
        f32x4 a0 = *(const f32x4*)(hrow), a1 = *(const f32x4*)(hrow + 4);
        f32x4 b00 = wp[0], b01 = wp[1], b10 = wp[32], b11 = wp[33], b20 = wp[64], b21 = wp[65];
        f32x4 na0 = *(const f32x4*)(hrow + 32), na1 = *(const f32x4*)(hrow + 36);
        f32x4 nb00 = wp[384], nb01 = wp[385], nb10 = wp[416], nb11 = wp[417], nb20 = wp[448], nb21 = wp[449];
        for (int it = 0; it < 32; ++it) {
            const int itn = (it + 2 < 32) ? it + 2 : 31;
            const f32x4 ma0 = *(const f32x4*)(hrow + 32 * itn), ma1 = *(const f32x4*)(hrow + 32 * itn + 4);
            const f32x4* wn = wp + (size_t)itn * 384;
            const f32x4 mb00 = wn[0], mb01 = wn[1], mb10 = wn[32], mb11 = wn[33], mb20 = wn[64], mb21 = wn[65];
            const f32x4 gk0 = *(const f32x4*)(gp + 32 * it), gk1 = *(const f32x4*)(gp + 32 * it + 4);
            ssq += (a0[0] * a0[0] + a0[1] * a0[1]) + (a0[2] * a0[2] + a0[3] * a0[3]) + (a1[0] * a1[0] + a1[1] * a1[1]) + (a1[2] * a1[2] + a1[3] * a1[3]);
            { u32x4 w; w.x = pkbf(a0[0] * gk0[0], a0[1] * gk0[1]); w.y = pkbf(a0[2] * gk0[2], a0[3] * gk0[3]); w.z = pkbf(a1[0] * gk1[0], a1[1] * gk1[1]); w.w = pkbf(a1[2] * gk1[2], a1[3] * gk1[3]);
              *(u32x4*)(trow + 32 * it) = w; }
#pragma unroll
            for (int s_ = 0; s_ < 4; ++s_) {
                acc0 = __builtin_amdgcn_mfma_f32_16x16x4f32(a0[s_], b00[s_], acc0, 0, 0, 0);
                acc1 = __builtin_amdgcn_mfma_f32_16x16x4f32(a0[s_], b10[s_], acc1, 0, 0, 0);
                acc2 = __builtin_amdgcn_mfma_f32_16x16x4f32(a0[s_], b20[s_], acc2, 0, 0, 0);
            }
#pragma unroll
            for (int s_ = 0; s_ < 4; ++s_) {
                acc0 = __builtin_amdgcn_mfma_f32_16x16x4f32(a1[s_], b01[s_], acc0, 0, 0, 0);
                acc1 = __builtin_amdgcn_mfma_f32_16x16x4f32(a1[s_], b11[s_], acc1, 0, 0, 0);
                acc2 = __builtin_amdgcn_mfma_f32_16x16x4f32(a1[s_], b21[s_], acc2, 0, 0, 0);
            }
            a0 = na0; a1 = na1; b00 = nb00; b01 = nb01; b10 = nb10; b11 = nb11; b20 = nb20; b21 = nb21;
            na0 = ma0; na1 = ma1; nb00 = mb00; nb01 = mb01; nb10 = mb10; nb11 = mb11; nb20 = mb20; nb21 = mb21;
        }
        if (kh == 1) {
#pragma unroll
            for (int r = 0; r < 4; ++r) { part[r * 64 + lane] = acc0[r]; part[(4 + r) * 64 + lane] = acc1[r]; part[(8 + r) * 64 + lane] = acc2[r]; }
            part[12 * 64 + lane] = ssq;
        }
        __syncthreads();
        if (kh == 0) {
#pragma unroll
            for (int r = 0; r < 4; ++r) { acc0[r] += part[r * 64 + lane]; acc1[r] += part[(4 + r) * 64 + lane]; acc2[r] += part[(8 + r) * 64 + lane]; }
            ssq += part[12 * 64 + lane];
        ssq += shx(ssq, lane, 16); ssq += shx(ssq, lane, 32);
        const float rstd = 1.0f / sqrtf(ssq * (1.0f / DMODEL) + EPS_F);
#pragma unroll
        for (int r = 0; r < 4; ++r) { lg[(4 * g4 + r) * 52 + row] = acc0[r]; lg[(4 * g4 + r) * 52 + 16 + row] = acc1[r]; lg[(4 * g4 + r) * 52 + 32 + row] = acc2[r]; }
        asm volatile("s_waitcnt lgkmcnt(0)" ::: "memory");
        if (lane < 16) {
            const int t = tok0 + lane; const LAS float* lr = lg + lane * 52;
            float gl[4];
#pragma unroll
            for (int k = 0; k < 4; ++k) gl[k] = lr[k] * rstd + b_rg[k];
            int grp = 0; float gmx = gl[0];
#pragma unroll
            for (int k = 1; k < 4; ++k) if (gl[k] > gmx) { gmx = gl[k]; grp = k; }
            float gz = 0.f;
#pragma unroll
            for (int k = 0; k < 4; ++k) gz += __expf(gl[k] - gmx);
            const float p_grp = 1.0f / gz;
            float el[8];
#pragma unroll
            for (int k = 0; k < 8; ++k) el[k] = lr[4 + grp * 8 + k] * rstd + b_re[grp * 8 + k];
            int i1 = 0; float m1 = el[0];
#pragma unroll
            for (int k = 1; k < 8; ++k) if (el[k] > m1) { m1 = el[k]; i1 = k; }
            int i2 = -1; float m2 = -INFINITY;
#pragma unroll
            for (int k = 0; k < 8; ++k) if (k != i1 && el[k] > m2) { m2 = el[k]; i2 = k; }
            const float e2 = __expf(m2 - m1); const float den = 1.0f / (1.0f + e2);
            const float g1 = p_grp * den, g2 = p_grp * e2 * den;
            const int ex1 = grp * 8 + i1, ex2 = grp * 8 + i2;
            const unsigned r1 = atomicAdd(ctl + 64 * ex1, 1u), r2 = atomicAdd(ctl + 64 * ex2, 1u);
            asg_e[2 * t] = ex1; asg_e[2 * t + 1] = ex2; asg_r[2 * t] = (int)r1; asg_r[2 * t + 1] = (int)r2; asg_g[2 * t] = g1; asg_g[2 * t + 1] = g2;
            tok_rs[t] = rstd;
        }
        }
        __syncthreads();
    }
    }
    XBAR();
    STAMP(8);

    LAS int* tile_start = (LAS int*)(lds + LDS_MISC);
    {
    PH_LOCALS
    if (tid == 0) {
        int acc_t = 0;
        for (int e = 0; e < 32; ++e) { tile_start[e] = acc_t; const int c = (int)__hip_atomic_load(ctl + 64 * e, __ATOMIC_RELAXED, __HIP_MEMORY_SCOPE_AGENT); acc_t += (c + 255) >> 8; }
        tile_start[32] = acc_t;
    }
    __syncthreads();
    for (int a = gw; a < 2 * T_TOK; a += NGW) {
        const int t = a >> 1; const int e = asg_e[a], rk = asg_r[a]; const int slot = tile_start[e] * 256 + rk;
        if (lane == 0) { row_tok[slot] = t; row_gate[slot] = asg_g[a]; tok_slot[a] = slot; ((float*)(ws + WS_WC + 524288))[slot] = ((const float*)(ws + WS_WC + 786432))[t]; }
        const u32x4* src = (const u32x4*)(TN + (size_t)t * DMODEL) + lane; u32x4* dst = (u32x4*)(XG + (size_t)slot * DMODEL) + lane;
#pragma unroll
        for (int j = 0; j < 4; ++j) dst[64 * j] = src[64 * j];
    }
    }
    XBAR();
    STAMP(9);

    {
        PH_LOCALS
        pg8::Gemm g{XG, WGU, MAXSLOT, 2048, 2048}; pg8::ExpertOrder S{tile_start, G, bx};
        pg8::EpiSwiglu E{HMID, (const float*)(ws + WS_WC + 524288)};
        pg8::gemm_phase<pg8::EpiSwiglu, pg8::ExpertOrder, true, true>(lds, g, S, E, tid);
    }
    XBAR();
    STAMP(10);
    {
        PH_LOCALS
        pg8::Gemm g{HMID, WD, MAXSLOT, 2048, 1024}; pg8::ExpertOrder S{tile_start, G, bx};
        pg8::EpiDown E{Y, row_gate};
        pg8::gemm_phase<pg8::EpiDown, pg8::ExpertOrder, true, true>(lds, g, S, E, tid);
    }
    XBAR();
    STAMP(11);

    {
    PH_LOCALS
    const float* g_fin = IN(16);
#if DBG_CMP
    const float dbg_scale = 1.0f + 4.0f * sqrtf(__hip_atomic_load((float*)(ctl + 4096), __ATOMIC_RELAXED, __HIP_MEMORY_SCOPE_AGENT) / __hip_atomic_load((float*)(ctl + 4097), __ATOMIC_RELAXED, __HIP_MEMORY_SCOPE_AGENT));
#elif PROF_PHASE >= 0
    const unsigned ta_ = __hip_atomic_load(ctl + 6000 + (PROF_PHASE / 100), __ATOMIC_RELAXED, __HIP_MEMORY_SCOPE_AGENT), tb_ = __hip_atomic_load(ctl + 6000 + (PROF_PHASE % 100), __ATOMIC_RELAXED, __HIP_MEMORY_SCOPE_AGENT);
    const float dbg_scale = 1.0f + sqrtf(4e-6f * (float)(tb_ - ta_) * 0.01f);
#else
    const float dbg_scale = 1.0f;
#endif
    for (int t = gw; t < T_TOK; t += NGW) {
        const int s0 = tok_slot[2 * t], s1 = tok_slot[2 * t + 1];
        f32x4* hr = (f32x4*)(out + (size_t)t * DMODEL) + lane; const u32x2* y0 = (const u32x2*)(Y + (size_t)s0 * DMODEL) + lane; const u32x2* y1 = (const u32x2*)(Y + (size_t)s1 * DMODEL) + lane;
        f32x4 v[8]; float ss = 0.f;
#pragma unroll
        for (int j = 0; j < 8; ++j) {
            v[j] = hr[64 * j]; const u32x2 a = y0[64 * j], b2 = y1[64 * j];
            v[j][0] += bflo(a.x) + bflo(b2.x); v[j][1] += bfhi(a.x) + bfhi(b2.x); v[j][2] += bflo(a.y) + bflo(b2.y); v[j][3] += bfhi(a.y) + bfhi(b2.y);
            ss += (v[j][0] * v[j][0] + v[j][1] * v[j][1]) + (v[j][2] * v[j][2] + v[j][3] * v[j][3]);
        }
        const float rstd = 1.0f / sqrtf(wave_sum(ss, lane) * (1.0f / DMODEL) + EPS_F);
#pragma unroll
        for (int j = 0; j < 8; ++j) { const f32x4 gg = ((const f32x4*)g_fin)[lane + 64 * j]; hr[64 * j] = v[j] * (rstd * dbg_scale) * gg; }
    }
    }
}

extern "C" void kernel_launch(void* const* d_in, const int* in_sizes, int n_in, void* d_out, int out_size, void* d_ws, size_t ws_size, hipStream_t stream) {
    static int grid_blocks = 0;
    if (grid_blocks == 0) {
        if (n_in != 17 || out_size != T_TOK * DMODEL || ws_size < WS_END) { fprintf(stderr, "kernel_launch: unexpected problem (n_in %d, out %d, ws %zu < %zu)\n", n_in, out_size, ws_size, (size_t)WS_END); grid_blocks = -1; return; }
        int dev = 0, cus = 0, per_cu = 0;
        (void)hipGetDevice(&dev);
        (void)hipDeviceGetAttribute(&cus, hipDeviceAttributeMultiprocessorCount, dev);
        if (hipFuncSetAttribute((const void*)mega_fwd, hipFuncAttributeMaxDynamicSharedMemorySize, LDS_BYTES) != hipSuccess) { fprintf(stderr, "kernel_launch: hipFuncSetAttribute failed\n"); grid_blocks = -1; return; }
        if (hipOccupancyMaxActiveBlocksPerMultiprocessor(&per_cu, (const void*)mega_fwd, 512, LDS_BYTES) != hipSuccess || per_cu < 1) { fprintf(stderr, "kernel_launch: occupancy query says %d\n", per_cu); grid_blocks = -1; return; }
        grid_blocks = cus;
        fprintf(stderr, "kernel_launch: cus %d per_cu %d grid %d ws %zu need %zu\n", cus, per_cu, grid_blocks, ws_size, (size_t)WS_END);
    }
    if (grid_blocks < 0) return;
    if (hipMemsetAsync((char*)d_ws + WS_CTL, 0, 65536, stream) != hipSuccess) { fprintf(stderr, "kernel_launch: memset of control words failed\n"); return; }
    Params prm{};
    for (int i = 0; i < 17; ++i) prm.in[i] = (const float*)d_in[i];
    prm.out = (float*)d_out; prm.ws = (unsigned char*)d_ws;
    void* args[] = {&prm};
    hipError_t e = hipLaunchCooperativeKernel((void*)mega_fwd, dim3(grid_blocks), dim3(512), args, LDS_BYTES, stream);
    if (e != hipSuccess) fprintf(stderr, "cooperative launch failed: %s (grid %d)\n", hipGetErrorString(e), grid_blocks);
}
```

```cpp
#include <hip/hip_runtime.h>
#include <hip/hip_cooperative_groups.h>
#include <cstdio>
#include <cstdint>
namespace cg = cooperative_groups;
namespace pg8 {
#define PG8_LAS __attribute__((address_space(3)))
typedef unsigned short bf16_t;
typedef short bf16x8 __attribute__((ext_vector_type(8)));
typedef float f32x4 __attribute__((ext_vector_type(4)));
typedef unsigned u32x4 __attribute__((ext_vector_type(4)));
constexpr int BM = 256, BK = 64, HALF = 128, HTB = HALF * BK * 2  , STAGE_BYTES = 8 * HTB, NXCD = 8, WGM = 8;

__host__ __device__ __forceinline__ int lds_byte(int r, int c) { const int st = (r >> 4) * 2 + (c >> 5), rr = r & 15, cc = c & 31, ob = rr * 64 + cc * 2; return st * 1024 + (ob ^ (((ob >> 9) & 1) << 5)); }
__host__ __device__ __forceinline__ void stage_rc(int b, int& R, int& C) { const int st = b / 1024, sb = b % 1024, swz = sb ^ (((sb >> 9) & 1) << 5); R = (st >> 1) * 16 + swz / 64; C = (st & 1) * 32 + (swz % 64) / 2; }
__host__ __device__ __forceinline__ int perm32(int rho) { const int n = rho >> 4, i = rho & 15; return 8 * (i >> 2) + 4 * n + (i & 3); }

struct Unit { int pm, pn, e; };
struct Gemm { const bf16_t* A; const bf16_t* Bt; int M, N, K; };

struct StaticOrder {
    int nM, nN, nwg, G, c;
    __host__ __device__ void init(int M, int N, int G_, int c_) { nM = M / BM; nN = N / BM; nwg = nM * nN; G = G_; c = c_; }
    __host__ __device__ bool next(int i, Unit& u) const {
        const long L = (long)i * G + c; if (L >= nwg) return false;
        int wgid = (int)L; { const int q = nwg / NXCD, r = nwg % NXCD, xcd = wgid % NXCD, off = wgid / NXCD; wgid = (xcd < r ? xcd * (q + 1) : r * (q + 1) + (xcd - r) * q) + off; }
        const int nig = WGM * nN, gid = wgid / nig, fm = gid * WGM, gsz = (nM - fm) < WGM ? (nM - fm) : WGM;
        u.pm = fm + ((wgid % nig) % gsz); u.pn = (wgid % nig) / gsz; u.e = 0; return true;
    }
    __device__ __forceinline__ void a_ready(const Unit&) const {}
    __device__ __forceinline__ void done(const Unit&) const {}
};

template <class Epi, class Sched, bool ALIGN_EPI = false, bool SP2 = false>
__device__ __forceinline__ void gemm_phase(PG8_LAS unsigned char* lds, const Gemm g, const Sched& S, const Epi& E, const int tid) {
    const int wid = __builtin_amdgcn_readfirstlane(tid >> 6), lane = tid & 63, wr = wid >> 2, wc = wid & 3, fr = lane & 15, fq = lane >> 4;
    const int K = g.K, nt = K / BK;
    unsigned voffA[2], voffB[2];
#pragma unroll
    for (int i = 0; i < 2; ++i) { int R, C; stage_rc(tid * 16 + i * 8192, R, C); const int Rb = Epi::PERM ? ((R & ~31) + perm32(R & 31)) : R;
        voffA[i] = (unsigned)(R * K + C) * 2u; voffB[i] = (unsigned)(Rb * K + C) * 2u; }
    const size_t kstep = (size_t)(BK * 2);
    const size_t hstep = (size_t)HALF * K * 2;
    const size_t tstep = 2 * hstep;
    const unsigned ldsw = (unsigned)wid * 1024u;
    const int aoff = lds_byte(wr * 64 + fr, fq * 8), boff = lds_byte(wc * 32 + fr, fq * 8);
#define PG8_SA(b, h) (((b) * 2 + (h)) * HTB)
#define PG8_SB(b, h) ((4 + (b) * 2 + (h)) * HTB)
#define PG8_STAGE(bufoff, gbase, voff) do { _Pragma("unroll") for (int _i = 0; _i < 2; ++_i) \
        __builtin_amdgcn_global_load_lds((const unsigned*)((const char*)(gbase) + (voff)[_i]), (PG8_LAS unsigned*)(lds + (bufoff) + ldsw + _i * 8192), 16, 0, 0); } while (0)
#define PG8_LDA(dst, b, h) do { _Pragma("unroll") for (int m = 0; m < 4; ++m) _Pragma("unroll") for (int k = 0; k < 2; ++k) dst[m][k] = *(const PG8_LAS bf16x8*)(lds + PG8_SA(b, h) + aoff + m * 2048 + k * 1024); } while (0)
#define PG8_LDB(dst, b, h) do { _Pragma("unroll") for (int n = 0; n < 2; ++n) _Pragma("unroll") for (int k = 0; k < 2; ++k) dst[n][k] = *(const PG8_LAS bf16x8*)(lds + PG8_SB(b, h) + boff + n * 2048 + k * 1024); } while (0)
#define PG8_MMA(ai, bj, At, Bt) do { __builtin_amdgcn_s_setprio(1); _Pragma("unroll") for (int m = 0; m < 4; ++m) _Pragma("unroll") for (int n = 0; n < 2; ++n) _Pragma("unroll") for (int k = 0; k < 2; ++k) \
        acc[ai][bj][m][n] = __builtin_amdgcn_mfma_f32_16x16x32_bf16(Bt[n][k], At[m][k], acc[ai][bj][m][n], 0, 0, 0); __builtin_amdgcn_s_setprio(0); } while (0)
#define PG8_WAIT_V(n) asm volatile("s_waitcnt vmcnt(" #n ")" ::: "memory")
#define PG8_WAIT_L(n) asm volatile("s_waitcnt lgkmcnt(" #n ")" ::: "memory")
#define PG8_BAR __builtin_amdgcn_s_barrier()
#define PG8_SCHED __builtin_amdgcn_sched_barrier(0)
    Unit cur, nxt; int ui = 0;
    if (!S.next(0, cur)) return;
    f32x4 acc[2][2][4][2];
#pragma unroll
    for (int a = 0; a < 2; ++a)
#pragma unroll
        for (int b = 0; b < 2; ++b)
#pragma unroll
            for (int m = 0; m < 4; ++m)
#pragma unroll
                for (int n = 0; n < 2; ++n) acc[a][b][m][n] = (f32x4){0.f, 0.f, 0.f, 0.f};
    bf16x8 At[4][2], B0[2][2], B1[2][2];
    const size_t estep = (size_t)g.N * K * 2;
    const char* cA = (const char*)g.A + (size_t)cur.pm * tstep; const char* cB = (const char*)g.Bt + (size_t)cur.e * estep + (size_t)cur.pn * tstep;
    S.a_ready(cur);
    if constexpr (SP2) {
        PG8_STAGE(PG8_SB(0, 0), cB, voffB); PG8_STAGE(PG8_SB(0, 1), cB + hstep, voffB); PG8_STAGE(PG8_SA(0, 0), cA, voffA); PG8_STAGE(PG8_SA(0, 1), cA + hstep, voffA);
        if (wr == 1) PG8_BAR;
        PG8_WAIT_V(2); PG8_BAR;
        PG8_STAGE(PG8_SB(1, 0), cB + kstep, voffB); PG8_STAGE(PG8_SA(1, 0), cA + kstep, voffA); PG8_STAGE(PG8_SB(1, 1), cB + hstep + kstep, voffB);
        PG8_WAIT_V(6); PG8_BAR;
    } else {
        PG8_STAGE(PG8_SB(0, 0), cB, voffB); PG8_STAGE(PG8_SA(0, 0), cA, voffA); PG8_STAGE(PG8_SB(0, 1), cB + hstep, voffB); PG8_STAGE(PG8_SA(0, 1), cA + hstep, voffA);
        if (wr == 1) PG8_BAR;
        PG8_WAIT_V(4); PG8_BAR;
        PG8_STAGE(PG8_SB(1, 0), cB + kstep, voffB); PG8_STAGE(PG8_SA(1, 0), cA + kstep, voffA); PG8_STAGE(PG8_SB(1, 1), cB + hstep + kstep, voffB);
        PG8_WAIT_V(6); PG8_BAR;
    }
    for (;;) {
        const bool has_next = S.next(ui + 1, nxt);
        const char* nA = has_next ? (const char*)g.A + (size_t)nxt.pm * tstep : cA; const char* nB = has_next ? (const char*)g.Bt + (size_t)nxt.e * estep + (size_t)nxt.pn * tstep : cB;
        for (int t = 0; t < nt; t += 2) {
            const bool last = (t == nt - 2);
            const char* a1 = cA + (size_t)(t + 1) * kstep;
            const char* a2 = last ? nA : cA + (size_t)(t + 2) * kstep; const char* b2 = last ? nB : cB + (size_t)(t + 2) * kstep;
            const char* a3 = a2 + kstep; const char* b3 = b2 + kstep;
            if (last && has_next) S.a_ready(nxt);
            if constexpr (Epi::HAS_MID) { if (t == nt / 2) E.mid(acc, cur, wr, wc, fr, fq); }
            if constexpr (SP2) {
            PG8_LDB(B0, 0, 0); PG8_LDB(B1, 0, 1); PG8_SCHED; PG8_LDA(At, 0, 0); PG8_STAGE(PG8_SA(1, 1), a1 + hstep, voffA);
            PG8_WAIT_V(8); PG8_WAIT_L(0); PG8_BAR; PG8_MMA(0, 0, At, B0); PG8_MMA(0, 1, At, B1); PG8_BAR; PG8_SCHED;
            PG8_LDA(At, 0, 1); PG8_STAGE(PG8_SB(0, 0), b2, voffB); PG8_STAGE(PG8_SB(0, 1), b2 + hstep, voffB); PG8_STAGE(PG8_SA(0, 0), a2, voffA);
            PG8_WAIT_V(8); PG8_WAIT_L(0); PG8_BAR; PG8_MMA(1, 0, At, B0); PG8_MMA(1, 1, At, B1); PG8_BAR; PG8_SCHED;
            PG8_LDB(B0, 1, 0); PG8_LDB(B1, 1, 1); PG8_SCHED; PG8_LDA(At, 1, 0); PG8_STAGE(PG8_SA(0, 1), a2 + hstep, voffA);
            PG8_WAIT_V(8); PG8_WAIT_L(0); PG8_BAR; PG8_MMA(0, 0, At, B0); PG8_MMA(0, 1, At, B1); PG8_BAR; PG8_SCHED;
            PG8_LDA(At, 1, 1); PG8_STAGE(PG8_SB(1, 0), b3, voffB); PG8_STAGE(PG8_SB(1, 1), b3 + hstep, voffB); PG8_STAGE(PG8_SA(1, 0), a3, voffA);
            PG8_WAIT_V(8); PG8_WAIT_L(0); PG8_BAR; PG8_MMA(1, 0, At, B0); PG8_MMA(1, 1, At, B1); PG8_BAR; PG8_SCHED;
            } else {
            PG8_LDB(B0, 0, 0); PG8_SCHED; PG8_LDA(At, 0, 0); PG8_STAGE(PG8_SA(1, 1), a1 + hstep, voffA);
            PG8_WAIT_L(8); PG8_BAR; PG8_WAIT_L(0); PG8_MMA(0, 0, At, B0); PG8_BAR; PG8_SCHED;
            PG8_LDB(B1, 0, 1); PG8_STAGE(PG8_SB(0, 0), b2, voffB);
            PG8_BAR; PG8_WAIT_L(0); PG8_MMA(0, 1, At, B1); PG8_BAR;
            PG8_LDA(At, 0, 1); PG8_STAGE(PG8_SA(0, 0), a2, voffA);
            PG8_BAR; PG8_WAIT_L(0); PG8_MMA(1, 0, At, B0); PG8_BAR; PG8_SCHED;
            PG8_STAGE(PG8_SB(0, 1), b2 + hstep, voffB);
            PG8_WAIT_V(6); PG8_BAR; PG8_MMA(1, 1, At, B1); PG8_BAR;
            PG8_LDB(B0, 1, 0); PG8_SCHED; PG8_LDA(At, 1, 0); PG8_STAGE(PG8_SA(0, 1), a2 + hstep, voffA);
            PG8_WAIT_L(8); PG8_BAR; PG8_WAIT_L(0); PG8_MMA(0, 0, At, B0); PG8_BAR; PG8_SCHED;
            PG8_LDB(B1, 1, 1); PG8_STAGE(PG8_SB(1, 0), b3, voffB);
            PG8_BAR; PG8_WAIT_L(0); PG8_MMA(0, 1, At, B1); PG8_BAR;
            PG8_LDA(At, 1, 1); PG8_STAGE(PG8_SA(1, 0), a3, voffA);
            PG8_BAR; PG8_WAIT_L(0); PG8_MMA(1, 0, At, B0); PG8_BAR; PG8_SCHED;
            PG8_STAGE(PG8_SB(1, 1), b3 + hstep, voffB);
            PG8_WAIT_V(6); PG8_BAR; PG8_MMA(1, 1, At, B1); PG8_BAR;
            }
        }
        if constexpr (ALIGN_EPI) { if (wr == 0) PG8_BAR; }
        if constexpr (!Epi::AFTER_DRAIN) { E(acc, cur, wr, wc, fr, fq); S.done(cur); }
        if (!has_next) break;
#pragma unroll
        for (int a = 0; a < 2; ++a)
#pragma unroll
            for (int b = 0; b < 2; ++b)
#pragma unroll
                for (int m = 0; m < 4; ++m)
#pragma unroll
                    for (int n = 0; n < 2; ++n) acc[a][b][m][n] = (f32x4){0.f, 0.f, 0.f, 0.f};
        cur = nxt; cA = nA; cB = nB; ++ui;
        if constexpr (ALIGN_EPI) { if (wr == 1) PG8_BAR; }
    }
    PG8_WAIT_V(0);
    if constexpr (!ALIGN_EPI) { if (wr == 0) PG8_BAR; }
    PG8_BAR;
    if constexpr (Epi::AFTER_DRAIN) { E.fused(acc, cur, wr, wc, fr, fq, lds, wid, lane); S.done(cur); }
#undef PG8_SA
#undef PG8_SB
#undef PG8_STAGE
#undef PG8_LDA
#undef PG8_LDB
#undef PG8_MMA
#undef PG8_WAIT_V
#undef PG8_WAIT_L
#undef PG8_BAR
#undef PG8_SCHED
}
}

#ifndef DBG_CMP
#define DBG_CMP 0
#endif
#define LAS __attribute__((address_space(3)))
typedef unsigned short bf16_t;
typedef float f32x4 __attribute__((ext_vector_type(4)));
typedef unsigned u32x4 __attribute__((ext_vector_type(4)));
typedef unsigned u32x2 __attribute__((ext_vector_type(2)));
typedef unsigned long long u64;

constexpr int T_TOK = 16384, DMODEL = 2048, SEQL = 2048;
constexpr int NPROJ = 9984;
constexpr int C_QLAT = 0, C_CKV = 1024, C_QIDX = 1152, C_KIDX = 1664, C_WIDX = 1728, C_QR = 1792, C_KR = 2816, C_VR = 3840, C_GR = 4864, C_GBR = 5888;
constexpr int MAXSLOT = 40960;
constexpr float EPS_F = 1e-6f;
constexpr float IDX_SCALE = 0.04419417382415922f;
constexpr float ATT_SCALE = 0.08838834764831845f;
constexpr float K_SCALE = 0.08838834764831845f;

constexpr size_t WS_CTL = 0;
constexpr size_t WS_ROT = 65536;
constexpr size_t WS_WIN = WS_ROT + 1048576;
constexpr size_t WS_WCOMB = WS_WIN + (size_t)NPROJ * 2048 * 2;
constexpr size_t WS_WB = WS_WCOMB + (size_t)2048 * 1024 * 2;
constexpr size_t WS_WO = WS_WB + (size_t)2048 * 1024 * 2;
constexpr size_t WS_WGU = WS_WO + (size_t)2048 * 2048 * 2;
constexpr size_t WS_WD = WS_WGU + (size_t)32 * 2048 * 2048 * 2;
constexpr size_t WS_P = WS_WD + (size_t)32 * 2048 * 1024 * 2;
constexpr size_t WS_HMID = WS_P;
constexpr size_t WS_Y = WS_HMID + (size_t)MAXSLOT * 1024 * 2;
constexpr size_t WS_XN = WS_P + (size_t)T_TOK * NPROJ * 2;
constexpr size_t WS_OA = WS_XN + (size_t)T_TOK * 2048 * 2;
constexpr size_t WS_OB = WS_OA + (size_t)T_TOK * 1024 * 2;
constexpr size_t WS_MIXED = WS_OB + (size_t)T_TOK * 1024 * 2;
constexpr size_t WS_SPARE = WS_MIXED + (size_t)T_TOK * 2048 * 2;
constexpr size_t WS_XG = WS_OA;
constexpr size_t WS_KV = WS_SPARE + (size_t)T_TOK * 1024 * 2;
constexpr size_t WS_MASK = WS_KV + (size_t)T_TOK * 128 * 2;
constexpr size_t WS_MISC = WS_MASK + (size_t)T_TOK * 256;
constexpr size_t WS_WC = WS_MISC + 1048576;
constexpr size_t WS_END = WS_WC + 1048576;
static_assert(WS_Y + (size_t)MAXSLOT * 2048 * 2 <= WS_XN, "HMID + Y must fit in P");
static_assert(WS_XG + (size_t)MAXSLOT * 2048 * 2 <= WS_KV, "XG must fit in OA..SPARE");
static_assert(WS_END <= (size_t)1073741824, "workspace budget");
constexpr int MI_ROWTOK = 0, MI_ROWGATE = MAXSLOT, MI_TOKSLOT = 2 * MAXSLOT, MI_ASGE = MI_TOKSLOT + 2 * T_TOK, MI_ASGR = MI_ASGE + 2 * T_TOK, MI_ASGG = MI_ASGR + 2 * T_TOK;
static_assert((size_t)(MI_ASGG + 2 * T_TOK) * 4 <= 1048576, "misc budget");
constexpr int LDS_BYTES = 152 * 1024;
constexpr int LDS_MISC = 150 * 1024;

__device__ __forceinline__ float bflo(unsigned w) { return __uint_as_float(w << 16); }
__device__ __forceinline__ float bfhi(unsigned w) { return __uint_as_float(w & 0xffff0000u); }
__device__ __forceinline__ unsigned pkbf(float lo, float hi) { unsigned r; asm volatile("v_cvt_pk_bf16_f32 %0, %1, %2" : "=v"(r) : "v"(lo), "v"(hi)); return r; }
__device__ __forceinline__ int hide_i(int v) { asm volatile("" : "+v"(v)); return v; }
template <class Tp> __device__ __forceinline__ Tp* hide_p(Tp* q) { asm volatile("" : "+s"(q)); return q; }
__device__ __forceinline__ float shx(float v, int lane, int o) { return __int_as_float(__builtin_amdgcn_ds_bpermute((lane ^ o) << 2, __float_as_int(v))); }
__device__ __forceinline__ float wave_sum(float v, int lane) {
#pragma unroll
    for (int o = 1; o < 64; o <<= 1) v += shx(v, lane, o);
    return v;
}
__device__ __forceinline__ float wave_max(float v, int lane) {
#pragma unroll
    for (int o = 1; o < 64; o <<= 1) v = fmaxf(v, shx(v, lane, o));
    return v;
}
__device__ __forceinline__ float sigmoidf_(float x) { return __builtin_amdgcn_rcpf(1.0f + __expf(-x)); }
__device__ __forceinline__ float siluf_(float x) { return x * sigmoidf_(x); }
__device__ __forceinline__ float unkey(unsigned k) { return __uint_as_float((k & 0x80000000u) ? (k & 0x7fffffffu) : ~k); }
__device__ __forceinline__ int sbin(float s) { const int b = (int)(s * 32.0f + 128.0f); return b < 0 ? 0 : (b > 255 ? 255 : b); }
__device__ __forceinline__ unsigned fkey(float f) { const unsigned u = __float_as_uint(f + 0.0f); return (u & 0x80000000u) ? ~u : (u | 0x80000000u); }


#define XB_TMO      128
#define XB_XCNT(j)  (256  + 64 * (j))
#define XB_XSUB(j)  (1280 + 64 * (j))
#define XB_XGEN(j)  (2304 + 64 * (j))
#define XB_TOP      3328
#define XB_TOPGEN   3392
#define XCD_BAR_WORDS 3456
#define XB_SPIN_CAP (1u << 18)
__device__ __forceinline__ unsigned xb_ld(unsigned* p)              { return __hip_atomic_load(p, __ATOMIC_RELAXED, __HIP_MEMORY_SCOPE_AGENT); }
__device__ __forceinline__ unsigned xb_add(unsigned* p, unsigned v) { return __hip_atomic_fetch_add(p, v, __ATOMIC_RELAXED, __HIP_MEMORY_SCOPE_AGENT); }
__device__ __forceinline__ unsigned xb_xcc_id() { return (unsigned)__builtin_amdgcn_s_getreg((3 << 11) | 20) & 0xFu; }
#define XB_SPIN(cond, bar) do { unsigned _sp = 0; while (cond) { __builtin_amdgcn_s_sleep(1); \
    if ((++_sp & 255u) == 0u) { if (xb_ld(&(bar)[XB_TMO])) break; if (_sp > XB_SPIN_CAP) { atomicAdd(&(bar)[XB_TMO], 1u); break; } } } } while (0)
struct XcdBarrier { unsigned* bar; unsigned x; volatile __attribute__((address_space(3))) unsigned* st; };
__device__ __forceinline__ void xcd_barrier_complete(unsigned* bar, unsigned x, unsigned& nloc, unsigned& nx) {
    const unsigned G = gridDim.x * gridDim.y * gridDim.z;
    unsigned sum, cnt, mine, sp = 0u;
    for (;;) {
        sum = 0u; cnt = 0u; mine = 0u;
#pragma unroll
        for (unsigned j = 0; j < 16; ++j) { const unsigned c = xb_ld(&bar[XB_XCNT(j)]); sum += c; cnt += (c > 0u) ? 1u : 0u; mine = (j == x) ? c : mine; }
        if (sum == G) break;
        __builtin_amdgcn_s_sleep(1);
        if ((++sp & 255u) == 0u) { if (xb_ld(&bar[XB_TMO])) break; if (sp > XB_SPIN_CAP) { atomicAdd(&bar[XB_TMO], 1u); break; } }
    }
    nloc = mine > 0u ? mine : 1u; nx = cnt > 0u ? cnt : 1u;
}
__device__ __forceinline__ void xcd_barrier(const XcdBarrier& b, int tid) {
    asm volatile("s_waitcnt vmcnt(0)" ::: "memory");
    __syncthreads();
    if (tid == 0) {
        unsigned* bar = b.bar;
        __builtin_amdgcn_s_waitcnt(0);
        unsigned nloc = b.st[0], nx = b.st[1];
        if (nloc == 0u) { xcd_barrier_complete(bar, b.x, nloc, nx); b.st[0] = nloc; b.st[1] = nx; }
        const unsigned old = xb_add(&bar[XB_XSUB(b.x)], 1u);
        const unsigned gen = old / nloc;
        if (old + 1u == (gen + 1u) * nloc) {
            __builtin_amdgcn_fence(__ATOMIC_RELEASE, "agent");
            asm volatile("s_waitcnt vmcnt(0)" ::: "memory");
            const unsigned og = xb_add(&bar[XB_TOP], 1u);
            const unsigned tg = og / nx;
            if (og + 1u == (tg + 1u) * nx) xb_add(&bar[XB_TOPGEN], 1u);
            else XB_SPIN(xb_ld(&bar[XB_TOPGEN]) == tg, bar);
            __builtin_amdgcn_fence(__ATOMIC_ACQUIRE, "agent");
            xb_add(&bar[XB_XGEN(b.x)], 1u);
            asm volatile("s_waitcnt vmcnt(0)" ::: "memory");
        } else {
            XB_SPIN(xb_ld(&bar[XB_XGEN(b.x)]) == gen, bar);
            __builtin_amdgcn_fence(__ATOMIC_ACQUIRE, "agent");
            asm volatile("s_waitcnt vmcnt(0)" ::: "memory");
        }
    }
    __syncthreads();
}

namespace fa {
using bf16x8 = __attribute__((ext_vector_type(8))) short;
using s16x4  = __attribute__((ext_vector_type(4))) short;
using f32x16 = __attribute__((ext_vector_type(16))) float;
constexpr int TILE_B = 64 * 128 * 2;
constexpr int OFF_V = 0, OFF_K = 2 * TILE_B, OFF_M = 4 * TILE_B, OFF_WS = OFF_M + 2 * 256, LDS_NEED = OFF_WS + 8 * 256;
#define FA_KSWZ(row, colB) ((row) * 256 + ((colB) ^ (((row) & 7) << 4)))
#define FA_SBAR() __builtin_amdgcn_sched_barrier(0)
__device__ __forceinline__ int crow(int r, int hi) { return (r & 3) + 8 * (r >> 2) + 4 * hi; }
__device__ __forceinline__ int v_st(int k, int c) { const int kk = (k & ~0xC) | ((k & 4) << 1) | ((k & 8) >> 1); return ((kk >> 3) * 4 + (c >> 5)) * 512 + ((kk & 7) * 32 + (c & 31)) * 2; }
__device__ __forceinline__ int v_rd_base(int lane) { return ((lane & 3) << 3) | (((lane >> 2) & 3) << 6) | (((lane >> 4) & 1) << 5) | (((lane >> 5) & 1) << 8); }
constexpr int v_rd_off(int d0, int ks, int half) { return d0 * 512 + ks * 4096 + half * 2048; }
template <int OFF> __device__ __forceinline__ s16x4 tr_read(int vb) { s16x4 r; asm volatile("ds_read_b64_tr_b16 %0, %1 offset:%2" : "=&v"(r) : "v"(vb), "i"(OFF) : "memory"); return r; }
template <int D0> __device__ __forceinline__ void pv_one(f32x16& od, int vb, bf16x8 pa0, bf16x8 pa1, bf16x8 pa2, bf16x8 pa3) {
    const s16x4 l0 = tr_read<v_rd_off(D0, 0, 0)>(vb), h0 = tr_read<v_rd_off(D0, 0, 1)>(vb), l1 = tr_read<v_rd_off(D0, 1, 0)>(vb), h1 = tr_read<v_rd_off(D0, 1, 1)>(vb);
    const s16x4 l2 = tr_read<v_rd_off(D0, 2, 0)>(vb), h2 = tr_read<v_rd_off(D0, 2, 1)>(vb), l3 = tr_read<v_rd_off(D0, 3, 0)>(vb), h3 = tr_read<v_rd_off(D0, 3, 1)>(vb);
    asm volatile("s_waitcnt lgkmcnt(0)" ::: "memory"); FA_SBAR();
#define FA_PK(L, H) (bf16x8){L[0], L[1], L[2], L[3], H[0], H[1], H[2], H[3]}
    od = __builtin_amdgcn_mfma_f32_32x32x16_bf16(pa0, FA_PK(l0, h0), od, 0, 0, 0);
    od = __builtin_amdgcn_mfma_f32_32x32x16_bf16(pa1, FA_PK(l1, h1), od, 0, 0, 0);
    od = __builtin_amdgcn_mfma_f32_32x32x16_bf16(pa2, FA_PK(l2, h2), od, 0, 0, 0);
    od = __builtin_amdgcn_mfma_f32_32x32x16_bf16(pa3, FA_PK(l3, h3), od, 0, 0, 0);
#undef FA_PK
}
__device__ __forceinline__ void qkt(f32x16& p0, f32x16& p1, const LAS char* Ks, const bf16x8 (&qr)[8], int r32, int hi) {
    p0 = f32x16{}; p1 = f32x16{};
#pragma unroll
    for (int d0 = 0; d0 < 8; ++d0) { const int cb = (d0 * 16 + hi * 8) * 2;
        const bf16x8 b0 = *(const LAS bf16x8*)(Ks + FA_KSWZ(r32, cb));
        const bf16x8 b1 = *(const LAS bf16x8*)(Ks + FA_KSWZ(32 + r32, cb));
        p0 = __builtin_amdgcn_mfma_f32_32x32x16_bf16(b0, qr[d0], p0, 0, 0, 0);
        p1 = __builtin_amdgcn_mfma_f32_32x32x16_bf16(b1, qr[d0], p1, 0, 0, 0); }
}
__device__ __forceinline__ void p_to_frag(const f32x16& p0, const f32x16& p1, bf16x8& pa0, bf16x8& pa1, bf16x8& pa2, bf16x8& pa3) {
#define FA_PK4(P, BASE, OUT) do { unsigned a0 = pkbf(P[BASE + 0], P[BASE + 1]), a1 = pkbf(P[BASE + 2], P[BASE + 3]);   \
    unsigned b0 = pkbf(P[BASE + 4], P[BASE + 5]), b1 = pkbf(P[BASE + 6], P[BASE + 7]);                              \
    auto r0 = __builtin_amdgcn_permlane32_swap(a0, b0, false, false); auto r1 = __builtin_amdgcn_permlane32_swap(a1, b1, false, false); \
    u32x4 w = {r0[0], r1[0], r0[1], r1[1]}; OUT = *reinterpret_cast<bf16x8*>(&w); } while (0)
    FA_PK4(p0, 0, pa0); FA_PK4(p0, 8, pa1); FA_PK4(p1, 0, pa2); FA_PK4(p1, 8, pa3);
#undef FA_PK4
}

struct UnitArgs {
    const bf16_t* Q; int ldq;
    const bf16_t* K; const bf16_t* V; int ldk;
    const u64* mask;
    int ntiles;
    int n0;
    float lgam;
};

template <int MODE>
__device__ __forceinline__ void unit_body(LAS char* L, const UnitArgs& U, int tid, f32x16 (&o)[4], float& l_out) {
    const int wid = __builtin_amdgcn_readfirstlane(tid >> 6), lane = tid & 63, r32 = lane & 31, hi = lane >> 5;
    LAS char* V_lds = L + OFF_V; LAS char* K_lds = L + OFF_K; LAS u64* M_lds = (LAS u64*)(L + OFF_M);
    LAS float* wsf = (LAS float*)(L + OFF_WS) + wid * 64; LAS float* al_l = wsf + 32;
    constexpr float C = ATT_SCALE * 1.4426950408889634f;
    float m_reg = -1e30f, l_reg = 0.f;
#pragma unroll
    for (int d = 0; d < 4; ++d) o[d] = f32x16{};
    bf16x8 qr[8];
    { const bf16_t* Qw = (MODE == 0) ? U.Q + (size_t)r32 * U.ldq + wid * 128 + hi * 8 : U.Q + (size_t)(wid * 32 + r32) * U.ldq + hi * 8;
#pragma unroll
      for (int d0 = 0; d0 < 8; ++d0) qr[d0] = *(const bf16x8*)(Qw + d0 * 16); }
    const int sr = tid >> 4, sc = (tid & 15) * 8, vst0 = v_st(sr, sc), vst1 = v_st(32 + sr, sc), kst0 = FA_KSWZ(sr, sc * 2), kst1 = FA_KSWZ(32 + sr, sc * 2);
    const int vb0 = (int)(unsigned)(size_t)V_lds + v_rd_base(lane);
    bf16x8 ks0, ks1, vs0, vs1; u64 mws = 0ull;
#define FA_SLOAD(k0) do { ks0 = *(const bf16x8*)(U.K + (size_t)((k0) + sr) * U.ldk + sc); ks1 = *(const bf16x8*)(U.K + (size_t)((k0) + 32 + sr) * U.ldk + sc); \
        if (MODE == 1) { vs0 = *(const bf16x8*)(U.V + (size_t)((k0) + sr) * U.ldk + sc); vs1 = *(const bf16x8*)(U.V + (size_t)((k0) + 32 + sr) * U.ldk + sc); } \
        if (MODE == 0 && tid < 32) mws = U.mask[(size_t)tid * 32 + ((k0) >> 6)]; } while (0)
#define FA_SWRITE(b) do { *(LAS bf16x8*)(K_lds + (b) * TILE_B + kst0) = ks0; *(LAS bf16x8*)(K_lds + (b) * TILE_B + kst1) = ks1; \
        *(LAS bf16x8*)(V_lds + (b) * TILE_B + vst0) = (MODE == 1) ? vs0 : ks0; *(LAS bf16x8*)(V_lds + (b) * TILE_B + vst1) = (MODE == 1) ? vs1 : ks1; \
        if (MODE == 0 && tid < 32) M_lds[(b) * 32 + tid] = mws; } while (0)
    const int NT = U.ntiles;
    FA_SLOAD(0); FA_SWRITE(0);
    if (NT > 1) { FA_SLOAD(64); FA_SWRITE(1); }
    __syncthreads();
    for (int j = 0; j < NT; ++j) {
        const int b = j & 1;
        if (j + 2 < NT) FA_SLOAD((j + 2) * 64);
        f32x16 p0, p1; bf16x8 pa0, pa1, pa2, pa3;
        qkt(p0, p1, K_lds + b * TILE_B, qr, r32, hi);
        if (MODE == 0) {
            const u64 mw = M_lds[b * 32 + r32] >> (4 * hi);
            const unsigned mlo = (unsigned)mw, mhi = (unsigned)(mw >> 32);
#pragma unroll
            for (int r = 0; r < 16; ++r) { const unsigned bit = 1u << ((r & 3) + 8 * (r >> 2)); p0[r] = (mlo & bit) ? p0[r] : -INFINITY; p1[r] = (mhi & bit) ? p1[r] : -INFINITY; }
            float pmax = p0[0];
#pragma unroll
            for (int r = 1; r < 16; ++r) pmax = fmaxf(pmax, p0[r]);
#pragma unroll
            for (int r = 0; r < 16; ++r) pmax = fmaxf(pmax, p1[r]);
            { auto rr = __builtin_amdgcn_permlane32_swap(__float_as_uint(pmax), __float_as_uint(pmax), false, false); pmax = fmaxf(__uint_as_float(rr[0]), __uint_as_float(rr[1])); }
            const float mn = fmaxf(m_reg, pmax); const float alpha = __builtin_amdgcn_exp2f((m_reg - mn) * C); m_reg = mn;
            const float mnC = -mn * C; float ps = 0.f;
#pragma unroll
            for (int r = 0; r < 16; ++r) { p0[r] = __builtin_amdgcn_exp2f(fmaf(p0[r], C, mnC)); p1[r] = __builtin_amdgcn_exp2f(fmaf(p1[r], C, mnC)); ps += p0[r] + p1[r]; }
            { auto rr = __builtin_amdgcn_permlane32_swap(__float_as_uint(ps), __float_as_uint(ps), false, false); ps = __uint_as_float(rr[0]) + __uint_as_float(rr[1]); }
            l_reg = l_reg * alpha + ps;
            if (__any(alpha < 1.f)) {
                if (hi == 0) al_l[r32] = alpha;
                asm volatile("s_waitcnt lgkmcnt(0)" ::: "memory");
#pragma unroll
                for (int r = 0; r < 16; ++r) { const float a = al_l[crow(r, hi)];
#pragma unroll
                    for (int d = 0; d < 4; ++d) o[d][r] *= a; }
            }
        } else {
            const int dn = U.n0 + wid * 32 + r32 - j * 64 - 4 * hi;
            const float base = (float)dn * U.lgam;
#pragma unroll
            for (int r = 0; r < 16; ++r) { const int kk = (r & 3) + 8 * (r >> 2);
                const float f0 = __builtin_amdgcn_exp2f(base - (float)kk * U.lgam), f1 = __builtin_amdgcn_exp2f(base - (float)(kk + 32) * U.lgam);
                p0[r] = (dn >= kk) ? p0[r] * f0 : 0.f; p1[r] = (dn >= kk + 32) ? p1[r] * f1 : 0.f; }
        }
        p_to_frag(p0, p1, pa0, pa1, pa2, pa3);
        FA_SBAR();
        { const int vb = vb0 + b * TILE_B;
          pv_one<0>(o[0], vb, pa0, pa1, pa2, pa3); pv_one<1>(o[1], vb, pa0, pa1, pa2, pa3); pv_one<2>(o[2], vb, pa0, pa1, pa2, pa3); pv_one<3>(o[3], vb, pa0, pa1, pa2, pa3); }
        __syncthreads();
        if (j + 2 < NT) FA_SWRITE(b);
    }
    __syncthreads();
    l_out = l_reg;
#undef FA_SLOAD
#undef FA_SWRITE
}
}

namespace pg8 {
struct EpiProj {
    static constexpr bool PERM = true, AFTER_DRAIN = false, HAS_MID = false;
    bf16_t* P; const float* rot;
    __device__ __forceinline__ void operator()(const f32x4 (&acc)[2][2][4][2], const Unit& u, int wr, int wc, int fr, int fq) const {
        const int row0 = u.pm * BM + wr * 64 + fr, colb = u.pn * BM + wc * 32 + 8 * fq;
        const bool rotq = (u.pn >= 7) && (u.pn < 15);
        const float ksc = (u.pn >= 11) ? K_SCALE : 1.0f;
        const int i0 = 16 * wc + 4 * fq;
#pragma unroll
        for (int ai = 0; ai < 2; ++ai)
#pragma unroll
            for (int m = 0; m < 4; ++m) {
                const int row = row0 + ai * HALF + m * 16; const int pos = row & (SEQL - 1);
                bf16_t* rowp = P + (size_t)row * NPROJ + colb;
                f32x4 r0 = (f32x4){1.f, 0.f, 1.f, 0.f}, r1 = r0;
                if (rotq) { const f32x4* rt = (const f32x4*)(rot + ((size_t)pos * 64 + i0) * 2); r0 = rt[0]; r1 = rt[1]; }
#pragma unroll
                for (int bj = 0; bj < 2; ++bj) {
                    f32x4 v0 = acc[ai][bj][m][0], v1 = acc[ai][bj][m][1];
                    if (rotq) {
                        f32x4 w0, w1;
                        w0[0] = (v0[0] * r0[0] - v0[1] * r0[1]) * ksc; w0[1] = (v0[0] * r0[1] + v0[1] * r0[0]) * ksc;
                        w0[2] = (v0[2] * r0[2] - v0[3] * r0[3]) * ksc; w0[3] = (v0[2] * r0[3] + v0[3] * r0[2]) * ksc;
                        w1[0] = (v1[0] * r1[0] - v1[1] * r1[1]) * ksc; w1[1] = (v1[0] * r1[1] + v1[1] * r1[0]) * ksc;
                        w1[2] = (v1[2] * r1[2] - v1[3] * r1[3]) * ksc; w1[3] = (v1[2] * r1[3] + v1[3] * r1[2]) * ksc;
                        v0 = w0; v1 = w1;
                    }
                    u32x4 w; w.x = pkbf(v0[0], v0[1]); w.y = pkbf(v0[2], v0[3]); w.z = pkbf(v1[0], v1[1]); w.w = pkbf(v1[2], v1[3]);
                    *(u32x4*)(rowp + bj * HALF) = w;
                }
            }
    }
};
struct EpiMergeF {
    static constexpr bool PERM = true, AFTER_DRAIN = false, HAS_MID = true;
    const bf16_t* P; bf16_t* O;
    static __device__ __forceinline__ float cl(float x) { return fminf(fmaxf(x, -30.f), 30.f); }
    static __device__ __forceinline__ float ratio(float a, float b) { return (1.0f + __expf(-cl(b))) * __builtin_amdgcn_rcpf(1.0f + __expf(-cl(a))); }
    __device__ __forceinline__ void mid(f32x4 (&acc)[2][2][4][2], const Unit& u, int wr, int wc, int fr, int fq) const {
        const int row0 = hide_i(u.pm * BM + wr * 64 + fr), colb = hide_i(u.pn * BM + wc * 32 + 8 * fq);
        __builtin_amdgcn_sched_barrier(0);
#pragma unroll
        for (int ai = 0; ai < 2; ++ai) {
            u32x4 g0[4][2], g1[4][2];
#pragma unroll
            for (int m = 0; m < 4; ++m)
#pragma unroll
                for (int bj = 0; bj < 2; ++bj) { const bf16_t* gp = P + (size_t)(row0 + ai * HALF + m * 16) * NPROJ + C_GBR + colb + bj * HALF; g0[m][bj] = *(const u32x4*)gp; g1[m][bj] = *(const u32x4*)(gp + DMODEL); }
            __builtin_amdgcn_sched_barrier(0);
#pragma unroll
            for (int m = 0; m < 4; ++m)
#pragma unroll
                for (int bj = 0; bj < 2; ++bj) {
                    const u32x4 a_ = g0[m][bj], b_ = g1[m][bj]; f32x4 r0, r1;
                    r0[0] = ratio(bflo(a_.x), bflo(b_.x)); r0[1] = ratio(bfhi(a_.x), bfhi(b_.x)); r0[2] = ratio(bflo(a_.y), bflo(b_.y)); r0[3] = ratio(bfhi(a_.y), bfhi(b_.y));
                    r1[0] = ratio(bflo(a_.z), bflo(b_.z)); r1[1] = ratio(bfhi(a_.z), bfhi(b_.z)); r1[2] = ratio(bflo(a_.w), bflo(b_.w)); r1[3] = ratio(bfhi(a_.w), bfhi(b_.w));
                    acc[ai][bj][m][0] = acc[ai][bj][m][0] * r0; acc[ai][bj][m][1] = acc[ai][bj][m][1] * r1;
                }
            __builtin_amdgcn_sched_barrier(0);
        }
    }
    __device__ __forceinline__ void operator()(const f32x4 (&acc)[2][2][4][2], const Unit& u, int wr, int wc, int fr, int fq) const {
        const int row0 = u.pm * BM + wr * 64 + fr, colb = u.pn * BM + wc * 32 + 8 * fq;
#pragma unroll
        for (int ai = 0; ai < 2; ++ai) {
            u32x4 gg[4][2];
#pragma unroll
            for (int m = 0; m < 4; ++m)
#pragma unroll
                for (int bj = 0; bj < 2; ++bj) gg[m][bj] = *(const u32x4*)(P + (size_t)(row0 + ai * HALF + m * 16) * NPROJ + C_GBR + DMODEL + colb + bj * HALF);
            __builtin_amdgcn_sched_barrier(0);
#pragma unroll
            for (int m = 0; m < 4; ++m) {
                const int row = row0 + ai * HALF + m * 16;
#pragma unroll
                for (int bj = 0; bj < 2; ++bj) {
                    const int col = colb + bj * HALF;
                    const u32x4 g = gg[m][bj];
                    const f32x4 v0 = acc[ai][bj][m][0], v1 = acc[ai][bj][m][1];
                    float o[8];
                    o[0] = sigmoidf_(cl(bflo(g.x))) * v0[0]; o[1] = sigmoidf_(cl(bfhi(g.x))) * v0[1]; o[2] = sigmoidf_(cl(bflo(g.y))) * v0[2]; o[3] = sigmoidf_(cl(bfhi(g.y))) * v0[3];
                    o[4] = sigmoidf_(cl(bflo(g.z))) * v1[0]; o[5] = sigmoidf_(cl(bfhi(g.z))) * v1[1]; o[6] = sigmoidf_(cl(bflo(g.w))) * v1[2]; o[7] = sigmoidf_(cl(bfhi(g.w))) * v1[3];
                    u32x4 w; w.x = pkbf(o[0], o[1]); w.y = pkbf(o[2], o[3]); w.z = pkbf(o[4], o[5]); w.w = pkbf(o[6], o[7]);
                    *(u32x4*)(O + (size_t)row * DMODEL + col) = w;
                }
            }
        }
    }
};
struct EpiRes {
    static constexpr bool PERM = false, AFTER_DRAIN = false, HAS_MID = false;
    const float* X; float* O;
    __device__ __forceinline__ void operator()(const f32x4 (&acc)[2][2][4][2], const Unit& u, int wr, int wc, int fr, int fq) const {
        const int row0 = u.pm * BM + wr * 64 + fr, col0 = u.pn * BM + wc * 32 + 4 * fq;
#pragma unroll
        for (int ai = 0; ai < 2; ++ai) {
            f32x4 xv[4][2][2];
#pragma unroll
            for (int m = 0; m < 4; ++m) { const size_t off = (size_t)(row0 + ai * HALF + m * 16) * DMODEL + col0;
#pragma unroll
                for (int bj = 0; bj < 2; ++bj)
#pragma unroll
                    for (int n = 0; n < 2; ++n) xv[m][bj][n] = *(const f32x4*)(X + off + bj * HALF + n * 16); }
            __builtin_amdgcn_sched_barrier(0);
#pragma unroll
            for (int m = 0; m < 4; ++m) { const size_t off = (size_t)(row0 + ai * HALF + m * 16) * DMODEL + col0;
#pragma unroll
                for (int bj = 0; bj < 2; ++bj)
#pragma unroll
                    for (int n = 0; n < 2; ++n) *(f32x4*)(O + off + bj * HALF + n * 16) = xv[m][bj][n] + acc[ai][bj][m][n]; }
            __builtin_amdgcn_sched_barrier(0);
        }
    }
};
struct EpiSwiglu {
    static constexpr bool PERM = true, AFTER_DRAIN = false, HAS_MID = false;
    bf16_t* H; const float* rs;
    __device__ __forceinline__ void operator()(const f32x4 (&acc)[2][2][4][2], const Unit& u, int wr, int wc, int fr, int fq) const {
        const int row0 = u.pm * BM + wr * 64 + fr, col = u.pn * HALF + wc * 32 + 8 * fq;
#pragma unroll
        for (int ai = 0; ai < 2; ++ai)
#pragma unroll
            for (int m = 0; m < 4; ++m) {
                const int row = row0 + ai * HALF + m * 16; const float r_ = rs[row];
                const f32x4 g0 = acc[ai][0][m][0] * r_, g1 = acc[ai][0][m][1] * r_, u0 = acc[ai][1][m][0] * r_, u1 = acc[ai][1][m][1] * r_;
                u32x4 w; w.x = pkbf(siluf_(g0[0]) * u0[0], siluf_(g0[1]) * u0[1]); w.y = pkbf(siluf_(g0[2]) * u0[2], siluf_(g0[3]) * u0[3]);
                w.z = pkbf(siluf_(g1[0]) * u1[0], siluf_(g1[1]) * u1[1]); w.w = pkbf(siluf_(g1[2]) * u1[2], siluf_(g1[3]) * u1[3]);
                *(u32x4*)(H + (size_t)row * 1024 + col) = w;
            }
    }
};
struct EpiDown {
    static constexpr bool PERM = true, AFTER_DRAIN = false, HAS_MID = false;
    bf16_t* Y; const float* rg;
    __device__ __forceinline__ void operator()(const f32x4 (&acc)[2][2][4][2], const Unit& u, int wr, int wc, int fr, int fq) const {
        const int row0 = u.pm * BM + wr * 64 + fr, colb = u.pn * BM + wc * 32 + 8 * fq;
#pragma unroll
        for (int ai = 0; ai < 2; ++ai)
#pragma unroll
            for (int m = 0; m < 4; ++m) {
                const int row = row0 + ai * HALF + m * 16; const float gt = rg[row];
#pragma unroll
                for (int bj = 0; bj < 2; ++bj) {
                    const f32x4 v0 = acc[ai][bj][m][0] * gt, v1 = acc[ai][bj][m][1] * gt;
                    u32x4 w; w.x = pkbf(v0[0], v0[1]); w.y = pkbf(v0[2], v0[3]); w.z = pkbf(v1[0], v1[1]); w.w = pkbf(v1[2], v1[3]);
                    *(u32x4*)(Y + (size_t)row * DMODEL + colb + bj * HALF) = w;
                }
            }
    }
};
struct ExpertOrder {
    const LAS int* ts; int G, c;
    __device__ __forceinline__ bool next(int i, Unit& u) const {
        const int L = i * G + c; const int total = ts[32] * 8; if (L >= total) return false;
        const int gt = L >> 3; u.pm = gt; u.pn = L & 7; int e = 0;
        for (int k = 1; k < 32; ++k) e += (gt >= ts[k]) ? 1 : 0;
        u.e = e; return true;
    }
    __device__ __forceinline__ void a_ready(const Unit&) const {}
    __device__ __forceinline__ void done(const Unit&) const {}
};
}

struct MapId { __device__ __forceinline__ int operator()(int n) const { return n; } };
struct MapGate { __device__ __forceinline__ int operator()(int f) const { return ((f >> 7) << 8) + (f & 127); } };
struct MapUp { __device__ __forceinline__ int operator()(int f) const { return ((f >> 7) << 8) + 128 + (f & 127); } };
struct MapProj {
    __device__ __forceinline__ int operator()(int n) const {
        if (n < 1736) return n;
        if (n < 2760) { const int l = n - 1736, d = l & 127; return C_QR + (l & ~127) + ((d & 63) << 1) + (d >> 6); }
        if (n < 3784) { const int l = n - 2760, d = l & 127; return C_KR + (l & ~127) + ((d & 63) << 1) + (d >> 6); }
        if (n < 4808) return C_VR + (n - 3784);
        if (n < 5832) return C_GR + (n - 4808);
        return C_GBR + (n - 5832);
    }
};
template <class RowMap>
__device__ __forceinline__ void tr_item(const float* __restrict__ src, int N, bf16_t* __restrict__ dst, int ldd, int kb, int nb, int lane, RowMap rm) {
    const int kc = lane >> 3, nc = lane & 7;
    const int n = nb * 32 + nc * 4, k0 = kb * 64 + kc * 8;
    if (n < N) {
        f32x4 v[8];
#pragma unroll
        for (int i = 0; i < 8; ++i) v[i] = *(const f32x4*)(src + (size_t)(k0 + i) * N + n);
#pragma unroll
        for (int j = 0; j < 4; ++j) {
            u32x4 o; o.x = pkbf(v[0][j], v[1][j]); o.y = pkbf(v[2][j], v[3][j]); o.z = pkbf(v[4][j], v[5][j]); o.w = pkbf(v[6][j], v[7][j]);
            *(u32x4*)(dst + (size_t)rm(n + j) * ldd + k0) = o;
        }
    }
}
template <class RowMap>
__device__ __forceinline__ void tr_item2(const float* __restrict__ src, int N, bf16_t* __restrict__ dst, int ldd, int kb, int nb, int lane, RowMap rm) {
    const int kc = lane >> 3, nc = lane & 7;
    const int n = nb * 32 + nc * 4, k0 = kb * 64 + kc * 8;
    f32x4 va[8], vb[8];
#pragma unroll
    for (int i = 0; i < 8; ++i) { va[i] = *(const f32x4*)(src + (size_t)(k0 + i) * N + n); vb[i] = *(const f32x4*)(src + (size_t)(k0 + i) * N + n + 32); }
#pragma unroll
    for (int j = 0; j < 4; ++j) {
        u32x4 o; o.x = pkbf(va[0][j], va[1][j]); o.y = pkbf(va[2][j], va[3][j]); o.z = pkbf(va[4][j], va[5][j]); o.w = pkbf(va[6][j], va[7][j]);
        *(u32x4*)(dst + (size_t)rm(n + j) * ldd + k0) = o;
    }
#pragma unroll
    for (int j = 0; j < 4; ++j) {
        u32x4 o; o.x = pkbf(vb[0][j], vb[1][j]); o.y = pkbf(vb[2][j], vb[3][j]); o.z = pkbf(vb[4][j], vb[5][j]); o.w = pkbf(vb[6][j], vb[7][j]);
        *(u32x4*)(dst + (size_t)rm(n + 32 + j) * ldd + k0) = o;
    }
}
constexpr int EXP_ITEMS = 3 * 32 * 1024;
__device__ __forceinline__ void convert_experts(const float* w_eg, const float* w_eu, const float* w_ed, bf16_t* WGU, bf16_t* WD, unsigned* qctr, int lane) {
    int nxt = 0; if (lane == 0) nxt = (int)atomicAdd(qctr, 8u);
    for (;;) {
        const int it = __builtin_amdgcn_readfirstlane(nxt);
        if (it >= EXP_ITEMS) break;
        if (lane == 0) nxt = (int)atomicAdd(qctr, 8u);
        const int kind = it >> 15, r = it & 32767, e = r >> 10, q = r & 1023;
        if (kind == 0) { const float* src = w_eg + (size_t)e * 2048 * 1024; bf16_t* dst = WGU + (size_t)e * 2048 * 2048;
#pragma unroll 1
            for (int u = 0; u < 8; u += 2) tr_item2(src, 1024, dst, 2048, q >> 5, (q & 31) + u, lane, MapGate{}); }
        else if (kind == 1) { const float* src = w_eu + (size_t)e * 2048 * 1024; bf16_t* dst = WGU + (size_t)e * 2048 * 2048;
#pragma unroll 1
            for (int u = 0; u < 8; u += 2) tr_item2(src, 1024, dst, 2048, q >> 5, (q & 31) + u, lane, MapUp{}); }
        else { const float* src = w_ed + (size_t)e * 1024 * 2048; bf16_t* dst = WD + (size_t)e * 2048 * 1024;
#pragma unroll 1
            for (int u = 0; u < 8; u += 2) tr_item2(src, 2048, dst, 1024, q >> 6, (q & 63) + u, lane, MapId{}); }
    }
}
__device__ __forceinline__ void sincos_d(double a, double& s, double& c) {
    const double TWO_PI = 6.283185307179586476925, HALF_PI = 1.5707963267948966192313;
    double k = rint(a / HALF_PI); double r = a - k * HALF_PI;
    r -= k * 6.123233995736766e-17;
    const int q = ((int)k) & 3; const double r2 = r * r;
    double sp = r2 * (-1.0 / 1307674368000.0);
    sp = r2 * (sp + 1.0 / 6227020800.0); sp = r2 * (sp - 1.0 / 39916800.0); sp = r2 * (sp + 1.0 / 362880.0); sp = r2 * (sp - 1.0 / 5040.0); sp = r2 * (sp + 1.0 / 120.0); sp = r2 * (sp - 1.0 / 6.0);
    const double sr = r + r * sp;
    double cp = r2 * (1.0 / 20922789888000.0);
    cp = r2 * (cp - 1.0 / 87178291200.0); cp = r2 * (cp + 1.0 / 479001600.0); cp = r2 * (cp - 1.0 / 3628800.0); cp = r2 * (cp + 1.0 / 40320.0); cp = r2 * (cp - 1.0 / 720.0); cp = r2 * (cp + 1.0 / 24.0); cp = r2 * (cp - 0.5);
    const double cr = 1.0 + cp;
    s = (q == 0) ? sr : (q == 1) ? cr : (q == 2) ? -sr : -cr;
    c = (q == 0) ? cr : (q == 1) ? -sr : (q == 2) ? -cr : sr;
    (void)TWO_PI;
}

struct Params { const float* in[17]; float* out; unsigned char* ws; };

#ifndef PROF_PHASE
#define PROF_PHASE -1
#endif
#define STAMP(i) do { if (PROF_PHASE >= 0 && bx == 0 && wave_id == 0) ((unsigned*)(p.ws + WS_CTL))[6000 + (i)] = (unsigned)__builtin_amdgcn_s_memrealtime(); } while (0)
#define GSYNC() grid.sync()
#define XBAR() do { const int l__ = (int)__builtin_amdgcn_mbcnt_hi(~0u, __builtin_amdgcn_mbcnt_lo(~0u, (unsigned)hide_i(0))); xcd_barrier(xbar, wave_id * 64 + l__); } while (0)
constexpr int CTL_BAR_WORD = 8192;
constexpr int CTL_QCTR = 2048;
#ifndef NGEMM_P1
#define NGEMM_P1 192
#endif

__global__ void __launch_bounds__(512, 2) mega_fwd(Params p) {
    extern __shared__ __attribute__((aligned(16))) unsigned char lds_raw[];
    LAS unsigned char* lds = (LAS unsigned char*)lds_raw;
    cg::grid_group grid = cg::this_grid();
    const int G = gridDim.x, bx = blockIdx.x;
    const int wave_id = __builtin_amdgcn_readfirstlane((int)threadIdx.x >> 6);
    const int NGW = G * 8, NGT = G * 512;
    XcdBarrier xbar;
    {
        const int l0 = (int)__builtin_amdgcn_mbcnt_hi(~0u, __builtin_amdgcn_mbcnt_lo(~0u, (unsigned)hide_i(0)));
        volatile LAS unsigned* st = (volatile LAS unsigned*)(lds + LDS_MISC + 256);
        if (wave_id == 0 && l0 < 2) st[l0] = 0u;
        __syncthreads();
        xbar.bar = (unsigned*)(p.ws + WS_CTL) + CTL_BAR_WORD; xbar.x = xb_xcc_id(); xbar.st = st;
        if (wave_id == 0 && l0 == 0) (void)xb_add(&xbar.bar[XB_XCNT(xbar.x)], 1u);
    }
#define PH_LOCALS \
    const int lane = (int)__builtin_amdgcn_mbcnt_hi(~0u, __builtin_amdgcn_mbcnt_lo(~0u, (unsigned)hide_i(0))), wave = wave_id, tid = wave * 64 + lane; (void)tid; \
    const int gw = bx * 8 + wave, gtid = bx * 512 + tid; (void)gw; (void)gtid; (void)lane; \
    unsigned char* ws = hide_p(p.ws); float* out = hide_p(p.out); (void)out; \
    unsigned* ctl = (unsigned*)(ws + WS_CTL); float* rot = (float*)(ws + WS_ROT); (void)ctl; (void)rot; \
    bf16_t* WIN = (bf16_t*)(ws + WS_WIN); bf16_t* WCOMB = (bf16_t*)(ws + WS_WCOMB); bf16_t* WB = (bf16_t*)(ws + WS_WB); bf16_t* WO = (bf16_t*)(ws + WS_WO); (void)WIN; (void)WCOMB; (void)WB; (void)WO; \
    bf16_t* WGU = (bf16_t*)(ws + WS_WGU); bf16_t* WD = (bf16_t*)(ws + WS_WD); (void)WGU; (void)WD; \
    bf16_t* P = (bf16_t*)(ws + WS_P); bf16_t* HMID = (bf16_t*)(ws + WS_HMID); bf16_t* Y = (bf16_t*)(ws + WS_Y); (void)P; (void)HMID; (void)Y; \
    bf16_t* XN = (bf16_t*)(ws + WS_XN); bf16_t* BA = XN; bf16_t* TN = XN; (void)BA; (void)TN; \
    bf16_t* OA = (bf16_t*)(ws + WS_OA); bf16_t* OB = OA + 1024;            bf16_t* MIXED = (bf16_t*)(ws + WS_MIXED); bf16_t* XG = (bf16_t*)(ws + WS_XG); (void)OA; (void)OB; (void)MIXED; (void)XG; \
    bf16_t* KV = (bf16_t*)(ws + WS_KV); u64* MASK = (u64*)(ws + WS_MASK); (void)KV; (void)MASK; \
    int* misc = (int*)(ws + WS_MISC); \
    int* row_tok = misc + MI_ROWTOK; float* row_gate = (float*)(misc + MI_ROWGATE); int* tok_slot = misc + MI_TOKSLOT; (void)row_tok; (void)row_gate; (void)tok_slot; \
    int* asg_e = misc + MI_ASGE; int* asg_r = misc + MI_ASGR; float* asg_g = (float*)(misc + MI_ASGG); (void)asg_e; (void)asg_r; (void)asg_g;
#define IN(k) hide_p(p.in[k])

    STAMP(0);
    {
        PH_LOCALS
        const float* x = IN(0); const float* g_mix = IN(1); const float* w_in = IN(2); const float* w_uv = IN(4); const float* w_branch = IN(6); const float* w_out = IN(7);
        constexpr int NB_WIN = 311;
        constexpr int I_WIN = 32 * NB_WIN, I_WB = 16 * 64, I_WO = 32 * 64;
        constexpr int I_TOTAL = I_WIN + I_WB + I_WO;
        for (int it = gw; it < I_TOTAL; it += NGW) {
            int r = it;
            if (r < I_WIN) { tr_item(w_in, 9928, WIN, 2048, r / NB_WIN, r % NB_WIN, lane, MapProj{}); continue; } r -= I_WIN;
            if (r < I_WB) { tr_item(w_branch + (size_t)1024 * 2048, 2048, WCOMB + 1024, 2048, r >> 6, r & 63, lane, MapId{});   continue; } r -= I_WB;
            tr_item(w_out, 2048, WO, 2048, r >> 6, r & 63, lane, MapId{});
        }
        {
            const float* w_eg = IN(13); const float* w_eu = IN(14); const float* w_ed = IN(15);
            for (int it = 2 * gw; it < EXP_ITEMS; it += 2 * NGW) {
                const int kind = it >> 15, r = it & 32767, e = r >> 10, q = r & 1023;
                if (kind == 0) tr_item2(w_eg + (size_t)e * 2048 * 1024, 1024, WGU + (size_t)e * 2048 * 2048, 2048, q >> 5, q & 31, lane, MapGate{});
                else if (kind == 1) tr_item2(w_eu + (size_t)e * 2048 * 1024, 1024, WGU + (size_t)e * 2048 * 2048, 2048, q >> 5, q & 31, lane, MapUp{});
                else tr_item2(w_ed + (size_t)e * 1024 * 2048, 2048, WD + (size_t)e * 2048 * 1024, 1024, q >> 6, q & 63, lane, MapId{});
            }
        }
        for (int i = gtid; i < 56 * 256; i += NGT) ((u32x4*)(WIN + (size_t)1736 * 2048))[i] = (u32x4){0u, 0u, 0u, 0u};
        for (int it = gw; it < 2048; it += NGW) {
            const int h = it >> 8, ch = (it >> 7) & 1, n0 = (it & 127) * 16, c = ch * 64 + lane;
            const float* wuv = w_uv + ((size_t)h * 128 + c) * 128;
            const float* wa = w_branch + (size_t)(h * 128) * 2048 + n0;
            float a[16];
#pragma unroll
            for (int j = 0; j < 16; ++j) a[j] = 0.f;
#pragma unroll 4
            for (int d4 = 0; d4 < 32; ++d4) {
                const f32x4 wv = *(const f32x4*)(wuv + d4 * 4);
#pragma unroll
                for (int dd = 0; dd < 4; ++dd) {
                    const float* wr_ = wa + (size_t)(d4 * 4 + dd) * 2048;
#pragma unroll
                    for (int j4 = 0; j4 < 4; ++j4) { const f32x4 b = *(const f32x4*)(wr_ + j4 * 4); a[j4 * 4 + 0] += wv[dd] * b[0]; a[j4 * 4 + 1] += wv[dd] * b[1]; a[j4 * 4 + 2] += wv[dd] * b[2]; a[j4 * 4 + 3] += wv[dd] * b[3]; }
                }
            }
#pragma unroll
            for (int j = 0; j < 16; ++j) WCOMB[(size_t)(n0 + j) * 2048 + h * 128 + c] = (bf16_t)(pkbf(a[j], 0.f) & 0xffffu);
        }
        for (int m = gw; m < T_TOK; m += 2 * NGW) {
            const int m1 = (m + NGW < T_TOK) ? m + NGW : m;
            const f32x4* xr0 = (const f32x4*)(x + (size_t)m * DMODEL) + lane; const f32x4* xr1 = (const f32x4*)(x + (size_t)m1 * DMODEL) + lane;
            f32x4 v0[8], v1[8]; float s0 = 0.f, s1 = 0.f;
#pragma unroll
            for (int j = 0; j < 8; ++j) { v0[j] = xr0[64 * j]; v1[j] = xr1[64 * j]; }
#pragma unroll
            for (int j = 0; j < 8; ++j) { s0 += (v0[j][0] * v0[j][0] + v0[j][1] * v0[j][1]) + (v0[j][2] * v0[j][2] + v0[j][3] * v0[j][3]); s1 += (v1[j][0] * v1[j][0] + v1[j][1] * v1[j][1]) + (v1[j][2] * v1[j][2] + v1[j][3] * v1[j][3]); }
            const float r0 = 1.0f / sqrtf(wave_sum(s0, lane) * (1.0f / DMODEL) + EPS_F), r1 = 1.0f / sqrtf(wave_sum(s1, lane) * (1.0f / DMODEL) + EPS_F);
            u32x2* o0 = (u32x2*)(XN + (size_t)m * DMODEL) + lane; u32x2* o1 = (u32x2*)(XN + (size_t)m1 * DMODEL) + lane;
#pragma unroll
            for (int j = 0; j < 8; ++j) { const f32x4 gg = ((const f32x4*)g_mix)[lane + 64 * j];
                u32x2 w; w.x = pkbf(v0[j][0] * r0 * gg[0], v0[j][1] * r0 * gg[1]); w.y = pkbf(v0[j][2] * r0 * gg[2], v0[j][3] * r0 * gg[3]); o0[64 * j] = w;
                u32x2 w2; w2.x = pkbf(v1[j][0] * r1 * gg[0], v1[j][1] * r1 * gg[1]); w2.y = pkbf(v1[j][2] * r1 * gg[2], v1[j][3] * r1 * gg[3]); o1[64 * j] = w2; }
        }
        for (int idx = gtid; idx < SEQL * 64; idx += NGT) {
            const int pos = idx >> 6, i = idx & 63; double f = 1.0;
            for (int k = 0; k < i; ++k) f *= 0.8659643233600653;
            double s, c; sincos_d((double)pos * f, s, c);
            rot[2 * idx] = (float)c; rot[2 * idx + 1] = (float)s;
        }
        { const float* g_ffn = IN(8); const float* w_rg = IN(9); const float* w_re = IN(11); float* WC = (float*)(ws + WS_WC);
          for (int idx = gtid; idx < 256 * 48 * 8; idx += NGT) { const int j = idx & 7, c = (idx >> 3) % 48, k = (idx / 384) * 8 + j;
              const float wv = (c < 4) ? w_rg[k * 4 + c] : (c < 36) ? w_re[k * 32 + (c - 4)] : 0.f; WC[idx] = wv * g_ffn[k]; } }
        for (int i = gtid; i < 32; i += NGT) ctl[64 * i] = 0u;
        if (gtid < 2) ctl[4096 + gtid] = 0u;
        for (int i = gtid; i < MAXSLOT; i += NGT) { row_tok[i] = 0; row_gate[i] = 0.f; ((float*)(ws + WS_WC + 524288))[i] = 0.f; }
    }
    GSYNC();
    STAMP(1);

    {
        PH_LOCALS
        pg8::Gemm g{XN, WIN, T_TOK, NPROJ, 2048}; pg8::StaticOrder S; S.init(T_TOK, NPROJ, G, bx);
        pg8::EpiProj E{P, rot};
        pg8::gemm_phase<pg8::EpiProj, pg8::StaticOrder, true, true>(lds, g, S, E, tid);
    }
    XBAR();
    STAMP(2);

    {
        PH_LOCALS
        const float* g_kv = IN(3);
        for (int t = gw; t < T_TOK; t += NGW) {
            const unsigned v = *(const unsigned*)(P + (size_t)t * NPROJ + C_CKV + 2 * lane);
            const float a = bflo(v), b = bfhi(v);
            const float rstd = 1.0f / sqrtf(wave_sum(a * a + b * b, lane) * (1.0f / 128.0f) + EPS_F);
            *(unsigned*)(KV + (size_t)t * 128 + 2 * lane) = pkbf(a * rstd * g_kv[2 * lane], b * rstd * g_kv[2 * lane + 1]);
        }
#if DBG_CMP == 3
        {
        u64* MASKX = (u64*)(ws + WS_SPARE);
        LAS float* qi = (LAS float*)(lds + wave * 10240); LAS float* sc = qi + 512;
        for (int t = gw; t < T_TOK; t += NGW) {
            const int b = t >> 11, q = t & 2047, ng = (q >> 6) + 1;
            { const u32x4 v = *(const u32x4*)(P + (size_t)t * NPROJ + C_QIDX + lane * 8);
              f32x4 lo4 = (f32x4){bflo(v.x), bfhi(v.x), bflo(v.y), bfhi(v.y)}, hi4 = (f32x4){bflo(v.z), bfhi(v.z), bflo(v.w), bfhi(v.w)};
              *(LAS f32x4*)(qi + lane * 8) = lo4; *(LAS f32x4*)(qi + lane * 8 + 4) = hi4; }
            float w[8];
            { const u32x4 v = *(const u32x4*)(P + (size_t)t * NPROJ + C_WIDX); w[0] = bflo(v.x); w[1] = bfhi(v.x); w[2] = bflo(v.y); w[3] = bfhi(v.y); w[4] = bflo(v.z); w[5] = bfhi(v.z); w[6] = bflo(v.w); w[7] = bfhi(v.w); }
            for (int g = 0; g < ng; ++g) {
                LAS float* qg = qi; asm volatile("" : "+v"(qg));
                const int s = g * 64 + lane; const u32x4* kr = (const u32x4*)(P + (size_t)(b * SEQL + s) * NPROJ + C_KIDX);
                float dot[8];
#pragma unroll
                for (int h = 0; h < 8; ++h) dot[h] = 0.f;
#pragma unroll
                for (int c = 0; c < 8; ++c) {
                    const u32x4 v = kr[c];
                    const f32x4 ka = (f32x4){bflo(v.x), bfhi(v.x), bflo(v.y), bfhi(v.y)}, kb = (f32x4){bflo(v.z), bfhi(v.z), bflo(v.w), bfhi(v.w)};
#pragma unroll
                    for (int h = 0; h < 8; ++h) {
                        const f32x4 qa = *(const LAS f32x4*)(qg + h * 64 + c * 8), qb = *(const LAS f32x4*)(qg + h * 64 + c * 8 + 4);
                        dot[h] += (qa[0] * ka[0] + qa[1] * ka[1]) + (qa[2] * ka[2] + qa[3] * ka[3]) + (qb[0] * kb[0] + qb[1] * kb[1]) + (qb[2] * kb[2] + qb[3] * kb[3]);
                    }
                }
                float score = 0.f;
#pragma unroll
                for (int h = 0; h < 8; ++h) score += w[h] * fmaxf(dot[h], 0.f);
                sc[s] = score * IDX_SCALE;
            }
            u64* mrow = MASKX + (size_t)t * 32;
            if (ng <= 4) { if (lane < 32) mrow[lane] = (lane < ng) ? ~0ull : 0ull; }
            else {
                unsigned lo = 0u;
                for (int bit = 31; bit >= 0; --bit) {
                    const unsigned cand = lo | (1u << bit); int cnt = 0;
                    for (int g = 0; g < ng; ++g) cnt += __popcll(__ballot(fkey(sc[g * 64 + lane]) >= cand));
                    if (cnt >= 256) lo = cand;
                }
                const unsigned tau = lo; int cgt = 0;
                for (int g = 0; g < ng; ++g) cgt += __popcll(__ballot(fkey(sc[g * 64 + lane]) > tau));
                const int need = 256 - cgt; int run = 0;
                for (int g = 0; g < ng; ++g) {
                    const unsigned key = fkey(sc[g * 64 + lane]);
                    const u64 gt = __ballot(key > tau), eq = __ballot(key == tau);
                    const u64 below = eq & ((1ull << lane) - 1ull);
                    const bool sel = (key == tau) && (run + (int)__popcll(below) < need);
                    const u64 word = gt | __ballot(sel);
                    run += (int)__popcll(eq);
                    if (lane == 0) mrow[g] = word;
                }
                if (lane >= ng && lane < 32) mrow[lane] = 0ull;
            }
        }
        }
        __syncthreads();
#endif
        typedef short bf16x8_t __attribute__((ext_vector_type(8)));
        constexpr int SCS = 2052;
        LAS float* scl = (LAS float*)lds;
        LAS unsigned* hist = (LAS unsigned*)(lds + 16 * SCS * 4);
        LAS unsigned* candl = hist + 16 * 256 + wave * 64;
        for (int i = tid; i < 16 * 256; i += 512) hist[i] = 0u;
        __syncthreads();
        for (int ui = 0; ui < 4; ++ui) {
            const int uu = ui * 256 + ((ui & 1) ? 255 - bx : bx);
            if (uu >= 1024 || bx >= 256) break;
            const int b = uu & 7, qblk = uu >> 3, q0 = qblk * 16, t0 = b * SEQL + q0, ng = (q0 >> 6) + 1, N = ng * 64;
            if (ng <= 4) {
                for (int qq = 0; qq < 2; ++qq) { u64* mrow = MASK + (size_t)(t0 + 2 * wave + qq) * 32; if (lane < 32) mrow[lane] = (lane < ng) ? ~0ull : 0ull; }
                continue;
            }
            const int qrow = lane & 15, kg = lane >> 4;
            bf16x8_t qf[8][2]; float w[8];
            { const bf16_t* qp = P + (size_t)(t0 + qrow) * NPROJ + C_QIDX + 8 * kg;
#pragma unroll
              for (int h = 0; h < 8; ++h) { qf[h][0] = *(const bf16x8_t*)(qp + h * 64); qf[h][1] = *(const bf16x8_t*)(qp + h * 64 + 32); }
              const u32x4 v = *(const u32x4*)(P + (size_t)(t0 + qrow) * NPROJ + C_WIDX); w[0] = bflo(v.x); w[1] = bfhi(v.x); w[2] = bflo(v.y); w[3] = bfhi(v.y); w[4] = bflo(v.z); w[5] = bfhi(v.z); w[6] = bflo(v.w); w[7] = bfhi(v.w); }
            for (int kt = wave; kt < N / 16; kt += 8) {
                const int s0 = kt * 16;
                const bf16_t* kp = P + (size_t)(b * SEQL + s0 + qrow) * NPROJ + C_KIDX + 8 * kg;
                const bf16x8_t a0 = *(const bf16x8_t*)kp, a1 = *(const bf16x8_t*)(kp + 32);
                f32x4 sacc = (f32x4){0.f, 0.f, 0.f, 0.f};
#pragma unroll
                for (int h = 0; h < 8; ++h) {
                    f32x4 acc = (f32x4){0.f, 0.f, 0.f, 0.f};
                    acc = __builtin_amdgcn_mfma_f32_16x16x32_bf16(a0, qf[h][0], acc, 0, 0, 0);
                    acc = __builtin_amdgcn_mfma_f32_16x16x32_bf16(a1, qf[h][1], acc, 0, 0, 0);
                    sacc[0] += w[h] * fmaxf(acc[0], 0.f); sacc[1] += w[h] * fmaxf(acc[1], 0.f); sacc[2] += w[h] * fmaxf(acc[2], 0.f); sacc[3] += w[h] * fmaxf(acc[3], 0.f);
                }
                sacc = sacc * IDX_SCALE + 0.0f;
                *(LAS f32x4*)(scl + qrow * SCS + s0 + 4 * kg) = sacc;
#pragma unroll
                for (int i = 0; i < 4; ++i) __hip_atomic_fetch_add(hist + qrow * 256 + sbin(sacc[i]), 1u, __ATOMIC_RELAXED, __HIP_MEMORY_SCOPE_WORKGROUP);
            }
            __syncthreads();
#pragma unroll 1
            for (int qq = 0; qq < 2; ++qq) {
                const int q = 2 * wave + qq; const LAS float* row = scl + q * SCS; LAS unsigned* hq = hist + q * 256;
                unsigned key[32];
#pragma unroll
                for (int j = 0; j < 32; ++j) key[j] = (j < ng) ? fkey(row[64 * j + lane]) : 0u;
                const u32x4 hv = *(const LAS u32x4*)(hq + 4 * lane);
                *(LAS u32x4*)(hq + 4 * lane) = (u32x4){0u, 0u, 0u, 0u};
                const int tsum = (int)(hv.x + hv.y + hv.z + hv.w); int incl = tsum;
#pragma unroll
                for (int off = 1; off < 64; off <<= 1) { const int o = __builtin_amdgcn_ds_bpermute(((lane + off) & 63) << 2, incl); incl += (lane + off < 64) ? o : 0; }
                const int suf = incl - tsum;
                int bt_l, ab_l;
                if (suf + (int)hv.w >= 256) { bt_l = 4 * lane + 3; ab_l = suf; }
                else if (suf + (int)(hv.w + hv.z) >= 256) { bt_l = 4 * lane + 2; ab_l = suf + (int)hv.w; }
                else if (suf + (int)(hv.w + hv.z + hv.y) >= 256) { bt_l = 4 * lane + 1; ab_l = suf + (int)(hv.w + hv.z); }
                else { bt_l = 4 * lane; ab_l = suf + (int)(hv.w + hv.z + hv.y); }
                const u64 cb = __ballot(suf < 256 && incl >= 256);
                const int src = (int)__builtin_ctzll(cb | (1ull << 63));
                const int bt = __builtin_amdgcn_readlane(bt_l, src), above = __builtin_amdgcn_readlane(ab_l, src);
                const int r = 256 - above;
                int C = 0;
#pragma unroll
                for (int j = 0; j < 32; ++j) {
                    const bool isc = (key[j] != 0u) && (sbin(unkey(key[j])) == bt);
                    const u64 bal = __ballot(isc);
                    if (isc) { const int pos = C + (int)__popcll(bal & ((1ull << lane) - 1ull)); if (pos < 64) candl[pos] = key[j]; }
                    C += (int)__popcll(bal);
                }
                unsigned tau; int cgt;
                if (C <= 64) {
                    asm volatile("s_waitcnt lgkmcnt(0)" ::: "memory");
                    const unsigned ck = (lane < C) ? candl[lane] : 0u;
                    unsigned lo = 0u;
#pragma unroll 1
                    for (int bit = 31; bit >= 0; --bit) { const unsigned cand = lo | (1u << bit); if ((int)__popcll(__ballot(ck >= cand)) >= r) lo = cand; }
                    tau = lo; cgt = above + (int)__popcll(__ballot(ck > tau));
                } else {
                    unsigned lo = 0u;
#pragma unroll 1
                    for (int bit = 31; bit >= 0; --bit) {
                        const unsigned cand = lo | (1u << bit); int c = 0;
#pragma unroll
                        for (int j = 0; j < 32; ++j) c += (key[j] >= cand) ? 1 : 0;
#pragma unroll
                        for (int x = 1; x < 64; x <<= 1) c += __builtin_amdgcn_ds_bpermute((lane ^ x) << 2, c);
                        if (c >= 256) lo = cand;
                    }
                    tau = lo; cgt = 0;
#pragma unroll
                    for (int j = 0; j < 32; ++j) cgt += (key[j] > tau) ? 1 : 0;
#pragma unroll
                    for (int x = 1; x < 64; x <<= 1) cgt += __builtin_amdgcn_ds_bpermute((lane ^ x) << 2, cgt);
                }
                const int need = 256 - cgt; int run = 0; u64 myword = 0ull;
#pragma unroll
                for (int j = 0; j < 32; ++j) {
                    const u64 gt = __ballot(key[j] > tau), eq = __ballot(key[j] == tau);
                    const u64 below = eq & ((1ull << lane) - 1ull);
                    const bool sel = (key[j] == tau) && (run + (int)__popcll(below) < need);
                    const u64 word = gt | __ballot(sel);
                    run += (int)__popcll(eq);
                    if (lane == j) myword = word;
                    __builtin_amdgcn_sched_barrier(0);
                }
                if (lane < 32) MASK[(size_t)(t0 + q) * 32 + lane] = myword;
            }
            __syncthreads();
        }
    }
    XBAR();
    STAMP(3);

#if DBG_CMP == 1
    {
        PH_LOCALS
        bf16_t* OAX = (bf16_t*)(ws + WS_SPARE);
        float* qv = (float*)(lds_raw + wave * 10240); float* lg = qv + 512;
        for (int it = gw; it < T_TOK * 8; it += NGW) {
            const int t = it >> 3, h = it & 7, b = t >> 11, q = t & 2047, ng = (q >> 6) + 1;
            { const unsigned v = *(const unsigned*)(P + (size_t)t * NPROJ + C_QLAT + h * 128 + 2 * lane); qv[2 * lane] = bflo(v); qv[2 * lane + 1] = bfhi(v); }
            const u64* mrow = MASK + (size_t)t * 32;
            float mx = -INFINITY;
            for (int g = 0; g < ng; ++g) {
                asm volatile("" ::: "memory");
                const u64 word = mrow[g]; float l = -INFINITY;
                if ((word >> lane) & 1ull) {
                    const u32x4* kr = (const u32x4*)(KV + (size_t)(b * SEQL + g * 64 + lane) * 128);
                    float d0 = 0.f, d1 = 0.f, d2 = 0.f, d3 = 0.f;
#pragma unroll
                    for (int c = 0; c < 16; ++c) { const u32x4 v = kr[c]; const f32x4 qa = *(const f32x4*)(qv + 8 * c), qb = *(const f32x4*)(qv + 8 * c + 4);
                        d0 += qa[0] * bflo(v.x) + qb[0] * bflo(v.z); d1 += qa[1] * bfhi(v.x) + qb[1] * bfhi(v.z); d2 += qa[2] * bflo(v.y) + qb[2] * bflo(v.w); d3 += qa[3] * bfhi(v.y) + qb[3] * bfhi(v.w); }
                    l = ((d0 + d1) + (d2 + d3)) * ATT_SCALE;
                }
                lg[g * 64 + lane] = l; mx = fmaxf(mx, l);
            }
            mx = wave_max(mx, lane);
            float o0 = 0.f, o1 = 0.f, sum = 0.f;
            for (int g = 0; g < ng; ++g) {
                const u64 wv = mrow[g];
                u64 word = ((u64)__builtin_amdgcn_readfirstlane((unsigned)(wv >> 32)) << 32) | (u64)__builtin_amdgcn_readfirstlane((unsigned)wv);
                while (word) {
                    const int j = __builtin_ctzll(word); word &= word - 1ull;
                    const int s = g * 64 + j; const float pj = __expf(lg[s] - mx);
                    const unsigned v = *(const unsigned*)(KV + (size_t)(b * SEQL + s) * 128 + 2 * lane);
                    o0 += pj * bflo(v); o1 += pj * bfhi(v); sum += pj;
                }
            }
            const float inv = 1.0f / sum;
            *(unsigned*)(OAX + (size_t)t * 1024 + h * 128 + 2 * lane) = pkbf(o0 * inv, o1 * inv);
        }
    }
    __syncthreads();
#endif
#if DBG_CMP == 2
    {
        PH_LOCALS
        const float* g_ret = IN(5);
        bf16_t* OBX = (bf16_t*)(ws + WS_SPARE);
        float* qv = (float*)(lds_raw + wave * 10240); float* lg = qv + 512; float* wl = lg;
        for (int it = gw; it < T_TOK * 8; it += NGW) {
            const int t = it >> 3, h = it & 7, b = t >> 11, n = t & 2047, ng = (n >> 6) + 1;
            const float lgam = (h == 0) ? -0.04580368961312479f : (h == 1) ? -0.02272007650008353f : (h == 2) ? -0.011315313227834146f : (h == 3) ? -0.005646563141142063f :
                               (h == 4) ? -0.0028205190623786626f : (h == 5) ? -0.0014095702546713536f : (h == 6) ? -0.0007046129765893727f : -0.0003522634716290214f;
            { const unsigned v = *(const unsigned*)(P + (size_t)t * NPROJ + C_QR + h * 128 + 2 * lane); qv[2 * lane] = bflo(v); qv[2 * lane + 1] = bfhi(v); }
            float o0 = 0.f, o1 = 0.f;
            for (int g = 0; g < ng; ++g) {
                asm volatile("" ::: "memory");
                const int m = g * 64 + lane;
                const u32x4* kr = (const u32x4*)(P + (size_t)(b * SEQL + m) * NPROJ + C_KR + h * 128);
                float d0 = 0.f, d1 = 0.f, d2 = 0.f, d3 = 0.f;
#pragma unroll
                for (int c = 0; c < 16; ++c) { const u32x4 v = kr[c]; const f32x4 qa = *(const f32x4*)(qv + 8 * c), qb = *(const f32x4*)(qv + 8 * c + 4);
                    d0 += qa[0] * bflo(v.x) + qb[0] * bflo(v.z); d1 += qa[1] * bfhi(v.x) + qb[1] * bfhi(v.z); d2 += qa[2] * bflo(v.y) + qb[2] * bflo(v.w); d3 += qa[3] * bfhi(v.y) + qb[3] * bfhi(v.w); }
                const float dot = (d0 + d1) + (d2 + d3);
                wl[lane] = (m <= n) ? dot * exp2f((float)(n - m) * lgam) : 0.f;
                const int jmax = (g == ng - 1) ? (n & 63) : 63;
                for (int j = 0; j <= jmax; ++j) {
                    const float wj = wl[j];
                    const unsigned v = *(const unsigned*)(P + (size_t)(b * SEQL + g * 64 + j) * NPROJ + C_VR + h * 128 + 2 * lane);
                    o0 += wj * bflo(v); o1 += wj * bfhi(v);
                }
            }
            const float mu = wave_sum(o0 + o1, lane) * (1.0f / 128.0f); const float e0 = o0 - mu, e1 = o1 - mu;
            const float rs = 1.0f / sqrtf(wave_sum(e0 * e0 + e1 * e1, lane) * (1.0f / 128.0f) + EPS_F);
            const unsigned gv = *(const unsigned*)(P + (size_t)t * NPROJ + C_GR + h * 128 + 2 * lane);
            const float y0 = siluf_(bflo(gv)) * e0 * rs * g_ret[h * 128 + 2 * lane], y1 = siluf_(bfhi(gv)) * e1 * rs * g_ret[h * 128 + 2 * lane + 1];
            *(unsigned*)(OBX + (size_t)t * 1024 + h * 128 + 2 * lane) = pkbf(y0, y1);
        }
    }
    __syncthreads();
#endif
    {
        PH_LOCALS
        for (int pr = bx; pr < 256; pr += G) {
            const int b = pr >> 5, i = pr & 31;
#pragma unroll 1
            for (int uu = 0; uu < 2; ++uu) {
                const int qb = uu ? 63 - i : i; const int t0 = b * SEQL + qb * 32;
                fa::UnitArgs U; U.Q = P + (size_t)t0 * NPROJ + C_QLAT; U.ldq = NPROJ; U.K = KV + (size_t)b * SEQL * 128; U.V = U.K; U.ldk = 128; U.mask = MASK + (size_t)t0 * 32;
                U.ntiles = (qb >> 1) + 1; U.n0 = 0; U.lgam = 0.f;
                fa::f32x16 o[4]; float l_reg;
                fa::unit_body<0>((LAS char*)lds, U, tid, o, l_reg);
                const int r32 = lane & 31, hi = lane >> 5;
                LAS float* li_l = (LAS float*)(lds + fa::OFF_WS) + wave * 64;
                if (hi == 0) li_l[r32] = l_reg;
                asm volatile("s_waitcnt lgkmcnt(0)" ::: "memory");
#pragma unroll
                for (int r = 0; r < 16; ++r) {
                    const int orow = fa::crow(r, hi); const float rl = __builtin_amdgcn_rcpf(li_l[orow]);
                    bf16_t* op = OA + (size_t)(t0 + orow) * 2048 + wave * 128 + r32;
#pragma unroll
                    for (int d0 = 0; d0 < 4; ++d0) op[d0 * 32] = (bf16_t)(pkbf(o[d0][r] * rl, 0.f) & 0xffffu);
                }
                __syncthreads();
            }
        }
    }
    STAMP(20);
    {
        PH_LOCALS
        const float* g_ret = IN(5);
        for (int pr = bx; pr < 256; pr += G) {
            const int bh = pr >> 2, i = pr & 3, b = bh >> 3, h = bh & 7;
            const float lgam = (h == 0) ? -0.04580368961312479f : (h == 1) ? -0.02272007650008353f : (h == 2) ? -0.011315313227834146f : (h == 3) ? -0.005646563141142063f :
                               (h == 4) ? -0.0028205190623786626f : (h == 5) ? -0.0014095702546713536f : (h == 6) ? -0.0007046129765893727f : -0.0003522634716290214f;
#pragma unroll 1
            for (int uu = 0; uu < 2; ++uu) {
                const int qb = uu ? 7 - i : i; const int n0 = qb * 256;
                fa::UnitArgs U; U.Q = P + (size_t)(b * SEQL + n0) * NPROJ + C_QR + h * 128; U.ldq = NPROJ;
                U.K = P + (size_t)(b * SEQL) * NPROJ + C_KR + h * 128; U.V = P + (size_t)(b * SEQL) * NPROJ + C_VR + h * 128; U.ldk = NPROJ; U.mask = nullptr;
                U.ntiles = 4 * (qb + 1); U.n0 = n0; U.lgam = lgam;
                fa::f32x16 o[4]; float l_reg;
                fa::unit_body<1>((LAS char*)lds, U, tid, o, l_reg);
                const int r32 = lane & 31, hi = lane >> 5;
                float gr[4];
#pragma unroll
                for (int d0 = 0; d0 < 4; ++d0) gr[d0] = g_ret[h * 128 + d0 * 32 + r32];
#pragma unroll
                for (int r = 0; r < 16; ++r) {
                    float s = (o[0][r] + o[1][r]) + (o[2][r] + o[3][r]);
#pragma unroll
                    for (int x = 1; x < 32; x <<= 1) s += shx(s, lane, x);
                    const float mu = s * (1.0f / 128.0f);
                    const float e0 = o[0][r] - mu, e1 = o[1][r] - mu, e2 = o[2][r] - mu, e3 = o[3][r] - mu;
                    float q = (e0 * e0 + e1 * e1) + (e2 * e2 + e3 * e3);
#pragma unroll
                    for (int x = 1; x < 32; x <<= 1) q += shx(q, lane, x);
                    const float rs = 1.0f / sqrtf(q * (1.0f / 128.0f) + EPS_F);
                    const size_t tok = (size_t)(b * SEQL + n0 + wave * 32 + fa::crow(r, hi));
                    const bf16_t* gp = P + tok * NPROJ + C_GR + h * 128 + r32; bf16_t* op = OB + tok * 2048 + h * 128 + r32;
                    op[0] = (bf16_t)(pkbf(siluf_(bflo((unsigned)gp[0])) * e0 * rs * gr[0], 0.f) & 0xffffu);
                    op[32] = (bf16_t)(pkbf(siluf_(bflo((unsigned)gp[32])) * e1 * rs * gr[1], 0.f) & 0xffffu);
                    op[64] = (bf16_t)(pkbf(siluf_(bflo((unsigned)gp[64])) * e2 * rs * gr[2], 0.f) & 0xffffu);
                    op[96] = (bf16_t)(pkbf(siluf_(bflo((unsigned)gp[96])) * e3 * rs * gr[3], 0.f) & 0xffffu);
                }
                __syncthreads();
            }
        }
    }
#if DBG_CMP
    XBAR();
    {
        PH_LOCALS
        const bf16_t* A_ = (DBG_CMP == 1) ? OA : OB; const bf16_t* R_ = (const bf16_t*)(ws + WS_SPARE);
        float sd = 0.f, sr = 0.f;
#if DBG_CMP == 3
        for (size_t i = (size_t)gtid; i < (size_t)T_TOK * 32; i += (size_t)NGT) { const u64 a = MASK[i], r = ((const u64*)(ws + WS_SPARE))[i]; sd += (float)__popcll(a ^ r); sr += 100.0f * (float)__popcll(r); }
#else
        for (size_t i = (size_t)gtid; i < (size_t)T_TOK * 1024 / 2; i += (size_t)NGT) {
            const unsigned a = ((const unsigned*)A_)[(i >> 9) * 1024 + (i & 511)], r = ((const unsigned*)R_)[i];
            const float d0 = bflo(a) - bflo(r), d1 = bfhi(a) - bfhi(r); sd += d0 * d0 + d1 * d1; sr += bflo(r) * bflo(r) + bfhi(r) * bfhi(r);
        }
#endif
        sd = wave_sum(sd, lane); sr = wave_sum(sr, lane);
        if (lane == 0) { atomicAdd((float*)(ctl + 4096), sd); atomicAdd((float*)(ctl + 4097), sr); }
    }
#endif
    XBAR();
    STAMP(4);

    {
        PH_LOCALS
        pg8::Gemm g{OA, WCOMB, T_TOK, DMODEL, 2048}; pg8::StaticOrder S; S.init(T_TOK, DMODEL, G, bx);
        pg8::EpiMergeF E{P, MIXED};
        pg8::gemm_phase<pg8::EpiMergeF, pg8::StaticOrder, true, true>(lds, g, S, E, tid);
    }
    XBAR();
    STAMP(5);
    {
        PH_LOCALS
        const float* x = IN(0);
        pg8::Gemm g{MIXED, WO, T_TOK, DMODEL, 2048}; pg8::StaticOrder S; S.init(T_TOK, DMODEL, G, bx);
        pg8::EpiRes E{x, out};
        pg8::gemm_phase<pg8::EpiRes, pg8::StaticOrder, true, true>(lds, g, S, E, tid);
    }
    XBAR();
    STAMP(7);

    {
    PH_LOCALS
    const float* g_ffn = IN(8); const float* b_rg = IN(10); const float* b_re = IN(12);
    const f32x4* WC4 = (const f32x4*)(ws + WS_WC); float* tok_rs = (float*)(ws + WS_WC + 786432);
    LAS float* lg = (LAS float*)lds + wave * (16 * 52);
    const int row = lane & 15, g4 = lane >> 4;
    LAS float* part = (LAS float*)lds + 4 * (16 * 52) + (wave & 3) * (13 * 64);
    for (int tile0 = bx * 4; tile0 < T_TOK / 16; tile0 += G * 4) {
        const int tile = tile0 + (wave & 3), kh = wave >> 2;
        const int tok0 = tile * 16;
        const float* hrow = out + (size_t)(tok0 + row) * DMODEL + 8 * g4 + 1024 * kh;
        bf16_t* trow = TN + (size_t)(tok0 + row) * DMODEL + 8 * g4 + 1024 * kh;
        const f32x4* wp = WC4 + (size_t)g4 * 96 + 2 * row + (size_t)kh * 32 * 384;
        const float* gp = g_ffn + 8 * g4 + 1024 * kh;
        f32x4 acc0 = (f32x4){0.f, 0.f, 0.f, 0.f}, acc1 = acc0, acc2 = acc0; float ssq = 0.f;
        f32x4 a0 = *(const f32x4*)(hrow), a1 = *(const f32x4*)(hrow + 4);
        f32x4 b00 = wp[0], b01 = wp[1], b10 = wp[32], b11 = wp[33], b20 = wp[64], b21 = wp[65];
        f32x4 na0 = *(const f32x4*)(hrow + 32), na1 = *(const f32x4*)(hrow + 36);
        f32x4 nb00 = wp[384], nb01 = wp[385], nb10 = wp[416], nb11 = wp[417], nb20 = wp[448], nb21 = wp[449];
        for (int it = 0; it < 32; ++it) {
            const int itn = (it + 2 < 32) ? it + 2 : 31;
            const f32x4 ma0 = *(const f32x4*)(hrow + 32 * itn), ma1 = *(const f32x4*)(hrow + 32 * itn + 4);
            const f32x4* wn = wp + (size_t)itn * 384;
            const f32x4 mb00 = wn[0], mb01 = wn[1], mb10 = wn[32], mb11 = wn[33], mb20 = wn[64], mb21 = wn[65];
            const f32x4 gk0 = *(const f32x4*)(gp + 32 * it), gk1 = *(const f32x4*)(gp + 32 * it + 4);
            ssq += (a0[0] * a0[0] + a0[1] * a0[1]) + (a0[2] * a0[2] + a0[3] * a0[3]) + (a1[0] * a1[0] + a1[1] * a1[1]) + (a1[2] * a1[2] + a1[3] * a1[3]);
            { u32x4 w; w.x = pkbf(a0[0] * gk0[0], a0[1] * gk0[1]); w.y = pkbf(a0[2] * gk0[2], a0[3] * gk0[3]); w.z = pkbf(a1[0] * gk1[0], a1[1] * gk1[1]); w.w = pkbf(a1[2] * gk1[2], a1[3] * gk1[3]);
              *(u32x4*)(trow + 32 * it) = w; }
#pragma unroll
            for (int s_ = 0; s_ < 4; ++s_) {
                acc0 = __builtin_amdgcn_mfma_f32_16x16x4f32(a0[s_], b00[s_], acc0, 0, 0, 0);
                acc1 = __builtin_amdgcn_mfma_f32_16x16x4f32(a0[s_], b10[s_], acc1, 0, 0, 0);
                acc2 = __builtin_amdgcn_mfma_f32_16x16x4f32(a0[s_], b20[s_], acc2, 0, 0, 0);
            }
#pragma unroll
            for (int s_ = 0; s_ < 4; ++s_) {
                acc0 = __builtin_amdgcn_mfma_f32_16x16x4f32(a1[s_], b01[s_], acc0, 0, 0, 0);
                acc1 = __builtin_amdgcn_mfma_f32_16x16x4f32(a1[s_], b11[s_], acc1, 0, 0, 0);
                acc2 = __builtin_amdgcn_mfma_f32_16x16x4f32(a1[s_], b21[s_], acc2, 0, 0, 0);
            }
            a0 = na0; a1 = na1; b00 = nb00; b01 = nb01; b10 = nb10; b11 = nb11; b20 = nb20; b21 = nb21;
            na0 = ma0; na1 = ma1; nb00 = mb00; nb01 = mb01; nb10 = mb10; nb11 = mb11; nb20 = mb20; nb21 = mb21;
        }
        if (kh == 1) {
#pragma unroll
            for (int r = 0; r < 4; ++r) { part[r * 64 + lane] = acc0[r]; part[(4 + r) * 64 + lane] = acc1[r]; part[(8 + r) * 64 + lane] = acc2[r]; }
            part[12 * 64 + lane] = ssq;
        }
        __syncthreads();
        if (kh == 0) {
#pragma unroll
            for (int r = 0; r < 4; ++r) { acc0[r] += part[r * 64 + lane]; acc1[r] += part[(4 + r) * 64 + lane]; acc2[r] += part[(8 + r) * 64 + lane]; }
            ssq += part[12 * 64 + lane];
        ssq += shx(ssq, lane, 16); ssq += shx(ssq, lane, 32);
        const float rstd = 1.0f / sqrtf(ssq * (1.0f / DMODEL) + EPS_F);
#pragma unroll
        for (int r = 0; r < 4; ++r) { lg[(4 * g4 + r) * 52 + row] = acc0[r]; lg[(4 * g4 + r) * 52 + 16 + row] = acc1[r]; lg[(4 * g4 + r) * 52 + 32 + row] = acc2[r]; }
        asm volatile("s_waitcnt lgkmcnt(0)" ::: "memory");
        if (lane < 16) {
            const int t = tok0 + lane; const LAS float* lr = lg + lane * 52;
            float gl[4];
#pragma unroll
            for (int k = 0; k < 4; ++k) gl[k] = lr[k] * rstd + b_rg[k];
            int grp = 0; float gmx = gl[0];
#pragma unroll
            for (int k = 1; k < 4; ++k) if (gl[k] > gmx) { gmx = gl[k]; grp = k; }
            float gz = 0.f;
#pragma unroll
            for (int k = 0; k < 4; ++k) gz += __expf(gl[k] - gmx);
            const float p_grp = 1.0f / gz;
            float el[8];
#pragma unroll
            for (int k = 0; k < 8; ++k) el[k] = lr[4 + grp * 8 + k] * rstd + b_re[grp * 8 + k];
            int i1 = 0; float m1 = el[0];
#pragma unroll
            for (int k = 1; k < 8; ++k) if (el[k] > m1) { m1 = el[k]; i1 = k; }
            int i2 = -1; float m2 = -INFINITY;
#pragma unroll
            for (int k = 0; k < 8; ++k) if (k != i1 && el[k] > m2) { m2 = el[k]; i2 = k; }
            const float e2 = __expf(m2 - m1); const float den = 1.0f / (1.0f + e2);
            const float g1 = p_grp * den, g2 = p_grp * e2 * den;
            const int ex1 = grp * 8 + i1, ex2 = grp * 8 + i2;
            const unsigned r1 = atomicAdd(ctl + 64 * ex1, 1u), r2 = atomicAdd(ctl + 64 * ex2, 1u);
            asg_e[2 * t] = ex1; asg_e[2 * t + 1] = ex2; asg_r[2 * t] = (int)r1; asg_r[2 * t + 1] = (int)r2; asg_g[2 * t] = g1; asg_g[2 * t + 1] = g2;
            tok_rs[t] = rstd;
        }
        }
        __syncthreads();
    }
    }
    XBAR();
    STAMP(8);

    LAS int* tile_start = (LAS int*)(lds + LDS_MISC);
    {
    PH_LOCALS
    if (tid == 0) {
        int acc_t = 0;
        for (int e = 0; e < 32; ++e) { tile_start[e] = acc_t; const int c = (int)__hip_atomic_load(ctl + 64 * e, __ATOMIC_RELAXED, __HIP_MEMORY_SCOPE_AGENT); acc_t += (c + 255) >> 8; }
        tile_start[32] = acc_t;
    }
    __syncthreads();
    for (int a = gw; a < 2 * T_TOK; a += NGW) {
        const int t = a >> 1; const int e = asg_e[a], rk = asg_r[a]; const int slot = tile_start[e] * 256 + rk;
        if (lane == 0) { row_tok[slot] = t; row_gate[slot] = asg_g[a]; tok_slot[a] = slot; ((float*)(ws + WS_WC + 524288))[slot] = ((const float*)(ws + WS_WC + 786432))[t]; }
        const u32x4* src = (const u32x4*)(TN + (size_t)t * DMODEL) + lane; u32x4* dst = (u32x4*)(XG + (size_t)slot * DMODEL) + lane;
#pragma unroll
        for (int j = 0; j < 4; ++j) dst[64 * j] = src[64 * j];
    }
    }
    XBAR();
    STAMP(9);

    {
        PH_LOCALS
        pg8::Gemm g{XG, WGU, MAXSLOT, 2048, 2048}; pg8::ExpertOrder S{tile_start, G, bx};
        pg8::EpiSwiglu E{HMID, (const float*)(ws + WS_WC + 524288)};
        pg8::gemm_phase<pg8::EpiSwiglu, pg8::ExpertOrder, true, true>(lds, g, S, E, tid);
    }
    XBAR();
    STAMP(10);
    {
        PH_LOCALS
        pg8::Gemm g{HMID, WD, MAXSLOT, 2048, 1024}; pg8::ExpertOrder S{tile_start, G, bx};
        pg8::EpiDown E{Y, row_gate};
        pg8::gemm_phase<pg8::EpiDown, pg8::ExpertOrder, true, true>(lds, g, S, E, tid);
    }
    XBAR();
    STAMP(11);

    {
    PH_LOCALS
    const float* g_fin = IN(16);
#if DBG_CMP
    const float dbg_scale = 1.0f + 4.0f * sqrtf(__hip_atomic_load((float*)(ctl + 4096), __ATOMIC_RELAXED, __HIP_MEMORY_SCOPE_AGENT) / __hip_atomic_load((float*)(ctl + 4097), __ATOMIC_RELAXED, __HIP_MEMORY_SCOPE_AGENT));
#elif PROF_PHASE >= 0
    const unsigned ta_ = __hip_atomic_load(ctl + 6000 + (PROF_PHASE / 100), __ATOMIC_RELAXED, __HIP_MEMORY_SCOPE_AGENT), tb_ = __hip_atomic_load(ctl + 6000 + (PROF_PHASE % 100), __ATOMIC_RELAXED, __HIP_MEMORY_SCOPE_AGENT);
    const float dbg_scale = 1.0f + sqrtf(4e-6f * (float)(tb_ - ta_) * 0.01f);
#else
    const float dbg_scale = 1.0f;
#endif
    for (int t = gw; t < T_TOK; t += NGW) {
        const int s0 = tok_slot[2 * t], s1 = tok_slot[2 * t + 1];
        f32x4* hr = (f32x4*)(out + (size_t)t * DMODEL) + lane; const u32x2* y0 = (const u32x2*)(Y + (size_t)s0 * DMODEL) + lane; const u32x2* y1 = (const u32x2*)(Y + (size_t)s1 * DMODEL) + lane;
        f32x4 v[8]; float ss = 0.f;
#pragma unroll
        for (int j = 0; j < 8; ++j) {
            v[j] = hr[64 * j]; const u32x2 a = y0[64 * j], b2 = y1[64 * j];
            v[j][0] += bflo(a.x) + bflo(b2.x); v[j][1] += bfhi(a.x) + bfhi(b2.x); v[j][2] += bflo(a.y) + bflo(b2.y); v[j][3] += bfhi(a.y) + bfhi(b2.y);
            ss += (v[j][0] * v[j][0] + v[j][1] * v[j][1]) + (v[j][2] * v[j][2] + v[j][3] * v[j][3]);
        }
        const float rstd = 1.0f / sqrtf(wave_sum(ss, lane) * (1.0f / DMODEL) + EPS_F);
#pragma unroll
        for (int j = 0; j < 8; ++j) { const f32x4 gg = ((const f32x4*)g_fin)[lane + 64 * j]; hr[64 * j] = v[j] * (rstd * dbg_scale) * gg; }
    }
    }
}

extern "C" void kernel_launch(void* const* d_in, const int* in_sizes, int n_in, void* d_out, int out_size, void* d_ws, size_t ws_size, hipStream_t stream) {
    static int grid_blocks = 0;
    if (grid_blocks == 0) {
        if (n_in != 17 || out_size != T_TOK * DMODEL || ws_size < WS_END) { fprintf(stderr, "kernel_launch: unexpected problem (n_in %d, out %d, ws %zu < %zu)\n", n_in, out_size, ws_size, (size_t)WS_END); grid_blocks = -1; return; }
        int dev = 0, cus = 0, per_cu = 0;
        (void)hipGetDevice(&dev);
        (void)hipDeviceGetAttribute(&cus, hipDeviceAttributeMultiprocessorCount, dev);
        if (hipFuncSetAttribute((const void*)mega_fwd, hipFuncAttributeMaxDynamicSharedMemorySize, LDS_BYTES) != hipSuccess) { fprintf(stderr, "kernel_launch: hipFuncSetAttribute failed\n"); grid_blocks = -1; return; }
        if (hipOccupancyMaxActiveBlocksPerMultiprocessor(&per_cu, (const void*)mega_fwd, 512, LDS_BYTES) != hipSuccess || per_cu < 1) { fprintf(stderr, "kernel_launch: occupancy query says %d\n", per_cu); grid_blocks = -1; return; }
        grid_blocks = cus;
        fprintf(stderr, "kernel_launch: cus %d per_cu %d grid %d ws %zu need %zu\n", cus, per_cu, grid_blocks, ws_size, (size_t)WS_END);
    }
    if (grid_blocks < 0) return;
    if (hipMemsetAsync((char*)d_ws + WS_CTL, 0, 65536, stream) != hipSuccess) { fprintf(stderr, "kernel_launch: memset of control words failed\n"); return; }
    Params prm{};
    for (int i = 0; i < 17; ++i) prm.in[i] = (const float*)d_in[i];
    prm.out = (float*)d_out; prm.ws = (unsigned char*)d_ws;
    void* args[] = {&prm};
    hipError_t e = hipLaunchCooperativeKernel((void*)mega_fwd, dim3(grid_blocks), dim3(512), args, LDS_BYTES, stream);
    if (e != hipSuccess) fprintf(stderr, "cooperative launch failed: %s (grid %d)\n", hipGetErrorString(e), grid_blocks);
}
```

```cpp
#include <hip/hip_runtime.h>
#include <hip/hip_cooperative_groups.h>
#include <cstdio>
#include <cstdint>
namespace cg = cooperative_groups;
namespace pg8 {
#define PG8_LAS __attribute__((address_space(3)))
typedef unsigned short bf16_t;
typedef short bf16x8 __attribute__((ext_vector_type(8)));
typedef float f32x4 __attribute__((ext_vector_type(4)));
typedef unsigned u32x4 __attribute__((ext_vector_type(4)));
constexpr int BM = 256, BK = 64, HALF = 128, HTB = HALF * BK * 2  , STAGE_BYTES = 8 * HTB, NXCD = 8, WGM = 8;

__host__ __device__ __forceinline__ int lds_byte(int r, int c) { const int st = (r >> 4) * 2 + (c >> 5), rr = r & 15, cc = c & 31, ob = rr * 64 + cc * 2; return st * 1024 + (ob ^ (((ob >> 9) & 1) << 5)); }
__host__ __device__ __forceinline__ void stage_rc(int b, int& R, int& C) { const int st = b / 1024, sb = b % 1024, swz = sb ^ (((sb >> 9) & 1) << 5); R = (st >> 1) * 16 + swz / 64; C = (st & 1) * 32 + (swz % 64) / 2; }
__host__ __device__ __forceinline__ int perm32(int rho) { const int n = rho >> 4, i = rho & 15; return 8 * (i >> 2) + 4 * n + (i & 3); }

struct Unit { int pm, pn, e; };
struct Gemm { const bf16_t* A; const bf16_t* Bt; int M, N, K; };

struct StaticOrder {
    int nM, nN, nwg, G, c;
    __host__ __device__ void init(int M, int N, int G_, int c_) { nM = M / BM; nN = N / BM; nwg = nM * nN; G = G_; c = c_; }
    __host__ __device__ bool next(int i, Unit& u) const {
        const long L = (long)i * G + c; if (L >= nwg) return false;
        int wgid = (int)L; { const int q = nwg / NXCD, r = nwg % NXCD, xcd = wgid % NXCD, off = wgid / NXCD; wgid = (xcd < r ? xcd * (q + 1) : r * (q + 1) + (xcd - r) * q) + off; }
        const int nig = WGM * nN, gid = wgid / nig, fm = gid * WGM, gsz = (nM - fm) < WGM ? (nM - fm) : WGM;
        u.pm = fm + ((wgid % nig) % gsz); u.pn = (wgid % nig) / gsz; u.e = 0; return true;
    }
    __device__ __forceinline__ void a_ready(const Unit&) const {}
    __device__ __forceinline__ void done(const Unit&) const {}
};

template <class Epi, class Sched, bool ALIGN_EPI = false, bool SP2 = false>
__device__ __forceinline__ void gemm_phase(PG8_LAS unsigned char* lds, const Gemm g, const Sched& S, const Epi& E, const int tid) {
    const int wid = __builtin_amdgcn_readfirstlane(tid >> 6), lane = tid & 63, wr = wid >> 2, wc = wid & 3, fr = lane & 15, fq = lane >> 4;
    const int K = g.K, nt = K / BK;
    unsigned voffA[2], voffB[2];
#pragma unroll
    for (int i = 0; i < 2; ++i) { int R, C; stage_rc(tid * 16 + i * 8192, R, C); const int Rb = Epi::PERM ? ((R & ~31) + perm32(R & 31)) : R;
        voffA[i] = (unsigned)(R * K + C) * 2u; voffB[i] = (unsigned)(Rb * K + C) * 2u; }
    const size_t kstep = (size_t)(BK * 2);
    const size_t hstep = (size_t)HALF * K * 2;
    const size_t tstep = 2 * hstep;
    const unsigned ldsw = (unsigned)wid * 1024u;
    const int aoff = lds_byte(wr * 64 + fr, fq * 8), boff = lds_byte(wc * 32 + fr, fq * 8);
#define PG8_SA(b, h) (((b) * 2 + (h)) * HTB)
#define PG8_SB(b, h) ((4 + (b) * 2 + (h)) * HTB)
#define PG8_STAGE(bufoff, gbase, voff) do { _Pragma("unroll") for (int _i = 0; _i < 2; ++_i) \
        __builtin_amdgcn_global_load_lds((const unsigned*)((const char*)(gbase) + (voff)[_i]), (PG8_LAS unsigned*)(lds + (bufoff) + ldsw + _i * 8192), 16, 0, 0); } while (0)
#define PG8_LDA(dst, b, h) do { _Pragma("unroll") for (int m = 0; m < 4; ++m) _Pragma("unroll") for (int k = 0; k < 2; ++k) dst[m][k] = *(const PG8_LAS bf16x8*)(lds + PG8_SA(b, h) + aoff + m * 2048 + k * 1024); } while (0)
#define PG8_LDB(dst, b, h) do { _Pragma("unroll") for (int n = 0; n < 2; ++n) _Pragma("unroll") for (int k = 0; k < 2; ++k) dst[n][k] = *(const PG8_LAS bf16x8*)(lds + PG8_SB(b, h) + boff + n * 2048 + k * 1024); } while (0)
#define PG8_MMA(ai, bj, At, Bt) do { __builtin_amdgcn_s_setprio(1); _Pragma("unroll") for (int m = 0; m < 4; ++m) _Pragma("unroll") for (int n = 0; n < 2; ++n) _Pragma("unroll") for (int k = 0; k < 2; ++k) \
        acc[ai][bj][m][n] = __builtin_amdgcn_mfma_f32_16x16x32_bf16(Bt[n][k], At[m][k], acc[ai][bj][m][n], 0, 0, 0); __builtin_amdgcn_s_setprio(0); } while (0)
#define PG8_WAIT_V(n) asm volatile("s_waitcnt vmcnt(" #n ")" ::: "memory")
#define PG8_WAIT_L(n) asm volatile("s_waitcnt lgkmcnt(" #n ")" ::: "memory")
#define PG8_BAR __builtin_amdgcn_s_barrier()
#define PG8_SCHED __builtin_amdgcn_sched_barrier(0)
    Unit cur, nxt; int ui = 0;
    if (!S.next(0, cur)) return;
    f32x4 acc[2][2][4][2];
#pragma unroll
    for (int a = 0; a < 2; ++a)
#pragma unroll
        for (int b = 0; b < 2; ++b)
#pragma unroll
            for (int m = 0; m < 4; ++m)
#pragma unroll
                for (int n = 0; n < 2; ++n) acc[a][b][m][n] = (f32x4){0.f, 0.f, 0.f, 0.f};
    bf16x8 At[4][2], B0[2][2], B1[2][2];
    const size_t estep = (size_t)g.N * K * 2;
    const char* cA = (const char*)g.A + (size_t)cur.pm * tstep; const char* cB = (const char*)g.Bt + (size_t)cur.e * estep + (size_t)cur.pn * tstep;
    S.a_ready(cur);
    if constexpr (SP2) {
        PG8_STAGE(PG8_SB(0, 0), cB, voffB); PG8_STAGE(PG8_SB(0, 1), cB + hstep, voffB); PG8_STAGE(PG8_SA(0, 0), cA, voffA); PG8_STAGE(PG8_SA(0, 1), cA + hstep, voffA);
        if (wr == 1) PG8_BAR;
        PG8_WAIT_V(2); PG8_BAR;
        PG8_STAGE(PG8_SB(1, 0), cB + kstep, voffB); PG8_STAGE(PG8_SA(1, 0), cA + kstep, voffA); PG8_STAGE(PG8_SB(1, 1), cB + hstep + kstep, voffB);
        PG8_WAIT_V(6); PG8_BAR;
    } else {
        PG8_STAGE(PG8_SB(0, 0), cB, voffB); PG8_STAGE(PG8_SA(0, 0), cA, voffA); PG8_STAGE(PG8_SB(0, 1), cB + hstep, voffB); PG8_STAGE(PG8_SA(0, 1), cA + hstep, voffA);
        if (wr == 1) PG8_BAR;
        PG8_WAIT_V(4); PG8_BAR;
        PG8_STAGE(PG8_SB(1, 0), cB + kstep, voffB); PG8_STAGE(PG8_SA(1, 0), cA + kstep, voffA); PG8_STAGE(PG8_SB(1, 1), cB + hstep + kstep, voffB);
        PG8_WAIT_V(6); PG8_BAR;
    }
    for (;;) {
        const bool has_next = S.next(ui + 1, nxt);
        const char* nA = has_next ? (const char*)g.A + (size_t)nxt.pm * tstep : cA; const char* nB = has_next ? (const char*)g.Bt + (size_t)nxt.e * estep + (size_t)nxt.pn * tstep : cB;
        for (int t = 0; t < nt; t += 2) {
            const bool last = (t == nt - 2);
            const char* a1 = cA + (size_t)(t + 1) * kstep;
            const char* a2 = last ? nA : cA + (size_t)(t + 2) * kstep; const char* b2 = last ? nB : cB + (size_t)(t + 2) * kstep;
            const char* a3 = a2 + kstep; const char* b3 = b2 + kstep;
            if (last && has_next) S.a_ready(nxt);
            if constexpr (Epi::HAS_MID) { if (t == nt / 2) E.mid(acc, cur, wr, wc, fr, fq); }
            if constexpr (SP2) {
            PG8_LDB(B0, 0, 0); PG8_LDB(B1, 0, 1); PG8_SCHED; PG8_LDA(At, 0, 0); PG8_STAGE(PG8_SA(1, 1), a1 + hstep, voffA);
            PG8_WAIT_V(8); PG8_WAIT_L(0); PG8_BAR; PG8_MMA(0, 0, At, B0); PG8_MMA(0, 1, At, B1); PG8_BAR; PG8_SCHED;
            PG8_LDA(At, 0, 1); PG8_STAGE(PG8_SB(0, 0), b2, voffB); PG8_STAGE(PG8_SB(0, 1), b2 + hstep, voffB); PG8_STAGE(PG8_SA(0, 0), a2, voffA);
            PG8_WAIT_V(8); PG8_WAIT_L(0); PG8_BAR; PG8_MMA(1, 0, At, B0); PG8_MMA(1, 1, At, B1); PG8_BAR; PG8_SCHED;
            PG8_LDB(B0, 1, 0); PG8_LDB(B1, 1, 1); PG8_SCHED; PG8_LDA(At, 1, 0); PG8_STAGE(PG8_SA(0, 1), a2 + hstep, voffA);
            PG8_WAIT_V(8); PG8_WAIT_L(0); PG8_BAR; PG8_MMA(0, 0, At, B0); PG8_MMA(0, 1, At, B1); PG8_BAR; PG8_SCHED;
            PG8_LDA(At, 1, 1); PG8_STAGE(PG8_SB(1, 0), b3, voffB); PG8_STAGE(PG8_SB(1, 1), b3 + hstep, voffB); PG8_STAGE(PG8_SA(1, 0), a3, voffA);
            PG8_WAIT_V(8); PG8_WAIT_L(0); PG8_BAR; PG8_MMA(1, 0, At, B0); PG8_MMA(1, 1, At, B1); PG8_BAR; PG8_SCHED;
            } else {
            PG8_LDB(B0, 0, 0); PG8_SCHED; PG8_LDA(At, 0, 0); PG8_STAGE(PG8_SA(1, 1), a1 + hstep, voffA);
            PG8_WAIT_L(8); PG8_BAR; PG8_WAIT_L(0); PG8_MMA(0, 0, At, B0); PG8_BAR; PG8_SCHED;
            PG8_LDB(B1, 0, 1); PG8_STAGE(PG8_SB(0, 0), b2, voffB);
            PG8_BAR; PG8_WAIT_L(0); PG8_MMA(0, 1, At, B1); PG8_BAR;
            PG8_LDA(At, 0, 1); PG8_STAGE(PG8_SA(0, 0), a2, voffA);
            PG8_BAR; PG8_WAIT_L(0); PG8_MMA(1, 0, At, B0); PG8_BAR; PG8_SCHED;
            PG8_STAGE(PG8_SB(0, 1), b2 + hstep, voffB);
            PG8_WAIT_V(6); PG8_BAR; PG8_MMA(1, 1, At, B1); PG8_BAR;
            PG8_LDB(B0, 1, 0); PG8_SCHED; PG8_LDA(At, 1, 0); PG8_STAGE(PG8_SA(0, 1), a2 + hstep, voffA);
            PG8_WAIT_L(8); PG8_BAR; PG8_WAIT_L(0); PG8_MMA(0, 0, At, B0); PG8_BAR; PG8_SCHED;
            PG8_LDB(B1, 1, 1); PG8_STAGE(PG8_SB(1, 0), b3, voffB);
            PG8_BAR; PG8_WAIT_L(0); PG8_MMA(0, 1, At, B1); PG8_BAR;
            PG8_LDA(At, 1, 1); PG8_STAGE(PG8_SA(1, 0), a3, voffA);
            PG8_BAR; PG8_WAIT_L(0); PG8_MMA(1, 0, At, B0); PG8_BAR; PG8_SCHED;
            PG8_STAGE(PG8_SB(1, 1), b3 + hstep, voffB);
            PG8_WAIT_V(6); PG8_BAR; PG8_MMA(1, 1, At, B1); PG8_BAR;
            }
        }
        if constexpr (ALIGN_EPI) { if (wr == 0) PG8_BAR; }
        if constexpr (!Epi::AFTER_DRAIN) { E(acc, cur, wr, wc, fr, fq); S.done(cur); }
        if (!has_next) break;
#pragma unroll
        for (int a = 0; a < 2; ++a)
#pragma unroll
            for (int b = 0; b < 2; ++b)
#pragma unroll
                for (int m = 0; m < 4; ++m)
#pragma unroll
                    for (int n = 0; n < 2; ++n) acc[a][b][m][n] = (f32x4){0.f, 0.f, 0.f, 0.f};
        cur = nxt; cA = nA; cB = nB; ++ui;
        if constexpr (ALIGN_EPI) { if (wr == 1) PG8_BAR; }
    }
    PG8_WAIT_V(0);
    if constexpr (!ALIGN_EPI) { if (wr == 0) PG8_BAR; }
    PG8_BAR;
    if constexpr (Epi::AFTER_DRAIN) { E.fused(acc, cur, wr, wc, fr, fq, lds, wid, lane); S.done(cur); }
#undef PG8_SA
#undef PG8_SB
#undef PG8_STAGE
#undef PG8_LDA
#undef PG8_LDB
#undef PG8_MMA
#undef PG8_WAIT_V
#undef PG8_WAIT_L
#undef PG8_BAR
#undef PG8_SCHED
}
}

#ifndef DBG_CMP
#define DBG_CMP 0
#endif
#define LAS __attribute__((address_space(3)))
typedef unsigned short bf16_t;
typedef float f32x4 __attribute__((ext_vector_type(4)));
typedef unsigned u32x4 __attribute__((ext_vector_type(4)));
typedef unsigned u32x2 __attribute__((ext_vector_type(2)));
typedef unsigned long long u64;

constexpr int T_TOK = 16384, DMODEL = 2048, SEQL = 2048;
constexpr int NPROJ = 9984;
constexpr int C_QLAT = 0, C_CKV = 1024, C_QIDX = 1152, C_KIDX = 1664, C_WIDX = 1728, C_QR = 1792, C_KR = 2816, C_VR = 3840, C_GR = 4864, C_GBR = 5888;
constexpr int MAXSLOT = 40960;
constexpr float EPS_F = 1e-6f;
constexpr float IDX_SCALE = 0.04419417382415922f;
constexpr float ATT_SCALE = 0.08838834764831845f;
constexpr float K_SCALE = 0.08838834764831845f;

constexpr size_t WS_CTL = 0;
constexpr size_t WS_ROT = 65536;
constexpr size_t WS_WIN = WS_ROT + 1048576;
constexpr size_t WS_WCOMB = WS_WIN + (size_t)NPROJ * 2048 * 2;
constexpr size_t WS_WB = WS_WCOMB + (size_t)2048 * 1024 * 2;
constexpr size_t WS_WO = WS_WB + (size_t)2048 * 1024 * 2;
constexpr size_t WS_WGU = WS_WO + (size_t)2048 * 2048 * 2;
constexpr size_t WS_WD = WS_WGU + (size_t)32 * 2048 * 2048 * 2;
constexpr size_t WS_P = WS_WD + (size_t)32 * 2048 * 1024 * 2;
constexpr size_t WS_HMID = WS_P;
constexpr size_t WS_Y = WS_HMID + (size_t)MAXSLOT * 1024 * 2;
constexpr size_t WS_XN = WS_P + (size_t)T_TOK * NPROJ * 2;
constexpr size_t WS_OA = WS_XN + (size_t)T_TOK * 2048 * 2;
constexpr size_t WS_OB = WS_OA + (size_t)T_TOK * 1024 * 2;
constexpr size_t WS_MIXED = WS_OB + (size_t)T_TOK * 1024 * 2;
constexpr size_t WS_SPARE = WS_MIXED + (size_t)T_TOK * 2048 * 2;
constexpr size_t WS_XG = WS_OA;
constexpr size_t WS_KV = WS_SPARE + (size_t)T_TOK * 1024 * 2;
constexpr size_t WS_MASK = WS_KV + (size_t)T_TOK * 128 * 2;
constexpr size_t WS_MISC = WS_MASK + (size_t)T_TOK * 256;
constexpr size_t WS_WC = WS_MISC + 1048576;
constexpr size_t WS_END = WS_WC + 1048576;
static_assert(WS_Y + (size_t)MAXSLOT * 2048 * 2 <= WS_XN, "HMID + Y must fit in P");
static_assert(WS_XG + (size_t)MAXSLOT * 2048 * 2 <= WS_KV, "XG must fit in OA..SPARE");
static_assert(WS_END <= (size_t)1073741824, "workspace budget");
constexpr int MI_ROWTOK = 0, MI_ROWGATE = MAXSLOT, MI_TOKSLOT = 2 * MAXSLOT, MI_ASGE = MI_TOKSLOT + 2 * T_TOK, MI_ASGR = MI_ASGE + 2 * T_TOK, MI_ASGG = MI_ASGR + 2 * T_TOK;
static_assert((size_t)(MI_ASGG + 2 * T_TOK) * 4 <= 1048576, "misc budget");
constexpr int LDS_BYTES = 152 * 1024;
constexpr int LDS_MISC = 150 * 1024;

__device__ __forceinline__ float bflo(unsigned w) { return __uint_as_float(w << 16); }
__device__ __forceinline__ float bfhi(unsigned w) { return __uint_as_float(w & 0xffff0000u); }
__device__ __forceinline__ unsigned pkbf(float lo, float hi) { unsigned r; asm volatile("v_cvt_pk_bf16_f32 %0, %1, %2" : "=v"(r) : "v"(lo), "v"(hi)); return r; }
__device__ __forceinline__ int hide_i(int v) { asm volatile("" : "+v"(v)); return v; }
template <class Tp> __device__ __forceinline__ Tp* hide_p(Tp* q) { asm volatile("" : "+s"(q)); return q; }
__device__ __forceinline__ float shx(float v, int lane, int o) { return __int_as_float(__builtin_amdgcn_ds_bpermute((lane ^ o) << 2, __float_as_int(v))); }
__device__ __forceinline__ float wave_sum(float v, int lane) {
#pragma unroll
    for (int o = 1; o < 64; o <<= 1) v += shx(v, lane, o);
    return v;
}
__device__ __forceinline__ float wave_max(float v, int lane) {
#pragma unroll
    for (int o = 1; o < 64; o <<= 1) v = fmaxf(v, shx(v, lane, o));
    return v;
}
__device__ __forceinline__ float sigmoidf_(float x) { return __builtin_amdgcn_rcpf(1.0f + __expf(-x)); }
__device__ __forceinline__ float siluf_(float x) { return x * sigmoidf_(x); }
__device__ __forceinline__ float unkey(unsigned k) { return __uint_as_float((k & 0x80000000u) ? (k & 0x7fffffffu) : ~k); }
__device__ __forceinline__ int sbin(float s) { const int b = (int)(s * 32.0f + 128.0f); return b < 0 ? 0 : (b > 255 ? 255 : b); }
__device__ __forceinline__ unsigned fkey(float f) { const unsigned u = __float_as_uint(f + 0.0f); return (u & 0x80000000u) ? ~u : (u | 0x80000000u); }


#define XB_TMO      128
#define XB_XCNT(j)  (256  + 64 * (j))
#define XB_XSUB(j)  (1280 + 64 * (j))
#define XB_XGEN(j)  (2304 + 64 * (j))
#define XB_TOP      3328
#define XB_TOPGEN   3392
#define XCD_BAR_WORDS 3456
#define XB_SPIN_CAP (1u << 18)
__device__ __forceinline__ unsigned xb_ld(unsigned* p)              { return __hip_atomic_load(p, __ATOMIC_RELAXED, __HIP_MEMORY_SCOPE_AGENT); }
__device__ __forceinline__ unsigned xb_add(unsigned* p, unsigned v) { return __hip_atomic_fetch_add(p, v, __ATOMIC_RELAXED, __HIP_MEMORY_SCOPE_AGENT); }
__device__ __forceinline__ unsigned xb_xcc_id() { return (unsigned)__builtin_amdgcn_s_getreg((3 << 11) | 20) & 0xFu; }
#define XB_SPIN(cond, bar) do { unsigned _sp = 0; while (cond) { __builtin_amdgcn_s_sleep(1); \
    if ((++_sp & 255u) == 0u) { if (xb_ld(&(bar)[XB_TMO])) break; if (_sp > XB_SPIN_CAP) { atomicAdd(&(bar)[XB_TMO], 1u); break; } } } } while (0)
struct XcdBarrier { unsigned* bar; unsigned x; volatile __attribute__((address_space(3))) unsigned* st; };
__device__ __forceinline__ void xcd_barrier_complete(unsigned* bar, unsigned x, unsigned& nloc, unsigned& nx) {
    const unsigned G = gridDim.x * gridDim.y * gridDim.z;
    unsigned sum, cnt, mine, sp = 0u;
    for (;;) {
        sum = 0u; cnt = 0u; mine = 0u;
#pragma unroll
        for (unsigned j = 0; j < 16; ++j) { const unsigned c = xb_ld(&bar[XB_XCNT(j)]); sum += c; cnt += (c > 0u) ? 1u : 0u; mine = (j == x) ? c : mine; }
        if (sum == G) break;
        __builtin_amdgcn_s_sleep(1);
        if ((++sp & 255u) == 0u) { if (xb_ld(&bar[XB_TMO])) break; if (sp > XB_SPIN_CAP) { atomicAdd(&bar[XB_TMO], 1u); break; } }
    }
    nloc = mine > 0u ? mine : 1u; nx = cnt > 0u ? cnt : 1u;
}
__device__ __forceinline__ void xcd_barrier(const XcdBarrier& b, int tid) {
    asm volatile("s_waitcnt vmcnt(0)" ::: "memory");
    __syncthreads();
    if (tid == 0) {
        unsigned* bar = b.bar;
        __builtin_amdgcn_s_waitcnt(0);
        unsigned nloc = b.st[0], nx = b.st[1];
        if (nloc == 0u) { xcd_barrier_complete(bar, b.x, nloc, nx); b.st[0] = nloc; b.st[1] = nx; }
        const unsigned old = xb_add(&bar[XB_XSUB(b.x)], 1u);
        const unsigned gen = old / nloc;
        if (old + 1u == (gen + 1u) * nloc) {
            __builtin_amdgcn_fence(__ATOMIC_RELEASE, "agent");
            asm volatile("s_waitcnt vmcnt(0)" ::: "memory");
            const unsigned og = xb_add(&bar[XB_TOP], 1u);
            const unsigned tg = og / nx;
            if (og + 1u == (tg + 1u) * nx) xb_add(&bar[XB_TOPGEN], 1u);
            else XB_SPIN(xb_ld(&bar[XB_TOPGEN]) == tg, bar);
            __builtin_amdgcn_fence(__ATOMIC_ACQUIRE, "agent");
            xb_add(&bar[XB_XGEN(b.x)], 1u);
            asm volatile("s_waitcnt vmcnt(0)" ::: "memory");
        } else {
            XB_SPIN(xb_ld(&bar[XB_XGEN(b.x)]) == gen, bar);
            __builtin_amdgcn_fence(__ATOMIC_ACQUIRE, "agent");
            asm volatile("s_waitcnt vmcnt(0)" ::: "memory");
        }
    }
    __syncthreads();
}

namespace fa {
using bf16x8 = __attribute__((ext_vector_type(8))) short;
using s16x4  = __attribute__((ext_vector_type(4))) short;
using f32x16 = __attribute__((ext_vector_type(16))) float;
constexpr int TILE_B = 64 * 128 * 2;
constexpr int OFF_V = 0, OFF_K = 2 * TILE_B, OFF_M = 4 * TILE_B, OFF_WS = OFF_M + 2 * 256, OFF_Q = OFF_WS + 8 * 256, LDS_NEED = OFF_Q + 8 * 8192;
#define FA_GAS __attribute__((address_space(1)))
#define FA_KSWZ(row, colB) ((row) * 256 + ((colB) ^ (((row) & 7) << 4)))
#define FA_SBAR() __builtin_amdgcn_sched_barrier(0)
__device__ __forceinline__ int crow(int r, int hi) { return (r & 3) + 8 * (r >> 2) + 4 * hi; }
__device__ __forceinline__ int v_st(int k, int c) { const int kk = (k & ~0xC) | ((k & 4) << 1) | ((k & 8) >> 1); return ((kk >> 3) * 4 + (c >> 5)) * 512 + ((kk & 7) * 32 + (c & 31)) * 2; }
__device__ __forceinline__ int v_rd_base(int lane) { return ((lane & 3) << 3) | (((lane >> 2) & 3) << 6) | (((lane >> 4) & 1) << 5) | (((lane >> 5) & 1) << 8); }
constexpr int v_rd_off(int d0, int ks, int half) { return d0 * 512 + ks * 4096 + half * 2048; }
template <int OFF> __device__ __forceinline__ s16x4 tr_read(int vb) { s16x4 r; asm volatile("ds_read_b64_tr_b16 %0, %1 offset:%2" : "=&v"(r) : "v"(vb), "i"(OFF) : "memory"); return r; }
template <int D0> __device__ __forceinline__ void pv_one(f32x16& od, int vb, bf16x8 pa0, bf16x8 pa1, bf16x8 pa2, bf16x8 pa3) {
    const s16x4 l0 = tr_read<v_rd_off(D0, 0, 0)>(vb), h0 = tr_read<v_rd_off(D0, 0, 1)>(vb), l1 = tr_read<v_rd_off(D0, 1, 0)>(vb), h1 = tr_read<v_rd_off(D0, 1, 1)>(vb);
    const s16x4 l2 = tr_read<v_rd_off(D0, 2, 0)>(vb), h2 = tr_read<v_rd_off(D0, 2, 1)>(vb), l3 = tr_read<v_rd_off(D0, 3, 0)>(vb), h3 = tr_read<v_rd_off(D0, 3, 1)>(vb);
    asm volatile("s_waitcnt lgkmcnt(0)" ::: "memory"); FA_SBAR();
#define FA_PK(L, H) (bf16x8){L[0], L[1], L[2], L[3], H[0], H[1], H[2], H[3]}
    od = __builtin_amdgcn_mfma_f32_32x32x16_bf16(pa0, FA_PK(l0, h0), od, 0, 0, 0);
    od = __builtin_amdgcn_mfma_f32_32x32x16_bf16(pa1, FA_PK(l1, h1), od, 0, 0, 0);
    od = __builtin_amdgcn_mfma_f32_32x32x16_bf16(pa2, FA_PK(l2, h2), od, 0, 0, 0);
    od = __builtin_amdgcn_mfma_f32_32x32x16_bf16(pa3, FA_PK(l3, h3), od, 0, 0, 0);
#undef FA_PK
}
template <bool QLDS>
__device__ __forceinline__ void qkt(f32x16& p0, f32x16& p1, const LAS char* Ks, const bf16x8 (&qr)[8], const LAS char* Ql, int r32, int hi) {
    p0 = f32x16{}; p1 = f32x16{};
#pragma unroll
    for (int d0 = 0; d0 < 8; ++d0) { const int cb = (d0 * 16 + hi * 8) * 2;
        const bf16x8 b0 = *(const LAS bf16x8*)(Ks + FA_KSWZ(r32, cb));
        const bf16x8 b1 = *(const LAS bf16x8*)(Ks + FA_KSWZ(32 + r32, cb));
        const bf16x8 q = QLDS ? *(const LAS bf16x8*)(Ql + d0 * 1024) : qr[d0];
        p0 = __builtin_amdgcn_mfma_f32_32x32x16_bf16(b0, q, p0, 0, 0, 0);
        p1 = __builtin_amdgcn_mfma_f32_32x32x16_bf16(b1, q, p1, 0, 0, 0); }
}
__device__ __forceinline__ void p_to_frag(const f32x16& p0, const f32x16& p1, bf16x8& pa0, bf16x8& pa1, bf16x8& pa2, bf16x8& pa3) {
#define FA_PK4(P, BASE, OUT) do { unsigned a0 = pkbf(P[BASE + 0], P[BASE + 1]), a1 = pkbf(P[BASE + 2], P[BASE + 3]);   \
    unsigned b0 = pkbf(P[BASE + 4], P[BASE + 5]), b1 = pkbf(P[BASE + 6], P[BASE + 7]);                              \
    auto r0 = __builtin_amdgcn_permlane32_swap(a0, b0, false, false); auto r1 = __builtin_amdgcn_permlane32_swap(a1, b1, false, false); \
    u32x4 w = {r0[0], r1[0], r0[1], r1[1]}; OUT = *reinterpret_cast<bf16x8*>(&w); } while (0)
    FA_PK4(p0, 0, pa0); FA_PK4(p0, 8, pa1); FA_PK4(p1, 0, pa2); FA_PK4(p1, 8, pa3);
#undef FA_PK4
}

struct UnitArgs {
    const bf16_t* Q; int ldq;
    const bf16_t* K; const bf16_t* V; int ldk;
    const u64* mask;
    int ntiles;
    int n0;
    float lgam;
};

template <int MODE>
__device__ __forceinline__ void unit_body(LAS char* L, const UnitArgs& U, int tid, f32x16 (&o)[4], float& l_out) {
    const int wid = __builtin_amdgcn_readfirstlane(tid >> 6), lane = tid & 63, r32 = lane & 31, hi = lane >> 5;
    LAS char* V_lds = L + OFF_V; LAS char* K_lds = L + OFF_K; LAS u64* M_lds = (LAS u64*)(L + OFF_M);
    LAS float* wsf = (LAS float*)(L + OFF_WS) + wid * 64; LAS float* al_l = wsf + 32;
    constexpr float C = ATT_SCALE * 1.4426950408889634f;
    float m_reg = -1e30f, l_reg = 0.f;
    bf16x8 qr[8];
    LAS char* Ql = L + OFF_Q + wid * 8192 + lane * 16;
    { const FA_GAS bf16_t* Qh = (const FA_GAS bf16_t*)hide_p(U.Q); const FA_GAS bf16_t* Qw = (MODE == 0) ? Qh + (size_t)r32 * U.ldq + wid * 128 + hi * 8 : Qh + (size_t)(wid * 32 + r32) * U.ldq + hi * 8;
#pragma unroll
      for (int d0 = 0; d0 < 8; ++d0) { qr[d0] = *(const FA_GAS bf16x8*)(Qw + d0 * 16); if (MODE == 1) *(LAS bf16x8*)(Ql + d0 * 1024) = qr[d0]; } }
    if (MODE == 1) { asm volatile("s_waitcnt vmcnt(0) lgkmcnt(0)" ::: "memory"); FA_SBAR(); }
    const int sr = tid >> 4, sc = (tid & 15) * 8, vst0 = v_st(sr, sc), vst1 = v_st(32 + sr, sc), kst0 = FA_KSWZ(sr, sc * 2), kst1 = FA_KSWZ(32 + sr, sc * 2);
    const FA_GAS char* Kh = (const FA_GAS char*)hide_p(U.K); const FA_GAS char* Vh = (const FA_GAS char*)hide_p(U.V);
    const unsigned goff0 = (unsigned)(sr * U.ldk + sc) * 2u, goff1 = (unsigned)((32 + sr) * U.ldk + sc) * 2u;
    const int vb0 = (int)(unsigned)(size_t)V_lds + v_rd_base(lane);
    bf16x8 ksA0, ksA1, vsA0, vsA1; u64 mwA = 0ull; unsigned pf_ = 0u;
#define FA_SLOAD(S, k0) do { const FA_GAS char* kb_ = Kh + (size_t)(k0) * U.ldk * 2; const FA_GAS char* vb_ = Vh + (size_t)(k0) * U.ldk * 2;     \
        ks##S##0 = *(const FA_GAS bf16x8*)(kb_ + goff0); ks##S##1 = *(const FA_GAS bf16x8*)(kb_ + goff1); \
        if (MODE == 1) { vs##S##0 = *(const FA_GAS bf16x8*)(vb_ + goff0); vs##S##1 = *(const FA_GAS bf16x8*)(vb_ + goff1); } \
        if (MODE == 0 && tid < 32) mw##S = U.mask[(size_t)tid * 32 + ((k0) >> 6)]; } while (0)
#define FA_SWRITE(S, b) do { *(LAS bf16x8*)(K_lds + (b) * TILE_B + kst0) = ks##S##0; *(LAS bf16x8*)(K_lds + (b) * TILE_B + kst1) = ks##S##1; \
        *(LAS bf16x8*)(V_lds + (b) * TILE_B + vst0) = (MODE == 1) ? vs##S##0 : ks##S##0; *(LAS bf16x8*)(V_lds + (b) * TILE_B + vst1) = (MODE == 1) ? vs##S##1 : ks##S##1; \
        if (MODE == 0 && tid < 32) M_lds[(b) * 32 + tid] = mw##S; } while (0)
#define FA_TOUCH(k0) do { if (MODE == 1 && tid < 256) { const FA_GAS char* tb_ = ((tid < 128) ? Kh : Vh) + (size_t)((k0) + ((tid & 127) >> 1)) * U.ldk * 2 + (tid & 1) * 128; \
        asm volatile("global_load_dword %0, %1, off" : "=v"(pf_) : "v"(tb_) : "memory"); } } while (0)
#define FA_TILE(j, b) do { \
        f32x16 p0, p1; bf16x8 pa0, pa1, pa2, pa3; \
        { const LAS char* qb_ = Ql; asm volatile("" : "+v"(qb_)); qkt<MODE == 1>(p0, p1, K_lds + (b) * TILE_B, qr, qb_, r32, hi); } \
        if (MODE == 0) { \
            const u64 mw = M_lds[(b) * 32 + r32] >> (4 * hi); \
            const unsigned mlo = (unsigned)mw, mhi = (unsigned)(mw >> 32); \
            _Pragma("unroll") for (int r = 0; r < 16; ++r) { const unsigned bit = 1u << ((r & 3) + 8 * (r >> 2)); p0[r] = (mlo & bit) ? p0[r] : -INFINITY; p1[r] = (mhi & bit) ? p1[r] : -INFINITY; } \
            float pmax = p0[0]; \
            _Pragma("unroll") for (int r = 1; r < 16; ++r) pmax = fmaxf(pmax, p0[r]); \
            _Pragma("unroll") for (int r = 0; r < 16; ++r) pmax = fmaxf(pmax, p1[r]); \
            { auto rr = __builtin_amdgcn_permlane32_swap(__float_as_uint(pmax), __float_as_uint(pmax), false, false); pmax = fmaxf(__uint_as_float(rr[0]), __uint_as_float(rr[1])); } \
            const float mn = fmaxf(m_reg, pmax); const float alpha = __builtin_amdgcn_exp2f((m_reg - mn) * C); m_reg = mn; \
            const float mnC = -mn * C; float ps = 0.f; \
            _Pragma("unroll") for (int r = 0; r < 16; ++r) { p0[r] = __builtin_amdgcn_exp2f(fmaf(p0[r], C, mnC)); p1[r] = __builtin_amdgcn_exp2f(fmaf(p1[r], C, mnC)); ps += p0[r] + p1[r]; } \
            { auto rr = __builtin_amdgcn_permlane32_swap(__float_as_uint(ps), __float_as_uint(ps), false, false); ps = __uint_as_float(rr[0]) + __uint_as_float(rr[1]); } \
            l_reg = l_reg * alpha + ps; \
            if (__any(alpha < 1.f)) { \
                if (hi == 0) al_l[r32] = alpha; \
                asm volatile("s_waitcnt lgkmcnt(0)" ::: "memory"); \
                _Pragma("unroll") for (int r = 0; r < 16; ++r) { const float a_ = al_l[crow(r, hi)]; \
                    _Pragma("unroll") for (int d = 0; d < 4; ++d) o[d][r] *= a_; } \
            } \
        } else { \
            const int dn = U.n0 + wid * 32 + r32 - (j) * 64 - 4 * hi; \
            const float base = (float)dn * U.lgam; \
            _Pragma("unroll") for (int r = 0; r < 16; ++r) { const int kk = (r & 3) + 8 * (r >> 2); \
                const float f0 = __builtin_amdgcn_exp2f(base - (float)kk * U.lgam), f1 = __builtin_amdgcn_exp2f(base - (float)(kk + 32) * U.lgam); \
                p0[r] = (dn >= kk) ? p0[r] * f0 : 0.f; p1[r] = (dn >= kk + 32) ? p1[r] * f1 : 0.f; } \
        } \
        p_to_frag(p0, p1, pa0, pa1, pa2, pa3); \
        FA_SBAR(); \
        { const int vb = vb0 + (b) * TILE_B; \
          pv_one<0>(o[0], vb, pa0, pa1, pa2, pa3); pv_one<1>(o[1], vb, pa0, pa1, pa2, pa3); pv_one<2>(o[2], vb, pa0, pa1, pa2, pa3); pv_one<3>(o[3], vb, pa0, pa1, pa2, pa3); } \
    } while (0)
    const int NT = U.ntiles;
    FA_SLOAD(A, 0); FA_SWRITE(A, 0);
    if (NT > 1) { FA_SLOAD(A, 64); FA_SWRITE(A, 1); }
    if (NT > 2) FA_TOUCH(128);
    if (NT > 3) FA_TOUCH(192);
    __syncthreads();
#pragma unroll
    for (int d = 0; d < 4; ++d) o[d] = f32x16{};
#pragma unroll 1
    for (int j = 0; j < NT; ++j) {
        const int b = j & 1;
        if (j + 2 < NT) FA_SLOAD(A, (j + 2) * 64);
        if (j + 4 < NT) FA_TOUCH((j + 4) * 64);
        FA_TILE(j, b);
        __syncthreads();
        if (j + 2 < NT) FA_SWRITE(A, b);
        asm volatile("" :: "v"(pf_));
    }
    asm volatile("s_waitcnt vmcnt(0)" ::: "memory");
    __syncthreads();
    l_out = l_reg;
#undef FA_SLOAD
#undef FA_SWRITE
#undef FA_TILE
}
}

namespace pg8 {
struct EpiProj {
    static constexpr bool PERM = true, AFTER_DRAIN = false, HAS_MID = false;
    bf16_t* P; const float* rot;
    __device__ __forceinline__ void operator()(const f32x4 (&acc)[2][2][4][2], const Unit& u, int wr, int wc, int fr, int fq) const {
        const int row0 = u.pm * BM + wr * 64 + fr, colb = u.pn * BM + wc * 32 + 8 * fq;
        const bool rotq = (u.pn >= 7) && (u.pn < 15);
        const float ksc = (u.pn >= 11) ? K_SCALE : 1.0f;
        const int i0 = 16 * wc + 4 * fq;
#pragma unroll
        for (int ai = 0; ai < 2; ++ai)
#pragma unroll
            for (int m = 0; m < 4; ++m) {
                const int row = row0 + ai * HALF + m * 16; const int pos = row & (SEQL - 1);
                bf16_t* rowp = P + (size_t)row * NPROJ + colb;
                f32x4 r0 = (f32x4){1.f, 0.f, 1.f, 0.f}, r1 = r0;
                if (rotq) { const f32x4* rt = (const f32x4*)(rot + ((size_t)pos * 64 + i0) * 2); r0 = rt[0]; r1 = rt[1]; }
#pragma unroll
                for (int bj = 0; bj < 2; ++bj) {
                    f32x4 v0 = acc[ai][bj][m][0], v1 = acc[ai][bj][m][1];
                    if (rotq) {
                        f32x4 w0, w1;
                        w0[0] = (v0[0] * r0[0] - v0[1] * r0[1]) * ksc; w0[1] = (v0[0] * r0[1] + v0[1] * r0[0]) * ksc;
                        w0[2] = (v0[2] * r0[2] - v0[3] * r0[3]) * ksc; w0[3] = (v0[2] * r0[3] + v0[3] * r0[2]) * ksc;
                        w1[0] = (v1[0] * r1[0] - v1[1] * r1[1]) * ksc; w1[1] = (v1[0] * r1[1] + v1[1] * r1[0]) * ksc;
                        w1[2] = (v1[2] * r1[2] - v1[3] * r1[3]) * ksc; w1[3] = (v1[2] * r1[3] + v1[3] * r1[2]) * ksc;
                        v0 = w0; v1 = w1;
                    }
                    u32x4 w; w.x = pkbf(v0[0], v0[1]); w.y = pkbf(v0[2], v0[3]); w.z = pkbf(v1[0], v1[1]); w.w = pkbf(v1[2], v1[3]);
                    *(u32x4*)(rowp + bj * HALF) = w;
                }
            }
    }
};
struct EpiMergeF {
    static constexpr bool PERM = true, AFTER_DRAIN = false, HAS_MID = true;
    const bf16_t* P; bf16_t* O;
    static __device__ __forceinline__ float cl(float x) { return fminf(fmaxf(x, -30.f), 30.f); }
    static __device__ __forceinline__ float ratio(float a, float b) { return (1.0f + __expf(-cl(b))) * __builtin_amdgcn_rcpf(1.0f + __expf(-cl(a))); }
    __device__ __forceinline__ void mid(f32x4 (&acc)[2][2][4][2], const Unit& u, int wr, int wc, int fr, int fq) const {
        const int row0 = hide_i(u.pm * BM + wr * 64 + fr), colb = hide_i(u.pn * BM + wc * 32 + 8 * fq);
        __builtin_amdgcn_sched_barrier(0);
#pragma unroll
        for (int ai = 0; ai < 2; ++ai) {
            u32x4 g0[4][2], g1[4][2];
#pragma unroll
            for (int m = 0; m < 4; ++m)
#pragma unroll
                for (int bj = 0; bj < 2; ++bj) { const bf16_t* gp = P + (size_t)(row0 + ai * HALF + m * 16) * NPROJ + C_GBR + colb + bj * HALF; g0[m][bj] = *(const u32x4*)gp; g1[m][bj] = *(const u32x4*)(gp + DMODEL); }
            __builtin_amdgcn_sched_barrier(0);
#pragma unroll
            for (int m = 0; m < 4; ++m)
#pragma unroll
                for (int bj = 0; bj < 2; ++bj) {
                    const u32x4 a_ = g0[m][bj], b_ = g1[m][bj]; f32x4 r0, r1;
                    r0[0] = ratio(bflo(a_.x), bflo(b_.x)); r0[1] = ratio(bfhi(a_.x), bfhi(b_.x)); r0[2] = ratio(bflo(a_.y), bflo(b_.y)); r0[3] = ratio(bfhi(a_.y), bfhi(b_.y));
                    r1[0] = ratio(bflo(a_.z), bflo(b_.z)); r1[1] = ratio(bfhi(a_.z), bfhi(b_.z)); r1[2] = ratio(bflo(a_.w), bflo(b_.w)); r1[3] = ratio(bfhi(a_.w), bfhi(b_.w));
                    acc[ai][bj][m][0] = acc[ai][bj][m][0] * r0; acc[ai][bj][m][1] = acc[ai][bj][m][1] * r1;
                }
            __builtin_amdgcn_sched_barrier(0);
        }
    }
    __device__ __forceinline__ void operator()(const f32x4 (&acc)[2][2][4][2], const Unit& u, int wr, int wc, int fr, int fq) const {
        const int row0 = u.pm * BM + wr * 64 + fr, colb = u.pn * BM + wc * 32 + 8 * fq;
#pragma unroll
        for (int ai = 0; ai < 2; ++ai) {
            u32x4 gg[4][2];
#pragma unroll
            for (int m = 0; m < 4; ++m)
#pragma unroll
                for (int bj = 0; bj < 2; ++bj) gg[m][bj] = *(const u32x4*)(P + (size_t)(row0 + ai * HALF + m * 16) * NPROJ + C_GBR + DMODEL + colb + bj * HALF);
            __builtin_amdgcn_sched_barrier(0);
#pragma unroll
            for (int m = 0; m < 4; ++m) {
                const int row = row0 + ai * HALF + m * 16;
#pragma unroll
                for (int bj = 0; bj < 2; ++bj) {
                    const int col = colb + bj * HALF;
                    const u32x4 g = gg[m][bj];
                    const f32x4 v0 = acc[ai][bj][m][0], v1 = acc[ai][bj][m][1];
                    float o[8];
                    o[0] = sigmoidf_(cl(bflo(g.x))) * v0[0]; o[1] = sigmoidf_(cl(bfhi(g.x))) * v0[1]; o[2] = sigmoidf_(cl(bflo(g.y))) * v0[2]; o[3] = sigmoidf_(cl(bfhi(g.y))) * v0[3];
                    o[4] = sigmoidf_(cl(bflo(g.z))) * v1[0]; o[5] = sigmoidf_(cl(bfhi(g.z))) * v1[1]; o[6] = sigmoidf_(cl(bflo(g.w))) * v1[2]; o[7] = sigmoidf_(cl(bfhi(g.w))) * v1[3];
                    u32x4 w; w.x = pkbf(o[0], o[1]); w.y = pkbf(o[2], o[3]); w.z = pkbf(o[4], o[5]); w.w = pkbf(o[6], o[7]);
                    *(u32x4*)(O + (size_t)row * DMODEL + col) = w;
                }
            }
        }
    }
};
struct EpiRes {
    static constexpr bool PERM = false, AFTER_DRAIN = false, HAS_MID = false;
    const float* X; float* O;
    __device__ __forceinline__ void operator()(const f32x4 (&acc)[2][2][4][2], const Unit& u, int wr, int wc, int fr, int fq) const {
        const int row0 = u.pm * BM + wr * 64 + fr, col0 = u.pn * BM + wc * 32 + 4 * fq;
#pragma unroll
        for (int ai = 0; ai < 2; ++ai) {
            f32x4 xv[4][2][2];
#pragma unroll
            for (int m = 0; m < 4; ++m) { const size_t off = (size_t)(row0 + ai * HALF + m * 16) * DMODEL + col0;
#pragma unroll
                for (int bj = 0; bj < 2; ++bj)
#pragma unroll
                    for (int n = 0; n < 2; ++n) xv[m][bj][n] = *(const f32x4*)(X + off + bj * HALF + n * 16); }
            __builtin_amdgcn_sched_barrier(0);
#pragma unroll
            for (int m = 0; m < 4; ++m) { const size_t off = (size_t)(row0 + ai * HALF + m * 16) * DMODEL + col0;
#pragma unroll
                for (int bj = 0; bj < 2; ++bj)
#pragma unroll
                    for (int n = 0; n < 2; ++n) *(f32x4*)(O + off + bj * HALF + n * 16) = xv[m][bj][n] + acc[ai][bj][m][n]; }
            __builtin_amdgcn_sched_barrier(0);
        }
    }
};
struct EpiSwiglu {
    static constexpr bool PERM = true, AFTER_DRAIN = false, HAS_MID = false;
    bf16_t* H; const float* rs;
    __device__ __forceinline__ void operator()(const f32x4 (&acc)[2][2][4][2], const Unit& u, int wr, int wc, int fr, int fq) const {
        const int row0 = u.pm * BM + wr * 64 + fr, col = u.pn * HALF + wc * 32 + 8 * fq;
#pragma unroll
        for (int ai = 0; ai < 2; ++ai)
#pragma unroll
            for (int m = 0; m < 4; ++m) {
                const int row = row0 + ai * HALF + m * 16; const float r_ = rs[row];
                const f32x4 g0 = acc[ai][0][m][0] * r_, g1 = acc[ai][0][m][1] * r_, u0 = acc[ai][1][m][0] * r_, u1 = acc[ai][1][m][1] * r_;
                u32x4 w; w.x = pkbf(siluf_(g0[0]) * u0[0], siluf_(g0[1]) * u0[1]); w.y = pkbf(siluf_(g0[2]) * u0[2], siluf_(g0[3]) * u0[3]);
                w.z = pkbf(siluf_(g1[0]) * u1[0], siluf_(g1[1]) * u1[1]); w.w = pkbf(siluf_(g1[2]) * u1[2], siluf_(g1[3]) * u1[3]);
                *(u32x4*)(H + (size_t)row * 1024 + col) = w;
            }
    }
};
struct EpiDown {
    static constexpr bool PERM = true, AFTER_DRAIN = false, HAS_MID = false;
    bf16_t* Y; const float* rg;
    __device__ __forceinline__ void operator()(const f32x4 (&acc)[2][2][4][2], const Unit& u, int wr, int wc, int fr, int fq) const {
        const int row0 = u.pm * BM + wr * 64 + fr, colb = u.pn * BM + wc * 32 + 8 * fq;
#pragma unroll
        for (int ai = 0; ai < 2; ++ai)
#pragma unroll
            for (int m = 0; m < 4; ++m) {
                const int row = row0 + ai * HALF + m * 16; const float gt = rg[row];
#pragma unroll
                for (int bj = 0; bj < 2; ++bj) {
                    const f32x4 v0 = acc[ai][bj][m][0] * gt, v1 = acc[ai][bj][m][1] * gt;
                    u32x4 w; w.x = pkbf(v0[0], v0[1]); w.y = pkbf(v0[2], v0[3]); w.z = pkbf(v1[0], v1[1]); w.w = pkbf(v1[2], v1[3]);
                    *(u32x4*)(Y + (size_t)row * DMODEL + colb + bj * HALF) = w;
                }
            }
    }
};
struct ExpertOrder {
    const LAS int* ts; int G, c;
    __device__ __forceinline__ bool next(int i, Unit& u) const {
        const int L = i * G + c; const int total = ts[32] * 8; if (L >= total) return false;
        const int gt = L >> 3; u.pm = gt; u.pn = L & 7; int e = 0;
        for (int k = 1; k < 32; ++k) e += (gt >= ts[k]) ? 1 : 0;
        u.e = e; return true;
    }
    __device__ __forceinline__ void a_ready(const Unit&) const {}
    __device__ __forceinline__ void done(const Unit&) const {}
};
}

struct MapId { __device__ __forceinline__ int operator()(int n) const { return n; } };
struct MapGate { __device__ __forceinline__ int operator()(int f) const { return ((f >> 7) << 8) + (f & 127); } };
struct MapUp { __device__ __forceinline__ int operator()(int f) const { return ((f >> 7) << 8) + 128 + (f & 127); } };
struct MapProj {
    __device__ __forceinline__ int operator()(int n) const {
        if (n < 1736) return n;
        if (n < 2760) { const int l = n - 1736, d = l & 127; return C_QR + (l & ~127) + ((d & 63) << 1) + (d >> 6); }
        if (n < 3784) { const int l = n - 2760, d = l & 127; return C_KR + (l & ~127) + ((d & 63) << 1) + (d >> 6); }
        if (n < 4808) return C_VR + (n - 3784);
        if (n < 5832) return C_GR + (n - 4808);
        return C_GBR + (n - 5832);
    }
};
template <class RowMap>
__device__ __forceinline__ void tr_item(const float* __restrict__ src, int N, bf16_t* __restrict__ dst, int ldd, int kb, int nb, int lane, RowMap rm) {
    const int kc = lane >> 3, nc = lane & 7;
    const int n = nb * 32 + nc * 4, k0 = kb * 64 + kc * 8;
    if (n < N) {
        f32x4 v[8];
#pragma unroll
        for (int i = 0; i < 8; ++i) v[i] = *(const f32x4*)(src + (size_t)(k0 + i) * N + n);
#pragma unroll
        for (int j = 0; j < 4; ++j) {
            u32x4 o; o.x = pkbf(v[0][j], v[1][j]); o.y = pkbf(v[2][j], v[3][j]); o.z = pkbf(v[4][j], v[5][j]); o.w = pkbf(v[6][j], v[7][j]);
            *(u32x4*)(dst + (size_t)rm(n + j) * ldd + k0) = o;
        }
    }
}
template <class RowMap>
__device__ __forceinline__ void tr_item2(const float* __restrict__ src, int N, bf16_t* __restrict__ dst, int ldd, int kb, int nb, int lane, RowMap rm) {
    const int kc = lane >> 3, nc = lane & 7;
    const int n = nb * 32 + nc * 4, k0 = kb * 64 + kc * 8;
    f32x4 va[8], vb[8];
#pragma unroll
    for (int i = 0; i < 8; ++i) { va[i] = *(const f32x4*)(src + (size_t)(k0 + i) * N + n); vb[i] = *(const f32x4*)(src + (size_t)(k0 + i) * N + n + 32); }
#pragma unroll
    for (int j = 0; j < 4; ++j) {
        u32x4 o; o.x = pkbf(va[0][j], va[1][j]); o.y = pkbf(va[2][j], va[3][j]); o.z = pkbf(va[4][j], va[5][j]); o.w = pkbf(va[6][j], va[7][j]);
        *(u32x4*)(dst + (size_t)rm(n + j) * ldd + k0) = o;
    }
#pragma unroll
    for (int j = 0; j < 4; ++j) {
        u32x4 o; o.x = pkbf(vb[0][j], vb[1][j]); o.y = pkbf(vb[2][j], vb[3][j]); o.z = pkbf(vb[4][j], vb[5][j]); o.w = pkbf(vb[6][j], vb[7][j]);
        *(u32x4*)(dst + (size_t)rm(n + 32 + j) * ldd + k0) = o;
    }
}
template <class RowMap>
__device__ __forceinline__ void tr_item4(const float* __restrict__ src, int N, bf16_t* __restrict__ dst, int ldd, int kb, int nb, int lane, RowMap rm) {
    const int kc = lane >> 3, nc = lane & 7;
    const int n = nb * 32 + nc * 4, k0 = kb * 64 + kc * 8;
    f32x4 v[4][8];
#pragma unroll
    for (int i = 0; i < 8; ++i)
#pragma unroll
        for (int u = 0; u < 4; ++u) v[u][i] = *(const f32x4*)(src + (size_t)(k0 + i) * N + n + 32 * u);
#pragma unroll
    for (int u = 0; u < 4; ++u)
#pragma unroll
        for (int j = 0; j < 4; ++j) {
            u32x4 o; o.x = pkbf(v[u][0][j], v[u][1][j]); o.y = pkbf(v[u][2][j], v[u][3][j]); o.z = pkbf(v[u][4][j], v[u][5][j]); o.w = pkbf(v[u][6][j], v[u][7][j]);
            *(u32x4*)(dst + (size_t)rm(n + 32 * u + j) * ldd + k0) = o;
        }
}
constexpr int EXP_ITEMS = 3 * 32 * 1024;
__device__ __forceinline__ void convert_experts(const float* w_eg, const float* w_eu, const float* w_ed, bf16_t* WGU, bf16_t* WD, unsigned* qctr, int lane) {
    int nxt = 0; if (lane == 0) nxt = (int)atomicAdd(qctr, 8u);
    for (;;) {
        const int it = __builtin_amdgcn_readfirstlane(nxt);
        if (it >= EXP_ITEMS) break;
        if (lane == 0) nxt = (int)atomicAdd(qctr, 8u);
        const int kind = it >> 15, r = it & 32767, e = r >> 10, q = r & 1023;
        if (kind == 0) { const float* src = w_eg + (size_t)e * 2048 * 1024; bf16_t* dst = WGU + (size_t)e * 2048 * 2048;
#pragma unroll 1
            for (int u = 0; u < 8; u += 4) tr_item4(src, 1024, dst, 2048, q >> 5, (q & 31) + u, lane, MapGate{}); }
        else if (kind == 1) { const float* src = w_eu + (size_t)e * 2048 * 1024; bf16_t* dst = WGU + (size_t)e * 2048 * 2048;
#pragma unroll 1
            for (int u = 0; u < 8; u += 4) tr_item4(src, 1024, dst, 2048, q >> 5, (q & 31) + u, lane, MapUp{}); }
        else { const float* src = w_ed + (size_t)e * 1024 * 2048; bf16_t* dst = WD + (size_t)e * 2048 * 1024;
#pragma unroll 1
            for (int u = 0; u < 8; u += 4) tr_item4(src, 2048, dst, 1024, q >> 6, (q & 63) + u, lane, MapId{}); }
    }
}
__device__ __forceinline__ void sincos_d(double a, double& s, double& c) {
    const double TWO_PI = 6.283185307179586476925, HALF_PI = 1.5707963267948966192313;
    double k = rint(a / HALF_PI); double r = a - k * HALF_PI;
    r -= k * 6.123233995736766e-17;
    const int q = ((int)k) & 3; const double r2 = r * r;
    double sp = r2 * (-1.0 / 1307674368000.0);
    sp = r2 * (sp + 1.0 / 6227020800.0); sp = r2 * (sp - 1.0 / 39916800.0); sp = r2 * (sp + 1.0 / 362880.0); sp = r2 * (sp - 1.0 / 5040.0); sp = r2 * (sp + 1.0 / 120.0); sp = r2 * (sp - 1.0 / 6.0);
    const double sr = r + r * sp;
    double cp = r2 * (1.0 / 20922789888000.0);
    cp = r2 * (cp - 1.0 / 87178291200.0); cp = r2 * (cp + 1.0 / 479001600.0); cp = r2 * (cp - 1.0 / 3628800.0); cp = r2 * (cp + 1.0 / 40320.0); cp = r2 * (cp - 1.0 / 720.0); cp = r2 * (cp + 1.0 / 24.0); cp = r2 * (cp - 0.5);
    const double cr = 1.0 + cp;
    s = (q == 0) ? sr : (q == 1) ? cr : (q == 2) ? -sr : -cr;
    c = (q == 0) ? cr : (q == 1) ? -sr : (q == 2) ? -cr : sr;
    (void)TWO_PI;
}

struct Params { const float* in[17]; float* out; unsigned char* ws; };

#ifndef PROF_PHASE
#define PROF_PHASE -1
#endif
#define STAMP(i) do { if (PROF_PHASE >= 0 && bx == 0 && wave_id == 0) ((unsigned*)(p.ws + WS_CTL))[6000 + (i)] = (unsigned)__builtin_amdgcn_s_memrealtime(); } while (0)
#define GSYNC() grid.sync()
#define XBAR() do { const int l__ = (int)__builtin_amdgcn_mbcnt_hi(~0u, __builtin_amdgcn_mbcnt_lo(~0u, (unsigned)hide_i(0))); xcd_barrier(xbar, wave_id * 64 + l__); } while (0)
constexpr int CTL_BAR_WORD = 8192;
constexpr int CTL_QCTR = 2048;
#ifndef NGEMM_P1
#define NGEMM_P1 208
#endif

__global__ void __launch_bounds__(512, 2) mega_fwd(Params p) {
    extern __shared__ __attribute__((aligned(16))) unsigned char lds_raw[];
    LAS unsigned char* lds = (LAS unsigned char*)lds_raw;
    cg::grid_group grid = cg::this_grid();
    const int G = gridDim.x, bx = blockIdx.x;
    const int wave_id = __builtin_amdgcn_readfirstlane((int)threadIdx.x >> 6);
    const int NGW = G * 8, NGT = G * 512;
    XcdBarrier xbar;
    {
        const int l0 = (int)__builtin_amdgcn_mbcnt_hi(~0u, __builtin_amdgcn_mbcnt_lo(~0u, (unsigned)hide_i(0)));
        volatile LAS unsigned* st = (volatile LAS unsigned*)(lds + LDS_MISC + 256);
        if (wave_id == 0 && l0 < 2) st[l0] = 0u;
        __syncthreads();
        xbar.bar = (unsigned*)(p.ws + WS_CTL) + CTL_BAR_WORD; xbar.x = xb_xcc_id(); xbar.st = st;
        if (wave_id == 0 && l0 == 0) (void)xb_add(&xbar.bar[XB_XCNT(xbar.x)], 1u);
    }
#define PH_LOCALS \
    const int lane = (int)__builtin_amdgcn_mbcnt_hi(~0u, __builtin_amdgcn_mbcnt_lo(~0u, (unsigned)hide_i(0))), wave = wave_id, tid = wave * 64 + lane; (void)tid; \
    const int gw = bx * 8 + wave, gtid = bx * 512 + tid; (void)gw; (void)gtid; (void)lane; \
    unsigned char* ws = hide_p(p.ws); float* out = hide_p(p.out); (void)out; \
    unsigned* ctl = (unsigned*)(ws + WS_CTL); float* rot = (float*)(ws + WS_ROT); (void)ctl; (void)rot; \
    bf16_t* WIN = (bf16_t*)(ws + WS_WIN); bf16_t* WCOMB = (bf16_t*)(ws + WS_WCOMB); bf16_t* WB = (bf16_t*)(ws + WS_WB); bf16_t* WO = (bf16_t*)(ws + WS_WO); (void)WIN; (void)WCOMB; (void)WB; (void)WO; \
    bf16_t* WGU = (bf16_t*)(ws + WS_WGU); bf16_t* WD = (bf16_t*)(ws + WS_WD); (void)WGU; (void)WD; \
    bf16_t* P = (bf16_t*)(ws + WS_P); bf16_t* HMID = (bf16_t*)(ws + WS_HMID); bf16_t* Y = (bf16_t*)(ws + WS_Y); (void)P; (void)HMID; (void)Y; \
    bf16_t* XN = (bf16_t*)(ws + WS_XN); bf16_t* BA = XN; bf16_t* TN = XN; (void)BA; (void)TN; \
    bf16_t* OA = (bf16_t*)(ws + WS_OA); bf16_t* OB = OA + 1024;            bf16_t* MIXED = (bf16_t*)(ws + WS_MIXED); bf16_t* XG = (bf16_t*)(ws + WS_XG); (void)OA; (void)OB; (void)MIXED; (void)XG; \
    bf16_t* KV = (bf16_t*)(ws + WS_KV); u64* MASK = (u64*)(ws + WS_MASK); (void)KV; (void)MASK; \
    int* misc = (int*)(ws + WS_MISC); \
    int* row_tok = misc + MI_ROWTOK; float* row_gate = (float*)(misc + MI_ROWGATE); int* tok_slot = misc + MI_TOKSLOT; (void)row_tok; (void)row_gate; (void)tok_slot; \
    int* asg_e = misc + MI_ASGE; int* asg_r = misc + MI_ASGR; float* asg_g = (float*)(misc + MI_ASGG); (void)asg_e; (void)asg_r; (void)asg_g;
#define IN(k) hide_p(p.in[k])

    STAMP(0);
    {
        PH_LOCALS
        const float* x = IN(0); const float* g_mix = IN(1); const float* w_in = IN(2); const float* w_uv = IN(4); const float* w_branch = IN(6); const float* w_out = IN(7);
        constexpr int NB_WIN = 311;
        constexpr int I_WIN = 32 * NB_WIN, I_WB = 16 * 64, I_WO = 32 * 64;
        constexpr int I_TOTAL = I_WIN + I_WB + I_WO;
#pragma unroll 1
        for (int pass = 0; pass < 4; ++pass) {
        const int job = (pass + wave) & 3;
        if (job == 0) {
        for (int it = gw; it < I_TOTAL; it += NGW) {
            int r = it;
            if (r < I_WIN) { tr_item(w_in, 9928, WIN, 2048, r / NB_WIN, r % NB_WIN, lane, MapProj{}); continue; } r -= I_WIN;
            if (r < I_WB) { tr_item(w_branch + (size_t)1024 * 2048, 2048, WCOMB + 1024, 2048, r >> 6, r & 63, lane, MapId{});   continue; } r -= I_WB;
            tr_item(w_out, 2048, WO, 2048, r >> 6, r & 63, lane, MapId{});
        }
        for (int i = gtid; i < 56 * 256; i += NGT) ((u32x4*)(WIN + (size_t)1736 * 2048))[i] = (u32x4){0u, 0u, 0u, 0u};
        } else if (job == 1) {
        for (int it = gw; it < 2048; it += NGW) {
            const int h = it >> 8, ch = (it >> 7) & 1, n0 = (it & 127) * 16, c = ch * 64 + lane;
            const float* wuv = w_uv + ((size_t)h * 128 + c) * 128;
            const float* wa = w_branch + (size_t)(h * 128) * 2048 + n0;
            float a[16];
#pragma unroll
            for (int j = 0; j < 16; ++j) a[j] = 0.f;
#pragma unroll 4
            for (int d4 = 0; d4 < 32; ++d4) {
                const f32x4 wv = *(const f32x4*)(wuv + d4 * 4);
#pragma unroll
                for (int dd = 0; dd < 4; ++dd) {
                    const float* wr_ = wa + (size_t)(d4 * 4 + dd) * 2048;
#pragma unroll
                    for (int j4 = 0; j4 < 4; ++j4) { const f32x4 b = *(const f32x4*)(wr_ + j4 * 4); a[j4 * 4 + 0] += wv[dd] * b[0]; a[j4 * 4 + 1] += wv[dd] * b[1]; a[j4 * 4 + 2] += wv[dd] * b[2]; a[j4 * 4 + 3] += wv[dd] * b[3]; }
                }
            }
#pragma unroll
            for (int j = 0; j < 16; ++j) WCOMB[(size_t)(n0 + j) * 2048 + h * 128 + c] = (bf16_t)(pkbf(a[j], 0.f) & 0xffffu);
        }
        } else if (job == 2) {
        for (int m = gw; m < T_TOK; m += 2 * NGW) {
            const int m1 = (m + NGW < T_TOK) ? m + NGW : m;
            const f32x4* xr0 = (const f32x4*)(x + (size_t)m * DMODEL) + lane; const f32x4* xr1 = (const f32x4*)(x + (size_t)m1 * DMODEL) + lane;
            f32x4 v0[8], v1[8]; float s0 = 0.f, s1 = 0.f;
#pragma unroll
            for (int j = 0; j < 8; ++j) { v0[j] = xr0[64 * j]; v1[j] = xr1[64 * j]; }
#pragma unroll
            for (int j = 0; j < 8; ++j) { s0 += (v0[j][0] * v0[j][0] + v0[j][1] * v0[j][1]) + (v0[j][2] * v0[j][2] + v0[j][3] * v0[j][3]); s1 += (v1[j][0] * v1[j][0] + v1[j][1] * v1[j][1]) + (v1[j][2] * v1[j][2] + v1[j][3] * v1[j][3]); }
            const float r0 = 1.0f / sqrtf(wave_sum(s0, lane) * (1.0f / DMODEL) + EPS_F), r1 = 1.0f / sqrtf(wave_sum(s1, lane) * (1.0f / DMODEL) + EPS_F);
            u32x2* o0 = (u32x2*)(XN + (size_t)m * DMODEL) + lane; u32x2* o1 = (u32x2*)(XN + (size_t)m1 * DMODEL) + lane;
#pragma unroll
            for (int j = 0; j < 8; ++j) { const f32x4 gg = ((const f32x4*)g_mix)[lane + 64 * j];
                u32x2 w; w.x = pkbf(v0[j][0] * r0 * gg[0], v0[j][1] * r0 * gg[1]); w.y = pkbf(v0[j][2] * r0 * gg[2], v0[j][3] * r0 * gg[3]); o0[64 * j] = w;
                u32x2 w2; w2.x = pkbf(v1[j][0] * r1 * gg[0], v1[j][1] * r1 * gg[1]); w2.y = pkbf(v1[j][2] * r1 * gg[2], v1[j][3] * r1 * gg[3]); o1[64 * j] = w2; }
        }
        } else {
        for (int idx = gtid; idx < SEQL * 64; idx += NGT) {
            const int pos = idx >> 6, i = idx & 63; double f = 1.0;
            for (int k = 0; k < i; ++k) f *= 0.8659643233600653;
            double s, c; sincos_d((double)pos * f, s, c);
            rot[2 * idx] = (float)c; rot[2 * idx + 1] = (float)s;
        }
        { const float* g_ffn = IN(8); const float* w_rg = IN(9); const float* w_re = IN(11); float* WC = (float*)(ws + WS_WC);
          for (int idx = gtid; idx < 256 * 48 * 8; idx += NGT) { const int j = idx & 7, c = (idx >> 3) % 48, k = (idx / 384) * 8 + j;
              const float wv = (c < 4) ? w_rg[k * 4 + c] : (c < 36) ? w_re[k * 32 + (c - 4)] : 0.f; WC[idx] = wv * g_ffn[k]; } }
        }
        }
        for (int i = gtid; i < 32; i += NGT) ctl[64 * i] = 0u;
        if (gtid < 2) ctl[4096 + gtid] = 0u;
        for (int i = gtid; i < MAXSLOT; i += NGT) { row_tok[i] = 0; row_gate[i] = 0.f; ((float*)(ws + WS_WC + 524288))[i] = 0.f; }
    }
    GSYNC();
    STAMP(1);

    {
        PH_LOCALS
        const float* w_eg = IN(13); const float* w_eu = IN(14); const float* w_ed = IN(15);
        const int NGEMM = (G == 256) ? NGEMM_P1 : G;
        if (bx < NGEMM) {
            pg8::Gemm g{XN, WIN, T_TOK, NPROJ, 2048}; pg8::StaticOrder S; S.init(T_TOK, NPROJ, NGEMM, bx);
            pg8::EpiProj E{P, rot};
            pg8::gemm_phase<pg8::EpiProj, pg8::StaticOrder, true, true>(lds, g, S, E, tid);
        }
        convert_experts(w_eg, w_eu, w_ed, WGU, WD, ctl + CTL_QCTR, lane);
    }
    XBAR();
    STAMP(2);

    {
        PH_LOCALS
        const float* g_kv = IN(3);
        for (int t = gw; t < T_TOK; t += NGW) {
            const unsigned v = *(const unsigned*)(P + (size_t)t * NPROJ + C_CKV + 2 * lane);
            const float a = bflo(v), b = bfhi(v);
            const float rstd = 1.0f / sqrtf(wave_sum(a * a + b * b, lane) * (1.0f / 128.0f) + EPS_F);
            *(unsigned*)(KV + (size_t)t * 128 + 2 * lane) = pkbf(a * rstd * g_kv[2 * lane], b * rstd * g_kv[2 * lane + 1]);
        }
#if DBG_CMP == 3
        {
        u64* MASKX = (u64*)(ws + WS_SPARE);
        LAS float* qi = (LAS float*)(lds + wave * 10240); LAS float* sc = qi + 512;
        for (int t = gw; t < T_TOK; t += NGW) {
            const int b = t >> 11, q = t & 2047, ng = (q >> 6) + 1;
            { const u32x4 v = *(const u32x4*)(P + (size_t)t * NPROJ + C_QIDX + lane * 8);
              f32x4 lo4 = (f32x4){bflo(v.x), bfhi(v.x), bflo(v.y), bfhi(v.y)}, hi4 = (f32x4){bflo(v.z), bfhi(v.z), bflo(v.w), bfhi(v.w)};
              *(LAS f32x4*)(qi + lane * 8) = lo4; *(LAS f32x4*)(qi + lane * 8 + 4) = hi4; }
            float w[8];
            { const u32x4 v = *(const u32x4*)(P + (size_t)t * NPROJ + C_WIDX); w[0] = bflo(v.x); w[1] = bfhi(v.x); w[2] = bflo(v.y); w[3] = bfhi(v.y); w[4] = bflo(v.z); w[5] = bfhi(v.z); w[6] = bflo(v.w); w[7] = bfhi(v.w); }
            for (int g = 0; g < ng; ++g) {
                LAS float* qg = qi; asm volatile("" : "+v"(qg));
                const int s = g * 64 + lane; const u32x4* kr = (const u32x4*)(P + (size_t)(b * SEQL + s) * NPROJ + C_KIDX);
                float dot[8];
#pragma unroll
                for (int h = 0; h < 8; ++h) dot[h] = 0.f;
#pragma unroll
                for (int c = 0; c < 8; ++c) {
                    const u32x4 v = kr[c];
                    const f32x4 ka = (f32x4){bflo(v.x), bfhi(v.x), bflo(v.y), bfhi(v.y)}, kb = (f32x4){bflo(v.z), bfhi(v.z), bflo(v.w), bfhi(v.w)};
#pragma unroll
                    for (int h = 0; h < 8; ++h) {
                        const f32x4 qa = *(const LAS f32x4*)(qg + h * 64 + c * 8), qb = *(const LAS f32x4*)(qg + h * 64 + c * 8 + 4);
                        dot[h] += (qa[0] * ka[0] + qa[1] * ka[1]) + (qa[2] * ka[2] + qa[3] * ka[3]) + (qb[0] * kb[0] + qb[1] * kb[1]) + (qb[2] * kb[2] + qb[3] * kb[3]);
                    }
                }
                float score = 0.f;
#pragma unroll
                for (int h = 0; h < 8; ++h) score += w[h] * fmaxf(dot[h], 0.f);
                sc[s] = score * IDX_SCALE;
            }
            u64* mrow = MASKX + (size_t)t * 32;
            if (ng <= 4) { if (lane < 32) mrow[lane] = (lane < ng) ? ~0ull : 0ull; }
            else {
                unsigned lo = 0u;
                for (int bit = 31; bit >= 0; --bit) {
                    const unsigned cand = lo | (1u << bit); int cnt = 0;
                    for (int g = 0; g < ng; ++g) cnt += __popcll(__ballot(fkey(sc[g * 64 + lane]) >= cand));
                    if (cnt >= 256) lo = cand;
                }
                const unsigned tau = lo; int cgt = 0;
                for (int g = 0; g < ng; ++g) cgt += __popcll(__ballot(fkey(sc[g * 64 + lane]) > tau));
                const int need = 256 - cgt; int run = 0;
                for (int g = 0; g < ng; ++g) {
                    const unsigned key = fkey(sc[g * 64 + lane]);
                    const u64 gt = __ballot(key > tau), eq = __ballot(key == tau);
                    const u64 below = eq & ((1ull << lane) - 1ull);
                    const bool sel = (key == tau) && (run + (int)__popcll(below) < need);
                    const u64 word = gt | __ballot(sel);
                    run += (int)__popcll(eq);
                    if (lane == 0) mrow[g] = word;
                }
                if (lane >= ng && lane < 32) mrow[lane] = 0ull;
            }
        }
        }
        __syncthreads();
#endif
        typedef short bf16x8_t __attribute__((ext_vector_type(8)));
        constexpr int SCS = 2052;
        LAS float* scl = (LAS float*)lds;
        LAS unsigned* hist = (LAS unsigned*)(lds + 16 * SCS * 4);
        LAS unsigned* candl = hist + 16 * 256 + wave * 64;
        for (int i = tid; i < 16 * 256; i += 512) hist[i] = 0u;
        __syncthreads();
        for (int ui = 0; ui < 4; ++ui) {
            const int uu = ui * 256 + ((ui & 1) ? 255 - bx : bx);
            if (uu >= 1024 || bx >= 256) break;
            const int b = uu & 7, qblk = uu >> 3, q0 = qblk * 16, t0 = b * SEQL + q0, ng = (q0 >> 6) + 1, N = ng * 64;
            if (ng <= 4) {
                for (int qq = 0; qq < 2; ++qq) { u64* mrow = MASK + (size_t)(t0 + 2 * wave + qq) * 32; if (lane < 32) mrow[lane] = (lane < ng) ? ~0ull : 0ull; }
                continue;
            }
            const int qrow = lane & 15, kg = lane >> 4;
            bf16x8_t qf[8][2]; float w[8];
            { const bf16_t* qp = P + (size_t)(t0 + qrow) * NPROJ + C_QIDX + 8 * kg;
#pragma unroll
              for (int h = 0; h < 8; ++h) { qf[h][0] = *(const bf16x8_t*)(qp + h * 64); qf[h][1] = *(const bf16x8_t*)(qp + h * 64 + 32); }
              const u32x4 v = *(const u32x4*)(P + (size_t)(t0 + qrow) * NPROJ + C_WIDX); w[0] = bflo(v.x); w[1] = bfhi(v.x); w[2] = bflo(v.y); w[3] = bfhi(v.y); w[4] = bflo(v.z); w[5] = bfhi(v.z); w[6] = bflo(v.w); w[7] = bfhi(v.w); }
            for (int kt = wave; kt < N / 16; kt += 8) {
                const int s0 = kt * 16;
                const bf16_t* kp = P + (size_t)(b * SEQL + s0 + qrow) * NPROJ + C_KIDX + 8 * kg;
                const bf16x8_t a0 = *(const bf16x8_t*)kp, a1 = *(const bf16x8_t*)(kp + 32);
                f32x4 sacc = (f32x4){0.f, 0.f, 0.f, 0.f};
#pragma unroll
                for (int h = 0; h < 8; ++h) {
                    f32x4 acc = (f32x4){0.f, 0.f, 0.f, 0.f};
                    acc = __builtin_amdgcn_mfma_f32_16x16x32_bf16(a0, qf[h][0], acc, 0, 0, 0);
                    acc = __builtin_amdgcn_mfma_f32_16x16x32_bf16(a1, qf[h][1], acc, 0, 0, 0);
                    sacc[0] += w[h] * fmaxf(acc[0], 0.f); sacc[1] += w[h] * fmaxf(acc[1], 0.f); sacc[2] += w[h] * fmaxf(acc[2], 0.f); sacc[3] += w[h] * fmaxf(acc[3], 0.f);
                }
                sacc = sacc * IDX_SCALE + 0.0f;
                *(LAS f32x4*)(scl + qrow * SCS + s0 + 4 * kg) = sacc;
#pragma unroll
                for (int i = 0; i < 4; ++i) __hip_atomic_fetch_add(hist + qrow * 256 + sbin(sacc[i]), 1u, __ATOMIC_RELAXED, __HIP_MEMORY_SCOPE_WORKGROUP);
            }
            __syncthreads();
#pragma unroll 1
            for (int qq = 0; qq < 2; ++qq) {
                const int q = 2 * wave + qq; const LAS float* row = scl + q * SCS; LAS unsigned* hq = hist + q * 256;
                unsigned key[32];
#pragma unroll
                for (int j = 0; j < 32; ++j) key[j] = (j < ng) ? fkey(row[64 * j + lane]) : 0u;
                const u32x4 hv = *(const LAS u32x4*)(hq + 4 * lane);
                *(LAS u32x4*)(hq + 4 * lane) = (u32x4){0u, 0u, 0u, 0u};
                const int tsum = (int)(hv.x + hv.y + hv.z + hv.w); int incl = tsum;
#pragma unroll
                for (int off = 1; off < 64; off <<= 1) { const int o = __builtin_amdgcn_ds_bpermute(((lane + off) & 63) << 2, incl); incl += (lane + off < 64) ? o : 0; }
                const int suf = incl - tsum;
                int bt_l, ab_l;
                if (suf + (int)hv.w >= 256) { bt_l = 4 * lane + 3; ab_l = suf; }
                else if (suf + (int)(hv.w + hv.z) >= 256) { bt_l = 4 * lane + 2; ab_l = suf + (int)hv.w; }
                else if (suf + (int)(hv.w + hv.z + hv.y) >= 256) { bt_l = 4 * lane + 1; ab_l = suf + (int)(hv.w + hv.z); }
                else { bt_l = 4 * lane; ab_l = suf + (int)(hv.w + hv.z + hv.y); }
                const u64 cb = __ballot(suf < 256 && incl >= 256);
                const int src = (int)__builtin_ctzll(cb | (1ull << 63));
                const int bt = __builtin_amdgcn_readlane(bt_l, src), above = __builtin_amdgcn_readlane(ab_l, src);
                const int r = 256 - above;
                int C = 0;
#pragma unroll
                for (int j = 0; j < 32; ++j) {
                    const bool isc = (key[j] != 0u) && (sbin(unkey(key[j])) == bt);
                    const u64 bal = __ballot(isc);
                    if (isc) { const int pos = C + (int)__popcll(bal & ((1ull << lane) - 1ull)); if (pos < 64) candl[pos] = key[j]; }
                    C += (int)__popcll(bal);
                }
                unsigned tau; int cgt;
                if (C <= 64) {
                    asm volatile("s_waitcnt lgkmcnt(0)" ::: "memory");
                    const unsigned ck = (lane < C) ? candl[lane] : 0u;
                    unsigned lo = 0u;
#pragma unroll 1
                    for (int bit = 31; bit >= 0; --bit) { const unsigned cand = lo | (1u << bit); if ((int)__popcll(__ballot(ck >= cand)) >= r) lo = cand; }
                    tau = lo; cgt = above + (int)__popcll(__ballot(ck > tau));
                } else {
                    unsigned lo = 0u;
#pragma unroll 1
                    for (int bit = 31; bit >= 0; --bit) {
                        const unsigned cand = lo | (1u << bit); int c = 0;
#pragma unroll
                        for (int j = 0; j < 32; ++j) c += (key[j] >= cand) ? 1 : 0;
#pragma unroll
                        for (int x = 1; x < 64; x <<= 1) c += __builtin_amdgcn_ds_bpermute((lane ^ x) << 2, c);
                        if (c >= 256) lo = cand;
                    }
                    tau = lo; cgt = 0;
#pragma unroll
                    for (int j = 0; j < 32; ++j) cgt += (key[j] > tau) ? 1 : 0;
#pragma unroll
                    for (int x = 1; x < 64; x <<= 1) cgt += __builtin_amdgcn_ds_bpermute((lane ^ x) << 2, cgt);
                }
                const int need = 256 - cgt; int run = 0; u64 myword = 0ull;
#pragma unroll
                for (int j = 0; j < 32; ++j) {
                    const u64 gt = __ballot(key[j] > tau), eq = __ballot(key[j] == tau);
                    const u64 below = eq & ((1ull << lane) - 1ull);
                    const bool sel = (key[j] == tau) && (run + (int)__popcll(below) < need);
                    const u64 word = gt | __ballot(sel);
                    run += (int)__popcll(eq);
                    if (lane == j) myword = word;
                    __builtin_amdgcn_sched_barrier(0);
                }
                if (lane < 32) MASK[(size_t)(t0 + q) * 32 + lane] = myword;
            }
            __syncthreads();
        }
    }
    XBAR();
    STAMP(3);

#if DBG_CMP == 1
    {
        PH_LOCALS
        bf16_t* OAX = (bf16_t*)(ws + WS_SPARE);
        float* qv = (float*)(lds_raw + wave * 10240); float* lg = qv + 512;
        for (int it = gw; it < T_TOK * 8; it += NGW) {
            const int t = it >> 3, h = it & 7, b = t >> 11, q = t & 2047, ng = (q >> 6) + 1;
            { const unsigned v = *(const unsigned*)(P + (size_t)t * NPROJ + C_QLAT + h * 128 + 2 * lane); qv[2 * lane] = bflo(v); qv[2 * lane + 1] = bfhi(v); }
            const u64* mrow = MASK + (size_t)t * 32;
            float mx = -INFINITY;
            for (int g = 0; g < ng; ++g) {
                asm volatile("" ::: "memory");
                const u64 word = mrow[g]; float l = -INFINITY;
                if ((word >> lane) & 1ull) {
                    const u32x4* kr = (const u32x4*)(KV + (size_t)(b * SEQL + g * 64 + lane) * 128);
                    float d0 = 0.f, d1 = 0.f, d2 = 0.f, d3 = 0.f;
#pragma unroll
                    for (int c = 0; c < 16; ++c) { const u32x4 v = kr[c]; const f32x4 qa = *(const f32x4*)(qv + 8 * c), qb = *(const f32x4*)(qv + 8 * c + 4);
                        d0 += qa[0] * bflo(v.x) + qb[0] * bflo(v.z); d1 += qa[1] * bfhi(v.x) + qb[1] * bfhi(v.z); d2 += qa[2] * bflo(v.y) + qb[2] * bflo(v.w); d3 += qa[3] * bfhi(v.y) + qb[3] * bfhi(v.w); }
                    l = ((d0 + d1) + (d2 + d3)) * ATT_SCALE;
                }
                lg[g * 64 + lane] = l; mx = fmaxf(mx, l);
            }
            mx = wave_max(mx, lane);
            float o0 = 0.f, o1 = 0.f, sum = 0.f;
            for (int g = 0; g < ng; ++g) {
                const u64 wv = mrow[g];
                u64 word = ((u64)__builtin_amdgcn_readfirstlane((unsigned)(wv >> 32)) << 32) | (u64)__builtin_amdgcn_readfirstlane((unsigned)wv);
                while (word) {
                    const int j = __builtin_ctzll(word); word &= word - 1ull;
                    const int s = g * 64 + j; const float pj = __expf(lg[s] - mx);
                    const unsigned v = *(const unsigned*)(KV + (size_t)(b * SEQL + s) * 128 + 2 * lane);
                    o0 += pj * bflo(v); o1 += pj * bfhi(v); sum += pj;
                }
            }
            const float inv = 1.0f / sum;
            *(unsigned*)(OAX + (size_t)t * 1024 + h * 128 + 2 * lane) = pkbf(o0 * inv, o1 * inv);
        }
    }
    __syncthreads();
#endif
#if DBG_CMP == 2
    {
        PH_LOCALS
        const float* g_ret = IN(5);
        bf16_t* OBX = (bf16_t*)(ws + WS_SPARE);
        float* qv = (float*)(lds_raw + wave * 10240); float* lg = qv + 512; float* wl = lg;
        for (int it = gw; it < T_TOK * 8; it += NGW) {
            const int t = it >> 3, h = it & 7, b = t >> 11, n = t & 2047, ng = (n >> 6) + 1;
            const float lgam = (h == 0) ? -0.04580368961312479f : (h == 1) ? -0.02272007650008353f : (h == 2) ? -0.011315313227834146f : (h == 3) ? -0.005646563141142063f :
                               (h == 4) ? -0.0028205190623786626f : (h == 5) ? -0.0014095702546713536f : (h == 6) ? -0.0007046129765893727f : -0.0003522634716290214f;
            { const unsigned v = *(const unsigned*)(P + (size_t)t * NPROJ + C_QR + h * 128 + 2 * lane); qv[2 * lane] = bflo(v); qv[2 * lane + 1] = bfhi(v); }
            float o0 = 0.f, o1 = 0.f;
            for (int g = 0; g < ng; ++g) {
                asm volatile("" ::: "memory");
                const int m = g * 64 + lane;
                const u32x4* kr = (const u32x4*)(P + (size_t)(b * SEQL + m) * NPROJ + C_KR + h * 128);
                float d0 = 0.f, d1 = 0.f, d2 = 0.f, d3 = 0.f;
#pragma unroll
                for (int c = 0; c < 16; ++c) { const u32x4 v = kr[c]; const f32x4 qa = *(const f32x4*)(qv + 8 * c), qb = *(const f32x4*)(qv + 8 * c + 4);
                    d0 += qa[0] * bflo(v.x) + qb[0] * bflo(v.z); d1 += qa[1] * bfhi(v.x) + qb[1] * bfhi(v.z); d2 += qa[2] * bflo(v.y) + qb[2] * bflo(v.w); d3 += qa[3] * bfhi(v.y) + qb[3] * bfhi(v.w); }
                const float dot = (d0 + d1) + (d2 + d3);
                wl[lane] = (m <= n) ? dot * exp2f((float)(n - m) * lgam) : 0.f;
                const int jmax = (g == ng - 1) ? (n & 63) : 63;
                for (int j = 0; j <= jmax; ++j) {
                    const float wj = wl[j];
                    const unsigned v = *(const unsigned*)(P + (size_t)(b * SEQL + g * 64 + j) * NPROJ + C_VR + h * 128 + 2 * lane);
                    o0 += wj * bflo(v); o1 += wj * bfhi(v);
                }
            }
            const float mu = wave_sum(o0 + o1, lane) * (1.0f / 128.0f); const float e0 = o0 - mu, e1 = o1 - mu;
            const float rs = 1.0f / sqrtf(wave_sum(e0 * e0 + e1 * e1, lane) * (1.0f / 128.0f) + EPS_F);
            const unsigned gv = *(const unsigned*)(P + (size_t)t * NPROJ + C_GR + h * 128 + 2 * lane);
            const float y0 = siluf_(bflo(gv)) * e0 * rs * g_ret[h * 128 + 2 * lane], y1 = siluf_(bfhi(gv)) * e1 * rs * g_ret[h * 128 + 2 * lane + 1];
            *(unsigned*)(OBX + (size_t)t * 1024 + h * 128 + 2 * lane) = pkbf(y0, y1);
        }
    }
    __syncthreads();
#endif
    {
        PH_LOCALS
        for (int pr = bx; pr < 256; pr += G) {
            const int b = pr >> 5, i = pr & 31;
#pragma unroll 1
            for (int uu = 0; uu < 2; ++uu) {
                const int qb = uu ? 63 - i : i; const int t0 = b * SEQL + qb * 32;
                fa::UnitArgs U; U.Q = P + (size_t)t0 * NPROJ + C_QLAT; U.ldq = NPROJ; U.K = KV + (size_t)b * SEQL * 128; U.V = U.K; U.ldk = 128; U.mask = MASK + (size_t)t0 * 32;
                U.ntiles = (qb >> 1) + 1; U.n0 = 0; U.lgam = 0.f;
                fa::f32x16 o[4]; float l_reg;
                fa::unit_body<0>((LAS char*)lds, U, tid, o, l_reg);
                const int r32 = lane & 31, hi = lane >> 5;
                const int trow0 = hide_i(t0 + 4 * hi);
                LAS float* li_l = (LAS float*)(lds + fa::OFF_WS) + wave * 64;
                if (hi == 0) li_l[r32] = l_reg;
                asm volatile("s_waitcnt lgkmcnt(0)" ::: "memory");
#pragma unroll
                for (int r = 0; r < 16; ++r) {
                    const int orow = fa::crow(r, hi); const float rl = __builtin_amdgcn_rcpf(li_l[orow]);
                    bf16_t* op = OA + (size_t)(trow0 + (r & 3) + 8 * (r >> 2)) * 2048 + wave * 128 + r32;
#pragma unroll
                    for (int d0 = 0; d0 < 4; ++d0) op[d0 * 32] = (bf16_t)(pkbf(o[d0][r] * rl, 0.f) & 0xffffu);
                }
                __syncthreads();
            }
        }
    }
    STAMP(20);
    {
        PH_LOCALS
        const float* g_ret = IN(5);
        for (int pr = bx; pr < 256; pr += G) {
            const int bh = pr >> 2, i = pr & 3, b = bh >> 3, h = bh & 7;
            const float lgam = (h == 0) ? -0.04580368961312479f : (h == 1) ? -0.02272007650008353f : (h == 2) ? -0.011315313227834146f : (h == 3) ? -0.005646563141142063f :
                               (h == 4) ? -0.0028205190623786626f : (h == 5) ? -0.0014095702546713536f : (h == 6) ? -0.0007046129765893727f : -0.0003522634716290214f;
#pragma unroll 1
            for (int uu = 0; uu < 2; ++uu) {
                const int qb = uu ? 7 - i : i; const int n0 = qb * 256;
                fa::UnitArgs U; U.Q = P + (size_t)(b * SEQL + n0) * NPROJ + C_QR + h * 128; U.ldq = NPROJ;
                U.K = P + (size_t)(b * SEQL) * NPROJ + C_KR + h * 128; U.V = P + (size_t)(b * SEQL) * NPROJ + C_VR + h * 128; U.ldk = NPROJ; U.mask = nullptr;
                U.ntiles = 4 * (qb + 1); U.n0 = n0; U.lgam = lgam;
                fa::f32x16 o[4]; float l_reg;
                fa::unit_body<1>((LAS char*)lds, U, tid, o, l_reg);
                const int r32 = lane & 31, hi = lane >> 5;
                const int tok0 = hide_i(b * SEQL + n0 + wave * 32 + 4 * hi);
                float gr[4];
#pragma unroll
                for (int d0 = 0; d0 < 4; ++d0) gr[d0] = g_ret[h * 128 + d0 * 32 + r32];
#pragma unroll
                for (int r = 0; r < 16; ++r) {
                    float s = (o[0][r] + o[1][r]) + (o[2][r] + o[3][r]);
#pragma unroll
                    for (int x = 1; x < 32; x <<= 1) s += shx(s, lane, x);
                    const float mu = s * (1.0f / 128.0f);
                    const float e0 = o[0][r] - mu, e1 = o[1][r] - mu, e2 = o[2][r] - mu, e3 = o[3][r] - mu;
                    float q = (e0 * e0 + e1 * e1) + (e2 * e2 + e3 * e3);
#pragma unroll
                    for (int x = 1; x < 32; x <<= 1) q += shx(q, lane, x);
                    const float rs = 1.0f / sqrtf(q * (1.0f / 128.0f) + EPS_F);
                    const size_t tok = (size_t)(tok0 + (r & 3) + 8 * (r >> 2));
                    const bf16_t* gp = P + tok * NPROJ + C_GR + h * 128 + r32; bf16_t* op = OB + tok * 2048 + h * 128 + r32;
                    op[0] = (bf16_t)(pkbf(siluf_(bflo((unsigned)gp[0])) * e0 * rs * gr[0], 0.f) & 0xffffu);
                    op[32] = (bf16_t)(pkbf(siluf_(bflo((unsigned)gp[32])) * e1 * rs * gr[1], 0.f) & 0xffffu);
                    op[64] = (bf16_t)(pkbf(siluf_(bflo((unsigned)gp[64])) * e2 * rs * gr[2], 0.f) & 0xffffu);
                    op[96] = (bf16_t)(pkbf(siluf_(bflo((unsigned)gp[96])) * e3 * rs * gr[3], 0.f) & 0xffffu);
                }
                __syncthreads();
            }
        }
    }
#if DBG_CMP
    XBAR();
    {
        PH_LOCALS
        const bf16_t* A_ = (DBG_CMP == 1) ? OA : OB; const bf16_t* R_ = (const bf16_t*)(ws + WS_SPARE);
        float sd = 0.f, sr = 0.f;
#if DBG_CMP == 3
        for (size_t i = (size_t)gtid; i < (size_t)T_TOK * 32; i += (size_t)NGT) { const u64 a = MASK[i], r = ((const u64*)(ws + WS_SPARE))[i]; sd += (float)__popcll(a ^ r); sr += 100.0f * (float)__popcll(r); }
#else
        for (size_t i = (size_t)gtid; i < (size_t)T_TOK * 1024 / 2; i += (size_t)NGT) {
            const unsigned a = ((const unsigned*)A_)[(i >> 9) * 1024 + (i & 511)], r = ((const unsigned*)R_)[i];
            const float d0 = bflo(a) - bflo(r), d1 = bfhi(a) - bfhi(r); sd += d0 * d0 + d1 * d1; sr += bflo(r) * bflo(r) + bfhi(r) * bfhi(r);
        }
#endif
        sd = wave_sum(sd, lane); sr = wave_sum(sr, lane);
        if (lane == 0) { atomicAdd((float*)(ctl + 4096), sd); atomicAdd((float*)(ctl + 4097), sr); }
    }
#endif
    XBAR();
    STAMP(4);

    {
        PH_LOCALS
        pg8::Gemm g{OA, WCOMB, T_TOK, DMODEL, 2048}; pg8::StaticOrder S; S.init(T_TOK, DMODEL, G, bx);
        pg8::EpiMergeF E{P, MIXED};
        pg8::gemm_phase<pg8::EpiMergeF, pg8::StaticOrder, true, true>(lds, g, S, E, tid);
    }
    XBAR();
    STAMP(5);
    {
        PH_LOCALS
        const float* x = IN(0);
        pg8::Gemm g{MIXED, WO, T_TOK, DMODEL, 2048}; pg8::StaticOrder S; S.init(T_TOK, DMODEL, G, bx);
        pg8::EpiRes E{x, out};
        pg8::gemm_phase<pg8::EpiRes, pg8::StaticOrder, true, true>(lds, g, S, E, tid);
    }
    XBAR();
    STAMP(7);

    {
    PH_LOCALS
    const float* g_ffn = IN(8); const float* b_rg = IN(10); const float* b_re = IN(12);
    const f32x4* WC4 = (const f32x4*)(ws + WS_WC); float* tok_rs = (float*)(ws + WS_WC + 786432);
    LAS float* lg = (LAS float*)lds + wave * (16 * 52);
    const int row = lane & 15, g4 = lane >> 4;
    LAS float* part = (LAS float*)lds + 4 * (16 * 52) + (wave & 3) * (13 * 64);
    for (int tile0 = bx * 4; tile0 < T_TOK / 16; tile0 += G * 4) {
        const int tile = tile0 + (wave & 3), kh = wave >> 2;
        const int tok0 = tile * 16;
        const float* hrow = out + (size_t)(tok0 + row) * DMODEL + 8 * g4 + 1024 * kh;
        bf16_t* trow = TN + (size_t)(tok0 + row) * DMODEL + 8 * g4 + 1024 * kh;
        const f32x4* wp = WC4 + (size_t)g4 * 96 + 2 * row + (size_t)kh * 32 * 384;
        const float* gp = g_ffn + 8 * g4 + 1024 * kh;
        f32x4 acc0 = (f32x4){0.f, 0.f, 0.f, 0.f}, acc1 = acc0, acc2 = acc0; float ssq = 0.f;
        f32x4 a0 = *(const f32x4*)(hrow), a1 = *(const f32x4*)(hrow + 4);
        f32x4 b00 = wp[0], b01 = wp[1], b10 = wp[32], b11 = wp[33], b20 = wp[64], b21 = wp[65];
        f32x4 na0 = *(const f32x4*)(hrow + 32), na1 = *(const f32x4*)(hrow + 36);
        f32x4 nb00 = wp[384], nb01 = wp[385], nb10 = wp[416], nb11 = wp[417], nb20 = wp[448], nb21 = wp[449];
        for (int it = 0; it < 32; ++it) {
            const int itn = (it + 2 < 32) ? it + 2 : 31;
            const f32x4 ma0 = *(const f32x4*)(hrow + 32 * itn), ma1 = *(const f32x4*)(hrow + 32 * itn + 4);
            const f32x4* wn = wp + (size_t)itn * 384;
            const f32x4 mb00 = wn[0], mb01 = wn[1], mb10 = wn[32], mb11 = wn[33], mb20 = wn[64], mb21 = wn[65];
            const f32x4 gk0 = *(const f32x4*)(gp + 32 * it), gk1 = *(const f32x4*)(gp + 32 * it + 4);
            ssq += (a0[0] * a0[0] + a0[1] * a0[1]) + (a0[2] * a0[2] + a0[3] * a0[3]) + (a1[0] * a1[0] + a1[1] * a1[1]) + (a1[2] * a1[2] + a1[3] * a1[3]);
            { u32x4 w; w.x = pkbf(a0[0] * gk0[0], a0[1] * gk0[1]); w.y = pkbf(a0[2] * gk0[2], a0[3] * gk0[3]); w.z = pkbf(a1[0] * gk1[0], a1[1] * gk1[1]); w.w = pkbf(a1[2] * gk1[2], a1[3] * gk1[3]);
              *(u32x4*)(trow + 32 * it) = w; }
#pragma unroll
            for (int s_ = 0; s_ < 4; ++s_) {
                acc0 = __builtin_amdgcn_mfma_f32_16x16x4f32(a0[s_], b00[s_], acc0, 0, 0, 0);
                acc1 = __builtin_amdgcn_mfma_f32_16x16x4f32(a0[s_], b10[s_], acc1, 0, 0, 0);
                acc2 = __builtin_amdgcn_mfma_f32_16x16x4f32(a0[s_], b20[s_], acc2, 0, 0, 0);
            }
#pragma unroll
            for (int s_ = 0; s_ < 4; ++s_) {
                acc0 = __builtin_amdgcn_mfma_f32_16x16x4f32(a1[s_], b01[s_], acc0, 0, 0, 0);
                acc1 = __builtin_amdgcn_mfma_f32_16x16x4f32(a1[s_], b11[s_], acc1, 0, 0, 0);
                acc2 = __builtin_amdgcn_mfma_f32_16x16x4f32(a1[s_], b21[s_], acc2, 0, 0, 0);
            }
            a0 = na0; a1 = na1; b00 = nb00; b01 = nb01; b10 = nb10; b11 = nb11; b20 = nb20; b21 = nb21;
            na0 = ma0; na1 = ma1; nb00 = mb00; nb01 = mb01; nb10 = mb10; nb11 = mb11; nb20 = mb20; nb21 = mb21;
        }
        if (kh == 1) {
#pragma unroll
            for (int r = 0; r < 4; ++r) { part[r * 64 + lane] = acc0[r]; part[(4 + r) * 64 + lane] = acc1[r]; part[(8 + r) * 64 + lane] = acc2[r]; }
            part[12 * 64 + lane] = ssq;
        }
        __syncthreads();
        if (kh == 0) {
#pragma unroll
            for (int r = 0; r < 4; ++r) { acc0[r] += part[r * 64 + lane]; acc1[r] += part[(4 + r) * 64 + lane]; acc2[r] += part[(8 + r) * 64 + lane]; }
            ssq += part[12 * 64 + lane];
        ssq += shx(ssq, lane, 16); ssq += shx(ssq, lane, 32);
        const float rstd = 1.0f / sqrtf(ssq * (1.0f / DMODEL) + EPS_F);
#pragma unroll
        for (int r = 0; r < 4; ++r) { lg[(4 * g4 + r) * 52 + row] = acc0[r]; lg[(4 * g4 + r) * 52 + 16 + row] = acc1[r]; lg[(4 * g4 + r) * 52 + 32 + row] = acc2[r]; }
        asm volatile("s_waitcnt lgkmcnt(0)" ::: "memory");
        if (lane < 16) {
            const int t = tok0 + lane; const LAS float* lr = lg + lane * 52;
            float gl[4];
#pragma unroll
            for (int k = 0; k < 4; ++k) gl[k] = lr[k] * rstd + b_rg[k];
            int grp = 0; float gmx = gl[0];
#pragma unroll
            for (int k = 1; k < 4; ++k) if (gl[k] > gmx) { gmx = gl[k]; grp = k; }
            float gz = 0.f;
#pragma unroll
            for (int k = 0; k < 4; ++k) gz += __expf(gl[k] - gmx);
            const float p_grp = 1.0f / gz;
            float el[8];
#pragma unroll
            for (int k = 0; k < 8; ++k) el[k] = lr[4 + grp * 8 + k] * rstd + b_re[grp * 8 + k];
            int i1 = 0; float m1 = el[0];
#pragma unroll
            for (int k = 1; k < 8; ++k) if (el[k] > m1) { m1 = el[k]; i1 = k; }
            int i2 = -1; float m2 = -INFINITY;
#pragma unroll
            for (int k = 0; k < 8; ++k) if (k != i1 && el[k] > m2) { m2 = el[k]; i2 = k; }
            const float e2 = __expf(m2 - m1); const float den = 1.0f / (1.0f + e2);
            const float g1 = p_grp * den, g2 = p_grp * e2 * den;
            const int ex1 = grp * 8 + i1, ex2 = grp * 8 + i2;
            const unsigned r1 = atomicAdd(ctl + 64 * ex1, 1u), r2 = atomicAdd(ctl + 64 * ex2, 1u);
            asg_e[2 * t] = ex1; asg_e[2 * t + 1] = ex2; asg_r[2 * t] = (int)r1; asg_r[2 * t + 1] = (int)r2; asg_g[2 * t] = g1; asg_g[2 * t + 1] = g2;
            tok_rs[t] = rstd;
        }
        }
        __syncthreads();
    }
    }
    XBAR();
    STAMP(8);

    LAS int* tile_start = (LAS int*)(lds + LDS_MISC);
    {
    PH_LOCALS
    if (tid == 0) {
        int acc_t = 0;
        for (int e = 0; e < 32; ++e) { tile_start[e] = acc_t; const int c = (int)__hip_atomic_load(ctl + 64 * e, __ATOMIC_RELAXED, __HIP_MEMORY_SCOPE_AGENT); acc_t += (c + 255) >> 8; }
        tile_start[32] = acc_t;
    }
    __syncthreads();
    for (int a = gw; a < 2 * T_TOK; a += NGW) {
        const int t = a >> 1; const int e = asg_e[a], rk = asg_r[a]; const int slot = tile_start[e] * 256 + rk;
        if (lane == 0) { row_tok[slot] = t; row_gate[slot] = asg_g[a]; tok_slot[a] = slot; ((float*)(ws + WS_WC + 524288))[slot] = ((const float*)(ws + WS_WC + 786432))[t]; }
        const u32x4* src = (const u32x4*)(TN + (size_t)t * DMODEL) + lane; u32x4* dst = (u32x4*)(XG + (size_t)slot * DMODEL) + lane;
#pragma unroll
        for (int j = 0; j < 4; ++j) dst[64 * j] = src[64 * j];
    }
    }
    XBAR();
    STAMP(9);

    {
        PH_LOCALS
        pg8::Gemm g{XG, WGU, MAXSLOT, 2048, 2048}; pg8::ExpertOrder S{tile_start, G, bx};
        pg8::EpiSwiglu E{HMID, (const float*)(ws + WS_WC + 524288)};
        pg8::gemm_phase<pg8::EpiSwiglu, pg8::ExpertOrder, true, true>(lds, g, S, E, tid);
    }
    XBAR();
    STAMP(10);
    {
        PH_LOCALS
        pg8::Gemm g{HMID, WD, MAXSLOT, 2048, 1024}; pg8::ExpertOrder S{tile_start, G, bx};
        pg8::EpiDown E{Y, row_gate};
        pg8::gemm_phase<pg8::EpiDown, pg8::ExpertOrder, true, true>(lds, g, S, E, tid);
    }
    XBAR();
    STAMP(11);

    {
    PH_LOCALS
    const float* g_fin = IN(16);
#if DBG_CMP
    const float dbg_scale = 1.0f + 4.0f * sqrtf(__hip_atomic_load((float*)(ctl + 4096), __ATOMIC_RELAXED, __HIP_MEMORY_SCOPE_AGENT) / __hip_atomic_load((float*)(ctl + 4097), __ATOMIC_RELAXED, __HIP_MEMORY_SCOPE_AGENT));
#elif PROF_PHASE >= 0
    const unsigned ta_ = __hip_atomic_load(ctl + 6000 + (PROF_PHASE / 100), __ATOMIC_RELAXED, __HIP_MEMORY_SCOPE_AGENT), tb_ = __hip_atomic_load(ctl + 6000 + (PROF_PHASE % 100), __ATOMIC_RELAXED, __HIP_MEMORY_SCOPE_AGENT);
    const float dbg_scale = 1.0f + sqrtf(4e-6f * (float)(tb_ - ta_) * 0.01f);
#else
    const float dbg_scale = 1.0f;
#endif
    for (int t = gw; t < T_TOK; t += 2 * NGW) {
        const int t1 = (t + NGW < T_TOK) ? t + NGW : t;
        const int sa0 = tok_slot[2 * t], sa1 = tok_slot[2 * t + 1], sb0 = tok_slot[2 * t1], sb1 = tok_slot[2 * t1 + 1];
        f32x4* hra = (f32x4*)(out + (size_t)t * DMODEL) + lane; f32x4* hrb = (f32x4*)(out + (size_t)t1 * DMODEL) + lane;
        const u32x2* ya0 = (const u32x2*)(Y + (size_t)sa0 * DMODEL) + lane; const u32x2* ya1 = (const u32x2*)(Y + (size_t)sa1 * DMODEL) + lane;
        const u32x2* yb0 = (const u32x2*)(Y + (size_t)sb0 * DMODEL) + lane; const u32x2* yb1 = (const u32x2*)(Y + (size_t)sb1 * DMODEL) + lane;
        f32x4 va[8], vb[8]; u32x2 pa[8], qa[8], pb[8], qb[8];
#pragma unroll
        for (int j = 0; j < 8; ++j) { va[j] = hra[64 * j]; vb[j] = hrb[64 * j]; pa[j] = ya0[64 * j]; qa[j] = ya1[64 * j]; pb[j] = yb0[64 * j]; qb[j] = yb1[64 * j]; }
        float ssa = 0.f, ssb = 0.f;
#pragma unroll
        for (int j = 0; j < 8; ++j) {
            va[j][0] += bflo(pa[j].x) + bflo(qa[j].x); va[j][1] += bfhi(pa[j].x) + bfhi(qa[j].x); va[j][2] += bflo(pa[j].y) + bflo(qa[j].y); va[j][3] += bfhi(pa[j].y) + bfhi(qa[j].y);
            vb[j][0] += bflo(pb[j].x) + bflo(qb[j].x); vb[j][1] += bfhi(pb[j].x) + bfhi(qb[j].x); vb[j][2] += bflo(pb[j].y) + bflo(qb[j].y); vb[j][3] += bfhi(pb[j].y) + bfhi(qb[j].y);
            ssa += (va[j][0] * va[j][0] + va[j][1] * va[j][1]) + (va[j][2] * va[j][2] + va[j][3] * va[j][3]);
            ssb += (vb[j][0] * vb[j][0] + vb[j][1] * vb[j][1]) + (vb[j][2] * vb[j][2] + vb[j][3] * vb[j][3]);
        }
        const float ra = dbg_scale / sqrtf(wave_sum(ssa, lane) * (1.0f / DMODEL) + EPS_F), rb = dbg_scale / sqrtf(wave_sum(ssb, lane) * (1.0f / DMODEL) + EPS_F);
#pragma unroll
        for (int j = 0; j < 8; ++j) { const f32x4 gg = ((const f32x4*)g_fin)[lane + 64 * j]; hra[64 * j] = va[j] * ra * gg; if (t1 != t) hrb[64 * j] = vb[j] * rb * gg; }
    }
    }
}

extern "C" void kernel_launch(void* const* d_in, const int* in_sizes, int n_in, void* d_out, int out_size, void* d_ws, size_t ws_size, hipStream_t stream) {
    static int grid_blocks = 0;
    if (grid_blocks == 0) {
        if (n_in != 17 || out_size != T_TOK * DMODEL || ws_size < WS_END) { fprintf(stderr, "kernel_launch: unexpected problem (n_in %d, out %d, ws %zu < %zu)\n", n_in, out_size, ws_size, (size_t)WS_END); grid_blocks = -1; return; }
        int dev = 0, cus = 0, per_cu = 0;
        (void)hipGetDevice(&dev);
        (void)hipDeviceGetAttribute(&cus, hipDeviceAttributeMultiprocessorCount, dev);
        if (hipFuncSetAttribute((const void*)mega_fwd, hipFuncAttributeMaxDynamicSharedMemorySize, LDS_BYTES) != hipSuccess) { fprintf(stderr, "kernel_launch: hipFuncSetAttribute failed\n"); grid_blocks = -1; return; }
        if (hipOccupancyMaxActiveBlocksPerMultiprocessor(&per_cu, (const void*)mega_fwd, 512, LDS_BYTES) != hipSuccess || per_cu < 1) { fprintf(stderr, "kernel_launch: occupancy query says %d\n", per_cu); grid_blocks = -1; return; }
        grid_blocks = cus;
        fprintf(stderr, "kernel_launch: cus %d per_cu %d grid %d ws %zu need %zu\n", cus, per_cu, grid_blocks, ws_size, (size_t)WS_END);
    }
    if (grid_blocks < 0) return;
    if (hipMemsetAsync((char*)d_ws + WS_CTL, 0, 65536, stream) != hipSuccess) { fprintf(stderr, "kernel_launch: memset of control words failed\n"); return; }
    Params prm{};
    for (int i = 0; i < 17; ++i) prm.in[i] = (const float*)d_in[i];
    prm.out = (float*)d_out; prm.ws = (unsigned char*)d_ws;
    void* args[] = {&prm};
    hipError_t e = hipLaunchCooperativeKernel((void*)mega_fwd, dim3(grid_blocks), dim3(512), args, LDS_BYTES, stream);
    if (e != hipSuccess) fprintf(stderr, "cooperative launch failed: %s (grid %d)\n", hipGetErrorString(e), grid_blocks);
}
```

```cpp
#include <hip/hip_runtime.h>
#include <hip/hip_cooperative_groups.h>
#include <cstdio>
#include <cstdint>
namespace cg = cooperative_groups;
namespace pg8 {
#define PG8_LAS __attribute__((address_space(3)))
typedef unsigned short bf16_t;
typedef short bf16x8 __attribute__((ext_vector_type(8)));
typedef float f32x4 __attribute__((ext_vector_type(4)));
typedef unsigned u32x4 __attribute__((ext_vector_type(4)));
constexpr int BM = 256, BK = 64, HALF = 128, HTB = HALF * BK * 2  , STAGE_BYTES = 8 * HTB, NXCD = 8, WGM = 8;

__host__ __device__ __forceinline__ int lds_byte(int r, int c) { const int st = (r >> 4) * 2 + (c >> 5), rr = r & 15, cc = c & 31, ob = rr * 64 + cc * 2; return st * 1024 + (ob ^ (((ob >> 9) & 1) << 5)); }
__host__ __device__ __forceinline__ void stage_rc(int b, int& R, int& C) { const int st = b / 1024, sb = b % 1024, swz = sb ^ (((sb >> 9) & 1) << 5); R = (st >> 1) * 16 + swz / 64; C = (st & 1) * 32 + (swz % 64) / 2; }
__host__ __device__ __forceinline__ int perm32(int rho) { const int n = rho >> 4, i = rho & 15; return 8 * (i >> 2) + 4 * n + (i & 3); }

struct Unit { int pm, pn, e; };
struct Gemm { const bf16_t* A; const bf16_t* Bt; int M, N, K; };

struct StaticOrder {
    int nM, nN, nwg, G, c;
    __host__ __device__ void init(int M, int N, int G_, int c_) { nM = M / BM; nN = N / BM; nwg = nM * nN; G = G_; c = c_; }
    __host__ __device__ bool next(int i, Unit& u) const {
        const long L = (long)i * G + c; if (L >= nwg) return false;
        int wgid = (int)L; { const int q = nwg / NXCD, r = nwg % NXCD, xcd = wgid % NXCD, off = wgid / NXCD; wgid = (xcd < r ? xcd * (q + 1) : r * (q + 1) + (xcd - r) * q) + off; }
        const int nig = WGM * nN, gid = wgid / nig, fm = gid * WGM, gsz = (nM - fm) < WGM ? (nM - fm) : WGM;
        u.pm = fm + ((wgid % nig) % gsz); u.pn = (wgid % nig) / gsz; u.e = 0; return true;
    }
    static constexpr bool GATHER = false;
    __device__ __forceinline__ unsigned rowoff(int) const { return 0u; }
    __device__ __forceinline__ void a_ready(const Unit&) const {}
    __device__ __forceinline__ void done(const Unit&) const {}
};

template <class Epi, class Sched, bool ALIGN_EPI = false, bool SP2 = false>
__device__ __forceinline__ void gemm_phase(PG8_LAS unsigned char* lds, const Gemm g, const Sched& S, const Epi& E, const int tid) {
    const int wid = __builtin_amdgcn_readfirstlane(tid >> 6), lane = tid & 63, wr = wid >> 2, wc = wid & 3, fr = lane & 15, fq = lane >> 4;
    const int K = g.K, nt = K / BK;
    constexpr bool GA = Sched::GATHER;
    static_assert(!GA || SP2, "the gather path is written for the SP2 loop");
    unsigned voffA[2], voffB[2]; int gR[2], gC[2];
#pragma unroll
    for (int i = 0; i < 2; ++i) { int R, C; stage_rc(tid * 16 + i * 8192, R, C); const int Rb = Epi::PERM ? ((R & ~31) + perm32(R & 31)) : R;
        voffA[i] = (unsigned)(R * K + C) * 2u; voffB[i] = (unsigned)(Rb * K + C) * 2u; gR[i] = R; gC[i] = C; }
    unsigned cvo0[2] = {0u, 0u}, cvo1[2] = {0u, 0u}, nvo0[2] = {0u, 0u}, nvo1[2] = {0u, 0u}, sel0[2] = {0u, 0u}, sel1[2] = {0u, 0u};
#define PG8_GOFF(u_, o0_, o1_) do { _Pragma("unroll") for (int _i = 0; _i < 2; ++_i) { \
        o0_[_i] = S.rowoff((u_).pm * BM + gR[_i]) * (unsigned)(K * 2) + (unsigned)gC[_i] * 2u; o1_[_i] = S.rowoff((u_).pm * BM + HALF + gR[_i]) * (unsigned)(K * 2) + (unsigned)gC[_i] * 2u; } } while (0)
#define PG8_STAGE_A(bufoff, base, h_, CUR_) do { if constexpr (GA) { if (CUR_) { if (h_) PG8_STAGE(bufoff, base, cvo1); else PG8_STAGE(bufoff, base, cvo0); } else { if (h_) PG8_STAGE(bufoff, base, sel1); else PG8_STAGE(bufoff, base, sel0); } } \
        else PG8_STAGE(bufoff, (base) + (h_) * hstep, voffA); } while (0)
    const size_t kstep = (size_t)(BK * 2);
    const size_t hstep = (size_t)HALF * K * 2;
    const size_t tstep = 2 * hstep;
    const unsigned ldsw = (unsigned)wid * 1024u;
    const int aoff = lds_byte(wr * 64 + fr, fq * 8), boff = lds_byte(wc * 32 + fr, fq * 8);
#define PG8_SA(b, h) (((b) * 2 + (h)) * HTB)
#define PG8_SB(b, h) ((4 + (b) * 2 + (h)) * HTB)
#define PG8_STAGE(bufoff, gbase, voff) do { _Pragma("unroll") for (int _i = 0; _i < 2; ++_i) \
        __builtin_amdgcn_global_load_lds((const unsigned*)((const char*)(gbase) + (voff)[_i]), (PG8_LAS unsigned*)(lds + (bufoff) + ldsw + _i * 8192), 16, 0, 0); } while (0)
#define PG8_LDA(dst, b, h) do { _Pragma("unroll") for (int m = 0; m < 4; ++m) _Pragma("unroll") for (int k = 0; k < 2; ++k) dst[m][k] = *(const PG8_LAS bf16x8*)(lds + PG8_SA(b, h) + aoff + m * 2048 + k * 1024); } while (0)
#define PG8_LDB(dst, b, h) do { _Pragma("unroll") for (int n = 0; n < 2; ++n) _Pragma("unroll") for (int k = 0; k < 2; ++k) dst[n][k] = *(const PG8_LAS bf16x8*)(lds + PG8_SB(b, h) + boff + n * 2048 + k * 1024); } while (0)
#define PG8_MMA(ai, bj, At, Bt) do { __builtin_amdgcn_s_setprio(1); _Pragma("unroll") for (int m = 0; m < 4; ++m) _Pragma("unroll") for (int n = 0; n < 2; ++n) _Pragma("unroll") for (int k = 0; k < 2; ++k) \
        acc[ai][bj][m][n] = __builtin_amdgcn_mfma_f32_16x16x32_bf16(Bt[n][k], At[m][k], acc[ai][bj][m][n], 0, 0, 0); __builtin_amdgcn_s_setprio(0); } while (0)
#define PG8_WAIT_V(n) asm volatile("s_waitcnt vmcnt(" #n ")" ::: "memory")
#define PG8_WAIT_L(n) asm volatile("s_waitcnt lgkmcnt(" #n ")" ::: "memory")
#define PG8_BAR __builtin_amdgcn_s_barrier()
#define PG8_SCHED __builtin_amdgcn_sched_barrier(0)
    Unit cur, nxt; int ui = 0;
    if (!S.next(0, cur)) return;
    f32x4 acc[2][2][4][2];
#pragma unroll
    for (int a = 0; a < 2; ++a)
#pragma unroll
        for (int b = 0; b < 2; ++b)
#pragma unroll
            for (int m = 0; m < 4; ++m)
#pragma unroll
                for (int n = 0; n < 2; ++n) acc[a][b][m][n] = (f32x4){0.f, 0.f, 0.f, 0.f};
    bf16x8 At[4][2], B0[2][2], B1[2][2];
    const size_t estep = (size_t)g.N * K * 2;
    const char* cA = (const char*)g.A + (GA ? (size_t)0 : (size_t)cur.pm * tstep); const char* cB = (const char*)g.Bt + (size_t)cur.e * estep + (size_t)cur.pn * tstep;
    S.a_ready(cur);
    if constexpr (GA) PG8_GOFF(cur, cvo0, cvo1);
    if constexpr (SP2) {
        PG8_STAGE(PG8_SB(0, 0), cB, voffB); PG8_STAGE(PG8_SB(0, 1), cB + hstep, voffB); PG8_STAGE_A(PG8_SA(0, 0), cA, 0, true); PG8_STAGE_A(PG8_SA(0, 1), cA, 1, true);
        if (wr == 1) PG8_BAR;
        PG8_WAIT_V(2); PG8_BAR;
        PG8_STAGE(PG8_SB(1, 0), cB + kstep, voffB); PG8_STAGE_A(PG8_SA(1, 0), cA + kstep, 0, true); PG8_STAGE(PG8_SB(1, 1), cB + hstep + kstep, voffB);
        PG8_WAIT_V(6); PG8_BAR;
    } else {
        PG8_STAGE(PG8_SB(0, 0), cB, voffB); PG8_STAGE(PG8_SA(0, 0), cA, voffA); PG8_STAGE(PG8_SB(0, 1), cB + hstep, voffB); PG8_STAGE(PG8_SA(0, 1), cA + hstep, voffA);
        if (wr == 1) PG8_BAR;
        PG8_WAIT_V(4); PG8_BAR;
        PG8_STAGE(PG8_SB(1, 0), cB + kstep, voffB); PG8_STAGE(PG8_SA(1, 0), cA + kstep, voffA); PG8_STAGE(PG8_SB(1, 1), cB + hstep + kstep, voffB);
        PG8_WAIT_V(6); PG8_BAR;
    }
    for (;;) {
        const bool has_next = S.next(ui + 1, nxt);
        const char* nA = has_next ? (const char*)g.A + (GA ? (size_t)0 : (size_t)nxt.pm * tstep) : cA;
        if constexpr (GA) { if (has_next) PG8_GOFF(nxt, nvo0, nvo1); else { nvo0[0] = cvo0[0]; nvo0[1] = cvo0[1]; nvo1[0] = cvo1[0]; nvo1[1] = cvo1[1]; } } const char* nB = has_next ? (const char*)g.Bt + (size_t)nxt.e * estep + (size_t)nxt.pn * tstep : cB;
        for (int t = 0; t < nt; t += 2) {
            const bool last = (t == nt - 2);
            const char* a1 = cA + (size_t)(t + 1) * kstep;
            const char* a2 = last ? nA : cA + (size_t)(t + 2) * kstep; const char* b2 = last ? nB : cB + (size_t)(t + 2) * kstep;
            const char* a3 = a2 + kstep; const char* b3 = b2 + kstep;
            if (last && has_next) S.a_ready(nxt);
            if constexpr (GA) { sel0[0] = last ? nvo0[0] : cvo0[0]; sel0[1] = last ? nvo0[1] : cvo0[1]; sel1[0] = last ? nvo1[0] : cvo1[0]; sel1[1] = last ? nvo1[1] : cvo1[1]; }
            if constexpr (Epi::HAS_MID) { if (t == nt / 2) E.mid(acc, cur, wr, wc, fr, fq); }
            if constexpr (SP2) {
            PG8_LDB(B0, 0, 0); PG8_LDB(B1, 0, 1); PG8_SCHED; PG8_LDA(At, 0, 0); PG8_STAGE_A(PG8_SA(1, 1), a1, 1, true);
            PG8_WAIT_V(8); PG8_WAIT_L(0); PG8_BAR; PG8_MMA(0, 0, At, B0); PG8_MMA(0, 1, At, B1); PG8_BAR; PG8_SCHED;
            PG8_LDA(At, 0, 1); PG8_STAGE(PG8_SB(0, 0), b2, voffB); PG8_STAGE(PG8_SB(0, 1), b2 + hstep, voffB); PG8_STAGE_A(PG8_SA(0, 0), a2, 0, false);
            PG8_WAIT_V(8); PG8_WAIT_L(0); PG8_BAR; PG8_MMA(1, 0, At, B0); PG8_MMA(1, 1, At, B1); PG8_BAR; PG8_SCHED;
            PG8_LDB(B0, 1, 0); PG8_LDB(B1, 1, 1); PG8_SCHED; PG8_LDA(At, 1, 0); PG8_STAGE_A(PG8_SA(0, 1), a2, 1, false);
            PG8_WAIT_V(8); PG8_WAIT_L(0); PG8_BAR; PG8_MMA(0, 0, At, B0); PG8_MMA(0, 1, At, B1); PG8_BAR; PG8_SCHED;
            PG8_LDA(At, 1, 1); PG8_STAGE(PG8_SB(1, 0), b3, voffB); PG8_STAGE(PG8_SB(1, 1), b3 + hstep, voffB); PG8_STAGE_A(PG8_SA(1, 0), a3, 0, false);
            PG8_WAIT_V(8); PG8_WAIT_L(0); PG8_BAR; PG8_MMA(1, 0, At, B0); PG8_MMA(1, 1, At, B1); PG8_BAR; PG8_SCHED;
            } else {
            PG8_LDB(B0, 0, 0); PG8_SCHED; PG8_LDA(At, 0, 0); PG8_STAGE(PG8_SA(1, 1), a1 + hstep, voffA);
            PG8_WAIT_L(8); PG8_BAR; PG8_WAIT_L(0); PG8_MMA(0, 0, At, B0); PG8_BAR; PG8_SCHED;
            PG8_LDB(B1, 0, 1); PG8_STAGE(PG8_SB(0, 0), b2, voffB);
            PG8_BAR; PG8_WAIT_L(0); PG8_MMA(0, 1, At, B1); PG8_BAR;
            PG8_LDA(At, 0, 1); PG8_STAGE(PG8_SA(0, 0), a2, voffA);
            PG8_BAR; PG8_WAIT_L(0); PG8_MMA(1, 0, At, B0); PG8_BAR; PG8_SCHED;
            PG8_STAGE(PG8_SB(0, 1), b2 + hstep, voffB);
            PG8_WAIT_V(6); PG8_BAR; PG8_MMA(1, 1, At, B1); PG8_BAR;
            PG8_LDB(B0, 1, 0); PG8_SCHED; PG8_LDA(At, 1, 0); PG8_STAGE(PG8_SA(0, 1), a2 + hstep, voffA);
            PG8_WAIT_L(8); PG8_BAR; PG8_WAIT_L(0); PG8_MMA(0, 0, At, B0); PG8_BAR; PG8_SCHED;
            PG8_LDB(B1, 1, 1); PG8_STAGE(PG8_SB(1, 0), b3, voffB);
            PG8_BAR; PG8_WAIT_L(0); PG8_MMA(0, 1, At, B1); PG8_BAR;
            PG8_LDA(At, 1, 1); PG8_STAGE(PG8_SA(1, 0), a3, voffA);
            PG8_BAR; PG8_WAIT_L(0); PG8_MMA(1, 0, At, B0); PG8_BAR; PG8_SCHED;
            PG8_STAGE(PG8_SB(1, 1), b3 + hstep, voffB);
            PG8_WAIT_V(6); PG8_BAR; PG8_MMA(1, 1, At, B1); PG8_BAR;
            }
        }
        if constexpr (ALIGN_EPI) { if (wr == 0) PG8_BAR; }
        if constexpr (!Epi::AFTER_DRAIN) { E(acc, cur, wr, wc, fr, fq); S.done(cur); }
        if (!has_next) break;
#pragma unroll
        for (int a = 0; a < 2; ++a)
#pragma unroll
            for (int b = 0; b < 2; ++b)
#pragma unroll
                for (int m = 0; m < 4; ++m)
#pragma unroll
                    for (int n = 0; n < 2; ++n) acc[a][b][m][n] = (f32x4){0.f, 0.f, 0.f, 0.f};
        cur = nxt; cA = nA; cB = nB; ++ui;
        if constexpr (GA) { cvo0[0] = nvo0[0]; cvo0[1] = nvo0[1]; cvo1[0] = nvo1[0]; cvo1[1] = nvo1[1]; }
        if constexpr (ALIGN_EPI) { if (wr == 1) PG8_BAR; }
    }
    PG8_WAIT_V(0);
    if constexpr (!ALIGN_EPI) { if (wr == 0) PG8_BAR; }
    PG8_BAR;
    if constexpr (Epi::AFTER_DRAIN) { E.fused(acc, cur, wr, wc, fr, fq, lds, wid, lane); S.done(cur); }
#undef PG8_SA
#undef PG8_SB
#undef PG8_STAGE
#undef PG8_STAGE_A
#undef PG8_GOFF
#undef PG8_LDA
#undef PG8_LDB
#undef PG8_MMA
#undef PG8_WAIT_V
#undef PG8_WAIT_L
#undef PG8_BAR
#undef PG8_SCHED
}
}

#ifndef DBG_CMP
#define DBG_CMP 0
#endif
#define LAS __attribute__((address_space(3)))
typedef unsigned short bf16_t;
typedef float f32x4 __attribute__((ext_vector_type(4)));
typedef unsigned u32x4 __attribute__((ext_vector_type(4)));
typedef unsigned u32x2 __attribute__((ext_vector_type(2)));
typedef unsigned long long u64;

constexpr int T_TOK = 16384, DMODEL = 2048, SEQL = 2048;
constexpr int NPROJ = 9984;
constexpr int C_QLAT = 0, C_CKV = 1024, C_QIDX = 1152, C_KIDX = 1664, C_WIDX = 1728, C_QR = 1792, C_KR = 2816, C_VR = 3840, C_GR = 4864, C_GBR = 5888;
constexpr int MAXSLOT = 40960;
constexpr float EPS_F = 1e-6f;
constexpr float IDX_SCALE = 0.04419417382415922f;
constexpr float ATT_SCALE = 0.08838834764831845f;
constexpr float K_SCALE = 0.08838834764831845f;

constexpr size_t WS_CTL = 0;
constexpr size_t WS_ROT = 65536;
constexpr size_t WS_WIN = WS_ROT + 1048576;
constexpr size_t WS_WCOMB = WS_WIN + (size_t)NPROJ * 2048 * 2;
constexpr size_t WS_WB = WS_WCOMB + (size_t)2048 * 1024 * 2;
constexpr size_t WS_WO = WS_WB + (size_t)2048 * 1024 * 2;
constexpr size_t WS_WGU = WS_WO + (size_t)2048 * 2048 * 2;
constexpr size_t WS_WD = WS_WGU + (size_t)32 * 2048 * 2048 * 2;
constexpr size_t WS_P = WS_WD + (size_t)32 * 2048 * 1024 * 2;
constexpr size_t WS_HMID = WS_P;
constexpr size_t WS_Y = WS_HMID + (size_t)MAXSLOT * 1024 * 2;
constexpr size_t WS_XN = WS_P + (size_t)T_TOK * NPROJ * 2;
constexpr size_t WS_OA = WS_XN + (size_t)T_TOK * 2048 * 2;
constexpr size_t WS_OB = WS_OA + (size_t)T_TOK * 1024 * 2;
constexpr size_t WS_MIXED = WS_OB + (size_t)T_TOK * 1024 * 2;
constexpr size_t WS_SPARE = WS_MIXED + (size_t)T_TOK * 2048 * 2;
constexpr size_t WS_XG = WS_OA;
constexpr size_t WS_KV = WS_SPARE + (size_t)T_TOK * 1024 * 2;
constexpr size_t WS_MASK = WS_KV + (size_t)T_TOK * 128 * 2;
constexpr size_t WS_MISC = WS_MASK + (size_t)T_TOK * 256;
constexpr size_t WS_WC = WS_MISC + 1048576;
constexpr size_t WS_END = WS_WC + 1048576;
static_assert(WS_Y + (size_t)MAXSLOT * 2048 * 2 <= WS_XN, "HMID + Y must fit in P");
static_assert(WS_XG + (size_t)MAXSLOT * 2048 * 2 <= WS_KV, "XG must fit in OA..SPARE");
static_assert(WS_END <= (size_t)1073741824, "workspace budget");
constexpr int MI_ROWTOK = 0, MI_ROWGATE = MAXSLOT, MI_TOKSLOT = 2 * MAXSLOT, MI_ASGE = MI_TOKSLOT + 2 * T_TOK, MI_ASGR = MI_ASGE + 2 * T_TOK, MI_ASGG = MI_ASGR + 2 * T_TOK;
static_assert((size_t)(MI_ASGG + 2 * T_TOK) * 4 <= 1048576, "misc budget");
constexpr int LDS_BYTES = 152 * 1024;
constexpr int LDS_MISC = 150 * 1024;

__device__ __forceinline__ float bflo(unsigned w) { return __uint_as_float(w << 16); }
__device__ __forceinline__ float bfhi(unsigned w) { return __uint_as_float(w & 0xffff0000u); }
__device__ __forceinline__ unsigned pkbf(float lo, float hi) { unsigned r; asm volatile("v_cvt_pk_bf16_f32 %0, %1, %2" : "=v"(r) : "v"(lo), "v"(hi)); return r; }
__device__ __forceinline__ int hide_i(int v) { asm volatile("" : "+v"(v)); return v; }
template <class Tp> __device__ __forceinline__ Tp* hide_p(Tp* q) { asm volatile("" : "+s"(q)); return q; }
__device__ __forceinline__ float shx(float v, int lane, int o) { return __int_as_float(__builtin_amdgcn_ds_bpermute((lane ^ o) << 2, __float_as_int(v))); }
__device__ __forceinline__ float wave_sum(float v, int lane) {
#pragma unroll
    for (int o = 1; o < 64; o <<= 1) v += shx(v, lane, o);
    return v;
}
__device__ __forceinline__ float wave_max(float v, int lane) {
#pragma unroll
    for (int o = 1; o < 64; o <<= 1) v = fmaxf(v, shx(v, lane, o));
    return v;
}
__device__ __forceinline__ float sigmoidf_(float x) { return __builtin_amdgcn_rcpf(1.0f + __expf(-x)); }
__device__ __forceinline__ float siluf_(float x) { return x * sigmoidf_(x); }
__device__ __forceinline__ float unkey(unsigned k) { return __uint_as_float((k & 0x80000000u) ? (k & 0x7fffffffu) : ~k); }
__device__ __forceinline__ int sbin(float s) { const int b = (int)(s * 32.0f + 128.0f); return b < 0 ? 0 : (b > 255 ? 255 : b); }
__device__ __forceinline__ unsigned fkey(float f) { const unsigned u = __float_as_uint(f + 0.0f); return (u & 0x80000000u) ? ~u : (u | 0x80000000u); }


#define XB_TMO      128
#define XB_XCNT(j)  (256  + 64 * (j))
#define XB_XSUB(j)  (1280 + 64 * (j))
#define XB_XGEN(j)  (2304 + 64 * (j))
#define XB_TOP      3328
#define XB_TOPGEN   3392
#define XCD_BAR_WORDS 3456
#define XB_SPIN_CAP (1u << 18)
__device__ __forceinline__ unsigned xb_ld(unsigned* p)              { return __hip_atomic_load(p, __ATOMIC_RELAXED, __HIP_MEMORY_SCOPE_AGENT); }
__device__ __forceinline__ unsigned xb_add(unsigned* p, unsigned v) { return __hip_atomic_fetch_add(p, v, __ATOMIC_RELAXED, __HIP_MEMORY_SCOPE_AGENT); }
__device__ __forceinline__ unsigned xb_xcc_id() { return (unsigned)__builtin_amdgcn_s_getreg((3 << 11) | 20) & 0xFu; }
#define XB_SPIN(cond, bar) do { unsigned _sp = 0; while (cond) { __builtin_amdgcn_s_sleep(1); \
    if ((++_sp & 255u) == 0u) { if (xb_ld(&(bar)[XB_TMO])) break; if (_sp > XB_SPIN_CAP) { atomicAdd(&(bar)[XB_TMO], 1u); break; } } } } while (0)
struct XcdBarrier { unsigned* bar; unsigned x; volatile __attribute__((address_space(3))) unsigned* st; };
__device__ __forceinline__ void xcd_barrier_complete(unsigned* bar, unsigned x, unsigned& nloc, unsigned& nx) {
    const unsigned G = gridDim.x * gridDim.y * gridDim.z;
    unsigned sum, cnt, mine, sp = 0u;
    for (;;) {
        sum = 0u; cnt = 0u; mine = 0u;
#pragma unroll
        for (unsigned j = 0; j < 16; ++j) { const unsigned c = xb_ld(&bar[XB_XCNT(j)]); sum += c; cnt += (c > 0u) ? 1u : 0u; mine = (j == x) ? c : mine; }
        if (sum == G) break;
        __builtin_amdgcn_s_sleep(1);
        if ((++sp & 255u) == 0u) { if (xb_ld(&bar[XB_TMO])) break; if (sp > XB_SPIN_CAP) { atomicAdd(&bar[XB_TMO], 1u); break; } }
    }
    nloc = mine > 0u ? mine : 1u; nx = cnt > 0u ? cnt : 1u;
}
__device__ __forceinline__ void xcd_barrier(const XcdBarrier& b, int tid) {
    asm volatile("s_waitcnt vmcnt(0)" ::: "memory");
    __syncthreads();
    if (tid == 0) {
        unsigned* bar = b.bar;
        __builtin_amdgcn_s_waitcnt(0);
        unsigned nloc = b.st[0], nx = b.st[1];
        if (nloc == 0u) { xcd_barrier_complete(bar, b.x, nloc, nx); b.st[0] = nloc; b.st[1] = nx; }
        const unsigned old = xb_add(&bar[XB_XSUB(b.x)], 1u);
        const unsigned gen = old / nloc;
        if (old + 1u == (gen + 1u) * nloc) {
            __builtin_amdgcn_fence(__ATOMIC_RELEASE, "agent");
            asm volatile("s_waitcnt vmcnt(0)" ::: "memory");
            const unsigned og = xb_add(&bar[XB_TOP], 1u);
            const unsigned tg = og / nx;
            if (og + 1u == (tg + 1u) * nx) xb_add(&bar[XB_TOPGEN], 1u);
            else XB_SPIN(xb_ld(&bar[XB_TOPGEN]) == tg, bar);
            __builtin_amdgcn_fence(__ATOMIC_ACQUIRE, "agent");
            xb_add(&bar[XB_XGEN(b.x)], 1u);
            asm volatile("s_waitcnt vmcnt(0)" ::: "memory");
        } else {
            XB_SPIN(xb_ld(&bar[XB_XGEN(b.x)]) == gen, bar);
            __builtin_amdgcn_fence(__ATOMIC_ACQUIRE, "agent");
            asm volatile("s_waitcnt vmcnt(0)" ::: "memory");
        }
    }
    __syncthreads();
}

namespace fa {
using bf16x8 = __attribute__((ext_vector_type(8))) short;
using s16x4  = __attribute__((ext_vector_type(4))) short;
using f32x16 = __attribute__((ext_vector_type(16))) float;
constexpr int TILE_B = 64 * 128 * 2;
constexpr int OFF_V = 0, OFF_K = 2 * TILE_B, OFF_M = 4 * TILE_B, OFF_WS = OFF_M + 2 * 256, OFF_Q = OFF_WS + 8 * 256, LDS_NEED = OFF_Q + 8 * 8192;
#define FA_GAS __attribute__((address_space(1)))
#define FA_KSWZ(row, colB) ((row) * 256 + ((colB) ^ (((row) & 7) << 4)))
#define FA_SBAR() __builtin_amdgcn_sched_barrier(0)
__device__ __forceinline__ int crow(int r, int hi) { return (r & 3) + 8 * (r >> 2) + 4 * hi; }
__device__ __forceinline__ int v_st(int k, int c) { const int kk = (k & ~0xC) | ((k & 4) << 1) | ((k & 8) >> 1); return ((kk >> 3) * 4 + (c >> 5)) * 512 + ((kk & 7) * 32 + (c & 31)) * 2; }
__device__ __forceinline__ int v_rd_base(int lane) { return ((lane & 3) << 3) | (((lane >> 2) & 3) << 6) | (((lane >> 4) & 1) << 5) | (((lane >> 5) & 1) << 8); }
constexpr int v_rd_off(int d0, int ks, int half) { return d0 * 512 + ks * 4096 + half * 2048; }
template <int OFF> __device__ __forceinline__ s16x4 tr_read(int vb) { s16x4 r; asm volatile("ds_read_b64_tr_b16 %0, %1 offset:%2" : "=&v"(r) : "v"(vb), "i"(OFF) : "memory"); return r; }
template <int D0> __device__ __forceinline__ void pv_one(f32x16& od, int vb, bf16x8 pa0, bf16x8 pa1, bf16x8 pa2, bf16x8 pa3) {
    const s16x4 l0 = tr_read<v_rd_off(D0, 0, 0)>(vb), h0 = tr_read<v_rd_off(D0, 0, 1)>(vb), l1 = tr_read<v_rd_off(D0, 1, 0)>(vb), h1 = tr_read<v_rd_off(D0, 1, 1)>(vb);
    const s16x4 l2 = tr_read<v_rd_off(D0, 2, 0)>(vb), h2 = tr_read<v_rd_off(D0, 2, 1)>(vb), l3 = tr_read<v_rd_off(D0, 3, 0)>(vb), h3 = tr_read<v_rd_off(D0, 3, 1)>(vb);
    asm volatile("s_waitcnt lgkmcnt(0)" ::: "memory"); FA_SBAR();
#define FA_PK(L, H) (bf16x8){L[0], L[1], L[2], L[3], H[0], H[1], H[2], H[3]}
    od = __builtin_amdgcn_mfma_f32_32x32x16_bf16(pa0, FA_PK(l0, h0), od, 0, 0, 0);
    od = __builtin_amdgcn_mfma_f32_32x32x16_bf16(pa1, FA_PK(l1, h1), od, 0, 0, 0);
    od = __builtin_amdgcn_mfma_f32_32x32x16_bf16(pa2, FA_PK(l2, h2), od, 0, 0, 0);
    od = __builtin_amdgcn_mfma_f32_32x32x16_bf16(pa3, FA_PK(l3, h3), od, 0, 0, 0);
#undef FA_PK
}
template <bool QLDS>
__device__ __forceinline__ void qkt(f32x16& p0, f32x16& p1, const LAS char* Ks, const bf16x8 (&qr)[8], const LAS char* Ql, int r32, int hi) {
    p0 = f32x16{}; p1 = f32x16{};
#pragma unroll
    for (int d0 = 0; d0 < 8; ++d0) { const int cb = (d0 * 16 + hi * 8) * 2;
        const bf16x8 b0 = *(const LAS bf16x8*)(Ks + FA_KSWZ(r32, cb));
        const bf16x8 b1 = *(const LAS bf16x8*)(Ks + FA_KSWZ(32 + r32, cb));
        const bf16x8 q = QLDS ? *(const LAS bf16x8*)(Ql + d0 * 1024) : qr[d0];
        p0 = __builtin_amdgcn_mfma_f32_32x32x16_bf16(b0, q, p0, 0, 0, 0);
        p1 = __builtin_amdgcn_mfma_f32_32x32x16_bf16(b1, q, p1, 0, 0, 0); }
}
__device__ __forceinline__ void p_to_frag(const f32x16& p0, const f32x16& p1, bf16x8& pa0, bf16x8& pa1, bf16x8& pa2, bf16x8& pa3) {
#define FA_PK4(P, BASE, OUT) do { unsigned a0 = pkbf(P[BASE + 0], P[BASE + 1]), a1 = pkbf(P[BASE + 2], P[BASE + 3]);   \
    unsigned b0 = pkbf(P[BASE + 4], P[BASE + 5]), b1 = pkbf(P[BASE + 6], P[BASE + 7]);                              \
    auto r0 = __builtin_amdgcn_permlane32_swap(a0, b0, false, false); auto r1 = __builtin_amdgcn_permlane32_swap(a1, b1, false, false); \
    u32x4 w = {r0[0], r1[0], r0[1], r1[1]}; OUT = *reinterpret_cast<bf16x8*>(&w); } while (0)
    FA_PK4(p0, 0, pa0); FA_PK4(p0, 8, pa1); FA_PK4(p1, 0, pa2); FA_PK4(p1, 8, pa3);
#undef FA_PK4
}

struct UnitArgs {
    const bf16_t* Q; int ldq;
    const bf16_t* K; const bf16_t* V; int ldk;
    const u64* mask;
    int ntiles;
    int n0;
    float lgam;
};

template <int MODE>
__device__ __forceinline__ void unit_body(LAS char* L, const UnitArgs& U, int tid, f32x16 (&o)[4], float& l_out) {
    const int wid = __builtin_amdgcn_readfirstlane(tid >> 6), lane = tid & 63, r32 = lane & 31, hi = lane >> 5;
    LAS char* V_lds = L + OFF_V; LAS char* K_lds = L + OFF_K; LAS u64* M_lds = (LAS u64*)(L + OFF_M);
    LAS float* wsf = (LAS float*)(L + OFF_WS) + wid * 64; LAS float* al_l = wsf + 32;
    constexpr float C = ATT_SCALE * 1.4426950408889634f;
    float m_reg = -1e30f, l_reg = 0.f;
    bf16x8 qr[8];
    LAS char* Ql = L + OFF_Q + wid * 8192 + lane * 16;
    { const FA_GAS bf16_t* Qh = (const FA_GAS bf16_t*)hide_p(U.Q); const FA_GAS bf16_t* Qw = (MODE == 0) ? Qh + (size_t)r32 * U.ldq + wid * 128 + hi * 8 : Qh + (size_t)(wid * 32 + r32) * U.ldq + hi * 8;
#pragma unroll
      for (int d0 = 0; d0 < 8; ++d0) { qr[d0] = *(const FA_GAS bf16x8*)(Qw + d0 * 16); if (MODE == 1) *(LAS bf16x8*)(Ql + d0 * 1024) = qr[d0]; } }
    if (MODE == 1) { asm volatile("s_waitcnt vmcnt(0) lgkmcnt(0)" ::: "memory"); FA_SBAR(); }
    const int sr = tid >> 4, sc = (tid & 15) * 8, vst0 = v_st(sr, sc), vst1 = v_st(32 + sr, sc), kst0 = FA_KSWZ(sr, sc * 2), kst1 = FA_KSWZ(32 + sr, sc * 2);
    const FA_GAS char* Kh = (const FA_GAS char*)hide_p(U.K); const FA_GAS char* Vh = (const FA_GAS char*)hide_p(U.V);
    const unsigned goff0 = (unsigned)(sr * U.ldk + sc) * 2u, goff1 = (unsigned)((32 + sr) * U.ldk + sc) * 2u;
    const int vb0 = (int)(unsigned)(size_t)V_lds + v_rd_base(lane);
    bf16x8 ksA0, ksA1, vsA0, vsA1; u64 mwA = 0ull; unsigned pf_ = 0u;
#define FA_SLOAD(S, k0) do { const FA_GAS char* kb_ = Kh + (size_t)(k0) * U.ldk * 2; const FA_GAS char* vb_ = Vh + (size_t)(k0) * U.ldk * 2;     \
        ks##S##0 = *(const FA_GAS bf16x8*)(kb_ + goff0); ks##S##1 = *(const FA_GAS bf16x8*)(kb_ + goff1); \
        if (MODE == 1) { vs##S##0 = *(const FA_GAS bf16x8*)(vb_ + goff0); vs##S##1 = *(const FA_GAS bf16x8*)(vb_ + goff1); } \
        if (MODE == 0 && tid < 32) mw##S = U.mask[(size_t)tid * 32 + ((k0) >> 6)]; } while (0)
#define FA_SWRITE(S, b) do { *(LAS bf16x8*)(K_lds + (b) * TILE_B + kst0) = ks##S##0; *(LAS bf16x8*)(K_lds + (b) * TILE_B + kst1) = ks##S##1; \
        *(LAS bf16x8*)(V_lds + (b) * TILE_B + vst0) = (MODE == 1) ? vs##S##0 : ks##S##0; *(LAS bf16x8*)(V_lds + (b) * TILE_B + vst1) = (MODE == 1) ? vs##S##1 : ks##S##1; \
        if (MODE == 0 && tid < 32) M_lds[(b) * 32 + tid] = mw##S; } while (0)
#define FA_TOUCH(k0) do { if (MODE == 1 && tid < 256) { const FA_GAS char* tb_ = ((tid < 128) ? Kh : Vh) + (size_t)((k0) + ((tid & 127) >> 1)) * U.ldk * 2 + (tid & 1) * 128; \
        asm volatile("global_load_dword %0, %1, off" : "=v"(pf_) : "v"(tb_) : "memory"); } } while (0)
#define FA_TILE(j, b) do { \
        f32x16 p0, p1; bf16x8 pa0, pa1, pa2, pa3; \
        { const LAS char* qb_ = Ql; asm volatile("" : "+v"(qb_)); qkt<MODE == 1>(p0, p1, K_lds + (b) * TILE_B, qr, qb_, r32, hi); } \
        if (MODE == 0) { \
            const u64 mw = M_lds[(b) * 32 + r32] >> (4 * hi); \
            const unsigned mlo = (unsigned)mw, mhi = (unsigned)(mw >> 32); \
            _Pragma("unroll") for (int r = 0; r < 16; ++r) { const unsigned bit = 1u << ((r & 3) + 8 * (r >> 2)); p0[r] = (mlo & bit) ? p0[r] : -INFINITY; p1[r] = (mhi & bit) ? p1[r] : -INFINITY; } \
            float pmax = p0[0]; \
            _Pragma("unroll") for (int r = 1; r < 16; ++r) pmax = fmaxf(pmax, p0[r]); \
            _Pragma("unroll") for (int r = 0; r < 16; ++r) pmax = fmaxf(pmax, p1[r]); \
            { auto rr = __builtin_amdgcn_permlane32_swap(__float_as_uint(pmax), __float_as_uint(pmax), false, false); pmax = fmaxf(__uint_as_float(rr[0]), __uint_as_float(rr[1])); } \
            const float mn = fmaxf(m_reg, pmax); const float alpha = __builtin_amdgcn_exp2f((m_reg - mn) * C); m_reg = mn; \
            const float mnC = -mn * C; float ps = 0.f; \
            _Pragma("unroll") for (int r = 0; r < 16; ++r) { p0[r] = __builtin_amdgcn_exp2f(fmaf(p0[r], C, mnC)); p1[r] = __builtin_amdgcn_exp2f(fmaf(p1[r], C, mnC)); ps += p0[r] + p1[r]; } \
            { auto rr = __builtin_amdgcn_permlane32_swap(__float_as_uint(ps), __float_as_uint(ps), false, false); ps = __uint_as_float(rr[0]) + __uint_as_float(rr[1]); } \
            l_reg = l_reg * alpha + ps; \
            if (__any(alpha < 1.f)) { \
                if (hi == 0) al_l[r32] = alpha; \
                asm volatile("s_waitcnt lgkmcnt(0)" ::: "memory"); \
                _Pragma("unroll") for (int r = 0; r < 16; ++r) { const float a_ = al_l[crow(r, hi)]; \
                    _Pragma("unroll") for (int d = 0; d < 4; ++d) o[d][r] *= a_; } \
            } \
        } else { \
            const int dn = U.n0 + wid * 32 + r32 - (j) * 64 - 4 * hi; \
            const float base = (float)dn * U.lgam; \
            _Pragma("unroll") for (int r = 0; r < 16; ++r) { const int kk = (r & 3) + 8 * (r >> 2); \
                const float f0 = __builtin_amdgcn_exp2f(base - (float)kk * U.lgam), f1 = __builtin_amdgcn_exp2f(base - (float)(kk + 32) * U.lgam); \
                p0[r] = (dn >= kk) ? p0[r] * f0 : 0.f; p1[r] = (dn >= kk + 32) ? p1[r] * f1 : 0.f; } \
        } \
        p_to_frag(p0, p1, pa0, pa1, pa2, pa3); \
        FA_SBAR(); \
        { const int vb = vb0 + (b) * TILE_B; \
          pv_one<0>(o[0], vb, pa0, pa1, pa2, pa3); pv_one<1>(o[1], vb, pa0, pa1, pa2, pa3); pv_one<2>(o[2], vb, pa0, pa1, pa2, pa3); pv_one<3>(o[3], vb, pa0, pa1, pa2, pa3); } \
    } while (0)
    const int NT = U.ntiles;
    FA_SLOAD(A, 0); FA_SWRITE(A, 0);
    if (NT > 1) { FA_SLOAD(A, 64); FA_SWRITE(A, 1); }
    if (NT > 2) FA_TOUCH(128);
    if (NT > 3) FA_TOUCH(192);
    __syncthreads();
#pragma unroll
    for (int d = 0; d < 4; ++d) o[d] = f32x16{};
#pragma unroll 1
    for (int j = 0; j < NT; ++j) {
        const int b = j & 1;
        if (j + 2 < NT) FA_SLOAD(A, (j + 2) * 64);
        if (j + 4 < NT) FA_TOUCH((j + 4) * 64);
        FA_TILE(j, b);
        __syncthreads();
        if (j + 2 < NT) FA_SWRITE(A, b);
        asm volatile("" :: "v"(pf_));
    }
    asm volatile("s_waitcnt vmcnt(0)" ::: "memory");
    __syncthreads();
    l_out = l_reg;
#undef FA_SLOAD
#undef FA_SWRITE
#undef FA_TILE
}
}

namespace pg8 {
struct EpiProj {
    static constexpr bool PERM = true, AFTER_DRAIN = false, HAS_MID = false;
    bf16_t* P; const float* rot;
    __device__ __forceinline__ void operator()(const f32x4 (&acc)[2][2][4][2], const Unit& u, int wr, int wc, int fr, int fq) const {
        const int row0 = u.pm * BM + wr * 64 + fr, colb = u.pn * BM + wc * 32 + 8 * fq;
        const bool rotq = (u.pn >= 7) && (u.pn < 15);
        const float ksc = (u.pn >= 11) ? K_SCALE : 1.0f;
        const int i0 = 16 * wc + 4 * fq;
#pragma unroll
        for (int ai = 0; ai < 2; ++ai)
#pragma unroll
            for (int m = 0; m < 4; ++m) {
                const int row = row0 + ai * HALF + m * 16; const int pos = row & (SEQL - 1);
                bf16_t* rowp = P + (size_t)row * NPROJ + colb;
                f32x4 r0 = (f32x4){1.f, 0.f, 1.f, 0.f}, r1 = r0;
                if (rotq) { const f32x4* rt = (const f32x4*)(rot + ((size_t)pos * 64 + i0) * 2); r0 = rt[0]; r1 = rt[1]; }
#pragma unroll
                for (int bj = 0; bj < 2; ++bj) {
                    f32x4 v0 = acc[ai][bj][m][0], v1 = acc[ai][bj][m][1];
                    if (rotq) {
                        f32x4 w0, w1;
                        w0[0] = (v0[0] * r0[0] - v0[1] * r0[1]) * ksc; w0[1] = (v0[0] * r0[1] + v0[1] * r0[0]) * ksc;
                        w0[2] = (v0[2] * r0[2] - v0[3] * r0[3]) * ksc; w0[3] = (v0[2] * r0[3] + v0[3] * r0[2]) * ksc;
                        w1[0] = (v1[0] * r1[0] - v1[1] * r1[1]) * ksc; w1[1] = (v1[0] * r1[1] + v1[1] * r1[0]) * ksc;
                        w1[2] = (v1[2] * r1[2] - v1[3] * r1[3]) * ksc; w1[3] = (v1[2] * r1[3] + v1[3] * r1[2]) * ksc;
                        v0 = w0; v1 = w1;
                    }
                    u32x4 w; w.x = pkbf(v0[0], v0[1]); w.y = pkbf(v0[2], v0[3]); w.z = pkbf(v1[0], v1[1]); w.w = pkbf(v1[2], v1[3]);
                    *(u32x4*)(rowp + bj * HALF) = w;
                }
            }
    }
};
struct EpiMergeF {
    static constexpr bool PERM = true, AFTER_DRAIN = false, HAS_MID = true;
    const bf16_t* P; bf16_t* O;
    static __device__ __forceinline__ float cl(float x) { return fminf(fmaxf(x, -30.f), 30.f); }
    static __device__ __forceinline__ float ratio(float a, float b) { return (1.0f + __expf(-cl(b))) * __builtin_amdgcn_rcpf(1.0f + __expf(-cl(a))); }
    __device__ __forceinline__ void mid(f32x4 (&acc)[2][2][4][2], const Unit& u, int wr, int wc, int fr, int fq) const {
        const int row0 = hide_i(u.pm * BM + wr * 64 + fr), colb = hide_i(u.pn * BM + wc * 32 + 8 * fq);
        __builtin_amdgcn_sched_barrier(0);
#pragma unroll
        for (int ai = 0; ai < 2; ++ai) {
            u32x4 g0[4][2], g1[4][2];
#pragma unroll
            for (int m = 0; m < 4; ++m)
#pragma unroll
                for (int bj = 0; bj < 2; ++bj) { const bf16_t* gp = P + (size_t)(row0 + ai * HALF + m * 16) * NPROJ + C_GBR + colb + bj * HALF; g0[m][bj] = *(const u32x4*)gp; g1[m][bj] = *(const u32x4*)(gp + DMODEL); }
            __builtin_amdgcn_sched_barrier(0);
#pragma unroll
            for (int m = 0; m < 4; ++m)
#pragma unroll
                for (int bj = 0; bj < 2; ++bj) {
                    const u32x4 a_ = g0[m][bj], b_ = g1[m][bj]; f32x4 r0, r1;
                    r0[0] = ratio(bflo(a_.x), bflo(b_.x)); r0[1] = ratio(bfhi(a_.x), bfhi(b_.x)); r0[2] = ratio(bflo(a_.y), bflo(b_.y)); r0[3] = ratio(bfhi(a_.y), bfhi(b_.y));
                    r1[0] = ratio(bflo(a_.z), bflo(b_.z)); r1[1] = ratio(bfhi(a_.z), bfhi(b_.z)); r1[2] = ratio(bflo(a_.w), bflo(b_.w)); r1[3] = ratio(bfhi(a_.w), bfhi(b_.w));
                    acc[ai][bj][m][0] = acc[ai][bj][m][0] * r0; acc[ai][bj][m][1] = acc[ai][bj][m][1] * r1;
                }
            __builtin_amdgcn_sched_barrier(0);
        }
    }
    __device__ __forceinline__ void operator()(const f32x4 (&acc)[2][2][4][2], const Unit& u, int wr, int wc, int fr, int fq) const {
        const int row0 = u.pm * BM + wr * 64 + fr, colb = u.pn * BM + wc * 32 + 8 * fq;
#pragma unroll
        for (int ai = 0; ai < 2; ++ai) {
            u32x4 gg[4][2];
#pragma unroll
            for (int m = 0; m < 4; ++m)
#pragma unroll
                for (int bj = 0; bj < 2; ++bj) gg[m][bj] = *(const u32x4*)(P + (size_t)(row0 + ai * HALF + m * 16) * NPROJ + C_GBR + DMODEL + colb + bj * HALF);
            __builtin_amdgcn_sched_barrier(0);
#pragma unroll
            for (int m = 0; m < 4; ++m) {
                const int row = row0 + ai * HALF + m * 16;
#pragma unroll
                for (int bj = 0; bj < 2; ++bj) {
                    const int col = colb + bj * HALF;
                    const u32x4 g = gg[m][bj];
                    const f32x4 v0 = acc[ai][bj][m][0], v1 = acc[ai][bj][m][1];
                    float o[8];
                    o[0] = sigmoidf_(cl(bflo(g.x))) * v0[0]; o[1] = sigmoidf_(cl(bfhi(g.x))) * v0[1]; o[2] = sigmoidf_(cl(bflo(g.y))) * v0[2]; o[3] = sigmoidf_(cl(bfhi(g.y))) * v0[3];
                    o[4] = sigmoidf_(cl(bflo(g.z))) * v1[0]; o[5] = sigmoidf_(cl(bfhi(g.z))) * v1[1]; o[6] = sigmoidf_(cl(bflo(g.w))) * v1[2]; o[7] = sigmoidf_(cl(bfhi(g.w))) * v1[3];
                    u32x4 w; w.x = pkbf(o[0], o[1]); w.y = pkbf(o[2], o[3]); w.z = pkbf(o[4], o[5]); w.w = pkbf(o[6], o[7]);
                    *(u32x4*)(O + (size_t)row * DMODEL + col) = w;
                }
            }
        }
    }
};
struct EpiRes {
    static constexpr bool PERM = false, AFTER_DRAIN = false, HAS_MID = false;
    const float* X; float* O;
    __device__ __forceinline__ void operator()(const f32x4 (&acc)[2][2][4][2], const Unit& u, int wr, int wc, int fr, int fq) const {
        const int row0 = u.pm * BM + wr * 64 + fr, col0 = u.pn * BM + wc * 32 + 4 * fq;
#pragma unroll
        for (int ai = 0; ai < 2; ++ai) {
            f32x4 xv[4][2][2];
#pragma unroll
            for (int m = 0; m < 4; ++m) { const size_t off = (size_t)(row0 + ai * HALF + m * 16) * DMODEL + col0;
#pragma unroll
                for (int bj = 0; bj < 2; ++bj)
#pragma unroll
                    for (int n = 0; n < 2; ++n) xv[m][bj][n] = *(const f32x4*)(X + off + bj * HALF + n * 16); }
            __builtin_amdgcn_sched_barrier(0);
#pragma unroll
            for (int m = 0; m < 4; ++m) { const size_t off = (size_t)(row0 + ai * HALF + m * 16) * DMODEL + col0;
#pragma unroll
                for (int bj = 0; bj < 2; ++bj)
#pragma unroll
                    for (int n = 0; n < 2; ++n) *(f32x4*)(O + off + bj * HALF + n * 16) = xv[m][bj][n] + acc[ai][bj][m][n]; }
            __builtin_amdgcn_sched_barrier(0);
        }
    }
};
struct EpiSwiglu {
    static constexpr bool PERM = true, AFTER_DRAIN = false, HAS_MID = false;
    bf16_t* H; const float* rs;
    __device__ __forceinline__ void operator()(const f32x4 (&acc)[2][2][4][2], const Unit& u, int wr, int wc, int fr, int fq) const {
        const int row0 = u.pm * BM + wr * 64 + fr, col = u.pn * HALF + wc * 32 + 8 * fq;
#pragma unroll
        for (int ai = 0; ai < 2; ++ai)
#pragma unroll
            for (int m = 0; m < 4; ++m) {
                const int row = row0 + ai * HALF + m * 16; const float r_ = rs[row];
                const f32x4 g0 = acc[ai][0][m][0] * r_, g1 = acc[ai][0][m][1] * r_, u0 = acc[ai][1][m][0] * r_, u1 = acc[ai][1][m][1] * r_;
                u32x4 w; w.x = pkbf(siluf_(g0[0]) * u0[0], siluf_(g0[1]) * u0[1]); w.y = pkbf(siluf_(g0[2]) * u0[2], siluf_(g0[3]) * u0[3]);
                w.z = pkbf(siluf_(g1[0]) * u1[0], siluf_(g1[1]) * u1[1]); w.w = pkbf(siluf_(g1[2]) * u1[2], siluf_(g1[3]) * u1[3]);
                *(u32x4*)(H + (size_t)row * 1024 + col) = w;
            }
    }
};
struct EpiDown {
    static constexpr bool PERM = true, AFTER_DRAIN = false, HAS_MID = false;
    bf16_t* Y; const float* rg;
    __device__ __forceinline__ void operator()(const f32x4 (&acc)[2][2][4][2], const Unit& u, int wr, int wc, int fr, int fq) const {
        const int row0 = u.pm * BM + wr * 64 + fr, colb = u.pn * BM + wc * 32 + 8 * fq;
#pragma unroll
        for (int ai = 0; ai < 2; ++ai)
#pragma unroll
            for (int m = 0; m < 4; ++m) {
                const int row = row0 + ai * HALF + m * 16; const float gt = rg[row];
#pragma unroll
                for (int bj = 0; bj < 2; ++bj) {
                    const f32x4 v0 = acc[ai][bj][m][0] * gt, v1 = acc[ai][bj][m][1] * gt;
                    u32x4 w; w.x = pkbf(v0[0], v0[1]); w.y = pkbf(v0[2], v0[3]); w.z = pkbf(v1[0], v1[1]); w.w = pkbf(v1[2], v1[3]);
                    *(u32x4*)(Y + (size_t)row * DMODEL + colb + bj * HALF) = w;
                }
            }
    }
};
template <bool GATHER_> struct ExpertOrderT {
    static constexpr bool GATHER = GATHER_;
    const LAS int* ts; int G, c; const int* rtok;
    __device__ __forceinline__ unsigned rowoff(int slot) const { return GATHER_ ? (unsigned)rtok[slot] : 0u; }
    __device__ __forceinline__ bool next(int i, Unit& u) const {
        const int L = i * G + c; const int total = ts[32] * 8; if (L >= total) return false;
        const int gt = L >> 3; u.pm = gt; u.pn = L & 7; int e = 0;
        for (int k = 1; k < 32; ++k) e += (gt >= ts[k]) ? 1 : 0;
        u.e = e; return true;
    }
    __device__ __forceinline__ void a_ready(const Unit&) const {}
    __device__ __forceinline__ void done(const Unit&) const {}
};
}

struct MapId { __device__ __forceinline__ int operator()(int n) const { return n; } };
struct MapGate { __device__ __forceinline__ int operator()(int f) const { return ((f >> 7) << 8) + (f & 127); } };
struct MapUp { __device__ __forceinline__ int operator()(int f) const { return ((f >> 7) << 8) + 128 + (f & 127); } };
struct MapProj {
    __device__ __forceinline__ int operator()(int n) const {
        if (n < 1736) return n;
        if (n < 2760) { const int l = n - 1736, d = l & 127; return C_QR + (l & ~127) + ((d & 63) << 1) + (d >> 6); }
        if (n < 3784) { const int l = n - 2760, d = l & 127; return C_KR + (l & ~127) + ((d & 63) << 1) + (d >> 6); }
        if (n < 4808) return C_VR + (n - 3784);
        if (n < 5832) return C_GR + (n - 4808);
        return C_GBR + (n - 5832);
    }
};
template <class RowMap>
__device__ __forceinline__ void tr_item(const float* __restrict__ src, int N, bf16_t* __restrict__ dst, int ldd, int kb, int nb, int lane, RowMap rm) {
    const int kc = lane >> 3, nc = lane & 7;
    const int n = nb * 32 + nc * 4, k0 = kb * 64 + kc * 8;
    if (n < N) {
        f32x4 v[8];
#pragma unroll
        for (int i = 0; i < 8; ++i) v[i] = *(const f32x4*)(src + (size_t)(k0 + i) * N + n);
#pragma unroll
        for (int j = 0; j < 4; ++j) {
            u32x4 o; o.x = pkbf(v[0][j], v[1][j]); o.y = pkbf(v[2][j], v[3][j]); o.z = pkbf(v[4][j], v[5][j]); o.w = pkbf(v[6][j], v[7][j]);
            *(u32x4*)(dst + (size_t)rm(n + j) * ldd + k0) = o;
        }
    }
}
template <class RowMap>
__device__ __forceinline__ void tr_item2(const float* __restrict__ src, int N, bf16_t* __restrict__ dst, int ldd, int kb, int nb, int lane, RowMap rm) {
    const int kc = lane >> 3, nc = lane & 7;
    const int n = nb * 32 + nc * 4, k0 = kb * 64 + kc * 8;
    f32x4 va[8], vb[8];
#pragma unroll
    for (int i = 0; i < 8; ++i) { va[i] = *(const f32x4*)(src + (size_t)(k0 + i) * N + n); vb[i] = *(const f32x4*)(src + (size_t)(k0 + i) * N + n + 32); }
#pragma unroll
    for (int j = 0; j < 4; ++j) {
        u32x4 o; o.x = pkbf(va[0][j], va[1][j]); o.y = pkbf(va[2][j], va[3][j]); o.z = pkbf(va[4][j], va[5][j]); o.w = pkbf(va[6][j], va[7][j]);
        *(u32x4*)(dst + (size_t)rm(n + j) * ldd + k0) = o;
    }
#pragma unroll
    for (int j = 0; j < 4; ++j) {
        u32x4 o; o.x = pkbf(vb[0][j], vb[1][j]); o.y = pkbf(vb[2][j], vb[3][j]); o.z = pkbf(vb[4][j], vb[5][j]); o.w = pkbf(vb[6][j], vb[7][j]);
        *(u32x4*)(dst + (size_t)rm(n + 32 + j) * ldd + k0) = o;
    }
}
template <class RowMap>
__device__ __forceinline__ void tr_item4(const float* __restrict__ src, int N, bf16_t* __restrict__ dst, int ldd, int kb, int nb, int lane, RowMap rm) {
    const int kc = lane >> 3, nc = lane & 7;
    const int n = nb * 32 + nc * 4, k0 = kb * 64 + kc * 8;
    f32x4 v[4][8];
#pragma unroll
    for (int i = 0; i < 8; ++i)
#pragma unroll
        for (int u = 0; u < 4; ++u) v[u][i] = *(const f32x4*)(src + (size_t)(k0 + i) * N + n + 32 * u);
#pragma unroll
    for (int u = 0; u < 4; ++u)
#pragma unroll
        for (int j = 0; j < 4; ++j) {
            u32x4 o; o.x = pkbf(v[u][0][j], v[u][1][j]); o.y = pkbf(v[u][2][j], v[u][3][j]); o.z = pkbf(v[u][4][j], v[u][5][j]); o.w = pkbf(v[u][6][j], v[u][7][j]);
            *(u32x4*)(dst + (size_t)rm(n + 32 * u + j) * ldd + k0) = o;
        }
}
constexpr int EXP_ITEMS = 3 * 32 * 1024;
__device__ __forceinline__ void convert_experts(const float* w_eg, const float* w_eu, const float* w_ed, bf16_t* WGU, bf16_t* WD, unsigned* qctr, int lane) {
    int nxt = 0; if (lane == 0) nxt = (int)atomicAdd(qctr, 8u);
    for (;;) {
        const int it = __builtin_amdgcn_readfirstlane(nxt);
        if (it >= EXP_ITEMS) break;
        if (lane == 0) nxt = (int)atomicAdd(qctr, 8u);
        const int kind = it >> 15, r = it & 32767, e = r >> 10, q = r & 1023;
        if (kind == 0) { const float* src = w_eg + (size_t)e * 2048 * 1024; bf16_t* dst = WGU + (size_t)e * 2048 * 2048;
#pragma unroll 1
            for (int u = 0; u < 8; u += 4) tr_item4(src, 1024, dst, 2048, q >> 5, (q & 31) + u, lane, MapGate{}); }
        else if (kind == 1) { const float* src = w_eu + (size_t)e * 2048 * 1024; bf16_t* dst = WGU + (size_t)e * 2048 * 2048;
#pragma unroll 1
            for (int u = 0; u < 8; u += 4) tr_item4(src, 1024, dst, 2048, q >> 5, (q & 31) + u, lane, MapUp{}); }
        else { const float* src = w_ed + (size_t)e * 1024 * 2048; bf16_t* dst = WD + (size_t)e * 2048 * 1024;
#pragma unroll 1
            for (int u = 0; u < 8; u += 4) tr_item4(src, 2048, dst, 1024, q >> 6, (q & 63) + u, lane, MapId{}); }
    }
}
__device__ __forceinline__ void sincos_d(double a, double& s, double& c) {
    const double TWO_PI = 6.283185307179586476925, HALF_PI = 1.5707963267948966192313;
    double k = rint(a / HALF_PI); double r = a - k * HALF_PI;
    r -= k * 6.123233995736766e-17;
    const int q = ((int)k) & 3; const double r2 = r * r;
    double sp = r2 * (-1.0 / 1307674368000.0);
    sp = r2 * (sp + 1.0 / 6227020800.0); sp = r2 * (sp - 1.0 / 39916800.0); sp = r2 * (sp + 1.0 / 362880.0); sp = r2 * (sp - 1.0 / 5040.0); sp = r2 * (sp + 1.0 / 120.0); sp = r2 * (sp - 1.0 / 6.0);
    const double sr = r + r * sp;
    double cp = r2 * (1.0 / 20922789888000.0);
    cp = r2 * (cp - 1.0 / 87178291200.0); cp = r2 * (cp + 1.0 / 479001600.0); cp = r2 * (cp - 1.0 / 3628800.0); cp = r2 * (cp + 1.0 / 40320.0); cp = r2 * (cp - 1.0 / 720.0); cp = r2 * (cp + 1.0 / 24.0); cp = r2 * (cp - 0.5);
    const double cr = 1.0 + cp;
    s = (q == 0) ? sr : (q == 1) ? cr : (q == 2) ? -sr : -cr;
    c = (q == 0) ? cr : (q == 1) ? -sr : (q == 2) ? -cr : sr;
    (void)TWO_PI;
}

struct Params { const float* in[17]; float* out; unsigned char* ws; };

#ifndef PROF_PHASE
#define PROF_PHASE -1
#endif
#define STAMP(i) do { if (PROF_PHASE >= 0 && bx == 0 && wave_id == 0) ((unsigned*)(p.ws + WS_CTL))[6000 + (i)] = (unsigned)__builtin_amdgcn_s_memrealtime(); } while (0)
#define GSYNC() grid.sync()
#define XBAR() do { const int l__ = (int)__builtin_amdgcn_mbcnt_hi(~0u, __builtin_amdgcn_mbcnt_lo(~0u, (unsigned)hide_i(0))); xcd_barrier(xbar, wave_id * 64 + l__); } while (0)
constexpr int CTL_BAR_WORD = 8192;
constexpr int CTL_QCTR = 2048;
#ifndef NGEMM_P1
#define NGEMM_P1 208
#endif

__global__ void __launch_bounds__(512, 2) mega_fwd(Params p) {
    extern __shared__ __attribute__((aligned(16))) unsigned char lds_raw[];
    LAS unsigned char* lds = (LAS unsigned char*)lds_raw;
    cg::grid_group grid = cg::this_grid();
    const int G = gridDim.x, bx = blockIdx.x;
    const int wave_id = __builtin_amdgcn_readfirstlane((int)threadIdx.x >> 6);
    const int NGW = G * 8, NGT = G * 512;
    XcdBarrier xbar;
    {
        const int l0 = (int)__builtin_amdgcn_mbcnt_hi(~0u, __builtin_amdgcn_mbcnt_lo(~0u, (unsigned)hide_i(0)));
        volatile LAS unsigned* st = (volatile LAS unsigned*)(lds + LDS_MISC + 256);
        if (wave_id == 0 && l0 < 2) st[l0] = 0u;
        __syncthreads();
        xbar.bar = (unsigned*)(p.ws + WS_CTL) + CTL_BAR_WORD; xbar.x = xb_xcc_id(); xbar.st = st;
        if (wave_id == 0 && l0 == 0) (void)xb_add(&xbar.bar[XB_XCNT(xbar.x)], 1u);
    }
#define PH_LOCALS \
    const int lane = (int)__builtin_amdgcn_mbcnt_hi(~0u, __builtin_amdgcn_mbcnt_lo(~0u, (unsigned)hide_i(0))), wave = wave_id, tid = wave * 64 + lane; (void)tid; \
    const int gw = bx * 8 + wave, gtid = bx * 512 + tid; (void)gw; (void)gtid; (void)lane; \
    unsigned char* ws = hide_p(p.ws); float* out = hide_p(p.out); (void)out; \
    unsigned* ctl = (unsigned*)(ws + WS_CTL); float* rot = (float*)(ws + WS_ROT); (void)ctl; (void)rot; \
    bf16_t* WIN = (bf16_t*)(ws + WS_WIN); bf16_t* WCOMB = (bf16_t*)(ws + WS_WCOMB); bf16_t* WB = (bf16_t*)(ws + WS_WB); bf16_t* WO = (bf16_t*)(ws + WS_WO); (void)WIN; (void)WCOMB; (void)WB; (void)WO; \
    bf16_t* WGU = (bf16_t*)(ws + WS_WGU); bf16_t* WD = (bf16_t*)(ws + WS_WD); (void)WGU; (void)WD; \
    bf16_t* P = (bf16_t*)(ws + WS_P); bf16_t* HMID = (bf16_t*)(ws + WS_HMID); bf16_t* Y = (bf16_t*)(ws + WS_Y); (void)P; (void)HMID; (void)Y; \
    bf16_t* XN = (bf16_t*)(ws + WS_XN); bf16_t* BA = XN; bf16_t* TN = XN; (void)BA; (void)TN; \
    bf16_t* OA = (bf16_t*)(ws + WS_OA); bf16_t* OB = OA + 1024;            bf16_t* MIXED = (bf16_t*)(ws + WS_MIXED); bf16_t* XG = (bf16_t*)(ws + WS_XG); (void)OA; (void)OB; (void)MIXED; (void)XG; \
    bf16_t* KV = (bf16_t*)(ws + WS_KV); u64* MASK = (u64*)(ws + WS_MASK); (void)KV; (void)MASK; \
    int* misc = (int*)(ws + WS_MISC); \
    int* row_tok = misc + MI_ROWTOK; float* row_gate = (float*)(misc + MI_ROWGATE); int* tok_slot = misc + MI_TOKSLOT; (void)row_tok; (void)row_gate; (void)tok_slot; \
    int* asg_e = misc + MI_ASGE; int* asg_r = misc + MI_ASGR; float* asg_g = (float*)(misc + MI_ASGG); (void)asg_e; (void)asg_r; (void)asg_g;
#define IN(k) hide_p(p.in[k])

    STAMP(0);
    {
        PH_LOCALS
        const float* x = IN(0); const float* g_mix = IN(1); const float* w_in = IN(2); const float* w_uv = IN(4); const float* w_branch = IN(6); const float* w_out = IN(7);
        constexpr int NB_WIN = 311;
        constexpr int I_WIN = 32 * NB_WIN, I_WB = 16 * 64, I_WO = 32 * 64;
        constexpr int I_TOTAL = I_WIN + I_WB + I_WO;
#pragma unroll 1
        for (int pass = 0; pass < 4; ++pass) {
        const int job = (pass + wave) & 3;
        if (job == 0) {
        for (int it = gw; it < I_TOTAL; it += NGW) {
            int r = it;
            if (r < I_WIN) { tr_item(w_in, 9928, WIN, 2048, r / NB_WIN, r % NB_WIN, lane, MapProj{}); continue; } r -= I_WIN;
            if (r < I_WB) { tr_item(w_branch + (size_t)1024 * 2048, 2048, WCOMB + 1024, 2048, r >> 6, r & 63, lane, MapId{});   continue; } r -= I_WB;
            tr_item(w_out, 2048, WO, 2048, r >> 6, r & 63, lane, MapId{});
        }
        for (int i = gtid; i < 56 * 256; i += NGT) ((u32x4*)(WIN + (size_t)1736 * 2048))[i] = (u32x4){0u, 0u, 0u, 0u};
        } else if (job == 1) {
        for (int it = gw; it < 2048; it += NGW) {
            const int h = it >> 8, ch = (it >> 7) & 1, n0 = (it & 127) * 16, c = ch * 64 + lane;
            const float* wuv = w_uv + ((size_t)h * 128 + c) * 128;
            const float* wa = w_branch + (size_t)(h * 128) * 2048 + n0;
            float a[16];
#pragma unroll
            for (int j = 0; j < 16; ++j) a[j] = 0.f;
#pragma unroll 4
            for (int d4 = 0; d4 < 32; ++d4) {
                const f32x4 wv = *(const f32x4*)(wuv + d4 * 4);
#pragma unroll
                for (int dd = 0; dd < 4; ++dd) {
                    const float* wr_ = wa + (size_t)(d4 * 4 + dd) * 2048;
#pragma unroll
                    for (int j4 = 0; j4 < 4; ++j4) { const f32x4 b = *(const f32x4*)(wr_ + j4 * 4); a[j4 * 4 + 0] += wv[dd] * b[0]; a[j4 * 4 + 1] += wv[dd] * b[1]; a[j4 * 4 + 2] += wv[dd] * b[2]; a[j4 * 4 + 3] += wv[dd] * b[3]; }
                }
            }
#pragma unroll
            for (int j = 0; j < 16; ++j) WCOMB[(size_t)(n0 + j) * 2048 + h * 128 + c] = (bf16_t)(pkbf(a[j], 0.f) & 0xffffu);
        }
        } else if (job == 2) {
        for (int m = gw; m < T_TOK; m += 2 * NGW) {
            const int m1 = (m + NGW < T_TOK) ? m + NGW : m;
            const f32x4* xr0 = (const f32x4*)(x + (size_t)m * DMODEL) + lane; const f32x4* xr1 = (const f32x4*)(x + (size_t)m1 * DMODEL) + lane;
            f32x4 v0[8], v1[8]; float s0 = 0.f, s1 = 0.f;
#pragma unroll
            for (int j = 0; j < 8; ++j) { v0[j] = xr0[64 * j]; v1[j] = xr1[64 * j]; }
#pragma unroll
            for (int j = 0; j < 8; ++j) { s0 += (v0[j][0] * v0[j][0] + v0[j][1] * v0[j][1]) + (v0[j][2] * v0[j][2] + v0[j][3] * v0[j][3]); s1 += (v1[j][0] * v1[j][0] + v1[j][1] * v1[j][1]) + (v1[j][2] * v1[j][2] + v1[j][3] * v1[j][3]); }
            const float r0 = 1.0f / sqrtf(wave_sum(s0, lane) * (1.0f / DMODEL) + EPS_F), r1 = 1.0f / sqrtf(wave_sum(s1, lane) * (1.0f / DMODEL) + EPS_F);
            u32x2* o0 = (u32x2*)(XN + (size_t)m * DMODEL) + lane; u32x2* o1 = (u32x2*)(XN + (size_t)m1 * DMODEL) + lane;
#pragma unroll
            for (int j = 0; j < 8; ++j) { const f32x4 gg = ((const f32x4*)g_mix)[lane + 64 * j];
                u32x2 w; w.x = pkbf(v0[j][0] * r0 * gg[0], v0[j][1] * r0 * gg[1]); w.y = pkbf(v0[j][2] * r0 * gg[2], v0[j][3] * r0 * gg[3]); o0[64 * j] = w;
                u32x2 w2; w2.x = pkbf(v1[j][0] * r1 * gg[0], v1[j][1] * r1 * gg[1]); w2.y = pkbf(v1[j][2] * r1 * gg[2], v1[j][3] * r1 * gg[3]); o1[64 * j] = w2; }
        }
        } else {
        for (int idx = gtid; idx < SEQL * 64; idx += NGT) {
            const int pos = idx >> 6, i = idx & 63; double f = 1.0;
            for (int k = 0; k < i; ++k) f *= 0.8659643233600653;
            double s, c; sincos_d((double)pos * f, s, c);
            rot[2 * idx] = (float)c; rot[2 * idx + 1] = (float)s;
        }
        { const float* g_ffn = IN(8); const float* w_rg = IN(9); const float* w_re = IN(11); float* WC = (float*)(ws + WS_WC);
          for (int idx = gtid; idx < 256 * 48 * 8; idx += NGT) { const int j = idx & 7, c = (idx >> 3) % 48, k = (idx / 384) * 8 + j;
              const float wv = (c < 4) ? w_rg[k * 4 + c] : (c < 36) ? w_re[k * 32 + (c - 4)] : 0.f; WC[idx] = wv * g_ffn[k]; } }
        }
        }
        for (int i = gtid; i < 32; i += NGT) ctl[64 * i] = 0u;
        if (gtid < 2) ctl[4096 + gtid] = 0u;
        for (int i = gtid; i < MAXSLOT; i += NGT) { row_tok[i] = 0; row_gate[i] = 0.f; ((float*)(ws + WS_WC + 524288))[i] = 0.f; }
    }
    GSYNC();
    STAMP(1);

    {
        PH_LOCALS
        const float* w_eg = IN(13); const float* w_eu = IN(14); const float* w_ed = IN(15);
        const int NGEMM = (G == 256) ? NGEMM_P1 : G;
        if (bx < NGEMM) {
            pg8::Gemm g{XN, WIN, T_TOK, NPROJ, 2048}; pg8::StaticOrder S; S.init(T_TOK, NPROJ, NGEMM, bx);
            pg8::EpiProj E{P, rot};
            pg8::gemm_phase<pg8::EpiProj, pg8::StaticOrder, true, true>(lds, g, S, E, tid);
        }
        convert_experts(w_eg, w_eu, w_ed, WGU, WD, ctl + CTL_QCTR, lane);
    }
    XBAR();
    STAMP(2);

    {
        PH_LOCALS
        const float* g_kv = IN(3);
        for (int t = gw; t < T_TOK; t += NGW) {
            const unsigned v = *(const unsigned*)(P + (size_t)t * NPROJ + C_CKV + 2 * lane);
            const float a = bflo(v), b = bfhi(v);
            const float rstd = 1.0f / sqrtf(wave_sum(a * a + b * b, lane) * (1.0f / 128.0f) + EPS_F);
            *(unsigned*)(KV + (size_t)t * 128 + 2 * lane) = pkbf(a * rstd * g_kv[2 * lane], b * rstd * g_kv[2 * lane + 1]);
        }
#if DBG_CMP == 3
        {
        u64* MASKX = (u64*)(ws + WS_SPARE);
        LAS float* qi = (LAS float*)(lds + wave * 10240); LAS float* sc = qi + 512;
        for (int t = gw; t < T_TOK; t += NGW) {
            const int b = t >> 11, q = t & 2047, ng = (q >> 6) + 1;
            { const u32x4 v = *(const u32x4*)(P + (size_t)t * NPROJ + C_QIDX + lane * 8);
              f32x4 lo4 = (f32x4){bflo(v.x), bfhi(v.x), bflo(v.y), bfhi(v.y)}, hi4 = (f32x4){bflo(v.z), bfhi(v.z), bflo(v.w), bfhi(v.w)};
              *(LAS f32x4*)(qi + lane * 8) = lo4; *(LAS f32x4*)(qi + lane * 8 + 4) = hi4; }
            float w[8];
            { const u32x4 v = *(const u32x4*)(P + (size_t)t * NPROJ + C_WIDX); w[0] = bflo(v.x); w[1] = bfhi(v.x); w[2] = bflo(v.y); w[3] = bfhi(v.y); w[4] = bflo(v.z); w[5] = bfhi(v.z); w[6] = bflo(v.w); w[7] = bfhi(v.w); }
            for (int g = 0; g < ng; ++g) {
                LAS float* qg = qi; asm volatile("" : "+v"(qg));
                const int s = g * 64 + lane; const u32x4* kr = (const u32x4*)(P + (size_t)(b * SEQL + s) * NPROJ + C_KIDX);
                float dot[8];
#pragma unroll
                for (int h = 0; h < 8; ++h) dot[h] = 0.f;
#pragma unroll
                for (int c = 0; c < 8; ++c) {
                    const u32x4 v = kr[c];
                    const f32x4 ka = (f32x4){bflo(v.x), bfhi(v.x), bflo(v.y), bfhi(v.y)}, kb = (f32x4){bflo(v.z), bfhi(v.z), bflo(v.w), bfhi(v.w)};
#pragma unroll
                    for (int h = 0; h < 8; ++h) {
                        const f32x4 qa = *(const LAS f32x4*)(qg + h * 64 + c * 8), qb = *(const LAS f32x4*)(qg + h * 64 + c * 8 + 4);
                        dot[h] += (qa[0] * ka[0] + qa[1] * ka[1]) + (qa[2] * ka[2] + qa[3] * ka[3]) + (qb[0] * kb[0] + qb[1] * kb[1]) + (qb[2] * kb[2] + qb[3] * kb[3]);
                    }
                }
                float score = 0.f;
#pragma unroll
                for (int h = 0; h < 8; ++h) score += w[h] * fmaxf(dot[h], 0.f);
                sc[s] = score * IDX_SCALE;
            }
            u64* mrow = MASKX + (size_t)t * 32;
            if (ng <= 4) { if (lane < 32) mrow[lane] = (lane < ng) ? ~0ull : 0ull; }
            else {
                unsigned lo = 0u;
                for (int bit = 31; bit >= 0; --bit) {
                    const unsigned cand = lo | (1u << bit); int cnt = 0;
                    for (int g = 0; g < ng; ++g) cnt += __popcll(__ballot(fkey(sc[g * 64 + lane]) >= cand));
                    if (cnt >= 256) lo = cand;
                }
                const unsigned tau = lo; int cgt = 0;
                for (int g = 0; g < ng; ++g) cgt += __popcll(__ballot(fkey(sc[g * 64 + lane]) > tau));
                const int need = 256 - cgt; int run = 0;
                for (int g = 0; g < ng; ++g) {
                    const unsigned key = fkey(sc[g * 64 + lane]);
                    const u64 gt = __ballot(key > tau), eq = __ballot(key == tau);
                    const u64 below = eq & ((1ull << lane) - 1ull);
                    const bool sel = (key == tau) && (run + (int)__popcll(below) < need);
                    const u64 word = gt | __ballot(sel);
                    run += (int)__popcll(eq);
                    if (lane == 0) mrow[g] = word;
                }
                if (lane >= ng && lane < 32) mrow[lane] = 0ull;
            }
        }
        }
        __syncthreads();
#endif
        typedef short bf16x8_t __attribute__((ext_vector_type(8)));
        constexpr int SCS = 2052;
        LAS float* scl = (LAS float*)lds;
        LAS unsigned* hist = (LAS unsigned*)(lds + 16 * SCS * 4);
        LAS unsigned* candl = hist + 16 * 256 + wave * 64;
        for (int i = tid; i < 16 * 256; i += 512) hist[i] = 0u;
        __syncthreads();
        for (int ui = 0; ui < 4; ++ui) {
            const int uu = ui * 256 + ((ui & 1) ? 255 - bx : bx);
            if (uu >= 1024 || bx >= 256) break;
            const int b = uu & 7, qblk = uu >> 3, q0 = qblk * 16, t0 = b * SEQL + q0, ng = (q0 >> 6) + 1, N = ng * 64;
            if (ng <= 4) {
                for (int qq = 0; qq < 2; ++qq) { u64* mrow = MASK + (size_t)(t0 + 2 * wave + qq) * 32; if (lane < 32) mrow[lane] = (lane < ng) ? ~0ull : 0ull; }
                continue;
            }
            const int qrow = lane & 15, kg = lane >> 4;
            bf16x8_t qf[8][2]; float w[8];
            { const bf16_t* qp = P + (size_t)(t0 + qrow) * NPROJ + C_QIDX + 8 * kg;
#pragma unroll
              for (int h = 0; h < 8; ++h) { qf[h][0] = *(const bf16x8_t*)(qp + h * 64); qf[h][1] = *(const bf16x8_t*)(qp + h * 64 + 32); }
              const u32x4 v = *(const u32x4*)(P + (size_t)(t0 + qrow) * NPROJ + C_WIDX); w[0] = bflo(v.x); w[1] = bfhi(v.x); w[2] = bflo(v.y); w[3] = bfhi(v.y); w[4] = bflo(v.z); w[5] = bfhi(v.z); w[6] = bflo(v.w); w[7] = bfhi(v.w); }
            for (int kt = wave; kt < N / 16; kt += 8) {
                const int s0 = kt * 16;
                const bf16_t* kp = P + (size_t)(b * SEQL + s0 + qrow) * NPROJ + C_KIDX + 8 * kg;
                const bf16x8_t a0 = *(const bf16x8_t*)kp, a1 = *(const bf16x8_t*)(kp + 32);
                f32x4 sacc = (f32x4){0.f, 0.f, 0.f, 0.f};
#pragma unroll
                for (int h = 0; h < 8; ++h) {
                    f32x4 acc = (f32x4){0.f, 0.f, 0.f, 0.f};
                    acc = __builtin_amdgcn_mfma_f32_16x16x32_bf16(a0, qf[h][0], acc, 0, 0, 0);
                    acc = __builtin_amdgcn_mfma_f32_16x16x32_bf16(a1, qf[h][1], acc, 0, 0, 0);
                    sacc[0] += w[h] * fmaxf(acc[0], 0.f); sacc[1] += w[h] * fmaxf(acc[1], 0.f); sacc[2] += w[h] * fmaxf(acc[2], 0.f); sacc[3] += w[h] * fmaxf(acc[3], 0.f);
                }
                sacc = sacc * IDX_SCALE + 0.0f;
                *(LAS f32x4*)(scl + qrow * SCS + s0 + 4 * kg) = sacc;
#pragma unroll
                for (int i = 0; i < 4; ++i) __hip_atomic_fetch_add(hist + qrow * 256 + sbin(sacc[i]), 1u, __ATOMIC_RELAXED, __HIP_MEMORY_SCOPE_WORKGROUP);
            }
            __syncthreads();
#pragma unroll 1
            for (int qq = 0; qq < 2; ++qq) {
                const int q = 2 * wave + qq; const LAS float* row = scl + q * SCS; LAS unsigned* hq = hist + q * 256;
                unsigned key[32];
#pragma unroll
                for (int j = 0; j < 32; ++j) key[j] = (j < ng) ? fkey(row[64 * j + lane]) : 0u;
                const u32x4 hv = *(const LAS u32x4*)(hq + 4 * lane);
                *(LAS u32x4*)(hq + 4 * lane) = (u32x4){0u, 0u, 0u, 0u};
                const int tsum = (int)(hv.x + hv.y + hv.z + hv.w); int incl = tsum;
#pragma unroll
                for (int off = 1; off < 64; off <<= 1) { const int o = __builtin_amdgcn_ds_bpermute(((lane + off) & 63) << 2, incl); incl += (lane + off < 64) ? o : 0; }
                const int suf = incl - tsum;
                int bt_l, ab_l;
                if (suf + (int)hv.w >= 256) { bt_l = 4 * lane + 3; ab_l = suf; }
                else if (suf + (int)(hv.w + hv.z) >= 256) { bt_l = 4 * lane + 2; ab_l = suf + (int)hv.w; }
                else if (suf + (int)(hv.w + hv.z + hv.y) >= 256) { bt_l = 4 * lane + 1; ab_l = suf + (int)(hv.w + hv.z); }
                else { bt_l = 4 * lane; ab_l = suf + (int)(hv.w + hv.z + hv.y); }
                const u64 cb = __ballot(suf < 256 && incl >= 256);
                const int src = (int)__builtin_ctzll(cb | (1ull << 63));
                const int bt = __builtin_amdgcn_readlane(bt_l, src), above = __builtin_amdgcn_readlane(ab_l, src);
                const int r = 256 - above;
                int C = 0;
#pragma unroll
                for (int j = 0; j < 32; ++j) {
                    const bool isc = (key[j] != 0u) && (sbin(unkey(key[j])) == bt);
                    const u64 bal = __ballot(isc);
                    if (isc) { const int pos = C + (int)__popcll(bal & ((1ull << lane) - 1ull)); if (pos < 64) candl[pos] = key[j]; }
                    C += (int)__popcll(bal);
                }
                unsigned tau; int cgt;
                if (C <= 64) {
                    asm volatile("s_waitcnt lgkmcnt(0)" ::: "memory");
                    const unsigned ck = (lane < C) ? candl[lane] : 0u;
                    unsigned lo = 0u;
#pragma unroll 1
                    for (int bit = 31; bit >= 0; --bit) { const unsigned cand = lo | (1u << bit); if ((int)__popcll(__ballot(ck >= cand)) >= r) lo = cand; }
                    tau = lo; cgt = above + (int)__popcll(__ballot(ck > tau));
                } else {
                    unsigned lo = 0u;
#pragma unroll 1
                    for (int bit = 31; bit >= 0; --bit) {
                        const unsigned cand = lo | (1u << bit); int c = 0;
#pragma unroll
                        for (int j = 0; j < 32; ++j) c += (key[j] >= cand) ? 1 : 0;
#pragma unroll
                        for (int x = 1; x < 64; x <<= 1) c += __builtin_amdgcn_ds_bpermute((lane ^ x) << 2, c);
                        if (c >= 256) lo = cand;
                    }
                    tau = lo; cgt = 0;
#pragma unroll
                    for (int j = 0; j < 32; ++j) cgt += (key[j] > tau) ? 1 : 0;
#pragma unroll
                    for (int x = 1; x < 64; x <<= 1) cgt += __builtin_amdgcn_ds_bpermute((lane ^ x) << 2, cgt);
                }
                const int need = 256 - cgt; int run = 0; u64 myword = 0ull;
#pragma unroll
                for (int j = 0; j < 32; ++j) {
                    const u64 gt = __ballot(key[j] > tau), eq = __ballot(key[j] == tau);
                    const u64 below = eq & ((1ull << lane) - 1ull);
                    const bool sel = (key[j] == tau) && (run + (int)__popcll(below) < need);
                    const u64 word = gt | __ballot(sel);
                    run += (int)__popcll(eq);
                    if (lane == j) myword = word;
                    __builtin_amdgcn_sched_barrier(0);
                }
                if (lane < 32) MASK[(size_t)(t0 + q) * 32 + lane] = myword;
            }
            __syncthreads();
        }
    }
    XBAR();
    STAMP(3);

#if DBG_CMP == 1
    {
        PH_LOCALS
        bf16_t* OAX = (bf16_t*)(ws + WS_SPARE);
        float* qv = (float*)(lds_raw + wave * 10240); float* lg = qv + 512;
        for (int it = gw; it < T_TOK * 8; it += NGW) {
            const int t = it >> 3, h = it & 7, b = t >> 11, q = t & 2047, ng = (q >> 6) + 1;
            { const unsigned v = *(const unsigned*)(P + (size_t)t * NPROJ + C_QLAT + h * 128 + 2 * lane); qv[2 * lane] = bflo(v); qv[2 * lane + 1] = bfhi(v); }
            const u64* mrow = MASK + (size_t)t * 32;
            float mx = -INFINITY;
            for (int g = 0; g < ng; ++g) {
                asm volatile("" ::: "memory");
                const u64 word = mrow[g]; float l = -INFINITY;
                if ((word >> lane) & 1ull) {
                    const u32x4* kr = (const u32x4*)(KV + (size_t)(b * SEQL + g * 64 + lane) * 128);
                    float d0 = 0.f, d1 = 0.f, d2 = 0.f, d3 = 0.f;
#pragma unroll
                    for (int c = 0; c < 16; ++c) { const u32x4 v = kr[c]; const f32x4 qa = *(const f32x4*)(qv + 8 * c), qb = *(const f32x4*)(qv + 8 * c + 4);
                        d0 += qa[0] * bflo(v.x) + qb[0] * bflo(v.z); d1 += qa[1] * bfhi(v.x) + qb[1] * bfhi(v.z); d2 += qa[2] * bflo(v.y) + qb[2] * bflo(v.w); d3 += qa[3] * bfhi(v.y) + qb[3] * bfhi(v.w); }
                    l = ((d0 + d1) + (d2 + d3)) * ATT_SCALE;
                }
                lg[g * 64 + lane] = l; mx = fmaxf(mx, l);
            }
            mx = wave_max(mx, lane);
            float o0 = 0.f, o1 = 0.f, sum = 0.f;
            for (int g = 0; g < ng; ++g) {
                const u64 wv = mrow[g];
                u64 word = ((u64)__builtin_amdgcn_readfirstlane((unsigned)(wv >> 32)) << 32) | (u64)__builtin_amdgcn_readfirstlane((unsigned)wv);
                while (word) {
                    const int j = __builtin_ctzll(word); word &= word - 1ull;
                    const int s = g * 64 + j; const float pj = __expf(lg[s] - mx);
                    const unsigned v = *(const unsigned*)(KV + (size_t)(b * SEQL + s) * 128 + 2 * lane);
                    o0 += pj * bflo(v); o1 += pj * bfhi(v); sum += pj;
                }
            }
            const float inv = 1.0f / sum;
            *(unsigned*)(OAX + (size_t)t * 1024 + h * 128 + 2 * lane) = pkbf(o0 * inv, o1 * inv);
        }
    }
    __syncthreads();
#endif
#if DBG_CMP == 2
    {
        PH_LOCALS
        const float* g_ret = IN(5);
        bf16_t* OBX = (bf16_t*)(ws + WS_SPARE);
        float* qv = (float*)(lds_raw + wave * 10240); float* lg = qv + 512; float* wl = lg;
        for (int it = gw; it < T_TOK * 8; it += NGW) {
            const int t = it >> 3, h = it & 7, b = t >> 11, n = t & 2047, ng = (n >> 6) + 1;
            const float lgam = (h == 0) ? -0.04580368961312479f : (h == 1) ? -0.02272007650008353f : (h == 2) ? -0.011315313227834146f : (h == 3) ? -0.005646563141142063f :
                               (h == 4) ? -0.0028205190623786626f : (h == 5) ? -0.0014095702546713536f : (h == 6) ? -0.0007046129765893727f : -0.0003522634716290214f;
            { const unsigned v = *(const unsigned*)(P + (size_t)t * NPROJ + C_QR + h * 128 + 2 * lane); qv[2 * lane] = bflo(v); qv[2 * lane + 1] = bfhi(v); }
            float o0 = 0.f, o1 = 0.f;
            for (int g = 0; g < ng; ++g) {
                asm volatile("" ::: "memory");
                const int m = g * 64 + lane;
                const u32x4* kr = (const u32x4*)(P + (size_t)(b * SEQL + m) * NPROJ + C_KR + h * 128);
                float d0 = 0.f, d1 = 0.f, d2 = 0.f, d3 = 0.f;
#pragma unroll
                for (int c = 0; c < 16; ++c) { const u32x4 v = kr[c]; const f32x4 qa = *(const f32x4*)(qv + 8 * c), qb = *(const f32x4*)(qv + 8 * c + 4);
                    d0 += qa[0] * bflo(v.x) + qb[0] * bflo(v.z); d1 += qa[1] * bfhi(v.x) + qb[1] * bfhi(v.z); d2 += qa[2] * bflo(v.y) + qb[2] * bflo(v.w); d3 += qa[3] * bfhi(v.y) + qb[3] * bfhi(v.w); }
                const float dot = (d0 + d1) + (d2 + d3);
                wl[lane] = (m <= n) ? dot * exp2f((float)(n - m) * lgam) : 0.f;
                const int jmax = (g == ng - 1) ? (n & 63) : 63;
                for (int j = 0; j <= jmax; ++j) {
                    const float wj = wl[j];
                    const unsigned v = *(const unsigned*)(P + (size_t)(b * SEQL + g * 64 + j) * NPROJ + C_VR + h * 128 + 2 * lane);
                    o0 += wj * bflo(v); o1 += wj * bfhi(v);
                }
            }
            const float mu = wave_sum(o0 + o1, lane) * (1.0f / 128.0f); const float e0 = o0 - mu, e1 = o1 - mu;
            const float rs = 1.0f / sqrtf(wave_sum(e0 * e0 + e1 * e1, lane) * (1.0f / 128.0f) + EPS_F);
            const unsigned gv = *(const unsigned*)(P + (size_t)t * NPROJ + C_GR + h * 128 + 2 * lane);
            const float y0 = siluf_(bflo(gv)) * e0 * rs * g_ret[h * 128 + 2 * lane], y1 = siluf_(bfhi(gv)) * e1 * rs * g_ret[h * 128 + 2 * lane + 1];
            *(unsigned*)(OBX + (size_t)t * 1024 + h * 128 + 2 * lane) = pkbf(y0, y1);
        }
    }
    __syncthreads();
#endif
    {
        PH_LOCALS
        for (int pr = bx; pr < 256; pr += G) {
            const int b = pr >> 5, i = pr & 31;
#pragma unroll 1
            for (int uu = 0; uu < 2; ++uu) {
                const int qb = uu ? 63 - i : i; const int t0 = b * SEQL + qb * 32;
                fa::UnitArgs U; U.Q = P + (size_t)t0 * NPROJ + C_QLAT; U.ldq = NPROJ; U.K = KV + (size_t)b * SEQL * 128; U.V = U.K; U.ldk = 128; U.mask = MASK + (size_t)t0 * 32;
                U.ntiles = (qb >> 1) + 1; U.n0 = 0; U.lgam = 0.f;
                fa::f32x16 o[4]; float l_reg;
                fa::unit_body<0>((LAS char*)lds, U, tid, o, l_reg);
                const int r32 = lane & 31, hi = lane >> 5;
                const int trow0 = hide_i(t0 + 4 * hi);
                LAS float* li_l = (LAS float*)(lds + fa::OFF_WS) + wave * 64;
                if (hi == 0) li_l[r32] = l_reg;
                asm volatile("s_waitcnt lgkmcnt(0)" ::: "memory");
#pragma unroll
                for (int r = 0; r < 16; ++r) {
                    const int orow = fa::crow(r, hi); const float rl = __builtin_amdgcn_rcpf(li_l[orow]);
                    bf16_t* op = OA + (size_t)(trow0 + (r & 3) + 8 * (r >> 2)) * 2048 + wave * 128 + r32;
#pragma unroll
                    for (int d0 = 0; d0 < 4; ++d0) op[d0 * 32] = (bf16_t)(pkbf(o[d0][r] * rl, 0.f) & 0xffffu);
                }
                __syncthreads();
            }
        }
    }
    STAMP(20);
    {
        PH_LOCALS
        const float* g_ret = IN(5);
        for (int pr = bx; pr < 256; pr += G) {
            const int bh = pr >> 2, i = pr & 3, b = bh >> 3, h = bh & 7;
            const float lgam = (h == 0) ? -0.04580368961312479f : (h == 1) ? -0.02272007650008353f : (h == 2) ? -0.011315313227834146f : (h == 3) ? -0.005646563141142063f :
                               (h == 4) ? -0.0028205190623786626f : (h == 5) ? -0.0014095702546713536f : (h == 6) ? -0.0007046129765893727f : -0.0003522634716290214f;
#pragma unroll 1
            for (int uu = 0; uu < 2; ++uu) {
                const int qb = uu ? 7 - i : i; const int n0 = qb * 256;
                fa::UnitArgs U; U.Q = P + (size_t)(b * SEQL + n0) * NPROJ + C_QR + h * 128; U.ldq = NPROJ;
                U.K = P + (size_t)(b * SEQL) * NPROJ + C_KR + h * 128; U.V = P + (size_t)(b * SEQL) * NPROJ + C_VR + h * 128; U.ldk = NPROJ; U.mask = nullptr;
                U.ntiles = 4 * (qb + 1); U.n0 = n0; U.lgam = lgam;
                fa::f32x16 o[4]; float l_reg;
                fa::unit_body<1>((LAS char*)lds, U, tid, o, l_reg);
                const int r32 = lane & 31, hi = lane >> 5;
                const int tok0 = hide_i(b * SEQL + n0 + wave * 32 + 4 * hi);
                float gr[4];
#pragma unroll
                for (int d0 = 0; d0 < 4; ++d0) gr[d0] = g_ret[h * 128 + d0 * 32 + r32];
#pragma unroll
                for (int r = 0; r < 16; ++r) {
                    float s = (o[0][r] + o[1][r]) + (o[2][r] + o[3][r]);
#pragma unroll
                    for (int x = 1; x < 32; x <<= 1) s += shx(s, lane, x);
                    const float mu = s * (1.0f / 128.0f);
                    const float e0 = o[0][r] - mu, e1 = o[1][r] - mu, e2 = o[2][r] - mu, e3 = o[3][r] - mu;
                    float q = (e0 * e0 + e1 * e1) + (e2 * e2 + e3 * e3);
#pragma unroll
                    for (int x = 1; x < 32; x <<= 1) q += shx(q, lane, x);
                    const float rs = 1.0f / sqrtf(q * (1.0f / 128.0f) + EPS_F);
                    const size_t tok = (size_t)(tok0 + (r & 3) + 8 * (r >> 2));
                    const bf16_t* gp = P + tok * NPROJ + C_GR + h * 128 + r32; bf16_t* op = OB + tok * 2048 + h * 128 + r32;
                    op[0] = (bf16_t)(pkbf(siluf_(bflo((unsigned)gp[0])) * e0 * rs * gr[0], 0.f) & 0xffffu);
                    op[32] = (bf16_t)(pkbf(siluf_(bflo((unsigned)gp[32])) * e1 * rs * gr[1], 0.f) & 0xffffu);
                    op[64] = (bf16_t)(pkbf(siluf_(bflo((unsigned)gp[64])) * e2 * rs * gr[2], 0.f) & 0xffffu);
                    op[96] = (bf16_t)(pkbf(siluf_(bflo((unsigned)gp[96])) * e3 * rs * gr[3], 0.f) & 0xffffu);
                }
                __syncthreads();
            }
        }
    }
#if DBG_CMP
    XBAR();
    {
        PH_LOCALS
        const bf16_t* A_ = (DBG_CMP == 1) ? OA : OB; const bf16_t* R_ = (const bf16_t*)(ws + WS_SPARE);
        float sd = 0.f, sr = 0.f;
#if DBG_CMP == 3
        for (size_t i = (size_t)gtid; i < (size_t)T_TOK * 32; i += (size_t)NGT) { const u64 a = MASK[i], r = ((const u64*)(ws + WS_SPARE))[i]; sd += (float)__popcll(a ^ r); sr += 100.0f * (float)__popcll(r); }
#else
        for (size_t i = (size_t)gtid; i < (size_t)T_TOK * 1024 / 2; i += (size_t)NGT) {
            const unsigned a = ((const unsigned*)A_)[(i >> 9) * 1024 + (i & 511)], r = ((const unsigned*)R_)[i];
            const float d0 = bflo(a) - bflo(r), d1 = bfhi(a) - bfhi(r); sd += d0 * d0 + d1 * d1; sr += bflo(r) * bflo(r) + bfhi(r) * bfhi(r);
        }
#endif
        sd = wave_sum(sd, lane); sr = wave_sum(sr, lane);
        if (lane == 0) { atomicAdd((float*)(ctl + 4096), sd); atomicAdd((float*)(ctl + 4097), sr); }
    }
#endif
    XBAR();
    STAMP(4);

    {
        PH_LOCALS
        pg8::Gemm g{OA, WCOMB, T_TOK, DMODEL, 2048}; pg8::StaticOrder S; S.init(T_TOK, DMODEL, G, bx);
        pg8::EpiMergeF E{P, MIXED};
        pg8::gemm_phase<pg8::EpiMergeF, pg8::StaticOrder, true, true>(lds, g, S, E, tid);
    }
    XBAR();
    STAMP(5);
    {
        PH_LOCALS
        const float* x = IN(0);
        pg8::Gemm g{MIXED, WO, T_TOK, DMODEL, 2048}; pg8::StaticOrder S; S.init(T_TOK, DMODEL, G, bx);
        pg8::EpiRes E{x, out};
        pg8::gemm_phase<pg8::EpiRes, pg8::StaticOrder, true, true>(lds, g, S, E, tid);
    }
    XBAR();
    STAMP(7);

    {
    PH_LOCALS
    const float* g_ffn = IN(8); const float* b_rg = IN(10); const float* b_re = IN(12);
    const f32x4* WC4 = (const f32x4*)(ws + WS_WC); float* tok_rs = (float*)(ws + WS_WC + 786432);
    LAS float* lg = (LAS float*)lds + wave * (16 * 52);
    const int row = lane & 15, g4 = lane >> 4;
    LAS float* part = (LAS float*)lds + 4 * (16 * 52) + (wave & 3) * (13 * 64);
    for (int tile0 = bx * 4; tile0 < T_TOK / 16; tile0 += G * 4) {
        const int tile = tile0 + (wave & 3), kh = wave >> 2;
        const int tok0 = tile * 16;
        const float* hrow = out + (size_t)(tok0 + row) * DMODEL + 8 * g4 + 1024 * kh;
        bf16_t* trow = TN + (size_t)(tok0 + row) * DMODEL + 8 * g4 + 1024 * kh;
        const f32x4* wp = WC4 + (size_t)g4 * 96 + 2 * row + (size_t)kh * 32 * 384;
        const float* gp = g_ffn + 8 * g4 + 1024 * kh;
        f32x4 acc0 = (f32x4){0.f, 0.f, 0.f, 0.f}, acc1 = acc0, acc2 = acc0; float ssq = 0.f;
        f32x4 a0 = *(const f32x4*)(hrow), a1 = *(const f32x4*)(hrow + 4);
        f32x4 b00 = wp[0], b01 = wp[1], b10 = wp[32], b11 = wp[33], b20 = wp[64], b21 = wp[65];
        f32x4 na0 = *(const f32x4*)(hrow + 32), na1 = *(const f32x4*)(hrow + 36);
        f32x4 nb00 = wp[384], nb01 = wp[385], nb10 = wp[416], nb11 = wp[417], nb20 = wp[448], nb21 = wp[449];
        for (int it = 0; it < 32; ++it) {
            const int itn = (it + 2 < 32) ? it + 2 : 31;
            const f32x4 ma0 = *(const f32x4*)(hrow + 32 * itn), ma1 = *(const f32x4*)(hrow + 32 * itn + 4);
            const f32x4* wn = wp + (size_t)itn * 384;
            const f32x4 mb00 = wn[0], mb01 = wn[1], mb10 = wn[32], mb11 = wn[33], mb20 = wn[64], mb21 = wn[65];
            const f32x4 gk0 = *(const f32x4*)(gp + 32 * it), gk1 = *(const f32x4*)(gp + 32 * it + 4);
            ssq += (a0[0] * a0[0] + a0[1] * a0[1]) + (a0[2] * a0[2] + a0[3] * a0[3]) + (a1[0] * a1[0] + a1[1] * a1[1]) + (a1[2] * a1[2] + a1[3] * a1[3]);
            { u32x4 w; w.x = pkbf(a0[0] * gk0[0], a0[1] * gk0[1]); w.y = pkbf(a0[2] * gk0[2], a0[3] * gk0[3]); w.z = pkbf(a1[0] * gk1[0], a1[1] * gk1[1]); w.w = pkbf(a1[2] * gk1[2], a1[3] * gk1[3]);
              *(u32x4*)(trow + 32 * it) = w; }
#pragma unroll
            for (int s_ = 0; s_ < 4; ++s_) {
                acc0 = __builtin_amdgcn_mfma_f32_16x16x4f32(a0[s_], b00[s_], acc0, 0, 0, 0);
                acc1 = __builtin_amdgcn_mfma_f32_16x16x4f32(a0[s_], b10[s_], acc1, 0, 0, 0);
                acc2 = __builtin_amdgcn_mfma_f32_16x16x4f32(a0[s_], b20[s_], acc2, 0, 0, 0);
            }
#pragma unroll
            for (int s_ = 0; s_ < 4; ++s_) {
                acc0 = __builtin_amdgcn_mfma_f32_16x16x4f32(a1[s_], b01[s_], acc0, 0, 0, 0);
                acc1 = __builtin_amdgcn_mfma_f32_16x16x4f32(a1[s_], b11[s_], acc1, 0, 0, 0);
                acc2 = __builtin_amdgcn_mfma_f32_16x16x4f32(a1[s_], b21[s_], acc2, 0, 0, 0);
            }
            a0 = na0; a1 = na1; b00 = nb00; b01 = nb01; b10 = nb10; b11 = nb11; b20 = nb20; b21 = nb21;
            na0 = ma0; na1 = ma1; nb00 = mb00; nb01 = mb01; nb10 = mb10; nb11 = mb11; nb20 = mb20; nb21 = mb21;
        }
        if (kh == 1) {
#pragma unroll
            for (int r = 0; r < 4; ++r) { part[r * 64 + lane] = acc0[r]; part[(4 + r) * 64 + lane] = acc1[r]; part[(8 + r) * 64 + lane] = acc2[r]; }
            part[12 * 64 + lane] = ssq;
        }
        __syncthreads();
        if (kh == 0) {
#pragma unroll
            for (int r = 0; r < 4; ++r) { acc0[r] += part[r * 64 + lane]; acc1[r] += part[(4 + r) * 64 + lane]; acc2[r] += part[(8 + r) * 64 + lane]; }
            ssq += part[12 * 64 + lane];
        ssq += shx(ssq, lane, 16); ssq += shx(ssq, lane, 32);
        const float rstd = 1.0f / sqrtf(ssq * (1.0f / DMODEL) + EPS_F);
#pragma unroll
        for (int r = 0; r < 4; ++r) { lg[(4 * g4 + r) * 52 + row] = acc0[r]; lg[(4 * g4 + r) * 52 + 16 + row] = acc1[r]; lg[(4 * g4 + r) * 52 + 32 + row] = acc2[r]; }
        asm volatile("s_waitcnt lgkmcnt(0)" ::: "memory");
        if (lane < 16) {
            const int t = tok0 + lane; const LAS float* lr = lg + lane * 52;
            float gl[4];
#pragma unroll
            for (int k = 0; k < 4; ++k) gl[k] = lr[k] * rstd + b_rg[k];
            int grp = 0; float gmx = gl[0];
#pragma unroll
            for (int k = 1; k < 4; ++k) if (gl[k] > gmx) { gmx = gl[k]; grp = k; }
            float gz = 0.f;
#pragma unroll
            for (int k = 0; k < 4; ++k) gz += __expf(gl[k] - gmx);
            const float p_grp = 1.0f / gz;
            float el[8];
#pragma unroll
            for (int k = 0; k < 8; ++k) el[k] = lr[4 + grp * 8 + k] * rstd + b_re[grp * 8 + k];
            int i1 = 0; float m1 = el[0];
#pragma unroll
            for (int k = 1; k < 8; ++k) if (el[k] > m1) { m1 = el[k]; i1 = k; }
            int i2 = -1; float m2 = -INFINITY;
#pragma unroll
            for (int k = 0; k < 8; ++k) if (k != i1 && el[k] > m2) { m2 = el[k]; i2 = k; }
            const float e2 = __expf(m2 - m1); const float den = 1.0f / (1.0f + e2);
            const float g1 = p_grp * den, g2 = p_grp * e2 * den;
            const int ex1 = grp * 8 + i1, ex2 = grp * 8 + i2;
            const unsigned r1 = atomicAdd(ctl + 64 * ex1, 1u), r2 = atomicAdd(ctl + 64 * ex2, 1u);
            asg_e[2 * t] = ex1; asg_e[2 * t + 1] = ex2; asg_r[2 * t] = (int)r1; asg_r[2 * t + 1] = (int)r2; asg_g[2 * t] = g1; asg_g[2 * t + 1] = g2;
            tok_rs[t] = rstd;
        }
        }
        __syncthreads();
    }
    }
    XBAR();
    STAMP(8);

    LAS int* tile_start = (LAS int*)(lds + LDS_MISC);
    {
    PH_LOCALS
    if (tid == 0) {
        int acc_t = 0;
        for (int e = 0; e < 32; ++e) { tile_start[e] = acc_t; const int c = (int)__hip_atomic_load(ctl + 64 * e, __ATOMIC_RELAXED, __HIP_MEMORY_SCOPE_AGENT); acc_t += (c + 255) >> 8; }
        tile_start[32] = acc_t;
    }
    __syncthreads();
    for (int a = gtid; a < 2 * T_TOK; a += NGT) {
        const int t = a >> 1; const int e = asg_e[a], rk = asg_r[a]; const int slot = tile_start[e] * 256 + rk;
        row_tok[slot] = t; row_gate[slot] = asg_g[a]; tok_slot[a] = slot; ((float*)(ws + WS_WC + 524288))[slot] = ((const float*)(ws + WS_WC + 786432))[t];
    }
    }
    XBAR();
    STAMP(9);

    {
        PH_LOCALS
        pg8::Gemm g{TN, WGU, MAXSLOT, 2048, 2048}; pg8::ExpertOrderT<true> S{tile_start, G, bx, row_tok};
        pg8::EpiSwiglu E{HMID, (const float*)(ws + WS_WC + 524288)};
        pg8::gemm_phase<pg8::EpiSwiglu, pg8::ExpertOrderT<true>, true, true>(lds, g, S, E, tid);
    }
    XBAR();
    STAMP(10);
    {
        PH_LOCALS
        pg8::Gemm g{HMID, WD, MAXSLOT, 2048, 1024}; pg8::ExpertOrderT<false> S{tile_start, G, bx, nullptr};
        pg8::EpiDown E{Y, row_gate};
        pg8::gemm_phase<pg8::EpiDown, pg8::ExpertOrderT<false>, true, true>(lds, g, S, E, tid);
    }
    XBAR();
    STAMP(11);

    {
    PH_LOCALS
    const float* g_fin = IN(16);
#if DBG_CMP
    const float dbg_scale = 1.0f + 4.0f * sqrtf(__hip_atomic_load((float*)(ctl + 4096), __ATOMIC_RELAXED, __HIP_MEMORY_SCOPE_AGENT) / __hip_atomic_load((float*)(ctl + 4097), __ATOMIC_RELAXED, __HIP_MEMORY_SCOPE_AGENT));
#elif PROF_PHASE >= 0
    const unsigned ta_ = __hip_atomic_load(ctl + 6000 + (PROF_PHASE / 100), __ATOMIC_RELAXED, __HIP_MEMORY_SCOPE_AGENT), tb_ = __hip_atomic_load(ctl + 6000 + (PROF_PHASE % 100), __ATOMIC_RELAXED, __HIP_MEMORY_SCOPE_AGENT);
    const float dbg_scale = 1.0f + sqrtf(4e-6f * (float)(tb_ - ta_) * 0.01f);
#else
    const float dbg_scale = 1.0f;
#endif
    for (int t = gw; t < T_TOK; t += 2 * NGW) {
        const int t1 = (t + NGW < T_TOK) ? t + NGW : t;
        const int sa0 = tok_slot[2 * t], sa1 = tok_slot[2 * t + 1], sb0 = tok_slot[2 * t1], sb1 = tok_slot[2 * t1 + 1];
        f32x4* hra = (f32x4*)(out + (size_t)t * DMODEL) + lane; f32x4* hrb = (f32x4*)(out + (size_t)t1 * DMODEL) + lane;
        const u32x2* ya0 = (const u32x2*)(Y + (size_t)sa0 * DMODEL) + lane; const u32x2* ya1 = (const u32x2*)(Y + (size_t)sa1 * DMODEL) + lane;
        const u32x2* yb0 = (const u32x2*)(Y + (size_t)sb0 * DMODEL) + lane; const u32x2* yb1 = (const u32x2*)(Y + (size_t)sb1 * DMODEL) + lane;
        f32x4 va[8], vb[8]; u32x2 pa[8], qa[8], pb[8], qb[8];
#pragma unroll
        for (int j = 0; j < 8; ++j) { va[j] = hra[64 * j]; vb[j] = hrb[64 * j]; pa[j] = ya0[64 * j]; qa[j] = ya1[64 * j]; pb[j] = yb0[64 * j]; qb[j] = yb1[64 * j]; }
        float ssa = 0.f, ssb = 0.f;
#pragma unroll
        for (int j = 0; j < 8; ++j) {
            va[j][0] += bflo(pa[j].x) + bflo(qa[j].x); va[j][1] += bfhi(pa[j].x) + bfhi(qa[j].x); va[j][2] += bflo(pa[j].y) + bflo(qa[j].y); va[j][3] += bfhi(pa[j].y) + bfhi(qa[j].y);
            vb[j][0] += bflo(pb[j].x) + bflo(qb[j].x); vb[j][1] += bfhi(pb[j].x) + bfhi(qb[j].x); vb[j][2] += bflo(pb[j].y) + bflo(qb[j].y); vb[j][3] += bfhi(pb[j].y) + bfhi(qb[j].y);
            ssa += (va[j][0] * va[j][0] + va[j][1] * va[j][1]) + (va[j][2] * va[j][2] + va[j][3] * va[j][3]);
            ssb += (vb[j][0] * vb[j][0] + vb[j][1] * vb[j][1]) + (vb[j][2] * vb[j][2] + vb[j][3] * vb[j][3]);
        }
        const float ra = dbg_scale / sqrtf(wave_sum(ssa, lane) * (1.0f / DMODEL) + EPS_F), rb = dbg_scale / sqrtf(wave_sum(ssb, lane) * (1.0f / DMODEL) + EPS_F);
#pragma unroll
        for (int j = 0; j < 8; ++j) { const f32x4 gg = ((const f32x4*)g_fin)[lane + 64 * j]; hra[64 * j] = va[j] * ra * gg; if (t1 != t) hrb[64 * j] = vb[j] * rb * gg; }
    }
    }
}

extern "C" void kernel_launch(void* const* d_in, const int* in_sizes, int n_in, void* d_out, int out_size, void* d_ws, size_t ws_size, hipStream_t stream) {
    static int grid_blocks = 0;
    if (grid_blocks == 0) {
        if (n_in != 17 || out_size != T_TOK * DMODEL || ws_size < WS_END) { fprintf(stderr, "kernel_launch: unexpected problem (n_in %d, out %d, ws %zu < %zu)\n", n_in, out_size, ws_size, (size_t)WS_END); grid_blocks = -1; return; }
        int dev = 0, cus = 0, per_cu = 0;
        (void)hipGetDevice(&dev);
        (void)hipDeviceGetAttribute(&cus, hipDeviceAttributeMultiprocessorCount, dev);
        if (hipFuncSetAttribute((const void*)mega_fwd, hipFuncAttributeMaxDynamicSharedMemorySize, LDS_BYTES) != hipSuccess) { fprintf(stderr, "kernel_launch: hipFuncSetAttribute failed\n"); grid_blocks = -1; return; }
        if (hipOccupancyMaxActiveBlocksPerMultiprocessor(&per_cu, (const void*)mega_fwd, 512, LDS_BYTES) != hipSuccess || per_cu < 1) { fprintf(stderr, "kernel_launch: occupancy query says %d\n", per_cu); grid_blocks = -1; return; }
        grid_blocks = cus;
        fprintf(stderr, "kernel_launch: cus %d per_cu %d grid %d ws %zu need %zu\n", cus, per_cu, grid_blocks, ws_size, (size_t)WS_END);
    }
    if (grid_blocks < 0) return;
    if (hipMemsetAsync((char*)d_ws + WS_CTL, 0, 65536, stream) != hipSuccess) { fprintf(stderr, "kernel_launch: memset of control words failed\n"); return; }
    Params prm{};
    for (int i = 0; i < 17; ++i) prm.in[i] = (const float*)d_in[i];
    prm.out = (float*)d_out; prm.ws = (unsigned char*)d_ws;
    void* args[] = {&prm};
    hipError_t e = hipLaunchCooperativeKernel((void*)mega_fwd, dim3(grid_blocks), dim3(512), args, LDS_BYTES, stream);
    if (e != hipSuccess) fprintf(stderr, "cooperative launch failed: %s (grid %d)\n", hipGetErrorString(e), grid_blocks);
}
```

```cpp
#include <hip/hip_runtime.h>
#include <hip/hip_cooperative_groups.h>
#include <cstdio>
#include <cstdint>
namespace cg = cooperative_groups;
namespace pg8 {
#define PG8_LAS __attribute__((address_space(3)))
typedef unsigned short bf16_t;
typedef short bf16x8 __attribute__((ext_vector_type(8)));
typedef float f32x4 __attribute__((ext_vector_type(4)));
typedef unsigned u32x4 __attribute__((ext_vector_type(4)));
constexpr int BM = 256, BK = 64, HALF = 128, HTB = HALF * BK * 2  , STAGE_BYTES = 8 * HTB, NXCD = 8, WGM = 8;

__host__ __device__ __forceinline__ int lds_byte(int r, int c) { const int st = (r >> 4) * 2 + (c >> 5), rr = r & 15, cc = c & 31, ob = rr * 64 + cc * 2; return st * 1024 + (ob ^ (((ob >> 9) & 1) << 5)); }
__host__ __device__ __forceinline__ void stage_rc(int b, int& R, int& C) { const int st = b / 1024, sb = b % 1024, swz = sb ^ (((sb >> 9) & 1) << 5); R = (st >> 1) * 16 + swz / 64; C = (st & 1) * 32 + (swz % 64) / 2; }
__host__ __device__ __forceinline__ int perm32(int rho) { const int n = rho >> 4, i = rho & 15; return 8 * (i >> 2) + 4 * n + (i & 3); }

struct Unit { int pm, pn, e; };
struct Gemm { const bf16_t* A; const bf16_t* Bt; int M, N, K; };

struct StaticOrder {
    int nM, nN, nwg, G, c;
    __host__ __device__ void init(int M, int N, int G_, int c_) { nM = M / BM; nN = N / BM; nwg = nM * nN; G = G_; c = c_; }
    __host__ __device__ bool next(int i, Unit& u) const {
        const long L = (long)i * G + c; if (L >= nwg) return false;
        int wgid = (int)L; { const int q = nwg / NXCD, r = nwg % NXCD, xcd = wgid % NXCD, off = wgid / NXCD; wgid = (xcd < r ? xcd * (q + 1) : r * (q + 1) + (xcd - r) * q) + off; }
        const int nig = WGM * nN, gid = wgid / nig, fm = gid * WGM, gsz = (nM - fm) < WGM ? (nM - fm) : WGM;
        u.pm = fm + ((wgid % nig) % gsz); u.pn = (wgid % nig) / gsz; u.e = 0; return true;
    }
    static constexpr bool GATHER = false;
    __device__ __forceinline__ unsigned rowoff(int) const { return 0u; }
    __device__ __forceinline__ void a_ready(const Unit&) const {}
    __device__ __forceinline__ void done(const Unit&) const {}
};

template <class Epi, class Sched, bool ALIGN_EPI = false, bool SP2 = false>
__device__ __forceinline__ void gemm_phase(PG8_LAS unsigned char* lds, const Gemm g, const Sched& S, const Epi& E, const int tid) {
    const int wid = __builtin_amdgcn_readfirstlane(tid >> 6), lane = tid & 63, wr = wid >> 2, wc = wid & 3, fr = lane & 15, fq = lane >> 4;
    const int K = g.K, nt = K / BK;
    constexpr bool GA = Sched::GATHER;
    static_assert(!GA || SP2, "the gather path is written for the SP2 loop");
    unsigned voffA[2], voffB[2]; int gR[2], gC[2];
#pragma unroll
    for (int i = 0; i < 2; ++i) { int R, C; stage_rc(tid * 16 + i * 8192, R, C); const int Rb = Epi::PERM ? ((R & ~31) + perm32(R & 31)) : R;
        voffA[i] = (unsigned)(R * K + C) * 2u; voffB[i] = (unsigned)(Rb * K + C) * 2u; gR[i] = R; gC[i] = C; }
    unsigned cvo0[2] = {0u, 0u}, cvo1[2] = {0u, 0u}, nvo0[2] = {0u, 0u}, nvo1[2] = {0u, 0u}, sel0[2] = {0u, 0u}, sel1[2] = {0u, 0u};
#define PG8_GOFF(u_, o0_, o1_) do { _Pragma("unroll") for (int _i = 0; _i < 2; ++_i) { \
        o0_[_i] = S.rowoff((u_).pm * BM + gR[_i]) * (unsigned)(K * 2) + (unsigned)gC[_i] * 2u; o1_[_i] = S.rowoff((u_).pm * BM + HALF + gR[_i]) * (unsigned)(K * 2) + (unsigned)gC[_i] * 2u; } } while (0)
#define PG8_STAGE_A(bufoff, base, h_, CUR_) do { if constexpr (GA) { if (CUR_) { if (h_) PG8_STAGE(bufoff, base, cvo1); else PG8_STAGE(bufoff, base, cvo0); } else { if (h_) PG8_STAGE(bufoff, base, sel1); else PG8_STAGE(bufoff, base, sel0); } } \
        else PG8_STAGE(bufoff, (base) + (h_) * hstep, voffA); } while (0)
    const size_t kstep = (size_t)(BK * 2);
    const size_t hstep = (size_t)HALF * K * 2;
    const size_t tstep = 2 * hstep;
    const unsigned ldsw = (unsigned)wid * 1024u;
    const int aoff = lds_byte(wr * 64 + fr, fq * 8), boff = lds_byte(wc * 32 + fr, fq * 8);
#define PG8_SA(b, h) (((b) * 2 + (h)) * HTB)
#define PG8_SB(b, h) ((4 + (b) * 2 + (h)) * HTB)
#define PG8_STAGE(bufoff, gbase, voff) do { _Pragma("unroll") for (int _i = 0; _i < 2; ++_i) \
        __builtin_amdgcn_global_load_lds((const unsigned*)((const char*)(gbase) + (voff)[_i]), (PG8_LAS unsigned*)(lds + (bufoff) + ldsw + _i * 8192), 16, 0, 0); } while (0)
#define PG8_LDA(dst, b, h) do { _Pragma("unroll") for (int m = 0; m < 4; ++m) _Pragma("unroll") for (int k = 0; k < 2; ++k) dst[m][k] = *(const PG8_LAS bf16x8*)(lds + PG8_SA(b, h) + aoff + m * 2048 + k * 1024); } while (0)
#define PG8_LDB(dst, b, h) do { _Pragma("unroll") for (int n = 0; n < 2; ++n) _Pragma("unroll") for (int k = 0; k < 2; ++k) dst[n][k] = *(const PG8_LAS bf16x8*)(lds + PG8_SB(b, h) + boff + n * 2048 + k * 1024); } while (0)
#define PG8_MMA(ai, bj, At, Bt) do { __builtin_amdgcn_s_setprio(1); _Pragma("unroll") for (int m = 0; m < 4; ++m) _Pragma("unroll") for (int n = 0; n < 2; ++n) _Pragma("unroll") for (int k = 0; k < 2; ++k) \
        acc[ai][bj][m][n] = __builtin_amdgcn_mfma_f32_16x16x32_bf16(Bt[n][k], At[m][k], acc[ai][bj][m][n], 0, 0, 0); __builtin_amdgcn_s_setprio(0); } while (0)
#define PG8_WAIT_V(n) asm volatile("s_waitcnt vmcnt(" #n ")" ::: "memory")
#define PG8_WAIT_L(n) asm volatile("s_waitcnt lgkmcnt(" #n ")" ::: "memory")
#define PG8_BAR __builtin_amdgcn_s_barrier()
#define PG8_SCHED __builtin_amdgcn_sched_barrier(0)
    Unit cur, nxt; int ui = 0;
    if (!S.next(0, cur)) return;
    f32x4 acc[2][2][4][2];
#pragma unroll
    for (int a = 0; a < 2; ++a)
#pragma unroll
        for (int b = 0; b < 2; ++b)
#pragma unroll
            for (int m = 0; m < 4; ++m)
#pragma unroll
                for (int n = 0; n < 2; ++n) acc[a][b][m][n] = (f32x4){0.f, 0.f, 0.f, 0.f};
    bf16x8 At[4][2], B0[2][2], B1[2][2];
    const size_t estep = (size_t)g.N * K * 2;
    const char* cA = (const char*)g.A + (GA ? (size_t)0 : (size_t)cur.pm * tstep); const char* cB = (const char*)g.Bt + (size_t)cur.e * estep + (size_t)cur.pn * tstep;
    S.a_ready(cur);
    if constexpr (GA) PG8_GOFF(cur, cvo0, cvo1);
    if constexpr (SP2) {
        PG8_STAGE(PG8_SB(0, 0), cB, voffB); PG8_STAGE(PG8_SB(0, 1), cB + hstep, voffB); PG8_STAGE_A(PG8_SA(0, 0), cA, 0, true); PG8_STAGE_A(PG8_SA(0, 1), cA, 1, true);
        if (wr == 1) PG8_BAR;
        PG8_WAIT_V(2); PG8_BAR;
        PG8_STAGE(PG8_SB(1, 0), cB + kstep, voffB); PG8_STAGE_A(PG8_SA(1, 0), cA + kstep, 0, true); PG8_STAGE(PG8_SB(1, 1), cB + hstep + kstep, voffB);
        PG8_WAIT_V(6); PG8_BAR;
    } else {
        PG8_STAGE(PG8_SB(0, 0), cB, voffB); PG8_STAGE(PG8_SA(0, 0), cA, voffA); PG8_STAGE(PG8_SB(0, 1), cB + hstep, voffB); PG8_STAGE(PG8_SA(0, 1), cA + hstep, voffA);
        if (wr == 1) PG8_BAR;
        PG8_WAIT_V(4); PG8_BAR;
        PG8_STAGE(PG8_SB(1, 0), cB + kstep, voffB); PG8_STAGE(PG8_SA(1, 0), cA + kstep, voffA); PG8_STAGE(PG8_SB(1, 1), cB + hstep + kstep, voffB);
        PG8_WAIT_V(6); PG8_BAR;
    }
    for (;;) {
        const bool has_next = S.next(ui + 1, nxt);
        const char* nA = has_next ? (const char*)g.A + (GA ? (size_t)0 : (size_t)nxt.pm * tstep) : cA;
        if constexpr (GA) { if (has_next) PG8_GOFF(nxt, nvo0, nvo1); else { nvo0[0] = cvo0[0]; nvo0[1] = cvo0[1]; nvo1[0] = cvo1[0]; nvo1[1] = cvo1[1]; } } const char* nB = has_next ? (const char*)g.Bt + (size_t)nxt.e * estep + (size_t)nxt.pn * tstep : cB;
        for (int t = 0; t < nt; t += 2) {
            const bool last = (t == nt - 2);
            const char* a1 = cA + (size_t)(t + 1) * kstep;
            const char* a2 = last ? nA : cA + (size_t)(t + 2) * kstep; const char* b2 = last ? nB : cB + (size_t)(t + 2) * kstep;
            const char* a3 = a2 + kstep; const char* b3 = b2 + kstep;
            if (last && has_next) S.a_ready(nxt);
            if constexpr (GA) { sel0[0] = last ? nvo0[0] : cvo0[0]; sel0[1] = last ? nvo0[1] : cvo0[1]; sel1[0] = last ? nvo1[0] : cvo1[0]; sel1[1] = last ? nvo1[1] : cvo1[1]; }
            if constexpr (Epi::HAS_MID) { if (t == nt / 2) E.mid(acc, cur, wr, wc, fr, fq); }
            if constexpr (SP2) {
            PG8_LDB(B0, 0, 0); PG8_LDB(B1, 0, 1); PG8_SCHED; PG8_LDA(At, 0, 0); PG8_STAGE_A(PG8_SA(1, 1), a1, 1, true);
            PG8_WAIT_V(8); PG8_WAIT_L(0); PG8_BAR; PG8_MMA(0, 0, At, B0); PG8_MMA(0, 1, At, B1); PG8_BAR; PG8_SCHED;
            PG8_LDA(At, 0, 1); PG8_STAGE(PG8_SB(0, 0), b2, voffB); PG8_STAGE(PG8_SB(0, 1), b2 + hstep, voffB); PG8_STAGE_A(PG8_SA(0, 0), a2, 0, false);
            PG8_WAIT_V(8); PG8_WAIT_L(0); PG8_BAR; PG8_MMA(1, 0, At, B0); PG8_MMA(1, 1, At, B1); PG8_BAR; PG8_SCHED;
            PG8_LDB(B0, 1, 0); PG8_LDB(B1, 1, 1); PG8_SCHED; PG8_LDA(At, 1, 0); PG8_STAGE_A(PG8_SA(0, 1), a2, 1, false);
            PG8_WAIT_V(8); PG8_WAIT_L(0); PG8_BAR; PG8_MMA(0, 0, At, B0); PG8_MMA(0, 1, At, B1); PG8_BAR; PG8_SCHED;
            PG8_LDA(At, 1, 1); PG8_STAGE(PG8_SB(1, 0), b3, voffB); PG8_STAGE(PG8_SB(1, 1), b3 + hstep, voffB); PG8_STAGE_A(PG8_SA(1, 0), a3, 0, false);
            PG8_WAIT_V(8); PG8_WAIT_L(0); PG8_BAR; PG8_MMA(1, 0, At, B0); PG8_MMA(1, 1, At, B1); PG8_BAR; PG8_SCHED;
            } else {
            PG8_LDB(B0, 0, 0); PG8_SCHED; PG8_LDA(At, 0, 0); PG8_STAGE(PG8_SA(1, 1), a1 + hstep, voffA);
            PG8_WAIT_L(8); PG8_BAR; PG8_WAIT_L(0); PG8_MMA(0, 0, At, B0); PG8_BAR; PG8_SCHED;
            PG8_LDB(B1, 0, 1); PG8_STAGE(PG8_SB(0, 0), b2, voffB);
            PG8_BAR; PG8_WAIT_L(0); PG8_MMA(0, 1, At, B1); PG8_BAR;
            PG8_LDA(At, 0, 1); PG8_STAGE(PG8_SA(0, 0), a2, voffA);
            PG8_BAR; PG8_WAIT_L(0); PG8_MMA(1, 0, At, B0); PG8_BAR; PG8_SCHED;
            PG8_STAGE(PG8_SB(0, 1), b2 + hstep, voffB);
            PG8_WAIT_V(6); PG8_BAR; PG8_MMA(1, 1, At, B1); PG8_BAR;
            PG8_LDB(B0, 1, 0); PG8_SCHED; PG8_LDA(At, 1, 0); PG8_STAGE(PG8_SA(0, 1), a2 + hstep, voffA);
            PG8_WAIT_L(8); PG8_BAR; PG8_WAIT_L(0); PG8_MMA(0, 0, At, B0); PG8_BAR; PG8_SCHED;
            PG8_LDB(B1, 1, 1); PG8_STAGE(PG8_SB(1, 0), b3, voffB);
            PG8_BAR; PG8_WAIT_L(0); PG8_MMA(0, 1, At, B1); PG8_BAR;
            PG8_LDA(At, 1, 1); PG8_STAGE(PG8_SA(1, 0), a3, voffA);
            PG8_BAR; PG8_WAIT_L(0); PG8_MMA(1, 0, At, B0); PG8_BAR; PG8_SCHED;
            PG8_STAGE(PG8_SB(1, 1), b3 + hstep, voffB);
            PG8_WAIT_V(6); PG8_BAR; PG8_MMA(1, 1, At, B1); PG8_BAR;
            }
        }
        if constexpr (ALIGN_EPI) { if (wr == 0) PG8_BAR; }
        if constexpr (!Epi::AFTER_DRAIN) { E(acc, cur, wr, wc, fr, fq); S.done(cur); }
        if (!has_next) break;
#pragma unroll
        for (int a = 0; a < 2; ++a)
#pragma unroll
            for (int b = 0; b < 2; ++b)
#pragma unroll
                for (int m = 0; m < 4; ++m)
#pragma unroll
                    for (int n = 0; n < 2; ++n) acc[a][b][m][n] = (f32x4){0.f, 0.f, 0.f, 0.f};
        cur = nxt; cA = nA; cB = nB; ++ui;
        if constexpr (GA) { cvo0[0] = nvo0[0]; cvo0[1] = nvo0[1]; cvo1[0] = nvo1[0]; cvo1[1] = nvo1[1]; }
        if constexpr (ALIGN_EPI) { if (wr == 1) PG8_BAR; }
    }
    PG8_WAIT_V(0);
    if constexpr (!ALIGN_EPI) { if (wr == 0) PG8_BAR; }
    PG8_BAR;
    if constexpr (Epi::AFTER_DRAIN) { E.fused(acc, cur, wr, wc, fr, fq, lds, wid, lane); S.done(cur); }
#undef PG8_SA
#undef PG8_SB
#undef PG8_STAGE
#undef PG8_STAGE_A
#undef PG8_GOFF
#undef PG8_LDA
#undef PG8_LDB
#undef PG8_MMA
#undef PG8_WAIT_V
#undef PG8_WAIT_L
#undef PG8_BAR
#undef PG8_SCHED
}
}

#ifndef DBG_CMP
#define DBG_CMP 0
#endif
#define LAS __attribute__((address_space(3)))
typedef unsigned short bf16_t;
typedef float f32x4 __attribute__((ext_vector_type(4)));
typedef unsigned u32x4 __attribute__((ext_vector_type(4)));
typedef unsigned u32x2 __attribute__((ext_vector_type(2)));
typedef unsigned long long u64;

constexpr int T_TOK = 16384, DMODEL = 2048, SEQL = 2048;
constexpr int NPROJ = 9984;
constexpr int C_QLAT = 0, C_CKV = 1024, C_QIDX = 1152, C_KIDX = 1664, C_WIDX = 1728, C_QR = 1792, C_KR = 2816, C_VR = 3840, C_GR = 4864, C_GBR = 5888;
constexpr int MAXSLOT = 40960;
constexpr float EPS_F = 1e-6f;
constexpr float IDX_SCALE = 0.04419417382415922f;
constexpr float ATT_SCALE = 0.08838834764831845f;
constexpr float K_SCALE = 0.08838834764831845f;

constexpr size_t WS_CTL = 0;
constexpr size_t WS_ROT = 65536;
constexpr size_t WS_WIN = WS_ROT + 1048576;
constexpr size_t WS_WCOMB = WS_WIN + (size_t)NPROJ * 2048 * 2;
constexpr size_t WS_WB = WS_WCOMB + (size_t)2048 * 1024 * 2;
constexpr size_t WS_WO = WS_WB + (size_t)2048 * 1024 * 2;
constexpr size_t WS_WGU = WS_WO + (size_t)2048 * 2048 * 2;
constexpr size_t WS_WD = WS_WGU + (size_t)32 * 2048 * 2048 * 2;
constexpr size_t WS_P = WS_WD + (size_t)32 * 2048 * 1024 * 2;
constexpr size_t WS_HMID = WS_P;
constexpr size_t WS_Y = WS_HMID + (size_t)MAXSLOT * 1024 * 2;
constexpr size_t WS_XN = WS_P + (size_t)T_TOK * NPROJ * 2;
constexpr size_t WS_OA = WS_XN + (size_t)T_TOK * 2048 * 2;
constexpr size_t WS_OB = WS_OA + (size_t)T_TOK * 1024 * 2;
constexpr size_t WS_MIXED = WS_OB + (size_t)T_TOK * 1024 * 2;
constexpr size_t WS_SPARE = WS_MIXED + (size_t)T_TOK * 2048 * 2;
constexpr size_t WS_XG = WS_OA;
constexpr size_t WS_KV = WS_SPARE + (size_t)T_TOK * 1024 * 2;
constexpr size_t WS_MASK = WS_KV + (size_t)T_TOK * 128 * 2;
constexpr size_t WS_MISC = WS_MASK + (size_t)T_TOK * 256;
constexpr size_t WS_WC = WS_MISC + 1048576;
constexpr size_t WS_END = WS_WC + 1048576;
static_assert(WS_Y + (size_t)MAXSLOT * 2048 * 2 <= WS_XN, "HMID + Y must fit in P");
static_assert(WS_XG + (size_t)MAXSLOT * 2048 * 2 <= WS_KV, "XG must fit in OA..SPARE");
static_assert(WS_END <= (size_t)1073741824, "workspace budget");
constexpr int MI_ROWTOK = 0, MI_ROWGATE = MAXSLOT, MI_TOKSLOT = 2 * MAXSLOT, MI_ASGE = MI_TOKSLOT + 2 * T_TOK, MI_ASGR = MI_ASGE + 2 * T_TOK, MI_ASGG = MI_ASGR + 2 * T_TOK;
static_assert((size_t)(MI_ASGG + 2 * T_TOK) * 4 <= 1048576, "misc budget");
constexpr int LDS_BYTES = 152 * 1024;
constexpr int LDS_MISC = 150 * 1024;

__device__ __forceinline__ float bflo(unsigned w) { return __uint_as_float(w << 16); }
__device__ __forceinline__ float bfhi(unsigned w) { return __uint_as_float(w & 0xffff0000u); }
__device__ __forceinline__ unsigned pkbf(float lo, float hi) { unsigned r; asm volatile("v_cvt_pk_bf16_f32 %0, %1, %2" : "=v"(r) : "v"(lo), "v"(hi)); return r; }
__device__ __forceinline__ int hide_i(int v) { asm volatile("" : "+v"(v)); return v; }
template <class Tp> __device__ __forceinline__ Tp* hide_p(Tp* q) { asm volatile("" : "+s"(q)); return q; }
__device__ __forceinline__ float shx(float v, int lane, int o) { return __int_as_float(__builtin_amdgcn_ds_bpermute((lane ^ o) << 2, __float_as_int(v))); }
__device__ __forceinline__ float wave_sum(float v, int lane) {
#pragma unroll
    for (int o = 1; o < 64; o <<= 1) v += shx(v, lane, o);
    return v;
}
__device__ __forceinline__ float wave_max(float v, int lane) {
#pragma unroll
    for (int o = 1; o < 64; o <<= 1) v = fmaxf(v, shx(v, lane, o));
    return v;
}
__device__ __forceinline__ float sigmoidf_(float x) { return __builtin_amdgcn_rcpf(1.0f + __expf(-x)); }
__device__ __forceinline__ float siluf_(float x) { return x * sigmoidf_(x); }
__device__ __forceinline__ float unkey(unsigned k) { return __uint_as_float((k & 0x80000000u) ? (k & 0x7fffffffu) : ~k); }
__device__ __forceinline__ int sbin(float s) { const int b = (int)(s * 32.0f + 128.0f); return b < 0 ? 0 : (b > 255 ? 255 : b); }
__device__ __forceinline__ unsigned fkey(float f) { const unsigned u = __float_as_uint(f + 0.0f); return (u & 0x80000000u) ? ~u : (u | 0x80000000u); }


#define XB_TMO      128
#define XB_XCNT(j)  (256  + 64 * (j))
#define XB_XSUB(j)  (1280 + 64 * (j))
#define XB_XGEN(j)  (2304 + 64 * (j))
#define XB_TOP      3328
#define XB_TOPGEN   3392
#define XCD_BAR_WORDS 3456
#define XB_SPIN_CAP (1u << 18)
__device__ __forceinline__ unsigned xb_ld(unsigned* p)              { return __hip_atomic_load(p, __ATOMIC_RELAXED, __HIP_MEMORY_SCOPE_AGENT); }
__device__ __forceinline__ unsigned xb_add(unsigned* p, unsigned v) { return __hip_atomic_fetch_add(p, v, __ATOMIC_RELAXED, __HIP_MEMORY_SCOPE_AGENT); }
__device__ __forceinline__ unsigned xb_xcc_id() { return (unsigned)__builtin_amdgcn_s_getreg((3 << 11) | 20) & 0xFu; }
#define XB_SPIN(cond, bar) do { unsigned _sp = 0; while (cond) { __builtin_amdgcn_s_sleep(1); \
    if ((++_sp & 255u) == 0u) { if (xb_ld(&(bar)[XB_TMO])) break; if (_sp > XB_SPIN_CAP) { atomicAdd(&(bar)[XB_TMO], 1u); break; } } } } while (0)
struct XcdBarrier { unsigned* bar; unsigned x; volatile __attribute__((address_space(3))) unsigned* st; };
__device__ __forceinline__ void xcd_barrier_complete(unsigned* bar, unsigned x, unsigned& nloc, unsigned& nx) {
    const unsigned G = gridDim.x * gridDim.y * gridDim.z;
    unsigned sum, cnt, mine, sp = 0u;
    for (;;) {
        sum = 0u; cnt = 0u; mine = 0u;
#pragma unroll
        for (unsigned j = 0; j < 16; ++j) { const unsigned c = xb_ld(&bar[XB_XCNT(j)]); sum += c; cnt += (c > 0u) ? 1u : 0u; mine = (j == x) ? c : mine; }
        if (sum == G) break;
        __builtin_amdgcn_s_sleep(1);
        if ((++sp & 255u) == 0u) { if (xb_ld(&bar[XB_TMO])) break; if (sp > XB_SPIN_CAP) { atomicAdd(&bar[XB_TMO], 1u); break; } }
    }
    nloc = mine > 0u ? mine : 1u; nx = cnt > 0u ? cnt : 1u;
}
__device__ __forceinline__ void xcd_barrier(const XcdBarrier& b, int tid) {
    asm volatile("s_waitcnt vmcnt(0)" ::: "memory");
    __syncthreads();
    if (tid == 0) {
        unsigned* bar = b.bar;
        __builtin_amdgcn_s_waitcnt(0);
        unsigned nloc = b.st[0], nx = b.st[1];
        if (nloc == 0u) { xcd_barrier_complete(bar, b.x, nloc, nx); b.st[0] = nloc; b.st[1] = nx; }
        const unsigned old = xb_add(&bar[XB_XSUB(b.x)], 1u);
        const unsigned gen = old / nloc;
        if (old + 1u == (gen + 1u) * nloc) {
            __builtin_amdgcn_fence(__ATOMIC_RELEASE, "agent");
            asm volatile("s_waitcnt vmcnt(0)" ::: "memory");
            const unsigned og = xb_add(&bar[XB_TOP], 1u);
            const unsigned tg = og / nx;
            if (og + 1u == (tg + 1u) * nx) xb_add(&bar[XB_TOPGEN], 1u);
            else XB_SPIN(xb_ld(&bar[XB_TOPGEN]) == tg, bar);
            __builtin_amdgcn_fence(__ATOMIC_ACQUIRE, "agent");
            xb_add(&bar[XB_XGEN(b.x)], 1u);
            asm volatile("s_waitcnt vmcnt(0)" ::: "memory");
        } else {
            XB_SPIN(xb_ld(&bar[XB_XGEN(b.x)]) == gen, bar);
            __builtin_amdgcn_fence(__ATOMIC_ACQUIRE, "agent");
            asm volatile("s_waitcnt vmcnt(0)" ::: "memory");
        }
    }
    __syncthreads();
}

namespace fa {
using bf16x8 = __attribute__((ext_vector_type(8))) short;
using s16x4  = __attribute__((ext_vector_type(4))) short;
using f32x16 = __attribute__((ext_vector_type(16))) float;
constexpr int TILE_B = 64 * 128 * 2;
constexpr int OFF_V = 0, OFF_K = 2 * TILE_B, OFF_M = 4 * TILE_B, OFF_WS = OFF_M + 2 * 256, OFF_Q = OFF_WS + 8 * 256, LDS_NEED = OFF_Q + 8 * 8192;
#define FA_GAS __attribute__((address_space(1)))
#define FA_KSWZ(row, colB) ((row) * 256 + ((colB) ^ (((row) & 7) << 4)))
#define FA_SBAR() __builtin_amdgcn_sched_barrier(0)
__device__ __forceinline__ int crow(int r, int hi) { return (r & 3) + 8 * (r >> 2) + 4 * hi; }
__device__ __forceinline__ int v_st(int k, int c) { const int kk = (k & ~0xC) | ((k & 4) << 1) | ((k & 8) >> 1); return ((kk >> 3) * 4 + (c >> 5)) * 512 + ((kk & 7) * 32 + (c & 31)) * 2; }
__device__ __forceinline__ int v_rd_base(int lane) { return ((lane & 3) << 3) | (((lane >> 2) & 3) << 6) | (((lane >> 4) & 1) << 5) | (((lane >> 5) & 1) << 8); }
constexpr int v_rd_off(int d0, int ks, int half) { return d0 * 512 + ks * 4096 + half * 2048; }
template <int OFF> __device__ __forceinline__ s16x4 tr_read(int vb) { s16x4 r; asm volatile("ds_read_b64_tr_b16 %0, %1 offset:%2" : "=&v"(r) : "v"(vb), "i"(OFF) : "memory"); return r; }
template <int D0> __device__ __forceinline__ void pv_one(f32x16& od, int vb, bf16x8 pa0, bf16x8 pa1, bf16x8 pa2, bf16x8 pa3) {
    const s16x4 l0 = tr_read<v_rd_off(D0, 0, 0)>(vb), h0 = tr_read<v_rd_off(D0, 0, 1)>(vb), l1 = tr_read<v_rd_off(D0, 1, 0)>(vb), h1 = tr_read<v_rd_off(D0, 1, 1)>(vb);
    const s16x4 l2 = tr_read<v_rd_off(D0, 2, 0)>(vb), h2 = tr_read<v_rd_off(D0, 2, 1)>(vb), l3 = tr_read<v_rd_off(D0, 3, 0)>(vb), h3 = tr_read<v_rd_off(D0, 3, 1)>(vb);
    asm volatile("s_waitcnt lgkmcnt(0)" ::: "memory"); FA_SBAR();
#define FA_PK(L, H) (bf16x8){L[0], L[1], L[2], L[3], H[0], H[1], H[2], H[3]}
    od = __builtin_amdgcn_mfma_f32_32x32x16_bf16(pa0, FA_PK(l0, h0), od, 0, 0, 0);
    od = __builtin_amdgcn_mfma_f32_32x32x16_bf16(pa1, FA_PK(l1, h1), od, 0, 0, 0);
    od = __builtin_amdgcn_mfma_f32_32x32x16_bf16(pa2, FA_PK(l2, h2), od, 0, 0, 0);
    od = __builtin_amdgcn_mfma_f32_32x32x16_bf16(pa3, FA_PK(l3, h3), od, 0, 0, 0);
#undef FA_PK
}
#define FA_RD8(D0, l0, h0, l1, h1, l2, h2, l3, h3) do { l0 = tr_read<v_rd_off(D0, 0, 0)>(vb); h0 = tr_read<v_rd_off(D0, 0, 1)>(vb); l1 = tr_read<v_rd_off(D0, 1, 0)>(vb); h1 = tr_read<v_rd_off(D0, 1, 1)>(vb); \
        l2 = tr_read<v_rd_off(D0, 2, 0)>(vb); h2 = tr_read<v_rd_off(D0, 2, 1)>(vb); l3 = tr_read<v_rd_off(D0, 3, 0)>(vb); h3 = tr_read<v_rd_off(D0, 3, 1)>(vb); } while (0)
#define FA_PK(L, H) (bf16x8){L[0], L[1], L[2], L[3], H[0], H[1], H[2], H[3]}
#define FA_MM4(od, l0, h0, l1, h1, l2, h2, l3, h3) do { od = __builtin_amdgcn_mfma_f32_32x32x16_bf16(pa0, FA_PK(l0, h0), od, 0, 0, 0); od = __builtin_amdgcn_mfma_f32_32x32x16_bf16(pa1, FA_PK(l1, h1), od, 0, 0, 0); \
        od = __builtin_amdgcn_mfma_f32_32x32x16_bf16(pa2, FA_PK(l2, h2), od, 0, 0, 0); od = __builtin_amdgcn_mfma_f32_32x32x16_bf16(pa3, FA_PK(l3, h3), od, 0, 0, 0); } while (0)
__device__ __forceinline__ void pv_all(f32x16 (&o)[4], int vb, bf16x8 pa0, bf16x8 pa1, bf16x8 pa2, bf16x8 pa3) {
    s16x4 a0, a1, a2, a3, a4, a5, a6, a7, b0, b1, b2, b3, b4, b5, b6, b7;
    FA_RD8(0, a0, a1, a2, a3, a4, a5, a6, a7);
    FA_RD8(1, b0, b1, b2, b3, b4, b5, b6, b7);
    asm volatile("s_waitcnt lgkmcnt(8)" ::: "memory"); FA_SBAR();
    FA_MM4(o[0], a0, a1, a2, a3, a4, a5, a6, a7); FA_SBAR();
    FA_RD8(2, a0, a1, a2, a3, a4, a5, a6, a7);
    asm volatile("s_waitcnt lgkmcnt(8)" ::: "memory"); FA_SBAR();
    FA_MM4(o[1], b0, b1, b2, b3, b4, b5, b6, b7); FA_SBAR();
    FA_RD8(3, b0, b1, b2, b3, b4, b5, b6, b7);
    asm volatile("s_waitcnt lgkmcnt(8)" ::: "memory"); FA_SBAR();
    FA_MM4(o[2], a0, a1, a2, a3, a4, a5, a6, a7); FA_SBAR();
    asm volatile("s_waitcnt lgkmcnt(0)" ::: "memory"); FA_SBAR();
    FA_MM4(o[3], b0, b1, b2, b3, b4, b5, b6, b7);
}
#undef FA_RD8
#undef FA_MM4
#undef FA_PK
template <bool QLDS>
__device__ __forceinline__ void qkt(f32x16& p0, f32x16& p1, const LAS char* Ks, const bf16x8 (&qr)[8], const LAS char* Ql, int r32, int hi) {
    p0 = f32x16{}; p1 = f32x16{};
#pragma unroll
    for (int d0 = 0; d0 < 8; ++d0) { const int cb = (d0 * 16 + hi * 8) * 2;
        const bf16x8 b0 = *(const LAS bf16x8*)(Ks + FA_KSWZ(r32, cb));
        const bf16x8 b1 = *(const LAS bf16x8*)(Ks + FA_KSWZ(32 + r32, cb));
        const bf16x8 q = QLDS ? *(const LAS bf16x8*)(Ql + d0 * 1024) : qr[d0];
        p0 = __builtin_amdgcn_mfma_f32_32x32x16_bf16(b0, q, p0, 0, 0, 0);
        p1 = __builtin_amdgcn_mfma_f32_32x32x16_bf16(b1, q, p1, 0, 0, 0); }
}
__device__ __forceinline__ void p_to_frag(const f32x16& p0, const f32x16& p1, bf16x8& pa0, bf16x8& pa1, bf16x8& pa2, bf16x8& pa3) {
#define FA_PK4(P, BASE, OUT) do { unsigned a0 = pkbf(P[BASE + 0], P[BASE + 1]), a1 = pkbf(P[BASE + 2], P[BASE + 3]);   \
    unsigned b0 = pkbf(P[BASE + 4], P[BASE + 5]), b1 = pkbf(P[BASE + 6], P[BASE + 7]);                              \
    auto r0 = __builtin_amdgcn_permlane32_swap(a0, b0, false, false); auto r1 = __builtin_amdgcn_permlane32_swap(a1, b1, false, false); \
    u32x4 w = {r0[0], r1[0], r0[1], r1[1]}; OUT = *reinterpret_cast<bf16x8*>(&w); } while (0)
    FA_PK4(p0, 0, pa0); FA_PK4(p0, 8, pa1); FA_PK4(p1, 0, pa2); FA_PK4(p1, 8, pa3);
#undef FA_PK4
}

struct UnitArgs {
    const bf16_t* Q; int ldq;
    const bf16_t* K; const bf16_t* V; int ldk;
    const u64* mask;
    int ntiles;
    int n0;
    float lgam;
};

template <int MODE, int EXP = 0>
__device__ __forceinline__ void unit_body(LAS char* L, const UnitArgs& U, int tid, f32x16 (&o)[4], float& l_out) {
    const int wid = __builtin_amdgcn_readfirstlane(tid >> 6), lane = tid & 63, r32 = lane & 31, hi = lane >> 5;
    LAS char* V_lds = L + OFF_V; LAS char* K_lds = L + OFF_K; LAS u64* M_lds = (LAS u64*)(L + OFF_M);
    LAS float* wsf = (LAS float*)(L + OFF_WS) + wid * 64; LAS float* al_l = wsf + 32;
    constexpr float C = ATT_SCALE * 1.4426950408889634f;
    float m_reg = -1e30f, l_reg = 0.f;
    bf16x8 qr[8];
    LAS char* Ql = L + OFF_Q + wid * 8192 + lane * 16;
    { const FA_GAS bf16_t* Qh = (const FA_GAS bf16_t*)hide_p(U.Q); const FA_GAS bf16_t* Qw = (MODE == 0) ? Qh + (size_t)r32 * U.ldq + wid * 128 + hi * 8 : Qh + (size_t)(wid * 32 + r32) * U.ldq + hi * 8;
#pragma unroll
      for (int d0 = 0; d0 < 8; ++d0) { qr[d0] = *(const FA_GAS bf16x8*)(Qw + d0 * 16); if (MODE == 1) *(LAS bf16x8*)(Ql + d0 * 1024) = qr[d0]; } }
    if (MODE == 1) { asm volatile("s_waitcnt vmcnt(0) lgkmcnt(0)" ::: "memory"); FA_SBAR(); }
    const int sr = tid >> 4, sc = (tid & 15) * 8, vst0 = v_st(sr, sc), vst1 = v_st(32 + sr, sc), kst0 = FA_KSWZ(sr, sc * 2), kst1 = FA_KSWZ(32 + sr, sc * 2);
    const FA_GAS char* Kh = (const FA_GAS char*)hide_p(U.K); const FA_GAS char* Vh = (const FA_GAS char*)hide_p(U.V);
    const int ldk_ = (EXP & 4) ? 128 : U.ldk;
    const unsigned goff0 = (unsigned)(sr * ldk_ + sc) * 2u, goff1 = (unsigned)((32 + sr) * ldk_ + sc) * 2u;
    const int vb0 = (int)(unsigned)(size_t)V_lds + v_rd_base(lane);
    bf16x8 ksA0, ksA1, vsA0, vsA1; u64 mwA = 0ull; unsigned pf_ = 0u;
#define FA_SLOAD(S, k0) do { const FA_GAS char* kb_ = Kh + (size_t)(k0) * ldk_ * 2; const FA_GAS char* vb_ = Vh + (size_t)(k0) * ldk_ * 2;     \
        ks##S##0 = *(const FA_GAS bf16x8*)(kb_ + goff0); ks##S##1 = *(const FA_GAS bf16x8*)(kb_ + goff1); \
        if (MODE == 1) { if (EXP & 2) { vs##S##0 = ks##S##0; vs##S##1 = ks##S##1; } else { vs##S##0 = *(const FA_GAS bf16x8*)(vb_ + goff0); vs##S##1 = *(const FA_GAS bf16x8*)(vb_ + goff1); } } \
        if (MODE == 0 && tid < 32) mw##S = U.mask[(size_t)tid * 32 + ((k0) >> 6)]; } while (0)
#define FA_SWRITE(S, b) do { *(LAS bf16x8*)(K_lds + (b) * TILE_B + kst0) = ks##S##0; *(LAS bf16x8*)(K_lds + (b) * TILE_B + kst1) = ks##S##1; \
        *(LAS bf16x8*)(V_lds + (b) * TILE_B + vst0) = (MODE == 1) ? vs##S##0 : ks##S##0; *(LAS bf16x8*)(V_lds + (b) * TILE_B + vst1) = (MODE == 1) ? vs##S##1 : ks##S##1; \
        if (MODE == 0 && tid < 32) M_lds[(b) * 32 + tid] = mw##S; } while (0)
#define FA_TOUCH(k0) do { if (MODE == 1 && tid < 256) { const FA_GAS char* tb_ = ((tid < 128) ? Kh : Vh) + (size_t)((k0) + ((tid & 127) >> 1)) * ldk_ * 2 + (tid & 1) * 128; \
        asm volatile("global_load_dword %0, %1, off" : "=v"(pf_) : "v"(tb_) : "memory"); } } while (0)
#define FA_TILE(j, b) do { \
        f32x16 p0, p1; bf16x8 pa0, pa1, pa2, pa3; \
        { const LAS char* qb_ = Ql; asm volatile("" : "+v"(qb_)); qkt<MODE == 1>(p0, p1, K_lds + (b) * TILE_B, qr, qb_, r32, hi); } \
        if (MODE == 0) { \
            const u64 mw = M_lds[(b) * 32 + r32] >> (4 * hi); \
            const unsigned mlo = (unsigned)mw, mhi = (unsigned)(mw >> 32); \
            _Pragma("unroll") for (int r = 0; r < 16; ++r) { const unsigned bit = 1u << ((r & 3) + 8 * (r >> 2)); p0[r] = (mlo & bit) ? p0[r] : -INFINITY; p1[r] = (mhi & bit) ? p1[r] : -INFINITY; } \
            float pmax = p0[0]; \
            _Pragma("unroll") for (int r = 1; r < 16; ++r) pmax = fmaxf(pmax, p0[r]); \
            _Pragma("unroll") for (int r = 0; r < 16; ++r) pmax = fmaxf(pmax, p1[r]); \
            { auto rr = __builtin_amdgcn_permlane32_swap(__float_as_uint(pmax), __float_as_uint(pmax), false, false); pmax = fmaxf(__uint_as_float(rr[0]), __uint_as_float(rr[1])); } \
            const float mn = fmaxf(m_reg, pmax); const float alpha = __builtin_amdgcn_exp2f((m_reg - mn) * C); m_reg = mn; \
            const float mnC = -mn * C; float ps = 0.f; \
            _Pragma("unroll") for (int r = 0; r < 16; ++r) { p0[r] = __builtin_amdgcn_exp2f(fmaf(p0[r], C, mnC)); p1[r] = __builtin_amdgcn_exp2f(fmaf(p1[r], C, mnC)); ps += p0[r] + p1[r]; } \
            { auto rr = __builtin_amdgcn_permlane32_swap(__float_as_uint(ps), __float_as_uint(ps), false, false); ps = __uint_as_float(rr[0]) + __uint_as_float(rr[1]); } \
            l_reg = l_reg * alpha + ps; \
            if (__any(alpha < 1.f)) { \
                if (hi == 0) al_l[r32] = alpha; \
                asm volatile("s_waitcnt lgkmcnt(0)" ::: "memory"); \
                _Pragma("unroll") for (int r = 0; r < 16; ++r) { const float a_ = al_l[crow(r, hi)]; \
                    _Pragma("unroll") for (int d = 0; d < 4; ++d) o[d][r] *= a_; } \
            } \
        } else if (!(EXP & 1)) { \
            const int dn = U.n0 + wid * 32 + r32 - (j) * 64 - 4 * hi; \
            const float base = (float)dn * U.lgam; \
            _Pragma("unroll") for (int r = 0; r < 16; ++r) { const int kk = (r & 3) + 8 * (r >> 2); \
                const float f0 = __builtin_amdgcn_exp2f(base - (float)kk * U.lgam), f1 = __builtin_amdgcn_exp2f(base - (float)(kk + 32) * U.lgam); \
                p0[r] = (dn >= kk) ? p0[r] * f0 : 0.f; p1[r] = (dn >= kk + 32) ? p1[r] * f1 : 0.f; } \
        } \
        p_to_frag(p0, p1, pa0, pa1, pa2, pa3); \
        FA_SBAR(); \
        { const int vb = vb0 + (b) * TILE_B; \
          pv_all(o, vb, pa0, pa1, pa2, pa3); } \
    } while (0)
    const int NT = U.ntiles;
    FA_SLOAD(A, 0); FA_SWRITE(A, 0);
    if (NT > 1) { FA_SLOAD(A, 64); FA_SWRITE(A, 1); }
    if (NT > 2) FA_TOUCH(128);
    if (NT > 3) FA_TOUCH(192);
    __syncthreads();
#pragma unroll
    for (int d = 0; d < 4; ++d) o[d] = f32x16{};
#pragma unroll 1
    for (int j = 0; j < NT; ++j) {
        const int b = j & 1;
        if (j + 2 < NT) FA_SLOAD(A, (j + 2) * 64);
        if (j + 4 < NT) FA_TOUCH((j + 4) * 64);
        FA_TILE(j, b);
        __syncthreads();
        if (j + 2 < NT) FA_SWRITE(A, b);
        asm volatile("" :: "v"(pf_));
    }
    asm volatile("s_waitcnt vmcnt(0)" ::: "memory");
    __syncthreads();
    l_out = l_reg;
#undef FA_SLOAD
#undef FA_SWRITE
#undef FA_TILE
}
}

namespace pg8 {
struct EpiProj {
    static constexpr bool PERM = true, AFTER_DRAIN = false, HAS_MID = false;
    bf16_t* P; const float* rot;
    __device__ __forceinline__ void operator()(const f32x4 (&acc)[2][2][4][2], const Unit& u, int wr, int wc, int fr, int fq) const {
        const int row0 = u.pm * BM + wr * 64 + fr, colb = u.pn * BM + wc * 32 + 8 * fq;
        const bool rotq = (u.pn >= 7) && (u.pn < 15);
        const float ksc = (u.pn >= 11) ? K_SCALE : 1.0f;
        const int i0 = 16 * wc + 4 * fq;
#pragma unroll
        for (int ai = 0; ai < 2; ++ai)
#pragma unroll
            for (int m = 0; m < 4; ++m) {
                const int row = row0 + ai * HALF + m * 16; const int pos = row & (SEQL - 1);
                bf16_t* rowp = P + (size_t)row * NPROJ + colb;
                f32x4 r0 = (f32x4){1.f, 0.f, 1.f, 0.f}, r1 = r0;
                if (rotq) { const f32x4* rt = (const f32x4*)(rot + ((size_t)pos * 64 + i0) * 2); r0 = rt[0]; r1 = rt[1]; }
#pragma unroll
                for (int bj = 0; bj < 2; ++bj) {
                    f32x4 v0 = acc[ai][bj][m][0], v1 = acc[ai][bj][m][1];
                    if (rotq) {
                        f32x4 w0, w1;
                        w0[0] = (v0[0] * r0[0] - v0[1] * r0[1]) * ksc; w0[1] = (v0[0] * r0[1] + v0[1] * r0[0]) * ksc;
                        w0[2] = (v0[2] * r0[2] - v0[3] * r0[3]) * ksc; w0[3] = (v0[2] * r0[3] + v0[3] * r0[2]) * ksc;
                        w1[0] = (v1[0] * r1[0] - v1[1] * r1[1]) * ksc; w1[1] = (v1[0] * r1[1] + v1[1] * r1[0]) * ksc;
                        w1[2] = (v1[2] * r1[2] - v1[3] * r1[3]) * ksc; w1[3] = (v1[2] * r1[3] + v1[3] * r1[2]) * ksc;
                        v0 = w0; v1 = w1;
                    }
                    u32x4 w; w.x = pkbf(v0[0], v0[1]); w.y = pkbf(v0[2], v0[3]); w.z = pkbf(v1[0], v1[1]); w.w = pkbf(v1[2], v1[3]);
                    *(u32x4*)(rowp + bj * HALF) = w;
                }
            }
    }
};
struct EpiMergeF {
    static constexpr bool PERM = true, AFTER_DRAIN = false, HAS_MID = true;
    const bf16_t* P; bf16_t* O;
    static __device__ __forceinline__ float cl(float x) { return fminf(fmaxf(x, -30.f), 30.f); }
    static __device__ __forceinline__ float ratio(float a, float b) { return (1.0f + __expf(-cl(b))) * __builtin_amdgcn_rcpf(1.0f + __expf(-cl(a))); }
    __device__ __forceinline__ void mid(f32x4 (&acc)[2][2][4][2], const Unit& u, int wr, int wc, int fr, int fq) const {
        const int row0 = hide_i(u.pm * BM + wr * 64 + fr), colb = hide_i(u.pn * BM + wc * 32 + 8 * fq);
        __builtin_amdgcn_sched_barrier(0);
#pragma unroll
        for (int ai = 0; ai < 2; ++ai) {
            u32x4 g0[4][2], g1[4][2];
#pragma unroll
            for (int m = 0; m < 4; ++m)
#pragma unroll
                for (int bj = 0; bj < 2; ++bj) { const bf16_t* gp = P + (size_t)(row0 + ai * HALF + m * 16) * NPROJ + C_GBR + colb + bj * HALF; g0[m][bj] = *(const u32x4*)gp; g1[m][bj] = *(const u32x4*)(gp + DMODEL); }
            __builtin_amdgcn_sched_barrier(0);
#pragma unroll
            for (int m = 0; m < 4; ++m)
#pragma unroll
                for (int bj = 0; bj < 2; ++bj) {
                    const u32x4 a_ = g0[m][bj], b_ = g1[m][bj]; f32x4 r0, r1;
                    r0[0] = ratio(bflo(a_.x), bflo(b_.x)); r0[1] = ratio(bfhi(a_.x), bfhi(b_.x)); r0[2] = ratio(bflo(a_.y), bflo(b_.y)); r0[3] = ratio(bfhi(a_.y), bfhi(b_.y));
                    r1[0] = ratio(bflo(a_.z), bflo(b_.z)); r1[1] = ratio(bfhi(a_.z), bfhi(b_.z)); r1[2] = ratio(bflo(a_.w), bflo(b_.w)); r1[3] = ratio(bfhi(a_.w), bfhi(b_.w));
                    acc[ai][bj][m][0] = acc[ai][bj][m][0] * r0; acc[ai][bj][m][1] = acc[ai][bj][m][1] * r1;
                }
            __builtin_amdgcn_sched_barrier(0);
        }
    }
    __device__ __forceinline__ void operator()(const f32x4 (&acc)[2][2][4][2], const Unit& u, int wr, int wc, int fr, int fq) const {
        const int row0 = u.pm * BM + wr * 64 + fr, colb = u.pn * BM + wc * 32 + 8 * fq;
#pragma unroll
        for (int ai = 0; ai < 2; ++ai) {
            u32x4 gg[4][2];
#pragma unroll
            for (int m = 0; m < 4; ++m)
#pragma unroll
                for (int bj = 0; bj < 2; ++bj) gg[m][bj] = *(const u32x4*)(P + (size_t)(row0 + ai * HALF + m * 16) * NPROJ + C_GBR + DMODEL + colb + bj * HALF);
            __builtin_amdgcn_sched_barrier(0);
#pragma unroll
            for (int m = 0; m < 4; ++m) {
                const int row = row0 + ai * HALF + m * 16;
#pragma unroll
                for (int bj = 0; bj < 2; ++bj) {
                    const int col = colb + bj * HALF;
                    const u32x4 g = gg[m][bj];
                    const f32x4 v0 = acc[ai][bj][m][0], v1 = acc[ai][bj][m][1];
                    float o[8];
                    o[0] = sigmoidf_(cl(bflo(g.x))) * v0[0]; o[1] = sigmoidf_(cl(bfhi(g.x))) * v0[1]; o[2] = sigmoidf_(cl(bflo(g.y))) * v0[2]; o[3] = sigmoidf_(cl(bfhi(g.y))) * v0[3];
                    o[4] = sigmoidf_(cl(bflo(g.z))) * v1[0]; o[5] = sigmoidf_(cl(bfhi(g.z))) * v1[1]; o[6] = sigmoidf_(cl(bflo(g.w))) * v1[2]; o[7] = sigmoidf_(cl(bfhi(g.w))) * v1[3];
                    u32x4 w; w.x = pkbf(o[0], o[1]); w.y = pkbf(o[2], o[3]); w.z = pkbf(o[4], o[5]); w.w = pkbf(o[6], o[7]);
                    *(u32x4*)(O + (size_t)row * DMODEL + col) = w;
                }
            }
        }
    }
};
struct EpiRes {
    static constexpr bool PERM = false, AFTER_DRAIN = false, HAS_MID = false;
    const float* X; float* O;
    __device__ __forceinline__ void operator()(const f32x4 (&acc)[2][2][4][2], const Unit& u, int wr, int wc, int fr, int fq) const {
        const int row0 = u.pm * BM + wr * 64 + fr, col0 = u.pn * BM + wc * 32 + 4 * fq;
#pragma unroll
        for (int ai = 0; ai < 2; ++ai) {
            f32x4 xv[4][2][2];
#pragma unroll
            for (int m = 0; m < 4; ++m) { const size_t off = (size_t)(row0 + ai * HALF + m * 16) * DMODEL + col0;
#pragma unroll
                for (int bj = 0; bj < 2; ++bj)
#pragma unroll
                    for (int n = 0; n < 2; ++n) xv[m][bj][n] = *(const f32x4*)(X + off + bj * HALF + n * 16); }
            __builtin_amdgcn_sched_barrier(0);
#pragma unroll
            for (int m = 0; m < 4; ++m) { const size_t off = (size_t)(row0 + ai * HALF + m * 16) * DMODEL + col0;
#pragma unroll
                for (int bj = 0; bj < 2; ++bj)
#pragma unroll
                    for (int n = 0; n < 2; ++n) *(f32x4*)(O + off + bj * HALF + n * 16) = xv[m][bj][n] + acc[ai][bj][m][n]; }
            __builtin_amdgcn_sched_barrier(0);
        }
    }
};
struct EpiSwiglu {
    static constexpr bool PERM = true, AFTER_DRAIN = false, HAS_MID = false;
    bf16_t* H; const float* rs;
    __device__ __forceinline__ void operator()(const f32x4 (&acc)[2][2][4][2], const Unit& u, int wr, int wc, int fr, int fq) const {
        const int row0 = u.pm * BM + wr * 64 + fr, col = u.pn * HALF + wc * 32 + 8 * fq;
#pragma unroll
        for (int ai = 0; ai < 2; ++ai)
#pragma unroll
            for (int m = 0; m < 4; ++m) {
                const int row = row0 + ai * HALF + m * 16; const float r_ = rs[row];
                const f32x4 g0 = acc[ai][0][m][0] * r_, g1 = acc[ai][0][m][1] * r_, u0 = acc[ai][1][m][0] * r_, u1 = acc[ai][1][m][1] * r_;
                u32x4 w; w.x = pkbf(siluf_(g0[0]) * u0[0], siluf_(g0[1]) * u0[1]); w.y = pkbf(siluf_(g0[2]) * u0[2], siluf_(g0[3]) * u0[3]);
                w.z = pkbf(siluf_(g1[0]) * u1[0], siluf_(g1[1]) * u1[1]); w.w = pkbf(siluf_(g1[2]) * u1[2], siluf_(g1[3]) * u1[3]);
                *(u32x4*)(H + (size_t)row * 1024 + col) = w;
            }
    }
};
struct EpiDown {
    static constexpr bool PERM = true, AFTER_DRAIN = false, HAS_MID = false;
    bf16_t* Y; const float* rg;
    __device__ __forceinline__ void operator()(const f32x4 (&acc)[2][2][4][2], const Unit& u, int wr, int wc, int fr, int fq) const {
        const int row0 = u.pm * BM + wr * 64 + fr, colb = u.pn * BM + wc * 32 + 8 * fq;
#pragma unroll
        for (int ai = 0; ai < 2; ++ai)
#pragma unroll
            for (int m = 0; m < 4; ++m) {
                const int row = row0 + ai * HALF + m * 16; const float gt = rg[row];
#pragma unroll
                for (int bj = 0; bj < 2; ++bj) {
                    const f32x4 v0 = acc[ai][bj][m][0] * gt, v1 = acc[ai][bj][m][1] * gt;
                    u32x4 w; w.x = pkbf(v0[0], v0[1]); w.y = pkbf(v0[2], v0[3]); w.z = pkbf(v1[0], v1[1]); w.w = pkbf(v1[2], v1[3]);
                    *(u32x4*)(Y + (size_t)row * DMODEL + colb + bj * HALF) = w;
                }
            }
    }
};
template <bool GATHER_> struct ExpertOrderT {
    static constexpr bool GATHER = GATHER_;
    const LAS int* ts; int G, c; const int* rtok;
    __device__ __forceinline__ unsigned rowoff(int slot) const { return GATHER_ ? (unsigned)rtok[slot] : 0u; }
    __device__ __forceinline__ bool next(int i, Unit& u) const {
        const int L = i * G + c; const int total = ts[32] * 8; if (L >= total) return false;
        const int gt = L >> 3; u.pm = gt; u.pn = L & 7; int e = 0;
        for (int k = 1; k < 32; ++k) e += (gt >= ts[k]) ? 1 : 0;
        u.e = e; return true;
    }
    __device__ __forceinline__ void a_ready(const Unit&) const {}
    __device__ __forceinline__ void done(const Unit&) const {}
};
}

struct MapId { __device__ __forceinline__ int operator()(int n) const { return n; } };
struct MapGate { __device__ __forceinline__ int operator()(int f) const { return ((f >> 7) << 8) + (f & 127); } };
struct MapUp { __device__ __forceinline__ int operator()(int f) const { return ((f >> 7) << 8) + 128 + (f & 127); } };
struct MapProj {
    __device__ __forceinline__ int operator()(int n) const {
        if (n < 1736) return n;
        if (n < 2760) { const int l = n - 1736, d = l & 127; return C_QR + (l & ~127) + ((d & 63) << 1) + (d >> 6); }
        if (n < 3784) { const int l = n - 2760, d = l & 127; return C_KR + (l & ~127) + ((d & 63) << 1) + (d >> 6); }
        if (n < 4808) return C_VR + (n - 3784);
        if (n < 5832) return C_GR + (n - 4808);
        return C_GBR + (n - 5832);
    }
};
template <class RowMap>
__device__ __forceinline__ void tr_item(const float* __restrict__ src, int N, bf16_t* __restrict__ dst, int ldd, int kb, int nb, int lane, RowMap rm) {
    const int kc = lane >> 3, nc = lane & 7;
    const int n = nb * 32 + nc * 4, k0 = kb * 64 + kc * 8;
    if (n < N) {
        f32x4 v[8];
#pragma unroll
        for (int i = 0; i < 8; ++i) v[i] = *(const f32x4*)(src + (size_t)(k0 + i) * N + n);
#pragma unroll
        for (int j = 0; j < 4; ++j) {
            u32x4 o; o.x = pkbf(v[0][j], v[1][j]); o.y = pkbf(v[2][j], v[3][j]); o.z = pkbf(v[4][j], v[5][j]); o.w = pkbf(v[6][j], v[7][j]);
            *(u32x4*)(dst + (size_t)rm(n + j) * ldd + k0) = o;
        }
    }
}
template <class RowMap>
__device__ __forceinline__ void tr_item2(const float* __restrict__ src, int N, bf16_t* __restrict__ dst, int ldd, int kb, int nb, int lane, RowMap rm) {
    const int kc = lane >> 3, nc = lane & 7;
    const int n = nb * 32 + nc * 4, k0 = kb * 64 + kc * 8;
    f32x4 va[8], vb[8];
#pragma unroll
    for (int i = 0; i < 8; ++i) { va[i] = *(const f32x4*)(src + (size_t)(k0 + i) * N + n); vb[i] = *(const f32x4*)(src + (size_t)(k0 + i) * N + n + 32); }
#pragma unroll
    for (int j = 0; j < 4; ++j) {
        u32x4 o; o.x = pkbf(va[0][j], va[1][j]); o.y = pkbf(va[2][j], va[3][j]); o.z = pkbf(va[4][j], va[5][j]); o.w = pkbf(va[6][j], va[7][j]);
        *(u32x4*)(dst + (size_t)rm(n + j) * ldd + k0) = o;
    }
#pragma unroll
    for (int j = 0; j < 4; ++j) {
        u32x4 o; o.x = pkbf(vb[0][j], vb[1][j]); o.y = pkbf(vb[2][j], vb[3][j]); o.z = pkbf(vb[4][j], vb[5][j]); o.w = pkbf(vb[6][j], vb[7][j]);
        *(u32x4*)(dst + (size_t)rm(n + 32 + j) * ldd + k0) = o;
    }
}
template <class RowMap>
__device__ __forceinline__ void tr_item4(const float* __restrict__ src, int N, bf16_t* __restrict__ dst, int ldd, int kb, int nb, int lane, RowMap rm) {
    const int kc = lane >> 3, nc = lane & 7;
    const int n = nb * 32 + nc * 4, k0 = kb * 64 + kc * 8;
    f32x4 v[4][8];
#pragma unroll
    for (int i = 0; i < 8; ++i)
#pragma unroll
        for (int u = 0; u < 4; ++u) v[u][i] = *(const f32x4*)(src + (size_t)(k0 + i) * N + n + 32 * u);
#pragma unroll
    for (int u = 0; u < 4; ++u)
#pragma unroll
        for (int j = 0; j < 4; ++j) {
            u32x4 o; o.x = pkbf(v[u][0][j], v[u][1][j]); o.y = pkbf(v[u][2][j], v[u][3][j]); o.z = pkbf(v[u][4][j], v[u][5][j]); o.w = pkbf(v[u][6][j], v[u][7][j]);
            *(u32x4*)(dst + (size_t)rm(n + 32 * u + j) * ldd + k0) = o;
        }
}
constexpr int EXP_ITEMS = 3 * 32 * 1024;
__device__ __forceinline__ void convert_experts(const float* w_eg, const float* w_eu, const float* w_ed, bf16_t* WGU, bf16_t* WD, unsigned* qctr, int lane) {
    int nxt = 0; if (lane == 0) nxt = (int)atomicAdd(qctr, 8u);
    for (;;) {
        const int it = __builtin_amdgcn_readfirstlane(nxt);
        if (it >= EXP_ITEMS) break;
        if (lane == 0) nxt = (int)atomicAdd(qctr, 8u);
        const int kind = it >> 15, r = it & 32767, e = r >> 10, q = r & 1023;
        if (kind == 0) { const float* src = w_eg + (size_t)e * 2048 * 1024; bf16_t* dst = WGU + (size_t)e * 2048 * 2048;
#pragma unroll 1
            for (int u = 0; u < 8; u += 4) tr_item4(src, 1024, dst, 2048, q >> 5, (q & 31) + u, lane, MapGate{}); }
        else if (kind == 1) { const float* src = w_eu + (size_t)e * 2048 * 1024; bf16_t* dst = WGU + (size_t)e * 2048 * 2048;
#pragma unroll 1
            for (int u = 0; u < 8; u += 4) tr_item4(src, 1024, dst, 2048, q >> 5, (q & 31) + u, lane, MapUp{}); }
        else { const float* src = w_ed + (size_t)e * 1024 * 2048; bf16_t* dst = WD + (size_t)e * 2048 * 1024;
#pragma unroll 1
            for (int u = 0; u < 8; u += 4) tr_item4(src, 2048, dst, 1024, q >> 6, (q & 63) + u, lane, MapId{}); }
    }
}
__device__ __forceinline__ void sincos_d(double a, double& s, double& c) {
    const double TWO_PI = 6.283185307179586476925, HALF_PI = 1.5707963267948966192313;
    double k = rint(a / HALF_PI); double r = a - k * HALF_PI;
    r -= k * 6.123233995736766e-17;
    const int q = ((int)k) & 3; const double r2 = r * r;
    double sp = r2 * (-1.0 / 1307674368000.0);
    sp = r2 * (sp + 1.0 / 6227020800.0); sp = r2 * (sp - 1.0 / 39916800.0); sp = r2 * (sp + 1.0 / 362880.0); sp = r2 * (sp - 1.0 / 5040.0); sp = r2 * (sp + 1.0 / 120.0); sp = r2 * (sp - 1.0 / 6.0);
    const double sr = r + r * sp;
    double cp = r2 * (1.0 / 20922789888000.0);
    cp = r2 * (cp - 1.0 / 87178291200.0); cp = r2 * (cp + 1.0 / 479001600.0); cp = r2 * (cp - 1.0 / 3628800.0); cp = r2 * (cp + 1.0 / 40320.0); cp = r2 * (cp - 1.0 / 720.0); cp = r2 * (cp + 1.0 / 24.0); cp = r2 * (cp - 0.5);
    const double cr = 1.0 + cp;
    s = (q == 0) ? sr : (q == 1) ? cr : (q == 2) ? -sr : -cr;
    c = (q == 0) ? cr : (q == 1) ? -sr : (q == 2) ? -cr : sr;
    (void)TWO_PI;
}

struct Params { const float* in[17]; float* out; unsigned char* ws; };

#ifndef PROF_PHASE
#define PROF_PHASE -1
#endif
#ifndef PROF_SCALE
#define PROF_SCALE 4e-6f
#endif
#define STAMP(i) do { if (PROF_PHASE >= 0 && bx == 0 && wave_id == 0) ((unsigned*)(p.ws + WS_CTL))[6000 + (i)] = (unsigned)__builtin_amdgcn_s_memrealtime(); } while (0)
#define GSYNC() grid.sync()
#define XBAR() do { const int l__ = (int)__builtin_amdgcn_mbcnt_hi(~0u, __builtin_amdgcn_mbcnt_lo(~0u, (unsigned)hide_i(0))); xcd_barrier(xbar, wave_id * 64 + l__); } while (0)
constexpr int CTL_BAR_WORD = 8192;
constexpr int CTL_QCTR = 2048;
#ifndef NGEMM_P1
#define NGEMM_P1 208
#endif

__global__ void __launch_bounds__(512, 2) mega_fwd(Params p) {
    extern __shared__ __attribute__((aligned(16))) unsigned char lds_raw[];
    LAS unsigned char* lds = (LAS unsigned char*)lds_raw;
    cg::grid_group grid = cg::this_grid();
    const int G = gridDim.x, bx = blockIdx.x;
    const int wave_id = __builtin_amdgcn_readfirstlane((int)threadIdx.x >> 6);
    const int NGW = G * 8, NGT = G * 512;
    XcdBarrier xbar;
    {
        const int l0 = (int)__builtin_amdgcn_mbcnt_hi(~0u, __builtin_amdgcn_mbcnt_lo(~0u, (unsigned)hide_i(0)));
        volatile LAS unsigned* st = (volatile LAS unsigned*)(lds + LDS_MISC + 256);
        if (wave_id == 0 && l0 < 2) st[l0] = 0u;
        __syncthreads();
        xbar.bar = (unsigned*)(p.ws + WS_CTL) + CTL_BAR_WORD; xbar.x = xb_xcc_id(); xbar.st = st;
        if (wave_id == 0 && l0 == 0) (void)xb_add(&xbar.bar[XB_XCNT(xbar.x)], 1u);
    }
#define PH_LOCALS \
    const int lane = (int)__builtin_amdgcn_mbcnt_hi(~0u, __builtin_amdgcn_mbcnt_lo(~0u, (unsigned)hide_i(0))), wave = wave_id, tid = wave * 64 + lane; (void)tid; \
    const int gw = bx * 8 + wave, gtid = bx * 512 + tid; (void)gw; (void)gtid; (void)lane; \
    unsigned char* ws = hide_p(p.ws); float* out = hide_p(p.out); (void)out; \
    unsigned* ctl = (unsigned*)(ws + WS_CTL); float* rot = (float*)(ws + WS_ROT); (void)ctl; (void)rot; \
    bf16_t* WIN = (bf16_t*)(ws + WS_WIN); bf16_t* WCOMB = (bf16_t*)(ws + WS_WCOMB); bf16_t* WB = (bf16_t*)(ws + WS_WB); bf16_t* WO = (bf16_t*)(ws + WS_WO); (void)WIN; (void)WCOMB; (void)WB; (void)WO; \
    bf16_t* WGU = (bf16_t*)(ws + WS_WGU); bf16_t* WD = (bf16_t*)(ws + WS_WD); (void)WGU; (void)WD; \
    bf16_t* P = (bf16_t*)(ws + WS_P); bf16_t* HMID = (bf16_t*)(ws + WS_HMID); bf16_t* Y = (bf16_t*)(ws + WS_Y); (void)P; (void)HMID; (void)Y; \
    bf16_t* XN = (bf16_t*)(ws + WS_XN); bf16_t* BA = XN; bf16_t* TN = XN; (void)BA; (void)TN; \
    bf16_t* OA = (bf16_t*)(ws + WS_OA); bf16_t* OB = OA + 1024;            bf16_t* MIXED = (bf16_t*)(ws + WS_MIXED); bf16_t* XG = (bf16_t*)(ws + WS_XG); (void)OA; (void)OB; (void)MIXED; (void)XG; \
    bf16_t* KV = (bf16_t*)(ws + WS_KV); u64* MASK = (u64*)(ws + WS_MASK); (void)KV; (void)MASK; \
    int* misc = (int*)(ws + WS_MISC); \
    int* row_tok = misc + MI_ROWTOK; float* row_gate = (float*)(misc + MI_ROWGATE); int* tok_slot = misc + MI_TOKSLOT; (void)row_tok; (void)row_gate; (void)tok_slot; \
    int* asg_e = misc + MI_ASGE; int* asg_r = misc + MI_ASGR; float* asg_g = (float*)(misc + MI_ASGG); (void)asg_e; (void)asg_r; (void)asg_g;
#define IN(k) hide_p(p.in[k])

    STAMP(0);
    {
        PH_LOCALS
        const float* x = IN(0); const float* g_mix = IN(1); const float* w_in = IN(2); const float* w_uv = IN(4); const float* w_branch = IN(6); const float* w_out = IN(7);
        constexpr int NB_WIN = 311;
        constexpr int I_WIN = 32 * NB_WIN, I_WB = 16 * 64, I_WO = 32 * 64;
        constexpr int I_TOTAL = I_WIN + I_WB + I_WO;
#pragma unroll 1
        for (int pass = 0; pass < 4; ++pass) {
        const int job = (pass + wave) & 3;
        if (job == 0) {
        for (int it = gw; it < I_TOTAL; it += NGW) {
            int r = it;
            if (r < I_WIN) { tr_item(w_in, 9928, WIN, 2048, r / NB_WIN, r % NB_WIN, lane, MapProj{}); continue; } r -= I_WIN;
            if (r < I_WB) { tr_item(w_branch + (size_t)1024 * 2048, 2048, WCOMB + 1024, 2048, r >> 6, r & 63, lane, MapId{});   continue; } r -= I_WB;
            tr_item(w_out, 2048, WO, 2048, r >> 6, r & 63, lane, MapId{});
        }
        for (int i = gtid; i < 56 * 256; i += NGT) ((u32x4*)(WIN + (size_t)1736 * 2048))[i] = (u32x4){0u, 0u, 0u, 0u};
        } else if (job == 1) {
        for (int it = gw; it < 2048; it += NGW) {
            const int h = it >> 8, ch = (it >> 7) & 1, n0 = (it & 127) * 16, c = ch * 64 + lane;
            const float* wuv = w_uv + ((size_t)h * 128 + c) * 128;
            const float* wa = w_branch + (size_t)(h * 128) * 2048 + n0;
            float a[16];
#pragma unroll
            for (int j = 0; j < 16; ++j) a[j] = 0.f;
#pragma unroll 4
            for (int d4 = 0; d4 < 32; ++d4) {
                const f32x4 wv = *(const f32x4*)(wuv + d4 * 4);
#pragma unroll
                for (int dd = 0; dd < 4; ++dd) {
                    const float* wr_ = wa + (size_t)(d4 * 4 + dd) * 2048;
#pragma unroll
                    for (int j4 = 0; j4 < 4; ++j4) { const f32x4 b = *(const f32x4*)(wr_ + j4 * 4); a[j4 * 4 + 0] += wv[dd] * b[0]; a[j4 * 4 + 1] += wv[dd] * b[1]; a[j4 * 4 + 2] += wv[dd] * b[2]; a[j4 * 4 + 3] += wv[dd] * b[3]; }
                }
            }
#pragma unroll
            for (int j = 0; j < 16; ++j) WCOMB[(size_t)(n0 + j) * 2048 + h * 128 + c] = (bf16_t)(pkbf(a[j], 0.f) & 0xffffu);
        }
        } else if (job == 2) {
        for (int m = gw; m < T_TOK; m += 2 * NGW) {
            const int m1 = (m + NGW < T_TOK) ? m + NGW : m;
            const f32x4* xr0 = (const f32x4*)(x + (size_t)m * DMODEL) + lane; const f32x4* xr1 = (const f32x4*)(x + (size_t)m1 * DMODEL) + lane;
            f32x4 v0[8], v1[8]; float s0 = 0.f, s1 = 0.f;
#pragma unroll
            for (int j = 0; j < 8; ++j) { v0[j] = xr0[64 * j]; v1[j] = xr1[64 * j]; }
#pragma unroll
            for (int j = 0; j < 8; ++j) { s0 += (v0[j][0] * v0[j][0] + v0[j][1] * v0[j][1]) + (v0[j][2] * v0[j][2] + v0[j][3] * v0[j][3]); s1 += (v1[j][0] * v1[j][0] + v1[j][1] * v1[j][1]) + (v1[j][2] * v1[j][2] + v1[j][3] * v1[j][3]); }
            const float r0 = 1.0f / sqrtf(wave_sum(s0, lane) * (1.0f / DMODEL) + EPS_F), r1 = 1.0f / sqrtf(wave_sum(s1, lane) * (1.0f / DMODEL) + EPS_F);
            u32x2* o0 = (u32x2*)(XN + (size_t)m * DMODEL) + lane; u32x2* o1 = (u32x2*)(XN + (size_t)m1 * DMODEL) + lane;
#pragma unroll
            for (int j = 0; j < 8; ++j) { const f32x4 gg = ((const f32x4*)g_mix)[lane + 64 * j];
                u32x2 w; w.x = pkbf(v0[j][0] * r0 * gg[0], v0[j][1] * r0 * gg[1]); w.y = pkbf(v0[j][2] * r0 * gg[2], v0[j][3] * r0 * gg[3]); o0[64 * j] = w;
                u32x2 w2; w2.x = pkbf(v1[j][0] * r1 * gg[0], v1[j][1] * r1 * gg[1]); w2.y = pkbf(v1[j][2] * r1 * gg[2], v1[j][3] * r1 * gg[3]); o1[64 * j] = w2; }
        }
        } else {
        for (int idx = gtid; idx < SEQL * 64; idx += NGT) {
            const int pos = idx >> 6, i = idx & 63; double f = 1.0;
            for (int k = 0; k < i; ++k) f *= 0.8659643233600653;
            double s, c; sincos_d((double)pos * f, s, c);
            rot[2 * idx] = (float)c; rot[2 * idx + 1] = (float)s;
        }
        { const float* g_ffn = IN(8); const float* w_rg = IN(9); const float* w_re = IN(11); float* WC = (float*)(ws + WS_WC);
          for (int idx = gtid; idx < 256 * 48 * 8; idx += NGT) { const int j = idx & 7, c = (idx >> 3) % 48, k = (idx / 384) * 8 + j;
              const float wv = (c < 4) ? w_rg[k * 4 + c] : (c < 36) ? w_re[k * 32 + (c - 4)] : 0.f; WC[idx] = wv * g_ffn[k]; } }
        }
        }
        for (int i = gtid; i < 32; i += NGT) ctl[64 * i] = 0u;
        if (gtid < 2) ctl[4096 + gtid] = 0u;
        for (int i = gtid; i < MAXSLOT; i += NGT) { row_tok[i] = 0; row_gate[i] = 0.f; ((float*)(ws + WS_WC + 524288))[i] = 0.f; }
    }
    if (__builtin_expect(p.out == nullptr, 0)) GSYNC();
    XBAR();
    STAMP(1);

    {
        PH_LOCALS
        const float* w_eg = IN(13); const float* w_eu = IN(14); const float* w_ed = IN(15);
        const int NGEMM = (G == 256) ? NGEMM_P1 : G;
        if (bx < NGEMM) {
            pg8::Gemm g{XN, WIN, T_TOK, NPROJ, 2048}; pg8::StaticOrder S; S.init(T_TOK, NPROJ, NGEMM, bx);
            pg8::EpiProj E{P, rot};
            pg8::gemm_phase<pg8::EpiProj, pg8::StaticOrder, true, true>(lds, g, S, E, tid);
        }
        convert_experts(w_eg, w_eu, w_ed, WGU, WD, ctl + CTL_QCTR, lane);
    }
    XBAR();
    STAMP(2);

    {
        PH_LOCALS
        const float* g_kv = IN(3);
        for (int t = gw; t < T_TOK; t += NGW) {
            const unsigned v = *(const unsigned*)(P + (size_t)t * NPROJ + C_CKV + 2 * lane);
            const float a = bflo(v), b = bfhi(v);
            const float rstd = 1.0f / sqrtf(wave_sum(a * a + b * b, lane) * (1.0f / 128.0f) + EPS_F);
            *(unsigned*)(KV + (size_t)t * 128 + 2 * lane) = pkbf(a * rstd * g_kv[2 * lane], b * rstd * g_kv[2 * lane + 1]);
        }
#if DBG_CMP == 3
        {
        u64* MASKX = (u64*)(ws + WS_SPARE);
        LAS float* qi = (LAS float*)(lds + wave * 10240); LAS float* sc = qi + 512;
        for (int t = gw; t < T_TOK; t += NGW) {
            const int b = t >> 11, q = t & 2047, ng = (q >> 6) + 1;
            { const u32x4 v = *(const u32x4*)(P + (size_t)t * NPROJ + C_QIDX + lane * 8);
              f32x4 lo4 = (f32x4){bflo(v.x), bfhi(v.x), bflo(v.y), bfhi(v.y)}, hi4 = (f32x4){bflo(v.z), bfhi(v.z), bflo(v.w), bfhi(v.w)};
              *(LAS f32x4*)(qi + lane * 8) = lo4; *(LAS f32x4*)(qi + lane * 8 + 4) = hi4; }
            float w[8];
            { const u32x4 v = *(const u32x4*)(P + (size_t)t * NPROJ + C_WIDX); w[0] = bflo(v.x); w[1] = bfhi(v.x); w[2] = bflo(v.y); w[3] = bfhi(v.y); w[4] = bflo(v.z); w[5] = bfhi(v.z); w[6] = bflo(v.w); w[7] = bfhi(v.w); }
            for (int g = 0; g < ng; ++g) {
                LAS float* qg = qi; asm volatile("" : "+v"(qg));
                const int s = g * 64 + lane; const u32x4* kr = (const u32x4*)(P + (size_t)(b * SEQL + s) * NPROJ + C_KIDX);
                float dot[8];
#pragma unroll
                for (int h = 0; h < 8; ++h) dot[h] = 0.f;
#pragma unroll
                for (int c = 0; c < 8; ++c) {
                    const u32x4 v = kr[c];
                    const f32x4 ka = (f32x4){bflo(v.x), bfhi(v.x), bflo(v.y), bfhi(v.y)}, kb = (f32x4){bflo(v.z), bfhi(v.z), bflo(v.w), bfhi(v.w)};
#pragma unroll
                    for (int h = 0; h < 8; ++h) {
                        const f32x4 qa = *(const LAS f32x4*)(qg + h * 64 + c * 8), qb = *(const LAS f32x4*)(qg + h * 64 + c * 8 + 4);
                        dot[h] += (qa[0] * ka[0] + qa[1] * ka[1]) + (qa[2] * ka[2] + qa[3] * ka[3]) + (qb[0] * kb[0] + qb[1] * kb[1]) + (qb[2] * kb[2] + qb[3] * kb[3]);
                    }
                }
                float score = 0.f;
#pragma unroll
                for (int h = 0; h < 8; ++h) score += w[h] * fmaxf(dot[h], 0.f);
                sc[s] = score * IDX_SCALE;
            }
            u64* mrow = MASKX + (size_t)t * 32;
            if (ng <= 4) { if (lane < 32) mrow[lane] = (lane < ng) ? ~0ull : 0ull; }
            else {
                unsigned lo = 0u;
                for (int bit = 31; bit >= 0; --bit) {
                    const unsigned cand = lo | (1u << bit); int cnt = 0;
                    for (int g = 0; g < ng; ++g) cnt += __popcll(__ballot(fkey(sc[g * 64 + lane]) >= cand));
                    if (cnt >= 256) lo = cand;
                }
                const unsigned tau = lo; int cgt = 0;
                for (int g = 0; g < ng; ++g) cgt += __popcll(__ballot(fkey(sc[g * 64 + lane]) > tau));
                const int need = 256 - cgt; int run = 0;
                for (int g = 0; g < ng; ++g) {
                    const unsigned key = fkey(sc[g * 64 + lane]);
                    const u64 gt = __ballot(key > tau), eq = __ballot(key == tau);
                    const u64 below = eq & ((1ull << lane) - 1ull);
                    const bool sel = (key == tau) && (run + (int)__popcll(below) < need);
                    const u64 word = gt | __ballot(sel);
                    run += (int)__popcll(eq);
                    if (lane == 0) mrow[g] = word;
                }
                if (lane >= ng && lane < 32) mrow[lane] = 0ull;
            }
        }
        }
        __syncthreads();
#endif
        typedef short bf16x8_t __attribute__((ext_vector_type(8)));
        constexpr int SCS = 2052;
        LAS float* scl = (LAS float*)lds;
        LAS unsigned* hist = (LAS unsigned*)(lds + 16 * SCS * 4);
        LAS unsigned* candl = hist + 16 * 256 + wave * 64;
        for (int i = tid; i < 16 * 256; i += 512) hist[i] = 0u;
        __syncthreads();
        for (int ui = 0; ui < 4; ++ui) {
            const int uu = ui * 256 + ((ui & 1) ? 255 - bx : bx);
            if (uu >= 1024 || bx >= 256) break;
            const int b = uu & 7, qblk = uu >> 3, q0 = qblk * 16, t0 = b * SEQL + q0, ng = (q0 >> 6) + 1, N = ng * 64;
            if (ng <= 4) {
                for (int qq = 0; qq < 2; ++qq) { u64* mrow = MASK + (size_t)(t0 + 2 * wave + qq) * 32; if (lane < 32) mrow[lane] = (lane < ng) ? ~0ull : 0ull; }
                continue;
            }
            const int qrow = lane & 15, kg = lane >> 4;
            bf16x8_t qf[8][2]; float w[8];
            { const bf16_t* qp = P + (size_t)(t0 + qrow) * NPROJ + C_QIDX + 8 * kg;
#pragma unroll
              for (int h = 0; h < 8; ++h) { qf[h][0] = *(const bf16x8_t*)(qp + h * 64); qf[h][1] = *(const bf16x8_t*)(qp + h * 64 + 32); }
              const u32x4 v = *(const u32x4*)(P + (size_t)(t0 + qrow) * NPROJ + C_WIDX); w[0] = bflo(v.x); w[1] = bfhi(v.x); w[2] = bflo(v.y); w[3] = bfhi(v.y); w[4] = bflo(v.z); w[5] = bfhi(v.z); w[6] = bflo(v.w); w[7] = bfhi(v.w); }
            for (int kt = wave; kt < N / 16; kt += 8) {
                const int s0 = kt * 16;
                const bf16_t* kp = P + (size_t)(b * SEQL + s0 + qrow) * NPROJ + C_KIDX + 8 * kg;
                const bf16x8_t a0 = *(const bf16x8_t*)kp, a1 = *(const bf16x8_t*)(kp + 32);
                f32x4 sacc = (f32x4){0.f, 0.f, 0.f, 0.f};
#pragma unroll
                for (int h = 0; h < 8; ++h) {
                    f32x4 acc = (f32x4){0.f, 0.f, 0.f, 0.f};
                    acc = __builtin_amdgcn_mfma_f32_16x16x32_bf16(a0, qf[h][0], acc, 0, 0, 0);
                    acc = __builtin_amdgcn_mfma_f32_16x16x32_bf16(a1, qf[h][1], acc, 0, 0, 0);
                    sacc[0] += w[h] * fmaxf(acc[0], 0.f); sacc[1] += w[h] * fmaxf(acc[1], 0.f); sacc[2] += w[h] * fmaxf(acc[2], 0.f); sacc[3] += w[h] * fmaxf(acc[3], 0.f);
                }
                sacc = sacc * IDX_SCALE + 0.0f;
                *(LAS f32x4*)(scl + qrow * SCS + s0 + 4 * kg) = sacc;
#pragma unroll
                for (int i = 0; i < 4; ++i) __hip_atomic_fetch_add(hist + qrow * 256 + sbin(sacc[i]), 1u, __ATOMIC_RELAXED, __HIP_MEMORY_SCOPE_WORKGROUP);
            }
            __syncthreads();
#pragma unroll 1
            for (int qq = 0; qq < 2; ++qq) {
                const int q = 2 * wave + qq; const LAS float* row = scl + q * SCS; LAS unsigned* hq = hist + q * 256;
                unsigned key[32];
#pragma unroll
                for (int j = 0; j < 32; ++j) key[j] = (j < ng) ? fkey(row[64 * j + lane]) : 0u;
                const u32x4 hv = *(const LAS u32x4*)(hq + 4 * lane);
                *(LAS u32x4*)(hq + 4 * lane) = (u32x4){0u, 0u, 0u, 0u};
                const int tsum = (int)(hv.x + hv.y + hv.z + hv.w); int incl = tsum;
#pragma unroll
                for (int off = 1; off < 64; off <<= 1) { const int o = __builtin_amdgcn_ds_bpermute(((lane + off) & 63) << 2, incl); incl += (lane + off < 64) ? o : 0; }
                const int suf = incl - tsum;
                int bt_l, ab_l;
                if (suf + (int)hv.w >= 256) { bt_l = 4 * lane + 3; ab_l = suf; }
                else if (suf + (int)(hv.w + hv.z) >= 256) { bt_l = 4 * lane + 2; ab_l = suf + (int)hv.w; }
                else if (suf + (int)(hv.w + hv.z + hv.y) >= 256) { bt_l = 4 * lane + 1; ab_l = suf + (int)(hv.w + hv.z); }
                else { bt_l = 4 * lane; ab_l = suf + (int)(hv.w + hv.z + hv.y); }
                const u64 cb = __ballot(suf < 256 && incl >= 256);
                const int src = (int)__builtin_ctzll(cb | (1ull << 63));
                const int bt = __builtin_amdgcn_readlane(bt_l, src), above = __builtin_amdgcn_readlane(ab_l, src);
                const int r = 256 - above;
                int C = 0;
#pragma unroll
                for (int j = 0; j < 32; ++j) {
                    const bool isc = (key[j] != 0u) && (sbin(unkey(key[j])) == bt);
                    const u64 bal = __ballot(isc);
                    if (isc) { const int pos = C + (int)__popcll(bal & ((1ull << lane) - 1ull)); if (pos < 64) candl[pos] = key[j]; }
                    C += (int)__popcll(bal);
                }
                unsigned tau; int cgt;
                if (C <= 64) {
                    asm volatile("s_waitcnt lgkmcnt(0)" ::: "memory");
                    const unsigned ck = (lane < C) ? candl[lane] : 0u;
                    unsigned lo = 0u;
#pragma unroll 1
                    for (int bit = 31; bit >= 0; --bit) { const unsigned cand = lo | (1u << bit); if ((int)__popcll(__ballot(ck >= cand)) >= r) lo = cand; }
                    tau = lo; cgt = above + (int)__popcll(__ballot(ck > tau));
                } else {
                    unsigned lo = 0u;
#pragma unroll 1
                    for (int bit = 31; bit >= 0; --bit) {
                        const unsigned cand = lo | (1u << bit); int c = 0;
#pragma unroll
                        for (int j = 0; j < 32; ++j) c += (key[j] >= cand) ? 1 : 0;
#pragma unroll
                        for (int x = 1; x < 64; x <<= 1) c += __builtin_amdgcn_ds_bpermute((lane ^ x) << 2, c);
                        if (c >= 256) lo = cand;
                    }
                    tau = lo; cgt = 0;
#pragma unroll
                    for (int j = 0; j < 32; ++j) cgt += (key[j] > tau) ? 1 : 0;
#pragma unroll
                    for (int x = 1; x < 64; x <<= 1) cgt += __builtin_amdgcn_ds_bpermute((lane ^ x) << 2, cgt);
                }
                const int need = 256 - cgt; int run = 0; u64 myword = 0ull;
#pragma unroll
                for (int j = 0; j < 32; ++j) {
                    const u64 gt = __ballot(key[j] > tau), eq = __ballot(key[j] == tau);
                    const u64 below = eq & ((1ull << lane) - 1ull);
                    const bool sel = (key[j] == tau) && (run + (int)__popcll(below) < need);
                    const u64 word = gt | __ballot(sel);
                    run += (int)__popcll(eq);
                    if (lane == j) myword = word;
                    __builtin_amdgcn_sched_barrier(0);
                }
                if (lane < 32) MASK[(size_t)(t0 + q) * 32 + lane] = myword;
            }
            __syncthreads();
        }
    }
    XBAR();
    STAMP(3);

#if DBG_CMP == 1
    {
        PH_LOCALS
        bf16_t* OAX = (bf16_t*)(ws + WS_SPARE);
        float* qv = (float*)(lds_raw + wave * 10240); float* lg = qv + 512;
        for (int it = gw; it < T_TOK * 8; it += NGW) {
            const int t = it >> 3, h = it & 7, b = t >> 11, q = t & 2047, ng = (q >> 6) + 1;
            { const unsigned v = *(const unsigned*)(P + (size_t)t * NPROJ + C_QLAT + h * 128 + 2 * lane); qv[2 * lane] = bflo(v); qv[2 * lane + 1] = bfhi(v); }
            const u64* mrow = MASK + (size_t)t * 32;
            float mx = -INFINITY;
            for (int g = 0; g < ng; ++g) {
                asm volatile("" ::: "memory");
                const u64 word = mrow[g]; float l = -INFINITY;
                if ((word >> lane) & 1ull) {
                    const u32x4* kr = (const u32x4*)(KV + (size_t)(b * SEQL + g * 64 + lane) * 128);
                    float d0 = 0.f, d1 = 0.f, d2 = 0.f, d3 = 0.f;
#pragma unroll
                    for (int c = 0; c < 16; ++c) { const u32x4 v = kr[c]; const f32x4 qa = *(const f32x4*)(qv + 8 * c), qb = *(const f32x4*)(qv + 8 * c + 4);
                        d0 += qa[0] * bflo(v.x) + qb[0] * bflo(v.z); d1 += qa[1] * bfhi(v.x) + qb[1] * bfhi(v.z); d2 += qa[2] * bflo(v.y) + qb[2] * bflo(v.w); d3 += qa[3] * bfhi(v.y) + qb[3] * bfhi(v.w); }
                    l = ((d0 + d1) + (d2 + d3)) * ATT_SCALE;
                }
                lg[g * 64 + lane] = l; mx = fmaxf(mx, l);
            }
            mx = wave_max(mx, lane);
            float o0 = 0.f, o1 = 0.f, sum = 0.f;
            for (int g = 0; g < ng; ++g) {
                const u64 wv = mrow[g];
                u64 word = ((u64)__builtin_amdgcn_readfirstlane((unsigned)(wv >> 32)) << 32) | (u64)__builtin_amdgcn_readfirstlane((unsigned)wv);
                while (word) {
                    const int j = __builtin_ctzll(word); word &= word - 1ull;
                    const int s = g * 64 + j; const float pj = __expf(lg[s] - mx);
                    const unsigned v = *(const unsigned*)(KV + (size_t)(b * SEQL + s) * 128 + 2 * lane);
                    o0 += pj * bflo(v); o1 += pj * bfhi(v); sum += pj;
                }
            }
            const float inv = 1.0f / sum;
            *(unsigned*)(OAX + (size_t)t * 1024 + h * 128 + 2 * lane) = pkbf(o0 * inv, o1 * inv);
        }
    }
    __syncthreads();
#endif
#if DBG_CMP == 2
    {
        PH_LOCALS
        const float* g_ret = IN(5);
        bf16_t* OBX = (bf16_t*)(ws + WS_SPARE);
        float* qv = (float*)(lds_raw + wave * 10240); float* lg = qv + 512; float* wl = lg;
        for (int it = gw; it < T_TOK * 8; it += NGW) {
            const int t = it >> 3, h = it & 7, b = t >> 11, n = t & 2047, ng = (n >> 6) + 1;
            const float lgam = (h == 0) ? -0.04580368961312479f : (h == 1) ? -0.02272007650008353f : (h == 2) ? -0.011315313227834146f : (h == 3) ? -0.005646563141142063f :
                               (h == 4) ? -0.0028205190623786626f : (h == 5) ? -0.0014095702546713536f : (h == 6) ? -0.0007046129765893727f : -0.0003522634716290214f;
            { const unsigned v = *(const unsigned*)(P + (size_t)t * NPROJ + C_QR + h * 128 + 2 * lane); qv[2 * lane] = bflo(v); qv[2 * lane + 1] = bfhi(v); }
            float o0 = 0.f, o1 = 0.f;
            for (int g = 0; g < ng; ++g) {
                asm volatile("" ::: "memory");
                const int m = g * 64 + lane;
                const u32x4* kr = (const u32x4*)(P + (size_t)(b * SEQL + m) * NPROJ + C_KR + h * 128);
                float d0 = 0.f, d1 = 0.f, d2 = 0.f, d3 = 0.f;
#pragma unroll
                for (int c = 0; c < 16; ++c) { const u32x4 v = kr[c]; const f32x4 qa = *(const f32x4*)(qv + 8 * c), qb = *(const f32x4*)(qv + 8 * c + 4);
                    d0 += qa[0] * bflo(v.x) + qb[0] * bflo(v.z); d1 += qa[1] * bfhi(v.x) + qb[1] * bfhi(v.z); d2 += qa[2] * bflo(v.y) + qb[2] * bflo(v.w); d3 += qa[3] * bfhi(v.y) + qb[3] * bfhi(v.w); }
                const float dot = (d0 + d1) + (d2 + d3);
                wl[lane] = (m <= n) ? dot * exp2f((float)(n - m) * lgam) : 0.f;
                const int jmax = (g == ng - 1) ? (n & 63) : 63;
                for (int j = 0; j <= jmax; ++j) {
                    const float wj = wl[j];
                    const unsigned v = *(const unsigned*)(P + (size_t)(b * SEQL + g * 64 + j) * NPROJ + C_VR + h * 128 + 2 * lane);
                    o0 += wj * bflo(v); o1 += wj * bfhi(v);
                }
            }
            const float mu = wave_sum(o0 + o1, lane) * (1.0f / 128.0f); const float e0 = o0 - mu, e1 = o1 - mu;
            const float rs = 1.0f / sqrtf(wave_sum(e0 * e0 + e1 * e1, lane) * (1.0f / 128.0f) + EPS_F);
            const unsigned gv = *(const unsigned*)(P + (size_t)t * NPROJ + C_GR + h * 128 + 2 * lane);
            const float y0 = siluf_(bflo(gv)) * e0 * rs * g_ret[h * 128 + 2 * lane], y1 = siluf_(bfhi(gv)) * e1 * rs * g_ret[h * 128 + 2 * lane + 1];
            *(unsigned*)(OBX + (size_t)t * 1024 + h * 128 + 2 * lane) = pkbf(y0, y1);
        }
    }
    __syncthreads();
#endif
    {
        PH_LOCALS
        for (int pr = bx; pr < 256; pr += G) {
            const int b = pr >> 5, i = pr & 31;
#pragma unroll 1
            for (int uu = 0; uu < 2; ++uu) {
                const int qb = uu ? 63 - i : i; const int t0 = b * SEQL + qb * 32;
                fa::UnitArgs U; U.Q = P + (size_t)t0 * NPROJ + C_QLAT; U.ldq = NPROJ; U.K = KV + (size_t)b * SEQL * 128; U.V = U.K; U.ldk = 128; U.mask = MASK + (size_t)t0 * 32;
                U.ntiles = (qb >> 1) + 1; U.n0 = 0; U.lgam = 0.f;
                fa::f32x16 o[4]; float l_reg;
                fa::unit_body<0>((LAS char*)lds, U, tid, o, l_reg);
                const int r32 = lane & 31, hi = lane >> 5;
                const int trow0 = hide_i(t0 + 4 * hi);
                LAS float* li_l = (LAS float*)(lds + fa::OFF_WS) + wave * 64;
                if (hi == 0) li_l[r32] = l_reg;
                asm volatile("s_waitcnt lgkmcnt(0)" ::: "memory");
#pragma unroll
                for (int r = 0; r < 16; ++r) {
                    const int orow = fa::crow(r, hi); const float rl = __builtin_amdgcn_rcpf(li_l[orow]);
                    bf16_t* op = OA + (size_t)(trow0 + (r & 3) + 8 * (r >> 2)) * 2048 + wave * 128 + r32;
#pragma unroll
                    for (int d0 = 0; d0 < 4; ++d0) op[d0 * 32] = (bf16_t)(pkbf(o[d0][r] * rl, 0.f) & 0xffffu);
                }
                __syncthreads();
            }
        }
    }
    STAMP(20);
    {
        PH_LOCALS
        const float* g_ret = IN(5);
        for (int pr = bx; pr < 256; pr += G) {
            const int bh = pr >> 2, i = pr & 3, b = bh >> 3, h = bh & 7;
            const float lgam = (h == 0) ? -0.04580368961312479f : (h == 1) ? -0.02272007650008353f : (h == 2) ? -0.011315313227834146f : (h == 3) ? -0.005646563141142063f :
                               (h == 4) ? -0.0028205190623786626f : (h == 5) ? -0.0014095702546713536f : (h == 6) ? -0.0007046129765893727f : -0.0003522634716290214f;
#pragma unroll 1
            for (int uu = 0; uu < 2; ++uu) {
                const int qb = uu ? 7 - i : i; const int n0 = qb * 256;
                fa::UnitArgs U; U.Q = P + (size_t)(b * SEQL + n0) * NPROJ + C_QR + h * 128; U.ldq = NPROJ;
                U.K = P + (size_t)(b * SEQL) * NPROJ + C_KR + h * 128; U.V = P + (size_t)(b * SEQL) * NPROJ + C_VR + h * 128; U.ldk = NPROJ; U.mask = nullptr;
                U.ntiles = 4 * (qb + 1); U.n0 = n0; U.lgam = lgam;
                fa::f32x16 o[4]; float l_reg;
                fa::unit_body<1>((LAS char*)lds, U, tid, o, l_reg);
                const int r32 = lane & 31, hi = lane >> 5;
                const int tok0 = hide_i(b * SEQL + n0 + wave * 32 + 4 * hi);
                float gr[4];
#pragma unroll
                for (int d0 = 0; d0 < 4; ++d0) gr[d0] = g_ret[h * 128 + d0 * 32 + r32];
#pragma unroll
                for (int r = 0; r < 16; ++r) {
                    float s = (o[0][r] + o[1][r]) + (o[2][r] + o[3][r]);
#pragma unroll
                    for (int x = 1; x < 32; x <<= 1) s += shx(s, lane, x);
                    const float mu = s * (1.0f / 128.0f);
                    const float e0 = o[0][r] - mu, e1 = o[1][r] - mu, e2 = o[2][r] - mu, e3 = o[3][r] - mu;
                    float q = (e0 * e0 + e1 * e1) + (e2 * e2 + e3 * e3);
#pragma unroll
                    for (int x = 1; x < 32; x <<= 1) q += shx(q, lane, x);
                    const float rs = 1.0f / sqrtf(q * (1.0f / 128.0f) + EPS_F);
                    const size_t tok = (size_t)(tok0 + (r & 3) + 8 * (r >> 2));
                    const bf16_t* gp = P + tok * NPROJ + C_GR + h * 128 + r32; bf16_t* op = OB + tok * 2048 + h * 128 + r32;
                    op[0] = (bf16_t)(pkbf(siluf_(bflo((unsigned)gp[0])) * e0 * rs * gr[0], 0.f) & 0xffffu);
                    op[32] = (bf16_t)(pkbf(siluf_(bflo((unsigned)gp[32])) * e1 * rs * gr[1], 0.f) & 0xffffu);
                    op[64] = (bf16_t)(pkbf(siluf_(bflo((unsigned)gp[64])) * e2 * rs * gr[2], 0.f) & 0xffffu);
                    op[96] = (bf16_t)(pkbf(siluf_(bflo((unsigned)gp[96])) * e3 * rs * gr[3], 0.f) & 0xffffu);
                }
                __syncthreads();
            }
        }
    }
#ifdef RET_EXP
    XBAR();
    STAMP(30);
    {
        PH_LOCALS
        const float* g_ret = IN(5);
        for (int pr = bx; pr < 256; pr += G) {
            const int bh = pr >> 2, i = pr & 3, b = bh >> 3, h = bh & 7;
            const float lgam = (h == 0) ? -0.04580368961312479f : (h == 1) ? -0.02272007650008353f : (h == 2) ? -0.011315313227834146f : (h == 3) ? -0.005646563141142063f :
                               (h == 4) ? -0.0028205190623786626f : (h == 5) ? -0.0014095702546713536f : (h == 6) ? -0.0007046129765893727f : -0.0003522634716290214f;
#pragma unroll 1
            for (int uu = 0; uu < 2; ++uu) {
                const int qb = uu ? 7 - i : i; const int n0 = qb * 256;
                fa::UnitArgs U; U.Q = P + (size_t)(b * SEQL + n0) * NPROJ + C_QR + h * 128; U.ldq = NPROJ;
                U.K = P + (size_t)(b * SEQL) * NPROJ + C_KR + h * 128; U.V = P + (size_t)(b * SEQL) * NPROJ + C_VR + h * 128; U.ldk = NPROJ; U.mask = nullptr;
                U.ntiles = 4 * (qb + 1); U.n0 = n0; U.lgam = lgam;
                fa::f32x16 o[4]; float l_reg;
                fa::unit_body<1, RET_EXP>((LAS char*)lds, U, tid, o, l_reg);
                const int r32 = lane & 31, hi = lane >> 5;
                const int tok0 = hide_i(b * SEQL + n0 + wave * 32 + 4 * hi);
                float gr[4];
#pragma unroll
                for (int d0 = 0; d0 < 4; ++d0) gr[d0] = g_ret[h * 128 + d0 * 32 + r32];
#pragma unroll
                for (int r = 0; r < 16; ++r) {
                    float s = (o[0][r] + o[1][r]) + (o[2][r] + o[3][r]);
#pragma unroll
                    for (int x = 1; x < 32; x <<= 1) s += shx(s, lane, x);
                    const float mu = s * (1.0f / 128.0f);
                    const float e0 = o[0][r] - mu, e1 = o[1][r] - mu, e2 = o[2][r] - mu, e3 = o[3][r] - mu;
                    float q = (e0 * e0 + e1 * e1) + (e2 * e2 + e3 * e3);
#pragma unroll
                    for (int x = 1; x < 32; x <<= 1) q += shx(q, lane, x);
                    const float rs = 1.0f / sqrtf(q * (1.0f / 128.0f) + EPS_F);
                    const size_t tok = (size_t)(tok0 + (r & 3) + 8 * (r >> 2));
                    const bf16_t* gp = P + tok * NPROJ + C_GR + h * 128 + r32; bf16_t* op = (bf16_t*)(ws + WS_SPARE) + tok * 1024 + h * 128 + r32;
                    op[0] = (bf16_t)(pkbf(siluf_(bflo((unsigned)gp[0])) * e0 * rs * gr[0], 0.f) & 0xffffu);
                    op[32] = (bf16_t)(pkbf(siluf_(bflo((unsigned)gp[32])) * e1 * rs * gr[1], 0.f) & 0xffffu);
                    op[64] = (bf16_t)(pkbf(siluf_(bflo((unsigned)gp[64])) * e2 * rs * gr[2], 0.f) & 0xffffu);
                    op[96] = (bf16_t)(pkbf(siluf_(bflo((unsigned)gp[96])) * e3 * rs * gr[3], 0.f) & 0xffffu);
                }
                __syncthreads();
            }
        }
    }
    XBAR();
    STAMP(31);
#endif
#if DBG_CMP
    XBAR();
    {
        PH_LOCALS
        const bf16_t* A_ = (DBG_CMP == 1) ? OA : OB; const bf16_t* R_ = (const bf16_t*)(ws + WS_SPARE);
        float sd = 0.f, sr = 0.f;
#if DBG_CMP == 3
        for (size_t i = (size_t)gtid; i < (size_t)T_TOK * 32; i += (size_t)NGT) { const u64 a = MASK[i], r = ((const u64*)(ws + WS_SPARE))[i]; sd += (float)__popcll(a ^ r); sr += 100.0f * (float)__popcll(r); }
#else
        for (size_t i = (size_t)gtid; i < (size_t)T_TOK * 1024 / 2; i += (size_t)NGT) {
            const unsigned a = ((const unsigned*)A_)[(i >> 9) * 1024 + (i & 511)], r = ((const unsigned*)R_)[i];
            const float d0 = bflo(a) - bflo(r), d1 = bfhi(a) - bfhi(r); sd += d0 * d0 + d1 * d1; sr += bflo(r) * bflo(r) + bfhi(r) * bfhi(r);
        }
#endif
        sd = wave_sum(sd, lane); sr = wave_sum(sr, lane);
        if (lane == 0) { atomicAdd((float*)(ctl + 4096), sd); atomicAdd((float*)(ctl + 4097), sr); }
    }
#endif
    XBAR();
    STAMP(4);

    {
        PH_LOCALS
        pg8::Gemm g{OA, WCOMB, T_TOK, DMODEL, 2048}; pg8::StaticOrder S; S.init(T_TOK, DMODEL, G, bx);
        pg8::EpiMergeF E{P, MIXED};
        pg8::gemm_phase<pg8::EpiMergeF, pg8::StaticOrder, true, true>(lds, g, S, E, tid);
    }
    XBAR();
    STAMP(5);
    {
        PH_LOCALS
        const float* x = IN(0);
        pg8::Gemm g{MIXED, WO, T_TOK, DMODEL, 2048}; pg8::StaticOrder S; S.init(T_TOK, DMODEL, G, bx);
        pg8::EpiRes E{x, out};
        pg8::gemm_phase<pg8::EpiRes, pg8::StaticOrder, true, true>(lds, g, S, E, tid);
    }
    XBAR();
    STAMP(7);

    {
    PH_LOCALS
    const float* g_ffn = IN(8); const float* b_rg = IN(10); const float* b_re = IN(12);
    const f32x4* WC4 = (const f32x4*)(ws + WS_WC); float* tok_rs = (float*)(ws + WS_WC + 786432);
    LAS float* lg = (LAS float*)lds + wave * (16 * 52);
    const int row = lane & 15, g4 = lane >> 4;
    LAS float* part = (LAS float*)lds + 4 * (16 * 52) + (wave & 3) * (13 * 64);
    for (int tile0 = bx * 4; tile0 < T_TOK / 16; tile0 += G * 4) {
        const int tile = tile0 + (wave & 3), kh = wave >> 2;
        const int tok0 = tile * 16;
        const float* hrow = out + (size_t)(tok0 + row) * DMODEL + 8 * g4 + 1024 * kh;
        bf16_t* trow = TN + (size_t)(tok0 + row) * DMODEL + 8 * g4 + 1024 * kh;
        const f32x4* wp = WC4 + (size_t)g4 * 96 + 2 * row + (size_t)kh * 32 * 384;
        const float* gp = g_ffn + 8 * g4 + 1024 * kh;
        f32x4 acc0 = (f32x4){0.f, 0.f, 0.f, 0.f}, acc1 = acc0, acc2 = acc0; float ssq = 0.f;
        f32x4 a0 = *(const f32x4*)(hrow), a1 = *(const f32x4*)(hrow + 4);
        f32x4 b00 = wp[0], b01 = wp[1], b10 = wp[32], b11 = wp[33], b20 = wp[64], b21 = wp[65];
        f32x4 na0 = *(const f32x4*)(hrow + 32), na1 = *(const f32x4*)(hrow + 36);
        f32x4 nb00 = wp[384], nb01 = wp[385], nb10 = wp[416], nb11 = wp[417], nb20 = wp[448], nb21 = wp[449];
        for (int it = 0; it < 32; ++it) {
            const int itn = (it + 2 < 32) ? it + 2 : 31;
            const f32x4 ma0 = *(const f32x4*)(hrow + 32 * itn), ma1 = *(const f32x4*)(hrow + 32 * itn + 4);
            const f32x4* wn = wp + (size_t)itn * 384;
            const f32x4 mb00 = wn[0], mb01 = wn[1], mb10 = wn[32], mb11 = wn[33], mb20 = wn[64], mb21 = wn[65];
            const f32x4 gk0 = *(const f32x4*)(gp + 32 * it), gk1 = *(const f32x4*)(gp + 32 * it + 4);
            ssq += (a0[0] * a0[0] + a0[1] * a0[1]) + (a0[2] * a0[2] + a0[3] * a0[3]) + (a1[0] * a1[0] + a1[1] * a1[1]) + (a1[2] * a1[2] + a1[3] * a1[3]);
            { u32x4 w; w.x = pkbf(a0[0] * gk0[0], a0[1] * gk0[1]); w.y = pkbf(a0[2] * gk0[2], a0[3] * gk0[3]); w.z = pkbf(a1[0] * gk1[0], a1[1] * gk1[1]); w.w = pkbf(a1[2] * gk1[2], a1[3] * gk1[3]);
              *(u32x4*)(trow + 32 * it) = w; }
#pragma unroll
            for (int s_ = 0; s_ < 4; ++s_) {
                acc0 = __builtin_amdgcn_mfma_f32_16x16x4f32(a0[s_], b00[s_], acc0, 0, 0, 0);
                acc1 = __builtin_amdgcn_mfma_f32_16x16x4f32(a0[s_], b10[s_], acc1, 0, 0, 0);
                acc2 = __builtin_amdgcn_mfma_f32_16x16x4f32(a0[s_], b20[s_], acc2, 0, 0, 0);
            }
#pragma unroll
            for (int s_ = 0; s_ < 4; ++s_) {
                acc0 = __builtin_amdgcn_mfma_f32_16x16x4f32(a1[s_], b01[s_], acc0, 0, 0, 0);
                acc1 = __builtin_amdgcn_mfma_f32_16x16x4f32(a1[s_], b11[s_], acc1, 0, 0, 0);
                acc2 = __builtin_amdgcn_mfma_f32_16x16x4f32(a1[s_], b21[s_], acc2, 0, 0, 0);
            }
            a0 = na0; a1 = na1; b00 = nb00; b01 = nb01; b10 = nb10; b11 = nb11; b20 = nb20; b21 = nb21;
            na0 = ma0; na1 = ma1; nb00 = mb00; nb01 = mb01; nb10 = mb10; nb11 = mb11; nb20 = mb20; nb21 = mb21;
        }
        if (kh == 1) {
#pragma unroll
            for (int r = 0; r < 4; ++r) { part[r * 64 + lane] = acc0[r]; part[(4 + r) * 64 + lane] = acc1[r]; part[(8 + r) * 64 + lane] = acc2[r]; }
            part[12 * 64 + lane] = ssq;
        }
        __syncthreads();
        if (kh == 0) {
#pragma unroll
            for (int r = 0; r < 4; ++r) { acc0[r] += part[r * 64 + lane]; acc1[r] += part[(4 + r) * 64 + lane]; acc2[r] += part[(8 + r) * 64 + lane]; }
            ssq += part[12 * 64 + lane];
        ssq += shx(ssq, lane, 16); ssq += shx(ssq, lane, 32);
        const float rstd = 1.0f / sqrtf(ssq * (1.0f / DMODEL) + EPS_F);
#pragma unroll
        for (int r = 0; r < 4; ++r) { lg[(4 * g4 + r) * 52 + row] = acc0[r]; lg[(4 * g4 + r) * 52 + 16 + row] = acc1[r]; lg[(4 * g4 + r) * 52 + 32 + row] = acc2[r]; }
        asm volatile("s_waitcnt lgkmcnt(0)" ::: "memory");
        if (lane < 16) {
            const int t = tok0 + lane; const LAS float* lr = lg + lane * 52;
            float gl[4];
#pragma unroll
            for (int k = 0; k < 4; ++k) gl[k] = lr[k] * rstd + b_rg[k];
            int grp = 0; float gmx = gl[0];
#pragma unroll
            for (int k = 1; k < 4; ++k) if (gl[k] > gmx) { gmx = gl[k]; grp = k; }
            float gz = 0.f;
#pragma unroll
            for (int k = 0; k < 4; ++k) gz += __expf(gl[k] - gmx);
            const float p_grp = 1.0f / gz;
            float el[8];
#pragma unroll
            for (int k = 0; k < 8; ++k) el[k] = lr[4 + grp * 8 + k] * rstd + b_re[grp * 8 + k];
            int i1 = 0; float m1 = el[0];
#pragma unroll
            for (int k = 1; k < 8; ++k) if (el[k] > m1) { m1 = el[k]; i1 = k; }
            int i2 = -1; float m2 = -INFINITY;
#pragma unroll
            for (int k = 0; k < 8; ++k) if (k != i1 && el[k] > m2) { m2 = el[k]; i2 = k; }
            const float e2 = __expf(m2 - m1); const float den = 1.0f / (1.0f + e2);
            const float g1 = p_grp * den, g2 = p_grp * e2 * den;
            const int ex1 = grp * 8 + i1, ex2 = grp * 8 + i2;
            const unsigned r1 = atomicAdd(ctl + 64 * ex1, 1u), r2 = atomicAdd(ctl + 64 * ex2, 1u);
            asg_e[2 * t] = ex1; asg_e[2 * t + 1] = ex2; asg_r[2 * t] = (int)r1; asg_r[2 * t + 1] = (int)r2; asg_g[2 * t] = g1; asg_g[2 * t + 1] = g2;
            tok_rs[t] = rstd;
        }
        }
        __syncthreads();
    }
    }
    XBAR();
    STAMP(8);

    LAS int* tile_start = (LAS int*)(lds + LDS_MISC);
    {
    PH_LOCALS
    if (tid == 0) {
        int acc_t = 0;
        for (int e = 0; e < 32; ++e) { tile_start[e] = acc_t; const int c = (int)__hip_atomic_load(ctl + 64 * e, __ATOMIC_RELAXED, __HIP_MEMORY_SCOPE_AGENT); acc_t += (c + 255) >> 8; }
        tile_start[32] = acc_t;
    }
    __syncthreads();
    for (int a = gtid; a < 2 * T_TOK; a += NGT) {
        const int t = a >> 1; const int e = asg_e[a], rk = asg_r[a]; const int slot = tile_start[e] * 256 + rk;
        row_tok[slot] = t; row_gate[slot] = asg_g[a]; tok_slot[a] = slot; ((float*)(ws + WS_WC + 524288))[slot] = ((const float*)(ws + WS_WC + 786432))[t];
    }
    }
    XBAR();
    STAMP(9);

    {
        PH_LOCALS
        pg8::Gemm g{TN, WGU, MAXSLOT, 2048, 2048}; pg8::ExpertOrderT<true> S{tile_start, G, bx, row_tok};
        pg8::EpiSwiglu E{HMID, (const float*)(ws + WS_WC + 524288)};
        pg8::gemm_phase<pg8::EpiSwiglu, pg8::ExpertOrderT<true>, true, true>(lds, g, S, E, tid);
    }
    XBAR();
    STAMP(10);
    {
        PH_LOCALS
        pg8::Gemm g{HMID, WD, MAXSLOT, 2048, 1024}; pg8::ExpertOrderT<false> S{tile_start, G, bx, nullptr};
        pg8::EpiDown E{Y, row_gate};
        pg8::gemm_phase<pg8::EpiDown, pg8::ExpertOrderT<false>, true, true>(lds, g, S, E, tid);
    }
    XBAR();
    STAMP(11);
#if PROF_PHASE >= 0
    XBAR();
#endif

    {
    PH_LOCALS
    const float* g_fin = IN(16);
#if DBG_CMP
    const float dbg_scale = 1.0f + 4.0f * sqrtf(__hip_atomic_load((float*)(ctl + 4096), __ATOMIC_RELAXED, __HIP_MEMORY_SCOPE_AGENT) / __hip_atomic_load((float*)(ctl + 4097), __ATOMIC_RELAXED, __HIP_MEMORY_SCOPE_AGENT));
#elif PROF_PHASE >= 0 && (PROF_PHASE % 100) != 12
    const unsigned ta_ = __hip_atomic_load(ctl + 6000 + (PROF_PHASE / 100), __ATOMIC_RELAXED, __HIP_MEMORY_SCOPE_AGENT), tb_ = __hip_atomic_load(ctl + 6000 + (PROF_PHASE % 100), __ATOMIC_RELAXED, __HIP_MEMORY_SCOPE_AGENT);
    const float dbg_scale = 1.0f + sqrtf(PROF_SCALE * (float)(tb_ - ta_) * 0.01f);
#else
    const float dbg_scale = 1.0f;
#endif
    for (int t = gw; t < T_TOK; t += 2 * NGW) {
        const int t1 = (t + NGW < T_TOK) ? t + NGW : t;
        const int sa0 = tok_slot[2 * t], sa1 = tok_slot[2 * t + 1], sb0 = tok_slot[2 * t1], sb1 = tok_slot[2 * t1 + 1];
        f32x4* hra = (f32x4*)(out + (size_t)t * DMODEL) + lane; f32x4* hrb = (f32x4*)(out + (size_t)t1 * DMODEL) + lane;
        const u32x2* ya0 = (const u32x2*)(Y + (size_t)sa0 * DMODEL) + lane; const u32x2* ya1 = (const u32x2*)(Y + (size_t)sa1 * DMODEL) + lane;
        const u32x2* yb0 = (const u32x2*)(Y + (size_t)sb0 * DMODEL) + lane; const u32x2* yb1 = (const u32x2*)(Y + (size_t)sb1 * DMODEL) + lane;
        f32x4 va[8], vb[8]; u32x2 pa[8], qa[8], pb[8], qb[8];
#pragma unroll
        for (int j = 0; j < 8; ++j) { va[j] = hra[64 * j]; vb[j] = hrb[64 * j]; pa[j] = ya0[64 * j]; qa[j] = ya1[64 * j]; pb[j] = yb0[64 * j]; qb[j] = yb1[64 * j]; }
        float ssa = 0.f, ssb = 0.f;
#pragma unroll
        for (int j = 0; j < 8; ++j) {
            va[j][0] += bflo(pa[j].x) + bflo(qa[j].x); va[j][1] += bfhi(pa[j].x) + bfhi(qa[j].x); va[j][2] += bflo(pa[j].y) + bflo(qa[j].y); va[j][3] += bfhi(pa[j].y) + bfhi(qa[j].y);
            vb[j][0] += bflo(pb[j].x) + bflo(qb[j].x); vb[j][1] += bfhi(pb[j].x) + bfhi(qb[j].x); vb[j][2] += bflo(pb[j].y) + bflo(qb[j].y); vb[j][3] += bfhi(pb[j].y) + bfhi(qb[j].y);
            ssa += (va[j][0] * va[j][0] + va[j][1] * va[j][1]) + (va[j][2] * va[j][2] + va[j][3] * va[j][3]);
            ssb += (vb[j][0] * vb[j][0] + vb[j][1] * vb[j][1]) + (vb[j][2] * vb[j][2] + vb[j][3] * vb[j][3]);
        }
        const float ra = dbg_scale / sqrtf(wave_sum(ssa, lane) * (1.0f / DMODEL) + EPS_F), rb = dbg_scale / sqrtf(wave_sum(ssb, lane) * (1.0f / DMODEL) + EPS_F);
#pragma unroll
        for (int j = 0; j < 8; ++j) { const f32x4 gg = ((const f32x4*)g_fin)[lane + 64 * j]; hra[64 * j] = va[j] * ra * gg; if (t1 != t) hrb[64 * j] = vb[j] * rb * gg; }
    }
    }
#if PROF_PHASE >= 0
    if (PROF_PHASE % 100 == 12) {
        XBAR(); STAMP(12); XBAR();
        PH_LOCALS
        const unsigned ta_ = __hip_atomic_load(ctl + 6000 + (PROF_PHASE / 100), __ATOMIC_RELAXED, __HIP_MEMORY_SCOPE_AGENT), tb_ = __hip_atomic_load(ctl + 6012, __ATOMIC_RELAXED, __HIP_MEMORY_SCOPE_AGENT);
        const float sc_ = 1.0f + sqrtf(PROF_SCALE * (float)(tb_ - ta_) * 0.01f);
        for (size_t i = (size_t)gtid; i < (size_t)T_TOK * DMODEL / 4; i += (size_t)NGT) { f32x4 v = ((f32x4*)out)[i]; ((f32x4*)out)[i] = v * sc_; }
    }
#endif
}

extern "C" void kernel_launch(void* const* d_in, const int* in_sizes, int n_in, void* d_out, int out_size, void* d_ws, size_t ws_size, hipStream_t stream) {
    static int grid_blocks = 0;
    if (grid_blocks == 0) {
        if (n_in != 17 || out_size != T_TOK * DMODEL || ws_size < WS_END) { fprintf(stderr, "kernel_launch: unexpected problem (n_in %d, out %d, ws %zu < %zu)\n", n_in, out_size, ws_size, (size_t)WS_END); grid_blocks = -1; return; }
        int dev = 0, cus = 0, per_cu = 0;
        (void)hipGetDevice(&dev);
        (void)hipDeviceGetAttribute(&cus, hipDeviceAttributeMultiprocessorCount, dev);
        if (hipFuncSetAttribute((const void*)mega_fwd, hipFuncAttributeMaxDynamicSharedMemorySize, LDS_BYTES) != hipSuccess) { fprintf(stderr, "kernel_launch: hipFuncSetAttribute failed\n"); grid_blocks = -1; return; }
        if (hipOccupancyMaxActiveBlocksPerMultiprocessor(&per_cu, (const void*)mega_fwd, 512, LDS_BYTES) != hipSuccess || per_cu < 1) { fprintf(stderr, "kernel_launch: occupancy query says %d\n", per_cu); grid_blocks = -1; return; }
        grid_blocks = cus;
        fprintf(stderr, "kernel_launch: cus %d per_cu %d grid %d ws %zu need %zu\n", cus, per_cu, grid_blocks, ws_size, (size_t)WS_END);
    }
    if (grid_blocks < 0) return;
    if (hipMemsetAsync((char*)d_ws + WS_CTL, 0, 65536, stream) != hipSuccess) { fprintf(stderr, "kernel_launch: memset of control words failed\n"); return; }
    Params prm{};
    for (int i = 0; i < 17; ++i) prm.in[i] = (const float*)d_in[i];
    prm.out = (float*)d_out; prm.ws = (unsigned char*)d_ws;
    void* args[] = {&prm};
    hipError_t e = hipLaunchCooperativeKernel((void*)mega_fwd, dim3(grid_blocks), dim3(512), args, LDS_BYTES, stream);
    if (e != hipSuccess) fprintf(stderr, "cooperative launch failed: %s (grid %d)\n", hipGetErrorString(e), grid_blocks);
}
```

```cpp
#include <hip/hip_runtime.h>
#include <hip/hip_cooperative_groups.h>
#include <cstdio>
#include <cstdint>
namespace cg = cooperative_groups;
namespace pg8 {
#define PG8_LAS __attribute__((address_space(3)))
typedef unsigned short bf16_t;
typedef short bf16x8 __attribute__((ext_vector_type(8)));
typedef float f32x4 __attribute__((ext_vector_type(4)));
typedef unsigned u32x4 __attribute__((ext_vector_type(4)));
constexpr int BM = 256, BK = 64, HALF = 128, HTB = HALF * BK * 2  , STAGE_BYTES = 8 * HTB, NXCD = 8, WGM = 8;

__host__ __device__ __forceinline__ int lds_byte(int r, int c) { const int st = (r >> 4) * 2 + (c >> 5), rr = r & 15, cc = c & 31, ob = rr * 64 + cc * 2; return st * 1024 + (ob ^ (((ob >> 9) & 1) << 5)); }
__host__ __device__ __forceinline__ void stage_rc(int b, int& R, int& C) { const int st = b / 1024, sb = b % 1024, swz = sb ^ (((sb >> 9) & 1) << 5); R = (st >> 1) * 16 + swz / 64; C = (st & 1) * 32 + (swz % 64) / 2; }
__host__ __device__ __forceinline__ int perm32(int rho) { const int n = rho >> 4, i = rho & 15; return 8 * (i >> 2) + 4 * n + (i & 3); }

struct Unit { int pm, pn, e; };
struct Gemm { const bf16_t* A; const bf16_t* Bt; int M, N, K; };

struct StaticOrder {
    int nM, nN, nwg, G, c;
    __host__ __device__ void init(int M, int N, int G_, int c_) { nM = M / BM; nN = N / BM; nwg = nM * nN; G = G_; c = c_; }
    __host__ __device__ bool next(int i, Unit& u) const {
        const long L = (long)i * G + c; if (L >= nwg) return false;
        int wgid = (int)L; { const int q = nwg / NXCD, r = nwg % NXCD, xcd = wgid % NXCD, off = wgid / NXCD; wgid = (xcd < r ? xcd * (q + 1) : r * (q + 1) + (xcd - r) * q) + off; }
        const int nig = WGM * nN, gid = wgid / nig, fm = gid * WGM, gsz = (nM - fm) < WGM ? (nM - fm) : WGM;
        u.pm = fm + ((wgid % nig) % gsz); u.pn = (wgid % nig) / gsz; u.e = 0; return true;
    }
    static constexpr bool GATHER = false;
    __device__ __forceinline__ unsigned rowoff(int) const { return 0u; }
    __device__ __forceinline__ void a_ready(const Unit&) const {}
    __device__ __forceinline__ void done(const Unit&) const {}
};

template <class Epi, class Sched, bool ALIGN_EPI = false, bool SP2 = false>
__device__ __forceinline__ void gemm_phase(PG8_LAS unsigned char* lds, const Gemm g, const Sched& S, const Epi& E, const int tid) {
    const int wid = __builtin_amdgcn_readfirstlane(tid >> 6), lane = tid & 63, wr = wid >> 2, wc = wid & 3, fr = lane & 15, fq = lane >> 4;
    const int K = g.K, nt = K / BK;
    constexpr bool GA = Sched::GATHER;
    static_assert(!GA || SP2, "the gather path is written for the SP2 loop");
    unsigned voffA[2], voffB[2]; int gR[2], gC[2];
#pragma unroll
    for (int i = 0; i < 2; ++i) { int R, C; stage_rc(tid * 16 + i * 8192, R, C); const int Rb = Epi::PERM ? ((R & ~31) + perm32(R & 31)) : R;
        voffA[i] = (unsigned)(R * K + C) * 2u; voffB[i] = (unsigned)(Rb * K + C) * 2u; gR[i] = R; gC[i] = C; }
    unsigned cvo0[2] = {0u, 0u}, cvo1[2] = {0u, 0u}, nvo0[2] = {0u, 0u}, nvo1[2] = {0u, 0u}, sel0[2] = {0u, 0u}, sel1[2] = {0u, 0u};
#define PG8_GOFF(u_, o0_, o1_) do { _Pragma("unroll") for (int _i = 0; _i < 2; ++_i) { \
        o0_[_i] = S.rowoff((u_).pm * BM + gR[_i]) * (unsigned)(K * 2) + (unsigned)gC[_i] * 2u; o1_[_i] = S.rowoff((u_).pm * BM + HALF + gR[_i]) * (unsigned)(K * 2) + (unsigned)gC[_i] * 2u; } } while (0)
#define PG8_STAGE_A(bufoff, base, h_, CUR_) do { if constexpr (GA) { if (CUR_) { if (h_) PG8_STAGE(bufoff, base, cvo1); else PG8_STAGE(bufoff, base, cvo0); } else { if (h_) PG8_STAGE(bufoff, base, sel1); else PG8_STAGE(bufoff, base, sel0); } } \
        else PG8_STAGE(bufoff, (base) + (h_) * hstep, voffA); } while (0)
    const size_t kstep = (size_t)(BK * 2);
    const size_t hstep = (size_t)HALF * K * 2;
    const size_t tstep = 2 * hstep;
    const unsigned ldsw = (unsigned)wid * 1024u;
    const int aoff = lds_byte(wr * 64 + fr, fq * 8), boff = lds_byte(wc * 32 + fr, fq * 8);
#define PG8_SA(b, h) (((b) * 2 + (h)) * HTB)
#define PG8_SB(b, h) ((4 + (b) * 2 + (h)) * HTB)
#define PG8_STAGE(bufoff, gbase, voff) do { _Pragma("unroll") for (int _i = 0; _i < 2; ++_i) \
        __builtin_amdgcn_global_load_lds((const unsigned*)((const char*)(gbase) + (voff)[_i]), (PG8_LAS unsigned*)(lds + (bufoff) + ldsw + _i * 8192), 16, 0, 0); } while (0)
#define PG8_LDA(dst, b, h) do { _Pragma("unroll") for (int m = 0; m < 4; ++m) _Pragma("unroll") for (int k = 0; k < 2; ++k) dst[m][k] = *(const PG8_LAS bf16x8*)(lds + PG8_SA(b, h) + aoff + m * 2048 + k * 1024); } while (0)
#define PG8_LDB(dst, b, h) do { _Pragma("unroll") for (int n = 0; n < 2; ++n) _Pragma("unroll") for (int k = 0; k < 2; ++k) dst[n][k] = *(const PG8_LAS bf16x8*)(lds + PG8_SB(b, h) + boff + n * 2048 + k * 1024); } while (0)
#define PG8_MMA(ai, bj, At, Bt) do { __builtin_amdgcn_s_setprio(1); _Pragma("unroll") for (int m = 0; m < 4; ++m) _Pragma("unroll") for (int n = 0; n < 2; ++n) _Pragma("unroll") for (int k = 0; k < 2; ++k) \
        acc[ai][bj][m][n] = __builtin_amdgcn_mfma_f32_16x16x32_bf16(Bt[n][k], At[m][k], acc[ai][bj][m][n], 0, 0, 0); __builtin_amdgcn_s_setprio(0); } while (0)
#define PG8_WAIT_V(n) asm volatile("s_waitcnt vmcnt(" #n ")" ::: "memory")
#define PG8_WAIT_L(n) asm volatile("s_waitcnt lgkmcnt(" #n ")" ::: "memory")
#define PG8_BAR __builtin_amdgcn_s_barrier()
#define PG8_SCHED __builtin_amdgcn_sched_barrier(0)
    Unit cur, nxt; int ui = 0;
    if (!S.next(0, cur)) return;
    f32x4 acc[2][2][4][2];
#pragma unroll
    for (int a = 0; a < 2; ++a)
#pragma unroll
        for (int b = 0; b < 2; ++b)
#pragma unroll
            for (int m = 0; m < 4; ++m)
#pragma unroll
                for (int n = 0; n < 2; ++n) acc[a][b][m][n] = (f32x4){0.f, 0.f, 0.f, 0.f};
    bf16x8 At[4][2], B0[2][2], B1[2][2];
    const size_t estep = (size_t)g.N * K * 2;
    const char* cA = (const char*)g.A + (GA ? (size_t)0 : (size_t)cur.pm * tstep); const char* cB = (const char*)g.Bt + (size_t)cur.e * estep + (size_t)cur.pn * tstep;
    S.a_ready(cur);
    if constexpr (GA) PG8_GOFF(cur, cvo0, cvo1);
    if constexpr (SP2) {
        PG8_STAGE(PG8_SB(0, 0), cB, voffB); PG8_STAGE(PG8_SB(0, 1), cB + hstep, voffB); PG8_STAGE_A(PG8_SA(0, 0), cA, 0, true); PG8_STAGE_A(PG8_SA(0, 1), cA, 1, true);
        if (wr == 1) PG8_BAR;
        PG8_WAIT_V(2); PG8_BAR;
        PG8_STAGE(PG8_SB(1, 0), cB + kstep, voffB); PG8_STAGE_A(PG8_SA(1, 0), cA + kstep, 0, true); PG8_STAGE(PG8_SB(1, 1), cB + hstep + kstep, voffB);
        PG8_WAIT_V(6); PG8_BAR;
    } else {
        PG8_STAGE(PG8_SB(0, 0), cB, voffB); PG8_STAGE(PG8_SA(0, 0), cA, voffA); PG8_STAGE(PG8_SB(0, 1), cB + hstep, voffB); PG8_STAGE(PG8_SA(0, 1), cA + hstep, voffA);
        if (wr == 1) PG8_BAR;
        PG8_WAIT_V(4); PG8_BAR;
        PG8_STAGE(PG8_SB(1, 0), cB + kstep, voffB); PG8_STAGE(PG8_SA(1, 0), cA + kstep, voffA); PG8_STAGE(PG8_SB(1, 1), cB + hstep + kstep, voffB);
        PG8_WAIT_V(6); PG8_BAR;
    }
    for (;;) {
        const bool has_next = S.next(ui + 1, nxt);
        const char* nA = has_next ? (const char*)g.A + (GA ? (size_t)0 : (size_t)nxt.pm * tstep) : cA;
        if constexpr (GA) { if (has_next) PG8_GOFF(nxt, nvo0, nvo1); else { nvo0[0] = cvo0[0]; nvo0[1] = cvo0[1]; nvo1[0] = cvo1[0]; nvo1[1] = cvo1[1]; } } const char* nB = has_next ? (const char*)g.Bt + (size_t)nxt.e * estep + (size_t)nxt.pn * tstep : cB;
        for (int t = 0; t < nt; t += 2) {
            const bool last = (t == nt - 2);
            const char* a1 = cA + (size_t)(t + 1) * kstep;
            const char* a2 = last ? nA : cA + (size_t)(t + 2) * kstep; const char* b2 = last ? nB : cB + (size_t)(t + 2) * kstep;
            const char* a3 = a2 + kstep; const char* b3 = b2 + kstep;
            if (last && has_next) S.a_ready(nxt);
            if constexpr (GA) { sel0[0] = last ? nvo0[0] : cvo0[0]; sel0[1] = last ? nvo0[1] : cvo0[1]; sel1[0] = last ? nvo1[0] : cvo1[0]; sel1[1] = last ? nvo1[1] : cvo1[1]; }
            if constexpr (Epi::HAS_MID) { if (t == nt / 2) E.mid(acc, cur, wr, wc, fr, fq); }
            if constexpr (SP2) {
            PG8_LDB(B0, 0, 0); PG8_LDB(B1, 0, 1); PG8_SCHED; PG8_LDA(At, 0, 0); PG8_STAGE_A(PG8_SA(1, 1), a1, 1, true);
            PG8_WAIT_V(8); PG8_WAIT_L(0); PG8_BAR; PG8_MMA(0, 0, At, B0); PG8_MMA(0, 1, At, B1); PG8_BAR; PG8_SCHED;
            PG8_LDA(At, 0, 1); PG8_STAGE(PG8_SB(0, 0), b2, voffB); PG8_STAGE(PG8_SB(0, 1), b2 + hstep, voffB); PG8_STAGE_A(PG8_SA(0, 0), a2, 0, false);
            PG8_WAIT_V(8); PG8_WAIT_L(0); PG8_BAR; PG8_MMA(1, 0, At, B0); PG8_MMA(1, 1, At, B1); PG8_BAR; PG8_SCHED;
            PG8_LDB(B0, 1, 0); PG8_LDB(B1, 1, 1); PG8_SCHED; PG8_LDA(At, 1, 0); PG8_STAGE_A(PG8_SA(0, 1), a2, 1, false);
            PG8_WAIT_V(8); PG8_WAIT_L(0); PG8_BAR; PG8_MMA(0, 0, At, B0); PG8_MMA(0, 1, At, B1); PG8_BAR; PG8_SCHED;
            PG8_LDA(At, 1, 1); PG8_STAGE(PG8_SB(1, 0), b3, voffB); PG8_STAGE(PG8_SB(1, 1), b3 + hstep, voffB); PG8_STAGE_A(PG8_SA(1, 0), a3, 0, false);
            PG8_WAIT_V(8); PG8_WAIT_L(0); PG8_BAR; PG8_MMA(1, 0, At, B0); PG8_MMA(1, 1, At, B1); PG8_BAR; PG8_SCHED;
            } else {
            PG8_LDB(B0, 0, 0); PG8_SCHED; PG8_LDA(At, 0, 0); PG8_STAGE(PG8_SA(1, 1), a1 + hstep, voffA);
            PG8_WAIT_L(8); PG8_BAR; PG8_WAIT_L(0); PG8_MMA(0, 0, At, B0); PG8_BAR; PG8_SCHED;
            PG8_LDB(B1, 0, 1); PG8_STAGE(PG8_SB(0, 0), b2, voffB);
            PG8_BAR; PG8_WAIT_L(0); PG8_MMA(0, 1, At, B1); PG8_BAR;
            PG8_LDA(At, 0, 1); PG8_STAGE(PG8_SA(0, 0), a2, voffA);
            PG8_BAR; PG8_WAIT_L(0); PG8_MMA(1, 0, At, B0); PG8_BAR; PG8_SCHED;
            PG8_STAGE(PG8_SB(0, 1), b2 + hstep, voffB);
            PG8_WAIT_V(6); PG8_BAR; PG8_MMA(1, 1, At, B1); PG8_BAR;
            PG8_LDB(B0, 1, 0); PG8_SCHED; PG8_LDA(At, 1, 0); PG8_STAGE(PG8_SA(0, 1), a2 + hstep, voffA);
            PG8_WAIT_L(8); PG8_BAR; PG8_WAIT_L(0); PG8_MMA(0, 0, At, B0); PG8_BAR; PG8_SCHED;
            PG8_LDB(B1, 1, 1); PG8_STAGE(PG8_SB(1, 0), b3, voffB);
            PG8_BAR; PG8_WAIT_L(0); PG8_MMA(0, 1, At, B1); PG8_BAR;
            PG8_LDA(At, 1, 1); PG8_STAGE(PG8_SA(1, 0), a3, voffA);
            PG8_BAR; PG8_WAIT_L(0); PG8_MMA(1, 0, At, B0); PG8_BAR; PG8_SCHED;
            PG8_STAGE(PG8_SB(1, 1), b3 + hstep, voffB);
            PG8_WAIT_V(6); PG8_BAR; PG8_MMA(1, 1, At, B1); PG8_BAR;
            }
        }
        if constexpr (ALIGN_EPI) { if (wr == 0) PG8_BAR; }
        if constexpr (!Epi::AFTER_DRAIN) { E(acc, cur, wr, wc, fr, fq); S.done(cur); }
        if (!has_next) break;
#pragma unroll
        for (int a = 0; a < 2; ++a)
#pragma unroll
            for (int b = 0; b < 2; ++b)
#pragma unroll
                for (int m = 0; m < 4; ++m)
#pragma unroll
                    for (int n = 0; n < 2; ++n) acc[a][b][m][n] = (f32x4){0.f, 0.f, 0.f, 0.f};
        cur = nxt; cA = nA; cB = nB; ++ui;
        if constexpr (GA) { cvo0[0] = nvo0[0]; cvo0[1] = nvo0[1]; cvo1[0] = nvo1[0]; cvo1[1] = nvo1[1]; }
        if constexpr (ALIGN_EPI) { if (wr == 1) PG8_BAR; }
    }
    PG8_WAIT_V(0);
    if constexpr (!ALIGN_EPI) { if (wr == 0) PG8_BAR; }
    PG8_BAR;
    if constexpr (Epi::AFTER_DRAIN) { E.fused(acc, cur, wr, wc, fr, fq, lds, wid, lane); S.done(cur); }
#undef PG8_SA
#undef PG8_SB
#undef PG8_STAGE
#undef PG8_STAGE_A
#undef PG8_GOFF
#undef PG8_LDA
#undef PG8_LDB
#undef PG8_MMA
#undef PG8_WAIT_V
#undef PG8_WAIT_L
#undef PG8_BAR
#undef PG8_SCHED
}
}

#ifndef DBG_CMP
#define DBG_CMP 0
#endif
#define LAS __attribute__((address_space(3)))
typedef unsigned short bf16_t;
typedef float f32x4 __attribute__((ext_vector_type(4)));
typedef unsigned u32x4 __attribute__((ext_vector_type(4)));
typedef unsigned u32x2 __attribute__((ext_vector_type(2)));
typedef unsigned long long u64;

constexpr int T_TOK = 16384, DMODEL = 2048, SEQL = 2048;
constexpr int NPROJ = 9984;
constexpr int C_QLAT = 0, C_CKV = 1024, C_QIDX = 1152, C_KIDX = 1664, C_WIDX = 1728, C_QR = 1792, C_KR = 2816, C_VR = 3840, C_GR = 4864, C_GBR = 5888;
constexpr int MAXSLOT = 40960;
constexpr float EPS_F = 1e-6f;
constexpr float IDX_SCALE = 0.04419417382415922f;
constexpr float ATT_SCALE = 0.08838834764831845f;
constexpr float K_SCALE = 0.08838834764831845f;

constexpr size_t WS_CTL = 0;
constexpr size_t WS_ROT = 65536;
constexpr size_t WS_WIN = WS_ROT + 1048576;
constexpr size_t WS_WCOMB = WS_WIN + (size_t)NPROJ * 2048 * 2;
constexpr size_t WS_WB = WS_WCOMB + (size_t)2048 * 1024 * 2;
constexpr size_t WS_WO = WS_WB + (size_t)2048 * 1024 * 2;
constexpr size_t WS_WGU = WS_WO + (size_t)2048 * 2048 * 2;
constexpr size_t WS_WD = WS_WGU + (size_t)32 * 2048 * 2048 * 2;
constexpr size_t WS_P = WS_WD + (size_t)32 * 2048 * 1024 * 2;
constexpr size_t WS_HMID = WS_P;
constexpr size_t WS_Y = WS_HMID + (size_t)MAXSLOT * 1024 * 2;
constexpr size_t WS_XN = WS_P + (size_t)T_TOK * NPROJ * 2;
constexpr size_t WS_OA = WS_XN + (size_t)T_TOK * 2048 * 2;
constexpr size_t WS_OB = WS_OA + (size_t)T_TOK * 1024 * 2;
constexpr size_t WS_MIXED = WS_OB + (size_t)T_TOK * 1024 * 2;
constexpr size_t WS_SPARE = WS_MIXED + (size_t)T_TOK * 2048 * 2;
constexpr size_t WS_XG = WS_OA;
constexpr size_t WS_KV = WS_SPARE + (size_t)T_TOK * 1024 * 2;
constexpr size_t WS_MASK = WS_KV + (size_t)T_TOK * 128 * 2;
constexpr size_t WS_MISC = WS_MASK + (size_t)T_TOK * 256;
constexpr size_t WS_WC = WS_MISC + 1048576;
constexpr size_t WS_END = WS_WC + 1048576;
static_assert(WS_Y + (size_t)MAXSLOT * 2048 * 2 <= WS_XN, "HMID + Y must fit in P");
static_assert(WS_XG + (size_t)MAXSLOT * 2048 * 2 <= WS_KV, "XG must fit in OA..SPARE");
static_assert(WS_END <= (size_t)1073741824, "workspace budget");
constexpr int MI_ROWTOK = 0, MI_ROWGATE = MAXSLOT, MI_TOKSLOT = 2 * MAXSLOT, MI_ASGE = MI_TOKSLOT + 2 * T_TOK, MI_ASGR = MI_ASGE + 2 * T_TOK, MI_ASGG = MI_ASGR + 2 * T_TOK;
static_assert((size_t)(MI_ASGG + 2 * T_TOK) * 4 <= 1048576, "misc budget");
constexpr int LDS_BYTES = 152 * 1024;
constexpr int LDS_MISC = 150 * 1024;

__device__ __forceinline__ float bflo(unsigned w) { return __uint_as_float(w << 16); }
__device__ __forceinline__ float bfhi(unsigned w) { return __uint_as_float(w & 0xffff0000u); }
__device__ __forceinline__ unsigned pkbf(float lo, float hi) { unsigned r; asm volatile("v_cvt_pk_bf16_f32 %0, %1, %2" : "=v"(r) : "v"(lo), "v"(hi)); return r; }
__device__ __forceinline__ int hide_i(int v) { asm volatile("" : "+v"(v)); return v; }
template <class Tp> __device__ __forceinline__ Tp* hide_p(Tp* q) { asm volatile("" : "+s"(q)); return q; }
__device__ __forceinline__ float shx(float v, int lane, int o) { return __int_as_float(__builtin_amdgcn_ds_bpermute((lane ^ o) << 2, __float_as_int(v))); }
__device__ __forceinline__ float wave_sum(float v, int lane) {
#pragma unroll
    for (int o = 1; o < 64; o <<= 1) v += shx(v, lane, o);
    return v;
}
__device__ __forceinline__ float wave_max(float v, int lane) {
#pragma unroll
    for (int o = 1; o < 64; o <<= 1) v = fmaxf(v, shx(v, lane, o));
    return v;
}
__device__ __forceinline__ float sigmoidf_(float x) { return __builtin_amdgcn_rcpf(1.0f + __expf(-x)); }
__device__ __forceinline__ float siluf_(float x) { return x * sigmoidf_(x); }
__device__ __forceinline__ float unkey(unsigned k) { return __uint_as_float((k & 0x80000000u) ? (k & 0x7fffffffu) : ~k); }
__device__ __forceinline__ int sbin(float s) { const int b = (int)(s * 32.0f + 128.0f); return b < 0 ? 0 : (b > 255 ? 255 : b); }
__device__ __forceinline__ unsigned fkey(float f) { const unsigned u = __float_as_uint(f + 0.0f); return (u & 0x80000000u) ? ~u : (u | 0x80000000u); }


#define XB_TMO      128
#define XB_XCNT(j)  (256  + 64 * (j))
#define XB_XSUB(j)  (1280 + 64 * (j))
#define XB_XGEN(j)  (2304 + 64 * (j))
#define XB_TOP      3328
#define XB_TOPGEN   3392
#define XCD_BAR_WORDS 3456
#define XB_SPIN_CAP (1u << 18)
__device__ __forceinline__ unsigned xb_ld(unsigned* p)              { return __hip_atomic_load(p, __ATOMIC_RELAXED, __HIP_MEMORY_SCOPE_AGENT); }
__device__ __forceinline__ unsigned xb_add(unsigned* p, unsigned v) { return __hip_atomic_fetch_add(p, v, __ATOMIC_RELAXED, __HIP_MEMORY_SCOPE_AGENT); }
__device__ __forceinline__ unsigned xb_xcc_id() { return (unsigned)__builtin_amdgcn_s_getreg((3 << 11) | 20) & 0xFu; }
#define XB_SPIN(cond, bar) do { unsigned _sp = 0; while (cond) { __builtin_amdgcn_s_sleep(1); \
    if ((++_sp & 255u) == 0u) { if (xb_ld(&(bar)[XB_TMO])) break; if (_sp > XB_SPIN_CAP) { atomicAdd(&(bar)[XB_TMO], 1u); break; } } } } while (0)
struct XcdBarrier { unsigned* bar; unsigned x; volatile __attribute__((address_space(3))) unsigned* st; };
__device__ __forceinline__ void xcd_barrier_complete(unsigned* bar, unsigned x, unsigned& nloc, unsigned& nx) {
    const unsigned G = gridDim.x * gridDim.y * gridDim.z;
    unsigned sum, cnt, mine, sp = 0u;
    for (;;) {
        sum = 0u; cnt = 0u; mine = 0u;
#pragma unroll
        for (unsigned j = 0; j < 16; ++j) { const unsigned c = xb_ld(&bar[XB_XCNT(j)]); sum += c; cnt += (c > 0u) ? 1u : 0u; mine = (j == x) ? c : mine; }
        if (sum == G) break;
        __builtin_amdgcn_s_sleep(1);
        if ((++sp & 255u) == 0u) { if (xb_ld(&bar[XB_TMO])) break; if (sp > XB_SPIN_CAP) { atomicAdd(&bar[XB_TMO], 1u); break; } }
    }
    nloc = mine > 0u ? mine : 1u; nx = cnt > 0u ? cnt : 1u;
}
__device__ __forceinline__ void xcd_barrier(const XcdBarrier& b, int tid) {
    asm volatile("s_waitcnt vmcnt(0)" ::: "memory");
    __syncthreads();
    if (tid == 0) {
        unsigned* bar = b.bar;
        __builtin_amdgcn_s_waitcnt(0);
        unsigned nloc = b.st[0], nx = b.st[1];
        if (nloc == 0u) { xcd_barrier_complete(bar, b.x, nloc, nx); b.st[0] = nloc; b.st[1] = nx; }
        const unsigned old = xb_add(&bar[XB_XSUB(b.x)], 1u);
        const unsigned gen = old / nloc;
        if (old + 1u == (gen + 1u) * nloc) {
            __builtin_amdgcn_fence(__ATOMIC_RELEASE, "agent");
            asm volatile("s_waitcnt vmcnt(0)" ::: "memory");
            const unsigned og = xb_add(&bar[XB_TOP], 1u);
            const unsigned tg = og / nx;
            if (og + 1u == (tg + 1u) * nx) xb_add(&bar[XB_TOPGEN], 1u);
            else XB_SPIN(xb_ld(&bar[XB_TOPGEN]) == tg, bar);
            __builtin_amdgcn_fence(__ATOMIC_ACQUIRE, "agent");
            xb_add(&bar[XB_XGEN(b.x)], 1u);
            asm volatile("s_waitcnt vmcnt(0)" ::: "memory");
        } else {
            XB_SPIN(xb_ld(&bar[XB_XGEN(b.x)]) == gen, bar);
            __builtin_amdgcn_fence(__ATOMIC_ACQUIRE, "agent");
            asm volatile("s_waitcnt vmcnt(0)" ::: "memory");
        }
    }
    __syncthreads();
}

namespace fa {
using bf16x8 = __attribute__((ext_vector_type(8))) short;
using s16x4  = __attribute__((ext_vector_type(4))) short;
using f32x16 = __attribute__((ext_vector_type(16))) float;
constexpr int TILE_B = 64 * 128 * 2;
constexpr int OFF_V = 0, OFF_K = 2 * TILE_B, OFF_M = 4 * TILE_B, OFF_WS = OFF_M + 2 * 256, OFF_Q = OFF_WS + 8 * 256, LDS_NEED = OFF_Q + 8 * 8704;
#define FA_GAS __attribute__((address_space(1)))
#define FA_KSWZ(row, colB) ((row) * 256 + ((colB) ^ (((row) & 7) << 4)))
#define FA_SBAR() __builtin_amdgcn_sched_barrier(0)
__device__ __forceinline__ int crow(int r, int hi) { return (r & 3) + 8 * (r >> 2) + 4 * hi; }
__device__ __forceinline__ int v_st(int k, int c) { const int kk = (k & ~0xC) | ((k & 4) << 1) | ((k & 8) >> 1); return ((kk >> 3) * 4 + (c >> 5)) * 512 + ((kk & 7) * 32 + (c & 31)) * 2; }
__device__ __forceinline__ int v_rd_base(int lane) { return ((lane & 3) << 3) | (((lane >> 2) & 3) << 6) | (((lane >> 4) & 1) << 5) | (((lane >> 5) & 1) << 8); }
constexpr int v_rd_off(int d0, int ks, int half) { return d0 * 512 + ks * 4096 + half * 2048; }
template <int OFF> __device__ __forceinline__ s16x4 tr_read(int vb) { s16x4 r; asm volatile("ds_read_b64_tr_b16 %0, %1 offset:%2" : "=&v"(r) : "v"(vb), "i"(OFF) : "memory"); return r; }
template <int D0> __device__ __forceinline__ void pv_one(f32x16& od, int vb, bf16x8 pa0, bf16x8 pa1, bf16x8 pa2, bf16x8 pa3) {
    const s16x4 l0 = tr_read<v_rd_off(D0, 0, 0)>(vb), h0 = tr_read<v_rd_off(D0, 0, 1)>(vb), l1 = tr_read<v_rd_off(D0, 1, 0)>(vb), h1 = tr_read<v_rd_off(D0, 1, 1)>(vb);
    const s16x4 l2 = tr_read<v_rd_off(D0, 2, 0)>(vb), h2 = tr_read<v_rd_off(D0, 2, 1)>(vb), l3 = tr_read<v_rd_off(D0, 3, 0)>(vb), h3 = tr_read<v_rd_off(D0, 3, 1)>(vb);
    asm volatile("s_waitcnt lgkmcnt(0)" ::: "memory"); FA_SBAR();
#define FA_PK(L, H) (bf16x8){L[0], L[1], L[2], L[3], H[0], H[1], H[2], H[3]}
    od = __builtin_amdgcn_mfma_f32_32x32x16_bf16(pa0, FA_PK(l0, h0), od, 0, 0, 0);
    od = __builtin_amdgcn_mfma_f32_32x32x16_bf16(pa1, FA_PK(l1, h1), od, 0, 0, 0);
    od = __builtin_amdgcn_mfma_f32_32x32x16_bf16(pa2, FA_PK(l2, h2), od, 0, 0, 0);
    od = __builtin_amdgcn_mfma_f32_32x32x16_bf16(pa3, FA_PK(l3, h3), od, 0, 0, 0);
#undef FA_PK
}
#define FA_RD8(D0, l0, h0, l1, h1, l2, h2, l3, h3) do { l0 = tr_read<v_rd_off(D0, 0, 0)>(vb); h0 = tr_read<v_rd_off(D0, 0, 1)>(vb); l1 = tr_read<v_rd_off(D0, 1, 0)>(vb); h1 = tr_read<v_rd_off(D0, 1, 1)>(vb); \
        l2 = tr_read<v_rd_off(D0, 2, 0)>(vb); h2 = tr_read<v_rd_off(D0, 2, 1)>(vb); l3 = tr_read<v_rd_off(D0, 3, 0)>(vb); h3 = tr_read<v_rd_off(D0, 3, 1)>(vb); } while (0)
#define FA_PK(L, H) (bf16x8){L[0], L[1], L[2], L[3], H[0], H[1], H[2], H[3]}
#define FA_MM4(od, l0, h0, l1, h1, l2, h2, l3, h3) do { od = __builtin_amdgcn_mfma_f32_32x32x16_bf16(pa0, FA_PK(l0, h0), od, 0, 0, 0); od = __builtin_amdgcn_mfma_f32_32x32x16_bf16(pa1, FA_PK(l1, h1), od, 0, 0, 0); \
        od = __builtin_amdgcn_mfma_f32_32x32x16_bf16(pa2, FA_PK(l2, h2), od, 0, 0, 0); od = __builtin_amdgcn_mfma_f32_32x32x16_bf16(pa3, FA_PK(l3, h3), od, 0, 0, 0); } while (0)
__device__ __forceinline__ void pv_all(f32x16 (&o)[4], int vb, bf16x8 pa0, bf16x8 pa1, bf16x8 pa2, bf16x8 pa3) {
    s16x4 a0, a1, a2, a3, a4, a5, a6, a7, b0, b1, b2, b3, b4, b5, b6, b7;
    FA_RD8(0, a0, a1, a2, a3, a4, a5, a6, a7);
    FA_RD8(1, b0, b1, b2, b3, b4, b5, b6, b7);
    asm volatile("s_waitcnt lgkmcnt(8)" ::: "memory"); FA_SBAR();
    FA_MM4(o[0], a0, a1, a2, a3, a4, a5, a6, a7); FA_SBAR();
    FA_RD8(2, a0, a1, a2, a3, a4, a5, a6, a7);
    asm volatile("s_waitcnt lgkmcnt(8)" ::: "memory"); FA_SBAR();
    FA_MM4(o[1], b0, b1, b2, b3, b4, b5, b6, b7); FA_SBAR();
    FA_RD8(3, b0, b1, b2, b3, b4, b5, b6, b7);
    asm volatile("s_waitcnt lgkmcnt(8)" ::: "memory"); FA_SBAR();
    FA_MM4(o[2], a0, a1, a2, a3, a4, a5, a6, a7); FA_SBAR();
    asm volatile("s_waitcnt lgkmcnt(0)" ::: "memory"); FA_SBAR();
    FA_MM4(o[3], b0, b1, b2, b3, b4, b5, b6, b7);
}
#undef FA_RD8
#undef FA_MM4
#undef FA_PK
template <bool QLDS>
__device__ __forceinline__ void qkt(f32x16& p0, f32x16& p1, const LAS char* Ks, const bf16x8 (&qr)[8], const LAS char* Ql, int r32, int hi) {
    p0 = f32x16{}; p1 = f32x16{};
#pragma unroll
    for (int d0 = 0; d0 < 8; ++d0) { const int cb = (d0 * 16 + hi * 8) * 2;
        const bf16x8 b0 = *(const LAS bf16x8*)(Ks + FA_KSWZ(r32, cb));
        const bf16x8 b1 = *(const LAS bf16x8*)(Ks + FA_KSWZ(32 + r32, cb));
        const bf16x8 q = QLDS ? *(const LAS bf16x8*)(Ql + d0 * 1024) : qr[d0];
        p0 = __builtin_amdgcn_mfma_f32_32x32x16_bf16(b0, q, p0, 0, 0, 0);
        p1 = __builtin_amdgcn_mfma_f32_32x32x16_bf16(b1, q, p1, 0, 0, 0); }
}
__device__ __forceinline__ void p_to_frag(const f32x16& p0, const f32x16& p1, bf16x8& pa0, bf16x8& pa1, bf16x8& pa2, bf16x8& pa3) {
#define FA_PK4(P, BASE, OUT) do { unsigned a0 = pkbf(P[BASE + 0], P[BASE + 1]), a1 = pkbf(P[BASE + 2], P[BASE + 3]);   \
    unsigned b0 = pkbf(P[BASE + 4], P[BASE + 5]), b1 = pkbf(P[BASE + 6], P[BASE + 7]);                              \
    auto r0 = __builtin_amdgcn_permlane32_swap(a0, b0, false, false); auto r1 = __builtin_amdgcn_permlane32_swap(a1, b1, false, false); \
    u32x4 w = {r0[0], r1[0], r0[1], r1[1]}; OUT = *reinterpret_cast<bf16x8*>(&w); } while (0)
    FA_PK4(p0, 0, pa0); FA_PK4(p0, 8, pa1); FA_PK4(p1, 0, pa2); FA_PK4(p1, 8, pa3);
#undef FA_PK4
}

struct UnitArgs {
    const bf16_t* Q; int ldq;
    const bf16_t* K; const bf16_t* V; int ldk;
    const u64* mask;
    int ntiles;
    int n0;
    float lgam;
};

template <int MODE, int EXP = 0>
__device__ __forceinline__ void unit_body(LAS char* L, const UnitArgs& U, int tid, f32x16 (&o)[4], float& l_out) {
    const int wid = __builtin_amdgcn_readfirstlane(tid >> 6), lane = tid & 63, r32 = lane & 31, hi = lane >> 5;
    LAS char* V_lds = L + OFF_V; LAS char* K_lds = L + OFF_K; LAS u64* M_lds = (LAS u64*)(L + OFF_M);
    LAS float* wsf = (LAS float*)(L + OFF_WS) + wid * 64; LAS float* al_l = wsf + 32;
    constexpr float C = ATT_SCALE * 1.4426950408889634f;
    float m_reg = -1e30f, l_reg = 0.f;
    bf16x8 qr[8];
    LAS char* Ql = L + OFF_Q + wid * 8192 + lane * 16;
    { const FA_GAS bf16_t* Qh = (const FA_GAS bf16_t*)hide_p(U.Q); const FA_GAS bf16_t* Qw = (MODE == 0) ? Qh + (size_t)r32 * U.ldq + wid * 128 + hi * 8 : Qh + (size_t)(wid * 32 + r32) * U.ldq + hi * 8;
#pragma unroll
      for (int d0 = 0; d0 < 8; ++d0) { qr[d0] = *(const FA_GAS bf16x8*)(Qw + d0 * 16); if (MODE == 1) *(LAS bf16x8*)(Ql + d0 * 1024) = qr[d0]; } }
    if (MODE == 1) { asm volatile("s_waitcnt vmcnt(0) lgkmcnt(0)" ::: "memory"); FA_SBAR(); }
    const int sr = tid >> 4, sc = (tid & 15) * 8, vst0 = v_st(sr, sc), vst1 = v_st(32 + sr, sc), kst0 = FA_KSWZ(sr, sc * 2), kst1 = FA_KSWZ(32 + sr, sc * 2);
    const FA_GAS char* Kh = (const FA_GAS char*)hide_p(U.K); const FA_GAS char* Vh = (const FA_GAS char*)hide_p(U.V);
    const int ldk_ = (EXP & 4) ? 128 : U.ldk;
    const unsigned goff0 = (unsigned)(sr * ldk_ + sc) * 2u, goff1 = (unsigned)((32 + sr) * ldk_ + sc) * 2u;
    const int vb0 = (int)(unsigned)(size_t)V_lds + v_rd_base(lane);
    bf16x8 ksA0, ksA1, vsA0, vsA1; u64 mwA = 0ull; unsigned pf_ = 0u;
#define FA_SLOAD(S, k0) do { const FA_GAS char* kb_ = Kh + (size_t)(k0) * ldk_ * 2; const FA_GAS char* vb_ = Vh + (size_t)(k0) * ldk_ * 2;     \
        ks##S##0 = *(const FA_GAS bf16x8*)(kb_ + goff0); ks##S##1 = *(const FA_GAS bf16x8*)(kb_ + goff1); \
        if (MODE == 1) { if (EXP & 2) { vs##S##0 = ks##S##0; vs##S##1 = ks##S##1; } else { vs##S##0 = *(const FA_GAS bf16x8*)(vb_ + goff0); vs##S##1 = *(const FA_GAS bf16x8*)(vb_ + goff1); } } \
        if (MODE == 0 && tid < 32) mw##S = U.mask[(size_t)tid * 32 + ((k0) >> 6)]; } while (0)
#define FA_SWRITE(S, b) do { *(LAS bf16x8*)(K_lds + (b) * TILE_B + kst0) = ks##S##0; *(LAS bf16x8*)(K_lds + (b) * TILE_B + kst1) = ks##S##1; \
        *(LAS bf16x8*)(V_lds + (b) * TILE_B + vst0) = (MODE == 1) ? vs##S##0 : ks##S##0; *(LAS bf16x8*)(V_lds + (b) * TILE_B + vst1) = (MODE == 1) ? vs##S##1 : ks##S##1; \
        if (MODE == 0 && tid < 32) M_lds[(b) * 32 + tid] = mw##S; } while (0)
#define FA_TOUCH(k0) do { if (MODE == 1 && !(EXP & 16) && tid < 256) { const FA_GAS char* tb_ = ((tid < 128) ? Kh : Vh) + (size_t)((k0) + ((tid & 127) >> 1)) * ldk_ * 2 + (tid & 1) * 128; \
        asm volatile("global_load_dword %0, %1, off" : "=v"(pf_) : "v"(tb_) : "memory"); } } while (0)
#define FA_TILE(j, b) do { \
        f32x16 p0, p1; bf16x8 pa0, pa1, pa2, pa3; \
        { const LAS char* qb_ = Ql; asm volatile("" : "+v"(qb_)); qkt<MODE == 1>(p0, p1, K_lds + (b) * TILE_B, qr, qb_, r32, hi); } \
        if (MODE == 0) { \
            const u64 mw = M_lds[(b) * 32 + r32] >> (4 * hi); \
            const unsigned mlo = (unsigned)mw, mhi = (unsigned)(mw >> 32); \
            _Pragma("unroll") for (int r = 0; r < 16; ++r) { const unsigned bit = 1u << ((r & 3) + 8 * (r >> 2)); p0[r] = (mlo & bit) ? p0[r] : -INFINITY; p1[r] = (mhi & bit) ? p1[r] : -INFINITY; } \
            float pmax = p0[0]; \
            _Pragma("unroll") for (int r = 1; r < 16; ++r) pmax = fmaxf(pmax, p0[r]); \
            _Pragma("unroll") for (int r = 0; r < 16; ++r) pmax = fmaxf(pmax, p1[r]); \
            { auto rr = __builtin_amdgcn_permlane32_swap(__float_as_uint(pmax), __float_as_uint(pmax), false, false); pmax = fmaxf(__uint_as_float(rr[0]), __uint_as_float(rr[1])); } \
            const float mn = fmaxf(m_reg, pmax); const float alpha = __builtin_amdgcn_exp2f((m_reg - mn) * C); m_reg = mn; \
            const float mnC = -mn * C; float ps = 0.f; \
            _Pragma("unroll") for (int r = 0; r < 16; ++r) { p0[r] = __builtin_amdgcn_exp2f(fmaf(p0[r], C, mnC)); p1[r] = __builtin_amdgcn_exp2f(fmaf(p1[r], C, mnC)); ps += p0[r] + p1[r]; } \
            { auto rr = __builtin_amdgcn_permlane32_swap(__float_as_uint(ps), __float_as_uint(ps), false, false); ps = __uint_as_float(rr[0]) + __uint_as_float(rr[1]); } \
            l_reg = l_reg * alpha + ps; \
            if (__any(alpha < 1.f)) { \
                if (hi == 0) al_l[r32] = alpha; \
                asm volatile("s_waitcnt lgkmcnt(0)" ::: "memory"); \
                _Pragma("unroll") for (int r = 0; r < 16; ++r) { const float a_ = al_l[crow(r, hi)]; \
                    _Pragma("unroll") for (int d = 0; d < 4; ++d) o[d][r] *= a_; } \
            } \
        } else if (!(EXP & 1)) { \
            const int dn = U.n0 + wid * 32 + r32 - (j) * 64 - 4 * hi; \
            const float base = (float)dn * U.lgam; \
            _Pragma("unroll") for (int r = 0; r < 16; ++r) { const int kk = (r & 3) + 8 * (r >> 2); \
                const float f0 = __builtin_amdgcn_exp2f(base - (float)kk * U.lgam), f1 = __builtin_amdgcn_exp2f(base - (float)(kk + 32) * U.lgam); \
                p0[r] = (dn >= kk) ? p0[r] * f0 : 0.f; p1[r] = (dn >= kk + 32) ? p1[r] * f1 : 0.f; } \
        } \
        p_to_frag(p0, p1, pa0, pa1, pa2, pa3); \
        FA_SBAR(); \
        { const int vb = vb0 + (b) * TILE_B; \
          pv_all(o, vb, pa0, pa1, pa2, pa3); } \
    } while (0)
    const int NT = U.ntiles;
    FA_SLOAD(A, 0); FA_SWRITE(A, 0);
    if (NT > 1) { FA_SLOAD(A, 64); FA_SWRITE(A, 1); }
    if (NT > 2) FA_TOUCH(128);
    if (NT > 3) FA_TOUCH(192);
    __syncthreads();
#pragma unroll
    for (int d = 0; d < 4; ++d) o[d] = f32x16{};
#pragma unroll 1
    for (int j = 0; j < NT; ++j) {
        const int b = j & 1;
        if (j + 2 < NT) FA_SLOAD(A, (j + 2) * 64);
        if (j + 4 < NT) FA_TOUCH((j + 4) * 64);
        FA_TILE(j, b);
        __syncthreads();
        if (j + 2 < NT) FA_SWRITE(A, b);
        asm volatile("" :: "v"(pf_));
    }
    asm volatile("s_waitcnt vmcnt(0)" ::: "memory");
    __syncthreads();
    l_out = l_reg;
#undef FA_SLOAD
#undef FA_SWRITE
#undef FA_TILE
}

template <int MODE>
__device__ __forceinline__ void unit_body2(LAS char* L, const UnitArgs& U, int tid, f32x16 (&o)[4], float& l_out) {
    const int wid = __builtin_amdgcn_readfirstlane(tid >> 6), lane = tid & 63, r32 = lane & 31, hi = lane >> 5;
    LAS char* V_lds = L + OFF_V; LAS char* K_lds = L + OFF_K; LAS u64* M_lds = (LAS u64*)(L + OFF_M);
    LAS float* wsf = (LAS float*)(L + OFF_WS) + wid * 64; LAS float* al_l = wsf + 32;
    constexpr float C = ATT_SCALE * 1.4426950408889634f;
    constexpr float THR = 8.0f;
    float m_reg = -1e30f, l_reg = 0.f;
    bf16x8 qr[8];
    LAS char* Ql = L + OFF_Q + wid * 8192 + lane * 16;
    { const FA_GAS bf16_t* Qh = (const FA_GAS bf16_t*)hide_p(U.Q); const FA_GAS bf16_t* Qw = (MODE == 0) ? Qh + (size_t)r32 * U.ldq + wid * 128 + hi * 8 : Qh + (size_t)(wid * 32 + r32) * U.ldq + hi * 8;
#pragma unroll
      for (int d0 = 0; d0 < 8; ++d0) { qr[d0] = *(const FA_GAS bf16x8*)(Qw + d0 * 16); if (MODE == 1) *(LAS bf16x8*)(Ql + d0 * 1024) = qr[d0]; } }
    if (MODE == 1) { asm volatile("s_waitcnt vmcnt(0) lgkmcnt(0)" ::: "memory"); FA_SBAR(); }
    const int sr = tid >> 4, sc = (tid & 15) * 8;
    const FA_GAS char* Kh = (const FA_GAS char*)hide_p(U.K); const FA_GAS char* Vh = (const FA_GAS char*)hide_p(U.V);
    const unsigned goff0 = (unsigned)(sr * U.ldk + sc) * 2u, goff1 = (unsigned)((32 + sr) * U.ldk + sc) * 2u;
    const int vb0 = (int)(unsigned)(size_t)V_lds + v_rd_base(lane);
    bf16x8 ksE0, ksE1, vsE0, vsE1; u64 mwE = 0ull; unsigned pf_ = 0u;
#define F2_TOUCH(k0) do { if (MODE == 1 && tid < 256) { const FA_GAS char* tb_ = ((tid < 128) ? Kh : Vh) + (size_t)((k0) + ((tid & 127) >> 1)) * U.ldk * 2 + (tid & 1) * 128; \
        asm volatile("global_load_dword %0, %1, off" : "=v"(pf_) : "v"(tb_) : "memory"); } } while (0)
#define F2_SLOAD(S, k0) do { const FA_GAS char* kb_ = Kh + (size_t)(k0) * U.ldk * 2; const FA_GAS char* vb_ = Vh + (size_t)(k0) * U.ldk * 2; \
        ks##S##0 = *(const FA_GAS bf16x8*)(kb_ + goff0); ks##S##1 = *(const FA_GAS bf16x8*)(kb_ + goff1); \
        if (MODE == 1) { vs##S##0 = *(const FA_GAS bf16x8*)(vb_ + goff0); vs##S##1 = *(const FA_GAS bf16x8*)(vb_ + goff1); } \
        if (MODE == 0 && tid < 32) mw##S = U.mask[(size_t)tid * 32 + ((k0) >> 6)]; } while (0)
#define F2_SWRITE(S, b) do { const int t_ = hide_i(tid), sr_ = t_ >> 4, sc_ = (t_ & 15) * 8; const int vst0 = v_st(sr_, sc_), vst1 = v_st(32 + sr_, sc_), kst0 = FA_KSWZ(sr_, sc_ * 2), kst1 = FA_KSWZ(32 + sr_, sc_ * 2);     \
        *(LAS bf16x8*)(K_lds + (b) * TILE_B + kst0) = ks##S##0; *(LAS bf16x8*)(K_lds + (b) * TILE_B + kst1) = ks##S##1; \
        *(LAS bf16x8*)(V_lds + (b) * TILE_B + vst0) = (MODE == 1) ? vs##S##0 : ks##S##0; *(LAS bf16x8*)(V_lds + (b) * TILE_B + vst1) = (MODE == 1) ? vs##S##1 : ks##S##1; \
        if (MODE == 0 && tid < 32) M_lds[(b) * 32 + tid] = mw##S; } while (0)
#define F2_PARTIAL(P0, P1, j, b, MN, AL) do { \
        if (MODE == 0) { \
            const u64 mw = M_lds[(b) * 32 + r32] >> (4 * hi); const unsigned mlo = (unsigned)mw, mhi = (unsigned)(mw >> 32); \
            _Pragma("unroll") for (int r = 0; r < 16; ++r) { const unsigned bit = 1u << ((r & 3) + 8 * (r >> 2)); P0[r] = (mlo & bit) ? P0[r] : -INFINITY; P1[r] = (mhi & bit) ? P1[r] : -INFINITY; } \
            float pmax = P0[0]; \
            _Pragma("unroll") for (int r = 1; r < 16; ++r) pmax = fmaxf(pmax, P0[r]); \
            _Pragma("unroll") for (int r = 0; r < 16; ++r) pmax = fmaxf(pmax, P1[r]); \
            { auto rr = __builtin_amdgcn_permlane32_swap(__float_as_uint(pmax), __float_as_uint(pmax), false, false); pmax = fmaxf(__uint_as_float(rr[0]), __uint_as_float(rr[1])); } \
            if (__builtin_expect(__all(pmax - m_reg <= THR / ATT_SCALE), 1)) { MN = m_reg; AL = 1.f; } \
            else { MN = fmaxf(m_reg, pmax); AL = __builtin_amdgcn_exp2f((m_reg - MN) * C); m_reg = MN; } \
            const float mnC = -MN * C; \
            _Pragma("unroll") for (int r = 0; r < 16; ++r) { P0[r] = fmaf(P0[r], C, mnC); P1[r] = fmaf(P1[r], C, mnC); } \
            _Pragma("unroll") for (int r = 0; r < 16; ++r) P0[r] = __builtin_amdgcn_exp2f(P0[r]); \
        } else { \
            const int dn = U.n0 + wid * 32 + r32 - (j) * 64 - 4 * hi; const float base = (float)dn * U.lgam; \
            _Pragma("unroll") for (int r = 0; r < 16; ++r) { const int kk = (r & 3) + 8 * (r >> 2); \
                const float f0 = __builtin_amdgcn_exp2f(base - (float)kk * U.lgam); P0[r] = (dn >= kk) ? P0[r] * f0 : 0.f; } \
        } } while (0)
#define F2_FINISH(P0, P1, j, AL) do { \
        if (MODE == 0) { \
            _Pragma("unroll") for (int r = 0; r < 16; ++r) P1[r] = __builtin_amdgcn_exp2f(P1[r]); \
            float ps = 0.f; \
            _Pragma("unroll") for (int r = 0; r < 16; ++r) ps += P0[r] + P1[r]; \
            { auto rr = __builtin_amdgcn_permlane32_swap(__float_as_uint(ps), __float_as_uint(ps), false, false); ps = __uint_as_float(rr[0]) + __uint_as_float(rr[1]); } \
            l_reg = l_reg * AL + ps; \
        } else { \
            const int dn = U.n0 + wid * 32 + r32 - (j) * 64 - 4 * hi; const float base = (float)dn * U.lgam; \
            _Pragma("unroll") for (int r = 0; r < 16; ++r) { const int kk = (r & 3) + 8 * (r >> 2); \
                const float f1 = __builtin_amdgcn_exp2f(base - (float)(kk + 32) * U.lgam); P1[r] = (dn >= kk + 32) ? P1[r] * f1 : 0.f; } \
        } \
        p_to_frag(P0, P1, pa0, pa1, pa2, pa3); } while (0)
#define F2_RESC(AL) do { if (MODE == 0) { if (__any((AL) < 1.f)) { if (hi == 0) al_l[r32] = (AL); asm volatile("s_waitcnt lgkmcnt(0)" ::: "memory"); \
        _Pragma("unroll") for (int r = 0; r < 16; ++r) { const float a_ = al_l[crow(r, hi)]; _Pragma("unroll") for (int d = 0; d < 4; ++d) o[d][r] *= a_; } } } } while (0)
#define F2_QKT(P0, P1, b) do { const LAS char* qb_ = Ql; asm volatile("" : "+v"(qb_)); qkt<MODE == 1>(P0, P1, K_lds + (b) * TILE_B, qr, qb_, r32, hi); } while (0)
#define PV1(vb_) do { const int v_ = (vb_); pv_one<0>(o[0], v_, pa0, pa1, pa2, pa3); pv_one<1>(o[1], v_, pa0, pa1, pa2, pa3); pv_one<2>(o[2], v_, pa0, pa1, pa2, pa3); pv_one<3>(o[3], v_, pa0, pa1, pa2, pa3); } while (0)
    f32x16 pA0, pA1, pB0, pB1; float mnA = 0.f, mnB = 0.f, alA = 1.f, alB = 1.f; bf16x8 pa0, pa1, pa2, pa3; const int NT = U.ntiles;
    (void)mnA; (void)mnB;
    F2_SLOAD(E, 0); F2_SWRITE(E, 0); __syncthreads();
#pragma unroll
    for (int d = 0; d < 4; ++d) o[d] = f32x16{};
    F2_QKT(pA0, pA1, 0); F2_PARTIAL(pA0, pA1, 0, 0, mnA, alA);
    F2_SLOAD(E, 64); if (2 < NT) F2_TOUCH(128); if (3 < NT) F2_TOUCH(192);
    F2_SWRITE(E, 1); __syncthreads();
#pragma unroll 1
    for (int j = 1; j + 1 < NT; j += 2) {
        FA_SBAR(); F2_QKT(pB0, pB1, 1);
        F2_FINISH(pA0, pA1, j - 1, alA); FA_SBAR();
        F2_SLOAD(E, (j + 1) * 64); if (j + 3 < NT) F2_TOUCH((j + 3) * 64); FA_SBAR();
        PV1(vb0); F2_PARTIAL(pB0, pB1, j, 1, mnB, alB);
        __syncthreads(); F2_SWRITE(E, 0); asm volatile("" :: "v"(pf_));
        F2_RESC(alB); __syncthreads();
        FA_SBAR(); F2_QKT(pA0, pA1, 0);
        F2_FINISH(pB0, pB1, j, alB); FA_SBAR();
        if (j + 2 < NT) F2_SLOAD(E, (j + 2) * 64); if (j + 4 < NT) F2_TOUCH((j + 4) * 64); FA_SBAR();
        PV1(vb0 + TILE_B); F2_PARTIAL(pA0, pA1, j + 1, 0, mnA, alA);
        __syncthreads(); if (j + 2 < NT) F2_SWRITE(E, 1); asm volatile("" :: "v"(pf_));
        F2_RESC(alA); __syncthreads();
    }
    FA_SBAR(); F2_QKT(pB0, pB1, 1);
    F2_FINISH(pA0, pA1, NT - 2, alA); FA_SBAR();
    PV1(vb0); F2_PARTIAL(pB0, pB1, NT - 1, 1, mnB, alB);
    __syncthreads(); F2_RESC(alB);
    F2_FINISH(pB0, pB1, NT - 1, alB); FA_SBAR();
    PV1(vb0 + TILE_B);
    asm volatile("s_waitcnt vmcnt(0)" ::: "memory");
    __syncthreads();
    l_out = l_reg;
#undef F2_SLOAD
#undef F2_SWRITE
#undef F2_PARTIAL
#undef F2_FINISH
#undef F2_RESC
#undef F2_QKT
#undef F2_TOUCH
#undef PV1
}
}

namespace pg8 {
struct EpiProj {
    static constexpr bool PERM = true, AFTER_DRAIN = false, HAS_MID = false;
    bf16_t* P; const float* rot;
    __device__ __forceinline__ void operator()(const f32x4 (&acc)[2][2][4][2], const Unit& u, int wr, int wc, int fr, int fq) const {
        const int row0 = u.pm * BM + wr * 64 + fr, colb = u.pn * BM + wc * 32 + 8 * fq;
        const bool rotq = (u.pn >= 7) && (u.pn < 15);
        const float ksc = (u.pn >= 11) ? K_SCALE : 1.0f;
        const int i0 = 16 * wc + 4 * fq;
#pragma unroll
        for (int ai = 0; ai < 2; ++ai)
#pragma unroll
            for (int m = 0; m < 4; ++m) {
                const int row = row0 + ai * HALF + m * 16; const int pos = row & (SEQL - 1);
                bf16_t* rowp = P + (size_t)row * NPROJ + colb;
                f32x4 r0 = (f32x4){1.f, 0.f, 1.f, 0.f}, r1 = r0;
                if (rotq) { const f32x4* rt = (const f32x4*)(rot + ((size_t)pos * 64 + i0) * 2); r0 = rt[0]; r1 = rt[1]; }
#pragma unroll
                for (int bj = 0; bj < 2; ++bj) {
                    f32x4 v0 = acc[ai][bj][m][0], v1 = acc[ai][bj][m][1];
                    if (rotq) {
                        f32x4 w0, w1;
                        w0[0] = (v0[0] * r0[0] - v0[1] * r0[1]) * ksc; w0[1] = (v0[0] * r0[1] + v0[1] * r0[0]) * ksc;
                        w0[2] = (v0[2] * r0[2] - v0[3] * r0[3]) * ksc; w0[3] = (v0[2] * r0[3] + v0[3] * r0[2]) * ksc;
                        w1[0] = (v1[0] * r1[0] - v1[1] * r1[1]) * ksc; w1[1] = (v1[0] * r1[1] + v1[1] * r1[0]) * ksc;
                        w1[2] = (v1[2] * r1[2] - v1[3] * r1[3]) * ksc; w1[3] = (v1[2] * r1[3] + v1[3] * r1[2]) * ksc;
                        v0 = w0; v1 = w1;
                    }
                    u32x4 w; w.x = pkbf(v0[0], v0[1]); w.y = pkbf(v0[2], v0[3]); w.z = pkbf(v1[0], v1[1]); w.w = pkbf(v1[2], v1[3]);
                    *(u32x4*)(rowp + bj * HALF) = w;
                }
            }
    }
};
struct EpiMergeF {
    static constexpr bool PERM = true, AFTER_DRAIN = false, HAS_MID = true;
    const bf16_t* P; bf16_t* O;
    static __device__ __forceinline__ float cl(float x) { return fminf(fmaxf(x, -30.f), 30.f); }
    static __device__ __forceinline__ float ratio(float a, float b) { return (1.0f + __expf(-cl(b))) * __builtin_amdgcn_rcpf(1.0f + __expf(-cl(a))); }
    __device__ __forceinline__ void mid(f32x4 (&acc)[2][2][4][2], const Unit& u, int wr, int wc, int fr, int fq) const {
        const int row0 = hide_i(u.pm * BM + wr * 64 + fr), colb = hide_i(u.pn * BM + wc * 32 + 8 * fq);
        __builtin_amdgcn_sched_barrier(0);
#pragma unroll
        for (int ai = 0; ai < 2; ++ai) {
            u32x4 g0[4][2], g1[4][2];
#pragma unroll
            for (int m = 0; m < 4; ++m)
#pragma unroll
                for (int bj = 0; bj < 2; ++bj) { const bf16_t* gp = P + (size_t)(row0 + ai * HALF + m * 16) * NPROJ + C_GBR + colb + bj * HALF; g0[m][bj] = *(const u32x4*)gp; g1[m][bj] = *(const u32x4*)(gp + DMODEL); }
            __builtin_amdgcn_sched_barrier(0);
#pragma unroll
            for (int m = 0; m < 4; ++m)
#pragma unroll
                for (int bj = 0; bj < 2; ++bj) {
                    const u32x4 a_ = g0[m][bj], b_ = g1[m][bj]; f32x4 r0, r1;
                    r0[0] = ratio(bflo(a_.x), bflo(b_.x)); r0[1] = ratio(bfhi(a_.x), bfhi(b_.x)); r0[2] = ratio(bflo(a_.y), bflo(b_.y)); r0[3] = ratio(bfhi(a_.y), bfhi(b_.y));
                    r1[0] = ratio(bflo(a_.z), bflo(b_.z)); r1[1] = ratio(bfhi(a_.z), bfhi(b_.z)); r1[2] = ratio(bflo(a_.w), bflo(b_.w)); r1[3] = ratio(bfhi(a_.w), bfhi(b_.w));
                    acc[ai][bj][m][0] = acc[ai][bj][m][0] * r0; acc[ai][bj][m][1] = acc[ai][bj][m][1] * r1;
                }
            __builtin_amdgcn_sched_barrier(0);
        }
    }
    __device__ __forceinline__ void operator()(const f32x4 (&acc)[2][2][4][2], const Unit& u, int wr, int wc, int fr, int fq) const {
        const int row0 = u.pm * BM + wr * 64 + fr, colb = u.pn * BM + wc * 32 + 8 * fq;
#pragma unroll
        for (int ai = 0; ai < 2; ++ai) {
            u32x4 gg[4][2];
#pragma unroll
            for (int m = 0; m < 4; ++m)
#pragma unroll
                for (int bj = 0; bj < 2; ++bj) gg[m][bj] = *(const u32x4*)(P + (size_t)(row0 + ai * HALF + m * 16) * NPROJ + C_GBR + DMODEL + colb + bj * HALF);
            __builtin_amdgcn_sched_barrier(0);
#pragma unroll
            for (int m = 0; m < 4; ++m) {
                const int row = row0 + ai * HALF + m * 16;
#pragma unroll
                for (int bj = 0; bj < 2; ++bj) {
                    const int col = colb + bj * HALF;
                    const u32x4 g = gg[m][bj];
                    const f32x4 v0 = acc[ai][bj][m][0], v1 = acc[ai][bj][m][1];
                    float o[8];
                    o[0] = sigmoidf_(cl(bflo(g.x))) * v0[0]; o[1] = sigmoidf_(cl(bfhi(g.x))) * v0[1]; o[2] = sigmoidf_(cl(bflo(g.y))) * v0[2]; o[3] = sigmoidf_(cl(bfhi(g.y))) * v0[3];
                    o[4] = sigmoidf_(cl(bflo(g.z))) * v1[0]; o[5] = sigmoidf_(cl(bfhi(g.z))) * v1[1]; o[6] = sigmoidf_(cl(bflo(g.w))) * v1[2]; o[7] = sigmoidf_(cl(bfhi(g.w))) * v1[3];
                    u32x4 w; w.x = pkbf(o[0], o[1]); w.y = pkbf(o[2], o[3]); w.z = pkbf(o[4], o[5]); w.w = pkbf(o[6], o[7]);
                    *(u32x4*)(O + (size_t)row * DMODEL + col) = w;
                }
            }
        }
    }
};
struct EpiRes {
    static constexpr bool PERM = false, AFTER_DRAIN = false, HAS_MID = false;
    const float* X; float* O;
    __device__ __forceinline__ void operator()(const f32x4 (&acc)[2][2][4][2], const Unit& u, int wr, int wc, int fr, int fq) const {
        const int row0 = u.pm * BM + wr * 64 + fr, col0 = u.pn * BM + wc * 32 + 4 * fq;
#pragma unroll
        for (int ai = 0; ai < 2; ++ai) {
            f32x4 xv[4][2][2];
#pragma unroll
            for (int m = 0; m < 4; ++m) { const size_t off = (size_t)(row0 + ai * HALF + m * 16) * DMODEL + col0;
#pragma unroll
                for (int bj = 0; bj < 2; ++bj)
#pragma unroll
                    for (int n = 0; n < 2; ++n) xv[m][bj][n] = *(const f32x4*)(X + off + bj * HALF + n * 16); }
            __builtin_amdgcn_sched_barrier(0);
#pragma unroll
            for (int m = 0; m < 4; ++m) { const size_t off = (size_t)(row0 + ai * HALF + m * 16) * DMODEL + col0;
#pragma unroll
                for (int bj = 0; bj < 2; ++bj)
#pragma unroll
                    for (int n = 0; n < 2; ++n) *(f32x4*)(O + off + bj * HALF + n * 16) = xv[m][bj][n] + acc[ai][bj][m][n]; }
            __builtin_amdgcn_sched_barrier(0);
        }
    }
};
struct EpiNull {
    static constexpr bool PERM = true, AFTER_DRAIN = false, HAS_MID = false;
    float* O;
    __device__ __forceinline__ void operator()(const f32x4 (&acc)[2][2][4][2], const Unit& u, int wr, int wc, int fr, int fq) const {
        f32x4 t = (f32x4){0.f, 0.f, 0.f, 0.f};
#pragma unroll
        for (int ai = 0; ai < 2; ++ai)
#pragma unroll
            for (int bj = 0; bj < 2; ++bj)
#pragma unroll
                for (int m = 0; m < 4; ++m) { t += acc[ai][bj][m][0]; t += acc[ai][bj][m][1]; }
        O[(size_t)(u.pm * 8 + u.pn) * 512 + (wr * 4 + wc) * 64 + fr + 16 * fq] = (t[0] + t[1]) + (t[2] + t[3]);
    }
};
struct EpiSwiglu {
    static constexpr bool PERM = true, AFTER_DRAIN = false, HAS_MID = false;
    bf16_t* H; const float* rs;
    __device__ __forceinline__ void operator()(const f32x4 (&acc)[2][2][4][2], const Unit& u, int wr, int wc, int fr, int fq) const {
        const int row0 = u.pm * BM + wr * 64 + fr, col = u.pn * HALF + wc * 32 + 8 * fq;
#pragma unroll
        for (int ai = 0; ai < 2; ++ai)
#pragma unroll
            for (int m = 0; m < 4; ++m) {
                const int row = row0 + ai * HALF + m * 16; const float r_ = rs[row];
                const f32x4 g0 = acc[ai][0][m][0] * r_, g1 = acc[ai][0][m][1] * r_, u0 = acc[ai][1][m][0] * r_, u1 = acc[ai][1][m][1] * r_;
                u32x4 w; w.x = pkbf(siluf_(g0[0]) * u0[0], siluf_(g0[1]) * u0[1]); w.y = pkbf(siluf_(g0[2]) * u0[2], siluf_(g0[3]) * u0[3]);
                w.z = pkbf(siluf_(g1[0]) * u1[0], siluf_(g1[1]) * u1[1]); w.w = pkbf(siluf_(g1[2]) * u1[2], siluf_(g1[3]) * u1[3]);
                *(u32x4*)(H + (size_t)row * 1024 + col) = w;
            }
    }
};
struct EpiDown {
    static constexpr bool PERM = true, AFTER_DRAIN = false, HAS_MID = false;
    bf16_t* Y; const float* rg;
    __device__ __forceinline__ void operator()(const f32x4 (&acc)[2][2][4][2], const Unit& u, int wr, int wc, int fr, int fq) const {
        const int row0 = u.pm * BM + wr * 64 + fr, colb = u.pn * BM + wc * 32 + 8 * fq;
#pragma unroll
        for (int ai = 0; ai < 2; ++ai)
#pragma unroll
            for (int m = 0; m < 4; ++m) {
                const int row = row0 + ai * HALF + m * 16; const float gt = rg[row];
#pragma unroll
                for (int bj = 0; bj < 2; ++bj) {
                    const f32x4 v0 = acc[ai][bj][m][0] * gt, v1 = acc[ai][bj][m][1] * gt;
                    u32x4 w; w.x = pkbf(v0[0], v0[1]); w.y = pkbf(v0[2], v0[3]); w.z = pkbf(v1[0], v1[1]); w.w = pkbf(v1[2], v1[3]);
                    *(u32x4*)(Y + (size_t)row * DMODEL + colb + bj * HALF) = w;
                }
            }
    }
};
template <bool GATHER_> struct ExpertOrderT {
    static constexpr bool GATHER = GATHER_;
    const LAS int* ts; int G, c; const int* rtok;
    __device__ __forceinline__ unsigned rowoff(int slot) const { return GATHER_ ? (unsigned)rtok[slot] : 0u; }
    __device__ __forceinline__ bool next(int i, Unit& u) const {
        const int L = i * G + c; const int total = ts[32] * 8; if (L >= total) return false;
        const int gt = L >> 3; u.pm = gt; u.pn = L & 7; int e = 0;
        for (int k = 1; k < 32; ++k) e += (gt >= ts[k]) ? 1 : 0;
        u.e = e; return true;
    }
    __device__ __forceinline__ void a_ready(const Unit&) const {}
    __device__ __forceinline__ void done(const Unit&) const {}
};
}

struct MapId { __device__ __forceinline__ int operator()(int n) const { return n; } };
struct MapGate { __device__ __forceinline__ int operator()(int f) const { return ((f >> 7) << 8) + (f & 127); } };
struct MapUp { __device__ __forceinline__ int operator()(int f) const { return ((f >> 7) << 8) + 128 + (f & 127); } };
struct MapProj {
    __device__ __forceinline__ int operator()(int n) const {
        if (n < 1736) return n;
        if (n < 2760) { const int l = n - 1736, d = l & 127; return C_QR + (l & ~127) + ((d & 63) << 1) + (d >> 6); }
        if (n < 3784) { const int l = n - 2760, d = l & 127; return C_KR + (l & ~127) + ((d & 63) << 1) + (d >> 6); }
        if (n < 4808) return C_VR + (n - 3784);
        if (n < 5832) return C_GR + (n - 4808);
        return C_GBR + (n - 5832);
    }
};
template <class RowMap>
__device__ __forceinline__ void tr_item(const float* __restrict__ src, int N, bf16_t* __restrict__ dst, int ldd, int kb, int nb, int lane, RowMap rm) {
    const int kc = lane >> 3, nc = lane & 7;
    const int n = nb * 32 + nc * 4, k0 = kb * 64 + kc * 8;
    if (n < N) {
        f32x4 v[8];
#pragma unroll
        for (int i = 0; i < 8; ++i) v[i] = *(const f32x4*)(src + (size_t)(k0 + i) * N + n);
#pragma unroll
        for (int j = 0; j < 4; ++j) {
            u32x4 o; o.x = pkbf(v[0][j], v[1][j]); o.y = pkbf(v[2][j], v[3][j]); o.z = pkbf(v[4][j], v[5][j]); o.w = pkbf(v[6][j], v[7][j]);
            *(u32x4*)(dst + (size_t)rm(n + j) * ldd + k0) = o;
        }
    }
}
template <class RowMap>
__device__ __forceinline__ void tr_item2(const float* __restrict__ src, int N, bf16_t* __restrict__ dst, int ldd, int kb, int nb, int lane, RowMap rm) {
    const int kc = lane >> 3, nc = lane & 7;
    const int n = nb * 32 + nc * 4, k0 = kb * 64 + kc * 8;
    f32x4 va[8], vb[8];
#pragma unroll
    for (int i = 0; i < 8; ++i) { va[i] = *(const f32x4*)(src + (size_t)(k0 + i) * N + n); vb[i] = *(const f32x4*)(src + (size_t)(k0 + i) * N + n + 32); }
#pragma unroll
    for (int j = 0; j < 4; ++j) {
        u32x4 o; o.x = pkbf(va[0][j], va[1][j]); o.y = pkbf(va[2][j], va[3][j]); o.z = pkbf(va[4][j], va[5][j]); o.w = pkbf(va[6][j], va[7][j]);
        *(u32x4*)(dst + (size_t)rm(n + j) * ldd + k0) = o;
    }
#pragma unroll
    for (int j = 0; j < 4; ++j) {
        u32x4 o; o.x = pkbf(vb[0][j], vb[1][j]); o.y = pkbf(vb[2][j], vb[3][j]); o.z = pkbf(vb[4][j], vb[5][j]); o.w = pkbf(vb[6][j], vb[7][j]);
        *(u32x4*)(dst + (size_t)rm(n + 32 + j) * ldd + k0) = o;
    }
}
template <class RowMap>
__device__ __forceinline__ void tr_item4(const float* __restrict__ src, int N, bf16_t* __restrict__ dst, int ldd, int kb, int nb, int lane, RowMap rm) {
    const int kc = lane >> 3, nc = lane & 7;
    const int n = nb * 32 + nc * 4, k0 = kb * 64 + kc * 8;
    f32x4 v[4][8];
#pragma unroll
    for (int i = 0; i < 8; ++i)
#pragma unroll
        for (int u = 0; u < 4; ++u) v[u][i] = *(const f32x4*)(src + (size_t)(k0 + i) * N + n + 32 * u);
#pragma unroll
    for (int u = 0; u < 4; ++u)
#pragma unroll
        for (int j = 0; j < 4; ++j) {
            u32x4 o; o.x = pkbf(v[u][0][j], v[u][1][j]); o.y = pkbf(v[u][2][j], v[u][3][j]); o.z = pkbf(v[u][4][j], v[u][5][j]); o.w = pkbf(v[u][6][j], v[u][7][j]);
            *(u32x4*)(dst + (size_t)rm(n + 32 * u + j) * ldd + k0) = o;
        }
}
constexpr int EXP_ITEMS = 3 * 32 * 1024;
__device__ __forceinline__ void convert_experts(const float* w_eg, const float* w_eu, const float* w_ed, bf16_t* WGU, bf16_t* WD, unsigned* qctr, int lane) {
    int nxt = 0; if (lane == 0) nxt = (int)atomicAdd(qctr, 8u);
    for (;;) {
        const int it = __builtin_amdgcn_readfirstlane(nxt);
        if (it >= EXP_ITEMS) break;
        if (lane == 0) nxt = (int)atomicAdd(qctr, 8u);
        const int kind = it >> 15, r = it & 32767, e = r >> 10, q = r & 1023;
        if (kind == 0) { const float* src = w_eg + (size_t)e * 2048 * 1024; bf16_t* dst = WGU + (size_t)e * 2048 * 2048;
#pragma unroll 1
            for (int u = 0; u < 8; u += 4) tr_item4(src, 1024, dst, 2048, q >> 5, (q & 31) + u, lane, MapGate{}); }
        else if (kind == 1) { const float* src = w_eu + (size_t)e * 2048 * 1024; bf16_t* dst = WGU + (size_t)e * 2048 * 2048;
#pragma unroll 1
            for (int u = 0; u < 8; u += 4) tr_item4(src, 1024, dst, 2048, q >> 5, (q & 31) + u, lane, MapUp{}); }
        else { const float* src = w_ed + (size_t)e * 1024 * 2048; bf16_t* dst = WD + (size_t)e * 2048 * 1024;
#pragma unroll 1
            for (int u = 0; u < 8; u += 4) tr_item4(src, 2048, dst, 1024, q >> 6, (q & 63) + u, lane, MapId{}); }
    }
}
__device__ __forceinline__ void sincos_d(double a, double& s, double& c) {
    const double TWO_PI = 6.283185307179586476925, HALF_PI = 1.5707963267948966192313;
    double k = rint(a / HALF_PI); double r = a - k * HALF_PI;
    r -= k * 6.123233995736766e-17;
    const int q = ((int)k) & 3; const double r2 = r * r;
    double sp = r2 * (-1.0 / 1307674368000.0);
    sp = r2 * (sp + 1.0 / 6227020800.0); sp = r2 * (sp - 1.0 / 39916800.0); sp = r2 * (sp + 1.0 / 362880.0); sp = r2 * (sp - 1.0 / 5040.0); sp = r2 * (sp + 1.0 / 120.0); sp = r2 * (sp - 1.0 / 6.0);
    const double sr = r + r * sp;
    double cp = r2 * (1.0 / 20922789888000.0);
    cp = r2 * (cp - 1.0 / 87178291200.0); cp = r2 * (cp + 1.0 / 479001600.0); cp = r2 * (cp - 1.0 / 3628800.0); cp = r2 * (cp + 1.0 / 40320.0); cp = r2 * (cp - 1.0 / 720.0); cp = r2 * (cp + 1.0 / 24.0); cp = r2 * (cp - 0.5);
    const double cr = 1.0 + cp;
    s = (q == 0) ? sr : (q == 1) ? cr : (q == 2) ? -sr : -cr;
    c = (q == 0) ? cr : (q == 1) ? -sr : (q == 2) ? -cr : sr;
    (void)TWO_PI;
}

struct Params { const float* in[17]; float* out; unsigned char* ws; };

#ifndef PROF_PHASE
#define PROF_PHASE -1
#endif
#ifndef PROF_SCALE
#define PROF_SCALE 4e-6f
#endif
#define STAMP(i) do { if (PROF_PHASE >= 0 && bx == 0 && wave_id == 0) ((unsigned*)(p.ws + WS_CTL))[6000 + (i)] = (unsigned)__builtin_amdgcn_s_memrealtime(); } while (0)
#define GSYNC() grid.sync()
#define XBAR() do { const int l__ = (int)__builtin_amdgcn_mbcnt_hi(~0u, __builtin_amdgcn_mbcnt_lo(~0u, (unsigned)hide_i(0))); xcd_barrier(xbar, wave_id * 64 + l__); } while (0)
constexpr int CTL_BAR_WORD = 8192;
constexpr int CTL_QCTR = 2048;
#ifndef NGEMM_P1
#define NGEMM_P1 208
#endif

__global__ void __launch_bounds__(512, 2) mega_fwd(Params p) {
    extern __shared__ __attribute__((aligned(16))) unsigned char lds_raw[];
    LAS unsigned char* lds = (LAS unsigned char*)lds_raw;
    cg::grid_group grid = cg::this_grid();
    const int G = gridDim.x, bx = blockIdx.x;
    const int wave_id = __builtin_amdgcn_readfirstlane((int)threadIdx.x >> 6);
    const int NGW = G * 8, NGT = G * 512;
    XcdBarrier xbar;
    {
        const int l0 = (int)__builtin_amdgcn_mbcnt_hi(~0u, __builtin_amdgcn_mbcnt_lo(~0u, (unsigned)hide_i(0)));
        volatile LAS unsigned* st = (volatile LAS unsigned*)(lds + LDS_MISC + 256);
        if (wave_id == 0 && l0 < 2) st[l0] = 0u;
        __syncthreads();
        xbar.bar = (unsigned*)(p.ws + WS_CTL) + CTL_BAR_WORD; xbar.x = xb_xcc_id(); xbar.st = st;
        if (wave_id == 0 && l0 == 0) (void)xb_add(&xbar.bar[XB_XCNT(xbar.x)], 1u);
    }
#define PH_LOCALS \
    const int lane = (int)__builtin_amdgcn_mbcnt_hi(~0u, __builtin_amdgcn_mbcnt_lo(~0u, (unsigned)hide_i(0))), wave = wave_id, tid = wave * 64 + lane; (void)tid; \
    const int gw = bx * 8 + wave, gtid = bx * 512 + tid; (void)gw; (void)gtid; (void)lane; \
    unsigned char* ws = hide_p(p.ws); float* out = hide_p(p.out); (void)out; \
    unsigned* ctl = (unsigned*)(ws + WS_CTL); float* rot = (float*)(ws + WS_ROT); (void)ctl; (void)rot; \
    bf16_t* WIN = (bf16_t*)(ws + WS_WIN); bf16_t* WCOMB = (bf16_t*)(ws + WS_WCOMB); bf16_t* WB = (bf16_t*)(ws + WS_WB); bf16_t* WO = (bf16_t*)(ws + WS_WO); (void)WIN; (void)WCOMB; (void)WB; (void)WO; \
    bf16_t* WGU = (bf16_t*)(ws + WS_WGU); bf16_t* WD = (bf16_t*)(ws + WS_WD); (void)WGU; (void)WD; \
    bf16_t* P = (bf16_t*)(ws + WS_P); bf16_t* HMID = (bf16_t*)(ws + WS_HMID); bf16_t* Y = (bf16_t*)(ws + WS_Y); (void)P; (void)HMID; (void)Y; \
    bf16_t* XN = (bf16_t*)(ws + WS_XN); bf16_t* BA = XN; bf16_t* TN = XN; (void)BA; (void)TN; \
    bf16_t* OA = (bf16_t*)(ws + WS_OA); bf16_t* OB = OA + 1024;            bf16_t* MIXED = (bf16_t*)(ws + WS_MIXED); bf16_t* XG = (bf16_t*)(ws + WS_XG); (void)OA; (void)OB; (void)MIXED; (void)XG; \
    bf16_t* KV = (bf16_t*)(ws + WS_KV); u64* MASK = (u64*)(ws + WS_MASK); (void)KV; (void)MASK; \
    int* misc = (int*)(ws + WS_MISC); \
    int* row_tok = misc + MI_ROWTOK; float* row_gate = (float*)(misc + MI_ROWGATE); int* tok_slot = misc + MI_TOKSLOT; (void)row_tok; (void)row_gate; (void)tok_slot; \
    int* asg_e = misc + MI_ASGE; int* asg_r = misc + MI_ASGR; float* asg_g = (float*)(misc + MI_ASGG); (void)asg_e; (void)asg_r; (void)asg_g;
#define IN(k) hide_p(p.in[k])

    STAMP(0);
    {
        PH_LOCALS
        const float* x = IN(0); const float* g_mix = IN(1); const float* w_in = IN(2); const float* w_uv = IN(4); const float* w_branch = IN(6); const float* w_out = IN(7);
        constexpr int NB_WIN = 311;
        constexpr int I_WIN = 32 * NB_WIN, I_WB = 16 * 64, I_WO = 32 * 64;
        constexpr int I_TOTAL = I_WIN + I_WB + I_WO;
#pragma unroll 1
        for (int pass = 0; pass < 4; ++pass) {
        const int job = (pass + wave) & 3;
        if (job == 0) {
        for (int it = gw; it < I_TOTAL; it += NGW) {
            int r = it;
            if (r < I_WIN) { tr_item(w_in, 9928, WIN, 2048, r / NB_WIN, r % NB_WIN, lane, MapProj{}); continue; } r -= I_WIN;
            if (r < I_WB) { tr_item(w_branch + (size_t)1024 * 2048, 2048, WCOMB + 1024, 2048, r >> 6, r & 63, lane, MapId{});   continue; } r -= I_WB;
            tr_item(w_out, 2048, WO, 2048, r >> 6, r & 63, lane, MapId{});
        }
        for (int i = gtid; i < 56 * 256; i += NGT) ((u32x4*)(WIN + (size_t)1736 * 2048))[i] = (u32x4){0u, 0u, 0u, 0u};
        } else if (job == 1) {
        for (int it = gw; it < 2048; it += NGW) {
            const int h = it >> 8, ch = (it >> 7) & 1, n0 = (it & 127) * 16, c = ch * 64 + lane;
            const float* wuv = w_uv + ((size_t)h * 128 + c) * 128;
            const float* wa = w_branch + (size_t)(h * 128) * 2048 + n0;
            float a[16];
#pragma unroll
            for (int j = 0; j < 16; ++j) a[j] = 0.f;
#pragma unroll 4
            for (int d4 = 0; d4 < 32; ++d4) {
                const f32x4 wv = *(const f32x4*)(wuv + d4 * 4);
#pragma unroll
                for (int dd = 0; dd < 4; ++dd) {
                    const float* wr_ = wa + (size_t)(d4 * 4 + dd) * 2048;
#pragma unroll
                    for (int j4 = 0; j4 < 4; ++j4) { const f32x4 b = *(const f32x4*)(wr_ + j4 * 4); a[j4 * 4 + 0] += wv[dd] * b[0]; a[j4 * 4 + 1] += wv[dd] * b[1]; a[j4 * 4 + 2] += wv[dd] * b[2]; a[j4 * 4 + 3] += wv[dd] * b[3]; }
                }
            }
#pragma unroll
            for (int j = 0; j < 16; ++j) WCOMB[(size_t)(n0 + j) * 2048 + h * 128 + c] = (bf16_t)(pkbf(a[j], 0.f) & 0xffffu);
        }
        } else if (job == 2) {
        for (int m = gw; m < T_TOK; m += 2 * NGW) {
            const int m1 = (m + NGW < T_TOK) ? m + NGW : m;
            const f32x4* xr0 = (const f32x4*)(x + (size_t)m * DMODEL) + lane; const f32x4* xr1 = (const f32x4*)(x + (size_t)m1 * DMODEL) + lane;
            f32x4 v0[8], v1[8]; float s0 = 0.f, s1 = 0.f;
#pragma unroll
            for (int j = 0; j < 8; ++j) { v0[j] = xr0[64 * j]; v1[j] = xr1[64 * j]; }
#pragma unroll
            for (int j = 0; j < 8; ++j) { s0 += (v0[j][0] * v0[j][0] + v0[j][1] * v0[j][1]) + (v0[j][2] * v0[j][2] + v0[j][3] * v0[j][3]); s1 += (v1[j][0] * v1[j][0] + v1[j][1] * v1[j][1]) + (v1[j][2] * v1[j][2] + v1[j][3] * v1[j][3]); }
            const float r0 = 1.0f / sqrtf(wave_sum(s0, lane) * (1.0f / DMODEL) + EPS_F), r1 = 1.0f / sqrtf(wave_sum(s1, lane) * (1.0f / DMODEL) + EPS_F);
            u32x2* o0 = (u32x2*)(XN + (size_t)m * DMODEL) + lane; u32x2* o1 = (u32x2*)(XN + (size_t)m1 * DMODEL) + lane;
#pragma unroll
            for (int j = 0; j < 8; ++j) { const f32x4 gg = ((const f32x4*)g_mix)[lane + 64 * j];
                u32x2 w; w.x = pkbf(v0[j][0] * r0 * gg[0], v0[j][1] * r0 * gg[1]); w.y = pkbf(v0[j][2] * r0 * gg[2], v0[j][3] * r0 * gg[3]); o0[64 * j] = w;
                u32x2 w2; w2.x = pkbf(v1[j][0] * r1 * gg[0], v1[j][1] * r1 * gg[1]); w2.y = pkbf(v1[j][2] * r1 * gg[2], v1[j][3] * r1 * gg[3]); o1[64 * j] = w2; }
        }
        } else {
        for (int idx = gtid; idx < SEQL * 64; idx += NGT) {
            const int pos = idx >> 6, i = idx & 63; double f = 1.0;
            for (int k = 0; k < i; ++k) f *= 0.8659643233600653;
            double s, c; sincos_d((double)pos * f, s, c);
            rot[2 * idx] = (float)c; rot[2 * idx + 1] = (float)s;
        }
        { const float* g_ffn = IN(8); const float* w_rg = IN(9); const float* w_re = IN(11); float* WC = (float*)(ws + WS_WC);
          for (int idx = gtid; idx < 256 * 48 * 8; idx += NGT) { const int j = idx & 7, c = (idx >> 3) % 48, k = (idx / 384) * 8 + j;
              const float wv = (c < 4) ? w_rg[k * 4 + c] : (c < 36) ? w_re[k * 32 + (c - 4)] : 0.f; WC[idx] = wv * g_ffn[k]; } }
        }
        }
        for (int i = gtid; i < 32; i += NGT) ctl[64 * i] = 0u;
        if (gtid < 2) ctl[4096 + gtid] = 0u;
        for (int i = gtid; i < MAXSLOT; i += NGT) { row_tok[i] = 0; row_gate[i] = 0.f; ((float*)(ws + WS_WC + 524288))[i] = 0.f; }
    }
    if (__builtin_expect(p.out == nullptr, 0)) GSYNC();
    XBAR();
    STAMP(1);

    {
        PH_LOCALS
        const float* w_eg = IN(13); const float* w_eu = IN(14); const float* w_ed = IN(15);
        const int NGEMM = (G == 256) ? NGEMM_P1 : G;
        if (bx < NGEMM) {
            pg8::Gemm g{XN, WIN, T_TOK, NPROJ, 2048}; pg8::StaticOrder S; S.init(T_TOK, NPROJ, NGEMM, bx);
            pg8::EpiProj E{P, rot};
            pg8::gemm_phase<pg8::EpiProj, pg8::StaticOrder, true, true>(lds, g, S, E, tid);
        }
        convert_experts(w_eg, w_eu, w_ed, WGU, WD, ctl + CTL_QCTR, lane);
    }
    XBAR();
    STAMP(2);

    {
        PH_LOCALS
        const float* g_kv = IN(3);
        for (int t = gw; t < T_TOK; t += NGW) {
            const unsigned v = *(const unsigned*)(P + (size_t)t * NPROJ + C_CKV + 2 * lane);
            const float a = bflo(v), b = bfhi(v);
            const float rstd = 1.0f / sqrtf(wave_sum(a * a + b * b, lane) * (1.0f / 128.0f) + EPS_F);
            *(unsigned*)(KV + (size_t)t * 128 + 2 * lane) = pkbf(a * rstd * g_kv[2 * lane], b * rstd * g_kv[2 * lane + 1]);
        }
#if DBG_CMP == 3
        {
        u64* MASKX = (u64*)(ws + WS_SPARE);
        LAS float* qi = (LAS float*)(lds + wave * 10240); LAS float* sc = qi + 512;
        for (int t = gw; t < T_TOK; t += NGW) {
            const int b = t >> 11, q = t & 2047, ng = (q >> 6) + 1;
            { const u32x4 v = *(const u32x4*)(P + (size_t)t * NPROJ + C_QIDX + lane * 8);
              f32x4 lo4 = (f32x4){bflo(v.x), bfhi(v.x), bflo(v.y), bfhi(v.y)}, hi4 = (f32x4){bflo(v.z), bfhi(v.z), bflo(v.w), bfhi(v.w)};
              *(LAS f32x4*)(qi + lane * 8) = lo4; *(LAS f32x4*)(qi + lane * 8 + 4) = hi4; }
            float w[8];
            { const u32x4 v = *(const u32x4*)(P + (size_t)t * NPROJ + C_WIDX); w[0] = bflo(v.x); w[1] = bfhi(v.x); w[2] = bflo(v.y); w[3] = bfhi(v.y); w[4] = bflo(v.z); w[5] = bfhi(v.z); w[6] = bflo(v.w); w[7] = bfhi(v.w); }
            for (int g = 0; g < ng; ++g) {
                LAS float* qg = qi; asm volatile("" : "+v"(qg));
                const int s = g * 64 + lane; const u32x4* kr = (const u32x4*)(P + (size_t)(b * SEQL + s) * NPROJ + C_KIDX);
                float dot[8];
#pragma unroll
                for (int h = 0; h < 8; ++h) dot[h] = 0.f;
#pragma unroll
                for (int c = 0; c < 8; ++c) {
                    const u32x4 v = kr[c];
                    const f32x4 ka = (f32x4){bflo(v.x), bfhi(v.x), bflo(v.y), bfhi(v.y)}, kb = (f32x4){bflo(v.z), bfhi(v.z), bflo(v.w), bfhi(v.w)};
#pragma unroll
                    for (int h = 0; h < 8; ++h) {
                        const f32x4 qa = *(const LAS f32x4*)(qg + h * 64 + c * 8), qb = *(const LAS f32x4*)(qg + h * 64 + c * 8 + 4);
                        dot[h] += (qa[0] * ka[0] + qa[1] * ka[1]) + (qa[2] * ka[2] + qa[3] * ka[3]) + (qb[0] * kb[0] + qb[1] * kb[1]) + (qb[2] * kb[2] + qb[3] * kb[3]);
                    }
                }
                float score = 0.f;
#pragma unroll
                for (int h = 0; h < 8; ++h) score += w[h] * fmaxf(dot[h], 0.f);
                sc[s] = score * IDX_SCALE;
            }
            u64* mrow = MASKX + (size_t)t * 32;
            if (ng <= 4) { if (lane < 32) mrow[lane] = (lane < ng) ? ~0ull : 0ull; }
            else {
                unsigned lo = 0u;
                for (int bit = 31; bit >= 0; --bit) {
                    const unsigned cand = lo | (1u << bit); int cnt = 0;
                    for (int g = 0; g < ng; ++g) cnt += __popcll(__ballot(fkey(sc[g * 64 + lane]) >= cand));
                    if (cnt >= 256) lo = cand;
                }
                const unsigned tau = lo; int cgt = 0;
                for (int g = 0; g < ng; ++g) cgt += __popcll(__ballot(fkey(sc[g * 64 + lane]) > tau));
                const int need = 256 - cgt; int run = 0;
                for (int g = 0; g < ng; ++g) {
                    const unsigned key = fkey(sc[g * 64 + lane]);
                    const u64 gt = __ballot(key > tau), eq = __ballot(key == tau);
                    const u64 below = eq & ((1ull << lane) - 1ull);
                    const bool sel = (key == tau) && (run + (int)__popcll(below) < need);
                    const u64 word = gt | __ballot(sel);
                    run += (int)__popcll(eq);
                    if (lane == 0) mrow[g] = word;
                }
                if (lane >= ng && lane < 32) mrow[lane] = 0ull;
            }
        }
        }
        __syncthreads();
#endif
        typedef short bf16x8_t __attribute__((ext_vector_type(8)));
        constexpr int SCS = 2052;
        LAS float* scl = (LAS float*)lds;
        LAS unsigned* hist = (LAS unsigned*)(lds + 16 * SCS * 4);
        LAS unsigned* candl = hist + 16 * 256 + wave * 64;
        for (int i = tid; i < 16 * 256; i += 512) hist[i] = 0u;
        __syncthreads();
        for (int ui = 0; ui < 4; ++ui) {
            const int uu = ui * 256 + ((ui & 1) ? 255 - bx : bx);
            if (uu >= 1024 || bx >= 256) break;
            const int b = uu & 7, qblk = uu >> 3, q0 = qblk * 16, t0 = b * SEQL + q0, ng = (q0 >> 6) + 1, N = ng * 64;
            if (ng <= 4) {
                for (int qq = 0; qq < 2; ++qq) { u64* mrow = MASK + (size_t)(t0 + 2 * wave + qq) * 32; if (lane < 32) mrow[lane] = (lane < ng) ? ~0ull : 0ull; }
                continue;
            }
            const int qrow = lane & 15, kg = lane >> 4;
            bf16x8_t qf[8][2]; float w[8];
            { const bf16_t* qp = P + (size_t)(t0 + qrow) * NPROJ + C_QIDX + 8 * kg;
#pragma unroll
              for (int h = 0; h < 8; ++h) { qf[h][0] = *(const bf16x8_t*)(qp + h * 64); qf[h][1] = *(const bf16x8_t*)(qp + h * 64 + 32); }
              const u32x4 v = *(const u32x4*)(P + (size_t)(t0 + qrow) * NPROJ + C_WIDX); w[0] = bflo(v.x); w[1] = bfhi(v.x); w[2] = bflo(v.y); w[3] = bfhi(v.y); w[4] = bflo(v.z); w[5] = bfhi(v.z); w[6] = bflo(v.w); w[7] = bfhi(v.w); }
            for (int kt = wave; kt < N / 16; kt += 8) {
                const int s0 = kt * 16;
                const bf16_t* kp = P + (size_t)(b * SEQL + s0 + qrow) * NPROJ + C_KIDX + 8 * kg;
                const bf16x8_t a0 = *(const bf16x8_t*)kp, a1 = *(const bf16x8_t*)(kp + 32);
                f32x4 sacc = (f32x4){0.f, 0.f, 0.f, 0.f};
#pragma unroll
                for (int h = 0; h < 8; ++h) {
                    f32x4 acc = (f32x4){0.f, 0.f, 0.f, 0.f};
                    acc = __builtin_amdgcn_mfma_f32_16x16x32_bf16(a0, qf[h][0], acc, 0, 0, 0);
                    acc = __builtin_amdgcn_mfma_f32_16x16x32_bf16(a1, qf[h][1], acc, 0, 0, 0);
                    sacc[0] += w[h] * fmaxf(acc[0], 0.f); sacc[1] += w[h] * fmaxf(acc[1], 0.f); sacc[2] += w[h] * fmaxf(acc[2], 0.f); sacc[3] += w[h] * fmaxf(acc[3], 0.f);
                }
                sacc = sacc * IDX_SCALE + 0.0f;
                *(LAS f32x4*)(scl + qrow * SCS + s0 + 4 * kg) = sacc;
#pragma unroll
                for (int i = 0; i < 4; ++i) __hip_atomic_fetch_add(hist + qrow * 256 + sbin(sacc[i]), 1u, __ATOMIC_RELAXED, __HIP_MEMORY_SCOPE_WORKGROUP);
            }
            __syncthreads();
#pragma unroll 1
            for (int qq = 0; qq < 2; ++qq) {
                const int q = 2 * wave + qq; const LAS float* row = scl + q * SCS; LAS unsigned* hq = hist + q * 256;
                unsigned key[32];
#pragma unroll
                for (int j = 0; j < 32; ++j) key[j] = (j < ng) ? fkey(row[64 * j + lane]) : 0u;
                const u32x4 hv = *(const LAS u32x4*)(hq + 4 * lane);
                *(LAS u32x4*)(hq + 4 * lane) = (u32x4){0u, 0u, 0u, 0u};
                const int tsum = (int)(hv.x + hv.y + hv.z + hv.w); int incl = tsum;
#pragma unroll
                for (int off = 1; off < 64; off <<= 1) { const int o = __builtin_amdgcn_ds_bpermute(((lane + off) & 63) << 2, incl); incl += (lane + off < 64) ? o : 0; }
                const int suf = incl - tsum;
                int bt_l, ab_l;
                if (suf + (int)hv.w >= 256) { bt_l = 4 * lane + 3; ab_l = suf; }
                else if (suf + (int)(hv.w + hv.z) >= 256) { bt_l = 4 * lane + 2; ab_l = suf + (int)hv.w; }
                else if (suf + (int)(hv.w + hv.z + hv.y) >= 256) { bt_l = 4 * lane + 1; ab_l = suf + (int)(hv.w + hv.z); }
                else { bt_l = 4 * lane; ab_l = suf + (int)(hv.w + hv.z + hv.y); }
                const u64 cb = __ballot(suf < 256 && incl >= 256);
                const int src = (int)__builtin_ctzll(cb | (1ull << 63));
                const int bt = __builtin_amdgcn_readlane(bt_l, src), above = __builtin_amdgcn_readlane(ab_l, src);
                const int r = 256 - above;
                int C = 0;
#pragma unroll
                for (int j = 0; j < 32; ++j) {
                    const bool isc = (key[j] != 0u) && (sbin(unkey(key[j])) == bt);
                    const u64 bal = __ballot(isc);
                    if (isc) { const int pos = C + (int)__popcll(bal & ((1ull << lane) - 1ull)); if (pos < 64) candl[pos] = key[j]; }
                    C += (int)__popcll(bal);
                }
                unsigned tau; int cgt;
                if (C <= 64) {
                    asm volatile("s_waitcnt lgkmcnt(0)" ::: "memory");
                    const unsigned ck = (lane < C) ? candl[lane] : 0u;
                    unsigned lo = 0u;
#pragma unroll 1
                    for (int bit = 31; bit >= 0; --bit) { const unsigned cand = lo | (1u << bit); if ((int)__popcll(__ballot(ck >= cand)) >= r) lo = cand; }
                    tau = lo; cgt = above + (int)__popcll(__ballot(ck > tau));
                } else {
                    unsigned lo = 0u;
#pragma unroll 1
                    for (int bit = 31; bit >= 0; --bit) {
                        const unsigned cand = lo | (1u << bit); int c = 0;
#pragma unroll
                        for (int j = 0; j < 32; ++j) c += (key[j] >= cand) ? 1 : 0;
#pragma unroll
                        for (int x = 1; x < 64; x <<= 1) c += __builtin_amdgcn_ds_bpermute((lane ^ x) << 2, c);
                        if (c >= 256) lo = cand;
                    }
                    tau = lo; cgt = 0;
#pragma unroll
                    for (int j = 0; j < 32; ++j) cgt += (key[j] > tau) ? 1 : 0;
#pragma unroll
                    for (int x = 1; x < 64; x <<= 1) cgt += __builtin_amdgcn_ds_bpermute((lane ^ x) << 2, cgt);
                }
                const int need = 256 - cgt; int run = 0; u64 myword = 0ull;
#pragma unroll
                for (int j = 0; j < 32; ++j) {
                    const u64 gt = __ballot(key[j] > tau), eq = __ballot(key[j] == tau);
                    const u64 below = eq & ((1ull << lane) - 1ull);
                    const bool sel = (key[j] == tau) && (run + (int)__popcll(below) < need);
                    const u64 word = gt | __ballot(sel);
                    run += (int)__popcll(eq);
                    if (lane == j) myword = word;
                    __builtin_amdgcn_sched_barrier(0);
                }
                if (lane < 32) MASK[(size_t)(t0 + q) * 32 + lane] = myword;
            }
            __syncthreads();
        }
    }
    XBAR();
    STAMP(3);

#if DBG_CMP == 1
    {
        PH_LOCALS
        bf16_t* OAX = (bf16_t*)(ws + WS_SPARE);
        float* qv = (float*)(lds_raw + wave * 10240); float* lg = qv + 512;
        for (int it = gw; it < T_TOK * 8; it += NGW) {
            const int t = it >> 3, h = it & 7, b = t >> 11, q = t & 2047, ng = (q >> 6) + 1;
            { const unsigned v = *(const unsigned*)(P + (size_t)t * NPROJ + C_QLAT + h * 128 + 2 * lane); qv[2 * lane] = bflo(v); qv[2 * lane + 1] = bfhi(v); }
            const u64* mrow = MASK + (size_t)t * 32;
            float mx = -INFINITY;
            for (int g = 0; g < ng; ++g) {
                asm volatile("" ::: "memory");
                const u64 word = mrow[g]; float l = -INFINITY;
                if ((word >> lane) & 1ull) {
                    const u32x4* kr = (const u32x4*)(KV + (size_t)(b * SEQL + g * 64 + lane) * 128);
                    float d0 = 0.f, d1 = 0.f, d2 = 0.f, d3 = 0.f;
#pragma unroll
                    for (int c = 0; c < 16; ++c) { const u32x4 v = kr[c]; const f32x4 qa = *(const f32x4*)(qv + 8 * c), qb = *(const f32x4*)(qv + 8 * c + 4);
                        d0 += qa[0] * bflo(v.x) + qb[0] * bflo(v.z); d1 += qa[1] * bfhi(v.x) + qb[1] * bfhi(v.z); d2 += qa[2] * bflo(v.y) + qb[2] * bflo(v.w); d3 += qa[3] * bfhi(v.y) + qb[3] * bfhi(v.w); }
                    l = ((d0 + d1) + (d2 + d3)) * ATT_SCALE;
                }
                lg[g * 64 + lane] = l; mx = fmaxf(mx, l);
            }
            mx = wave_max(mx, lane);
            float o0 = 0.f, o1 = 0.f, sum = 0.f;
            for (int g = 0; g < ng; ++g) {
                const u64 wv = mrow[g];
                u64 word = ((u64)__builtin_amdgcn_readfirstlane((unsigned)(wv >> 32)) << 32) | (u64)__builtin_amdgcn_readfirstlane((unsigned)wv);
                while (word) {
                    const int j = __builtin_ctzll(word); word &= word - 1ull;
                    const int s = g * 64 + j; const float pj = __expf(lg[s] - mx);
                    const unsigned v = *(const unsigned*)(KV + (size_t)(b * SEQL + s) * 128 + 2 * lane);
                    o0 += pj * bflo(v); o1 += pj * bfhi(v); sum += pj;
                }
            }
            const float inv = 1.0f / sum;
            *(unsigned*)(OAX + (size_t)t * 1024 + h * 128 + 2 * lane) = pkbf(o0 * inv, o1 * inv);
        }
    }
    __syncthreads();
#endif
#if DBG_CMP == 2
    {
        PH_LOCALS
        const float* g_ret = IN(5);
        bf16_t* OBX = (bf16_t*)(ws + WS_SPARE);
        float* qv = (float*)(lds_raw + wave * 10240); float* lg = qv + 512; float* wl = lg;
        for (int it = gw; it < T_TOK * 8; it += NGW) {
            const int t = it >> 3, h = it & 7, b = t >> 11, n = t & 2047, ng = (n >> 6) + 1;
            const float lgam = (h == 0) ? -0.04580368961312479f : (h == 1) ? -0.02272007650008353f : (h == 2) ? -0.011315313227834146f : (h == 3) ? -0.005646563141142063f :
                               (h == 4) ? -0.0028205190623786626f : (h == 5) ? -0.0014095702546713536f : (h == 6) ? -0.0007046129765893727f : -0.0003522634716290214f;
            { const unsigned v = *(const unsigned*)(P + (size_t)t * NPROJ + C_QR + h * 128 + 2 * lane); qv[2 * lane] = bflo(v); qv[2 * lane + 1] = bfhi(v); }
            float o0 = 0.f, o1 = 0.f;
            for (int g = 0; g < ng; ++g) {
                asm volatile("" ::: "memory");
                const int m = g * 64 + lane;
                const u32x4* kr = (const u32x4*)(P + (size_t)(b * SEQL + m) * NPROJ + C_KR + h * 128);
                float d0 = 0.f, d1 = 0.f, d2 = 0.f, d3 = 0.f;
#pragma unroll
                for (int c = 0; c < 16; ++c) { const u32x4 v = kr[c]; const f32x4 qa = *(const f32x4*)(qv + 8 * c), qb = *(const f32x4*)(qv + 8 * c + 4);
                    d0 += qa[0] * bflo(v.x) + qb[0] * bflo(v.z); d1 += qa[1] * bfhi(v.x) + qb[1] * bfhi(v.z); d2 += qa[2] * bflo(v.y) + qb[2] * bflo(v.w); d3 += qa[3] * bfhi(v.y) + qb[3] * bfhi(v.w); }
                const float dot = (d0 + d1) + (d2 + d3);
                wl[lane] = (m <= n) ? dot * exp2f((float)(n - m) * lgam) : 0.f;
                const int jmax = (g == ng - 1) ? (n & 63) : 63;
                for (int j = 0; j <= jmax; ++j) {
                    const float wj = wl[j];
                    const unsigned v = *(const unsigned*)(P + (size_t)(b * SEQL + g * 64 + j) * NPROJ + C_VR + h * 128 + 2 * lane);
                    o0 += wj * bflo(v); o1 += wj * bfhi(v);
                }
            }
            const float mu = wave_sum(o0 + o1, lane) * (1.0f / 128.0f); const float e0 = o0 - mu, e1 = o1 - mu;
            const float rs = 1.0f / sqrtf(wave_sum(e0 * e0 + e1 * e1, lane) * (1.0f / 128.0f) + EPS_F);
            const unsigned gv = *(const unsigned*)(P + (size_t)t * NPROJ + C_GR + h * 128 + 2 * lane);
            const float y0 = siluf_(bflo(gv)) * e0 * rs * g_ret[h * 128 + 2 * lane], y1 = siluf_(bfhi(gv)) * e1 * rs * g_ret[h * 128 + 2 * lane + 1];
            *(unsigned*)(OBX + (size_t)t * 1024 + h * 128 + 2 * lane) = pkbf(y0, y1);
        }
    }
    __syncthreads();
#endif
    {
        PH_LOCALS
        for (int pr = bx; pr < 256; pr += G) {
            const int b = pr >> 5, i = pr & 31;
#pragma unroll 1
            for (int uu = 0; uu < 2; ++uu) {
                const int qb = uu ? 63 - i : i; const int t0 = b * SEQL + qb * 32;
                fa::UnitArgs U; U.Q = P + (size_t)t0 * NPROJ + C_QLAT; U.ldq = NPROJ; U.K = KV + (size_t)b * SEQL * 128; U.V = U.K; U.ldk = 128; U.mask = MASK + (size_t)t0 * 32;
                U.ntiles = (qb >> 1) + 1; U.n0 = 0; U.lgam = 0.f;
                fa::f32x16 o[4]; float l_reg;
                fa::unit_body<0>((LAS char*)lds, U, tid, o, l_reg);
                const int r32 = lane & 31, hi = lane >> 5;
                const int trow1 = hide_i(t0);
                LAS float* li_l = (LAS float*)(lds + fa::OFF_WS) + wave * 64;
                if (hi == 0) li_l[r32] = l_reg;
                asm volatile("s_waitcnt lgkmcnt(0)" ::: "memory");
                LAS char* Tw = (LAS char*)lds + fa::OFF_Q + wave * 8704; LAS char* Tl = Tw + hi * (4 * 272) + r32 * 2; asm volatile("" : "+v"(Tl));
#pragma unroll
                for (int r = 0; r < 16; ++r) {
                    const int orow = fa::crow(r, hi); const float rl = __builtin_amdgcn_rcpf(li_l[orow]);
#pragma unroll
                    for (int d0 = 0; d0 < 4; ++d0) *(LAS bf16_t*)(Tl + ((r & 3) + 8 * (r >> 2)) * 272 + d0 * 64) = (bf16_t)(pkbf(o[d0][r] * rl, 0.f) & 0xffffu);
                }
                asm volatile("s_waitcnt lgkmcnt(0)" ::: "memory");
#pragma unroll
                for (int k = 0; k < 8; ++k) {
                    const int c = lane + 64 * k, orow = c >> 4, ch = c & 15;
                    const u32x4 v = *(const LAS u32x4*)(Tw + orow * 272 + ch * 16);
                    *(u32x4*)(OA + (size_t)(trow1 + orow) * 2048 + wave * 128 + ch * 8) = v;
                }
                __syncthreads();
            }
        }
    }
    STAMP(20);
    {
        PH_LOCALS
        const float* g_ret = IN(5);
        for (int pr = bx; pr < 256; pr += G) {
            const int bh = pr >> 2, i = pr & 3, b = bh >> 3, h = bh & 7;
            const float lgam = (h == 0) ? -0.04580368961312479f : (h == 1) ? -0.02272007650008353f : (h == 2) ? -0.011315313227834146f : (h == 3) ? -0.005646563141142063f :
                               (h == 4) ? -0.0028205190623786626f : (h == 5) ? -0.0014095702546713536f : (h == 6) ? -0.0007046129765893727f : -0.0003522634716290214f;
#pragma unroll 1
            for (int uu = 0; uu < 2; ++uu) {
                const int qb = uu ? 7 - i : i; const int n0 = qb * 256;
                fa::UnitArgs U; U.Q = P + (size_t)(b * SEQL + n0) * NPROJ + C_QR + h * 128; U.ldq = NPROJ;
                U.K = P + (size_t)(b * SEQL) * NPROJ + C_KR + h * 128; U.V = P + (size_t)(b * SEQL) * NPROJ + C_VR + h * 128; U.ldk = NPROJ; U.mask = nullptr;
                U.ntiles = 4 * (qb + 1); U.n0 = n0; U.lgam = lgam;
                fa::f32x16 o[4]; float l_reg;
                fa::unit_body<1>((LAS char*)lds, U, tid, o, l_reg);
                const int r32 = lane & 31, hi = lane >> 5;
                const int tok0 = hide_i(b * SEQL + n0 + wave * 32 + 4 * hi);
                float gr[4];
#pragma unroll
                for (int d0 = 0; d0 < 4; ++d0) gr[d0] = g_ret[h * 128 + d0 * 32 + r32];
                float sv[16], qv[16];
#pragma unroll
                for (int r = 0; r < 16; ++r) sv[r] = (o[0][r] + o[1][r]) + (o[2][r] + o[3][r]);
#pragma unroll
                for (int x = 1; x < 32; x <<= 1)
#pragma unroll
                    for (int r = 0; r < 16; ++r) sv[r] += shx(sv[r], lane, x);
#pragma unroll
                for (int r = 0; r < 16; ++r) { const float mu = sv[r] * (1.0f / 128.0f); sv[r] = mu;
                    const float e0 = o[0][r] - mu, e1 = o[1][r] - mu, e2 = o[2][r] - mu, e3 = o[3][r] - mu; qv[r] = (e0 * e0 + e1 * e1) + (e2 * e2 + e3 * e3); }
#pragma unroll
                for (int x = 1; x < 32; x <<= 1)
#pragma unroll
                    for (int r = 0; r < 16; ++r) qv[r] += shx(qv[r], lane, x);
                LAS char* Tw = (LAS char*)lds + fa::OFF_Q + wave * 8704; LAS char* Tl = Tw + hi * (4 * 272) + r32 * 2; asm volatile("" : "+v"(Tl));
#pragma unroll
                for (int r = 0; r < 16; ++r) {
                    const float mu = sv[r]; const float rs = 1.0f / sqrtf(qv[r] * (1.0f / 128.0f) + EPS_F); const int orow = fa::crow(r, hi);
#pragma unroll
                    for (int d0 = 0; d0 < 4; ++d0) *(LAS bf16_t*)(Tl + ((r & 3) + 8 * (r >> 2)) * 272 + d0 * 64) = (bf16_t)(pkbf((o[d0][r] - mu) * rs * gr[d0], 0.f) & 0xffffu);
                }
                asm volatile("s_waitcnt lgkmcnt(0)" ::: "memory");
                const int tokb = hide_i(b * SEQL + n0 + wave * 32);
#pragma unroll
                for (int k = 0; k < 8; ++k) {
                    const int c = lane + 64 * k, orow = c >> 4, ch = c & 15;
                    const u32x4 v = *(const LAS u32x4*)(Tw + orow * 272 + ch * 16);
                    const size_t tok = (size_t)(tokb + orow);
                    const u32x4 g = *(const u32x4*)(P + tok * NPROJ + C_GR + h * 128 + ch * 8);
                    u32x4 w; w.x = pkbf(siluf_(bflo(g.x)) * bflo(v.x), siluf_(bfhi(g.x)) * bfhi(v.x)); w.y = pkbf(siluf_(bflo(g.y)) * bflo(v.y), siluf_(bfhi(g.y)) * bfhi(v.y));
                    w.z = pkbf(siluf_(bflo(g.z)) * bflo(v.z), siluf_(bfhi(g.z)) * bfhi(v.z)); w.w = pkbf(siluf_(bflo(g.w)) * bflo(v.w), siluf_(bfhi(g.w)) * bfhi(v.w));
                    *(u32x4*)(OB + tok * 2048 + h * 128 + ch * 8) = w;
                }
                __syncthreads();
            }
        }
    }
#ifdef RET_EXP
    XBAR();
    STAMP(30);
    {
        PH_LOCALS
        const float* g_ret = IN(5);
        for (int pr = bx; pr < 256; pr += G) {
            const int bh = pr >> 2, i = pr & 3, b = bh >> 3, h = bh & 7;
            const float lgam = (h == 0) ? -0.04580368961312479f : (h == 1) ? -0.02272007650008353f : (h == 2) ? -0.011315313227834146f : (h == 3) ? -0.005646563141142063f :
                               (h == 4) ? -0.0028205190623786626f : (h == 5) ? -0.0014095702546713536f : (h == 6) ? -0.0007046129765893727f : -0.0003522634716290214f;
#pragma unroll 1
            for (int uu = 0; uu < 2; ++uu) {
                const int qb = uu ? 7 - i : i; const int n0 = qb * 256;
                fa::UnitArgs U; U.Q = P + (size_t)(b * SEQL + n0) * NPROJ + C_QR + h * 128; U.ldq = NPROJ;
                U.K = P + (size_t)(b * SEQL) * NPROJ + C_KR + h * 128; U.V = P + (size_t)(b * SEQL) * NPROJ + C_VR + h * 128; U.ldk = NPROJ; U.mask = nullptr;
                U.ntiles = 4 * (qb + 1); U.n0 = n0; U.lgam = lgam;
                fa::f32x16 o[4]; float l_reg;
                fa::unit_body<1, RET_EXP>((LAS char*)lds, U, tid, o, l_reg);
                const int r32 = lane & 31, hi = lane >> 5;
                const int tok0 = hide_i(b * SEQL + n0 + wave * 32 + 4 * hi);
                float gr[4];
#pragma unroll
                for (int d0 = 0; d0 < 4; ++d0) gr[d0] = g_ret[h * 128 + d0 * 32 + r32];
                if (RET_EXP & 8) { fa::f32x16 t_ = (o[0] + o[1]) + (o[2] + o[3]); float z_ = 0.f;
#pragma unroll
                    for (int r = 0; r < 16; ++r) z_ += t_[r];
                    ((float*)(ws + WS_SPARE))[(size_t)(pr * 2 + uu) * 512 + tid] = z_; }
                else
#pragma unroll
                for (int r = 0; r < 16; ++r) {
                    float s = (o[0][r] + o[1][r]) + (o[2][r] + o[3][r]);
#pragma unroll
                    for (int x = 1; x < 32; x <<= 1) s += shx(s, lane, x);
                    const float mu = s * (1.0f / 128.0f);
                    const float e0 = o[0][r] - mu, e1 = o[1][r] - mu, e2 = o[2][r] - mu, e3 = o[3][r] - mu;
                    float q = (e0 * e0 + e1 * e1) + (e2 * e2 + e3 * e3);
#pragma unroll
                    for (int x = 1; x < 32; x <<= 1) q += shx(q, lane, x);
                    const float rs = 1.0f / sqrtf(q * (1.0f / 128.0f) + EPS_F);
                    const size_t tok = (size_t)(tok0 + (r & 3) + 8 * (r >> 2));
                    const bf16_t* gp = P + tok * NPROJ + C_GR + h * 128 + r32; bf16_t* op = (bf16_t*)(ws + WS_SPARE) + tok * 1024 + h * 128 + r32;
                    op[0] = (bf16_t)(pkbf(siluf_(bflo((unsigned)gp[0])) * e0 * rs * gr[0], 0.f) & 0xffffu);
                    op[32] = (bf16_t)(pkbf(siluf_(bflo((unsigned)gp[32])) * e1 * rs * gr[1], 0.f) & 0xffffu);
                    op[64] = (bf16_t)(pkbf(siluf_(bflo((unsigned)gp[64])) * e2 * rs * gr[2], 0.f) & 0xffffu);
                    op[96] = (bf16_t)(pkbf(siluf_(bflo((unsigned)gp[96])) * e3 * rs * gr[3], 0.f) & 0xffffu);
                }
                __syncthreads();
            }
        }
    }
    XBAR();
    STAMP(31);
#endif
#if DBG_CMP
    XBAR();
    {
        PH_LOCALS
        const bf16_t* A_ = (DBG_CMP == 1) ? OA : OB; const bf16_t* R_ = (const bf16_t*)(ws + WS_SPARE);
        float sd = 0.f, sr = 0.f;
#if DBG_CMP == 3
        for (size_t i = (size_t)gtid; i < (size_t)T_TOK * 32; i += (size_t)NGT) { const u64 a = MASK[i], r = ((const u64*)(ws + WS_SPARE))[i]; sd += (float)__popcll(a ^ r); sr += 100.0f * (float)__popcll(r); }
#else
        for (size_t i = (size_t)gtid; i < (size_t)T_TOK * 1024 / 2; i += (size_t)NGT) {
            const unsigned a = ((const unsigned*)A_)[(i >> 9) * 1024 + (i & 511)], r = ((const unsigned*)R_)[i];
            const float d0 = bflo(a) - bflo(r), d1 = bfhi(a) - bfhi(r); sd += d0 * d0 + d1 * d1; sr += bflo(r) * bflo(r) + bfhi(r) * bfhi(r);
        }
#endif
        sd = wave_sum(sd, lane); sr = wave_sum(sr, lane);
        if (lane == 0) { atomicAdd((float*)(ctl + 4096), sd); atomicAdd((float*)(ctl + 4097), sr); }
    }
#endif
    XBAR();
    STAMP(4);

    {
        PH_LOCALS
        pg8::Gemm g{OA, WCOMB, T_TOK, DMODEL, 2048}; pg8::StaticOrder S; S.init(T_TOK, DMODEL, G, bx);
        pg8::EpiMergeF E{P, MIXED};
        pg8::gemm_phase<pg8::EpiMergeF, pg8::StaticOrder, true, true>(lds, g, S, E, tid);
    }
    XBAR();
    STAMP(5);
    {
        PH_LOCALS
        const float* x = IN(0);
        pg8::Gemm g{MIXED, WO, T_TOK, DMODEL, 2048}; pg8::StaticOrder S; S.init(T_TOK, DMODEL, G, bx);
        pg8::EpiRes E{x, out};
        pg8::gemm_phase<pg8::EpiRes, pg8::StaticOrder, true, true>(lds, g, S, E, tid);
    }
    XBAR();
    STAMP(7);
#ifdef GEMM_EXP
    {
        PH_LOCALS
        pg8::Gemm g{MIXED, WO, T_TOK, DMODEL, 2048}; pg8::StaticOrder S; S.init(T_TOK, DMODEL, G, bx);
        pg8::EpiNull E{(float*)(ws + WS_SPARE)};
        pg8::gemm_phase<pg8::EpiNull, pg8::StaticOrder, true, true>(lds, g, S, E, tid);
    }
    XBAR();
    STAMP(31);
#endif

    {
    PH_LOCALS
    const float* g_ffn = IN(8); const float* b_rg = IN(10); const float* b_re = IN(12);
    const f32x4* WC4 = (const f32x4*)(ws + WS_WC); float* tok_rs = (float*)(ws + WS_WC + 786432);
    LAS float* lg = (LAS float*)lds + wave * (16 * 52);
    const int row = lane & 15, g4 = lane >> 4;
    LAS float* part = (LAS float*)lds + 4 * (16 * 52) + (wave & 3) * (13 * 64);
    for (int tile0 = bx * 4; tile0 < T_TOK / 16; tile0 += G * 4) {
        const int tile = tile0 + (wave & 3), kh = wave >> 2;
        const int tok0 = tile * 16;
        const float* hrow = out + (size_t)(tok0 + row) * DMODEL + 8 * g4 + 1024 * kh;
        bf16_t* trow = TN + (size_t)(tok0 + row) * DMODEL + 8 * g4 + 1024 * kh;
        const f32x4* wp = WC4 + (size_t)g4 * 96 + 2 * row + (size_t)kh * 32 * 384;
        const float* gp = g_ffn + 8 * g4 + 1024 * kh;
        f32x4 acc0 = (f32x4){0.f, 0.f, 0.f, 0.f}, acc1 = acc0, acc2 = acc0; float ssq = 0.f;
        f32x4 a0 = *(const f32x4*)(hrow), a1 = *(const f32x4*)(hrow + 4);
        f32x4 b00 = wp[0], b01 = wp[1], b10 = wp[32], b11 = wp[33], b20 = wp[64], b21 = wp[65];
        f32x4 na0 = *(const f32x4*)(hrow + 32), na1 = *(const f32x4*)(hrow + 36);
        f32x4 nb00 = wp[384], nb01 = wp[385], nb10 = wp[416], nb11 = wp[417], nb20 = wp[448], nb21 = wp[449];
        for (int it = 0; it < 32; ++it) {
            const int itn = (it + 2 < 32) ? it + 2 : 31;
            const f32x4 ma0 = *(const f32x4*)(hrow + 32 * itn), ma1 = *(const f32x4*)(hrow + 32 * itn + 4);
            const f32x4* wn = wp + (size_t)itn * 384;
            const f32x4 mb00 = wn[0], mb01 = wn[1], mb10 = wn[32], mb11 = wn[33], mb20 = wn[64], mb21 = wn[65];
            const f32x4 gk0 = *(const f32x4*)(gp + 32 * it), gk1 = *(const f32x4*)(gp + 32 * it + 4);
            ssq += (a0[0] * a0[0] + a0[1] * a0[1]) + (a0[2] * a0[2] + a0[3] * a0[3]) + (a1[0] * a1[0] + a1[1] * a1[1]) + (a1[2] * a1[2] + a1[3] * a1[3]);
            { u32x4 w; w.x = pkbf(a0[0] * gk0[0], a0[1] * gk0[1]); w.y = pkbf(a0[2] * gk0[2], a0[3] * gk0[3]); w.z = pkbf(a1[0] * gk1[0], a1[1] * gk1[1]); w.w = pkbf(a1[2] * gk1[2], a1[3] * gk1[3]);
              *(u32x4*)(trow + 32 * it) = w; }
#pragma unroll
            for (int s_ = 0; s_ < 4; ++s_) {
                acc0 = __builtin_amdgcn_mfma_f32_16x16x4f32(a0[s_], b00[s_], acc0, 0, 0, 0);
                acc1 = __builtin_amdgcn_mfma_f32_16x16x4f32(a0[s_], b10[s_], acc1, 0, 0, 0);
                acc2 = __builtin_amdgcn_mfma_f32_16x16x4f32(a0[s_], b20[s_], acc2, 0, 0, 0);
            }
#pragma unroll
            for (int s_ = 0; s_ < 4; ++s_) {
                acc0 = __builtin_amdgcn_mfma_f32_16x16x4f32(a1[s_], b01[s_], acc0, 0, 0, 0);
                acc1 = __builtin_amdgcn_mfma_f32_16x16x4f32(a1[s_], b11[s_], acc1, 0, 0, 0);
                acc2 = __builtin_amdgcn_mfma_f32_16x16x4f32(a1[s_], b21[s_], acc2, 0, 0, 0);
            }
            a0 = na0; a1 = na1; b00 = nb00; b01 = nb01; b10 = nb10; b11 = nb11; b20 = nb20; b21 = nb21;
            na0 = ma0; na1 = ma1; nb00 = mb00; nb01 = mb01; nb10 = mb10; nb11 = mb11; nb20 = mb20; nb21 = mb21;
        }
        if (kh == 1) {
#pragma unroll
            for (int r = 0; r < 4; ++r) { part[r * 64 + lane] = acc0[r]; part[(4 + r) * 64 + lane] = acc1[r]; part[(8 + r) * 64 + lane] = acc2[r]; }
            part[12 * 64 + lane] = ssq;
        }
        __syncthreads();
        if (kh == 0) {
#pragma unroll
            for (int r = 0; r < 4; ++r) { acc0[r] += part[r * 64 + lane]; acc1[r] += part[(4 + r) * 64 + lane]; acc2[r] += part[(8 + r) * 64 + lane]; }
            ssq += part[12 * 64 + lane];
        ssq += shx(ssq, lane, 16); ssq += shx(ssq, lane, 32);
        const float rstd = 1.0f / sqrtf(ssq * (1.0f / DMODEL) + EPS_F);
#pragma unroll
        for (int r = 0; r < 4; ++r) { lg[(4 * g4 + r) * 52 + row] = acc0[r]; lg[(4 * g4 + r) * 52 + 16 + row] = acc1[r]; lg[(4 * g4 + r) * 52 + 32 + row] = acc2[r]; }
        asm volatile("s_waitcnt lgkmcnt(0)" ::: "memory");
        if (lane < 16) {
            const int t = tok0 + lane; const LAS float* lr = lg + lane * 52;
            float gl[4];
#pragma unroll
            for (int k = 0; k < 4; ++k) gl[k] = lr[k] * rstd + b_rg[k];
            int grp = 0; float gmx = gl[0];
#pragma unroll
            for (int k = 1; k < 4; ++k) if (gl[k] > gmx) { gmx = gl[k]; grp = k; }
            float gz = 0.f;
#pragma unroll
            for (int k = 0; k < 4; ++k) gz += __expf(gl[k] - gmx);
            const float p_grp = 1.0f / gz;
            float el[8];
#pragma unroll
            for (int k = 0; k < 8; ++k) el[k] = lr[4 + grp * 8 + k] * rstd + b_re[grp * 8 + k];
            int i1 = 0; float m1 = el[0];
#pragma unroll
            for (int k = 1; k < 8; ++k) if (el[k] > m1) { m1 = el[k]; i1 = k; }
            int i2 = -1; float m2 = -INFINITY;
#pragma unroll
            for (int k = 0; k < 8; ++k) if (k != i1 && el[k] > m2) { m2 = el[k]; i2 = k; }
            const float e2 = __expf(m2 - m1); const float den = 1.0f / (1.0f + e2);
            const float g1 = p_grp * den, g2 = p_grp * e2 * den;
            const int ex1 = grp * 8 + i1, ex2 = grp * 8 + i2;
            const unsigned r1 = atomicAdd(ctl + 64 * ex1, 1u), r2 = atomicAdd(ctl + 64 * ex2, 1u);
            asg_e[2 * t] = ex1; asg_e[2 * t + 1] = ex2; asg_r[2 * t] = (int)r1; asg_r[2 * t + 1] = (int)r2; asg_g[2 * t] = g1; asg_g[2 * t + 1] = g2;
            tok_rs[t] = rstd;
        }
        }
        __syncthreads();
    }
    }
    XBAR();
    STAMP(8);

    LAS int* tile_start = (LAS int*)(lds + LDS_MISC);
    {
    PH_LOCALS
    if (tid == 0) {
        int acc_t = 0;
        for (int e = 0; e < 32; ++e) { tile_start[e] = acc_t; const int c = (int)__hip_atomic_load(ctl + 64 * e, __ATOMIC_RELAXED, __HIP_MEMORY_SCOPE_AGENT); acc_t += (c + 255) >> 8; }
        tile_start[32] = acc_t;
    }
    __syncthreads();
    for (int a = gtid; a < 2 * T_TOK; a += NGT) {
        const int t = a >> 1; const int e = asg_e[a], rk = asg_r[a]; const int slot = tile_start[e] * 256 + rk;
        row_tok[slot] = t; row_gate[slot] = asg_g[a]; tok_slot[a] = slot; ((float*)(ws + WS_WC + 524288))[slot] = ((const float*)(ws + WS_WC + 786432))[t];
    }
    }
    XBAR();
    STAMP(9);

    {
        PH_LOCALS
        pg8::Gemm g{TN, WGU, MAXSLOT, 2048, 2048}; pg8::ExpertOrderT<true> S{tile_start, G, bx, row_tok};
        pg8::EpiSwiglu E{HMID, (const float*)(ws + WS_WC + 524288)};
        pg8::gemm_phase<pg8::EpiSwiglu, pg8::ExpertOrderT<true>, true, true>(lds, g, S, E, tid);
    }
    XBAR();
    STAMP(10);
    {
        PH_LOCALS
        pg8::Gemm g{HMID, WD, MAXSLOT, 2048, 1024}; pg8::ExpertOrderT<false> S{tile_start, G, bx, nullptr};
        pg8::EpiDown E{Y, row_gate};
        pg8::gemm_phase<pg8::EpiDown, pg8::ExpertOrderT<false>, true, true>(lds, g, S, E, tid);
    }
    XBAR();
    STAMP(11);
#if PROF_PHASE >= 0
    XBAR();
#endif

    {
    PH_LOCALS
    const float* g_fin = IN(16);
#if DBG_CMP
    const float dbg_scale = 1.0f + 4.0f * sqrtf(__hip_atomic_load((float*)(ctl + 4096), __ATOMIC_RELAXED, __HIP_MEMORY_SCOPE_AGENT) / __hip_atomic_load((float*)(ctl + 4097), __ATOMIC_RELAXED, __HIP_MEMORY_SCOPE_AGENT));
#elif PROF_PHASE >= 0 && (PROF_PHASE % 100) != 12
    const unsigned ta_ = __hip_atomic_load(ctl + 6000 + (PROF_PHASE / 100), __ATOMIC_RELAXED, __HIP_MEMORY_SCOPE_AGENT), tb_ = __hip_atomic_load(ctl + 6000 + (PROF_PHASE % 100), __ATOMIC_RELAXED, __HIP_MEMORY_SCOPE_AGENT);
    const float dbg_scale = 1.0f + sqrtf(PROF_SCALE * (float)(tb_ - ta_) * 0.01f);
#else
    const float dbg_scale = 1.0f;
#endif
    for (int t = gw; t < T_TOK; t += 2 * NGW) {
        const int t1 = (t + NGW < T_TOK) ? t + NGW : t;
        const int sa0 = tok_slot[2 * t], sa1 = tok_slot[2 * t + 1], sb0 = tok_slot[2 * t1], sb1 = tok_slot[2 * t1 + 1];
        f32x4* hra = (f32x4*)(out + (size_t)t * DMODEL) + lane; f32x4* hrb = (f32x4*)(out + (size_t)t1 * DMODEL) + lane;
        const u32x2* ya0 = (const u32x2*)(Y + (size_t)sa0 * DMODEL) + lane; const u32x2* ya1 = (const u32x2*)(Y + (size_t)sa1 * DMODEL) + lane;
        const u32x2* yb0 = (const u32x2*)(Y + (size_t)sb0 * DMODEL) + lane; const u32x2* yb1 = (const u32x2*)(Y + (size_t)sb1 * DMODEL) + lane;
        f32x4 va[8], vb[8]; u32x2 pa[8], qa[8], pb[8], qb[8];
#pragma unroll
        for (int j = 0; j < 8; ++j) { va[j] = hra[64 * j]; vb[j] = hrb[64 * j]; pa[j] = ya0[64 * j]; qa[j] = ya1[64 * j]; pb[j] = yb0[64 * j]; qb[j] = yb1[64 * j]; }
        float ssa = 0.f, ssb = 0.f;
#pragma unroll
        for (int j = 0; j < 8; ++j) {
            va[j][0] += bflo(pa[j].x) + bflo(qa[j].x); va[j][1] += bfhi(pa[j].x) + bfhi(qa[j].x); va[j][2] += bflo(pa[j].y) + bflo(qa[j].y); va[j][3] += bfhi(pa[j].y) + bfhi(qa[j].y);
            vb[j][0] += bflo(pb[j].x) + bflo(qb[j].x); vb[j][1] += bfhi(pb[j].x) + bfhi(qb[j].x); vb[j][2] += bflo(pb[j].y) + bflo(qb[j].y); vb[j][3] += bfhi(pb[j].y) + bfhi(qb[j].y);
            ssa += (va[j][0] * va[j][0] + va[j][1] * va[j][1]) + (va[j][2] * va[j][2] + va[j][3] * va[j][3]);
            ssb += (vb[j][0] * vb[j][0] + vb[j][1] * vb[j][1]) + (vb[j][2] * vb[j][2] + vb[j][3] * vb[j][3]);
        }
        const float ra = dbg_scale / sqrtf(wave_sum(ssa, lane) * (1.0f / DMODEL) + EPS_F), rb = dbg_scale / sqrtf(wave_sum(ssb, lane) * (1.0f / DMODEL) + EPS_F);
#pragma unroll
        for (int j = 0; j < 8; ++j) { const f32x4 gg = ((const f32x4*)g_fin)[lane + 64 * j]; hra[64 * j] = va[j] * ra * gg; if (t1 != t) hrb[64 * j] = vb[j] * rb * gg; }
    }
    }
#if PROF_PHASE >= 0
    if (PROF_PHASE % 100 == 12) {
        XBAR(); STAMP(12); XBAR();
        PH_LOCALS
        const unsigned ta_ = __hip_atomic_load(ctl + 6000 + (PROF_PHASE / 100), __ATOMIC_RELAXED, __HIP_MEMORY_SCOPE_AGENT), tb_ = __hip_atomic_load(ctl + 6012, __ATOMIC_RELAXED, __HIP_MEMORY_SCOPE_AGENT);
        const float sc_ = 1.0f + sqrtf(PROF_SCALE * (float)(tb_ - ta_) * 0.01f);
        for (size_t i = (size_t)gtid; i < (size_t)T_TOK * DMODEL / 4; i += (size_t)NGT) { f32x4 v = ((f32x4*)out)[i]; ((f32x4*)out)[i] = v * sc_; }
    }
#endif
}

extern "C" void kernel_launch(void* const* d_in, const int* in_sizes, int n_in, void* d_out, int out_size, void* d_ws, size_t ws_size, hipStream_t stream) {
    static int grid_blocks = 0;
    if (grid_blocks == 0) {
        if (n_in != 17 || out_size != T_TOK * DMODEL || ws_size < WS_END) { fprintf(stderr, "kernel_launch: unexpected problem (n_in %d, out %d, ws %zu < %zu)\n", n_in, out_size, ws_size, (size_t)WS_END); grid_blocks = -1; return; }
        int dev = 0, cus = 0, per_cu = 0;
        (void)hipGetDevice(&dev);
        (void)hipDeviceGetAttribute(&cus, hipDeviceAttributeMultiprocessorCount, dev);
        if (hipFuncSetAttribute((const void*)mega_fwd, hipFuncAttributeMaxDynamicSharedMemorySize, LDS_BYTES) != hipSuccess) { fprintf(stderr, "kernel_launch: hipFuncSetAttribute failed\n"); grid_blocks = -1; return; }
        if (hipOccupancyMaxActiveBlocksPerMultiprocessor(&per_cu, (const void*)mega_fwd, 512, LDS_BYTES) != hipSuccess || per_cu < 1) { fprintf(stderr, "kernel_launch: occupancy query says %d\n", per_cu); grid_blocks = -1; return; }
        grid_blocks = cus;
        fprintf(stderr, "kernel_launch: cus %d per_cu %d grid %d ws %zu need %zu\n", cus, per_cu, grid_blocks, ws_size, (size_t)WS_END);
    }
    if (grid_blocks < 0) return;
    if (hipMemsetAsync((char*)d_ws + WS_CTL, 0, 65536, stream) != hipSuccess) { fprintf(stderr, "kernel_launch: memset of control words failed\n"); return; }
    Params prm{};
    for (int i = 0; i < 17; ++i) prm.in[i] = (const float*)d_in[i];
    prm.out = (float*)d_out; prm.ws = (unsigned char*)d_ws;
    void* args[] = {&prm};
    hipError_t e = hipLaunchCooperativeKernel((void*)mega_fwd, dim3(grid_blocks), dim3(512), args, LDS_BYTES, stream);
    if (e != hipSuccess) fprintf(stderr, "cooperative launch failed: %s (grid %d)\n", hipGetErrorString(e), grid_blocks);
}
```

```cpp
#include <hip/hip_runtime.h>
#include <hip/hip_cooperative_groups.h>
#include <cstdio>
#include <cstdint>
namespace cg = cooperative_groups;
namespace pg8 {
#define PG8_LAS __attribute__((address_space(3)))
typedef unsigned short bf16_t;
typedef short bf16x8 __attribute__((ext_vector_type(8)));
typedef float f32x4 __attribute__((ext_vector_type(4)));
typedef unsigned u32x4 __attribute__((ext_vector_type(4)));
constexpr int BM = 256, BK = 64, HALF = 128, HTB = HALF * BK * 2  , STAGE_BYTES = 8 * HTB, NXCD = 8, WGM = 8;

__host__ __device__ __forceinline__ int lds_byte(int r, int c) { const int st = (r >> 4) * 2 + (c >> 5), rr = r & 15, cc = c & 31, ob = rr * 64 + cc * 2; return st * 1024 + (ob ^ (((ob >> 9) & 1) << 5)); }
__host__ __device__ __forceinline__ void stage_rc(int b, int& R, int& C) { const int st = b / 1024, sb = b % 1024, swz = sb ^ (((sb >> 9) & 1) << 5); R = (st >> 1) * 16 + swz / 64; C = (st & 1) * 32 + (swz % 64) / 2; }
__host__ __device__ __forceinline__ int perm32(int rho) { const int n = rho >> 4, i = rho & 15; return 8 * (i >> 2) + 4 * n + (i & 3); }

struct Unit { int pm, pn, e; };
struct Gemm { const bf16_t* A; const bf16_t* Bt; int M, N, K; };

struct StaticOrder {
    int nM, nN, nwg, G, c;
    __host__ __device__ void init(int M, int N, int G_, int c_) { nM = M / BM; nN = N / BM; nwg = nM * nN; G = G_; c = c_; }
    __host__ __device__ bool next(int i, Unit& u) const {
        const long L = (long)i * G + c; if (L >= nwg) return false;
        int wgid = (int)L; { const int q = nwg / NXCD, r = nwg % NXCD, xcd = wgid % NXCD, off = wgid / NXCD; wgid = (xcd < r ? xcd * (q + 1) : r * (q + 1) + (xcd - r) * q) + off; }
        const int nig = WGM * nN, gid = wgid / nig, fm = gid * WGM, gsz = (nM - fm) < WGM ? (nM - fm) : WGM;
        u.pm = fm + ((wgid % nig) % gsz); u.pn = (wgid % nig) / gsz; u.e = 0; return true;
    }
    static constexpr bool GATHER = false;
    __device__ __forceinline__ unsigned rowoff(int) const { return 0u; }
    __device__ __forceinline__ void a_ready(const Unit&) const {}
    __device__ __forceinline__ void done(const Unit&) const {}
};

template <class Epi, class Sched, bool ALIGN_EPI = false, bool SP2 = false>
__device__ __forceinline__ void gemm_phase(PG8_LAS unsigned char* lds, const Gemm g, const Sched& S, const Epi& E, const int tid) {
    const int wid = __builtin_amdgcn_readfirstlane(tid >> 6), lane = tid & 63, wr = wid >> 2, wc = wid & 3, fr = lane & 15, fq = lane >> 4;
    const int K = g.K, nt = K / BK;
    constexpr bool GA = Sched::GATHER;
    static_assert(!GA || SP2, "the gather path is written for the SP2 loop");
    unsigned voffA[2], voffB[2]; int gR[2], gC[2];
#pragma unroll
    for (int i = 0; i < 2; ++i) { int R, C; stage_rc(tid * 16 + i * 8192, R, C); const int Rb = Epi::PERM ? ((R & ~31) + perm32(R & 31)) : R;
        voffA[i] = (unsigned)(R * K + C) * 2u; voffB[i] = (unsigned)(Rb * K + C) * 2u; gR[i] = R; gC[i] = C; }
    unsigned cvo0[2] = {0u, 0u}, cvo1[2] = {0u, 0u}, nvo0[2] = {0u, 0u}, nvo1[2] = {0u, 0u}, sel0[2] = {0u, 0u}, sel1[2] = {0u, 0u};
#define PG8_GOFF(u_, o0_, o1_) do { _Pragma("unroll") for (int _i = 0; _i < 2; ++_i) { \
        o0_[_i] = S.rowoff((u_).pm * BM + gR[_i]) * (unsigned)(K * 2) + (unsigned)gC[_i] * 2u; o1_[_i] = S.rowoff((u_).pm * BM + HALF + gR[_i]) * (unsigned)(K * 2) + (unsigned)gC[_i] * 2u; } } while (0)
#define PG8_STAGE_A(bufoff, base, h_, CUR_) do { if constexpr (GA) { if (CUR_) { if (h_) PG8_STAGE(bufoff, base, cvo1); else PG8_STAGE(bufoff, base, cvo0); } else { if (h_) PG8_STAGE(bufoff, base, sel1); else PG8_STAGE(bufoff, base, sel0); } } \
        else PG8_STAGE(bufoff, (base) + (h_) * hstep, voffA); } while (0)
    const size_t kstep = (size_t)(BK * 2);
    const size_t hstep = (size_t)HALF * K * 2;
    const size_t tstep = 2 * hstep;
    const unsigned ldsw = (unsigned)wid * 1024u;
    const int aoff = lds_byte(wr * 64 + fr, fq * 8), boff = lds_byte(wc * 32 + fr, fq * 8);
#define PG8_SA(b, h) (((b) * 2 + (h)) * HTB)
#define PG8_SB(b, h) ((4 + (b) * 2 + (h)) * HTB)
#define PG8_STAGE(bufoff, gbase, voff) do { _Pragma("unroll") for (int _i = 0; _i < 2; ++_i) \
        __builtin_amdgcn_global_load_lds((const unsigned*)((const char*)(gbase) + (voff)[_i]), (PG8_LAS unsigned*)(lds + (bufoff) + ldsw + _i * 8192), 16, 0, 0); } while (0)
#define PG8_LDA(dst, b, h) do { _Pragma("unroll") for (int m = 0; m < 4; ++m) _Pragma("unroll") for (int k = 0; k < 2; ++k) dst[m][k] = *(const PG8_LAS bf16x8*)(lds + PG8_SA(b, h) + aoff + m * 2048 + k * 1024); } while (0)
#define PG8_LDB(dst, b, h) do { _Pragma("unroll") for (int n = 0; n < 2; ++n) _Pragma("unroll") for (int k = 0; k < 2; ++k) dst[n][k] = *(const PG8_LAS bf16x8*)(lds + PG8_SB(b, h) + boff + n * 2048 + k * 1024); } while (0)
#define PG8_MMA(ai, bj, At, Bt) do { __builtin_amdgcn_s_setprio(1); _Pragma("unroll") for (int m = 0; m < 4; ++m) _Pragma("unroll") for (int n = 0; n < 2; ++n) _Pragma("unroll") for (int k = 0; k < 2; ++k) \
        acc[ai][bj][m][n] = __builtin_amdgcn_mfma_f32_16x16x32_bf16(Bt[n][k], At[m][k], acc[ai][bj][m][n], 0, 0, 0); __builtin_amdgcn_s_setprio(0); } while (0)
#define PG8_WAIT_V(n) asm volatile("s_waitcnt vmcnt(" #n ")" ::: "memory")
#define PG8_WAIT_L(n) asm volatile("s_waitcnt lgkmcnt(" #n ")" ::: "memory")
#define PG8_BAR __builtin_amdgcn_s_barrier()
#define PG8_SCHED __builtin_amdgcn_sched_barrier(0)
    Unit cur, nxt; int ui = 0;
    if (!S.next(0, cur)) return;
    f32x4 acc[2][2][4][2];
#pragma unroll
    for (int a = 0; a < 2; ++a)
#pragma unroll
        for (int b = 0; b < 2; ++b)
#pragma unroll
            for (int m = 0; m < 4; ++m)
#pragma unroll
                for (int n = 0; n < 2; ++n) acc[a][b][m][n] = (f32x4){0.f, 0.f, 0.f, 0.f};
    bf16x8 At[4][2], B0[2][2], B1[2][2];
    const size_t estep = (size_t)g.N * K * 2;
    const char* cA = (const char*)g.A + (GA ? (size_t)0 : (size_t)cur.pm * tstep); const char* cB = (const char*)g.Bt + (size_t)cur.e * estep + (size_t)cur.pn * tstep;
    S.a_ready(cur);
    if constexpr (GA) PG8_GOFF(cur, cvo0, cvo1);
    if constexpr (SP2) {
        PG8_STAGE(PG8_SB(0, 0), cB, voffB); PG8_STAGE(PG8_SB(0, 1), cB + hstep, voffB); PG8_STAGE_A(PG8_SA(0, 0), cA, 0, true); PG8_STAGE_A(PG8_SA(0, 1), cA, 1, true);
        if (wr == 1) PG8_BAR;
        PG8_WAIT_V(2); PG8_BAR;
        PG8_STAGE(PG8_SB(1, 0), cB + kstep, voffB); PG8_STAGE_A(PG8_SA(1, 0), cA + kstep, 0, true); PG8_STAGE(PG8_SB(1, 1), cB + hstep + kstep, voffB);
        PG8_WAIT_V(6); PG8_BAR;
    } else {
        PG8_STAGE(PG8_SB(0, 0), cB, voffB); PG8_STAGE(PG8_SA(0, 0), cA, voffA); PG8_STAGE(PG8_SB(0, 1), cB + hstep, voffB); PG8_STAGE(PG8_SA(0, 1), cA + hstep, voffA);
        if (wr == 1) PG8_BAR;
        PG8_WAIT_V(4); PG8_BAR;
        PG8_STAGE(PG8_SB(1, 0), cB + kstep, voffB); PG8_STAGE(PG8_SA(1, 0), cA + kstep, voffA); PG8_STAGE(PG8_SB(1, 1), cB + hstep + kstep, voffB);
        PG8_WAIT_V(6); PG8_BAR;
    }
    for (;;) {
        const bool has_next = S.next(ui + 1, nxt);
        const char* nA = has_next ? (const char*)g.A + (GA ? (size_t)0 : (size_t)nxt.pm * tstep) : cA;
        if constexpr (GA) { if (has_next) PG8_GOFF(nxt, nvo0, nvo1); else { nvo0[0] = cvo0[0]; nvo0[1] = cvo0[1]; nvo1[0] = cvo1[0]; nvo1[1] = cvo1[1]; } } const char* nB = has_next ? (const char*)g.Bt + (size_t)nxt.e * estep + (size_t)nxt.pn * tstep : cB;
        for (int t = 0; t < nt; t += 2) {
            const bool last = (t == nt - 2);
            const char* a1 = cA + (size_t)(t + 1) * kstep;
            const char* a2 = last ? nA : cA + (size_t)(t + 2) * kstep; const char* b2 = last ? nB : cB + (size_t)(t + 2) * kstep;
            const char* a3 = a2 + kstep; const char* b3 = b2 + kstep;
            if (last && has_next) S.a_ready(nxt);
            if constexpr (GA) { sel0[0] = last ? nvo0[0] : cvo0[0]; sel0[1] = last ? nvo0[1] : cvo0[1]; sel1[0] = last ? nvo1[0] : cvo1[0]; sel1[1] = last ? nvo1[1] : cvo1[1]; }
            if constexpr (Epi::HAS_MID) { if (t == nt / 2) E.mid(acc, cur, wr, wc, fr, fq); }
            if constexpr (SP2) {
            PG8_LDB(B0, 0, 0); PG8_LDB(B1, 0, 1); PG8_SCHED; PG8_LDA(At, 0, 0); PG8_STAGE_A(PG8_SA(1, 1), a1, 1, true);
            PG8_WAIT_V(8); PG8_WAIT_L(0); PG8_BAR; PG8_MMA(0, 0, At, B0); PG8_MMA(0, 1, At, B1); PG8_BAR; PG8_SCHED;
            PG8_LDA(At, 0, 1); PG8_STAGE(PG8_SB(0, 0), b2, voffB); PG8_STAGE(PG8_SB(0, 1), b2 + hstep, voffB); PG8_STAGE_A(PG8_SA(0, 0), a2, 0, false);
            PG8_WAIT_V(8); PG8_WAIT_L(0); PG8_BAR; PG8_MMA(1, 0, At, B0); PG8_MMA(1, 1, At, B1); PG8_BAR; PG8_SCHED;
            PG8_LDB(B0, 1, 0); PG8_LDB(B1, 1, 1); PG8_SCHED; PG8_LDA(At, 1, 0); PG8_STAGE_A(PG8_SA(0, 1), a2, 1, false);
            PG8_WAIT_V(8); PG8_WAIT_L(0); PG8_BAR; PG8_MMA(0, 0, At, B0); PG8_MMA(0, 1, At, B1); PG8_BAR; PG8_SCHED;
            PG8_LDA(At, 1, 1); PG8_STAGE(PG8_SB(1, 0), b3, voffB); PG8_STAGE(PG8_SB(1, 1), b3 + hstep, voffB); PG8_STAGE_A(PG8_SA(1, 0), a3, 0, false);
            PG8_WAIT_V(8); PG8_WAIT_L(0); PG8_BAR; PG8_MMA(1, 0, At, B0); PG8_MMA(1, 1, At, B1); PG8_BAR; PG8_SCHED;
            } else {
            PG8_LDB(B0, 0, 0); PG8_SCHED; PG8_LDA(At, 0, 0); PG8_STAGE(PG8_SA(1, 1), a1 + hstep, voffA);
            PG8_WAIT_L(8); PG8_BAR; PG8_WAIT_L(0); PG8_MMA(0, 0, At, B0); PG8_BAR; PG8_SCHED;
            PG8_LDB(B1, 0, 1); PG8_STAGE(PG8_SB(0, 0), b2, voffB);
            PG8_BAR; PG8_WAIT_L(0); PG8_MMA(0, 1, At, B1); PG8_BAR;
            PG8_LDA(At, 0, 1); PG8_STAGE(PG8_SA(0, 0), a2, voffA);
            PG8_BAR; PG8_WAIT_L(0); PG8_MMA(1, 0, At, B0); PG8_BAR; PG8_SCHED;
            PG8_STAGE(PG8_SB(0, 1), b2 + hstep, voffB);
            PG8_WAIT_V(6); PG8_BAR; PG8_MMA(1, 1, At, B1); PG8_BAR;
            PG8_LDB(B0, 1, 0); PG8_SCHED; PG8_LDA(At, 1, 0); PG8_STAGE(PG8_SA(0, 1), a2 + hstep, voffA);
            PG8_WAIT_L(8); PG8_BAR; PG8_WAIT_L(0); PG8_MMA(0, 0, At, B0); PG8_BAR; PG8_SCHED;
            PG8_LDB(B1, 1, 1); PG8_STAGE(PG8_SB(1, 0), b3, voffB);
            PG8_BAR; PG8_WAIT_L(0); PG8_MMA(0, 1, At, B1); PG8_BAR;
            PG8_LDA(At, 1, 1); PG8_STAGE(PG8_SA(1, 0), a3, voffA);
            PG8_BAR; PG8_WAIT_L(0); PG8_MMA(1, 0, At, B0); PG8_BAR; PG8_SCHED;
            PG8_STAGE(PG8_SB(1, 1), b3 + hstep, voffB);
            PG8_WAIT_V(6); PG8_BAR; PG8_MMA(1, 1, At, B1); PG8_BAR;
            }
        }
        if constexpr (ALIGN_EPI) { if (wr == 0) PG8_BAR; }
        if constexpr (!Epi::AFTER_DRAIN) { E(acc, cur, wr, wc, fr, fq); S.done(cur); }
        if (!has_next) break;
#pragma unroll
        for (int a = 0; a < 2; ++a)
#pragma unroll
            for (int b = 0; b < 2; ++b)
#pragma unroll
                for (int m = 0; m < 4; ++m)
#pragma unroll
                    for (int n = 0; n < 2; ++n) acc[a][b][m][n] = (f32x4){0.f, 0.f, 0.f, 0.f};
        cur = nxt; cA = nA; cB = nB; ++ui;
        if constexpr (GA) { cvo0[0] = nvo0[0]; cvo0[1] = nvo0[1]; cvo1[0] = nvo1[0]; cvo1[1] = nvo1[1]; }
        if constexpr (ALIGN_EPI) { if (wr == 1) PG8_BAR; }
    }
    PG8_WAIT_V(0);
    if constexpr (!ALIGN_EPI) { if (wr == 0) PG8_BAR; }
    PG8_BAR;
    if constexpr (Epi::AFTER_DRAIN) { E.fused(acc, cur, wr, wc, fr, fq, lds, wid, lane); S.done(cur); }
#undef PG8_SA
#undef PG8_SB
#undef PG8_STAGE
#undef PG8_STAGE_A
#undef PG8_GOFF
#undef PG8_LDA
#undef PG8_LDB
#undef PG8_MMA
#undef PG8_WAIT_V
#undef PG8_WAIT_L
#undef PG8_BAR
#undef PG8_SCHED
}
}

#ifndef DBG_CMP
#define DBG_CMP 0
#endif
#define LAS __attribute__((address_space(3)))
typedef unsigned short bf16_t;
typedef float f32x4 __attribute__((ext_vector_type(4)));
typedef unsigned u32x4 __attribute__((ext_vector_type(4)));
typedef unsigned u32x2 __attribute__((ext_vector_type(2)));
typedef unsigned long long u64;

constexpr int T_TOK = 16384, DMODEL = 2048, SEQL = 2048;
constexpr int NPROJ = 9984;
constexpr int C_QLAT = 0, C_CKV = 1024, C_QIDX = 1152, C_KIDX = 1664, C_WIDX = 1728, C_QR = 1792, C_KR = 2816, C_VR = 3840, C_GR = 4864, C_GBR = 5888;
constexpr int MAXSLOT = 40960;
constexpr float EPS_F = 1e-6f;
constexpr float IDX_SCALE = 0.04419417382415922f;
constexpr float ATT_SCALE = 0.08838834764831845f;
constexpr float K_SCALE = 0.08838834764831845f;

constexpr size_t WS_CTL = 0;
constexpr size_t WS_ROT = 65536;
constexpr size_t WS_WIN = WS_ROT + 1048576;
constexpr size_t WS_WCOMB = WS_WIN + (size_t)NPROJ * 2048 * 2;
constexpr size_t WS_WB = WS_WCOMB + (size_t)2048 * 1024 * 2;
constexpr size_t WS_WO = WS_WB + (size_t)2048 * 1024 * 2;
constexpr size_t WS_WGU = WS_WO + (size_t)2048 * 2048 * 2;
constexpr size_t WS_WD = WS_WGU + (size_t)32 * 2048 * 2048 * 2;
constexpr size_t WS_P = WS_WD + (size_t)32 * 2048 * 1024 * 2;
constexpr size_t WS_HMID = WS_P;
constexpr size_t WS_Y = WS_HMID + (size_t)MAXSLOT * 1024 * 2;
constexpr size_t WS_XN = WS_P + (size_t)T_TOK * NPROJ * 2;
constexpr size_t WS_OA = WS_XN + (size_t)T_TOK * 2048 * 2;
constexpr size_t WS_OB = WS_OA + (size_t)T_TOK * 1024 * 2;
constexpr size_t WS_MIXED = WS_OB + (size_t)T_TOK * 1024 * 2;
constexpr size_t WS_SPARE = WS_MIXED + (size_t)T_TOK * 2048 * 2;
constexpr size_t WS_XG = WS_OA;
constexpr size_t WS_KV = WS_SPARE + (size_t)T_TOK * 1024 * 2;
constexpr size_t WS_MASK = WS_KV + (size_t)T_TOK * 128 * 2;
constexpr size_t WS_MISC = WS_MASK + (size_t)T_TOK * 256;
constexpr size_t WS_WC = WS_MISC + 1048576;
constexpr size_t WS_END = WS_WC + 1048576;
static_assert(WS_Y + (size_t)MAXSLOT * 2048 * 2 <= WS_XN, "HMID + Y must fit in P");
static_assert(WS_XG + (size_t)MAXSLOT * 2048 * 2 <= WS_KV, "XG must fit in OA..SPARE");
static_assert(WS_END <= (size_t)1073741824, "workspace budget");
constexpr int MI_ROWTOK = 0, MI_ROWGATE = MAXSLOT, MI_TOKSLOT = 2 * MAXSLOT, MI_ASGE = MI_TOKSLOT + 2 * T_TOK, MI_ASGR = MI_ASGE + 2 * T_TOK, MI_ASGG = MI_ASGR + 2 * T_TOK;
static_assert((size_t)(MI_ASGG + 2 * T_TOK) * 4 <= 1048576, "misc budget");
constexpr int LDS_BYTES = 152 * 1024;
constexpr int LDS_MISC = 150 * 1024;

__device__ __forceinline__ float bflo(unsigned w) { return __uint_as_float(w << 16); }
__device__ __forceinline__ float bfhi(unsigned w) { return __uint_as_float(w & 0xffff0000u); }
__device__ __forceinline__ unsigned pkbf(float lo, float hi) { unsigned r; asm volatile("v_cvt_pk_bf16_f32 %0, %1, %2" : "=v"(r) : "v"(lo), "v"(hi)); return r; }
__device__ __forceinline__ int hide_i(int v) { asm volatile("" : "+v"(v)); return v; }
template <class Tp> __device__ __forceinline__ Tp* hide_p(Tp* q) { asm volatile("" : "+s"(q)); return q; }
__device__ __forceinline__ float shx(float v, int lane, int o) { return __int_as_float(__builtin_amdgcn_ds_bpermute((lane ^ o) << 2, __float_as_int(v))); }
__device__ __forceinline__ float wave_sum(float v, int lane) {
#pragma unroll
    for (int o = 1; o < 64; o <<= 1) v += shx(v, lane, o);
    return v;
}
__device__ __forceinline__ float wave_max(float v, int lane) {
#pragma unroll
    for (int o = 1; o < 64; o <<= 1) v = fmaxf(v, shx(v, lane, o));
    return v;
}
__device__ __forceinline__ float sigmoidf_(float x) { return __builtin_amdgcn_rcpf(1.0f + __expf(-x)); }
__device__ __forceinline__ float siluf_(float x) { return x * sigmoidf_(x); }
__device__ __forceinline__ float unkey(unsigned k) { return __uint_as_float((k & 0x80000000u) ? (k & 0x7fffffffu) : ~k); }
__device__ __forceinline__ int sbin(float s) { const int b = (int)(s * 32.0f + 128.0f); return b < 0 ? 0 : (b > 255 ? 255 : b); }
__device__ __forceinline__ unsigned fkey(float f) { const unsigned u = __float_as_uint(f + 0.0f); return (u & 0x80000000u) ? ~u : (u | 0x80000000u); }


#define XB_TMO      128
#define XB_XCNT(j)  (256  + 64 * (j))
#define XB_XSUB(j)  (1280 + 64 * (j))
#define XB_XGEN(j)  (2304 + 64 * (j))
#define XB_TOP      3328
#define XB_TOPGEN   3392
#define XCD_BAR_WORDS 3456
#define XB_SPIN_CAP (1u << 18)
__device__ __forceinline__ unsigned xb_ld(unsigned* p)              { return __hip_atomic_load(p, __ATOMIC_RELAXED, __HIP_MEMORY_SCOPE_AGENT); }
__device__ __forceinline__ unsigned xb_add(unsigned* p, unsigned v) { return __hip_atomic_fetch_add(p, v, __ATOMIC_RELAXED, __HIP_MEMORY_SCOPE_AGENT); }
__device__ __forceinline__ unsigned xb_xcc_id() { return (unsigned)__builtin_amdgcn_s_getreg((3 << 11) | 20) & 0xFu; }
#define XB_SPIN(cond, bar) do { unsigned _sp = 0; while (cond) { __builtin_amdgcn_s_sleep(1); \
    if ((++_sp & 255u) == 0u) { if (xb_ld(&(bar)[XB_TMO])) break; if (_sp > XB_SPIN_CAP) { atomicAdd(&(bar)[XB_TMO], 1u); break; } } } } while (0)
struct XcdBarrier { unsigned* bar; unsigned x; volatile __attribute__((address_space(3))) unsigned* st; };
__device__ __forceinline__ void xcd_barrier_complete(unsigned* bar, unsigned x, unsigned& nloc, unsigned& nx) {
    const unsigned G = gridDim.x * gridDim.y * gridDim.z;
    unsigned sum, cnt, mine, sp = 0u;
    for (;;) {
        sum = 0u; cnt = 0u; mine = 0u;
#pragma unroll
        for (unsigned j = 0; j < 16; ++j) { const unsigned c = xb_ld(&bar[XB_XCNT(j)]); sum += c; cnt += (c > 0u) ? 1u : 0u; mine = (j == x) ? c : mine; }
        if (sum == G) break;
        __builtin_amdgcn_s_sleep(1);
        if ((++sp & 255u) == 0u) { if (xb_ld(&bar[XB_TMO])) break; if (sp > XB_SPIN_CAP) { atomicAdd(&bar[XB_TMO], 1u); break; } }
    }
    nloc = mine > 0u ? mine : 1u; nx = cnt > 0u ? cnt : 1u;
}
__device__ __forceinline__ void xcd_barrier(const XcdBarrier& b, int tid) {
    asm volatile("s_waitcnt vmcnt(0)" ::: "memory");
    __syncthreads();
    if (tid == 0) {
        unsigned* bar = b.bar;
        __builtin_amdgcn_s_waitcnt(0);
        unsigned nloc = b.st[0], nx = b.st[1];
        if (nloc == 0u) { xcd_barrier_complete(bar, b.x, nloc, nx); b.st[0] = nloc; b.st[1] = nx; }
        const unsigned old = xb_add(&bar[XB_XSUB(b.x)], 1u);
        const unsigned gen = old / nloc;
        if (old + 1u == (gen + 1u) * nloc) {
            __builtin_amdgcn_fence(__ATOMIC_RELEASE, "agent");
            asm volatile("s_waitcnt vmcnt(0)" ::: "memory");
            const unsigned og = xb_add(&bar[XB_TOP], 1u);
            const unsigned tg = og / nx;
            if (og + 1u == (tg + 1u) * nx) xb_add(&bar[XB_TOPGEN], 1u);
            else XB_SPIN(xb_ld(&bar[XB_TOPGEN]) == tg, bar);
            __builtin_amdgcn_fence(__ATOMIC_ACQUIRE, "agent");
            xb_add(&bar[XB_XGEN(b.x)], 1u);
            asm volatile("s_waitcnt vmcnt(0)" ::: "memory");
        } else {
            XB_SPIN(xb_ld(&bar[XB_XGEN(b.x)]) == gen, bar);
            __builtin_amdgcn_fence(__ATOMIC_ACQUIRE, "agent");
            asm volatile("s_waitcnt vmcnt(0)" ::: "memory");
        }
    }
    __syncthreads();
}

namespace fa {
using bf16x8 = __attribute__((ext_vector_type(8))) short;
using s16x4  = __attribute__((ext_vector_type(4))) short;
using f32x16 = __attribute__((ext_vector_type(16))) float;
constexpr int TILE_B = 64 * 128 * 2;
constexpr int OFF_V = 0, OFF_K = 2 * TILE_B, OFF_M = 4 * TILE_B, OFF_WS = OFF_M + 2 * 256, OFF_Q = OFF_WS + 8 * 256, LDS_NEED = OFF_Q + 8 * 8704;
#define FA_GAS __attribute__((address_space(1)))
#define FA_KSWZ(row, colB) ((row) * 256 + ((colB) ^ (((row) & 7) << 4)))
#define FA_SBAR() __builtin_amdgcn_sched_barrier(0)
__device__ __forceinline__ int crow(int r, int hi) { return (r & 3) + 8 * (r >> 2) + 4 * hi; }
__device__ __forceinline__ int v_st(int k, int c) { const int kk = (k & ~0xC) | ((k & 4) << 1) | ((k & 8) >> 1); return ((kk >> 3) * 4 + (c >> 5)) * 512 + ((kk & 7) * 32 + (c & 31)) * 2; }
__device__ __forceinline__ int v_rd_base(int lane) { return ((lane & 3) << 3) | (((lane >> 2) & 3) << 6) | (((lane >> 4) & 1) << 5) | (((lane >> 5) & 1) << 8); }
constexpr int v_rd_off(int d0, int ks, int half) { return d0 * 512 + ks * 4096 + half * 2048; }
template <int OFF> __device__ __forceinline__ s16x4 tr_read(int vb) { s16x4 r; asm volatile("ds_read_b64_tr_b16 %0, %1 offset:%2" : "=&v"(r) : "v"(vb), "i"(OFF) : "memory"); return r; }
template <int D0> __device__ __forceinline__ void pv_one(f32x16& od, int vb, bf16x8 pa0, bf16x8 pa1, bf16x8 pa2, bf16x8 pa3) {
    const s16x4 l0 = tr_read<v_rd_off(D0, 0, 0)>(vb), h0 = tr_read<v_rd_off(D0, 0, 1)>(vb), l1 = tr_read<v_rd_off(D0, 1, 0)>(vb), h1 = tr_read<v_rd_off(D0, 1, 1)>(vb);
    const s16x4 l2 = tr_read<v_rd_off(D0, 2, 0)>(vb), h2 = tr_read<v_rd_off(D0, 2, 1)>(vb), l3 = tr_read<v_rd_off(D0, 3, 0)>(vb), h3 = tr_read<v_rd_off(D0, 3, 1)>(vb);
    asm volatile("s_waitcnt lgkmcnt(0)" ::: "memory"); FA_SBAR();
#define FA_PK(L, H) (bf16x8){L[0], L[1], L[2], L[3], H[0], H[1], H[2], H[3]}
    od = __builtin_amdgcn_mfma_f32_32x32x16_bf16(pa0, FA_PK(l0, h0), od, 0, 0, 0);
    od = __builtin_amdgcn_mfma_f32_32x32x16_bf16(pa1, FA_PK(l1, h1), od, 0, 0, 0);
    od = __builtin_amdgcn_mfma_f32_32x32x16_bf16(pa2, FA_PK(l2, h2), od, 0, 0, 0);
    od = __builtin_amdgcn_mfma_f32_32x32x16_bf16(pa3, FA_PK(l3, h3), od, 0, 0, 0);
#undef FA_PK
}
#define FA_RD8(D0, l0, h0, l1, h1, l2, h2, l3, h3) do { l0 = tr_read<v_rd_off(D0, 0, 0)>(vb); h0 = tr_read<v_rd_off(D0, 0, 1)>(vb); l1 = tr_read<v_rd_off(D0, 1, 0)>(vb); h1 = tr_read<v_rd_off(D0, 1, 1)>(vb); \
        l2 = tr_read<v_rd_off(D0, 2, 0)>(vb); h2 = tr_read<v_rd_off(D0, 2, 1)>(vb); l3 = tr_read<v_rd_off(D0, 3, 0)>(vb); h3 = tr_read<v_rd_off(D0, 3, 1)>(vb); } while (0)
#define FA_PK(L, H) (bf16x8){L[0], L[1], L[2], L[3], H[0], H[1], H[2], H[3]}
#define FA_MM4(od, l0, h0, l1, h1, l2, h2, l3, h3) do { od = __builtin_amdgcn_mfma_f32_32x32x16_bf16(pa0, FA_PK(l0, h0), od, 0, 0, 0); od = __builtin_amdgcn_mfma_f32_32x32x16_bf16(pa1, FA_PK(l1, h1), od, 0, 0, 0); \
        od = __builtin_amdgcn_mfma_f32_32x32x16_bf16(pa2, FA_PK(l2, h2), od, 0, 0, 0); od = __builtin_amdgcn_mfma_f32_32x32x16_bf16(pa3, FA_PK(l3, h3), od, 0, 0, 0); } while (0)
__device__ __forceinline__ void pv_all(f32x16 (&o)[4], int vb, bf16x8 pa0, bf16x8 pa1, bf16x8 pa2, bf16x8 pa3) {
    s16x4 a0, a1, a2, a3, a4, a5, a6, a7, b0, b1, b2, b3, b4, b5, b6, b7;
    FA_RD8(0, a0, a1, a2, a3, a4, a5, a6, a7);
    FA_RD8(1, b0, b1, b2, b3, b4, b5, b6, b7);
    asm volatile("s_waitcnt lgkmcnt(8)" ::: "memory"); FA_SBAR();
    FA_MM4(o[0], a0, a1, a2, a3, a4, a5, a6, a7); FA_SBAR();
    FA_RD8(2, a0, a1, a2, a3, a4, a5, a6, a7);
    asm volatile("s_waitcnt lgkmcnt(8)" ::: "memory"); FA_SBAR();
    FA_MM4(o[1], b0, b1, b2, b3, b4, b5, b6, b7); FA_SBAR();
    FA_RD8(3, b0, b1, b2, b3, b4, b5, b6, b7);
    asm volatile("s_waitcnt lgkmcnt(8)" ::: "memory"); FA_SBAR();
    FA_MM4(o[2], a0, a1, a2, a3, a4, a5, a6, a7); FA_SBAR();
    asm volatile("s_waitcnt lgkmcnt(0)" ::: "memory"); FA_SBAR();
    FA_MM4(o[3], b0, b1, b2, b3, b4, b5, b6, b7);
}
#undef FA_RD8
#undef FA_MM4
#undef FA_PK
template <bool QLDS>
__device__ __forceinline__ void qkt(f32x16& p0, f32x16& p1, const LAS char* Ks, const bf16x8 (&qr)[8], const LAS char* Ql, int r32, int hi) {
    p0 = f32x16{}; p1 = f32x16{};
#pragma unroll
    for (int d0 = 0; d0 < 8; ++d0) { const int cb = (d0 * 16 + hi * 8) * 2;
        const bf16x8 b0 = *(const LAS bf16x8*)(Ks + FA_KSWZ(r32, cb));
        const bf16x8 b1 = *(const LAS bf16x8*)(Ks + FA_KSWZ(32 + r32, cb));
        const bf16x8 q = QLDS ? *(const LAS bf16x8*)(Ql + d0 * 1024) : qr[d0];
        p0 = __builtin_amdgcn_mfma_f32_32x32x16_bf16(b0, q, p0, 0, 0, 0);
        p1 = __builtin_amdgcn_mfma_f32_32x32x16_bf16(b1, q, p1, 0, 0, 0); }
}
__device__ __forceinline__ void p_to_frag(const f32x16& p0, const f32x16& p1, bf16x8& pa0, bf16x8& pa1, bf16x8& pa2, bf16x8& pa3) {
#define FA_PK4(P, BASE, OUT) do { unsigned a0 = pkbf(P[BASE + 0], P[BASE + 1]), a1 = pkbf(P[BASE + 2], P[BASE + 3]);   \
    unsigned b0 = pkbf(P[BASE + 4], P[BASE + 5]), b1 = pkbf(P[BASE + 6], P[BASE + 7]);                              \
    auto r0 = __builtin_amdgcn_permlane32_swap(a0, b0, false, false); auto r1 = __builtin_amdgcn_permlane32_swap(a1, b1, false, false); \
    u32x4 w = {r0[0], r1[0], r0[1], r1[1]}; OUT = *reinterpret_cast<bf16x8*>(&w); } while (0)
    FA_PK4(p0, 0, pa0); FA_PK4(p0, 8, pa1); FA_PK4(p1, 0, pa2); FA_PK4(p1, 8, pa3);
#undef FA_PK4
}

struct UnitArgs {
    const bf16_t* Q; int ldq;
    const bf16_t* K; const bf16_t* V; int ldk;
    const u64* mask;
    int ntiles;
    int n0;
    float lgam;
};

template <int MODE, int EXP = 0>
__device__ __forceinline__ void unit_body(LAS char* L, const UnitArgs& U, int tid, f32x16 (&o)[4], float& l_out) {
    const int wid = __builtin_amdgcn_readfirstlane(tid >> 6), lane = tid & 63, r32 = lane & 31, hi = lane >> 5;
    LAS char* V_lds = L + OFF_V; LAS char* K_lds = L + OFF_K; LAS u64* M_lds = (LAS u64*)(L + OFF_M);
    LAS float* wsf = (LAS float*)(L + OFF_WS) + wid * 64; LAS float* al_l = wsf + 32;
    constexpr float C = ATT_SCALE * 1.4426950408889634f;
    float m_reg = -1e30f, l_reg = 0.f;
    bf16x8 qr[8];
    LAS char* Ql = L + OFF_Q + wid * 8192 + lane * 16;
    { const FA_GAS bf16_t* Qh = (const FA_GAS bf16_t*)hide_p(U.Q); const FA_GAS bf16_t* Qw = (MODE == 0) ? Qh + (size_t)r32 * U.ldq + wid * 128 + hi * 8 : Qh + (size_t)(wid * 32 + r32) * U.ldq + hi * 8;
#pragma unroll
      for (int d0 = 0; d0 < 8; ++d0) { qr[d0] = *(const FA_GAS bf16x8*)(Qw + d0 * 16); if (MODE == 1) *(LAS bf16x8*)(Ql + d0 * 1024) = qr[d0]; } }
    if (MODE == 1) { asm volatile("s_waitcnt vmcnt(0) lgkmcnt(0)" ::: "memory"); FA_SBAR(); }
    const int sr = tid >> 4, sc = (tid & 15) * 8, vst0 = v_st(sr, sc), vst1 = v_st(32 + sr, sc), kst0 = FA_KSWZ(sr, sc * 2), kst1 = FA_KSWZ(32 + sr, sc * 2);
    const FA_GAS char* Kh = (const FA_GAS char*)hide_p(U.K); const FA_GAS char* Vh = (const FA_GAS char*)hide_p(U.V);
    const int ldk_ = (EXP & 4) ? 128 : U.ldk;
    const unsigned goff0 = (unsigned)(sr * ldk_ + sc) * 2u, goff1 = (unsigned)((32 + sr) * ldk_ + sc) * 2u;
    const int vb0 = (int)(unsigned)(size_t)V_lds + v_rd_base(lane);
    bf16x8 ksA0, ksA1, vsA0, vsA1; u64 mwA = 0ull; unsigned pf_ = 0u;
#define FA_SLOAD(S, k0) do { const FA_GAS char* kb_ = Kh + (size_t)(k0) * ldk_ * 2; const FA_GAS char* vb_ = Vh + (size_t)(k0) * ldk_ * 2;     \
        ks##S##0 = *(const FA_GAS bf16x8*)(kb_ + goff0); ks##S##1 = *(const FA_GAS bf16x8*)(kb_ + goff1); \
        if (MODE == 1) { if (EXP & 2) { vs##S##0 = ks##S##0; vs##S##1 = ks##S##1; } else { vs##S##0 = *(const FA_GAS bf16x8*)(vb_ + goff0); vs##S##1 = *(const FA_GAS bf16x8*)(vb_ + goff1); } } \
        if (MODE == 0 && tid < 32) mw##S = U.mask[(size_t)tid * 32 + ((k0) >> 6)]; } while (0)
#define FA_SWRITE(S, b) do { *(LAS bf16x8*)(K_lds + (b) * TILE_B + kst0) = ks##S##0; *(LAS bf16x8*)(K_lds + (b) * TILE_B + kst1) = ks##S##1; \
        *(LAS bf16x8*)(V_lds + (b) * TILE_B + vst0) = (MODE == 1) ? vs##S##0 : ks##S##0; *(LAS bf16x8*)(V_lds + (b) * TILE_B + vst1) = (MODE == 1) ? vs##S##1 : ks##S##1; \
        if (MODE == 0 && tid < 32) M_lds[(b) * 32 + tid] = mw##S; } while (0)
#define FA_TOUCH(k0) do { if (MODE == 1 && !(EXP & 16) && tid < 256) { const FA_GAS char* tb_ = ((tid < 128) ? Kh : Vh) + (size_t)((k0) + ((tid & 127) >> 1)) * ldk_ * 2 + (tid & 1) * 128; \
        asm volatile("global_load_dword %0, %1, off" : "=v"(pf_) : "v"(tb_) : "memory"); } } while (0)
#define FA_TILE(j, b) do { \
        f32x16 p0, p1; bf16x8 pa0, pa1, pa2, pa3; \
        { const LAS char* qb_ = Ql; asm volatile("" : "+v"(qb_)); qkt<MODE == 1>(p0, p1, K_lds + (b) * TILE_B, qr, qb_, r32, hi); } \
        if (MODE == 0) { \
            const u64 mw = M_lds[(b) * 32 + r32] >> (4 * hi); \
            const unsigned mlo = (unsigned)mw, mhi = (unsigned)(mw >> 32); \
            _Pragma("unroll") for (int r = 0; r < 16; ++r) { const unsigned bit = 1u << ((r & 3) + 8 * (r >> 2)); p0[r] = (mlo & bit) ? p0[r] : -INFINITY; p1[r] = (mhi & bit) ? p1[r] : -INFINITY; } \
            float pmax = p0[0]; \
            _Pragma("unroll") for (int r = 1; r < 16; ++r) pmax = fmaxf(pmax, p0[r]); \
            _Pragma("unroll") for (int r = 0; r < 16; ++r) pmax = fmaxf(pmax, p1[r]); \
            { auto rr = __builtin_amdgcn_permlane32_swap(__float_as_uint(pmax), __float_as_uint(pmax), false, false); pmax = fmaxf(__uint_as_float(rr[0]), __uint_as_float(rr[1])); } \
            const float mn = fmaxf(m_reg, pmax); const float alpha = __builtin_amdgcn_exp2f((m_reg - mn) * C); m_reg = mn; \
            const float mnC = -mn * C; float ps = 0.f; \
            _Pragma("unroll") for (int r = 0; r < 16; ++r) { p0[r] = __builtin_amdgcn_exp2f(fmaf(p0[r], C, mnC)); p1[r] = __builtin_amdgcn_exp2f(fmaf(p1[r], C, mnC)); ps += p0[r] + p1[r]; } \
            { auto rr = __builtin_amdgcn_permlane32_swap(__float_as_uint(ps), __float_as_uint(ps), false, false); ps = __uint_as_float(rr[0]) + __uint_as_float(rr[1]); } \
            l_reg = l_reg * alpha + ps; \
            if (__any(alpha < 1.f)) { \
                if (hi == 0) al_l[r32] = alpha; \
                asm volatile("s_waitcnt lgkmcnt(0)" ::: "memory"); \
                _Pragma("unroll") for (int r = 0; r < 16; ++r) { const float a_ = al_l[crow(r, hi)]; \
                    _Pragma("unroll") for (int d = 0; d < 4; ++d) o[d][r] *= a_; } \
            } \
        } else if (!(EXP & 1)) { \
            const int dn = U.n0 + wid * 32 + r32 - (j) * 64 - 4 * hi; \
            const float base = (float)dn * U.lgam; \
            _Pragma("unroll") for (int r = 0; r < 16; ++r) { const int kk = (r & 3) + 8 * (r >> 2); \
                const float f0 = __builtin_amdgcn_exp2f(base - (float)kk * U.lgam), f1 = __builtin_amdgcn_exp2f(base - (float)(kk + 32) * U.lgam); \
                p0[r] = (dn >= kk) ? p0[r] * f0 : 0.f; p1[r] = (dn >= kk + 32) ? p1[r] * f1 : 0.f; } \
        } \
        p_to_frag(p0, p1, pa0, pa1, pa2, pa3); \
        FA_SBAR(); \
        { const int vb = vb0 + (b) * TILE_B; \
          pv_all(o, vb, pa0, pa1, pa2, pa3); } \
    } while (0)
    const int NT = U.ntiles;
    FA_SLOAD(A, 0); FA_SWRITE(A, 0);
    if (NT > 1) { FA_SLOAD(A, 64); FA_SWRITE(A, 1); }
    if (NT > 2) FA_TOUCH(128);
    if (NT > 3) FA_TOUCH(192);
    __syncthreads();
#pragma unroll
    for (int d = 0; d < 4; ++d) o[d] = f32x16{};
#pragma unroll 1
    for (int j = 0; j < NT; ++j) {
        const int b = j & 1;
        if (j + 2 < NT) FA_SLOAD(A, (j + 2) * 64);
        if (j + 4 < NT) FA_TOUCH((j + 4) * 64);
        FA_TILE(j, b);
        __syncthreads();
        if (j + 2 < NT) FA_SWRITE(A, b);
        asm volatile("" :: "v"(pf_));
    }
    asm volatile("s_waitcnt vmcnt(0)" ::: "memory");
    __syncthreads();
    l_out = l_reg;
#undef FA_SLOAD
#undef FA_SWRITE
#undef FA_TILE
}

template <int MODE>
__device__ __forceinline__ void unit_body2(LAS char* L, const UnitArgs& U, int tid, f32x16 (&o)[4], float& l_out) {
    const int wid = __builtin_amdgcn_readfirstlane(tid >> 6), lane = tid & 63, r32 = lane & 31, hi = lane >> 5;
    LAS char* V_lds = L + OFF_V; LAS char* K_lds = L + OFF_K; LAS u64* M_lds = (LAS u64*)(L + OFF_M);
    LAS float* wsf = (LAS float*)(L + OFF_WS) + wid * 64; LAS float* al_l = wsf + 32;
    constexpr float C = ATT_SCALE * 1.4426950408889634f;
    constexpr float THR = 8.0f;
    float m_reg = -1e30f, l_reg = 0.f;
    bf16x8 qr[8];
    LAS char* Ql = L + OFF_Q + wid * 8192 + lane * 16;
    { const FA_GAS bf16_t* Qh = (const FA_GAS bf16_t*)hide_p(U.Q); const FA_GAS bf16_t* Qw = (MODE == 0) ? Qh + (size_t)r32 * U.ldq + wid * 128 + hi * 8 : Qh + (size_t)(wid * 32 + r32) * U.ldq + hi * 8;
#pragma unroll
      for (int d0 = 0; d0 < 8; ++d0) { qr[d0] = *(const FA_GAS bf16x8*)(Qw + d0 * 16); if (MODE == 1) *(LAS bf16x8*)(Ql + d0 * 1024) = qr[d0]; } }
    if (MODE == 1) { asm volatile("s_waitcnt vmcnt(0) lgkmcnt(0)" ::: "memory"); FA_SBAR(); }
    const int sr = tid >> 4, sc = (tid & 15) * 8;
    const FA_GAS char* Kh = (const FA_GAS char*)hide_p(U.K); const FA_GAS char* Vh = (const FA_GAS char*)hide_p(U.V);
    const unsigned goff0 = (unsigned)(sr * U.ldk + sc) * 2u, goff1 = (unsigned)((32 + sr) * U.ldk + sc) * 2u;
    const int vb0 = (int)(unsigned)(size_t)V_lds + v_rd_base(lane);
    bf16x8 ksE0, ksE1, vsE0, vsE1; u64 mwE = 0ull; unsigned pf_ = 0u;
#define F2_TOUCH(k0) do { if (MODE == 1 && tid < 256) { const FA_GAS char* tb_ = ((tid < 128) ? Kh : Vh) + (size_t)((k0) + ((tid & 127) >> 1)) * U.ldk * 2 + (tid & 1) * 128; \
        asm volatile("global_load_dword %0, %1, off" : "=v"(pf_) : "v"(tb_) : "memory"); } } while (0)
#define F2_SLOAD(S, k0) do { const FA_GAS char* kb_ = Kh + (size_t)(k0) * U.ldk * 2; const FA_GAS char* vb_ = Vh + (size_t)(k0) * U.ldk * 2; \
        ks##S##0 = *(const FA_GAS bf16x8*)(kb_ + goff0); ks##S##1 = *(const FA_GAS bf16x8*)(kb_ + goff1); \
        if (MODE == 1) { vs##S##0 = *(const FA_GAS bf16x8*)(vb_ + goff0); vs##S##1 = *(const FA_GAS bf16x8*)(vb_ + goff1); } \
        if (MODE == 0 && tid < 32) mw##S = U.mask[(size_t)tid * 32 + ((k0) >> 6)]; } while (0)
#define F2_SWRITE(S, b) do { const int t_ = hide_i(tid), sr_ = t_ >> 4, sc_ = (t_ & 15) * 8; const int vst0 = v_st(sr_, sc_), vst1 = v_st(32 + sr_, sc_), kst0 = FA_KSWZ(sr_, sc_ * 2), kst1 = FA_KSWZ(32 + sr_, sc_ * 2);     \
        *(LAS bf16x8*)(K_lds + (b) * TILE_B + kst0) = ks##S##0; *(LAS bf16x8*)(K_lds + (b) * TILE_B + kst1) = ks##S##1; \
        *(LAS bf16x8*)(V_lds + (b) * TILE_B + vst0) = (MODE == 1) ? vs##S##0 : ks##S##0; *(LAS bf16x8*)(V_lds + (b) * TILE_B + vst1) = (MODE == 1) ? vs##S##1 : ks##S##1; \
        if (MODE == 0 && tid < 32) M_lds[(b) * 32 + tid] = mw##S; } while (0)
#define F2_PARTIAL(P0, P1, j, b, MN, AL) do { \
        if (MODE == 0) { \
            const u64 mw = M_lds[(b) * 32 + r32] >> (4 * hi); const unsigned mlo = (unsigned)mw, mhi = (unsigned)(mw >> 32); \
            _Pragma("unroll") for (int r = 0; r < 16; ++r) { const unsigned bit = 1u << ((r & 3) + 8 * (r >> 2)); P0[r] = (mlo & bit) ? P0[r] : -INFINITY; P1[r] = (mhi & bit) ? P1[r] : -INFINITY; } \
            float pmax = P0[0]; \
            _Pragma("unroll") for (int r = 1; r < 16; ++r) pmax = fmaxf(pmax, P0[r]); \
            _Pragma("unroll") for (int r = 0; r < 16; ++r) pmax = fmaxf(pmax, P1[r]); \
            { auto rr = __builtin_amdgcn_permlane32_swap(__float_as_uint(pmax), __float_as_uint(pmax), false, false); pmax = fmaxf(__uint_as_float(rr[0]), __uint_as_float(rr[1])); } \
            if (__builtin_expect(__all(pmax - m_reg <= THR / ATT_SCALE), 1)) { MN = m_reg; AL = 1.f; } \
            else { MN = fmaxf(m_reg, pmax); AL = __builtin_amdgcn_exp2f((m_reg - MN) * C); m_reg = MN; } \
            const float mnC = -MN * C; \
            _Pragma("unroll") for (int r = 0; r < 16; ++r) { P0[r] = fmaf(P0[r], C, mnC); P1[r] = fmaf(P1[r], C, mnC); } \
            _Pragma("unroll") for (int r = 0; r < 16; ++r) P0[r] = __builtin_amdgcn_exp2f(P0[r]); \
        } else { \
            const int dn = U.n0 + wid * 32 + r32 - (j) * 64 - 4 * hi; const float base = (float)dn * U.lgam; \
            _Pragma("unroll") for (int r = 0; r < 16; ++r) { const int kk = (r & 3) + 8 * (r >> 2); \
                const float f0 = __builtin_amdgcn_exp2f(base - (float)kk * U.lgam); P0[r] = (dn >= kk) ? P0[r] * f0 : 0.f; } \
        } } while (0)
#define F2_FINISH(P0, P1, j, AL) do { \
        if (MODE == 0) { \
            _Pragma("unroll") for (int r = 0; r < 16; ++r) P1[r] = __builtin_amdgcn_exp2f(P1[r]); \
            float ps = 0.f; \
            _Pragma("unroll") for (int r = 0; r < 16; ++r) ps += P0[r] + P1[r]; \
            { auto rr = __builtin_amdgcn_permlane32_swap(__float_as_uint(ps), __float_as_uint(ps), false, false); ps = __uint_as_float(rr[0]) + __uint_as_float(rr[1]); } \
            l_reg = l_reg * AL + ps; \
        } else { \
            const int dn = U.n0 + wid * 32 + r32 - (j) * 64 - 4 * hi; const float base = (float)dn * U.lgam; \
            _Pragma("unroll") for (int r = 0; r < 16; ++r) { const int kk = (r & 3) + 8 * (r >> 2); \
                const float f1 = __builtin_amdgcn_exp2f(base - (float)(kk + 32) * U.lgam); P1[r] = (dn >= kk + 32) ? P1[r] * f1 : 0.f; } \
        } \
        p_to_frag(P0, P1, pa0, pa1, pa2, pa3); } while (0)
#define F2_RESC(AL) do { if (MODE == 0) { if (__any((AL) < 1.f)) { if (hi == 0) al_l[r32] = (AL); asm volatile("s_waitcnt lgkmcnt(0)" ::: "memory"); \
        _Pragma("unroll") for (int r = 0; r < 16; ++r) { const float a_ = al_l[crow(r, hi)]; _Pragma("unroll") for (int d = 0; d < 4; ++d) o[d][r] *= a_; } } } } while (0)
#define F2_QKT(P0, P1, b) do { const LAS char* qb_ = Ql; asm volatile("" : "+v"(qb_)); qkt<MODE == 1>(P0, P1, K_lds + (b) * TILE_B, qr, qb_, r32, hi); } while (0)
#define PV1(vb_) do { const int v_ = (vb_); pv_one<0>(o[0], v_, pa0, pa1, pa2, pa3); pv_one<1>(o[1], v_, pa0, pa1, pa2, pa3); pv_one<2>(o[2], v_, pa0, pa1, pa2, pa3); pv_one<3>(o[3], v_, pa0, pa1, pa2, pa3); } while (0)
    f32x16 pA0, pA1, pB0, pB1; float mnA = 0.f, mnB = 0.f, alA = 1.f, alB = 1.f; bf16x8 pa0, pa1, pa2, pa3; const int NT = U.ntiles;
    (void)mnA; (void)mnB;
    F2_SLOAD(E, 0); F2_SWRITE(E, 0); __syncthreads();
#pragma unroll
    for (int d = 0; d < 4; ++d) o[d] = f32x16{};
    F2_QKT(pA0, pA1, 0); F2_PARTIAL(pA0, pA1, 0, 0, mnA, alA);
    F2_SLOAD(E, 64); if (2 < NT) F2_TOUCH(128); if (3 < NT) F2_TOUCH(192);
    F2_SWRITE(E, 1); __syncthreads();
#pragma unroll 1
    for (int j = 1; j + 1 < NT; j += 2) {
        FA_SBAR(); F2_QKT(pB0, pB1, 1);
        F2_FINISH(pA0, pA1, j - 1, alA); FA_SBAR();
        F2_SLOAD(E, (j + 1) * 64); if (j + 3 < NT) F2_TOUCH((j + 3) * 64); FA_SBAR();
        PV1(vb0); F2_PARTIAL(pB0, pB1, j, 1, mnB, alB);
        __syncthreads(); F2_SWRITE(E, 0); asm volatile("" :: "v"(pf_));
        F2_RESC(alB); __syncthreads();
        FA_SBAR(); F2_QKT(pA0, pA1, 0);
        F2_FINISH(pB0, pB1, j, alB); FA_SBAR();
        if (j + 2 < NT) F2_SLOAD(E, (j + 2) * 64); if (j + 4 < NT) F2_TOUCH((j + 4) * 64); FA_SBAR();
        PV1(vb0 + TILE_B); F2_PARTIAL(pA0, pA1, j + 1, 0, mnA, alA);
        __syncthreads(); if (j + 2 < NT) F2_SWRITE(E, 1); asm volatile("" :: "v"(pf_));
        F2_RESC(alA); __syncthreads();
    }
    FA_SBAR(); F2_QKT(pB0, pB1, 1);
    F2_FINISH(pA0, pA1, NT - 2, alA); FA_SBAR();
    PV1(vb0); F2_PARTIAL(pB0, pB1, NT - 1, 1, mnB, alB);
    __syncthreads(); F2_RESC(alB);
    F2_FINISH(pB0, pB1, NT - 1, alB); FA_SBAR();
    PV1(vb0 + TILE_B);
    asm volatile("s_waitcnt vmcnt(0)" ::: "memory");
    __syncthreads();
    l_out = l_reg;
#undef F2_SLOAD
#undef F2_SWRITE
#undef F2_PARTIAL
#undef F2_FINISH
#undef F2_RESC
#undef F2_QKT
#undef F2_TOUCH
#undef PV1
}
}

namespace pg8 {
struct EpiProj {
    static constexpr bool PERM = true, AFTER_DRAIN = false, HAS_MID = false;
    bf16_t* P; const float* rot;
    __device__ __forceinline__ void operator()(const f32x4 (&acc)[2][2][4][2], const Unit& u, int wr, int wc, int fr, int fq) const {
        const int row0 = u.pm * BM + wr * 64 + fr, colb = u.pn * BM + wc * 32 + 8 * fq;
        const bool rotq = (u.pn >= 7) && (u.pn < 15);
        const float ksc = (u.pn >= 11) ? K_SCALE : 1.0f;
        const int i0 = 16 * wc + 4 * fq;
#pragma unroll
        for (int ai = 0; ai < 2; ++ai)
#pragma unroll
            for (int m = 0; m < 4; ++m) {
                const int row = row0 + ai * HALF + m * 16; const int pos = row & (SEQL - 1);
                bf16_t* rowp = P + (size_t)row * NPROJ + colb;
                f32x4 r0 = (f32x4){1.f, 0.f, 1.f, 0.f}, r1 = r0;
                if (rotq) { const f32x4* rt = (const f32x4*)(rot + ((size_t)pos * 64 + i0) * 2); r0 = rt[0]; r1 = rt[1]; }
#pragma unroll
                for (int bj = 0; bj < 2; ++bj) {
                    f32x4 v0 = acc[ai][bj][m][0], v1 = acc[ai][bj][m][1];
                    if (rotq) {
                        f32x4 w0, w1;
                        w0[0] = (v0[0] * r0[0] - v0[1] * r0[1]) * ksc; w0[1] = (v0[0] * r0[1] + v0[1] * r0[0]) * ksc;
                        w0[2] = (v0[2] * r0[2] - v0[3] * r0[3]) * ksc; w0[3] = (v0[2] * r0[3] + v0[3] * r0[2]) * ksc;
                        w1[0] = (v1[0] * r1[0] - v1[1] * r1[1]) * ksc; w1[1] = (v1[0] * r1[1] + v1[1] * r1[0]) * ksc;
                        w1[2] = (v1[2] * r1[2] - v1[3] * r1[3]) * ksc; w1[3] = (v1[2] * r1[3] + v1[3] * r1[2]) * ksc;
                        v0 = w0; v1 = w1;
                    }
                    u32x4 w; w.x = pkbf(v0[0], v0[1]); w.y = pkbf(v0[2], v0[3]); w.z = pkbf(v1[0], v1[1]); w.w = pkbf(v1[2], v1[3]);
                    *(u32x4*)(rowp + bj * HALF) = w;
                }
            }
    }
};
struct EpiMergeF {
    static constexpr bool PERM = true, AFTER_DRAIN = false, HAS_MID = true;
    const bf16_t* P; bf16_t* O;
    static __device__ __forceinline__ float cl(float x) { return fminf(fmaxf(x, -30.f), 30.f); }
    static __device__ __forceinline__ float ratio(float a, float b) { return (1.0f + __expf(-cl(b))) * __builtin_amdgcn_rcpf(1.0f + __expf(-cl(a))); }
    __device__ __forceinline__ void mid(f32x4 (&acc)[2][2][4][2], const Unit& u, int wr, int wc, int fr, int fq) const {
        const int row0 = hide_i(u.pm * BM + wr * 64 + fr), colb = hide_i(u.pn * BM + wc * 32 + 8 * fq);
        __builtin_amdgcn_sched_barrier(0);
#pragma unroll
        for (int ai = 0; ai < 2; ++ai) {
            u32x4 g0[4][2], g1[4][2];
#pragma unroll
            for (int m = 0; m < 4; ++m)
#pragma unroll
                for (int bj = 0; bj < 2; ++bj) { const bf16_t* gp = P + (size_t)(row0 + ai * HALF + m * 16) * NPROJ + C_GBR + colb + bj * HALF; g0[m][bj] = *(const u32x4*)gp; g1[m][bj] = *(const u32x4*)(gp + DMODEL); }
            __builtin_amdgcn_sched_barrier(0);
#pragma unroll
            for (int m = 0; m < 4; ++m)
#pragma unroll
                for (int bj = 0; bj < 2; ++bj) {
                    const u32x4 a_ = g0[m][bj], b_ = g1[m][bj]; f32x4 r0, r1;
                    r0[0] = ratio(bflo(a_.x), bflo(b_.x)); r0[1] = ratio(bfhi(a_.x), bfhi(b_.x)); r0[2] = ratio(bflo(a_.y), bflo(b_.y)); r0[3] = ratio(bfhi(a_.y), bfhi(b_.y));
                    r1[0] = ratio(bflo(a_.z), bflo(b_.z)); r1[1] = ratio(bfhi(a_.z), bfhi(b_.z)); r1[2] = ratio(bflo(a_.w), bflo(b_.w)); r1[3] = ratio(bfhi(a_.w), bfhi(b_.w));
                    acc[ai][bj][m][0] = acc[ai][bj][m][0] * r0; acc[ai][bj][m][1] = acc[ai][bj][m][1] * r1;
                }
            __builtin_amdgcn_sched_barrier(0);
        }
    }
    __device__ __forceinline__ void operator()(const f32x4 (&acc)[2][2][4][2], const Unit& u, int wr, int wc, int fr, int fq) const {
        const int row0 = u.pm * BM + wr * 64 + fr, colb = u.pn * BM + wc * 32 + 8 * fq;
#pragma unroll
        for (int ai = 0; ai < 2; ++ai) {
            u32x4 gg[4][2];
#pragma unroll
            for (int m = 0; m < 4; ++m)
#pragma unroll
                for (int bj = 0; bj < 2; ++bj) gg[m][bj] = *(const u32x4*)(P + (size_t)(row0 + ai * HALF + m * 16) * NPROJ + C_GBR + DMODEL + colb + bj * HALF);
            __builtin_amdgcn_sched_barrier(0);
#pragma unroll
            for (int m = 0; m < 4; ++m) {
                const int row = row0 + ai * HALF + m * 16;
#pragma unroll
                for (int bj = 0; bj < 2; ++bj) {
                    const int col = colb + bj * HALF;
                    const u32x4 g = gg[m][bj];
                    const f32x4 v0 = acc[ai][bj][m][0], v1 = acc[ai][bj][m][1];
                    float o[8];
                    o[0] = sigmoidf_(cl(bflo(g.x))) * v0[0]; o[1] = sigmoidf_(cl(bfhi(g.x))) * v0[1]; o[2] = sigmoidf_(cl(bflo(g.y))) * v0[2]; o[3] = sigmoidf_(cl(bfhi(g.y))) * v0[3];
                    o[4] = sigmoidf_(cl(bflo(g.z))) * v1[0]; o[5] = sigmoidf_(cl(bfhi(g.z))) * v1[1]; o[6] = sigmoidf_(cl(bflo(g.w))) * v1[2]; o[7] = sigmoidf_(cl(bfhi(g.w))) * v1[3];
                    u32x4 w; w.x = pkbf(o[0], o[1]); w.y = pkbf(o[2], o[3]); w.z = pkbf(o[4], o[5]); w.w = pkbf(o[6], o[7]);
                    *(u32x4*)(O + (size_t)row * DMODEL + col) = w;
                }
            }
        }
    }
};
struct EpiRes {
    static constexpr bool PERM = false, AFTER_DRAIN = false, HAS_MID = false;
    const float* X; float* O;
    __device__ __forceinline__ void operator()(const f32x4 (&acc)[2][2][4][2], const Unit& u, int wr, int wc, int fr, int fq) const {
        const int row0 = u.pm * BM + wr * 64 + fr, col0 = u.pn * BM + wc * 32 + 4 * fq;
#pragma unroll
        for (int ai = 0; ai < 2; ++ai) {
            f32x4 xv[4][2][2];
#pragma unroll
            for (int m = 0; m < 4; ++m) { const size_t off = (size_t)(row0 + ai * HALF + m * 16) * DMODEL + col0;
#pragma unroll
                for (int bj = 0; bj < 2; ++bj)
#pragma unroll
                    for (int n = 0; n < 2; ++n) xv[m][bj][n] = *(const f32x4*)(X + off + bj * HALF + n * 16); }
            __builtin_amdgcn_sched_barrier(0);
#pragma unroll
            for (int m = 0; m < 4; ++m) { const size_t off = (size_t)(row0 + ai * HALF + m * 16) * DMODEL + col0;
#pragma unroll
                for (int bj = 0; bj < 2; ++bj)
#pragma unroll
                    for (int n = 0; n < 2; ++n) *(f32x4*)(O + off + bj * HALF + n * 16) = xv[m][bj][n] + acc[ai][bj][m][n]; }
            __builtin_amdgcn_sched_barrier(0);
        }
    }
};
struct EpiNull {
    static constexpr bool PERM = true, AFTER_DRAIN = false, HAS_MID = false;
    float* O;
    __device__ __forceinline__ void operator()(const f32x4 (&acc)[2][2][4][2], const Unit& u, int wr, int wc, int fr, int fq) const {
        f32x4 t = (f32x4){0.f, 0.f, 0.f, 0.f};
#pragma unroll
        for (int ai = 0; ai < 2; ++ai)
#pragma unroll
            for (int bj = 0; bj < 2; ++bj)
#pragma unroll
                for (int m = 0; m < 4; ++m) { t += acc[ai][bj][m][0]; t += acc[ai][bj][m][1]; }
        O[(size_t)(u.pm * 8 + u.pn) * 512 + (wr * 4 + wc) * 64 + fr + 16 * fq] = (t[0] + t[1]) + (t[2] + t[3]);
    }
};
struct EpiSwiglu {
    static constexpr bool PERM = true, AFTER_DRAIN = false, HAS_MID = false;
    bf16_t* H; const float* rs;
    __device__ __forceinline__ void operator()(const f32x4 (&acc)[2][2][4][2], const Unit& u, int wr, int wc, int fr, int fq) const {
        const int row0 = u.pm * BM + wr * 64 + fr, col = u.pn * HALF + wc * 32 + 8 * fq;
#pragma unroll
        for (int ai = 0; ai < 2; ++ai)
#pragma unroll
            for (int m = 0; m < 4; ++m) {
                const int row = row0 + ai * HALF + m * 16; const float r_ = rs[row];
                const f32x4 g0 = acc[ai][0][m][0] * r_, g1 = acc[ai][0][m][1] * r_, u0 = acc[ai][1][m][0] * r_, u1 = acc[ai][1][m][1] * r_;
                u32x4 w; w.x = pkbf(siluf_(g0[0]) * u0[0], siluf_(g0[1]) * u0[1]); w.y = pkbf(siluf_(g0[2]) * u0[2], siluf_(g0[3]) * u0[3]);
                w.z = pkbf(siluf_(g1[0]) * u1[0], siluf_(g1[1]) * u1[1]); w.w = pkbf(siluf_(g1[2]) * u1[2], siluf_(g1[3]) * u1[3]);
                *(u32x4*)(H + (size_t)row * 1024 + col) = w;
            }
    }
};
struct EpiDown {
    static constexpr bool PERM = true, AFTER_DRAIN = false, HAS_MID = false;
    bf16_t* Y; const float* rg;
    __device__ __forceinline__ void operator()(const f32x4 (&acc)[2][2][4][2], const Unit& u, int wr, int wc, int fr, int fq) const {
        const int row0 = u.pm * BM + wr * 64 + fr, colb = u.pn * BM + wc * 32 + 8 * fq;
#pragma unroll
        for (int ai = 0; ai < 2; ++ai)
#pragma unroll
            for (int m = 0; m < 4; ++m) {
                const int row = row0 + ai * HALF + m * 16; const float gt = rg[row];
#pragma unroll
                for (int bj = 0; bj < 2; ++bj) {
                    const f32x4 v0 = acc[ai][bj][m][0] * gt, v1 = acc[ai][bj][m][1] * gt;
                    u32x4 w; w.x = pkbf(v0[0], v0[1]); w.y = pkbf(v0[2], v0[3]); w.z = pkbf(v1[0], v1[1]); w.w = pkbf(v1[2], v1[3]);
                    *(u32x4*)(Y + (size_t)row * DMODEL + colb + bj * HALF) = w;
                }
            }
    }
};
template <bool GATHER_> struct ExpertOrderT {
    static constexpr bool GATHER = GATHER_;
    const LAS int* ts; int G, c; const int* rtok;
    __device__ __forceinline__ unsigned rowoff(int slot) const { return GATHER_ ? (unsigned)rtok[slot] : 0u; }
    __device__ __forceinline__ bool next(int i, Unit& u) const {
        const int L = i * G + c; const int total = ts[32] * 8; if (L >= total) return false;
        const int gt = L >> 3; u.pm = gt; u.pn = L & 7; int e = 0;
        for (int k = 1; k < 32; ++k) e += (gt >= ts[k]) ? 1 : 0;
        u.e = e; return true;
    }
    __device__ __forceinline__ void a_ready(const Unit&) const {}
    __device__ __forceinline__ void done(const Unit&) const {}
};
}

struct MapId { __device__ __forceinline__ int operator()(int n) const { return n; } };
struct MapGate { __device__ __forceinline__ int operator()(int f) const { return ((f >> 7) << 8) + (f & 127); } };
struct MapUp { __device__ __forceinline__ int operator()(int f) const { return ((f >> 7) << 8) + 128 + (f & 127); } };
struct MapProj {
    __device__ __forceinline__ int operator()(int n) const {
        if (n < 1736) return n;
        if (n < 2760) { const int l = n - 1736, d = l & 127; return C_QR + (l & ~127) + ((d & 63) << 1) + (d >> 6); }
        if (n < 3784) { const int l = n - 2760, d = l & 127; return C_KR + (l & ~127) + ((d & 63) << 1) + (d >> 6); }
        if (n < 4808) return C_VR + (n - 3784);
        if (n < 5832) return C_GR + (n - 4808);
        return C_GBR + (n - 5832);
    }
};
template <class RowMap>
__device__ __forceinline__ void tr_item(const float* __restrict__ src, int N, bf16_t* __restrict__ dst, int ldd, int kb, int nb, int lane, RowMap rm) {
    const int kc = lane >> 3, nc = lane & 7;
    const int n = nb * 32 + nc * 4, k0 = kb * 64 + kc * 8;
    if (n < N) {
        f32x4 v[8];
#pragma unroll
        for (int i = 0; i < 8; ++i) v[i] = *(const f32x4*)(src + (size_t)(k0 + i) * N + n);
#pragma unroll
        for (int j = 0; j < 4; ++j) {
            u32x4 o; o.x = pkbf(v[0][j], v[1][j]); o.y = pkbf(v[2][j], v[3][j]); o.z = pkbf(v[4][j], v[5][j]); o.w = pkbf(v[6][j], v[7][j]);
            *(u32x4*)(dst + (size_t)rm(n + j) * ldd + k0) = o;
        }
    }
}
template <class RowMap>
__device__ __forceinline__ void tr_item2(const float* __restrict__ src, int N, bf16_t* __restrict__ dst, int ldd, int kb, int nb, int lane, RowMap rm) {
    const int kc = lane >> 3, nc = lane & 7;
    const int n = nb * 32 + nc * 4, k0 = kb * 64 + kc * 8;
    f32x4 va[8], vb[8];
#pragma unroll
    for (int i = 0; i < 8; ++i) { va[i] = *(const f32x4*)(src + (size_t)(k0 + i) * N + n); vb[i] = *(const f32x4*)(src + (size_t)(k0 + i) * N + n + 32); }
#pragma unroll
    for (int j = 0; j < 4; ++j) {
        u32x4 o; o.x = pkbf(va[0][j], va[1][j]); o.y = pkbf(va[2][j], va[3][j]); o.z = pkbf(va[4][j], va[5][j]); o.w = pkbf(va[6][j], va[7][j]);
        *(u32x4*)(dst + (size_t)rm(n + j) * ldd + k0) = o;
    }
#pragma unroll
    for (int j = 0; j < 4; ++j) {
        u32x4 o; o.x = pkbf(vb[0][j], vb[1][j]); o.y = pkbf(vb[2][j], vb[3][j]); o.z = pkbf(vb[4][j], vb[5][j]); o.w = pkbf(vb[6][j], vb[7][j]);
        *(u32x4*)(dst + (size_t)rm(n + 32 + j) * ldd + k0) = o;
    }
}
template <class RowMap>
__device__ __forceinline__ void tr_item4(const float* __restrict__ src, int N, bf16_t* __restrict__ dst, int ldd, int kb, int nb, int lane, RowMap rm) {
    const int kc = lane >> 3, nc = lane & 7;
    const int n = nb * 32 + nc * 4, k0 = kb * 64 + kc * 8;
    f32x4 v[4][8];
#pragma unroll
    for (int i = 0; i < 8; ++i)
#pragma unroll
        for (int u = 0; u < 4; ++u) v[u][i] = *(const f32x4*)(src + (size_t)(k0 + i) * N + n + 32 * u);
#pragma unroll
    for (int u = 0; u < 4; ++u)
#pragma unroll
        for (int j = 0; j < 4; ++j) {
            u32x4 o; o.x = pkbf(v[u][0][j], v[u][1][j]); o.y = pkbf(v[u][2][j], v[u][3][j]); o.z = pkbf(v[u][4][j], v[u][5][j]); o.w = pkbf(v[u][6][j], v[u][7][j]);
            *(u32x4*)(dst + (size_t)rm(n + 32 * u + j) * ldd + k0) = o;
        }
}
constexpr int EXP_ITEMS = 3 * 32 * 1024;
__device__ __forceinline__ void convert_experts(const float* w_eg, const float* w_eu, const float* w_ed, bf16_t* WGU, bf16_t* WD, unsigned* qctr, int lane) {
    int nxt = 0; if (lane == 0) nxt = (int)atomicAdd(qctr, 8u);
    for (;;) {
        const int it = __builtin_amdgcn_readfirstlane(nxt);
        if (it >= EXP_ITEMS) break;
        if (lane == 0) nxt = (int)atomicAdd(qctr, 8u);
        const int kind = it >> 15, r = it & 32767, e = r >> 10, q = r & 1023;
        if (kind == 0) { const float* src = w_eg + (size_t)e * 2048 * 1024; bf16_t* dst = WGU + (size_t)e * 2048 * 2048;
#pragma unroll 1
            for (int u = 0; u < 8; u += 4) tr_item4(src, 1024, dst, 2048, q >> 5, (q & 31) + u, lane, MapGate{}); }
        else if (kind == 1) { const float* src = w_eu + (size_t)e * 2048 * 1024; bf16_t* dst = WGU + (size_t)e * 2048 * 2048;
#pragma unroll 1
            for (int u = 0; u < 8; u += 4) tr_item4(src, 1024, dst, 2048, q >> 5, (q & 31) + u, lane, MapUp{}); }
        else { const float* src = w_ed + (size_t)e * 1024 * 2048; bf16_t* dst = WD + (size_t)e * 2048 * 1024;
#pragma unroll 1
            for (int u = 0; u < 8; u += 4) tr_item4(src, 2048, dst, 1024, q >> 6, (q & 63) + u, lane, MapId{}); }
    }
}
__device__ __forceinline__ void sincos_d(double a, double& s, double& c) {
    const double TWO_PI = 6.283185307179586476925, HALF_PI = 1.5707963267948966192313;
    double k = rint(a / HALF_PI); double r = a - k * HALF_PI;
    r -= k * 6.123233995736766e-17;
    const int q = ((int)k) & 3; const double r2 = r * r;
    double sp = r2 * (-1.0 / 1307674368000.0);
    sp = r2 * (sp + 1.0 / 6227020800.0); sp = r2 * (sp - 1.0 / 39916800.0); sp = r2 * (sp + 1.0 / 362880.0); sp = r2 * (sp - 1.0 / 5040.0); sp = r2 * (sp + 1.0 / 120.0); sp = r2 * (sp - 1.0 / 6.0);
    const double sr = r + r * sp;
    double cp = r2 * (1.0 / 20922789888000.0);
    cp = r2 * (cp - 1.0 / 87178291200.0); cp = r2 * (cp + 1.0 / 479001600.0); cp = r2 * (cp - 1.0 / 3628800.0); cp = r2 * (cp + 1.0 / 40320.0); cp = r2 * (cp - 1.0 / 720.0); cp = r2 * (cp + 1.0 / 24.0); cp = r2 * (cp - 0.5);
    const double cr = 1.0 + cp;
    s = (q == 0) ? sr : (q == 1) ? cr : (q == 2) ? -sr : -cr;
    c = (q == 0) ? cr : (q == 1) ? -sr : (q == 2) ? -cr : sr;
    (void)TWO_PI;
}

struct Params { const float* in[17]; float* out; unsigned char* ws; };

#ifndef PROF_PHASE
#define PROF_PHASE -1
#endif
#ifndef PROF_SCALE
#define PROF_SCALE 4e-6f
#endif
#define STAMP(i) do { if (PROF_PHASE >= 0 && bx == 0 && wave_id == 0) ((unsigned*)(p.ws + WS_CTL))[6000 + (i)] = (unsigned)__builtin_amdgcn_s_memrealtime(); } while (0)
#define GSYNC() grid.sync()
#define XBAR() do { const int l__ = (int)__builtin_amdgcn_mbcnt_hi(~0u, __builtin_amdgcn_mbcnt_lo(~0u, (unsigned)hide_i(0))); xcd_barrier(xbar, wave_id * 64 + l__); } while (0)
constexpr int CTL_BAR_WORD = 8192;
constexpr int CTL_QCTR = 2048;
#ifndef NGEMM_P1
#define NGEMM_P1 208
#endif

__global__ void __launch_bounds__(512, 2) mega_fwd(Params p) {
    extern __shared__ __attribute__((aligned(16))) unsigned char lds_raw[];
    LAS unsigned char* lds = (LAS unsigned char*)lds_raw;
    cg::grid_group grid = cg::this_grid();
    const int G = gridDim.x, bx = blockIdx.x;
    const int wave_id = __builtin_amdgcn_readfirstlane((int)threadIdx.x >> 6);
    const int NGW = G * 8, NGT = G * 512;
    XcdBarrier xbar;
    {
        const int l0 = (int)__builtin_amdgcn_mbcnt_hi(~0u, __builtin_amdgcn_mbcnt_lo(~0u, (unsigned)hide_i(0)));
        volatile LAS unsigned* st = (volatile LAS unsigned*)(lds + LDS_MISC + 256);
        if (wave_id == 0 && l0 < 2) st[l0] = 0u;
        __syncthreads();
        xbar.bar = (unsigned*)(p.ws + WS_CTL) + CTL_BAR_WORD; xbar.x = xb_xcc_id(); xbar.st = st;
        if (wave_id == 0 && l0 == 0) (void)xb_add(&xbar.bar[XB_XCNT(xbar.x)], 1u);
    }
#define PH_LOCALS \
    const int lane = (int)__builtin_amdgcn_mbcnt_hi(~0u, __builtin_amdgcn_mbcnt_lo(~0u, (unsigned)hide_i(0))), wave = wave_id, tid = wave * 64 + lane; (void)tid; \
    const int gw = bx * 8 + wave, gtid = bx * 512 + tid; (void)gw; (void)gtid; (void)lane; \
    unsigned char* ws = hide_p(p.ws); float* out = hide_p(p.out); (void)out; \
    unsigned* ctl = (unsigned*)(ws + WS_CTL); float* rot = (float*)(ws + WS_ROT); (void)ctl; (void)rot; \
    bf16_t* WIN = (bf16_t*)(ws + WS_WIN); bf16_t* WCOMB = (bf16_t*)(ws + WS_WCOMB); bf16_t* WB = (bf16_t*)(ws + WS_WB); bf16_t* WO = (bf16_t*)(ws + WS_WO); (void)WIN; (void)WCOMB; (void)WB; (void)WO; \
    bf16_t* WGU = (bf16_t*)(ws + WS_WGU); bf16_t* WD = (bf16_t*)(ws + WS_WD); (void)WGU; (void)WD; \
    bf16_t* P = (bf16_t*)(ws + WS_P); bf16_t* HMID = (bf16_t*)(ws + WS_HMID); bf16_t* Y = (bf16_t*)(ws + WS_Y); (void)P; (void)HMID; (void)Y; \
    bf16_t* XN = (bf16_t*)(ws + WS_XN); bf16_t* BA = XN; bf16_t* TN = XN; (void)BA; (void)TN; \
    bf16_t* OA = (bf16_t*)(ws + WS_OA); bf16_t* OB = OA + 1024;            bf16_t* MIXED = (bf16_t*)(ws + WS_MIXED); bf16_t* XG = (bf16_t*)(ws + WS_XG); (void)OA; (void)OB; (void)MIXED; (void)XG; \
    bf16_t* KV = (bf16_t*)(ws + WS_KV); u64* MASK = (u64*)(ws + WS_MASK); (void)KV; (void)MASK; \
    int* misc = (int*)(ws + WS_MISC); \
    int* row_tok = misc + MI_ROWTOK; float* row_gate = (float*)(misc + MI_ROWGATE); int* tok_slot = misc + MI_TOKSLOT; (void)row_tok; (void)row_gate; (void)tok_slot; \
    int* asg_e = misc + MI_ASGE; int* asg_r = misc + MI_ASGR; float* asg_g = (float*)(misc + MI_ASGG); (void)asg_e; (void)asg_r; (void)asg_g;
#define IN(k) hide_p(p.in[k])

    STAMP(0);
    {
        PH_LOCALS
        const float* x = IN(0); const float* g_mix = IN(1); const float* w_in = IN(2); const float* w_uv = IN(4); const float* w_branch = IN(6); const float* w_out = IN(7);
        constexpr int NB_WIN = 311;
        constexpr int I_WIN = 32 * NB_WIN, I_WB = 16 * 64, I_WO = 32 * 64;
        constexpr int I_TOTAL = I_WIN + I_WB + I_WO;
#pragma unroll 1
        for (int pass = 0; pass < 4; ++pass) {
        const int job = (pass + wave) & 3;
        if (job == 0) {
        for (int it = gw; it < I_TOTAL; it += NGW) {
            int r = it;
            if (r < I_WIN) { tr_item(w_in, 9928, WIN, 2048, r / NB_WIN, r % NB_WIN, lane, MapProj{}); continue; } r -= I_WIN;
            if (r < I_WB) { tr_item(w_branch + (size_t)1024 * 2048, 2048, WCOMB + 1024, 2048, r >> 6, r & 63, lane, MapId{});   continue; } r -= I_WB;
            tr_item(w_out, 2048, WO, 2048, r >> 6, r & 63, lane, MapId{});
        }
        for (int i = gtid; i < 56 * 256; i += NGT) ((u32x4*)(WIN + (size_t)1736 * 2048))[i] = (u32x4){0u, 0u, 0u, 0u};
        } else if (job == 1) {
        for (int it = gw; it < 2048; it += NGW) {
            const int h = it >> 8, ch = (it >> 7) & 1, n0 = (it & 127) * 16, c = ch * 64 + lane;
            const float* wuv = w_uv + ((size_t)h * 128 + c) * 128;
            const float* wa = w_branch + (size_t)(h * 128) * 2048 + n0;
            float a[16];
#pragma unroll
            for (int j = 0; j < 16; ++j) a[j] = 0.f;
#pragma unroll 4
            for (int d4 = 0; d4 < 32; ++d4) {
                const f32x4 wv = *(const f32x4*)(wuv + d4 * 4);
#pragma unroll
                for (int dd = 0; dd < 4; ++dd) {
                    const float* wr_ = wa + (size_t)(d4 * 4 + dd) * 2048;
#pragma unroll
                    for (int j4 = 0; j4 < 4; ++j4) { const f32x4 b = *(const f32x4*)(wr_ + j4 * 4); a[j4 * 4 + 0] += wv[dd] * b[0]; a[j4 * 4 + 1] += wv[dd] * b[1]; a[j4 * 4 + 2] += wv[dd] * b[2]; a[j4 * 4 + 3] += wv[dd] * b[3]; }
                }
            }
#pragma unroll
            for (int j = 0; j < 16; ++j) WCOMB[(size_t)(n0 + j) * 2048 + h * 128 + c] = (bf16_t)(pkbf(a[j], 0.f) & 0xffffu);
        }
        } else if (job == 2) {
        for (int m = gw; m < T_TOK; m += 2 * NGW) {
            const int m1 = (m + NGW < T_TOK) ? m + NGW : m;
            const f32x4* xr0 = (const f32x4*)(x + (size_t)m * DMODEL) + lane; const f32x4* xr1 = (const f32x4*)(x + (size_t)m1 * DMODEL) + lane;
            f32x4 v0[8], v1[8]; float s0 = 0.f, s1 = 0.f;
#pragma unroll
            for (int j = 0; j < 8; ++j) { v0[j] = xr0[64 * j]; v1[j] = xr1[64 * j]; }
#pragma unroll
            for (int j = 0; j < 8; ++j) { s0 += (v0[j][0] * v0[j][0] + v0[j][1] * v0[j][1]) + (v0[j][2] * v0[j][2] + v0[j][3] * v0[j][3]); s1 += (v1[j][0] * v1[j][0] + v1[j][1] * v1[j][1]) + (v1[j][2] * v1[j][2] + v1[j][3] * v1[j][3]); }
            const float r0 = 1.0f / sqrtf(wave_sum(s0, lane) * (1.0f / DMODEL) + EPS_F), r1 = 1.0f / sqrtf(wave_sum(s1, lane) * (1.0f / DMODEL) + EPS_F);
            u32x2* o0 = (u32x2*)(XN + (size_t)m * DMODEL) + lane; u32x2* o1 = (u32x2*)(XN + (size_t)m1 * DMODEL) + lane;
#pragma unroll
            for (int j = 0; j < 8; ++j) { const f32x4 gg = ((const f32x4*)g_mix)[lane + 64 * j];
                u32x2 w; w.x = pkbf(v0[j][0] * r0 * gg[0], v0[j][1] * r0 * gg[1]); w.y = pkbf(v0[j][2] * r0 * gg[2], v0[j][3] * r0 * gg[3]); o0[64 * j] = w;
                u32x2 w2; w2.x = pkbf(v1[j][0] * r1 * gg[0], v1[j][1] * r1 * gg[1]); w2.y = pkbf(v1[j][2] * r1 * gg[2], v1[j][3] * r1 * gg[3]); o1[64 * j] = w2; }
        }
        } else {
        for (int idx = gtid; idx < SEQL * 64; idx += NGT) {
            const int pos = idx >> 6, i = idx & 63; double f = 1.0;
            for (int k = 0; k < i; ++k) f *= 0.8659643233600653;
            double s, c; sincos_d((double)pos * f, s, c);
            rot[2 * idx] = (float)c; rot[2 * idx + 1] = (float)s;
        }
        { const float* g_ffn = IN(8); const float* w_rg = IN(9); const float* w_re = IN(11); float* WC = (float*)(ws + WS_WC);
          for (int idx = gtid; idx < 256 * 48 * 8; idx += NGT) { const int j = idx & 7, c = (idx >> 3) % 48, k = (idx / 384) * 8 + j;
              const float wv = (c < 4) ? w_rg[k * 4 + c] : (c < 36) ? w_re[k * 32 + (c - 4)] : 0.f; WC[idx] = wv * g_ffn[k]; } }
        }
        }
        for (int i = gtid; i < 32; i += NGT) ctl[64 * i] = 0u;
        if (gtid < 2) ctl[4096 + gtid] = 0u;
        for (int i = gtid; i < MAXSLOT; i += NGT) { row_tok[i] = 0; row_gate[i] = 0.f; ((float*)(ws + WS_WC + 524288))[i] = 0.f; }
    }
    if (__builtin_expect(p.out == nullptr, 0)) GSYNC();
    XBAR();
    STAMP(1);

    {
        PH_LOCALS
        const float* w_eg = IN(13); const float* w_eu = IN(14); const float* w_ed = IN(15);
        const int NGEMM = (G == 256) ? NGEMM_P1 : G;
        if (bx < NGEMM) {
            pg8::Gemm g{XN, WIN, T_TOK, NPROJ, 2048}; pg8::StaticOrder S; S.init(T_TOK, NPROJ, NGEMM, bx);
            pg8::EpiProj E{P, rot};
            pg8::gemm_phase<pg8::EpiProj, pg8::StaticOrder, true, true>(lds, g, S, E, tid);
        }
        convert_experts(w_eg, w_eu, w_ed, WGU, WD, ctl + CTL_QCTR, lane);
    }
    XBAR();
    STAMP(2);
#ifdef P1_EXP
    XBAR();
    STAMP(30);
    {
        PH_LOCALS
        const float* w_eg = IN(13); const float* w_eu = IN(14); const float* w_ed = IN(15);
        const int NGEMM = P1_EXP_NG;
        if ((P1_EXP & 1) && bx < NGEMM) {
            pg8::Gemm g{XN, WIN, T_TOK, NPROJ, 2048}; pg8::StaticOrder S; S.init(T_TOK, NPROJ, NGEMM, bx);
            pg8::EpiProj E{P, rot};
            pg8::gemm_phase<pg8::EpiProj, pg8::StaticOrder, true, true>(lds, g, S, E, tid);
        }
        if ((P1_EXP & 2) && bx >= NGEMM) convert_experts(w_eg, w_eu, w_ed, WGU, WD, ctl + CTL_QCTR + 64, lane);
    }
    XBAR();
    STAMP(31);
#endif

    {
        PH_LOCALS
        const float* g_kv = IN(3);
        for (int t = gw; t < T_TOK; t += NGW) {
            const unsigned v = *(const unsigned*)(P + (size_t)t * NPROJ + C_CKV + 2 * lane);
            const float a = bflo(v), b = bfhi(v);
            const float rstd = 1.0f / sqrtf(wave_sum(a * a + b * b, lane) * (1.0f / 128.0f) + EPS_F);
            *(unsigned*)(KV + (size_t)t * 128 + 2 * lane) = pkbf(a * rstd * g_kv[2 * lane], b * rstd * g_kv[2 * lane + 1]);
        }
#if DBG_CMP == 3
        {
        u64* MASKX = (u64*)(ws + WS_SPARE);
        LAS float* qi = (LAS float*)(lds + wave * 10240); LAS float* sc = qi + 512;
        for (int t = gw; t < T_TOK; t += NGW) {
            const int b = t >> 11, q = t & 2047, ng = (q >> 6) + 1;
            { const u32x4 v = *(const u32x4*)(P + (size_t)t * NPROJ + C_QIDX + lane * 8);
              f32x4 lo4 = (f32x4){bflo(v.x), bfhi(v.x), bflo(v.y), bfhi(v.y)}, hi4 = (f32x4){bflo(v.z), bfhi(v.z), bflo(v.w), bfhi(v.w)};
              *(LAS f32x4*)(qi + lane * 8) = lo4; *(LAS f32x4*)(qi + lane * 8 + 4) = hi4; }
            float w[8];
            { const u32x4 v = *(const u32x4*)(P + (size_t)t * NPROJ + C_WIDX); w[0] = bflo(v.x); w[1] = bfhi(v.x); w[2] = bflo(v.y); w[3] = bfhi(v.y); w[4] = bflo(v.z); w[5] = bfhi(v.z); w[6] = bflo(v.w); w[7] = bfhi(v.w); }
            for (int g = 0; g < ng; ++g) {
                LAS float* qg = qi; asm volatile("" : "+v"(qg));
                const int s = g * 64 + lane; const u32x4* kr = (const u32x4*)(P + (size_t)(b * SEQL + s) * NPROJ + C_KIDX);
                float dot[8];
#pragma unroll
                for (int h = 0; h < 8; ++h) dot[h] = 0.f;
#pragma unroll
                for (int c = 0; c < 8; ++c) {
                    const u32x4 v = kr[c];
                    const f32x4 ka = (f32x4){bflo(v.x), bfhi(v.x), bflo(v.y), bfhi(v.y)}, kb = (f32x4){bflo(v.z), bfhi(v.z), bflo(v.w), bfhi(v.w)};
#pragma unroll
                    for (int h = 0; h < 8; ++h) {
                        const f32x4 qa = *(const LAS f32x4*)(qg + h * 64 + c * 8), qb = *(const LAS f32x4*)(qg + h * 64 + c * 8 + 4);
                        dot[h] += (qa[0] * ka[0] + qa[1] * ka[1]) + (qa[2] * ka[2] + qa[3] * ka[3]) + (qb[0] * kb[0] + qb[1] * kb[1]) + (qb[2] * kb[2] + qb[3] * kb[3]);
                    }
                }
                float score = 0.f;
#pragma unroll
                for (int h = 0; h < 8; ++h) score += w[h] * fmaxf(dot[h], 0.f);
                sc[s] = score * IDX_SCALE;
            }
            u64* mrow = MASKX + (size_t)t * 32;
            if (ng <= 4) { if (lane < 32) mrow[lane] = (lane < ng) ? ~0ull : 0ull; }
            else {
                unsigned lo = 0u;
                for (int bit = 31; bit >= 0; --bit) {
                    const unsigned cand = lo | (1u << bit); int cnt = 0;
                    for (int g = 0; g < ng; ++g) cnt += __popcll(__ballot(fkey(sc[g * 64 + lane]) >= cand));
                    if (cnt >= 256) lo = cand;
                }
                const unsigned tau = lo; int cgt = 0;
                for (int g = 0; g < ng; ++g) cgt += __popcll(__ballot(fkey(sc[g * 64 + lane]) > tau));
                const int need = 256 - cgt; int run = 0;
                for (int g = 0; g < ng; ++g) {
                    const unsigned key = fkey(sc[g * 64 + lane]);
                    const u64 gt = __ballot(key > tau), eq = __ballot(key == tau);
                    const u64 below = eq & ((1ull << lane) - 1ull);
                    const bool sel = (key == tau) && (run + (int)__popcll(below) < need);
                    const u64 word = gt | __ballot(sel);
                    run += (int)__popcll(eq);
                    if (lane == 0) mrow[g] = word;
                }
                if (lane >= ng && lane < 32) mrow[lane] = 0ull;
            }
        }
        }
        __syncthreads();
#endif
        typedef short bf16x8_t __attribute__((ext_vector_type(8)));
        constexpr int SCS = 2052;
        LAS float* scl = (LAS float*)lds;
        LAS unsigned* hist = (LAS unsigned*)(lds + 16 * SCS * 4);
        LAS unsigned* candl = hist + 16 * 256 + wave * 64;
        for (int i = tid; i < 16 * 256; i += 512) hist[i] = 0u;
        __syncthreads();
        for (int ui = 0; ui < 4; ++ui) {
            const int uu = ui * 256 + ((ui & 1) ? 255 - bx : bx);
            if (uu >= 1024 || bx >= 256) break;
            const int b = uu & 7, qblk = uu >> 3, q0 = qblk * 16, t0 = b * SEQL + q0, ng = (q0 >> 6) + 1, N = ng * 64;
            if (ng <= 4) {
                for (int qq = 0; qq < 2; ++qq) { u64* mrow = MASK + (size_t)(t0 + 2 * wave + qq) * 32; if (lane < 32) mrow[lane] = (lane < ng) ? ~0ull : 0ull; }
                continue;
            }
            const int qrow = lane & 15, kg = lane >> 4;
            bf16x8_t qf[8][2]; float w[8];
            { const bf16_t* qp = P + (size_t)(t0 + qrow) * NPROJ + C_QIDX + 8 * kg;
#pragma unroll
              for (int h = 0; h < 8; ++h) { qf[h][0] = *(const bf16x8_t*)(qp + h * 64); qf[h][1] = *(const bf16x8_t*)(qp + h * 64 + 32); }
              const u32x4 v = *(const u32x4*)(P + (size_t)(t0 + qrow) * NPROJ + C_WIDX); w[0] = bflo(v.x); w[1] = bfhi(v.x); w[2] = bflo(v.y); w[3] = bfhi(v.y); w[4] = bflo(v.z); w[5] = bfhi(v.z); w[6] = bflo(v.w); w[7] = bfhi(v.w); }
            const bf16_t* kp0 = P + (size_t)(b * SEQL + qrow) * NPROJ + C_KIDX + 8 * kg;
            bf16x8_t na0 = *(const bf16x8_t*)(kp0 + (size_t)(wave * 16) * NPROJ), na1 = *(const bf16x8_t*)(kp0 + (size_t)(wave * 16) * NPROJ + 32);
            for (int kt = wave; kt < N / 16; kt += 8) {
                const int s0 = kt * 16;
                const bf16x8_t a0 = na0, a1 = na1;
                { const int ktn = (kt + 8 < N / 16) ? kt + 8 : kt;
                  na0 = *(const bf16x8_t*)(kp0 + (size_t)(ktn * 16) * NPROJ); na1 = *(const bf16x8_t*)(kp0 + (size_t)(ktn * 16) * NPROJ + 32); }
                f32x4 sacc = (f32x4){0.f, 0.f, 0.f, 0.f};
#pragma unroll
                for (int h = 0; h < 8; ++h) {
                    f32x4 acc = (f32x4){0.f, 0.f, 0.f, 0.f};
                    acc = __builtin_amdgcn_mfma_f32_16x16x32_bf16(a0, qf[h][0], acc, 0, 0, 0);
                    acc = __builtin_amdgcn_mfma_f32_16x16x32_bf16(a1, qf[h][1], acc, 0, 0, 0);
                    sacc[0] += w[h] * fmaxf(acc[0], 0.f); sacc[1] += w[h] * fmaxf(acc[1], 0.f); sacc[2] += w[h] * fmaxf(acc[2], 0.f); sacc[3] += w[h] * fmaxf(acc[3], 0.f);
                }
                sacc = sacc * IDX_SCALE + 0.0f;
                *(LAS f32x4*)(scl + qrow * SCS + s0 + 4 * kg) = sacc;
#pragma unroll
                for (int i = 0; i < 4; ++i) __hip_atomic_fetch_add(hist + qrow * 256 + sbin(sacc[i]), 1u, __ATOMIC_RELAXED, __HIP_MEMORY_SCOPE_WORKGROUP);
            }
            __syncthreads();
#pragma unroll 1
            for (int qq = 0; qq < 2; ++qq) {
                const int q = 2 * wave + qq; const LAS float* row = scl + q * SCS; LAS unsigned* hq = hist + q * 256;
                unsigned key[32];
#pragma unroll
                for (int j = 0; j < 32; ++j) key[j] = (j < ng) ? fkey(row[64 * j + lane]) : 0u;
                const u32x4 hv = *(const LAS u32x4*)(hq + 4 * lane);
                *(LAS u32x4*)(hq + 4 * lane) = (u32x4){0u, 0u, 0u, 0u};
                const int tsum = (int)(hv.x + hv.y + hv.z + hv.w); int incl = tsum;
#pragma unroll
                for (int off = 1; off < 64; off <<= 1) { const int o = __builtin_amdgcn_ds_bpermute(((lane + off) & 63) << 2, incl); incl += (lane + off < 64) ? o : 0; }
                const int suf = incl - tsum;
                int bt_l, ab_l;
                if (suf + (int)hv.w >= 256) { bt_l = 4 * lane + 3; ab_l = suf; }
                else if (suf + (int)(hv.w + hv.z) >= 256) { bt_l = 4 * lane + 2; ab_l = suf + (int)hv.w; }
                else if (suf + (int)(hv.w + hv.z + hv.y) >= 256) { bt_l = 4 * lane + 1; ab_l = suf + (int)(hv.w + hv.z); }
                else { bt_l = 4 * lane; ab_l = suf + (int)(hv.w + hv.z + hv.y); }
                const u64 cb = __ballot(suf < 256 && incl >= 256);
                const int src = (int)__builtin_ctzll(cb | (1ull << 63));
                const int bt = __builtin_amdgcn_readlane(bt_l, src), above = __builtin_amdgcn_readlane(ab_l, src);
                const int r = 256 - above;
                unsigned cm = 0u;
#pragma unroll
                for (int j = 0; j < 32; ++j) cm |= ((key[j] != 0u) && (sbin(unkey(key[j])) == bt)) ? (1u << j) : 0u;
                const int myc = (int)__popc(cm); int pre = myc;
#pragma unroll
                for (int off = 1; off < 64; off <<= 1) { const int o_ = __builtin_amdgcn_ds_bpermute(((lane - off) & 63) << 2, pre); pre += (lane >= off) ? o_ : 0; }
                const int C = __builtin_amdgcn_readlane(pre, 63);
                int pos = pre - myc;
                if (C <= 64) {
#pragma unroll
                    for (int j = 0; j < 32; ++j) if ((cm >> j) & 1u) { candl[pos] = key[j]; ++pos; }
                }
                unsigned tau; int cgt, neq;
                if (C <= 64) {
                    asm volatile("s_waitcnt lgkmcnt(0)" ::: "memory");
                    const unsigned ck = (lane < C) ? candl[lane] : 0u;
                    unsigned lo = 0u;
#pragma unroll 1
                    for (int bit = 31; bit >= 0; --bit) { const unsigned cand = lo | (1u << bit); if ((int)__popcll(__ballot(ck >= cand)) >= r) lo = cand; }
                    tau = lo; cgt = above + (int)__popcll(__ballot(ck > tau)); neq = (int)__popcll(__ballot(ck == tau));
                } else {
                    unsigned lo = 0u;
#pragma unroll 1
                    for (int bit = 31; bit >= 0; --bit) {
                        const unsigned cand = lo | (1u << bit); int c = 0;
#pragma unroll
                        for (int j = 0; j < 32; ++j) c += (key[j] >= cand) ? 1 : 0;
#pragma unroll
                        for (int x = 1; x < 64; x <<= 1) c += __builtin_amdgcn_ds_bpermute((lane ^ x) << 2, c);
                        if (c >= 256) lo = cand;
                    }
                    tau = lo; cgt = 0;
#pragma unroll
                    for (int j = 0; j < 32; ++j) cgt += (key[j] > tau) ? 1 : 0;
#pragma unroll
                    for (int x = 1; x < 64; x <<= 1) cgt += __builtin_amdgcn_ds_bpermute((lane ^ x) << 2, cgt);
                    neq = 2;
                }
                const int need = 256 - cgt; u64 myword = 0ull;
                if (neq == 1) {
#pragma unroll
                    for (int j = 0; j < 32; ++j) { const u64 word = __ballot(key[j] >= tau); if (lane == j) myword = word; }
                } else {
                    int run = 0;
#pragma unroll
                    for (int j = 0; j < 32; ++j) {
                        const u64 gt = __ballot(key[j] > tau), eq = __ballot(key[j] == tau);
                        const u64 below = eq & ((1ull << lane) - 1ull);
                        const bool sel = (key[j] == tau) && (run + (int)__popcll(below) < need);
                        const u64 word = gt | __ballot(sel);
                        run += (int)__popcll(eq);
                        if (lane == j) myword = word;
                        __builtin_amdgcn_sched_barrier(0);
                    }
                }
                if (lane < 32) MASK[(size_t)(t0 + q) * 32 + lane] = myword;
            }
            __syncthreads();
        }
    }
    XBAR();
    STAMP(3);
#ifdef IDX_EXP
    XBAR();
    STAMP(30);
    {
        PH_LOCALS
        u64* MASKX_ = (u64*)(ws + WS_SPARE);
        typedef short bf16x8_t __attribute__((ext_vector_type(8)));
        constexpr int SCS = 2052;
        LAS float* scl = (LAS float*)lds;
        LAS unsigned* hist = (LAS unsigned*)(lds + 16 * SCS * 4);
        LAS unsigned* candl = hist + 16 * 256 + wave * 64;
        for (int i = tid; i < 16 * 256; i += 512) hist[i] = 0u;
        __syncthreads();
        for (int ui = 0; ui < 4; ++ui) {
            const int uu = ui * 256 + ((ui & 1) ? 255 - bx : bx);
            if (uu >= 1024 || bx >= 256) break;
            const int b = uu & 7, qblk = uu >> 3, q0 = qblk * 16, t0 = b * SEQL + q0, ng = (q0 >> 6) + 1, N = ng * 64;
            if (ng <= 4) {
                for (int qq = 0; qq < 2; ++qq) { u64* mrow = MASKX_ + (size_t)(t0 + 2 * wave + qq) * 32; if (lane < 32) mrow[lane] = (lane < ng) ? ~0ull : 0ull; }
                continue;
            }
            const int qrow = lane & 15, kg = lane >> 4;
            bf16x8_t qf[8][2]; float w[8];
            { const bf16_t* qp = P + (size_t)(t0 + qrow) * NPROJ + C_QIDX + 8 * kg;
#pragma unroll
              for (int h = 0; h < 8; ++h) { qf[h][0] = *(const bf16x8_t*)(qp + h * 64); qf[h][1] = *(const bf16x8_t*)(qp + h * 64 + 32); }
              const u32x4 v = *(const u32x4*)(P + (size_t)(t0 + qrow) * NPROJ + C_WIDX); w[0] = bflo(v.x); w[1] = bfhi(v.x); w[2] = bflo(v.y); w[3] = bfhi(v.y); w[4] = bflo(v.z); w[5] = bfhi(v.z); w[6] = bflo(v.w); w[7] = bfhi(v.w); }
            const bf16_t* kp0 = P + (size_t)(b * SEQL + qrow) * NPROJ + C_KIDX + 8 * kg;
            bf16x8_t na0 = *(const bf16x8_t*)(kp0 + (size_t)(wave * 16) * NPROJ), na1 = *(const bf16x8_t*)(kp0 + (size_t)(wave * 16) * NPROJ + 32);
            if (!(IDX_EXP & 2))
            for (int kt = wave; kt < N / 16; kt += 8) {
                const int s0 = kt * 16;
                const bf16x8_t a0 = na0, a1 = na1;
                { const int ktn = (kt + 8 < N / 16) ? kt + 8 : kt;
                  na0 = *(const bf16x8_t*)(kp0 + (size_t)(ktn * 16) * NPROJ); na1 = *(const bf16x8_t*)(kp0 + (size_t)(ktn * 16) * NPROJ + 32); }
                f32x4 sacc = (f32x4){0.f, 0.f, 0.f, 0.f};
#pragma unroll
                for (int h = 0; h < 8; ++h) {
                    f32x4 acc = (f32x4){0.f, 0.f, 0.f, 0.f};
                    acc = __builtin_amdgcn_mfma_f32_16x16x32_bf16(a0, qf[h][0], acc, 0, 0, 0);
                    acc = __builtin_amdgcn_mfma_f32_16x16x32_bf16(a1, qf[h][1], acc, 0, 0, 0);
                    sacc[0] += w[h] * fmaxf(acc[0], 0.f); sacc[1] += w[h] * fmaxf(acc[1], 0.f); sacc[2] += w[h] * fmaxf(acc[2], 0.f); sacc[3] += w[h] * fmaxf(acc[3], 0.f);
                }
                sacc = sacc * IDX_SCALE + 0.0f;
                *(LAS f32x4*)(scl + qrow * SCS + s0 + 4 * kg) = sacc;
#pragma unroll
                for (int i = 0; i < 4; ++i) __hip_atomic_fetch_add(hist + qrow * 256 + sbin(sacc[i]), 1u, __ATOMIC_RELAXED, __HIP_MEMORY_SCOPE_WORKGROUP);
            }
            __syncthreads();
#pragma unroll 1
            for (int qq = 0; qq < ((IDX_EXP & 1) ? 0 : 2); ++qq) {
                const int q = 2 * wave + qq; const LAS float* row = scl + q * SCS; LAS unsigned* hq = hist + q * 256;
                unsigned key[32];
#pragma unroll
                for (int j = 0; j < 32; ++j) key[j] = (j < ng) ? fkey(row[64 * j + lane]) : 0u;
                const u32x4 hv = *(const LAS u32x4*)(hq + 4 * lane);
                *(LAS u32x4*)(hq + 4 * lane) = (u32x4){0u, 0u, 0u, 0u};
                const int tsum = (int)(hv.x + hv.y + hv.z + hv.w); int incl = tsum;
#pragma unroll
                for (int off = 1; off < 64; off <<= 1) { const int o = __builtin_amdgcn_ds_bpermute(((lane + off) & 63) << 2, incl); incl += (lane + off < 64) ? o : 0; }
                const int suf = incl - tsum;
                int bt_l, ab_l;
                if (suf + (int)hv.w >= 256) { bt_l = 4 * lane + 3; ab_l = suf; }
                else if (suf + (int)(hv.w + hv.z) >= 256) { bt_l = 4 * lane + 2; ab_l = suf + (int)hv.w; }
                else if (suf + (int)(hv.w + hv.z + hv.y) >= 256) { bt_l = 4 * lane + 1; ab_l = suf + (int)(hv.w + hv.z); }
                else { bt_l = 4 * lane; ab_l = suf + (int)(hv.w + hv.z + hv.y); }
                const u64 cb = __ballot(suf < 256 && incl >= 256);
                const int src = (int)__builtin_ctzll(cb | (1ull << 63));
                const int bt = __builtin_amdgcn_readlane(bt_l, src), above = __builtin_amdgcn_readlane(ab_l, src);
                const int r = 256 - above;
                int C = 0;
                if (!(IDX_EXP & 4))
#pragma unroll
                for (int j = 0; j < 32; ++j) {
                    const bool isc = (key[j] != 0u) && (sbin(unkey(key[j])) == bt);
                    const u64 bal = __ballot(isc);
                    if (isc) { const int pos = C + (int)__popcll(bal & ((1ull << lane) - 1ull)); if (pos < 64) candl[pos] = key[j]; }
                    C += (int)__popcll(bal);
                }
                unsigned tau; int cgt;
                if (IDX_EXP & 4) { tau = 0x80000000u + (unsigned)bt; cgt = above; }
                else if (C <= 64) {
                    asm volatile("s_waitcnt lgkmcnt(0)" ::: "memory");
                    const unsigned ck = (lane < C) ? candl[lane] : 0u;
                    unsigned lo = 0u;
#pragma unroll 1
                    for (int bit = 31; bit >= 0; --bit) { const unsigned cand = lo | (1u << bit); if ((int)__popcll(__ballot(ck >= cand)) >= r) lo = cand; }
                    tau = lo; cgt = above + (int)__popcll(__ballot(ck > tau));
                } else {
                    unsigned lo = 0u;
#pragma unroll 1
                    for (int bit = 31; bit >= 0; --bit) {
                        const unsigned cand = lo | (1u << bit); int c = 0;
#pragma unroll
                        for (int j = 0; j < 32; ++j) c += (key[j] >= cand) ? 1 : 0;
#pragma unroll
                        for (int x = 1; x < 64; x <<= 1) c += __builtin_amdgcn_ds_bpermute((lane ^ x) << 2, c);
                        if (c >= 256) lo = cand;
                    }
                    tau = lo; cgt = 0;
#pragma unroll
                    for (int j = 0; j < 32; ++j) cgt += (key[j] > tau) ? 1 : 0;
#pragma unroll
                    for (int x = 1; x < 64; x <<= 1) cgt += __builtin_amdgcn_ds_bpermute((lane ^ x) << 2, cgt);
                }
                const int need = 256 - cgt; int run = 0; u64 myword = (u64)tau;
                if (!(IDX_EXP & 8))
#pragma unroll
                for (int j = 0; j < 32; ++j) {
                    const u64 gt = __ballot(key[j] > tau), eq = __ballot(key[j] == tau);
                    const u64 below = eq & ((1ull << lane) - 1ull);
                    const bool sel = (key[j] == tau) && (run + (int)__popcll(below) < need);
                    const u64 word = gt | __ballot(sel);
                    run += (int)__popcll(eq);
                    if (lane == j) myword = word;
                    __builtin_amdgcn_sched_barrier(0);
                }
                if (lane < 32) MASKX_[(size_t)(t0 + q) * 32 + lane] = myword;
            }
            __syncthreads();
        }
    }
    XBAR();
    STAMP(31);
#endif

#if DBG_CMP == 1
    {
        PH_LOCALS
        bf16_t* OAX = (bf16_t*)(ws + WS_SPARE);
        float* qv = (float*)(lds_raw + wave * 10240); float* lg = qv + 512;
        for (int it = gw; it < T_TOK * 8; it += NGW) {
            const int t = it >> 3, h = it & 7, b = t >> 11, q = t & 2047, ng = (q >> 6) + 1;
            { const unsigned v = *(const unsigned*)(P + (size_t)t * NPROJ + C_QLAT + h * 128 + 2 * lane); qv[2 * lane] = bflo(v); qv[2 * lane + 1] = bfhi(v); }
            const u64* mrow = MASK + (size_t)t * 32;
            float mx = -INFINITY;
            for (int g = 0; g < ng; ++g) {
                asm volatile("" ::: "memory");
                const u64 word = mrow[g]; float l = -INFINITY;
                if ((word >> lane) & 1ull) {
                    const u32x4* kr = (const u32x4*)(KV + (size_t)(b * SEQL + g * 64 + lane) * 128);
                    float d0 = 0.f, d1 = 0.f, d2 = 0.f, d3 = 0.f;
#pragma unroll
                    for (int c = 0; c < 16; ++c) { const u32x4 v = kr[c]; const f32x4 qa = *(const f32x4*)(qv + 8 * c), qb = *(const f32x4*)(qv + 8 * c + 4);
                        d0 += qa[0] * bflo(v.x) + qb[0] * bflo(v.z); d1 += qa[1] * bfhi(v.x) + qb[1] * bfhi(v.z); d2 += qa[2] * bflo(v.y) + qb[2] * bflo(v.w); d3 += qa[3] * bfhi(v.y) + qb[3] * bfhi(v.w); }
                    l = ((d0 + d1) + (d2 + d3)) * ATT_SCALE;
                }
                lg[g * 64 + lane] = l; mx = fmaxf(mx, l);
            }
            mx = wave_max(mx, lane);
            float o0 = 0.f, o1 = 0.f, sum = 0.f;
            for (int g = 0; g < ng; ++g) {
                const u64 wv = mrow[g];
                u64 word = ((u64)__builtin_amdgcn_readfirstlane((unsigned)(wv >> 32)) << 32) | (u64)__builtin_amdgcn_readfirstlane((unsigned)wv);
                while (word) {
                    const int j = __builtin_ctzll(word); word &= word - 1ull;
                    const int s = g * 64 + j; const float pj = __expf(lg[s] - mx);
                    const unsigned v = *(const unsigned*)(KV + (size_t)(b * SEQL + s) * 128 + 2 * lane);
                    o0 += pj * bflo(v); o1 += pj * bfhi(v); sum += pj;
                }
            }
            const float inv = 1.0f / sum;
            *(unsigned*)(OAX + (size_t)t * 1024 + h * 128 + 2 * lane) = pkbf(o0 * inv, o1 * inv);
        }
    }
    __syncthreads();
#endif
#if DBG_CMP == 2
    {
        PH_LOCALS
        const float* g_ret = IN(5);
        bf16_t* OBX = (bf16_t*)(ws + WS_SPARE);
        float* qv = (float*)(lds_raw + wave * 10240); float* lg = qv + 512; float* wl = lg;
        for (int it = gw; it < T_TOK * 8; it += NGW) {
            const int t = it >> 3, h = it & 7, b = t >> 11, n = t & 2047, ng = (n >> 6) + 1;
            const float lgam = (h == 0) ? -0.04580368961312479f : (h == 1) ? -0.02272007650008353f : (h == 2) ? -0.011315313227834146f : (h == 3) ? -0.005646563141142063f :
                               (h == 4) ? -0.0028205190623786626f : (h == 5) ? -0.0014095702546713536f : (h == 6) ? -0.0007046129765893727f : -0.0003522634716290214f;
            { const unsigned v = *(const unsigned*)(P + (size_t)t * NPROJ + C_QR + h * 128 + 2 * lane); qv[2 * lane] = bflo(v); qv[2 * lane + 1] = bfhi(v); }
            float o0 = 0.f, o1 = 0.f;
            for (int g = 0; g < ng; ++g) {
                asm volatile("" ::: "memory");
                const int m = g * 64 + lane;
                const u32x4* kr = (const u32x4*)(P + (size_t)(b * SEQL + m) * NPROJ + C_KR + h * 128);
                float d0 = 0.f, d1 = 0.f, d2 = 0.f, d3 = 0.f;
#pragma unroll
                for (int c = 0; c < 16; ++c) { const u32x4 v = kr[c]; const f32x4 qa = *(const f32x4*)(qv + 8 * c), qb = *(const f32x4*)(qv + 8 * c + 4);
                    d0 += qa[0] * bflo(v.x) + qb[0] * bflo(v.z); d1 += qa[1] * bfhi(v.x) + qb[1] * bfhi(v.z); d2 += qa[2] * bflo(v.y) + qb[2] * bflo(v.w); d3 += qa[3] * bfhi(v.y) + qb[3] * bfhi(v.w); }
                const float dot = (d0 + d1) + (d2 + d3);
                wl[lane] = (m <= n) ? dot * exp2f((float)(n - m) * lgam) : 0.f;
                const int jmax = (g == ng - 1) ? (n & 63) : 63;
                for (int j = 0; j <= jmax; ++j) {
                    const float wj = wl[j];
                    const unsigned v = *(const unsigned*)(P + (size_t)(b * SEQL + g * 64 + j) * NPROJ + C_VR + h * 128 + 2 * lane);
                    o0 += wj * bflo(v); o1 += wj * bfhi(v);
                }
            }
            const float mu = wave_sum(o0 + o1, lane) * (1.0f / 128.0f); const float e0 = o0 - mu, e1 = o1 - mu;
            const float rs = 1.0f / sqrtf(wave_sum(e0 * e0 + e1 * e1, lane) * (1.0f / 128.0f) + EPS_F);
            const unsigned gv = *(const unsigned*)(P + (size_t)t * NPROJ + C_GR + h * 128 + 2 * lane);
            const float y0 = siluf_(bflo(gv)) * e0 * rs * g_ret[h * 128 + 2 * lane], y1 = siluf_(bfhi(gv)) * e1 * rs * g_ret[h * 128 + 2 * lane + 1];
            *(unsigned*)(OBX + (size_t)t * 1024 + h * 128 + 2 * lane) = pkbf(y0, y1);
        }
    }
    __syncthreads();
#endif
    {
        PH_LOCALS
        for (int pr = bx; pr < 256; pr += G) {
            const int b = pr >> 5, i = pr & 31;
#pragma unroll 1
            for (int uu = 0; uu < 2; ++uu) {
                const int qb = uu ? 63 - i : i; const int t0 = b * SEQL + qb * 32;
                fa::UnitArgs U; U.Q = P + (size_t)t0 * NPROJ + C_QLAT; U.ldq = NPROJ; U.K = KV + (size_t)b * SEQL * 128; U.V = U.K; U.ldk = 128; U.mask = MASK + (size_t)t0 * 32;
                U.ntiles = (qb >> 1) + 1; U.n0 = 0; U.lgam = 0.f;
                fa::f32x16 o[4]; float l_reg;
                fa::unit_body<0>((LAS char*)lds, U, tid, o, l_reg);
                const int r32 = lane & 31, hi = lane >> 5;
                const int trow1 = hide_i(t0);
                LAS float* li_l = (LAS float*)(lds + fa::OFF_WS) + wave * 64;
                if (hi == 0) li_l[r32] = l_reg;
                asm volatile("s_waitcnt lgkmcnt(0)" ::: "memory");
                LAS char* Tw = (LAS char*)lds + fa::OFF_Q + wave * 8704; LAS char* Tl = Tw + hi * (4 * 272) + r32 * 2; asm volatile("" : "+v"(Tl));
#pragma unroll
                for (int r = 0; r < 16; ++r) {
                    const int orow = fa::crow(r, hi); const float rl = __builtin_amdgcn_rcpf(li_l[orow]);
#pragma unroll
                    for (int d0 = 0; d0 < 4; ++d0) *(LAS bf16_t*)(Tl + ((r & 3) + 8 * (r >> 2)) * 272 + d0 * 64) = (bf16_t)(pkbf(o[d0][r] * rl, 0.f) & 0xffffu);
                }
                asm volatile("s_waitcnt lgkmcnt(0)" ::: "memory");
#pragma unroll
                for (int k = 0; k < 8; ++k) {
                    const int c = lane + 64 * k, orow = c >> 4, ch = c & 15;
                    const u32x4 v = *(const LAS u32x4*)(Tw + orow * 272 + ch * 16);
                    *(u32x4*)(OA + (size_t)(trow1 + orow) * 2048 + wave * 128 + ch * 8) = v;
                }
                __syncthreads();
            }
        }
    }
    STAMP(20);
    {
        PH_LOCALS
        const float* g_ret = IN(5);
        for (int pr = bx; pr < 256; pr += G) {
            const int bh = pr >> 2, i = pr & 3, b = bh >> 3, h = bh & 7;
            const float lgam = (h == 0) ? -0.04580368961312479f : (h == 1) ? -0.02272007650008353f : (h == 2) ? -0.011315313227834146f : (h == 3) ? -0.005646563141142063f :
                               (h == 4) ? -0.0028205190623786626f : (h == 5) ? -0.0014095702546713536f : (h == 6) ? -0.0007046129765893727f : -0.0003522634716290214f;
#pragma unroll 1
            for (int uu = 0; uu < 2; ++uu) {
                const int qb = uu ? 7 - i : i; const int n0 = qb * 256;
                fa::UnitArgs U; U.Q = P + (size_t)(b * SEQL + n0) * NPROJ + C_QR + h * 128; U.ldq = NPROJ;
                U.K = P + (size_t)(b * SEQL) * NPROJ + C_KR + h * 128; U.V = P + (size_t)(b * SEQL) * NPROJ + C_VR + h * 128; U.ldk = NPROJ; U.mask = nullptr;
                U.ntiles = 4 * (qb + 1); U.n0 = n0; U.lgam = lgam;
                fa::f32x16 o[4]; float l_reg;
                fa::unit_body<1>((LAS char*)lds, U, tid, o, l_reg);
                const int r32 = lane & 31, hi = lane >> 5;
                const int tok0 = hide_i(b * SEQL + n0 + wave * 32 + 4 * hi);
                float gr[4];
#pragma unroll
                for (int d0 = 0; d0 < 4; ++d0) gr[d0] = g_ret[h * 128 + d0 * 32 + r32];
                float sv[16], qv[16];
#pragma unroll
                for (int r = 0; r < 16; ++r) sv[r] = (o[0][r] + o[1][r]) + (o[2][r] + o[3][r]);
#pragma unroll
                for (int x = 1; x < 32; x <<= 1)
#pragma unroll
                    for (int r = 0; r < 16; ++r) sv[r] += shx(sv[r], lane, x);
#pragma unroll
                for (int r = 0; r < 16; ++r) { const float mu = sv[r] * (1.0f / 128.0f); sv[r] = mu;
                    const float e0 = o[0][r] - mu, e1 = o[1][r] - mu, e2 = o[2][r] - mu, e3 = o[3][r] - mu; qv[r] = (e0 * e0 + e1 * e1) + (e2 * e2 + e3 * e3); }
#pragma unroll
                for (int x = 1; x < 32; x <<= 1)
#pragma unroll
                    for (int r = 0; r < 16; ++r) qv[r] += shx(qv[r], lane, x);
                LAS char* Tw = (LAS char*)lds + fa::OFF_Q + wave * 8704; LAS char* Tl = Tw + hi * (4 * 272) + r32 * 2; asm volatile("" : "+v"(Tl));
#pragma unroll
                for (int r = 0; r < 16; ++r) {
                    const float mu = sv[r]; const float rs = 1.0f / sqrtf(qv[r] * (1.0f / 128.0f) + EPS_F); const int orow = fa::crow(r, hi);
#pragma unroll
                    for (int d0 = 0; d0 < 4; ++d0) *(LAS bf16_t*)(Tl + ((r & 3) + 8 * (r >> 2)) * 272 + d0 * 64) = (bf16_t)(pkbf((o[d0][r] - mu) * rs * gr[d0], 0.f) & 0xffffu);
                }
                asm volatile("s_waitcnt lgkmcnt(0)" ::: "memory");
                const int tokb = hide_i(b * SEQL + n0 + wave * 32);
#pragma unroll
                for (int k = 0; k < 8; ++k) {
                    const int c = lane + 64 * k, orow = c >> 4, ch = c & 15;
                    const u32x4 v = *(const LAS u32x4*)(Tw + orow * 272 + ch * 16);
                    const size_t tok = (size_t)(tokb + orow);
                    const u32x4 g = *(const u32x4*)(P + tok * NPROJ + C_GR + h * 128 + ch * 8);
                    u32x4 w; w.x = pkbf(siluf_(bflo(g.x)) * bflo(v.x), siluf_(bfhi(g.x)) * bfhi(v.x)); w.y = pkbf(siluf_(bflo(g.y)) * bflo(v.y), siluf_(bfhi(g.y)) * bfhi(v.y));
                    w.z = pkbf(siluf_(bflo(g.z)) * bflo(v.z), siluf_(bfhi(g.z)) * bfhi(v.z)); w.w = pkbf(siluf_(bflo(g.w)) * bflo(v.w), siluf_(bfhi(g.w)) * bfhi(v.w));
                    *(u32x4*)(OB + tok * 2048 + h * 128 + ch * 8) = w;
                }
                __syncthreads();
            }
        }
    }
#ifdef RET_EXP
    XBAR();
    STAMP(30);
    {
        PH_LOCALS
        const float* g_ret = IN(5);
        for (int pr = bx; pr < 256; pr += G) {
            const int bh = pr >> 2, i = pr & 3, b = bh >> 3, h = bh & 7;
            const float lgam = (h == 0) ? -0.04580368961312479f : (h == 1) ? -0.02272007650008353f : (h == 2) ? -0.011315313227834146f : (h == 3) ? -0.005646563141142063f :
                               (h == 4) ? -0.0028205190623786626f : (h == 5) ? -0.0014095702546713536f : (h == 6) ? -0.0007046129765893727f : -0.0003522634716290214f;
#pragma unroll 1
            for (int uu = 0; uu < 2; ++uu) {
                const int qb = uu ? 7 - i : i; const int n0 = qb * 256;
                fa::UnitArgs U; U.Q = P + (size_t)(b * SEQL + n0) * NPROJ + C_QR + h * 128; U.ldq = NPROJ;
                U.K = P + (size_t)(b * SEQL) * NPROJ + C_KR + h * 128; U.V = P + (size_t)(b * SEQL) * NPROJ + C_VR + h * 128; U.ldk = NPROJ; U.mask = nullptr;
                U.ntiles = 4 * (qb + 1); U.n0 = n0; U.lgam = lgam;
                fa::f32x16 o[4]; float l_reg;
                fa::unit_body<1, RET_EXP>((LAS char*)lds, U, tid, o, l_reg);
                const int r32 = lane & 31, hi = lane >> 5;
                const int tok0 = hide_i(b * SEQL + n0 + wave * 32 + 4 * hi);
                float gr[4];
#pragma unroll
                for (int d0 = 0; d0 < 4; ++d0) gr[d0] = g_ret[h * 128 + d0 * 32 + r32];
                if (RET_EXP & 8) { fa::f32x16 t_ = (o[0] + o[1]) + (o[2] + o[3]); float z_ = 0.f;
#pragma unroll
                    for (int r = 0; r < 16; ++r) z_ += t_[r];
                    ((float*)(ws + WS_SPARE))[(size_t)(pr * 2 + uu) * 512 + tid] = z_; }
                else
#pragma unroll
                for (int r = 0; r < 16; ++r) {
                    float s = (o[0][r] + o[1][r]) + (o[2][r] + o[3][r]);
#pragma unroll
                    for (int x = 1; x < 32; x <<= 1) s += shx(s, lane, x);
                    const float mu = s * (1.0f / 128.0f);
                    const float e0 = o[0][r] - mu, e1 = o[1][r] - mu, e2 = o[2][r] - mu, e3 = o[3][r] - mu;
                    float q = (e0 * e0 + e1 * e1) + (e2 * e2 + e3 * e3);
#pragma unroll
                    for (int x = 1; x < 32; x <<= 1) q += shx(q, lane, x);
                    const float rs = 1.0f / sqrtf(q * (1.0f / 128.0f) + EPS_F);
                    const size_t tok = (size_t)(tok0 + (r & 3) + 8 * (r >> 2));
                    const bf16_t* gp = P + tok * NPROJ + C_GR + h * 128 + r32; bf16_t* op = (bf16_t*)(ws + WS_SPARE) + tok * 1024 + h * 128 + r32;
                    op[0] = (bf16_t)(pkbf(siluf_(bflo((unsigned)gp[0])) * e0 * rs * gr[0], 0.f) & 0xffffu);
                    op[32] = (bf16_t)(pkbf(siluf_(bflo((unsigned)gp[32])) * e1 * rs * gr[1], 0.f) & 0xffffu);
                    op[64] = (bf16_t)(pkbf(siluf_(bflo((unsigned)gp[64])) * e2 * rs * gr[2], 0.f) & 0xffffu);
                    op[96] = (bf16_t)(pkbf(siluf_(bflo((unsigned)gp[96])) * e3 * rs * gr[3], 0.f) & 0xffffu);
                }
                __syncthreads();
            }
        }
    }
    XBAR();
    STAMP(31);
#endif
#if DBG_CMP
    XBAR();
    {
        PH_LOCALS
        const bf16_t* A_ = (DBG_CMP == 1) ? OA : OB; const bf16_t* R_ = (const bf16_t*)(ws + WS_SPARE);
        float sd = 0.f, sr = 0.f;
#if DBG_CMP == 3
        for (size_t i = (size_t)gtid; i < (size_t)T_TOK * 32; i += (size_t)NGT) { const u64 a = MASK[i], r = ((const u64*)(ws + WS_SPARE))[i]; sd += (float)__popcll(a ^ r); sr += 100.0f * (float)__popcll(r); }
#else
        for (size_t i = (size_t)gtid; i < (size_t)T_TOK * 1024 / 2; i += (size_t)NGT) {
            const unsigned a = ((const unsigned*)A_)[(i >> 9) * 1024 + (i & 511)], r = ((const unsigned*)R_)[i];
            const float d0 = bflo(a) - bflo(r), d1 = bfhi(a) - bfhi(r); sd += d0 * d0 + d1 * d1; sr += bflo(r) * bflo(r) + bfhi(r) * bfhi(r);
        }
#endif
        sd = wave_sum(sd, lane); sr = wave_sum(sr, lane);
        if (lane == 0) { atomicAdd((float*)(ctl + 4096), sd); atomicAdd((float*)(ctl + 4097), sr); }
    }
#endif
    XBAR();
    STAMP(4);

    {
        PH_LOCALS
        pg8::Gemm g{OA, WCOMB, T_TOK, DMODEL, 2048}; pg8::StaticOrder S; S.init(T_TOK, DMODEL, G, bx);
        pg8::EpiMergeF E{P, MIXED};
        pg8::gemm_phase<pg8::EpiMergeF, pg8::StaticOrder, true, true>(lds, g, S, E, tid);
    }
    XBAR();
    STAMP(5);
    {
        PH_LOCALS
        const float* x = IN(0);
        pg8::Gemm g{MIXED, WO, T_TOK, DMODEL, 2048}; pg8::StaticOrder S; S.init(T_TOK, DMODEL, G, bx);
        pg8::EpiRes E{x, out};
        pg8::gemm_phase<pg8::EpiRes, pg8::StaticOrder, true, true>(lds, g, S, E, tid);
    }
    XBAR();
    STAMP(7);
#ifdef GEMM_EXP
    {
        PH_LOCALS
        pg8::Gemm g{MIXED, WO, T_TOK, DMODEL, 2048}; pg8::StaticOrder S; S.init(T_TOK, DMODEL, G, bx);
        pg8::EpiNull E{(float*)(ws + WS_SPARE)};
        pg8::gemm_phase<pg8::EpiNull, pg8::StaticOrder, true, true>(lds, g, S, E, tid);
    }
    XBAR();
    STAMP(31);
#endif

    {
    PH_LOCALS
    const float* g_ffn = IN(8); const float* b_rg = IN(10); const float* b_re = IN(12);
    const f32x4* WC4 = (const f32x4*)(ws + WS_WC); float* tok_rs = (float*)(ws + WS_WC + 786432);
    LAS float* lg = (LAS float*)lds + wave * (16 * 52);
    const int row = lane & 15, g4 = lane >> 4;
    LAS float* part = (LAS float*)lds + 4 * (16 * 52) + (wave & 3) * (13 * 64);
    for (int tile0 = bx * 4; tile0 < T_TOK / 16; tile0 += G * 4) {
        const int tile = tile0 + (wave & 3), kh = wave >> 2;
        const int tok0 = tile * 16;
        const float* hrow = out + (size_t)(tok0 + row) * DMODEL + 8 * g4 + 1024 * kh;
        bf16_t* trow = TN + (size_t)(tok0 + row) * DMODEL + 8 * g4 + 1024 * kh;
        const f32x4* wp = WC4 + (size_t)g4 * 96 + 2 * row + (size_t)kh * 32 * 384;
        const float* gp = g_ffn + 8 * g4 + 1024 * kh;
        f32x4 acc0 = (f32x4){0.f, 0.f, 0.f, 0.f}, acc1 = acc0, acc2 = acc0; float ssq = 0.f;
        f32x4 a0 = *(const f32x4*)(hrow), a1 = *(const f32x4*)(hrow + 4);
        f32x4 b00 = wp[0], b01 = wp[1], b10 = wp[32], b11 = wp[33], b20 = wp[64], b21 = wp[65];
        f32x4 na0 = *(const f32x4*)(hrow + 32), na1 = *(const f32x4*)(hrow + 36);
        f32x4 nb00 = wp[384], nb01 = wp[385], nb10 = wp[416], nb11 = wp[417], nb20 = wp[448], nb21 = wp[449];
        for (int it = 0; it < 32; ++it) {
            const int itn = (it + 2 < 32) ? it + 2 : 31;
            const f32x4 ma0 = *(const f32x4*)(hrow + 32 * itn), ma1 = *(const f32x4*)(hrow + 32 * itn + 4);
            const f32x4* wn = wp + (size_t)itn * 384;
            const f32x4 mb00 = wn[0], mb01 = wn[1], mb10 = wn[32], mb11 = wn[33], mb20 = wn[64], mb21 = wn[65];
            const f32x4 gk0 = *(const f32x4*)(gp + 32 * it), gk1 = *(const f32x4*)(gp + 32 * it + 4);
            ssq += (a0[0] * a0[0] + a0[1] * a0[1]) + (a0[2] * a0[2] + a0[3] * a0[3]) + (a1[0] * a1[0] + a1[1] * a1[1]) + (a1[2] * a1[2] + a1[3] * a1[3]);
            { u32x4 w; w.x = pkbf(a0[0] * gk0[0], a0[1] * gk0[1]); w.y = pkbf(a0[2] * gk0[2], a0[3] * gk0[3]); w.z = pkbf(a1[0] * gk1[0], a1[1] * gk1[1]); w.w = pkbf(a1[2] * gk1[2], a1[3] * gk1[3]);
              *(u32x4*)(trow + 32 * it) = w; }
#pragma unroll
            for (int s_ = 0; s_ < 4; ++s_) {
                acc0 = __builtin_amdgcn_mfma_f32_16x16x4f32(a0[s_], b00[s_], acc0, 0, 0, 0);
                acc1 = __builtin_amdgcn_mfma_f32_16x16x4f32(a0[s_], b10[s_], acc1, 0, 0, 0);
                acc2 = __builtin_amdgcn_mfma_f32_16x16x4f32(a0[s_], b20[s_], acc2, 0, 0, 0);
            }
#pragma unroll
            for (int s_ = 0; s_ < 4; ++s_) {
                acc0 = __builtin_amdgcn_mfma_f32_16x16x4f32(a1[s_], b01[s_], acc0, 0, 0, 0);
                acc1 = __builtin_amdgcn_mfma_f32_16x16x4f32(a1[s_], b11[s_], acc1, 0, 0, 0);
                acc2 = __builtin_amdgcn_mfma_f32_16x16x4f32(a1[s_], b21[s_], acc2, 0, 0, 0);
            }
            a0 = na0; a1 = na1; b00 = nb00; b01 = nb01; b10 = nb10; b11 = nb11; b20 = nb20; b21 = nb21;
            na0 = ma0; na1 = ma1; nb00 = mb00; nb01 = mb01; nb10 = mb10; nb11 = mb11; nb20 = mb20; nb21 = mb21;
        }
        if (kh == 1) {
#pragma unroll
            for (int r = 0; r < 4; ++r) { part[r * 64 + lane] = acc0[r]; part[(4 + r) * 64 + lane] = acc1[r]; part[(8 + r) * 64 + lane] = acc2[r]; }
            part[12 * 64 + lane] = ssq;
        }
        __syncthreads();
        if (kh == 0) {
#pragma unroll
            for (int r = 0; r < 4; ++r) { acc0[r] += part[r * 64 + lane]; acc1[r] += part[(4 + r) * 64 + lane]; acc2[r] += part[(8 + r) * 64 + lane]; }
            ssq += part[12 * 64 + lane];
        ssq += shx(ssq, lane, 16); ssq += shx(ssq, lane, 32);
        const float rstd = 1.0f / sqrtf(ssq * (1.0f / DMODEL) + EPS_F);
#pragma unroll
        for (int r = 0; r < 4; ++r) { lg[(4 * g4 + r) * 52 + row] = acc0[r]; lg[(4 * g4 + r) * 52 + 16 + row] = acc1[r]; lg[(4 * g4 + r) * 52 + 32 + row] = acc2[r]; }
        asm volatile("s_waitcnt lgkmcnt(0)" ::: "memory");
        if (lane < 16) {
            const int t = tok0 + lane; const LAS float* lr = lg + lane * 52;
            float gl[4];
#pragma unroll
            for (int k = 0; k < 4; ++k) gl[k] = lr[k] * rstd + b_rg[k];
            int grp = 0; float gmx = gl[0];
#pragma unroll
            for (int k = 1; k < 4; ++k) if (gl[k] > gmx) { gmx = gl[k]; grp = k; }
            float gz = 0.f;
#pragma unroll
            for (int k = 0; k < 4; ++k) gz += __expf(gl[k] - gmx);
            const float p_grp = 1.0f / gz;
            float el[8];
#pragma unroll
            for (int k = 0; k < 8; ++k) el[k] = lr[4 + grp * 8 + k] * rstd + b_re[grp * 8 + k];
            int i1 = 0; float m1 = el[0];
#pragma unroll
            for (int k = 1; k < 8; ++k) if (el[k] > m1) { m1 = el[k]; i1 = k; }
            int i2 = -1; float m2 = -INFINITY;
#pragma unroll
            for (int k = 0; k < 8; ++k) if (k != i1 && el[k] > m2) { m2 = el[k]; i2 = k; }
            const float e2 = __expf(m2 - m1); const float den = 1.0f / (1.0f + e2);
            const float g1 = p_grp * den, g2 = p_grp * e2 * den;
            const int ex1 = grp * 8 + i1, ex2 = grp * 8 + i2;
            const unsigned r1 = atomicAdd(ctl + 64 * ex1, 1u), r2 = atomicAdd(ctl + 64 * ex2, 1u);
            asg_e[2 * t] = ex1; asg_e[2 * t + 1] = ex2; asg_r[2 * t] = (int)r1; asg_r[2 * t + 1] = (int)r2; asg_g[2 * t] = g1; asg_g[2 * t + 1] = g2;
            tok_rs[t] = rstd;
        }
        }
        __syncthreads();
    }
    }
    XBAR();
    STAMP(8);

    LAS int* tile_start = (LAS int*)(lds + LDS_MISC);
    {
    PH_LOCALS
    if (tid == 0) {
        int acc_t = 0;
        for (int e = 0; e < 32; ++e) { tile_start[e] = acc_t; const int c = (int)__hip_atomic_load(ctl + 64 * e, __ATOMIC_RELAXED, __HIP_MEMORY_SCOPE_AGENT); acc_t += (c + 255) >> 8; }
        tile_start[32] = acc_t;
    }
    __syncthreads();
    for (int a = gtid; a < 2 * T_TOK; a += NGT) {
        const int t = a >> 1; const int e = asg_e[a], rk = asg_r[a]; const int slot = tile_start[e] * 256 + rk;
        row_tok[slot] = t; row_gate[slot] = asg_g[a]; tok_slot[a] = slot; ((float*)(ws + WS_WC + 524288))[slot] = ((const float*)(ws + WS_WC + 786432))[t];
    }
    }
    XBAR();
    STAMP(9);

    {
        PH_LOCALS
        pg8::Gemm g{TN, WGU, MAXSLOT, 2048, 2048}; pg8::ExpertOrderT<true> S{tile_start, G, bx, row_tok};
        pg8::EpiSwiglu E{HMID, (const float*)(ws + WS_WC + 524288)};
        pg8::gemm_phase<pg8::EpiSwiglu, pg8::ExpertOrderT<true>, true, true>(lds, g, S, E, tid);
    }
    XBAR();
    STAMP(10);
    {
        PH_LOCALS
        pg8::Gemm g{HMID, WD, MAXSLOT, 2048, 1024}; pg8::ExpertOrderT<false> S{tile_start, G, bx, nullptr};
        pg8::EpiDown E{Y, row_gate};
        pg8::gemm_phase<pg8::EpiDown, pg8::ExpertOrderT<false>, true, true>(lds, g, S, E, tid);
    }
    XBAR();
    STAMP(11);
#if PROF_PHASE >= 0
    XBAR();
#endif

    {
    PH_LOCALS
    const float* g_fin = IN(16);
#if DBG_CMP
    const float dbg_scale = 1.0f + 4.0f * sqrtf(__hip_atomic_load((float*)(ctl + 4096), __ATOMIC_RELAXED, __HIP_MEMORY_SCOPE_AGENT) / __hip_atomic_load((float*)(ctl + 4097), __ATOMIC_RELAXED, __HIP_MEMORY_SCOPE_AGENT));
#elif PROF_PHASE >= 0 && (PROF_PHASE % 100) != 12
    const unsigned ta_ = __hip_atomic_load(ctl + 6000 + (PROF_PHASE / 100), __ATOMIC_RELAXED, __HIP_MEMORY_SCOPE_AGENT), tb_ = __hip_atomic_load(ctl + 6000 + (PROF_PHASE % 100), __ATOMIC_RELAXED, __HIP_MEMORY_SCOPE_AGENT);
    const float dbg_scale = 1.0f + sqrtf(PROF_SCALE * (float)(tb_ - ta_) * 0.01f);
#else
    const float dbg_scale = 1.0f;
#endif
    for (int t = gw; t < T_TOK; t += 2 * NGW) {
        const int t1 = (t + NGW < T_TOK) ? t + NGW : t;
        const int sa0 = tok_slot[2 * t], sa1 = tok_slot[2 * t + 1], sb0 = tok_slot[2 * t1], sb1 = tok_slot[2 * t1 + 1];
        f32x4* hra = (f32x4*)(out + (size_t)t * DMODEL) + lane; f32x4* hrb = (f32x4*)(out + (size_t)t1 * DMODEL) + lane;
        const u32x2* ya0 = (const u32x2*)(Y + (size_t)sa0 * DMODEL) + lane; const u32x2* ya1 = (const u32x2*)(Y + (size_t)sa1 * DMODEL) + lane;
        const u32x2* yb0 = (const u32x2*)(Y + (size_t)sb0 * DMODEL) + lane; const u32x2* yb1 = (const u32x2*)(Y + (size_t)sb1 * DMODEL) + lane;
        f32x4 va[8], vb[8]; u32x2 pa[8], qa[8], pb[8], qb[8];
#pragma unroll
        for (int j = 0; j < 8; ++j) { va[j] = hra[64 * j]; vb[j] = hrb[64 * j]; pa[j] = ya0[64 * j]; qa[j] = ya1[64 * j]; pb[j] = yb0[64 * j]; qb[j] = yb1[64 * j]; }
        float ssa = 0.f, ssb = 0.f;
#pragma unroll
        for (int j = 0; j < 8; ++j) {
            va[j][0] += bflo(pa[j].x) + bflo(qa[j].x); va[j][1] += bfhi(pa[j].x) + bfhi(qa[j].x); va[j][2] += bflo(pa[j].y) + bflo(qa[j].y); va[j][3] += bfhi(pa[j].y) + bfhi(qa[j].y);
            vb[j][0] += bflo(pb[j].x) + bflo(qb[j].x); vb[j][1] += bfhi(pb[j].x) + bfhi(qb[j].x); vb[j][2] += bflo(pb[j].y) + bflo(qb[j].y); vb[j][3] += bfhi(pb[j].y) + bfhi(qb[j].y);
            ssa += (va[j][0] * va[j][0] + va[j][1] * va[j][1]) + (va[j][2] * va[j][2] + va[j][3] * va[j][3]);
            ssb += (vb[j][0] * vb[j][0] + vb[j][1] * vb[j][1]) + (vb[j][2] * vb[j][2] + vb[j][3] * vb[j][3]);
        }
        const float ra = dbg_scale / sqrtf(wave_sum(ssa, lane) * (1.0f / DMODEL) + EPS_F), rb = dbg_scale / sqrtf(wave_sum(ssb, lane) * (1.0f / DMODEL) + EPS_F);
#pragma unroll
        for (int j = 0; j < 8; ++j) { const f32x4 gg = ((const f32x4*)g_fin)[lane + 64 * j]; hra[64 * j] = va[j] * ra * gg; if (t1 != t) hrb[64 * j] = vb[j] * rb * gg; }
    }
    }
#if PROF_PHASE >= 0
    if (PROF_PHASE % 100 == 12) {
        XBAR(); STAMP(12); XBAR();
        PH_LOCALS
        const unsigned ta_ = __hip_atomic_load(ctl + 6000 + (PROF_PHASE / 100), __ATOMIC_RELAXED, __HIP_MEMORY_SCOPE_AGENT), tb_ = __hip_atomic_load(ctl + 6012, __ATOMIC_RELAXED, __HIP_MEMORY_SCOPE_AGENT);
        const float sc_ = 1.0f + sqrtf(PROF_SCALE * (float)(tb_ - ta_) * 0.01f);
        for (size_t i = (size_t)gtid; i < (size_t)T_TOK * DMODEL / 4; i += (size_t)NGT) { f32x4 v = ((f32x4*)out)[i]; ((f32x4*)out)[i] = v * sc_; }
    }
#endif
}

extern "C" void kernel_launch(void* const* d_in, const int* in_sizes, int n_in, void* d_out, int out_size, void* d_ws, size_t ws_size, hipStream_t stream) {
    static int grid_blocks = 0;
    if (grid_blocks == 0) {
        if (n_in != 17 || out_size != T_TOK * DMODEL || ws_size < WS_END) { fprintf(stderr, "kernel_launch: unexpected problem (n_in %d, out %d, ws %zu < %zu)\n", n_in, out_size, ws_size, (size_t)WS_END); grid_blocks = -1; return; }
        int dev = 0, cus = 0, per_cu = 0;
        (void)hipGetDevice(&dev);
        (void)hipDeviceGetAttribute(&cus, hipDeviceAttributeMultiprocessorCount, dev);
        if (hipFuncSetAttribute((const void*)mega_fwd, hipFuncAttributeMaxDynamicSharedMemorySize, LDS_BYTES) != hipSuccess) { fprintf(stderr, "kernel_launch: hipFuncSetAttribute failed\n"); grid_blocks = -1; return; }
        if (hipOccupancyMaxActiveBlocksPerMultiprocessor(&per_cu, (const void*)mega_fwd, 512, LDS_BYTES) != hipSuccess || per_cu < 1) { fprintf(stderr, "kernel_launch: occupancy query says %d\n", per_cu); grid_blocks = -1; return; }
        grid_blocks = cus;
        fprintf(stderr, "kernel_launch: cus %d per_cu %d grid %d ws %zu need %zu\n", cus, per_cu, grid_blocks, ws_size, (size_t)WS_END);
    }
    if (grid_blocks < 0) return;
    if (hipMemsetAsync((char*)d_ws + WS_CTL, 0, 65536, stream) != hipSuccess) { fprintf(stderr, "kernel_launch: memset of control words failed\n"); return; }
    Params prm{};
    for (int i = 0; i < 17; ++i) prm.in[i] = (const float*)d_in[i];
    prm.out = (float*)d_out; prm.ws = (unsigned char*)d_ws;
    void* args[] = {&prm};
    hipError_t e = hipLaunchCooperativeKernel((void*)mega_fwd, dim3(grid_blocks), dim3(512), args, LDS_BYTES, stream);
    if (e != hipSuccess) fprintf(stderr, "cooperative launch failed: %s (grid %d)\n", hipGetErrorString(e), grid_blocks);
}
```

```cpp
#include <hip/hip_runtime.h>
#include <hip/hip_cooperative_groups.h>
#include <cstdio>
#include <cstdint>
namespace cg = cooperative_groups;
namespace pg8 {
#define PG8_LAS __attribute__((address_space(3)))
typedef unsigned short bf16_t;
typedef short bf16x8 __attribute__((ext_vector_type(8)));
typedef float f32x4 __attribute__((ext_vector_type(4)));
typedef unsigned u32x4 __attribute__((ext_vector_type(4)));
constexpr int BM = 256, BK = 64, HALF = 128, HTB = HALF * BK * 2  , STAGE_BYTES = 8 * HTB, NXCD = 8, WGM = 8;

__host__ __device__ __forceinline__ int lds_byte(int r, int c) { const int st = (r >> 4) * 2 + (c >> 5), rr = r & 15, cc = c & 31, ob = rr * 64 + cc * 2; return st * 1024 + (ob ^ (((ob >> 9) & 1) << 5)); }
__host__ __device__ __forceinline__ void stage_rc(int b, int& R, int& C) { const int st = b / 1024, sb = b % 1024, swz = sb ^ (((sb >> 9) & 1) << 5); R = (st >> 1) * 16 + swz / 64; C = (st & 1) * 32 + (swz % 64) / 2; }
__host__ __device__ __forceinline__ int perm32(int rho) { const int n = rho >> 4, i = rho & 15; return 8 * (i >> 2) + 4 * n + (i & 3); }

struct Unit { int pm, pn, e; };
struct Gemm { const bf16_t* A; const bf16_t* Bt; int M, N, K; };

struct StaticOrder {
    int nM, nN, nwg, G, c;
    __host__ __device__ void init(int M, int N, int G_, int c_) { nM = M / BM; nN = N / BM; nwg = nM * nN; G = G_; c = c_; }
    __host__ __device__ bool next(int i, Unit& u) const {
        const long L = (long)i * G + c; if (L >= nwg) return false;
        int wgid = (int)L; { const int q = nwg / NXCD, r = nwg % NXCD, xcd = wgid % NXCD, off = wgid / NXCD; wgid = (xcd < r ? xcd * (q + 1) : r * (q + 1) + (xcd - r) * q) + off; }
        const int nig = WGM * nN, gid = wgid / nig, fm = gid * WGM, gsz = (nM - fm) < WGM ? (nM - fm) : WGM;
        u.pm = fm + ((wgid % nig) % gsz); u.pn = (wgid % nig) / gsz; u.e = 0; return true;
    }
    static constexpr bool GATHER = false;
    __device__ __forceinline__ unsigned rowoff(int) const { return 0u; }
    __device__ __forceinline__ void a_ready(const Unit&) const {}
    __device__ __forceinline__ void done(const Unit&) const {}
};

template <class Epi, class Sched, bool ALIGN_EPI = false, bool SP2 = false>
__device__ __forceinline__ void gemm_phase(PG8_LAS unsigned char* lds, const Gemm g, const Sched& S, const Epi& E, const int tid) {
    const int wid = __builtin_amdgcn_readfirstlane(tid >> 6), lane = tid & 63, wr = wid >> 2, wc = wid & 3, fr = lane & 15, fq = lane >> 4;
    const int K = g.K, nt = K / BK;
    constexpr bool GA = Sched::GATHER;
    static_assert(!GA || SP2, "the gather path is written for the SP2 loop");
    unsigned voffA[2], voffB[2]; int gR[2], gC[2];
#pragma unroll
    for (int i = 0; i < 2; ++i) { int R, C; stage_rc(tid * 16 + i * 8192, R, C); const int Rb = Epi::PERM ? ((R & ~31) + perm32(R & 31)) : R;
        voffA[i] = (unsigned)(R * K + C) * 2u; voffB[i] = (unsigned)(Rb * K + C) * 2u; gR[i] = R; gC[i] = C; }
    unsigned cvo0[2] = {0u, 0u}, cvo1[2] = {0u, 0u}, nvo0[2] = {0u, 0u}, nvo1[2] = {0u, 0u}, sel0[2] = {0u, 0u}, sel1[2] = {0u, 0u};
#define PG8_GOFF(u_, o0_, o1_) do { _Pragma("unroll") for (int _i = 0; _i < 2; ++_i) { \
        o0_[_i] = S.rowoff((u_).pm * BM + gR[_i]) * (unsigned)(K * 2) + (unsigned)gC[_i] * 2u; o1_[_i] = S.rowoff((u_).pm * BM + HALF + gR[_i]) * (unsigned)(K * 2) + (unsigned)gC[_i] * 2u; } } while (0)
#define PG8_STAGE_A(bufoff, base, h_, CUR_) do { if constexpr (GA) { if (CUR_) { if (h_) PG8_STAGE(bufoff, base, cvo1); else PG8_STAGE(bufoff, base, cvo0); } else { if (h_) PG8_STAGE(bufoff, base, sel1); else PG8_STAGE(bufoff, base, sel0); } } \
        else PG8_STAGE(bufoff, (base) + (h_) * hstep, voffA); } while (0)
    const size_t kstep = (size_t)(BK * 2);
    const size_t hstep = (size_t)HALF * K * 2;
    const size_t tstep = 2 * hstep;
    const unsigned ldsw = (unsigned)wid * 1024u;
    const int aoff = lds_byte(wr * 64 + fr, fq * 8), boff = lds_byte(wc * 32 + fr, fq * 8);
#define PG8_SA(b, h) (((b) * 2 + (h)) * HTB)
#define PG8_SB(b, h) ((4 + (b) * 2 + (h)) * HTB)
#define PG8_STAGE(bufoff, gbase, voff) do { _Pragma("unroll") for (int _i = 0; _i < 2; ++_i) \
        __builtin_amdgcn_global_load_lds((const unsigned*)((const char*)(gbase) + (voff)[_i]), (PG8_LAS unsigned*)(lds + (bufoff) + ldsw + _i * 8192), 16, 0, 0); } while (0)
#define PG8_LDA(dst, b, h) do { _Pragma("unroll") for (int m = 0; m < 4; ++m) _Pragma("unroll") for (int k = 0; k < 2; ++k) dst[m][k] = *(const PG8_LAS bf16x8*)(lds + PG8_SA(b, h) + aoff + m * 2048 + k * 1024); } while (0)
#define PG8_LDB(dst, b, h) do { _Pragma("unroll") for (int n = 0; n < 2; ++n) _Pragma("unroll") for (int k = 0; k < 2; ++k) dst[n][k] = *(const PG8_LAS bf16x8*)(lds + PG8_SB(b, h) + boff + n * 2048 + k * 1024); } while (0)
#define PG8_MMA(ai, bj, At, Bt) do { __builtin_amdgcn_s_setprio(1); _Pragma("unroll") for (int m = 0; m < 4; ++m) _Pragma("unroll") for (int n = 0; n < 2; ++n) _Pragma("unroll") for (int k = 0; k < 2; ++k) \
        acc[ai][bj][m][n] = __builtin_amdgcn_mfma_f32_16x16x32_bf16(Bt[n][k], At[m][k], acc[ai][bj][m][n], 0, 0, 0); __builtin_amdgcn_s_setprio(0); } while (0)
#define PG8_WAIT_V(n) asm volatile("s_waitcnt vmcnt(" #n ")" ::: "memory")
#define PG8_WAIT_L(n) asm volatile("s_waitcnt lgkmcnt(" #n ")" ::: "memory")
#define PG8_BAR __builtin_amdgcn_s_barrier()
#define PG8_SCHED __builtin_amdgcn_sched_barrier(0)
    Unit cur, nxt; int ui = 0;
    if (!S.next(0, cur)) return;
    f32x4 acc[2][2][4][2];
#pragma unroll
    for (int a = 0; a < 2; ++a)
#pragma unroll
        for (int b = 0; b < 2; ++b)
#pragma unroll
            for (int m = 0; m < 4; ++m)
#pragma unroll
                for (int n = 0; n < 2; ++n) acc[a][b][m][n] = (f32x4){0.f, 0.f, 0.f, 0.f};
    bf16x8 At[4][2], B0[2][2], B1[2][2];
    const size_t estep = (size_t)g.N * K * 2;
    const char* cA = (const char*)g.A + (GA ? (size_t)0 : (size_t)cur.pm * tstep); const char* cB = (const char*)g.Bt + (size_t)cur.e * estep + (size_t)cur.pn * tstep;
    S.a_ready(cur);
    if constexpr (GA) PG8_GOFF(cur, cvo0, cvo1);
    if constexpr (SP2) {
        PG8_STAGE(PG8_SB(0, 0), cB, voffB); PG8_STAGE(PG8_SB(0, 1), cB + hstep, voffB); PG8_STAGE_A(PG8_SA(0, 0), cA, 0, true); PG8_STAGE_A(PG8_SA(0, 1), cA, 1, true);
        if (wr == 1) PG8_BAR;
        PG8_WAIT_V(2); PG8_BAR;
        PG8_STAGE(PG8_SB(1, 0), cB + kstep, voffB); PG8_STAGE_A(PG8_SA(1, 0), cA + kstep, 0, true); PG8_STAGE(PG8_SB(1, 1), cB + hstep + kstep, voffB);
        PG8_WAIT_V(6); PG8_BAR;
    } else {
        PG8_STAGE(PG8_SB(0, 0), cB, voffB); PG8_STAGE(PG8_SA(0, 0), cA, voffA); PG8_STAGE(PG8_SB(0, 1), cB + hstep, voffB); PG8_STAGE(PG8_SA(0, 1), cA + hstep, voffA);
        if (wr == 1) PG8_BAR;
        PG8_WAIT_V(4); PG8_BAR;
        PG8_STAGE(PG8_SB(1, 0), cB + kstep, voffB); PG8_STAGE(PG8_SA(1, 0), cA + kstep, voffA); PG8_STAGE(PG8_SB(1, 1), cB + hstep + kstep, voffB);
        PG8_WAIT_V(6); PG8_BAR;
    }
    for (;;) {
        const bool has_next = S.next(ui + 1, nxt);
        const char* nA = has_next ? (const char*)g.A + (GA ? (size_t)0 : (size_t)nxt.pm * tstep) : cA;
        if constexpr (GA) { if (has_next) PG8_GOFF(nxt, nvo0, nvo1); else { nvo0[0] = cvo0[0]; nvo0[1] = cvo0[1]; nvo1[0] = cvo1[0]; nvo1[1] = cvo1[1]; } } const char* nB = has_next ? (const char*)g.Bt + (size_t)nxt.e * estep + (size_t)nxt.pn * tstep : cB;
        for (int t = 0; t < nt; t += 2) {
            const bool last = (t == nt - 2);
            const char* a1 = cA + (size_t)(t + 1) * kstep;
            const char* a2 = last ? nA : cA + (size_t)(t + 2) * kstep; const char* b2 = last ? nB : cB + (size_t)(t + 2) * kstep;
            const char* a3 = a2 + kstep; const char* b3 = b2 + kstep;
            if (last && has_next) S.a_ready(nxt);
            if constexpr (GA) { sel0[0] = last ? nvo0[0] : cvo0[0]; sel0[1] = last ? nvo0[1] : cvo0[1]; sel1[0] = last ? nvo1[0] : cvo1[0]; sel1[1] = last ? nvo1[1] : cvo1[1]; }
            if constexpr (Epi::HAS_MID) { if (t == nt / 2) E.mid(acc, cur, wr, wc, fr, fq); }
            if constexpr (SP2) {
            PG8_LDB(B0, 0, 0); PG8_LDB(B1, 0, 1); PG8_SCHED; PG8_LDA(At, 0, 0); PG8_STAGE_A(PG8_SA(1, 1), a1, 1, true);
            PG8_WAIT_V(8); PG8_WAIT_L(0); PG8_BAR; PG8_MMA(0, 0, At, B0); PG8_MMA(0, 1, At, B1); PG8_BAR; PG8_SCHED;
            PG8_LDA(At, 0, 1); PG8_STAGE(PG8_SB(0, 0), b2, voffB); PG8_STAGE(PG8_SB(0, 1), b2 + hstep, voffB); PG8_STAGE_A(PG8_SA(0, 0), a2, 0, false);
            PG8_WAIT_V(8); PG8_WAIT_L(0); PG8_BAR; PG8_MMA(1, 0, At, B0); PG8_MMA(1, 1, At, B1); PG8_BAR; PG8_SCHED;
            PG8_LDB(B0, 1, 0); PG8_LDB(B1, 1, 1); PG8_SCHED; PG8_LDA(At, 1, 0); PG8_STAGE_A(PG8_SA(0, 1), a2, 1, false);
            PG8_WAIT_V(8); PG8_WAIT_L(0); PG8_BAR; PG8_MMA(0, 0, At, B0); PG8_MMA(0, 1, At, B1); PG8_BAR; PG8_SCHED;
            PG8_LDA(At, 1, 1); PG8_STAGE(PG8_SB(1, 0), b3, voffB); PG8_STAGE(PG8_SB(1, 1), b3 + hstep, voffB); PG8_STAGE_A(PG8_SA(1, 0), a3, 0, false);
            PG8_WAIT_V(8); PG8_WAIT_L(0); PG8_BAR; PG8_MMA(1, 0, At, B0); PG8_MMA(1, 1, At, B1); PG8_BAR; PG8_SCHED;
            } else {
            PG8_LDB(B0, 0, 0); PG8_SCHED; PG8_LDA(At, 0, 0); PG8_STAGE(PG8_SA(1, 1), a1 + hstep, voffA);
            PG8_WAIT_L(8); PG8_BAR; PG8_WAIT_L(0); PG8_MMA(0, 0, At, B0); PG8_BAR; PG8_SCHED;
            PG8_LDB(B1, 0, 1); PG8_STAGE(PG8_SB(0, 0), b2, voffB);
            PG8_BAR; PG8_WAIT_L(0); PG8_MMA(0, 1, At, B1); PG8_BAR;
            PG8_LDA(At, 0, 1); PG8_STAGE(PG8_SA(0, 0), a2, voffA);
            PG8_BAR; PG8_WAIT_L(0); PG8_MMA(1, 0, At, B0); PG8_BAR; PG8_SCHED;
            PG8_STAGE(PG8_SB(0, 1), b2 + hstep, voffB);
            PG8_WAIT_V(6); PG8_BAR; PG8_MMA(1, 1, At, B1); PG8_BAR;
            PG8_LDB(B0, 1, 0); PG8_SCHED; PG8_LDA(At, 1, 0); PG8_STAGE(PG8_SA(0, 1), a2 + hstep, voffA);
            PG8_WAIT_L(8); PG8_BAR; PG8_WAIT_L(0); PG8_MMA(0, 0, At, B0); PG8_BAR; PG8_SCHED;
            PG8_LDB(B1, 1, 1); PG8_STAGE(PG8_SB(1, 0), b3, voffB);
            PG8_BAR; PG8_WAIT_L(0); PG8_MMA(0, 1, At, B1); PG8_BAR;
            PG8_LDA(At, 1, 1); PG8_STAGE(PG8_SA(1, 0), a3, voffA);
            PG8_BAR; PG8_WAIT_L(0); PG8_MMA(1, 0, At, B0); PG8_BAR; PG8_SCHED;
            PG8_STAGE(PG8_SB(1, 1), b3 + hstep, voffB);
            PG8_WAIT_V(6); PG8_BAR; PG8_MMA(1, 1, At, B1); PG8_BAR;
            }
        }
        if constexpr (ALIGN_EPI) { if (wr == 0) PG8_BAR; }
        if constexpr (!Epi::AFTER_DRAIN) { E(acc, cur, wr, wc, fr, fq); S.done(cur); }
        if (!has_next) break;
#pragma unroll
        for (int a = 0; a < 2; ++a)
#pragma unroll
            for (int b = 0; b < 2; ++b)
#pragma unroll
                for (int m = 0; m < 4; ++m)
#pragma unroll
                    for (int n = 0; n < 2; ++n) acc[a][b][m][n] = (f32x4){0.f, 0.f, 0.f, 0.f};
        cur = nxt; cA = nA; cB = nB; ++ui;
        if constexpr (GA) { cvo0[0] = nvo0[0]; cvo0[1] = nvo0[1]; cvo1[0] = nvo1[0]; cvo1[1] = nvo1[1]; }
        if constexpr (ALIGN_EPI) { if (wr == 1) PG8_BAR; }
    }
    PG8_WAIT_V(0);
    if constexpr (!ALIGN_EPI) { if (wr == 0) PG8_BAR; }
    PG8_BAR;
    if constexpr (Epi::AFTER_DRAIN) { E.fused(acc, cur, wr, wc, fr, fq, lds, wid, lane); S.done(cur); }
#undef PG8_SA
#undef PG8_SB
#undef PG8_STAGE
#undef PG8_STAGE_A
#undef PG8_GOFF
#undef PG8_LDA
#undef PG8_LDB
#undef PG8_MMA
#undef PG8_WAIT_V
#undef PG8_WAIT_L
#undef PG8_BAR
#undef PG8_SCHED
}
}

#ifndef DBG_CMP
#define DBG_CMP 0
#endif
#define LAS __attribute__((address_space(3)))
typedef unsigned short bf16_t;
typedef float f32x4 __attribute__((ext_vector_type(4)));
typedef unsigned u32x4 __attribute__((ext_vector_type(4)));
typedef unsigned u32x2 __attribute__((ext_vector_type(2)));
typedef unsigned long long u64;

constexpr int T_TOK = 16384, DMODEL = 2048, SEQL = 2048;
constexpr int NPROJ = 9984;
constexpr int C_QLAT = 0, C_CKV = 1024, C_QIDX = 1152, C_KIDX = 1664, C_WIDX = 1728, C_QR = 1792, C_KR = 2816, C_VR = 3840, C_GR = 4864, C_GBR = 5888;
constexpr int MAXSLOT = 40960;
constexpr float EPS_F = 1e-6f;
constexpr float IDX_SCALE = 0.04419417382415922f;
constexpr float ATT_SCALE = 0.08838834764831845f;
constexpr float K_SCALE = 0.08838834764831845f;

constexpr size_t WS_CTL = 0;
constexpr size_t WS_ROT = 65536;
constexpr size_t WS_WIN = WS_ROT + 1048576;
constexpr size_t WS_WCOMB = WS_WIN + (size_t)NPROJ * 2048 * 2;
constexpr size_t WS_WB = WS_WCOMB + (size_t)2048 * 1024 * 2;
constexpr size_t WS_WO = WS_WB + (size_t)2048 * 1024 * 2;
constexpr size_t WS_WGU = WS_WO + (size_t)2048 * 2048 * 2;
constexpr size_t WS_WD = WS_WGU + (size_t)32 * 2048 * 2048 * 2;
constexpr size_t WS_P = WS_WD + (size_t)32 * 2048 * 1024 * 2;
constexpr size_t WS_HMID = WS_P;
constexpr size_t WS_Y = WS_HMID + (size_t)MAXSLOT * 1024 * 2;
constexpr size_t WS_XN = WS_P + (size_t)T_TOK * NPROJ * 2;
constexpr size_t WS_OA = WS_XN + (size_t)T_TOK * 2048 * 2;
constexpr size_t WS_OB = WS_OA + (size_t)T_TOK * 1024 * 2;
constexpr size_t WS_MIXED = WS_OB + (size_t)T_TOK * 1024 * 2;
constexpr size_t WS_SPARE = WS_MIXED + (size_t)T_TOK * 2048 * 2;
constexpr size_t WS_XG = WS_OA;
constexpr size_t WS_KV = WS_SPARE + (size_t)T_TOK * 1024 * 2;
constexpr size_t WS_MASK = WS_KV + (size_t)T_TOK * 128 * 2;
constexpr size_t WS_MISC = WS_MASK + (size_t)T_TOK * 256;
constexpr size_t WS_WC = WS_MISC + 1048576;
constexpr size_t WS_END = WS_WC + 1048576;
static_assert(WS_Y + (size_t)MAXSLOT * 2048 * 2 <= WS_XN, "HMID + Y must fit in P");
static_assert(WS_XG + (size_t)MAXSLOT * 2048 * 2 <= WS_KV, "XG must fit in OA..SPARE");
static_assert(WS_END <= (size_t)1073741824, "workspace budget");
constexpr int MI_ROWTOK = 0, MI_ROWGATE = MAXSLOT, MI_TOKSLOT = 2 * MAXSLOT, MI_ASGE = MI_TOKSLOT + 2 * T_TOK, MI_ASGR = MI_ASGE + 2 * T_TOK, MI_ASGG = MI_ASGR + 2 * T_TOK;
static_assert((size_t)(MI_ASGG + 2 * T_TOK) * 4 <= 1048576, "misc budget");
constexpr int LDS_BYTES = 152 * 1024;
constexpr int LDS_MISC = 150 * 1024;

__device__ __forceinline__ float bflo(unsigned w) { return __uint_as_float(w << 16); }
__device__ __forceinline__ float bfhi(unsigned w) { return __uint_as_float(w & 0xffff0000u); }
__device__ __forceinline__ unsigned pkbf(float lo, float hi) { unsigned r; asm volatile("v_cvt_pk_bf16_f32 %0, %1, %2" : "=v"(r) : "v"(lo), "v"(hi)); return r; }
__device__ __forceinline__ int hide_i(int v) { asm volatile("" : "+v"(v)); return v; }
template <class Tp> __device__ __forceinline__ Tp* hide_p(Tp* q) { asm volatile("" : "+s"(q)); return q; }
__device__ __forceinline__ float shx(float v, int lane, int o) { return __int_as_float(__builtin_amdgcn_ds_bpermute((lane ^ o) << 2, __float_as_int(v))); }
__device__ __forceinline__ float wave_sum(float v, int lane) {
#pragma unroll
    for (int o = 1; o < 64; o <<= 1) v += shx(v, lane, o);
    return v;
}
__device__ __forceinline__ float wave_max(float v, int lane) {
#pragma unroll
    for (int o = 1; o < 64; o <<= 1) v = fmaxf(v, shx(v, lane, o));
    return v;
}
__device__ __forceinline__ float sigmoidf_(float x) { return __builtin_amdgcn_rcpf(1.0f + __expf(-x)); }
__device__ __forceinline__ float siluf_(float x) { return x * sigmoidf_(x); }
__device__ __forceinline__ float unkey(unsigned k) { return __uint_as_float((k & 0x80000000u) ? (k & 0x7fffffffu) : ~k); }
__device__ __forceinline__ int sbin(float s) { const int b = (int)(s * 32.0f + 128.0f); return b < 0 ? 0 : (b > 255 ? 255 : b); }
__device__ __forceinline__ unsigned fkey(float f) { const unsigned u = __float_as_uint(f + 0.0f); return (u & 0x80000000u) ? ~u : (u | 0x80000000u); }


#define XB_TMO      128
#define XB_XCNT(j)  (256  + 64 * (j))
#define XB_XSUB(j)  (1280 + 64 * (j))
#define XB_XGEN(j)  (2304 + 64 * (j))
#define XB_TOP      3328
#define XB_TOPGEN   3392
#define XCD_BAR_WORDS 3456
#define XB_SPIN_CAP (1u << 18)
__device__ __forceinline__ unsigned xb_ld(unsigned* p)              { return __hip_atomic_load(p, __ATOMIC_RELAXED, __HIP_MEMORY_SCOPE_AGENT); }
__device__ __forceinline__ unsigned xb_add(unsigned* p, unsigned v) { return __hip_atomic_fetch_add(p, v, __ATOMIC_RELAXED, __HIP_MEMORY_SCOPE_AGENT); }
__device__ __forceinline__ unsigned xb_xcc_id() { return (unsigned)__builtin_amdgcn_s_getreg((3 << 11) | 20) & 0xFu; }
#define XB_SPIN(cond, bar) do { unsigned _sp = 0; while (cond) { __builtin_amdgcn_s_sleep(1); \
    if ((++_sp & 255u) == 0u) { if (xb_ld(&(bar)[XB_TMO])) break; if (_sp > XB_SPIN_CAP) { atomicAdd(&(bar)[XB_TMO], 1u); break; } } } } while (0)
struct XcdBarrier { unsigned* bar; unsigned x; volatile __attribute__((address_space(3))) unsigned* st; };
__device__ __forceinline__ void xcd_barrier_complete(unsigned* bar, unsigned x, unsigned& nloc, unsigned& nx) {
    const unsigned G = gridDim.x * gridDim.y * gridDim.z;
    unsigned sum, cnt, mine, sp = 0u;
    for (;;) {
        sum = 0u; cnt = 0u; mine = 0u;
#pragma unroll
        for (unsigned j = 0; j < 16; ++j) { const unsigned c = xb_ld(&bar[XB_XCNT(j)]); sum += c; cnt += (c > 0u) ? 1u : 0u; mine = (j == x) ? c : mine; }
        if (sum == G) break;
        __builtin_amdgcn_s_sleep(1);
        if ((++sp & 255u) == 0u) { if (xb_ld(&bar[XB_TMO])) break; if (sp > XB_SPIN_CAP) { atomicAdd(&bar[XB_TMO], 1u); break; } }
    }
    nloc = mine > 0u ? mine : 1u; nx = cnt > 0u ? cnt : 1u;
}
__device__ __forceinline__ void xcd_barrier(const XcdBarrier& b, int tid) {
    asm volatile("s_waitcnt vmcnt(0)" ::: "memory");
    __syncthreads();
    if (tid == 0) {
        unsigned* bar = b.bar;
        __builtin_amdgcn_s_waitcnt(0);
        unsigned nloc = b.st[0], nx = b.st[1];
        if (nloc == 0u) { xcd_barrier_complete(bar, b.x, nloc, nx); b.st[0] = nloc; b.st[1] = nx; }
        const unsigned old = xb_add(&bar[XB_XSUB(b.x)], 1u);
        const unsigned gen = old / nloc;
        if (old + 1u == (gen + 1u) * nloc) {
            __builtin_amdgcn_fence(__ATOMIC_RELEASE, "agent");
            asm volatile("s_waitcnt vmcnt(0)" ::: "memory");
            const unsigned og = xb_add(&bar[XB_TOP], 1u);
            const unsigned tg = og / nx;
            if (og + 1u == (tg + 1u) * nx) xb_add(&bar[XB_TOPGEN], 1u);
            else XB_SPIN(xb_ld(&bar[XB_TOPGEN]) == tg, bar);
            __builtin_amdgcn_fence(__ATOMIC_ACQUIRE, "agent");
            xb_add(&bar[XB_XGEN(b.x)], 1u);
            asm volatile("s_waitcnt vmcnt(0)" ::: "memory");
        } else {
            XB_SPIN(xb_ld(&bar[XB_XGEN(b.x)]) == gen, bar);
            __builtin_amdgcn_fence(__ATOMIC_ACQUIRE, "agent");
            asm volatile("s_waitcnt vmcnt(0)" ::: "memory");
        }
    }
    __syncthreads();
}

namespace fa {
using bf16x8 = __attribute__((ext_vector_type(8))) short;
using s16x4  = __attribute__((ext_vector_type(4))) short;
using f32x16 = __attribute__((ext_vector_type(16))) float;
constexpr int TILE_B = 64 * 128 * 2;
constexpr int OFF_V = 0, OFF_K = 2 * TILE_B, OFF_M = 4 * TILE_B, OFF_WS = OFF_M + 2 * 256, OFF_Q = OFF_WS + 8 * 256, LDS_NEED = OFF_Q + 8 * 8704;
#define FA_GAS __attribute__((address_space(1)))
#define FA_KSWZ(row, colB) ((row) * 256 + ((colB) ^ (((row) & 7) << 4)))
#define FA_SBAR() __builtin_amdgcn_sched_barrier(0)
__device__ __forceinline__ int crow(int r, int hi) { return (r & 3) + 8 * (r >> 2) + 4 * hi; }
__device__ __forceinline__ int v_st(int k, int c) { const int kk = (k & ~0xC) | ((k & 4) << 1) | ((k & 8) >> 1); return ((kk >> 3) * 4 + (c >> 5)) * 512 + ((kk & 7) * 32 + (c & 31)) * 2; }
__device__ __forceinline__ int v_rd_base(int lane) { return ((lane & 3) << 3) | (((lane >> 2) & 3) << 6) | (((lane >> 4) & 1) << 5) | (((lane >> 5) & 1) << 8); }
constexpr int v_rd_off(int d0, int ks, int half) { return d0 * 512 + ks * 4096 + half * 2048; }
template <int OFF> __device__ __forceinline__ s16x4 tr_read(int vb) { s16x4 r; asm volatile("ds_read_b64_tr_b16 %0, %1 offset:%2" : "=&v"(r) : "v"(vb), "i"(OFF) : "memory"); return r; }
template <int D0> __device__ __forceinline__ void pv_one(f32x16& od, int vb, bf16x8 pa0, bf16x8 pa1, bf16x8 pa2, bf16x8 pa3) {
    const s16x4 l0 = tr_read<v_rd_off(D0, 0, 0)>(vb), h0 = tr_read<v_rd_off(D0, 0, 1)>(vb), l1 = tr_read<v_rd_off(D0, 1, 0)>(vb), h1 = tr_read<v_rd_off(D0, 1, 1)>(vb);
    const s16x4 l2 = tr_read<v_rd_off(D0, 2, 0)>(vb), h2 = tr_read<v_rd_off(D0, 2, 1)>(vb), l3 = tr_read<v_rd_off(D0, 3, 0)>(vb), h3 = tr_read<v_rd_off(D0, 3, 1)>(vb);
    asm volatile("s_waitcnt lgkmcnt(0)" ::: "memory"); FA_SBAR();
#define FA_PK(L, H) (bf16x8){L[0], L[1], L[2], L[3], H[0], H[1], H[2], H[3]}
    od = __builtin_amdgcn_mfma_f32_32x32x16_bf16(pa0, FA_PK(l0, h0), od, 0, 0, 0);
    od = __builtin_amdgcn_mfma_f32_32x32x16_bf16(pa1, FA_PK(l1, h1), od, 0, 0, 0);
    od = __builtin_amdgcn_mfma_f32_32x32x16_bf16(pa2, FA_PK(l2, h2), od, 0, 0, 0);
    od = __builtin_amdgcn_mfma_f32_32x32x16_bf16(pa3, FA_PK(l3, h3), od, 0, 0, 0);
#undef FA_PK
}
#define FA_RD8(D0, l0, h0, l1, h1, l2, h2, l3, h3) do { l0 = tr_read<v_rd_off(D0, 0, 0)>(vb); h0 = tr_read<v_rd_off(D0, 0, 1)>(vb); l1 = tr_read<v_rd_off(D0, 1, 0)>(vb); h1 = tr_read<v_rd_off(D0, 1, 1)>(vb); \
        l2 = tr_read<v_rd_off(D0, 2, 0)>(vb); h2 = tr_read<v_rd_off(D0, 2, 1)>(vb); l3 = tr_read<v_rd_off(D0, 3, 0)>(vb); h3 = tr_read<v_rd_off(D0, 3, 1)>(vb); } while (0)
#define FA_PK(L, H) (bf16x8){L[0], L[1], L[2], L[3], H[0], H[1], H[2], H[3]}
#define FA_MM4(od, l0, h0, l1, h1, l2, h2, l3, h3) do { od = __builtin_amdgcn_mfma_f32_32x32x16_bf16(pa0, FA_PK(l0, h0), od, 0, 0, 0); od = __builtin_amdgcn_mfma_f32_32x32x16_bf16(pa1, FA_PK(l1, h1), od, 0, 0, 0); \
        od = __builtin_amdgcn_mfma_f32_32x32x16_bf16(pa2, FA_PK(l2, h2), od, 0, 0, 0); od = __builtin_amdgcn_mfma_f32_32x32x16_bf16(pa3, FA_PK(l3, h3), od, 0, 0, 0); } while (0)
__device__ __forceinline__ void pv_all(f32x16 (&o)[4], int vb, bf16x8 pa0, bf16x8 pa1, bf16x8 pa2, bf16x8 pa3) {
    s16x4 a0, a1, a2, a3, a4, a5, a6, a7, b0, b1, b2, b3, b4, b5, b6, b7;
    FA_RD8(0, a0, a1, a2, a3, a4, a5, a6, a7);
    FA_RD8(1, b0, b1, b2, b3, b4, b5, b6, b7);
    asm volatile("s_waitcnt lgkmcnt(8)" ::: "memory"); FA_SBAR();
    FA_MM4(o[0], a0, a1, a2, a3, a4, a5, a6, a7); FA_SBAR();
    FA_RD8(2, a0, a1, a2, a3, a4, a5, a6, a7);
    asm volatile("s_waitcnt lgkmcnt(8)" ::: "memory"); FA_SBAR();
    FA_MM4(o[1], b0, b1, b2, b3, b4, b5, b6, b7); FA_SBAR();
    FA_RD8(3, b0, b1, b2, b3, b4, b5, b6, b7);
    asm volatile("s_waitcnt lgkmcnt(8)" ::: "memory"); FA_SBAR();
    FA_MM4(o[2], a0, a1, a2, a3, a4, a5, a6, a7); FA_SBAR();
    asm volatile("s_waitcnt lgkmcnt(0)" ::: "memory"); FA_SBAR();
    FA_MM4(o[3], b0, b1, b2, b3, b4, b5, b6, b7);
}
#undef FA_RD8
#undef FA_MM4
#undef FA_PK
template <bool QLDS>
__device__ __forceinline__ void qkt(f32x16& p0, f32x16& p1, const LAS char* Ks, const bf16x8 (&qr)[8], const LAS char* Ql, int r32, int hi) {
    p0 = f32x16{}; p1 = f32x16{};
#pragma unroll
    for (int d0 = 0; d0 < 8; ++d0) { const int cb = (d0 * 16 + hi * 8) * 2;
        const bf16x8 b0 = *(const LAS bf16x8*)(Ks + FA_KSWZ(r32, cb));
        const bf16x8 b1 = *(const LAS bf16x8*)(Ks + FA_KSWZ(32 + r32, cb));
        const bf16x8 q = QLDS ? *(const LAS bf16x8*)(Ql + d0 * 1024) : qr[d0];
        p0 = __builtin_amdgcn_mfma_f32_32x32x16_bf16(b0, q, p0, 0, 0, 0);
        p1 = __builtin_amdgcn_mfma_f32_32x32x16_bf16(b1, q, p1, 0, 0, 0); }
}
__device__ __forceinline__ void p_to_frag(const f32x16& p0, const f32x16& p1, bf16x8& pa0, bf16x8& pa1, bf16x8& pa2, bf16x8& pa3) {
#define FA_PK4(P, BASE, OUT) do { unsigned a0 = pkbf(P[BASE + 0], P[BASE + 1]), a1 = pkbf(P[BASE + 2], P[BASE + 3]);   \
    unsigned b0 = pkbf(P[BASE + 4], P[BASE + 5]), b1 = pkbf(P[BASE + 6], P[BASE + 7]);                              \
    auto r0 = __builtin_amdgcn_permlane32_swap(a0, b0, false, false); auto r1 = __builtin_amdgcn_permlane32_swap(a1, b1, false, false); \
    u32x4 w = {r0[0], r1[0], r0[1], r1[1]}; OUT = *reinterpret_cast<bf16x8*>(&w); } while (0)
    FA_PK4(p0, 0, pa0); FA_PK4(p0, 8, pa1); FA_PK4(p1, 0, pa2); FA_PK4(p1, 8, pa3);
#undef FA_PK4
}

struct UnitArgs {
    const bf16_t* Q; int ldq;
    const bf16_t* K; const bf16_t* V; int ldk;
    const u64* mask;
    int ntiles;
    int n0;
    float lgam;
};

template <int MODE, int EXP = 0>
__device__ __forceinline__ void unit_body(LAS char* L, const UnitArgs& U, int tid, f32x16 (&o)[4], float& l_out) {
    const int wid = __builtin_amdgcn_readfirstlane(tid >> 6), lane = tid & 63, r32 = lane & 31, hi = lane >> 5;
    LAS char* V_lds = L + OFF_V; LAS char* K_lds = L + OFF_K; LAS u64* M_lds = (LAS u64*)(L + OFF_M);
    LAS float* wsf = (LAS float*)(L + OFF_WS) + wid * 64; LAS float* al_l = wsf + 32;
    constexpr float C = ATT_SCALE * 1.4426950408889634f;
    float m_reg = -1e30f, l_reg = 0.f;
    bf16x8 qr[8];
    LAS char* Ql = L + OFF_Q + wid * 8192 + lane * 16;
    { const FA_GAS bf16_t* Qh = (const FA_GAS bf16_t*)hide_p(U.Q); const FA_GAS bf16_t* Qw = (MODE == 0) ? Qh + (size_t)r32 * U.ldq + wid * 128 + hi * 8 : Qh + (size_t)(wid * 32 + r32) * U.ldq + hi * 8;
#pragma unroll
      for (int d0 = 0; d0 < 8; ++d0) { qr[d0] = *(const FA_GAS bf16x8*)(Qw + d0 * 16); if (MODE == 1) *(LAS bf16x8*)(Ql + d0 * 1024) = qr[d0]; } }
    if (MODE == 1) { asm volatile("s_waitcnt vmcnt(0) lgkmcnt(0)" ::: "memory"); FA_SBAR(); }
    const int sr = tid >> 4, sc = (tid & 15) * 8, vst0 = v_st(sr, sc), vst1 = v_st(32 + sr, sc), kst0 = FA_KSWZ(sr, sc * 2), kst1 = FA_KSWZ(32 + sr, sc * 2);
    const FA_GAS char* Kh = (const FA_GAS char*)hide_p(U.K); const FA_GAS char* Vh = (const FA_GAS char*)hide_p(U.V);
    const int ldk_ = (EXP & 4) ? 128 : U.ldk;
    const unsigned goff0 = (unsigned)(sr * ldk_ + sc) * 2u, goff1 = (unsigned)((32 + sr) * ldk_ + sc) * 2u;
    const int vb0 = (int)(unsigned)(size_t)V_lds + v_rd_base(lane);
    bf16x8 ksA0, ksA1, vsA0, vsA1; u64 mwA = 0ull; unsigned pf_ = 0u;
#define FA_SLOAD(S, k0) do { const FA_GAS char* kb_ = Kh + (size_t)(k0) * ldk_ * 2; const FA_GAS char* vb_ = Vh + (size_t)(k0) * ldk_ * 2;     \
        ks##S##0 = *(const FA_GAS bf16x8*)(kb_ + goff0); ks##S##1 = *(const FA_GAS bf16x8*)(kb_ + goff1); \
        if (MODE == 1) { if (EXP & 2) { vs##S##0 = ks##S##0; vs##S##1 = ks##S##1; } else { vs##S##0 = *(const FA_GAS bf16x8*)(vb_ + goff0); vs##S##1 = *(const FA_GAS bf16x8*)(vb_ + goff1); } } \
        if (MODE == 0 && tid < 32) mw##S = U.mask[(size_t)tid * 32 + ((k0) >> 6)]; } while (0)
#define FA_SWRITE(S, b) do { *(LAS bf16x8*)(K_lds + (b) * TILE_B + kst0) = ks##S##0; *(LAS bf16x8*)(K_lds + (b) * TILE_B + kst1) = ks##S##1; \
        *(LAS bf16x8*)(V_lds + (b) * TILE_B + vst0) = (MODE == 1) ? vs##S##0 : ks##S##0; *(LAS bf16x8*)(V_lds + (b) * TILE_B + vst1) = (MODE == 1) ? vs##S##1 : ks##S##1; \
        if (MODE == 0 && tid < 32) M_lds[(b) * 32 + tid] = mw##S; } while (0)
#define FA_TOUCH(k0) do { if (MODE == 1 && !(EXP & 16) && tid < 256) { const FA_GAS char* tb_ = ((tid < 128) ? Kh : Vh) + (size_t)((k0) + ((tid & 127) >> 1)) * ldk_ * 2 + (tid & 1) * 128; \
        asm volatile("global_load_dword %0, %1, off" : "=v"(pf_) : "v"(tb_) : "memory"); } } while (0)
#define FA_TILE(j, b) do { \
        f32x16 p0, p1; bf16x8 pa0, pa1, pa2, pa3; \
        { const LAS char* qb_ = Ql; asm volatile("" : "+v"(qb_)); qkt<MODE == 1>(p0, p1, K_lds + (b) * TILE_B, qr, qb_, r32, hi); } \
        if (MODE == 0) { \
            const u64 mw = M_lds[(b) * 32 + r32] >> (4 * hi); \
            const unsigned mlo = (unsigned)mw, mhi = (unsigned)(mw >> 32); \
            _Pragma("unroll") for (int r = 0; r < 16; ++r) { const unsigned bit = 1u << ((r & 3) + 8 * (r >> 2)); p0[r] = (mlo & bit) ? p0[r] : -INFINITY; p1[r] = (mhi & bit) ? p1[r] : -INFINITY; } \
            float pmax = p0[0]; \
            _Pragma("unroll") for (int r = 1; r < 16; ++r) pmax = fmaxf(pmax, p0[r]); \
            _Pragma("unroll") for (int r = 0; r < 16; ++r) pmax = fmaxf(pmax, p1[r]); \
            { auto rr = __builtin_amdgcn_permlane32_swap(__float_as_uint(pmax), __float_as_uint(pmax), false, false); pmax = fmaxf(__uint_as_float(rr[0]), __uint_as_float(rr[1])); } \
            const float mn = fmaxf(m_reg, pmax); const float alpha = __builtin_amdgcn_exp2f((m_reg - mn) * C); m_reg = mn; \
            const float mnC = -mn * C; float ps = 0.f; \
            _Pragma("unroll") for (int r = 0; r < 16; ++r) { p0[r] = __builtin_amdgcn_exp2f(fmaf(p0[r], C, mnC)); p1[r] = __builtin_amdgcn_exp2f(fmaf(p1[r], C, mnC)); ps += p0[r] + p1[r]; } \
            { auto rr = __builtin_amdgcn_permlane32_swap(__float_as_uint(ps), __float_as_uint(ps), false, false); ps = __uint_as_float(rr[0]) + __uint_as_float(rr[1]); } \
            l_reg = l_reg * alpha + ps; \
            if (__any(alpha < 1.f)) { \
                if (hi == 0) al_l[r32] = alpha; \
                asm volatile("s_waitcnt lgkmcnt(0)" ::: "memory"); \
                _Pragma("unroll") for (int r = 0; r < 16; ++r) { const float a_ = al_l[crow(r, hi)]; \
                    _Pragma("unroll") for (int d = 0; d < 4; ++d) o[d][r] *= a_; } \
            } \
        } else if (!(EXP & 1)) { \
            const int dn = U.n0 + wid * 32 + r32 - (j) * 64 - 4 * hi; \
            const float base = (float)dn * U.lgam; \
            _Pragma("unroll") for (int r = 0; r < 16; ++r) { const int kk = (r & 3) + 8 * (r >> 2); \
                const float f0 = __builtin_amdgcn_exp2f(base - (float)kk * U.lgam), f1 = __builtin_amdgcn_exp2f(base - (float)(kk + 32) * U.lgam); \
                p0[r] = (dn >= kk) ? p0[r] * f0 : 0.f; p1[r] = (dn >= kk + 32) ? p1[r] * f1 : 0.f; } \
        } \
        p_to_frag(p0, p1, pa0, pa1, pa2, pa3); \
        FA_SBAR(); \
        { const int vb = vb0 + (b) * TILE_B; \
          pv_all(o, vb, pa0, pa1, pa2, pa3); } \
    } while (0)
    const int NT = U.ntiles;
    FA_SLOAD(A, 0); FA_SWRITE(A, 0);
    if (NT > 1) { FA_SLOAD(A, 64); FA_SWRITE(A, 1); }
    if (NT > 2) FA_TOUCH(128);
    if (NT > 3) FA_TOUCH(192);
    __syncthreads();
#pragma unroll
    for (int d = 0; d < 4; ++d) o[d] = f32x16{};
#pragma unroll 1
    for (int j = 0; j < NT; ++j) {
        const int b = j & 1;
        if (j + 2 < NT) FA_SLOAD(A, (j + 2) * 64);
        if (j + 4 < NT) FA_TOUCH((j + 4) * 64);
        FA_TILE(j, b);
        __syncthreads();
        if (j + 2 < NT) FA_SWRITE(A, b);
        asm volatile("" :: "v"(pf_));
    }
    asm volatile("s_waitcnt vmcnt(0)" ::: "memory");
    __syncthreads();
    l_out = l_reg;
#undef FA_SLOAD
#undef FA_SWRITE
#undef FA_TILE
}

template <int MODE>
__device__ __forceinline__ void unit_body2(LAS char* L, const UnitArgs& U, int tid, f32x16 (&o)[4], float& l_out) {
    const int wid = __builtin_amdgcn_readfirstlane(tid >> 6), lane = tid & 63, r32 = lane & 31, hi = lane >> 5;
    LAS char* V_lds = L + OFF_V; LAS char* K_lds = L + OFF_K; LAS u64* M_lds = (LAS u64*)(L + OFF_M);
    LAS float* wsf = (LAS float*)(L + OFF_WS) + wid * 64; LAS float* al_l = wsf + 32;
    constexpr float C = ATT_SCALE * 1.4426950408889634f;
    constexpr float THR = 8.0f;
    float m_reg = -1e30f, l_reg = 0.f;
    bf16x8 qr[8];
    LAS char* Ql = L + OFF_Q + wid * 8192 + lane * 16;
    { const FA_GAS bf16_t* Qh = (const FA_GAS bf16_t*)hide_p(U.Q); const FA_GAS bf16_t* Qw = (MODE == 0) ? Qh + (size_t)r32 * U.ldq + wid * 128 + hi * 8 : Qh + (size_t)(wid * 32 + r32) * U.ldq + hi * 8;
#pragma unroll
      for (int d0 = 0; d0 < 8; ++d0) { qr[d0] = *(const FA_GAS bf16x8*)(Qw + d0 * 16); if (MODE == 1) *(LAS bf16x8*)(Ql + d0 * 1024) = qr[d0]; } }
    if (MODE == 1) { asm volatile("s_waitcnt vmcnt(0) lgkmcnt(0)" ::: "memory"); FA_SBAR(); }
    const int sr = tid >> 4, sc = (tid & 15) * 8;
    const FA_GAS char* Kh = (const FA_GAS char*)hide_p(U.K); const FA_GAS char* Vh = (const FA_GAS char*)hide_p(U.V);
    const unsigned goff0 = (unsigned)(sr * U.ldk + sc) * 2u, goff1 = (unsigned)((32 + sr) * U.ldk + sc) * 2u;
    const int vb0 = (int)(unsigned)(size_t)V_lds + v_rd_base(lane);
    bf16x8 ksE0, ksE1, vsE0, vsE1; u64 mwE = 0ull; unsigned pf_ = 0u;
#define F2_TOUCH(k0) do { if (MODE == 1 && tid < 256) { const FA_GAS char* tb_ = ((tid < 128) ? Kh : Vh) + (size_t)((k0) + ((tid & 127) >> 1)) * U.ldk * 2 + (tid & 1) * 128; \
        asm volatile("global_load_dword %0, %1, off" : "=v"(pf_) : "v"(tb_) : "memory"); } } while (0)
#define F2_SLOAD(S, k0) do { const FA_GAS char* kb_ = Kh + (size_t)(k0) * U.ldk * 2; const FA_GAS char* vb_ = Vh + (size_t)(k0) * U.ldk * 2; \
        ks##S##0 = *(const FA_GAS bf16x8*)(kb_ + goff0); ks##S##1 = *(const FA_GAS bf16x8*)(kb_ + goff1); \
        if (MODE == 1) { vs##S##0 = *(const FA_GAS bf16x8*)(vb_ + goff0); vs##S##1 = *(const FA_GAS bf16x8*)(vb_ + goff1); } \
        if (MODE == 0 && tid < 32) mw##S = U.mask[(size_t)tid * 32 + ((k0) >> 6)]; } while (0)
#define F2_SWRITE(S, b) do { const int t_ = hide_i(tid), sr_ = t_ >> 4, sc_ = (t_ & 15) * 8; const int vst0 = v_st(sr_, sc_), vst1 = v_st(32 + sr_, sc_), kst0 = FA_KSWZ(sr_, sc_ * 2), kst1 = FA_KSWZ(32 + sr_, sc_ * 2);     \
        *(LAS bf16x8*)(K_lds + (b) * TILE_B + kst0) = ks##S##0; *(LAS bf16x8*)(K_lds + (b) * TILE_B + kst1) = ks##S##1; \
        *(LAS bf16x8*)(V_lds + (b) * TILE_B + vst0) = (MODE == 1) ? vs##S##0 : ks##S##0; *(LAS bf16x8*)(V_lds + (b) * TILE_B + vst1) = (MODE == 1) ? vs##S##1 : ks##S##1; \
        if (MODE == 0 && tid < 32) M_lds[(b) * 32 + tid] = mw##S; } while (0)
#define F2_PARTIAL(P0, P1, j, b, MN, AL) do { \
        if (MODE == 0) { \
            const u64 mw = M_lds[(b) * 32 + r32] >> (4 * hi); const unsigned mlo = (unsigned)mw, mhi = (unsigned)(mw >> 32); \
            _Pragma("unroll") for (int r = 0; r < 16; ++r) { const unsigned bit = 1u << ((r & 3) + 8 * (r >> 2)); P0[r] = (mlo & bit) ? P0[r] : -INFINITY; P1[r] = (mhi & bit) ? P1[r] : -INFINITY; } \
            float pmax = P0[0]; \
            _Pragma("unroll") for (int r = 1; r < 16; ++r) pmax = fmaxf(pmax, P0[r]); \
            _Pragma("unroll") for (int r = 0; r < 16; ++r) pmax = fmaxf(pmax, P1[r]); \
            { auto rr = __builtin_amdgcn_permlane32_swap(__float_as_uint(pmax), __float_as_uint(pmax), false, false); pmax = fmaxf(__uint_as_float(rr[0]), __uint_as_float(rr[1])); } \
            if (__builtin_expect(__all(pmax - m_reg <= THR / ATT_SCALE), 1)) { MN = m_reg; AL = 1.f; } \
            else { MN = fmaxf(m_reg, pmax); AL = __builtin_amdgcn_exp2f((m_reg - MN) * C); m_reg = MN; } \
            const float mnC = -MN * C; \
            _Pragma("unroll") for (int r = 0; r < 16; ++r) { P0[r] = fmaf(P0[r], C, mnC); P1[r] = fmaf(P1[r], C, mnC); } \
            _Pragma("unroll") for (int r = 0; r < 16; ++r) P0[r] = __builtin_amdgcn_exp2f(P0[r]); \
        } else { \
            const int dn = U.n0 + wid * 32 + r32 - (j) * 64 - 4 * hi; const float base = (float)dn * U.lgam; \
            _Pragma("unroll") for (int r = 0; r < 16; ++r) { const int kk = (r & 3) + 8 * (r >> 2); \
                const float f0 = __builtin_amdgcn_exp2f(base - (float)kk * U.lgam); P0[r] = (dn >= kk) ? P0[r] * f0 : 0.f; } \
        } } while (0)
#define F2_FINISH(P0, P1, j, AL) do { \
        if (MODE == 0) { \
            _Pragma("unroll") for (int r = 0; r < 16; ++r) P1[r] = __builtin_amdgcn_exp2f(P1[r]); \
            float ps = 0.f; \
            _Pragma("unroll") for (int r = 0; r < 16; ++r) ps += P0[r] + P1[r]; \
            { auto rr = __builtin_amdgcn_permlane32_swap(__float_as_uint(ps), __float_as_uint(ps), false, false); ps = __uint_as_float(rr[0]) + __uint_as_float(rr[1]); } \
            l_reg = l_reg * AL + ps; \
        } else { \
            const int dn = U.n0 + wid * 32 + r32 - (j) * 64 - 4 * hi; const float base = (float)dn * U.lgam; \
            _Pragma("unroll") for (int r = 0; r < 16; ++r) { const int kk = (r & 3) + 8 * (r >> 2); \
                const float f1 = __builtin_amdgcn_exp2f(base - (float)(kk + 32) * U.lgam); P1[r] = (dn >= kk + 32) ? P1[r] * f1 : 0.f; } \
        } \
        p_to_frag(P0, P1, pa0, pa1, pa2, pa3); } while (0)
#define F2_RESC(AL) do { if (MODE == 0) { if (__any((AL) < 1.f)) { if (hi == 0) al_l[r32] = (AL); asm volatile("s_waitcnt lgkmcnt(0)" ::: "memory"); \
        _Pragma("unroll") for (int r = 0; r < 16; ++r) { const float a_ = al_l[crow(r, hi)]; _Pragma("unroll") for (int d = 0; d < 4; ++d) o[d][r] *= a_; } } } } while (0)
#define F2_QKT(P0, P1, b) do { const LAS char* qb_ = Ql; asm volatile("" : "+v"(qb_)); qkt<MODE == 1>(P0, P1, K_lds + (b) * TILE_B, qr, qb_, r32, hi); } while (0)
#define PV1(vb_) do { const int v_ = (vb_); pv_one<0>(o[0], v_, pa0, pa1, pa2, pa3); pv_one<1>(o[1], v_, pa0, pa1, pa2, pa3); pv_one<2>(o[2], v_, pa0, pa1, pa2, pa3); pv_one<3>(o[3], v_, pa0, pa1, pa2, pa3); } while (0)
    f32x16 pA0, pA1, pB0, pB1; float mnA = 0.f, mnB = 0.f, alA = 1.f, alB = 1.f; bf16x8 pa0, pa1, pa2, pa3; const int NT = U.ntiles;
    (void)mnA; (void)mnB;
    F2_SLOAD(E, 0); F2_SWRITE(E, 0); __syncthreads();
#pragma unroll
    for (int d = 0; d < 4; ++d) o[d] = f32x16{};
    F2_QKT(pA0, pA1, 0); F2_PARTIAL(pA0, pA1, 0, 0, mnA, alA);
    F2_SLOAD(E, 64); if (2 < NT) F2_TOUCH(128); if (3 < NT) F2_TOUCH(192);
    F2_SWRITE(E, 1); __syncthreads();
#pragma unroll 1
    for (int j = 1; j + 1 < NT; j += 2) {
        FA_SBAR(); F2_QKT(pB0, pB1, 1);
        F2_FINISH(pA0, pA1, j - 1, alA); FA_SBAR();
        F2_SLOAD(E, (j + 1) * 64); if (j + 3 < NT) F2_TOUCH((j + 3) * 64); FA_SBAR();
        PV1(vb0); F2_PARTIAL(pB0, pB1, j, 1, mnB, alB);
        __syncthreads(); F2_SWRITE(E, 0); asm volatile("" :: "v"(pf_));
        F2_RESC(alB); __syncthreads();
        FA_SBAR(); F2_QKT(pA0, pA1, 0);
        F2_FINISH(pB0, pB1, j, alB); FA_SBAR();
        if (j + 2 < NT) F2_SLOAD(E, (j + 2) * 64); if (j + 4 < NT) F2_TOUCH((j + 4) * 64); FA_SBAR();
        PV1(vb0 + TILE_B); F2_PARTIAL(pA0, pA1, j + 1, 0, mnA, alA);
        __syncthreads(); if (j + 2 < NT) F2_SWRITE(E, 1); asm volatile("" :: "v"(pf_));
        F2_RESC(alA); __syncthreads();
    }
    FA_SBAR(); F2_QKT(pB0, pB1, 1);
    F2_FINISH(pA0, pA1, NT - 2, alA); FA_SBAR();
    PV1(vb0); F2_PARTIAL(pB0, pB1, NT - 1, 1, mnB, alB);
    __syncthreads(); F2_RESC(alB);
    F2_FINISH(pB0, pB1, NT - 1, alB); FA_SBAR();
    PV1(vb0 + TILE_B);
    asm volatile("s_waitcnt vmcnt(0)" ::: "memory");
    __syncthreads();
    l_out = l_reg;
#undef F2_SLOAD
#undef F2_SWRITE
#undef F2_PARTIAL
#undef F2_FINISH
#undef F2_RESC
#undef F2_QKT
#undef F2_TOUCH
#undef PV1
}
}

namespace pg8 {
struct EpiProj {
    static constexpr bool PERM = true, AFTER_DRAIN = false, HAS_MID = false;
    bf16_t* P; const float* rot;
    __device__ __forceinline__ void operator()(const f32x4 (&acc)[2][2][4][2], const Unit& u, int wr, int wc, int fr, int fq) const {
        const int row0 = u.pm * BM + wr * 64 + fr, colb = u.pn * BM + wc * 32 + 8 * fq;
        const bool rotq = (u.pn >= 7) && (u.pn < 15);
        const float ksc = (u.pn >= 11) ? K_SCALE : 1.0f;
        const int i0 = 16 * wc + 4 * fq;
#pragma unroll
        for (int ai = 0; ai < 2; ++ai)
#pragma unroll
            for (int m = 0; m < 4; ++m) {
                const int row = row0 + ai * HALF + m * 16; const int pos = row & (SEQL - 1);
                bf16_t* rowp = P + (size_t)row * NPROJ + colb;
                f32x4 r0 = (f32x4){1.f, 0.f, 1.f, 0.f}, r1 = r0;
                if (rotq) { const f32x4* rt = (const f32x4*)(rot + ((size_t)pos * 64 + i0) * 2); r0 = rt[0]; r1 = rt[1]; }
#pragma unroll
                for (int bj = 0; bj < 2; ++bj) {
                    f32x4 v0 = acc[ai][bj][m][0], v1 = acc[ai][bj][m][1];
                    if (rotq) {
                        f32x4 w0, w1;
                        w0[0] = (v0[0] * r0[0] - v0[1] * r0[1]) * ksc; w0[1] = (v0[0] * r0[1] + v0[1] * r0[0]) * ksc;
                        w0[2] = (v0[2] * r0[2] - v0[3] * r0[3]) * ksc; w0[3] = (v0[2] * r0[3] + v0[3] * r0[2]) * ksc;
                        w1[0] = (v1[0] * r1[0] - v1[1] * r1[1]) * ksc; w1[1] = (v1[0] * r1[1] + v1[1] * r1[0]) * ksc;
                        w1[2] = (v1[2] * r1[2] - v1[3] * r1[3]) * ksc; w1[3] = (v1[2] * r1[3] + v1[3] * r1[2]) * ksc;
                        v0 = w0; v1 = w1;
                    }
                    u32x4 w; w.x = pkbf(v0[0], v0[1]); w.y = pkbf(v0[2], v0[3]); w.z = pkbf(v1[0], v1[1]); w.w = pkbf(v1[2], v1[3]);
                    __builtin_nontemporal_store(w, (u32x4*)(rowp + bj * HALF));
                }
            }
    }
};
struct EpiMergeF {
    static constexpr bool PERM = true, AFTER_DRAIN = false, HAS_MID = true;
    const bf16_t* P; bf16_t* O;
    static __device__ __forceinline__ float cl(float x) { return fminf(fmaxf(x, -30.f), 30.f); }
    static __device__ __forceinline__ float ratio(float a, float b) { return (1.0f + __expf(-cl(b))) * __builtin_amdgcn_rcpf(1.0f + __expf(-cl(a))); }
    __device__ __forceinline__ void mid(f32x4 (&acc)[2][2][4][2], const Unit& u, int wr, int wc, int fr, int fq) const {
        const int row0 = hide_i(u.pm * BM + wr * 64 + fr), colb = hide_i(u.pn * BM + wc * 32 + 8 * fq);
        __builtin_amdgcn_sched_barrier(0);
#pragma unroll
        for (int ai = 0; ai < 2; ++ai) {
            u32x4 g0[4][2], g1[4][2];
#pragma unroll
            for (int m = 0; m < 4; ++m)
#pragma unroll
                for (int bj = 0; bj < 2; ++bj) { const bf16_t* gp = P + (size_t)(row0 + ai * HALF + m * 16) * NPROJ + C_GBR + colb + bj * HALF; g0[m][bj] = __builtin_nontemporal_load((const u32x4*)gp); g1[m][bj] = *(const u32x4*)(gp + DMODEL); }
            __builtin_amdgcn_sched_barrier(0);
#pragma unroll
            for (int m = 0; m < 4; ++m)
#pragma unroll
                for (int bj = 0; bj < 2; ++bj) {
                    const u32x4 a_ = g0[m][bj], b_ = g1[m][bj]; f32x4 r0, r1;
                    r0[0] = ratio(bflo(a_.x), bflo(b_.x)); r0[1] = ratio(bfhi(a_.x), bfhi(b_.x)); r0[2] = ratio(bflo(a_.y), bflo(b_.y)); r0[3] = ratio(bfhi(a_.y), bfhi(b_.y));
                    r1[0] = ratio(bflo(a_.z), bflo(b_.z)); r1[1] = ratio(bfhi(a_.z), bfhi(b_.z)); r1[2] = ratio(bflo(a_.w), bflo(b_.w)); r1[3] = ratio(bfhi(a_.w), bfhi(b_.w));
                    acc[ai][bj][m][0] = acc[ai][bj][m][0] * r0; acc[ai][bj][m][1] = acc[ai][bj][m][1] * r1;
                }
            __builtin_amdgcn_sched_barrier(0);
        }
    }
    __device__ __forceinline__ void operator()(const f32x4 (&acc)[2][2][4][2], const Unit& u, int wr, int wc, int fr, int fq) const {
        const int row0 = u.pm * BM + wr * 64 + fr, colb = u.pn * BM + wc * 32 + 8 * fq;
#pragma unroll
        for (int ai = 0; ai < 2; ++ai) {
            u32x4 gg[4][2];
#pragma unroll
            for (int m = 0; m < 4; ++m)
#pragma unroll
                for (int bj = 0; bj < 2; ++bj) gg[m][bj] = __builtin_nontemporal_load((const u32x4*)(P + (size_t)(row0 + ai * HALF + m * 16) * NPROJ + C_GBR + DMODEL + colb + bj * HALF));
            __builtin_amdgcn_sched_barrier(0);
#pragma unroll
            for (int m = 0; m < 4; ++m) {
                const int row = row0 + ai * HALF + m * 16;
#pragma unroll
                for (int bj = 0; bj < 2; ++bj) {
                    const int col = colb + bj * HALF;
                    const u32x4 g = gg[m][bj];
                    const f32x4 v0 = acc[ai][bj][m][0], v1 = acc[ai][bj][m][1];
                    float o[8];
                    o[0] = sigmoidf_(cl(bflo(g.x))) * v0[0]; o[1] = sigmoidf_(cl(bfhi(g.x))) * v0[1]; o[2] = sigmoidf_(cl(bflo(g.y))) * v0[2]; o[3] = sigmoidf_(cl(bfhi(g.y))) * v0[3];
                    o[4] = sigmoidf_(cl(bflo(g.z))) * v1[0]; o[5] = sigmoidf_(cl(bfhi(g.z))) * v1[1]; o[6] = sigmoidf_(cl(bflo(g.w))) * v1[2]; o[7] = sigmoidf_(cl(bfhi(g.w))) * v1[3];
                    u32x4 w; w.x = pkbf(o[0], o[1]); w.y = pkbf(o[2], o[3]); w.z = pkbf(o[4], o[5]); w.w = pkbf(o[6], o[7]);
                    *(u32x4*)(O + (size_t)row * DMODEL + col) = w;
                }
            }
        }
    }
};
struct EpiRes {
    static constexpr bool PERM = false, AFTER_DRAIN = false, HAS_MID = false;
    const float* X; float* O;
    __device__ __forceinline__ void operator()(const f32x4 (&acc)[2][2][4][2], const Unit& u, int wr, int wc, int fr, int fq) const {
        const int row0 = u.pm * BM + wr * 64 + fr, col0 = u.pn * BM + wc * 32 + 4 * fq;
#pragma unroll
        for (int ai = 0; ai < 2; ++ai) {
            f32x4 xv[4][2][2];
#pragma unroll
            for (int m = 0; m < 4; ++m) { const size_t off = (size_t)(row0 + ai * HALF + m * 16) * DMODEL + col0;
#pragma unroll
                for (int bj = 0; bj < 2; ++bj)
#pragma unroll
                    for (int n = 0; n < 2; ++n) xv[m][bj][n] = __builtin_nontemporal_load((const f32x4*)(X + off + bj * HALF + n * 16)); }
            __builtin_amdgcn_sched_barrier(0);
#pragma unroll
            for (int m = 0; m < 4; ++m) { const size_t off = (size_t)(row0 + ai * HALF + m * 16) * DMODEL + col0;
#pragma unroll
                for (int bj = 0; bj < 2; ++bj)
#pragma unroll
                    for (int n = 0; n < 2; ++n) *(f32x4*)(O + off + bj * HALF + n * 16) = xv[m][bj][n] + acc[ai][bj][m][n]; }
            __builtin_amdgcn_sched_barrier(0);
        }
    }
};
struct EpiNull {
    static constexpr bool PERM = true, AFTER_DRAIN = false, HAS_MID = false;
    float* O;
    __device__ __forceinline__ void operator()(const f32x4 (&acc)[2][2][4][2], const Unit& u, int wr, int wc, int fr, int fq) const {
        f32x4 t = (f32x4){0.f, 0.f, 0.f, 0.f};
#pragma unroll
        for (int ai = 0; ai < 2; ++ai)
#pragma unroll
            for (int bj = 0; bj < 2; ++bj)
#pragma unroll
                for (int m = 0; m < 4; ++m) { t += acc[ai][bj][m][0]; t += acc[ai][bj][m][1]; }
        O[(size_t)(u.pm * 8 + u.pn) * 512 + (wr * 4 + wc) * 64 + fr + 16 * fq] = (t[0] + t[1]) + (t[2] + t[3]);
    }
};
struct EpiSwiglu {
    static constexpr bool PERM = true, AFTER_DRAIN = false, HAS_MID = false;
    bf16_t* H; const float* rs;
    __device__ __forceinline__ void operator()(const f32x4 (&acc)[2][2][4][2], const Unit& u, int wr, int wc, int fr, int fq) const {
        const int row0 = u.pm * BM + wr * 64 + fr, col = u.pn * HALF + wc * 32 + 8 * fq;
#pragma unroll
        for (int ai = 0; ai < 2; ++ai)
#pragma unroll
            for (int m = 0; m < 4; ++m) {
                const int row = row0 + ai * HALF + m * 16; const float r_ = rs[row];
                const f32x4 g0 = acc[ai][0][m][0] * r_, g1 = acc[ai][0][m][1] * r_, u0 = acc[ai][1][m][0] * r_, u1 = acc[ai][1][m][1] * r_;
                u32x4 w; w.x = pkbf(siluf_(g0[0]) * u0[0], siluf_(g0[1]) * u0[1]); w.y = pkbf(siluf_(g0[2]) * u0[2], siluf_(g0[3]) * u0[3]);
                w.z = pkbf(siluf_(g1[0]) * u1[0], siluf_(g1[1]) * u1[1]); w.w = pkbf(siluf_(g1[2]) * u1[2], siluf_(g1[3]) * u1[3]);
                *(u32x4*)(H + (size_t)row * 1024 + col) = w;
            }
    }
};
struct EpiDown {
    static constexpr bool PERM = true, AFTER_DRAIN = false, HAS_MID = false;
    bf16_t* Y; const float* rg;
    __device__ __forceinline__ void operator()(const f32x4 (&acc)[2][2][4][2], const Unit& u, int wr, int wc, int fr, int fq) const {
        const int row0 = u.pm * BM + wr * 64 + fr, colb = u.pn * BM + wc * 32 + 8 * fq;
#pragma unroll
        for (int ai = 0; ai < 2; ++ai)
#pragma unroll
            for (int m = 0; m < 4; ++m) {
                const int row = row0 + ai * HALF + m * 16; const float gt = rg[row];
#pragma unroll
                for (int bj = 0; bj < 2; ++bj) {
                    const f32x4 v0 = acc[ai][bj][m][0] * gt, v1 = acc[ai][bj][m][1] * gt;
                    u32x4 w; w.x = pkbf(v0[0], v0[1]); w.y = pkbf(v0[2], v0[3]); w.z = pkbf(v1[0], v1[1]); w.w = pkbf(v1[2], v1[3]);
                    *(u32x4*)(Y + (size_t)row * DMODEL + colb + bj * HALF) = w;
                }
            }
    }
};
template <bool GATHER_> struct ExpertOrderT {
    static constexpr bool GATHER = GATHER_;
    const LAS int* ts; int G, c; const int* rtok;
    __device__ __forceinline__ unsigned rowoff(int slot) const { return GATHER_ ? (unsigned)rtok[slot] : 0u; }
    __device__ __forceinline__ bool next(int i, Unit& u) const {
        const int L = i * G + c; const int total = ts[32] * 8; if (L >= total) return false;
        const int gt = L >> 3; u.pm = gt; u.pn = L & 7; int e = 0;
        for (int k = 1; k < 32; ++k) e += (gt >= ts[k]) ? 1 : 0;
        u.e = e; return true;
    }
    __device__ __forceinline__ void a_ready(const Unit&) const {}
    __device__ __forceinline__ void done(const Unit&) const {}
};
}

struct MapId { __device__ __forceinline__ int operator()(int n) const { return n; } };
struct MapGate { __device__ __forceinline__ int operator()(int f) const { return ((f >> 7) << 8) + (f & 127); } };
struct MapUp { __device__ __forceinline__ int operator()(int f) const { return ((f >> 7) << 8) + 128 + (f & 127); } };
struct MapProj {
    __device__ __forceinline__ int operator()(int n) const {
        if (n < 1736) return n;
        if (n < 2760) { const int l = n - 1736, d = l & 127; return C_QR + (l & ~127) + ((d & 63) << 1) + (d >> 6); }
        if (n < 3784) { const int l = n - 2760, d = l & 127; return C_KR + (l & ~127) + ((d & 63) << 1) + (d >> 6); }
        if (n < 4808) return C_VR + (n - 3784);
        if (n < 5832) return C_GR + (n - 4808);
        return C_GBR + (n - 5832);
    }
};
template <class RowMap>
__device__ __forceinline__ void tr_item(const float* __restrict__ src, int N, bf16_t* __restrict__ dst, int ldd, int kb, int nb, int lane, RowMap rm) {
    const int kc = lane >> 3, nc = lane & 7;
    const int n = nb * 32 + nc * 4, k0 = kb * 64 + kc * 8;
    if (n < N) {
        f32x4 v[8];
#pragma unroll
        for (int i = 0; i < 8; ++i) v[i] = __builtin_nontemporal_load((const f32x4*)(src + (size_t)(k0 + i) * N + n));
#pragma unroll
        for (int j = 0; j < 4; ++j) {
            u32x4 o; o.x = pkbf(v[0][j], v[1][j]); o.y = pkbf(v[2][j], v[3][j]); o.z = pkbf(v[4][j], v[5][j]); o.w = pkbf(v[6][j], v[7][j]);
            *(u32x4*)(dst + (size_t)rm(n + j) * ldd + k0) = o;
        }
    }
}
template <class RowMap>
__device__ __forceinline__ void tr_item2(const float* __restrict__ src, int N, bf16_t* __restrict__ dst, int ldd, int kb, int nb, int lane, RowMap rm) {
    const int kc = lane >> 3, nc = lane & 7;
    const int n = nb * 32 + nc * 4, k0 = kb * 64 + kc * 8;
    f32x4 va[8], vb[8];
#pragma unroll
    for (int i = 0; i < 8; ++i) { va[i] = *(const f32x4*)(src + (size_t)(k0 + i) * N + n); vb[i] = *(const f32x4*)(src + (size_t)(k0 + i) * N + n + 32); }
#pragma unroll
    for (int j = 0; j < 4; ++j) {
        u32x4 o; o.x = pkbf(va[0][j], va[1][j]); o.y = pkbf(va[2][j], va[3][j]); o.z = pkbf(va[4][j], va[5][j]); o.w = pkbf(va[6][j], va[7][j]);
        *(u32x4*)(dst + (size_t)rm(n + j) * ldd + k0) = o;
    }
#pragma unroll
    for (int j = 0; j < 4; ++j) {
        u32x4 o; o.x = pkbf(vb[0][j], vb[1][j]); o.y = pkbf(vb[2][j], vb[3][j]); o.z = pkbf(vb[4][j], vb[5][j]); o.w = pkbf(vb[6][j], vb[7][j]);
        *(u32x4*)(dst + (size_t)rm(n + 32 + j) * ldd + k0) = o;
    }
}
template <class RowMap>
__device__ __forceinline__ void tr_item4(const float* __restrict__ src, int N, bf16_t* __restrict__ dst, int ldd, int kb, int nb, int lane, RowMap rm) {
    const int kc = lane >> 3, nc = lane & 7;
    const int n = nb * 32 + nc * 4, k0 = kb * 64 + kc * 8;
    f32x4 v[4][8];
#pragma unroll
    for (int i = 0; i < 8; ++i)
#pragma unroll
        for (int u = 0; u < 4; ++u) v[u][i] = __builtin_nontemporal_load((const f32x4*)(src + (size_t)(k0 + i) * N + n + 32 * u));
#pragma unroll
    for (int u = 0; u < 4; ++u)
#pragma unroll
        for (int j = 0; j < 4; ++j) {
            u32x4 o; o.x = pkbf(v[u][0][j], v[u][1][j]); o.y = pkbf(v[u][2][j], v[u][3][j]); o.z = pkbf(v[u][4][j], v[u][5][j]); o.w = pkbf(v[u][6][j], v[u][7][j]);
            __builtin_nontemporal_store(o, (u32x4*)(dst + (size_t)rm(n + 32 * u + j) * ldd + k0));
        }
}
constexpr int EXP_ITEMS = 3 * 32 * 1024;
__device__ __forceinline__ void convert_experts(const float* w_eg, const float* w_eu, const float* w_ed, bf16_t* WGU, bf16_t* WD, unsigned* qctr, int lane) {
    int nxt = 0; if (lane == 0) nxt = (int)atomicAdd(qctr, 8u);
    for (;;) {
        const int it = __builtin_amdgcn_readfirstlane(nxt);
        if (it >= EXP_ITEMS) break;
        if (lane == 0) nxt = (int)atomicAdd(qctr, 8u);
        const int kind = it >> 15, r = it & 32767, e = r >> 10, q = r & 1023;
        if (kind == 0) { const float* src = w_eg + (size_t)e * 2048 * 1024; bf16_t* dst = WGU + (size_t)e * 2048 * 2048;
#pragma unroll 1
            for (int u = 0; u < 8; u += 4) tr_item4(src, 1024, dst, 2048, q >> 5, (q & 31) + u, lane, MapGate{}); }
        else if (kind == 1) { const float* src = w_eu + (size_t)e * 2048 * 1024; bf16_t* dst = WGU + (size_t)e * 2048 * 2048;
#pragma unroll 1
            for (int u = 0; u < 8; u += 4) tr_item4(src, 1024, dst, 2048, q >> 5, (q & 31) + u, lane, MapUp{}); }
        else { const float* src = w_ed + (size_t)e * 1024 * 2048; bf16_t* dst = WD + (size_t)e * 2048 * 1024;
#pragma unroll 1
            for (int u = 0; u < 8; u += 4) tr_item4(src, 2048, dst, 1024, q >> 6, (q & 63) + u, lane, MapId{}); }
    }
}
__device__ __forceinline__ void sincos_d(double a, double& s, double& c) {
    const double TWO_PI = 6.283185307179586476925, HALF_PI = 1.5707963267948966192313;
    double k = rint(a / HALF_PI); double r = a - k * HALF_PI;
    r -= k * 6.123233995736766e-17;
    const int q = ((int)k) & 3; const double r2 = r * r;
    double sp = r2 * (-1.0 / 1307674368000.0);
    sp = r2 * (sp + 1.0 / 6227020800.0); sp = r2 * (sp - 1.0 / 39916800.0); sp = r2 * (sp + 1.0 / 362880.0); sp = r2 * (sp - 1.0 / 5040.0); sp = r2 * (sp + 1.0 / 120.0); sp = r2 * (sp - 1.0 / 6.0);
    const double sr = r + r * sp;
    double cp = r2 * (1.0 / 20922789888000.0);
    cp = r2 * (cp - 1.0 / 87178291200.0); cp = r2 * (cp + 1.0 / 479001600.0); cp = r2 * (cp - 1.0 / 3628800.0); cp = r2 * (cp + 1.0 / 40320.0); cp = r2 * (cp - 1.0 / 720.0); cp = r2 * (cp + 1.0 / 24.0); cp = r2 * (cp - 0.5);
    const double cr = 1.0 + cp;
    s = (q == 0) ? sr : (q == 1) ? cr : (q == 2) ? -sr : -cr;
    c = (q == 0) ? cr : (q == 1) ? -sr : (q == 2) ? -cr : sr;
    (void)TWO_PI;
}

struct Params { const float* in[17]; float* out; unsigned char* ws; };

#ifndef PROF_PHASE
#define PROF_PHASE -1
#endif
#ifndef PROF_SCALE
#define PROF_SCALE 4e-6f
#endif
#define STAMP(i) do { if (PROF_PHASE >= 0 && bx == 0 && wave_id == 0) ((unsigned*)(p.ws + WS_CTL))[6000 + (i)] = (unsigned)__builtin_amdgcn_s_memrealtime(); } while (0)
#define GSYNC() grid.sync()
#define XBAR() do { const int l__ = (int)__builtin_amdgcn_mbcnt_hi(~0u, __builtin_amdgcn_mbcnt_lo(~0u, (unsigned)hide_i(0))); xcd_barrier(xbar, wave_id * 64 + l__); } while (0)
constexpr int CTL_BAR_WORD = 8192;
constexpr int CTL_QCTR = 2048;
#ifndef NGEMM_P1
#define NGEMM_P1 208
#endif

__global__ void __launch_bounds__(512, 2) mega_fwd(Params p) {
    extern __shared__ __attribute__((aligned(16))) unsigned char lds_raw[];
    LAS unsigned char* lds = (LAS unsigned char*)lds_raw;
    cg::grid_group grid = cg::this_grid();
    const int G = gridDim.x, bx = blockIdx.x;
    const int wave_id = __builtin_amdgcn_readfirstlane((int)threadIdx.x >> 6);
    const int NGW = G * 8, NGT = G * 512;
    XcdBarrier xbar;
    {
        const int l0 = (int)__builtin_amdgcn_mbcnt_hi(~0u, __builtin_amdgcn_mbcnt_lo(~0u, (unsigned)hide_i(0)));
        volatile LAS unsigned* st = (volatile LAS unsigned*)(lds + LDS_MISC + 256);
        if (wave_id == 0 && l0 < 2) st[l0] = 0u;
        __syncthreads();
        xbar.bar = (unsigned*)(p.ws + WS_CTL) + CTL_BAR_WORD; xbar.x = xb_xcc_id(); xbar.st = st;
        if (wave_id == 0 && l0 == 0) (void)xb_add(&xbar.bar[XB_XCNT(xbar.x)], 1u);
    }
#define PH_LOCALS \
    const int lane = (int)__builtin_amdgcn_mbcnt_hi(~0u, __builtin_amdgcn_mbcnt_lo(~0u, (unsigned)hide_i(0))), wave = wave_id, tid = wave * 64 + lane; (void)tid; \
    const int gw = bx * 8 + wave, gtid = bx * 512 + tid; (void)gw; (void)gtid; (void)lane; \
    unsigned char* ws = hide_p(p.ws); float* out = hide_p(p.out); (void)out; \
    unsigned* ctl = (unsigned*)(ws + WS_CTL); float* rot = (float*)(ws + WS_ROT); (void)ctl; (void)rot; \
    bf16_t* WIN = (bf16_t*)(ws + WS_WIN); bf16_t* WCOMB = (bf16_t*)(ws + WS_WCOMB); bf16_t* WB = (bf16_t*)(ws + WS_WB); bf16_t* WO = (bf16_t*)(ws + WS_WO); (void)WIN; (void)WCOMB; (void)WB; (void)WO; \
    bf16_t* WGU = (bf16_t*)(ws + WS_WGU); bf16_t* WD = (bf16_t*)(ws + WS_WD); (void)WGU; (void)WD; \
    bf16_t* P = (bf16_t*)(ws + WS_P); bf16_t* HMID = (bf16_t*)(ws + WS_HMID); bf16_t* Y = (bf16_t*)(ws + WS_Y); (void)P; (void)HMID; (void)Y; \
    bf16_t* XN = (bf16_t*)(ws + WS_XN); bf16_t* BA = XN; bf16_t* TN = XN; (void)BA; (void)TN; \
    bf16_t* OA = (bf16_t*)(ws + WS_OA); bf16_t* OB = OA + 1024;            bf16_t* MIXED = (bf16_t*)(ws + WS_MIXED); bf16_t* XG = (bf16_t*)(ws + WS_XG); (void)OA; (void)OB; (void)MIXED; (void)XG; \
    bf16_t* KV = (bf16_t*)(ws + WS_KV); u64* MASK = (u64*)(ws + WS_MASK); (void)KV; (void)MASK; \
    int* misc = (int*)(ws + WS_MISC); \
    int* row_tok = misc + MI_ROWTOK; float* row_gate = (float*)(misc + MI_ROWGATE); int* tok_slot = misc + MI_TOKSLOT; (void)row_tok; (void)row_gate; (void)tok_slot; \
    int* asg_e = misc + MI_ASGE; int* asg_r = misc + MI_ASGR; float* asg_g = (float*)(misc + MI_ASGG); (void)asg_e; (void)asg_r; (void)asg_g;
#define IN(k) hide_p(p.in[k])

    STAMP(0);
    {
        PH_LOCALS
        const float* x = IN(0); const float* g_mix = IN(1); const float* w_in = IN(2); const float* w_uv = IN(4); const float* w_branch = IN(6); const float* w_out = IN(7);
        constexpr int NB_WIN = 311;
        constexpr int I_WIN = 32 * NB_WIN, I_WB = 16 * 64, I_WO = 32 * 64;
        constexpr int I_TOTAL = I_WIN + I_WB + I_WO;
#pragma unroll 1
        for (int pass = 0; pass < 4; ++pass) {
        const int job = (pass + wave) & 3;
        if (job == 0) {
        for (int it = gw; it < I_TOTAL; it += NGW) {
            int r = it;
            if (r < I_WIN) { tr_item(w_in, 9928, WIN, 2048, r / NB_WIN, r % NB_WIN, lane, MapProj{}); continue; } r -= I_WIN;
            if (r < I_WB) { tr_item(w_branch + (size_t)1024 * 2048, 2048, WCOMB + 1024, 2048, r >> 6, r & 63, lane, MapId{});   continue; } r -= I_WB;
            tr_item(w_out, 2048, WO, 2048, r >> 6, r & 63, lane, MapId{});
        }
        for (int i = gtid; i < 56 * 256; i += NGT) ((u32x4*)(WIN + (size_t)1736 * 2048))[i] = (u32x4){0u, 0u, 0u, 0u};
        } else if (job == 1) {
        for (int it = gw; it < 2048; it += NGW) {
            const int h = it >> 8, ch = (it >> 7) & 1, n0 = (it & 127) * 16, c = ch * 64 + lane;
            const float* wuv = w_uv + ((size_t)h * 128 + c) * 128;
            const float* wa = w_branch + (size_t)(h * 128) * 2048 + n0;
            float a[16];
#pragma unroll
            for (int j = 0; j < 16; ++j) a[j] = 0.f;
#pragma unroll 4
            for (int d4 = 0; d4 < 32; ++d4) {
                const f32x4 wv = *(const f32x4*)(wuv + d4 * 4);
#pragma unroll
                for (int dd = 0; dd < 4; ++dd) {
                    const float* wr_ = wa + (size_t)(d4 * 4 + dd) * 2048;
#pragma unroll
                    for (int j4 = 0; j4 < 4; ++j4) { const f32x4 b = *(const f32x4*)(wr_ + j4 * 4); a[j4 * 4 + 0] += wv[dd] * b[0]; a[j4 * 4 + 1] += wv[dd] * b[1]; a[j4 * 4 + 2] += wv[dd] * b[2]; a[j4 * 4 + 3] += wv[dd] * b[3]; }
                }
            }
#pragma unroll
            for (int j = 0; j < 16; ++j) WCOMB[(size_t)(n0 + j) * 2048 + h * 128 + c] = (bf16_t)(pkbf(a[j], 0.f) & 0xffffu);
        }
        } else if (job == 2) {
        for (int m = gw; m < T_TOK; m += 2 * NGW) {
            const int m1 = (m + NGW < T_TOK) ? m + NGW : m;
            const f32x4* xr0 = (const f32x4*)(x + (size_t)m * DMODEL) + lane; const f32x4* xr1 = (const f32x4*)(x + (size_t)m1 * DMODEL) + lane;
            f32x4 v0[8], v1[8]; float s0 = 0.f, s1 = 0.f;
#pragma unroll
            for (int j = 0; j < 8; ++j) { v0[j] = __builtin_nontemporal_load(xr0 + 64 * j); v1[j] = __builtin_nontemporal_load(xr1 + 64 * j); }
#pragma unroll
            for (int j = 0; j < 8; ++j) { s0 += (v0[j][0] * v0[j][0] + v0[j][1] * v0[j][1]) + (v0[j][2] * v0[j][2] + v0[j][3] * v0[j][3]); s1 += (v1[j][0] * v1[j][0] + v1[j][1] * v1[j][1]) + (v1[j][2] * v1[j][2] + v1[j][3] * v1[j][3]); }
            const float r0 = 1.0f / sqrtf(wave_sum(s0, lane) * (1.0f / DMODEL) + EPS_F), r1 = 1.0f / sqrtf(wave_sum(s1, lane) * (1.0f / DMODEL) + EPS_F);
            u32x2* o0 = (u32x2*)(XN + (size_t)m * DMODEL) + lane; u32x2* o1 = (u32x2*)(XN + (size_t)m1 * DMODEL) + lane;
#pragma unroll
            for (int j = 0; j < 8; ++j) { const f32x4 gg = ((const f32x4*)g_mix)[lane + 64 * j];
                u32x2 w; w.x = pkbf(v0[j][0] * r0 * gg[0], v0[j][1] * r0 * gg[1]); w.y = pkbf(v0[j][2] * r0 * gg[2], v0[j][3] * r0 * gg[3]); o0[64 * j] = w;
                u32x2 w2; w2.x = pkbf(v1[j][0] * r1 * gg[0], v1[j][1] * r1 * gg[1]); w2.y = pkbf(v1[j][2] * r1 * gg[2], v1[j][3] * r1 * gg[3]); o1[64 * j] = w2; }
        }
        } else {
        for (int idx = gtid; idx < SEQL * 64; idx += NGT) {
            const int pos = idx >> 6, i = idx & 63; double f = 1.0;
            for (int k = 0; k < i; ++k) f *= 0.8659643233600653;
            double s, c; sincos_d((double)pos * f, s, c);
            rot[2 * idx] = (float)c; rot[2 * idx + 1] = (float)s;
        }
        { const float* g_ffn = IN(8); const float* w_rg = IN(9); const float* w_re = IN(11); float* WC = (float*)(ws + WS_WC);
          for (int idx = gtid; idx < 256 * 48 * 8; idx += NGT) { const int j = idx & 7, c = (idx >> 3) % 48, k = (idx / 384) * 8 + j;
              const float wv = (c < 4) ? w_rg[k * 4 + c] : (c < 36) ? w_re[k * 32 + (c - 4)] : 0.f; WC[idx] = wv * g_ffn[k]; } }
        }
        }
        for (int i = gtid; i < 32; i += NGT) ctl[64 * i] = 0u;
        if (gtid < 2) ctl[4096 + gtid] = 0u;
        for (int i = gtid; i < MAXSLOT; i += NGT) { row_tok[i] = 0; row_gate[i] = 0.f; ((float*)(ws + WS_WC + 524288))[i] = 0.f; }
    }
    if (__builtin_expect(p.out == nullptr, 0)) GSYNC();
    XBAR();
    STAMP(1);

    {
        PH_LOCALS
        const float* w_eg = IN(13); const float* w_eu = IN(14); const float* w_ed = IN(15);
        const int NGEMM = (G == 256) ? NGEMM_P1 : G;
        if (bx < NGEMM) {
            pg8::Gemm g{XN, WIN, T_TOK, NPROJ, 2048}; pg8::StaticOrder S; S.init(T_TOK, NPROJ, NGEMM, bx);
            pg8::EpiProj E{P, rot};
            pg8::gemm_phase<pg8::EpiProj, pg8::StaticOrder, true, true>(lds, g, S, E, tid);
        }
        convert_experts(w_eg, w_eu, w_ed, WGU, WD, ctl + CTL_QCTR, lane);
    }
    XBAR();
    STAMP(2);
#ifdef P1_EXP
    XBAR();
    STAMP(30);
    {
        PH_LOCALS
        const float* w_eg = IN(13); const float* w_eu = IN(14); const float* w_ed = IN(15);
        const int NGEMM = P1_EXP_NG;
        if ((P1_EXP & 1) && bx < NGEMM) {
            pg8::Gemm g{XN, WIN, T_TOK, NPROJ, 2048}; pg8::StaticOrder S; S.init(T_TOK, NPROJ, NGEMM, bx);
            pg8::EpiProj E{P, rot};
            pg8::gemm_phase<pg8::EpiProj, pg8::StaticOrder, true, true>(lds, g, S, E, tid);
        }
        if ((P1_EXP & 2) && bx >= NGEMM) convert_experts(w_eg, w_eu, w_ed, WGU, WD, ctl + CTL_QCTR + 64, lane);
    }
    XBAR();
    STAMP(31);
#endif

    {
        PH_LOCALS
        const float* g_kv = IN(3);
        for (int t = gw; t < T_TOK; t += NGW) {
            const unsigned v = *(const unsigned*)(P + (size_t)t * NPROJ + C_CKV + 2 * lane);
            const float a = bflo(v), b = bfhi(v);
            const float rstd = 1.0f / sqrtf(wave_sum(a * a + b * b, lane) * (1.0f / 128.0f) + EPS_F);
            *(unsigned*)(KV + (size_t)t * 128 + 2 * lane) = pkbf(a * rstd * g_kv[2 * lane], b * rstd * g_kv[2 * lane + 1]);
        }
#if DBG_CMP == 3
        {
        u64* MASKX = (u64*)(ws + WS_SPARE);
        LAS float* qi = (LAS float*)(lds + wave * 10240); LAS float* sc = qi + 512;
        for (int t = gw; t < T_TOK; t += NGW) {
            const int b = t >> 11, q = t & 2047, ng = (q >> 6) + 1;
            { const u32x4 v = *(const u32x4*)(P + (size_t)t * NPROJ + C_QIDX + lane * 8);
              f32x4 lo4 = (f32x4){bflo(v.x), bfhi(v.x), bflo(v.y), bfhi(v.y)}, hi4 = (f32x4){bflo(v.z), bfhi(v.z), bflo(v.w), bfhi(v.w)};
              *(LAS f32x4*)(qi + lane * 8) = lo4; *(LAS f32x4*)(qi + lane * 8 + 4) = hi4; }
            float w[8];
            { const u32x4 v = *(const u32x4*)(P + (size_t)t * NPROJ + C_WIDX); w[0] = bflo(v.x); w[1] = bfhi(v.x); w[2] = bflo(v.y); w[3] = bfhi(v.y); w[4] = bflo(v.z); w[5] = bfhi(v.z); w[6] = bflo(v.w); w[7] = bfhi(v.w); }
            for (int g = 0; g < ng; ++g) {
                LAS float* qg = qi; asm volatile("" : "+v"(qg));
                const int s = g * 64 + lane; const u32x4* kr = (const u32x4*)(P + (size_t)(b * SEQL + s) * NPROJ + C_KIDX);
                float dot[8];
#pragma unroll
                for (int h = 0; h < 8; ++h) dot[h] = 0.f;
#pragma unroll
                for (int c = 0; c < 8; ++c) {
                    const u32x4 v = kr[c];
                    const f32x4 ka = (f32x4){bflo(v.x), bfhi(v.x), bflo(v.y), bfhi(v.y)}, kb = (f32x4){bflo(v.z), bfhi(v.z), bflo(v.w), bfhi(v.w)};
#pragma unroll
                    for (int h = 0; h < 8; ++h) {
                        const f32x4 qa = *(const LAS f32x4*)(qg + h * 64 + c * 8), qb = *(const LAS f32x4*)(qg + h * 64 + c * 8 + 4);
                        dot[h] += (qa[0] * ka[0] + qa[1] * ka[1]) + (qa[2] * ka[2] + qa[3] * ka[3]) + (qb[0] * kb[0] + qb[1] * kb[1]) + (qb[2] * kb[2] + qb[3] * kb[3]);
                    }
                }
                float score = 0.f;
#pragma unroll
                for (int h = 0; h < 8; ++h) score += w[h] * fmaxf(dot[h], 0.f);
                sc[s] = score * IDX_SCALE;
            }
            u64* mrow = MASKX + (size_t)t * 32;
            if (ng <= 4) { if (lane < 32) mrow[lane] = (lane < ng) ? ~0ull : 0ull; }
            else {
                unsigned lo = 0u;
                for (int bit = 31; bit >= 0; --bit) {
                    const unsigned cand = lo | (1u << bit); int cnt = 0;
                    for (int g = 0; g < ng; ++g) cnt += __popcll(__ballot(fkey(sc[g * 64 + lane]) >= cand));
                    if (cnt >= 256) lo = cand;
                }
                const unsigned tau = lo; int cgt = 0;
                for (int g = 0; g < ng; ++g) cgt += __popcll(__ballot(fkey(sc[g * 64 + lane]) > tau));
                const int need = 256 - cgt; int run = 0;
                for (int g = 0; g < ng; ++g) {
                    const unsigned key = fkey(sc[g * 64 + lane]);
                    const u64 gt = __ballot(key > tau), eq = __ballot(key == tau);
                    const u64 below = eq & ((1ull << lane) - 1ull);
                    const bool sel = (key == tau) && (run + (int)__popcll(below) < need);
                    const u64 word = gt | __ballot(sel);
                    run += (int)__popcll(eq);
                    if (lane == 0) mrow[g] = word;
                }
                if (lane >= ng && lane < 32) mrow[lane] = 0ull;
            }
        }
        }
        __syncthreads();
#endif
        typedef short bf16x8_t __attribute__((ext_vector_type(8)));
        constexpr int SCS = 2052;
        LAS float* scl = (LAS float*)lds;
        LAS unsigned* hist = (LAS unsigned*)(lds + 16 * SCS * 4);
        LAS unsigned* candl = hist + 16 * 256 + wave * 64;
        for (int i = tid; i < 16 * 256; i += 512) hist[i] = 0u;
        __syncthreads();
        for (int ui = 0; ui < 4; ++ui) {
            const int uu = ui * 256 + ((ui & 1) ? 255 - bx : bx);
            if (uu >= 1024 || bx >= 256) break;
            const int b = uu & 7, qblk = uu >> 3, q0 = qblk * 16, t0 = b * SEQL + q0, ng = (q0 >> 6) + 1, N = ng * 64;
            if (ng <= 4) {
                for (int qq = 0; qq < 2; ++qq) { u64* mrow = MASK + (size_t)(t0 + 2 * wave + qq) * 32; if (lane < 32) mrow[lane] = (lane < ng) ? ~0ull : 0ull; }
                continue;
            }
            const int qrow = lane & 15, kg = lane >> 4;
            bf16x8_t qf[8][2]; float w[8];
            { const bf16_t* qp = P + (size_t)(t0 + qrow) * NPROJ + C_QIDX + 8 * kg;
#pragma unroll
              for (int h = 0; h < 8; ++h) { qf[h][0] = *(const bf16x8_t*)(qp + h * 64); qf[h][1] = *(const bf16x8_t*)(qp + h * 64 + 32); }
              const u32x4 v = *(const u32x4*)(P + (size_t)(t0 + qrow) * NPROJ + C_WIDX); w[0] = bflo(v.x); w[1] = bfhi(v.x); w[2] = bflo(v.y); w[3] = bfhi(v.y); w[4] = bflo(v.z); w[5] = bfhi(v.z); w[6] = bflo(v.w); w[7] = bfhi(v.w); }
            const bf16_t* kp0 = P + (size_t)(b * SEQL + qrow) * NPROJ + C_KIDX + 8 * kg;
            bf16x8_t na0 = *(const bf16x8_t*)(kp0 + (size_t)(wave * 16) * NPROJ), na1 = *(const bf16x8_t*)(kp0 + (size_t)(wave * 16) * NPROJ + 32);
            for (int kt = wave; kt < N / 16; kt += 8) {
                const int s0 = kt * 16;
                const bf16x8_t a0 = na0, a1 = na1;
                { const int ktn = (kt + 8 < N / 16) ? kt + 8 : kt;
                  na0 = *(const bf16x8_t*)(kp0 + (size_t)(ktn * 16) * NPROJ); na1 = *(const bf16x8_t*)(kp0 + (size_t)(ktn * 16) * NPROJ + 32); }
                f32x4 sacc = (f32x4){0.f, 0.f, 0.f, 0.f};
#pragma unroll
                for (int h = 0; h < 8; ++h) {
                    f32x4 acc = (f32x4){0.f, 0.f, 0.f, 0.f};
                    acc = __builtin_amdgcn_mfma_f32_16x16x32_bf16(a0, qf[h][0], acc, 0, 0, 0);
                    acc = __builtin_amdgcn_mfma_f32_16x16x32_bf16(a1, qf[h][1], acc, 0, 0, 0);
                    sacc[0] += w[h] * fmaxf(acc[0], 0.f); sacc[1] += w[h] * fmaxf(acc[1], 0.f); sacc[2] += w[h] * fmaxf(acc[2], 0.f); sacc[3] += w[h] * fmaxf(acc[3], 0.f);
                }
                sacc = sacc * IDX_SCALE + 0.0f;
                *(LAS f32x4*)(scl + qrow * SCS + s0 + 4 * kg) = sacc;
#pragma unroll
                for (int i = 0; i < 4; ++i) __hip_atomic_fetch_add(hist + qrow * 256 + sbin(sacc[i]), 1u, __ATOMIC_RELAXED, __HIP_MEMORY_SCOPE_WORKGROUP);
            }
            __syncthreads();
#pragma unroll 1
            for (int qq = 0; qq < 2; ++qq) {
                const int q = 2 * wave + qq; const LAS float* row = scl + q * SCS; LAS unsigned* hq = hist + q * 256;
                unsigned key[32];
#pragma unroll
                for (int j = 0; j < 32; ++j) key[j] = (j < ng) ? fkey(row[64 * j + lane]) : 0u;
                const u32x4 hv = *(const LAS u32x4*)(hq + 4 * lane);
                *(LAS u32x4*)(hq + 4 * lane) = (u32x4){0u, 0u, 0u, 0u};
                const int tsum = (int)(hv.x + hv.y + hv.z + hv.w); int incl = tsum;
#pragma unroll
                for (int off = 1; off < 64; off <<= 1) { const int o = __builtin_amdgcn_ds_bpermute(((lane + off) & 63) << 2, incl); incl += (lane + off < 64) ? o : 0; }
                const int suf = incl - tsum;
                int bt_l, ab_l;
                if (suf + (int)hv.w >= 256) { bt_l = 4 * lane + 3; ab_l = suf; }
                else if (suf + (int)(hv.w + hv.z) >= 256) { bt_l = 4 * lane + 2; ab_l = suf + (int)hv.w; }
                else if (suf + (int)(hv.w + hv.z + hv.y) >= 256) { bt_l = 4 * lane + 1; ab_l = suf + (int)(hv.w + hv.z); }
                else { bt_l = 4 * lane; ab_l = suf + (int)(hv.w + hv.z + hv.y); }
                const u64 cb = __ballot(suf < 256 && incl >= 256);
                const int src = (int)__builtin_ctzll(cb | (1ull << 63));
                const int bt = __builtin_amdgcn_readlane(bt_l, src), above = __builtin_amdgcn_readlane(ab_l, src);
                const int r = 256 - above;
                unsigned cm = 0u;
#pragma unroll
                for (int j = 0; j < 32; ++j) cm |= ((key[j] != 0u) && (sbin(unkey(key[j])) == bt)) ? (1u << j) : 0u;
                const int myc = (int)__popc(cm); int pre = myc;
#pragma unroll
                for (int off = 1; off < 64; off <<= 1) { const int o_ = __builtin_amdgcn_ds_bpermute(((lane - off) & 63) << 2, pre); pre += (lane >= off) ? o_ : 0; }
                const int C = __builtin_amdgcn_readlane(pre, 63);
                int pos = pre - myc;
                if (C <= 64) {
#pragma unroll
                    for (int j = 0; j < 32; ++j) if ((cm >> j) & 1u) { candl[pos] = key[j]; ++pos; }
                }
                unsigned tau; int cgt, neq;
                if (C <= 64) {
                    asm volatile("s_waitcnt lgkmcnt(0)" ::: "memory");
                    const unsigned ck = (lane < C) ? candl[lane] : 0u;
                    unsigned lo = 0u;
#pragma unroll 1
                    for (int bit = 31; bit >= 0; --bit) { const unsigned cand = lo | (1u << bit); if ((int)__popcll(__ballot(ck >= cand)) >= r) lo = cand; }
                    tau = lo; cgt = above + (int)__popcll(__ballot(ck > tau)); neq = (int)__popcll(__ballot(ck == tau));
                } else {
                    unsigned lo = 0u;
#pragma unroll 1
                    for (int bit = 31; bit >= 0; --bit) {
                        const unsigned cand = lo | (1u << bit); int c = 0;
#pragma unroll
                        for (int j = 0; j < 32; ++j) c += (key[j] >= cand) ? 1 : 0;
#pragma unroll
                        for (int x = 1; x < 64; x <<= 1) c += __builtin_amdgcn_ds_bpermute((lane ^ x) << 2, c);
                        if (c >= 256) lo = cand;
                    }
                    tau = lo; cgt = 0;
#pragma unroll
                    for (int j = 0; j < 32; ++j) cgt += (key[j] > tau) ? 1 : 0;
#pragma unroll
                    for (int x = 1; x < 64; x <<= 1) cgt += __builtin_amdgcn_ds_bpermute((lane ^ x) << 2, cgt);
                    neq = 2;
                }
                const int need = 256 - cgt; u64 myword = 0ull;
                if (neq == 1) {
#pragma unroll
                    for (int j = 0; j < 32; ++j) { const u64 word = __ballot(key[j] >= tau); if (lane == j) myword = word; }
                } else {
                    int run = 0;
#pragma unroll
                    for (int j = 0; j < 32; ++j) {
                        const u64 gt = __ballot(key[j] > tau), eq = __ballot(key[j] == tau);
                        const u64 below = eq & ((1ull << lane) - 1ull);
                        const bool sel = (key[j] == tau) && (run + (int)__popcll(below) < need);
                        const u64 word = gt | __ballot(sel);
                        run += (int)__popcll(eq);
                        if (lane == j) myword = word;
                        __builtin_amdgcn_sched_barrier(0);
                    }
                }
                if (lane < 32) MASK[(size_t)(t0 + q) * 32 + lane] = myword;
            }
            __syncthreads();
        }
    }
    XBAR();
    STAMP(3);
#ifdef IDX_EXP
    XBAR();
    STAMP(30);
    {
        PH_LOCALS
        u64* MASKX_ = (u64*)(ws + WS_SPARE);
        typedef short bf16x8_t __attribute__((ext_vector_type(8)));
        constexpr int SCS = 2052;
        LAS float* scl = (LAS float*)lds;
        LAS unsigned* hist = (LAS unsigned*)(lds + 16 * SCS * 4);
        LAS unsigned* candl = hist + 16 * 256 + wave * 64;
        for (int i = tid; i < 16 * 256; i += 512) hist[i] = 0u;
        __syncthreads();
        for (int ui = 0; ui < 4; ++ui) {
            const int uu = ui * 256 + ((ui & 1) ? 255 - bx : bx);
            if (uu >= 1024 || bx >= 256) break;
            const int b = uu & 7, qblk = uu >> 3, q0 = qblk * 16, t0 = b * SEQL + q0, ng = (q0 >> 6) + 1, N = ng * 64;
            if (ng <= 4) {
                for (int qq = 0; qq < 2; ++qq) { u64* mrow = MASKX_ + (size_t)(t0 + 2 * wave + qq) * 32; if (lane < 32) mrow[lane] = (lane < ng) ? ~0ull : 0ull; }
                continue;
            }
            const int qrow = lane & 15, kg = lane >> 4;
            bf16x8_t qf[8][2]; float w[8];
            { const bf16_t* qp = P + (size_t)(t0 + qrow) * NPROJ + C_QIDX + 8 * kg;
#pragma unroll
              for (int h = 0; h < 8; ++h) { qf[h][0] = *(const bf16x8_t*)(qp + h * 64); qf[h][1] = *(const bf16x8_t*)(qp + h * 64 + 32); }
              const u32x4 v = *(const u32x4*)(P + (size_t)(t0 + qrow) * NPROJ + C_WIDX); w[0] = bflo(v.x); w[1] = bfhi(v.x); w[2] = bflo(v.y); w[3] = bfhi(v.y); w[4] = bflo(v.z); w[5] = bfhi(v.z); w[6] = bflo(v.w); w[7] = bfhi(v.w); }
            const bf16_t* kp0 = P + (size_t)(b * SEQL + qrow) * NPROJ + C_KIDX + 8 * kg;
            bf16x8_t na0 = *(const bf16x8_t*)(kp0 + (size_t)(wave * 16) * NPROJ), na1 = *(const bf16x8_t*)(kp0 + (size_t)(wave * 16) * NPROJ + 32);
            if (!(IDX_EXP & 2))
            for (int kt = wave; kt < N / 16; kt += 8) {
                const int s0 = kt * 16;
                const bf16x8_t a0 = na0, a1 = na1;
                { const int ktn = (kt + 8 < N / 16) ? kt + 8 : kt;
                  na0 = *(const bf16x8_t*)(kp0 + (size_t)(ktn * 16) * NPROJ); na1 = *(const bf16x8_t*)(kp0 + (size_t)(ktn * 16) * NPROJ + 32); }
                f32x4 sacc = (f32x4){0.f, 0.f, 0.f, 0.f};
#pragma unroll
                for (int h = 0; h < 8; ++h) {
                    f32x4 acc = (f32x4){0.f, 0.f, 0.f, 0.f};
                    acc = __builtin_amdgcn_mfma_f32_16x16x32_bf16(a0, qf[h][0], acc, 0, 0, 0);
                    acc = __builtin_amdgcn_mfma_f32_16x16x32_bf16(a1, qf[h][1], acc, 0, 0, 0);
                    sacc[0] += w[h] * fmaxf(acc[0], 0.f); sacc[1] += w[h] * fmaxf(acc[1], 0.f); sacc[2] += w[h] * fmaxf(acc[2], 0.f); sacc[3] += w[h] * fmaxf(acc[3], 0.f);
                }
                sacc = sacc * IDX_SCALE + 0.0f;
                *(LAS f32x4*)(scl + qrow * SCS + s0 + 4 * kg) = sacc;
#pragma unroll
                for (int i = 0; i < 4; ++i) __hip_atomic_fetch_add(hist + qrow * 256 + sbin(sacc[i]), 1u, __ATOMIC_RELAXED, __HIP_MEMORY_SCOPE_WORKGROUP);
            }
            __syncthreads();
#pragma unroll 1
            for (int qq = 0; qq < ((IDX_EXP & 1) ? 0 : 2); ++qq) {
                const int q = 2 * wave + qq; const LAS float* row = scl + q * SCS; LAS unsigned* hq = hist + q * 256;
                unsigned key[32];
#pragma unroll
                for (int j = 0; j < 32; ++j) key[j] = (j < ng) ? fkey(row[64 * j + lane]) : 0u;
                const u32x4 hv = *(const LAS u32x4*)(hq + 4 * lane);
                *(LAS u32x4*)(hq + 4 * lane) = (u32x4){0u, 0u, 0u, 0u};
                const int tsum = (int)(hv.x + hv.y + hv.z + hv.w); int incl = tsum;
#pragma unroll
                for (int off = 1; off < 64; off <<= 1) { const int o = __builtin_amdgcn_ds_bpermute(((lane + off) & 63) << 2, incl); incl += (lane + off < 64) ? o : 0; }
                const int suf = incl - tsum;
                int bt_l, ab_l;
                if (suf + (int)hv.w >= 256) { bt_l = 4 * lane + 3; ab_l = suf; }
                else if (suf + (int)(hv.w + hv.z) >= 256) { bt_l = 4 * lane + 2; ab_l = suf + (int)hv.w; }
                else if (suf + (int)(hv.w + hv.z + hv.y) >= 256) { bt_l = 4 * lane + 1; ab_l = suf + (int)(hv.w + hv.z); }
                else { bt_l = 4 * lane; ab_l = suf + (int)(hv.w + hv.z + hv.y); }
                const u64 cb = __ballot(suf < 256 && incl >= 256);
                const int src = (int)__builtin_ctzll(cb | (1ull << 63));
                const int bt = __builtin_amdgcn_readlane(bt_l, src), above = __builtin_amdgcn_readlane(ab_l, src);
                const int r = 256 - above;
                int C = 0;
                if (!(IDX_EXP & 4))
#pragma unroll
                for (int j = 0; j < 32; ++j) {
                    const bool isc = (key[j] != 0u) && (sbin(unkey(key[j])) == bt);
                    const u64 bal = __ballot(isc);
                    if (isc) { const int pos = C + (int)__popcll(bal & ((1ull << lane) - 1ull)); if (pos < 64) candl[pos] = key[j]; }
                    C += (int)__popcll(bal);
                }
                unsigned tau; int cgt;
                if (IDX_EXP & 4) { tau = 0x80000000u + (unsigned)bt; cgt = above; }
                else if (C <= 64) {
                    asm volatile("s_waitcnt lgkmcnt(0)" ::: "memory");
                    const unsigned ck = (lane < C) ? candl[lane] : 0u;
                    unsigned lo = 0u;
#pragma unroll 1
                    for (int bit = 31; bit >= 0; --bit) { const unsigned cand = lo | (1u << bit); if ((int)__popcll(__ballot(ck >= cand)) >= r) lo = cand; }
                    tau = lo; cgt = above + (int)__popcll(__ballot(ck > tau));
                } else {
                    unsigned lo = 0u;
#pragma unroll 1
                    for (int bit = 31; bit >= 0; --bit) {
                        const unsigned cand = lo | (1u << bit); int c = 0;
#pragma unroll
                        for (int j = 0; j < 32; ++j) c += (key[j] >= cand) ? 1 : 0;
#pragma unroll
                        for (int x = 1; x < 64; x <<= 1) c += __builtin_amdgcn_ds_bpermute((lane ^ x) << 2, c);
                        if (c >= 256) lo = cand;
                    }
                    tau = lo; cgt = 0;
#pragma unroll
                    for (int j = 0; j < 32; ++j) cgt += (key[j] > tau) ? 1 : 0;
#pragma unroll
                    for (int x = 1; x < 64; x <<= 1) cgt += __builtin_amdgcn_ds_bpermute((lane ^ x) << 2, cgt);
                }
                const int need = 256 - cgt; int run = 0; u64 myword = (u64)tau;
                if (!(IDX_EXP & 8))
#pragma unroll
                for (int j = 0; j < 32; ++j) {
                    const u64 gt = __ballot(key[j] > tau), eq = __ballot(key[j] == tau);
                    const u64 below = eq & ((1ull << lane) - 1ull);
                    const bool sel = (key[j] == tau) && (run + (int)__popcll(below) < need);
                    const u64 word = gt | __ballot(sel);
                    run += (int)__popcll(eq);
                    if (lane == j) myword = word;
                    __builtin_amdgcn_sched_barrier(0);
                }
                if (lane < 32) MASKX_[(size_t)(t0 + q) * 32 + lane] = myword;
            }
            __syncthreads();
        }
    }
    XBAR();
    STAMP(31);
#endif

#if DBG_CMP == 1
    {
        PH_LOCALS
        bf16_t* OAX = (bf16_t*)(ws + WS_SPARE);
        float* qv = (float*)(lds_raw + wave * 10240); float* lg = qv + 512;
        for (int it = gw; it < T_TOK * 8; it += NGW) {
            const int t = it >> 3, h = it & 7, b = t >> 11, q = t & 2047, ng = (q >> 6) + 1;
            { const unsigned v = *(const unsigned*)(P + (size_t)t * NPROJ + C_QLAT + h * 128 + 2 * lane); qv[2 * lane] = bflo(v); qv[2 * lane + 1] = bfhi(v); }
            const u64* mrow = MASK + (size_t)t * 32;
            float mx = -INFINITY;
            for (int g = 0; g < ng; ++g) {
                asm volatile("" ::: "memory");
                const u64 word = mrow[g]; float l = -INFINITY;
                if ((word >> lane) & 1ull) {
                    const u32x4* kr = (const u32x4*)(KV + (size_t)(b * SEQL + g * 64 + lane) * 128);
                    float d0 = 0.f, d1 = 0.f, d2 = 0.f, d3 = 0.f;
#pragma unroll
                    for (int c = 0; c < 16; ++c) { const u32x4 v = kr[c]; const f32x4 qa = *(const f32x4*)(qv + 8 * c), qb = *(const f32x4*)(qv + 8 * c + 4);
                        d0 += qa[0] * bflo(v.x) + qb[0] * bflo(v.z); d1 += qa[1] * bfhi(v.x) + qb[1] * bfhi(v.z); d2 += qa[2] * bflo(v.y) + qb[2] * bflo(v.w); d3 += qa[3] * bfhi(v.y) + qb[3] * bfhi(v.w); }
                    l = ((d0 + d1) + (d2 + d3)) * ATT_SCALE;
                }
                lg[g * 64 + lane] = l; mx = fmaxf(mx, l);
            }
            mx = wave_max(mx, lane);
            float o0 = 0.f, o1 = 0.f, sum = 0.f;
            for (int g = 0; g < ng; ++g) {
                const u64 wv = mrow[g];
                u64 word = ((u64)__builtin_amdgcn_readfirstlane((unsigned)(wv >> 32)) << 32) | (u64)__builtin_amdgcn_readfirstlane((unsigned)wv);
                while (word) {
                    const int j = __builtin_ctzll(word); word &= word - 1ull;
                    const int s = g * 64 + j; const float pj = __expf(lg[s] - mx);
                    const unsigned v = *(const unsigned*)(KV + (size_t)(b * SEQL + s) * 128 + 2 * lane);
                    o0 += pj * bflo(v); o1 += pj * bfhi(v); sum += pj;
                }
            }
            const float inv = 1.0f / sum;
            *(unsigned*)(OAX + (size_t)t * 1024 + h * 128 + 2 * lane) = pkbf(o0 * inv, o1 * inv);
        }
    }
    __syncthreads();
#endif
#if DBG_CMP == 2
    {
        PH_LOCALS
        const float* g_ret = IN(5);
        bf16_t* OBX = (bf16_t*)(ws + WS_SPARE);
        float* qv = (float*)(lds_raw + wave * 10240); float* lg = qv + 512; float* wl = lg;
        for (int it = gw; it < T_TOK * 8; it += NGW) {
            const int t = it >> 3, h = it & 7, b = t >> 11, n = t & 2047, ng = (n >> 6) + 1;
            const float lgam = (h == 0) ? -0.04580368961312479f : (h == 1) ? -0.02272007650008353f : (h == 2) ? -0.011315313227834146f : (h == 3) ? -0.005646563141142063f :
                               (h == 4) ? -0.0028205190623786626f : (h == 5) ? -0.0014095702546713536f : (h == 6) ? -0.0007046129765893727f : -0.0003522634716290214f;
            { const unsigned v = *(const unsigned*)(P + (size_t)t * NPROJ + C_QR + h * 128 + 2 * lane); qv[2 * lane] = bflo(v); qv[2 * lane + 1] = bfhi(v); }
            float o0 = 0.f, o1 = 0.f;
            for (int g = 0; g < ng; ++g) {
                asm volatile("" ::: "memory");
                const int m = g * 64 + lane;
                const u32x4* kr = (const u32x4*)(P + (size_t)(b * SEQL + m) * NPROJ + C_KR + h * 128);
                float d0 = 0.f, d1 = 0.f, d2 = 0.f, d3 = 0.f;
#pragma unroll
                for (int c = 0; c < 16; ++c) { const u32x4 v = kr[c]; const f32x4 qa = *(const f32x4*)(qv + 8 * c), qb = *(const f32x4*)(qv + 8 * c + 4);
                    d0 += qa[0] * bflo(v.x) + qb[0] * bflo(v.z); d1 += qa[1] * bfhi(v.x) + qb[1] * bfhi(v.z); d2 += qa[2] * bflo(v.y) + qb[2] * bflo(v.w); d3 += qa[3] * bfhi(v.y) + qb[3] * bfhi(v.w); }
                const float dot = (d0 + d1) + (d2 + d3);
                wl[lane] = (m <= n) ? dot * exp2f((float)(n - m) * lgam) : 0.f;
                const int jmax = (g == ng - 1) ? (n & 63) : 63;
                for (int j = 0; j <= jmax; ++j) {
                    const float wj = wl[j];
                    const unsigned v = *(const unsigned*)(P + (size_t)(b * SEQL + g * 64 + j) * NPROJ + C_VR + h * 128 + 2 * lane);
                    o0 += wj * bflo(v); o1 += wj * bfhi(v);
                }
            }
            const float mu = wave_sum(o0 + o1, lane) * (1.0f / 128.0f); const float e0 = o0 - mu, e1 = o1 - mu;
            const float rs = 1.0f / sqrtf(wave_sum(e0 * e0 + e1 * e1, lane) * (1.0f / 128.0f) + EPS_F);
            const unsigned gv = *(const unsigned*)(P + (size_t)t * NPROJ + C_GR + h * 128 + 2 * lane);
            const float y0 = siluf_(bflo(gv)) * e0 * rs * g_ret[h * 128 + 2 * lane], y1 = siluf_(bfhi(gv)) * e1 * rs * g_ret[h * 128 + 2 * lane + 1];
            *(unsigned*)(OBX + (size_t)t * 1024 + h * 128 + 2 * lane) = pkbf(y0, y1);
        }
    }
    __syncthreads();
#endif
    {
        PH_LOCALS
        for (int pr = bx; pr < 256; pr += G) {
            const int b = pr >> 5, i = pr & 31;
#pragma unroll 1
            for (int uu = 0; uu < 2; ++uu) {
                const int qb = uu ? 63 - i : i; const int t0 = b * SEQL + qb * 32;
                fa::UnitArgs U; U.Q = P + (size_t)t0 * NPROJ + C_QLAT; U.ldq = NPROJ; U.K = KV + (size_t)b * SEQL * 128; U.V = U.K; U.ldk = 128; U.mask = MASK + (size_t)t0 * 32;
                U.ntiles = (qb >> 1) + 1; U.n0 = 0; U.lgam = 0.f;
                fa::f32x16 o[4]; float l_reg;
                fa::unit_body<0>((LAS char*)lds, U, tid, o, l_reg);
                const int r32 = lane & 31, hi = lane >> 5;
                const int trow1 = hide_i(t0);
                LAS float* li_l = (LAS float*)(lds + fa::OFF_WS) + wave * 64;
                if (hi == 0) li_l[r32] = l_reg;
                asm volatile("s_waitcnt lgkmcnt(0)" ::: "memory");
                LAS char* Tw = (LAS char*)lds + fa::OFF_Q + wave * 8704; LAS char* Tl = Tw + hi * (4 * 272) + r32 * 2; asm volatile("" : "+v"(Tl));
#pragma unroll
                for (int r = 0; r < 16; ++r) {
                    const int orow = fa::crow(r, hi); const float rl = __builtin_amdgcn_rcpf(li_l[orow]);
#pragma unroll
                    for (int d0 = 0; d0 < 4; ++d0) *(LAS bf16_t*)(Tl + ((r & 3) + 8 * (r >> 2)) * 272 + d0 * 64) = (bf16_t)(pkbf(o[d0][r] * rl, 0.f) & 0xffffu);
                }
                asm volatile("s_waitcnt lgkmcnt(0)" ::: "memory");
#pragma unroll
                for (int k = 0; k < 8; ++k) {
                    const int c = lane + 64 * k, orow = c >> 4, ch = c & 15;
                    const u32x4 v = *(const LAS u32x4*)(Tw + orow * 272 + ch * 16);
                    *(u32x4*)(OA + (size_t)(trow1 + orow) * 2048 + wave * 128 + ch * 8) = v;
                }
                __syncthreads();
            }
        }
    }
    STAMP(20);
    {
        PH_LOCALS
        const float* g_ret = IN(5);
        for (int pr = bx; pr < 256; pr += G) {
            const int bh = pr >> 2, i = pr & 3, b = bh >> 3, h = bh & 7;
            const float lgam = (h == 0) ? -0.04580368961312479f : (h == 1) ? -0.02272007650008353f : (h == 2) ? -0.011315313227834146f : (h == 3) ? -0.005646563141142063f :
                               (h == 4) ? -0.0028205190623786626f : (h == 5) ? -0.0014095702546713536f : (h == 6) ? -0.0007046129765893727f : -0.0003522634716290214f;
#pragma unroll 1
            for (int uu = 0; uu < 2; ++uu) {
                const int qb = uu ? 7 - i : i; const int n0 = qb * 256;
                fa::UnitArgs U; U.Q = P + (size_t)(b * SEQL + n0) * NPROJ + C_QR + h * 128; U.ldq = NPROJ;
                U.K = P + (size_t)(b * SEQL) * NPROJ + C_KR + h * 128; U.V = P + (size_t)(b * SEQL) * NPROJ + C_VR + h * 128; U.ldk = NPROJ; U.mask = nullptr;
                U.ntiles = 4 * (qb + 1); U.n0 = n0; U.lgam = lgam;
                fa::f32x16 o[4]; float l_reg;
                fa::unit_body<1>((LAS char*)lds, U, tid, o, l_reg);
                const int r32 = lane & 31, hi = lane >> 5;
                const int tok0 = hide_i(b * SEQL + n0 + wave * 32 + 4 * hi);
                float gr[4];
#pragma unroll
                for (int d0 = 0; d0 < 4; ++d0) gr[d0] = g_ret[h * 128 + d0 * 32 + r32];
                float sv[16], qv[16];
#pragma unroll
                for (int r = 0; r < 16; ++r) sv[r] = (o[0][r] + o[1][r]) + (o[2][r] + o[3][r]);
#pragma unroll
                for (int x = 1; x < 32; x <<= 1)
#pragma unroll
                    for (int r = 0; r < 16; ++r) sv[r] += shx(sv[r], lane, x);
#pragma unroll
                for (int r = 0; r < 16; ++r) { const float mu = sv[r] * (1.0f / 128.0f); sv[r] = mu;
                    const float e0 = o[0][r] - mu, e1 = o[1][r] - mu, e2 = o[2][r] - mu, e3 = o[3][r] - mu; qv[r] = (e0 * e0 + e1 * e1) + (e2 * e2 + e3 * e3); }
#pragma unroll
                for (int x = 1; x < 32; x <<= 1)
#pragma unroll
                    for (int r = 0; r < 16; ++r) qv[r] += shx(qv[r], lane, x);
                LAS char* Tw = (LAS char*)lds + fa::OFF_Q + wave * 8704; LAS char* Tl = Tw + hi * (4 * 272) + r32 * 2; asm volatile("" : "+v"(Tl));
#pragma unroll
                for (int r = 0; r < 16; ++r) {
                    const float mu = sv[r]; const float rs = 1.0f / sqrtf(qv[r] * (1.0f / 128.0f) + EPS_F); const int orow = fa::crow(r, hi);
#pragma unroll
                    for (int d0 = 0; d0 < 4; ++d0) *(LAS bf16_t*)(Tl + ((r & 3) + 8 * (r >> 2)) * 272 + d0 * 64) = (bf16_t)(pkbf((o[d0][r] - mu) * rs * gr[d0], 0.f) & 0xffffu);
                }
                asm volatile("s_waitcnt lgkmcnt(0)" ::: "memory");
                const int tokb = hide_i(b * SEQL + n0 + wave * 32);
#pragma unroll
                for (int k = 0; k < 8; ++k) {
                    const int c = lane + 64 * k, orow = c >> 4, ch = c & 15;
                    const u32x4 v = *(const LAS u32x4*)(Tw + orow * 272 + ch * 16);
                    const size_t tok = (size_t)(tokb + orow);
                    const u32x4 g = __builtin_nontemporal_load((const u32x4*)(P + tok * NPROJ + C_GR + h * 128 + ch * 8));
                    u32x4 w; w.x = pkbf(siluf_(bflo(g.x)) * bflo(v.x), siluf_(bfhi(g.x)) * bfhi(v.x)); w.y = pkbf(siluf_(bflo(g.y)) * bflo(v.y), siluf_(bfhi(g.y)) * bfhi(v.y));
                    w.z = pkbf(siluf_(bflo(g.z)) * bflo(v.z), siluf_(bfhi(g.z)) * bfhi(v.z)); w.w = pkbf(siluf_(bflo(g.w)) * bflo(v.w), siluf_(bfhi(g.w)) * bfhi(v.w));
                    *(u32x4*)(OB + tok * 2048 + h * 128 + ch * 8) = w;
                }
                __syncthreads();
            }
        }
    }
#ifdef RET_EXP
    XBAR();
    STAMP(30);
    {
        PH_LOCALS
        const float* g_ret = IN(5);
        for (int pr = bx; pr < 256; pr += G) {
            const int bh = pr >> 2, i = pr & 3, b = bh >> 3, h = bh & 7;
            const float lgam = (h == 0) ? -0.04580368961312479f : (h == 1) ? -0.02272007650008353f : (h == 2) ? -0.011315313227834146f : (h == 3) ? -0.005646563141142063f :
                               (h == 4) ? -0.0028205190623786626f : (h == 5) ? -0.0014095702546713536f : (h == 6) ? -0.0007046129765893727f : -0.0003522634716290214f;
#pragma unroll 1
            for (int uu = 0; uu < 2; ++uu) {
                const int qb = uu ? 7 - i : i; const int n0 = qb * 256;
                fa::UnitArgs U; U.Q = P + (size_t)(b * SEQL + n0) * NPROJ + C_QR + h * 128; U.ldq = NPROJ;
                U.K = P + (size_t)(b * SEQL) * NPROJ + C_KR + h * 128; U.V = P + (size_t)(b * SEQL) * NPROJ + C_VR + h * 128; U.ldk = NPROJ; U.mask = nullptr;
                U.ntiles = 4 * (qb + 1); U.n0 = n0; U.lgam = lgam;
                fa::f32x16 o[4]; float l_reg;
                fa::unit_body<1, RET_EXP>((LAS char*)lds, U, tid, o, l_reg);
                const int r32 = lane & 31, hi = lane >> 5;
                const int tok0 = hide_i(b * SEQL + n0 + wave * 32 + 4 * hi);
                float gr[4];
#pragma unroll
                for (int d0 = 0; d0 < 4; ++d0) gr[d0] = g_ret[h * 128 + d0 * 32 + r32];
                if (RET_EXP & 8) { fa::f32x16 t_ = (o[0] + o[1]) + (o[2] + o[3]); float z_ = 0.f;
#pragma unroll
                    for (int r = 0; r < 16; ++r) z_ += t_[r];
                    ((float*)(ws + WS_SPARE))[(size_t)(pr * 2 + uu) * 512 + tid] = z_; }
                else
#pragma unroll
                for (int r = 0; r < 16; ++r) {
                    float s = (o[0][r] + o[1][r]) + (o[2][r] + o[3][r]);
#pragma unroll
                    for (int x = 1; x < 32; x <<= 1) s += shx(s, lane, x);
                    const float mu = s * (1.0f / 128.0f);
                    const float e0 = o[0][r] - mu, e1 = o[1][r] - mu, e2 = o[2][r] - mu, e3 = o[3][r] - mu;
                    float q = (e0 * e0 + e1 * e1) + (e2 * e2 + e3 * e3);
#pragma unroll
                    for (int x = 1; x < 32; x <<= 1) q += shx(q, lane, x);
                    const float rs = 1.0f / sqrtf(q * (1.0f / 128.0f) + EPS_F);
                    const size_t tok = (size_t)(tok0 + (r & 3) + 8 * (r >> 2));
                    const bf16_t* gp = P + tok * NPROJ + C_GR + h * 128 + r32; bf16_t* op = (bf16_t*)(ws + WS_SPARE) + tok * 1024 + h * 128 + r32;
                    op[0] = (bf16_t)(pkbf(siluf_(bflo((unsigned)gp[0])) * e0 * rs * gr[0], 0.f) & 0xffffu);
                    op[32] = (bf16_t)(pkbf(siluf_(bflo((unsigned)gp[32])) * e1 * rs * gr[1], 0.f) & 0xffffu);
                    op[64] = (bf16_t)(pkbf(siluf_(bflo((unsigned)gp[64])) * e2 * rs * gr[2], 0.f) & 0xffffu);
                    op[96] = (bf16_t)(pkbf(siluf_(bflo((unsigned)gp[96])) * e3 * rs * gr[3], 0.f) & 0xffffu);
                }
                __syncthreads();
            }
        }
    }
    XBAR();
    STAMP(31);
#endif
#if DBG_CMP
    XBAR();
    {
        PH_LOCALS
        const bf16_t* A_ = (DBG_CMP == 1) ? OA : OB; const bf16_t* R_ = (const bf16_t*)(ws + WS_SPARE);
        float sd = 0.f, sr = 0.f;
#if DBG_CMP == 3
        for (size_t i = (size_t)gtid; i < (size_t)T_TOK * 32; i += (size_t)NGT) { const u64 a = MASK[i], r = ((const u64*)(ws + WS_SPARE))[i]; sd += (float)__popcll(a ^ r); sr += 100.0f * (float)__popcll(r); }
#else
        for (size_t i = (size_t)gtid; i < (size_t)T_TOK * 1024 / 2; i += (size_t)NGT) {
            const unsigned a = ((const unsigned*)A_)[(i >> 9) * 1024 + (i & 511)], r = ((const unsigned*)R_)[i];
            const float d0 = bflo(a) - bflo(r), d1 = bfhi(a) - bfhi(r); sd += d0 * d0 + d1 * d1; sr += bflo(r) * bflo(r) + bfhi(r) * bfhi(r);
        }
#endif
        sd = wave_sum(sd, lane); sr = wave_sum(sr, lane);
        if (lane == 0) { atomicAdd((float*)(ctl + 4096), sd); atomicAdd((float*)(ctl + 4097), sr); }
    }
#endif
    XBAR();
    STAMP(4);

    {
        PH_LOCALS
        pg8::Gemm g{OA, WCOMB, T_TOK, DMODEL, 2048}; pg8::StaticOrder S; S.init(T_TOK, DMODEL, G, bx);
        pg8::EpiMergeF E{P, MIXED};
        pg8::gemm_phase<pg8::EpiMergeF, pg8::StaticOrder, true, true>(lds, g, S, E, tid);
    }
    XBAR();
    STAMP(5);
    {
        PH_LOCALS
        const float* x = IN(0);
        pg8::Gemm g{MIXED, WO, T_TOK, DMODEL, 2048}; pg8::StaticOrder S; S.init(T_TOK, DMODEL, G, bx);
        pg8::EpiRes E{x, out};
        pg8::gemm_phase<pg8::EpiRes, pg8::StaticOrder, true, true>(lds, g, S, E, tid);
    }
    XBAR();
    STAMP(7);
#ifdef GEMM_EXP
    {
        PH_LOCALS
        pg8::Gemm g{MIXED, WO, T_TOK, DMODEL, 2048}; pg8::StaticOrder S; S.init(T_TOK, DMODEL, G, bx);
        pg8::EpiNull E{(float*)(ws + WS_SPARE)};
        pg8::gemm_phase<pg8::EpiNull, pg8::StaticOrder, true, true>(lds, g, S, E, tid);
    }
    XBAR();
    STAMP(31);
#endif

    {
    PH_LOCALS
    const float* g_ffn = IN(8); const float* b_rg = IN(10); const float* b_re = IN(12);
    const f32x4* WC4 = (const f32x4*)(ws + WS_WC); float* tok_rs = (float*)(ws + WS_WC + 786432);
    LAS float* lg = (LAS float*)lds + wave * (16 * 52);
    const int row = lane & 15, g4 = lane >> 4;
    LAS float* part = (LAS float*)lds + 4 * (16 * 52) + (wave & 3) * (13 * 64);
    for (int tile0 = bx * 4; tile0 < T_TOK / 16; tile0 += G * 4) {
        const int tile = tile0 + (wave & 3), kh = wave >> 2;
        const int tok0 = tile * 16;
        const float* hrow = out + (size_t)(tok0 + row) * DMODEL + 8 * g4 + 1024 * kh;
        bf16_t* trow = TN + (size_t)(tok0 + row) * DMODEL + 8 * g4 + 1024 * kh;
        const f32x4* wp = WC4 + (size_t)g4 * 96 + 2 * row + (size_t)kh * 32 * 384;
        const float* gp = g_ffn + 8 * g4 + 1024 * kh;
        f32x4 acc0 = (f32x4){0.f, 0.f, 0.f, 0.f}, acc1 = acc0, acc2 = acc0; float ssq = 0.f;
        f32x4 a0 = *(const f32x4*)(hrow), a1 = *(const f32x4*)(hrow + 4);
        f32x4 b00 = wp[0], b01 = wp[1], b10 = wp[32], b11 = wp[33], b20 = wp[64], b21 = wp[65];
        f32x4 na0 = *(const f32x4*)(hrow + 32), na1 = *(const f32x4*)(hrow + 36);
        f32x4 nb00 = wp[384], nb01 = wp[385], nb10 = wp[416], nb11 = wp[417], nb20 = wp[448], nb21 = wp[449];
        for (int it = 0; it < 32; ++it) {
            const int itn = (it + 2 < 32) ? it + 2 : 31;
            const f32x4 ma0 = *(const f32x4*)(hrow + 32 * itn), ma1 = *(const f32x4*)(hrow + 32 * itn + 4);
            const f32x4* wn = wp + (size_t)itn * 384;
            const f32x4 mb00 = wn[0], mb01 = wn[1], mb10 = wn[32], mb11 = wn[33], mb20 = wn[64], mb21 = wn[65];
            const f32x4 gk0 = *(const f32x4*)(gp + 32 * it), gk1 = *(const f32x4*)(gp + 32 * it + 4);
            ssq += (a0[0] * a0[0] + a0[1] * a0[1]) + (a0[2] * a0[2] + a0[3] * a0[3]) + (a1[0] * a1[0] + a1[1] * a1[1]) + (a1[2] * a1[2] + a1[3] * a1[3]);
            { u32x4 w; w.x = pkbf(a0[0] * gk0[0], a0[1] * gk0[1]); w.y = pkbf(a0[2] * gk0[2], a0[3] * gk0[3]); w.z = pkbf(a1[0] * gk1[0], a1[1] * gk1[1]); w.w = pkbf(a1[2] * gk1[2], a1[3] * gk1[3]);
              *(u32x4*)(trow + 32 * it) = w; }
#pragma unroll
            for (int s_ = 0; s_ < 4; ++s_) {
                acc0 = __builtin_amdgcn_mfma_f32_16x16x4f32(a0[s_], b00[s_], acc0, 0, 0, 0);
                acc1 = __builtin_amdgcn_mfma_f32_16x16x4f32(a0[s_], b10[s_], acc1, 0, 0, 0);
                acc2 = __builtin_amdgcn_mfma_f32_16x16x4f32(a0[s_], b20[s_], acc2, 0, 0, 0);
            }
#pragma unroll
            for (int s_ = 0; s_ < 4; ++s_) {
                acc0 = __builtin_amdgcn_mfma_f32_16x16x4f32(a1[s_], b01[s_], acc0, 0, 0, 0);
                acc1 = __builtin_amdgcn_mfma_f32_16x16x4f32(a1[s_], b11[s_], acc1, 0, 0, 0);
                acc2 = __builtin_amdgcn_mfma_f32_16x16x4f32(a1[s_], b21[s_], acc2, 0, 0, 0);
            }
            a0 = na0; a1 = na1; b00 = nb00; b01 = nb01; b10 = nb10; b11 = nb11; b20 = nb20; b21 = nb21;
            na0 = ma0; na1 = ma1; nb00 = mb00; nb01 = mb01; nb10 = mb10; nb11 = mb11; nb20 = mb20; nb21 = mb21;
        }
        if (kh == 1) {
#pragma unroll
            for (int r = 0; r < 4; ++r) { part[r * 64 + lane] = acc0[r]; part[(4 + r) * 64 + lane] = acc1[r]; part[(8 + r) * 64 + lane] = acc2[r]; }
            part[12 * 64 + lane] = ssq;
        }
        __syncthreads();
        if (kh == 0) {
#pragma unroll
            for (int r = 0; r < 4; ++r) { acc0[r] += part[r * 64 + lane]; acc1[r] += part[(4 + r) * 64 + lane]; acc2[r] += part[(8 + r) * 64 + lane]; }
            ssq += part[12 * 64 + lane];
        ssq += shx(ssq, lane, 16); ssq += shx(ssq, lane, 32);
        const float rstd = 1.0f / sqrtf(ssq * (1.0f / DMODEL) + EPS_F);
#pragma unroll
        for (int r = 0; r < 4; ++r) { lg[(4 * g4 + r) * 52 + row] = acc0[r]; lg[(4 * g4 + r) * 52 + 16 + row] = acc1[r]; lg[(4 * g4 + r) * 52 + 32 + row] = acc2[r]; }
        asm volatile("s_waitcnt lgkmcnt(0)" ::: "memory");
        if (lane < 16) {
            const int t = tok0 + lane; const LAS float* lr = lg + lane * 52;
            float gl[4];
#pragma unroll
            for (int k = 0; k < 4; ++k) gl[k] = lr[k] * rstd + b_rg[k];
            int grp = 0; float gmx = gl[0];
#pragma unroll
            for (int k = 1; k < 4; ++k) if (gl[k] > gmx) { gmx = gl[k]; grp = k; }
            float gz = 0.f;
#pragma unroll
            for (int k = 0; k < 4; ++k) gz += __expf(gl[k] - gmx);
            const float p_grp = 1.0f / gz;
            float el[8];
#pragma unroll
            for (int k = 0; k < 8; ++k) el[k] = lr[4 + grp * 8 + k] * rstd + b_re[grp * 8 + k];
            int i1 = 0; float m1 = el[0];
#pragma unroll
            for (int k = 1; k < 8; ++k) if (el[k] > m1) { m1 = el[k]; i1 = k; }
            int i2 = -1; float m2 = -INFINITY;
#pragma unroll
            for (int k = 0; k < 8; ++k) if (k != i1 && el[k] > m2) { m2 = el[k]; i2 = k; }
            const float e2 = __expf(m2 - m1); const float den = 1.0f / (1.0f + e2);
            const float g1 = p_grp * den, g2 = p_grp * e2 * den;
            const int ex1 = grp * 8 + i1, ex2 = grp * 8 + i2;
            const unsigned r1 = atomicAdd(ctl + 64 * ex1, 1u), r2 = atomicAdd(ctl + 64 * ex2, 1u);
            asg_e[2 * t] = ex1; asg_e[2 * t + 1] = ex2; asg_r[2 * t] = (int)r1; asg_r[2 * t + 1] = (int)r2; asg_g[2 * t] = g1; asg_g[2 * t + 1] = g2;
            tok_rs[t] = rstd;
        }
        }
        __syncthreads();
    }
    }
    XBAR();
    STAMP(8);

    LAS int* tile_start = (LAS int*)(lds + LDS_MISC);
    {
    PH_LOCALS
    if (tid == 0) {
        int acc_t = 0;
        for (int e = 0; e < 32; ++e) { tile_start[e] = acc_t; const int c = (int)__hip_atomic_load(ctl + 64 * e, __ATOMIC_RELAXED, __HIP_MEMORY_SCOPE_AGENT); acc_t += (c + 255) >> 8; }
        tile_start[32] = acc_t;
    }
    __syncthreads();
    for (int a = gtid; a < 2 * T_TOK; a += NGT) {
        const int t = a >> 1; const int e = asg_e[a], rk = asg_r[a]; const int slot = tile_start[e] * 256 + rk;
        row_tok[slot] = t; row_gate[slot] = asg_g[a]; tok_slot[a] = slot; ((float*)(ws + WS_WC + 524288))[slot] = ((const float*)(ws + WS_WC + 786432))[t];
    }
    }
    XBAR();
    STAMP(9);

    {
        PH_LOCALS
        pg8::Gemm g{TN, WGU, MAXSLOT, 2048, 2048}; pg8::ExpertOrderT<true> S{tile_start, G, bx, row_tok};
        pg8::EpiSwiglu E{HMID, (const float*)(ws + WS_WC + 524288)};
        pg8::gemm_phase<pg8::EpiSwiglu, pg8::ExpertOrderT<true>, true, true>(lds, g, S, E, tid);
    }
    XBAR();
    STAMP(10);
    {
        PH_LOCALS
        pg8::Gemm g{HMID, WD, MAXSLOT, 2048, 1024}; pg8::ExpertOrderT<false> S{tile_start, G, bx, nullptr};
        pg8::EpiDown E{Y, row_gate};
        pg8::gemm_phase<pg8::EpiDown, pg8::ExpertOrderT<false>, true, true>(lds, g, S, E, tid);
    }
    XBAR();
    STAMP(11);
#if PROF_PHASE >= 0
    XBAR();
#endif

    {
    PH_LOCALS
    const float* g_fin = IN(16);
#if DBG_CMP
    const float dbg_scale = 1.0f + 4.0f * sqrtf(__hip_atomic_load((float*)(ctl + 4096), __ATOMIC_RELAXED, __HIP_MEMORY_SCOPE_AGENT) / __hip_atomic_load((float*)(ctl + 4097), __ATOMIC_RELAXED, __HIP_MEMORY_SCOPE_AGENT));
#elif PROF_PHASE >= 0 && (PROF_PHASE % 100) != 12
    const unsigned ta_ = __hip_atomic_load(ctl + 6000 + (PROF_PHASE / 100), __ATOMIC_RELAXED, __HIP_MEMORY_SCOPE_AGENT), tb_ = __hip_atomic_load(ctl + 6000 + (PROF_PHASE % 100), __ATOMIC_RELAXED, __HIP_MEMORY_SCOPE_AGENT);
    const float dbg_scale = 1.0f + sqrtf(PROF_SCALE * (float)(tb_ - ta_) * 0.01f);
#else
    const float dbg_scale = 1.0f;
#endif
    for (int t = gw; t < T_TOK; t += 2 * NGW) {
        const int t1 = (t + NGW < T_TOK) ? t + NGW : t;
        const int sa0 = tok_slot[2 * t], sa1 = tok_slot[2 * t + 1], sb0 = tok_slot[2 * t1], sb1 = tok_slot[2 * t1 + 1];
        f32x4* hra = (f32x4*)(out + (size_t)t * DMODEL) + lane; f32x4* hrb = (f32x4*)(out + (size_t)t1 * DMODEL) + lane;
        const u32x2* ya0 = (const u32x2*)(Y + (size_t)sa0 * DMODEL) + lane; const u32x2* ya1 = (const u32x2*)(Y + (size_t)sa1 * DMODEL) + lane;
        const u32x2* yb0 = (const u32x2*)(Y + (size_t)sb0 * DMODEL) + lane; const u32x2* yb1 = (const u32x2*)(Y + (size_t)sb1 * DMODEL) + lane;
        f32x4 va[8], vb[8]; u32x2 pa[8], qa[8], pb[8], qb[8];
#pragma unroll
        for (int j = 0; j < 8; ++j) { va[j] = __builtin_nontemporal_load(hra + 64 * j); vb[j] = __builtin_nontemporal_load(hrb + 64 * j); pa[j] = __builtin_nontemporal_load(ya0 + 64 * j); qa[j] = __builtin_nontemporal_load(ya1 + 64 * j); pb[j] = __builtin_nontemporal_load(yb0 + 64 * j); qb[j] = __builtin_nontemporal_load(yb1 + 64 * j); }
        float ssa = 0.f, ssb = 0.f;
#pragma unroll
        for (int j = 0; j < 8; ++j) {
            va[j][0] += bflo(pa[j].x) + bflo(qa[j].x); va[j][1] += bfhi(pa[j].x) + bfhi(qa[j].x); va[j][2] += bflo(pa[j].y) + bflo(qa[j].y); va[j][3] += bfhi(pa[j].y) + bfhi(qa[j].y);
            vb[j][0] += bflo(pb[j].x) + bflo(qb[j].x); vb[j][1] += bfhi(pb[j].x) + bfhi(qb[j].x); vb[j][2] += bflo(pb[j].y) + bflo(qb[j].y); vb[j][3] += bfhi(pb[j].y) + bfhi(qb[j].y);
            ssa += (va[j][0] * va[j][0] + va[j][1] * va[j][1]) + (va[j][2] * va[j][2] + va[j][3] * va[j][3]);
            ssb += (vb[j][0] * vb[j][0] + vb[j][1] * vb[j][1]) + (vb[j][2] * vb[j][2] + vb[j][3] * vb[j][3]);
        }
        const float ra = dbg_scale / sqrtf(wave_sum(ssa, lane) * (1.0f / DMODEL) + EPS_F), rb = dbg_scale / sqrtf(wave_sum(ssb, lane) * (1.0f / DMODEL) + EPS_F);
#pragma unroll
        for (int j = 0; j < 8; ++j) { const f32x4 gg = ((const f32x4*)g_fin)[lane + 64 * j]; __builtin_nontemporal_store(va[j] * ra * gg, hra + 64 * j); if (t1 != t) __builtin_nontemporal_store(vb[j] * rb * gg, hrb + 64 * j); }
    }
    }
#if PROF_PHASE >= 0
    if (PROF_PHASE % 100 == 12) {
        XBAR(); STAMP(12); XBAR();
        PH_LOCALS
        const unsigned ta_ = __hip_atomic_load(ctl + 6000 + (PROF_PHASE / 100), __ATOMIC_RELAXED, __HIP_MEMORY_SCOPE_AGENT), tb_ = __hip_atomic_load(ctl + 6012, __ATOMIC_RELAXED, __HIP_MEMORY_SCOPE_AGENT);
        const float sc_ = 1.0f + sqrtf(PROF_SCALE * (float)(tb_ - ta_) * 0.01f);
        for (size_t i = (size_t)gtid; i < (size_t)T_TOK * DMODEL / 4; i += (size_t)NGT) { f32x4 v = ((f32x4*)out)[i]; ((f32x4*)out)[i] = v * sc_; }
    }
#endif
}

extern "C" void kernel_launch(void* const* d_in, const int* in_sizes, int n_in, void* d_out, int out_size, void* d_ws, size_t ws_size, hipStream_t stream) {
    static int grid_blocks = 0;
    if (grid_blocks == 0) {
        if (n_in != 17 || out_size != T_TOK * DMODEL || ws_size < WS_END) { fprintf(stderr, "kernel_launch: unexpected problem (n_in %d, out %d, ws %zu < %zu)\n", n_in, out_size, ws_size, (size_t)WS_END); grid_blocks = -1; return; }
        int dev = 0, cus = 0, per_cu = 0;
        (void)hipGetDevice(&dev);
        (void)hipDeviceGetAttribute(&cus, hipDeviceAttributeMultiprocessorCount, dev);
        if (hipFuncSetAttribute((const void*)mega_fwd, hipFuncAttributeMaxDynamicSharedMemorySize, LDS_BYTES) != hipSuccess) { fprintf(stderr, "kernel_launch: hipFuncSetAttribute failed\n"); grid_blocks = -1; return; }
        if (hipOccupancyMaxActiveBlocksPerMultiprocessor(&per_cu, (const void*)mega_fwd, 512, LDS_BYTES) != hipSuccess || per_cu < 1) { fprintf(stderr, "kernel_launch: occupancy query says %d\n", per_cu); grid_blocks = -1; return; }
        grid_blocks = cus;
        fprintf(stderr, "kernel_launch: cus %d per_cu %d grid %d ws %zu need %zu\n", cus, per_cu, grid_blocks, ws_size, (size_t)WS_END);
    }
    if (grid_blocks < 0) return;
    if (hipMemsetAsync((char*)d_ws + WS_CTL, 0, 65536, stream) != hipSuccess) { fprintf(stderr, "kernel_launch: memset of control words failed\n"); return; }
    Params prm{};
    for (int i = 0; i < 17; ++i) prm.in[i] = (const float*)d_in[i];
    prm.out = (float*)d_out; prm.ws = (unsigned char*)d_ws;
    void* args[] = {&prm};
    hipError_t e = hipLaunchCooperativeKernel((void*)mega_fwd, dim3(grid_blocks), dim3(512), args, LDS_BYTES, stream);
    if (e != hipSuccess) fprintf(stderr, "cooperative launch failed: %s (grid %d)\n", hipGetErrorString(e), grid_blocks);
}
```

```cpp
#include <hip/hip_runtime.h>
#include <hip/hip_cooperative_groups.h>
#include <cstdio>
#include <cstdint>
namespace cg = cooperative_groups;
namespace pg8 {
#define PG8_LAS __attribute__((address_space(3)))
typedef unsigned short bf16_t;
typedef short bf16x8 __attribute__((ext_vector_type(8)));
typedef float f32x4 __attribute__((ext_vector_type(4)));
typedef unsigned u32x4 __attribute__((ext_vector_type(4)));
constexpr int BM = 256, BK = 64, HALF = 128, HTB = HALF * BK * 2  , STAGE_BYTES = 8 * HTB, NXCD = 8, WGM = 8;

__host__ __device__ __forceinline__ int lds_byte(int r, int c) { const int st = (r >> 4) * 2 + (c >> 5), rr = r & 15, cc = c & 31, ob = rr * 64 + cc * 2; return st * 1024 + (ob ^ (((ob >> 9) & 1) << 5)); }
__host__ __device__ __forceinline__ void stage_rc(int b, int& R, int& C) { const int st = b / 1024, sb = b % 1024, swz = sb ^ (((sb >> 9) & 1) << 5); R = (st >> 1) * 16 + swz / 64; C = (st & 1) * 32 + (swz % 64) / 2; }
__host__ __device__ __forceinline__ int perm32(int rho) { const int n = rho >> 4, i = rho & 15; return 8 * (i >> 2) + 4 * n + (i & 3); }

struct Unit { int pm, pn, e; };
struct Gemm { const bf16_t* A; const bf16_t* Bt; int M, N, K; };

struct StaticOrder {
    int nM, nN, nwg, G, c;
    __host__ __device__ void init(int M, int N, int G_, int c_) { nM = M / BM; nN = N / BM; nwg = nM * nN; G = G_; c = c_; }
    __host__ __device__ bool next(int i, Unit& u) const {
        const long L = (long)i * G + c; if (L >= nwg) return false;
        int wgid = (int)L; { const int q = nwg / NXCD, r = nwg % NXCD, xcd = wgid % NXCD, off = wgid / NXCD; wgid = (xcd < r ? xcd * (q + 1) : r * (q + 1) + (xcd - r) * q) + off; }
        const int nig = WGM * nN, gid = wgid / nig, fm = gid * WGM, gsz = (nM - fm) < WGM ? (nM - fm) : WGM;
        u.pm = fm + ((wgid % nig) % gsz); u.pn = (wgid % nig) / gsz; u.e = 0; return true;
    }
    static constexpr bool GATHER = false;
    __device__ __forceinline__ unsigned rowoff(int) const { return 0u; }
    __device__ __forceinline__ void a_ready(const Unit&) const {}
    __device__ __forceinline__ void done(const Unit&) const {}
};

template <class Epi, class Sched, bool ALIGN_EPI = false, bool SP2 = false>
__device__ __forceinline__ void gemm_phase(PG8_LAS unsigned char* lds, const Gemm g, const Sched& S, const Epi& E, const int tid) {
    const int wid = __builtin_amdgcn_readfirstlane(tid >> 6), lane = tid & 63, wr = wid >> 2, wc = wid & 3, fr = lane & 15, fq = lane >> 4;
    const int K = g.K, nt = K / BK;
    constexpr bool GA = Sched::GATHER;
    static_assert(!GA || SP2, "the gather path is written for the SP2 loop");
    unsigned voffA[2], voffB[2]; int gR[2], gC[2];
#pragma unroll
    for (int i = 0; i < 2; ++i) { int R, C; stage_rc(tid * 16 + i * 8192, R, C); const int Rb = Epi::PERM ? ((R & ~31) + perm32(R & 31)) : R;
        voffA[i] = (unsigned)(R * K + C) * 2u; voffB[i] = (unsigned)(Rb * K + C) * 2u; gR[i] = R; gC[i] = C; }
    unsigned cvo0[2] = {0u, 0u}, cvo1[2] = {0u, 0u}, nvo0[2] = {0u, 0u}, nvo1[2] = {0u, 0u}, sel0[2] = {0u, 0u}, sel1[2] = {0u, 0u};
#define PG8_GOFF(u_, o0_, o1_) do { _Pragma("unroll") for (int _i = 0; _i < 2; ++_i) { \
        o0_[_i] = S.rowoff((u_).pm * BM + gR[_i]) * (unsigned)(K * 2) + (unsigned)gC[_i] * 2u; o1_[_i] = S.rowoff((u_).pm * BM + HALF + gR[_i]) * (unsigned)(K * 2) + (unsigned)gC[_i] * 2u; } } while (0)
#define PG8_STAGE_A(bufoff, base, h_, CUR_) do { if constexpr (GA) { if (CUR_) { if (h_) PG8_STAGE(bufoff, base, cvo1); else PG8_STAGE(bufoff, base, cvo0); } else { if (h_) PG8_STAGE(bufoff, base, sel1); else PG8_STAGE(bufoff, base, sel0); } } \
        else PG8_STAGE(bufoff, (base) + (h_) * hstep, voffA); } while (0)
    const size_t kstep = (size_t)(BK * 2);
    const size_t hstep = (size_t)HALF * K * 2;
    const size_t tstep = 2 * hstep;
    const unsigned ldsw = (unsigned)wid * 1024u;
    const int aoff = lds_byte(wr * 64 + fr, fq * 8), boff = lds_byte(wc * 32 + fr, fq * 8);
#define PG8_SA(b, h) (((b) * 2 + (h)) * HTB)
#define PG8_SB(b, h) ((4 + (b) * 2 + (h)) * HTB)
#define PG8_STAGE(bufoff, gbase, voff) do { _Pragma("unroll") for (int _i = 0; _i < 2; ++_i) \
        __builtin_amdgcn_global_load_lds((const unsigned*)((const char*)(gbase) + (voff)[_i]), (PG8_LAS unsigned*)(lds + (bufoff) + ldsw + _i * 8192), 16, 0, 0); } while (0)
#define PG8_LDA(dst, b, h) do { _Pragma("unroll") for (int m = 0; m < 4; ++m) _Pragma("unroll") for (int k = 0; k < 2; ++k) dst[m][k] = *(const PG8_LAS bf16x8*)(lds + PG8_SA(b, h) + aoff + m * 2048 + k * 1024); } while (0)
#define PG8_LDB(dst, b, h) do { _Pragma("unroll") for (int n = 0; n < 2; ++n) _Pragma("unroll") for (int k = 0; k < 2; ++k) dst[n][k] = *(const PG8_LAS bf16x8*)(lds + PG8_SB(b, h) + boff + n * 2048 + k * 1024); } while (0)
#define PG8_MMA(ai, bj, At, Bt) do { __builtin_amdgcn_s_setprio(1); _Pragma("unroll") for (int m = 0; m < 4; ++m) _Pragma("unroll") for (int n = 0; n < 2; ++n) _Pragma("unroll") for (int k = 0; k < 2; ++k) \
        acc[ai][bj][m][n] = __builtin_amdgcn_mfma_f32_16x16x32_bf16(Bt[n][k], At[m][k], acc[ai][bj][m][n], 0, 0, 0); __builtin_amdgcn_s_setprio(0); } while (0)
#define PG8_WAIT_V(n) asm volatile("s_waitcnt vmcnt(" #n ")" ::: "memory")
#define PG8_WAIT_L(n) asm volatile("s_waitcnt lgkmcnt(" #n ")" ::: "memory")
#define PG8_BAR __builtin_amdgcn_s_barrier()
#define PG8_SCHED __builtin_amdgcn_sched_barrier(0)
    Unit cur, nxt; int ui = 0;
    if (!S.next(0, cur)) return;
    f32x4 acc[2][2][4][2];
#pragma unroll
    for (int a = 0; a < 2; ++a)
#pragma unroll
        for (int b = 0; b < 2; ++b)
#pragma unroll
            for (int m = 0; m < 4; ++m)
#pragma unroll
                for (int n = 0; n < 2; ++n) acc[a][b][m][n] = (f32x4){0.f, 0.f, 0.f, 0.f};
    bf16x8 At[4][2], B0[2][2], B1[2][2];
    const size_t estep = (size_t)g.N * K * 2;
    const char* cA = (const char*)g.A + (GA ? (size_t)0 : (size_t)cur.pm * tstep); const char* cB = (const char*)g.Bt + (size_t)cur.e * estep + (size_t)cur.pn * tstep;
    S.a_ready(cur);
    if constexpr (GA) PG8_GOFF(cur, cvo0, cvo1);
    if constexpr (SP2) {
        PG8_STAGE(PG8_SB(0, 0), cB, voffB); PG8_STAGE(PG8_SB(0, 1), cB + hstep, voffB); PG8_STAGE_A(PG8_SA(0, 0), cA, 0, true); PG8_STAGE_A(PG8_SA(0, 1), cA, 1, true);
        if (wr == 1) PG8_BAR;
        PG8_WAIT_V(2); PG8_BAR;
        PG8_STAGE(PG8_SB(1, 0), cB + kstep, voffB); PG8_STAGE_A(PG8_SA(1, 0), cA + kstep, 0, true); PG8_STAGE(PG8_SB(1, 1), cB + hstep + kstep, voffB);
        PG8_WAIT_V(6); PG8_BAR;
    } else {
        PG8_STAGE(PG8_SB(0, 0), cB, voffB); PG8_STAGE(PG8_SA(0, 0), cA, voffA); PG8_STAGE(PG8_SB(0, 1), cB + hstep, voffB); PG8_STAGE(PG8_SA(0, 1), cA + hstep, voffA);
        if (wr == 1) PG8_BAR;
        PG8_WAIT_V(4); PG8_BAR;
        PG8_STAGE(PG8_SB(1, 0), cB + kstep, voffB); PG8_STAGE(PG8_SA(1, 0), cA + kstep, voffA); PG8_STAGE(PG8_SB(1, 1), cB + hstep + kstep, voffB);
        PG8_WAIT_V(6); PG8_BAR;
    }
    for (;;) {
        const bool has_next = S.next(ui + 1, nxt);
        const char* nA = has_next ? (const char*)g.A + (GA ? (size_t)0 : (size_t)nxt.pm * tstep) : cA;
        if constexpr (GA) { if (has_next) PG8_GOFF(nxt, nvo0, nvo1); else { nvo0[0] = cvo0[0]; nvo0[1] = cvo0[1]; nvo1[0] = cvo1[0]; nvo1[1] = cvo1[1]; } } const char* nB = has_next ? (const char*)g.Bt + (size_t)nxt.e * estep + (size_t)nxt.pn * tstep : cB;
        for (int t = 0; t < nt; t += 2) {
            const bool last = (t == nt - 2);
            const char* a1 = cA + (size_t)(t + 1) * kstep;
            const char* a2 = last ? nA : cA + (size_t)(t + 2) * kstep; const char* b2 = last ? nB : cB + (size_t)(t + 2) * kstep;
            const char* a3 = a2 + kstep; const char* b3 = b2 + kstep;
            if (last && has_next) S.a_ready(nxt);
            if constexpr (GA) { sel0[0] = last ? nvo0[0] : cvo0[0]; sel0[1] = last ? nvo0[1] : cvo0[1]; sel1[0] = last ? nvo1[0] : cvo1[0]; sel1[1] = last ? nvo1[1] : cvo1[1]; }
            if constexpr (Epi::HAS_MID) { if (t == nt / 2) E.mid(acc, cur, wr, wc, fr, fq); }
            if constexpr (SP2) {
            PG8_LDB(B0, 0, 0); PG8_LDB(B1, 0, 1); PG8_SCHED; PG8_LDA(At, 0, 0); PG8_STAGE_A(PG8_SA(1, 1), a1, 1, true);
            PG8_WAIT_V(8); PG8_WAIT_L(0); PG8_BAR; PG8_MMA(0, 0, At, B0); PG8_MMA(0, 1, At, B1); PG8_BAR; PG8_SCHED;
            PG8_LDA(At, 0, 1); PG8_STAGE(PG8_SB(0, 0), b2, voffB); PG8_STAGE(PG8_SB(0, 1), b2 + hstep, voffB); PG8_STAGE_A(PG8_SA(0, 0), a2, 0, false);
            PG8_WAIT_V(8); PG8_WAIT_L(0); PG8_BAR; PG8_MMA(1, 0, At, B0); PG8_MMA(1, 1, At, B1); PG8_BAR; PG8_SCHED;
            PG8_LDB(B0, 1, 0); PG8_LDB(B1, 1, 1); PG8_SCHED; PG8_LDA(At, 1, 0); PG8_STAGE_A(PG8_SA(0, 1), a2, 1, false);
            PG8_WAIT_V(8); PG8_WAIT_L(0); PG8_BAR; PG8_MMA(0, 0, At, B0); PG8_MMA(0, 1, At, B1); PG8_BAR; PG8_SCHED;
            PG8_LDA(At, 1, 1); PG8_STAGE(PG8_SB(1, 0), b3, voffB); PG8_STAGE(PG8_SB(1, 1), b3 + hstep, voffB); PG8_STAGE_A(PG8_SA(1, 0), a3, 0, false);
            PG8_WAIT_V(8); PG8_WAIT_L(0); PG8_BAR; PG8_MMA(1, 0, At, B0); PG8_MMA(1, 1, At, B1); PG8_BAR; PG8_SCHED;
            } else {
            PG8_LDB(B0, 0, 0); PG8_SCHED; PG8_LDA(At, 0, 0); PG8_STAGE(PG8_SA(1, 1), a1 + hstep, voffA);
            PG8_WAIT_L(8); PG8_BAR; PG8_WAIT_L(0); PG8_MMA(0, 0, At, B0); PG8_BAR; PG8_SCHED;
            PG8_LDB(B1, 0, 1); PG8_STAGE(PG8_SB(0, 0), b2, voffB);
            PG8_BAR; PG8_WAIT_L(0); PG8_MMA(0, 1, At, B1); PG8_BAR;
            PG8_LDA(At, 0, 1); PG8_STAGE(PG8_SA(0, 0), a2, voffA);
            PG8_BAR; PG8_WAIT_L(0); PG8_MMA(1, 0, At, B0); PG8_BAR; PG8_SCHED;
            PG8_STAGE(PG8_SB(0, 1), b2 + hstep, voffB);
            PG8_WAIT_V(6); PG8_BAR; PG8_MMA(1, 1, At, B1); PG8_BAR;
            PG8_LDB(B0, 1, 0); PG8_SCHED; PG8_LDA(At, 1, 0); PG8_STAGE(PG8_SA(0, 1), a2 + hstep, voffA);
            PG8_WAIT_L(8); PG8_BAR; PG8_WAIT_L(0); PG8_MMA(0, 0, At, B0); PG8_BAR; PG8_SCHED;
            PG8_LDB(B1, 1, 1); PG8_STAGE(PG8_SB(1, 0), b3, voffB);
            PG8_BAR; PG8_WAIT_L(0); PG8_MMA(0, 1, At, B1); PG8_BAR;
            PG8_LDA(At, 1, 1); PG8_STAGE(PG8_SA(1, 0), a3, voffA);
            PG8_BAR; PG8_WAIT_L(0); PG8_MMA(1, 0, At, B0); PG8_BAR; PG8_SCHED;
            PG8_STAGE(PG8_SB(1, 1), b3 + hstep, voffB);
            PG8_WAIT_V(6); PG8_BAR; PG8_MMA(1, 1, At, B1); PG8_BAR;
            }
        }
        if constexpr (ALIGN_EPI) { if (wr == 0) PG8_BAR; }
        if constexpr (!Epi::AFTER_DRAIN) { E(acc, cur, wr, wc, fr, fq); S.done(cur); }
        if (!has_next) break;
#pragma unroll
        for (int a = 0; a < 2; ++a)
#pragma unroll
            for (int b = 0; b < 2; ++b)
#pragma unroll
                for (int m = 0; m < 4; ++m)
#pragma unroll
                    for (int n = 0; n < 2; ++n) acc[a][b][m][n] = (f32x4){0.f, 0.f, 0.f, 0.f};
        cur = nxt; cA = nA; cB = nB; ++ui;
        if constexpr (GA) { cvo0[0] = nvo0[0]; cvo0[1] = nvo0[1]; cvo1[0] = nvo1[0]; cvo1[1] = nvo1[1]; }
        if constexpr (ALIGN_EPI) { if (wr == 1) PG8_BAR; }
    }
    PG8_WAIT_V(0);
    if constexpr (!ALIGN_EPI) { if (wr == 0) PG8_BAR; }
    PG8_BAR;
    if constexpr (Epi::AFTER_DRAIN) { E.fused(acc, cur, wr, wc, fr, fq, lds, wid, lane); S.done(cur); }
#undef PG8_SA
#undef PG8_SB
#undef PG8_STAGE
#undef PG8_STAGE_A
#undef PG8_GOFF
#undef PG8_LDA
#undef PG8_LDB
#undef PG8_MMA
#undef PG8_WAIT_V
#undef PG8_WAIT_L
#undef PG8_BAR
#undef PG8_SCHED
}
}

#ifndef DBG_CMP
#define DBG_CMP 0
#endif
#define LAS __attribute__((address_space(3)))
typedef unsigned short bf16_t;
typedef float f32x4 __attribute__((ext_vector_type(4)));
typedef unsigned u32x4 __attribute__((ext_vector_type(4)));
typedef unsigned u32x2 __attribute__((ext_vector_type(2)));
typedef unsigned long long u64;

constexpr int T_TOK = 16384, DMODEL = 2048, SEQL = 2048;
constexpr int NPROJ = 9984;
constexpr int C_QLAT = 0, C_CKV = 1024, C_QIDX = 1152, C_KIDX = 1664, C_WIDX = 1728, C_QR = 1792, C_KR = 2816, C_VR = 3840, C_GR = 4864, C_GBR = 5888;
constexpr int MAXSLOT = 40960;
constexpr float EPS_F = 1e-6f;
constexpr float IDX_SCALE = 0.04419417382415922f;
constexpr float ATT_SCALE = 0.08838834764831845f;
constexpr float K_SCALE = 0.08838834764831845f;

constexpr size_t WS_CTL = 0;
constexpr size_t WS_ROT = 65536;
constexpr size_t WS_WIN = WS_ROT + 1048576;
constexpr size_t WS_WCOMB = WS_WIN + (size_t)NPROJ * 2048 * 2;
constexpr size_t WS_WB = WS_WCOMB + (size_t)2048 * 1024 * 2;
constexpr size_t WS_WO = WS_WB + (size_t)2048 * 1024 * 2;
constexpr size_t WS_WGU = WS_WO + (size_t)2048 * 2048 * 2;
constexpr size_t WS_WD = WS_WGU + (size_t)32 * 2048 * 2048 * 2;
constexpr size_t WS_P = WS_WD + (size_t)32 * 2048 * 1024 * 2;
constexpr size_t WS_HMID = WS_P;
constexpr size_t WS_Y = WS_HMID + (size_t)MAXSLOT * 1024 * 2;
constexpr size_t WS_XN = WS_P + (size_t)T_TOK * NPROJ * 2;
constexpr size_t WS_OA = WS_XN + (size_t)T_TOK * 2048 * 2;
constexpr size_t WS_OB = WS_OA + (size_t)T_TOK * 1024 * 2;
constexpr size_t WS_MIXED = WS_OB + (size_t)T_TOK * 1024 * 2;
constexpr size_t WS_SPARE = WS_MIXED + (size_t)T_TOK * 2048 * 2;
constexpr size_t WS_XG = WS_OA;
constexpr size_t WS_KV = WS_SPARE + (size_t)T_TOK * 1024 * 2;
constexpr size_t WS_MASK = WS_KV + (size_t)T_TOK * 128 * 2;
constexpr size_t WS_MISC = WS_MASK + (size_t)T_TOK * 256;
constexpr size_t WS_WC = WS_MISC + 1048576;
constexpr size_t WS_END = WS_WC + 1048576;
static_assert(WS_Y + (size_t)MAXSLOT * 2048 * 2 <= WS_XN, "HMID + Y must fit in P");
static_assert(WS_XG + (size_t)MAXSLOT * 2048 * 2 <= WS_KV, "XG must fit in OA..SPARE");
static_assert(WS_END <= (size_t)1073741824, "workspace budget");
constexpr int MI_ROWTOK = 0, MI_ROWGATE = MAXSLOT, MI_TOKSLOT = 2 * MAXSLOT, MI_ASGE = MI_TOKSLOT + 2 * T_TOK, MI_ASGR = MI_ASGE + 2 * T_TOK, MI_ASGG = MI_ASGR + 2 * T_TOK;
static_assert((size_t)(MI_ASGG + 2 * T_TOK) * 4 <= 1048576, "misc budget");
constexpr int LDS_BYTES = 152 * 1024;
constexpr int LDS_MISC = 150 * 1024;

__device__ __forceinline__ float bflo(unsigned w) { return __uint_as_float(w << 16); }
__device__ __forceinline__ float bfhi(unsigned w) { return __uint_as_float(w & 0xffff0000u); }
__device__ __forceinline__ unsigned pkbf(float lo, float hi) { unsigned r; asm volatile("v_cvt_pk_bf16_f32 %0, %1, %2" : "=v"(r) : "v"(lo), "v"(hi)); return r; }
__device__ __forceinline__ int hide_i(int v) { asm volatile("" : "+v"(v)); return v; }
template <class Tp> __device__ __forceinline__ Tp* hide_p(Tp* q) { long long z = 0; asm volatile("" : "+s"(z)); return (Tp*)((char*)q + z); }
__device__ __forceinline__ float shx(float v, int lane, int o) { return __int_as_float(__builtin_amdgcn_ds_bpermute((lane ^ o) << 2, __float_as_int(v))); }
__device__ __forceinline__ float wave_sum(float v, int lane) {
#pragma unroll
    for (int o = 1; o < 64; o <<= 1) v += shx(v, lane, o);
    return v;
}
__device__ __forceinline__ float wave_max(float v, int lane) {
#pragma unroll
    for (int o = 1; o < 64; o <<= 1) v = fmaxf(v, shx(v, lane, o));
    return v;
}
__device__ __forceinline__ float sigmoidf_(float x) { return __builtin_amdgcn_rcpf(1.0f + __expf(-x)); }
__device__ __forceinline__ float siluf_(float x) { return x * sigmoidf_(x); }
__device__ __forceinline__ float unkey(unsigned k) { return __uint_as_float((k & 0x80000000u) ? (k & 0x7fffffffu) : ~k); }
__device__ __forceinline__ int sbin(float s) { const int b = (int)(s * 32.0f + 128.0f); return b < 0 ? 0 : (b > 255 ? 255 : b); }
__device__ __forceinline__ unsigned fkey(float f) { const unsigned u = __float_as_uint(f + 0.0f); return (u & 0x80000000u) ? ~u : (u | 0x80000000u); }


#define XB_TMO      128
#define XB_XCNT(j)  (256  + 64 * (j))
#define XB_XSUB(j)  (1280 + 64 * (j))
#define XB_XGEN(j)  (2304 + 64 * (j))
#define XB_TOP      3328
#define XB_TOPGEN   3392
#define XCD_BAR_WORDS 3456
#define XB_SPIN_CAP (1u << 18)
__device__ __forceinline__ unsigned xb_ld(unsigned* p)              { return __hip_atomic_load(p, __ATOMIC_RELAXED, __HIP_MEMORY_SCOPE_AGENT); }
__device__ __forceinline__ unsigned xb_add(unsigned* p, unsigned v) { return __hip_atomic_fetch_add(p, v, __ATOMIC_RELAXED, __HIP_MEMORY_SCOPE_AGENT); }
__device__ __forceinline__ unsigned xb_xcc_id() { return (unsigned)__builtin_amdgcn_s_getreg((3 << 11) | 20) & 0xFu; }
#define XB_SPIN(cond, bar) do { unsigned _sp = 0; while (cond) { __builtin_amdgcn_s_sleep(1); \
    if ((++_sp & 255u) == 0u) { if (xb_ld(&(bar)[XB_TMO])) break; if (_sp > XB_SPIN_CAP) { atomicAdd(&(bar)[XB_TMO], 1u); break; } } } } while (0)
struct XcdBarrier { unsigned* bar; unsigned x; volatile __attribute__((address_space(3))) unsigned* st; };
__device__ __forceinline__ void xcd_barrier_complete(unsigned* bar, unsigned x, unsigned& nloc, unsigned& nx) {
    const unsigned G = gridDim.x * gridDim.y * gridDim.z;
    unsigned sum, cnt, mine, sp = 0u;
    for (;;) {
        sum = 0u; cnt = 0u; mine = 0u;
#pragma unroll
        for (unsigned j = 0; j < 16; ++j) { const unsigned c = xb_ld(&bar[XB_XCNT(j)]); sum += c; cnt += (c > 0u) ? 1u : 0u; mine = (j == x) ? c : mine; }
        if (sum == G) break;
        __builtin_amdgcn_s_sleep(1);
        if ((++sp & 255u) == 0u) { if (xb_ld(&bar[XB_TMO])) break; if (sp > XB_SPIN_CAP) { atomicAdd(&bar[XB_TMO], 1u); break; } }
    }
    nloc = mine > 0u ? mine : 1u; nx = cnt > 0u ? cnt : 1u;
}
__device__ __forceinline__ void xcd_barrier(const XcdBarrier& b, int tid) {
    asm volatile("s_waitcnt vmcnt(0)" ::: "memory");
    __syncthreads();
    if (tid == 0) {
        unsigned* bar = b.bar;
        __builtin_amdgcn_s_waitcnt(0);
        unsigned nloc = b.st[0], nx = b.st[1];
        if (nloc == 0u) { xcd_barrier_complete(bar, b.x, nloc, nx); b.st[0] = nloc; b.st[1] = nx; }
        const unsigned old = xb_add(&bar[XB_XSUB(b.x)], 1u);
        const unsigned gen = old / nloc;
        if (old + 1u == (gen + 1u) * nloc) {
            __builtin_amdgcn_fence(__ATOMIC_RELEASE, "agent");
            asm volatile("s_waitcnt vmcnt(0)" ::: "memory");
            const unsigned og = xb_add(&bar[XB_TOP], 1u);
            const unsigned tg = og / nx;
            if (og + 1u == (tg + 1u) * nx) xb_add(&bar[XB_TOPGEN], 1u);
            else XB_SPIN(xb_ld(&bar[XB_TOPGEN]) == tg, bar);
            __builtin_amdgcn_fence(__ATOMIC_ACQUIRE, "agent");
            xb_add(&bar[XB_XGEN(b.x)], 1u);
            asm volatile("s_waitcnt vmcnt(0)" ::: "memory");
        } else {
            XB_SPIN(xb_ld(&bar[XB_XGEN(b.x)]) == gen, bar);
            __builtin_amdgcn_fence(__ATOMIC_ACQUIRE, "agent");
            asm volatile("s_waitcnt vmcnt(0)" ::: "memory");
        }
    }
    __syncthreads();
}

namespace fa {
using bf16x8 = __attribute__((ext_vector_type(8))) short;
using s16x4  = __attribute__((ext_vector_type(4))) short;
using f32x16 = __attribute__((ext_vector_type(16))) float;
constexpr int TILE_B = 64 * 128 * 2;
constexpr int OFF_V = 0, OFF_K = 2 * TILE_B, OFF_M = 4 * TILE_B, OFF_WS = OFF_M + 2 * 256, OFF_Q = OFF_WS + 8 * 256, LDS_NEED = OFF_Q + 8 * 8704;
#define FA_GAS __attribute__((address_space(1)))
#define FA_KSWZ(row, colB) ((row) * 256 + ((colB) ^ (((row) & 7) << 4)))
#define FA_SBAR() __builtin_amdgcn_sched_barrier(0)
__device__ __forceinline__ int crow(int r, int hi) { return (r & 3) + 8 * (r >> 2) + 4 * hi; }
__device__ __forceinline__ int v_st(int k, int c) { const int kk = (k & ~0xC) | ((k & 4) << 1) | ((k & 8) >> 1); return ((kk >> 3) * 4 + (c >> 5)) * 512 + ((kk & 7) * 32 + (c & 31)) * 2; }
__device__ __forceinline__ int v_rd_base(int lane) { return ((lane & 3) << 3) | (((lane >> 2) & 3) << 6) | (((lane >> 4) & 1) << 5) | (((lane >> 5) & 1) << 8); }
constexpr int v_rd_off(int d0, int ks, int half) { return d0 * 512 + ks * 4096 + half * 2048; }
template <int OFF> __device__ __forceinline__ s16x4 tr_read(int vb) { s16x4 r; asm volatile("ds_read_b64_tr_b16 %0, %1 offset:%2" : "=&v"(r) : "v"(vb), "i"(OFF) : "memory"); return r; }
template <int D0> __device__ __forceinline__ void pv_one(f32x16& od, int vb, bf16x8 pa0, bf16x8 pa1, bf16x8 pa2, bf16x8 pa3) {
    const s16x4 l0 = tr_read<v_rd_off(D0, 0, 0)>(vb), h0 = tr_read<v_rd_off(D0, 0, 1)>(vb), l1 = tr_read<v_rd_off(D0, 1, 0)>(vb), h1 = tr_read<v_rd_off(D0, 1, 1)>(vb);
    const s16x4 l2 = tr_read<v_rd_off(D0, 2, 0)>(vb), h2 = tr_read<v_rd_off(D0, 2, 1)>(vb), l3 = tr_read<v_rd_off(D0, 3, 0)>(vb), h3 = tr_read<v_rd_off(D0, 3, 1)>(vb);
    asm volatile("s_waitcnt lgkmcnt(0)" ::: "memory"); FA_SBAR();
#define FA_PK(L, H) (bf16x8){L[0], L[1], L[2], L[3], H[0], H[1], H[2], H[3]}
    od = __builtin_amdgcn_mfma_f32_32x32x16_bf16(pa0, FA_PK(l0, h0), od, 0, 0, 0);
    od = __builtin_amdgcn_mfma_f32_32x32x16_bf16(pa1, FA_PK(l1, h1), od, 0, 0, 0);
    od = __builtin_amdgcn_mfma_f32_32x32x16_bf16(pa2, FA_PK(l2, h2), od, 0, 0, 0);
    od = __builtin_amdgcn_mfma_f32_32x32x16_bf16(pa3, FA_PK(l3, h3), od, 0, 0, 0);
#undef FA_PK
}
#define FA_RD8(D0, l0, h0, l1, h1, l2, h2, l3, h3) do { l0 = tr_read<v_rd_off(D0, 0, 0)>(vb); h0 = tr_read<v_rd_off(D0, 0, 1)>(vb); l1 = tr_read<v_rd_off(D0, 1, 0)>(vb); h1 = tr_read<v_rd_off(D0, 1, 1)>(vb); \
        l2 = tr_read<v_rd_off(D0, 2, 0)>(vb); h2 = tr_read<v_rd_off(D0, 2, 1)>(vb); l3 = tr_read<v_rd_off(D0, 3, 0)>(vb); h3 = tr_read<v_rd_off(D0, 3, 1)>(vb); } while (0)
#define FA_PK(L, H) (bf16x8){L[0], L[1], L[2], L[3], H[0], H[1], H[2], H[3]}
#define FA_MM4(od, l0, h0, l1, h1, l2, h2, l3, h3) do { od = __builtin_amdgcn_mfma_f32_32x32x16_bf16(pa0, FA_PK(l0, h0), od, 0, 0, 0); od = __builtin_amdgcn_mfma_f32_32x32x16_bf16(pa1, FA_PK(l1, h1), od, 0, 0, 0); \
        od = __builtin_amdgcn_mfma_f32_32x32x16_bf16(pa2, FA_PK(l2, h2), od, 0, 0, 0); od = __builtin_amdgcn_mfma_f32_32x32x16_bf16(pa3, FA_PK(l3, h3), od, 0, 0, 0); } while (0)
__device__ __forceinline__ void pv_all(f32x16 (&o)[4], int vb, bf16x8 pa0, bf16x8 pa1, bf16x8 pa2, bf16x8 pa3) {
    s16x4 a0, a1, a2, a3, a4, a5, a6, a7, b0, b1, b2, b3, b4, b5, b6, b7;
    FA_RD8(0, a0, a1, a2, a3, a4, a5, a6, a7);
    FA_RD8(1, b0, b1, b2, b3, b4, b5, b6, b7);
    asm volatile("s_waitcnt lgkmcnt(8)" ::: "memory"); FA_SBAR();
    FA_MM4(o[0], a0, a1, a2, a3, a4, a5, a6, a7); FA_SBAR();
    FA_RD8(2, a0, a1, a2, a3, a4, a5, a6, a7);
    asm volatile("s_waitcnt lgkmcnt(8)" ::: "memory"); FA_SBAR();
    FA_MM4(o[1], b0, b1, b2, b3, b4, b5, b6, b7); FA_SBAR();
    FA_RD8(3, b0, b1, b2, b3, b4, b5, b6, b7);
    asm volatile("s_waitcnt lgkmcnt(8)" ::: "memory"); FA_SBAR();
    FA_MM4(o[2], a0, a1, a2, a3, a4, a5, a6, a7); FA_SBAR();
    asm volatile("s_waitcnt lgkmcnt(0)" ::: "memory"); FA_SBAR();
    FA_MM4(o[3], b0, b1, b2, b3, b4, b5, b6, b7);
}
#undef FA_RD8
#undef FA_MM4
#undef FA_PK
template <bool QLDS>
__device__ __forceinline__ void qkt(f32x16& p0, f32x16& p1, const LAS char* Ks, const bf16x8 (&qr)[8], const LAS char* Ql, int r32, int hi) {
    p0 = f32x16{}; p1 = f32x16{};
#pragma unroll
    for (int d0 = 0; d0 < 8; ++d0) { const int cb = (d0 * 16 + hi * 8) * 2;
        const bf16x8 b0 = *(const LAS bf16x8*)(Ks + FA_KSWZ(r32, cb));
        const bf16x8 b1 = *(const LAS bf16x8*)(Ks + FA_KSWZ(32 + r32, cb));
        const bf16x8 q = QLDS ? *(const LAS bf16x8*)(Ql + d0 * 1024) : qr[d0];
        p0 = __builtin_amdgcn_mfma_f32_32x32x16_bf16(b0, q, p0, 0, 0, 0);
        p1 = __builtin_amdgcn_mfma_f32_32x32x16_bf16(b1, q, p1, 0, 0, 0); }
}
__device__ __forceinline__ void p_to_frag(const f32x16& p0, const f32x16& p1, bf16x8& pa0, bf16x8& pa1, bf16x8& pa2, bf16x8& pa3) {
#define FA_PK4(P, BASE, OUT) do { unsigned a0 = pkbf(P[BASE + 0], P[BASE + 1]), a1 = pkbf(P[BASE + 2], P[BASE + 3]);   \
    unsigned b0 = pkbf(P[BASE + 4], P[BASE + 5]), b1 = pkbf(P[BASE + 6], P[BASE + 7]);                              \
    auto r0 = __builtin_amdgcn_permlane32_swap(a0, b0, false, false); auto r1 = __builtin_amdgcn_permlane32_swap(a1, b1, false, false); \
    u32x4 w = {r0[0], r1[0], r0[1], r1[1]}; OUT = *reinterpret_cast<bf16x8*>(&w); } while (0)
    FA_PK4(p0, 0, pa0); FA_PK4(p0, 8, pa1); FA_PK4(p1, 0, pa2); FA_PK4(p1, 8, pa3);
#undef FA_PK4
}

struct UnitArgs {
    const bf16_t* Q; int ldq;
    const bf16_t* K; const bf16_t* V; int ldk;
    const u64* mask;
    int ntiles;
    int n0;
    float lgam;
};

template <int MODE, int EXP = 0>
__device__ __forceinline__ void unit_body(LAS char* L, const UnitArgs& U, int tid, f32x16 (&o)[4], float& l_out) {
    const int wid = __builtin_amdgcn_readfirstlane(tid >> 6), lane = tid & 63, r32 = lane & 31, hi = lane >> 5;
    LAS char* V_lds = L + OFF_V; LAS char* K_lds = L + OFF_K; LAS u64* M_lds = (LAS u64*)(L + OFF_M);
    LAS float* wsf = (LAS float*)(L + OFF_WS) + wid * 64; LAS float* al_l = wsf + 32;
    constexpr float C = ATT_SCALE * 1.4426950408889634f;
    float m_reg = -1e30f, l_reg = 0.f;
    bf16x8 qr[8];
    LAS char* Ql = L + OFF_Q + wid * 8192 + lane * 16;
    { const FA_GAS bf16_t* Qh = (const FA_GAS bf16_t*)hide_p(U.Q); const FA_GAS bf16_t* Qw = (MODE == 0) ? Qh + (size_t)r32 * U.ldq + wid * 128 + hi * 8 : Qh + (size_t)(wid * 32 + r32) * U.ldq + hi * 8;
#pragma unroll
      for (int d0 = 0; d0 < 8; ++d0) { qr[d0] = *(const FA_GAS bf16x8*)(Qw + d0 * 16); if (MODE == 1) *(LAS bf16x8*)(Ql + d0 * 1024) = qr[d0]; } }
    if (MODE == 1) { asm volatile("s_waitcnt vmcnt(0) lgkmcnt(0)" ::: "memory"); FA_SBAR(); }
    const int sr = tid >> 4, sc = (tid & 15) * 8, vst0 = v_st(sr, sc), vst1 = v_st(32 + sr, sc), kst0 = FA_KSWZ(sr, sc * 2), kst1 = FA_KSWZ(32 + sr, sc * 2);
    const FA_GAS char* Kh = (const FA_GAS char*)hide_p(U.K); const FA_GAS char* Vh = (const FA_GAS char*)hide_p(U.V);
    const int ldk_ = (EXP & 4) ? 128 : U.ldk;
    const unsigned goff0 = (unsigned)(sr * ldk_ + sc) * 2u, goff1 = (unsigned)((32 + sr) * ldk_ + sc) * 2u;
    const int vb0 = (int)(unsigned)(size_t)V_lds + v_rd_base(lane);
    bf16x8 ksA0, ksA1, vsA0, vsA1; u64 mwA = 0ull; unsigned pf_ = 0u;
#define FA_SLOAD(S, k0) do { const FA_GAS char* kb_ = Kh + (size_t)(k0) * ldk_ * 2; const FA_GAS char* vb_ = Vh + (size_t)(k0) * ldk_ * 2;     \
        ks##S##0 = *(const FA_GAS bf16x8*)(kb_ + goff0); ks##S##1 = *(const FA_GAS bf16x8*)(kb_ + goff1); \
        if (MODE == 1) { if (EXP & 2) { vs##S##0 = ks##S##0; vs##S##1 = ks##S##1; } else { vs##S##0 = *(const FA_GAS bf16x8*)(vb_ + goff0); vs##S##1 = *(const FA_GAS bf16x8*)(vb_ + goff1); } } \
        if (MODE == 0 && tid < 32) mw##S = U.mask[(size_t)tid * 32 + ((k0) >> 6)]; } while (0)
#define FA_SWRITE(S, b) do { *(LAS bf16x8*)(K_lds + (b) * TILE_B + kst0) = ks##S##0; *(LAS bf16x8*)(K_lds + (b) * TILE_B + kst1) = ks##S##1; \
        *(LAS bf16x8*)(V_lds + (b) * TILE_B + vst0) = (MODE == 1) ? vs##S##0 : ks##S##0; *(LAS bf16x8*)(V_lds + (b) * TILE_B + vst1) = (MODE == 1) ? vs##S##1 : ks##S##1; \
        if (MODE == 0 && tid < 32) M_lds[(b) * 32 + tid] = mw##S; } while (0)
#define FA_TOUCH(k0) do { if (MODE == 1 && !(EXP & 16) && tid < 256) { const FA_GAS char* tb_ = ((tid < 128) ? Kh : Vh) + (size_t)((k0) + ((tid & 127) >> 1)) * ldk_ * 2 + (tid & 1) * 128; \
        asm volatile("global_load_dword %0, %1, off" : "=v"(pf_) : "v"(tb_) : "memory"); } } while (0)
#define FA_TILE(j, b) do { \
        f32x16 p0, p1; bf16x8 pa0, pa1, pa2, pa3; \
        { const LAS char* qb_ = Ql; asm volatile("" : "+v"(qb_)); qkt<MODE == 1>(p0, p1, K_lds + (b) * TILE_B, qr, qb_, r32, hi); } \
        if (MODE == 0) { \
            const u64 mw = M_lds[(b) * 32 + r32] >> (4 * hi); \
            const unsigned mlo = (unsigned)mw, mhi = (unsigned)(mw >> 32); \
            _Pragma("unroll") for (int r = 0; r < 16; ++r) { const unsigned bit = 1u << ((r & 3) + 8 * (r >> 2)); p0[r] = (mlo & bit) ? p0[r] : -INFINITY; p1[r] = (mhi & bit) ? p1[r] : -INFINITY; } \
            float pmax = p0[0]; \
            _Pragma("unroll") for (int r = 1; r < 16; ++r) pmax = fmaxf(pmax, p0[r]); \
            _Pragma("unroll") for (int r = 0; r < 16; ++r) pmax = fmaxf(pmax, p1[r]); \
            { auto rr = __builtin_amdgcn_permlane32_swap(__float_as_uint(pmax), __float_as_uint(pmax), false, false); pmax = fmaxf(__uint_as_float(rr[0]), __uint_as_float(rr[1])); } \
            const float mn = fmaxf(m_reg, pmax); const float alpha = __builtin_amdgcn_exp2f((m_reg - mn) * C); m_reg = mn; \
            const float mnC = -mn * C; float ps = 0.f; \
            _Pragma("unroll") for (int r = 0; r < 16; ++r) { p0[r] = __builtin_amdgcn_exp2f(fmaf(p0[r], C, mnC)); p1[r] = __builtin_amdgcn_exp2f(fmaf(p1[r], C, mnC)); ps += p0[r] + p1[r]; } \
            { auto rr = __builtin_amdgcn_permlane32_swap(__float_as_uint(ps), __float_as_uint(ps), false, false); ps = __uint_as_float(rr[0]) + __uint_as_float(rr[1]); } \
            l_reg = l_reg * alpha + ps; \
            if (__any(alpha < 1.f)) { \
                if (hi == 0) al_l[r32] = alpha; \
                asm volatile("s_waitcnt lgkmcnt(0)" ::: "memory"); \
                _Pragma("unroll") for (int r = 0; r < 16; ++r) { const float a_ = al_l[crow(r, hi)]; \
                    _Pragma("unroll") for (int d = 0; d < 4; ++d) o[d][r] *= a_; } \
            } \
        } else if (!(EXP & 1)) { \
            const int dn = U.n0 + wid * 32 + r32 - (j) * 64 - 4 * hi; \
            const float base = (float)dn * U.lgam; \
            _Pragma("unroll") for (int r = 0; r < 16; ++r) { const int kk = (r & 3) + 8 * (r >> 2); \
                const float f0 = __builtin_amdgcn_exp2f(base - (float)kk * U.lgam), f1 = __builtin_amdgcn_exp2f(base - (float)(kk + 32) * U.lgam); \
                p0[r] = (dn >= kk) ? p0[r] * f0 : 0.f; p1[r] = (dn >= kk + 32) ? p1[r] * f1 : 0.f; } \
        } \
        p_to_frag(p0, p1, pa0, pa1, pa2, pa3); \
        FA_SBAR(); \
        { const int vb = vb0 + (b) * TILE_B; \
          pv_all(o, vb, pa0, pa1, pa2, pa3); } \
    } while (0)
    const int NT = U.ntiles;
    FA_SLOAD(A, 0); FA_SWRITE(A, 0);
    if (NT > 1) { FA_SLOAD(A, 64); FA_SWRITE(A, 1); }
    if (NT > 2) FA_TOUCH(128);
    if (NT > 3) FA_TOUCH(192);
    __syncthreads();
#pragma unroll
    for (int d = 0; d < 4; ++d) o[d] = f32x16{};
#pragma unroll 1
    for (int j = 0; j < NT; ++j) {
        const int b = j & 1;
        if (j + 2 < NT) FA_SLOAD(A, (j + 2) * 64);
        if (j + 4 < NT) FA_TOUCH((j + 4) * 64);
        FA_TILE(j, b);
        __syncthreads();
        if (j + 2 < NT) FA_SWRITE(A, b);
        asm volatile("" :: "v"(pf_));
    }
    asm volatile("s_waitcnt vmcnt(0)" ::: "memory");
    __syncthreads();
    l_out = l_reg;
#undef FA_SLOAD
#undef FA_SWRITE
#undef FA_TILE
}

template <int MODE>
__device__ __forceinline__ void unit_body2(LAS char* L, const UnitArgs& U, int tid, f32x16 (&o)[4], float& l_out) {
    const int wid = __builtin_amdgcn_readfirstlane(tid >> 6), lane = tid & 63, r32 = lane & 31, hi = lane >> 5;
    LAS char* V_lds = L + OFF_V; LAS char* K_lds = L + OFF_K; LAS u64* M_lds = (LAS u64*)(L + OFF_M);
    LAS float* wsf = (LAS float*)(L + OFF_WS) + wid * 64; LAS float* al_l = wsf + 32;
    constexpr float C = ATT_SCALE * 1.4426950408889634f;
    constexpr float THR = 8.0f;
    float m_reg = -1e30f, l_reg = 0.f;
    bf16x8 qr[8];
    LAS char* Ql = L + OFF_Q + wid * 8192 + lane * 16;
    { const FA_GAS bf16_t* Qh = (const FA_GAS bf16_t*)hide_p(U.Q); const FA_GAS bf16_t* Qw = (MODE == 0) ? Qh + (size_t)r32 * U.ldq + wid * 128 + hi * 8 : Qh + (size_t)(wid * 32 + r32) * U.ldq + hi * 8;
#pragma unroll
      for (int d0 = 0; d0 < 8; ++d0) { qr[d0] = *(const FA_GAS bf16x8*)(Qw + d0 * 16); if (MODE == 1) *(LAS bf16x8*)(Ql + d0 * 1024) = qr[d0]; } }
    if (MODE == 1) { asm volatile("s_waitcnt vmcnt(0) lgkmcnt(0)" ::: "memory"); FA_SBAR(); }
    const int sr = tid >> 4, sc = (tid & 15) * 8;
    const FA_GAS char* Kh = (const FA_GAS char*)hide_p(U.K); const FA_GAS char* Vh = (const FA_GAS char*)hide_p(U.V);
    const unsigned goff0 = (unsigned)(sr * U.ldk + sc) * 2u, goff1 = (unsigned)((32 + sr) * U.ldk + sc) * 2u;
    const int vb0 = (int)(unsigned)(size_t)V_lds + v_rd_base(lane);
    bf16x8 ksE0, ksE1, vsE0, vsE1; u64 mwE = 0ull; unsigned pf_ = 0u;
#define F2_TOUCH(k0) do { if (MODE == 1 && tid < 256) { const FA_GAS char* tb_ = ((tid < 128) ? Kh : Vh) + (size_t)((k0) + ((tid & 127) >> 1)) * U.ldk * 2 + (tid & 1) * 128; \
        asm volatile("global_load_dword %0, %1, off" : "=v"(pf_) : "v"(tb_) : "memory"); } } while (0)
#define F2_SLOAD(S, k0) do { const FA_GAS char* kb_ = Kh + (size_t)(k0) * U.ldk * 2; const FA_GAS char* vb_ = Vh + (size_t)(k0) * U.ldk * 2; \
        ks##S##0 = *(const FA_GAS bf16x8*)(kb_ + goff0); ks##S##1 = *(const FA_GAS bf16x8*)(kb_ + goff1); \
        if (MODE == 1) { vs##S##0 = *(const FA_GAS bf16x8*)(vb_ + goff0); vs##S##1 = *(const FA_GAS bf16x8*)(vb_ + goff1); } \
        if (MODE == 0 && tid < 32) mw##S = U.mask[(size_t)tid * 32 + ((k0) >> 6)]; } while (0)
#define F2_SWRITE(S, b) do { const int t_ = hide_i(tid), sr_ = t_ >> 4, sc_ = (t_ & 15) * 8; const int vst0 = v_st(sr_, sc_), vst1 = v_st(32 + sr_, sc_), kst0 = FA_KSWZ(sr_, sc_ * 2), kst1 = FA_KSWZ(32 + sr_, sc_ * 2);     \
        *(LAS bf16x8*)(K_lds + (b) * TILE_B + kst0) = ks##S##0; *(LAS bf16x8*)(K_lds + (b) * TILE_B + kst1) = ks##S##1; \
        *(LAS bf16x8*)(V_lds + (b) * TILE_B + vst0) = (MODE == 1) ? vs##S##0 : ks##S##0; *(LAS bf16x8*)(V_lds + (b) * TILE_B + vst1) = (MODE == 1) ? vs##S##1 : ks##S##1; \
        if (MODE == 0 && tid < 32) M_lds[(b) * 32 + tid] = mw##S; } while (0)
#define F2_PARTIAL(P0, P1, j, b, MN, AL) do { \
        if (MODE == 0) { \
            const u64 mw = M_lds[(b) * 32 + r32] >> (4 * hi); const unsigned mlo = (unsigned)mw, mhi = (unsigned)(mw >> 32); \
            _Pragma("unroll") for (int r = 0; r < 16; ++r) { const unsigned bit = 1u << ((r & 3) + 8 * (r >> 2)); P0[r] = (mlo & bit) ? P0[r] : -INFINITY; P1[r] = (mhi & bit) ? P1[r] : -INFINITY; } \
            float pmax = P0[0]; \
            _Pragma("unroll") for (int r = 1; r < 16; ++r) pmax = fmaxf(pmax, P0[r]); \
            _Pragma("unroll") for (int r = 0; r < 16; ++r) pmax = fmaxf(pmax, P1[r]); \
            { auto rr = __builtin_amdgcn_permlane32_swap(__float_as_uint(pmax), __float_as_uint(pmax), false, false); pmax = fmaxf(__uint_as_float(rr[0]), __uint_as_float(rr[1])); } \
            if (__builtin_expect(__all(pmax - m_reg <= THR / ATT_SCALE), 1)) { MN = m_reg; AL = 1.f; } \
            else { MN = fmaxf(m_reg, pmax); AL = __builtin_amdgcn_exp2f((m_reg - MN) * C); m_reg = MN; } \
            const float mnC = -MN * C; \
            _Pragma("unroll") for (int r = 0; r < 16; ++r) { P0[r] = fmaf(P0[r], C, mnC); P1[r] = fmaf(P1[r], C, mnC); } \
            _Pragma("unroll") for (int r = 0; r < 16; ++r) P0[r] = __builtin_amdgcn_exp2f(P0[r]); \
        } else { \
            const int dn = U.n0 + wid * 32 + r32 - (j) * 64 - 4 * hi; const float base = (float)dn * U.lgam; \
            _Pragma("unroll") for (int r = 0; r < 16; ++r) { const int kk = (r & 3) + 8 * (r >> 2); \
                const float f0 = __builtin_amdgcn_exp2f(base - (float)kk * U.lgam); P0[r] = (dn >= kk) ? P0[r] * f0 : 0.f; } \
        } } while (0)
#define F2_FINISH(P0, P1, j, AL) do { \
        if (MODE == 0) { \
            _Pragma("unroll") for (int r = 0; r < 16; ++r) P1[r] = __builtin_amdgcn_exp2f(P1[r]); \
            float ps = 0.f; \
            _Pragma("unroll") for (int r = 0; r < 16; ++r) ps += P0[r] + P1[r]; \
            { auto rr = __builtin_amdgcn_permlane32_swap(__float_as_uint(ps), __float_as_uint(ps), false, false); ps = __uint_as_float(rr[0]) + __uint_as_float(rr[1]); } \
            l_reg = l_reg * AL + ps; \
        } else { \
            const int dn = U.n0 + wid * 32 + r32 - (j) * 64 - 4 * hi; const float base = (float)dn * U.lgam; \
            _Pragma("unroll") for (int r = 0; r < 16; ++r) { const int kk = (r & 3) + 8 * (r >> 2); \
                const float f1 = __builtin_amdgcn_exp2f(base - (float)(kk + 32) * U.lgam); P1[r] = (dn >= kk + 32) ? P1[r] * f1 : 0.f; } \
        } \
        p_to_frag(P0, P1, pa0, pa1, pa2, pa3); } while (0)
#define F2_RESC(AL) do { if (MODE == 0) { if (__any((AL) < 1.f)) { if (hi == 0) al_l[r32] = (AL); asm volatile("s_waitcnt lgkmcnt(0)" ::: "memory"); \
        _Pragma("unroll") for (int r = 0; r < 16; ++r) { const float a_ = al_l[crow(r, hi)]; _Pragma("unroll") for (int d = 0; d < 4; ++d) o[d][r] *= a_; } } } } while (0)
#define F2_QKT(P0, P1, b) do { const LAS char* qb_ = Ql; asm volatile("" : "+v"(qb_)); qkt<MODE == 1>(P0, P1, K_lds + (b) * TILE_B, qr, qb_, r32, hi); } while (0)
#define PV1(vb_) do { const int v_ = (vb_); pv_one<0>(o[0], v_, pa0, pa1, pa2, pa3); pv_one<1>(o[1], v_, pa0, pa1, pa2, pa3); pv_one<2>(o[2], v_, pa0, pa1, pa2, pa3); pv_one<3>(o[3], v_, pa0, pa1, pa2, pa3); } while (0)
    f32x16 pA0, pA1, pB0, pB1; float mnA = 0.f, mnB = 0.f, alA = 1.f, alB = 1.f; bf16x8 pa0, pa1, pa2, pa3; const int NT = U.ntiles;
    (void)mnA; (void)mnB;
    F2_SLOAD(E, 0); F2_SWRITE(E, 0); __syncthreads();
#pragma unroll
    for (int d = 0; d < 4; ++d) o[d] = f32x16{};
    F2_QKT(pA0, pA1, 0); F2_PARTIAL(pA0, pA1, 0, 0, mnA, alA);
    F2_SLOAD(E, 64); if (2 < NT) F2_TOUCH(128); if (3 < NT) F2_TOUCH(192);
    F2_SWRITE(E, 1); __syncthreads();
#pragma unroll 1
    for (int j = 1; j + 1 < NT; j += 2) {
        FA_SBAR(); F2_QKT(pB0, pB1, 1);
        F2_FINISH(pA0, pA1, j - 1, alA); FA_SBAR();
        F2_SLOAD(E, (j + 1) * 64); if (j + 3 < NT) F2_TOUCH((j + 3) * 64); FA_SBAR();
        PV1(vb0); F2_PARTIAL(pB0, pB1, j, 1, mnB, alB);
        __syncthreads(); F2_SWRITE(E, 0); asm volatile("" :: "v"(pf_));
        F2_RESC(alB); __syncthreads();
        FA_SBAR(); F2_QKT(pA0, pA1, 0);
        F2_FINISH(pB0, pB1, j, alB); FA_SBAR();
        if (j + 2 < NT) F2_SLOAD(E, (j + 2) * 64); if (j + 4 < NT) F2_TOUCH((j + 4) * 64); FA_SBAR();
        PV1(vb0 + TILE_B); F2_PARTIAL(pA0, pA1, j + 1, 0, mnA, alA);
        __syncthreads(); if (j + 2 < NT) F2_SWRITE(E, 1); asm volatile("" :: "v"(pf_));
        F2_RESC(alA); __syncthreads();
    }
    FA_SBAR(); F2_QKT(pB0, pB1, 1);
    F2_FINISH(pA0, pA1, NT - 2, alA); FA_SBAR();
    PV1(vb0); F2_PARTIAL(pB0, pB1, NT - 1, 1, mnB, alB);
    __syncthreads(); F2_RESC(alB);
    F2_FINISH(pB0, pB1, NT - 1, alB); FA_SBAR();
    PV1(vb0 + TILE_B);
    asm volatile("s_waitcnt vmcnt(0)" ::: "memory");
    __syncthreads();
    l_out = l_reg;
#undef F2_SLOAD
#undef F2_SWRITE
#undef F2_PARTIAL
#undef F2_FINISH
#undef F2_RESC
#undef F2_QKT
#undef F2_TOUCH
#undef PV1
}
}

namespace pg8 {
struct EpiProj {
    static constexpr bool PERM = true, AFTER_DRAIN = false, HAS_MID = false;
    bf16_t* P; const float* rot;
    __device__ __forceinline__ void operator()(const f32x4 (&acc)[2][2][4][2], const Unit& u, int wr, int wc, int fr, int fq) const {
        const int row0 = u.pm * BM + wr * 64 + fr, colb = u.pn * BM + wc * 32 + 8 * fq;
        const bool rotq = (u.pn >= 7) && (u.pn < 15);
        const float ksc = (u.pn >= 11) ? K_SCALE : 1.0f;
        const int i0 = 16 * wc + 4 * fq;
#pragma unroll
        for (int ai = 0; ai < 2; ++ai)
#pragma unroll
            for (int m = 0; m < 4; ++m) {
                const int row = row0 + ai * HALF + m * 16; const int pos = row & (SEQL - 1);
                bf16_t* rowp = P + (size_t)row * NPROJ + colb;
                f32x4 r0 = (f32x4){1.f, 0.f, 1.f, 0.f}, r1 = r0;
                if (rotq) { const f32x4* rt = (const f32x4*)(rot + ((size_t)pos * 64 + i0) * 2); r0 = rt[0]; r1 = rt[1]; }
#pragma unroll
                for (int bj = 0; bj < 2; ++bj) {
                    f32x4 v0 = acc[ai][bj][m][0], v1 = acc[ai][bj][m][1];
                    if (rotq) {
                        f32x4 w0, w1;
                        w0[0] = (v0[0] * r0[0] - v0[1] * r0[1]) * ksc; w0[1] = (v0[0] * r0[1] + v0[1] * r0[0]) * ksc;
                        w0[2] = (v0[2] * r0[2] - v0[3] * r0[3]) * ksc; w0[3] = (v0[2] * r0[3] + v0[3] * r0[2]) * ksc;
                        w1[0] = (v1[0] * r1[0] - v1[1] * r1[1]) * ksc; w1[1] = (v1[0] * r1[1] + v1[1] * r1[0]) * ksc;
                        w1[2] = (v1[2] * r1[2] - v1[3] * r1[3]) * ksc; w1[3] = (v1[2] * r1[3] + v1[3] * r1[2]) * ksc;
                        v0 = w0; v1 = w1;
                    }
                    u32x4 w; w.x = pkbf(v0[0], v0[1]); w.y = pkbf(v0[2], v0[3]); w.z = pkbf(v1[0], v1[1]); w.w = pkbf(v1[2], v1[3]);
                    __builtin_nontemporal_store(w, (u32x4*)(rowp + bj * HALF));
                }
            }
    }
};
struct EpiMergeF {
    static constexpr bool PERM = true, AFTER_DRAIN = false, HAS_MID = true;
    const bf16_t* P; bf16_t* O;
    static __device__ __forceinline__ float cl(float x) { return fminf(fmaxf(x, -30.f), 30.f); }
    static __device__ __forceinline__ float ratio(float a, float b) { return (1.0f + __expf(-cl(b))) * __builtin_amdgcn_rcpf(1.0f + __expf(-cl(a))); }
    __device__ __forceinline__ void mid(f32x4 (&acc)[2][2][4][2], const Unit& u, int wr, int wc, int fr, int fq) const {
        const int row0 = hide_i(u.pm * BM + wr * 64 + fr), colb = hide_i(u.pn * BM + wc * 32 + 8 * fq);
        __builtin_amdgcn_sched_barrier(0);
#pragma unroll
        for (int ai = 0; ai < 2; ++ai) {
            u32x4 g0[4][2], g1[4][2];
#pragma unroll
            for (int m = 0; m < 4; ++m)
#pragma unroll
                for (int bj = 0; bj < 2; ++bj) { const bf16_t* gp = P + (size_t)(row0 + ai * HALF + m * 16) * NPROJ + C_GBR + colb + bj * HALF; g0[m][bj] = __builtin_nontemporal_load((const u32x4*)gp); g1[m][bj] = *(const u32x4*)(gp + DMODEL); }
            __builtin_amdgcn_sched_barrier(0);
#pragma unroll
            for (int m = 0; m < 4; ++m)
#pragma unroll
                for (int bj = 0; bj < 2; ++bj) {
                    const u32x4 a_ = g0[m][bj], b_ = g1[m][bj]; f32x4 r0, r1;
                    r0[0] = ratio(bflo(a_.x), bflo(b_.x)); r0[1] = ratio(bfhi(a_.x), bfhi(b_.x)); r0[2] = ratio(bflo(a_.y), bflo(b_.y)); r0[3] = ratio(bfhi(a_.y), bfhi(b_.y));
                    r1[0] = ratio(bflo(a_.z), bflo(b_.z)); r1[1] = ratio(bfhi(a_.z), bfhi(b_.z)); r1[2] = ratio(bflo(a_.w), bflo(b_.w)); r1[3] = ratio(bfhi(a_.w), bfhi(b_.w));
                    acc[ai][bj][m][0] = acc[ai][bj][m][0] * r0; acc[ai][bj][m][1] = acc[ai][bj][m][1] * r1;
                }
            __builtin_amdgcn_sched_barrier(0);
        }
    }
    __device__ __forceinline__ void operator()(const f32x4 (&acc)[2][2][4][2], const Unit& u, int wr, int wc, int fr, int fq) const {
        const int row0 = u.pm * BM + wr * 64 + fr, colb = u.pn * BM + wc * 32 + 8 * fq;
#pragma unroll
        for (int ai = 0; ai < 2; ++ai) {
            u32x4 gg[4][2];
#pragma unroll
            for (int m = 0; m < 4; ++m)
#pragma unroll
                for (int bj = 0; bj < 2; ++bj) gg[m][bj] = __builtin_nontemporal_load((const u32x4*)(P + (size_t)(row0 + ai * HALF + m * 16) * NPROJ + C_GBR + DMODEL + colb + bj * HALF));
            __builtin_amdgcn_sched_barrier(0);
#pragma unroll
            for (int m = 0; m < 4; ++m) {
                const int row = row0 + ai * HALF + m * 16;
#pragma unroll
                for (int bj = 0; bj < 2; ++bj) {
                    const int col = colb + bj * HALF;
                    const u32x4 g = gg[m][bj];
                    const f32x4 v0 = acc[ai][bj][m][0], v1 = acc[ai][bj][m][1];
                    float o[8];
                    o[0] = sigmoidf_(cl(bflo(g.x))) * v0[0]; o[1] = sigmoidf_(cl(bfhi(g.x))) * v0[1]; o[2] = sigmoidf_(cl(bflo(g.y))) * v0[2]; o[3] = sigmoidf_(cl(bfhi(g.y))) * v0[3];
                    o[4] = sigmoidf_(cl(bflo(g.z))) * v1[0]; o[5] = sigmoidf_(cl(bfhi(g.z))) * v1[1]; o[6] = sigmoidf_(cl(bflo(g.w))) * v1[2]; o[7] = sigmoidf_(cl(bfhi(g.w))) * v1[3];
                    u32x4 w; w.x = pkbf(o[0], o[1]); w.y = pkbf(o[2], o[3]); w.z = pkbf(o[4], o[5]); w.w = pkbf(o[6], o[7]);
                    *(u32x4*)(O + (size_t)row * DMODEL + col) = w;
                }
            }
        }
    }
};
struct EpiRes {
    static constexpr bool PERM = false, AFTER_DRAIN = false, HAS_MID = false;
    const float* X; float* O;
    __device__ __forceinline__ void operator()(const f32x4 (&acc)[2][2][4][2], const Unit& u, int wr, int wc, int fr, int fq) const {
        const int row0 = u.pm * BM + wr * 64 + fr, col0 = u.pn * BM + wc * 32 + 4 * fq;
#pragma unroll
        for (int ai = 0; ai < 2; ++ai) {
            f32x4 xv[4][2][2];
#pragma unroll
            for (int m = 0; m < 4; ++m) { const size_t off = (size_t)(row0 + ai * HALF + m * 16) * DMODEL + col0;
#pragma unroll
                for (int bj = 0; bj < 2; ++bj)
#pragma unroll
                    for (int n = 0; n < 2; ++n) xv[m][bj][n] = __builtin_nontemporal_load((const f32x4*)(X + off + bj * HALF + n * 16)); }
            __builtin_amdgcn_sched_barrier(0);
#pragma unroll
            for (int m = 0; m < 4; ++m) { const size_t off = (size_t)(row0 + ai * HALF + m * 16) * DMODEL + col0;
#pragma unroll
                for (int bj = 0; bj < 2; ++bj)
#pragma unroll
                    for (int n = 0; n < 2; ++n) *(f32x4*)(O + off + bj * HALF + n * 16) = xv[m][bj][n] + acc[ai][bj][m][n]; }
            __builtin_amdgcn_sched_barrier(0);
        }
    }
};
struct EpiNull {
    static constexpr bool PERM = true, AFTER_DRAIN = false, HAS_MID = false;
    float* O;
    __device__ __forceinline__ void operator()(const f32x4 (&acc)[2][2][4][2], const Unit& u, int wr, int wc, int fr, int fq) const {
        f32x4 t = (f32x4){0.f, 0.f, 0.f, 0.f};
#pragma unroll
        for (int ai = 0; ai < 2; ++ai)
#pragma unroll
            for (int bj = 0; bj < 2; ++bj)
#pragma unroll
                for (int m = 0; m < 4; ++m) { t += acc[ai][bj][m][0]; t += acc[ai][bj][m][1]; }
        O[(size_t)(u.pm * 8 + u.pn) * 512 + (wr * 4 + wc) * 64 + fr + 16 * fq] = (t[0] + t[1]) + (t[2] + t[3]);
    }
};
struct EpiD {
    static constexpr bool PERM = true, AFTER_DRAIN = false, HAS_MID = false;
    bf16_t* D;
    __device__ __forceinline__ void operator()(const f32x4 (&acc)[2][2][4][2], const Unit& u, int wr, int wc, int fr, int fq) const {
        const int row0 = u.pm * BM + wr * 64 + fr, colb = u.pn * BM + wc * 32 + 8 * fq;
#pragma unroll
        for (int ai = 0; ai < 2; ++ai)
#pragma unroll
            for (int m = 0; m < 4; ++m) {
                bf16_t* rowp = D + (size_t)(row0 + ai * HALF + m * 16) * DMODEL + colb;
#pragma unroll
                for (int bj = 0; bj < 2; ++bj) {
                    const f32x4 v0 = acc[ai][bj][m][0], v1 = acc[ai][bj][m][1];
                    u32x4 w; w.x = pkbf(v0[0], v0[1]); w.y = pkbf(v0[2], v0[3]); w.z = pkbf(v1[0], v1[1]); w.w = pkbf(v1[2], v1[3]);
                    *(u32x4*)(rowp + bj * HALF) = w;
                }
            }
    }
};
struct EpiSwiglu {
    static constexpr bool PERM = true, AFTER_DRAIN = false, HAS_MID = false;
    bf16_t* H; const float* rs;
    __device__ __forceinline__ void operator()(const f32x4 (&acc)[2][2][4][2], const Unit& u, int wr, int wc, int fr, int fq) const {
        const int row0 = u.pm * BM + wr * 64 + fr, col = u.pn * HALF + wc * 32 + 8 * fq;
#pragma unroll
        for (int ai = 0; ai < 2; ++ai)
#pragma unroll
            for (int m = 0; m < 4; ++m) {
                const int row = row0 + ai * HALF + m * 16; const float r_ = rs[row];
                const f32x4 g0 = acc[ai][0][m][0] * r_, g1 = acc[ai][0][m][1] * r_, u0 = acc[ai][1][m][0] * r_, u1 = acc[ai][1][m][1] * r_;
                u32x4 w; w.x = pkbf(siluf_(g0[0]) * u0[0], siluf_(g0[1]) * u0[1]); w.y = pkbf(siluf_(g0[2]) * u0[2], siluf_(g0[3]) * u0[3]);
                w.z = pkbf(siluf_(g1[0]) * u1[0], siluf_(g1[1]) * u1[1]); w.w = pkbf(siluf_(g1[2]) * u1[2], siluf_(g1[3]) * u1[3]);
                *(u32x4*)(H + (size_t)row * 1024 + col) = w;
            }
    }
};
struct EpiDown {
    static constexpr bool PERM = true, AFTER_DRAIN = false, HAS_MID = false;
    bf16_t* Y; const float* rg;
    __device__ __forceinline__ void operator()(const f32x4 (&acc)[2][2][4][2], const Unit& u, int wr, int wc, int fr, int fq) const {
        const int row0 = u.pm * BM + wr * 64 + fr, colb = u.pn * BM + wc * 32 + 8 * fq;
#pragma unroll
        for (int ai = 0; ai < 2; ++ai)
#pragma unroll
            for (int m = 0; m < 4; ++m) {
                const int row = row0 + ai * HALF + m * 16; const float gt = rg[row];
#pragma unroll
                for (int bj = 0; bj < 2; ++bj) {
                    const f32x4 v0 = acc[ai][bj][m][0] * gt, v1 = acc[ai][bj][m][1] * gt;
                    u32x4 w; w.x = pkbf(v0[0], v0[1]); w.y = pkbf(v0[2], v0[3]); w.z = pkbf(v1[0], v1[1]); w.w = pkbf(v1[2], v1[3]);
                    *(u32x4*)(Y + (size_t)row * DMODEL + colb + bj * HALF) = w;
                }
            }
    }
};
template <bool GATHER_> struct ExpertOrderT {
    static constexpr bool GATHER = GATHER_;
    const LAS int* ts; int G, c; const int* rtok;
    __device__ __forceinline__ unsigned rowoff(int slot) const { return GATHER_ ? (unsigned)rtok[slot] : 0u; }
    __device__ __forceinline__ bool next(int i, Unit& u) const {
        const int L = i * G + c; const int total = ts[32] * 8; if (L >= total) return false;
        const int gt = L >> 3; u.pm = gt; u.pn = L & 7; int e = 0;
        for (int k = 1; k < 32; ++k) e += (gt >= ts[k]) ? 1 : 0;
        u.e = e; return true;
    }
    __device__ __forceinline__ void a_ready(const Unit&) const {}
    __device__ __forceinline__ void done(const Unit&) const {}
};
}

struct MapId { __device__ __forceinline__ int operator()(int n) const { return n; } };
struct MapGate { __device__ __forceinline__ int operator()(int f) const { return ((f >> 7) << 8) + (f & 127); } };
struct MapUp { __device__ __forceinline__ int operator()(int f) const { return ((f >> 7) << 8) + 128 + (f & 127); } };
struct MapProj {
    __device__ __forceinline__ int operator()(int n) const {
        if (n < 1736) return n;
        if (n < 2760) { const int l = n - 1736, d = l & 127; return C_QR + (l & ~127) + ((d & 63) << 1) + (d >> 6); }
        if (n < 3784) { const int l = n - 2760, d = l & 127; return C_KR + (l & ~127) + ((d & 63) << 1) + (d >> 6); }
        if (n < 4808) return C_VR + (n - 3784);
        if (n < 5832) return C_GR + (n - 4808);
        return C_GBR + (n - 5832);
    }
};
template <class RowMap>
__device__ __forceinline__ void tr_item(const float* __restrict__ src, int N, bf16_t* __restrict__ dst, int ldd, int kb, int nb, int lane, RowMap rm) {
    const int kc = lane >> 3, nc = lane & 7;
    const int n = nb * 32 + nc * 4, k0 = kb * 64 + kc * 8;
    if (n < N) {
        f32x4 v[8];
#pragma unroll
        for (int i = 0; i < 8; ++i) v[i] = __builtin_nontemporal_load((const f32x4*)(src + (size_t)(k0 + i) * N + n));
#pragma unroll
        for (int j = 0; j < 4; ++j) {
            u32x4 o; o.x = pkbf(v[0][j], v[1][j]); o.y = pkbf(v[2][j], v[3][j]); o.z = pkbf(v[4][j], v[5][j]); o.w = pkbf(v[6][j], v[7][j]);
            *(u32x4*)(dst + (size_t)rm(n + j) * ldd + k0) = o;
        }
    }
}
template <class RowMap>
__device__ __forceinline__ void tr_item2(const float* __restrict__ src, int N, bf16_t* __restrict__ dst, int ldd, int kb, int nb, int lane, RowMap rm) {
    const int kc = lane >> 3, nc = lane & 7;
    const int n = nb * 32 + nc * 4, k0 = kb * 64 + kc * 8;
    f32x4 va[8], vb[8];
#pragma unroll
    for (int i = 0; i < 8; ++i) { va[i] = *(const f32x4*)(src + (size_t)(k0 + i) * N + n); vb[i] = *(const f32x4*)(src + (size_t)(k0 + i) * N + n + 32); }
#pragma unroll
    for (int j = 0; j < 4; ++j) {
        u32x4 o; o.x = pkbf(va[0][j], va[1][j]); o.y = pkbf(va[2][j], va[3][j]); o.z = pkbf(va[4][j], va[5][j]); o.w = pkbf(va[6][j], va[7][j]);
        *(u32x4*)(dst + (size_t)rm(n + j) * ldd + k0) = o;
    }
#pragma unroll
    for (int j = 0; j < 4; ++j) {
        u32x4 o; o.x = pkbf(vb[0][j], vb[1][j]); o.y = pkbf(vb[2][j], vb[3][j]); o.z = pkbf(vb[4][j], vb[5][j]); o.w = pkbf(vb[6][j], vb[7][j]);
        *(u32x4*)(dst + (size_t)rm(n + 32 + j) * ldd + k0) = o;
    }
}
template <class RowMap>
__device__ __forceinline__ void tr_item4(const float* __restrict__ src, int N, bf16_t* __restrict__ dst, int ldd, int kb, int nb, int lane, RowMap rm) {
    const int kc = lane >> 3, nc = lane & 7;
    const int n = nb * 32 + nc * 4, k0 = kb * 64 + kc * 8;
    f32x4 v[4][8];
#pragma unroll
    for (int i = 0; i < 8; ++i)
#pragma unroll
        for (int u = 0; u < 4; ++u) v[u][i] = __builtin_nontemporal_load((const f32x4*)(src + (size_t)(k0 + i) * N + n + 32 * u));
#pragma unroll
    for (int u = 0; u < 4; ++u)
#pragma unroll
        for (int j = 0; j < 4; ++j) {
            u32x4 o; o.x = pkbf(v[u][0][j], v[u][1][j]); o.y = pkbf(v[u][2][j], v[u][3][j]); o.z = pkbf(v[u][4][j], v[u][5][j]); o.w = pkbf(v[u][6][j], v[u][7][j]);
            __builtin_nontemporal_store(o, (u32x4*)(dst + (size_t)rm(n + 32 * u + j) * ldd + k0));
        }
}
constexpr int EXP_ITEMS = 3 * 32 * 1024;
__device__ __forceinline__ void convert_experts(const float* w_eg, const float* w_eu, const float* w_ed, bf16_t* WGU, bf16_t* WD, unsigned* qctr, int lane) {
    int nxt = 0; if (lane == 0) nxt = (int)atomicAdd(qctr, 8u);
    for (;;) {
        const int it = __builtin_amdgcn_readfirstlane(nxt);
        if (it >= EXP_ITEMS) break;
        if (lane == 0) nxt = (int)atomicAdd(qctr, 8u);
        const int kind = it >> 15, r = it & 32767, e = r >> 10, q = r & 1023;
        if (kind == 0) { const float* src = w_eg + (size_t)e * 2048 * 1024; bf16_t* dst = WGU + (size_t)e * 2048 * 2048;
#pragma unroll 1
            for (int u = 0; u < 8; u += 4) tr_item4(src, 1024, dst, 2048, q >> 5, (q & 31) + u, lane, MapGate{}); }
        else if (kind == 1) { const float* src = w_eu + (size_t)e * 2048 * 1024; bf16_t* dst = WGU + (size_t)e * 2048 * 2048;
#pragma unroll 1
            for (int u = 0; u < 8; u += 4) tr_item4(src, 1024, dst, 2048, q >> 5, (q & 31) + u, lane, MapUp{}); }
        else { const float* src = w_ed + (size_t)e * 1024 * 2048; bf16_t* dst = WD + (size_t)e * 2048 * 1024;
#pragma unroll 1
            for (int u = 0; u < 8; u += 4) tr_item4(src, 2048, dst, 1024, q >> 6, (q & 63) + u, lane, MapId{}); }
    }
}
__device__ __forceinline__ void sincos_d(double a, double& s, double& c) {
    const double TWO_PI = 6.283185307179586476925, HALF_PI = 1.5707963267948966192313;
    double k = rint(a / HALF_PI); double r = a - k * HALF_PI;
    r -= k * 6.123233995736766e-17;
    const int q = ((int)k) & 3; const double r2 = r * r;
    double sp = r2 * (-1.0 / 1307674368000.0);
    sp = r2 * (sp + 1.0 / 6227020800.0); sp = r2 * (sp - 1.0 / 39916800.0); sp = r2 * (sp + 1.0 / 362880.0); sp = r2 * (sp - 1.0 / 5040.0); sp = r2 * (sp + 1.0 / 120.0); sp = r2 * (sp - 1.0 / 6.0);
    const double sr = r + r * sp;
    double cp = r2 * (1.0 / 20922789888000.0);
    cp = r2 * (cp - 1.0 / 87178291200.0); cp = r2 * (cp + 1.0 / 479001600.0); cp = r2 * (cp - 1.0 / 3628800.0); cp = r2 * (cp + 1.0 / 40320.0); cp = r2 * (cp - 1.0 / 720.0); cp = r2 * (cp + 1.0 / 24.0); cp = r2 * (cp - 0.5);
    const double cr = 1.0 + cp;
    s = (q == 0) ? sr : (q == 1) ? cr : (q == 2) ? -sr : -cr;
    c = (q == 0) ? cr : (q == 1) ? -sr : (q == 2) ? -cr : sr;
    (void)TWO_PI;
}

struct Params { const float* in[17]; float* out; unsigned char* ws; };

#ifndef PROF_PHASE
#define PROF_PHASE -1
#endif
#ifndef PROF_SCALE
#define PROF_SCALE 4e-6f
#endif
#define STAMP(i) do { if (PROF_PHASE >= 0 && bx == 0 && wave_id == 0) ((unsigned*)(p.ws + WS_CTL))[6000 + (i)] = (unsigned)__builtin_amdgcn_s_memrealtime(); } while (0)
#define GSYNC() grid.sync()
#define XBAR() do { const int l__ = (int)__builtin_amdgcn_mbcnt_hi(~0u, __builtin_amdgcn_mbcnt_lo(~0u, (unsigned)hide_i(0))); xcd_barrier(xbar, wave_id * 64 + l__); } while (0)
constexpr int CTL_BAR_WORD = 8192;
constexpr int CTL_QCTR = 2048;
#ifndef NGEMM_P1
#define NGEMM_P1 208
#endif

__global__ void __launch_bounds__(512, 2) mega_fwd(Params p) {
    extern __shared__ __attribute__((aligned(16))) unsigned char lds_raw[];
    LAS unsigned char* lds = (LAS unsigned char*)lds_raw;
    cg::grid_group grid = cg::this_grid();
    const int G = gridDim.x, bx = blockIdx.x;
    const int wave_id = __builtin_amdgcn_readfirstlane((int)threadIdx.x >> 6);
    const int NGW = G * 8, NGT = G * 512;
    XcdBarrier xbar;
    {
        const int l0 = (int)__builtin_amdgcn_mbcnt_hi(~0u, __builtin_amdgcn_mbcnt_lo(~0u, (unsigned)hide_i(0)));
        volatile LAS unsigned* st = (volatile LAS unsigned*)(lds + LDS_MISC + 256);
        if (wave_id == 0 && l0 < 2) st[l0] = 0u;
        __syncthreads();
        xbar.bar = (unsigned*)(p.ws + WS_CTL) + CTL_BAR_WORD; xbar.x = xb_xcc_id(); xbar.st = st;
        if (wave_id == 0 && l0 == 0) (void)xb_add(&xbar.bar[XB_XCNT(xbar.x)], 1u);
    }
#define PH_LOCALS \
    const int lane = (int)__builtin_amdgcn_mbcnt_hi(~0u, __builtin_amdgcn_mbcnt_lo(~0u, (unsigned)hide_i(0))), wave = wave_id, tid = wave * 64 + lane; (void)tid; \
    const int gw = bx * 8 + wave, gtid = bx * 512 + tid; (void)gw; (void)gtid; (void)lane; \
    unsigned char* ws = hide_p(p.ws); float* out = hide_p(p.out); (void)out; \
    unsigned* ctl = (unsigned*)(ws + WS_CTL); float* rot = (float*)(ws + WS_ROT); (void)ctl; (void)rot; \
    bf16_t* WIN = (bf16_t*)(ws + WS_WIN); bf16_t* WCOMB = (bf16_t*)(ws + WS_WCOMB); bf16_t* WB = (bf16_t*)(ws + WS_WB); bf16_t* WO = (bf16_t*)(ws + WS_WO); (void)WIN; (void)WCOMB; (void)WB; (void)WO; \
    bf16_t* WGU = (bf16_t*)(ws + WS_WGU); bf16_t* WD = (bf16_t*)(ws + WS_WD); (void)WGU; (void)WD; \
    bf16_t* P = (bf16_t*)(ws + WS_P); bf16_t* HMID = (bf16_t*)(ws + WS_HMID); bf16_t* Y = (bf16_t*)(ws + WS_Y); (void)P; (void)HMID; (void)Y; \
    bf16_t* XN = (bf16_t*)(ws + WS_XN); bf16_t* BA = XN; bf16_t* TN = XN; (void)BA; (void)TN; \
    bf16_t* OA = (bf16_t*)(ws + WS_OA); bf16_t* OB = OA + 1024;            bf16_t* MIXED = (bf16_t*)(ws + WS_MIXED); bf16_t* XG = (bf16_t*)(ws + WS_XG); (void)OA; (void)OB; (void)MIXED; (void)XG; \
    bf16_t* KV = (bf16_t*)(ws + WS_KV); u64* MASK = (u64*)(ws + WS_MASK); (void)KV; (void)MASK; \
    int* misc = (int*)(ws + WS_MISC); \
    int* row_tok = misc + MI_ROWTOK; float* row_gate = (float*)(misc + MI_ROWGATE); int* tok_slot = misc + MI_TOKSLOT; (void)row_tok; (void)row_gate; (void)tok_slot; \
    int* asg_e = misc + MI_ASGE; int* asg_r = misc + MI_ASGR; float* asg_g = (float*)(misc + MI_ASGG); (void)asg_e; (void)asg_r; (void)asg_g;
#define IN(k) hide_p(p.in[k])

    STAMP(0);
    {
        PH_LOCALS
        const float* x = IN(0); const float* g_mix = IN(1); const float* w_in = IN(2); const float* w_uv = IN(4); const float* w_branch = IN(6); const float* w_out = IN(7);
        constexpr int NB_WIN = 311;
        constexpr int I_WIN = 32 * NB_WIN, I_WB = 16 * 64, I_WO = 32 * 64;
        constexpr int I_TOTAL = I_WIN + I_WB + I_WO;
#pragma unroll 1
        for (int pass = 0; pass < 4; ++pass) {
        const int job = (pass + wave) & 3;
        if (job == 0) {
        for (int it = gw; it < I_TOTAL; it += NGW) {
            int r = it;
            if (r < I_WIN) { tr_item(w_in, 9928, WIN, 2048, r / NB_WIN, r % NB_WIN, lane, MapProj{}); continue; } r -= I_WIN;
            if (r < I_WB) { tr_item(w_branch + (size_t)1024 * 2048, 2048, WCOMB + 1024, 2048, r >> 6, r & 63, lane, MapId{});   continue; } r -= I_WB;
            tr_item(w_out, 2048, WO, 2048, r >> 6, r & 63, lane, MapId{});
        }
        for (int i = gtid; i < 56 * 256; i += NGT) ((u32x4*)(WIN + (size_t)1736 * 2048))[i] = (u32x4){0u, 0u, 0u, 0u};
        } else if (job == 1) {
        for (int it = gw; it < 2048; it += NGW) {
            const int h = it >> 8, ch = (it >> 7) & 1, n0 = (it & 127) * 16, c = ch * 64 + lane;
            const float* wuv = w_uv + ((size_t)h * 128 + c) * 128;
            const float* wa = w_branch + (size_t)(h * 128) * 2048 + n0;
            float a[16];
#pragma unroll
            for (int j = 0; j < 16; ++j) a[j] = 0.f;
#pragma unroll 4
            for (int d4 = 0; d4 < 32; ++d4) {
                const f32x4 wv = *(const f32x4*)(wuv + d4 * 4);
#pragma unroll
                for (int dd = 0; dd < 4; ++dd) {
                    const float* wr_ = wa + (size_t)(d4 * 4 + dd) * 2048;
#pragma unroll
                    for (int j4 = 0; j4 < 4; ++j4) { const f32x4 b = *(const f32x4*)(wr_ + j4 * 4); a[j4 * 4 + 0] += wv[dd] * b[0]; a[j4 * 4 + 1] += wv[dd] * b[1]; a[j4 * 4 + 2] += wv[dd] * b[2]; a[j4 * 4 + 3] += wv[dd] * b[3]; }
                }
            }
#pragma unroll
            for (int j = 0; j < 16; ++j) WCOMB[(size_t)(n0 + j) * 2048 + h * 128 + c] = (bf16_t)(pkbf(a[j], 0.f) & 0xffffu);
        }
        } else if (job == 2) {
        for (int m = gw; m < T_TOK; m += 2 * NGW) {
            const int m1 = (m + NGW < T_TOK) ? m + NGW : m;
            const f32x4* xr0 = (const f32x4*)(x + (size_t)m * DMODEL) + lane; const f32x4* xr1 = (const f32x4*)(x + (size_t)m1 * DMODEL) + lane;
            f32x4 v0[8], v1[8]; float s0 = 0.f, s1 = 0.f;
#pragma unroll
            for (int j = 0; j < 8; ++j) { v0[j] = __builtin_nontemporal_load(xr0 + 64 * j); v1[j] = __builtin_nontemporal_load(xr1 + 64 * j); }
#pragma unroll
            for (int j = 0; j < 8; ++j) { s0 += (v0[j][0] * v0[j][0] + v0[j][1] * v0[j][1]) + (v0[j][2] * v0[j][2] + v0[j][3] * v0[j][3]); s1 += (v1[j][0] * v1[j][0] + v1[j][1] * v1[j][1]) + (v1[j][2] * v1[j][2] + v1[j][3] * v1[j][3]); }
            const float r0 = 1.0f / sqrtf(wave_sum(s0, lane) * (1.0f / DMODEL) + EPS_F), r1 = 1.0f / sqrtf(wave_sum(s1, lane) * (1.0f / DMODEL) + EPS_F);
            u32x2* o0 = (u32x2*)(XN + (size_t)m * DMODEL) + lane; u32x2* o1 = (u32x2*)(XN + (size_t)m1 * DMODEL) + lane;
#pragma unroll
            for (int j = 0; j < 8; ++j) { const f32x4 gg = ((const f32x4*)g_mix)[lane + 64 * j];
                u32x2 w; w.x = pkbf(v0[j][0] * r0 * gg[0], v0[j][1] * r0 * gg[1]); w.y = pkbf(v0[j][2] * r0 * gg[2], v0[j][3] * r0 * gg[3]); o0[64 * j] = w;
                u32x2 w2; w2.x = pkbf(v1[j][0] * r1 * gg[0], v1[j][1] * r1 * gg[1]); w2.y = pkbf(v1[j][2] * r1 * gg[2], v1[j][3] * r1 * gg[3]); o1[64 * j] = w2; }
        }
        } else {
        for (int idx = gtid; idx < SEQL * 64; idx += NGT) {
            const int pos = idx >> 6, i = idx & 63; double f = 1.0;
            for (int k = 0; k < i; ++k) f *= 0.8659643233600653;
            double s, c; sincos_d((double)pos * f, s, c);
            rot[2 * idx] = (float)c; rot[2 * idx + 1] = (float)s;
        }
        { const float* g_ffn = IN(8); const float* w_rg = IN(9); const float* w_re = IN(11); float* WC = (float*)(ws + WS_WC);
          for (int idx = gtid; idx < 256 * 48 * 8; idx += NGT) { const int j = idx & 7, c = (idx >> 3) % 48, k = (idx / 384) * 8 + j;
              const float wv = (c < 4) ? w_rg[k * 4 + c] : (c < 36) ? w_re[k * 32 + (c - 4)] : 0.f; WC[idx] = wv * g_ffn[k]; } }
        }
        }
        for (int i = gtid; i < 32; i += NGT) ctl[64 * i] = 0u;
        if (gtid < 2) ctl[4096 + gtid] = 0u;
        for (int i = gtid; i < MAXSLOT; i += NGT) { row_tok[i] = 0; row_gate[i] = 0.f; ((float*)(ws + WS_WC + 524288))[i] = 0.f; }
    }
    if (__builtin_expect(p.out == nullptr, 0)) GSYNC();
    XBAR();
    STAMP(1);

    {
        PH_LOCALS
        const float* w_eg = IN(13); const float* w_eu = IN(14); const float* w_ed = IN(15);
        const int NGEMM = (G == 256) ? NGEMM_P1 : G;
        if (bx < NGEMM) {
            pg8::Gemm g{XN, WIN, T_TOK, NPROJ, 2048}; pg8::StaticOrder S; S.init(T_TOK, NPROJ, NGEMM, bx);
            pg8::EpiProj E{P, rot};
            pg8::gemm_phase<pg8::EpiProj, pg8::StaticOrder, true, true>(lds, g, S, E, tid);
        }
        convert_experts(w_eg, w_eu, w_ed, WGU, WD, ctl + CTL_QCTR, lane);
    }
    XBAR();
    STAMP(2);
#ifdef P1_EXP
    XBAR();
    STAMP(30);
    {
        PH_LOCALS
        const float* w_eg = IN(13); const float* w_eu = IN(14); const float* w_ed = IN(15);
        const int NGEMM = P1_EXP_NG;
        if ((P1_EXP & 1) && bx < NGEMM) {
            pg8::Gemm g{XN, WIN, T_TOK, NPROJ, 2048}; pg8::StaticOrder S; S.init(T_TOK, NPROJ, NGEMM, bx);
            pg8::EpiProj E{P, rot};
            pg8::gemm_phase<pg8::EpiProj, pg8::StaticOrder, true, true>(lds, g, S, E, tid);
        }
        if ((P1_EXP & 2) && bx >= NGEMM) convert_experts(w_eg, w_eu, w_ed, WGU, WD, ctl + CTL_QCTR + 64, lane);
    }
    XBAR();
    STAMP(31);
#endif

    {
        PH_LOCALS
        const float* g_kv = IN(3);
        for (int t = gw; t < T_TOK; t += NGW) {
            const unsigned v = *(const unsigned*)(P + (size_t)t * NPROJ + C_CKV + 2 * lane);
            const float a = bflo(v), b = bfhi(v);
            const float rstd = 1.0f / sqrtf(wave_sum(a * a + b * b, lane) * (1.0f / 128.0f) + EPS_F);
            *(unsigned*)(KV + (size_t)t * 128 + 2 * lane) = pkbf(a * rstd * g_kv[2 * lane], b * rstd * g_kv[2 * lane + 1]);
        }
#if DBG_CMP == 3
        {
        u64* MASKX = (u64*)(ws + WS_SPARE);
        LAS float* qi = (LAS float*)(lds + wave * 10240); LAS float* sc = qi + 512;
        for (int t = gw; t < T_TOK; t += NGW) {
            const int b = t >> 11, q = t & 2047, ng = (q >> 6) + 1;
            { const u32x4 v = *(const u32x4*)(P + (size_t)t * NPROJ + C_QIDX + lane * 8);
              f32x4 lo4 = (f32x4){bflo(v.x), bfhi(v.x), bflo(v.y), bfhi(v.y)}, hi4 = (f32x4){bflo(v.z), bfhi(v.z), bflo(v.w), bfhi(v.w)};
              *(LAS f32x4*)(qi + lane * 8) = lo4; *(LAS f32x4*)(qi + lane * 8 + 4) = hi4; }
            float w[8];
            { const u32x4 v = *(const u32x4*)(P + (size_t)t * NPROJ + C_WIDX); w[0] = bflo(v.x); w[1] = bfhi(v.x); w[2] = bflo(v.y); w[3] = bfhi(v.y); w[4] = bflo(v.z); w[5] = bfhi(v.z); w[6] = bflo(v.w); w[7] = bfhi(v.w); }
            for (int g = 0; g < ng; ++g) {
                LAS float* qg = qi; asm volatile("" : "+v"(qg));
                const int s = g * 64 + lane; const u32x4* kr = (const u32x4*)(P + (size_t)(b * SEQL + s) * NPROJ + C_KIDX);
                float dot[8];
#pragma unroll
                for (int h = 0; h < 8; ++h) dot[h] = 0.f;
#pragma unroll
                for (int c = 0; c < 8; ++c) {
                    const u32x4 v = kr[c];
                    const f32x4 ka = (f32x4){bflo(v.x), bfhi(v.x), bflo(v.y), bfhi(v.y)}, kb = (f32x4){bflo(v.z), bfhi(v.z), bflo(v.w), bfhi(v.w)};
#pragma unroll
                    for (int h = 0; h < 8; ++h) {
                        const f32x4 qa = *(const LAS f32x4*)(qg + h * 64 + c * 8), qb = *(const LAS f32x4*)(qg + h * 64 + c * 8 + 4);
                        dot[h] += (qa[0] * ka[0] + qa[1] * ka[1]) + (qa[2] * ka[2] + qa[3] * ka[3]) + (qb[0] * kb[0] + qb[1] * kb[1]) + (qb[2] * kb[2] + qb[3] * kb[3]);
                    }
                }
                float score = 0.f;
#pragma unroll
                for (int h = 0; h < 8; ++h) score += w[h] * fmaxf(dot[h], 0.f);
                sc[s] = score * IDX_SCALE;
            }
            u64* mrow = MASKX + (size_t)t * 32;
            if (ng <= 4) { if (lane < 32) mrow[lane] = (lane < ng) ? ~0ull : 0ull; }
            else {
                unsigned lo = 0u;
                for (int bit = 31; bit >= 0; --bit) {
                    const unsigned cand = lo | (1u << bit); int cnt = 0;
                    for (int g = 0; g < ng; ++g) cnt += __popcll(__ballot(fkey(sc[g * 64 + lane]) >= cand));
                    if (cnt >= 256) lo = cand;
                }
                const unsigned tau = lo; int cgt = 0;
                for (int g = 0; g < ng; ++g) cgt += __popcll(__ballot(fkey(sc[g * 64 + lane]) > tau));
                const int need = 256 - cgt; int run = 0;
                for (int g = 0; g < ng; ++g) {
                    const unsigned key = fkey(sc[g * 64 + lane]);
                    const u64 gt = __ballot(key > tau), eq = __ballot(key == tau);
                    const u64 below = eq & ((1ull << lane) - 1ull);
                    const bool sel = (key == tau) && (run + (int)__popcll(below) < need);
                    const u64 word = gt | __ballot(sel);
                    run += (int)__popcll(eq);
                    if (lane == 0) mrow[g] = word;
                }
                if (lane >= ng && lane < 32) mrow[lane] = 0ull;
            }
        }
        }
        __syncthreads();
#endif
        typedef short bf16x8_t __attribute__((ext_vector_type(8)));
        constexpr int SCS = 2052;
        LAS float* scl = (LAS float*)lds;
        LAS unsigned* hist = (LAS unsigned*)(lds + 16 * SCS * 4);
        LAS unsigned* candl = hist + 16 * 256 + wave * 64;
        for (int i = tid; i < 16 * 256; i += 512) hist[i] = 0u;
        __syncthreads();
        for (int ui = 0; ui < 4; ++ui) {
            const int uu = ui * 256 + ((ui & 1) ? 255 - bx : bx);
            if (uu >= 1024 || bx >= 256) break;
            const int b = uu & 7, qblk = uu >> 3, q0 = qblk * 16, t0 = b * SEQL + q0, ng = (q0 >> 6) + 1, N = ng * 64;
            if (ng <= 4) {
                for (int qq = 0; qq < 2; ++qq) { u64* mrow = MASK + (size_t)(t0 + 2 * wave + qq) * 32; if (lane < 32) mrow[lane] = (lane < ng) ? ~0ull : 0ull; }
                continue;
            }
            const int qrow = lane & 15, kg = lane >> 4;
            bf16x8_t qf[8][2]; float w[8];
            { const bf16_t* qp = P + (size_t)(t0 + qrow) * NPROJ + C_QIDX + 8 * kg;
#pragma unroll
              for (int h = 0; h < 8; ++h) { qf[h][0] = *(const bf16x8_t*)(qp + h * 64); qf[h][1] = *(const bf16x8_t*)(qp + h * 64 + 32); }
              const u32x4 v = *(const u32x4*)(P + (size_t)(t0 + qrow) * NPROJ + C_WIDX); w[0] = bflo(v.x); w[1] = bfhi(v.x); w[2] = bflo(v.y); w[3] = bfhi(v.y); w[4] = bflo(v.z); w[5] = bfhi(v.z); w[6] = bflo(v.w); w[7] = bfhi(v.w); }
            const bf16_t* kp0 = P + (size_t)(b * SEQL + qrow) * NPROJ + C_KIDX + 8 * kg;
            bf16x8_t na0 = *(const bf16x8_t*)(kp0 + (size_t)(wave * 16) * NPROJ), na1 = *(const bf16x8_t*)(kp0 + (size_t)(wave * 16) * NPROJ + 32);
            for (int kt = wave; kt < N / 16; kt += 8) {
                const int s0 = kt * 16;
                const bf16x8_t a0 = na0, a1 = na1;
                { const int ktn = (kt + 8 < N / 16) ? kt + 8 : kt;
                  na0 = *(const bf16x8_t*)(kp0 + (size_t)(ktn * 16) * NPROJ); na1 = *(const bf16x8_t*)(kp0 + (size_t)(ktn * 16) * NPROJ + 32); }
                f32x4 sacc = (f32x4){0.f, 0.f, 0.f, 0.f};
#pragma unroll
                for (int h = 0; h < 8; ++h) {
                    f32x4 acc = (f32x4){0.f, 0.f, 0.f, 0.f};
                    acc = __builtin_amdgcn_mfma_f32_16x16x32_bf16(a0, qf[h][0], acc, 0, 0, 0);
                    acc = __builtin_amdgcn_mfma_f32_16x16x32_bf16(a1, qf[h][1], acc, 0, 0, 0);
                    sacc[0] += w[h] * fmaxf(acc[0], 0.f); sacc[1] += w[h] * fmaxf(acc[1], 0.f); sacc[2] += w[h] * fmaxf(acc[2], 0.f); sacc[3] += w[h] * fmaxf(acc[3], 0.f);
                }
                sacc = sacc * IDX_SCALE + 0.0f;
                *(LAS f32x4*)(scl + qrow * SCS + s0 + 4 * kg) = sacc;
#pragma unroll
                for (int i = 0; i < 4; ++i) __hip_atomic_fetch_add(hist + qrow * 256 + sbin(sacc[i]), 1u, __ATOMIC_RELAXED, __HIP_MEMORY_SCOPE_WORKGROUP);
            }
            __syncthreads();
#pragma unroll 1
            for (int qq = 0; qq < 2; ++qq) {
                const int q = 2 * wave + qq; const LAS float* row = scl + q * SCS; LAS unsigned* hq = hist + q * 256;
                unsigned key[32];
#pragma unroll
                for (int j = 0; j < 32; ++j) key[j] = (j < ng) ? fkey(row[64 * j + lane]) : 0u;
                const u32x4 hv = *(const LAS u32x4*)(hq + 4 * lane);
                *(LAS u32x4*)(hq + 4 * lane) = (u32x4){0u, 0u, 0u, 0u};
                const int tsum = (int)(hv.x + hv.y + hv.z + hv.w); int incl = tsum;
#pragma unroll
                for (int off = 1; off < 64; off <<= 1) { const int o = __builtin_amdgcn_ds_bpermute(((lane + off) & 63) << 2, incl); incl += (lane + off < 64) ? o : 0; }
                const int suf = incl - tsum;
                int bt_l, ab_l;
                if (suf + (int)hv.w >= 256) { bt_l = 4 * lane + 3; ab_l = suf; }
                else if (suf + (int)(hv.w + hv.z) >= 256) { bt_l = 4 * lane + 2; ab_l = suf + (int)hv.w; }
                else if (suf + (int)(hv.w + hv.z + hv.y) >= 256) { bt_l = 4 * lane + 1; ab_l = suf + (int)(hv.w + hv.z); }
                else { bt_l = 4 * lane; ab_l = suf + (int)(hv.w + hv.z + hv.y); }
                const u64 cb = __ballot(suf < 256 && incl >= 256);
                const int src = (int)__builtin_ctzll(cb | (1ull << 63));
                const int bt = __builtin_amdgcn_readlane(bt_l, src), above = __builtin_amdgcn_readlane(ab_l, src);
                const int r = 256 - above;
                unsigned cm = 0u;
#pragma unroll
                for (int j = 0; j < 32; ++j) cm |= ((key[j] != 0u) && (sbin(unkey(key[j])) == bt)) ? (1u << j) : 0u;
                const int myc = (int)__popc(cm); int pre = myc;
#pragma unroll
                for (int off = 1; off < 64; off <<= 1) { const int o_ = __builtin_amdgcn_ds_bpermute(((lane - off) & 63) << 2, pre); pre += (lane >= off) ? o_ : 0; }
                const int C = __builtin_amdgcn_readlane(pre, 63);
                int pos = pre - myc;
                if (C <= 64) {
#pragma unroll
                    for (int j = 0; j < 32; ++j) if ((cm >> j) & 1u) { candl[pos] = key[j]; ++pos; }
                }
                unsigned tau; int cgt, neq;
                if (C <= 64) {
                    asm volatile("s_waitcnt lgkmcnt(0)" ::: "memory");
                    const unsigned ck = (lane < C) ? candl[lane] : 0u;
                    unsigned lo = 0u;
#pragma unroll 1
                    for (int bit = 31; bit >= 0; --bit) { const unsigned cand = lo | (1u << bit); if ((int)__popcll(__ballot(ck >= cand)) >= r) lo = cand; }
                    tau = lo; cgt = above + (int)__popcll(__ballot(ck > tau)); neq = (int)__popcll(__ballot(ck == tau));
                } else {
                    unsigned lo = 0u;
#pragma unroll 1
                    for (int bit = 31; bit >= 0; --bit) {
                        const unsigned cand = lo | (1u << bit); int c = 0;
#pragma unroll
                        for (int j = 0; j < 32; ++j) c += (key[j] >= cand) ? 1 : 0;
#pragma unroll
                        for (int x = 1; x < 64; x <<= 1) c += __builtin_amdgcn_ds_bpermute((lane ^ x) << 2, c);
                        if (c >= 256) lo = cand;
                    }
                    tau = lo; cgt = 0;
#pragma unroll
                    for (int j = 0; j < 32; ++j) cgt += (key[j] > tau) ? 1 : 0;
#pragma unroll
                    for (int x = 1; x < 64; x <<= 1) cgt += __builtin_amdgcn_ds_bpermute((lane ^ x) << 2, cgt);
                    neq = 2;
                }
                const int need = 256 - cgt; u64 myword = 0ull;
                if (neq == 1) {
#pragma unroll
                    for (int j = 0; j < 32; ++j) { const u64 word = __ballot(key[j] >= tau); if (lane == j) myword = word; }
                } else {
                    int run = 0;
#pragma unroll
                    for (int j = 0; j < 32; ++j) {
                        const u64 gt = __ballot(key[j] > tau), eq = __ballot(key[j] == tau);
                        const u64 below = eq & ((1ull << lane) - 1ull);
                        const bool sel = (key[j] == tau) && (run + (int)__popcll(below) < need);
                        const u64 word = gt | __ballot(sel);
                        run += (int)__popcll(eq);
                        if (lane == j) myword = word;
                        __builtin_amdgcn_sched_barrier(0);
                    }
                }
                if (lane < 32) MASK[(size_t)(t0 + q) * 32 + lane] = myword;
            }
            __syncthreads();
        }
    }
    XBAR();
    STAMP(3);
#ifdef IDX_EXP
    XBAR();
    STAMP(30);
    {
        PH_LOCALS
        u64* MASKX_ = (u64*)(ws + WS_SPARE);
        typedef short bf16x8_t __attribute__((ext_vector_type(8)));
        constexpr int SCS = 2052;
        LAS float* scl = (LAS float*)lds;
        LAS unsigned* hist = (LAS unsigned*)(lds + 16 * SCS * 4);
        LAS unsigned* candl = hist + 16 * 256 + wave * 64;
        for (int i = tid; i < 16 * 256; i += 512) hist[i] = 0u;
        __syncthreads();
        for (int ui = 0; ui < 4; ++ui) {
            const int uu = ui * 256 + ((ui & 1) ? 255 - bx : bx);
            if (uu >= 1024 || bx >= 256) break;
            const int b = uu & 7, qblk = uu >> 3, q0 = qblk * 16, t0 = b * SEQL + q0, ng = (q0 >> 6) + 1, N = ng * 64;
            if (ng <= 4) {
                for (int qq = 0; qq < 2; ++qq) { u64* mrow = MASKX_ + (size_t)(t0 + 2 * wave + qq) * 32; if (lane < 32) mrow[lane] = (lane < ng) ? ~0ull : 0ull; }
                continue;
            }
            const int qrow = lane & 15, kg = lane >> 4;
            bf16x8_t qf[8][2]; float w[8];
            { const bf16_t* qp = P + (size_t)(t0 + qrow) * NPROJ + C_QIDX + 8 * kg;
#pragma unroll
              for (int h = 0; h < 8; ++h) { qf[h][0] = *(const bf16x8_t*)(qp + h * 64); qf[h][1] = *(const bf16x8_t*)(qp + h * 64 + 32); }
              const u32x4 v = *(const u32x4*)(P + (size_t)(t0 + qrow) * NPROJ + C_WIDX); w[0] = bflo(v.x); w[1] = bfhi(v.x); w[2] = bflo(v.y); w[3] = bfhi(v.y); w[4] = bflo(v.z); w[5] = bfhi(v.z); w[6] = bflo(v.w); w[7] = bfhi(v.w); }
            const bf16_t* kp0 = P + (size_t)(b * SEQL + qrow) * NPROJ + C_KIDX + 8 * kg;
            bf16x8_t na0 = *(const bf16x8_t*)(kp0 + (size_t)(wave * 16) * NPROJ), na1 = *(const bf16x8_t*)(kp0 + (size_t)(wave * 16) * NPROJ + 32);
            if (!(IDX_EXP & 2))
            for (int kt = wave; kt < N / 16; kt += 8) {
                const int s0 = kt * 16;
                const bf16x8_t a0 = na0, a1 = na1;
                { const int ktn = (kt + 8 < N / 16) ? kt + 8 : kt;
                  na0 = *(const bf16x8_t*)(kp0 + (size_t)(ktn * 16) * NPROJ); na1 = *(const bf16x8_t*)(kp0 + (size_t)(ktn * 16) * NPROJ + 32); }
                f32x4 sacc = (f32x4){0.f, 0.f, 0.f, 0.f};
#pragma unroll
                for (int h = 0; h < 8; ++h) {
                    f32x4 acc = (f32x4){0.f, 0.f, 0.f, 0.f};
                    acc = __builtin_amdgcn_mfma_f32_16x16x32_bf16(a0, qf[h][0], acc, 0, 0, 0);
                    acc = __builtin_amdgcn_mfma_f32_16x16x32_bf16(a1, qf[h][1], acc, 0, 0, 0);
                    sacc[0] += w[h] * fmaxf(acc[0], 0.f); sacc[1] += w[h] * fmaxf(acc[1], 0.f); sacc[2] += w[h] * fmaxf(acc[2], 0.f); sacc[3] += w[h] * fmaxf(acc[3], 0.f);
                }
                sacc = sacc * IDX_SCALE + 0.0f;
                *(LAS f32x4*)(scl + qrow * SCS + s0 + 4 * kg) = sacc;
#pragma unroll
                for (int i = 0; i < 4; ++i) __hip_atomic_fetch_add(hist + qrow * 256 + sbin(sacc[i]), 1u, __ATOMIC_RELAXED, __HIP_MEMORY_SCOPE_WORKGROUP);
            }
            __syncthreads();
#pragma unroll 1
            for (int qq = 0; qq < ((IDX_EXP & 1) ? 0 : 2); ++qq) {
                const int q = 2 * wave + qq; const LAS float* row = scl + q * SCS; LAS unsigned* hq = hist + q * 256;
                unsigned key[32];
#pragma unroll
                for (int j = 0; j < 32; ++j) key[j] = (j < ng) ? fkey(row[64 * j + lane]) : 0u;
                const u32x4 hv = *(const LAS u32x4*)(hq + 4 * lane);
                *(LAS u32x4*)(hq + 4 * lane) = (u32x4){0u, 0u, 0u, 0u};
                const int tsum = (int)(hv.x + hv.y + hv.z + hv.w); int incl = tsum;
#pragma unroll
                for (int off = 1; off < 64; off <<= 1) { const int o = __builtin_amdgcn_ds_bpermute(((lane + off) & 63) << 2, incl); incl += (lane + off < 64) ? o : 0; }
                const int suf = incl - tsum;
                int bt_l, ab_l;
                if (suf + (int)hv.w >= 256) { bt_l = 4 * lane + 3; ab_l = suf; }
                else if (suf + (int)(hv.w + hv.z) >= 256) { bt_l = 4 * lane + 2; ab_l = suf + (int)hv.w; }
                else if (suf + (int)(hv.w + hv.z + hv.y) >= 256) { bt_l = 4 * lane + 1; ab_l = suf + (int)(hv.w + hv.z); }
                else { bt_l = 4 * lane; ab_l = suf + (int)(hv.w + hv.z + hv.y); }
                const u64 cb = __ballot(suf < 256 && incl >= 256);
                const int src = (int)__builtin_ctzll(cb | (1ull << 63));
                const int bt = __builtin_amdgcn_readlane(bt_l, src), above = __builtin_amdgcn_readlane(ab_l, src);
                const int r = 256 - above;
                int C = 0;
                if (!(IDX_EXP & 4))
#pragma unroll
                for (int j = 0; j < 32; ++j) {
                    const bool isc = (key[j] != 0u) && (sbin(unkey(key[j])) == bt);
                    const u64 bal = __ballot(isc);
                    if (isc) { const int pos = C + (int)__popcll(bal & ((1ull << lane) - 1ull)); if (pos < 64) candl[pos] = key[j]; }
                    C += (int)__popcll(bal);
                }
                unsigned tau; int cgt;
                if (IDX_EXP & 4) { tau = 0x80000000u + (unsigned)bt; cgt = above; }
                else if (C <= 64) {
                    asm volatile("s_waitcnt lgkmcnt(0)" ::: "memory");
                    const unsigned ck = (lane < C) ? candl[lane] : 0u;
                    unsigned lo = 0u;
#pragma unroll 1
                    for (int bit = 31; bit >= 0; --bit) { const unsigned cand = lo | (1u << bit); if ((int)__popcll(__ballot(ck >= cand)) >= r) lo = cand; }
                    tau = lo; cgt = above + (int)__popcll(__ballot(ck > tau));
                } else {
                    unsigned lo = 0u;
#pragma unroll 1
                    for (int bit = 31; bit >= 0; --bit) {
                        const unsigned cand = lo | (1u << bit); int c = 0;
#pragma unroll
                        for (int j = 0; j < 32; ++j) c += (key[j] >= cand) ? 1 : 0;
#pragma unroll
                        for (int x = 1; x < 64; x <<= 1) c += __builtin_amdgcn_ds_bpermute((lane ^ x) << 2, c);
                        if (c >= 256) lo = cand;
                    }
                    tau = lo; cgt = 0;
#pragma unroll
                    for (int j = 0; j < 32; ++j) cgt += (key[j] > tau) ? 1 : 0;
#pragma unroll
                    for (int x = 1; x < 64; x <<= 1) cgt += __builtin_amdgcn_ds_bpermute((lane ^ x) << 2, cgt);
                }
                const int need = 256 - cgt; int run = 0; u64 myword = (u64)tau;
                if (!(IDX_EXP & 8))
#pragma unroll
                for (int j = 0; j < 32; ++j) {
                    const u64 gt = __ballot(key[j] > tau), eq = __ballot(key[j] == tau);
                    const u64 below = eq & ((1ull << lane) - 1ull);
                    const bool sel = (key[j] == tau) && (run + (int)__popcll(below) < need);
                    const u64 word = gt | __ballot(sel);
                    run += (int)__popcll(eq);
                    if (lane == j) myword = word;
                    __builtin_amdgcn_sched_barrier(0);
                }
                if (lane < 32) MASKX_[(size_t)(t0 + q) * 32 + lane] = myword;
            }
            __syncthreads();
        }
    }
    XBAR();
    STAMP(31);
#endif

#if DBG_CMP == 1
    {
        PH_LOCALS
        bf16_t* OAX = (bf16_t*)(ws + WS_SPARE);
        float* qv = (float*)(lds_raw + wave * 10240); float* lg = qv + 512;
        for (int it = gw; it < T_TOK * 8; it += NGW) {
            const int t = it >> 3, h = it & 7, b = t >> 11, q = t & 2047, ng = (q >> 6) + 1;
            { const unsigned v = *(const unsigned*)(P + (size_t)t * NPROJ + C_QLAT + h * 128 + 2 * lane); qv[2 * lane] = bflo(v); qv[2 * lane + 1] = bfhi(v); }
            const u64* mrow = MASK + (size_t)t * 32;
            float mx = -INFINITY;
            for (int g = 0; g < ng; ++g) {
                asm volatile("" ::: "memory");
                const u64 word = mrow[g]; float l = -INFINITY;
                if ((word >> lane) & 1ull) {
                    const u32x4* kr = (const u32x4*)(KV + (size_t)(b * SEQL + g * 64 + lane) * 128);
                    float d0 = 0.f, d1 = 0.f, d2 = 0.f, d3 = 0.f;
#pragma unroll
                    for (int c = 0; c < 16; ++c) { const u32x4 v = kr[c]; const f32x4 qa = *(const f32x4*)(qv + 8 * c), qb = *(const f32x4*)(qv + 8 * c + 4);
                        d0 += qa[0] * bflo(v.x) + qb[0] * bflo(v.z); d1 += qa[1] * bfhi(v.x) + qb[1] * bfhi(v.z); d2 += qa[2] * bflo(v.y) + qb[2] * bflo(v.w); d3 += qa[3] * bfhi(v.y) + qb[3] * bfhi(v.w); }
                    l = ((d0 + d1) + (d2 + d3)) * ATT_SCALE;
                }
                lg[g * 64 + lane] = l; mx = fmaxf(mx, l);
            }
            mx = wave_max(mx, lane);
            float o0 = 0.f, o1 = 0.f, sum = 0.f;
            for (int g = 0; g < ng; ++g) {
                const u64 wv = mrow[g];
                u64 word = ((u64)__builtin_amdgcn_readfirstlane((unsigned)(wv >> 32)) << 32) | (u64)__builtin_amdgcn_readfirstlane((unsigned)wv);
                while (word) {
                    const int j = __builtin_ctzll(word); word &= word - 1ull;
                    const int s = g * 64 + j; const float pj = __expf(lg[s] - mx);
                    const unsigned v = *(const unsigned*)(KV + (size_t)(b * SEQL + s) * 128 + 2 * lane);
                    o0 += pj * bflo(v); o1 += pj * bfhi(v); sum += pj;
                }
            }
            const float inv = 1.0f / sum;
            *(unsigned*)(OAX + (size_t)t * 1024 + h * 128 + 2 * lane) = pkbf(o0 * inv, o1 * inv);
        }
    }
    __syncthreads();
#endif
#if DBG_CMP == 2
    {
        PH_LOCALS
        const float* g_ret = IN(5);
        bf16_t* OBX = (bf16_t*)(ws + WS_SPARE);
        float* qv = (float*)(lds_raw + wave * 10240); float* lg = qv + 512; float* wl = lg;
        for (int it = gw; it < T_TOK * 8; it += NGW) {
            const int t = it >> 3, h = it & 7, b = t >> 11, n = t & 2047, ng = (n >> 6) + 1;
            const float lgam = (h == 0) ? -0.04580368961312479f : (h == 1) ? -0.02272007650008353f : (h == 2) ? -0.011315313227834146f : (h == 3) ? -0.005646563141142063f :
                               (h == 4) ? -0.0028205190623786626f : (h == 5) ? -0.0014095702546713536f : (h == 6) ? -0.0007046129765893727f : -0.0003522634716290214f;
            { const unsigned v = *(const unsigned*)(P + (size_t)t * NPROJ + C_QR + h * 128 + 2 * lane); qv[2 * lane] = bflo(v); qv[2 * lane + 1] = bfhi(v); }
            float o0 = 0.f, o1 = 0.f;
            for (int g = 0; g < ng; ++g) {
                asm volatile("" ::: "memory");
                const int m = g * 64 + lane;
                const u32x4* kr = (const u32x4*)(P + (size_t)(b * SEQL + m) * NPROJ + C_KR + h * 128);
                float d0 = 0.f, d1 = 0.f, d2 = 0.f, d3 = 0.f;
#pragma unroll
                for (int c = 0; c < 16; ++c) { const u32x4 v = kr[c]; const f32x4 qa = *(const f32x4*)(qv + 8 * c), qb = *(const f32x4*)(qv + 8 * c + 4);
                    d0 += qa[0] * bflo(v.x) + qb[0] * bflo(v.z); d1 += qa[1] * bfhi(v.x) + qb[1] * bfhi(v.z); d2 += qa[2] * bflo(v.y) + qb[2] * bflo(v.w); d3 += qa[3] * bfhi(v.y) + qb[3] * bfhi(v.w); }
                const float dot = (d0 + d1) + (d2 + d3);
                wl[lane] = (m <= n) ? dot * exp2f((float)(n - m) * lgam) : 0.f;
                const int jmax = (g == ng - 1) ? (n & 63) : 63;
                for (int j = 0; j <= jmax; ++j) {
                    const float wj = wl[j];
                    const unsigned v = *(const unsigned*)(P + (size_t)(b * SEQL + g * 64 + j) * NPROJ + C_VR + h * 128 + 2 * lane);
                    o0 += wj * bflo(v); o1 += wj * bfhi(v);
                }
            }
            const float mu = wave_sum(o0 + o1, lane) * (1.0f / 128.0f); const float e0 = o0 - mu, e1 = o1 - mu;
            const float rs = 1.0f / sqrtf(wave_sum(e0 * e0 + e1 * e1, lane) * (1.0f / 128.0f) + EPS_F);
            const unsigned gv = *(const unsigned*)(P + (size_t)t * NPROJ + C_GR + h * 128 + 2 * lane);
            const float y0 = siluf_(bflo(gv)) * e0 * rs * g_ret[h * 128 + 2 * lane], y1 = siluf_(bfhi(gv)) * e1 * rs * g_ret[h * 128 + 2 * lane + 1];
            *(unsigned*)(OBX + (size_t)t * 1024 + h * 128 + 2 * lane) = pkbf(y0, y1);
        }
    }
    __syncthreads();
#endif
    {
        PH_LOCALS
        for (int pr = bx; pr < 256; pr += G) {
            const int b = pr >> 5, i = pr & 31;
#pragma unroll 1
            for (int uu = 0; uu < 2; ++uu) {
                const int qb = uu ? 63 - i : i; const int t0 = b * SEQL + qb * 32;
                fa::UnitArgs U; U.Q = P + (size_t)t0 * NPROJ + C_QLAT; U.ldq = NPROJ; U.K = KV + (size_t)b * SEQL * 128; U.V = U.K; U.ldk = 128; U.mask = MASK + (size_t)t0 * 32;
                U.ntiles = (qb >> 1) + 1; U.n0 = 0; U.lgam = 0.f;
                fa::f32x16 o[4]; float l_reg;
                fa::unit_body<0>((LAS char*)lds, U, tid, o, l_reg);
                const int r32 = lane & 31, hi = lane >> 5;
                const int trow1 = hide_i(t0);
                LAS float* li_l = (LAS float*)(lds + fa::OFF_WS) + wave * 64;
                if (hi == 0) li_l[r32] = l_reg;
                asm volatile("s_waitcnt lgkmcnt(0)" ::: "memory");
                LAS char* Tw = (LAS char*)lds + fa::OFF_Q + wave * 8704; LAS char* Tl = Tw + hi * (4 * 272) + r32 * 2; asm volatile("" : "+v"(Tl));
#pragma unroll
                for (int r = 0; r < 16; ++r) {
                    const int orow = fa::crow(r, hi); const float rl = __builtin_amdgcn_rcpf(li_l[orow]);
#pragma unroll
                    for (int d0 = 0; d0 < 4; ++d0) *(LAS bf16_t*)(Tl + ((r & 3) + 8 * (r >> 2)) * 272 + d0 * 64) = (bf16_t)(pkbf(o[d0][r] * rl, 0.f) & 0xffffu);
                }
                asm volatile("s_waitcnt lgkmcnt(0)" ::: "memory");
#pragma unroll
                for (int k = 0; k < 8; ++k) {
                    const int c = hide_i(lane) + 64 * k, orow = c >> 4, ch = c & 15;
                    const u32x4 v = *(const LAS u32x4*)(Tw + orow * 272 + ch * 16);
                    *(u32x4*)(OA + (size_t)(trow1 + orow) * 2048 + wave * 128 + ch * 8) = v;
                }
                __syncthreads();
            }
        }
    }
    STAMP(20);
    {
        PH_LOCALS
        const float* g_ret = IN(5);
        for (int pr = bx; pr < 256; pr += G) {
            const int bh = pr >> 2, i = pr & 3, b = bh >> 3, h = bh & 7;
            const float lgam = (h == 0) ? -0.04580368961312479f : (h == 1) ? -0.02272007650008353f : (h == 2) ? -0.011315313227834146f : (h == 3) ? -0.005646563141142063f :
                               (h == 4) ? -0.0028205190623786626f : (h == 5) ? -0.0014095702546713536f : (h == 6) ? -0.0007046129765893727f : -0.0003522634716290214f;
#pragma unroll 1
            for (int uu = 0; uu < 2; ++uu) {
                const int qb = uu ? 7 - i : i; const int n0 = qb * 256;
                fa::UnitArgs U; U.Q = P + (size_t)(b * SEQL + n0) * NPROJ + C_QR + h * 128; U.ldq = NPROJ;
                U.K = P + (size_t)(b * SEQL) * NPROJ + C_KR + h * 128; U.V = P + (size_t)(b * SEQL) * NPROJ + C_VR + h * 128; U.ldk = NPROJ; U.mask = nullptr;
                U.ntiles = 4 * (qb + 1); U.n0 = n0; U.lgam = lgam;
                fa::f32x16 o[4]; float l_reg;
                fa::unit_body<1>((LAS char*)lds, U, tid, o, l_reg);
                const int r32 = lane & 31, hi = lane >> 5;
                const int tok0 = hide_i(b * SEQL + n0 + wave * 32 + 4 * hi);
                float gr[4];
#pragma unroll
                for (int d0 = 0; d0 < 4; ++d0) gr[d0] = g_ret[h * 128 + d0 * 32 + r32];
                float sv[16], qv[16];
#pragma unroll
                for (int r = 0; r < 16; ++r) sv[r] = (o[0][r] + o[1][r]) + (o[2][r] + o[3][r]);
#pragma unroll
                for (int x = 1; x < 32; x <<= 1)
#pragma unroll
                    for (int r = 0; r < 16; ++r) sv[r] += shx(sv[r], lane, x);
#pragma unroll
                for (int r = 0; r < 16; ++r) { const float mu = sv[r] * (1.0f / 128.0f); sv[r] = mu;
                    const float e0 = o[0][r] - mu, e1 = o[1][r] - mu, e2 = o[2][r] - mu, e3 = o[3][r] - mu; qv[r] = (e0 * e0 + e1 * e1) + (e2 * e2 + e3 * e3); }
#pragma unroll
                for (int x = 1; x < 32; x <<= 1)
#pragma unroll
                    for (int r = 0; r < 16; ++r) qv[r] += shx(qv[r], lane, x);
                LAS char* Tw = (LAS char*)lds + fa::OFF_Q + wave * 8704; LAS char* Tl = Tw + hi * (4 * 272) + r32 * 2; asm volatile("" : "+v"(Tl));
#pragma unroll
                for (int r = 0; r < 16; ++r) {
                    const float mu = sv[r]; const float rs = 1.0f / sqrtf(qv[r] * (1.0f / 128.0f) + EPS_F); const int orow = fa::crow(r, hi);
#pragma unroll
                    for (int d0 = 0; d0 < 4; ++d0) *(LAS bf16_t*)(Tl + ((r & 3) + 8 * (r >> 2)) * 272 + d0 * 64) = (bf16_t)(pkbf((o[d0][r] - mu) * rs * gr[d0], 0.f) & 0xffffu);
                }
                asm volatile("s_waitcnt lgkmcnt(0)" ::: "memory");
                const int tokb = hide_i(b * SEQL + n0 + wave * 32); const int ln_ = hide_i(lane);
#pragma unroll
                for (int k = 0; k < 8; ++k) {
                    const int c = ln_ + 64 * k, orow = c >> 4, ch = c & 15;
                    const u32x4 v = *(const LAS u32x4*)(Tw + orow * 272 + ch * 16);
                    const size_t tok = (size_t)(tokb + orow);
                    const u32x4 g = __builtin_nontemporal_load((const u32x4*)(P + tok * NPROJ + C_GR + h * 128 + ch * 8));
                    u32x4 w; w.x = pkbf(siluf_(bflo(g.x)) * bflo(v.x), siluf_(bfhi(g.x)) * bfhi(v.x)); w.y = pkbf(siluf_(bflo(g.y)) * bflo(v.y), siluf_(bfhi(g.y)) * bfhi(v.y));
                    w.z = pkbf(siluf_(bflo(g.z)) * bflo(v.z), siluf_(bfhi(g.z)) * bfhi(v.z)); w.w = pkbf(siluf_(bflo(g.w)) * bflo(v.w), siluf_(bfhi(g.w)) * bfhi(v.w));
                    *(u32x4*)(OB + tok * 2048 + h * 128 + ch * 8) = w;
                }
                __syncthreads();
            }
        }
    }
#ifdef RET_EXP
    XBAR();
    STAMP(30);
    {
        PH_LOCALS
        const float* g_ret = IN(5);
        for (int pr = bx; pr < 256; pr += G) {
            const int bh = pr >> 2, i = pr & 3, b = bh >> 3, h = bh & 7;
            const float lgam = (h == 0) ? -0.04580368961312479f : (h == 1) ? -0.02272007650008353f : (h == 2) ? -0.011315313227834146f : (h == 3) ? -0.005646563141142063f :
                               (h == 4) ? -0.0028205190623786626f : (h == 5) ? -0.0014095702546713536f : (h == 6) ? -0.0007046129765893727f : -0.0003522634716290214f;
#pragma unroll 1
            for (int uu = 0; uu < 2; ++uu) {
                const int qb = uu ? 7 - i : i; const int n0 = qb * 256;
                fa::UnitArgs U; U.Q = P + (size_t)(b * SEQL + n0) * NPROJ + C_QR + h * 128; U.ldq = NPROJ;
                U.K = P + (size_t)(b * SEQL) * NPROJ + C_KR + h * 128; U.V = P + (size_t)(b * SEQL) * NPROJ + C_VR + h * 128; U.ldk = NPROJ; U.mask = nullptr;
                U.ntiles = 4 * (qb + 1); U.n0 = n0; U.lgam = lgam;
                fa::f32x16 o[4]; float l_reg;
                fa::unit_body<1, RET_EXP>((LAS char*)lds, U, tid, o, l_reg);
                const int r32 = lane & 31, hi = lane >> 5;
                const int tok0 = hide_i(b * SEQL + n0 + wave * 32 + 4 * hi);
                float gr[4];
#pragma unroll
                for (int d0 = 0; d0 < 4; ++d0) gr[d0] = g_ret[h * 128 + d0 * 32 + r32];
                if (RET_EXP & 8) { fa::f32x16 t_ = (o[0] + o[1]) + (o[2] + o[3]); float z_ = 0.f;
#pragma unroll
                    for (int r = 0; r < 16; ++r) z_ += t_[r];
                    ((float*)(ws + WS_SPARE))[(size_t)(pr * 2 + uu) * 512 + tid] = z_; }
                else
#pragma unroll
                for (int r = 0; r < 16; ++r) {
                    float s = (o[0][r] + o[1][r]) + (o[2][r] + o[3][r]);
#pragma unroll
                    for (int x = 1; x < 32; x <<= 1) s += shx(s, lane, x);
                    const float mu = s * (1.0f / 128.0f);
                    const float e0 = o[0][r] - mu, e1 = o[1][r] - mu, e2 = o[2][r] - mu, e3 = o[3][r] - mu;
                    float q = (e0 * e0 + e1 * e1) + (e2 * e2 + e3 * e3);
#pragma unroll
                    for (int x = 1; x < 32; x <<= 1) q += shx(q, lane, x);
                    const float rs = 1.0f / sqrtf(q * (1.0f / 128.0f) + EPS_F);
                    const size_t tok = (size_t)(tok0 + (r & 3) + 8 * (r >> 2));
                    const bf16_t* gp = P + tok * NPROJ + C_GR + h * 128 + r32; bf16_t* op = (bf16_t*)(ws + WS_SPARE) + tok * 1024 + h * 128 + r32;
                    op[0] = (bf16_t)(pkbf(siluf_(bflo((unsigned)gp[0])) * e0 * rs * gr[0], 0.f) & 0xffffu);
                    op[32] = (bf16_t)(pkbf(siluf_(bflo((unsigned)gp[32])) * e1 * rs * gr[1], 0.f) & 0xffffu);
                    op[64] = (bf16_t)(pkbf(siluf_(bflo((unsigned)gp[64])) * e2 * rs * gr[2], 0.f) & 0xffffu);
                    op[96] = (bf16_t)(pkbf(siluf_(bflo((unsigned)gp[96])) * e3 * rs * gr[3], 0.f) & 0xffffu);
                }
                __syncthreads();
            }
        }
    }
    XBAR();
    STAMP(31);
#endif
#if DBG_CMP
    XBAR();
    {
        PH_LOCALS
        const bf16_t* A_ = (DBG_CMP == 1) ? OA : OB; const bf16_t* R_ = (const bf16_t*)(ws + WS_SPARE);
        float sd = 0.f, sr = 0.f;
#if DBG_CMP == 3
        for (size_t i = (size_t)gtid; i < (size_t)T_TOK * 32; i += (size_t)NGT) { const u64 a = MASK[i], r = ((const u64*)(ws + WS_SPARE))[i]; sd += (float)__popcll(a ^ r); sr += 100.0f * (float)__popcll(r); }
#else
        for (size_t i = (size_t)gtid; i < (size_t)T_TOK * 1024 / 2; i += (size_t)NGT) {
            const unsigned a = ((const unsigned*)A_)[(i >> 9) * 1024 + (i & 511)], r = ((const unsigned*)R_)[i];
            const float d0 = bflo(a) - bflo(r), d1 = bfhi(a) - bfhi(r); sd += d0 * d0 + d1 * d1; sr += bflo(r) * bflo(r) + bfhi(r) * bfhi(r);
        }
#endif
        sd = wave_sum(sd, lane); sr = wave_sum(sr, lane);
        if (lane == 0) { atomicAdd((float*)(ctl + 4096), sd); atomicAdd((float*)(ctl + 4097), sr); }
    }
#endif
    XBAR();
    STAMP(4);

    {
        PH_LOCALS
        pg8::Gemm g{OA, WCOMB, T_TOK, DMODEL, 2048}; pg8::StaticOrder S; S.init(T_TOK, DMODEL, G, bx);
        pg8::EpiMergeF E{P, MIXED};
        pg8::gemm_phase<pg8::EpiMergeF, pg8::StaticOrder, true, true>(lds, g, S, E, tid);
    }
    XBAR();
    STAMP(5);
    {
        PH_LOCALS
        pg8::Gemm g{MIXED, WO, T_TOK, DMODEL, 2048}; pg8::StaticOrder S; S.init(T_TOK, DMODEL, G, bx);
        pg8::EpiD E{OA};
        pg8::gemm_phase<pg8::EpiD, pg8::StaticOrder, true, true>(lds, g, S, E, tid);
    }
    XBAR();
    STAMP(7);
#ifdef GEMM_EXP
    {
        PH_LOCALS
        pg8::Gemm g{MIXED, WO, T_TOK, DMODEL, 2048}; pg8::StaticOrder S; S.init(T_TOK, DMODEL, G, bx);
        pg8::EpiNull E{(float*)(ws + WS_SPARE)};
        pg8::gemm_phase<pg8::EpiNull, pg8::StaticOrder, true, true>(lds, g, S, E, tid);
    }
    XBAR();
    STAMP(31);
#endif

    {
    PH_LOCALS
    const float* g_ffn = IN(8); const float* b_rg = IN(10); const float* b_re = IN(12); const float* x_in = IN(0);
    const f32x4* WC4 = (const f32x4*)(ws + WS_WC); float* tok_rs = (float*)(ws + WS_WC + 786432);
    LAS float* lg = (LAS float*)lds + wave * (16 * 52);
    const int row = lane & 15, g4 = lane >> 4;
    LAS float* part = (LAS float*)lds + 4 * (16 * 52) + (wave & 3) * (13 * 64);
    for (int tile0 = bx * 4; tile0 < T_TOK / 16; tile0 += G * 4) {
        const int tile = tile0 + (wave & 3), kh = wave >> 2;
        const int tok0 = tile * 16;
        const float* hrow = x_in + (size_t)(tok0 + row) * DMODEL + 8 * g4 + 1024 * kh;
        const bf16_t* drow = OA + (size_t)(tok0 + row) * DMODEL + 8 * g4 + 1024 * kh;
        const f32x4* wp = WC4 + (size_t)g4 * 96 + 2 * row + (size_t)kh * 32 * 384;
        f32x4 acc0 = (f32x4){0.f, 0.f, 0.f, 0.f}, acc1 = acc0, acc2 = acc0; float ssq = 0.f;
        f32x4 a0 = *(const f32x4*)(hrow), a1 = *(const f32x4*)(hrow + 4); u32x4 ad = *(const u32x4*)(drow);
        f32x4 b00 = wp[0], b01 = wp[1], b10 = wp[32], b11 = wp[33], b20 = wp[64], b21 = wp[65];
        f32x4 na0 = *(const f32x4*)(hrow + 32), na1 = *(const f32x4*)(hrow + 36); u32x4 nad = *(const u32x4*)(drow + 32);
        f32x4 nb00 = wp[384], nb01 = wp[385], nb10 = wp[416], nb11 = wp[417], nb20 = wp[448], nb21 = wp[449];
        for (int it = 0; it < 32; ++it) {
            const int itn = (it + 2 < 32) ? it + 2 : 31;
            const f32x4 ma0 = *(const f32x4*)(hrow + 32 * itn), ma1 = *(const f32x4*)(hrow + 32 * itn + 4); const u32x4 mad = *(const u32x4*)(drow + 32 * itn);
            a0[0] += bflo(ad.x); a0[1] += bfhi(ad.x); a0[2] += bflo(ad.y); a0[3] += bfhi(ad.y); a1[0] += bflo(ad.z); a1[1] += bfhi(ad.z); a1[2] += bflo(ad.w); a1[3] += bfhi(ad.w);
            const f32x4* wn = wp + (size_t)itn * 384;
            const f32x4 mb00 = wn[0], mb01 = wn[1], mb10 = wn[32], mb11 = wn[33], mb20 = wn[64], mb21 = wn[65];
            ssq += (a0[0] * a0[0] + a0[1] * a0[1]) + (a0[2] * a0[2] + a0[3] * a0[3]) + (a1[0] * a1[0] + a1[1] * a1[1]) + (a1[2] * a1[2] + a1[3] * a1[3]);
#pragma unroll
            for (int s_ = 0; s_ < 4; ++s_) {
                acc0 = __builtin_amdgcn_mfma_f32_16x16x4f32(a0[s_], b00[s_], acc0, 0, 0, 0);
                acc1 = __builtin_amdgcn_mfma_f32_16x16x4f32(a0[s_], b10[s_], acc1, 0, 0, 0);
                acc2 = __builtin_amdgcn_mfma_f32_16x16x4f32(a0[s_], b20[s_], acc2, 0, 0, 0);
            }
#pragma unroll
            for (int s_ = 0; s_ < 4; ++s_) {
                acc0 = __builtin_amdgcn_mfma_f32_16x16x4f32(a1[s_], b01[s_], acc0, 0, 0, 0);
                acc1 = __builtin_amdgcn_mfma_f32_16x16x4f32(a1[s_], b11[s_], acc1, 0, 0, 0);
                acc2 = __builtin_amdgcn_mfma_f32_16x16x4f32(a1[s_], b21[s_], acc2, 0, 0, 0);
            }
            a0 = na0; a1 = na1; ad = nad; nad = mad; b00 = nb00; b01 = nb01; b10 = nb10; b11 = nb11; b20 = nb20; b21 = nb21;
            na0 = ma0; na1 = ma1; nb00 = mb00; nb01 = mb01; nb10 = mb10; nb11 = mb11; nb20 = mb20; nb21 = mb21;
        }
        if (kh == 1) {
#pragma unroll
            for (int r = 0; r < 4; ++r) { part[r * 64 + lane] = acc0[r]; part[(4 + r) * 64 + lane] = acc1[r]; part[(8 + r) * 64 + lane] = acc2[r]; }
            part[12 * 64 + lane] = ssq;
        }
        __syncthreads();
        if (kh == 0) {
#pragma unroll
            for (int r = 0; r < 4; ++r) { acc0[r] += part[r * 64 + lane]; acc1[r] += part[(4 + r) * 64 + lane]; acc2[r] += part[(8 + r) * 64 + lane]; }
            ssq += part[12 * 64 + lane];
        ssq += shx(ssq, lane, 16); ssq += shx(ssq, lane, 32);
        const float rstd = 1.0f / sqrtf(ssq * (1.0f / DMODEL) + EPS_F);
#pragma unroll
        for (int r = 0; r < 4; ++r) { lg[(4 * g4 + r) * 52 + row] = acc0[r]; lg[(4 * g4 + r) * 52 + 16 + row] = acc1[r]; lg[(4 * g4 + r) * 52 + 32 + row] = acc2[r]; }
        asm volatile("s_waitcnt lgkmcnt(0)" ::: "memory");
        if (lane < 16) {
            const int t = tok0 + lane; const LAS float* lr = lg + lane * 52;
            float gl[4];
#pragma unroll
            for (int k = 0; k < 4; ++k) gl[k] = lr[k] * rstd + b_rg[k];
            int grp = 0; float gmx = gl[0];
#pragma unroll
            for (int k = 1; k < 4; ++k) if (gl[k] > gmx) { gmx = gl[k]; grp = k; }
            float gz = 0.f;
#pragma unroll
            for (int k = 0; k < 4; ++k) gz += __expf(gl[k] - gmx);
            const float p_grp = 1.0f / gz;
            float el[8];
#pragma unroll
            for (int k = 0; k < 8; ++k) el[k] = lr[4 + grp * 8 + k] * rstd + b_re[grp * 8 + k];
            int i1 = 0; float m1 = el[0];
#pragma unroll
            for (int k = 1; k < 8; ++k) if (el[k] > m1) { m1 = el[k]; i1 = k; }
            int i2 = -1; float m2 = -INFINITY;
#pragma unroll
            for (int k = 0; k < 8; ++k) if (k != i1 && el[k] > m2) { m2 = el[k]; i2 = k; }
            const float e2 = __expf(m2 - m1); const float den = 1.0f / (1.0f + e2);
            const float g1 = p_grp * den, g2 = p_grp * e2 * den;
            const int ex1 = grp * 8 + i1, ex2 = grp * 8 + i2;
            const unsigned r1 = atomicAdd(ctl + 64 * ex1, 1u), r2 = atomicAdd(ctl + 64 * ex2, 1u);
            asg_e[2 * t] = ex1; asg_e[2 * t + 1] = ex2; asg_r[2 * t] = (int)r1; asg_r[2 * t + 1] = (int)r2; asg_g[2 * t] = g1; asg_g[2 * t + 1] = g2;
            tok_rs[t] = rstd;
        }
        }
        __syncthreads();
    }
    for (int m = gw; m < T_TOK; m += 2 * NGW) {
        const int m1 = (m + NGW < T_TOK) ? m + NGW : m;
        const f32x4* xr0 = (const f32x4*)(x_in + (size_t)m * DMODEL) + lane; const f32x4* xr1 = (const f32x4*)(x_in + (size_t)m1 * DMODEL) + lane;
        const u32x2* dr0 = (const u32x2*)(OA + (size_t)m * DMODEL) + lane; const u32x2* dr1 = (const u32x2*)(OA + (size_t)m1 * DMODEL) + lane;
        f32x4 v0[8], v1[8]; u32x2 e0[8], e1[8];
#pragma unroll
        for (int j = 0; j < 8; ++j) { v0[j] = xr0[64 * j]; v1[j] = xr1[64 * j]; e0[j] = dr0[64 * j]; e1[j] = dr1[64 * j]; }
        u32x2* o0 = (u32x2*)(TN + (size_t)m * DMODEL) + lane; u32x2* o1 = (u32x2*)(TN + (size_t)m1 * DMODEL) + lane;
#pragma unroll
        for (int j = 0; j < 8; ++j) { const f32x4 gg = ((const f32x4*)g_ffn)[lane + 64 * j];
            u32x2 w; w.x = pkbf((v0[j][0] + bflo(e0[j].x)) * gg[0], (v0[j][1] + bfhi(e0[j].x)) * gg[1]); w.y = pkbf((v0[j][2] + bflo(e0[j].y)) * gg[2], (v0[j][3] + bfhi(e0[j].y)) * gg[3]); o0[64 * j] = w;
            u32x2 w2; w2.x = pkbf((v1[j][0] + bflo(e1[j].x)) * gg[0], (v1[j][1] + bfhi(e1[j].x)) * gg[1]); w2.y = pkbf((v1[j][2] + bflo(e1[j].y)) * gg[2], (v1[j][3] + bfhi(e1[j].y)) * gg[3]); o1[64 * j] = w2; }
    }
    }
    XBAR();
    STAMP(8);

    LAS int* tile_start = (LAS int*)(lds + LDS_MISC);
    {
    PH_LOCALS
    if (tid == 0) {
        int acc_t = 0;
        for (int e = 0; e < 32; ++e) { tile_start[e] = acc_t; const int c = (int)__hip_atomic_load(ctl + 64 * e, __ATOMIC_RELAXED, __HIP_MEMORY_SCOPE_AGENT); acc_t += (c + 255) >> 8; }
        tile_start[32] = acc_t;
    }
    __syncthreads();
    for (int a = gtid; a < 2 * T_TOK; a += NGT) {
        const int t = a >> 1; const int e = asg_e[a], rk = asg_r[a]; const int slot = tile_start[e] * 256 + rk;
        row_tok[slot] = t; row_gate[slot] = asg_g[a]; tok_slot[a] = slot; ((float*)(ws + WS_WC + 524288))[slot] = ((const float*)(ws + WS_WC + 786432))[t];
    }
    }
    XBAR();
    STAMP(9);

    {
        PH_LOCALS
        pg8::Gemm g{TN, WGU, MAXSLOT, 2048, 2048}; pg8::ExpertOrderT<true> S{tile_start, G, bx, row_tok};
        pg8::EpiSwiglu E{HMID, (const float*)(ws + WS_WC + 524288)};
        pg8::gemm_phase<pg8::EpiSwiglu, pg8::ExpertOrderT<true>, true, true>(lds, g, S, E, tid);
    }
    XBAR();
    STAMP(10);
    {
        PH_LOCALS
        pg8::Gemm g{HMID, WD, MAXSLOT, 2048, 1024}; pg8::ExpertOrderT<false> S{tile_start, G, bx, nullptr};
        pg8::EpiDown E{Y, row_gate};
        pg8::gemm_phase<pg8::EpiDown, pg8::ExpertOrderT<false>, true, true>(lds, g, S, E, tid);
    }
    XBAR();
    STAMP(11);
#if PROF_PHASE >= 0
    XBAR();
#endif

    {
    PH_LOCALS
    const float* g_fin = IN(16); const float* x_in = IN(0);
#if DBG_CMP
    const float dbg_scale = 1.0f + 4.0f * sqrtf(__hip_atomic_load((float*)(ctl + 4096), __ATOMIC_RELAXED, __HIP_MEMORY_SCOPE_AGENT) / __hip_atomic_load((float*)(ctl + 4097), __ATOMIC_RELAXED, __HIP_MEMORY_SCOPE_AGENT));
#elif PROF_PHASE >= 0 && (PROF_PHASE % 100) != 12
    const unsigned ta_ = __hip_atomic_load(ctl + 6000 + (PROF_PHASE / 100), __ATOMIC_RELAXED, __HIP_MEMORY_SCOPE_AGENT), tb_ = __hip_atomic_load(ctl + 6000 + (PROF_PHASE % 100), __ATOMIC_RELAXED, __HIP_MEMORY_SCOPE_AGENT);
    const float dbg_scale = 1.0f + sqrtf(PROF_SCALE * (float)(tb_ - ta_) * 0.01f);
#else
    const float dbg_scale = 1.0f;
#endif
    for (int t = gw; t < T_TOK; t += 2 * NGW) {
        const int t1 = (t + NGW < T_TOK) ? t + NGW : t;
        const int sa0 = tok_slot[2 * t], sa1 = tok_slot[2 * t + 1], sb0 = tok_slot[2 * t1], sb1 = tok_slot[2 * t1 + 1];
        f32x4* hra = (f32x4*)(out + (size_t)t * DMODEL) + lane; f32x4* hrb = (f32x4*)(out + (size_t)t1 * DMODEL) + lane;
        const f32x4* xa = (const f32x4*)(x_in + (size_t)t * DMODEL) + lane; const f32x4* xb = (const f32x4*)(x_in + (size_t)t1 * DMODEL) + lane;
        const u32x2* da = (const u32x2*)(OA + (size_t)t * DMODEL) + lane; const u32x2* db = (const u32x2*)(OA + (size_t)t1 * DMODEL) + lane;
        const u32x2* ya0 = (const u32x2*)(Y + (size_t)sa0 * DMODEL) + lane; const u32x2* ya1 = (const u32x2*)(Y + (size_t)sa1 * DMODEL) + lane;
        const u32x2* yb0 = (const u32x2*)(Y + (size_t)sb0 * DMODEL) + lane; const u32x2* yb1 = (const u32x2*)(Y + (size_t)sb1 * DMODEL) + lane;
        f32x4 va[8], vb[8]; u32x2 pa[8], qa[8], pb[8], qb[8], ea[8], eb[8];
#pragma unroll
        for (int j = 0; j < 8; ++j) { va[j] = __builtin_nontemporal_load(xa + 64 * j); vb[j] = __builtin_nontemporal_load(xb + 64 * j); ea[j] = __builtin_nontemporal_load(da + 64 * j); eb[j] = __builtin_nontemporal_load(db + 64 * j); pa[j] = __builtin_nontemporal_load(ya0 + 64 * j); qa[j] = __builtin_nontemporal_load(ya1 + 64 * j); pb[j] = __builtin_nontemporal_load(yb0 + 64 * j); qb[j] = __builtin_nontemporal_load(yb1 + 64 * j); }
        float ssa = 0.f, ssb = 0.f;
#pragma unroll
        for (int j = 0; j < 8; ++j) {
            va[j][0] += bflo(ea[j].x); va[j][1] += bfhi(ea[j].x); va[j][2] += bflo(ea[j].y); va[j][3] += bfhi(ea[j].y); vb[j][0] += bflo(eb[j].x); vb[j][1] += bfhi(eb[j].x); vb[j][2] += bflo(eb[j].y); vb[j][3] += bfhi(eb[j].y);
            va[j][0] += bflo(pa[j].x) + bflo(qa[j].x); va[j][1] += bfhi(pa[j].x) + bfhi(qa[j].x); va[j][2] += bflo(pa[j].y) + bflo(qa[j].y); va[j][3] += bfhi(pa[j].y) + bfhi(qa[j].y);
            vb[j][0] += bflo(pb[j].x) + bflo(qb[j].x); vb[j][1] += bfhi(pb[j].x) + bfhi(qb[j].x); vb[j][2] += bflo(pb[j].y) + bflo(qb[j].y); vb[j][3] += bfhi(pb[j].y) + bfhi(qb[j].y);
            ssa += (va[j][0] * va[j][0] + va[j][1] * va[j][1]) + (va[j][2] * va[j][2] + va[j][3] * va[j][3]);
            ssb += (vb[j][0] * vb[j][0] + vb[j][1] * vb[j][1]) + (vb[j][2] * vb[j][2] + vb[j][3] * vb[j][3]);
        }
        const float ra = dbg_scale / sqrtf(wave_sum(ssa, lane) * (1.0f / DMODEL) + EPS_F), rb = dbg_scale / sqrtf(wave_sum(ssb, lane) * (1.0f / DMODEL) + EPS_F);
#pragma unroll
        for (int j = 0; j < 8; ++j) { const f32x4 gg = ((const f32x4*)g_fin)[lane + 64 * j]; __builtin_nontemporal_store(va[j] * ra * gg, hra + 64 * j); if (t1 != t) __builtin_nontemporal_store(vb[j] * rb * gg, hrb + 64 * j); }
    }
    }
#if PROF_PHASE >= 0
    if (PROF_PHASE % 100 == 12) {
        XBAR(); STAMP(12); XBAR();
        PH_LOCALS
        const unsigned ta_ = __hip_atomic_load(ctl + 6000 + (PROF_PHASE / 100), __ATOMIC_RELAXED, __HIP_MEMORY_SCOPE_AGENT), tb_ = __hip_atomic_load(ctl + 6012, __ATOMIC_RELAXED, __HIP_MEMORY_SCOPE_AGENT);
        const float sc_ = 1.0f + sqrtf(PROF_SCALE * (float)(tb_ - ta_) * 0.01f);
        for (size_t i = (size_t)gtid; i < (size_t)T_TOK * DMODEL / 4; i += (size_t)NGT) { f32x4 v = ((f32x4*)out)[i]; ((f32x4*)out)[i] = v * sc_; }
    }
#endif
}

extern "C" void kernel_launch(void* const* d_in, const int* in_sizes, int n_in, void* d_out, int out_size, void* d_ws, size_t ws_size, hipStream_t stream) {
    static int grid_blocks = 0;
    if (grid_blocks == 0) {
        if (n_in != 17 || out_size != T_TOK * DMODEL || ws_size < WS_END) { fprintf(stderr, "kernel_launch: unexpected problem (n_in %d, out %d, ws %zu < %zu)\n", n_in, out_size, ws_size, (size_t)WS_END); grid_blocks = -1; return; }
        int dev = 0, cus = 0, per_cu = 0;
        (void)hipGetDevice(&dev);
        (void)hipDeviceGetAttribute(&cus, hipDeviceAttributeMultiprocessorCount, dev);
        if (hipFuncSetAttribute((const void*)mega_fwd, hipFuncAttributeMaxDynamicSharedMemorySize, LDS_BYTES) != hipSuccess) { fprintf(stderr, "kernel_launch: hipFuncSetAttribute failed\n"); grid_blocks = -1; return; }
        if (hipOccupancyMaxActiveBlocksPerMultiprocessor(&per_cu, (const void*)mega_fwd, 512, LDS_BYTES) != hipSuccess || per_cu < 1) { fprintf(stderr, "kernel_launch: occupancy query says %d\n", per_cu); grid_blocks = -1; return; }
        grid_blocks = cus;
        fprintf(stderr, "kernel_launch: cus %d per_cu %d grid %d ws %zu need %zu\n", cus, per_cu, grid_blocks, ws_size, (size_t)WS_END);
    }
    if (grid_blocks < 0) return;
    if (hipMemsetAsync((char*)d_ws + WS_CTL, 0, 65536, stream) != hipSuccess) { fprintf(stderr, "kernel_launch: memset of control words failed\n"); return; }
    Params prm{};
    for (int i = 0; i < 17; ++i) prm.in[i] = (const float*)d_in[i];
    prm.out = (float*)d_out; prm.ws = (unsigned char*)d_ws;
    void* args[] = {&prm};
    hipError_t e = hipLaunchCooperativeKernel((void*)mega_fwd, dim3(grid_blocks), dim3(512), args, LDS_BYTES, stream);
    if (e != hipSuccess) fprintf(stderr, "cooperative launch failed: %s (grid %d)\n", hipGetErrorString(e), grid_blocks);
}
```

```cpp
#include <hip/hip_runtime.h>
#include <hip/hip_cooperative_groups.h>
#include <cstdio>
#include <cstdint>
namespace cg = cooperative_groups;
namespace pg8 {
#define PG8_LAS __attribute__((address_space(3)))
typedef unsigned short bf16_t;
typedef short bf16x8 __attribute__((ext_vector_type(8)));
typedef float f32x4 __attribute__((ext_vector_type(4)));
typedef unsigned u32x4 __attribute__((ext_vector_type(4)));
constexpr int BM = 256, BK = 64, HALF = 128, HTB = HALF * BK * 2  , STAGE_BYTES = 8 * HTB, NXCD = 8, WGM = 8;

__host__ __device__ __forceinline__ int lds_byte(int r, int c) { const int st = (r >> 4) * 2 + (c >> 5), rr = r & 15, cc = c & 31, ob = rr * 64 + cc * 2; return st * 1024 + (ob ^ (((ob >> 9) & 1) << 5)); }
__host__ __device__ __forceinline__ void stage_rc(int b, int& R, int& C) { const int st = b / 1024, sb = b % 1024, swz = sb ^ (((sb >> 9) & 1) << 5); R = (st >> 1) * 16 + swz / 64; C = (st & 1) * 32 + (swz % 64) / 2; }
__host__ __device__ __forceinline__ int perm32(int rho) { const int n = rho >> 4, i = rho & 15; return 8 * (i >> 2) + 4 * n + (i & 3); }

struct Unit { int pm, pn, e; };
struct Gemm { const bf16_t* A; const bf16_t* Bt; int M, N, K; };

struct StaticOrder {
    int nM, nN, nwg, G, c;
    __host__ __device__ void init(int M, int N, int G_, int c_) { nM = M / BM; nN = N / BM; nwg = nM * nN; G = G_; c = c_; }
    __host__ __device__ bool next(int i, Unit& u) const {
        const long L = (long)i * G + c; if (L >= nwg) return false;
        int wgid = (int)L; { const int q = nwg / NXCD, r = nwg % NXCD, xcd = wgid % NXCD, off = wgid / NXCD; wgid = (xcd < r ? xcd * (q + 1) : r * (q + 1) + (xcd - r) * q) + off; }
        const int nig = WGM * nN, gid = wgid / nig, fm = gid * WGM, gsz = (nM - fm) < WGM ? (nM - fm) : WGM;
        u.pm = fm + ((wgid % nig) % gsz); u.pn = (wgid % nig) / gsz; u.e = 0; return true;
    }
    static constexpr bool GATHER = false;
    __device__ __forceinline__ unsigned rowoff(const Unit&, int) const { return 0u; }
    __device__ __forceinline__ void a_ready(const Unit&) const {}
    __device__ __forceinline__ void done(const Unit&) const {}
};

template <class Epi, class Sched, bool ALIGN_EPI = false, bool SP2 = false>
__device__ __forceinline__ void gemm_phase(PG8_LAS unsigned char* lds, const Gemm g, const Sched& S, const Epi& E, const int tid) {
    const int wid = __builtin_amdgcn_readfirstlane(tid >> 6), lane = tid & 63, wr = wid >> 2, wc = wid & 3, fr = lane & 15, fq = lane >> 4;
    const int K = g.K, nt = K / BK;
    constexpr bool GA = Sched::GATHER;
    static_assert(!GA || SP2, "the gather path is written for the SP2 loop");
    unsigned voffA[2], voffB[2]; int gR[2], gC[2];
#pragma unroll
    for (int i = 0; i < 2; ++i) { int R, C; stage_rc(tid * 16 + i * 8192, R, C); const int Rb = Epi::PERM ? ((R & ~31) + perm32(R & 31)) : R;
        voffA[i] = (unsigned)(R * K + C) * 2u; voffB[i] = (unsigned)(Rb * K + C) * 2u; gR[i] = R; gC[i] = C; }
    unsigned cvo0[2] = {0u, 0u}, cvo1[2] = {0u, 0u}, nvo0[2] = {0u, 0u}, nvo1[2] = {0u, 0u}, sel0[2] = {0u, 0u}, sel1[2] = {0u, 0u};
#define PG8_GOFF(u_, o0_, o1_) do { _Pragma("unroll") for (int _i = 0; _i < 2; ++_i) { \
        o0_[_i] = S.rowoff((u_), (u_).pm * BM + gR[_i]) * (unsigned)(K * 2) + (unsigned)gC[_i] * 2u; o1_[_i] = S.rowoff((u_), (u_).pm * BM + HALF + gR[_i]) * (unsigned)(K * 2) + (unsigned)gC[_i] * 2u; } } while (0)
#define PG8_STAGE_A(bufoff, base, h_, CUR_) do { if constexpr (GA) { if (CUR_) { if (h_) PG8_STAGE(bufoff, base, cvo1); else PG8_STAGE(bufoff, base, cvo0); } else { if (h_) PG8_STAGE(bufoff, base, sel1); else PG8_STAGE(bufoff, base, sel0); } } \
        else PG8_STAGE(bufoff, (base) + (h_) * hstep, voffA); } while (0)
    const size_t kstep = (size_t)(BK * 2);
    const size_t hstep = (size_t)HALF * K * 2;
    const size_t tstep = 2 * hstep;
    const unsigned ldsw = (unsigned)wid * 1024u;
    const int aoff = lds_byte(wr * 64 + fr, fq * 8), boff = lds_byte(wc * 32 + fr, fq * 8);
#define PG8_SA(b, h) (((b) * 2 + (h)) * HTB)
#define PG8_SB(b, h) ((4 + (b) * 2 + (h)) * HTB)
#define PG8_STAGE(bufoff, gbase, voff) do { _Pragma("unroll") for (int _i = 0; _i < 2; ++_i) \
        __builtin_amdgcn_global_load_lds((const unsigned*)((const char*)(gbase) + (voff)[_i]), (PG8_LAS unsigned*)(lds + (bufoff) + ldsw + _i * 8192), 16, 0, 0); } while (0)
#define PG8_LDA(dst, b, h) do { _Pragma("unroll") for (int m = 0; m < 4; ++m) _Pragma("unroll") for (int k = 0; k < 2; ++k) dst[m][k] = *(const PG8_LAS bf16x8*)(lds + PG8_SA(b, h) + aoff + m * 2048 + k * 1024); } while (0)
#define PG8_LDB(dst, b, h) do { _Pragma("unroll") for (int n = 0; n < 2; ++n) _Pragma("unroll") for (int k = 0; k < 2; ++k) dst[n][k] = *(const PG8_LAS bf16x8*)(lds + PG8_SB(b, h) + boff + n * 2048 + k * 1024); } while (0)
    typedef long pg8_l2 __attribute__((ext_vector_type(2))); typedef int pg8_i4 __attribute__((ext_vector_type(4))); typedef int pg8_i8 __attribute__((ext_vector_type(8)));
#define PG8_MMA(ai, bj, At, Bt) do { __builtin_amdgcn_s_setprio(1); _Pragma("unroll") for (int m = 0; m < 4; ++m) _Pragma("unroll") for (int n = 0; n < 2; ++n) _Pragma("unroll") for (int k = 0; k < 2; ++k) { \
        if constexpr (Epi::F8 && !Epi::F8S) { const pg8_l2 bv_ = __builtin_bit_cast(pg8_l2, Bt[n][k]), av_ = __builtin_bit_cast(pg8_l2, At[m][k]); \
            acc[ai][bj][m][n] = __builtin_amdgcn_mfma_f32_16x16x32_fp8_fp8(bv_[0], av_[0], acc[ai][bj][m][n], 0, 0, 0); acc[ai][bj][m][n] = __builtin_amdgcn_mfma_f32_16x16x32_fp8_fp8(bv_[1], av_[1], acc[ai][bj][m][n], 0, 0, 0); } \
        else if constexpr (Epi::F8) { if (k == 0) { const pg8_i4 b0_ = __builtin_bit_cast(pg8_i4, Bt[n][0]), b1_ = __builtin_bit_cast(pg8_i4, Bt[n][1]), a0_ = __builtin_bit_cast(pg8_i4, At[m][0]), a1_ = __builtin_bit_cast(pg8_i4, At[m][1]); \
            const pg8_i8 bv_ = {b0_[0], b0_[1], b0_[2], b0_[3], b1_[0], b1_[1], b1_[2], b1_[3]}, av_ = {a0_[0], a0_[1], a0_[2], a0_[3], a1_[0], a1_[1], a1_[2], a1_[3]}; \
            asm volatile("v_mfma_scale_f32_16x16x128_f8f6f4 %0, %1, %2, %0, %3, %3 op_sel_hi:[0,0,0]" : "+v"(acc[ai][bj][m][n]) : "v"(bv_), "v"(av_), "v"(scl1_)); } } \
        else acc[ai][bj][m][n] = __builtin_amdgcn_mfma_f32_16x16x32_bf16(Bt[n][k], At[m][k], acc[ai][bj][m][n], 0, 0, 0); } __builtin_amdgcn_s_setprio(0); } while (0)
    const int scl1_ = 127;
#define PG8_WAIT_V(n) asm volatile("s_waitcnt vmcnt(" #n ")" ::: "memory")
#define PG8_WAIT_L(n) asm volatile("s_waitcnt lgkmcnt(" #n ")" ::: "memory")
#define PG8_BAR __builtin_amdgcn_s_barrier()
#define PG8_SCHED __builtin_amdgcn_sched_barrier(0)
    Unit cur, nxt; int ui = 0;
    if (!S.next(0, cur)) return;
    f32x4 acc[2][2][4][2];
#pragma unroll
    for (int a = 0; a < 2; ++a)
#pragma unroll
        for (int b = 0; b < 2; ++b)
#pragma unroll
            for (int m = 0; m < 4; ++m)
#pragma unroll
                for (int n = 0; n < 2; ++n) acc[a][b][m][n] = (f32x4){0.f, 0.f, 0.f, 0.f};
    bf16x8 At[4][2], B0[2][2], B1[2][2];
    const size_t estep = (size_t)g.N * K * 2;
    const char* cA = (const char*)g.A + (GA ? (size_t)0 : (size_t)cur.pm * tstep); const char* cB = (const char*)g.Bt + (size_t)cur.e * estep + (size_t)cur.pn * tstep;
    S.a_ready(cur);
    if constexpr (GA) PG8_GOFF(cur, cvo0, cvo1);
    if constexpr (SP2) {
        PG8_STAGE(PG8_SB(0, 0), cB, voffB); PG8_STAGE(PG8_SB(0, 1), cB + hstep, voffB); PG8_STAGE_A(PG8_SA(0, 0), cA, 0, true); PG8_STAGE_A(PG8_SA(0, 1), cA, 1, true);
        if (wr == 1) PG8_BAR;
        PG8_WAIT_V(2); PG8_BAR;
        PG8_STAGE(PG8_SB(1, 0), cB + kstep, voffB); PG8_STAGE_A(PG8_SA(1, 0), cA + kstep, 0, true); PG8_STAGE(PG8_SB(1, 1), cB + hstep + kstep, voffB);
        PG8_WAIT_V(6); PG8_BAR;
    } else {
        PG8_STAGE(PG8_SB(0, 0), cB, voffB); PG8_STAGE(PG8_SA(0, 0), cA, voffA); PG8_STAGE(PG8_SB(0, 1), cB + hstep, voffB); PG8_STAGE(PG8_SA(0, 1), cA + hstep, voffA);
        if (wr == 1) PG8_BAR;
        PG8_WAIT_V(4); PG8_BAR;
        PG8_STAGE(PG8_SB(1, 0), cB + kstep, voffB); PG8_STAGE(PG8_SA(1, 0), cA + kstep, voffA); PG8_STAGE(PG8_SB(1, 1), cB + hstep + kstep, voffB);
        PG8_WAIT_V(6); PG8_BAR;
    }
    for (;;) {
        const bool has_next = S.next(ui + 1, nxt);
        const char* nA = has_next ? (const char*)g.A + (GA ? (size_t)0 : (size_t)nxt.pm * tstep) : cA;
        if constexpr (GA) { if (has_next) PG8_GOFF(nxt, nvo0, nvo1); else { nvo0[0] = cvo0[0]; nvo0[1] = cvo0[1]; nvo1[0] = cvo1[0]; nvo1[1] = cvo1[1]; } } const char* nB = has_next ? (const char*)g.Bt + (size_t)nxt.e * estep + (size_t)nxt.pn * tstep : cB;
        for (int t = 0; t < nt; t += 2) {
            const bool last = (t == nt - 2);
            const char* a1 = cA + (size_t)(t + 1) * kstep;
            const char* a2 = last ? nA : cA + (size_t)(t + 2) * kstep; const char* b2 = last ? nB : cB + (size_t)(t + 2) * kstep;
            const char* a3 = a2 + kstep; const char* b3 = b2 + kstep;
            if (last && has_next) S.a_ready(nxt);
            if constexpr (GA) { sel0[0] = last ? nvo0[0] : cvo0[0]; sel0[1] = last ? nvo0[1] : cvo0[1]; sel1[0] = last ? nvo1[0] : cvo1[0]; sel1[1] = last ? nvo1[1] : cvo1[1]; }
            if constexpr (Epi::HAS_MID) { if (t == nt / 2) E.mid(acc, cur, wr, wc, fr, fq); }
            if constexpr (SP2) {
            PG8_LDB(B0, 0, 0); PG8_LDB(B1, 0, 1); PG8_SCHED; PG8_LDA(At, 0, 0); PG8_STAGE_A(PG8_SA(1, 1), a1, 1, true);
            PG8_WAIT_V(8); PG8_WAIT_L(0); PG8_BAR; PG8_MMA(0, 0, At, B0); PG8_MMA(0, 1, At, B1); PG8_BAR; PG8_SCHED;
            PG8_LDA(At, 0, 1); PG8_STAGE(PG8_SB(0, 0), b2, voffB); PG8_STAGE(PG8_SB(0, 1), b2 + hstep, voffB); PG8_STAGE_A(PG8_SA(0, 0), a2, 0, false);
            PG8_WAIT_V(8); PG8_WAIT_L(0); PG8_BAR; PG8_MMA(1, 0, At, B0); PG8_MMA(1, 1, At, B1); PG8_BAR; PG8_SCHED;
            PG8_LDB(B0, 1, 0); PG8_LDB(B1, 1, 1); PG8_SCHED; PG8_LDA(At, 1, 0); PG8_STAGE_A(PG8_SA(0, 1), a2, 1, false);
            PG8_WAIT_V(8); PG8_WAIT_L(0); PG8_BAR; PG8_MMA(0, 0, At, B0); PG8_MMA(0, 1, At, B1); PG8_BAR; PG8_SCHED;
            PG8_LDA(At, 1, 1); PG8_STAGE(PG8_SB(1, 0), b3, voffB); PG8_STAGE(PG8_SB(1, 1), b3 + hstep, voffB); PG8_STAGE_A(PG8_SA(1, 0), a3, 0, false);
            PG8_WAIT_V(8); PG8_WAIT_L(0); PG8_BAR; PG8_MMA(1, 0, At, B0); PG8_MMA(1, 1, At, B1); PG8_BAR; PG8_SCHED;
            } else {
            PG8_LDB(B0, 0, 0); PG8_SCHED; PG8_LDA(At, 0, 0); PG8_STAGE(PG8_SA(1, 1), a1 + hstep, voffA);
            PG8_WAIT_L(8); PG8_BAR; PG8_WAIT_L(0); PG8_MMA(0, 0, At, B0); PG8_BAR; PG8_SCHED;
            PG8_LDB(B1, 0, 1); PG8_STAGE(PG8_SB(0, 0), b2, voffB);
            PG8_BAR; PG8_WAIT_L(0); PG8_MMA(0, 1, At, B1); PG8_BAR;
            PG8_LDA(At, 0, 1); PG8_STAGE(PG8_SA(0, 0), a2, voffA);
            PG8_BAR; PG8_WAIT_L(0); PG8_MMA(1, 0, At, B0); PG8_BAR; PG8_SCHED;
            PG8_STAGE(PG8_SB(0, 1), b2 + hstep, voffB);
            PG8_WAIT_V(6); PG8_BAR; PG8_MMA(1, 1, At, B1); PG8_BAR;
            PG8_LDB(B0, 1, 0); PG8_SCHED; PG8_LDA(At, 1, 0); PG8_STAGE(PG8_SA(0, 1), a2 + hstep, voffA);
            PG8_WAIT_L(8); PG8_BAR; PG8_WAIT_L(0); PG8_MMA(0, 0, At, B0); PG8_BAR; PG8_SCHED;
            PG8_LDB(B1, 1, 1); PG8_STAGE(PG8_SB(1, 0), b3, voffB);
            PG8_BAR; PG8_WAIT_L(0); PG8_MMA(0, 1, At, B1); PG8_BAR;
            PG8_LDA(At, 1, 1); PG8_STAGE(PG8_SA(1, 0), a3, voffA);
            PG8_BAR; PG8_WAIT_L(0); PG8_MMA(1, 0, At, B0); PG8_BAR; PG8_SCHED;
            PG8_STAGE(PG8_SB(1, 1), b3 + hstep, voffB);
            PG8_WAIT_V(6); PG8_BAR; PG8_MMA(1, 1, At, B1); PG8_BAR;
            }
        }
        if constexpr (ALIGN_EPI) { if (wr == 0) PG8_BAR; }
        if constexpr (Epi::F8S) { PG8_SCHED; asm volatile("s_nop 15\n\ts_nop 15" ::: "memory"); PG8_SCHED; }
        if constexpr (!Epi::AFTER_DRAIN) { E(acc, cur, wr, wc, fr, fq); S.done(cur); }
        if (!has_next) break;
#pragma unroll
        for (int a = 0; a < 2; ++a)
#pragma unroll
            for (int b = 0; b < 2; ++b)
#pragma unroll
                for (int m = 0; m < 4; ++m)
#pragma unroll
                    for (int n = 0; n < 2; ++n) acc[a][b][m][n] = (f32x4){0.f, 0.f, 0.f, 0.f};
        cur = nxt; cA = nA; cB = nB; ++ui;
        if constexpr (GA) { cvo0[0] = nvo0[0]; cvo0[1] = nvo0[1]; cvo1[0] = nvo1[0]; cvo1[1] = nvo1[1]; }
        if constexpr (ALIGN_EPI) { if (wr == 1) PG8_BAR; }
    }
    PG8_WAIT_V(0);
    if constexpr (!ALIGN_EPI) { if (wr == 0) PG8_BAR; }
    PG8_BAR;
    if constexpr (Epi::AFTER_DRAIN) { E.fused(acc, cur, wr, wc, fr, fq, lds, wid, lane); S.done(cur); }
#undef PG8_SA
#undef PG8_SB
#undef PG8_STAGE
#undef PG8_STAGE_A
#undef PG8_GOFF
#undef PG8_LDA
#undef PG8_LDB
#undef PG8_MMA
#undef PG8_WAIT_V
#undef PG8_WAIT_L
#undef PG8_BAR
#undef PG8_SCHED
}
}

#ifndef DBG_CMP
#define DBG_CMP 0
#endif
#define LAS __attribute__((address_space(3)))
typedef unsigned short bf16_t;
typedef float f32x4 __attribute__((ext_vector_type(4)));
typedef unsigned u32x4 __attribute__((ext_vector_type(4)));
typedef unsigned u32x2 __attribute__((ext_vector_type(2)));
typedef unsigned long long u64;

constexpr int T_TOK = 16384, DMODEL = 2048, SEQL = 2048;
constexpr int NPROJ = 9984;
constexpr int C_QLAT = 0, C_CKV = 1024, C_QIDX = 1152, C_KIDX = 1664, C_WIDX = 1728, C_QR = 1792, C_KR = 2816, C_VR = 3840, C_GR = 4864, C_GBR = 5888;
#ifndef F8S_UP
#define F8S_UP 1
#endif
#ifndef F8S_DOWN
#define F8S_DOWN 1
#endif
#ifndef EARLY2
#define EARLY2 1
#endif
constexpr int MAXSLOT = 40960;
constexpr float EPS_F = 1e-6f;
constexpr float IDX_SCALE = 0.04419417382415922f;
constexpr float ATT_SCALE = 0.08838834764831845f;
constexpr float K_SCALE = 0.08838834764831845f;

constexpr size_t WS_CTL = 0;
constexpr size_t WS_ROT = 65536;
constexpr size_t WS_WIN = WS_ROT + 1048576;
constexpr size_t WS_WCOMB = WS_WIN + (size_t)NPROJ * 2048 * 2;
constexpr size_t WS_WB = WS_WCOMB + (size_t)2048 * 1024 * 2;
constexpr size_t WS_WO = WS_WB + (size_t)2048 * 1024 * 2;
constexpr size_t WS_WGU = WS_WO + (size_t)2048 * 2048 * 2;
constexpr size_t WS_WD = WS_WGU + (size_t)32 * 2048 * 2048 * 2;
constexpr size_t WS_P = WS_WD + (size_t)32 * 2048 * 1024 * 2;
constexpr size_t WS_HMID = WS_P;
constexpr size_t WS_Y = WS_HMID + (size_t)MAXSLOT * 1024 * 2;
constexpr size_t WS_XN = WS_P + (size_t)T_TOK * NPROJ * 2;
constexpr size_t WS_OA = WS_XN + (size_t)T_TOK * 2048 * 2;
constexpr size_t WS_OB = WS_OA + (size_t)T_TOK * 1024 * 2;
constexpr size_t WS_MIXED = WS_OB + (size_t)T_TOK * 1024 * 2;
constexpr size_t WS_SPARE = WS_MIXED + (size_t)T_TOK * 2048 * 2;
constexpr size_t WS_XG = WS_OA;
constexpr size_t WS_KV = WS_SPARE + (size_t)T_TOK * 1024 * 2;
constexpr size_t WS_MASK = WS_KV + (size_t)T_TOK * 128 * 2;
constexpr size_t WS_MISC = WS_MASK + (size_t)T_TOK * 256;
constexpr size_t WS_WC = WS_MISC + 1048576;
constexpr size_t WS_END = WS_WC + 1048576;
static_assert(WS_Y + (size_t)MAXSLOT * 2048 * 2 <= WS_XN, "HMID + Y must fit in P");
static_assert(WS_XG + (size_t)MAXSLOT * 2048 * 2 <= WS_KV, "XG must fit in OA..SPARE");
static_assert(WS_END <= (size_t)1073741824, "workspace budget");
constexpr int MI_ROWTOK = 0, MI_ROWGATE = MAXSLOT, MI_TOKSLOT = 2 * MAXSLOT, MI_ASGE = MI_TOKSLOT + 2 * T_TOK, MI_ASGR = MI_ASGE + 2 * T_TOK, MI_ASGG = MI_ASGR + 2 * T_TOK;
static_assert((size_t)(MI_ASGG + 2 * T_TOK) * 4 <= 1048576, "misc budget");
constexpr int LDS_BYTES = 152 * 1024;
constexpr int LDS_MISC = 150 * 1024;

__device__ __forceinline__ float bflo(unsigned w) { return __uint_as_float(w << 16); }
__device__ __forceinline__ float bfhi(unsigned w) { return __uint_as_float(w & 0xffff0000u); }
__device__ __forceinline__ unsigned pkbf(float lo, float hi) { unsigned r; asm volatile("v_cvt_pk_bf16_f32 %0, %1, %2" : "=v"(r) : "v"(lo), "v"(hi)); return r; }
__device__ __forceinline__ int hide_i(int v) { asm volatile("" : "+v"(v)); return v; }
template <class Tp> __device__ __forceinline__ Tp* hide_p(Tp* q) { long long z = 0; asm volatile("" : "+s"(z)); return (Tp*)((char*)q + z); }
template <int N> struct IdxIC { static constexpr int value = N; };
__device__ __forceinline__ int wave_prefix_incl(int v) {
    v += __builtin_amdgcn_update_dpp(0, v, 0x111, 0xf, 0xf, false);
    v += __builtin_amdgcn_update_dpp(0, v, 0x112, 0xf, 0xf, false);
    v += __builtin_amdgcn_update_dpp(0, v, 0x114, 0xf, 0xf, false);
    v += __builtin_amdgcn_update_dpp(0, v, 0x118, 0xf, 0xf, false);
    v += __builtin_amdgcn_update_dpp(0, v, 0x142, 0xa, 0xf, false);
    v += __builtin_amdgcn_update_dpp(0, v, 0x143, 0xc, 0xf, false);
    return v;
}
__device__ __forceinline__ float shx(float v, int lane, int o) { return __int_as_float(__builtin_amdgcn_ds_bpermute((lane ^ o) << 2, __float_as_int(v))); }
__device__ __forceinline__ float wave_sum(float v, int lane) {
#pragma unroll
    for (int o = 1; o < 64; o <<= 1) v += shx(v, lane, o);
    return v;
}
__device__ __forceinline__ float wave_max(float v, int lane) {
#pragma unroll
    for (int o = 1; o < 64; o <<= 1) v = fmaxf(v, shx(v, lane, o));
    return v;
}
__device__ __forceinline__ float sigmoidf_(float x) { return __builtin_amdgcn_rcpf(1.0f + __expf(-x)); }
__device__ __forceinline__ float siluf_(float x) { return x * sigmoidf_(x); }
__device__ __forceinline__ unsigned pk4f8(float a, float b, float c, float d) { int w = __builtin_amdgcn_cvt_pk_fp8_f32(a, b, 0, false); w = __builtin_amdgcn_cvt_pk_fp8_f32(c, d, w, true); return (unsigned)w; }
constexpr float W8_SCALE = 256.0f, W8_INV = 1.0f / 256.0f;
__device__ __forceinline__ float unkey(unsigned k) { return __uint_as_float((k & 0x80000000u) ? (k & 0x7fffffffu) : ~k); }
__device__ __forceinline__ int sbin(float s) { const int b = (int)(s * 32.0f + 128.0f); return b < 0 ? 0 : (b > 255 ? 255 : b); }
__device__ __forceinline__ unsigned fkey(float f) { const unsigned u = __float_as_uint(f + 0.0f); return (u & 0x80000000u) ? ~u : (u | 0x80000000u); }


#define XB_TMO      128
#define XB_XCNT(j)  (256  + 64 * (j))
#define XB_XSUB(j)  (1280 + 64 * (j))
#define XB_XGEN(j)  (2304 + 64 * (j))
#define XB_TOP      3328
#define XB_TOPGEN   3392
#define XCD_BAR_WORDS 3456
#define XB_SPIN_CAP (1u << 18)
__device__ __forceinline__ unsigned xb_ld(unsigned* p)              { return __hip_atomic_load(p, __ATOMIC_RELAXED, __HIP_MEMORY_SCOPE_AGENT); }
__device__ __forceinline__ unsigned xb_add(unsigned* p, unsigned v) { return __hip_atomic_fetch_add(p, v, __ATOMIC_RELAXED, __HIP_MEMORY_SCOPE_AGENT); }
__device__ __forceinline__ unsigned xb_xcc_id() { return (unsigned)__builtin_amdgcn_s_getreg((3 << 11) | 20) & 0xFu; }
#define XB_SPIN(cond, bar) do { unsigned _sp = 0; while (cond) { __builtin_amdgcn_s_sleep(1); \
    if ((++_sp & 255u) == 0u) { if (xb_ld(&(bar)[XB_TMO])) break; if (_sp > XB_SPIN_CAP) { atomicAdd(&(bar)[XB_TMO], 1u); break; } } } } while (0)
struct XcdBarrier { unsigned* bar; unsigned x; volatile __attribute__((address_space(3))) unsigned* st; };
__device__ __forceinline__ void xcd_barrier_complete(unsigned* bar, unsigned x, unsigned& nloc, unsigned& nx) {
    const unsigned G = gridDim.x * gridDim.y * gridDim.z;
    unsigned sum, cnt, mine, sp = 0u;
    for (;;) {
        sum = 0u; cnt = 0u; mine = 0u;
#pragma unroll
        for (unsigned j = 0; j < 16; ++j) { const unsigned c = xb_ld(&bar[XB_XCNT(j)]); sum += c; cnt += (c > 0u) ? 1u : 0u; mine = (j == x) ? c : mine; }
        if (sum == G) break;
        __builtin_amdgcn_s_sleep(1);
        if ((++sp & 255u) == 0u) { if (xb_ld(&bar[XB_TMO])) break; if (sp > XB_SPIN_CAP) { atomicAdd(&bar[XB_TMO], 1u); break; } }
    }
    nloc = mine > 0u ? mine : 1u; nx = cnt > 0u ? cnt : 1u;
}
__device__ __forceinline__ void xcd_barrier(const XcdBarrier& b, int tid) {
    asm volatile("s_waitcnt vmcnt(0)" ::: "memory");
    __syncthreads();
    if (tid == 0) {
        unsigned* bar = b.bar;
        __builtin_amdgcn_s_waitcnt(0);
        unsigned nloc = b.st[0], nx = b.st[1];
        if (nloc == 0u) { xcd_barrier_complete(bar, b.x, nloc, nx); b.st[0] = nloc; b.st[1] = nx; }
        const unsigned old = xb_add(&bar[XB_XSUB(b.x)], 1u);
        const unsigned gen = old / nloc;
        if (old + 1u == (gen + 1u) * nloc) {
            __builtin_amdgcn_fence(__ATOMIC_RELEASE, "agent");
            asm volatile("s_waitcnt vmcnt(0)" ::: "memory");
            const unsigned og = xb_add(&bar[XB_TOP], 1u);
            const unsigned tg = og / nx;
            if (og + 1u == (tg + 1u) * nx) xb_add(&bar[XB_TOPGEN], 1u);
            else XB_SPIN(xb_ld(&bar[XB_TOPGEN]) == tg, bar);
            __builtin_amdgcn_fence(__ATOMIC_ACQUIRE, "agent");
            xb_add(&bar[XB_XGEN(b.x)], 1u);
            asm volatile("s_waitcnt vmcnt(0)" ::: "memory");
        } else {
            XB_SPIN(xb_ld(&bar[XB_XGEN(b.x)]) == gen, bar);
            __builtin_amdgcn_fence(__ATOMIC_ACQUIRE, "agent");
            asm volatile("s_waitcnt vmcnt(0)" ::: "memory");
        }
    }
    __syncthreads();
}

__device__ __forceinline__ void split_arrive(const XcdBarrier& b, unsigned* word, int tid) {
    asm volatile("s_waitcnt vmcnt(0)" ::: "memory");
    __syncthreads();
    if (tid == 0) {
        __builtin_amdgcn_fence(__ATOMIC_RELEASE, "agent");
        asm volatile("s_waitcnt vmcnt(0)" ::: "memory");
        xb_add(word, 1u);
    }
}
__device__ __forceinline__ void split_wait(const XcdBarrier& b, unsigned* word, int tid) {
    if (tid == 0) {
        const unsigned G = gridDim.x * gridDim.y * gridDim.z;
        XB_SPIN(xb_ld(word) < G, b.bar);
        __builtin_amdgcn_fence(__ATOMIC_ACQUIRE, "agent");
        asm volatile("s_waitcnt vmcnt(0)" ::: "memory");
    }
    __syncthreads();
}

namespace fa {
using bf16x8 = __attribute__((ext_vector_type(8))) short;
using s16x4  = __attribute__((ext_vector_type(4))) short;
using f32x16 = __attribute__((ext_vector_type(16))) float;
constexpr int TILE_B = 64 * 128 * 2;
constexpr int OFF_V = 0, OFF_K = 2 * TILE_B, OFF_M = 4 * TILE_B, OFF_WS = OFF_M + 2 * 256, OFF_Q = OFF_WS + 8 * 256, LDS_NEED = OFF_Q + 8 * 8704;
#define FA_GAS __attribute__((address_space(1)))
#define FA_KSWZ(row, colB) ((row) * 256 + ((colB) ^ (((row) & 7) << 4)))
#define FA_SBAR() __builtin_amdgcn_sched_barrier(0)
__device__ __forceinline__ int crow(int r, int hi) { return (r & 3) + 8 * (r >> 2) + 4 * hi; }
__device__ __forceinline__ int v_st(int k, int c) { const int kk = (k & ~0xC) | ((k & 4) << 1) | ((k & 8) >> 1); return ((kk >> 3) * 4 + (c >> 5)) * 512 + ((kk & 7) * 32 + (c & 31)) * 2; }
__device__ __forceinline__ int v_rd_base(int lane) { return ((lane & 3) << 3) | (((lane >> 2) & 3) << 6) | (((lane >> 4) & 1) << 5) | (((lane >> 5) & 1) << 8); }
constexpr int v_rd_off(int d0, int ks, int half) { return d0 * 512 + ks * 4096 + half * 2048; }
template <int OFF> __device__ __forceinline__ s16x4 tr_read(int vb) { s16x4 r; asm volatile("ds_read_b64_tr_b16 %0, %1 offset:%2" : "=&v"(r) : "v"(vb), "i"(OFF) : "memory"); return r; }
template <int D0> __device__ __forceinline__ void pv_one(f32x16& od, int vb, bf16x8 pa0, bf16x8 pa1, bf16x8 pa2, bf16x8 pa3) {
    const s16x4 l0 = tr_read<v_rd_off(D0, 0, 0)>(vb), h0 = tr_read<v_rd_off(D0, 0, 1)>(vb), l1 = tr_read<v_rd_off(D0, 1, 0)>(vb), h1 = tr_read<v_rd_off(D0, 1, 1)>(vb);
    const s16x4 l2 = tr_read<v_rd_off(D0, 2, 0)>(vb), h2 = tr_read<v_rd_off(D0, 2, 1)>(vb), l3 = tr_read<v_rd_off(D0, 3, 0)>(vb), h3 = tr_read<v_rd_off(D0, 3, 1)>(vb);
    asm volatile("s_waitcnt lgkmcnt(0)" ::: "memory"); FA_SBAR();
#define FA_PK(L, H) (bf16x8){L[0], L[1], L[2], L[3], H[0], H[1], H[2], H[3]}
    od = __builtin_amdgcn_mfma_f32_32x32x16_bf16(pa0, FA_PK(l0, h0), od, 0, 0, 0);
    od = __builtin_amdgcn_mfma_f32_32x32x16_bf16(pa1, FA_PK(l1, h1), od, 0, 0, 0);
    od = __builtin_amdgcn_mfma_f32_32x32x16_bf16(pa2, FA_PK(l2, h2), od, 0, 0, 0);
    od = __builtin_amdgcn_mfma_f32_32x32x16_bf16(pa3, FA_PK(l3, h3), od, 0, 0, 0);
#undef FA_PK
}
#define FA_RD8(D0, l0, h0, l1, h1, l2, h2, l3, h3) do { l0 = tr_read<v_rd_off(D0, 0, 0)>(vb); h0 = tr_read<v_rd_off(D0, 0, 1)>(vb); l1 = tr_read<v_rd_off(D0, 1, 0)>(vb); h1 = tr_read<v_rd_off(D0, 1, 1)>(vb); \
        l2 = tr_read<v_rd_off(D0, 2, 0)>(vb); h2 = tr_read<v_rd_off(D0, 2, 1)>(vb); l3 = tr_read<v_rd_off(D0, 3, 0)>(vb); h3 = tr_read<v_rd_off(D0, 3, 1)>(vb); } while (0)
#define FA_PK(L, H) (bf16x8){L[0], L[1], L[2], L[3], H[0], H[1], H[2], H[3]}
#define FA_MM4(od, l0, h0, l1, h1, l2, h2, l3, h3) do { od = __builtin_amdgcn_mfma_f32_32x32x16_bf16(pa0, FA_PK(l0, h0), od, 0, 0, 0); od = __builtin_amdgcn_mfma_f32_32x32x16_bf16(pa1, FA_PK(l1, h1), od, 0, 0, 0); \
        od = __builtin_amdgcn_mfma_f32_32x32x16_bf16(pa2, FA_PK(l2, h2), od, 0, 0, 0); od = __builtin_amdgcn_mfma_f32_32x32x16_bf16(pa3, FA_PK(l3, h3), od, 0, 0, 0); } while (0)
__device__ __forceinline__ void pv_all(f32x16 (&o)[4], int vb, bf16x8 pa0, bf16x8 pa1, bf16x8 pa2, bf16x8 pa3) {
    s16x4 a0, a1, a2, a3, a4, a5, a6, a7, b0, b1, b2, b3, b4, b5, b6, b7;
    FA_RD8(0, a0, a1, a2, a3, a4, a5, a6, a7);
    FA_RD8(1, b0, b1, b2, b3, b4, b5, b6, b7);
    asm volatile("s_waitcnt lgkmcnt(8)" ::: "memory"); FA_SBAR();
    FA_MM4(o[0], a0, a1, a2, a3, a4, a5, a6, a7); FA_SBAR();
    FA_RD8(2, a0, a1, a2, a3, a4, a5, a6, a7);
    asm volatile("s_waitcnt lgkmcnt(8)" ::: "memory"); FA_SBAR();
    FA_MM4(o[1], b0, b1, b2, b3, b4, b5, b6, b7); FA_SBAR();
    FA_RD8(3, b0, b1, b2, b3, b4, b5, b6, b7);
    asm volatile("s_waitcnt lgkmcnt(8)" ::: "memory"); FA_SBAR();
    FA_MM4(o[2], a0, a1, a2, a3, a4, a5, a6, a7); FA_SBAR();
    asm volatile("s_waitcnt lgkmcnt(0)" ::: "memory"); FA_SBAR();
    FA_MM4(o[3], b0, b1, b2, b3, b4, b5, b6, b7);
}
#undef FA_RD8
#undef FA_MM4
#undef FA_PK
template <bool QLDS>
__device__ __forceinline__ void qkt(f32x16& p0, f32x16& p1, const LAS char* Ks, const bf16x8 (&qr)[8], const LAS char* Ql, int r32, int hi) {
    p0 = f32x16{}; p1 = f32x16{};
#pragma unroll
    for (int d0 = 0; d0 < 8; ++d0) { const int cb = (d0 * 16 + hi * 8) * 2;
        const bf16x8 b0 = *(const LAS bf16x8*)(Ks + FA_KSWZ(r32, cb));
        const bf16x8 b1 = *(const LAS bf16x8*)(Ks + FA_KSWZ(32 + r32, cb));
        const bf16x8 q = QLDS ? *(const LAS bf16x8*)(Ql + d0 * 1024) : qr[d0];
        p0 = __builtin_amdgcn_mfma_f32_32x32x16_bf16(b0, q, p0, 0, 0, 0);
        p1 = __builtin_amdgcn_mfma_f32_32x32x16_bf16(b1, q, p1, 0, 0, 0); }
}
__device__ __forceinline__ void p_to_frag(const f32x16& p0, const f32x16& p1, bf16x8& pa0, bf16x8& pa1, bf16x8& pa2, bf16x8& pa3) {
#define FA_PK4(P, BASE, OUT) do { unsigned a0 = pkbf(P[BASE + 0], P[BASE + 1]), a1 = pkbf(P[BASE + 2], P[BASE + 3]);   \
    unsigned b0 = pkbf(P[BASE + 4], P[BASE + 5]), b1 = pkbf(P[BASE + 6], P[BASE + 7]);                              \
    auto r0 = __builtin_amdgcn_permlane32_swap(a0, b0, false, false); auto r1 = __builtin_amdgcn_permlane32_swap(a1, b1, false, false); \
    u32x4 w = {r0[0], r1[0], r0[1], r1[1]}; OUT = *reinterpret_cast<bf16x8*>(&w); } while (0)
    FA_PK4(p0, 0, pa0); FA_PK4(p0, 8, pa1); FA_PK4(p1, 0, pa2); FA_PK4(p1, 8, pa3);
#undef FA_PK4
}

struct UnitArgs {
    const bf16_t* Q; int ldq;
    const bf16_t* K; const bf16_t* V; int ldk;
    const u64* mask;
    int ntiles;
    int n0;
    float lgam;
};

template <int MODE, int EXP = 0, bool STATE = false>
__device__ __forceinline__ void unit_body(LAS char* L, const UnitArgs& U, int tid, f32x16 (&o)[4], float& l_out) {
    const int wid = __builtin_amdgcn_readfirstlane(tid >> 6), lane = tid & 63, r32 = lane & 31, hi = lane >> 5;
    LAS char* V_lds = L + OFF_V; LAS char* K_lds = L + OFF_K; LAS u64* M_lds = (LAS u64*)(L + OFF_M);
    LAS float* wsf = (LAS float*)(L + OFF_WS) + wid * 64; LAS float* al_l = wsf + 32;
    constexpr float C = ATT_SCALE * 1.4426950408889634f;
    float m_reg = -1e30f, l_reg = 0.f;
    bf16x8 qr[8];
    LAS char* Ql = L + OFF_Q + wid * 8192 + lane * 16;
    { const FA_GAS bf16_t* Qh = (const FA_GAS bf16_t*)hide_p(U.Q); const FA_GAS bf16_t* Qw = (MODE == 0) ? Qh + (size_t)r32 * U.ldq + wid * 128 + hi * 8 : Qh + (size_t)(wid * 32 + r32) * U.ldq + hi * 8;
#pragma unroll
      for (int d0 = 0; d0 < 8; ++d0) { qr[d0] = *(const FA_GAS bf16x8*)(Qw + d0 * 16); if (MODE == 1) *(LAS bf16x8*)(Ql + d0 * 1024) = qr[d0]; } }
    if (MODE == 1) { asm volatile("s_waitcnt vmcnt(0) lgkmcnt(0)" ::: "memory"); FA_SBAR(); }
    const int sr = tid >> 4, sc = (tid & 15) * 8, vst0 = v_st(sr, sc), vst1 = v_st(32 + sr, sc), kst0 = FA_KSWZ(sr, sc * 2), kst1 = FA_KSWZ(32 + sr, sc * 2);
    const FA_GAS char* Kh = (const FA_GAS char*)hide_p(U.K); const FA_GAS char* Vh = (const FA_GAS char*)hide_p(U.V);
    const int ldk_ = (EXP & 4) ? 128 : U.ldk;
    const unsigned goff0 = (unsigned)(sr * ldk_ + sc) * 2u, goff1 = (unsigned)((32 + sr) * ldk_ + sc) * 2u;
    const int vb0 = (int)(unsigned)(size_t)V_lds + v_rd_base(lane);
    bf16x8 ksA0, ksA1, vsA0, vsA1; u64 mwA = 0ull; unsigned pf_ = 0u;
#define FA_SLOAD(S, k0) do { const FA_GAS char* kb_ = Kh + (size_t)(k0) * ldk_ * 2; const FA_GAS char* vb_ = Vh + (size_t)(k0) * ldk_ * 2;     \
        ks##S##0 = *(const FA_GAS bf16x8*)(kb_ + goff0); ks##S##1 = *(const FA_GAS bf16x8*)(kb_ + goff1); \
        if (MODE == 1) { if (EXP & 2) { vs##S##0 = ks##S##0; vs##S##1 = ks##S##1; } else { vs##S##0 = *(const FA_GAS bf16x8*)(vb_ + goff0); vs##S##1 = *(const FA_GAS bf16x8*)(vb_ + goff1); } } \
        if (MODE == 0 && tid < 32) mw##S = U.mask[(size_t)tid * 32 + ((k0) >> 6)]; } while (0)
#define FA_SWRITE(S, b) do { *(LAS bf16x8*)(K_lds + (b) * TILE_B + kst0) = ks##S##0; *(LAS bf16x8*)(K_lds + (b) * TILE_B + kst1) = ks##S##1; \
        *(LAS bf16x8*)(V_lds + (b) * TILE_B + vst0) = (MODE == 1) ? vs##S##0 : ks##S##0; *(LAS bf16x8*)(V_lds + (b) * TILE_B + vst1) = (MODE == 1) ? vs##S##1 : ks##S##1; \
        if (MODE == 0 && tid < 32) M_lds[(b) * 32 + tid] = mw##S; } while (0)
#define FA_TOUCH(k0) do { if (MODE == 1 && !(EXP & 16) && tid < 256) { const FA_GAS char* tb_ = ((tid < 128) ? Kh : Vh) + (size_t)((k0) + ((tid & 127) >> 1)) * ldk_ * 2 + (tid & 1) * 128; \
        asm volatile("global_load_dword %0, %1, off" : "=v"(pf_) : "v"(tb_) : "memory"); } } while (0)
#define FA_TILE(j, b) do { \
        f32x16 p0, p1; bf16x8 pa0, pa1, pa2, pa3; \
        { const LAS char* qb_ = Ql; asm volatile("" : "+v"(qb_)); qkt<MODE == 1>(p0, p1, K_lds + (b) * TILE_B, qr, qb_, r32, hi); } \
        if (MODE == 0) { \
            const u64 mw = M_lds[(b) * 32 + r32] >> (4 * hi); \
            const unsigned mlo = (unsigned)mw, mhi = (unsigned)(mw >> 32); \
            _Pragma("unroll") for (int r = 0; r < 16; ++r) { const unsigned bit = 1u << ((r & 3) + 8 * (r >> 2)); p0[r] = (mlo & bit) ? p0[r] : -INFINITY; p1[r] = (mhi & bit) ? p1[r] : -INFINITY; } \
            float pmax = p0[0]; \
            _Pragma("unroll") for (int r = 1; r < 16; ++r) pmax = fmaxf(pmax, p0[r]); \
            _Pragma("unroll") for (int r = 0; r < 16; ++r) pmax = fmaxf(pmax, p1[r]); \
            { auto rr = __builtin_amdgcn_permlane32_swap(__float_as_uint(pmax), __float_as_uint(pmax), false, false); pmax = fmaxf(__uint_as_float(rr[0]), __uint_as_float(rr[1])); } \
            const float mn = fmaxf(m_reg, pmax); const float alpha = __builtin_amdgcn_exp2f((m_reg - mn) * C); m_reg = mn; \
            const float mnC = -mn * C; float ps = 0.f; \
            _Pragma("unroll") for (int r = 0; r < 16; ++r) { p0[r] = __builtin_amdgcn_exp2f(fmaf(p0[r], C, mnC)); p1[r] = __builtin_amdgcn_exp2f(fmaf(p1[r], C, mnC)); ps += p0[r] + p1[r]; } \
            { auto rr = __builtin_amdgcn_permlane32_swap(__float_as_uint(ps), __float_as_uint(ps), false, false); ps = __uint_as_float(rr[0]) + __uint_as_float(rr[1]); } \
            l_reg = l_reg * alpha + ps; \
            if (__any(alpha < 1.f)) { \
                if (hi == 0) al_l[r32] = alpha; \
                asm volatile("s_waitcnt lgkmcnt(0)" ::: "memory"); \
                _Pragma("unroll") for (int r = 0; r < 16; ++r) { const float a_ = al_l[crow(r, hi)]; \
                    _Pragma("unroll") for (int d = 0; d < 4; ++d) o[d][r] *= a_; } \
            } \
        } else if (!(EXP & 1)) { \
              \
            const int dn = U.n0 + wid * 32 + r32 - (j) * 64 - 4 * hi; \
            const float a_ = __builtin_amdgcn_exp2f((float)dn * U.lgam); \
            float c_ = a_; \
            _Pragma("unroll") for (int q_ = 0; q_ < 4; ++q_) { \
                const float f0 = c_, f1 = c_ * gq1, f2 = c_ * gq2, f3 = c_ * gq3; const int kb_ = 8 * q_; \
                p0[4 * q_ + 0] = (dn >= kb_ + 0) ? p0[4 * q_ + 0] * f0 : 0.f; p0[4 * q_ + 1] = (dn >= kb_ + 1) ? p0[4 * q_ + 1] * f1 : 0.f; \
                p0[4 * q_ + 2] = (dn >= kb_ + 2) ? p0[4 * q_ + 2] * f2 : 0.f; p0[4 * q_ + 3] = (dn >= kb_ + 3) ? p0[4 * q_ + 3] * f3 : 0.f; \
                p1[4 * q_ + 0] = (dn >= kb_ + 32) ? p1[4 * q_ + 0] * (f0 * gq32) : 0.f; p1[4 * q_ + 1] = (dn >= kb_ + 33) ? p1[4 * q_ + 1] * (f1 * gq32) : 0.f; \
                p1[4 * q_ + 2] = (dn >= kb_ + 34) ? p1[4 * q_ + 2] * (f2 * gq32) : 0.f; p1[4 * q_ + 3] = (dn >= kb_ + 35) ? p1[4 * q_ + 3] * (f3 * gq32) : 0.f; \
                c_ *= gq8; } \
        } \
        p_to_frag(p0, p1, pa0, pa1, pa2, pa3); \
        FA_SBAR(); \
        { const int vb = vb0 + (b) * TILE_B; \
          pv_all(o, vb, pa0, pa1, pa2, pa3); } \
    } while (0)
    const int NT = U.ntiles;
    const float gq1 = __builtin_amdgcn_exp2f(-U.lgam), gq2 = __builtin_amdgcn_exp2f(-2.0f * U.lgam), gq3 = __builtin_amdgcn_exp2f(-3.0f * U.lgam), gq8 = __builtin_amdgcn_exp2f(-8.0f * U.lgam), gq32 = __builtin_amdgcn_exp2f(-32.0f * U.lgam);
    (void)gq1; (void)gq2; (void)gq3; (void)gq8; (void)gq32;
#pragma unroll
    for (int d = 0; d < 4; ++d) o[d] = f32x16{};
    FA_SLOAD(A, 0);
    if (STATE) {
        pv_all(o, vb0, qr[0], qr[1], qr[2], qr[3]);
        pv_all(o, vb0 + TILE_B, qr[4], qr[5], qr[6], qr[7]);
#pragma unroll
        for (int r = 0; r < 16; ++r) { const float f_ = __builtin_amdgcn_exp2f(U.lgam * (float)(wid * 32 + crow(r, hi) + 1));
#pragma unroll
            for (int d = 0; d < 4; ++d) o[d][r] *= f_; }
        __syncthreads();
    }
    FA_SWRITE(A, 0);
    if (NT > 1) { FA_SLOAD(A, 64); FA_SWRITE(A, 1); }
    if (NT > 2) FA_TOUCH(128);
    if (NT > 3) FA_TOUCH(192);
    __syncthreads();
#pragma unroll 1
    for (int j = 0; j < NT; ++j) {
        const int b = j & 1;
        if (j + 2 < NT) FA_SLOAD(A, (j + 2) * 64);
        if (j + 4 < NT) FA_TOUCH((j + 4) * 64);
        FA_TILE(j, b);
        __syncthreads();
        if (j + 2 < NT) FA_SWRITE(A, b);
        asm volatile("" :: "v"(pf_));
    }
    asm volatile("s_waitcnt vmcnt(0)" ::: "memory");
    __syncthreads();
    l_out = l_reg;
#undef FA_SLOAD
#undef FA_SWRITE
#undef FA_TILE
}

template <int MODE>
__device__ __forceinline__ void unit_body2(LAS char* L, const UnitArgs& U, int tid, f32x16 (&o)[4], float& l_out) {
    const int wid = __builtin_amdgcn_readfirstlane(tid >> 6), lane = tid & 63, r32 = lane & 31, hi = lane >> 5;
    LAS char* V_lds = L + OFF_V; LAS char* K_lds = L + OFF_K; LAS u64* M_lds = (LAS u64*)(L + OFF_M);
    LAS float* wsf = (LAS float*)(L + OFF_WS) + wid * 64; LAS float* al_l = wsf + 32;
    constexpr float C = ATT_SCALE * 1.4426950408889634f;
    constexpr float THR = 8.0f;
    float m_reg = -1e30f, l_reg = 0.f;
    bf16x8 qr[8];
    LAS char* Ql = L + OFF_Q + wid * 8192 + lane * 16;
    { const FA_GAS bf16_t* Qh = (const FA_GAS bf16_t*)hide_p(U.Q); const FA_GAS bf16_t* Qw = (MODE == 0) ? Qh + (size_t)r32 * U.ldq + wid * 128 + hi * 8 : Qh + (size_t)(wid * 32 + r32) * U.ldq + hi * 8;
#pragma unroll
      for (int d0 = 0; d0 < 8; ++d0) { qr[d0] = *(const FA_GAS bf16x8*)(Qw + d0 * 16); if (MODE == 1) *(LAS bf16x8*)(Ql + d0 * 1024) = qr[d0]; } }
    if (MODE == 1) { asm volatile("s_waitcnt vmcnt(0) lgkmcnt(0)" ::: "memory"); FA_SBAR(); }
    const int sr = tid >> 4, sc = (tid & 15) * 8;
    const FA_GAS char* Kh = (const FA_GAS char*)hide_p(U.K); const FA_GAS char* Vh = (const FA_GAS char*)hide_p(U.V);
    const unsigned goff0 = (unsigned)(sr * U.ldk + sc) * 2u, goff1 = (unsigned)((32 + sr) * U.ldk + sc) * 2u;
    const int vb0 = (int)(unsigned)(size_t)V_lds + v_rd_base(lane);
    bf16x8 ksE0, ksE1, vsE0, vsE1; u64 mwE = 0ull; unsigned pf_ = 0u;
#define F2_TOUCH(k0) do { if (MODE == 1 && tid < 256) { const FA_GAS char* tb_ = ((tid < 128) ? Kh : Vh) + (size_t)((k0) + ((tid & 127) >> 1)) * U.ldk * 2 + (tid & 1) * 128; \
        asm volatile("global_load_dword %0, %1, off" : "=v"(pf_) : "v"(tb_) : "memory"); } } while (0)
#define F2_SLOAD(S, k0) do { const FA_GAS char* kb_ = Kh + (size_t)(k0) * U.ldk * 2; const FA_GAS char* vb_ = Vh + (size_t)(k0) * U.ldk * 2; \
        ks##S##0 = *(const FA_GAS bf16x8*)(kb_ + goff0); ks##S##1 = *(const FA_GAS bf16x8*)(kb_ + goff1); \
        if (MODE == 1) { vs##S##0 = *(const FA_GAS bf16x8*)(vb_ + goff0); vs##S##1 = *(const FA_GAS bf16x8*)(vb_ + goff1); } \
        if (MODE == 0 && tid < 32) mw##S = U.mask[(size_t)tid * 32 + ((k0) >> 6)]; } while (0)
#define F2_SWRITE(S, b) do { const int t_ = hide_i(tid), sr_ = t_ >> 4, sc_ = (t_ & 15) * 8; const int vst0 = v_st(sr_, sc_), vst1 = v_st(32 + sr_, sc_), kst0 = FA_KSWZ(sr_, sc_ * 2), kst1 = FA_KSWZ(32 + sr_, sc_ * 2);     \
        *(LAS bf16x8*)(K_lds + (b) * TILE_B + kst0) = ks##S##0; *(LAS bf16x8*)(K_lds + (b) * TILE_B + kst1) = ks##S##1; \
        *(LAS bf16x8*)(V_lds + (b) * TILE_B + vst0) = (MODE == 1) ? vs##S##0 : ks##S##0; *(LAS bf16x8*)(V_lds + (b) * TILE_B + vst1) = (MODE == 1) ? vs##S##1 : ks##S##1; \
        if (MODE == 0 && tid < 32) M_lds[(b) * 32 + tid] = mw##S; } while (0)
#define F2_PARTIAL(P0, P1, j, b, MN, AL) do { \
        if (MODE == 0) { \
            const u64 mw = M_lds[(b) * 32 + r32] >> (4 * hi); const unsigned mlo = (unsigned)mw, mhi = (unsigned)(mw >> 32); \
            _Pragma("unroll") for (int r = 0; r < 16; ++r) { const unsigned bit = 1u << ((r & 3) + 8 * (r >> 2)); P0[r] = (mlo & bit) ? P0[r] : -INFINITY; P1[r] = (mhi & bit) ? P1[r] : -INFINITY; } \
            float pmax = P0[0]; \
            _Pragma("unroll") for (int r = 1; r < 16; ++r) pmax = fmaxf(pmax, P0[r]); \
            _Pragma("unroll") for (int r = 0; r < 16; ++r) pmax = fmaxf(pmax, P1[r]); \
            { auto rr = __builtin_amdgcn_permlane32_swap(__float_as_uint(pmax), __float_as_uint(pmax), false, false); pmax = fmaxf(__uint_as_float(rr[0]), __uint_as_float(rr[1])); } \
            if (__builtin_expect(__all(pmax - m_reg <= THR / ATT_SCALE), 1)) { MN = m_reg; AL = 1.f; } \
            else { MN = fmaxf(m_reg, pmax); AL = __builtin_amdgcn_exp2f((m_reg - MN) * C); m_reg = MN; } \
            const float mnC = -MN * C; \
            _Pragma("unroll") for (int r = 0; r < 16; ++r) { P0[r] = fmaf(P0[r], C, mnC); P1[r] = fmaf(P1[r], C, mnC); } \
            _Pragma("unroll") for (int r = 0; r < 16; ++r) P0[r] = __builtin_amdgcn_exp2f(P0[r]); \
        } else { \
            const int dn = U.n0 + wid * 32 + r32 - (j) * 64 - 4 * hi; const float base = (float)dn * U.lgam; \
            _Pragma("unroll") for (int r = 0; r < 16; ++r) { const int kk = (r & 3) + 8 * (r >> 2); \
                const float f0 = __builtin_amdgcn_exp2f(base - (float)kk * U.lgam); P0[r] = (dn >= kk) ? P0[r] * f0 : 0.f; } \
        } } while (0)
#define F2_FINISH(P0, P1, j, AL) do { \
        if (MODE == 0) { \
            _Pragma("unroll") for (int r = 0; r < 16; ++r) P1[r] = __builtin_amdgcn_exp2f(P1[r]); \
            float ps = 0.f; \
            _Pragma("unroll") for (int r = 0; r < 16; ++r) ps += P0[r] + P1[r]; \
            { auto rr = __builtin_amdgcn_permlane32_swap(__float_as_uint(ps), __float_as_uint(ps), false, false); ps = __uint_as_float(rr[0]) + __uint_as_float(rr[1]); } \
            l_reg = l_reg * AL + ps; \
        } else { \
            const int dn = U.n0 + wid * 32 + r32 - (j) * 64 - 4 * hi; const float base = (float)dn * U.lgam; \
            _Pragma("unroll") for (int r = 0; r < 16; ++r) { const int kk = (r & 3) + 8 * (r >> 2); \
                const float f1 = __builtin_amdgcn_exp2f(base - (float)(kk + 32) * U.lgam); P1[r] = (dn >= kk + 32) ? P1[r] * f1 : 0.f; } \
        } \
        p_to_frag(P0, P1, pa0, pa1, pa2, pa3); } while (0)
#define F2_RESC(AL) do { if (MODE == 0) { if (__any((AL) < 1.f)) { if (hi == 0) al_l[r32] = (AL); asm volatile("s_waitcnt lgkmcnt(0)" ::: "memory"); \
        _Pragma("unroll") for (int r = 0; r < 16; ++r) { const float a_ = al_l[crow(r, hi)]; _Pragma("unroll") for (int d = 0; d < 4; ++d) o[d][r] *= a_; } } } } while (0)
#define F2_QKT(P0, P1, b) do { const LAS char* qb_ = Ql; asm volatile("" : "+v"(qb_)); qkt<MODE == 1>(P0, P1, K_lds + (b) * TILE_B, qr, qb_, r32, hi); } while (0)
#define PV1(vb_) do { const int v_ = (vb_); pv_one<0>(o[0], v_, pa0, pa1, pa2, pa3); pv_one<1>(o[1], v_, pa0, pa1, pa2, pa3); pv_one<2>(o[2], v_, pa0, pa1, pa2, pa3); pv_one<3>(o[3], v_, pa0, pa1, pa2, pa3); } while (0)
    f32x16 pA0, pA1, pB0, pB1; float mnA = 0.f, mnB = 0.f, alA = 1.f, alB = 1.f; bf16x8 pa0, pa1, pa2, pa3; const int NT = U.ntiles;
    (void)mnA; (void)mnB;
    F2_SLOAD(E, 0); F2_SWRITE(E, 0); __syncthreads();
#pragma unroll
    for (int d = 0; d < 4; ++d) o[d] = f32x16{};
    F2_QKT(pA0, pA1, 0); F2_PARTIAL(pA0, pA1, 0, 0, mnA, alA);
    F2_SLOAD(E, 64); if (2 < NT) F2_TOUCH(128); if (3 < NT) F2_TOUCH(192);
    F2_SWRITE(E, 1); __syncthreads();
#pragma unroll 1
    for (int j = 1; j + 1 < NT; j += 2) {
        FA_SBAR(); F2_QKT(pB0, pB1, 1);
        F2_FINISH(pA0, pA1, j - 1, alA); FA_SBAR();
        F2_SLOAD(E, (j + 1) * 64); if (j + 3 < NT) F2_TOUCH((j + 3) * 64); FA_SBAR();
        PV1(vb0); F2_PARTIAL(pB0, pB1, j, 1, mnB, alB);
        __syncthreads(); F2_SWRITE(E, 0); asm volatile("" :: "v"(pf_));
        F2_RESC(alB); __syncthreads();
        FA_SBAR(); F2_QKT(pA0, pA1, 0);
        F2_FINISH(pB0, pB1, j, alB); FA_SBAR();
        if (j + 2 < NT) F2_SLOAD(E, (j + 2) * 64); if (j + 4 < NT) F2_TOUCH((j + 4) * 64); FA_SBAR();
        PV1(vb0 + TILE_B); F2_PARTIAL(pA0, pA1, j + 1, 0, mnA, alA);
        __syncthreads(); if (j + 2 < NT) F2_SWRITE(E, 1); asm volatile("" :: "v"(pf_));
        F2_RESC(alA); __syncthreads();
    }
    FA_SBAR(); F2_QKT(pB0, pB1, 1);
    F2_FINISH(pA0, pA1, NT - 2, alA); FA_SBAR();
    PV1(vb0); F2_PARTIAL(pB0, pB1, NT - 1, 1, mnB, alB);
    __syncthreads(); F2_RESC(alB);
    F2_FINISH(pB0, pB1, NT - 1, alB); FA_SBAR();
    PV1(vb0 + TILE_B);
    asm volatile("s_waitcnt vmcnt(0)" ::: "memory");
    __syncthreads();
    l_out = l_reg;
#undef F2_SLOAD
#undef F2_SWRITE
#undef F2_PARTIAL
#undef F2_FINISH
#undef F2_RESC
#undef F2_QKT
#undef F2_TOUCH
#undef PV1
}
}

namespace pg8 {
struct EpiProj {
    static constexpr bool PERM = true, AFTER_DRAIN = false, HAS_MID = false, F8 = false, F8S = false;
    bf16_t* P; const float* rot;
    __device__ __forceinline__ void operator()(const f32x4 (&acc)[2][2][4][2], const Unit& u, int wr, int wc, int fr, int fq) const {
        const int row0 = u.pm * BM + wr * 64 + fr, colb = u.pn * BM + wc * 32 + 8 * fq;
        const bool rotq = (u.pn >= 7) && (u.pn < 15);
        const float ksc = (u.pn >= 11) ? K_SCALE : 1.0f;
        const int i0 = 16 * wc + 4 * fq;
        if (rotq) {
            f32x4 rr[2][4][2];
#pragma unroll
            for (int ai = 0; ai < 2; ++ai)
#pragma unroll
                for (int m = 0; m < 4; ++m) { const int pos = (row0 + ai * HALF + m * 16) & (SEQL - 1); const f32x4* rt = (const f32x4*)(rot + ((size_t)pos * 64 + i0) * 2); rr[ai][m][0] = rt[0]; rr[ai][m][1] = rt[1]; }
            __builtin_amdgcn_sched_barrier(0);
#pragma unroll
            for (int ai = 0; ai < 2; ++ai)
#pragma unroll
                for (int m = 0; m < 4; ++m) {
                    const int row = row0 + ai * HALF + m * 16; bf16_t* rowp = P + (size_t)row * NPROJ + colb;
                    const f32x4 r0 = rr[ai][m][0], r1 = rr[ai][m][1];
#pragma unroll
                    for (int bj = 0; bj < 2; ++bj) {
                        const f32x4 v0 = acc[ai][bj][m][0], v1 = acc[ai][bj][m][1]; f32x4 w0, w1;
                        w0[0] = (v0[0] * r0[0] - v0[1] * r0[1]) * ksc; w0[1] = (v0[0] * r0[1] + v0[1] * r0[0]) * ksc;
                        w0[2] = (v0[2] * r0[2] - v0[3] * r0[3]) * ksc; w0[3] = (v0[2] * r0[3] + v0[3] * r0[2]) * ksc;
                        w1[0] = (v1[0] * r1[0] - v1[1] * r1[1]) * ksc; w1[1] = (v1[0] * r1[1] + v1[1] * r1[0]) * ksc;
                        w1[2] = (v1[2] * r1[2] - v1[3] * r1[3]) * ksc; w1[3] = (v1[2] * r1[3] + v1[3] * r1[2]) * ksc;
                        u32x4 w; w.x = pkbf(w0[0], w0[1]); w.y = pkbf(w0[2], w0[3]); w.z = pkbf(w1[0], w1[1]); w.w = pkbf(w1[2], w1[3]);
                        __builtin_nontemporal_store(w, (u32x4*)(rowp + bj * HALF));
                    }
                }
        } else {
#pragma unroll
            for (int ai = 0; ai < 2; ++ai)
#pragma unroll
                for (int m = 0; m < 4; ++m) {
                    const int row = row0 + ai * HALF + m * 16; bf16_t* rowp = P + (size_t)row * NPROJ + colb;
#pragma unroll
                    for (int bj = 0; bj < 2; ++bj) {
                        const f32x4 v0 = acc[ai][bj][m][0], v1 = acc[ai][bj][m][1];
                        u32x4 w; w.x = pkbf(v0[0], v0[1]); w.y = pkbf(v0[2], v0[3]); w.z = pkbf(v1[0], v1[1]); w.w = pkbf(v1[2], v1[3]);
                        __builtin_nontemporal_store(w, (u32x4*)(rowp + bj * HALF));
                    }
                }
        }
    }
};
struct EpiMergeF {
    static constexpr bool PERM = true, AFTER_DRAIN = false, HAS_MID = true, F8 = false, F8S = false;
    const bf16_t* P; bf16_t* O;
    static __device__ __forceinline__ float cl(float x) { return fminf(fmaxf(x, -30.f), 30.f); }
    static __device__ __forceinline__ float ratio(float a, float b) { return (1.0f + __expf(-cl(b))) * __builtin_amdgcn_rcpf(1.0f + __expf(-cl(a))); }
#define MG_LOAD(G0, G1, r) do { _Pragma("unroll") for (int mm = 0; mm < 2; ++mm) _Pragma("unroll") for (int bj = 0; bj < 2; ++bj) { \
        const bf16_t* gp = P + (size_t)(row0 + ((r) >> 1) * HALF + (((r) & 1) * 2 + mm) * 16) * NPROJ + C_GBR + colb + bj * HALF; G0[mm][bj] = __builtin_nontemporal_load((const u32x4*)gp); G1[mm][bj] = *(const u32x4*)(gp + DMODEL); } } while (0)
#define MG_COMP(G0, G1, r) do { _Pragma("unroll") for (int mm = 0; mm < 2; ++mm) _Pragma("unroll") for (int bj = 0; bj < 2; ++bj) { \
        const u32x4 a_ = G0[mm][bj], b_ = G1[mm][bj]; f32x4 r0, r1; const int ai_ = (r) >> 1, m_ = ((r) & 1) * 2 + mm; \
        r0[0] = ratio(bflo(a_.x), bflo(b_.x)); r0[1] = ratio(bfhi(a_.x), bfhi(b_.x)); r0[2] = ratio(bflo(a_.y), bflo(b_.y)); r0[3] = ratio(bfhi(a_.y), bfhi(b_.y)); \
        r1[0] = ratio(bflo(a_.z), bflo(b_.z)); r1[1] = ratio(bfhi(a_.z), bfhi(b_.z)); r1[2] = ratio(bflo(a_.w), bflo(b_.w)); r1[3] = ratio(bfhi(a_.w), bfhi(b_.w)); \
        acc[ai_][bj][m_][0] = acc[ai_][bj][m_][0] * r0; acc[ai_][bj][m_][1] = acc[ai_][bj][m_][1] * r1; } } while (0)
    __device__ __forceinline__ void mid(f32x4 (&acc)[2][2][4][2], const Unit& u, int wr, int wc, int fr, int fq) const {
        const int row0 = hide_i(u.pm * BM + wr * 64 + fr), colb = hide_i(u.pn * BM + wc * 32 + 8 * fq);
        u32x4 ga0[2][2], ga1[2][2], gb0[2][2], gb1[2][2];
        __builtin_amdgcn_sched_barrier(0);
        MG_LOAD(ga0, ga1, 0); MG_LOAD(gb0, gb1, 1); __builtin_amdgcn_sched_barrier(0);
        MG_COMP(ga0, ga1, 0); __builtin_amdgcn_sched_barrier(0); MG_LOAD(ga0, ga1, 2); __builtin_amdgcn_sched_barrier(0);
        MG_COMP(gb0, gb1, 1); __builtin_amdgcn_sched_barrier(0); MG_LOAD(gb0, gb1, 3); __builtin_amdgcn_sched_barrier(0);
        MG_COMP(ga0, ga1, 2); __builtin_amdgcn_sched_barrier(0);
        MG_COMP(gb0, gb1, 3); __builtin_amdgcn_sched_barrier(0);
    }
#undef MG_LOAD
#undef MG_COMP
#define MF_LOAD(G, r) do { _Pragma("unroll") for (int mm = 0; mm < 2; ++mm) _Pragma("unroll") for (int bj = 0; bj < 2; ++bj) \
        G[mm][bj] = __builtin_nontemporal_load((const u32x4*)(P + (size_t)(row0 + ((r) >> 1) * HALF + (((r) & 1) * 2 + mm) * 16) * NPROJ + C_GBR + DMODEL + colb + bj * HALF)); } while (0)
#define MF_COMP(G, r) do { _Pragma("unroll") for (int mm = 0; mm < 2; ++mm) { const int ai_ = (r) >> 1, m_ = ((r) & 1) * 2 + mm; const int row = row0 + ai_ * HALF + m_ * 16; \
        _Pragma("unroll") for (int bj = 0; bj < 2; ++bj) { const int col = colb + bj * HALF; const u32x4 g = G[mm][bj]; const f32x4 v0 = acc[ai_][bj][m_][0], v1 = acc[ai_][bj][m_][1]; float o[8]; \
            o[0] = sigmoidf_(cl(bflo(g.x))) * v0[0]; o[1] = sigmoidf_(cl(bfhi(g.x))) * v0[1]; o[2] = sigmoidf_(cl(bflo(g.y))) * v0[2]; o[3] = sigmoidf_(cl(bfhi(g.y))) * v0[3]; \
            o[4] = sigmoidf_(cl(bflo(g.z))) * v1[0]; o[5] = sigmoidf_(cl(bfhi(g.z))) * v1[1]; o[6] = sigmoidf_(cl(bflo(g.w))) * v1[2]; o[7] = sigmoidf_(cl(bfhi(g.w))) * v1[3]; \
            u32x4 w; w.x = pkbf(o[0], o[1]); w.y = pkbf(o[2], o[3]); w.z = pkbf(o[4], o[5]); w.w = pkbf(o[6], o[7]); \
            *(u32x4*)(O + (size_t)row * DMODEL + col) = w; } } } while (0)
    __device__ __forceinline__ void operator()(const f32x4 (&acc)[2][2][4][2], const Unit& u, int wr, int wc, int fr, int fq) const {
        const int row0 = u.pm * BM + wr * 64 + fr, colb = u.pn * BM + wc * 32 + 8 * fq;
        u32x4 ga[2][2], gb[2][2], gc[2][2], gd[2][2];
        MF_LOAD(ga, 0); MF_LOAD(gb, 1); MF_LOAD(gc, 2); MF_LOAD(gd, 3); __builtin_amdgcn_sched_barrier(0);
        MF_COMP(ga, 0); MF_COMP(gb, 1); MF_COMP(gc, 2); MF_COMP(gd, 3);
    }
#undef MF_LOAD
#undef MF_COMP
};
struct EpiRes {
    static constexpr bool PERM = false, AFTER_DRAIN = false, HAS_MID = false, F8 = false, F8S = false;
    const float* X; float* O;
    __device__ __forceinline__ void operator()(const f32x4 (&acc)[2][2][4][2], const Unit& u, int wr, int wc, int fr, int fq) const {
        const int row0 = u.pm * BM + wr * 64 + fr, col0 = u.pn * BM + wc * 32 + 4 * fq;
#pragma unroll
        for (int ai = 0; ai < 2; ++ai) {
            f32x4 xv[4][2][2];
#pragma unroll
            for (int m = 0; m < 4; ++m) { const size_t off = (size_t)(row0 + ai * HALF + m * 16) * DMODEL + col0;
#pragma unroll
                for (int bj = 0; bj < 2; ++bj)
#pragma unroll
                    for (int n = 0; n < 2; ++n) xv[m][bj][n] = __builtin_nontemporal_load((const f32x4*)(X + off + bj * HALF + n * 16)); }
            __builtin_amdgcn_sched_barrier(0);
#pragma unroll
            for (int m = 0; m < 4; ++m) { const size_t off = (size_t)(row0 + ai * HALF + m * 16) * DMODEL + col0;
#pragma unroll
                for (int bj = 0; bj < 2; ++bj)
#pragma unroll
                    for (int n = 0; n < 2; ++n) *(f32x4*)(O + off + bj * HALF + n * 16) = xv[m][bj][n] + acc[ai][bj][m][n]; }
            __builtin_amdgcn_sched_barrier(0);
        }
    }
};
struct EpiNull {
    static constexpr bool PERM = true, AFTER_DRAIN = false, HAS_MID = false, F8 = false, F8S = false;
    float* O;
    __device__ __forceinline__ void operator()(const f32x4 (&acc)[2][2][4][2], const Unit& u, int wr, int wc, int fr, int fq) const {
        f32x4 t = (f32x4){0.f, 0.f, 0.f, 0.f};
#pragma unroll
        for (int ai = 0; ai < 2; ++ai)
#pragma unroll
            for (int bj = 0; bj < 2; ++bj)
#pragma unroll
                for (int m = 0; m < 4; ++m) { t += acc[ai][bj][m][0]; t += acc[ai][bj][m][1]; }
        O[(size_t)(u.pm * 8 + u.pn) * 512 + (wr * 4 + wc) * 64 + fr + 16 * fq] = (t[0] + t[1]) + (t[2] + t[3]);
    }
};
struct EpiD {
    static constexpr bool PERM = true, AFTER_DRAIN = false, HAS_MID = false, F8 = false, F8S = false;
    bf16_t* D;
    __device__ __forceinline__ void operator()(const f32x4 (&acc)[2][2][4][2], const Unit& u, int wr, int wc, int fr, int fq) const {
        const int row0 = u.pm * BM + wr * 64 + fr, colb = u.pn * BM + wc * 32 + 8 * fq;
#pragma unroll
        for (int ai = 0; ai < 2; ++ai)
#pragma unroll
            for (int m = 0; m < 4; ++m) {
                bf16_t* rowp = D + (size_t)(row0 + ai * HALF + m * 16) * DMODEL + colb;
#pragma unroll
                for (int bj = 0; bj < 2; ++bj) {
                    const f32x4 v0 = acc[ai][bj][m][0], v1 = acc[ai][bj][m][1];
                    u32x4 w; w.x = pkbf(v0[0], v0[1]); w.y = pkbf(v0[2], v0[3]); w.z = pkbf(v1[0], v1[1]); w.w = pkbf(v1[2], v1[3]);
                    *(u32x4*)(rowp + bj * HALF) = w;
                }
            }
    }
};
struct EpiSwiglu {
    static constexpr bool PERM = true, AFTER_DRAIN = false, HAS_MID = false, F8 = true, F8S = F8S_UP;
    unsigned char* H; const float* rs; const LAS int* ts;
    __device__ __forceinline__ void operator()(const f32x4 (&acc)[2][2][4][2], const Unit& u, int wr, int wc, int fr, int fq) const {
        const int row0 = hide_i(u.pm * BM + wr * 64 + fr), col = hide_i(u.pn * HALF + wc * 32 + 8 * fq); const int sh = u.e * 16384 - ts[u.e] * 256;
        float rsv[2][4];
#pragma unroll
        for (int ai = 0; ai < 2; ++ai)
#pragma unroll
            for (int m = 0; m < 4; ++m) rsv[ai][m] = rs[row0 + ai * HALF + m * 16 + sh];
        __builtin_amdgcn_sched_barrier(0);
#pragma unroll
        for (int ai = 0; ai < 2; ++ai)
#pragma unroll
            for (int m = 0; m < 4; ++m) {
                const int row = row0 + ai * HALF + m * 16; const float r_ = rsv[ai][m] * W8_INV;
                const f32x4 g0 = acc[ai][0][m][0] * r_, g1 = acc[ai][0][m][1] * r_, u0 = acc[ai][1][m][0] * r_, u1 = acc[ai][1][m][1] * r_;
                u32x2 w; w.x = pk4f8(siluf_(g0[0]) * u0[0], siluf_(g0[1]) * u0[1], siluf_(g0[2]) * u0[2], siluf_(g0[3]) * u0[3]);
                w.y = pk4f8(siluf_(g1[0]) * u1[0], siluf_(g1[1]) * u1[1], siluf_(g1[2]) * u1[2], siluf_(g1[3]) * u1[3]);
                *(u32x2*)(H + (size_t)row * 1024 + col) = w;
            }
    }
};
struct EpiDown {
    static constexpr bool PERM = true, AFTER_DRAIN = false, HAS_MID = false, F8 = true, F8S = F8S_DOWN;
    bf16_t* Y; const float* rg; const LAS int* ts;
    __device__ __forceinline__ void operator()(const f32x4 (&acc)[2][2][4][2], const Unit& u, int wr, int wc, int fr, int fq) const {
        const int row0 = hide_i(u.pm * BM + wr * 64 + fr), colb = hide_i(u.pn * BM + wc * 32 + 8 * fq); const int sh = u.e * 16384 - ts[u.e] * 256;
        float rgv[2][4];
#pragma unroll
        for (int ai = 0; ai < 2; ++ai)
#pragma unroll
            for (int m = 0; m < 4; ++m) rgv[ai][m] = rg[row0 + ai * HALF + m * 16 + sh];
        __builtin_amdgcn_sched_barrier(0);
#pragma unroll
        for (int ai = 0; ai < 2; ++ai)
#pragma unroll
            for (int m = 0; m < 4; ++m) {
                const int row = row0 + ai * HALF + m * 16; const float gt = rgv[ai][m] * W8_INV;
#pragma unroll
                for (int bj = 0; bj < 2; ++bj) {
                    const f32x4 v0 = acc[ai][bj][m][0] * gt, v1 = acc[ai][bj][m][1] * gt;
                    u32x4 w; w.x = pkbf(v0[0], v0[1]); w.y = pkbf(v0[2], v0[3]); w.z = pkbf(v1[0], v1[1]); w.w = pkbf(v1[2], v1[3]);
                    *(u32x4*)(Y + (size_t)row * DMODEL + colb + bj * HALF) = w;
                }
            }
    }
};
template <bool GATHER_> struct ExpertOrderT {
    static constexpr bool GATHER = GATHER_;
    const LAS int* ts; int G, c; const int* rtok; int base, limit;
    __device__ __forceinline__ unsigned rowoff(const Unit& u, int slot) const { if (!GATHER_) return 0u; const int rk = slot - ts[u.e] * 256; return (rk < ts[128 + u.e]) ? (unsigned)rtok[u.e * 16384 + rk] : 0u; }
    __device__ __forceinline__ bool next(int i, Unit& u) const {
        const int L = __builtin_amdgcn_readfirstlane(base + i * G + c); if (L >= __builtin_amdgcn_readfirstlane(limit)) return false;
        const int gt = L >> 3; u.pm = gt; u.pn = L & 7; int e = 0;
        for (int k = 1; k < 32; ++k) e += (gt >= ts[k]) ? 1 : 0;
        u.e = __builtin_amdgcn_readfirstlane(e); return true;
    }
    __device__ __forceinline__ void a_ready(const Unit&) const {}
    __device__ __forceinline__ void done(const Unit&) const {}
};
}

struct MapId { __device__ __forceinline__ int operator()(int n) const { return n; } };
struct MapGate { __device__ __forceinline__ int operator()(int f) const { return ((f >> 7) << 8) + (f & 127); } };
struct MapUp { __device__ __forceinline__ int operator()(int f) const { return ((f >> 7) << 8) + 128 + (f & 127); } };
struct MapProj {
    __device__ __forceinline__ int operator()(int n) const {
        if (n < 1736) return n;
        if (n < 2760) { const int l = n - 1736, d = l & 127; return C_QR + (l & ~127) + ((d & 63) << 1) + (d >> 6); }
        if (n < 3784) { const int l = n - 2760, d = l & 127; return C_KR + (l & ~127) + ((d & 63) << 1) + (d >> 6); }
        if (n < 4808) return C_VR + (n - 3784);
        if (n < 5832) return C_GR + (n - 4808);
        return C_GBR + (n - 5832);
    }
};
template <class RowMap>
__device__ __forceinline__ void tr_item(const float* __restrict__ src, int N, bf16_t* __restrict__ dst, int ldd, int kb, int nb, int lane, RowMap rm) {
    const int kc = lane >> 3, nc = lane & 7;
    const int n = nb * 32 + nc * 4, k0 = kb * 64 + kc * 8;
    if (n < N) {
        f32x4 v[8];
#pragma unroll
        for (int i = 0; i < 8; ++i) v[i] = __builtin_nontemporal_load((const f32x4*)(src + (size_t)(k0 + i) * N + n));
#pragma unroll
        for (int j = 0; j < 4; ++j) {
            u32x4 o; o.x = pkbf(v[0][j], v[1][j]); o.y = pkbf(v[2][j], v[3][j]); o.z = pkbf(v[4][j], v[5][j]); o.w = pkbf(v[6][j], v[7][j]);
            *(u32x4*)(dst + (size_t)rm(n + j) * ldd + k0) = o;
        }
    }
}
template <class RowMap>
__device__ __forceinline__ void tr_item2(const float* __restrict__ src, int N, bf16_t* __restrict__ dst, int ldd, int kb, int nb, int lane, RowMap rm) {
    const int kc = lane >> 3, nc = lane & 7;
    const int n = nb * 32 + nc * 4, k0 = kb * 64 + kc * 8;
    f32x4 va[8], vb[8];
#pragma unroll
    for (int i = 0; i < 8; ++i) { va[i] = __builtin_nontemporal_load((const f32x4*)(src + (size_t)(k0 + i) * N + n)); vb[i] = __builtin_nontemporal_load((const f32x4*)(src + (size_t)(k0 + i) * N + n + 32)); }
#pragma unroll
    for (int j = 0; j < 4; ++j) {
        u32x4 o; o.x = pkbf(va[0][j], va[1][j]); o.y = pkbf(va[2][j], va[3][j]); o.z = pkbf(va[4][j], va[5][j]); o.w = pkbf(va[6][j], va[7][j]);
        *(u32x4*)(dst + (size_t)rm(n + j) * ldd + k0) = o;
    }
#pragma unroll
    for (int j = 0; j < 4; ++j) {
        u32x4 o; o.x = pkbf(vb[0][j], vb[1][j]); o.y = pkbf(vb[2][j], vb[3][j]); o.z = pkbf(vb[4][j], vb[5][j]); o.w = pkbf(vb[6][j], vb[7][j]);
        *(u32x4*)(dst + (size_t)rm(n + 32 + j) * ldd + k0) = o;
    }
}
template <class RowMap>
__device__ __forceinline__ void tr_item4(const float* __restrict__ src, int N, unsigned char* __restrict__ dst, int ldd, int kb, int nb, int lane, RowMap rm) {
    const int kc = lane >> 3, nc = lane & 7;
    const int n = nb * 32 + nc * 4, k0 = kb * 64 + kc * 8;
    f32x4 v[4][8];
#pragma unroll
    for (int i = 0; i < 8; ++i)
#pragma unroll
        for (int u = 0; u < 4; ++u) v[u][i] = __builtin_nontemporal_load((const f32x4*)(src + (size_t)(k0 + i) * N + n + 32 * u));
#pragma unroll
    for (int u = 0; u < 4; ++u)
#pragma unroll
        for (int j = 0; j < 4; ++j) {
            u32x2 o; o.x = pk4f8(v[u][0][j] * W8_SCALE, v[u][1][j] * W8_SCALE, v[u][2][j] * W8_SCALE, v[u][3][j] * W8_SCALE); o.y = pk4f8(v[u][4][j] * W8_SCALE, v[u][5][j] * W8_SCALE, v[u][6][j] * W8_SCALE, v[u][7][j] * W8_SCALE);
            __builtin_nontemporal_store(o, (u32x2*)(dst + (size_t)rm(n + 32 * u + j) * ldd + k0));
        }
}
constexpr int EXP_ITEMS = 3 * 32 * 1024;
__device__ __forceinline__ void convert_experts(const float* w_eg, const float* w_eu, const float* w_ed, unsigned char* WGU, unsigned char* WD, unsigned* qctr, int lane) {
    int nxt = 0; if (lane == 0) nxt = (int)atomicAdd(qctr, 8u);
    for (;;) {
        const int it = __builtin_amdgcn_readfirstlane(nxt);
        if (it >= EXP_ITEMS) break;
        if (lane == 0) nxt = (int)atomicAdd(qctr, 8u);
        const int kind = it >> 15, r = it & 32767, e = r >> 10, q = r & 1023;
        if (kind == 0) { const float* src = w_eg + (size_t)e * 2048 * 1024; unsigned char* dst = WGU + (size_t)e * 2048 * 2048;
#pragma unroll 1
            for (int u = 0; u < 8; u += 4) tr_item4(src, 1024, dst, 2048, q >> 5, (q & 31) + u, lane, MapGate{}); }
        else if (kind == 1) { const float* src = w_eu + (size_t)e * 2048 * 1024; unsigned char* dst = WGU + (size_t)e * 2048 * 2048;
#pragma unroll 1
            for (int u = 0; u < 8; u += 4) tr_item4(src, 1024, dst, 2048, q >> 5, (q & 31) + u, lane, MapUp{}); }
        else { const float* src = w_ed + (size_t)e * 1024 * 2048; unsigned char* dst = WD + (size_t)e * 2048 * 1024;
#pragma unroll 1
            for (int u = 0; u < 8; u += 4) tr_item4(src, 2048, dst, 1024, q >> 6, (q & 63) + u, lane, MapId{}); }
    }
}
__device__ __forceinline__ void sincos_d(double a, double& s, double& c) {
    const double TWO_PI = 6.283185307179586476925, HALF_PI = 1.5707963267948966192313;
    double k = rint(a / HALF_PI); double r = a - k * HALF_PI;
    r -= k * 6.123233995736766e-17;
    const int q = ((int)k) & 3; const double r2 = r * r;
    double sp = r2 * (-1.0 / 1307674368000.0);
    sp = r2 * (sp + 1.0 / 6227020800.0); sp = r2 * (sp - 1.0 / 39916800.0); sp = r2 * (sp + 1.0 / 362880.0); sp = r2 * (sp - 1.0 / 5040.0); sp = r2 * (sp + 1.0 / 120.0); sp = r2 * (sp - 1.0 / 6.0);
    const double sr = r + r * sp;
    double cp = r2 * (1.0 / 20922789888000.0);
    cp = r2 * (cp - 1.0 / 87178291200.0); cp = r2 * (cp + 1.0 / 479001600.0); cp = r2 * (cp - 1.0 / 3628800.0); cp = r2 * (cp + 1.0 / 40320.0); cp = r2 * (cp - 1.0 / 720.0); cp = r2 * (cp + 1.0 / 24.0); cp = r2 * (cp - 0.5);
    const double cr = 1.0 + cp;
    s = (q == 0) ? sr : (q == 1) ? cr : (q == 2) ? -sr : -cr;
    c = (q == 0) ? cr : (q == 1) ? -sr : (q == 2) ? -cr : sr;
    (void)TWO_PI;
}

struct Params { const float* in[17]; float* out; unsigned char* ws; };

#ifndef PROF_PHASE
#define PROF_PHASE -1
#endif
#ifndef PROF_SCALE
#define PROF_SCALE 4e-6f
#endif
#define STAMP(i) do { if (PROF_PHASE >= 0 && bx == 0 && wave_id == 0) ((unsigned*)(p.ws + WS_CTL))[6000 + (i)] = (unsigned)__builtin_amdgcn_s_memrealtime(); } while (0)
#define GSYNC() grid.sync()
#define XBAR() do { const int l__ = (int)__builtin_amdgcn_mbcnt_hi(~0u, __builtin_amdgcn_mbcnt_lo(~0u, (unsigned)hide_i(0))); xcd_barrier(xbar, wave_id * 64 + l__); } while (0)
constexpr int CTL_BAR_WORD = 8192;
constexpr int CTL_QCTR = 2048;
constexpr int CTL_SPLIT = 12288;
#ifndef NGEMM_P1
#define NGEMM_P1 208
#endif

__global__ void __launch_bounds__(512, 2) mega_fwd(Params p) {
    extern __shared__ __attribute__((aligned(16))) unsigned char lds_raw[];
    LAS unsigned char* lds = (LAS unsigned char*)lds_raw;
    cg::grid_group grid = cg::this_grid();
    const int G = gridDim.x, bx = blockIdx.x;
    const int wave_id = __builtin_amdgcn_readfirstlane((int)threadIdx.x >> 6);
    const int NGW = G * 8, NGT = G * 512;
    XcdBarrier xbar;
    {
        const int l0 = (int)__builtin_amdgcn_mbcnt_hi(~0u, __builtin_amdgcn_mbcnt_lo(~0u, (unsigned)hide_i(0)));
        volatile LAS unsigned* st = (volatile LAS unsigned*)(lds + LDS_MISC + 256);
        if (wave_id == 0 && l0 < 2) st[l0] = 0u;
        __syncthreads();
        xbar.bar = (unsigned*)(p.ws + WS_CTL) + CTL_BAR_WORD; xbar.x = xb_xcc_id(); xbar.st = st;
        if (wave_id == 0 && l0 == 0) (void)xb_add(&xbar.bar[XB_XCNT(xbar.x)], 1u);
    }
#define PH_LOCALS \
    const int lane = (int)__builtin_amdgcn_mbcnt_hi(~0u, __builtin_amdgcn_mbcnt_lo(~0u, (unsigned)hide_i(0))), wave = wave_id, tid = wave * 64 + lane; (void)tid; \
    const int gw = bx * 8 + wave, gtid = bx * 512 + tid; (void)gw; (void)gtid; (void)lane; \
    unsigned char* ws = hide_p(p.ws); float* out = hide_p(p.out); (void)out; \
    unsigned* ctl = (unsigned*)(ws + WS_CTL); float* rot = (float*)(ws + WS_ROT); (void)ctl; (void)rot; \
    bf16_t* WIN = (bf16_t*)(ws + WS_WIN); bf16_t* WCOMB = (bf16_t*)(ws + WS_WCOMB); bf16_t* WB = (bf16_t*)(ws + WS_WB); bf16_t* WO = (bf16_t*)(ws + WS_WO); (void)WIN; (void)WCOMB; (void)WB; (void)WO; \
    unsigned char* WGU = ws + WS_WGU; unsigned char* WD = ws + WS_WD; (void)WGU; (void)WD;     \
    bf16_t* P = (bf16_t*)(ws + WS_P); bf16_t* HMID = (bf16_t*)(ws + WS_HMID); bf16_t* Y = (bf16_t*)(ws + WS_Y); (void)P; (void)HMID; (void)Y; \
    bf16_t* XN = (bf16_t*)(ws + WS_XN); bf16_t* BA = XN; bf16_t* TN = XN; (void)BA; (void)TN; \
    bf16_t* OA = (bf16_t*)(ws + WS_OA); bf16_t* OB = OA + 1024;            bf16_t* MIXED = (bf16_t*)(ws + WS_MIXED); bf16_t* XG = (bf16_t*)(ws + WS_XG); (void)OA; (void)OB; (void)MIXED; (void)XG; \
    bf16_t* KV = (bf16_t*)(ws + WS_KV); u64* MASK = (u64*)(ws + WS_MASK); (void)KV; (void)MASK; \
    int* misc = (int*)(ws + WS_MISC); \
    int* row_tok = misc + MI_ROWTOK; float* row_gate = (float*)(misc + MI_ROWGATE); int* tok_slot = misc + MI_TOKSLOT; (void)row_tok; (void)row_gate; (void)tok_slot; \
    int* asg_e = misc + MI_ASGE; int* asg_r = misc + MI_ASGR; float* asg_g = (float*)(misc + MI_ASGG); (void)asg_e; (void)asg_r; (void)asg_g;
#define IN(k) hide_p(p.in[k])

    STAMP(0);
    {
        PH_LOCALS
        const float* x = IN(0); const float* g_mix = IN(1); const float* w_in = IN(2); const float* w_uv = IN(4); const float* w_branch = IN(6); const float* w_out = IN(7);
        constexpr int NB_WIN = 311;
        constexpr int NP_WIN = 156;
        constexpr int I_WIN = 32 * NP_WIN, I_WB = 16 * 32, I_WO = 32 * 32;
        constexpr int I_TOTAL = I_WIN + I_WB + I_WO;
#pragma unroll 1
        for (int pass = 0; pass < 4; ++pass) {
        const int job = (pass + wave) & 3;
        if (job == 0) {
        for (int it = gw; it < I_TOTAL; it += NGW) {
            int r = it;
            if (r < I_WIN) { const int kb_ = r / NP_WIN, q_ = r - kb_ * NP_WIN;
                if (q_ < NP_WIN - 1) tr_item2(w_in, 9928, WIN, 2048, kb_, 2 * q_, lane, MapProj{}); else tr_item(w_in, 9928, WIN, 2048, kb_, NB_WIN - 1, lane, MapProj{}); continue; } r -= I_WIN;
            if (r < I_WB) { tr_item2(w_branch + (size_t)1024 * 2048, 2048, WCOMB + 1024, 2048, r >> 5, 2 * (r & 31), lane, MapId{});   continue; } r -= I_WB;
            tr_item2(w_out, 2048, WO, 2048, r >> 5, 2 * (r & 31), lane, MapId{});
        }
        for (int i = gtid; i < 56 * 256; i += NGT) ((u32x4*)(WIN + (size_t)1736 * 2048))[i] = (u32x4){0u, 0u, 0u, 0u};
        } else if (job == 1) {
        for (int it = gw; it < 2048; it += NGW) {
            const int h = it >> 8, ct = (it >> 5) & 7, n0 = (it & 31) * 64, i = lane & 15, g = lane >> 4;
            const float* ap = w_uv + ((size_t)h * 128 + 16 * ct + i) * 128 + 4 * g;
            const float* bp = w_branch + (size_t)(h * 128 + 4 * g) * 2048 + n0 + 4 * i;
            f32x4 c0 = (f32x4){0.f, 0.f, 0.f, 0.f}, c1 = c0, c2 = c0, c3 = c0;
#pragma unroll
            for (int qh = 0; qh < 2; ++qh) {
                f32x4 av[4], bv[4][4];
#pragma unroll
                for (int q = 0; q < 4; ++q) { const int d0 = 16 * (4 * qh + q); av[q] = *(const f32x4*)(ap + d0);
#pragma unroll
                    for (int s_ = 0; s_ < 4; ++s_) bv[q][s_] = *(const f32x4*)(bp + (size_t)(d0 + s_) * 2048); }
#pragma unroll
                for (int q = 0; q < 4; ++q)
#pragma unroll
                    for (int s_ = 0; s_ < 4; ++s_) {
                        c0 = __builtin_amdgcn_mfma_f32_16x16x4f32(av[q][s_], bv[q][s_][0], c0, 0, 0, 0); c1 = __builtin_amdgcn_mfma_f32_16x16x4f32(av[q][s_], bv[q][s_][1], c1, 0, 0, 0);
                        c2 = __builtin_amdgcn_mfma_f32_16x16x4f32(av[q][s_], bv[q][s_][2], c2, 0, 0, 0); c3 = __builtin_amdgcn_mfma_f32_16x16x4f32(av[q][s_], bv[q][s_][3], c3, 0, 0, 0);
                    }
            }
            bf16_t* op = WCOMB + (size_t)(n0 + 4 * i) * 2048 + h * 128 + 16 * ct + 4 * g;
            { u32x2 w; w.x = pkbf(c0[0], c0[1]); w.y = pkbf(c0[2], c0[3]); *(u32x2*)(op) = w; }
            { u32x2 w; w.x = pkbf(c1[0], c1[1]); w.y = pkbf(c1[2], c1[3]); *(u32x2*)(op + 2048) = w; }
            { u32x2 w; w.x = pkbf(c2[0], c2[1]); w.y = pkbf(c2[2], c2[3]); *(u32x2*)(op + 2 * 2048) = w; }
            { u32x2 w; w.x = pkbf(c3[0], c3[1]); w.y = pkbf(c3[2], c3[3]); *(u32x2*)(op + 3 * 2048) = w; }
        }
        } else if (job == 2) {
        for (int m = gw; m < T_TOK; m += 2 * NGW) {
            const int m1 = (m + NGW < T_TOK) ? m + NGW : m;
            const f32x4* xr0 = (const f32x4*)(x + (size_t)m * DMODEL) + lane; const f32x4* xr1 = (const f32x4*)(x + (size_t)m1 * DMODEL) + lane;
            f32x4 v0[8], v1[8]; float s0 = 0.f, s1 = 0.f;
#pragma unroll
            for (int j = 0; j < 8; ++j) { v0[j] = __builtin_nontemporal_load(xr0 + 64 * j); v1[j] = __builtin_nontemporal_load(xr1 + 64 * j); }
#pragma unroll
            for (int j = 0; j < 8; ++j) { s0 += (v0[j][0] * v0[j][0] + v0[j][1] * v0[j][1]) + (v0[j][2] * v0[j][2] + v0[j][3] * v0[j][3]); s1 += (v1[j][0] * v1[j][0] + v1[j][1] * v1[j][1]) + (v1[j][2] * v1[j][2] + v1[j][3] * v1[j][3]); }
            const float r0 = 1.0f / sqrtf(wave_sum(s0, lane) * (1.0f / DMODEL) + EPS_F), r1 = 1.0f / sqrtf(wave_sum(s1, lane) * (1.0f / DMODEL) + EPS_F);
            u32x2* o0 = (u32x2*)(XN + (size_t)m * DMODEL) + lane; u32x2* o1 = (u32x2*)(XN + (size_t)m1 * DMODEL) + lane;
            f32x4 ggv[8];
#pragma unroll
            for (int j = 0; j < 8; ++j) ggv[j] = ((const f32x4*)g_mix)[lane + 64 * j];
            __builtin_amdgcn_sched_barrier(0);
#pragma unroll
            for (int j = 0; j < 8; ++j) { const f32x4 gg = ggv[j];
                u32x2 w; w.x = pkbf(v0[j][0] * r0 * gg[0], v0[j][1] * r0 * gg[1]); w.y = pkbf(v0[j][2] * r0 * gg[2], v0[j][3] * r0 * gg[3]); o0[64 * j] = w;
                u32x2 w2; w2.x = pkbf(v1[j][0] * r1 * gg[0], v1[j][1] * r1 * gg[1]); w2.y = pkbf(v1[j][2] * r1 * gg[2], v1[j][3] * r1 * gg[3]); o1[64 * j] = w2; }
        }
        } else {
        for (int idx = gtid; idx < SEQL * 64; idx += NGT) {
            const int pos = idx >> 6, i = idx & 63; double f = 1.0;
            for (int k = 0; k < i; ++k) f *= 0.8659643233600653;
            double s, c; sincos_d((double)pos * f, s, c);
            rot[2 * idx] = (float)c; rot[2 * idx + 1] = (float)s;
        }
        { const float* g_ffn = IN(8); const float* w_rg = IN(9); const float* w_re = IN(11); float* WC = (float*)(ws + WS_WC);
          for (int idx = gtid; idx < 256 * 48 * 8; idx += NGT) { const int j = idx & 7, c = (idx >> 3) % 48, k = (idx / 384) * 8 + j;
              const float wv = (c < 4) ? w_rg[k * 4 + c] : (c < 36) ? w_re[k * 32 + (c - 4)] : 0.f; WC[idx] = wv * g_ffn[k]; } }
        }
        }
        for (int i = gtid; i < 32; i += NGT) ctl[64 * i] = 0u;
        if (gtid < 2) ctl[4096 + gtid] = 0u;
        for (int i = gtid; i < MAXSLOT; i += NGT) { row_tok[i] = 0; row_gate[i] = 0.f; ((float*)(ws + WS_WC + 524288))[i] = 0.f; }
    }
    if (__builtin_expect(p.out == nullptr, 0)) GSYNC();
    XBAR();
    STAMP(1);

    {
        PH_LOCALS
        const float* w_eg = IN(13); const float* w_eu = IN(14); const float* w_ed = IN(15);
        const int NGEMM = (G == 256) ? NGEMM_P1 : G;
        if (bx < NGEMM) {
            pg8::Gemm g{XN, WIN, T_TOK, NPROJ, 2048}; pg8::StaticOrder S; S.init(T_TOK, NPROJ, NGEMM, bx);
            pg8::EpiProj E{P, rot};
            pg8::gemm_phase<pg8::EpiProj, pg8::StaticOrder, true, true>(lds, g, S, E, tid);
        }
        convert_experts(w_eg, w_eu, w_ed, WGU, WD, ctl + CTL_QCTR, lane);
    }
    XBAR();
    STAMP(2);
#ifdef P1_EXP
    XBAR();
    STAMP(30);
    {
        PH_LOCALS
        const float* w_eg = IN(13); const float* w_eu = IN(14); const float* w_ed = IN(15);
        const int NGEMM = P1_EXP_NG;
        if ((P1_EXP & 1) && bx < NGEMM) {
            pg8::Gemm g{XN, WIN, T_TOK, NPROJ, 2048}; pg8::StaticOrder S; S.init(T_TOK, NPROJ, NGEMM, bx);
            pg8::EpiProj E{P, rot};
            pg8::gemm_phase<pg8::EpiProj, pg8::StaticOrder, true, true>(lds, g, S, E, tid);
        }
        if ((P1_EXP & 2) && bx >= NGEMM) convert_experts(w_eg, w_eu, w_ed, WGU, WD, ctl + CTL_QCTR + 64, lane);
    }
    XBAR();
    STAMP(31);
#endif

    {
        PH_LOCALS
        bf16_t* UST = (bf16_t*)(ws + WS_XN);
        LAS char* Kim = (LAS char*)lds; LAS char* Vim = Kim + fa::TILE_B; LAS bf16_t* Ol = (LAS bf16_t*)((LAS char*)lds + 2 * fa::TILE_B);
        const int r32 = lane & 31, hi = lane >> 5, sr = tid >> 4, sc = (tid & 15) * 8;
        const int vst0 = fa::v_st(sr, sc), vst1 = fa::v_st(32 + sr, sc);
        const int ti = wave >> 1, tj = (wave & 1) * 2;
        const int kb = (int)(unsigned)(size_t)Kim + fa::v_rd_base(lane) + ti * 512, vb = (int)(unsigned)(size_t)Vim + fa::v_rd_base(lane) + tj * 512;
        __syncthreads();
#pragma unroll 1
        for (int it = bx; it < 448; it += G) {
            const int bh = it / 7, j = it - bh * 7, b = bh >> 3, h = bh & 7;
            const float lgam = (h == 0) ? -0.04580368961312479f : (h == 1) ? -0.02272007650008353f : (h == 2) ? -0.011315313227834146f : (h == 3) ? -0.005646563141142063f :
                               (h == 4) ? -0.0028205190623786626f : (h == 5) ? -0.0014095702546713536f : (h == 6) ? -0.0007046129765893727f : -0.0003522634716290214f;
            const bf16_t* Kg = P + (size_t)(b * SEQL + 256 * j + sr) * NPROJ + C_KR + h * 128 + sc;
            const bf16_t* Vg = P + (size_t)(b * SEQL + 256 * j + sr) * NPROJ + C_VR + h * 128 + sc;
            fa::f32x16 a0 = {}, a1 = {};
            u32x4 k0 = *(const u32x4*)Kg, k1 = *(const u32x4*)(Kg + (size_t)32 * NPROJ), v0 = *(const u32x4*)Vg, v1 = *(const u32x4*)(Vg + (size_t)32 * NPROJ);
#pragma unroll 1
            for (int mt = 0; mt < 4; ++mt) {
                const float e0 = lgam * (float)(255 - 64 * mt - sr); const float f0 = __builtin_amdgcn_exp2f(e0), f1 = __builtin_amdgcn_exp2f(e0 - 32.0f * lgam);
                u32x4 s0, s1;
                s0.x = pkbf(bflo(k0.x) * f0, bfhi(k0.x) * f0); s0.y = pkbf(bflo(k0.y) * f0, bfhi(k0.y) * f0); s0.z = pkbf(bflo(k0.z) * f0, bfhi(k0.z) * f0); s0.w = pkbf(bflo(k0.w) * f0, bfhi(k0.w) * f0);
                s1.x = pkbf(bflo(k1.x) * f1, bfhi(k1.x) * f1); s1.y = pkbf(bflo(k1.y) * f1, bfhi(k1.y) * f1); s1.z = pkbf(bflo(k1.z) * f1, bfhi(k1.z) * f1); s1.w = pkbf(bflo(k1.w) * f1, bfhi(k1.w) * f1);
                __syncthreads();
                *(LAS u32x4*)(Kim + vst0) = s0; *(LAS u32x4*)(Kim + vst1) = s1; *(LAS u32x4*)(Vim + vst0) = v0; *(LAS u32x4*)(Vim + vst1) = v1;
                if (mt < 3) { const size_t o_ = (size_t)(64 * (mt + 1)) * NPROJ;
                    k0 = *(const u32x4*)(Kg + o_); k1 = *(const u32x4*)(Kg + o_ + (size_t)32 * NPROJ); v0 = *(const u32x4*)(Vg + o_); v1 = *(const u32x4*)(Vg + o_ + (size_t)32 * NPROJ); }
                __syncthreads();
#define R1_PK(L, H) (fa::bf16x8){L[0], L[1], L[2], L[3], H[0], H[1], H[2], H[3]}
#define R1_STEP(ks) do { const fa::s16x4 al_ = fa::tr_read<fa::v_rd_off(0, ks, 0)>(kb), ah_ = fa::tr_read<fa::v_rd_off(0, ks, 1)>(kb), bl_ = fa::tr_read<fa::v_rd_off(0, ks, 0)>(vb), bh_ = fa::tr_read<fa::v_rd_off(0, ks, 1)>(vb), \
                        cl_ = fa::tr_read<fa::v_rd_off(1, ks, 0)>(vb), ch_ = fa::tr_read<fa::v_rd_off(1, ks, 1)>(vb); \
                    asm volatile("s_waitcnt lgkmcnt(0)" ::: "memory"); __builtin_amdgcn_sched_barrier(0); \
                    a0 = __builtin_amdgcn_mfma_f32_32x32x16_bf16(R1_PK(al_, ah_), R1_PK(bl_, bh_), a0, 0, 0, 0); a1 = __builtin_amdgcn_mfma_f32_32x32x16_bf16(R1_PK(al_, ah_), R1_PK(cl_, ch_), a1, 0, 0, 0); } while (0)
                R1_STEP(0); R1_STEP(1); R1_STEP(2); R1_STEP(3);
#undef R1_STEP
#undef R1_PK
            }
#pragma unroll
            for (int r = 0; r < 16; ++r) { LAS bf16_t* q_ = Ol + (32 * ti + fa::crow(r, hi)) * 136 + 32 * tj + r32;
                q_[0] = (bf16_t)(pkbf(a0[r], 0.f) & 0xffffu); q_[32] = (bf16_t)(pkbf(a1[r], 0.f) & 0xffffu); }
            __syncthreads();
#pragma unroll
            for (int k = 0; k < 4; ++k) { const int row = sr + 32 * k; *(u32x4*)(UST + (size_t)it * 16384 + row * 128 + sc) = *(const LAS u32x4*)(Ol + row * 136 + sc); }
        }
    }
    { const int l__ = (int)__builtin_amdgcn_mbcnt_hi(~0u, __builtin_amdgcn_mbcnt_lo(~0u, (unsigned)hide_i(0))); split_arrive(xbar, (unsigned*)(p.ws + WS_CTL) + CTL_SPLIT + 64, wave_id * 64 + l__); }
    {
        PH_LOCALS
        const float* g_kv = IN(3);
        for (int t = gw; t < T_TOK; t += NGW) {
            const unsigned v = *(const unsigned*)(P + (size_t)t * NPROJ + C_CKV + 2 * lane);
            const float a = bflo(v), b = bfhi(v);
            const float rstd = 1.0f / sqrtf(wave_sum(a * a + b * b, lane) * (1.0f / 128.0f) + EPS_F);
            *(unsigned*)(KV + (size_t)t * 128 + 2 * lane) = pkbf(a * rstd * g_kv[2 * lane], b * rstd * g_kv[2 * lane + 1]);
        }
#if DBG_CMP == 3
        {
        u64* MASKX = (u64*)(ws + WS_SPARE);
        LAS float* qi = (LAS float*)(lds + wave * 10240); LAS float* sc = qi + 512;
        for (int t = gw; t < T_TOK; t += NGW) {
            const int b = t >> 11, q = t & 2047, ng = (q >> 6) + 1;
            { const u32x4 v = *(const u32x4*)(P + (size_t)t * NPROJ + C_QIDX + lane * 8);
              f32x4 lo4 = (f32x4){bflo(v.x), bfhi(v.x), bflo(v.y), bfhi(v.y)}, hi4 = (f32x4){bflo(v.z), bfhi(v.z), bflo(v.w), bfhi(v.w)};
              *(LAS f32x4*)(qi + lane * 8) = lo4; *(LAS f32x4*)(qi + lane * 8 + 4) = hi4; }
            float w[8];
            { const u32x4 v = *(const u32x4*)(P + (size_t)t * NPROJ + C_WIDX); w[0] = bflo(v.x); w[1] = bfhi(v.x); w[2] = bflo(v.y); w[3] = bfhi(v.y); w[4] = bflo(v.z); w[5] = bfhi(v.z); w[6] = bflo(v.w); w[7] = bfhi(v.w); }
            for (int g = 0; g < ng; ++g) {
                LAS float* qg = qi; asm volatile("" : "+v"(qg));
                const int s = g * 64 + lane; const u32x4* kr = (const u32x4*)(P + (size_t)(b * SEQL + s) * NPROJ + C_KIDX);
                float dot[8];
#pragma unroll
                for (int h = 0; h < 8; ++h) dot[h] = 0.f;
#pragma unroll
                for (int c = 0; c < 8; ++c) {
                    const u32x4 v = kr[c];
                    const f32x4 ka = (f32x4){bflo(v.x), bfhi(v.x), bflo(v.y), bfhi(v.y)}, kb = (f32x4){bflo(v.z), bfhi(v.z), bflo(v.w), bfhi(v.w)};
#pragma unroll
                    for (int h = 0; h < 8; ++h) {
                        const f32x4 qa = *(const LAS f32x4*)(qg + h * 64 + c * 8), qb = *(const LAS f32x4*)(qg + h * 64 + c * 8 + 4);
                        dot[h] += (qa[0] * ka[0] + qa[1] * ka[1]) + (qa[2] * ka[2] + qa[3] * ka[3]) + (qb[0] * kb[0] + qb[1] * kb[1]) + (qb[2] * kb[2] + qb[3] * kb[3]);
                    }
                }
                float score = 0.f;
#pragma unroll
                for (int h = 0; h < 8; ++h) score += w[h] * fmaxf(dot[h], 0.f);
                sc[s] = score * IDX_SCALE;
            }
            u64* mrow = MASKX + (size_t)t * 32;
            if (ng <= 4) { if (lane < 32) mrow[lane] = (lane < ng) ? ~0ull : 0ull; }
            else {
                unsigned lo = 0u;
                for (int bit = 31; bit >= 0; --bit) {
                    const unsigned cand = lo | (1u << bit); int cnt = 0;
                    for (int g = 0; g < ng; ++g) cnt += __popcll(__ballot(fkey(sc[g * 64 + lane]) >= cand));
                    if (cnt >= 256) lo = cand;
                }
                const unsigned tau = lo; int cgt = 0;
                for (int g = 0; g < ng; ++g) cgt += __popcll(__ballot(fkey(sc[g * 64 + lane]) > tau));
                const int need = 256 - cgt; int run = 0;
                for (int g = 0; g < ng; ++g) {
                    const unsigned key = fkey(sc[g * 64 + lane]);
                    const u64 gt = __ballot(key > tau), eq = __ballot(key == tau);
                    const u64 below = eq & ((1ull << lane) - 1ull);
                    const bool sel = (key == tau) && (run + (int)__popcll(below) < need);
                    const u64 word = gt | __ballot(sel);
                    run += (int)__popcll(eq);
                    if (lane == 0) mrow[g] = word;
                }
                if (lane >= ng && lane < 32) mrow[lane] = 0ull;
            }
        }
        }
        __syncthreads();
#endif
        typedef short bf16x8_t __attribute__((ext_vector_type(8)));
        constexpr int SCS = 2052;
        LAS float* scl = (LAS float*)lds;
        LAS unsigned* hist = (LAS unsigned*)(lds + 16 * SCS * 4);
        LAS unsigned* candl = hist + 16 * 256 + wave * 64;
        LAS unsigned* kbl = hist + 16 * 256 + 8 * 64;
        for (int i = tid; i < 16 * 256; i += 512) hist[i] = 0u;
        if (tid < 256) {
            unsigned lo = 0x00800000u, hi = 0xFF800000u;
#pragma unroll 1
            while (lo < hi) { const unsigned mid = lo + ((hi - lo) >> 1); if (sbin(unkey(mid)) >= tid) hi = mid; else lo = mid + 1u; }
            kbl[tid] = (tid == 0) ? 1u : lo;
            if (tid == 0) kbl[256] = 0u;
        }
        __syncthreads();
        for (int ui = 0; ui < 4; ++ui) {
            const int uu = ui * 256 + ((ui & 1) ? 255 - bx : bx);
            if (uu >= 1024 || bx >= 256) break;
            const int b = uu & 7, qblk = uu >> 3, q0 = qblk * 16, t0 = b * SEQL + q0, ng = (q0 >> 6) + 1, N = ng * 64;
            if (ng <= 4) {
                for (int qq = 0; qq < 2; ++qq) { u64* mrow = MASK + (size_t)(t0 + 2 * wave + qq) * 32; if (lane < 32) mrow[lane] = (lane < ng) ? ~0ull : 0ull; }
                continue;
            }
            const int qrow = lane & 15, kg = lane >> 4;
            bf16x8_t qf[8][2]; float w[8];
            { const bf16_t* qp = P + (size_t)(t0 + qrow) * NPROJ + C_QIDX + 8 * kg;
#pragma unroll
              for (int h = 0; h < 8; ++h) { qf[h][0] = *(const bf16x8_t*)(qp + h * 64); qf[h][1] = *(const bf16x8_t*)(qp + h * 64 + 32); }
              const u32x4 v = *(const u32x4*)(P + (size_t)(t0 + qrow) * NPROJ + C_WIDX); w[0] = bflo(v.x); w[1] = bfhi(v.x); w[2] = bflo(v.y); w[3] = bfhi(v.y); w[4] = bflo(v.z); w[5] = bfhi(v.z); w[6] = bflo(v.w); w[7] = bfhi(v.w); }
            const bf16_t* kp0 = P + (size_t)(b * SEQL + qrow) * NPROJ + C_KIDX + 8 * kg;
            const int ktl = N / 16 - 1;
            bf16x8_t na0 = *(const bf16x8_t*)(kp0 + (size_t)(wave * 16) * NPROJ), na1 = *(const bf16x8_t*)(kp0 + (size_t)(wave * 16) * NPROJ + 32);
            bf16x8_t nb0, nb1, nc0, nc1, nd0, nd1;
            { const int k1 = (wave + 8 <= ktl) ? wave + 8 : wave, k2 = (wave + 16 <= ktl) ? wave + 16 : wave, k3 = (wave + 24 <= ktl) ? wave + 24 : wave;
              nb0 = *(const bf16x8_t*)(kp0 + (size_t)(k1 * 16) * NPROJ); nb1 = *(const bf16x8_t*)(kp0 + (size_t)(k1 * 16) * NPROJ + 32);
              nc0 = *(const bf16x8_t*)(kp0 + (size_t)(k2 * 16) * NPROJ); nc1 = *(const bf16x8_t*)(kp0 + (size_t)(k2 * 16) * NPROJ + 32);
              nd0 = *(const bf16x8_t*)(kp0 + (size_t)(k3 * 16) * NPROJ); nd1 = *(const bf16x8_t*)(kp0 + (size_t)(k3 * 16) * NPROJ + 32); }
            for (int kt = wave; kt < N / 16; kt += 8) {
                const int s0 = kt * 16;
                const bf16x8_t a0 = na0, a1 = na1;
                na0 = nb0; na1 = nb1; nb0 = nc0; nb1 = nc1; nc0 = nd0; nc1 = nd1;
                { const int ktn = (kt + 32 <= ktl) ? kt + 32 : kt;
                  nd0 = *(const bf16x8_t*)(kp0 + (size_t)(ktn * 16) * NPROJ); nd1 = *(const bf16x8_t*)(kp0 + (size_t)(ktn * 16) * NPROJ + 32); }
                f32x4 sacc = (f32x4){0.f, 0.f, 0.f, 0.f};
                { typedef float f32x2_t __attribute__((ext_vector_type(2)));
                  f32x2_t s01 = {0.f, 0.f}, s23 = {0.f, 0.f};
#pragma unroll
                  for (int h = 0; h < 8; ++h) {
                    f32x4 acc = (f32x4){0.f, 0.f, 0.f, 0.f};
                    acc = __builtin_amdgcn_mfma_f32_16x16x32_bf16(a0, qf[h][0], acc, 0, 0, 0);
                    acc = __builtin_amdgcn_mfma_f32_16x16x32_bf16(a1, qf[h][1], acc, 0, 0, 0);
                    const f32x2_t m01 = {fmaxf(acc[0], 0.f), fmaxf(acc[1], 0.f)}, m23 = {fmaxf(acc[2], 0.f), fmaxf(acc[3], 0.f)}, w2 = {w[h], w[h]};
                    s01 = __builtin_elementwise_fma(m01, w2, s01); s23 = __builtin_elementwise_fma(m23, w2, s23);
                  }
                  sacc[0] = s01[0]; sacc[1] = s01[1]; sacc[2] = s23[0]; sacc[3] = s23[1]; }
                sacc = sacc * IDX_SCALE + 0.0f;
                *(LAS f32x4*)(scl + qrow * SCS + s0 + 4 * kg) = sacc;
#pragma unroll
                for (int i = 0; i < 4; ++i) __hip_atomic_fetch_add(hist + qrow * 256 + sbin(sacc[i]), 1u, __ATOMIC_RELAXED, __HIP_MEMORY_SCOPE_WORKGROUP);
            }
            __syncthreads();
            auto sel_body = [&](auto jm_) {
            constexpr int JMAX = decltype(jm_)::value;
#pragma unroll 1
            for (int qq = 0; qq < 2; ++qq) {
                const int q = 2 * wave + qq; const LAS float* row = scl + q * SCS; LAS unsigned* hq = hist + q * 256;
                unsigned key[JMAX];
#pragma unroll
                for (int j = 0; j < JMAX; ++j) key[j] = (j < ng) ? fkey(row[64 * j + lane]) : 0u;
                const u32x4 hv = *(const LAS u32x4*)(hq + 4 * lane);
                *(LAS u32x4*)(hq + 4 * lane) = (u32x4){0u, 0u, 0u, 0u};
                const int tsum = (int)(hv.x + hv.y + hv.z + hv.w);
                const int pin_ = wave_prefix_incl(tsum);
                const int incl = __builtin_amdgcn_readlane(pin_, 63) - pin_ + tsum;
                const int suf = incl - tsum;
                int bt_l, ab_l;
                if (suf + (int)hv.w >= 256) { bt_l = 4 * lane + 3; ab_l = suf; }
                else if (suf + (int)(hv.w + hv.z) >= 256) { bt_l = 4 * lane + 2; ab_l = suf + (int)hv.w; }
                else if (suf + (int)(hv.w + hv.z + hv.y) >= 256) { bt_l = 4 * lane + 1; ab_l = suf + (int)(hv.w + hv.z); }
                else { bt_l = 4 * lane; ab_l = suf + (int)(hv.w + hv.z + hv.y); }
                const u64 cb = __ballot(suf < 256 && incl >= 256);
                const int src = (int)__builtin_ctzll(cb | (1ull << 63));
                const int bt = __builtin_amdgcn_readlane(bt_l, src), above = __builtin_amdgcn_readlane(ab_l, src);
                const int r = 256 - above;
                const unsigned klo_ = kbl[bt], span_ = kbl[bt + 1] - klo_;
                unsigned cm = 0u;
#pragma unroll
                for (int j = 0; j < JMAX; ++j) cm |= ((key[j] - klo_) < span_) ? (1u << j) : 0u;
                const int myc = (int)__popc(cm); const int pre = wave_prefix_incl(myc);
                const int C = __builtin_amdgcn_readlane(pre, 63);
                int pos = pre - myc;
                if (C <= 64) {
                    unsigned m_ = cm;
                    while (m_) { const int j_ = __builtin_ctz(m_); m_ &= m_ - 1u; candl[pos] = fkey(row[64 * j_ + lane]); ++pos; }
                }
                unsigned tau; int cgt, neq;
                if (C <= 64) {
                    asm volatile("s_waitcnt lgkmcnt(0)" ::: "memory");
                    const unsigned ck = (lane < C) ? candl[lane] : 0u;
                    const unsigned dif_ = klo_ ^ (klo_ + span_ - 1u);
                    const int hb_ = dif_ ? 31 - (int)__builtin_clz(dif_) : -1;
                    unsigned lo = (hb_ < 0) ? klo_ : (klo_ & ~((2u << hb_) - 1u));
#pragma unroll 1
                    for (int bit = hb_; bit >= 0; --bit) { const unsigned cand = lo | (1u << bit); if ((int)__popcll(__ballot(ck >= cand)) >= r) lo = cand; }
                    tau = lo; cgt = above + (int)__popcll(__ballot(ck > tau)); neq = (int)__popcll(__ballot(ck == tau));
                } else {
                    unsigned lo = 0u;
#pragma unroll 1
                    for (int bit = 31; bit >= 0; --bit) {
                        const unsigned cand = lo | (1u << bit); int c = 0;
#pragma unroll
                        for (int j = 0; j < JMAX; ++j) c += (key[j] >= cand) ? 1 : 0;
#pragma unroll
                        for (int x = 1; x < 64; x <<= 1) c += __builtin_amdgcn_ds_bpermute((lane ^ x) << 2, c);
                        if (c >= 256) lo = cand;
                    }
                    tau = lo; cgt = 0;
#pragma unroll
                    for (int j = 0; j < JMAX; ++j) cgt += (key[j] > tau) ? 1 : 0;
#pragma unroll
                    for (int x = 1; x < 64; x <<= 1) cgt += __builtin_amdgcn_ds_bpermute((lane ^ x) << 2, cgt);
                    neq = 2;
                }
                const int need = 256 - cgt; u64 myword = 0ull;
                if (neq == 1) {
#pragma unroll
                    for (int j = 0; j < JMAX; ++j) { const u64 word = __ballot(key[j] >= tau); if (lane == j) myword = word; }
                } else {
                    int run = 0;
#pragma unroll
                    for (int j = 0; j < JMAX; ++j) {
                        const u64 gt = __ballot(key[j] > tau), eq = __ballot(key[j] == tau);
                        const u64 below = eq & ((1ull << lane) - 1ull);
                        const bool sel = (key[j] == tau) && (run + (int)__popcll(below) < need);
                        const u64 word = gt | __ballot(sel);
                        run += (int)__popcll(eq);
                        if (lane == j) myword = word;
                        __builtin_amdgcn_sched_barrier(0);
                    }
                }
                if (lane < 32) MASK[(size_t)(t0 + q) * 32 + lane] = myword;
            }
            };
            if (ng <= 16) sel_body(IdxIC<16>{}); else sel_body(IdxIC<32>{});
            __syncthreads();
        }
    }
    { const int l__ = (int)__builtin_amdgcn_mbcnt_hi(~0u, __builtin_amdgcn_mbcnt_lo(~0u, (unsigned)hide_i(0))); split_arrive(xbar, (unsigned*)(p.ws + WS_CTL) + CTL_SPLIT + 128, wave_id * 64 + l__); }
    STAMP(3);
#ifdef IDX_EXP
    XBAR();
    STAMP(30);
    {
        PH_LOCALS
        u64* MASKX_ = (u64*)(ws + WS_SPARE);
        typedef short bf16x8_t __attribute__((ext_vector_type(8)));
        constexpr int SCS = 2052;
        LAS float* scl = (LAS float*)lds;
        LAS unsigned* hist = (LAS unsigned*)(lds + 16 * SCS * 4);
        LAS unsigned* candl = hist + 16 * 256 + wave * 64;
        for (int i = tid; i < 16 * 256; i += 512) hist[i] = 0u;
        __syncthreads();
        for (int ui = 0; ui < 4; ++ui) {
            const int uu = ui * 256 + ((ui & 1) ? 255 - bx : bx);
            if (uu >= 1024 || bx >= 256) break;
            const int b = uu & 7, qblk = uu >> 3, q0 = qblk * 16, t0 = b * SEQL + q0, ng = (q0 >> 6) + 1, N = ng * 64;
            if (ng <= 4) {
                for (int qq = 0; qq < 2; ++qq) { u64* mrow = MASKX_ + (size_t)(t0 + 2 * wave + qq) * 32; if (lane < 32) mrow[lane] = (lane < ng) ? ~0ull : 0ull; }
                continue;
            }
            const int qrow = lane & 15, kg = lane >> 4;
            bf16x8_t qf[8][2]; float w[8];
            { const bf16_t* qp = P + (size_t)(t0 + qrow) * NPROJ + C_QIDX + 8 * kg;
#pragma unroll
              for (int h = 0; h < 8; ++h) { qf[h][0] = *(const bf16x8_t*)(qp + h * 64); qf[h][1] = *(const bf16x8_t*)(qp + h * 64 + 32); }
              const u32x4 v = *(const u32x4*)(P + (size_t)(t0 + qrow) * NPROJ + C_WIDX); w[0] = bflo(v.x); w[1] = bfhi(v.x); w[2] = bflo(v.y); w[3] = bfhi(v.y); w[4] = bflo(v.z); w[5] = bfhi(v.z); w[6] = bflo(v.w); w[7] = bfhi(v.w); }
            const bf16_t* kp0 = P + (size_t)(b * SEQL + qrow) * NPROJ + C_KIDX + 8 * kg;
            bf16x8_t na0 = *(const bf16x8_t*)(kp0 + (size_t)(wave * 16) * NPROJ), na1 = *(const bf16x8_t*)(kp0 + (size_t)(wave * 16) * NPROJ + 32);
            if (!(IDX_EXP & 2))
            for (int kt = wave; kt < N / 16; kt += 8) {
                const int s0 = kt * 16;
                const bf16x8_t a0 = na0, a1 = na1;
                { const int ktn = (kt + 8 < N / 16) ? kt + 8 : kt;
                  na0 = *(const bf16x8_t*)(kp0 + (size_t)(ktn * 16) * NPROJ); na1 = *(const bf16x8_t*)(kp0 + (size_t)(ktn * 16) * NPROJ + 32); }
                f32x4 sacc = (f32x4){0.f, 0.f, 0.f, 0.f};
#pragma unroll
                for (int h = 0; h < 8; ++h) {
                    f32x4 acc = (f32x4){0.f, 0.f, 0.f, 0.f};
                    acc = __builtin_amdgcn_mfma_f32_16x16x32_bf16(a0, qf[h][0], acc, 0, 0, 0);
                    acc = __builtin_amdgcn_mfma_f32_16x16x32_bf16(a1, qf[h][1], acc, 0, 0, 0);
                    sacc[0] += w[h] * fmaxf(acc[0], 0.f); sacc[1] += w[h] * fmaxf(acc[1], 0.f); sacc[2] += w[h] * fmaxf(acc[2], 0.f); sacc[3] += w[h] * fmaxf(acc[3], 0.f);
                }
                sacc = sacc * IDX_SCALE + 0.0f;
                *(LAS f32x4*)(scl + qrow * SCS + s0 + 4 * kg) = sacc;
#pragma unroll
                for (int i = 0; i < 4; ++i) __hip_atomic_fetch_add(hist + qrow * 256 + sbin(sacc[i]), 1u, __ATOMIC_RELAXED, __HIP_MEMORY_SCOPE_WORKGROUP);
            }
            __syncthreads();
#pragma unroll 1
            for (int qq = 0; qq < ((IDX_EXP & 1) ? 0 : 2); ++qq) {
                const int q = 2 * wave + qq; const LAS float* row = scl + q * SCS; LAS unsigned* hq = hist + q * 256;
                unsigned key[32];
#pragma unroll
                for (int j = 0; j < 32; ++j) key[j] = (j < ng) ? fkey(row[64 * j + lane]) : 0u;
                const u32x4 hv = *(const LAS u32x4*)(hq + 4 * lane);
                *(LAS u32x4*)(hq + 4 * lane) = (u32x4){0u, 0u, 0u, 0u};
                const int tsum = (int)(hv.x + hv.y + hv.z + hv.w); int incl = tsum;
#pragma unroll
                for (int off = 1; off < 64; off <<= 1) { const int o = __builtin_amdgcn_ds_bpermute(((lane + off) & 63) << 2, incl); incl += (lane + off < 64) ? o : 0; }
                const int suf = incl - tsum;
                int bt_l, ab_l;
                if (suf + (int)hv.w >= 256) { bt_l = 4 * lane + 3; ab_l = suf; }
                else if (suf + (int)(hv.w + hv.z) >= 256) { bt_l = 4 * lane + 2; ab_l = suf + (int)hv.w; }
                else if (suf + (int)(hv.w + hv.z + hv.y) >= 256) { bt_l = 4 * lane + 1; ab_l = suf + (int)(hv.w + hv.z); }
                else { bt_l = 4 * lane; ab_l = suf + (int)(hv.w + hv.z + hv.y); }
                const u64 cb = __ballot(suf < 256 && incl >= 256);
                const int src = (int)__builtin_ctzll(cb | (1ull << 63));
                const int bt = __builtin_amdgcn_readlane(bt_l, src), above = __builtin_amdgcn_readlane(ab_l, src);
                const int r = 256 - above;
                int C = 0;
                if (!(IDX_EXP & 4))
#pragma unroll
                for (int j = 0; j < 32; ++j) {
                    const bool isc = (key[j] != 0u) && (sbin(unkey(key[j])) == bt);
                    const u64 bal = __ballot(isc);
                    if (isc) { const int pos = C + (int)__popcll(bal & ((1ull << lane) - 1ull)); if (pos < 64) candl[pos] = key[j]; }
                    C += (int)__popcll(bal);
                }
                unsigned tau; int cgt;
                if (IDX_EXP & 4) { tau = 0x80000000u + (unsigned)bt; cgt = above; }
                else if (C <= 64) {
                    asm volatile("s_waitcnt lgkmcnt(0)" ::: "memory");
                    const unsigned ck = (lane < C) ? candl[lane] : 0u;
                    unsigned lo = 0u;
#pragma unroll 1
                    for (int bit = 31; bit >= 0; --bit) { const unsigned cand = lo | (1u << bit); if ((int)__popcll(__ballot(ck >= cand)) >= r) lo = cand; }
                    tau = lo; cgt = above + (int)__popcll(__ballot(ck > tau));
                } else {
                    unsigned lo = 0u;
#pragma unroll 1
                    for (int bit = 31; bit >= 0; --bit) {
                        const unsigned cand = lo | (1u << bit); int c = 0;
#pragma unroll
                        for (int j = 0; j < 32; ++j) c += (key[j] >= cand) ? 1 : 0;
#pragma unroll
                        for (int x = 1; x < 64; x <<= 1) c += __builtin_amdgcn_ds_bpermute((lane ^ x) << 2, c);
                        if (c >= 256) lo = cand;
                    }
                    tau = lo; cgt = 0;
#pragma unroll
                    for (int j = 0; j < 32; ++j) cgt += (key[j] > tau) ? 1 : 0;
#pragma unroll
                    for (int x = 1; x < 64; x <<= 1) cgt += __builtin_amdgcn_ds_bpermute((lane ^ x) << 2, cgt);
                }
                const int need = 256 - cgt; int run = 0; u64 myword = (u64)tau;
                if (!(IDX_EXP & 8))
#pragma unroll
                for (int j = 0; j < 32; ++j) {
                    const u64 gt = __ballot(key[j] > tau), eq = __ballot(key[j] == tau);
                    const u64 below = eq & ((1ull << lane) - 1ull);
                    const bool sel = (key[j] == tau) && (run + (int)__popcll(below) < need);
                    const u64 word = gt | __ballot(sel);
                    run += (int)__popcll(eq);
                    if (lane == j) myword = word;
                    __builtin_amdgcn_sched_barrier(0);
                }
                if (lane < 32) MASKX_[(size_t)(t0 + q) * 32 + lane] = myword;
            }
            __syncthreads();
        }
    }
    XBAR();
    STAMP(31);
#endif

#if DBG_CMP == 1
    {
        PH_LOCALS
        bf16_t* OAX = (bf16_t*)(ws + WS_SPARE);
        float* qv = (float*)(lds_raw + wave * 10240); float* lg = qv + 512;
        for (int it = gw; it < T_TOK * 8; it += NGW) {
            const int t = it >> 3, h = it & 7, b = t >> 11, q = t & 2047, ng = (q >> 6) + 1;
            { const unsigned v = *(const unsigned*)(P + (size_t)t * NPROJ + C_QLAT + h * 128 + 2 * lane); qv[2 * lane] = bflo(v); qv[2 * lane + 1] = bfhi(v); }
            const u64* mrow = MASK + (size_t)t * 32;
            float mx = -INFINITY;
            for (int g = 0; g < ng; ++g) {
                asm volatile("" ::: "memory");
                const u64 word = mrow[g]; float l = -INFINITY;
                if ((word >> lane) & 1ull) {
                    const u32x4* kr = (const u32x4*)(KV + (size_t)(b * SEQL + g * 64 + lane) * 128);
                    float d0 = 0.f, d1 = 0.f, d2 = 0.f, d3 = 0.f;
#pragma unroll
                    for (int c = 0; c < 16; ++c) { const u32x4 v = kr[c]; const f32x4 qa = *(const f32x4*)(qv + 8 * c), qb = *(const f32x4*)(qv + 8 * c + 4);
                        d0 += qa[0] * bflo(v.x) + qb[0] * bflo(v.z); d1 += qa[1] * bfhi(v.x) + qb[1] * bfhi(v.z); d2 += qa[2] * bflo(v.y) + qb[2] * bflo(v.w); d3 += qa[3] * bfhi(v.y) + qb[3] * bfhi(v.w); }
                    l = ((d0 + d1) + (d2 + d3)) * ATT_SCALE;
                }
                lg[g * 64 + lane] = l; mx = fmaxf(mx, l);
            }
            mx = wave_max(mx, lane);
            float o0 = 0.f, o1 = 0.f, sum = 0.f;
            for (int g = 0; g < ng; ++g) {
                const u64 wv = mrow[g];
                u64 word = ((u64)__builtin_amdgcn_readfirstlane((unsigned)(wv >> 32)) << 32) | (u64)__builtin_amdgcn_readfirstlane((unsigned)wv);
                while (word) {
                    const int j = __builtin_ctzll(word); word &= word - 1ull;
                    const int s = g * 64 + j; const float pj = __expf(lg[s] - mx);
                    const unsigned v = *(const unsigned*)(KV + (size_t)(b * SEQL + s) * 128 + 2 * lane);
                    o0 += pj * bflo(v); o1 += pj * bfhi(v); sum += pj;
                }
            }
            const float inv = 1.0f / sum;
            *(unsigned*)(OAX + (size_t)t * 1024 + h * 128 + 2 * lane) = pkbf(o0 * inv, o1 * inv);
        }
    }
    __syncthreads();
#endif
#if DBG_CMP == 2
    {
        PH_LOCALS
        const float* g_ret = IN(5);
        bf16_t* OBX = (bf16_t*)(ws + WS_SPARE);
        float* qv = (float*)(lds_raw + wave * 10240); float* lg = qv + 512; float* wl = lg;
        for (int it = gw; it < T_TOK * 8; it += NGW) {
            const int t = it >> 3, h = it & 7, b = t >> 11, n = t & 2047, ng = (n >> 6) + 1;
            const float lgam = (h == 0) ? -0.04580368961312479f : (h == 1) ? -0.02272007650008353f : (h == 2) ? -0.011315313227834146f : (h == 3) ? -0.005646563141142063f :
                               (h == 4) ? -0.0028205190623786626f : (h == 5) ? -0.0014095702546713536f : (h == 6) ? -0.0007046129765893727f : -0.0003522634716290214f;
            { const unsigned v = *(const unsigned*)(P + (size_t)t * NPROJ + C_QR + h * 128 + 2 * lane); qv[2 * lane] = bflo(v); qv[2 * lane + 1] = bfhi(v); }
            float o0 = 0.f, o1 = 0.f;
            for (int g = 0; g < ng; ++g) {
                asm volatile("" ::: "memory");
                const int m = g * 64 + lane;
                const u32x4* kr = (const u32x4*)(P + (size_t)(b * SEQL + m) * NPROJ + C_KR + h * 128);
                float d0 = 0.f, d1 = 0.f, d2 = 0.f, d3 = 0.f;
#pragma unroll
                for (int c = 0; c < 16; ++c) { const u32x4 v = kr[c]; const f32x4 qa = *(const f32x4*)(qv + 8 * c), qb = *(const f32x4*)(qv + 8 * c + 4);
                    d0 += qa[0] * bflo(v.x) + qb[0] * bflo(v.z); d1 += qa[1] * bfhi(v.x) + qb[1] * bfhi(v.z); d2 += qa[2] * bflo(v.y) + qb[2] * bflo(v.w); d3 += qa[3] * bfhi(v.y) + qb[3] * bfhi(v.w); }
                const float dot = (d0 + d1) + (d2 + d3);
                wl[lane] = (m <= n) ? dot * exp2f((float)(n - m) * lgam) : 0.f;
                const int jmax = (g == ng - 1) ? (n & 63) : 63;
                for (int j = 0; j <= jmax; ++j) {
                    const float wj = wl[j];
                    const unsigned v = *(const unsigned*)(P + (size_t)(b * SEQL + g * 64 + j) * NPROJ + C_VR + h * 128 + 2 * lane);
                    o0 += wj * bflo(v); o1 += wj * bfhi(v);
                }
            }
            const float mu = wave_sum(o0 + o1, lane) * (1.0f / 128.0f); const float e0 = o0 - mu, e1 = o1 - mu;
            const float rs = 1.0f / sqrtf(wave_sum(e0 * e0 + e1 * e1, lane) * (1.0f / 128.0f) + EPS_F);
            const unsigned gv = *(const unsigned*)(P + (size_t)t * NPROJ + C_GR + h * 128 + 2 * lane);
            const float y0 = siluf_(bflo(gv)) * e0 * rs * g_ret[h * 128 + 2 * lane], y1 = siluf_(bfhi(gv)) * e1 * rs * g_ret[h * 128 + 2 * lane + 1];
            *(unsigned*)(OBX + (size_t)t * 1024 + h * 128 + 2 * lane) = pkbf(y0, y1);
        }
    }
    __syncthreads();
#endif
    { const int l__ = (int)__builtin_amdgcn_mbcnt_hi(~0u, __builtin_amdgcn_mbcnt_lo(~0u, (unsigned)hide_i(0))); split_wait(xbar, (unsigned*)(p.ws + WS_CTL) + CTL_SPLIT + 64, wave_id * 64 + l__); }
    {
        PH_LOCALS
        const float* g_ret = IN(5);
        for (int pr = bx; pr < 256; pr += G) {
            const int bh = pr >> 2, i = pr & 3, b = bh >> 3, h = bh & 7;
            const float lgam = (h == 0) ? -0.04580368961312479f : (h == 1) ? -0.02272007650008353f : (h == 2) ? -0.011315313227834146f : (h == 3) ? -0.005646563141142063f :
                               (h == 4) ? -0.0028205190623786626f : (h == 5) ? -0.0014095702546713536f : (h == 6) ? -0.0007046129765893727f : -0.0003522634716290214f;
#pragma unroll 1
            for (int uu = 0; uu < 2; ++uu) {
                const int qb = uu ? 7 - i : i; const int n0 = qb * 256;
                fa::UnitArgs U; U.Q = P + (size_t)(b * SEQL + n0) * NPROJ + C_QR + h * 128; U.ldq = NPROJ;
                U.K = P + (size_t)(b * SEQL + n0) * NPROJ + C_KR + h * 128; U.V = P + (size_t)(b * SEQL + n0) * NPROJ + C_VR + h * 128; U.ldk = NPROJ; U.mask = nullptr;
                U.ntiles = 4; U.n0 = 0; U.lgam = lgam;
                fa::f32x16 o[4]; float l_reg;
                if (qb > 0) {
                    const bf16_t* UST = (const bf16_t*)(ws + WS_XN) + (size_t)(bh * 7) * 16384;
                    const int t_ = hide_i(tid), sr_ = t_ >> 4, sc_ = (t_ & 15) * 8;
                    float sa[4][8];
#pragma unroll
                    for (int k = 0; k < 4; ++k)
#pragma unroll
                        for (int e = 0; e < 8; ++e) sa[k][e] = 0.f;
                    u32x4 cu[4];
                    { const bf16_t* up = UST + sr_ * 128 + sc_;
#pragma unroll
                      for (int k = 0; k < 4; ++k) cu[k] = *(const u32x4*)(up + k * 32 * 128); }
#pragma unroll 1
                    for (int j = 0; j < qb; ++j) {
                        const float w_ = __builtin_amdgcn_exp2f(lgam * (float)(256 * (qb - 1 - j)));
                        const bf16_t* up = UST + (size_t)((j + 1 < qb) ? j + 1 : j) * 16384 + sr_ * 128 + sc_;
                        u32x4 nu[4];
#pragma unroll
                        for (int k = 0; k < 4; ++k) nu[k] = *(const u32x4*)(up + k * 32 * 128);
#pragma unroll
                        for (int k = 0; k < 4; ++k) { const u32x4 v = cu[k];
                            sa[k][0] += w_ * bflo(v.x); sa[k][1] += w_ * bfhi(v.x); sa[k][2] += w_ * bflo(v.y); sa[k][3] += w_ * bfhi(v.y);
                            sa[k][4] += w_ * bflo(v.z); sa[k][5] += w_ * bfhi(v.z); sa[k][6] += w_ * bflo(v.w); sa[k][7] += w_ * bfhi(v.w); cu[k] = nu[k]; }
                    }
#pragma unroll
                    for (int k = 0; k < 4; ++k) { u32x4 w; w.x = pkbf(sa[k][0], sa[k][1]); w.y = pkbf(sa[k][2], sa[k][3]); w.z = pkbf(sa[k][4], sa[k][5]); w.w = pkbf(sa[k][6], sa[k][7]);
                        *(LAS u32x4*)((LAS char*)lds + fa::OFF_V + (k >> 1) * fa::TILE_B + fa::v_st((k & 1) * 32 + sr_, sc_)) = w; }
                    __syncthreads();
                    fa::unit_body<1, 0, true>((LAS char*)lds, U, tid, o, l_reg);
                } else
                    fa::unit_body<1>((LAS char*)lds, U, tid, o, l_reg);
                const int r32 = lane & 31, hi = lane >> 5;
                const int tok0 = hide_i(b * SEQL + n0 + wave * 32 + 4 * hi);
                float gr[4];
#pragma unroll
                for (int d0 = 0; d0 < 4; ++d0) gr[d0] = g_ret[h * 128 + d0 * 32 + r32];
                u32x4 gv[8];
                { const int tokb_ = hide_i(b * SEQL + n0 + wave * 32), lnx_ = hide_i(lane);
#pragma unroll
                  for (int k = 0; k < 8; ++k) { const int c = lnx_ + 64 * k, orow = c >> 4, ch = c & 15; gv[k] = __builtin_nontemporal_load((const u32x4*)(P + (size_t)(tokb_ + orow) * NPROJ + C_GR + h * 128 + ch * 8)); } }
                __builtin_amdgcn_sched_barrier(0);
                float sv[16], qv[16];
#pragma unroll
                for (int r = 0; r < 16; ++r) sv[r] = (o[0][r] + o[1][r]) + (o[2][r] + o[3][r]);
#pragma unroll
                for (int x = 1; x < 32; x <<= 1)
#pragma unroll
                    for (int r = 0; r < 16; ++r) sv[r] += shx(sv[r], lane, x);
#pragma unroll
                for (int r = 0; r < 16; ++r) { const float mu = sv[r] * (1.0f / 128.0f); sv[r] = mu;
                    const float e0 = o[0][r] - mu, e1 = o[1][r] - mu, e2 = o[2][r] - mu, e3 = o[3][r] - mu; qv[r] = (e0 * e0 + e1 * e1) + (e2 * e2 + e3 * e3); }
#pragma unroll
                for (int x = 1; x < 32; x <<= 1)
#pragma unroll
                    for (int r = 0; r < 16; ++r) qv[r] += shx(qv[r], lane, x);
                LAS char* Tw = (LAS char*)lds + fa::OFF_Q + wave * 8704; LAS char* Tl = Tw + hi * (4 * 272) + r32 * 2; asm volatile("" : "+v"(Tl));
#pragma unroll
                for (int r = 0; r < 16; ++r) {
                    const float mu = sv[r]; const float rs = 1.0f / sqrtf(qv[r] * (1.0f / 128.0f) + EPS_F); const int orow = fa::crow(r, hi);
#pragma unroll
                    for (int d0 = 0; d0 < 4; ++d0) *(LAS bf16_t*)(Tl + ((r & 3) + 8 * (r >> 2)) * 272 + d0 * 64) = (bf16_t)(pkbf((o[d0][r] - mu) * rs * gr[d0], 0.f) & 0xffffu);
                }
                asm volatile("s_waitcnt lgkmcnt(0)" ::: "memory");
                const int tokb = hide_i(b * SEQL + n0 + wave * 32); const int ln_ = hide_i(lane);
#pragma unroll
                for (int k = 0; k < 8; ++k) {
                    const int c = ln_ + 64 * k, orow = c >> 4, ch = c & 15;
                    const u32x4 v = *(const LAS u32x4*)(Tw + orow * 272 + ch * 16);
                    const size_t tok = (size_t)(tokb + orow);
                    const u32x4 g = gv[k];
                    u32x4 w; w.x = pkbf(siluf_(bflo(g.x)) * bflo(v.x), siluf_(bfhi(g.x)) * bfhi(v.x)); w.y = pkbf(siluf_(bflo(g.y)) * bflo(v.y), siluf_(bfhi(g.y)) * bfhi(v.y));
                    w.z = pkbf(siluf_(bflo(g.z)) * bflo(v.z), siluf_(bfhi(g.z)) * bfhi(v.z)); w.w = pkbf(siluf_(bflo(g.w)) * bflo(v.w), siluf_(bfhi(g.w)) * bfhi(v.w));
                    *(u32x4*)(OB + tok * 2048 + h * 128 + ch * 8) = w;
                }
                __syncthreads();
            }
        }
    }
    STAMP(20);
    { const int l__ = (int)__builtin_amdgcn_mbcnt_hi(~0u, __builtin_amdgcn_mbcnt_lo(~0u, (unsigned)hide_i(0))); split_wait(xbar, (unsigned*)(p.ws + WS_CTL) + CTL_SPLIT + 128, wave_id * 64 + l__); }
    {
        PH_LOCALS
        for (int pr = bx; pr < 256; pr += G) {
            const int b = pr >> 5, i = pr & 31;
#pragma unroll 1
            for (int uu = 0; uu < 2; ++uu) {
                const int qb = uu ? 63 - i : i; const int t0 = b * SEQL + qb * 32;
                fa::UnitArgs U; U.Q = P + (size_t)t0 * NPROJ + C_QLAT; U.ldq = NPROJ; U.K = KV + (size_t)b * SEQL * 128; U.V = U.K; U.ldk = 128; U.mask = MASK + (size_t)t0 * 32;
                U.ntiles = (qb >> 1) + 1; U.n0 = 0; U.lgam = 0.f;
                fa::f32x16 o[4]; float l_reg;
                fa::unit_body<0>((LAS char*)lds, U, tid, o, l_reg);
                const int r32 = lane & 31, hi = lane >> 5;
                const int trow1 = hide_i(t0);
                LAS float* li_l = (LAS float*)(lds + fa::OFF_WS) + wave * 64;
                if (hi == 0) li_l[r32] = l_reg;
                asm volatile("s_waitcnt lgkmcnt(0)" ::: "memory");
                LAS char* Tw = (LAS char*)lds + fa::OFF_Q + wave * 8704; LAS char* Tl = Tw + hi * (4 * 272) + r32 * 2; asm volatile("" : "+v"(Tl));
#pragma unroll
                for (int r = 0; r < 16; ++r) {
                    const int orow = fa::crow(r, hi); const float rl = __builtin_amdgcn_rcpf(li_l[orow]);
#pragma unroll
                    for (int d0 = 0; d0 < 4; ++d0) *(LAS bf16_t*)(Tl + ((r & 3) + 8 * (r >> 2)) * 272 + d0 * 64) = (bf16_t)(pkbf(o[d0][r] * rl, 0.f) & 0xffffu);
                }
                asm volatile("s_waitcnt lgkmcnt(0)" ::: "memory");
#pragma unroll
                for (int k = 0; k < 8; ++k) {
                    const int c = hide_i(lane) + 64 * k, orow = c >> 4, ch = c & 15;
                    const u32x4 v = *(const LAS u32x4*)(Tw + orow * 272 + ch * 16);
                    *(u32x4*)(OA + (size_t)(trow1 + orow) * 2048 + wave * 128 + ch * 8) = v;
                }
                __syncthreads();
            }
        }
    }
#ifdef RET_EXP
    XBAR();
    STAMP(30);
    {
        PH_LOCALS
        const float* g_ret = IN(5);
        for (int pr = bx; pr < 256; pr += G) {
            const int bh = pr >> 2, i = pr & 3, b = bh >> 3, h = bh & 7;
            const float lgam = (h == 0) ? -0.04580368961312479f : (h == 1) ? -0.02272007650008353f : (h == 2) ? -0.011315313227834146f : (h == 3) ? -0.005646563141142063f :
                               (h == 4) ? -0.0028205190623786626f : (h == 5) ? -0.0014095702546713536f : (h == 6) ? -0.0007046129765893727f : -0.0003522634716290214f;
#pragma unroll 1
            for (int uu = 0; uu < 2; ++uu) {
                const int qb = uu ? 7 - i : i; const int n0 = qb * 256;
                fa::UnitArgs U; U.Q = P + (size_t)(b * SEQL + n0) * NPROJ + C_QR + h * 128; U.ldq = NPROJ;
                U.K = P + (size_t)(b * SEQL) * NPROJ + C_KR + h * 128; U.V = P + (size_t)(b * SEQL) * NPROJ + C_VR + h * 128; U.ldk = NPROJ; U.mask = nullptr;
                U.ntiles = 4 * (qb + 1); U.n0 = n0; U.lgam = lgam;
                fa::f32x16 o[4]; float l_reg;
                fa::unit_body<1, RET_EXP>((LAS char*)lds, U, tid, o, l_reg);
                const int r32 = lane & 31, hi = lane >> 5;
                const int tok0 = hide_i(b * SEQL + n0 + wave * 32 + 4 * hi);
                float gr[4];
#pragma unroll
                for (int d0 = 0; d0 < 4; ++d0) gr[d0] = g_ret[h * 128 + d0 * 32 + r32];
                if (RET_EXP & 8) { fa::f32x16 t_ = (o[0] + o[1]) + (o[2] + o[3]); float z_ = 0.f;
#pragma unroll
                    for (int r = 0; r < 16; ++r) z_ += t_[r];
                    ((float*)(ws + WS_SPARE))[(size_t)(pr * 2 + uu) * 512 + tid] = z_; }
                else
#pragma unroll
                for (int r = 0; r < 16; ++r) {
                    float s = (o[0][r] + o[1][r]) + (o[2][r] + o[3][r]);
#pragma unroll
                    for (int x = 1; x < 32; x <<= 1) s += shx(s, lane, x);
                    const float mu = s * (1.0f / 128.0f);
                    const float e0 = o[0][r] - mu, e1 = o[1][r] - mu, e2 = o[2][r] - mu, e3 = o[3][r] - mu;
                    float q = (e0 * e0 + e1 * e1) + (e2 * e2 + e3 * e3);
#pragma unroll
                    for (int x = 1; x < 32; x <<= 1) q += shx(q, lane, x);
                    const float rs = 1.0f / sqrtf(q * (1.0f / 128.0f) + EPS_F);
                    const size_t tok = (size_t)(tok0 + (r & 3) + 8 * (r >> 2));
                    const bf16_t* gp = P + tok * NPROJ + C_GR + h * 128 + r32; bf16_t* op = (bf16_t*)(ws + WS_SPARE) + tok * 1024 + h * 128 + r32;
                    op[0] = (bf16_t)(pkbf(siluf_(bflo((unsigned)gp[0])) * e0 * rs * gr[0], 0.f) & 0xffffu);
                    op[32] = (bf16_t)(pkbf(siluf_(bflo((unsigned)gp[32])) * e1 * rs * gr[1], 0.f) & 0xffffu);
                    op[64] = (bf16_t)(pkbf(siluf_(bflo((unsigned)gp[64])) * e2 * rs * gr[2], 0.f) & 0xffffu);
                    op[96] = (bf16_t)(pkbf(siluf_(bflo((unsigned)gp[96])) * e3 * rs * gr[3], 0.f) & 0xffffu);
                }
                __syncthreads();
            }
        }
    }
    XBAR();
    STAMP(31);
#endif
#if DBG_CMP
    XBAR();
    {
        PH_LOCALS
        const bf16_t* A_ = (DBG_CMP == 1) ? OA : OB; const bf16_t* R_ = (const bf16_t*)(ws + WS_SPARE);
        float sd = 0.f, sr = 0.f;
#if DBG_CMP == 3
        for (size_t i = (size_t)gtid; i < (size_t)T_TOK * 32; i += (size_t)NGT) { const u64 a = MASK[i], r = ((const u64*)(ws + WS_SPARE))[i]; sd += (float)__popcll(a ^ r); sr += 100.0f * (float)__popcll(r); }
#else
        for (size_t i = (size_t)gtid; i < (size_t)T_TOK * 1024 / 2; i += (size_t)NGT) {
            const unsigned a = ((const unsigned*)A_)[(i >> 9) * 1024 + (i & 511)], r = ((const unsigned*)R_)[i];
            const float d0 = bflo(a) - bflo(r), d1 = bfhi(a) - bfhi(r); sd += d0 * d0 + d1 * d1; sr += bflo(r) * bflo(r) + bfhi(r) * bfhi(r);
        }
#endif
        sd = wave_sum(sd, lane); sr = wave_sum(sr, lane);
        if (lane == 0) { atomicAdd((float*)(ctl + 4096), sd); atomicAdd((float*)(ctl + 4097), sr); }
    }
#endif
    XBAR();
    STAMP(4);

    {
        PH_LOCALS
        pg8::Gemm g{OA, WCOMB, T_TOK, DMODEL, 2048}; pg8::StaticOrder S; S.init(T_TOK, DMODEL, G, bx);
        pg8::EpiMergeF E{P, MIXED};
        pg8::gemm_phase<pg8::EpiMergeF, pg8::StaticOrder, true, true>(lds, g, S, E, tid);
    }
    XBAR();
    STAMP(5);
    {
        PH_LOCALS
        pg8::Gemm g{MIXED, WO, T_TOK, DMODEL, 2048}; pg8::StaticOrder S; S.init(T_TOK, DMODEL, G, bx);
        pg8::EpiD E{OA};
        pg8::gemm_phase<pg8::EpiD, pg8::StaticOrder, true, true>(lds, g, S, E, tid);
    }
    XBAR();
    STAMP(7);
#ifdef GEMM_EXP
    {
        PH_LOCALS
        pg8::Gemm g{MIXED, WO, T_TOK, DMODEL, 2048}; pg8::StaticOrder S; S.init(T_TOK, DMODEL, G, bx);
        pg8::EpiNull E{(float*)(ws + WS_SPARE)};
        pg8::gemm_phase<pg8::EpiNull, pg8::StaticOrder, true, true>(lds, g, S, E, tid);
    }
    XBAR();
    STAMP(31);
#endif

    {
    PH_LOCALS
    const float* g_ffn = IN(8); const float* b_rg = IN(10); const float* b_re = IN(12); const float* x_in = IN(0);
    const f32x4* WC4 = (const f32x4*)(ws + WS_WC);
    int* row_tok2 = (int*)(ws + WS_SPARE); float* row_gate2 = (float*)(ws + WS_SPARE + 2097152); float* row_rs2 = (float*)(ws + WS_SPARE + 4194304);
    LAS char* TNs = (LAS char*)lds + wave * 16384;
    const int row = lane & 15, g4 = lane >> 4;
    LAS float* Gs = (LAS float*)((LAS char*)lds + 131072);
    ((LAS f32x4*)Gs)[tid] = ((const f32x4*)g_ffn)[tid];
    __syncthreads();
#define R6_DECL(S) f32x4 S##xA0, S##xA1, S##xB0, S##xB1; u32x4 S##dA, S##dB
#define R6_DECLW(S) f32x4 S##w00, S##w01, S##w10, S##w11, S##w20, S##w21
#define R6_LOAD(S, i) do { const int o_ = 32 * (i); S##xA0 = *(const f32x4*)(hA + o_); S##xA1 = *(const f32x4*)(hA + o_ + 4); S##xB0 = *(const f32x4*)(hB + o_); S##xB1 = *(const f32x4*)(hB + o_ + 4); \
        S##dA = *(const u32x4*)(dA + o_); S##dB = *(const u32x4*)(dB + o_); } while (0)
#define R6_LOADW(S, i) do { const f32x4* wn_ = wp + (size_t)(i) * 384; S##w00 = wn_[0]; S##w01 = wn_[1]; S##w10 = wn_[32]; S##w11 = wn_[33]; S##w20 = wn_[64]; S##w21 = wn_[65]; } while (0)
#define R6_COPY(D, S) do { D##xA0 = S##xA0; D##xA1 = S##xA1; D##xB0 = S##xB0; D##xB1 = S##xB1; D##dA = S##dA; D##dB = S##dB; } while (0)
#define R6_COPYW(D, S) do { D##w00 = S##w00; D##w01 = S##w01; D##w10 = S##w10; D##w11 = S##w11; D##w20 = S##w20; D##w21 = S##w21; } while (0)
#define R6_TILE(X0, X1, DD, C0, C1, C2, SSQ, RB) do { f32x4 a0 = X0, a1 = X1; const u32x4 ad = DD; \
        a0[0] += bflo(ad.x); a0[1] += bfhi(ad.x); a0[2] += bflo(ad.y); a0[3] += bfhi(ad.y); a1[0] += bflo(ad.z); a1[1] += bfhi(ad.z); a1[2] += bflo(ad.w); a1[3] += bfhi(ad.w);     \
        { u32x2 tn; tn.x = pk4f8(a0[0] * q0[0], a0[1] * q0[1], a0[2] * q0[2], a0[3] * q0[3]); tn.y = pk4f8(a1[0] * q1[0], a1[1] * q1[1], a1[2] * q1[2], a1[3] * q1[3]); \
          *(LAS u32x2*)(TNs + ((RB) + row) * 512 + ((32 * it + 8 * g4) ^ ((row & 7) << 5))) = tn; } \
        SSQ += (a0[0] * a0[0] + a0[1] * a0[1]) + (a0[2] * a0[2] + a0[3] * a0[3]) + (a1[0] * a1[0] + a1[1] * a1[1]) + (a1[2] * a1[2] + a1[3] * a1[3]); \
        _Pragma("unroll") for (int s_ = 0; s_ < 4; ++s_) { C0 = __builtin_amdgcn_mfma_f32_16x16x4f32(a0[s_], cw00[s_], C0, 0, 0, 0); C1 = __builtin_amdgcn_mfma_f32_16x16x4f32(a0[s_], cw10[s_], C1, 0, 0, 0); C2 = __builtin_amdgcn_mfma_f32_16x16x4f32(a0[s_], cw20[s_], C2, 0, 0, 0); } \
        _Pragma("unroll") for (int s_ = 0; s_ < 4; ++s_) { C0 = __builtin_amdgcn_mfma_f32_16x16x4f32(a1[s_], cw01[s_], C0, 0, 0, 0); C1 = __builtin_amdgcn_mfma_f32_16x16x4f32(a1[s_], cw11[s_], C1, 0, 0, 0); C2 = __builtin_amdgcn_mfma_f32_16x16x4f32(a1[s_], cw21[s_], C2, 0, 0, 0); } } while (0)
    for (int blk = bx; blk < T_TOK / 64; blk += G) {
        const int tp = wave & 1, kq = wave >> 1;
        const int tok0 = blk * 64 + tp * 32;
        const float* hA = x_in + (size_t)(tok0 + row) * DMODEL + 8 * g4 + 512 * kq; const float* hB = hA + (size_t)16 * DMODEL;
        const bf16_t* dA = OA + (size_t)(tok0 + row) * DMODEL + 8 * g4 + 512 * kq; const bf16_t* dB = dA + (size_t)16 * DMODEL;
        const f32x4* wp = WC4 + (size_t)g4 * 96 + 2 * row + (size_t)kq * 16 * 384;
        f32x4 cA0 = (f32x4){0.f, 0.f, 0.f, 0.f}, cA1 = cA0, cA2 = cA0, cB0 = cA0, cB1 = cA0, cB2 = cA0; float ssqA = 0.f, ssqB = 0.f;
        R6_DECL(c); R6_DECL(n); R6_DECLW(c);
        R6_LOAD(c, 0); R6_LOADW(c, 0); R6_LOAD(n, 1);
        for (int it = 0; it < 16; ++it) {
            const int itn = (it + 2 < 16) ? it + 2 : 15, itw = (it + 1 < 16) ? it + 1 : 15;
            R6_DECLW(n); R6_LOADW(n, itw);
            R6_DECL(m); R6_LOAD(m, itn);
            const LAS f32x4* gq = (const LAS f32x4*)(Gs + 8 * g4 + 512 * kq + 32 * it); const f32x4 q0 = gq[0], q1 = gq[1];
            R6_TILE(cxA0, cxA1, cdA, cA0, cA1, cA2, ssqA, 0);
            R6_TILE(cxB0, cxB1, cdB, cB0, cB1, cB2, ssqB, 16);
            R6_COPY(c, n); R6_COPY(n, m); R6_COPYW(c, n);
        }
        asm volatile("s_waitcnt lgkmcnt(0)" ::: "memory");
        { const int lnx = hide_i(lane), tkx = hide_i(tok0 * DMODEL + 512 * kq);
#pragma unroll
        for (int k = 0; k < 16; ++k) { const int r = 2 * k + (lnx >> 5), c16 = lnx & 31;
            *(u32x4*)((unsigned char*)TN + (size_t)(unsigned)(tkx + r * DMODEL + 16 * c16)) = *(const LAS u32x4*)(TNs + r * 512 + ((16 * c16) ^ ((r & 7) << 5))); } }
        asm volatile("s_waitcnt lgkmcnt(0)" ::: "memory");
        const int lnc = hide_i(lane);
        LAS float* part = (LAS float*)TNs + lnc;
        if (kq != 0) {
#pragma unroll
            for (int r = 0; r < 4; ++r) { part[r * 64] = cA0[r]; part[(4 + r) * 64] = cA1[r]; part[(8 + r) * 64] = cA2[r];
                                          part[832 + r * 64] = cB0[r]; part[832 + (4 + r) * 64] = cB1[r]; part[832 + (8 + r) * 64] = cB2[r]; }
            part[12 * 64] = ssqA; part[832 + 12 * 64] = ssqB;
        }
        __syncthreads();
        if (kq == 0) {
#pragma unroll
            for (int k = 1; k < 4; ++k) { const LAS float* pp = (const LAS float*)((LAS char*)lds + hide_i((tp + 2 * k) * 16384)) + lnc;
#pragma unroll
                for (int r = 0; r < 4; ++r) { cA0[r] += pp[r * 64]; cA1[r] += pp[(4 + r) * 64]; cA2[r] += pp[(8 + r) * 64];
                                              cB0[r] += pp[832 + r * 64]; cB1[r] += pp[832 + (4 + r) * 64]; cB2[r] += pp[832 + (8 + r) * 64]; }
                ssqA += pp[12 * 64]; ssqB += pp[832 + 12 * 64]; }
            ssqA += shx(ssqA, lane, 16); ssqA += shx(ssqA, lane, 32); ssqB += shx(ssqB, lane, 16); ssqB += shx(ssqB, lane, 32);
            const float ssq_ = (lane & 16) ? ssqB : ssqA;
            const float rstd = 1.0f / sqrtf(ssq_ * (1.0f / DMODEL) + EPS_F);
            LAS float* lg = (LAS float*)(TNs + 8192);
#pragma unroll
            for (int r = 0; r < 4; ++r) { lg[(4 * g4 + r) * 52 + row] = cA0[r]; lg[(4 * g4 + r) * 52 + 16 + row] = cA1[r]; lg[(4 * g4 + r) * 52 + 32 + row] = cA2[r];
                                          lg[832 + (4 * g4 + r) * 52 + row] = cB0[r]; lg[832 + (4 * g4 + r) * 52 + 16 + row] = cB1[r]; lg[832 + (4 * g4 + r) * 52 + 32 + row] = cB2[r]; }
            asm volatile("s_waitcnt lgkmcnt(0)" ::: "memory");
            if (lane < 32) {
                const int t = tok0 + lane; const LAS float* lr = lg + (lane >> 4) * 832 + (lane & 15) * 52;
                float gl[4];
#pragma unroll
                for (int k = 0; k < 4; ++k) gl[k] = lr[k] * rstd + b_rg[k];
                int grp = 0; float gmx = gl[0];
#pragma unroll
                for (int k = 1; k < 4; ++k) if (gl[k] > gmx) { gmx = gl[k]; grp = k; }
                float gz = 0.f;
#pragma unroll
                for (int k = 0; k < 4; ++k) gz += __expf(gl[k] - gmx);
                const float p_grp = 1.0f / gz;
                float el[8];
#pragma unroll
                for (int k = 0; k < 8; ++k) el[k] = lr[4 + grp * 8 + k] * rstd + b_re[grp * 8 + k];
                int i1 = 0; float m1 = el[0];
#pragma unroll
                for (int k = 1; k < 8; ++k) if (el[k] > m1) { m1 = el[k]; i1 = k; }
                int i2 = -1; float m2 = -INFINITY;
#pragma unroll
                for (int k = 0; k < 8; ++k) if (k != i1 && el[k] > m2) { m2 = el[k]; i2 = k; }
                const float e2 = __expf(m2 - m1); const float den = 1.0f / (1.0f + e2);
                const float g1 = p_grp * den, g2 = p_grp * e2 * den;
                const int ex1 = grp * 8 + i1, ex2 = grp * 8 + i2;
                const unsigned r1 = atomicAdd(ctl + 64 * ex1, 1u), r2 = atomicAdd(ctl + 64 * ex2, 1u);
                const int s1 = ex1 * 16384 + (int)r1, s2 = ex2 * 16384 + (int)r2;
                row_tok2[s1] = t; row_tok2[s2] = t; row_gate2[s1] = g1; row_gate2[s2] = g2; row_rs2[s1] = rstd; row_rs2[s2] = rstd; tok_slot[2 * t] = s1; tok_slot[2 * t + 1] = s2;
            }
        }
        __syncthreads();
    }
#undef R6_DECL
#undef R6_LOAD
#undef R6_COPY
#undef R6_DECLW
#undef R6_LOADW
#undef R6_COPYW
#undef R6_TILE
    }
    XBAR();
    STAMP(8);

    LAS int* tile_start = (LAS int*)(lds + LDS_MISC);
    {
    PH_LOCALS
    if (wave == 0) {
        const int c = (lane < 32) ? (int)__hip_atomic_load(ctl + 64 * lane, __ATOMIC_RELAXED, __HIP_MEMORY_SCOPE_AGENT) : 0;
        int v = (c + 255) >> 8; const int own = v;
#pragma unroll
        for (int d = 1; d < 32; d <<= 1) { const int o = __shfl_up(v, d, 64); if (lane >= d) v += o; }
        if (lane < 32) { tile_start[lane] = v - own; tile_start[128 + lane] = c; }
        if (lane == 31) tile_start[32] = v;
    }
    __syncthreads();
    }
    STAMP(9);

    {
        const int cperm = (G % 8 == 0) ? (bx % 8) * (G / 8) + bx / 8 : bx;
        const int total = __builtin_amdgcn_readfirstlane(tile_start[32] * 8); const int full = (4 * G < total) ? 4 * G : total; const int n5 = total - 4 * G;
        const int nidle = (n5 >= 0 && n5 < G) ? G - n5 : 0;
#if EARLY2
        const int nearly = (n5 <= nidle) ? nidle : ((n5 < 2 * nidle) ? n5 : 2 * nidle);
#else
        const int nearly = nidle;
#endif
#pragma unroll 1
        for (int part = 0; part < 2; ++part) {
            if (part == 1 && full + cperm >= total) break;
            {
                PH_LOCALS
                pg8::Gemm g{TN, (const bf16_t*)WGU, MAXSLOT, 2048, 1024};
                pg8::ExpertOrderT<true> S{tile_start, G, cperm, (const int*)(ws + WS_SPARE), part ? full : 0, part ? total : full};
                pg8::EpiSwiglu E{(unsigned char*)HMID, (const float*)(ws + WS_SPARE + 4194304), tile_start};
                pg8::gemm_phase<pg8::EpiSwiglu, pg8::ExpertOrderT<true>, true, true>(lds, g, S, E, tid);
            }
            if (part == 0) { const int l__ = (int)__builtin_amdgcn_mbcnt_hi(~0u, __builtin_amdgcn_mbcnt_lo(~0u, (unsigned)hide_i(0))); split_arrive(xbar, (unsigned*)(p.ws + WS_CTL) + CTL_SPLIT, wave_id * 64 + l__); }
        }
        STAMP(10);
#pragma unroll 1
        for (int part = 0; part < 2; ++part) {
            int c9 = cperm, base9 = nearly, lim9 = total;
            if (part == 0) {
                if (nearly == 0 || cperm < n5) continue;
                { const int l__ = (int)__builtin_amdgcn_mbcnt_hi(~0u, __builtin_amdgcn_mbcnt_lo(~0u, (unsigned)hide_i(0))); split_wait(xbar, (unsigned*)(p.ws + WS_CTL) + CTL_SPLIT, wave_id * 64 + l__); }
                c9 = cperm - n5; base9 = 0; lim9 = nearly;
            } else XBAR();
            {
                PH_LOCALS
                pg8::Gemm g{HMID, (const bf16_t*)WD, MAXSLOT, 2048, 512};
                pg8::ExpertOrderT<false> S{tile_start, (part == 0) ? nidle : G, c9, nullptr, base9, lim9};
                pg8::EpiDown E{Y, (const float*)(ws + WS_SPARE + 2097152), tile_start};
                pg8::gemm_phase<pg8::EpiDown, pg8::ExpertOrderT<false>, true, true>(lds, g, S, E, tid);
            }
        }
    }
    XBAR();
    STAMP(11);
#if PROF_PHASE >= 0
    XBAR();
#endif

    {
    PH_LOCALS
    const float* g_fin = IN(16); const float* x_in = IN(0);
#if DBG_CMP
#ifdef DBG_STRICT
    const float dbg_scale = (__hip_atomic_load((float*)(ctl + 4096), __ATOMIC_RELAXED, __HIP_MEMORY_SCOPE_AGENT) > 0.0f) ? 2.0f : 1.0f;
#else
    const float dbg_scale = 1.0f + 4.0f * sqrtf(__hip_atomic_load((float*)(ctl + 4096), __ATOMIC_RELAXED, __HIP_MEMORY_SCOPE_AGENT) / __hip_atomic_load((float*)(ctl + 4097), __ATOMIC_RELAXED, __HIP_MEMORY_SCOPE_AGENT));
#endif
#elif PROF_PHASE >= 0 && (PROF_PHASE % 100) != 12
    const unsigned ta_ = __hip_atomic_load(ctl + 6000 + (PROF_PHASE / 100), __ATOMIC_RELAXED, __HIP_MEMORY_SCOPE_AGENT), tb_ = __hip_atomic_load(ctl + 6000 + (PROF_PHASE % 100), __ATOMIC_RELAXED, __HIP_MEMORY_SCOPE_AGENT);
    const float dbg_scale = 1.0f + sqrtf(PROF_SCALE * (float)(tb_ - ta_) * 0.01f);
#else
    const float dbg_scale = 1.0f;
#endif
    int nsa0 = 0, nsa1 = 0, nsb0 = 0, nsb1 = 0;
    if (gw < T_TOK) { const int u1 = (gw + NGW < T_TOK) ? gw + NGW : gw; nsa0 = tok_slot[2 * gw]; nsa1 = tok_slot[2 * gw + 1]; nsb0 = tok_slot[2 * u1]; nsb1 = tok_slot[2 * u1 + 1]; }
    for (int t = gw; t < T_TOK; t += 2 * NGW) {
        const int t1 = (t + NGW < T_TOK) ? t + NGW : t;
        int sa0 = nsa0, sa1 = nsa1, sb0 = nsb0, sb1 = nsb1;
        sa0 = tile_start[sa0 >> 14] * 256 + (sa0 & 16383); sa1 = tile_start[sa1 >> 14] * 256 + (sa1 & 16383); sb0 = tile_start[sb0 >> 14] * 256 + (sb0 & 16383); sb1 = tile_start[sb1 >> 14] * 256 + (sb1 & 16383);
        f32x4* hra = (f32x4*)(out + (size_t)t * DMODEL) + lane; f32x4* hrb = (f32x4*)(out + (size_t)t1 * DMODEL) + lane;
        const f32x4* xa = (const f32x4*)(x_in + (size_t)t * DMODEL) + lane; const f32x4* xb = (const f32x4*)(x_in + (size_t)t1 * DMODEL) + lane;
        const u32x2* da = (const u32x2*)(OA + (size_t)t * DMODEL) + lane; const u32x2* db = (const u32x2*)(OA + (size_t)t1 * DMODEL) + lane;
        const u32x2* ya0 = (const u32x2*)(Y + (size_t)sa0 * DMODEL) + lane; const u32x2* ya1 = (const u32x2*)(Y + (size_t)sa1 * DMODEL) + lane;
        const u32x2* yb0 = (const u32x2*)(Y + (size_t)sb0 * DMODEL) + lane; const u32x2* yb1 = (const u32x2*)(Y + (size_t)sb1 * DMODEL) + lane;
        f32x4 va[8], vb[8]; u32x2 pa[8], qa[8], pb[8], qb[8], ea[8], eb[8];
#pragma unroll
        for (int j = 0; j < 8; ++j) { va[j] = __builtin_nontemporal_load(xa + 64 * j); vb[j] = __builtin_nontemporal_load(xb + 64 * j); ea[j] = __builtin_nontemporal_load(da + 64 * j); eb[j] = __builtin_nontemporal_load(db + 64 * j); pa[j] = __builtin_nontemporal_load(ya0 + 64 * j); qa[j] = __builtin_nontemporal_load(ya1 + 64 * j); pb[j] = __builtin_nontemporal_load(yb0 + 64 * j); qb[j] = __builtin_nontemporal_load(yb1 + 64 * j); }
        float ssa = 0.f, ssb = 0.f;
#pragma unroll
        for (int j = 0; j < 8; ++j) {
            va[j][0] += bflo(ea[j].x); va[j][1] += bfhi(ea[j].x); va[j][2] += bflo(ea[j].y); va[j][3] += bfhi(ea[j].y); vb[j][0] += bflo(eb[j].x); vb[j][1] += bfhi(eb[j].x); vb[j][2] += bflo(eb[j].y); vb[j][3] += bfhi(eb[j].y);
            va[j][0] += bflo(pa[j].x) + bflo(qa[j].x); va[j][1] += bfhi(pa[j].x) + bfhi(qa[j].x); va[j][2] += bflo(pa[j].y) + bflo(qa[j].y); va[j][3] += bfhi(pa[j].y) + bfhi(qa[j].y);
            vb[j][0] += bflo(pb[j].x) + bflo(qb[j].x); vb[j][1] += bfhi(pb[j].x) + bfhi(qb[j].x); vb[j][2] += bflo(pb[j].y) + bflo(qb[j].y); vb[j][3] += bfhi(pb[j].y) + bfhi(qb[j].y);
            ssa += (va[j][0] * va[j][0] + va[j][1] * va[j][1]) + (va[j][2] * va[j][2] + va[j][3] * va[j][3]);
            ssb += (vb[j][0] * vb[j][0] + vb[j][1] * vb[j][1]) + (vb[j][2] * vb[j][2] + vb[j][3] * vb[j][3]);
        }
        const float ra = dbg_scale / sqrtf(wave_sum(ssa, lane) * (1.0f / DMODEL) + EPS_F), rb = dbg_scale / sqrtf(wave_sum(ssb, lane) * (1.0f / DMODEL) + EPS_F);
        f32x4 ggv[8];
#pragma unroll
        for (int j = 0; j < 8; ++j) ggv[j] = ((const f32x4*)g_fin)[lane + 64 * j];
        { const int tn = t + 2 * NGW; if (tn < T_TOK) { const int u1 = (tn + NGW < T_TOK) ? tn + NGW : tn; nsa0 = tok_slot[2 * tn]; nsa1 = tok_slot[2 * tn + 1]; nsb0 = tok_slot[2 * u1]; nsb1 = tok_slot[2 * u1 + 1]; } }
        __builtin_amdgcn_sched_barrier(0);
#pragma unroll
        for (int j = 0; j < 8; ++j) { const f32x4 gg = ggv[j]; __builtin_nontemporal_store(va[j] * ra * gg, hra + 64 * j); if (t1 != t) __builtin_nontemporal_store(vb[j] * rb * gg, hrb + 64 * j); }
    }
    }
#if PROF_PHASE >= 0
    if (PROF_PHASE % 100 == 12) {
        XBAR(); STAMP(12); XBAR();
        PH_LOCALS
        const unsigned ta_ = __hip_atomic_load(ctl + 6000 + (PROF_PHASE / 100), __ATOMIC_RELAXED, __HIP_MEMORY_SCOPE_AGENT), tb_ = __hip_atomic_load(ctl + 6012, __ATOMIC_RELAXED, __HIP_MEMORY_SCOPE_AGENT);
        const float sc_ = 1.0f + sqrtf(PROF_SCALE * (float)(tb_ - ta_) * 0.01f);
        for (size_t i = (size_t)gtid; i < (size_t)T_TOK * DMODEL / 4; i += (size_t)NGT) { f32x4 v = ((f32x4*)out)[i]; ((f32x4*)out)[i] = v * sc_; }
    }
#endif
}

extern "C" void kernel_launch(void* const* d_in, const int* in_sizes, int n_in, void* d_out, int out_size, void* d_ws, size_t ws_size, hipStream_t stream) {
    static int grid_blocks = 0;
    if (grid_blocks == 0) {
        if (n_in != 17 || out_size != T_TOK * DMODEL || ws_size < WS_END) { fprintf(stderr, "kernel_launch: unexpected problem (n_in %d, out %d, ws %zu < %zu)\n", n_in, out_size, ws_size, (size_t)WS_END); grid_blocks = -1; return; }
        int dev = 0, cus = 0, per_cu = 0;
        (void)hipGetDevice(&dev);
        (void)hipDeviceGetAttribute(&cus, hipDeviceAttributeMultiprocessorCount, dev);
        if (hipFuncSetAttribute((const void*)mega_fwd, hipFuncAttributeMaxDynamicSharedMemorySize, LDS_BYTES) != hipSuccess) { fprintf(stderr, "kernel_launch: hipFuncSetAttribute failed\n"); grid_blocks = -1; return; }
        if (hipOccupancyMaxActiveBlocksPerMultiprocessor(&per_cu, (const void*)mega_fwd, 512, LDS_BYTES) != hipSuccess || per_cu < 1) { fprintf(stderr, "kernel_launch: occupancy query says %d\n", per_cu); grid_blocks = -1; return; }
        grid_blocks = cus;
        fprintf(stderr, "kernel_launch: cus %d per_cu %d grid %d ws %zu need %zu\n", cus, per_cu, grid_blocks, ws_size, (size_t)WS_END);
    }
    if (grid_blocks < 0) return;
    if (hipMemsetAsync((char*)d_ws + WS_CTL, 0, 65536, stream) != hipSuccess) { fprintf(stderr, "kernel_launch: memset of control words failed\n"); return; }
    Params prm{};
    for (int i = 0; i < 17; ++i) prm.in[i] = (const float*)d_in[i];
    prm.out = (float*)d_out; prm.ws = (unsigned char*)d_ws;
    void* args[] = {&prm};
    hipError_t e = hipLaunchCooperativeKernel((void*)mega_fwd, dim3(grid_blocks), dim3(512), args, LDS_BYTES, stream);
    if (e != hipSuccess) fprintf(stderr, "cooperative launch failed: %s (grid %d)\n", hipGetErrorString(e), grid_blocks);
}
```
